# Optimizing an MI355X kernel written in HIP

```python
import math
import jax, jax.numpy as jnp
from jax import lax
import numpy as np

D_MODEL = 1024
BATCH = 8
SEQ = 4096
DEPTH = 1

CHUNK = 64
RMS_EPS = 1e-6
S5_WIDTH = D_MODEL // 2
S5_GROUP = 16
S5_GROUPS = S5_WIDTH // S5_GROUP
S5_STATE = 64
S5_DT_MIN = 1e-3
S5_DT_MAX = 1e-1
LRU_WIDTH = D_MODEL
LRU_HEADS = 16
LRU_HEAD_DIM = LRU_WIDTH // LRU_HEADS
CONV_WIDTH = 4
LRU_C = 8.0
LRU_A_MIN = 0.9
LRU_A_MAX = 0.999
IN_WIDTH = S5_WIDTH + 2 * LRU_WIDTH + 2 * D_MODEL
N_GROUPS = 4
EXPERTS_PER_GROUP = 8
N_EXPERTS = N_GROUPS * EXPERTS_PER_GROUP
TOP_K = 2
D_EXPERT = D_MODEL // 2
MOE_BLOCK = 128

kernel_name = "hybrid_s5_rglru_hmoe_block"


def rms_norm(x, g):
    xf = x.astype(jnp.float32)
    y = xf * lax.rsqrt(jnp.mean(xf * xf, axis=-1, keepdims=True) + RMS_EPS)
    return (y * g.astype(jnp.float32)).astype(x.dtype)


def _linear_combine(left, right):
    a_l, b_l = left
    a_r, b_r = right
    return a_r * a_l, a_r * b_l + b_r


def s5_mixer(u, lam_re, lam_im, log_dt, b_re, b_im, c_re, c_im, d_skip):
    bsz, seq, _ = u.shape
    uf = u.astype(jnp.float32).reshape(bsz, seq, S5_GROUPS, S5_GROUP)
    lam = lax.complex(lam_re.astype(jnp.float32), lam_im.astype(jnp.float32))
    dt = jnp.exp(log_dt.astype(jnp.float32))[:, None]
    lam_bar = jnp.exp(lam * dt)
    bmat = lax.complex(b_re.astype(jnp.float32), b_im.astype(jnp.float32))
    b_bar = ((lam_bar - 1.0) / lam)[..., None] * bmat
    bu = jnp.einsum('gpc,blgc->blgp', b_bar, uf.astype(jnp.complex64))
    a = jnp.broadcast_to(lam_bar, (1, seq, S5_GROUPS, S5_STATE))
    _, s = lax.associative_scan(_linear_combine, (a, bu), axis=1)
    cmat = lax.complex(c_re.astype(jnp.float32), c_im.astype(jnp.float32))
    y = jnp.real(jnp.einsum('gcp,blgp->blgc', cmat, s))
    y = y + d_skip.astype(jnp.float32).reshape(S5_GROUPS, S5_GROUP) * uf
    return y.reshape(bsz, seq, S5_WIDTH)


def rglru_mixer(x, conv_w, conv_b, w_r, b_r, w_i, b_i, lam):
    bsz, seq, width = x.shape
    xp = jnp.pad(x, ((0, 0), (CONV_WIDTH - 1, 0), (0, 0)))
    xc = conv_b + sum(xp[:, k:k + seq] * conv_w[k] for k in range(CONV_WIDTH))
    xh = xc.reshape(bsz, seq, LRU_HEADS, LRU_HEAD_DIM)
    r = jax.nn.sigmoid(jnp.einsum('blhi,hij->blhj', xh, w_r).reshape(bsz, seq, width) + b_r)
    i = jax.nn.sigmoid(jnp.einsum('blhi,hij->blhj', xh, w_i).reshape(bsz, seq, width) + b_i)
    log_a = -LRU_C * r.astype(jnp.float32) * jax.nn.softplus(-lam.astype(jnp.float32))
    a = jnp.exp(log_a)
    mult = jnp.sqrt(-jnp.expm1(2.0 * log_a))
    bx = mult * (i * xc).astype(jnp.float32)
    _, h = lax.associative_scan(_linear_combine, (a, bx), axis=1)
    return h.astype(x.dtype)


def hierarchical_moe(h, w_rg, b_rg, w_re, b_re, w_gate, w_up, w_down):
    bsz, seq, d = h.shape
    n_tok = bsz * seq
    hf = h.reshape(n_tok, d)
    g_prob = jax.nn.softmax((hf @ w_rg).astype(jnp.float32) + b_rg.astype(jnp.float32), axis=-1)
    g_idx = jnp.argmax(g_prob, axis=-1).astype(jnp.int32)
    p_g = jnp.max(g_prob, axis=-1, keepdims=True)
    e_logits = ((hf @ w_re).astype(jnp.float32) + b_re.astype(jnp.float32)).reshape(n_tok, N_GROUPS, EXPERTS_PER_GROUP)
    e_logits = jnp.take_along_axis(e_logits, g_idx[:, None, None], axis=1)[:, 0]
    e_prob = jax.nn.softmax(e_logits, axis=-1)
    top_p, top_i = lax.top_k(e_prob, TOP_K)
    gate = p_g * (top_p / jnp.sum(top_p, axis=-1, keepdims=True))
    expert_id = g_idx[:, None] * EXPERTS_PER_GROUP + top_i.astype(jnp.int32)

    n_assign = n_tok * TOP_K
    flat_e = expert_id.reshape(n_assign)
    flat_tok = jnp.repeat(jnp.arange(n_tok, dtype=jnp.int32), TOP_K)
    flat_w = gate.reshape(n_assign)
    order = jnp.argsort(flat_e)
    sorted_e = flat_e[order]
    counts = jnp.bincount(flat_e, length=N_EXPERTS)
    starts = jnp.cumsum(counts) - counts
    padded = ((counts + MOE_BLOCK - 1) // MOE_BLOCK) * MOE_BLOCK
    pad_ends = jnp.cumsum(padded)
    pad_starts = pad_ends - padded
    dest = pad_starts[sorted_e] + (jnp.arange(n_assign, dtype=jnp.int32) - starts[sorted_e])
    n_blocks = -(-n_assign // MOE_BLOCK) + N_EXPERTS
    slot_tok = jnp.full((n_blocks * MOE_BLOCK,), n_tok, jnp.int32).at[dest].set(flat_tok[order])
    slot_w = jnp.zeros((n_blocks * MOE_BLOCK,), jnp.float32).at[dest].set(flat_w[order])
    block_e = jnp.minimum(jnp.searchsorted(pad_ends, jnp.arange(n_blocks, dtype=jnp.int32) * MOE_BLOCK, side='right'), N_EXPERTS - 1)
    h_pad = jnp.concatenate([hf, jnp.zeros((1, d), hf.dtype)], axis=0)

    def expert_block(args):
        tok, wt, e = args
        xb = h_pad[tok]
        y = (jax.nn.silu(xb @ w_gate[e]) * (xb @ w_up[e])) @ w_down[e]
        return y * wt[:, None].astype(y.dtype)

    y = lax.map(expert_block, (slot_tok.reshape(n_blocks, MOE_BLOCK), slot_w.reshape(n_blocks, MOE_BLOCK), block_e))
    out = jnp.zeros((n_tok + 1, d), h.dtype).at[slot_tok].add(y.reshape(-1, d).astype(h.dtype))[:n_tok]
    return out.reshape(bsz, seq, d)


def setup_inputs(seed: int = 0) -> dict:
    key = jax.random.key(seed)
    ks = jax.random.split(key, 32)
    f32 = jnp.float32
    nrm = lambda k, shape, scale: jax.random.normal(k, shape, f32) * scale
    x = jax.random.normal(ks[0], (BATCH, SEQ, D_MODEL), f32)
    norm_mix = 1.0 + nrm(ks[1], (DEPTH, D_MODEL), 0.02)
    w_in = nrm(ks[2], (DEPTH, D_MODEL, IN_WIDTH), D_MODEL ** -0.5)
    s5_lam_re = -0.5 + nrm(ks[3], (DEPTH, S5_GROUPS, S5_STATE), 0.01)
    s5_lam_im = math.pi * jnp.arange(S5_STATE, dtype=f32) + nrm(ks[4], (DEPTH, S5_GROUPS, S5_STATE), 0.01)
    s5_log_dt = jax.random.uniform(ks[5], (DEPTH, S5_GROUPS), f32, math.log(S5_DT_MIN), math.log(S5_DT_MAX))
    s5_b_re = nrm(ks[6], (DEPTH, S5_GROUPS, S5_STATE, S5_GROUP), (2.0 * S5_GROUP) ** -0.5)
    s5_b_im = nrm(ks[7], (DEPTH, S5_GROUPS, S5_STATE, S5_GROUP), (2.0 * S5_GROUP) ** -0.5)
    s5_c_re = nrm(ks[8], (DEPTH, S5_GROUPS, S5_GROUP, S5_STATE), (2.0 * S5_STATE) ** -0.5)
    s5_c_im = nrm(ks[9], (DEPTH, S5_GROUPS, S5_GROUP, S5_STATE), (2.0 * S5_STATE) ** -0.5)
    s5_d = nrm(ks[10], (DEPTH, S5_WIDTH), 1.0)
    w_s5_out = nrm(ks[11], (DEPTH, S5_WIDTH, 2 * D_MODEL), S5_WIDTH ** -0.5)
    conv_w = nrm(ks[12], (DEPTH, CONV_WIDTH, LRU_WIDTH), CONV_WIDTH ** -0.5)
    conv_b = nrm(ks[13], (DEPTH, LRU_WIDTH), 0.01)
    lru_w_r = nrm(ks[14], (DEPTH, LRU_HEADS, LRU_HEAD_DIM, LRU_HEAD_DIM), LRU_HEAD_DIM ** -0.5)
    lru_b_r = nrm(ks[15], (DEPTH, LRU_WIDTH), 0.01)
    lru_w_i = nrm(ks[16], (DEPTH, LRU_HEADS, LRU_HEAD_DIM, LRU_HEAD_DIM), LRU_HEAD_DIM ** -0.5)
    lru_b_i = nrm(ks[17], (DEPTH, LRU_WIDTH), 0.01)
    a_c = jax.random.uniform(ks[18], (DEPTH, LRU_WIDTH), f32, LRU_A_MIN, LRU_A_MAX)
    a0 = a_c ** (1.0 / LRU_C)
    lru_lambda = jnp.log(a0) - jnp.log1p(-a0)
    w_lru_out = nrm(ks[19], (DEPTH, LRU_WIDTH, D_MODEL), LRU_WIDTH ** -0.5)
    w_o = nrm(ks[20], (DEPTH, D_MODEL, D_MODEL), D_MODEL ** -0.5)
    norm_ffn = 1.0 + nrm(ks[21], (DEPTH, D_MODEL), 0.02)
    router_group_w = nrm(ks[22], (DEPTH, D_MODEL, N_GROUPS), D_MODEL ** -0.5)
    router_group_b = nrm(ks[23], (DEPTH, N_GROUPS), 0.01)
    router_expert_w = nrm(ks[24], (DEPTH, D_MODEL, N_EXPERTS), D_MODEL ** -0.5)
    router_expert_b = nrm(ks[25], (DEPTH, N_EXPERTS), 0.01)
    expert_w_gate = nrm(ks[26], (DEPTH, N_EXPERTS, D_MODEL, D_EXPERT), D_MODEL ** -0.5)
    expert_w_up = nrm(ks[27], (DEPTH, N_EXPERTS, D_MODEL, D_EXPERT), D_MODEL ** -0.5)
    expert_w_down = nrm(ks[28], (DEPTH, N_EXPERTS, D_EXPERT, D_MODEL), D_EXPERT ** -0.5)
    norm_final = 1.0 + nrm(ks[29], (D_MODEL,), 0.02)
    return {"x": x, "norm_mix": norm_mix, "w_in": w_in,
            "s5_lam_re": s5_lam_re, "s5_lam_im": s5_lam_im, "s5_log_dt": s5_log_dt,
            "s5_b_re": s5_b_re, "s5_b_im": s5_b_im, "s5_c_re": s5_c_re, "s5_c_im": s5_c_im,
            "s5_d": s5_d, "w_s5_out": w_s5_out,
            "conv_w": conv_w, "conv_b": conv_b, "lru_w_r": lru_w_r, "lru_b_r": lru_b_r,
            "lru_w_i": lru_w_i, "lru_b_i": lru_b_i, "lru_lambda": lru_lambda, "w_lru_out": w_lru_out,
            "w_o": w_o, "norm_ffn": norm_ffn,
            "router_group_w": router_group_w, "router_group_b": router_group_b,
            "router_expert_w": router_expert_w, "router_expert_b": router_expert_b,
            "expert_w_gate": expert_w_gate, "expert_w_up": expert_w_up, "expert_w_down": expert_w_down,
            "norm_final": norm_final}


def reference(x, norm_mix, w_in, s5_lam_re, s5_lam_im, s5_log_dt, s5_b_re, s5_b_im, s5_c_re, s5_c_im,
              s5_d, w_s5_out, conv_w, conv_b, lru_w_r, lru_b_r, lru_w_i, lru_b_i, lru_lambda, w_lru_out,
              w_o, norm_ffn, router_group_w, router_group_b, router_expert_w, router_expert_b,
              expert_w_gate, expert_w_up, expert_w_down, norm_final):
    d = D_MODEL
    for l in range(DEPTH):
        h = rms_norm(x, norm_mix[l])
        proj = h @ w_in[l]
        o1 = S5_WIDTH
        o2 = o1 + LRU_WIDTH
        o3 = o2 + LRU_WIDTH
        o4 = o3 + d
        u_s5 = proj[..., :o1]
        x_lru = proj[..., o1:o2]
        g_lru = proj[..., o2:o3]
        gate_a = jax.nn.sigmoid(proj[..., o3:o4])
        gate_b = jax.nn.sigmoid(proj[..., o4:])
        y_s5 = s5_mixer(u_s5, s5_lam_re[l], s5_lam_im[l], s5_log_dt[l], s5_b_re[l], s5_b_im[l],
                        s5_c_re[l], s5_c_im[l], s5_d[l]).astype(x.dtype)
        z = jax.nn.gelu(y_s5) @ w_s5_out[l]
        y_a = z[..., :d] * jax.nn.sigmoid(z[..., d:])
        y_lru = rglru_mixer(x_lru, conv_w[l], conv_b[l], lru_w_r[l], lru_b_r[l], lru_w_i[l], lru_b_i[l],
                            lru_lambda[l]) * jax.nn.gelu(g_lru)
        y_b = y_lru @ w_lru_out[l]
        x = x + (gate_a * y_a + gate_b * y_b) @ w_o[l]
        x = x + hierarchical_moe(rms_norm(x, norm_ffn[l]), router_group_w[l], router_group_b[l],
                                 router_expert_w[l], router_expert_b[l], expert_w_gate[l],
                                 expert_w_up[l], expert_w_down[l])
    return rms_norm(x, norm_final)
```

```cpp
#include <hip/hip_runtime.h>
#include <cstdio>
#include <cstdint>

#ifndef MK_N_LAUNCHES
#define MK_N_LAUNCHES 1
#endif

namespace pg8 {
#define PG8_LAS __attribute__((address_space(3)))
typedef unsigned short bf16_t;
typedef short bf16x8 __attribute__((ext_vector_type(8)));
typedef float f32x4 __attribute__((ext_vector_type(4)));
typedef unsigned u32x4 __attribute__((ext_vector_type(4)));
constexpr int BM = 256, BK = 64, HALF = 128, HTB = HALF * BK * 2  , STAGE_BYTES = 8 * HTB, NXCD = 8, WGM = 8;

__host__ __device__ __forceinline__ int lds_byte(int r, int c) { const int st = (r >> 4) * 2 + (c >> 5), rr = r & 15, cc = c & 31, ob = rr * 64 + cc * 2; return st * 1024 + (ob ^ (((ob >> 9) & 1) << 5)); }
__host__ __device__ __forceinline__ void stage_rc(int b, int& R, int& C) { const int st = b / 1024, sb = b % 1024, swz = sb ^ (((sb >> 9) & 1) << 5); R = (st >> 1) * 16 + swz / 64; C = (st & 1) * 32 + (swz % 64) / 2; }
__host__ __device__ __forceinline__ int perm32(int rho) { const int n = rho >> 4, i = rho & 15; return 8 * (i >> 2) + 4 * n + (i & 3); }

struct Unit { const char* A; const char* B; int pm, pn, aux; };

__device__ __forceinline__ unsigned cvt_pk_bf16(float lo, float hi) { unsigned r; asm volatile("v_cvt_pk_bf16_f32 %0, %1, %2" : "=v"(r) : "v"(lo), "v"(hi)); return r; }

template <class Epi, class Sched, bool ALIGN_EPI>
__device__ __forceinline__ void gemm_phase(PG8_LAS unsigned char* lds, const int ldb, const int K, const Sched& S, const Epi& E, const size_t kstepA = (size_t)(BK * 2)) {
    const int tid = threadIdx.x, wid = __builtin_amdgcn_readfirstlane(tid >> 6), lane = tid & 63, wr = wid >> 2, wc = wid & 3, fr = lane & 15, fq = lane >> 4;
    int nt = K / BK; asm volatile("" : "+s"(nt));
    int Rr[2], Cc[2]; unsigned voffB[4], vAc[4], vAn[4];
#pragma unroll
    for (int i = 0; i < 2; ++i) { int R, C; stage_rc(tid * 16 + i * 8192, R, C); Rr[i] = R; Cc[i] = C; const int Rb = Epi::PERM ? ((R & ~31) + perm32(R & 31)) : R;
        voffB[i] = (unsigned)(Rb * ldb + C) * 2u; voffB[2 + i] = (unsigned)((HALF + Rb) * ldb + C) * 2u; }
    const size_t kstep = (size_t)(BK * 2);
    const unsigned ldsw = (unsigned)wid * 1024u;
    const int aoff = lds_byte(wr * 64 + fr, fq * 8), boff = lds_byte(wc * 32 + fr, fq * 8);
#define PG8_SA(b, h) (((b) * 2 + (h)) * HTB)
#define PG8_SB(b, h) ((4 + (b) * 2 + (h)) * HTB)
#define PG8_STAGE(bufoff, gbase, voff, h) do { _Pragma("unroll") for (int _i = 0; _i < 2; ++_i) \
        __builtin_amdgcn_global_load_lds((const unsigned*)((const char*)(gbase) + (voff)[2 * (h) + _i]), (PG8_LAS unsigned*)(lds + (bufoff) + ldsw + _i * 8192), 16, 0, 0); } while (0)
#define PG8_LDA(dst, b, h) do { _Pragma("unroll") for (int m = 0; m < 4; ++m) _Pragma("unroll") for (int k = 0; k < 2; ++k) dst[m][k] = *(const PG8_LAS bf16x8*)(lds + PG8_SA(b, h) + aoff + m * 2048 + k * 1024); } while (0)
#define PG8_LDB(dst, b, h) do { _Pragma("unroll") for (int n = 0; n < 2; ++n) _Pragma("unroll") for (int k = 0; k < 2; ++k) dst[n][k] = *(const PG8_LAS bf16x8*)(lds + PG8_SB(b, h) + boff + n * 2048 + k * 1024); } while (0)
#define PG8_MMA(ai, bj, At, Bt) do { __builtin_amdgcn_s_setprio(1); _Pragma("unroll") for (int m = 0; m < 4; ++m) _Pragma("unroll") for (int n = 0; n < 2; ++n) _Pragma("unroll") for (int k = 0; k < 2; ++k) \
        acc[ai][bj][m][n] = __builtin_amdgcn_mfma_f32_16x16x32_bf16(Bt[n][k], At[m][k], acc[ai][bj][m][n], 0, 0, 0); __builtin_amdgcn_s_setprio(0); } while (0)
#define PG8_WAIT_V(n) asm volatile("s_waitcnt vmcnt(" #n ")" ::: "memory")
#define PG8_WAIT_L(n) asm volatile("s_waitcnt lgkmcnt(" #n ")" ::: "memory")
#define PG8_BAR __builtin_amdgcn_s_barrier()
#define PG8_SCHED __builtin_amdgcn_sched_barrier(0)
    Unit cur, nxt; int ui = 0;
    if (!S.next(0, cur)) return;
    S.a_offsets(cur, Rr, Cc, vAc);
    f32x4 acc[2][2][4][2];
    if constexpr (Epi::ACC_INIT) E.init(acc, cur, wr, wc, fr, fq);
    else {
#pragma unroll
    for (int a = 0; a < 2; ++a)
#pragma unroll
        for (int b = 0; b < 2; ++b)
#pragma unroll
            for (int m = 0; m < 4; ++m)
#pragma unroll
                for (int n = 0; n < 2; ++n) acc[a][b][m][n] = (f32x4){0.f, 0.f, 0.f, 0.f}; }
    bf16x8 At[4][2], B0[2][2], B1[2][2];
    const char* cA = cur.A; const char* cB = cur.B;
    if constexpr (Sched::GATHER) { PG8_WAIT_L(0); }
    PG8_STAGE(PG8_SB(0, 0), cB, voffB, 0); PG8_STAGE(PG8_SB(0, 1), cB, voffB, 1); PG8_STAGE(PG8_SA(0, 0), cA, vAc, 0); PG8_STAGE(PG8_SA(0, 1), cA, vAc, 1);
    if (wr == 1) PG8_BAR;
    PG8_WAIT_V(2); PG8_BAR;
    PG8_STAGE(PG8_SB(1, 0), cB + kstep, voffB, 0); PG8_STAGE(PG8_SA(1, 0), cA + kstepA, vAc, 0); PG8_STAGE(PG8_SB(1, 1), cB + kstep, voffB, 1);
    PG8_WAIT_V(6); PG8_BAR;
    for (;;) {
        const bool has_next = S.next(ui + 1, nxt);
        const char* nA = has_next ? nxt.A : cA; const char* nB = has_next ? nxt.B : cB;
        for (int t = 0; t < nt; t += 2) {
            const bool last = (t == nt - 2);
            const char* a1 = cA + (size_t)(t + 1) * kstepA;
            const char* a2 = last ? nA : cA + (size_t)(t + 2) * kstepA; const char* b2 = last ? nB : cB + (size_t)(t + 2) * kstep;
            const char* a3 = a2 + kstepA; const char* b3 = b2 + kstep;
            unsigned va2[4];
            if constexpr (Sched::GATHER) {
                if (last) { if (has_next) { S.a_offsets(nxt, Rr, Cc, vAn); PG8_WAIT_L(0); } else {
#pragma unroll
                        for (int q = 0; q < 4; ++q) vAn[q] = vAc[q]; } }
#pragma unroll
                for (int q = 0; q < 4; ++q) va2[q] = last ? vAn[q] : vAc[q];
            } else {
#pragma unroll
                for (int q = 0; q < 4; ++q) va2[q] = vAc[q];
            }
            PG8_LDB(B0, 0, 0); PG8_LDB(B1, 0, 1); PG8_SCHED; PG8_LDA(At, 0, 0); PG8_STAGE(PG8_SA(1, 1), a1, vAc, 1);
            PG8_WAIT_V(8); PG8_WAIT_L(0); PG8_BAR; PG8_MMA(0, 0, At, B0); PG8_MMA(0, 1, At, B1); PG8_BAR; PG8_SCHED;
            const bool fin = last && !has_next;
            PG8_LDA(At, 0, 1);
            if (!fin) { PG8_STAGE(PG8_SB(0, 0), b2, voffB, 0); PG8_STAGE(PG8_SB(0, 1), b2, voffB, 1); PG8_STAGE(PG8_SA(0, 0), a2, va2, 0); PG8_WAIT_V(8); } else { PG8_WAIT_V(0); }
            PG8_WAIT_L(0); PG8_BAR; PG8_MMA(1, 0, At, B0); PG8_MMA(1, 1, At, B1); PG8_BAR; PG8_SCHED;
            PG8_LDB(B0, 1, 0); PG8_LDB(B1, 1, 1); PG8_SCHED; PG8_LDA(At, 1, 0);
            if (!fin) { PG8_STAGE(PG8_SA(0, 1), a2, va2, 1); PG8_WAIT_V(8); } else { PG8_WAIT_V(0); }
            PG8_WAIT_L(0); PG8_BAR; PG8_MMA(0, 0, At, B0); PG8_MMA(0, 1, At, B1); PG8_BAR; PG8_SCHED;
            PG8_LDA(At, 1, 1);
            if (!fin) { PG8_STAGE(PG8_SB(1, 0), b3, voffB, 0); PG8_STAGE(PG8_SB(1, 1), b3, voffB, 1); PG8_STAGE(PG8_SA(1, 0), a3, va2, 0); PG8_WAIT_V(8); } else { PG8_WAIT_V(0); }
            PG8_WAIT_L(0); PG8_BAR; PG8_MMA(1, 0, At, B0); PG8_MMA(1, 1, At, B1); PG8_BAR; PG8_SCHED;
        }
        if constexpr (ALIGN_EPI) { if (wr == 0) PG8_BAR; }
        E(acc, cur, wr, wc, fr, fq);
        if (!has_next) break;
        if constexpr (Epi::ACC_INIT) E.init(acc, nxt, wr, wc, fr, fq);
        else {
#pragma unroll
        for (int a = 0; a < 2; ++a)
#pragma unroll
            for (int b = 0; b < 2; ++b)
#pragma unroll
                for (int m = 0; m < 4; ++m)
#pragma unroll
                    for (int n = 0; n < 2; ++n) acc[a][b][m][n] = (f32x4){0.f, 0.f, 0.f, 0.f}; }
        cur = nxt; cA = nA; cB = nB; ++ui;
        if constexpr (Sched::GATHER) {
#pragma unroll
            for (int q = 0; q < 4; ++q) vAc[q] = vAn[q]; }
        if constexpr (ALIGN_EPI) { if (wr == 1) PG8_BAR; }
    }
    PG8_WAIT_V(0);
    if constexpr (!ALIGN_EPI) { if (wr == 0) PG8_BAR; }
    PG8_BAR;
#undef PG8_SA
#undef PG8_SB
#undef PG8_STAGE
#undef PG8_LDA
#undef PG8_LDB
#undef PG8_MMA
#undef PG8_WAIT_V
#undef PG8_WAIT_L
#undef PG8_BAR
#undef PG8_SCHED
}
}

constexpr int NWAVES = 8;
constexpr int BATCH = 8, SEQ = 4096, D = 1024, T = BATCH * SEQ;
constexpr int S5W = 512, S5G = 32, S5C = 16, S5P = 64, S5Q = 128;
constexpr int S5LC = 16, S5NCH = SEQ / S5LC, S5N = BATCH * S5NCH;
constexpr int S5K = S5Q + S5LC * S5C;
constexpr int LRUW = 1024, LRUH = 16, LRUHD = 64, LRUCH = 64, LRUNCH = SEQ / LRUCH;
constexpr int NIN = S5W + 2 * LRUW + 2 * D;
constexpr int NEXP = 32, EPG = 8, NGRP = 4, DEXP = 512, NROUT = 48;
constexpr int MAXSLOT = 73728;
constexpr int MAXU = 8;
constexpr float RMS_EPS = 1e-6f;

constexpr size_t MiB = 1u << 20;
constexpr size_t WS_CTL = 0, CTL_ZERO_BYTES = 128 * 1024;
constexpr size_t WS_SMALL = 1 * MiB;
constexpr size_t SM_LAM16 = WS_SMALL + 0;
constexpr size_t SM_LRUC = WS_SMALL + 16384;
constexpr size_t SM_WRT = WS_SMALL + 32768;
constexpr size_t SM_RHI = WS_SMALL + 327680;
constexpr size_t SM_RLO = SM_RHI + 98304;
constexpr size_t SM_RSTD = WS_SMALL + 524288;
constexpr size_t WS_BTT = 2 * MiB;
constexpr size_t WS_BTW = 8 * MiB;
constexpr size_t WS_WIN = 11 * MiB;
constexpr size_t WS_WS5 = 20 * MiB;
constexpr size_t WS_WLRU = 22 * MiB;
constexpr size_t WS_WO = 24 * MiB;
constexpr size_t WS_LP = 26 * MiB, WS_LH = 28 * MiB, WS_LHIN = 30 * MiB;
constexpr size_t WS_AG = 32 * MiB;
constexpr size_t WS_SLOC = 80 * MiB;
constexpr size_t WS_H = 112 * MiB;
constexpr size_t WS_XL = 176 * MiB;
constexpr size_t WS_GL = 240 * MiB;
constexpr size_t WS_GA = 304 * MiB, WS_GB = 368 * MiB;
constexpr size_t WS_GY = 432 * MiB;
constexpr size_t WS_WGU = 32 * MiB;
constexpr size_t WS_WD = 96 * MiB;
constexpr size_t WS_H2 = 128 * MiB;
constexpr size_t WS_ACT = 192 * MiB;
constexpr size_t WS_YS = 264 * MiB;
constexpr size_t WS_LTOK = 408 * MiB, WS_LW = 412 * MiB;
constexpr size_t WS_TOKE = 416 * MiB, WS_TOKR = WS_TOKE + 262144;
constexpr size_t WS_END = 464 * MiB;
static_assert(WS_YS + (size_t)MAXSLOT * 1024 * 2 <= WS_LTOK && WS_ACT + (size_t)MAXSLOT * 512 * 2 <= WS_YS && WS_GY + (size_t)T * 512 * 2 <= WS_END, "d_ws map");
constexpr int CW_BAR = 4096;
constexpr int CW_CNT = 16384;

constexpr int RING_BYTES = 131072;
constexpr int TOKL_OFF = RING_BYTES, SCLL_OFF = TOKL_OFF + MAXU * 256 * 4, MISC_OFF = SCLL_OFF + MAXU * 256 * 4;
constexpr int LDS_BYTES = MISC_OFF + 1024;

#define GAS __attribute__((address_space(1)))
#define LAS __attribute__((address_space(3)))
typedef unsigned short bf16;
typedef unsigned v4u __attribute__((ext_vector_type(4)));
typedef unsigned v2u __attribute__((ext_vector_type(2)));
typedef float f32x4 __attribute__((ext_vector_type(4)));
typedef short bf16x8 __attribute__((ext_vector_type(8)));
#define LDS_WAIT() asm volatile("s_waitcnt lgkmcnt(0)" ::: "memory")
#define VM_WAIT() asm volatile("s_waitcnt vmcnt(0)" ::: "memory")
__device__ __forceinline__ unsigned f2bf(float f) { unsigned u = __builtin_bit_cast(unsigned, f); return (u + 0x7fffu + ((u >> 16) & 1u)) >> 16; }
__device__ __forceinline__ float bf2f(unsigned h) { return __builtin_bit_cast(float, h << 16); }
__device__ __forceinline__ unsigned pk2(float lo, float hi) { return f2bf(lo) | (f2bf(hi) << 16); }
__device__ __forceinline__ float bflo(unsigned w) { return __builtin_bit_cast(float, w << 16); }
__device__ __forceinline__ float bfhi(unsigned w) { return __builtin_bit_cast(float, w & 0xffff0000u); }
__device__ __forceinline__ float fsigmoid(float x) { return __builtin_amdgcn_rcpf(1.0f + __builtin_amdgcn_exp2f(-1.44269504f * x)); }
__device__ __forceinline__ float gelu_t(float x) { const float u = x * (0.7978845608f + 0.0356774081f * x * x); return x * __builtin_amdgcn_rcpf(1.0f + __builtin_amdgcn_exp2f(-2.88539008f * u)); }
__device__ __forceinline__ float wave_sum(float v) {
#pragma unroll
    for (int o = 1; o < 64; o <<= 1) v += __shfl_xor(v, o);
    return v;
}

#define XB_TMO      128
#define XB_XCNT(j)  (256  + 64 * (j))
#define XB_XSUB(j)  (1280 + 64 * (j))
#define XB_XGEN(j)  (2304 + 64 * (j))
#define XB_TOP      3328
#define XB_TOPGEN   3392
#define XCD_BAR_WORDS 3456
#define XB_SPIN_CAP (1u << 18)
__device__ __forceinline__ unsigned xb_ld(unsigned* p)              { return __hip_atomic_load(p, __ATOMIC_RELAXED, __HIP_MEMORY_SCOPE_AGENT); }
__device__ __forceinline__ unsigned xb_add(unsigned* p, unsigned v) { return __hip_atomic_fetch_add(p, v, __ATOMIC_RELAXED, __HIP_MEMORY_SCOPE_AGENT); }
__device__ __forceinline__ unsigned xb_xcc_id() { return (unsigned)__builtin_amdgcn_s_getreg((3 << 11) | 20) & 0xFu; }
#define XB_SPIN(cond, bar) do { unsigned _sp = 0; while (cond) { __builtin_amdgcn_s_sleep(1); \
    if ((++_sp & 255u) == 0u) { if (xb_ld(&(bar)[XB_TMO])) break; if (_sp > XB_SPIN_CAP) { atomicAdd(&(bar)[XB_TMO], 1u); break; } } } } while (0)
struct XcdBarrier { unsigned* bar; unsigned x; volatile LAS unsigned* st; };
__device__ __forceinline__ XcdBarrier xcd_barrier_post(unsigned* bar, volatile LAS unsigned* st) {
    XcdBarrier b; b.bar = bar; b.x = xb_xcc_id(); b.st = st;
    if (threadIdx.x == 0) (void)xb_add(&bar[XB_XCNT(b.x)], 1u);
    return b;
}
__device__ __forceinline__ void xcd_barrier_complete(unsigned* bar, unsigned x, unsigned& nloc, unsigned& nx) {
    const unsigned G = gridDim.x * gridDim.y * gridDim.z;
    unsigned sum, cnt, mine, sp = 0u;
    for (;;) {
        sum = 0u; cnt = 0u; mine = 0u;
#pragma unroll
        for (unsigned j = 0; j < 16; ++j) { const unsigned c = xb_ld(&bar[XB_XCNT(j)]); sum += c; cnt += (c > 0u) ? 1u : 0u; mine = (j == x) ? c : mine; }
        if (sum == G) break;
        __builtin_amdgcn_s_sleep(1);
        if ((++sp & 255u) == 0u) { if (xb_ld(&bar[XB_TMO])) break; if (sp > XB_SPIN_CAP) { atomicAdd(&bar[XB_TMO], 1u); break; } }
    }
    nloc = mine > 0u ? mine : 1u; nx = cnt > 0u ? cnt : 1u;
}
__device__ __forceinline__ void xcd_barrier(const XcdBarrier& b) {
    asm volatile("s_waitcnt vmcnt(0)" ::: "memory");
    __syncthreads();
    if (threadIdx.x == 0) {
        unsigned* bar = b.bar;
        __builtin_amdgcn_s_waitcnt(0);
        unsigned nloc = b.st[0], nx = b.st[1];
        if (nloc == 0u) { xcd_barrier_complete(bar, b.x, nloc, nx); b.st[0] = nloc; b.st[1] = nx; }
        const unsigned old = xb_add(&bar[XB_XSUB(b.x)], 1u);
        const unsigned gen = old / nloc;
        if (old + 1u == (gen + 1u) * nloc) {
            __builtin_amdgcn_fence(__ATOMIC_RELEASE, "agent");
            asm volatile("s_waitcnt vmcnt(0)" ::: "memory");
            const unsigned og = xb_add(&bar[XB_TOP], 1u);
            const unsigned tg = og / nx;
            if (og + 1u == (tg + 1u) * nx) xb_add(&bar[XB_TOPGEN], 1u);
            else XB_SPIN(xb_ld(&bar[XB_TOPGEN]) == tg, bar);
            __builtin_amdgcn_fence(__ATOMIC_ACQUIRE, "agent");
            xb_add(&bar[XB_XGEN(b.x)], 1u);
            asm volatile("s_waitcnt vmcnt(0)" ::: "memory");
        } else {
            XB_SPIN(xb_ld(&bar[XB_XGEN(b.x)]) == gen, bar);
            __builtin_amdgcn_fence(__ATOMIC_ACQUIRE, "agent");
            asm volatile("s_waitcnt vmcnt(0)" ::: "memory");
        }
    }
    __syncthreads();
}

struct Frame {
    LAS unsigned char* lds;
    volatile LAS unsigned* MISC;
    unsigned* ctl;
    int tid, lane, wave, vcu, G;
    const float* const* in;
    unsigned char* ws; float* out;
};

using pg8::Unit;
struct DenseOrder {
    static constexpr bool GATHER = false;
    const char* A0; const char* B0; int lda, ldb, nM, nN, nwg, G, c;
    __device__ __forceinline__ void init(const void* A, const void* B, int lda_, int ldb_, int M, int N, int G_, int c_) { A0 = (const char*)A; B0 = (const char*)B; lda = lda_; ldb = ldb_; nM = M / 256; nN = N / 256; nwg = nM * nN; G = G_; c = c_; }
    __device__ __forceinline__ bool next(int i, Unit& u) const {
        const long L = (long)i * G + c; if (L >= nwg) return false;
        int wgid = (int)L; { const int q = nwg / 8, r = nwg % 8, xcd = wgid % 8, off = wgid / 8; wgid = (xcd < r ? xcd * (q + 1) : r * (q + 1) + (xcd - r) * q) + off; }
        const int nig = 8 * nN, gid = wgid / nig, fm = gid * 8, gsz = (nM - fm) < 8 ? (nM - fm) : 8;
        u.pm = fm + ((wgid % nig) % gsz); u.pn = (wgid % nig) / gsz; u.aux = 0;
        u.A = A0 + (size_t)u.pm * 256 * lda * 2; u.B = B0 + (size_t)u.pn * 256 * ldb * 2; return true;
    }
    __device__ __forceinline__ void a_offsets(const Unit&, const int (&R)[2], const int (&C)[2], unsigned (&v)[4]) const {
#pragma unroll
        for (int i = 0; i < 2; ++i) { v[i] = (unsigned)(R[i] * lda + C[i]) * 2u; v[2 + i] = (unsigned)((128 + R[i]) * lda + C[i]) * 2u; }
    }
};
struct S5One {
    static constexpr bool GATHER = false;
    const char* A0; const char* B0; size_t sA, sB; int lda, g, mt;
    __device__ __forceinline__ bool next(int i, Unit& u) const {
        if (i > 0) return false;
        u.pm = mt; u.pn = 0; u.aux = g; u.A = A0 + (size_t)g * sA + (size_t)mt * 256 * lda * 2; u.B = B0 + (size_t)g * sB; return true;
    }
    __device__ __forceinline__ void a_offsets(const Unit&, const int (&R)[2], const int (&C)[2], unsigned (&v)[4]) const {
#pragma unroll
        for (int i = 0; i < 2; ++i) { v[i] = (unsigned)(R[i] * lda + C[i]) * 2u; v[2 + i] = (unsigned)((128 + R[i]) * lda + C[i]) * 2u; }
    }
};
struct GyOrder {
    static constexpr bool GATHER = false;
    DenseOrder d;
    __device__ __forceinline__ bool next(int i, Unit& u) const { if (!d.next(i, u)) return false; u.A = d.A0 + (size_t)u.pm * 256 * 32; return true; }
    __device__ __forceinline__ void a_offsets(const Unit&, const int (&R)[2], const int (&C)[2], unsigned (&v)[4]) const {
#pragma unroll
        for (int i = 0; i < 2; ++i) { const unsigned o = (unsigned)(C[i] >> 4) * (unsigned)(T * 32) + (unsigned)(C[i] & 15) * 2u; v[i] = (unsigned)R[i] * 32u + o; v[2 + i] = (unsigned)(128 + R[i]) * 32u + o; }
    }
};
template <bool GATH> struct MoeOrder {
    static constexpr bool GATHER = GATH;
    const char* A0; const char* B0; size_t sBe; int lda, ldb, G, c; volatile LAS unsigned* MISC; const LAS int* tokL;
    __device__ __forceinline__ bool next(int i, Unit& u) const {
        if (i >= (int)MISC[152]) return false;
        const int e = (int)MISC[136 + i], mtg = (int)MISC[96 + e] + (int)MISC[144 + i], L = i * G + c;
        u.pm = mtg; u.pn = L & 3; u.aux = i;
        u.A = GATH ? A0 : A0 + (size_t)mtg * 256 * lda * 2; u.B = B0 + (size_t)e * sBe + (size_t)u.pn * 256 * ldb * 2; return true;
    }
    __device__ __forceinline__ void a_offsets(const Unit& u, const int (&R)[2], const int (&C)[2], unsigned (&v)[4]) const {
#pragma unroll
        for (int i = 0; i < 2; ++i) {
            if constexpr (GATH) { v[i] = (unsigned)tokL[u.aux * 256 + R[i]] * (unsigned)(lda * 2) + (unsigned)C[i] * 2u; v[2 + i] = (unsigned)tokL[u.aux * 256 + 128 + R[i]] * (unsigned)(lda * 2) + (unsigned)C[i] * 2u; }
            else { v[i] = (unsigned)(R[i] * lda + C[i]) * 2u; v[2 + i] = (unsigned)((128 + R[i]) * lda + C[i]) * 2u; } }
    }
};

using pg8::cvt_pk_bf16;
template <int ACT> __device__ __forceinline__ float actf(float x) { if (ACT == 1) return gelu_t(x); if (ACT == 2) return fsigmoid(x); return x; }
__device__ __forceinline__ v4u pack8(const f32x4 a, const f32x4 b) { v4u w; w.x = cvt_pk_bf16(a[0], a[1]); w.y = cvt_pk_bf16(a[2], a[3]); w.z = cvt_pk_bf16(b[0], b[1]); w.w = cvt_pk_bf16(b[2], b[3]); return w; }

__device__ __forceinline__ void unpack_u8x8(const v2u w, float (&f)[8]) {
    const float k = 1.0f / 255.0f;
    f[0] = (float)(w.x & 0xffu) * k; f[1] = (float)((w.x >> 8) & 0xffu) * k; f[2] = (float)((w.x >> 16) & 0xffu) * k; f[3] = (float)(w.x >> 24) * k;
    f[4] = (float)(w.y & 0xffu) * k; f[5] = (float)((w.y >> 8) & 0xffu) * k; f[6] = (float)((w.y >> 16) & 0xffu) * k; f[7] = (float)(w.y >> 24) * k;
}
struct EpiInProj {
    static constexpr bool PERM = true, ACC_INIT = false;
    bf16 *AG, *XL, *GL, *GA, *GB;
    template <int MODE  > __device__ __forceinline__ void tile(const f32x4 (&acc)[2][2][4][2], const Unit& u, bf16* base, int colbase, bool s5, int wr, int wc, int fr, int fq) const {
#pragma unroll
        for (int ai = 0; ai < 2; ++ai)
#pragma unroll
            for (int m = 0; m < 4; ++m) { const int r = u.pm * 256 + ai * 128 + wr * 64 + m * 16 + fr;
#pragma unroll
                for (int bj = 0; bj < 2; ++bj) { const int cl = colbase + bj * 128 + wc * 32 + 8 * fq;
                    f32x4 v0 = acc[ai][bj][m][0], v1 = acc[ai][bj][m][1];
                    if (MODE == 2) {
                        unsigned q[8];
#pragma unroll
                        for (int j = 0; j < 4; ++j) { q[j] = (unsigned)(fsigmoid(v0[j]) * 255.0f + 0.5f); q[4 + j] = (unsigned)(fsigmoid(v1[j]) * 255.0f + 0.5f); }
                        v2u w8; w8.x = q[0] | (q[1] << 8) | (q[2] << 16) | (q[3] << 24); w8.y = q[4] | (q[5] << 8) | (q[6] << 16) | (q[7] << 24);
                        __builtin_nontemporal_store(w8, (v2u*)((unsigned char*)base + (size_t)r * 1024 + cl));
                    } else {
                        if (MODE == 1) {
#pragma unroll
                            for (int j = 0; j < 4; ++j) { v0[j] = gelu_t(v0[j]); v1[j] = gelu_t(v1[j]); } }
                        const v4u w = pack8(v0, v1);
                        const int g = cl >> 4, cp = cl & 15, b = r >> 12, l = r & 4095, n = b * S5NCH + (l >> 4), s = l & 15;
                        const size_t off = s5 ? ((size_t)(g * S5N + n) * S5K + S5Q + s * 16 + cp) : ((size_t)r * 1024 + cl);
                        __builtin_nontemporal_store(w, (v4u*)(base + off)); } }
                asm volatile("" ::: "memory"); }
    }
    __device__ __forceinline__ void operator()(const f32x4 (&acc)[2][2][4][2], const Unit& u, int wr, int wc, int fr, int fq) const {
        const int pn = u.pn, reg = pn < 2 ? 0 : ((pn - 2) >> 2) + 1;
        const int colbase = reg == 0 ? pn * 256 : ((pn - 2) & 3) * 256;
        if (reg < 2) tile<0>(acc, u, reg == 0 ? AG : XL, colbase, reg == 0, wr, wc, fr, fq);
        else if (reg == 2) tile<1>(acc, u, GL, colbase, false, wr, wc, fr, fq);
        else tile<2>(acc, u, reg == 3 ? GA : GB, colbase, false, wr, wc, fr, fq);
    }
};
struct EpiS5State {
    static constexpr bool PERM = false, ACC_INIT = false;
    float* SLOC;
    __device__ __forceinline__ void operator()(const f32x4 (&acc)[2][2][4][2], const Unit& u, int wr, int wc, int fr, int fq) const {
#pragma unroll
        for (int ai = 0; ai < 2; ++ai)
#pragma unroll
            for (int m = 0; m < 4; ++m) { const int nr = u.pm * 256 + ai * 128 + wr * 64 + m * 16 + fr; float* rowp = SLOC + (size_t)(u.aux * S5N + nr) * S5Q + wc * 32 + 4 * fq;
#pragma unroll
                for (int n = 0; n < 2; ++n) *(f32x4*)(rowp + n * 16) = acc[ai][0][m][n]; }
    }
};
struct EpiS5Out {
    static constexpr bool PERM = true, ACC_INIT = false;
    bf16* GY;
    __device__ __forceinline__ void operator()(const f32x4 (&acc)[2][2][4][2], const Unit& u, int wr, int wc, int fr, int fq) const {
#pragma unroll
        for (int ai = 0; ai < 2; ++ai)
#pragma unroll
            for (int m = 0; m < 4; ++m) { const int nr = u.pm * 256 + ai * 128 + wr * 64 + m * 16 + fr, b = nr >> 8, j16 = nr & 255;
#pragma unroll
                for (int bj = 0; bj < 2; ++bj) { const int cc = bj * 128 + wc * 32 + 8 * fq, t = cc >> 4, c0 = cc & 15;
                    f32x4 v0 = acc[ai][bj][m][0], v1 = acc[ai][bj][m][1];
#pragma unroll
                    for (int j = 0; j < 4; ++j) { v0[j] = gelu_t(v0[j]); v1[j] = gelu_t(v1[j]); }
                    *(v4u*)(GY + ((size_t)u.aux * T + (size_t)(b * SEQ + j16 * 16 + t)) * 16 + c0) = pack8(v0, v1); }
                asm volatile("" ::: "memory"); }
    }
};
struct EpiYa {
    static constexpr bool PERM = true, ACC_INIT = false;
    const bf16* GA; bf16* YA;
    __device__ __forceinline__ void operator()(const f32x4 (&acc)[2][2][4][2], const Unit& u, int wr, int wc, int fr, int fq) const {
        const size_t off0 = (size_t)(u.pm * 256 + wr * 64 + fr) * 1024 + u.pn * 128 + wc * 32 + 8 * fq;
        v2u gav[2][4];
#pragma unroll
        for (int ai = 0; ai < 2; ++ai)
#pragma unroll
            for (int m = 0; m < 4; ++m) gav[ai][m] = __builtin_nontemporal_load((const v2u*)((const unsigned char*)GA + off0 + (size_t)(ai * 128 + m * 16) * 1024));
        asm volatile("" ::: "memory");
#pragma unroll
        for (int ai = 0; ai < 2; ++ai)
#pragma unroll
            for (int m = 0; m < 4; ++m) { float gaf[8]; unpack_u8x8(gav[ai][m], gaf);
                f32x4 o0, o1;
#pragma unroll
                for (int j = 0; j < 4; ++j) { o0[j] = gaf[j] * acc[ai][0][m][0][j] * fsigmoid(acc[ai][1][m][0][j]); o1[j] = gaf[4 + j] * acc[ai][0][m][1][j] * fsigmoid(acc[ai][1][m][1][j]); }
                *(v4u*)(YA + off0 + (size_t)(ai * 128 + m * 16) * 1024) = pack8(o0, o1); }
    }
};
struct EpiYb {
    static constexpr bool PERM = true, ACC_INIT = false;
    const bf16* YA; const bf16* GB; bf16* MIX;
    __device__ __forceinline__ void operator()(const f32x4 (&acc)[2][2][4][2], const Unit& u, int wr, int wc, int fr, int fq) const {
        const size_t off0 = (size_t)(u.pm * 256 + wr * 64 + fr) * 1024 + u.pn * 256 + wc * 32 + 8 * fq;
        v4u ya[2][2][2]; v2u gb[2][2][2];
#define YB_LOAD(buf, grp) do { _Pragma("unroll") for (int mm = 0; mm < 2; ++mm) _Pragma("unroll") for (int bj = 0; bj < 2; ++bj) { \
            const size_t o = off0 + (size_t)(((grp) >> 1) * 128 + (2 * ((grp) & 1) + mm) * 16) * 1024 + bj * 128; ya[buf][mm][bj] = __builtin_nontemporal_load((const v4u*)(YA + o)); gb[buf][mm][bj] = __builtin_nontemporal_load((const v2u*)((const unsigned char*)GB + o)); } } while (0)
        YB_LOAD(0, 0);
#pragma unroll
        for (int grp = 0; grp < 4; ++grp) { const int buf = grp & 1, ai = grp >> 1;
            if (grp < 3) YB_LOAD(buf ^ 1, grp + 1);
            asm volatile("" ::: "memory");
#pragma unroll
            for (int mm = 0; mm < 2; ++mm) { const int m = 2 * (grp & 1) + mm;
#pragma unroll
                for (int bj = 0; bj < 2; ++bj) { const v4u y = ya[buf][mm][bj];
                    const float yaf[8] = {bflo(y.x), bfhi(y.x), bflo(y.y), bfhi(y.y), bflo(y.z), bfhi(y.z), bflo(y.w), bfhi(y.w)};
                    float gbf[8]; unpack_u8x8(gb[buf][mm][bj], gbf);
                    f32x4 o0, o1;
#pragma unroll
                    for (int j = 0; j < 4; ++j) { o0[j] = yaf[j] + gbf[j] * acc[ai][bj][m][0][j]; o1[j] = yaf[4 + j] + gbf[4 + j] * acc[ai][bj][m][1][j]; }
                    *(v4u*)(MIX + off0 + (size_t)(ai * 128 + m * 16) * 1024 + bj * 128) = pack8(o0, o1); } }
        }
#undef YB_LOAD
    }
};
struct EpiWo {
    static constexpr bool PERM = false, ACC_INIT = true;
    const float* X; float* O;
    __device__ __forceinline__ void init(f32x4 (&acc)[2][2][4][2], const Unit& u, int wr, int wc, int fr, int fq) const {
        const size_t off0 = (size_t)(u.pm * 256 + wr * 64 + fr) * 1024 + u.pn * 256 + wc * 32 + 4 * fq;
#pragma unroll
        for (int ai = 0; ai < 2; ++ai)
#pragma unroll
            for (int m = 0; m < 4; ++m)
#pragma unroll
                for (int bj = 0; bj < 2; ++bj)
#pragma unroll
                    for (int n = 0; n < 2; ++n) acc[ai][bj][m][n] = __builtin_nontemporal_load((const f32x4*)(X + off0 + (size_t)(ai * 128 + m * 16) * 1024 + bj * 128 + n * 16));
    }
    __device__ __forceinline__ void operator()(const f32x4 (&acc)[2][2][4][2], const Unit& u, int wr, int wc, int fr, int fq) const {
        const size_t off0 = (size_t)(u.pm * 256 + wr * 64 + fr) * 1024 + u.pn * 256 + wc * 32 + 4 * fq;
#pragma unroll
        for (int ai = 0; ai < 2; ++ai)
#pragma unroll
            for (int m = 0; m < 4; ++m)
#pragma unroll
                for (int bj = 0; bj < 2; ++bj)
#pragma unroll
                    for (int n = 0; n < 2; ++n) *(f32x4*)(O + off0 + (size_t)(ai * 128 + m * 16) * 1024 + bj * 128 + n * 16) = acc[ai][bj][m][n];
    }
};
struct EpiGU {
    static constexpr bool PERM = true, ACC_INIT = false;
    bf16* ACT; const LAS float* sclL;
    __device__ __forceinline__ void operator()(const f32x4 (&acc)[2][2][4][2], const Unit& u, int wr, int wc, int fr, int fq) const {
#pragma unroll
        for (int ai = 0; ai < 2; ++ai)
#pragma unroll
            for (int m = 0; m < 4; ++m) { const int rl = ai * 128 + wr * 64 + m * 16 + fr; const float sc = sclL[u.aux * 256 + rl];
                f32x4 o0, o1;
#pragma unroll
                for (int j = 0; j < 4; ++j) { const float g0 = acc[ai][0][m][0][j] * sc, g1 = acc[ai][0][m][1][j] * sc;
                    o0[j] = g0 * fsigmoid(g0) * (acc[ai][1][m][0][j] * sc); o1[j] = g1 * fsigmoid(g1) * (acc[ai][1][m][1][j] * sc); }
                *(v4u*)(ACT + (size_t)(u.pm * 256 + rl) * DEXP + u.pn * 128 + wc * 32 + 8 * fq) = pack8(o0, o1); }
    }
};
struct EpiDown {
    static constexpr bool PERM = true, ACC_INIT = false;
    bf16* YS; const LAS float* sclL;
    __device__ __forceinline__ void operator()(const f32x4 (&acc)[2][2][4][2], const Unit& u, int wr, int wc, int fr, int fq) const {
#pragma unroll
        for (int ai = 0; ai < 2; ++ai)
#pragma unroll
            for (int m = 0; m < 4; ++m) { const int rl = ai * 128 + wr * 64 + m * 16 + fr; const float sc = sclL[u.aux * 256 + rl];
#pragma unroll
                for (int bj = 0; bj < 2; ++bj)
                    *(v4u*)(YS + (size_t)(u.pm * 256 + rl) * 1024 + u.pn * 256 + bj * 128 + wc * 32 + 8 * fq) = pack8(acc[ai][bj][m][0] * sc, acc[ai][bj][m][1] * sc); }
    }
};

struct TItem { const float* W; int N; bf16* WT; int ldk, k0, n0, drow0; };
__device__ __forceinline__ void transpose_load(const TItem& it, f32x4 (&tv)[8], int lane) {
#pragma unroll
    for (int i = 0; i < 8; ++i) tv[i] = __builtin_nontemporal_load((const f32x4*)(it.W + (size_t)(it.k0 + 8 * i + (lane >> 3)) * it.N + it.n0 + 4 * (lane & 7)));
}
__device__ __forceinline__ void transpose_store(const TItem& it, const f32x4 (&tv)[8], LAS float* scr, int lane) {
#pragma unroll
    for (int i = 0; i < 8; ++i) { LAS float* d = scr + (8 * i + (lane >> 3)) * 33 + 4 * (lane & 7); d[0] = tv[i].x; d[1] = tv[i].y; d[2] = tv[i].z; d[3] = tv[i].w; }
    LDS_WAIT(); asm volatile("" ::: "memory");
    const int c = lane & 7;
#pragma unroll
    for (int j = 0; j < 4; ++j) { const int n = (lane >> 3) + 8 * j; const LAS float* s = scr + (8 * c) * 33 + n;
        v4u o; o.x = pk2(s[0 * 33], s[1 * 33]); o.y = pk2(s[2 * 33], s[3 * 33]); o.z = pk2(s[4 * 33], s[5 * 33]); o.w = pk2(s[6 * 33], s[7 * 33]);
        *(v4u*)(it.WT + (size_t)(it.drow0 + n) * it.ldk + it.k0 + 8 * c) = o; }
    LDS_WAIT(); asm volatile("" ::: "memory");
}
__device__ __forceinline__ int ileave_row(int n, int half) { return 256 * (n >> 7) + 128 * half + (n & 127); }

template <int NR> __device__ __forceinline__ void rms_rows_to_bf16(const float* x0, const float* gain, bf16* o0, size_t rstride, int lane) {
    f32x4 v[NR][4];
#pragma unroll
    for (int r = 0; r < NR; ++r) { const f32x4* xr = (const f32x4*)(x0 + r * rstride) + lane;
#pragma unroll
        for (int j = 0; j < 4; ++j) v[r][j] = __builtin_nontemporal_load(xr + 64 * j); }
    asm volatile("" ::: "memory");
    const f32x4* gr = (const f32x4*)gain + lane;
    f32x4 g[4];
#pragma unroll
    for (int j = 0; j < 4; ++j) g[j] = gr[64 * j];
#pragma unroll
    for (int r = 0; r < NR; ++r) { float s = 0.f;
#pragma unroll
        for (int j = 0; j < 4; ++j) s += (v[r][j].x * v[r][j].x + v[r][j].y * v[r][j].y) + (v[r][j].z * v[r][j].z + v[r][j].w * v[r][j].w);
        const float rstd = 1.0f / sqrtf(wave_sum(s) * (1.f / D) + RMS_EPS);
        unsigned long long* o8 = (unsigned long long*)(o0 + r * rstride) + lane;
#pragma unroll
        for (int j = 0; j < 4; ++j) o8[64 * j] = (unsigned long long)pk2(v[r][j].x * rstd * g[j].x, v[r][j].y * rstd * g[j].y) | ((unsigned long long)pk2(v[r][j].z * rstd * g[j].z, v[r][j].w * rstd * g[j].w) << 32); }
}

__device__ __forceinline__ void s5_tables(const Frame& F, int g, const float* lam_re, const float* lam_im, const float* log_dt, const float* b_re, const float* b_im, const float* c_re, const float* c_im, const float* dsk) {
    LAS float* Cre = (LAS float*)F.lds;
    LAS float* Cim = Cre + 1024;
    LAS float* Bre = Cim + 1024;
    LAS float* Bim = Bre + 1024;
    LAS float* Pre = Bim + 1024;
    LAS float* Pim = Pre + 17 * 64;
    LAS float* Kt = Pim + 17 * 64;
    const int tid = F.tid;
    for (int i = tid; i < 1024; i += 512) { Cre[i] = c_re[g * 1024 + i]; Cim[i] = c_im[g * 1024 + i]; }
    if (tid < 64) {
        const int p = tid; const float lr = lam_re[g * 64 + p], li = lam_im[g * 64 + p], dt = expf(log_dt[g]);
        const float er = expf(lr * dt), lbr = er * cosf(li * dt), lbi = er * sinf(li * dt);
        const float den = lr * lr + li * li, nr = lbr - 1.0f, ni = lbi;
        const float cr = (nr * lr + ni * li) / den, ci = (ni * lr - nr * li) / den;
        { float pr = 1.f, pi = 0.f; for (int k = 0; k <= 16; ++k) { Pre[k * 64 + p] = pr; Pim[k * 64 + p] = pi; const float nr2 = pr * lbr - pi * lbi, ni2 = pr * lbi + pi * lbr; pr = nr2; pi = ni2; } }
        for (int c = 0; c < 16; ++c) { const float br = b_re[(g * 64 + p) * 16 + c], bi = b_im[(g * 64 + p) * 16 + c]; Bre[p * 16 + c] = cr * br - ci * bi; Bim[p * 16 + c] = cr * bi + ci * br; }
    }
    __syncthreads();
    for (int e = tid; e < 4096; e += 512) {
        const int k = e >> 8, c = (e >> 4) & 15, cp = e & 15; float s = 0.f;
        for (int p = 0; p < 64; ++p) { const float xr = Cre[c * 64 + p] * Pre[k * 64 + p] - Cim[c * 64 + p] * Pim[k * 64 + p], xi = Cre[c * 64 + p] * Pim[k * 64 + p] + Cim[c * 64 + p] * Pre[k * 64 + p];
            s += xr * Bre[p * 16 + cp] - xi * Bim[p * 16 + cp]; }
        if (k == 0 && c == cp) s += dsk[g * 16 + c];
        Kt[e] = s;
    }
    __syncthreads();
    unsigned* btt = (unsigned*)(F.ws + WS_BTT) + (size_t)g * 256 * (S5K / 2);
    for (int e = tid; e < 256 * (S5K / 2); e += 512) {
        const int row = e / (S5K / 2), cpair = e % (S5K / 2), t = row >> 4, c = row & 15, col = 2 * cpair; float v0, v1;
        if (col < S5Q) { const int p = col >> 1; const float xr = Cre[c * 64 + p] * Pre[(t + 1) * 64 + p] - Cim[c * 64 + p] * Pim[(t + 1) * 64 + p], xi = Cre[c * 64 + p] * Pim[(t + 1) * 64 + p] + Cim[c * 64 + p] * Pre[(t + 1) * 64 + p];
            v0 = xr; v1 = -xi; }
        else { const int s = (col - S5Q) >> 4, cp = (col - S5Q) & 15;
            if (s <= t) { v0 = Kt[(t - s) * 256 + c * 16 + cp]; v1 = Kt[(t - s) * 256 + c * 16 + cp + 1]; } else { v0 = 0.f; v1 = 0.f; } }
        btt[e] = pk2(v0, v1);
    }
    unsigned* btw = (unsigned*)(F.ws + WS_BTW) + (size_t)g * 128 * 128;
    for (int e = tid; e < 128 * 128; e += 512) {
        const int q = e >> 7, cpair = e & 127, col = 2 * cpair, s = col >> 4, cp = col & 15, p = q >> 1, k = 15 - s;
        const float pr = Pre[k * 64 + p], pi = Pim[k * 64 + p];
        float v0, v1;
        if (q & 1) { v0 = pr * Bim[p * 16 + cp] + pi * Bre[p * 16 + cp]; v1 = pr * Bim[p * 16 + cp + 1] + pi * Bre[p * 16 + cp + 1]; }
        else { v0 = pr * Bre[p * 16 + cp] - pi * Bim[p * 16 + cp]; v1 = pr * Bre[p * 16 + cp + 1] - pi * Bim[p * 16 + cp + 1]; }
        btw[e] = pk2(v0, v1);
    }
    if (tid < 64) { float* l16 = (float*)(F.ws + SM_LAM16) + (g * 64 + tid) * 2; l16[0] = Pre[16 * 64 + tid]; l16[1] = Pim[16 * 64 + tid]; }
    __syncthreads();
}

struct In { const float* p[30]; };

__device__ __forceinline__ void p0_prologue(const Frame& F, const In& I) {
    for (int g = F.vcu; g < S5G; g += F.G) s5_tables(F, g, I.p[3], I.p[4], I.p[5], I.p[6], I.p[7], I.p[8], I.p[9], I.p[10]);
    const int gt = F.vcu * 512 + F.tid, NGT = F.G * 512;
    { float* lc = (float*)(F.ws + SM_LRUC); for (int i = gt; i < LRUW; i += NGT) { const float lam = I.p[18][i]; lc[i] = -8.0f * log1pf(expf(-lam)) * 1.44269504f; } }
    { bf16* wrt = (bf16*)(F.ws + SM_WRT);
        for (int i = gt; i < 2 * 65536; i += NGT) { const int which = i >> 16, r = i & 65535, h = r >> 12, j = (r >> 6) & 63, k = r & 63; const float* src = which ? I.p[16] : I.p[14]; wrt[i] = (bf16)f2bf(src[(h * 64 + k) * 64 + j]); } }
    { bf16* rhi = (bf16*)(F.ws + SM_RHI); bf16* rlo = (bf16*)(F.ws + SM_RLO);
        for (int i = gt; i < NROUT * 1024; i += NGT) { const int n = i >> 10, k = i & 1023; float w = 0.f; if (n < 4) w = I.p[22][k * 4 + n]; else if (n < 36) w = I.p[24][k * 32 + (n - 4)];
            const unsigned h = f2bf(w); rhi[i] = (bf16)h; rlo[i] = (bf16)f2bf(w - bf2f(h)); } }
    LAS float* scr = (LAS float*)(F.lds + F.wave * 16384);
    const int gw = F.vcu * NWAVES + F.wave, NGW = F.G * NWAVES;
    constexpr int I_IN = (D / 64) * (NIN / 32), I_S5 = (S5W / 64) * (2 * D / 32), I_LRU = (D / 64) * (D / 32), I_O = I_LRU;
    constexpr int NITEMS = I_IN + I_S5 + I_LRU + I_O;
    for (int it = gw; it < NITEMS; it += NGW) {
        int r = it; TItem ti;
        if (r < I_IN) { const int nb = NIN / 32, kb = r / nb, n0 = 32 * (r % nb); ti = TItem{I.p[2], NIN, (bf16*)(F.ws + WS_WIN), D, 64 * kb, n0, n0}; }
        else if ((r -= I_IN) < I_S5) { const int nb = 2 * D / 32, kb = r / nb, n0 = 32 * (r % nb); ti = TItem{I.p[11], 2 * D, (bf16*)(F.ws + WS_WS5), S5W, 64 * kb, n0, n0 < D ? ileave_row(n0, 0) : ileave_row(n0 - D, 1)}; }
        else if ((r -= I_S5) < I_LRU) { const int nb = D / 32, kb = r / nb, n0 = 32 * (r % nb); ti = TItem{I.p[19], D, (bf16*)(F.ws + WS_WLRU), D, 64 * kb, n0, n0}; }
        else { r -= I_LRU; const int nb = D / 32, kb = r / nb, n0 = 32 * (r % nb); ti = TItem{I.p[20], D, (bf16*)(F.ws + WS_WO), D, 64 * kb, n0, n0}; }
        f32x4 tv[8]; transpose_load(ti, tv, F.lane); asm volatile("" ::: "memory"); transpose_store(ti, tv, scr, F.lane);
    }
    { const int skip = F.G > 2 * S5G ? S5G : 0;
      if (F.vcu >= skip) { const int gw2 = (F.vcu - skip) * NWAVES + F.wave, NGW2 = (F.G - skip) * NWAVES;
        for (int m = gw2 * 4; m < T; m += NGW2 * 4) rms_rows_to_bf16<4>(I.p[0] + (size_t)m * D, I.p[1], (bf16*)(F.ws + WS_H) + (size_t)m * D, D, F.lane); } }
}
__device__ __forceinline__ TItem expert_item(const Frame& F, const In& I, int it) {
    constexpr int I_G = (D / 64) * (DEXP / 32), I_D = (DEXP / 64) * (D / 32);
    const int e = it / (2 * I_G + I_D); int r = it % (2 * I_G + I_D);
    if (r < 2 * I_G) { const int half = r / I_G; r %= I_G; const int nb = DEXP / 32, kb = r / nb, n0 = 32 * (r % nb);
        return TItem{(half ? I.p[27] : I.p[26]) + (size_t)e * D * DEXP, DEXP, (bf16*)(F.ws + WS_WGU) + (size_t)e * 1024 * 1024, D, 64 * kb, n0, ileave_row(n0, half)}; }
    r -= 2 * I_G; const int nb = D / 32, kb = r / nb, n0 = 32 * (r % nb);
    return TItem{I.p[28] + (size_t)e * DEXP * D, D, (bf16*)(F.ws + WS_WD) + (size_t)e * 1024 * DEXP, DEXP, 64 * kb, n0, n0};
}
__device__ __forceinline__ void expert_weight_copies(const Frame& F, const In& I) {
    LAS float* scr = (LAS float*)(F.lds + F.wave * 16384);
    const int gw = F.vcu * NWAVES + F.wave, NGW = F.G * NWAVES;
    constexpr int NIT = NEXP * 768;
    for (int it = gw; it < NIT; it += 2 * NGW) {
        const TItem t0 = expert_item(F, I, it); const bool has1 = it + NGW < NIT; const TItem t1 = expert_item(F, I, has1 ? it + NGW : it);
        f32x4 v0[8], v1[8]; transpose_load(t0, v0, F.lane); transpose_load(t1, v1, F.lane); asm volatile("" ::: "memory");
        transpose_store(t0, v0, scr, F.lane); if (has1) transpose_store(t1, v1, scr, F.lane);
    }
}

__device__ __forceinline__ void lru_seq(const Frame& F, const In& I) {
    LAS unsigned char* wl = F.lds + F.wave * 17920;
    LAS bf16* xcA = (LAS bf16*)wl;
    LAS float* pre = (LAS float*)(wl + 9216);
    typedef float f32x2 __attribute__((ext_vector_type(2)));
    LAS f32x2* sumT = (LAS f32x2*)(F.lds + 143360);
    const int lane = F.lane, jj = lane & 15, ks = lane >> 4, c32 = lane & 31, th = lane >> 5;
    const bf16* XL = (const bf16*)(F.ws + WS_XL); const bf16* GL = (const bf16*)(F.ws + WS_GL); bf16* YL = (bf16*)(F.ws + WS_H);
    const bf16* WRT = (const bf16*)(F.ws + SM_WRT);
    for (int un = F.vcu; un < BATCH * LRUH * 2; un += F.G) {
        const int b = un >> 5, hd = (un >> 1) & 15, half = un & 1;
        const int chin = hd * 64 + lane;
        const int chg = hd * 64 + 32 * half + c32;
        const float w0 = I.p[12][chin], w1 = I.p[12][1024 + chin], w2 = I.p[12][2048 + chin], w3 = I.p[12][3072 + chin], cb = I.p[13][chin];
        const float brs = I.p[15][chg] * -1.44269504f, bis = I.p[17][chg] * -1.44269504f, cch2 = ((const float*)(F.ws + SM_LRUC))[chg];
        bf16x8 Bw[4][2];
#pragma unroll
        for (int n = 0; n < 4; ++n)
#pragma unroll
            for (int k = 0; k < 2; ++k) Bw[n][k] = *(const bf16x8*)(WRT + (size_t)(n >> 1) * 65536 + (size_t)(hd * 64 + 32 * half + 16 * (n & 1) + jj) * 64 + 32 * k + 8 * ks);
        float Rc = 0.f;
        for (int rd = 0; rd < 8; ++rd) {
            const int j = rd * 8 + F.wave;
            const size_t tok0 = (size_t)b * SEQ + (size_t)j * LRUCH;
            unsigned short xr[64], xh[3], ggr[2][16];
            { const bf16* xp = XL + tok0 * 1024 + chin;
              xh[0] = 0; xh[1] = 0; xh[2] = 0;
              if (j > 0) { xh[0] = xp[-3 * 1024]; xh[1] = xp[-2 * 1024]; xh[2] = xp[-1 * 1024]; }
#pragma unroll
              for (int t = 0; t < 64; ++t) xr[t] = xp[t * 1024]; }
#pragma unroll
            for (int st = 0; st < 2; ++st)
#pragma unroll
                for (int tl = 0; tl < 16; ++tl) ggr[st][tl] = GL[(tok0 + 32 * st + 16 * th + tl) * 1024 + chg];
            asm volatile("" ::: "memory");
            { typedef float f2v __attribute__((ext_vector_type(2)));
              float xm3 = bf2f(xh[0]), xm2 = bf2f(xh[1]), xm1 = bf2f(xh[2]);
              const f2v vw0 = {w0, w0}, vw1 = {w1, w1}, vw2 = {w2, w2}, vw3 = {w3, w3}, vcb = {cb, cb};
#pragma unroll
              for (int t = 0; t < 64; t += 2) { const float x0 = bf2f(xr[t]), x1 = bf2f(xr[t + 1]);
                  f2v xc = vcb + vw0 * (f2v){xm3, xm2}; xc = xc + vw1 * (f2v){xm2, xm1}; xc = xc + vw2 * (f2v){xm1, x0}; xc = xc + vw3 * (f2v){x0, x1};
                  const unsigned pk = pg8::cvt_pk_bf16(xc.x, xc.y);
                  xcA[t * 72 + lane] = (bf16)(pk & 0xffffu); xcA[(t + 1) * 72 + lane] = (bf16)(pk >> 16);
                  xm3 = xm1; xm2 = x0; xm1 = x1; } }
            LDS_WAIT();
            float hl[2][16], Pl[2][16], Prun[2], Hrun[2];
#pragma unroll
            for (int st = 0; st < 2; ++st) {
#pragma unroll
                for (int mh = 0; mh < 2; ++mh) { const int mt = 2 * st + mh;
                    bf16x8 a[2];
#pragma unroll
                    for (int k = 0; k < 2; ++k) a[k] = *(const LAS bf16x8*)(xcA + (16 * mt + jj) * 72 + 32 * k + 8 * ks);
#pragma unroll
                    for (int n = 0; n < 4; ++n) { f32x4 d = (f32x4){0.f, 0.f, 0.f, 0.f};
#pragma unroll
                        for (int k = 0; k < 2; ++k) d = __builtin_amdgcn_mfma_f32_16x16x32_bf16(a[k], Bw[n][k], d, 0, 0, 0);
#pragma unroll
                        for (int r = 0; r < 4; ++r) pre[(16 * mh + 4 * ks + r) * 68 + 16 * n + jj] = d[r]; } }
                LDS_WAIT();
                float h = 0.f, P = 1.f;
                typedef float f2v __attribute__((ext_vector_type(2)));
#pragma unroll
                for (int tl = 0; tl < 16; tl += 2) {
                    const int trow = 16 * th + tl;
                    const f2v pr = {pre[trow * 68 + c32], pre[(trow + 1) * 68 + c32]}, pi = {pre[trow * 68 + 32 + c32], pre[(trow + 1) * 68 + 32 + c32]};
                    const f2v zr = pr * (f2v){-1.44269504f, -1.44269504f} + (f2v){brs, brs}, zi = pi * (f2v){-1.44269504f, -1.44269504f} + (f2v){bis, bis};
                    const f2v er = {__builtin_amdgcn_exp2f(zr.x), __builtin_amdgcn_exp2f(zr.y)}, ei = {__builtin_amdgcn_exp2f(zi.x), __builtin_amdgcn_exp2f(zi.y)};
                    const f2v dr = er + (f2v){1.f, 1.f};
                    const f2v rg = {__builtin_amdgcn_rcpf(dr.x), __builtin_amdgcn_rcpf(dr.y)};
                    const f2v la2 = rg * (f2v){cch2, cch2};
                    const f2v a_ = {__builtin_amdgcn_exp2f(la2.x), __builtin_amdgcn_exp2f(la2.y)};
                    const f2v x2 = la2 * (f2v){1.38629436f, 1.38629436f};
                    f2v q = x2 * (f2v){0.0013888889f, 0.0013888889f} + (f2v){0.0083333333f, 0.0083333333f};
                    q = q * x2 + (f2v){0.041666667f, 0.041666667f}; q = q * x2 + (f2v){0.16666667f, 0.16666667f}; q = q * x2 + (f2v){0.5f, 0.5f}; q = q * x2 + (f2v){1.f, 1.f};
                    f2v om = -(q * x2);
                    const f2v alt = (f2v){1.f, 1.f} - a_ * a_;
                    om.x = x2.x > -0.3f ? om.x : alt.x; om.y = x2.y > -0.3f ? om.y : alt.y;
                    om.x = fmaxf(om.x, 1e-30f); om.y = fmaxf(om.y, 1e-30f);
                    const f2v dd = ei + (f2v){1.f, 1.f};
                    const f2v rq = om * dd * dd;
                    const f2v mi = om * (f2v){__builtin_amdgcn_rsqf(rq.x), __builtin_amdgcn_rsqf(rq.y)};
                    const f2v bx = mi * (f2v){bf2f(xcA[(32 * st + trow) * 72 + 32 * half + c32]), bf2f(xcA[(32 * st + trow + 1) * 72 + 32 * half + c32])};
                    h = a_.x * h + bx.x; P *= a_.x; hl[st][tl] = h; Pl[st][tl] = P;
                    h = a_.y * h + bx.y; P *= a_.y; hl[st][tl + 1] = h; Pl[st][tl + 1] = P;
                }
                Prun[st] = P; Hrun[st] = h;
                LDS_WAIT();
            }
            const float pP0 = __shfl_xor(Prun[0], 32), pH0 = __shfl_xor(Hrun[0], 32), pP1 = __shfl_xor(Prun[1], 32), pH1 = __shfl_xor(Hrun[1], 32);
            const float P0 = th ? pP0 : Prun[0], H0 = th ? pH0 : Hrun[0], P1 = th ? Prun[0] : pP0, H1 = th ? Hrun[0] : pH0;
            const float P2 = th ? pP1 : Prun[1], H2 = th ? pH1 : Hrun[1], P3 = th ? Prun[1] : pP1, H3 = th ? Hrun[1] : pH1;
            const float C1 = H0, Q1 = P0, C2 = P1 * C1 + H1, Q2 = P1 * Q1, C3 = P2 * C2 + H2, Q3 = P2 * Q2, Hc = P3 * C3 + H3, Pc = P3 * Q3;
            const float Cs0 = th ? C1 : 0.f, Qs0 = th ? Q1 : 1.f, Cs1 = th ? C3 : C2, Qs1 = th ? Q3 : Q2;
            if (th == 0) sumT[((rd & 1) * 8 + F.wave) * 32 + c32] = (f32x2){Pc, Hc};
            LDS_WAIT();
            __syncthreads();
            float cin = Rc, mycin = 0.f;
#pragma unroll
            for (int w = 0; w < 8; ++w) { const f32x2 ph = sumT[((rd & 1) * 8 + w) * 32 + c32]; mycin = (w == F.wave) ? cin : mycin; cin = ph.x * cin + ph.y; }
            Rc = cin;
#pragma unroll
            for (int st = 0; st < 2; ++st) { const float hin = (st ? Cs1 : Cs0) + (st ? Qs1 : Qs0) * mycin;
#pragma unroll
                for (int tl = 0; tl < 16; ++tl) { const float hh = hl[st][tl] + Pl[st][tl] * hin;
                    YL[(tok0 + 32 * st + 16 * th + tl) * 1024 + chg] = (bf16)f2bf(hh * bf2f(ggr[st][tl])); } }
        }
        __syncthreads();
    }
}

__device__ __forceinline__ void s5_chain(const Frame& F, int b, int g) {
    typedef float f32x2 __attribute__((ext_vector_type(2)));
    LAS f32x2* segE = (LAS f32x2*)(F.lds);
    const int lane = F.lane, w = F.wave;
    const float* SLOC = (const float*)(F.ws + WS_SLOC); unsigned* AGw = (unsigned*)(F.ws + WS_AG); const float* L16 = (const float*)(F.ws + SM_LAM16);
    const float lr = L16[(g * 64 + lane) * 2], li = L16[(g * 64 + lane) * 2 + 1];
    const float* sl = SLOC + ((size_t)(g * S5N + b * S5NCH + 32 * w)) * S5Q + 2 * lane;
    unsigned* ag = AGw + ((size_t)(g * S5N + b * S5NCH + 32 * w)) * (S5K / 2) + lane;
    float xr[32], xi[32];
#pragma unroll
    for (int u = 0; u < 32; ++u) { const float2 v = *(const float2*)(sl + (size_t)u * S5Q); xr[u] = v.x; xi[u] = v.y; }
    asm volatile("" ::: "memory");
    float sr = 0.f, si = 0.f;
#pragma unroll
    for (int u = 0; u < 32; ++u) { const float nr = lr * sr - li * si + xr[u], ni = lr * si + li * sr + xi[u]; xr[u] = sr; xi[u] = si; sr = nr; si = ni; }
    segE[w * 64 + lane] = (f32x2){sr, si};
    float qr = lr, qi = li;
#pragma unroll
    for (int k = 0; k < 5; ++k) { const float nr = qr * qr - qi * qi, ni = 2.f * qr * qi; qr = nr; qi = ni; }
    LDS_WAIT();
    __syncthreads();
    float cr = 0.f, ci = 0.f;
    for (int ww = 0; ww < w; ++ww) { const f32x2 e = segE[ww * 64 + lane]; const float nr = qr * cr - qi * ci + e.x, ni = qr * ci + qi * cr + e.y; cr = nr; ci = ni; }
#pragma unroll
    for (int u = 0; u < 32; ++u) { ag[(size_t)u * (S5K / 2)] = pk2(xr[u] + cr, xi[u] + ci); const float nr = lr * cr - li * ci, ni = lr * ci + li * cr; cr = nr; ci = ni; }
    __syncthreads();
}

__device__ __forceinline__ void p8_router(const Frame& F, const In& I) {
    const int lane = F.lane, tk = lane & 15, ks = lane >> 4;
    LAS float* lg = (LAS float*)(F.lds + F.wave * 4096);
    volatile LAS unsigned* cntL = F.MISC + 32; volatile LAS unsigned* baseL = F.MISC + 64;
    const float* X1 = F.out; bf16* H2 = (bf16*)(F.ws + WS_H2); const float* gf = I.p[21];
    const bf16* RHI = (const bf16*)(F.ws + SM_RHI); const bf16* RLO = (const bf16*)(F.ws + SM_RLO);
    float* RSTD = (float*)(F.ws + SM_RSTD); unsigned* gcnt = F.ctl + CW_CNT;
    int* LTOK = (int*)(F.ws + WS_LTOK); float* LW = (float*)(F.ws + WS_LW); int* TOKE = (int*)(F.ws + WS_TOKE); int* TOKR = (int*)(F.ws + WS_TOKR);
    for (int blk = F.vcu; blk < T / 128; blk += F.G) {
        if (F.tid < 32) cntL[F.tid] = 0u;
        __syncthreads();
        const int tok0 = blk * 128 + F.wave * 16;
        const float* xrow = X1 + (size_t)(tok0 + tk) * D + 8 * ks; bf16* hrow = H2 + (size_t)(tok0 + tk) * D + 8 * ks;
        f32x4 acc[3]; acc[0] = acc[1] = acc[2] = (f32x4){0.f, 0.f, 0.f, 0.f}; float ss = 0.f;
        f32x4 xnx[4][2];
#pragma unroll
        for (int q = 0; q < 4; ++q) { xnx[q][0] = __builtin_nontemporal_load((const f32x4*)(xrow + 32 * q)); xnx[q][1] = __builtin_nontemporal_load((const f32x4*)(xrow + 32 * q + 4)); }
        LAS bf16* slab = (LAS bf16*)(F.lds + 32768);
        v4u wst[3];
#define RT_SLAB_LOAD(g) do { _Pragma("unroll") for (int j = 0; j < 3; ++j) { const int c = F.tid + 512 * j, which = c / 768, r = (c % 768) >> 4, kq = c & 15; \
            wst[j] = *(const v4u*)((which ? RLO : RHI) + (size_t)r * D + 128 * (g) + 8 * kq); } } while (0)
#define RT_SLAB_STORE(buf) do { _Pragma("unroll") for (int j = 0; j < 3; ++j) { const int c = F.tid + 512 * j, which = c / 768, r = (c % 768) >> 4, kq = c & 15; \
            *(LAS v4u*)(slab + ((size_t)((buf) * 2 + which) * 48 + r) * 136 + 8 * kq) = wst[j]; } } while (0)
        RT_SLAB_LOAD(0); RT_SLAB_STORE(0);
        LDS_WAIT();
        __syncthreads();
        for (int kg = 0; kg < 8; ++kg) {
            f32x4 xa[4][2];
#pragma unroll
            for (int q = 0; q < 4; ++q) { xa[q][0] = xnx[q][0]; xa[q][1] = xnx[q][1]; }
            { const int kgn = kg < 7 ? kg + 1 : kg;
#pragma unroll
              for (int q = 0; q < 4; ++q) { xnx[q][0] = __builtin_nontemporal_load((const f32x4*)(xrow + 32 * (4 * kgn + q))); xnx[q][1] = __builtin_nontemporal_load((const f32x4*)(xrow + 32 * (4 * kgn + q) + 4)); }
              RT_SLAB_LOAD(kgn); }
            f32x4 ga[4][2];
#pragma unroll
            for (int q = 0; q < 4; ++q) { const int kc = 4 * kg + q; ga[q][0] = *(const f32x4*)(gf + 32 * kc + 8 * ks); ga[q][1] = *(const f32x4*)(gf + 32 * kc + 8 * ks + 4); }
            asm volatile("" ::: "memory");
            const LAS bf16* sh = slab + (size_t)((kg & 1) * 2) * 48 * 136, * sl = sh + 48 * 136;
#pragma unroll
            for (int q = 0; q < 4; ++q) { const int kc = 4 * kg + q;
                const f32x4 a0 = xa[q][0], a1 = xa[q][1];
                ss += (a0.x * a0.x + a0.y * a0.y) + (a0.z * a0.z + a0.w * a0.w) + (a1.x * a1.x + a1.y * a1.y) + (a1.z * a1.z + a1.w * a1.w);
                const f32x4 v0 = a0 * ga[q][0], v1 = a1 * ga[q][1];
                v4u hi, lo;
                { const unsigned h0 = f2bf(v0.x), h1 = f2bf(v0.y), h2 = f2bf(v0.z), h3 = f2bf(v0.w), h4 = f2bf(v1.x), h5 = f2bf(v1.y), h6 = f2bf(v1.z), h7 = f2bf(v1.w);
                  hi.x = h0 | (h1 << 16); hi.y = h2 | (h3 << 16); hi.z = h4 | (h5 << 16); hi.w = h6 | (h7 << 16);
                  lo.x = pk2(v0.x - bf2f(h0), v0.y - bf2f(h1)); lo.y = pk2(v0.z - bf2f(h2), v0.w - bf2f(h3)); lo.z = pk2(v1.x - bf2f(h4), v1.y - bf2f(h5)); lo.w = pk2(v1.z - bf2f(h6), v1.w - bf2f(h7)); }
                *(v4u*)(hrow + 32 * kc) = hi;
                const bf16x8 hf = __builtin_bit_cast(bf16x8, hi), lf = __builtin_bit_cast(bf16x8, lo);
#pragma unroll
                for (int n = 0; n < 3; ++n) {
                    const bf16x8 wh = *(const LAS bf16x8*)(sh + (16 * n + tk) * 136 + 32 * q + 8 * ks), wl = *(const LAS bf16x8*)(sl + (16 * n + tk) * 136 + 32 * q + 8 * ks);
                    acc[n] = __builtin_amdgcn_mfma_f32_16x16x32_bf16(wh, hf, acc[n], 0, 0, 0);
                    acc[n] = __builtin_amdgcn_mfma_f32_16x16x32_bf16(wh, lf, acc[n], 0, 0, 0);
                    acc[n] = __builtin_amdgcn_mfma_f32_16x16x32_bf16(wl, hf, acc[n], 0, 0, 0);
                } }
            if (kg < 7) RT_SLAB_STORE((kg + 1) & 1);
            LDS_WAIT();
            __syncthreads();
        }
#undef RT_SLAB_LOAD
#undef RT_SLAB_STORE
        ss += __shfl_xor(ss, 16); ss += __shfl_xor(ss, 32);
        const float rstd = 1.0f / sqrtf(ss * (1.f / D) + RMS_EPS);
        if (ks == 0) RSTD[tok0 + tk] = rstd;
#pragma unroll
        for (int n = 0; n < 3; ++n)
#pragma unroll
            for (int r = 0; r < 4; ++r) lg[tk * 49 + 16 * n + 4 * ks + r] = acc[n][r] * rstd;
        LDS_WAIT();
        int E1 = 0, E2 = 0; float w1 = 0.f, w2 = 0.f; unsigned r1 = 0, r2 = 0;
        if (lane < 16) {
            const LAS float* my = lg + lane * 49;
            float lgp[4];
#pragma unroll
            for (int i = 0; i < 4; ++i) lgp[i] = my[i] + I.p[23][i];
            int gi = 0; float mx = lgp[0];
#pragma unroll
            for (int i = 1; i < 4; ++i) if (lgp[i] > mx) { mx = lgp[i]; gi = i; }
            float den = 0.f;
#pragma unroll
            for (int i = 0; i < 4; ++i) den += expf(lgp[i] - mx);
            const float pg = 1.0f / den;
            float le[8];
#pragma unroll
            for (int i = 0; i < 8; ++i) le[i] = my[4 + gi * 8 + i] + I.p[25][gi * 8 + i];
            int i1 = 0; float m1 = le[0];
#pragma unroll
            for (int i = 1; i < 8; ++i) if (le[i] > m1) { m1 = le[i]; i1 = i; }
            int i2 = -1; float m2 = -3.0e38f;
#pragma unroll
            for (int i = 0; i < 8; ++i) if (i != i1 && le[i] > m2) { m2 = le[i]; i2 = i; }
            const float e2 = expf(m2 - m1);
            w1 = pg / (1.0f + e2); w2 = pg * e2 / (1.0f + e2);
            E1 = gi * 8 + i1; E2 = gi * 8 + i2;
            r1 = __hip_atomic_fetch_add((LAS unsigned*)(F.MISC + 32) + E1, 1u, __ATOMIC_RELAXED, __HIP_MEMORY_SCOPE_WORKGROUP);
            r2 = __hip_atomic_fetch_add((LAS unsigned*)(F.MISC + 32) + E2, 1u, __ATOMIC_RELAXED, __HIP_MEMORY_SCOPE_WORKGROUP);
        }
        LDS_WAIT();
        __syncthreads();
        if (F.tid < 32) { const unsigned c = cntL[F.tid]; baseL[F.tid] = c ? __hip_atomic_fetch_add(gcnt + F.tid, c, __ATOMIC_RELAXED, __HIP_MEMORY_SCOPE_AGENT) : 0u; }
        __syncthreads();
        if (lane < 16) {
            const int tok = tok0 + lane; const int k1 = (int)(baseL[E1] + r1), k2 = (int)(baseL[E2] + r2);
            LTOK[(size_t)E1 * T + k1] = tok; LW[(size_t)E1 * T + k1] = w1; LTOK[(size_t)E2 * T + k2] = tok; LW[(size_t)E2 * T + k2] = w2;
            TOKE[tok * 2] = E1; TOKE[tok * 2 + 1] = E2; TOKR[tok * 2] = k1; TOKR[tok * 2 + 1] = k2;
        }
        __syncthreads();
    }
}

__device__ __forceinline__ void moe_prefix(const Frame& F) {
    if (F.tid < 64) {
        const unsigned nt = F.tid < NEXP ? (F.ctl[CW_CNT + F.tid] + 255u) >> 8 : 0u; unsigned inc = nt;
#pragma unroll
        for (int o = 1; o < 32; o <<= 1) { const unsigned v = __shfl_up(inc, o); if (F.lane >= o) inc += v; }
        if (F.tid < NEXP) F.MISC[96 + F.tid] = inc - nt;
        if (F.tid == NEXP - 1) F.MISC[128] = inc;
    }
    LDS_WAIT();
    __syncthreads();
}
template <int MODE  >
__device__ __forceinline__ void moe_setup(const Frame& F) {
    moe_prefix(F);
    const int NT = (int)F.MISC[128];
    if (F.tid < MAXU) { const int L = F.tid * F.G + F.vcu; int e = -1, mt = 0;
        if (L < NT * 4) { const int mtg = L >> 2; e = 0; while (e < NEXP - 1 && (int)F.MISC[96 + e + 1] <= mtg) ++e; mt = mtg - (int)F.MISC[96 + e]; }
        F.MISC[136 + F.tid] = (unsigned)e; F.MISC[144 + F.tid] = (unsigned)mt; }
    __syncthreads();
    if (F.tid == 0) { int n = 0; while (n < MAXU && (int)F.MISC[136 + n] >= 0) ++n; F.MISC[152] = (unsigned)n; }
    __syncthreads();
    const int nU = (int)F.MISC[152];
    LAS int* tokL = (LAS int*)(F.lds + TOKL_OFF); LAS float* sclL = (LAS float*)(F.lds + SCLL_OFF);
    const int* LTOK = (const int*)(F.ws + WS_LTOK); const float* LW = (const float*)(F.ws + WS_LW); const float* RSTD = (const float*)(F.ws + SM_RSTD);
    for (int i = F.tid; i < nU * 256; i += 512) { const int ui = i >> 8, r = i & 255, e = (int)F.MISC[136 + ui], rank = (int)F.MISC[144 + ui] * 256 + r; const bool valid = rank < (int)F.ctl[CW_CNT + e];
        const int tok = valid ? LTOK[(size_t)e * T + rank] : 0; tokL[i] = tok; sclL[i] = valid ? (MODE == 0 ? RSTD[tok] : LW[(size_t)e * T + rank]) : 0.f; }
    LDS_WAIT(); VM_WAIT();
    __syncthreads();
}

__device__ __forceinline__ void p11_final(const Frame& F, const In& I, float* dst) {
    moe_prefix(F);
    const int gw = F.vcu * NWAVES + F.wave, NGW = F.G * NWAVES, lane = F.lane;
    const int* TOKE = (const int*)(F.ws + WS_TOKE); const int* TOKR = (const int*)(F.ws + WS_TOKR); const bf16* YS = (const bf16*)(F.ws + WS_YS);
    f32x4 gfin[4];
#pragma unroll
    for (int j = 0; j < 4; ++j) gfin[j] = ((const f32x4*)I.p[29])[lane + 64 * j];
    int ee[2][2], rr[2][2];
    { const int m0 = gw * 2 < T ? gw * 2 : 0;
#pragma unroll
      for (int q = 0; q < 2; ++q) { ee[q][0] = TOKE[2 * (m0 + q)]; ee[q][1] = TOKE[2 * (m0 + q) + 1]; rr[q][0] = TOKR[2 * (m0 + q)]; rr[q][1] = TOKR[2 * (m0 + q) + 1]; } }
    for (int m0 = gw * 2; m0 < T; m0 += NGW * 2) {
        f32x4 xv[2][4]; v2u ya[2][4], yb[2][4];
#pragma unroll
        for (int q = 0; q < 2; ++q) { const size_t s0 = (size_t)F.MISC[96 + ee[q][0]] * 256 + rr[q][0], s1 = (size_t)F.MISC[96 + ee[q][1]] * 256 + rr[q][1];
            const f32x4* xr = (const f32x4*)(F.out + (size_t)(m0 + q) * D) + lane; const v2u* y0 = (const v2u*)(YS + s0 * 1024) + lane; const v2u* y1 = (const v2u*)(YS + s1 * 1024) + lane;
#pragma unroll
            for (int j = 0; j < 4; ++j) { xv[q][j] = __builtin_nontemporal_load(xr + 64 * j); ya[q][j] = __builtin_nontemporal_load(y0 + 64 * j); yb[q][j] = __builtin_nontemporal_load(y1 + 64 * j); } }
        { const int mn = m0 + NGW * 2 < T ? m0 + NGW * 2 : m0;
#pragma unroll
          for (int q = 0; q < 2; ++q) { ee[q][0] = TOKE[2 * (mn + q)]; ee[q][1] = TOKE[2 * (mn + q) + 1]; rr[q][0] = TOKR[2 * (mn + q)]; rr[q][1] = TOKR[2 * (mn + q) + 1]; } }
        asm volatile("" ::: "memory");
#pragma unroll
        for (int q = 0; q < 2; ++q) { f32x4 v[4]; float s = 0.f;
#pragma unroll
            for (int j = 0; j < 4; ++j) { const f32x4 x = xv[q][j]; const v2u a = ya[q][j], b = yb[q][j];
                v[j].x = x.x + bflo(a.x) + bflo(b.x); v[j].y = x.y + bfhi(a.x) + bfhi(b.x); v[j].z = x.z + bflo(a.y) + bflo(b.y); v[j].w = x.w + bfhi(a.y) + bfhi(b.y);
                s += (v[j].x * v[j].x + v[j].y * v[j].y) + (v[j].z * v[j].z + v[j].w * v[j].w); }
            const float rstd = 1.0f / sqrtf(wave_sum(s) * (1.f / D) + RMS_EPS);
            f32x4* xw = (f32x4*)(dst + (size_t)(m0 + q) * D) + lane;
#pragma unroll
            for (int j = 0; j < 4; ++j) { const f32x4 g = gfin[j]; __builtin_nontemporal_store((f32x4){v[j].x * rstd * g.x, v[j].y * rstd * g.y, v[j].z * rstd * g.z, v[j].w * rstd * g.w}, xw + 64 * j); } }
    }
}

constexpr int N_PHASES = 12;
struct Args { In in; float* out; unsigned char* ws; float* fin_dst; int ph_lo, ph_hi, li, pad; };
__global__ void __launch_bounds__(NWAVES * 64, 2) mk_fwd(Args args) {
    extern __shared__ __attribute__((aligned(16))) unsigned char lds[];
    Frame F;
    F.lds = (LAS unsigned char*)lds;
    F.MISC = (volatile LAS unsigned*)(F.lds + MISC_OFF);
    F.tid = threadIdx.x; F.lane = F.tid & 63; F.wave = __builtin_amdgcn_readfirstlane(F.tid >> 6);
    F.G = gridDim.x; { const int bx = blockIdx.x; F.vcu = (F.G % 8 == 0) ? (bx % 8) * (F.G / 8) + bx / 8 : bx; }
    F.ws = args.ws; F.out = args.out; F.ctl = (unsigned*)(args.ws + WS_CTL); F.in = nullptr;
    const In& I = args.in;
    for (int u = F.tid; u < 256; u += NWAVES * 64) F.MISC[u] = 0u;
    __syncthreads();
    const int lo = args.ph_lo, hi = args.ph_hi;
    XcdBarrier bar; bar.bar = F.ctl + CW_BAR + args.li * XCD_BAR_WORDS; bar.x = 0; bar.st = nullptr;
    if (hi - lo > 1) bar = xcd_barrier_post(F.ctl + CW_BAR + args.li * XCD_BAR_WORDS, F.MISC + 8);
#ifndef PH_MASK
#define PH_MASK 0xFFF
#endif
#define IN(k) (((PH_MASK >> (k)) & 1) && lo <= (k) && (k) < hi)
#define SEAM(k) do { if (IN(k) && IN(NEXT_PH(k))) xcd_barrier(bar); } while (0)
#define NEXT_PH(k) ((k) == 2 ? 5 : (k) + 1)
    const int cblk = (int)blockIdx.x;
    LAS unsigned char* ring = F.lds;

    if (IN(0)) { p0_prologue(F, I); SEAM(0); }

    if (IN(1)) {
        DenseOrder S; S.init(F.ws + WS_H, F.ws + WS_WIN, D, D, T, NIN, F.G, cblk);
        EpiInProj E{(bf16*)(F.ws + WS_AG), (bf16*)(F.ws + WS_XL), (bf16*)(F.ws + WS_GL), (bf16*)(F.ws + WS_GA), (bf16*)(F.ws + WS_GB)};
        pg8::gemm_phase<EpiInProj, DenseOrder, true>(ring, D, D, S, E);
        SEAM(1);
    }
    if (IN(2)) {
        if (cblk < 256) {
            const int L = cblk, wgid = (L % 8) * 32 + L / 8, g = wgid >> 3, mt = wgid & 7;
            { S5One S{(const char*)(F.ws + WS_AG) + S5Q * 2, (const char*)(F.ws + WS_BTW), (size_t)S5N * S5K * 2, (size_t)128 * 256 * 2, S5K, g, mt};
              EpiS5State E{(float*)(F.ws + WS_SLOC)};
              pg8::gemm_phase<EpiS5State, S5One, false>(ring, 256, 256, S, E); }
            if (F.wave == 0) { __builtin_amdgcn_fence(__ATOMIC_ACQUIRE, "agent"); VM_WAIT(); }
            __syncthreads();
            s5_chain(F, mt, g);
            VM_WAIT();
            __syncthreads();
            if (F.wave == 0) { __builtin_amdgcn_fence(__ATOMIC_ACQUIRE, "agent"); VM_WAIT(); }
            __syncthreads();
            { S5One S{(const char*)(F.ws + WS_AG), (const char*)(F.ws + WS_BTT), (size_t)S5N * S5K * 2, (size_t)256 * S5K * 2, S5K, g, mt};
              EpiS5Out E{(bf16*)(F.ws + WS_GY)};
              pg8::gemm_phase<EpiS5Out, S5One, false>(ring, S5K, S5K, S, E); }
            __syncthreads();
        }
        lru_seq(F, I);
        SEAM(2);
    }
    if (IN(5)) {
        GyOrder S; S.d.init(F.ws + WS_GY, F.ws + WS_WS5, S5W, S5W, T, 2 * D, F.G, cblk);
        EpiYa E{(const bf16*)(F.ws + WS_GA), (bf16*)(F.ws + WS_XL)};
        pg8::gemm_phase<EpiYa, GyOrder, true>(ring, S5W, S5W, S, E, (size_t)4 * T * 32);
        SEAM(5);
    }
    if (IN(6)) {
        DenseOrder S; S.init(F.ws + WS_H, F.ws + WS_WLRU, D, D, T, D, F.G, cblk);
        EpiYb E{(const bf16*)(F.ws + WS_XL), (const bf16*)(F.ws + WS_GB), (bf16*)(F.ws + WS_GL)};
        pg8::gemm_phase<EpiYb, DenseOrder, true>(ring, D, D, S, E);
        SEAM(6);
    }
    if (IN(7)) {
        DenseOrder S; S.init(F.ws + WS_GL, F.ws + WS_WO, D, D, T, D, F.G, cblk);
        EpiWo E{I.p[0], F.out};
        pg8::gemm_phase<EpiWo, DenseOrder, true>(ring, D, D, S, E);
        SEAM(7);
    }
    if (IN(8)) { p8_router(F, I); __syncthreads(); expert_weight_copies(F, I); SEAM(8); }
    if (IN(9)) {
        moe_setup<0>(F);
        MoeOrder<true> S{(const char*)(F.ws + WS_H2), (const char*)(F.ws + WS_WGU), (size_t)1024 * 1024 * 2, D, D, F.G, F.vcu, F.MISC, (const LAS int*)(F.lds + TOKL_OFF)};
        EpiGU E{(bf16*)(F.ws + WS_ACT), (const LAS float*)(F.lds + SCLL_OFF)};
        pg8::gemm_phase<EpiGU, MoeOrder<true>, true>(ring, D, D, S, E);
        SEAM(9);
    }
    if (IN(10)) {
        moe_setup<1>(F);
        MoeOrder<false> S{(const char*)(F.ws + WS_ACT), (const char*)(F.ws + WS_WD), (size_t)1024 * DEXP * 2, DEXP, DEXP, F.G, F.vcu, F.MISC, (const LAS int*)(F.lds + TOKL_OFF)};
        EpiDown E{(bf16*)(F.ws + WS_YS), (const LAS float*)(F.lds + SCLL_OFF)};
        pg8::gemm_phase<EpiDown, MoeOrder<false>, true>(ring, DEXP, DEXP, S, E);
        SEAM(10);
    }
    if (IN(11)) { p11_final(F, I, args.fin_dst); }
#undef IN
#undef SEAM
}

extern "C" void kernel_launch(void* const* d_in, const int* in_sizes, int n_in, void* d_out, int out_size, void* d_ws, size_t ws_size, hipStream_t stream) {
    static int grid = 0;
    if (grid == 0) {
        if (n_in != 30 || in_sizes[0] != T * D || out_size != T * D || ws_size < WS_END) { fprintf(stderr, "kernel_launch: unexpected shapes / workspace (n_in %d, ws %zu)\n", n_in, ws_size); grid = -1; return; }
        int dev = 0, cus = 0, per_cu = 0;
        if (hipGetDevice(&dev) != hipSuccess || hipDeviceGetAttribute(&cus, hipDeviceAttributeMultiprocessorCount, dev) != hipSuccess) { grid = -1; return; }
        if (hipFuncSetAttribute((const void*)mk_fwd, hipFuncAttributeMaxDynamicSharedMemorySize, LDS_BYTES) != hipSuccess) { fprintf(stderr, "kernel_launch: hipFuncSetAttribute failed\n"); grid = -1; return; }
        if (hipOccupancyMaxActiveBlocksPerMultiprocessor(&per_cu, (const void*)mk_fwd, NWAVES * 64, LDS_BYTES) != hipSuccess || per_cu < 1) { fprintf(stderr, "kernel_launch: occupancy query says %d\n", per_cu); }
        (void)hipGetLastError();
        grid = cus;
    }
    if (grid < 0) return;
    if (hipMemsetAsync((char*)d_ws + WS_CTL, 0, CTL_ZERO_BYTES, stream) != hipSuccess) return;
    Args a{};
    for (int i = 0; i < 30; ++i) a.in.p[i] = (const float*)d_in[i];
    a.out = (float*)d_out; a.ws = (unsigned char*)d_ws; a.fin_dst = (float*)d_out;
#if defined(PROBE_LO)
    a.ph_lo = 0; a.ph_hi = PROBE_HI; a.li = 0;
#if PROBE_LO == 11
    a.fin_dst = (float*)((char*)d_ws + WS_WGU);
#endif
    hipLaunchKernelGGL(mk_fwd, dim3(grid), dim3(NWAVES * 64), LDS_BYTES, stream, a);
#if PROBE_LO == 8
    hipMemsetAsync((char*)d_ws + WS_CTL + CW_CNT * 4, 0, 128, stream);
#endif
    a.fin_dst = (float*)d_out;
    a.ph_lo = PROBE_LO; a.ph_hi = N_PHASES; a.li = 1;
    hipLaunchKernelGGL(mk_fwd, dim3(grid), dim3(NWAVES * 64), LDS_BYTES, stream, a);
#elif MK_N_LAUNCHES == 1
    a.ph_lo = 0; a.ph_hi = N_PHASES;
    hipLaunchKernelGGL(mk_fwd, dim3(grid), dim3(NWAVES * 64), LDS_BYTES, stream, a);
#else
    for (int p = 0; p < N_PHASES; ++p) { a.ph_lo = p; a.ph_hi = p + 1; hipLaunchKernelGGL(mk_fwd, dim3(grid), dim3(NWAVES * 64), LDS_BYTES, stream, a); }
#endif
}
```

```cpp
#include <hip/hip_runtime.h>
#include <cstdio>
#include <cstdint>

#ifndef MK_N_LAUNCHES
#define MK_N_LAUNCHES 1
#endif

namespace pg8 {
#define PG8_LAS __attribute__((address_space(3)))
typedef unsigned short bf16_t;
typedef short bf16x8 __attribute__((ext_vector_type(8)));
typedef float f32x4 __attribute__((ext_vector_type(4)));
typedef unsigned u32x4 __attribute__((ext_vector_type(4)));
constexpr int BM = 256, BK = 64, HALF = 128, HTB = HALF * BK * 2  , STAGE_BYTES = 8 * HTB, NXCD = 8, WGM = 8;

__host__ __device__ __forceinline__ int lds_byte(int r, int c) { const int st = (r >> 4) * 2 + (c >> 5), rr = r & 15, cc = c & 31, ob = rr * 64 + cc * 2; return st * 1024 + (ob ^ (((ob >> 9) & 1) << 5)); }
__host__ __device__ __forceinline__ void stage_rc(int b, int& R, int& C) { const int st = b / 1024, sb = b % 1024, swz = sb ^ (((sb >> 9) & 1) << 5); R = (st >> 1) * 16 + swz / 64; C = (st & 1) * 32 + (swz % 64) / 2; }
__host__ __device__ __forceinline__ int perm32(int rho) { const int n = rho >> 4, i = rho & 15; return 8 * (i >> 2) + 4 * n + (i & 3); }

struct Unit { const char* A; const char* B; int pm, pn, aux; };

__device__ __forceinline__ unsigned cvt_pk_bf16(float lo, float hi) { unsigned r; asm volatile("v_cvt_pk_bf16_f32 %0, %1, %2" : "=v"(r) : "v"(lo), "v"(hi)); return r; }

template <class Epi, class Sched, bool ALIGN_EPI>
__device__ __forceinline__ void gemm_phase(PG8_LAS unsigned char* lds, const int ldb, const int K, const Sched& S, const Epi& E, const size_t kstepA = (size_t)(BK * 2)) {
    const int tid = threadIdx.x, wid = __builtin_amdgcn_readfirstlane(tid >> 6), lane = tid & 63, wr = wid >> 2, wc = wid & 3, fr = lane & 15, fq = lane >> 4;
    int nt = K / BK; asm volatile("" : "+s"(nt));
    int Rr[2], Cc[2]; unsigned voffB[4], vAc[4], vAn[4];
#pragma unroll
    for (int i = 0; i < 2; ++i) { int R, C; stage_rc(tid * 16 + i * 8192, R, C); Rr[i] = R; Cc[i] = C; const int Rb = Epi::PERM ? ((R & ~31) + perm32(R & 31)) : R;
        voffB[i] = (unsigned)(Rb * ldb + C) * 2u; voffB[2 + i] = (unsigned)((HALF + Rb) * ldb + C) * 2u; }
    const size_t kstep = (size_t)(BK * 2);
    const unsigned ldsw = (unsigned)wid * 1024u;
    const int aoff = lds_byte(wr * 64 + fr, fq * 8), boff = lds_byte(wc * 32 + fr, fq * 8);
#define PG8_SA(b, h) (((b) * 2 + (h)) * HTB)
#define PG8_SB(b, h) ((4 + (b) * 2 + (h)) * HTB)
#define PG8_STAGE(bufoff, gbase, voff, h) do { _Pragma("unroll") for (int _i = 0; _i < 2; ++_i) \
        __builtin_amdgcn_global_load_lds((const unsigned*)((const char*)(gbase) + (voff)[2 * (h) + _i]), (PG8_LAS unsigned*)(lds + (bufoff) + ldsw + _i * 8192), 16, 0, 0); } while (0)
#define PG8_LDA(dst, b, h) do { _Pragma("unroll") for (int m = 0; m < 4; ++m) _Pragma("unroll") for (int k = 0; k < 2; ++k) dst[m][k] = *(const PG8_LAS bf16x8*)(lds + PG8_SA(b, h) + aoff + m * 2048 + k * 1024); } while (0)
#define PG8_LDB(dst, b, h) do { _Pragma("unroll") for (int n = 0; n < 2; ++n) _Pragma("unroll") for (int k = 0; k < 2; ++k) dst[n][k] = *(const PG8_LAS bf16x8*)(lds + PG8_SB(b, h) + boff + n * 2048 + k * 1024); } while (0)
#define PG8_MMA(ai, bj, At, Bt) do { __builtin_amdgcn_s_setprio(1); _Pragma("unroll") for (int m = 0; m < 4; ++m) _Pragma("unroll") for (int n = 0; n < 2; ++n) _Pragma("unroll") for (int k = 0; k < 2; ++k) \
        acc[ai][bj][m][n] = __builtin_amdgcn_mfma_f32_16x16x32_bf16(Bt[n][k], At[m][k], acc[ai][bj][m][n], 0, 0, 0); __builtin_amdgcn_s_setprio(0); } while (0)
#define PG8_WAIT_V(n) asm volatile("s_waitcnt vmcnt(" #n ")" ::: "memory")
#define PG8_WAIT_L(n) asm volatile("s_waitcnt lgkmcnt(" #n ")" ::: "memory")
#define PG8_BAR __builtin_amdgcn_s_barrier()
#define PG8_SCHED __builtin_amdgcn_sched_barrier(0)
    Unit cur, nxt; int ui = 0;
    if (!S.next(0, cur)) return;
    S.a_offsets(cur, Rr, Cc, vAc);
    f32x4 acc[2][2][4][2];
    if constexpr (Epi::ACC_INIT) E.init(acc, cur, wr, wc, fr, fq);
    else {
#pragma unroll
    for (int a = 0; a < 2; ++a)
#pragma unroll
        for (int b = 0; b < 2; ++b)
#pragma unroll
            for (int m = 0; m < 4; ++m)
#pragma unroll
                for (int n = 0; n < 2; ++n) acc[a][b][m][n] = (f32x4){0.f, 0.f, 0.f, 0.f}; }
    bf16x8 At[4][2], B0[2][2], B1[2][2];
    const char* cA = cur.A; const char* cB = cur.B;
    if constexpr (Sched::GATHER) { PG8_WAIT_L(0); }
    PG8_STAGE(PG8_SB(0, 0), cB, voffB, 0); PG8_STAGE(PG8_SB(0, 1), cB, voffB, 1); PG8_STAGE(PG8_SA(0, 0), cA, vAc, 0); PG8_STAGE(PG8_SA(0, 1), cA, vAc, 1);
    if (wr == 1) PG8_BAR;
    PG8_WAIT_V(2); PG8_BAR;
    PG8_STAGE(PG8_SB(1, 0), cB + kstep, voffB, 0); PG8_STAGE(PG8_SA(1, 0), cA + kstepA, vAc, 0); PG8_STAGE(PG8_SB(1, 1), cB + kstep, voffB, 1);
    PG8_WAIT_V(6); PG8_BAR;
    for (;;) {
        const bool has_next = S.next(ui + 1, nxt);
        const char* nA = has_next ? nxt.A : cA; const char* nB = has_next ? nxt.B : cB;
        for (int t = 0; t < nt; t += 2) {
            const bool last = (t == nt - 2);
            const char* a1 = cA + (size_t)(t + 1) * kstepA;
            const char* a2 = last ? nA : cA + (size_t)(t + 2) * kstepA; const char* b2 = last ? nB : cB + (size_t)(t + 2) * kstep;
            const char* a3 = a2 + kstepA; const char* b3 = b2 + kstep;
            unsigned va2[4];
            if constexpr (Sched::GATHER) {
                if (last) { if (has_next) { S.a_offsets(nxt, Rr, Cc, vAn); PG8_WAIT_L(0); } else {
#pragma unroll
                        for (int q = 0; q < 4; ++q) vAn[q] = vAc[q]; } }
#pragma unroll
                for (int q = 0; q < 4; ++q) va2[q] = last ? vAn[q] : vAc[q];
            } else {
#pragma unroll
                for (int q = 0; q < 4; ++q) va2[q] = vAc[q];
            }
            PG8_LDB(B0, 0, 0); PG8_LDB(B1, 0, 1); PG8_SCHED; PG8_LDA(At, 0, 0); PG8_STAGE(PG8_SA(1, 1), a1, vAc, 1);
            PG8_WAIT_V(8); PG8_WAIT_L(0); PG8_BAR; PG8_MMA(0, 0, At, B0); PG8_MMA(0, 1, At, B1); PG8_BAR; PG8_SCHED;
            const bool fin = last && !has_next;
            PG8_LDA(At, 0, 1);
            if (!fin) { PG8_STAGE(PG8_SB(0, 0), b2, voffB, 0); PG8_STAGE(PG8_SB(0, 1), b2, voffB, 1); PG8_STAGE(PG8_SA(0, 0), a2, va2, 0); PG8_WAIT_V(8); } else { PG8_WAIT_V(0); }
            PG8_WAIT_L(0); PG8_BAR; PG8_MMA(1, 0, At, B0); PG8_MMA(1, 1, At, B1); PG8_BAR; PG8_SCHED;
            PG8_LDB(B0, 1, 0); PG8_LDB(B1, 1, 1); PG8_SCHED; PG8_LDA(At, 1, 0);
            if (!fin) { PG8_STAGE(PG8_SA(0, 1), a2, va2, 1); PG8_WAIT_V(8); } else { PG8_WAIT_V(0); }
            PG8_WAIT_L(0); PG8_BAR; PG8_MMA(0, 0, At, B0); PG8_MMA(0, 1, At, B1); PG8_BAR; PG8_SCHED;
            PG8_LDA(At, 1, 1);
            if (!fin) { PG8_STAGE(PG8_SB(1, 0), b3, voffB, 0); PG8_STAGE(PG8_SB(1, 1), b3, voffB, 1); PG8_STAGE(PG8_SA(1, 0), a3, va2, 0); PG8_WAIT_V(8); } else { PG8_WAIT_V(0); }
            PG8_WAIT_L(0); PG8_BAR; PG8_MMA(1, 0, At, B0); PG8_MMA(1, 1, At, B1); PG8_BAR; PG8_SCHED;
        }
        if constexpr (ALIGN_EPI) { if (wr == 0) PG8_BAR; }
        E(acc, cur, wr, wc, fr, fq);
        if (!has_next) break;
        if constexpr (Epi::ACC_INIT) E.init(acc, nxt, wr, wc, fr, fq);
        else {
#pragma unroll
        for (int a = 0; a < 2; ++a)
#pragma unroll
            for (int b = 0; b < 2; ++b)
#pragma unroll
                for (int m = 0; m < 4; ++m)
#pragma unroll
                    for (int n = 0; n < 2; ++n) acc[a][b][m][n] = (f32x4){0.f, 0.f, 0.f, 0.f}; }
        cur = nxt; cA = nA; cB = nB; ++ui;
        if constexpr (Sched::GATHER) {
#pragma unroll
            for (int q = 0; q < 4; ++q) vAc[q] = vAn[q]; }
        if constexpr (ALIGN_EPI) { if (wr == 1) PG8_BAR; }
    }
    PG8_WAIT_V(0);
    if constexpr (!ALIGN_EPI) { if (wr == 0) PG8_BAR; }
    PG8_BAR;
#undef PG8_SA
#undef PG8_SB
#undef PG8_STAGE
#undef PG8_LDA
#undef PG8_LDB
#undef PG8_MMA
#undef PG8_WAIT_V
#undef PG8_WAIT_L
#undef PG8_BAR
#undef PG8_SCHED
}
}

constexpr int NWAVES = 8;
constexpr int BATCH = 8, SEQ = 4096, D = 1024, T = BATCH * SEQ;
constexpr int S5W = 512, S5G = 32, S5C = 16, S5P = 64, S5Q = 128;
constexpr int S5LC = 16, S5NCH = SEQ / S5LC, S5N = BATCH * S5NCH;
constexpr int S5K = S5Q + S5LC * S5C;
constexpr int LRUW = 1024, LRUH = 16, LRUHD = 64, LRUCH = 64, LRUNCH = SEQ / LRUCH;
constexpr int NIN = S5W + 2 * LRUW + 2 * D;
constexpr int NEXP = 32, EPG = 8, NGRP = 4, DEXP = 512, NROUT = 48;
constexpr int MAXSLOT = 73728;
constexpr int MAXU = 8;
constexpr float RMS_EPS = 1e-6f;

constexpr size_t MiB = 1u << 20;
constexpr size_t WS_CTL = 0, CTL_ZERO_BYTES = 128 * 1024;
constexpr size_t WS_SMALL = 1 * MiB;
constexpr size_t SM_LAM16 = WS_SMALL + 0;
constexpr size_t SM_LRUC = WS_SMALL + 16384;
constexpr size_t SM_WRT = WS_SMALL + 32768;
constexpr size_t SM_RHI = WS_SMALL + 327680;
constexpr size_t SM_RLO = SM_RHI + 98304;
constexpr size_t SM_RSTD = WS_SMALL + 524288;
constexpr size_t WS_BTT = 2 * MiB;
constexpr size_t WS_BTW = 8 * MiB;
constexpr size_t WS_WIN = 11 * MiB;
constexpr size_t WS_WS5 = 20 * MiB;
constexpr size_t WS_WLRU = 22 * MiB;
constexpr size_t WS_WO = 24 * MiB;
constexpr size_t WS_LP = 26 * MiB, WS_LH = 28 * MiB, WS_LHIN = 30 * MiB;
constexpr size_t WS_AG = 32 * MiB;
constexpr size_t WS_SLOC = 80 * MiB;
constexpr size_t WS_H = 112 * MiB;
constexpr size_t WS_XL = 176 * MiB;
constexpr size_t WS_GL = 240 * MiB;
constexpr size_t WS_GA = 304 * MiB, WS_GB = 336 * MiB;
constexpr size_t WS_GY = 368 * MiB;
constexpr size_t WS_WGU = 400 * MiB;
constexpr size_t WS_WD = 464 * MiB;
constexpr size_t WS_H2 = 32 * MiB;
constexpr size_t WS_ACT = 96 * MiB;
constexpr size_t WS_YS = 168 * MiB;
constexpr size_t WS_LTOK = 312 * MiB, WS_LW = 316 * MiB;
constexpr size_t WS_TOKE = 320 * MiB, WS_TOKR = WS_TOKE + 262144;
constexpr size_t WS_END = 496 * MiB;
static_assert(WS_YS + (size_t)MAXSLOT * 1024 * 2 <= WS_LTOK && WS_ACT + (size_t)MAXSLOT * 512 * 2 <= WS_YS && WS_TOKR + 262144 <= WS_WGU && WS_GY + (size_t)T * 512 * 2 <= WS_WGU && WS_WD + (size_t)32 * 1024 * 512 * 2 <= WS_END, "d_ws map");
constexpr int CW_BAR = 4096;
constexpr int CW_CNT = 16384;

constexpr int RING_BYTES = 131072;
constexpr int TOKL_OFF = RING_BYTES, SCLL_OFF = TOKL_OFF + MAXU * 256 * 4, MISC_OFF = SCLL_OFF + MAXU * 256 * 4;
constexpr int LDS_BYTES = MISC_OFF + 1024;

#define GAS __attribute__((address_space(1)))
#define LAS __attribute__((address_space(3)))
typedef unsigned short bf16;
typedef unsigned v4u __attribute__((ext_vector_type(4)));
typedef unsigned v2u __attribute__((ext_vector_type(2)));
typedef float f32x4 __attribute__((ext_vector_type(4)));
typedef short bf16x8 __attribute__((ext_vector_type(8)));
#define LDS_WAIT() asm volatile("s_waitcnt lgkmcnt(0)" ::: "memory")
#define VM_WAIT() asm volatile("s_waitcnt vmcnt(0)" ::: "memory")
__device__ __forceinline__ unsigned f2bf(float f) { unsigned u = __builtin_bit_cast(unsigned, f); return (u + 0x7fffu + ((u >> 16) & 1u)) >> 16; }
__device__ __forceinline__ float bf2f(unsigned h) { return __builtin_bit_cast(float, h << 16); }
__device__ __forceinline__ unsigned pk2(float lo, float hi) { return f2bf(lo) | (f2bf(hi) << 16); }
__device__ __forceinline__ float bflo(unsigned w) { return __builtin_bit_cast(float, w << 16); }
__device__ __forceinline__ float bfhi(unsigned w) { return __builtin_bit_cast(float, w & 0xffff0000u); }
__device__ __forceinline__ float fsigmoid(float x) { return __builtin_amdgcn_rcpf(1.0f + __builtin_amdgcn_exp2f(-1.44269504f * x)); }
__device__ __forceinline__ float gelu_t(float x) { const float u = x * (0.7978845608f + 0.0356774081f * x * x); return x * __builtin_amdgcn_rcpf(1.0f + __builtin_amdgcn_exp2f(-2.88539008f * u)); }
__device__ __forceinline__ float wave_sum(float v) {
#pragma unroll
    for (int o = 1; o < 64; o <<= 1) v += __shfl_xor(v, o);
    return v;
}

#define XB_TMO      128
#define XB_XCNT(j)  (256  + 64 * (j))
#define XB_XSUB(j)  (1280 + 64 * (j))
#define XB_XGEN(j)  (2304 + 64 * (j))
#define XB_TOP      3328
#define XB_TOPGEN   3392
#define XCD_BAR_WORDS 3456
#define XB_SPIN_CAP (1u << 18)
__device__ __forceinline__ unsigned xb_ld(unsigned* p)              { return __hip_atomic_load(p, __ATOMIC_RELAXED, __HIP_MEMORY_SCOPE_AGENT); }
__device__ __forceinline__ unsigned xb_add(unsigned* p, unsigned v) { return __hip_atomic_fetch_add(p, v, __ATOMIC_RELAXED, __HIP_MEMORY_SCOPE_AGENT); }
__device__ __forceinline__ unsigned xb_xcc_id() { return (unsigned)__builtin_amdgcn_s_getreg((3 << 11) | 20) & 0xFu; }
#define XB_SPIN(cond, bar) do { unsigned _sp = 0; while (cond) { __builtin_amdgcn_s_sleep(1); \
    if ((++_sp & 255u) == 0u) { if (xb_ld(&(bar)[XB_TMO])) break; if (_sp > XB_SPIN_CAP) { atomicAdd(&(bar)[XB_TMO], 1u); break; } } } } while (0)
struct XcdBarrier { unsigned* bar; unsigned x; volatile LAS unsigned* st; };
__device__ __forceinline__ XcdBarrier xcd_barrier_post(unsigned* bar, volatile LAS unsigned* st) {
    XcdBarrier b; b.bar = bar; b.x = xb_xcc_id(); b.st = st;
    if (threadIdx.x == 0) (void)xb_add(&bar[XB_XCNT(b.x)], 1u);
    return b;
}
__device__ __forceinline__ void xcd_barrier_complete(unsigned* bar, unsigned x, unsigned& nloc, unsigned& nx) {
    const unsigned G = gridDim.x * gridDim.y * gridDim.z;
    unsigned sum, cnt, mine, sp = 0u;
    for (;;) {
        sum = 0u; cnt = 0u; mine = 0u;
#pragma unroll
        for (unsigned j = 0; j < 16; ++j) { const unsigned c = xb_ld(&bar[XB_XCNT(j)]); sum += c; cnt += (c > 0u) ? 1u : 0u; mine = (j == x) ? c : mine; }
        if (sum == G) break;
        __builtin_amdgcn_s_sleep(1);
        if ((++sp & 255u) == 0u) { if (xb_ld(&bar[XB_TMO])) break; if (sp > XB_SPIN_CAP) { atomicAdd(&bar[XB_TMO], 1u); break; } }
    }
    nloc = mine > 0u ? mine : 1u; nx = cnt > 0u ? cnt : 1u;
}
__device__ __forceinline__ void xcd_barrier(const XcdBarrier& b) {
    asm volatile("s_waitcnt vmcnt(0)" ::: "memory");
    __syncthreads();
    if (threadIdx.x == 0) {
        unsigned* bar = b.bar;
        __builtin_amdgcn_s_waitcnt(0);
        unsigned nloc = b.st[0], nx = b.st[1];
        if (nloc == 0u) { xcd_barrier_complete(bar, b.x, nloc, nx); b.st[0] = nloc; b.st[1] = nx; }
        const unsigned old = xb_add(&bar[XB_XSUB(b.x)], 1u);
        const unsigned gen = old / nloc;
        if (old + 1u == (gen + 1u) * nloc) {
            __builtin_amdgcn_fence(__ATOMIC_RELEASE, "agent");
            asm volatile("s_waitcnt vmcnt(0)" ::: "memory");
            const unsigned og = xb_add(&bar[XB_TOP], 1u);
            const unsigned tg = og / nx;
            if (og + 1u == (tg + 1u) * nx) xb_add(&bar[XB_TOPGEN], 1u);
            else XB_SPIN(xb_ld(&bar[XB_TOPGEN]) == tg, bar);
            __builtin_amdgcn_fence(__ATOMIC_ACQUIRE, "agent");
            xb_add(&bar[XB_XGEN(b.x)], 1u);
            asm volatile("s_waitcnt vmcnt(0)" ::: "memory");
        } else {
            XB_SPIN(xb_ld(&bar[XB_XGEN(b.x)]) == gen, bar);
            __builtin_amdgcn_fence(__ATOMIC_ACQUIRE, "agent");
            asm volatile("s_waitcnt vmcnt(0)" ::: "memory");
        }
    }
    __syncthreads();
}

struct Frame {
    LAS unsigned char* lds;
    volatile LAS unsigned* MISC;
    unsigned* ctl;
    int tid, lane, wave, vcu, G;
    const float* const* in;
    unsigned char* ws; float* out;
};

using pg8::Unit;
struct DenseOrder {
    static constexpr bool GATHER = false;
    const char* A0; const char* B0; int lda, ldb, nM, nN, nwg, G, c;
    __device__ __forceinline__ void init(const void* A, const void* B, int lda_, int ldb_, int M, int N, int G_, int c_) { A0 = (const char*)A; B0 = (const char*)B; lda = lda_; ldb = ldb_; nM = M / 256; nN = N / 256; nwg = nM * nN; G = G_; c = c_; }
    __device__ __forceinline__ bool next(int i, Unit& u) const {
        const long L = (long)i * G + c; if (L >= nwg) return false;
        int wgid = (int)L; { const int q = nwg / 8, r = nwg % 8, xcd = wgid % 8, off = wgid / 8; wgid = (xcd < r ? xcd * (q + 1) : r * (q + 1) + (xcd - r) * q) + off; }
        const int nig = 8 * nN, gid = wgid / nig, fm = gid * 8, gsz = (nM - fm) < 8 ? (nM - fm) : 8;
        u.pm = fm + ((wgid % nig) % gsz); u.pn = (wgid % nig) / gsz; u.aux = 0;
        u.A = A0 + (size_t)u.pm * 256 * lda * 2; u.B = B0 + (size_t)u.pn * 256 * ldb * 2; return true;
    }
    __device__ __forceinline__ void a_offsets(const Unit&, const int (&R)[2], const int (&C)[2], unsigned (&v)[4]) const {
#pragma unroll
        for (int i = 0; i < 2; ++i) { v[i] = (unsigned)(R[i] * lda + C[i]) * 2u; v[2 + i] = (unsigned)((128 + R[i]) * lda + C[i]) * 2u; }
    }
};
struct S5One {
    static constexpr bool GATHER = false;
    const char* A0; const char* B0; size_t sA, sB; int lda, g, mt;
    __device__ __forceinline__ bool next(int i, Unit& u) const {
        if (i > 0) return false;
        u.pm = mt; u.pn = 0; u.aux = g; u.A = A0 + (size_t)g * sA + (size_t)mt * 256 * lda * 2; u.B = B0 + (size_t)g * sB; return true;
    }
    __device__ __forceinline__ void a_offsets(const Unit&, const int (&R)[2], const int (&C)[2], unsigned (&v)[4]) const {
#pragma unroll
        for (int i = 0; i < 2; ++i) { v[i] = (unsigned)(R[i] * lda + C[i]) * 2u; v[2 + i] = (unsigned)((128 + R[i]) * lda + C[i]) * 2u; }
    }
};
struct GyOrder {
    static constexpr bool GATHER = false;
    DenseOrder d;
    __device__ __forceinline__ bool next(int i, Unit& u) const { if (!d.next(i, u)) return false; u.A = d.A0 + (size_t)u.pm * 256 * 32; return true; }
    __device__ __forceinline__ void a_offsets(const Unit&, const int (&R)[2], const int (&C)[2], unsigned (&v)[4]) const {
#pragma unroll
        for (int i = 0; i < 2; ++i) { const unsigned o = (unsigned)(C[i] >> 4) * (unsigned)(T * 32) + (unsigned)(C[i] & 15) * 2u; v[i] = (unsigned)R[i] * 32u + o; v[2 + i] = (unsigned)(128 + R[i]) * 32u + o; }
    }
};
template <bool GATH> struct MoeOrder {
    static constexpr bool GATHER = GATH;
    const char* A0; const char* B0; size_t sBe; int lda, ldb, G, c; volatile LAS unsigned* MISC; const LAS int* tokL;
    __device__ __forceinline__ bool next(int i, Unit& u) const {
        if (i >= (int)MISC[152]) return false;
        const int e = (int)MISC[136 + i], mtg = (int)MISC[96 + e] + (int)MISC[144 + i], L = i * G + c;
        u.pm = mtg; u.pn = L & 3; u.aux = i;
        u.A = GATH ? A0 : A0 + (size_t)mtg * 256 * lda * 2; u.B = B0 + (size_t)e * sBe + (size_t)u.pn * 256 * ldb * 2; return true;
    }
    __device__ __forceinline__ void a_offsets(const Unit& u, const int (&R)[2], const int (&C)[2], unsigned (&v)[4]) const {
#pragma unroll
        for (int i = 0; i < 2; ++i) {
            if constexpr (GATH) { v[i] = (unsigned)tokL[u.aux * 256 + R[i]] * (unsigned)(lda * 2) + (unsigned)C[i] * 2u; v[2 + i] = (unsigned)tokL[u.aux * 256 + 128 + R[i]] * (unsigned)(lda * 2) + (unsigned)C[i] * 2u; }
            else { v[i] = (unsigned)(R[i] * lda + C[i]) * 2u; v[2 + i] = (unsigned)((128 + R[i]) * lda + C[i]) * 2u; } }
    }
};

using pg8::cvt_pk_bf16;
template <int ACT> __device__ __forceinline__ float actf(float x) { if (ACT == 1) return gelu_t(x); if (ACT == 2) return fsigmoid(x); return x; }
__device__ __forceinline__ v4u pack8(const f32x4 a, const f32x4 b) { v4u w; w.x = cvt_pk_bf16(a[0], a[1]); w.y = cvt_pk_bf16(a[2], a[3]); w.z = cvt_pk_bf16(b[0], b[1]); w.w = cvt_pk_bf16(b[2], b[3]); return w; }

__device__ __forceinline__ void unpack_u8x8(const v2u w, float (&f)[8]) {
    const float k = 1.0f / 255.0f;
    f[0] = (float)(w.x & 0xffu) * k; f[1] = (float)((w.x >> 8) & 0xffu) * k; f[2] = (float)((w.x >> 16) & 0xffu) * k; f[3] = (float)(w.x >> 24) * k;
    f[4] = (float)(w.y & 0xffu) * k; f[5] = (float)((w.y >> 8) & 0xffu) * k; f[6] = (float)((w.y >> 16) & 0xffu) * k; f[7] = (float)(w.y >> 24) * k;
}
struct EpiInProj {
    static constexpr bool PERM = true, ACC_INIT = false;
    bf16 *AG, *XL, *GL, *GA, *GB;
    template <int MODE  > __device__ __forceinline__ void tile(const f32x4 (&acc)[2][2][4][2], const Unit& u, bf16* base, int colbase, bool s5, int wr, int wc, int fr, int fq) const {
#pragma unroll
        for (int ai = 0; ai < 2; ++ai)
#pragma unroll
            for (int m = 0; m < 4; ++m) { const int r = u.pm * 256 + ai * 128 + wr * 64 + m * 16 + fr;
#pragma unroll
                for (int bj = 0; bj < 2; ++bj) { const int cl = colbase + bj * 128 + wc * 32 + 8 * fq;
                    f32x4 v0 = acc[ai][bj][m][0], v1 = acc[ai][bj][m][1];
                    if (MODE == 2) {
                        unsigned q[8];
#pragma unroll
                        for (int j = 0; j < 4; ++j) { q[j] = (unsigned)(fsigmoid(v0[j]) * 255.0f + 0.5f); q[4 + j] = (unsigned)(fsigmoid(v1[j]) * 255.0f + 0.5f); }
                        v2u w8; w8.x = q[0] | (q[1] << 8) | (q[2] << 16) | (q[3] << 24); w8.y = q[4] | (q[5] << 8) | (q[6] << 16) | (q[7] << 24);
                        __builtin_nontemporal_store(w8, (v2u*)((unsigned char*)base + (size_t)r * 1024 + cl));
                    } else {
                        if (MODE == 1) {
#pragma unroll
                            for (int j = 0; j < 4; ++j) { v0[j] = gelu_t(v0[j]); v1[j] = gelu_t(v1[j]); } }
                        const v4u w = pack8(v0, v1);
                        const int g = cl >> 4, cp = cl & 15, b = r >> 12, l = r & 4095, n = b * S5NCH + (l >> 4), s = l & 15;
                        const size_t off = s5 ? ((size_t)(g * S5N + n) * S5K + S5Q + s * 16 + cp) : ((size_t)r * 1024 + cl);
                        __builtin_nontemporal_store(w, (v4u*)(base + off)); } }
                asm volatile("" ::: "memory"); }
    }
    __device__ __forceinline__ void operator()(const f32x4 (&acc)[2][2][4][2], const Unit& u, int wr, int wc, int fr, int fq) const {
        const int pn = u.pn, reg = pn < 2 ? 0 : ((pn - 2) >> 2) + 1;
        const int colbase = reg == 0 ? pn * 256 : ((pn - 2) & 3) * 256;
        if (reg < 2) tile<0>(acc, u, reg == 0 ? AG : XL, colbase, reg == 0, wr, wc, fr, fq);
        else if (reg == 2) tile<1>(acc, u, GL, colbase, false, wr, wc, fr, fq);
        else tile<2>(acc, u, reg == 3 ? GA : GB, colbase, false, wr, wc, fr, fq);
    }
};
struct EpiS5State {
    static constexpr bool PERM = false, ACC_INIT = false;
    float* SLOC;
    __device__ __forceinline__ void operator()(const f32x4 (&acc)[2][2][4][2], const Unit& u, int wr, int wc, int fr, int fq) const {
#pragma unroll
        for (int ai = 0; ai < 2; ++ai)
#pragma unroll
            for (int m = 0; m < 4; ++m) { const int nr = u.pm * 256 + ai * 128 + wr * 64 + m * 16 + fr; float* rowp = SLOC + (size_t)(u.aux * S5N + nr) * S5Q + wc * 32 + 4 * fq;
#pragma unroll
                for (int n = 0; n < 2; ++n) *(f32x4*)(rowp + n * 16) = acc[ai][0][m][n]; }
    }
};
struct EpiS5Out {
    static constexpr bool PERM = true, ACC_INIT = false;
    bf16* GY;
    __device__ __forceinline__ void operator()(const f32x4 (&acc)[2][2][4][2], const Unit& u, int wr, int wc, int fr, int fq) const {
#pragma unroll
        for (int ai = 0; ai < 2; ++ai)
#pragma unroll
            for (int m = 0; m < 4; ++m) { const int nr = u.pm * 256 + ai * 128 + wr * 64 + m * 16 + fr, b = nr >> 8, j16 = nr & 255;
#pragma unroll
                for (int bj = 0; bj < 2; ++bj) { const int cc = bj * 128 + wc * 32 + 8 * fq, t = cc >> 4, c0 = cc & 15;
                    f32x4 v0 = acc[ai][bj][m][0], v1 = acc[ai][bj][m][1];
#pragma unroll
                    for (int j = 0; j < 4; ++j) { v0[j] = gelu_t(v0[j]); v1[j] = gelu_t(v1[j]); }
                    *(v4u*)(GY + ((size_t)u.aux * T + (size_t)(b * SEQ + j16 * 16 + t)) * 16 + c0) = pack8(v0, v1); }
                asm volatile("" ::: "memory"); }
    }
};
struct EpiYa {
    static constexpr bool PERM = true, ACC_INIT = false;
    const bf16* GA; bf16* YA;
    __device__ __forceinline__ void operator()(const f32x4 (&acc)[2][2][4][2], const Unit& u, int wr, int wc, int fr, int fq) const {
        const size_t off0 = (size_t)(u.pm * 256 + wr * 64 + fr) * 1024 + u.pn * 128 + wc * 32 + 8 * fq;
        v2u gav[2][4];
#pragma unroll
        for (int ai = 0; ai < 2; ++ai)
#pragma unroll
            for (int m = 0; m < 4; ++m) gav[ai][m] = __builtin_nontemporal_load((const v2u*)((const unsigned char*)GA + off0 + (size_t)(ai * 128 + m * 16) * 1024));
        asm volatile("" ::: "memory");
#pragma unroll
        for (int ai = 0; ai < 2; ++ai)
#pragma unroll
            for (int m = 0; m < 4; ++m) { float gaf[8]; unpack_u8x8(gav[ai][m], gaf);
                f32x4 o0, o1;
#pragma unroll
                for (int j = 0; j < 4; ++j) { o0[j] = gaf[j] * acc[ai][0][m][0][j] * fsigmoid(acc[ai][1][m][0][j]); o1[j] = gaf[4 + j] * acc[ai][0][m][1][j] * fsigmoid(acc[ai][1][m][1][j]); }
                *(v4u*)(YA + off0 + (size_t)(ai * 128 + m * 16) * 1024) = pack8(o0, o1); }
    }
};
struct EpiYb {
    static constexpr bool PERM = true, ACC_INIT = false;
    const bf16* YA; const bf16* GB; bf16* MIX;
    __device__ __forceinline__ void operator()(const f32x4 (&acc)[2][2][4][2], const Unit& u, int wr, int wc, int fr, int fq) const {
        const size_t off0 = (size_t)(u.pm * 256 + wr * 64 + fr) * 1024 + u.pn * 256 + wc * 32 + 8 * fq;
        v4u ya[2][2][2]; v2u gb[2][2][2];
#define YB_LOAD(buf, grp) do { _Pragma("unroll") for (int mm = 0; mm < 2; ++mm) _Pragma("unroll") for (int bj = 0; bj < 2; ++bj) { \
            const size_t o = off0 + (size_t)(((grp) >> 1) * 128 + (2 * ((grp) & 1) + mm) * 16) * 1024 + bj * 128; ya[buf][mm][bj] = __builtin_nontemporal_load((const v4u*)(YA + o)); gb[buf][mm][bj] = __builtin_nontemporal_load((const v2u*)((const unsigned char*)GB + o)); } } while (0)
        YB_LOAD(0, 0);
#pragma unroll
        for (int grp = 0; grp < 4; ++grp) { const int buf = grp & 1, ai = grp >> 1;
            if (grp < 3) YB_LOAD(buf ^ 1, grp + 1);
            asm volatile("" ::: "memory");
#pragma unroll
            for (int mm = 0; mm < 2; ++mm) { const int m = 2 * (grp & 1) + mm;
#pragma unroll
                for (int bj = 0; bj < 2; ++bj) { const v4u y = ya[buf][mm][bj];
                    const float yaf[8] = {bflo(y.x), bfhi(y.x), bflo(y.y), bfhi(y.y), bflo(y.z), bfhi(y.z), bflo(y.w), bfhi(y.w)};
                    float gbf[8]; unpack_u8x8(gb[buf][mm][bj], gbf);
                    f32x4 o0, o1;
#pragma unroll
                    for (int j = 0; j < 4; ++j) { o0[j] = yaf[j] + gbf[j] * acc[ai][bj][m][0][j]; o1[j] = yaf[4 + j] + gbf[4 + j] * acc[ai][bj][m][1][j]; }
                    *(v4u*)(MIX + off0 + (size_t)(ai * 128 + m * 16) * 1024 + bj * 128) = pack8(o0, o1); } }
        }
#undef YB_LOAD
    }
};
struct EpiWo {
    static constexpr bool PERM = false, ACC_INIT = true;
    const float* X; float* O;
    __device__ __forceinline__ void init(f32x4 (&acc)[2][2][4][2], const Unit& u, int wr, int wc, int fr, int fq) const {
        const size_t off0 = (size_t)(u.pm * 256 + wr * 64 + fr) * 1024 + u.pn * 256 + wc * 32 + 4 * fq;
#pragma unroll
        for (int ai = 0; ai < 2; ++ai)
#pragma unroll
            for (int m = 0; m < 4; ++m)
#pragma unroll
                for (int bj = 0; bj < 2; ++bj)
#pragma unroll
                    for (int n = 0; n < 2; ++n) acc[ai][bj][m][n] = __builtin_nontemporal_load((const f32x4*)(X + off0 + (size_t)(ai * 128 + m * 16) * 1024 + bj * 128 + n * 16));
    }
    __device__ __forceinline__ void operator()(const f32x4 (&acc)[2][2][4][2], const Unit& u, int wr, int wc, int fr, int fq) const {
        const size_t off0 = (size_t)(u.pm * 256 + wr * 64 + fr) * 1024 + u.pn * 256 + wc * 32 + 4 * fq;
#pragma unroll
        for (int ai = 0; ai < 2; ++ai)
#pragma unroll
            for (int m = 0; m < 4; ++m)
#pragma unroll
                for (int bj = 0; bj < 2; ++bj)
#pragma unroll
                    for (int n = 0; n < 2; ++n) *(f32x4*)(O + off0 + (size_t)(ai * 128 + m * 16) * 1024 + bj * 128 + n * 16) = acc[ai][bj][m][n];
    }
};
struct EpiGU {
    static constexpr bool PERM = true, ACC_INIT = false;
    bf16* ACT; const LAS float* sclL;
    __device__ __forceinline__ void operator()(const f32x4 (&acc)[2][2][4][2], const Unit& u, int wr, int wc, int fr, int fq) const {
#pragma unroll
        for (int ai = 0; ai < 2; ++ai)
#pragma unroll
            for (int m = 0; m < 4; ++m) { const int rl = ai * 128 + wr * 64 + m * 16 + fr; const float sc = sclL[u.aux * 256 + rl];
                f32x4 o0, o1;
#pragma unroll
                for (int j = 0; j < 4; ++j) { const float g0 = acc[ai][0][m][0][j] * sc, g1 = acc[ai][0][m][1][j] * sc;
                    o0[j] = g0 * fsigmoid(g0) * (acc[ai][1][m][0][j] * sc); o1[j] = g1 * fsigmoid(g1) * (acc[ai][1][m][1][j] * sc); }
                *(v4u*)(ACT + (size_t)(u.pm * 256 + rl) * DEXP + u.pn * 128 + wc * 32 + 8 * fq) = pack8(o0, o1); }
    }
};
struct EpiDown {
    static constexpr bool PERM = true, ACC_INIT = false;
    bf16* YS; const LAS float* sclL;
    __device__ __forceinline__ void operator()(const f32x4 (&acc)[2][2][4][2], const Unit& u, int wr, int wc, int fr, int fq) const {
#pragma unroll
        for (int ai = 0; ai < 2; ++ai)
#pragma unroll
            for (int m = 0; m < 4; ++m) { const int rl = ai * 128 + wr * 64 + m * 16 + fr; const float sc = sclL[u.aux * 256 + rl];
#pragma unroll
                for (int bj = 0; bj < 2; ++bj)
                    *(v4u*)(YS + (size_t)(u.pm * 256 + rl) * 1024 + u.pn * 256 + bj * 128 + wc * 32 + 8 * fq) = pack8(acc[ai][bj][m][0] * sc, acc[ai][bj][m][1] * sc); }
    }
};

struct TItem { const float* W; int N; bf16* WT; int ldk, k0, n0, drow0; };
__device__ __forceinline__ void transpose_load(const TItem& it, f32x4 (&tv)[8], int lane) {
#pragma unroll
    for (int i = 0; i < 8; ++i) tv[i] = __builtin_nontemporal_load((const f32x4*)(it.W + (size_t)(it.k0 + 8 * i + (lane >> 3)) * it.N + it.n0 + 4 * (lane & 7)));
}
__device__ __forceinline__ void transpose_store(const TItem& it, const f32x4 (&tv)[8], LAS float* scr, int lane) {
#pragma unroll
    for (int i = 0; i < 8; ++i) { LAS float* d = scr + (8 * i + (lane >> 3)) * 33 + 4 * (lane & 7); d[0] = tv[i].x; d[1] = tv[i].y; d[2] = tv[i].z; d[3] = tv[i].w; }
    LDS_WAIT(); asm volatile("" ::: "memory");
    const int c = lane & 7;
#pragma unroll
    for (int j = 0; j < 4; ++j) { const int n = (lane >> 3) + 8 * j; const LAS float* s = scr + (8 * c) * 33 + n;
        v4u o; o.x = pk2(s[0 * 33], s[1 * 33]); o.y = pk2(s[2 * 33], s[3 * 33]); o.z = pk2(s[4 * 33], s[5 * 33]); o.w = pk2(s[6 * 33], s[7 * 33]);
        *(v4u*)(it.WT + (size_t)(it.drow0 + n) * it.ldk + it.k0 + 8 * c) = o; }
    LDS_WAIT(); asm volatile("" ::: "memory");
}
__device__ __forceinline__ int ileave_row(int n, int half) { return 256 * (n >> 7) + 128 * half + (n & 127); }

template <int NR> __device__ __forceinline__ void rms_rows_to_bf16(const float* x0, const float* gain, bf16* o0, size_t rstride, int lane) {
    f32x4 v[NR][4];
#pragma unroll
    for (int r = 0; r < NR; ++r) { const f32x4* xr = (const f32x4*)(x0 + r * rstride) + lane;
#pragma unroll
        for (int j = 0; j < 4; ++j) v[r][j] = __builtin_nontemporal_load(xr + 64 * j); }
    asm volatile("" ::: "memory");
    const f32x4* gr = (const f32x4*)gain + lane;
    f32x4 g[4];
#pragma unroll
    for (int j = 0; j < 4; ++j) g[j] = gr[64 * j];
#pragma unroll
    for (int r = 0; r < NR; ++r) { float s = 0.f;
#pragma unroll
        for (int j = 0; j < 4; ++j) s += (v[r][j].x * v[r][j].x + v[r][j].y * v[r][j].y) + (v[r][j].z * v[r][j].z + v[r][j].w * v[r][j].w);
        const float rstd = 1.0f / sqrtf(wave_sum(s) * (1.f / D) + RMS_EPS);
        unsigned long long* o8 = (unsigned long long*)(o0 + r * rstride) + lane;
#pragma unroll
        for (int j = 0; j < 4; ++j) o8[64 * j] = (unsigned long long)pk2(v[r][j].x * rstd * g[j].x, v[r][j].y * rstd * g[j].y) | ((unsigned long long)pk2(v[r][j].z * rstd * g[j].z, v[r][j].w * rstd * g[j].w) << 32); }
}

__device__ __forceinline__ void s5_tables(const Frame& F, int g, const float* lam_re, const float* lam_im, const float* log_dt, const float* b_re, const float* b_im, const float* c_re, const float* c_im, const float* dsk) {
    LAS float* Cre = (LAS float*)F.lds;
    LAS float* Cim = Cre + 1024;
    LAS float* Bre = Cim + 1024;
    LAS float* Bim = Bre + 1024;
    LAS float* Pre = Bim + 1024;
    LAS float* Pim = Pre + 17 * 64;
    LAS float* Kt = Pim + 17 * 64;
    const int tid = F.tid;
    for (int i = tid; i < 1024; i += 512) { Cre[i] = c_re[g * 1024 + i]; Cim[i] = c_im[g * 1024 + i]; }
    if (tid < 64) {
        const int p = tid; const float lr = lam_re[g * 64 + p], li = lam_im[g * 64 + p], dt = expf(log_dt[g]);
        const float er = expf(lr * dt), lbr = er * cosf(li * dt), lbi = er * sinf(li * dt);
        const float den = lr * lr + li * li, nr = lbr - 1.0f, ni = lbi;
        const float cr = (nr * lr + ni * li) / den, ci = (ni * lr - nr * li) / den;
        { float pr = 1.f, pi = 0.f; for (int k = 0; k <= 16; ++k) { Pre[k * 64 + p] = pr; Pim[k * 64 + p] = pi; const float nr2 = pr * lbr - pi * lbi, ni2 = pr * lbi + pi * lbr; pr = nr2; pi = ni2; } }
        for (int c = 0; c < 16; ++c) { const float br = b_re[(g * 64 + p) * 16 + c], bi = b_im[(g * 64 + p) * 16 + c]; Bre[p * 16 + c] = cr * br - ci * bi; Bim[p * 16 + c] = cr * bi + ci * br; }
    }
    __syncthreads();
    for (int e = tid; e < 4096; e += 512) {
        const int k = e >> 8, c = (e >> 4) & 15, cp = e & 15; float s = 0.f;
        for (int p = 0; p < 64; ++p) { const float xr = Cre[c * 64 + p] * Pre[k * 64 + p] - Cim[c * 64 + p] * Pim[k * 64 + p], xi = Cre[c * 64 + p] * Pim[k * 64 + p] + Cim[c * 64 + p] * Pre[k * 64 + p];
            s += xr * Bre[p * 16 + cp] - xi * Bim[p * 16 + cp]; }
        if (k == 0 && c == cp) s += dsk[g * 16 + c];
        Kt[e] = s;
    }
    __syncthreads();
    unsigned* btt = (unsigned*)(F.ws + WS_BTT) + (size_t)g * 256 * (S5K / 2);
    for (int e = tid; e < 256 * (S5K / 2); e += 512) {
        const int row = e / (S5K / 2), cpair = e % (S5K / 2), t = row >> 4, c = row & 15, col = 2 * cpair; float v0, v1;
        if (col < S5Q) { const int p = col >> 1; const float xr = Cre[c * 64 + p] * Pre[(t + 1) * 64 + p] - Cim[c * 64 + p] * Pim[(t + 1) * 64 + p], xi = Cre[c * 64 + p] * Pim[(t + 1) * 64 + p] + Cim[c * 64 + p] * Pre[(t + 1) * 64 + p];
            v0 = xr; v1 = -xi; }
        else { const int s = (col - S5Q) >> 4, cp = (col - S5Q) & 15;
            if (s <= t) { v0 = Kt[(t - s) * 256 + c * 16 + cp]; v1 = Kt[(t - s) * 256 + c * 16 + cp + 1]; } else { v0 = 0.f; v1 = 0.f; } }
        btt[e] = pk2(v0, v1);
    }
    unsigned* btw = (unsigned*)(F.ws + WS_BTW) + (size_t)g * 128 * 128;
    for (int e = tid; e < 128 * 128; e += 512) {
        const int q = e >> 7, cpair = e & 127, col = 2 * cpair, s = col >> 4, cp = col & 15, p = q >> 1, k = 15 - s;
        const float pr = Pre[k * 64 + p], pi = Pim[k * 64 + p];
        float v0, v1;
        if (q & 1) { v0 = pr * Bim[p * 16 + cp] + pi * Bre[p * 16 + cp]; v1 = pr * Bim[p * 16 + cp + 1] + pi * Bre[p * 16 + cp + 1]; }
        else { v0 = pr * Bre[p * 16 + cp] - pi * Bim[p * 16 + cp]; v1 = pr * Bre[p * 16 + cp + 1] - pi * Bim[p * 16 + cp + 1]; }
        btw[e] = pk2(v0, v1);
    }
    if (tid < 64) { float* l16 = (float*)(F.ws + SM_LAM16) + (g * 64 + tid) * 2; l16[0] = Pre[16 * 64 + tid]; l16[1] = Pim[16 * 64 + tid]; }
    __syncthreads();
}

struct In { const float* p[30]; };

__device__ __forceinline__ void p0_prologue(const Frame& F, const In& I) {
    for (int g = F.vcu; g < S5G; g += F.G) s5_tables(F, g, I.p[3], I.p[4], I.p[5], I.p[6], I.p[7], I.p[8], I.p[9], I.p[10]);
    const int gt = F.vcu * 512 + F.tid, NGT = F.G * 512;
    { float* lc = (float*)(F.ws + SM_LRUC); for (int i = gt; i < LRUW; i += NGT) { const float lam = I.p[18][i]; lc[i] = -8.0f * log1pf(expf(-lam)) * 1.44269504f; } }
    { bf16* wrt = (bf16*)(F.ws + SM_WRT);
        for (int i = gt; i < 2 * 65536; i += NGT) { const int which = i >> 16, r = i & 65535, h = r >> 12, j = (r >> 6) & 63, k = r & 63; const float* src = which ? I.p[16] : I.p[14]; wrt[i] = (bf16)f2bf(src[(h * 64 + k) * 64 + j]); } }
    { bf16* rhi = (bf16*)(F.ws + SM_RHI); bf16* rlo = (bf16*)(F.ws + SM_RLO);
        for (int i = gt; i < NROUT * 1024; i += NGT) { const int n = i >> 10, k = i & 1023; float w = 0.f; if (n < 4) w = I.p[22][k * 4 + n]; else if (n < 36) w = I.p[24][k * 32 + (n - 4)];
            const unsigned h = f2bf(w); rhi[i] = (bf16)h; rlo[i] = (bf16)f2bf(w - bf2f(h)); } }
    LAS float* scr = (LAS float*)(F.lds + F.wave * 16384);
    const int gw = F.vcu * NWAVES + F.wave, NGW = F.G * NWAVES;
    constexpr int I_IN = (D / 64) * (NIN / 32), I_S5 = (S5W / 64) * (2 * D / 32), I_LRU = (D / 64) * (D / 32), I_O = I_LRU;
    constexpr int NITEMS = I_IN + I_S5 + I_LRU + I_O;
    for (int it = gw; it < NITEMS; it += NGW) {
        int r = it; TItem ti;
        if (r < I_IN) { const int nb = NIN / 32, kb = r / nb, n0 = 32 * (r % nb); ti = TItem{I.p[2], NIN, (bf16*)(F.ws + WS_WIN), D, 64 * kb, n0, n0}; }
        else if ((r -= I_IN) < I_S5) { const int nb = 2 * D / 32, kb = r / nb, n0 = 32 * (r % nb); ti = TItem{I.p[11], 2 * D, (bf16*)(F.ws + WS_WS5), S5W, 64 * kb, n0, n0 < D ? ileave_row(n0, 0) : ileave_row(n0 - D, 1)}; }
        else if ((r -= I_S5) < I_LRU) { const int nb = D / 32, kb = r / nb, n0 = 32 * (r % nb); ti = TItem{I.p[19], D, (bf16*)(F.ws + WS_WLRU), D, 64 * kb, n0, n0}; }
        else { r -= I_LRU; const int nb = D / 32, kb = r / nb, n0 = 32 * (r % nb); ti = TItem{I.p[20], D, (bf16*)(F.ws + WS_WO), D, 64 * kb, n0, n0}; }
        f32x4 tv[8]; transpose_load(ti, tv, F.lane); asm volatile("" ::: "memory"); transpose_store(ti, tv, scr, F.lane);
    }
    { const int skip = F.G > 2 * S5G ? S5G : 0;
      if (F.vcu >= skip) { const int gw2 = (F.vcu - skip) * NWAVES + F.wave, NGW2 = (F.G - skip) * NWAVES;
        for (int m = gw2 * 4; m < T; m += NGW2 * 4) rms_rows_to_bf16<4>(I.p[0] + (size_t)m * D, I.p[1], (bf16*)(F.ws + WS_H) + (size_t)m * D, D, F.lane); } }
}
__device__ __forceinline__ TItem expert_item(const Frame& F, const In& I, int it) {
    constexpr int I_G = (D / 64) * (DEXP / 32), I_D = (DEXP / 64) * (D / 32);
    const int e = it / (2 * I_G + I_D); int r = it % (2 * I_G + I_D);
    if (r < 2 * I_G) { const int half = r / I_G; r %= I_G; const int nb = DEXP / 32, kb = r / nb, n0 = 32 * (r % nb);
        return TItem{(half ? I.p[27] : I.p[26]) + (size_t)e * D * DEXP, DEXP, (bf16*)(F.ws + WS_WGU) + (size_t)e * 1024 * 1024, D, 64 * kb, n0, ileave_row(n0, half)}; }
    r -= 2 * I_G; const int nb = D / 32, kb = r / nb, n0 = 32 * (r % nb);
    return TItem{I.p[28] + (size_t)e * DEXP * D, D, (bf16*)(F.ws + WS_WD) + (size_t)e * 1024 * DEXP, DEXP, 64 * kb, n0, n0};
}
__device__ __forceinline__ void expert_weight_copies(const Frame& F, const In& I) {
    LAS float* scr = (LAS float*)(F.lds + F.wave * 16384);
    const int gw = F.vcu * NWAVES + F.wave, NGW = F.G * NWAVES;
    constexpr int NIT = NEXP * 768;
    const int first = 8 * NGW < NIT ? 8 * NGW : NIT;
    for (int it = first + gw; it < NIT; it += 2 * NGW) {
        const TItem t0 = expert_item(F, I, it); const bool has1 = it + NGW < NIT; const TItem t1 = expert_item(F, I, has1 ? it + NGW : it);
        f32x4 v0[8], v1[8]; transpose_load(t0, v0, F.lane); transpose_load(t1, v1, F.lane); asm volatile("" ::: "memory");
        transpose_store(t0, v0, scr, F.lane); if (has1) transpose_store(t1, v1, scr, F.lane);
    }
}

__device__ __forceinline__ void lru_seq(const Frame& F, const In& I) {
    LAS unsigned char* wl = F.lds + F.wave * 17920;
    LAS bf16* xcA = (LAS bf16*)wl;
    LAS float* pre = (LAS float*)(wl + 9216);
    typedef float f32x2 __attribute__((ext_vector_type(2)));
    LAS f32x2* sumT = (LAS f32x2*)(F.lds + 143360);
    const int lane = F.lane, jj = lane & 15, ks = lane >> 4, c32 = lane & 31, th = lane >> 5;
    const bf16* XL = (const bf16*)(F.ws + WS_XL); const bf16* GL = (const bf16*)(F.ws + WS_GL); bf16* YL = (bf16*)(F.ws + WS_H);
    const bf16* WRT = (const bf16*)(F.ws + SM_WRT);
    for (int un = F.vcu; un < BATCH * LRUH * 2; un += F.G) {
        const int b = un >> 5, hd = (un >> 1) & 15, half = un & 1;
        const int chin = hd * 64 + lane;
        const int chg = hd * 64 + 32 * half + c32;
        const float w0 = I.p[12][chin], w1 = I.p[12][1024 + chin], w2 = I.p[12][2048 + chin], w3 = I.p[12][3072 + chin], cb = I.p[13][chin];
        const float brs = I.p[15][chg] * -1.44269504f, bis = I.p[17][chg] * -1.44269504f, cch2 = ((const float*)(F.ws + SM_LRUC))[chg];
        bf16x8 Bw[4][2];
#pragma unroll
        for (int n = 0; n < 4; ++n)
#pragma unroll
            for (int k = 0; k < 2; ++k) Bw[n][k] = *(const bf16x8*)(WRT + (size_t)(n >> 1) * 65536 + (size_t)(hd * 64 + 32 * half + 16 * (n & 1) + jj) * 64 + 32 * k + 8 * ks);
        float Rc = 0.f;
        for (int rd = 0; rd < 8; ++rd) {
            const int j = rd * 8 + F.wave;
            const size_t tok0 = (size_t)b * SEQ + (size_t)j * LRUCH;
            unsigned short xr[64], xh[3];
            { const bf16* xp = XL + tok0 * 1024 + chin;
              xh[0] = 0; xh[1] = 0; xh[2] = 0;
              if (j > 0) { xh[0] = xp[-3 * 1024]; xh[1] = xp[-2 * 1024]; xh[2] = xp[-1 * 1024]; }
#pragma unroll
              for (int t = 0; t < 64; ++t) xr[t] = xp[t * 1024]; }
            asm volatile("" ::: "memory");
            { typedef float f2v __attribute__((ext_vector_type(2)));
              float xm3 = bf2f(xh[0]), xm2 = bf2f(xh[1]), xm1 = bf2f(xh[2]);
              const f2v vw0 = {w0, w0}, vw1 = {w1, w1}, vw2 = {w2, w2}, vw3 = {w3, w3}, vcb = {cb, cb};
#pragma unroll
              for (int t = 0; t < 64; t += 2) { const float x0 = bf2f(xr[t]), x1 = bf2f(xr[t + 1]);
                  f2v xc = vcb + vw0 * (f2v){xm3, xm2}; xc = xc + vw1 * (f2v){xm2, xm1}; xc = xc + vw2 * (f2v){xm1, x0}; xc = xc + vw3 * (f2v){x0, x1};
                  const unsigned pk = pg8::cvt_pk_bf16(xc.x, xc.y);
                  xcA[t * 72 + lane] = (bf16)(pk & 0xffffu); xcA[(t + 1) * 72 + lane] = (bf16)(pk >> 16);
                  xm3 = xm1; xm2 = x0; xm1 = x1; } }
            LDS_WAIT();
            float hl[2][16], Pl[2][16], Prun[2], Hrun[2];
#pragma unroll
            for (int st = 0; st < 2; ++st) {
#pragma unroll
                for (int mh = 0; mh < 2; ++mh) { const int mt = 2 * st + mh;
                    bf16x8 a[2];
#pragma unroll
                    for (int k = 0; k < 2; ++k) a[k] = *(const LAS bf16x8*)(xcA + (16 * mt + jj) * 72 + 32 * k + 8 * ks);
#pragma unroll
                    for (int n = 0; n < 4; ++n) { f32x4 d = (f32x4){0.f, 0.f, 0.f, 0.f};
#pragma unroll
                        for (int k = 0; k < 2; ++k) d = __builtin_amdgcn_mfma_f32_16x16x32_bf16(a[k], Bw[n][k], d, 0, 0, 0);
#pragma unroll
                        for (int r = 0; r < 4; ++r) pre[(16 * mh + 4 * ks + r) * 68 + 16 * n + jj] = d[r]; } }
                LDS_WAIT();
                float h = 0.f, P = 1.f;
                typedef float f2v __attribute__((ext_vector_type(2)));
#pragma unroll
                for (int tl = 0; tl < 16; tl += 2) {
                    const int trow = 16 * th + tl;
                    const f2v pr = {pre[trow * 68 + c32], pre[(trow + 1) * 68 + c32]}, pi = {pre[trow * 68 + 32 + c32], pre[(trow + 1) * 68 + 32 + c32]};
                    const f2v zr = pr * (f2v){-1.44269504f, -1.44269504f} + (f2v){brs, brs}, zi = pi * (f2v){-1.44269504f, -1.44269504f} + (f2v){bis, bis};
                    const f2v er = {__builtin_amdgcn_exp2f(zr.x), __builtin_amdgcn_exp2f(zr.y)}, ei = {__builtin_amdgcn_exp2f(zi.x), __builtin_amdgcn_exp2f(zi.y)};
                    const f2v dr = er + (f2v){1.f, 1.f};
                    const f2v rg = {__builtin_amdgcn_rcpf(dr.x), __builtin_amdgcn_rcpf(dr.y)};
                    const f2v la2 = rg * (f2v){cch2, cch2};
                    const f2v a_ = {__builtin_amdgcn_exp2f(la2.x), __builtin_amdgcn_exp2f(la2.y)};
                    const f2v x2 = la2 * (f2v){1.38629436f, 1.38629436f};
                    f2v q = x2 * (f2v){0.0013888889f, 0.0013888889f} + (f2v){0.0083333333f, 0.0083333333f};
                    q = q * x2 + (f2v){0.041666667f, 0.041666667f}; q = q * x2 + (f2v){0.16666667f, 0.16666667f}; q = q * x2 + (f2v){0.5f, 0.5f}; q = q * x2 + (f2v){1.f, 1.f};
                    f2v om = -(q * x2);
                    const f2v alt = (f2v){1.f, 1.f} - a_ * a_;
                    om.x = x2.x > -0.3f ? om.x : alt.x; om.y = x2.y > -0.3f ? om.y : alt.y;
                    om.x = fmaxf(om.x, 1e-30f); om.y = fmaxf(om.y, 1e-30f);
                    const f2v dd = ei + (f2v){1.f, 1.f};
                    const f2v rq = om * dd * dd;
                    const f2v mi = om * (f2v){__builtin_amdgcn_rsqf(rq.x), __builtin_amdgcn_rsqf(rq.y)};
                    const f2v bx = mi * (f2v){bf2f(xcA[(32 * st + trow) * 72 + 32 * half + c32]), bf2f(xcA[(32 * st + trow + 1) * 72 + 32 * half + c32])};
                    h = a_.x * h + bx.x; P *= a_.x; hl[st][tl] = h; Pl[st][tl] = P;
                    h = a_.y * h + bx.y; P *= a_.y; hl[st][tl + 1] = h; Pl[st][tl + 1] = P;
                }
                Prun[st] = P; Hrun[st] = h;
                LDS_WAIT();
            }
            const float pP0 = __shfl_xor(Prun[0], 32), pH0 = __shfl_xor(Hrun[0], 32), pP1 = __shfl_xor(Prun[1], 32), pH1 = __shfl_xor(Hrun[1], 32);
            const float P0 = th ? pP0 : Prun[0], H0 = th ? pH0 : Hrun[0], P1 = th ? Prun[0] : pP0, H1 = th ? Hrun[0] : pH0;
            const float P2 = th ? pP1 : Prun[1], H2 = th ? pH1 : Hrun[1], P3 = th ? Prun[1] : pP1, H3 = th ? Hrun[1] : pH1;
            const float C1 = H0, Q1 = P0, C2 = P1 * C1 + H1, Q2 = P1 * Q1, C3 = P2 * C2 + H2, Q3 = P2 * Q2, Hc = P3 * C3 + H3, Pc = P3 * Q3;
            const float Cs0 = th ? C1 : 0.f, Qs0 = th ? Q1 : 1.f, Cs1 = th ? C3 : C2, Qs1 = th ? Q3 : Q2;
            const int cit = (rd * F.G + F.vcu) * NWAVES + F.wave; const bool cdo = cit < NEXP * 768;
            f32x4 ctv[8]; unsigned short ggr[2][16];
            if (cdo) { const TItem citem = expert_item(F, I, cit); transpose_load(citem, ctv, lane); }
#pragma unroll
            for (int st = 0; st < 2; ++st)
#pragma unroll
                for (int tl = 0; tl < 16; ++tl) ggr[st][tl] = GL[(tok0 + 32 * st + 16 * th + tl) * 1024 + chg];
            asm volatile("" ::: "memory");
            if (th == 0) sumT[((rd & 1) * 8 + F.wave) * 32 + c32] = (f32x2){Pc, Hc};
            LDS_WAIT();
            __syncthreads();
            float cin = Rc, mycin = 0.f;
#pragma unroll
            for (int w = 0; w < 8; ++w) { const f32x2 ph = sumT[((rd & 1) * 8 + w) * 32 + c32]; mycin = (w == F.wave) ? cin : mycin; cin = ph.x * cin + ph.y; }
            Rc = cin;
#pragma unroll
            for (int st = 0; st < 2; ++st) { const float hin = (st ? Cs1 : Cs0) + (st ? Qs1 : Qs0) * mycin;
#pragma unroll
                for (int tl = 0; tl < 16; ++tl) { const float hh = hl[st][tl] + Pl[st][tl] * hin;
                    YL[(tok0 + 32 * st + 16 * th + tl) * 1024 + chg] = (bf16)f2bf(hh * bf2f(ggr[st][tl])); } }
            if (cdo) { const TItem citem = expert_item(F, I, cit); transpose_store(citem, ctv, pre, lane); }
        }
        __syncthreads();
    }
}

__device__ __forceinline__ void s5_chain(const Frame& F, int b, int g) {
    typedef float f32x2 __attribute__((ext_vector_type(2)));
    LAS f32x2* segE = (LAS f32x2*)(F.lds);
    const int lane = F.lane, w = F.wave;
    const float* SLOC = (const float*)(F.ws + WS_SLOC); unsigned* AGw = (unsigned*)(F.ws + WS_AG); const float* L16 = (const float*)(F.ws + SM_LAM16);
    const float lr = L16[(g * 64 + lane) * 2], li = L16[(g * 64 + lane) * 2 + 1];
    const float* sl = SLOC + ((size_t)(g * S5N + b * S5NCH + 32 * w)) * S5Q + 2 * lane;
    unsigned* ag = AGw + ((size_t)(g * S5N + b * S5NCH + 32 * w)) * (S5K / 2) + lane;
    float xr[32], xi[32];
#pragma unroll
    for (int u = 0; u < 32; ++u) { const float2 v = *(const float2*)(sl + (size_t)u * S5Q); xr[u] = v.x; xi[u] = v.y; }
    asm volatile("" ::: "memory");
    float sr = 0.f, si = 0.f;
#pragma unroll
    for (int u = 0; u < 32; ++u) { const float nr = lr * sr - li * si + xr[u], ni = lr * si + li * sr + xi[u]; xr[u] = sr; xi[u] = si; sr = nr; si = ni; }
    segE[w * 64 + lane] = (f32x2){sr, si};
    float qr = lr, qi = li;
#pragma unroll
    for (int k = 0; k < 5; ++k) { const float nr = qr * qr - qi * qi, ni = 2.f * qr * qi; qr = nr; qi = ni; }
    LDS_WAIT();
    __syncthreads();
    float cr = 0.f, ci = 0.f;
    for (int ww = 0; ww < w; ++ww) { const f32x2 e = segE[ww * 64 + lane]; const float nr = qr * cr - qi * ci + e.x, ni = qr * ci + qi * cr + e.y; cr = nr; ci = ni; }
#pragma unroll
    for (int u = 0; u < 32; ++u) { ag[(size_t)u * (S5K / 2)] = pk2(xr[u] + cr, xi[u] + ci); const float nr = lr * cr - li * ci, ni = lr * ci + li * cr; cr = nr; ci = ni; }
    __syncthreads();
}

__device__ __forceinline__ void p8_router(const Frame& F, const In& I) {
    const int lane = F.lane, tk = lane & 15, ks = lane >> 4;
    LAS float* lg = (LAS float*)(F.lds + F.wave * 4096);
    volatile LAS unsigned* cntL = F.MISC + 32; volatile LAS unsigned* baseL = F.MISC + 64;
    const float* X1 = F.out; bf16* H2 = (bf16*)(F.ws + WS_H2); const float* gf = I.p[21];
    const bf16* RHI = (const bf16*)(F.ws + SM_RHI); const bf16* RLO = (const bf16*)(F.ws + SM_RLO);
    float* RSTD = (float*)(F.ws + SM_RSTD); unsigned* gcnt = F.ctl + CW_CNT;
    int* LTOK = (int*)(F.ws + WS_LTOK); float* LW = (float*)(F.ws + WS_LW); int* TOKE = (int*)(F.ws + WS_TOKE); int* TOKR = (int*)(F.ws + WS_TOKR);
    for (int blk = F.vcu; blk < T / 128; blk += F.G) {
        if (F.tid < 32) cntL[F.tid] = 0u;
        __syncthreads();
        const int tok0 = blk * 128 + F.wave * 16;
        const float* xrow = X1 + (size_t)(tok0 + tk) * D + 8 * ks; bf16* hrow = H2 + (size_t)(tok0 + tk) * D + 8 * ks;
        f32x4 acc[3]; acc[0] = acc[1] = acc[2] = (f32x4){0.f, 0.f, 0.f, 0.f}; float ss = 0.f;
        f32x4 xnx[4][2];
#pragma unroll
        for (int q = 0; q < 4; ++q) { xnx[q][0] = __builtin_nontemporal_load((const f32x4*)(xrow + 32 * q)); xnx[q][1] = __builtin_nontemporal_load((const f32x4*)(xrow + 32 * q + 4)); }
        LAS bf16* slab = (LAS bf16*)(F.lds + 32768);
        v4u wst[3];
#define RT_SLAB_LOAD(g) do { _Pragma("unroll") for (int j = 0; j < 3; ++j) { const int c = F.tid + 512 * j, which = c / 768, r = (c % 768) >> 4, kq = c & 15; \
            wst[j] = *(const v4u*)((which ? RLO : RHI) + (size_t)r * D + 128 * (g) + 8 * kq); } } while (0)
#define RT_SLAB_STORE(buf) do { _Pragma("unroll") for (int j = 0; j < 3; ++j) { const int c = F.tid + 512 * j, which = c / 768, r = (c % 768) >> 4, kq = c & 15; \
            *(LAS v4u*)(slab + ((size_t)((buf) * 2 + which) * 48 + r) * 136 + 8 * kq) = wst[j]; } } while (0)
        RT_SLAB_LOAD(0); RT_SLAB_STORE(0);
        LDS_WAIT();
        __syncthreads();
        for (int kg = 0; kg < 8; ++kg) {
            f32x4 xa[4][2];
#pragma unroll
            for (int q = 0; q < 4; ++q) { xa[q][0] = xnx[q][0]; xa[q][1] = xnx[q][1]; }
            { const int kgn = kg < 7 ? kg + 1 : kg;
#pragma unroll
              for (int q = 0; q < 4; ++q) { xnx[q][0] = __builtin_nontemporal_load((const f32x4*)(xrow + 32 * (4 * kgn + q))); xnx[q][1] = __builtin_nontemporal_load((const f32x4*)(xrow + 32 * (4 * kgn + q) + 4)); }
              RT_SLAB_LOAD(kgn); }
            f32x4 ga[4][2];
#pragma unroll
            for (int q = 0; q < 4; ++q) { const int kc = 4 * kg + q; ga[q][0] = *(const f32x4*)(gf + 32 * kc + 8 * ks); ga[q][1] = *(const f32x4*)(gf + 32 * kc + 8 * ks + 4); }
            asm volatile("" ::: "memory");
            const LAS bf16* sh = slab + (size_t)((kg & 1) * 2) * 48 * 136, * sl = sh + 48 * 136;
#pragma unroll
            for (int q = 0; q < 4; ++q) { const int kc = 4 * kg + q;
                const f32x4 a0 = xa[q][0], a1 = xa[q][1];
                ss += (a0.x * a0.x + a0.y * a0.y) + (a0.z * a0.z + a0.w * a0.w) + (a1.x * a1.x + a1.y * a1.y) + (a1.z * a1.z + a1.w * a1.w);
                const f32x4 v0 = a0 * ga[q][0], v1 = a1 * ga[q][1];
                v4u hi, lo;
                { const unsigned h0 = f2bf(v0.x), h1 = f2bf(v0.y), h2 = f2bf(v0.z), h3 = f2bf(v0.w), h4 = f2bf(v1.x), h5 = f2bf(v1.y), h6 = f2bf(v1.z), h7 = f2bf(v1.w);
                  hi.x = h0 | (h1 << 16); hi.y = h2 | (h3 << 16); hi.z = h4 | (h5 << 16); hi.w = h6 | (h7 << 16);
                  lo.x = pk2(v0.x - bf2f(h0), v0.y - bf2f(h1)); lo.y = pk2(v0.z - bf2f(h2), v0.w - bf2f(h3)); lo.z = pk2(v1.x - bf2f(h4), v1.y - bf2f(h5)); lo.w = pk2(v1.z - bf2f(h6), v1.w - bf2f(h7)); }
                *(v4u*)(hrow + 32 * kc) = hi;
                const bf16x8 hf = __builtin_bit_cast(bf16x8, hi), lf = __builtin_bit_cast(bf16x8, lo);
#pragma unroll
                for (int n = 0; n < 3; ++n) {
                    const bf16x8 wh = *(const LAS bf16x8*)(sh + (16 * n + tk) * 136 + 32 * q + 8 * ks), wl = *(const LAS bf16x8*)(sl + (16 * n + tk) * 136 + 32 * q + 8 * ks);
                    acc[n] = __builtin_amdgcn_mfma_f32_16x16x32_bf16(wh, hf, acc[n], 0, 0, 0);
                    acc[n] = __builtin_amdgcn_mfma_f32_16x16x32_bf16(wh, lf, acc[n], 0, 0, 0);
                    acc[n] = __builtin_amdgcn_mfma_f32_16x16x32_bf16(wl, hf, acc[n], 0, 0, 0);
                } }
            if (kg < 7) RT_SLAB_STORE((kg + 1) & 1);
            LDS_WAIT();
            __syncthreads();
        }
#undef RT_SLAB_LOAD
#undef RT_SLAB_STORE
        ss += __shfl_xor(ss, 16); ss += __shfl_xor(ss, 32);
        const float rstd = 1.0f / sqrtf(ss * (1.f / D) + RMS_EPS);
        if (ks == 0) RSTD[tok0 + tk] = rstd;
#pragma unroll
        for (int n = 0; n < 3; ++n)
#pragma unroll
            for (int r = 0; r < 4; ++r) lg[tk * 49 + 16 * n + 4 * ks + r] = acc[n][r] * rstd;
        LDS_WAIT();
        int E1 = 0, E2 = 0; float w1 = 0.f, w2 = 0.f; unsigned r1 = 0, r2 = 0;
        if (lane < 16) {
            const LAS float* my = lg + lane * 49;
            float lgp[4];
#pragma unroll
            for (int i = 0; i < 4; ++i) lgp[i] = my[i] + I.p[23][i];
            int gi = 0; float mx = lgp[0];
#pragma unroll
            for (int i = 1; i < 4; ++i) if (lgp[i] > mx) { mx = lgp[i]; gi = i; }
            float den = 0.f;
#pragma unroll
            for (int i = 0; i < 4; ++i) den += expf(lgp[i] - mx);
            const float pg = 1.0f / den;
            float le[8];
#pragma unroll
            for (int i = 0; i < 8; ++i) le[i] = my[4 + gi * 8 + i] + I.p[25][gi * 8 + i];
            int i1 = 0; float m1 = le[0];
#pragma unroll
            for (int i = 1; i < 8; ++i) if (le[i] > m1) { m1 = le[i]; i1 = i; }
            int i2 = -1; float m2 = -3.0e38f;
#pragma unroll
            for (int i = 0; i < 8; ++i) if (i != i1 && le[i] > m2) { m2 = le[i]; i2 = i; }
            const float e2 = expf(m2 - m1);
            w1 = pg / (1.0f + e2); w2 = pg * e2 / (1.0f + e2);
            E1 = gi * 8 + i1; E2 = gi * 8 + i2;
            r1 = __hip_atomic_fetch_add((LAS unsigned*)(F.MISC + 32) + E1, 1u, __ATOMIC_RELAXED, __HIP_MEMORY_SCOPE_WORKGROUP);
            r2 = __hip_atomic_fetch_add((LAS unsigned*)(F.MISC + 32) + E2, 1u, __ATOMIC_RELAXED, __HIP_MEMORY_SCOPE_WORKGROUP);
        }
        LDS_WAIT();
        __syncthreads();
        if (F.tid < 32) { const unsigned c = cntL[F.tid]; baseL[F.tid] = c ? __hip_atomic_fetch_add(gcnt + F.tid, c, __ATOMIC_RELAXED, __HIP_MEMORY_SCOPE_AGENT) : 0u; }
        __syncthreads();
        if (lane < 16) {
            const int tok = tok0 + lane; const int k1 = (int)(baseL[E1] + r1), k2 = (int)(baseL[E2] + r2);
            LTOK[(size_t)E1 * T + k1] = tok; LW[(size_t)E1 * T + k1] = w1; LTOK[(size_t)E2 * T + k2] = tok; LW[(size_t)E2 * T + k2] = w2;
            TOKE[tok * 2] = E1; TOKE[tok * 2 + 1] = E2; TOKR[tok * 2] = k1; TOKR[tok * 2 + 1] = k2;
        }
        __syncthreads();
    }
}

__device__ __forceinline__ void moe_prefix(const Frame& F) {
    if (F.tid < 64) {
        const unsigned nt = F.tid < NEXP ? (F.ctl[CW_CNT + F.tid] + 255u) >> 8 : 0u; unsigned inc = nt;
#pragma unroll
        for (int o = 1; o < 32; o <<= 1) { const unsigned v = __shfl_up(inc, o); if (F.lane >= o) inc += v; }
        if (F.tid < NEXP) F.MISC[96 + F.tid] = inc - nt;
        if (F.tid == NEXP - 1) F.MISC[128] = inc;
    }
    LDS_WAIT();
    __syncthreads();
}
template <int MODE  >
__device__ __forceinline__ void moe_setup(const Frame& F) {
    moe_prefix(F);
    const int NT = (int)F.MISC[128];
    if (F.tid < MAXU) { const int L = F.tid * F.G + F.vcu; int e = -1, mt = 0;
        if (L < NT * 4) { const int mtg = L >> 2; e = 0; while (e < NEXP - 1 && (int)F.MISC[96 + e + 1] <= mtg) ++e; mt = mtg - (int)F.MISC[96 + e]; }
        F.MISC[136 + F.tid] = (unsigned)e; F.MISC[144 + F.tid] = (unsigned)mt; }
    __syncthreads();
    if (F.tid == 0) { int n = 0; while (n < MAXU && (int)F.MISC[136 + n] >= 0) ++n; F.MISC[152] = (unsigned)n; }
    __syncthreads();
    const int nU = (int)F.MISC[152];
    LAS int* tokL = (LAS int*)(F.lds + TOKL_OFF); LAS float* sclL = (LAS float*)(F.lds + SCLL_OFF);
    const int* LTOK = (const int*)(F.ws + WS_LTOK); const float* LW = (const float*)(F.ws + WS_LW); const float* RSTD = (const float*)(F.ws + SM_RSTD);
    for (int i = F.tid; i < nU * 256; i += 512) { const int ui = i >> 8, r = i & 255, e = (int)F.MISC[136 + ui], rank = (int)F.MISC[144 + ui] * 256 + r; const bool valid = rank < (int)F.ctl[CW_CNT + e];
        const int tok = valid ? LTOK[(size_t)e * T + rank] : 0; tokL[i] = tok; sclL[i] = valid ? (MODE == 0 ? RSTD[tok] : LW[(size_t)e * T + rank]) : 0.f; }
    LDS_WAIT(); VM_WAIT();
    __syncthreads();
}

__device__ __forceinline__ void p11_final(const Frame& F, const In& I, float* dst) {
    moe_prefix(F);
    const int gw = F.vcu * NWAVES + F.wave, NGW = F.G * NWAVES, lane = F.lane;
    const int* TOKE = (const int*)(F.ws + WS_TOKE); const int* TOKR = (const int*)(F.ws + WS_TOKR); const bf16* YS = (const bf16*)(F.ws + WS_YS);
    f32x4 gfin[4];
#pragma unroll
    for (int j = 0; j < 4; ++j) gfin[j] = ((const f32x4*)I.p[29])[lane + 64 * j];
    int ee[2][2], rr[2][2];
    { const int m0 = gw * 2 < T ? gw * 2 : 0;
#pragma unroll
      for (int q = 0; q < 2; ++q) { ee[q][0] = TOKE[2 * (m0 + q)]; ee[q][1] = TOKE[2 * (m0 + q) + 1]; rr[q][0] = TOKR[2 * (m0 + q)]; rr[q][1] = TOKR[2 * (m0 + q) + 1]; } }
    for (int m0 = gw * 2; m0 < T; m0 += NGW * 2) {
        f32x4 xv[2][4]; v2u ya[2][4], yb[2][4];
#pragma unroll
        for (int q = 0; q < 2; ++q) { const size_t s0 = (size_t)F.MISC[96 + ee[q][0]] * 256 + rr[q][0], s1 = (size_t)F.MISC[96 + ee[q][1]] * 256 + rr[q][1];
            const f32x4* xr = (const f32x4*)(F.out + (size_t)(m0 + q) * D) + lane; const v2u* y0 = (const v2u*)(YS + s0 * 1024) + lane; const v2u* y1 = (const v2u*)(YS + s1 * 1024) + lane;
#pragma unroll
            for (int j = 0; j < 4; ++j) { xv[q][j] = __builtin_nontemporal_load(xr + 64 * j); ya[q][j] = __builtin_nontemporal_load(y0 + 64 * j); yb[q][j] = __builtin_nontemporal_load(y1 + 64 * j); } }
        { const int mn = m0 + NGW * 2 < T ? m0 + NGW * 2 : m0;
#pragma unroll
          for (int q = 0; q < 2; ++q) { ee[q][0] = TOKE[2 * (mn + q)]; ee[q][1] = TOKE[2 * (mn + q) + 1]; rr[q][0] = TOKR[2 * (mn + q)]; rr[q][1] = TOKR[2 * (mn + q) + 1]; } }
        asm volatile("" ::: "memory");
#pragma unroll
        for (int q = 0; q < 2; ++q) { f32x4 v[4]; float s = 0.f;
#pragma unroll
            for (int j = 0; j < 4; ++j) { const f32x4 x = xv[q][j]; const v2u a = ya[q][j], b = yb[q][j];
                v[j].x = x.x + bflo(a.x) + bflo(b.x); v[j].y = x.y + bfhi(a.x) + bfhi(b.x); v[j].z = x.z + bflo(a.y) + bflo(b.y); v[j].w = x.w + bfhi(a.y) + bfhi(b.y);
                s += (v[j].x * v[j].x + v[j].y * v[j].y) + (v[j].z * v[j].z + v[j].w * v[j].w); }
            const float rstd = 1.0f / sqrtf(wave_sum(s) * (1.f / D) + RMS_EPS);
            f32x4* xw = (f32x4*)(dst + (size_t)(m0 + q) * D) + lane;
#pragma unroll
            for (int j = 0; j < 4; ++j) { const f32x4 g = gfin[j]; __builtin_nontemporal_store((f32x4){v[j].x * rstd * g.x, v[j].y * rstd * g.y, v[j].z * rstd * g.z, v[j].w * rstd * g.w}, xw + 64 * j); } }
    }
}

constexpr int N_PHASES = 12;
struct Args { In in; float* out; unsigned char* ws; float* fin_dst; int ph_lo, ph_hi, li, pad; };
__global__ void __launch_bounds__(NWAVES * 64, 2) mk_fwd(Args args) {
    extern __shared__ __attribute__((aligned(16))) unsigned char lds[];
    Frame F;
    F.lds = (LAS unsigned char*)lds;
    F.MISC = (volatile LAS unsigned*)(F.lds + MISC_OFF);
    F.tid = threadIdx.x; F.lane = F.tid & 63; F.wave = __builtin_amdgcn_readfirstlane(F.tid >> 6);
    F.G = gridDim.x; { const int bx = blockIdx.x; F.vcu = (F.G % 8 == 0) ? (bx % 8) * (F.G / 8) + bx / 8 : bx; }
    F.ws = args.ws; F.out = args.out; F.ctl = (unsigned*)(args.ws + WS_CTL); F.in = nullptr;
    const In& I = args.in;
    for (int u = F.tid; u < 256; u += NWAVES * 64) F.MISC[u] = 0u;
    __syncthreads();
    const int lo = args.ph_lo, hi = args.ph_hi;
    XcdBarrier bar; bar.bar = F.ctl + CW_BAR + args.li * XCD_BAR_WORDS; bar.x = 0; bar.st = nullptr;
    if (hi - lo > 1) bar = xcd_barrier_post(F.ctl + CW_BAR + args.li * XCD_BAR_WORDS, F.MISC + 8);
#ifndef PH_MASK
#define PH_MASK 0xFFF
#endif
#define IN(k) (((PH_MASK >> (k)) & 1) && lo <= (k) && (k) < hi)
#define SEAM(k) do { if (IN(k) && IN(NEXT_PH(k))) xcd_barrier(bar); } while (0)
#define NEXT_PH(k) ((k) == 2 ? 5 : (k) + 1)
    const int cblk = (int)blockIdx.x;
    LAS unsigned char* ring = F.lds;

    if (IN(0)) { p0_prologue(F, I); SEAM(0); }

    if (IN(1)) {
        DenseOrder S; S.init(F.ws + WS_H, F.ws + WS_WIN, D, D, T, NIN, F.G, cblk);
        EpiInProj E{(bf16*)(F.ws + WS_AG), (bf16*)(F.ws + WS_XL), (bf16*)(F.ws + WS_GL), (bf16*)(F.ws + WS_GA), (bf16*)(F.ws + WS_GB)};
        pg8::gemm_phase<EpiInProj, DenseOrder, true>(ring, D, D, S, E);
        SEAM(1);
    }
    if (IN(2)) {
        if (cblk < 256) {
            const int L = cblk, wgid = (L % 8) * 32 + L / 8, g = wgid >> 3, mt = wgid & 7;
            { S5One S{(const char*)(F.ws + WS_AG) + S5Q * 2, (const char*)(F.ws + WS_BTW), (size_t)S5N * S5K * 2, (size_t)128 * 256 * 2, S5K, g, mt};
              EpiS5State E{(float*)(F.ws + WS_SLOC)};
              pg8::gemm_phase<EpiS5State, S5One, false>(ring, 256, 256, S, E); }
            if (F.wave == 0) { __builtin_amdgcn_fence(__ATOMIC_ACQUIRE, "agent"); VM_WAIT(); }
            __syncthreads();
            s5_chain(F, mt, g);
            VM_WAIT();
            __syncthreads();
            if (F.wave == 0) { __builtin_amdgcn_fence(__ATOMIC_ACQUIRE, "agent"); VM_WAIT(); }
            __syncthreads();
            { S5One S{(const char*)(F.ws + WS_AG), (const char*)(F.ws + WS_BTT), (size_t)S5N * S5K * 2, (size_t)256 * S5K * 2, S5K, g, mt};
              EpiS5Out E{(bf16*)(F.ws + WS_GY)};
              pg8::gemm_phase<EpiS5Out, S5One, false>(ring, S5K, S5K, S, E); }
            __syncthreads();
        }
        lru_seq(F, I);
        SEAM(2);
    }
    if (IN(5)) {
        GyOrder S; S.d.init(F.ws + WS_GY, F.ws + WS_WS5, S5W, S5W, T, 2 * D, F.G, cblk);
        EpiYa E{(const bf16*)(F.ws + WS_GA), (bf16*)(F.ws + WS_XL)};
        pg8::gemm_phase<EpiYa, GyOrder, true>(ring, S5W, S5W, S, E, (size_t)4 * T * 32);
        SEAM(5);
    }
    if (IN(6)) {
        DenseOrder S; S.init(F.ws + WS_H, F.ws + WS_WLRU, D, D, T, D, F.G, cblk);
        EpiYb E{(const bf16*)(F.ws + WS_XL), (const bf16*)(F.ws + WS_GB), (bf16*)(F.ws + WS_GL)};
        pg8::gemm_phase<EpiYb, DenseOrder, true>(ring, D, D, S, E);
        SEAM(6);
    }
    if (IN(7)) {
        DenseOrder S; S.init(F.ws + WS_GL, F.ws + WS_WO, D, D, T, D, F.G, cblk);
        EpiWo E{I.p[0], F.out};
        pg8::gemm_phase<EpiWo, DenseOrder, true>(ring, D, D, S, E);
        SEAM(7);
    }
    if (IN(8)) { p8_router(F, I); __syncthreads(); expert_weight_copies(F, I); SEAM(8); }
    if (IN(9)) {
        moe_setup<0>(F);
        MoeOrder<true> S{(const char*)(F.ws + WS_H2), (const char*)(F.ws + WS_WGU), (size_t)1024 * 1024 * 2, D, D, F.G, F.vcu, F.MISC, (const LAS int*)(F.lds + TOKL_OFF)};
        EpiGU E{(bf16*)(F.ws + WS_ACT), (const LAS float*)(F.lds + SCLL_OFF)};
        pg8::gemm_phase<EpiGU, MoeOrder<true>, true>(ring, D, D, S, E);
        SEAM(9);
    }
    if (IN(10)) {
        moe_setup<1>(F);
        MoeOrder<false> S{(const char*)(F.ws + WS_ACT), (const char*)(F.ws + WS_WD), (size_t)1024 * DEXP * 2, DEXP, DEXP, F.G, F.vcu, F.MISC, (const LAS int*)(F.lds + TOKL_OFF)};
        EpiDown E{(bf16*)(F.ws + WS_YS), (const LAS float*)(F.lds + SCLL_OFF)};
        pg8::gemm_phase<EpiDown, MoeOrder<false>, true>(ring, DEXP, DEXP, S, E);
        SEAM(10);
    }
    if (IN(11)) { p11_final(F, I, args.fin_dst); }
#undef IN
#undef SEAM
}

extern "C" void kernel_launch(void* const* d_in, const int* in_sizes, int n_in, void* d_out, int out_size, void* d_ws, size_t ws_size, hipStream_t stream) {
    static int grid = 0;
    if (grid == 0) {
        if (n_in != 30 || in_sizes[0] != T * D || out_size != T * D || ws_size < WS_END) { fprintf(stderr, "kernel_launch: unexpected shapes / workspace (n_in %d, ws %zu)\n", n_in, ws_size); grid = -1; return; }
        int dev = 0, cus = 0, per_cu = 0;
        if (hipGetDevice(&dev) != hipSuccess || hipDeviceGetAttribute(&cus, hipDeviceAttributeMultiprocessorCount, dev) != hipSuccess) { grid = -1; return; }
        if (hipFuncSetAttribute((const void*)mk_fwd, hipFuncAttributeMaxDynamicSharedMemorySize, LDS_BYTES) != hipSuccess) { fprintf(stderr, "kernel_launch: hipFuncSetAttribute failed\n"); grid = -1; return; }
        if (hipOccupancyMaxActiveBlocksPerMultiprocessor(&per_cu, (const void*)mk_fwd, NWAVES * 64, LDS_BYTES) != hipSuccess || per_cu < 1) { fprintf(stderr, "kernel_launch: occupancy query says %d\n", per_cu); }
        (void)hipGetLastError();
        grid = cus;
    }
    if (grid < 0) return;
    if (hipMemsetAsync((char*)d_ws + WS_CTL, 0, CTL_ZERO_BYTES, stream) != hipSuccess) return;
    Args a{};
    for (int i = 0; i < 30; ++i) a.in.p[i] = (const float*)d_in[i];
    a.out = (float*)d_out; a.ws = (unsigned char*)d_ws; a.fin_dst = (float*)d_out;
#if defined(PROBE_LO)
    a.ph_lo = 0; a.ph_hi = PROBE_HI; a.li = 0;
#if PROBE_LO == 11
    a.fin_dst = (float*)((char*)d_ws + WS_WGU);
#endif
    hipLaunchKernelGGL(mk_fwd, dim3(grid), dim3(NWAVES * 64), LDS_BYTES, stream, a);
#if PROBE_LO == 8
    hipMemsetAsync((char*)d_ws + WS_CTL + CW_CNT * 4, 0, 128, stream);
#endif
    a.fin_dst = (float*)d_out;
    a.ph_lo = PROBE_LO; a.ph_hi = N_PHASES; a.li = 1;
    hipLaunchKernelGGL(mk_fwd, dim3(grid), dim3(NWAVES * 64), LDS_BYTES, stream, a);
#elif MK_N_LAUNCHES == 1
    a.ph_lo = 0; a.ph_hi = N_PHASES;
    hipLaunchKernelGGL(mk_fwd, dim3(grid), dim3(NWAVES * 64), LDS_BYTES, stream, a);
#else
    for (int p = 0; p < N_PHASES; ++p) { a.ph_lo = p; a.ph_hi = p + 1; hipLaunchKernelGGL(mk_fwd, dim3(grid), dim3(NWAVES * 64), LDS_BYTES, stream, a); }
#endif
}
```

```cpp
#include <hip/hip_runtime.h>
#include <cstdio>
#include <cstdint>

#ifndef MK_N_LAUNCHES
#define MK_N_LAUNCHES 1
#endif

namespace pg8 {
#define PG8_LAS __attribute__((address_space(3)))
typedef unsigned short bf16_t;
typedef short bf16x8 __attribute__((ext_vector_type(8)));
typedef float f32x4 __attribute__((ext_vector_type(4)));
typedef unsigned u32x4 __attribute__((ext_vector_type(4)));
constexpr int BM = 256, BK = 64, HALF = 128, HTB = HALF * BK * 2  , STAGE_BYTES = 8 * HTB, NXCD = 8, WGM = 8;

__host__ __device__ __forceinline__ int lds_byte(int r, int c) { const int st = (r >> 4) * 2 + (c >> 5), rr = r & 15, cc = c & 31, ob = rr * 64 + cc * 2; return st * 1024 + (ob ^ (((ob >> 9) & 1) << 5)); }
__host__ __device__ __forceinline__ void stage_rc(int b, int& R, int& C) { const int st = b / 1024, sb = b % 1024, swz = sb ^ (((sb >> 9) & 1) << 5); R = (st >> 1) * 16 + swz / 64; C = (st & 1) * 32 + (swz % 64) / 2; }
__host__ __device__ __forceinline__ int perm32(int rho) { const int n = rho >> 4, i = rho & 15; return 8 * (i >> 2) + 4 * n + (i & 3); }

struct Unit { const char* A; const char* B; int pm, pn, aux; };

__device__ __forceinline__ unsigned cvt_pk_bf16(float lo, float hi) { unsigned r; asm volatile("v_cvt_pk_bf16_f32 %0, %1, %2" : "=v"(r) : "v"(lo), "v"(hi)); return r; }

template <class Epi, class Sched, bool ALIGN_EPI>
__device__ __forceinline__ void gemm_phase(PG8_LAS unsigned char* lds, const int ldb, const int K, const Sched& S, const Epi& E, const size_t kstepA = (size_t)(BK * 2)) {
    const int tid = threadIdx.x, wid = __builtin_amdgcn_readfirstlane(tid >> 6), lane = tid & 63, wr = wid >> 2, wc = wid & 3, fr = lane & 15, fq = lane >> 4;
    int nt = K / BK; asm volatile("" : "+s"(nt));
    int Rr[2], Cc[2]; unsigned voffB[4], vAc[4], vAn[4];
#pragma unroll
    for (int i = 0; i < 2; ++i) { int R, C; stage_rc(tid * 16 + i * 8192, R, C); Rr[i] = R; Cc[i] = C; const int Rb = Epi::PERM ? ((R & ~31) + perm32(R & 31)) : R;
        voffB[i] = (unsigned)(Rb * ldb + C) * 2u; voffB[2 + i] = (unsigned)((HALF + Rb) * ldb + C) * 2u; }
    const size_t kstep = (size_t)(BK * 2);
    const unsigned ldsw = (unsigned)wid * 1024u;
    const int aoff = lds_byte(wr * 64 + fr, fq * 8), boff = lds_byte(wc * 32 + fr, fq * 8);
#define PG8_SA(b, h) (((b) * 2 + (h)) * HTB)
#define PG8_SB(b, h) ((4 + (b) * 2 + (h)) * HTB)
#define PG8_STAGE(bufoff, gbase, voff, h) do { _Pragma("unroll") for (int _i = 0; _i < 2; ++_i) \
        __builtin_amdgcn_global_load_lds((const unsigned*)((const char*)(gbase) + (voff)[2 * (h) + _i]), (PG8_LAS unsigned*)(lds + (bufoff) + ldsw + _i * 8192), 16, 0, 0); } while (0)
#define PG8_LDA(dst, b, h) do { _Pragma("unroll") for (int m = 0; m < 4; ++m) _Pragma("unroll") for (int k = 0; k < 2; ++k) dst[m][k] = *(const PG8_LAS bf16x8*)(lds + PG8_SA(b, h) + aoff + m * 2048 + k * 1024); } while (0)
#define PG8_LDB(dst, b, h) do { _Pragma("unroll") for (int n = 0; n < 2; ++n) _Pragma("unroll") for (int k = 0; k < 2; ++k) dst[n][k] = *(const PG8_LAS bf16x8*)(lds + PG8_SB(b, h) + boff + n * 2048 + k * 1024); } while (0)
#define PG8_MMA(ai, bj, At, Bt) do { __builtin_amdgcn_s_setprio(1); _Pragma("unroll") for (int m = 0; m < 4; ++m) _Pragma("unroll") for (int n = 0; n < 2; ++n) _Pragma("unroll") for (int k = 0; k < 2; ++k) \
        acc[ai][bj][m][n] = __builtin_amdgcn_mfma_f32_16x16x32_bf16(Bt[n][k], At[m][k], acc[ai][bj][m][n], 0, 0, 0); __builtin_amdgcn_s_setprio(0); } while (0)
#define PG8_WAIT_V(n) asm volatile("s_waitcnt vmcnt(" #n ")" ::: "memory")
#define PG8_WAIT_L(n) asm volatile("s_waitcnt lgkmcnt(" #n ")" ::: "memory")
#define PG8_BAR __builtin_amdgcn_s_barrier()
#define PG8_SCHED __builtin_amdgcn_sched_barrier(0)
    Unit cur, nxt; int ui = 0;
    if (!S.next(0, cur)) return;
    S.a_offsets(cur, Rr, Cc, vAc);
    f32x4 acc[2][2][4][2];
    if constexpr (Epi::ACC_INIT) E.init(acc, cur, wr, wc, fr, fq);
    else {
#pragma unroll
    for (int a = 0; a < 2; ++a)
#pragma unroll
        for (int b = 0; b < 2; ++b)
#pragma unroll
            for (int m = 0; m < 4; ++m)
#pragma unroll
                for (int n = 0; n < 2; ++n) acc[a][b][m][n] = (f32x4){0.f, 0.f, 0.f, 0.f}; }
    bf16x8 At[4][2], B0[2][2], B1[2][2];
    const char* cA = cur.A; const char* cB = cur.B;
    if constexpr (Sched::GATHER) { PG8_WAIT_L(0); }
    PG8_STAGE(PG8_SB(0, 0), cB, voffB, 0); PG8_STAGE(PG8_SB(0, 1), cB, voffB, 1); PG8_STAGE(PG8_SA(0, 0), cA, vAc, 0); PG8_STAGE(PG8_SA(0, 1), cA, vAc, 1);
    if (wr == 1) PG8_BAR;
    PG8_WAIT_V(2); PG8_BAR;
    PG8_STAGE(PG8_SB(1, 0), cB + kstep, voffB, 0); PG8_STAGE(PG8_SA(1, 0), cA + kstepA, vAc, 0); PG8_STAGE(PG8_SB(1, 1), cB + kstep, voffB, 1);
    PG8_WAIT_V(6); PG8_BAR;
    for (;;) {
        const bool has_next = S.next(ui + 1, nxt);
        const char* nA = has_next ? nxt.A : cA; const char* nB = has_next ? nxt.B : cB;
        for (int t = 0; t < nt; t += 2) {
            const bool last = (t == nt - 2);
            const char* a1 = cA + (size_t)(t + 1) * kstepA;
            const char* a2 = last ? nA : cA + (size_t)(t + 2) * kstepA; const char* b2 = last ? nB : cB + (size_t)(t + 2) * kstep;
            const char* a3 = a2 + kstepA; const char* b3 = b2 + kstep;
            unsigned va2[4];
            if constexpr (Sched::GATHER) {
                if (last) { if (has_next) { S.a_offsets(nxt, Rr, Cc, vAn); PG8_WAIT_L(0); } else {
#pragma unroll
                        for (int q = 0; q < 4; ++q) vAn[q] = vAc[q]; } }
#pragma unroll
                for (int q = 0; q < 4; ++q) va2[q] = last ? vAn[q] : vAc[q];
            } else {
#pragma unroll
                for (int q = 0; q < 4; ++q) va2[q] = vAc[q];
            }
            PG8_LDB(B0, 0, 0); PG8_LDB(B1, 0, 1); PG8_SCHED; PG8_LDA(At, 0, 0); PG8_STAGE(PG8_SA(1, 1), a1, vAc, 1);
            PG8_WAIT_V(8); PG8_WAIT_L(0); PG8_BAR; PG8_MMA(0, 0, At, B0); PG8_MMA(0, 1, At, B1); PG8_BAR; PG8_SCHED;
            const bool fin = last && !has_next;
            PG8_LDA(At, 0, 1);
            if (!fin) { PG8_STAGE(PG8_SB(0, 0), b2, voffB, 0); PG8_STAGE(PG8_SB(0, 1), b2, voffB, 1); PG8_STAGE(PG8_SA(0, 0), a2, va2, 0); PG8_WAIT_V(8); } else { PG8_WAIT_V(0); }
            PG8_WAIT_L(0); PG8_BAR; PG8_MMA(1, 0, At, B0); PG8_MMA(1, 1, At, B1); PG8_BAR; PG8_SCHED;
            PG8_LDB(B0, 1, 0); PG8_LDB(B1, 1, 1); PG8_SCHED; PG8_LDA(At, 1, 0);
            if (!fin) { PG8_STAGE(PG8_SA(0, 1), a2, va2, 1); PG8_WAIT_V(8); } else { PG8_WAIT_V(0); }
            PG8_WAIT_L(0); PG8_BAR; PG8_MMA(0, 0, At, B0); PG8_MMA(0, 1, At, B1); PG8_BAR; PG8_SCHED;
            PG8_LDA(At, 1, 1);
            if (!fin) { PG8_STAGE(PG8_SB(1, 0), b3, voffB, 0); PG8_STAGE(PG8_SB(1, 1), b3, voffB, 1); PG8_STAGE(PG8_SA(1, 0), a3, va2, 0); PG8_WAIT_V(8); } else { PG8_WAIT_V(0); }
            PG8_WAIT_L(0); PG8_BAR; PG8_MMA(1, 0, At, B0); PG8_MMA(1, 1, At, B1); PG8_BAR; PG8_SCHED;
        }
        if constexpr (ALIGN_EPI) { if (wr == 0) PG8_BAR; }
        E(acc, cur, wr, wc, fr, fq);
        if (!has_next) break;
        if constexpr (Epi::ACC_INIT) E.init(acc, nxt, wr, wc, fr, fq);
        else {
#pragma unroll
        for (int a = 0; a < 2; ++a)
#pragma unroll
            for (int b = 0; b < 2; ++b)
#pragma unroll
                for (int m = 0; m < 4; ++m)
#pragma unroll
                    for (int n = 0; n < 2; ++n) acc[a][b][m][n] = (f32x4){0.f, 0.f, 0.f, 0.f}; }
        cur = nxt; cA = nA; cB = nB; ++ui;
        if constexpr (Sched::GATHER) {
#pragma unroll
            for (int q = 0; q < 4; ++q) vAc[q] = vAn[q]; }
        if constexpr (ALIGN_EPI) { if (wr == 1) PG8_BAR; }
    }
    PG8_WAIT_V(0);
    if constexpr (!ALIGN_EPI) { if (wr == 0) PG8_BAR; }
    PG8_BAR;
#undef PG8_SA
#undef PG8_SB
#undef PG8_STAGE
#undef PG8_LDA
#undef PG8_LDB
#undef PG8_MMA
#undef PG8_WAIT_V
#undef PG8_WAIT_L
#undef PG8_BAR
#undef PG8_SCHED
}
}

constexpr int NWAVES = 8;
constexpr int BATCH = 8, SEQ = 4096, D = 1024, T = BATCH * SEQ;
constexpr int S5W = 512, S5G = 32, S5C = 16, S5P = 64, S5Q = 128;
constexpr int S5LC = 16, S5NCH = SEQ / S5LC, S5N = BATCH * S5NCH;
constexpr int S5K = S5Q + S5LC * S5C;
constexpr int LRUW = 1024, LRUH = 16, LRUHD = 64, LRUCH = 64, LRUNCH = SEQ / LRUCH;
constexpr int NIN = S5W + 2 * LRUW + 2 * D;
constexpr int NEXP = 32, EPG = 8, NGRP = 4, DEXP = 512, NROUT = 48;
constexpr int MAXSLOT = 73728;
constexpr int MAXU = 8;
constexpr float RMS_EPS = 1e-6f;

constexpr size_t MiB = 1u << 20;
constexpr size_t WS_CTL = 0, CTL_ZERO_BYTES = 128 * 1024;
constexpr size_t WS_SMALL = 1 * MiB;
constexpr size_t SM_LAM16 = WS_SMALL + 0;
constexpr size_t SM_LRUC = WS_SMALL + 16384;
constexpr size_t SM_WRT = WS_SMALL + 32768;
constexpr size_t SM_RHI = WS_SMALL + 327680;
constexpr size_t SM_RLO = SM_RHI + 98304;
constexpr size_t SM_RSTD = WS_SMALL + 524288;
constexpr size_t WS_BTT = 2 * MiB;
constexpr size_t WS_BTW = 8 * MiB;
constexpr size_t WS_WIN = 11 * MiB;
constexpr size_t WS_WS5 = 20 * MiB;
constexpr size_t WS_WLRU = 22 * MiB;
constexpr size_t WS_WO = 24 * MiB;
constexpr size_t WS_LP = 26 * MiB, WS_LH = 28 * MiB, WS_LHIN = 30 * MiB;
constexpr size_t WS_AG = 32 * MiB;
constexpr size_t WS_SLOC = 80 * MiB;
constexpr size_t WS_H = 112 * MiB;
constexpr size_t WS_XL = 176 * MiB;
constexpr size_t WS_GL = 240 * MiB;
constexpr size_t WS_GA = 304 * MiB, WS_GB = 336 * MiB;
constexpr size_t WS_GY = 368 * MiB;
constexpr size_t WS_WGU = 400 * MiB;
constexpr size_t WS_WD = 464 * MiB;
constexpr size_t WS_H2 = 32 * MiB;
constexpr size_t WS_ACT = 96 * MiB;
constexpr size_t WS_YS = 168 * MiB;
constexpr size_t WS_LTOK = 312 * MiB, WS_LW = 316 * MiB;
constexpr size_t WS_TOKE = 320 * MiB, WS_TOKR = WS_TOKE + 262144;
constexpr size_t WS_END = 496 * MiB;
static_assert(WS_YS + (size_t)MAXSLOT * 1024 * 2 <= WS_LTOK && WS_ACT + (size_t)MAXSLOT * 512 * 2 <= WS_YS && WS_TOKR + 262144 <= WS_WGU && WS_GY + (size_t)T * 512 * 2 <= WS_WGU && WS_WD + (size_t)32 * 1024 * 512 * 2 <= WS_END, "d_ws map");
constexpr int CW_BAR = 4096;
constexpr int CW_CNT = 16384;

constexpr int RING_BYTES = 131072;
constexpr int TOKL_OFF = RING_BYTES, SCLL_OFF = TOKL_OFF + MAXU * 256 * 4, MISC_OFF = SCLL_OFF + MAXU * 256 * 4;
constexpr int LDS_BYTES = MISC_OFF + 1024;

#define GAS __attribute__((address_space(1)))
#define LAS __attribute__((address_space(3)))
typedef unsigned short bf16;
typedef unsigned v4u __attribute__((ext_vector_type(4)));
typedef unsigned v2u __attribute__((ext_vector_type(2)));
typedef float f32x4 __attribute__((ext_vector_type(4)));
typedef short bf16x8 __attribute__((ext_vector_type(8)));
#define LDS_WAIT() asm volatile("s_waitcnt lgkmcnt(0)" ::: "memory")
#define VM_WAIT() asm volatile("s_waitcnt vmcnt(0)" ::: "memory")
__device__ __forceinline__ unsigned f2bf(float f) { unsigned u = __builtin_bit_cast(unsigned, f); return (u + 0x7fffu + ((u >> 16) & 1u)) >> 16; }
__device__ __forceinline__ float bf2f(unsigned h) { return __builtin_bit_cast(float, h << 16); }
__device__ __forceinline__ unsigned pk2(float lo, float hi) { return f2bf(lo) | (f2bf(hi) << 16); }
__device__ __forceinline__ float bflo(unsigned w) { return __builtin_bit_cast(float, w << 16); }
__device__ __forceinline__ float bfhi(unsigned w) { return __builtin_bit_cast(float, w & 0xffff0000u); }
__device__ __forceinline__ float fsigmoid(float x) { return __builtin_amdgcn_rcpf(1.0f + __builtin_amdgcn_exp2f(-1.44269504f * x)); }
__device__ __forceinline__ float gelu_t(float x) { const float u = x * (0.7978845608f + 0.0356774081f * x * x); return x * __builtin_amdgcn_rcpf(1.0f + __builtin_amdgcn_exp2f(-2.88539008f * u)); }
__device__ __forceinline__ float wave_sum(float v) {
#pragma unroll
    for (int o = 1; o < 64; o <<= 1) v += __shfl_xor(v, o);
    return v;
}

#define XB_TMO      128
#define XB_XCNT(j)  (256  + 64 * (j))
#define XB_XSUB(j)  (1280 + 64 * (j))
#define XB_XGEN(j)  (2304 + 64 * (j))
#define XB_TOP      3328
#define XB_TOPGEN   3392
#define XCD_BAR_WORDS 3456
#define XB_SPIN_CAP (1u << 18)
__device__ __forceinline__ unsigned xb_ld(unsigned* p)              { return __hip_atomic_load(p, __ATOMIC_RELAXED, __HIP_MEMORY_SCOPE_AGENT); }
__device__ __forceinline__ unsigned xb_add(unsigned* p, unsigned v) { return __hip_atomic_fetch_add(p, v, __ATOMIC_RELAXED, __HIP_MEMORY_SCOPE_AGENT); }
__device__ __forceinline__ unsigned xb_xcc_id() { return (unsigned)__builtin_amdgcn_s_getreg((3 << 11) | 20) & 0xFu; }
#define XB_SPIN(cond, bar) do { unsigned _sp = 0; while (cond) { __builtin_amdgcn_s_sleep(1); \
    if ((++_sp & 255u) == 0u) { if (xb_ld(&(bar)[XB_TMO])) break; if (_sp > XB_SPIN_CAP) { atomicAdd(&(bar)[XB_TMO], 1u); break; } } } } while (0)
struct XcdBarrier { unsigned* bar; unsigned x; volatile LAS unsigned* st; };
__device__ __forceinline__ XcdBarrier xcd_barrier_post(unsigned* bar, volatile LAS unsigned* st) {
    XcdBarrier b; b.bar = bar; b.x = xb_xcc_id(); b.st = st;
    if (threadIdx.x == 0) (void)xb_add(&bar[XB_XCNT(b.x)], 1u);
    return b;
}
__device__ __forceinline__ void xcd_barrier_complete(unsigned* bar, unsigned x, unsigned& nloc, unsigned& nx) {
    const unsigned G = gridDim.x * gridDim.y * gridDim.z;
    unsigned sum, cnt, mine, sp = 0u;
    for (;;) {
        sum = 0u; cnt = 0u; mine = 0u;
#pragma unroll
        for (unsigned j = 0; j < 16; ++j) { const unsigned c = xb_ld(&bar[XB_XCNT(j)]); sum += c; cnt += (c > 0u) ? 1u : 0u; mine = (j == x) ? c : mine; }
        if (sum == G) break;
        __builtin_amdgcn_s_sleep(1);
        if ((++sp & 255u) == 0u) { if (xb_ld(&bar[XB_TMO])) break; if (sp > XB_SPIN_CAP) { atomicAdd(&bar[XB_TMO], 1u); break; } }
    }
    nloc = mine > 0u ? mine : 1u; nx = cnt > 0u ? cnt : 1u;
}
__device__ __forceinline__ void xcd_barrier(const XcdBarrier& b) {
    asm volatile("s_waitcnt vmcnt(0)" ::: "memory");
    __syncthreads();
    if (threadIdx.x == 0) {
        unsigned* bar = b.bar;
        __builtin_amdgcn_s_waitcnt(0);
        unsigned nloc = b.st[0], nx = b.st[1];
        if (nloc == 0u) { xcd_barrier_complete(bar, b.x, nloc, nx); b.st[0] = nloc; b.st[1] = nx; }
        const unsigned old = xb_add(&bar[XB_XSUB(b.x)], 1u);
        const unsigned gen = old / nloc;
        if (old + 1u == (gen + 1u) * nloc) {
            __builtin_amdgcn_fence(__ATOMIC_RELEASE, "agent");
            asm volatile("s_waitcnt vmcnt(0)" ::: "memory");
            const unsigned og = xb_add(&bar[XB_TOP], 1u);
            const unsigned tg = og / nx;
            if (og + 1u == (tg + 1u) * nx) xb_add(&bar[XB_TOPGEN], 1u);
            else XB_SPIN(xb_ld(&bar[XB_TOPGEN]) == tg, bar);
            __builtin_amdgcn_fence(__ATOMIC_ACQUIRE, "agent");
            xb_add(&bar[XB_XGEN(b.x)], 1u);
            asm volatile("s_waitcnt vmcnt(0)" ::: "memory");
        } else {
            XB_SPIN(xb_ld(&bar[XB_XGEN(b.x)]) == gen, bar);
            __builtin_amdgcn_fence(__ATOMIC_ACQUIRE, "agent");
            asm volatile("s_waitcnt vmcnt(0)" ::: "memory");
        }
    }
    __syncthreads();
}

struct Frame {
    LAS unsigned char* lds;
    volatile LAS unsigned* MISC;
    unsigned* ctl;
    int tid, lane, wave, vcu, G;
    const float* const* in;
    unsigned char* ws; float* out;
};

using pg8::Unit;
struct DenseOrder {
    static constexpr bool GATHER = false;
    const char* A0; const char* B0; int lda, ldb, nM, nN, nwg, G, c;
    __device__ __forceinline__ void init(const void* A, const void* B, int lda_, int ldb_, int M, int N, int G_, int c_) { A0 = (const char*)A; B0 = (const char*)B; lda = lda_; ldb = ldb_; nM = M / 256; nN = N / 256; nwg = nM * nN; G = G_; c = c_; }
    __device__ __forceinline__ bool next(int i, Unit& u) const {
        const long L = (long)i * G + c; if (L >= nwg) return false;
        int wgid = (int)L; { const int q = nwg / 8, r = nwg % 8, xcd = wgid % 8, off = wgid / 8; wgid = (xcd < r ? xcd * (q + 1) : r * (q + 1) + (xcd - r) * q) + off; }
        const int nig = 8 * nN, gid = wgid / nig, fm = gid * 8, gsz = (nM - fm) < 8 ? (nM - fm) : 8;
        u.pm = fm + ((wgid % nig) % gsz); u.pn = (wgid % nig) / gsz; u.aux = 0;
        u.A = A0 + (size_t)u.pm * 256 * lda * 2; u.B = B0 + (size_t)u.pn * 256 * ldb * 2; return true;
    }
    __device__ __forceinline__ void a_offsets(const Unit&, const int (&R)[2], const int (&C)[2], unsigned (&v)[4]) const {
#pragma unroll
        for (int i = 0; i < 2; ++i) { v[i] = (unsigned)(R[i] * lda + C[i]) * 2u; v[2 + i] = (unsigned)((128 + R[i]) * lda + C[i]) * 2u; }
    }
};
struct S5One {
    static constexpr bool GATHER = false;
    const char* A0; const char* B0; size_t sA, sB; int lda, g, mt;
    __device__ __forceinline__ bool next(int i, Unit& u) const {
        if (i > 0) return false;
        u.pm = mt; u.pn = 0; u.aux = g; u.A = A0 + (size_t)g * sA + (size_t)mt * 256 * lda * 2; u.B = B0 + (size_t)g * sB; return true;
    }
    __device__ __forceinline__ void a_offsets(const Unit&, const int (&R)[2], const int (&C)[2], unsigned (&v)[4]) const {
#pragma unroll
        for (int i = 0; i < 2; ++i) { v[i] = (unsigned)(R[i] * lda + C[i]) * 2u; v[2 + i] = (unsigned)((128 + R[i]) * lda + C[i]) * 2u; }
    }
};
struct GyOrder {
    static constexpr bool GATHER = false;
    DenseOrder d;
    __device__ __forceinline__ bool next(int i, Unit& u) const { if (!d.next(i, u)) return false; u.A = d.A0 + (size_t)u.pm * 256 * 32; return true; }
    __device__ __forceinline__ void a_offsets(const Unit&, const int (&R)[2], const int (&C)[2], unsigned (&v)[4]) const {
#pragma unroll
        for (int i = 0; i < 2; ++i) { const unsigned o = (unsigned)(C[i] >> 4) * (unsigned)(T * 32) + (unsigned)(C[i] & 15) * 2u; v[i] = (unsigned)R[i] * 32u + o; v[2 + i] = (unsigned)(128 + R[i]) * 32u + o; }
    }
};
template <bool GATH> struct MoeOrder {
    static constexpr bool GATHER = GATH;
    const char* A0; const char* B0; size_t sBe; int lda, ldb, G, c; volatile LAS unsigned* MISC; const LAS int* tokL;
    __device__ __forceinline__ bool next(int i, Unit& u) const {
        if (i >= (int)MISC[152]) return false;
        const int e = (int)MISC[136 + i], mtg = (int)MISC[96 + e] + (int)MISC[144 + i], L = i * G + c;
        u.pm = mtg; u.pn = L & 3; u.aux = i;
        u.A = GATH ? A0 : A0 + (size_t)mtg * 256 * lda * 2; u.B = B0 + (size_t)e * sBe + (size_t)u.pn * 256 * ldb * 2; return true;
    }
    __device__ __forceinline__ void a_offsets(const Unit& u, const int (&R)[2], const int (&C)[2], unsigned (&v)[4]) const {
#pragma unroll
        for (int i = 0; i < 2; ++i) {
            if constexpr (GATH) { v[i] = (unsigned)tokL[u.aux * 256 + R[i]] * (unsigned)(lda * 2) + (unsigned)C[i] * 2u; v[2 + i] = (unsigned)tokL[u.aux * 256 + 128 + R[i]] * (unsigned)(lda * 2) + (unsigned)C[i] * 2u; }
            else { v[i] = (unsigned)(R[i] * lda + C[i]) * 2u; v[2 + i] = (unsigned)((128 + R[i]) * lda + C[i]) * 2u; } }
    }
};

using pg8::cvt_pk_bf16;
template <int ACT> __device__ __forceinline__ float actf(float x) { if (ACT == 1) return gelu_t(x); if (ACT == 2) return fsigmoid(x); return x; }
__device__ __forceinline__ v4u pack8(const f32x4 a, const f32x4 b) { v4u w; w.x = cvt_pk_bf16(a[0], a[1]); w.y = cvt_pk_bf16(a[2], a[3]); w.z = cvt_pk_bf16(b[0], b[1]); w.w = cvt_pk_bf16(b[2], b[3]); return w; }

__device__ __forceinline__ void unpack_u8x8(const v2u w, float (&f)[8]) {
    const float k = 1.0f / 255.0f;
    f[0] = (float)(w.x & 0xffu) * k; f[1] = (float)((w.x >> 8) & 0xffu) * k; f[2] = (float)((w.x >> 16) & 0xffu) * k; f[3] = (float)(w.x >> 24) * k;
    f[4] = (float)(w.y & 0xffu) * k; f[5] = (float)((w.y >> 8) & 0xffu) * k; f[6] = (float)((w.y >> 16) & 0xffu) * k; f[7] = (float)(w.y >> 24) * k;
}
struct EpiInProj {
    static constexpr bool PERM = true, ACC_INIT = false;
    bf16 *AG, *XL, *GL, *GA, *GB;
    template <int MODE  > __device__ __forceinline__ void tile(const f32x4 (&acc)[2][2][4][2], const Unit& u, bf16* base, int colbase, bool s5, int wr, int wc, int fr, int fq) const {
#pragma unroll
        for (int ai = 0; ai < 2; ++ai)
#pragma unroll
            for (int m = 0; m < 4; ++m) { const int r = u.pm * 256 + ai * 128 + wr * 64 + m * 16 + fr;
#pragma unroll
                for (int bj = 0; bj < 2; ++bj) { const int cl = colbase + bj * 128 + wc * 32 + 8 * fq;
                    f32x4 v0 = acc[ai][bj][m][0], v1 = acc[ai][bj][m][1];
                    if (MODE == 2) {
                        unsigned q[8];
#pragma unroll
                        for (int j = 0; j < 4; ++j) { q[j] = (unsigned)(fsigmoid(v0[j]) * 255.0f + 0.5f); q[4 + j] = (unsigned)(fsigmoid(v1[j]) * 255.0f + 0.5f); }
                        v2u w8; w8.x = q[0] | (q[1] << 8) | (q[2] << 16) | (q[3] << 24); w8.y = q[4] | (q[5] << 8) | (q[6] << 16) | (q[7] << 24);
                        __builtin_nontemporal_store(w8, (v2u*)((unsigned char*)base + (size_t)r * 1024 + cl));
                    } else {
                        if (MODE == 1) {
#pragma unroll
                            for (int j = 0; j < 4; ++j) { v0[j] = gelu_t(v0[j]); v1[j] = gelu_t(v1[j]); } }
                        const v4u w = pack8(v0, v1);
                        const int g = cl >> 4, cp = cl & 15, b = r >> 12, l = r & 4095, n = b * S5NCH + (l >> 4), s = l & 15;
                        const size_t off = s5 ? ((size_t)(g * S5N + n) * S5K + S5Q + s * 16 + cp) : ((size_t)r * 1024 + cl);
                        __builtin_nontemporal_store(w, (v4u*)(base + off)); } }
                asm volatile("" ::: "memory"); }
    }
    __device__ __forceinline__ void operator()(const f32x4 (&acc)[2][2][4][2], const Unit& u, int wr, int wc, int fr, int fq) const {
        const int pn = u.pn, reg = pn < 2 ? 0 : ((pn - 2) >> 2) + 1;
        const int colbase = reg == 0 ? pn * 256 : ((pn - 2) & 3) * 256;
        if (reg < 2) tile<0>(acc, u, reg == 0 ? AG : XL, colbase, reg == 0, wr, wc, fr, fq);
        else if (reg == 2) tile<1>(acc, u, GL, colbase, false, wr, wc, fr, fq);
        else tile<2>(acc, u, reg == 3 ? GA : GB, colbase, false, wr, wc, fr, fq);
    }
};
struct EpiS5State {
    static constexpr bool PERM = false, ACC_INIT = false;
    float* SLOC;
    __device__ __forceinline__ void operator()(const f32x4 (&acc)[2][2][4][2], const Unit& u, int wr, int wc, int fr, int fq) const {
#pragma unroll
        for (int ai = 0; ai < 2; ++ai)
#pragma unroll
            for (int m = 0; m < 4; ++m) { const int nr = u.pm * 256 + ai * 128 + wr * 64 + m * 16 + fr; float* rowp = SLOC + (size_t)(u.aux * S5N + nr) * S5Q + wc * 32 + 4 * fq;
#pragma unroll
                for (int n = 0; n < 2; ++n) *(f32x4*)(rowp + n * 16) = acc[ai][0][m][n]; }
    }
};
struct EpiS5Out {
    static constexpr bool PERM = true, ACC_INIT = false;
    bf16* GY;
    __device__ __forceinline__ void operator()(const f32x4 (&acc)[2][2][4][2], const Unit& u, int wr, int wc, int fr, int fq) const {
#pragma unroll
        for (int ai = 0; ai < 2; ++ai)
#pragma unroll
            for (int m = 0; m < 4; ++m) { const int nr = u.pm * 256 + ai * 128 + wr * 64 + m * 16 + fr, b = nr >> 8, j16 = nr & 255;
#pragma unroll
                for (int bj = 0; bj < 2; ++bj) { const int cc = bj * 128 + wc * 32 + 8 * fq, t = cc >> 4, c0 = cc & 15;
                    f32x4 v0 = acc[ai][bj][m][0], v1 = acc[ai][bj][m][1];
#pragma unroll
                    for (int j = 0; j < 4; ++j) { v0[j] = gelu_t(v0[j]); v1[j] = gelu_t(v1[j]); }
                    *(v4u*)(GY + ((size_t)u.aux * T + (size_t)(b * SEQ + j16 * 16 + t)) * 16 + c0) = pack8(v0, v1); }
                asm volatile("" ::: "memory"); }
    }
};
struct EpiYa {
    static constexpr bool PERM = true, ACC_INIT = false;
    const bf16* GA; bf16* YA;
    __device__ __forceinline__ void operator()(const f32x4 (&acc)[2][2][4][2], const Unit& u, int wr, int wc, int fr, int fq) const {
        const size_t off0 = (size_t)(u.pm * 256 + wr * 64 + fr) * 1024 + u.pn * 128 + wc * 32 + 8 * fq;
        v2u gav[2][4];
#pragma unroll
        for (int ai = 0; ai < 2; ++ai)
#pragma unroll
            for (int m = 0; m < 4; ++m) gav[ai][m] = __builtin_nontemporal_load((const v2u*)((const unsigned char*)GA + off0 + (size_t)(ai * 128 + m * 16) * 1024));
        asm volatile("" ::: "memory");
#pragma unroll
        for (int ai = 0; ai < 2; ++ai)
#pragma unroll
            for (int m = 0; m < 4; ++m) { float gaf[8]; unpack_u8x8(gav[ai][m], gaf);
                f32x4 o0, o1;
#pragma unroll
                for (int j = 0; j < 4; ++j) { o0[j] = gaf[j] * acc[ai][0][m][0][j] * fsigmoid(acc[ai][1][m][0][j]); o1[j] = gaf[4 + j] * acc[ai][0][m][1][j] * fsigmoid(acc[ai][1][m][1][j]); }
                *(v4u*)(YA + off0 + (size_t)(ai * 128 + m * 16) * 1024) = pack8(o0, o1); }
    }
};
struct EpiYb {
    static constexpr bool PERM = true, ACC_INIT = false;
    const bf16* YA; const bf16* GB; bf16* MIX;
    __device__ __forceinline__ void operator()(const f32x4 (&acc)[2][2][4][2], const Unit& u, int wr, int wc, int fr, int fq) const {
        const size_t off0 = (size_t)(u.pm * 256 + wr * 64 + fr) * 1024 + u.pn * 256 + wc * 32 + 8 * fq;
        v4u ya[2][2][2]; v2u gb[2][2][2];
#define YB_LOAD(buf, grp) do { _Pragma("unroll") for (int mm = 0; mm < 2; ++mm) _Pragma("unroll") for (int bj = 0; bj < 2; ++bj) { \
            const size_t o = off0 + (size_t)(((grp) >> 1) * 128 + (2 * ((grp) & 1) + mm) * 16) * 1024 + bj * 128; ya[buf][mm][bj] = __builtin_nontemporal_load((const v4u*)(YA + o)); gb[buf][mm][bj] = __builtin_nontemporal_load((const v2u*)((const unsigned char*)GB + o)); } } while (0)
        YB_LOAD(0, 0);
#pragma unroll
        for (int grp = 0; grp < 4; ++grp) { const int buf = grp & 1, ai = grp >> 1;
            if (grp < 3) YB_LOAD(buf ^ 1, grp + 1);
            asm volatile("" ::: "memory");
#pragma unroll
            for (int mm = 0; mm < 2; ++mm) { const int m = 2 * (grp & 1) + mm;
#pragma unroll
                for (int bj = 0; bj < 2; ++bj) { const v4u y = ya[buf][mm][bj];
                    const float yaf[8] = {bflo(y.x), bfhi(y.x), bflo(y.y), bfhi(y.y), bflo(y.z), bfhi(y.z), bflo(y.w), bfhi(y.w)};
                    float gbf[8]; unpack_u8x8(gb[buf][mm][bj], gbf);
                    f32x4 o0, o1;
#pragma unroll
                    for (int j = 0; j < 4; ++j) { o0[j] = yaf[j] + gbf[j] * acc[ai][bj][m][0][j]; o1[j] = yaf[4 + j] + gbf[4 + j] * acc[ai][bj][m][1][j]; }
                    *(v4u*)(MIX + off0 + (size_t)(ai * 128 + m * 16) * 1024 + bj * 128) = pack8(o0, o1); } }
        }
#undef YB_LOAD
    }
};
struct EpiWo {
    static constexpr bool PERM = false, ACC_INIT = true;
    const float* X; float* O;
    __device__ __forceinline__ void init(f32x4 (&acc)[2][2][4][2], const Unit& u, int wr, int wc, int fr, int fq) const {
        const size_t off0 = (size_t)(u.pm * 256 + wr * 64 + fr) * 1024 + u.pn * 256 + wc * 32 + 4 * fq;
#pragma unroll
        for (int ai = 0; ai < 2; ++ai)
#pragma unroll
            for (int m = 0; m < 4; ++m)
#pragma unroll
                for (int bj = 0; bj < 2; ++bj)
#pragma unroll
                    for (int n = 0; n < 2; ++n) acc[ai][bj][m][n] = __builtin_nontemporal_load((const f32x4*)(X + off0 + (size_t)(ai * 128 + m * 16) * 1024 + bj * 128 + n * 16));
    }
    __device__ __forceinline__ void operator()(const f32x4 (&acc)[2][2][4][2], const Unit& u, int wr, int wc, int fr, int fq) const {
        const size_t off0 = (size_t)(u.pm * 256 + wr * 64 + fr) * 1024 + u.pn * 256 + wc * 32 + 4 * fq;
#pragma unroll
        for (int ai = 0; ai < 2; ++ai)
#pragma unroll
            for (int m = 0; m < 4; ++m)
#pragma unroll
                for (int bj = 0; bj < 2; ++bj)
#pragma unroll
                    for (int n = 0; n < 2; ++n) *(f32x4*)(O + off0 + (size_t)(ai * 128 + m * 16) * 1024 + bj * 128 + n * 16) = acc[ai][bj][m][n];
    }
};
struct EpiGU {
    static constexpr bool PERM = true, ACC_INIT = false;
    bf16* ACT; const LAS float* sclL;
    __device__ __forceinline__ void operator()(const f32x4 (&acc)[2][2][4][2], const Unit& u, int wr, int wc, int fr, int fq) const {
#pragma unroll
        for (int ai = 0; ai < 2; ++ai)
#pragma unroll
            for (int m = 0; m < 4; ++m) { const int rl = ai * 128 + wr * 64 + m * 16 + fr; const float sc = sclL[u.aux * 256 + rl];
                f32x4 o0, o1;
#pragma unroll
                for (int j = 0; j < 4; ++j) { const float g0 = acc[ai][0][m][0][j] * sc, g1 = acc[ai][0][m][1][j] * sc;
                    o0[j] = g0 * fsigmoid(g0) * (acc[ai][1][m][0][j] * sc); o1[j] = g1 * fsigmoid(g1) * (acc[ai][1][m][1][j] * sc); }
                *(v4u*)(ACT + (size_t)(u.pm * 256 + rl) * DEXP + u.pn * 128 + wc * 32 + 8 * fq) = pack8(o0, o1); }
    }
};
struct EpiDown {
    static constexpr bool PERM = true, ACC_INIT = false;
    bf16* YS; const LAS float* sclL;
    __device__ __forceinline__ void operator()(const f32x4 (&acc)[2][2][4][2], const Unit& u, int wr, int wc, int fr, int fq) const {
#pragma unroll
        for (int ai = 0; ai < 2; ++ai)
#pragma unroll
            for (int m = 0; m < 4; ++m) { const int rl = ai * 128 + wr * 64 + m * 16 + fr; const float sc = sclL[u.aux * 256 + rl];
#pragma unroll
                for (int bj = 0; bj < 2; ++bj)
                    *(v4u*)(YS + (size_t)(u.pm * 256 + rl) * 1024 + u.pn * 256 + bj * 128 + wc * 32 + 8 * fq) = pack8(acc[ai][bj][m][0] * sc, acc[ai][bj][m][1] * sc); }
    }
};

struct TItem { const float* W; int N; bf16* WT; int ldk, k0, n0, drow0; };
__device__ __forceinline__ void transpose_load(const TItem& it, f32x4 (&tv)[8], int lane) {
#pragma unroll
    for (int i = 0; i < 8; ++i) tv[i] = __builtin_nontemporal_load((const f32x4*)(it.W + (size_t)(it.k0 + 8 * i + (lane >> 3)) * it.N + it.n0 + 4 * (lane & 7)));
}
__device__ __forceinline__ void transpose_store(const TItem& it, const f32x4 (&tv)[8], LAS float* scr, int lane) {
#pragma unroll
    for (int i = 0; i < 8; ++i) { LAS float* d = scr + (8 * i + (lane >> 3)) * 33 + 4 * (lane & 7); d[0] = tv[i].x; d[1] = tv[i].y; d[2] = tv[i].z; d[3] = tv[i].w; }
    LDS_WAIT(); asm volatile("" ::: "memory");
    const int c = lane & 7;
#pragma unroll
    for (int j = 0; j < 4; ++j) { const int n = (lane >> 3) + 8 * j; const LAS float* s = scr + (8 * c) * 33 + n;
        v4u o; o.x = pk2(s[0 * 33], s[1 * 33]); o.y = pk2(s[2 * 33], s[3 * 33]); o.z = pk2(s[4 * 33], s[5 * 33]); o.w = pk2(s[6 * 33], s[7 * 33]);
        *(v4u*)(it.WT + (size_t)(it.drow0 + n) * it.ldk + it.k0 + 8 * c) = o; }
    LDS_WAIT(); asm volatile("" ::: "memory");
}
__device__ __forceinline__ int ileave_row(int n, int half) { return 256 * (n >> 7) + 128 * half + (n & 127); }

template <int NR> __device__ __forceinline__ void rms_rows_to_bf16(const float* x0, const float* gain, bf16* o0, size_t rstride, int lane) {
    f32x4 v[NR][4];
#pragma unroll
    for (int r = 0; r < NR; ++r) { const f32x4* xr = (const f32x4*)(x0 + r * rstride) + lane;
#pragma unroll
        for (int j = 0; j < 4; ++j) v[r][j] = __builtin_nontemporal_load(xr + 64 * j); }
    asm volatile("" ::: "memory");
    const f32x4* gr = (const f32x4*)gain + lane;
    f32x4 g[4];
#pragma unroll
    for (int j = 0; j < 4; ++j) g[j] = gr[64 * j];
#pragma unroll
    for (int r = 0; r < NR; ++r) { float s = 0.f;
#pragma unroll
        for (int j = 0; j < 4; ++j) s += (v[r][j].x * v[r][j].x + v[r][j].y * v[r][j].y) + (v[r][j].z * v[r][j].z + v[r][j].w * v[r][j].w);
        const float rstd = 1.0f / sqrtf(wave_sum(s) * (1.f / D) + RMS_EPS);
        unsigned long long* o8 = (unsigned long long*)(o0 + r * rstride) + lane;
#pragma unroll
        for (int j = 0; j < 4; ++j) o8[64 * j] = (unsigned long long)pk2(v[r][j].x * rstd * g[j].x, v[r][j].y * rstd * g[j].y) | ((unsigned long long)pk2(v[r][j].z * rstd * g[j].z, v[r][j].w * rstd * g[j].w) << 32); }
}

__device__ __forceinline__ void s5_tables(const Frame& F, int g, const float* lam_re, const float* lam_im, const float* log_dt, const float* b_re, const float* b_im, const float* c_re, const float* c_im, const float* dsk) {
    LAS float* Cre = (LAS float*)F.lds;
    LAS float* Cim = Cre + 1024;
    LAS float* Bre = Cim + 1024;
    LAS float* Bim = Bre + 1024;
    LAS float* Pre = Bim + 1024;
    LAS float* Pim = Pre + 17 * 64;
    LAS float* Kt = Pim + 17 * 64;
    const int tid = F.tid;
    for (int i = tid; i < 1024; i += 512) { Cre[i] = c_re[g * 1024 + i]; Cim[i] = c_im[g * 1024 + i]; }
    if (tid < 64) {
        const int p = tid; const float lr = lam_re[g * 64 + p], li = lam_im[g * 64 + p], dt = expf(log_dt[g]);
        const float er = expf(lr * dt), lbr = er * cosf(li * dt), lbi = er * sinf(li * dt);
        const float den = lr * lr + li * li, nr = lbr - 1.0f, ni = lbi;
        const float cr = (nr * lr + ni * li) / den, ci = (ni * lr - nr * li) / den;
        { float pr = 1.f, pi = 0.f; for (int k = 0; k <= 16; ++k) { Pre[k * 64 + p] = pr; Pim[k * 64 + p] = pi; const float nr2 = pr * lbr - pi * lbi, ni2 = pr * lbi + pi * lbr; pr = nr2; pi = ni2; } }
        for (int c = 0; c < 16; ++c) { const float br = b_re[(g * 64 + p) * 16 + c], bi = b_im[(g * 64 + p) * 16 + c]; Bre[p * 16 + c] = cr * br - ci * bi; Bim[p * 16 + c] = cr * bi + ci * br; }
    }
    __syncthreads();
    for (int e = tid; e < 4096; e += 512) {
        const int k = e >> 8, c = (e >> 4) & 15, cp = e & 15; float s = 0.f;
        for (int p = 0; p < 64; ++p) { const float xr = Cre[c * 64 + p] * Pre[k * 64 + p] - Cim[c * 64 + p] * Pim[k * 64 + p], xi = Cre[c * 64 + p] * Pim[k * 64 + p] + Cim[c * 64 + p] * Pre[k * 64 + p];
            s += xr * Bre[p * 16 + cp] - xi * Bim[p * 16 + cp]; }
        if (k == 0 && c == cp) s += dsk[g * 16 + c];
        Kt[e] = s;
    }
    __syncthreads();
    unsigned* btt = (unsigned*)(F.ws + WS_BTT) + (size_t)g * 256 * (S5K / 2);
    for (int e = tid; e < 256 * (S5K / 2); e += 512) {
        const int row = e / (S5K / 2), cpair = e % (S5K / 2), t = row >> 4, c = row & 15, col = 2 * cpair; float v0, v1;
        if (col < S5Q) { const int p = col >> 1; const float xr = Cre[c * 64 + p] * Pre[(t + 1) * 64 + p] - Cim[c * 64 + p] * Pim[(t + 1) * 64 + p], xi = Cre[c * 64 + p] * Pim[(t + 1) * 64 + p] + Cim[c * 64 + p] * Pre[(t + 1) * 64 + p];
            v0 = xr; v1 = -xi; }
        else { const int s = (col - S5Q) >> 4, cp = (col - S5Q) & 15;
            if (s <= t) { v0 = Kt[(t - s) * 256 + c * 16 + cp]; v1 = Kt[(t - s) * 256 + c * 16 + cp + 1]; } else { v0 = 0.f; v1 = 0.f; } }
        btt[e] = pk2(v0, v1);
    }
    unsigned* btw = (unsigned*)(F.ws + WS_BTW) + (size_t)g * 128 * 128;
    for (int e = tid; e < 128 * 128; e += 512) {
        const int q = e >> 7, cpair = e & 127, col = 2 * cpair, s = col >> 4, cp = col & 15, p = q >> 1, k = 15 - s;
        const float pr = Pre[k * 64 + p], pi = Pim[k * 64 + p];
        float v0, v1;
        if (q & 1) { v0 = pr * Bim[p * 16 + cp] + pi * Bre[p * 16 + cp]; v1 = pr * Bim[p * 16 + cp + 1] + pi * Bre[p * 16 + cp + 1]; }
        else { v0 = pr * Bre[p * 16 + cp] - pi * Bim[p * 16 + cp]; v1 = pr * Bre[p * 16 + cp + 1] - pi * Bim[p * 16 + cp + 1]; }
        btw[e] = pk2(v0, v1);
    }
    if (tid < 64) { float* l16 = (float*)(F.ws + SM_LAM16) + (g * 64 + tid) * 2; l16[0] = Pre[16 * 64 + tid]; l16[1] = Pim[16 * 64 + tid]; }
    __syncthreads();
}

struct In { const float* p[30]; };

__device__ __forceinline__ void p0_prologue(const Frame& F, const In& I) {
    for (int g = F.vcu; g < S5G; g += F.G) s5_tables(F, g, I.p[3], I.p[4], I.p[5], I.p[6], I.p[7], I.p[8], I.p[9], I.p[10]);
    const int gt = F.vcu * 512 + F.tid, NGT = F.G * 512;
    { float* lc = (float*)(F.ws + SM_LRUC); for (int i = gt; i < LRUW; i += NGT) { const float lam = I.p[18][i]; lc[i] = -8.0f * log1pf(expf(-lam)) * 1.44269504f; } }
    { bf16* wrt = (bf16*)(F.ws + SM_WRT);
        for (int i = gt; i < 2 * 65536; i += NGT) { const int which = i >> 16, r = i & 65535, h = r >> 12, j = (r >> 6) & 63, k = r & 63; const float* src = which ? I.p[16] : I.p[14]; wrt[i] = (bf16)f2bf(src[(h * 64 + k) * 64 + j]); } }
    { bf16* rhi = (bf16*)(F.ws + SM_RHI); bf16* rlo = (bf16*)(F.ws + SM_RLO);
        for (int i = gt; i < NROUT * 1024; i += NGT) { const int n = i >> 10, k = i & 1023; float w = 0.f; if (n < 4) w = I.p[22][k * 4 + n]; else if (n < 36) w = I.p[24][k * 32 + (n - 4)];
            const unsigned h = f2bf(w); rhi[i] = (bf16)h; rlo[i] = (bf16)f2bf(w - bf2f(h)); } }
    LAS float* scr = (LAS float*)(F.lds + F.wave * 16384);
    const int gw = F.vcu * NWAVES + F.wave, NGW = F.G * NWAVES;
    constexpr int I_IN = (D / 64) * (NIN / 32), I_S5 = (S5W / 64) * (2 * D / 32), I_LRU = (D / 64) * (D / 32), I_O = I_LRU;
    constexpr int NITEMS = I_IN + I_S5 + I_LRU + I_O;
    for (int it = gw; it < NITEMS; it += NGW) {
        int r = it; TItem ti;
        if (r < I_IN) { const int nb = NIN / 32, kb = r / nb, n0 = 32 * (r % nb); ti = TItem{I.p[2], NIN, (bf16*)(F.ws + WS_WIN), D, 64 * kb, n0, n0}; }
        else if ((r -= I_IN) < I_S5) { const int nb = 2 * D / 32, kb = r / nb, n0 = 32 * (r % nb); ti = TItem{I.p[11], 2 * D, (bf16*)(F.ws + WS_WS5), S5W, 64 * kb, n0, n0 < D ? ileave_row(n0, 0) : ileave_row(n0 - D, 1)}; }
        else if ((r -= I_S5) < I_LRU) { const int nb = D / 32, kb = r / nb, n0 = 32 * (r % nb); ti = TItem{I.p[19], D, (bf16*)(F.ws + WS_WLRU), D, 64 * kb, n0, n0}; }
        else { r -= I_LRU; const int nb = D / 32, kb = r / nb, n0 = 32 * (r % nb); ti = TItem{I.p[20], D, (bf16*)(F.ws + WS_WO), D, 64 * kb, n0, n0}; }
        f32x4 tv[8]; transpose_load(ti, tv, F.lane); asm volatile("" ::: "memory"); transpose_store(ti, tv, scr, F.lane);
    }
    { const int skip = F.G > 2 * S5G ? S5G : 0;
      if (F.vcu >= skip) { const int gw2 = (F.vcu - skip) * NWAVES + F.wave, NGW2 = (F.G - skip) * NWAVES;
        for (int m = gw2 * 4; m < T; m += NGW2 * 4) rms_rows_to_bf16<4>(I.p[0] + (size_t)m * D, I.p[1], (bf16*)(F.ws + WS_H) + (size_t)m * D, D, F.lane); } }
}
__device__ __forceinline__ TItem expert_item(const Frame& F, const In& I, int it) {
    constexpr int I_G = (D / 64) * (DEXP / 32), I_D = (DEXP / 64) * (D / 32);
    const int e = it / (2 * I_G + I_D); int r = it % (2 * I_G + I_D);
    if (r < 2 * I_G) { const int half = r / I_G; r %= I_G; const int nb = DEXP / 32, kb = r / nb, n0 = 32 * (r % nb);
        return TItem{(half ? I.p[27] : I.p[26]) + (size_t)e * D * DEXP, DEXP, (bf16*)(F.ws + WS_WGU) + (size_t)e * 1024 * 1024, D, 64 * kb, n0, ileave_row(n0, half)}; }
    r -= 2 * I_G; const int nb = D / 32, kb = r / nb, n0 = 32 * (r % nb);
    return TItem{I.p[28] + (size_t)e * DEXP * D, D, (bf16*)(F.ws + WS_WD) + (size_t)e * 1024 * DEXP, DEXP, 64 * kb, n0, n0};
}
__device__ __forceinline__ void expert_weight_copies(const Frame& F, const In& I) {
    LAS float* scr = (LAS float*)(F.lds + F.wave * 16384);
    const int gw = F.vcu * NWAVES + F.wave, NGW = F.G * NWAVES;
    constexpr int NIT = NEXP * 768;
    const int first = 8 * NGW < NIT ? 8 * NGW : NIT;
    for (int it = first + gw; it < NIT; it += 2 * NGW) {
        const TItem t0 = expert_item(F, I, it); const bool has1 = it + NGW < NIT; const TItem t1 = expert_item(F, I, has1 ? it + NGW : it);
        f32x4 v0[8], v1[8]; transpose_load(t0, v0, F.lane); transpose_load(t1, v1, F.lane); asm volatile("" ::: "memory");
        transpose_store(t0, v0, scr, F.lane); if (has1) transpose_store(t1, v1, scr, F.lane);
    }
}

__device__ __forceinline__ void lru_seq(const Frame& F, const In& I) {
    LAS unsigned char* wl = F.lds + F.wave * 17920;
    LAS bf16* xcA = (LAS bf16*)wl;
    LAS float* pre = (LAS float*)(wl + 9216);
    typedef float f32x2 __attribute__((ext_vector_type(2)));
    LAS f32x2* sumT = (LAS f32x2*)(F.lds + 143360);
    const int lane = F.lane, jj = lane & 15, ks = lane >> 4, c32 = lane & 31, th = lane >> 5;
    const bf16* XL = (const bf16*)(F.ws + WS_XL); const bf16* GL = (const bf16*)(F.ws + WS_GL); bf16* YL = (bf16*)(F.ws + WS_H);
    const bf16* WRT = (const bf16*)(F.ws + SM_WRT);
    for (int un = F.vcu; un < BATCH * LRUH * 2; un += F.G) {
        const int b = un >> 5, hd = (un >> 1) & 15, half = un & 1;
        const int chin = hd * 64 + lane;
        const int chg = hd * 64 + 32 * half + c32;
        const float w0 = I.p[12][chin], w1 = I.p[12][1024 + chin], w2 = I.p[12][2048 + chin], w3 = I.p[12][3072 + chin], cb = I.p[13][chin];
        const float brs = I.p[15][chg] * -1.44269504f, bis = I.p[17][chg] * -1.44269504f, cch2 = ((const float*)(F.ws + SM_LRUC))[chg];
        bf16x8 Bw[4][2];
#pragma unroll
        for (int n = 0; n < 4; ++n)
#pragma unroll
            for (int k = 0; k < 2; ++k) Bw[n][k] = *(const bf16x8*)(WRT + (size_t)(n >> 1) * 65536 + (size_t)(hd * 64 + 32 * half + 16 * (n & 1) + jj) * 64 + 32 * k + 8 * ks);
        float Rc = 0.f;
        for (int rd = 0; rd < 8; ++rd) {
            const int j = rd * 8 + F.wave;
            const size_t tok0 = (size_t)b * SEQ + (size_t)j * LRUCH;
            unsigned short xr[64], xh[3];
            { const bf16* xp = XL + tok0 * 1024 + chin;
              xh[0] = 0; xh[1] = 0; xh[2] = 0;
              if (j > 0) { xh[0] = xp[-3 * 1024]; xh[1] = xp[-2 * 1024]; xh[2] = xp[-1 * 1024]; }
#pragma unroll
              for (int t = 0; t < 64; ++t) xr[t] = xp[t * 1024]; }
            asm volatile("" ::: "memory");
            { typedef float f2v __attribute__((ext_vector_type(2)));
              float xm3 = bf2f(xh[0]), xm2 = bf2f(xh[1]), xm1 = bf2f(xh[2]);
              const f2v vw0 = {w0, w0}, vw1 = {w1, w1}, vw2 = {w2, w2}, vw3 = {w3, w3}, vcb = {cb, cb};
#pragma unroll
              for (int t = 0; t < 64; t += 2) { const float x0 = bf2f(xr[t]), x1 = bf2f(xr[t + 1]);
                  f2v xc = vcb + vw0 * (f2v){xm3, xm2}; xc = xc + vw1 * (f2v){xm2, xm1}; xc = xc + vw2 * (f2v){xm1, x0}; xc = xc + vw3 * (f2v){x0, x1};
                  const unsigned pk = pg8::cvt_pk_bf16(xc.x, xc.y);
                  xcA[t * 72 + lane] = (bf16)(pk & 0xffffu); xcA[(t + 1) * 72 + lane] = (bf16)(pk >> 16);
                  xm3 = xm1; xm2 = x0; xm1 = x1; } }
            LDS_WAIT();
            float hl[2][16], Pl[2][16], Prun[2], Hrun[2];
#pragma unroll
            for (int st = 0; st < 2; ++st) {
#pragma unroll
                for (int mh = 0; mh < 2; ++mh) { const int mt = 2 * st + mh;
                    bf16x8 a[2];
#pragma unroll
                    for (int k = 0; k < 2; ++k) a[k] = *(const LAS bf16x8*)(xcA + (16 * mt + jj) * 72 + 32 * k + 8 * ks);
#pragma unroll
                    for (int n = 0; n < 4; ++n) { f32x4 d = (f32x4){0.f, 0.f, 0.f, 0.f};
#pragma unroll
                        for (int k = 0; k < 2; ++k) d = __builtin_amdgcn_mfma_f32_16x16x32_bf16(a[k], Bw[n][k], d, 0, 0, 0);
#pragma unroll
                        for (int r = 0; r < 4; ++r) pre[(16 * mh + 4 * ks + r) * 68 + 16 * n + jj] = d[r]; } }
                LDS_WAIT();
                float h = 0.f, P = 1.f;
                typedef float f2v __attribute__((ext_vector_type(2)));
#pragma unroll
                for (int tl = 0; tl < 16; tl += 2) {
                    const int trow = 16 * th + tl;
                    const f2v pr = {pre[trow * 68 + c32], pre[(trow + 1) * 68 + c32]}, pi = {pre[trow * 68 + 32 + c32], pre[(trow + 1) * 68 + 32 + c32]};
                    const f2v zr = pr * (f2v){-1.44269504f, -1.44269504f} + (f2v){brs, brs}, zi = pi * (f2v){-1.44269504f, -1.44269504f} + (f2v){bis, bis};
                    const f2v er = {__builtin_amdgcn_exp2f(zr.x), __builtin_amdgcn_exp2f(zr.y)}, ei = {__builtin_amdgcn_exp2f(zi.x), __builtin_amdgcn_exp2f(zi.y)};
                    const f2v dr = er + (f2v){1.f, 1.f};
                    const f2v rg = {__builtin_amdgcn_rcpf(dr.x), __builtin_amdgcn_rcpf(dr.y)};
                    const f2v la2 = rg * (f2v){cch2, cch2};
                    const f2v a_ = {__builtin_amdgcn_exp2f(la2.x), __builtin_amdgcn_exp2f(la2.y)};
                    const f2v x2 = la2 * (f2v){1.38629436f, 1.38629436f};
                    f2v q = x2 * (f2v){0.0013888889f, 0.0013888889f} + (f2v){0.0083333333f, 0.0083333333f};
                    q = q * x2 + (f2v){0.041666667f, 0.041666667f}; q = q * x2 + (f2v){0.16666667f, 0.16666667f}; q = q * x2 + (f2v){0.5f, 0.5f}; q = q * x2 + (f2v){1.f, 1.f};
                    f2v om = -(q * x2);
                    const f2v alt = (f2v){1.f, 1.f} - a_ * a_;
                    om.x = x2.x > -0.3f ? om.x : alt.x; om.y = x2.y > -0.3f ? om.y : alt.y;
                    om.x = fmaxf(om.x, 1e-30f); om.y = fmaxf(om.y, 1e-30f);
                    const f2v dd = ei + (f2v){1.f, 1.f};
                    const f2v rq = om * dd * dd;
                    const f2v mi = om * (f2v){__builtin_amdgcn_rsqf(rq.x), __builtin_amdgcn_rsqf(rq.y)};
                    const f2v bx = mi * (f2v){bf2f(xcA[(32 * st + trow) * 72 + 32 * half + c32]), bf2f(xcA[(32 * st + trow + 1) * 72 + 32 * half + c32])};
                    h = a_.x * h + bx.x; P *= a_.x; hl[st][tl] = h; Pl[st][tl] = P;
                    h = a_.y * h + bx.y; P *= a_.y; hl[st][tl + 1] = h; Pl[st][tl + 1] = P;
                }
                Prun[st] = P; Hrun[st] = h;
                LDS_WAIT();
            }
            const float pP0 = __shfl_xor(Prun[0], 32), pH0 = __shfl_xor(Hrun[0], 32), pP1 = __shfl_xor(Prun[1], 32), pH1 = __shfl_xor(Hrun[1], 32);
            const float P0 = th ? pP0 : Prun[0], H0 = th ? pH0 : Hrun[0], P1 = th ? Prun[0] : pP0, H1 = th ? Hrun[0] : pH0;
            const float P2 = th ? pP1 : Prun[1], H2 = th ? pH1 : Hrun[1], P3 = th ? Prun[1] : pP1, H3 = th ? Hrun[1] : pH1;
            const float C1 = H0, Q1 = P0, C2 = P1 * C1 + H1, Q2 = P1 * Q1, C3 = P2 * C2 + H2, Q3 = P2 * Q2, Hc = P3 * C3 + H3, Pc = P3 * Q3;
            const float Cs0 = th ? C1 : 0.f, Qs0 = th ? Q1 : 1.f, Cs1 = th ? C3 : C2, Qs1 = th ? Q3 : Q2;
            const int cit = (rd * F.G + F.vcu) * NWAVES + F.wave; const bool cdo = cit < NEXP * 768;
            f32x4 ctv[8]; unsigned short ggr[2][16];
            if (cdo) { const TItem citem = expert_item(F, I, cit); transpose_load(citem, ctv, lane); }
#pragma unroll
            for (int st = 0; st < 2; ++st)
#pragma unroll
                for (int tl = 0; tl < 16; ++tl) ggr[st][tl] = GL[(tok0 + 32 * st + 16 * th + tl) * 1024 + chg];
            asm volatile("" ::: "memory");
            if (th == 0) sumT[((rd & 1) * 8 + F.wave) * 32 + c32] = (f32x2){Pc, Hc};
            LDS_WAIT();
            __syncthreads();
            float cin = Rc, mycin = 0.f;
#pragma unroll
            for (int w = 0; w < 8; ++w) { const f32x2 ph = sumT[((rd & 1) * 8 + w) * 32 + c32]; mycin = (w == F.wave) ? cin : mycin; cin = ph.x * cin + ph.y; }
            Rc = cin;
#pragma unroll
            for (int st = 0; st < 2; ++st) { const float hin = (st ? Cs1 : Cs0) + (st ? Qs1 : Qs0) * mycin;
#pragma unroll
                for (int tl = 0; tl < 16; ++tl) { const float hh = hl[st][tl] + Pl[st][tl] * hin;
                    YL[(tok0 + 32 * st + 16 * th + tl) * 1024 + chg] = (bf16)f2bf(hh * bf2f(ggr[st][tl])); } }
            if (cdo) { const TItem citem = expert_item(F, I, cit); transpose_store(citem, ctv, pre, lane); }
        }
        __syncthreads();
    }
}

__device__ __forceinline__ void s5_chain(const Frame& F, int b, int g) {
    typedef float f32x2 __attribute__((ext_vector_type(2)));
    LAS f32x2* segE = (LAS f32x2*)(F.lds);
    const int lane = F.lane, w = F.wave;
    const float* SLOC = (const float*)(F.ws + WS_SLOC); unsigned* AGw = (unsigned*)(F.ws + WS_AG); const float* L16 = (const float*)(F.ws + SM_LAM16);
    const float lr = L16[(g * 64 + lane) * 2], li = L16[(g * 64 + lane) * 2 + 1];
    const float* sl = SLOC + ((size_t)(g * S5N + b * S5NCH + 32 * w)) * S5Q + 2 * lane;
    unsigned* ag = AGw + ((size_t)(g * S5N + b * S5NCH + 32 * w)) * (S5K / 2) + lane;
    float xr[32], xi[32];
#pragma unroll
    for (int u = 0; u < 32; ++u) { const float2 v = *(const float2*)(sl + (size_t)u * S5Q); xr[u] = v.x; xi[u] = v.y; }
    asm volatile("" ::: "memory");
    float sr = 0.f, si = 0.f;
#pragma unroll
    for (int u = 0; u < 32; ++u) { const float nr = lr * sr - li * si + xr[u], ni = lr * si + li * sr + xi[u]; xr[u] = sr; xi[u] = si; sr = nr; si = ni; }
    segE[w * 64 + lane] = (f32x2){sr, si};
    float qr = lr, qi = li;
#pragma unroll
    for (int k = 0; k < 5; ++k) { const float nr = qr * qr - qi * qi, ni = 2.f * qr * qi; qr = nr; qi = ni; }
    LDS_WAIT();
    __syncthreads();
    float cr = 0.f, ci = 0.f;
    for (int ww = 0; ww < w; ++ww) { const f32x2 e = segE[ww * 64 + lane]; const float nr = qr * cr - qi * ci + e.x, ni = qr * ci + qi * cr + e.y; cr = nr; ci = ni; }
#pragma unroll
    for (int u = 0; u < 32; ++u) { ag[(size_t)u * (S5K / 2)] = pk2(xr[u] + cr, xi[u] + ci); const float nr = lr * cr - li * ci, ni = lr * ci + li * cr; cr = nr; ci = ni; }
    __syncthreads();
}

__device__ __forceinline__ void p8_router(const Frame& F, const In& I) {
    const int lane = F.lane, tk = lane & 15, ks = lane >> 4;
    LAS float* lg = (LAS float*)(F.lds + F.wave * 4096);
    volatile LAS unsigned* cntL = F.MISC + 32; volatile LAS unsigned* baseL = F.MISC + 64;
    const float* X1 = F.out; bf16* H2 = (bf16*)(F.ws + WS_H2); const float* gf = I.p[21];
    const bf16* RHI = (const bf16*)(F.ws + SM_RHI); const bf16* RLO = (const bf16*)(F.ws + SM_RLO);
    float* RSTD = (float*)(F.ws + SM_RSTD); unsigned* gcnt = F.ctl + CW_CNT;
    int* LTOK = (int*)(F.ws + WS_LTOK); float* LW = (float*)(F.ws + WS_LW); int* TOKE = (int*)(F.ws + WS_TOKE); int* TOKR = (int*)(F.ws + WS_TOKR);
    for (int blk = F.vcu; blk < T / 128; blk += F.G) {
        if (F.tid < 32) cntL[F.tid] = 0u;
        __syncthreads();
        const int tok0 = blk * 128 + F.wave * 16;
        const float* xrow = X1 + (size_t)(tok0 + tk) * D + 8 * ks; bf16* hrow = H2 + (size_t)(tok0 + tk) * D + 8 * ks;
        f32x4 acc[3]; acc[0] = acc[1] = acc[2] = (f32x4){0.f, 0.f, 0.f, 0.f}; float ss = 0.f;
        f32x4 xnx[4][2];
#pragma unroll
        for (int q = 0; q < 4; ++q) { xnx[q][0] = __builtin_nontemporal_load((const f32x4*)(xrow + 32 * q)); xnx[q][1] = __builtin_nontemporal_load((const f32x4*)(xrow + 32 * q + 4)); }
        LAS bf16* slab = (LAS bf16*)(F.lds + 32768);
        v4u wst[3];
#define RT_SLAB_LOAD(g) do { _Pragma("unroll") for (int j = 0; j < 3; ++j) { const int c = F.tid + 512 * j, which = c / 768, r = (c % 768) >> 4, kq = c & 15; \
            wst[j] = *(const v4u*)((which ? RLO : RHI) + (size_t)r * D + 128 * (g) + 8 * kq); } } while (0)
#define RT_SLAB_STORE(buf) do { _Pragma("unroll") for (int j = 0; j < 3; ++j) { const int c = F.tid + 512 * j, which = c / 768, r = (c % 768) >> 4, kq = c & 15; \
            *(LAS v4u*)(slab + ((size_t)((buf) * 2 + which) * 48 + r) * 136 + 8 * kq) = wst[j]; } } while (0)
        RT_SLAB_LOAD(0); RT_SLAB_STORE(0);
        LDS_WAIT();
        __syncthreads();
        for (int kg = 0; kg < 8; ++kg) {
            f32x4 xa[4][2];
#pragma unroll
            for (int q = 0; q < 4; ++q) { xa[q][0] = xnx[q][0]; xa[q][1] = xnx[q][1]; }
            { const int kgn = kg < 7 ? kg + 1 : kg;
#pragma unroll
              for (int q = 0; q < 4; ++q) { xnx[q][0] = __builtin_nontemporal_load((const f32x4*)(xrow + 32 * (4 * kgn + q))); xnx[q][1] = __builtin_nontemporal_load((const f32x4*)(xrow + 32 * (4 * kgn + q) + 4)); }
              RT_SLAB_LOAD(kgn); }
            f32x4 ga[4][2];
#pragma unroll
            for (int q = 0; q < 4; ++q) { const int kc = 4 * kg + q; ga[q][0] = *(const f32x4*)(gf + 32 * kc + 8 * ks); ga[q][1] = *(const f32x4*)(gf + 32 * kc + 8 * ks + 4); }
            asm volatile("" ::: "memory");
            const LAS bf16* sh = slab + (size_t)((kg & 1) * 2) * 48 * 136, * sl = sh + 48 * 136;
#pragma unroll
            for (int q = 0; q < 4; ++q) { const int kc = 4 * kg + q;
                const f32x4 a0 = xa[q][0], a1 = xa[q][1];
                ss += (a0.x * a0.x + a0.y * a0.y) + (a0.z * a0.z + a0.w * a0.w) + (a1.x * a1.x + a1.y * a1.y) + (a1.z * a1.z + a1.w * a1.w);
                const f32x4 v0 = a0 * ga[q][0], v1 = a1 * ga[q][1];
                v4u hi, lo;
                { const unsigned h0 = f2bf(v0.x), h1 = f2bf(v0.y), h2 = f2bf(v0.z), h3 = f2bf(v0.w), h4 = f2bf(v1.x), h5 = f2bf(v1.y), h6 = f2bf(v1.z), h7 = f2bf(v1.w);
                  hi.x = h0 | (h1 << 16); hi.y = h2 | (h3 << 16); hi.z = h4 | (h5 << 16); hi.w = h6 | (h7 << 16);
                  lo.x = pk2(v0.x - bf2f(h0), v0.y - bf2f(h1)); lo.y = pk2(v0.z - bf2f(h2), v0.w - bf2f(h3)); lo.z = pk2(v1.x - bf2f(h4), v1.y - bf2f(h5)); lo.w = pk2(v1.z - bf2f(h6), v1.w - bf2f(h7)); }
                *(v4u*)(hrow + 32 * kc) = hi;
                const bf16x8 hf = __builtin_bit_cast(bf16x8, hi), lf = __builtin_bit_cast(bf16x8, lo);
#pragma unroll
                for (int n = 0; n < 3; ++n) {
                    const bf16x8 wh = *(const LAS bf16x8*)(sh + (16 * n + tk) * 136 + 32 * q + 8 * ks), wl = *(const LAS bf16x8*)(sl + (16 * n + tk) * 136 + 32 * q + 8 * ks);
                    acc[n] = __builtin_amdgcn_mfma_f32_16x16x32_bf16(wh, hf, acc[n], 0, 0, 0);
                    acc[n] = __builtin_amdgcn_mfma_f32_16x16x32_bf16(wh, lf, acc[n], 0, 0, 0);
                    acc[n] = __builtin_amdgcn_mfma_f32_16x16x32_bf16(wl, hf, acc[n], 0, 0, 0);
                } }
            if (kg < 7) RT_SLAB_STORE((kg + 1) & 1);
            LDS_WAIT();
            __syncthreads();
        }
#undef RT_SLAB_LOAD
#undef RT_SLAB_STORE
        ss += __shfl_xor(ss, 16); ss += __shfl_xor(ss, 32);
        const float rstd = 1.0f / sqrtf(ss * (1.f / D) + RMS_EPS);
        if (ks == 0) RSTD[tok0 + tk] = rstd;
#pragma unroll
        for (int n = 0; n < 3; ++n)
#pragma unroll
            for (int r = 0; r < 4; ++r) lg[tk * 49 + 16 * n + 4 * ks + r] = acc[n][r] * rstd;
        LDS_WAIT();
        int E1 = 0, E2 = 0; float w1 = 0.f, w2 = 0.f; unsigned r1 = 0, r2 = 0;
        if (lane < 16) {
            const LAS float* my = lg + lane * 49;
            float lgp[4];
#pragma unroll
            for (int i = 0; i < 4; ++i) lgp[i] = my[i] + I.p[23][i];
            int gi = 0; float mx = lgp[0];
#pragma unroll
            for (int i = 1; i < 4; ++i) if (lgp[i] > mx) { mx = lgp[i]; gi = i; }
            float den = 0.f;
#pragma unroll
            for (int i = 0; i < 4; ++i) den += expf(lgp[i] - mx);
            const float pg = 1.0f / den;
            float le[8];
#pragma unroll
            for (int i = 0; i < 8; ++i) le[i] = my[4 + gi * 8 + i] + I.p[25][gi * 8 + i];
            int i1 = 0; float m1 = le[0];
#pragma unroll
            for (int i = 1; i < 8; ++i) if (le[i] > m1) { m1 = le[i]; i1 = i; }
            int i2 = -1; float m2 = -3.0e38f;
#pragma unroll
            for (int i = 0; i < 8; ++i) if (i != i1 && le[i] > m2) { m2 = le[i]; i2 = i; }
            const float e2 = expf(m2 - m1);
            w1 = pg / (1.0f + e2); w2 = pg * e2 / (1.0f + e2);
            E1 = gi * 8 + i1; E2 = gi * 8 + i2;
            r1 = __hip_atomic_fetch_add((LAS unsigned*)(F.MISC + 32) + E1, 1u, __ATOMIC_RELAXED, __HIP_MEMORY_SCOPE_WORKGROUP);
            r2 = __hip_atomic_fetch_add((LAS unsigned*)(F.MISC + 32) + E2, 1u, __ATOMIC_RELAXED, __HIP_MEMORY_SCOPE_WORKGROUP);
        }
        LDS_WAIT();
        __syncthreads();
        if (F.tid < 32) { const unsigned c = cntL[F.tid]; baseL[F.tid] = c ? __hip_atomic_fetch_add(gcnt + F.tid, c, __ATOMIC_RELAXED, __HIP_MEMORY_SCOPE_AGENT) : 0u; }
        __syncthreads();
        if (lane < 16) {
            const int tok = tok0 + lane; const int k1 = (int)(baseL[E1] + r1), k2 = (int)(baseL[E2] + r2);
            LTOK[(size_t)E1 * T + k1] = tok; LW[(size_t)E1 * T + k1] = w1; LTOK[(size_t)E2 * T + k2] = tok; LW[(size_t)E2 * T + k2] = w2;
            TOKE[tok * 2] = E1; TOKE[tok * 2 + 1] = E2; TOKR[tok * 2] = k1; TOKR[tok * 2 + 1] = k2;
        }
        __syncthreads();
    }
}

__device__ __forceinline__ void moe_prefix(const Frame& F) {
    if (F.tid < 64) {
        const unsigned nt = F.tid < NEXP ? (F.ctl[CW_CNT + F.tid] + 255u) >> 8 : 0u; unsigned inc = nt;
#pragma unroll
        for (int o = 1; o < 32; o <<= 1) { const unsigned v = __shfl_up(inc, o); if (F.lane >= o) inc += v; }
        if (F.tid < NEXP) F.MISC[96 + F.tid] = inc - nt;
        if (F.tid == NEXP - 1) F.MISC[128] = inc;
    }
    LDS_WAIT();
    __syncthreads();
}
template <int MODE  >
__device__ __forceinline__ void moe_setup(const Frame& F) {
    moe_prefix(F);
    const int NT = (int)F.MISC[128];
    if (F.tid < MAXU) { const int L = F.tid * F.G + F.vcu; int e = -1, mt = 0;
        if (L < NT * 4) { const int mtg = L >> 2; e = 0; while (e < NEXP - 1 && (int)F.MISC[96 + e + 1] <= mtg) ++e; mt = mtg - (int)F.MISC[96 + e]; }
        F.MISC[136 + F.tid] = (unsigned)e; F.MISC[144 + F.tid] = (unsigned)mt; }
    __syncthreads();
    if (F.tid == 0) { int n = 0; while (n < MAXU && (int)F.MISC[136 + n] >= 0) ++n; F.MISC[152] = (unsigned)n; }
    __syncthreads();
    const int nU = (int)F.MISC[152];
    LAS int* tokL = (LAS int*)(F.lds + TOKL_OFF); LAS float* sclL = (LAS float*)(F.lds + SCLL_OFF);
    const int* LTOK = (const int*)(F.ws + WS_LTOK); const float* LW = (const float*)(F.ws + WS_LW); const float* RSTD = (const float*)(F.ws + SM_RSTD);
    for (int i = F.tid; i < nU * 256; i += 512) { const int ui = i >> 8, r = i & 255, e = (int)F.MISC[136 + ui], rank = (int)F.MISC[144 + ui] * 256 + r; const bool valid = rank < (int)F.ctl[CW_CNT + e];
        const int tok = valid ? LTOK[(size_t)e * T + rank] : 0; tokL[i] = tok; sclL[i] = valid ? (MODE == 0 ? RSTD[tok] : LW[(size_t)e * T + rank]) : 0.f; }
    LDS_WAIT(); VM_WAIT();
    __syncthreads();
}

__device__ __forceinline__ void p11_final(const Frame& F, const In& I, float* dst) {
    moe_prefix(F);
    const int gw = F.vcu * NWAVES + F.wave, NGW = F.G * NWAVES, lane = F.lane;
    const int* TOKE = (const int*)(F.ws + WS_TOKE); const int* TOKR = (const int*)(F.ws + WS_TOKR); const bf16* YS = (const bf16*)(F.ws + WS_YS);
    f32x4 gfin[4];
#pragma unroll
    for (int j = 0; j < 4; ++j) gfin[j] = ((const f32x4*)I.p[29])[lane + 64 * j];
    int ee[2][2], rr[2][2];
    { const int m0 = gw * 2 < T ? gw * 2 : 0;
#pragma unroll
      for (int q = 0; q < 2; ++q) { ee[q][0] = TOKE[2 * (m0 + q)]; ee[q][1] = TOKE[2 * (m0 + q) + 1]; rr[q][0] = TOKR[2 * (m0 + q)]; rr[q][1] = TOKR[2 * (m0 + q) + 1]; } }
    for (int m0 = gw * 2; m0 < T; m0 += NGW * 2) {
        f32x4 xv[2][4]; v2u ya[2][4], yb[2][4];
#pragma unroll
        for (int q = 0; q < 2; ++q) { const size_t s0 = (size_t)F.MISC[96 + ee[q][0]] * 256 + rr[q][0], s1 = (size_t)F.MISC[96 + ee[q][1]] * 256 + rr[q][1];
            const f32x4* xr = (const f32x4*)(F.out + (size_t)(m0 + q) * D) + lane; const v2u* y0 = (const v2u*)(YS + s0 * 1024) + lane; const v2u* y1 = (const v2u*)(YS + s1 * 1024) + lane;
#pragma unroll
            for (int j = 0; j < 4; ++j) { xv[q][j] = __builtin_nontemporal_load(xr + 64 * j); ya[q][j] = __builtin_nontemporal_load(y0 + 64 * j); yb[q][j] = __builtin_nontemporal_load(y1 + 64 * j); } }
        { const int mn = m0 + NGW * 2 < T ? m0 + NGW * 2 : m0;
#pragma unroll
          for (int q = 0; q < 2; ++q) { ee[q][0] = TOKE[2 * (mn + q)]; ee[q][1] = TOKE[2 * (mn + q) + 1]; rr[q][0] = TOKR[2 * (mn + q)]; rr[q][1] = TOKR[2 * (mn + q) + 1]; } }
        asm volatile("" ::: "memory");
#pragma unroll
        for (int q = 0; q < 2; ++q) { f32x4 v[4]; float s = 0.f;
#pragma unroll
            for (int j = 0; j < 4; ++j) { const f32x4 x = xv[q][j]; const v2u a = ya[q][j], b = yb[q][j];
                v[j].x = x.x + bflo(a.x) + bflo(b.x); v[j].y = x.y + bfhi(a.x) + bfhi(b.x); v[j].z = x.z + bflo(a.y) + bflo(b.y); v[j].w = x.w + bfhi(a.y) + bfhi(b.y);
                s += (v[j].x * v[j].x + v[j].y * v[j].y) + (v[j].z * v[j].z + v[j].w * v[j].w); }
            const float rstd = 1.0f / sqrtf(wave_sum(s) * (1.f / D) + RMS_EPS);
            f32x4* xw = (f32x4*)(dst + (size_t)(m0 + q) * D) + lane;
#pragma unroll
            for (int j = 0; j < 4; ++j) { const f32x4 g = gfin[j]; __builtin_nontemporal_store((f32x4){v[j].x * rstd * g.x, v[j].y * rstd * g.y, v[j].z * rstd * g.z, v[j].w * rstd * g.w}, xw + 64 * j); } }
    }
}

constexpr int N_PHASES = 12;
struct Args { In in; float* out; unsigned char* ws; float* fin_dst; int ph_lo, ph_hi, li, pad; };
__global__ void __launch_bounds__(NWAVES * 64, 2) mk_fwd(Args args) {
    extern __shared__ __attribute__((aligned(16))) unsigned char lds[];
    Frame F;
    F.lds = (LAS unsigned char*)lds;
    F.MISC = (volatile LAS unsigned*)(F.lds + MISC_OFF);
    F.tid = threadIdx.x; F.lane = F.tid & 63; F.wave = __builtin_amdgcn_readfirstlane(F.tid >> 6);
    F.G = gridDim.x; { const int bx = blockIdx.x; F.vcu = (F.G % 8 == 0) ? (bx % 8) * (F.G / 8) + bx / 8 : bx; }
    F.ws = args.ws; F.out = args.out; F.ctl = (unsigned*)(args.ws + WS_CTL); F.in = nullptr;
    const In& I = args.in;
    for (int u = F.tid; u < 256; u += NWAVES * 64) F.MISC[u] = 0u;
    __syncthreads();
    const int lo = args.ph_lo, hi = args.ph_hi;
    XcdBarrier bar; bar.bar = F.ctl + CW_BAR + args.li * XCD_BAR_WORDS; bar.x = 0; bar.st = nullptr;
    if (hi - lo > 1) bar = xcd_barrier_post(F.ctl + CW_BAR + args.li * XCD_BAR_WORDS, F.MISC + 8);
#ifndef PH_MASK
#define PH_MASK 0xFFF
#endif
#define IN(k) (((PH_MASK >> (k)) & 1) && lo <= (k) && (k) < hi)
#define SEAM(k) do { if (IN(k) && IN(NEXT_PH(k))) xcd_barrier(bar); } while (0)
#define NEXT_PH(k) ((k) == 2 ? 5 : (k) + 1)
    const int cblk = (int)blockIdx.x;
    LAS unsigned char* ring = F.lds;

    if (IN(0)) { p0_prologue(F, I); SEAM(0); }

    if (IN(1)) {
        DenseOrder S; S.init(F.ws + WS_H, F.ws + WS_WIN, D, D, T, NIN, F.G, cblk);
        EpiInProj E{(bf16*)(F.ws + WS_AG), (bf16*)(F.ws + WS_XL), (bf16*)(F.ws + WS_GL), (bf16*)(F.ws + WS_GA), (bf16*)(F.ws + WS_GB)};
        pg8::gemm_phase<EpiInProj, DenseOrder, true>(ring, D, D, S, E);
        SEAM(1);
    }
    if (IN(2)) {
        if (cblk < 256) {
            const int L = cblk, wgid = (L % 8) * 32 + L / 8, g = wgid >> 3, mt = wgid & 7;
            { S5One S{(const char*)(F.ws + WS_AG) + S5Q * 2, (const char*)(F.ws + WS_BTW), (size_t)S5N * S5K * 2, (size_t)128 * 256 * 2, S5K, g, mt};
              EpiS5State E{(float*)(F.ws + WS_SLOC)};
              pg8::gemm_phase<EpiS5State, S5One, false>(ring, 256, 256, S, E); }
            if (F.wave == 0) { __builtin_amdgcn_fence(__ATOMIC_ACQUIRE, "agent"); VM_WAIT(); }
            __syncthreads();
            s5_chain(F, mt, g);
            VM_WAIT();
            __syncthreads();
            if (F.wave == 0) { __builtin_amdgcn_fence(__ATOMIC_ACQUIRE, "agent"); VM_WAIT(); }
            __syncthreads();
            { S5One S{(const char*)(F.ws + WS_AG), (const char*)(F.ws + WS_BTT), (size_t)S5N * S5K * 2, (size_t)256 * S5K * 2, S5K, g, mt};
              EpiS5Out E{(bf16*)(F.ws + WS_GY)};
              pg8::gemm_phase<EpiS5Out, S5One, false>(ring, S5K, S5K, S, E); }
            __syncthreads();
        }
        lru_seq(F, I);
        SEAM(2);
    }
    if (IN(5)) {
        GyOrder S; S.d.init(F.ws + WS_GY, F.ws + WS_WS5, S5W, S5W, T, 2 * D, F.G, cblk);
        EpiYa E{(const bf16*)(F.ws + WS_GA), (bf16*)(F.ws + WS_XL)};
        pg8::gemm_phase<EpiYa, GyOrder, true>(ring, S5W, S5W, S, E, (size_t)4 * T * 32);
        SEAM(5);
    }
    if (IN(6)) {
        DenseOrder S; S.init(F.ws + WS_H, F.ws + WS_WLRU, D, D, T, D, F.G, cblk);
        EpiYb E{(const bf16*)(F.ws + WS_XL), (const bf16*)(F.ws + WS_GB), (bf16*)(F.ws + WS_GL)};
        pg8::gemm_phase<EpiYb, DenseOrder, true>(ring, D, D, S, E);
        SEAM(6);
    }
    if (IN(7)) {
        DenseOrder S; S.init(F.ws + WS_GL, F.ws + WS_WO, D, D, T, D, F.G, cblk);
        EpiWo E{I.p[0], F.out};
        pg8::gemm_phase<EpiWo, DenseOrder, true>(ring, D, D, S, E);
        SEAM(7);
    }
    if (IN(8)) { p8_router(F, I); __syncthreads(); expert_weight_copies(F, I); SEAM(8); }
    if (IN(9)) {
        moe_setup<0>(F);
        MoeOrder<true> S{(const char*)(F.ws + WS_H2), (const char*)(F.ws + WS_WGU), (size_t)1024 * 1024 * 2, D, D, F.G, F.vcu, F.MISC, (const LAS int*)(F.lds + TOKL_OFF)};
        EpiGU E{(bf16*)(F.ws + WS_ACT), (const LAS float*)(F.lds + SCLL_OFF)};
        pg8::gemm_phase<EpiGU, MoeOrder<true>, true>(ring, D, D, S, E);
        SEAM(9);
    }
    if (IN(10)) {
        moe_setup<1>(F);
        MoeOrder<false> S{(const char*)(F.ws + WS_ACT), (const char*)(F.ws + WS_WD), (size_t)1024 * DEXP * 2, DEXP, DEXP, F.G, F.vcu, F.MISC, (const LAS int*)(F.lds + TOKL_OFF)};
        EpiDown E{(bf16*)(F.ws + WS_YS), (const LAS float*)(F.lds + SCLL_OFF)};
        pg8::gemm_phase<EpiDown, MoeOrder<false>, true>(ring, DEXP, DEXP, S, E);
        SEAM(10);
    }
    if (IN(11)) { p11_final(F, I, args.fin_dst); }
#undef IN
#undef SEAM
}

extern "C" void kernel_launch(void* const* d_in, const int* in_sizes, int n_in, void* d_out, int out_size, void* d_ws, size_t ws_size, hipStream_t stream) {
    static int grid = 0;
    if (grid == 0) {
        if (n_in != 30 || in_sizes[0] != T * D || out_size != T * D || ws_size < WS_END) { fprintf(stderr, "kernel_launch: unexpected shapes / workspace (n_in %d, ws %zu)\n", n_in, ws_size); grid = -1; return; }
        int dev = 0, cus = 0, per_cu = 0;
        if (hipGetDevice(&dev) != hipSuccess || hipDeviceGetAttribute(&cus, hipDeviceAttributeMultiprocessorCount, dev) != hipSuccess) { grid = -1; return; }
        if (hipFuncSetAttribute((const void*)mk_fwd, hipFuncAttributeMaxDynamicSharedMemorySize, LDS_BYTES) != hipSuccess) { fprintf(stderr, "kernel_launch: hipFuncSetAttribute failed\n"); grid = -1; return; }
        if (hipOccupancyMaxActiveBlocksPerMultiprocessor(&per_cu, (const void*)mk_fwd, NWAVES * 64, LDS_BYTES) != hipSuccess || per_cu < 1) { fprintf(stderr, "kernel_launch: occupancy query says %d\n", per_cu); }
        (void)hipGetLastError();
        grid = cus;
    }
    if (grid < 0) return;
    if (hipMemsetAsync((char*)d_ws + WS_CTL, 0, CTL_ZERO_BYTES, stream) != hipSuccess) return;
    Args a{};
    for (int i = 0; i < 30; ++i) a.in.p[i] = (const float*)d_in[i];
    a.out = (float*)d_out; a.ws = (unsigned char*)d_ws; a.fin_dst = (float*)d_out;
#if defined(PROBE_LO)
    a.ph_lo = 0; a.ph_hi = PROBE_HI; a.li = 0;
#if PROBE_LO == 11
    a.fin_dst = (float*)((char*)d_ws + WS_H2);
#endif
    hipLaunchKernelGGL(mk_fwd, dim3(grid), dim3(NWAVES * 64), LDS_BYTES, stream, a);
#if PROBE_LO == 8
    hipMemsetAsync((char*)d_ws + WS_CTL + CW_CNT * 4, 0, 128, stream);
#endif
    a.fin_dst = (float*)d_out;
    a.ph_lo = PROBE_LO; a.ph_hi = N_PHASES; a.li = 1;
    hipLaunchKernelGGL(mk_fwd, dim3(grid), dim3(NWAVES * 64), LDS_BYTES, stream, a);
#elif MK_N_LAUNCHES == 1
    a.ph_lo = 0; a.ph_hi = N_PHASES;
    hipLaunchKernelGGL(mk_fwd, dim3(grid), dim3(NWAVES * 64), LDS_BYTES, stream, a);
#else
    for (int p = 0; p < N_PHASES; ++p) { a.ph_lo = p; a.ph_hi = p + 1; hipLaunchKernelGGL(mk_fwd, dim3(grid), dim3(NWAVES * 64), LDS_BYTES, stream, a); }
#endif
}
```

```cpp
#include <hip/hip_runtime.h>
#include <cstdio>
#include <cstdint>

#ifndef MK_N_LAUNCHES
#define MK_N_LAUNCHES 1
#endif

namespace pg8 {
#define PG8_LAS __attribute__((address_space(3)))
typedef unsigned short bf16_t;
typedef short bf16x8 __attribute__((ext_vector_type(8)));
typedef float f32x4 __attribute__((ext_vector_type(4)));
typedef unsigned u32x4 __attribute__((ext_vector_type(4)));
constexpr int BM = 256, BK = 64, HALF = 128, HTB = HALF * BK * 2  , STAGE_BYTES = 8 * HTB, NXCD = 8, WGM = 8;

__host__ __device__ __forceinline__ int lds_byte(int r, int c) { const int st = (r >> 4) * 2 + (c >> 5), rr = r & 15, cc = c & 31, ob = rr * 64 + cc * 2; return st * 1024 + (ob ^ (((ob >> 9) & 1) << 5)); }
__host__ __device__ __forceinline__ void stage_rc(int b, int& R, int& C) { const int st = b / 1024, sb = b % 1024, swz = sb ^ (((sb >> 9) & 1) << 5); R = (st >> 1) * 16 + swz / 64; C = (st & 1) * 32 + (swz % 64) / 2; }
__host__ __device__ __forceinline__ int perm32(int rho) { const int n = rho >> 4, i = rho & 15; return 8 * (i >> 2) + 4 * n + (i & 3); }

struct Unit { const char* A; const char* B; int pm, pn, aux; };

__device__ __forceinline__ unsigned cvt_pk_bf16(float lo, float hi) { unsigned r; asm volatile("v_cvt_pk_bf16_f32 %0, %1, %2" : "=v"(r) : "v"(lo), "v"(hi)); return r; }

template <class Epi, class Sched, bool ALIGN_EPI>
__device__ __forceinline__ void gemm_phase(PG8_LAS unsigned char* lds, const int ldb, const int K, const Sched& S, const Epi& E, const size_t kstepA = (size_t)(BK * 2)) {
    const int tid = threadIdx.x, wid = __builtin_amdgcn_readfirstlane(tid >> 6), lane = tid & 63, wr = wid >> 2, wc = wid & 3, fr = lane & 15, fq = lane >> 4;
    int nt = K / BK; asm volatile("" : "+s"(nt));
    int Rr[2], Cc[2]; unsigned voffB[4], vAc[4], vAn[4];
#pragma unroll
    for (int i = 0; i < 2; ++i) { int R, C; stage_rc(tid * 16 + i * 8192, R, C); Rr[i] = R; Cc[i] = C; const int Rb = Epi::PERM ? ((R & ~31) + perm32(R & 31)) : R;
        voffB[i] = (unsigned)(Rb * ldb + C) * 2u; voffB[2 + i] = (unsigned)((HALF + Rb) * ldb + C) * 2u; }
    const size_t kstep = (size_t)(BK * 2);
    const unsigned ldsw = (unsigned)wid * 1024u;
    const int aoff = lds_byte(wr * 64 + fr, fq * 8), boff = lds_byte(wc * 32 + fr, fq * 8);
#define PG8_SA(b, h) (((b) * 2 + (h)) * HTB)
#define PG8_SB(b, h) ((4 + (b) * 2 + (h)) * HTB)
#define PG8_STAGE(bufoff, gbase, voff, h) do { _Pragma("unroll") for (int _i = 0; _i < 2; ++_i) \
        __builtin_amdgcn_global_load_lds((const unsigned*)((const char*)(gbase) + (voff)[2 * (h) + _i]), (PG8_LAS unsigned*)(lds + (bufoff) + ldsw + _i * 8192), 16, 0, 0); } while (0)
#define PG8_LDA(dst, b, h) do { _Pragma("unroll") for (int m = 0; m < 4; ++m) _Pragma("unroll") for (int k = 0; k < 2; ++k) dst[m][k] = *(const PG8_LAS bf16x8*)(lds + PG8_SA(b, h) + aoff + m * 2048 + k * 1024); } while (0)
#define PG8_LDB(dst, b, h) do { _Pragma("unroll") for (int n = 0; n < 2; ++n) _Pragma("unroll") for (int k = 0; k < 2; ++k) dst[n][k] = *(const PG8_LAS bf16x8*)(lds + PG8_SB(b, h) + boff + n * 2048 + k * 1024); } while (0)
#define PG8_MMA(ai, bj, At, Bt) do { __builtin_amdgcn_s_setprio(1); _Pragma("unroll") for (int m = 0; m < 4; ++m) _Pragma("unroll") for (int n = 0; n < 2; ++n) _Pragma("unroll") for (int k = 0; k < 2; ++k) \
        acc[ai][bj][m][n] = __builtin_amdgcn_mfma_f32_16x16x32_bf16(Bt[n][k], At[m][k], acc[ai][bj][m][n], 0, 0, 0); __builtin_amdgcn_s_setprio(0); } while (0)
#define PG8_WAIT_V(n) asm volatile("s_waitcnt vmcnt(" #n ")" ::: "memory")
#define PG8_WAIT_L(n) asm volatile("s_waitcnt lgkmcnt(" #n ")" ::: "memory")
#define PG8_BAR __builtin_amdgcn_s_barrier()
#define PG8_SCHED __builtin_amdgcn_sched_barrier(0)
    Unit cur, nxt; int ui = 0;
    if (!S.next(0, cur)) return;
    S.a_offsets(cur, Rr, Cc, vAc);
    f32x4 acc[2][2][4][2];
    if constexpr (Epi::ACC_INIT) E.init(acc, cur, wr, wc, fr, fq);
    else {
#pragma unroll
    for (int a = 0; a < 2; ++a)
#pragma unroll
        for (int b = 0; b < 2; ++b)
#pragma unroll
            for (int m = 0; m < 4; ++m)
#pragma unroll
                for (int n = 0; n < 2; ++n) acc[a][b][m][n] = (f32x4){0.f, 0.f, 0.f, 0.f}; }
    bf16x8 At[4][2], B0[2][2], B1[2][2];
    const char* cA = cur.A; const char* cB = cur.B;
    if constexpr (Sched::GATHER) { PG8_WAIT_L(0); }
    PG8_STAGE(PG8_SB(0, 0), cB, voffB, 0); PG8_STAGE(PG8_SB(0, 1), cB, voffB, 1); PG8_STAGE(PG8_SA(0, 0), cA, vAc, 0); PG8_STAGE(PG8_SA(0, 1), cA, vAc, 1);
    if (wr == 1) PG8_BAR;
    PG8_WAIT_V(2); PG8_BAR;
    PG8_STAGE(PG8_SB(1, 0), cB + kstep, voffB, 0); PG8_STAGE(PG8_SA(1, 0), cA + kstepA, vAc, 0); PG8_STAGE(PG8_SB(1, 1), cB + kstep, voffB, 1);
    PG8_WAIT_V(6); PG8_BAR;
    for (;;) {
        const bool has_next = S.next(ui + 1, nxt);
        const char* nA = has_next ? nxt.A : cA; const char* nB = has_next ? nxt.B : cB;
        for (int t = 0; t < nt; t += 2) {
            const bool last = (t == nt - 2);
            const char* a1 = cA + (size_t)(t + 1) * kstepA;
            const char* a2 = last ? nA : cA + (size_t)(t + 2) * kstepA; const char* b2 = last ? nB : cB + (size_t)(t + 2) * kstep;
            const char* a3 = a2 + kstepA; const char* b3 = b2 + kstep;
            unsigned va2[4];
            if constexpr (Sched::GATHER) {
                if (last) { if (has_next) { S.a_offsets(nxt, Rr, Cc, vAn); PG8_WAIT_L(0); } else {
#pragma unroll
                        for (int q = 0; q < 4; ++q) vAn[q] = vAc[q]; } }
#pragma unroll
                for (int q = 0; q < 4; ++q) va2[q] = last ? vAn[q] : vAc[q];
            } else {
#pragma unroll
                for (int q = 0; q < 4; ++q) va2[q] = vAc[q];
            }
            PG8_LDB(B0, 0, 0); PG8_LDB(B1, 0, 1); PG8_SCHED; PG8_LDA(At, 0, 0); PG8_STAGE(PG8_SA(1, 1), a1, vAc, 1);
            PG8_WAIT_V(8); PG8_WAIT_L(0); PG8_BAR; PG8_MMA(0, 0, At, B0); PG8_MMA(0, 1, At, B1); PG8_BAR; PG8_SCHED;
            const bool fin = last && !has_next;
            PG8_LDA(At, 0, 1);
            if (!fin) { PG8_STAGE(PG8_SB(0, 0), b2, voffB, 0); PG8_STAGE(PG8_SB(0, 1), b2, voffB, 1); PG8_STAGE(PG8_SA(0, 0), a2, va2, 0); PG8_WAIT_V(8); } else { PG8_WAIT_V(0); }
            PG8_WAIT_L(0); PG8_BAR; PG8_MMA(1, 0, At, B0); PG8_MMA(1, 1, At, B1); PG8_BAR; PG8_SCHED;
            PG8_LDB(B0, 1, 0); PG8_LDB(B1, 1, 1); PG8_SCHED; PG8_LDA(At, 1, 0);
            if (!fin) { PG8_STAGE(PG8_SA(0, 1), a2, va2, 1); PG8_WAIT_V(8); } else { PG8_WAIT_V(0); }
            PG8_WAIT_L(0); PG8_BAR; PG8_MMA(0, 0, At, B0); PG8_MMA(0, 1, At, B1); PG8_BAR; PG8_SCHED;
            PG8_LDA(At, 1, 1);
            if (!fin) { PG8_STAGE(PG8_SB(1, 0), b3, voffB, 0); PG8_STAGE(PG8_SB(1, 1), b3, voffB, 1); PG8_STAGE(PG8_SA(1, 0), a3, va2, 0); PG8_WAIT_V(8); } else { PG8_WAIT_V(0); }
            PG8_WAIT_L(0); PG8_BAR; PG8_MMA(1, 0, At, B0); PG8_MMA(1, 1, At, B1); PG8_BAR; PG8_SCHED;
        }
        if constexpr (ALIGN_EPI) { if (wr == 0) PG8_BAR; }
        E(acc, cur, wr, wc, fr, fq);
        if (!has_next) break;
        if constexpr (Epi::ACC_INIT) E.init(acc, nxt, wr, wc, fr, fq);
        else {
#pragma unroll
        for (int a = 0; a < 2; ++a)
#pragma unroll
            for (int b = 0; b < 2; ++b)
#pragma unroll
                for (int m = 0; m < 4; ++m)
#pragma unroll
                    for (int n = 0; n < 2; ++n) acc[a][b][m][n] = (f32x4){0.f, 0.f, 0.f, 0.f}; }
        cur = nxt; cA = nA; cB = nB; ++ui;
        if constexpr (Sched::GATHER) {
#pragma unroll
            for (int q = 0; q < 4; ++q) vAc[q] = vAn[q]; }
        if constexpr (ALIGN_EPI) { if (wr == 1) PG8_BAR; }
    }
    PG8_WAIT_V(0);
    if constexpr (!ALIGN_EPI) { if (wr == 0) PG8_BAR; }
    PG8_BAR;
#undef PG8_SA
#undef PG8_SB
#undef PG8_STAGE
#undef PG8_LDA
#undef PG8_LDB
#undef PG8_MMA
#undef PG8_WAIT_V
#undef PG8_WAIT_L
#undef PG8_BAR
#undef PG8_SCHED
}
}

constexpr int NWAVES = 8;
constexpr int BATCH = 8, SEQ = 4096, D = 1024, T = BATCH * SEQ;
constexpr int S5W = 512, S5G = 32, S5C = 16, S5P = 64, S5Q = 128;
constexpr int S5LC = 16, S5NCH = SEQ / S5LC, S5N = BATCH * S5NCH;
constexpr int S5K = S5Q + S5LC * S5C;
constexpr int LRUW = 1024, LRUH = 16, LRUHD = 64, LRUCH = 64, LRUNCH = SEQ / LRUCH;
constexpr int NIN = S5W + 2 * LRUW + 2 * D;
constexpr int NEXP = 32, EPG = 8, NGRP = 4, DEXP = 512, NROUT = 48;
constexpr int MAXSLOT = 73728;
constexpr int MAXU = 8;
constexpr float RMS_EPS = 1e-6f;

constexpr size_t MiB = 1u << 20;
constexpr size_t WS_CTL = 0, CTL_ZERO_BYTES = 128 * 1024;
constexpr size_t WS_SMALL = 1 * MiB;
constexpr size_t SM_LAM16 = WS_SMALL + 0;
constexpr size_t SM_LRUC = WS_SMALL + 16384;
constexpr size_t SM_WRT = WS_SMALL + 32768;
constexpr size_t SM_RHI = WS_SMALL + 327680;
constexpr size_t SM_RLO = SM_RHI + 98304;
constexpr size_t SM_RSTD = WS_SMALL + 524288;
constexpr size_t WS_BTT = 2 * MiB;
constexpr size_t WS_BTW = 8 * MiB;
constexpr size_t WS_WIN = 11 * MiB;
constexpr size_t WS_WS5 = 20 * MiB;
constexpr size_t WS_WLRU = 22 * MiB;
constexpr size_t WS_WO = 24 * MiB;
constexpr size_t WS_LP = 26 * MiB, WS_LH = 28 * MiB, WS_LHIN = 30 * MiB;
constexpr size_t WS_AG = 32 * MiB;
constexpr size_t WS_SLOC = 80 * MiB;
constexpr size_t WS_H = 112 * MiB;
constexpr size_t WS_XL = 176 * MiB;
constexpr size_t WS_GL = 240 * MiB;
constexpr size_t WS_GA = 304 * MiB, WS_GB = 336 * MiB;
constexpr size_t WS_GY = 368 * MiB;
constexpr size_t WS_WGU = 400 * MiB;
constexpr size_t WS_WD = 464 * MiB;
constexpr size_t WS_H2 = 32 * MiB;
constexpr size_t WS_ACT = 96 * MiB;
constexpr size_t WS_YS = 168 * MiB;
constexpr size_t WS_LTOK = 312 * MiB, WS_LW = 316 * MiB;
constexpr size_t WS_TOKE = 320 * MiB, WS_TOKR = WS_TOKE + 262144;
constexpr size_t WS_END = 496 * MiB;
static_assert(WS_YS + (size_t)MAXSLOT * 1024 * 2 <= WS_LTOK && WS_ACT + (size_t)MAXSLOT * 512 * 2 <= WS_YS && WS_TOKR + 262144 <= WS_WGU && WS_GY + (size_t)T * 512 * 2 <= WS_WGU && WS_WD + (size_t)32 * 1024 * 512 * 2 <= WS_END, "d_ws map");
constexpr int CW_BAR = 4096;
constexpr int CW_CNT = 16384;

constexpr int RING_BYTES = 131072;
constexpr int TOKL_OFF = RING_BYTES, SCLL_OFF = TOKL_OFF + MAXU * 256 * 4, MISC_OFF = SCLL_OFF + MAXU * 256 * 4;
constexpr int LDS_BYTES = MISC_OFF + 1024;

#define GAS __attribute__((address_space(1)))
#define LAS __attribute__((address_space(3)))
typedef unsigned short bf16;
typedef unsigned v4u __attribute__((ext_vector_type(4)));
typedef unsigned v2u __attribute__((ext_vector_type(2)));
typedef float f32x4 __attribute__((ext_vector_type(4)));
typedef short bf16x8 __attribute__((ext_vector_type(8)));
#define LDS_WAIT() asm volatile("s_waitcnt lgkmcnt(0)" ::: "memory")
#define VM_WAIT() asm volatile("s_waitcnt vmcnt(0)" ::: "memory")
__device__ __forceinline__ unsigned f2bf(float f) { unsigned u = __builtin_bit_cast(unsigned, f); return (u + 0x7fffu + ((u >> 16) & 1u)) >> 16; }
__device__ __forceinline__ float bf2f(unsigned h) { return __builtin_bit_cast(float, h << 16); }
__device__ __forceinline__ unsigned pk2(float lo, float hi) { return f2bf(lo) | (f2bf(hi) << 16); }
__device__ __forceinline__ float bflo(unsigned w) { return __builtin_bit_cast(float, w << 16); }
__device__ __forceinline__ float bfhi(unsigned w) { return __builtin_bit_cast(float, w & 0xffff0000u); }
__device__ __forceinline__ float fsigmoid(float x) { return __builtin_amdgcn_rcpf(1.0f + __builtin_amdgcn_exp2f(-1.44269504f * x)); }
__device__ __forceinline__ float gelu_t(float x) { const float u = x * (0.7978845608f + 0.0356774081f * x * x); return x * __builtin_amdgcn_rcpf(1.0f + __builtin_amdgcn_exp2f(-2.88539008f * u)); }
__device__ __forceinline__ float wave_sum(float v) {
#pragma unroll
    for (int o = 1; o < 64; o <<= 1) v += __shfl_xor(v, o);
    return v;
}

#define XB_TMO      128
#define XB_XCNT(j)  (256  + 64 * (j))
#define XB_XSUB(j)  (1280 + 64 * (j))
#define XB_XGEN(j)  (2304 + 64 * (j))
#define XB_TOP      3328
#define XB_TOPGEN   3392
#define XCD_BAR_WORDS 3456
#define XB_SPIN_CAP (1u << 18)
__device__ __forceinline__ unsigned xb_ld(unsigned* p)              { return __hip_atomic_load(p, __ATOMIC_RELAXED, __HIP_MEMORY_SCOPE_AGENT); }
__device__ __forceinline__ unsigned xb_add(unsigned* p, unsigned v) { return __hip_atomic_fetch_add(p, v, __ATOMIC_RELAXED, __HIP_MEMORY_SCOPE_AGENT); }
__device__ __forceinline__ unsigned xb_xcc_id() { return (unsigned)__builtin_amdgcn_s_getreg((3 << 11) | 20) & 0xFu; }
#define XB_SPIN(cond, bar) do { unsigned _sp = 0; while (cond) { __builtin_amdgcn_s_sleep(1); \
    if ((++_sp & 255u) == 0u) { if (xb_ld(&(bar)[XB_TMO])) break; if (_sp > XB_SPIN_CAP) { atomicAdd(&(bar)[XB_TMO], 1u); break; } } } } while (0)
struct XcdBarrier { unsigned* bar; unsigned x; volatile LAS unsigned* st; };
__device__ __forceinline__ XcdBarrier xcd_barrier_post(unsigned* bar, volatile LAS unsigned* st) {
    XcdBarrier b; b.bar = bar; b.x = xb_xcc_id(); b.st = st;
    if (threadIdx.x == 0) (void)xb_add(&bar[XB_XCNT(b.x)], 1u);
    return b;
}
__device__ __forceinline__ void xcd_barrier_complete(unsigned* bar, unsigned x, unsigned& nloc, unsigned& nx) {
    const unsigned G = gridDim.x * gridDim.y * gridDim.z;
    unsigned sum, cnt, mine, sp = 0u;
    for (;;) {
        sum = 0u; cnt = 0u; mine = 0u;
#pragma unroll
        for (unsigned j = 0; j < 16; ++j) { const unsigned c = xb_ld(&bar[XB_XCNT(j)]); sum += c; cnt += (c > 0u) ? 1u : 0u; mine = (j == x) ? c : mine; }
        if (sum == G) break;
        __builtin_amdgcn_s_sleep(1);
        if ((++sp & 255u) == 0u) { if (xb_ld(&bar[XB_TMO])) break; if (sp > XB_SPIN_CAP) { atomicAdd(&bar[XB_TMO], 1u); break; } }
    }
    nloc = mine > 0u ? mine : 1u; nx = cnt > 0u ? cnt : 1u;
}
__device__ __forceinline__ void xcd_barrier(const XcdBarrier& b) {
    asm volatile("s_waitcnt vmcnt(0)" ::: "memory");
    __syncthreads();
    if (threadIdx.x == 0) {
        unsigned* bar = b.bar;
        __builtin_amdgcn_s_waitcnt(0);
        unsigned nloc = b.st[0], nx = b.st[1];
        if (nloc == 0u) { xcd_barrier_complete(bar, b.x, nloc, nx); b.st[0] = nloc; b.st[1] = nx; }
        const unsigned old = xb_add(&bar[XB_XSUB(b.x)], 1u);
        const unsigned gen = old / nloc;
        if (old + 1u == (gen + 1u) * nloc) {
            __builtin_amdgcn_fence(__ATOMIC_RELEASE, "agent");
            asm volatile("s_waitcnt vmcnt(0)" ::: "memory");
            const unsigned og = xb_add(&bar[XB_TOP], 1u);
            const unsigned tg = og / nx;
            if (og + 1u == (tg + 1u) * nx) xb_add(&bar[XB_TOPGEN], 1u);
            else XB_SPIN(xb_ld(&bar[XB_TOPGEN]) == tg, bar);
            __builtin_amdgcn_fence(__ATOMIC_ACQUIRE, "agent");
            xb_add(&bar[XB_XGEN(b.x)], 1u);
            asm volatile("s_waitcnt vmcnt(0)" ::: "memory");
        } else {
            XB_SPIN(xb_ld(&bar[XB_XGEN(b.x)]) == gen, bar);
            __builtin_amdgcn_fence(__ATOMIC_ACQUIRE, "agent");
            asm volatile("s_waitcnt vmcnt(0)" ::: "memory");
        }
    }
    __syncthreads();
}

struct Frame {
    LAS unsigned char* lds;
    volatile LAS unsigned* MISC;
    unsigned* ctl;
    int tid, lane, wave, vcu, G;
    const float* const* in;
    unsigned char* ws; float* out;
};

using pg8::Unit;
struct DenseOrder {
    static constexpr bool GATHER = false;
    const char* A0; const char* B0; int lda, ldb, nM, nN, nwg, G, c;
    __device__ __forceinline__ void init(const void* A, const void* B, int lda_, int ldb_, int M, int N, int G_, int c_) { A0 = (const char*)A; B0 = (const char*)B; lda = lda_; ldb = ldb_; nM = M / 256; nN = N / 256; nwg = nM * nN; G = G_; c = c_; }
    __device__ __forceinline__ bool next(int i, Unit& u) const {
        const long L = (long)i * G + c; if (L >= nwg) return false;
        int wgid = (int)L; { const int q = nwg / 8, r = nwg % 8, xcd = wgid % 8, off = wgid / 8; wgid = (xcd < r ? xcd * (q + 1) : r * (q + 1) + (xcd - r) * q) + off; }
        const int nig = 8 * nN, gid = wgid / nig, fm = gid * 8, gsz = (nM - fm) < 8 ? (nM - fm) : 8;
        u.pm = fm + ((wgid % nig) % gsz); u.pn = (wgid % nig) / gsz; u.aux = 0;
        u.A = A0 + (size_t)u.pm * 256 * lda * 2; u.B = B0 + (size_t)u.pn * 256 * ldb * 2; return true;
    }
    __device__ __forceinline__ void a_offsets(const Unit&, const int (&R)[2], const int (&C)[2], unsigned (&v)[4]) const {
#pragma unroll
        for (int i = 0; i < 2; ++i) { v[i] = (unsigned)(R[i] * lda + C[i]) * 2u; v[2 + i] = (unsigned)((128 + R[i]) * lda + C[i]) * 2u; }
    }
};
struct S5One {
    static constexpr bool GATHER = false;
    const char* A0; const char* B0; size_t sA, sB; int lda, g, mt;
    __device__ __forceinline__ bool next(int i, Unit& u) const {
        if (i > 0) return false;
        u.pm = mt; u.pn = 0; u.aux = g; u.A = A0 + (size_t)g * sA + (size_t)mt * 256 * lda * 2; u.B = B0 + (size_t)g * sB; return true;
    }
    __device__ __forceinline__ void a_offsets(const Unit&, const int (&R)[2], const int (&C)[2], unsigned (&v)[4]) const {
#pragma unroll
        for (int i = 0; i < 2; ++i) { v[i] = (unsigned)(R[i] * lda + C[i]) * 2u; v[2 + i] = (unsigned)((128 + R[i]) * lda + C[i]) * 2u; }
    }
};
struct GyOrder {
    static constexpr bool GATHER = false;
    DenseOrder d;
    __device__ __forceinline__ bool next(int i, Unit& u) const { if (!d.next(i, u)) return false; u.A = d.A0 + (size_t)u.pm * 256 * 32; return true; }
    __device__ __forceinline__ void a_offsets(const Unit&, const int (&R)[2], const int (&C)[2], unsigned (&v)[4]) const {
#pragma unroll
        for (int i = 0; i < 2; ++i) { const unsigned o = (unsigned)(C[i] >> 4) * (unsigned)(T * 32) + (unsigned)(C[i] & 15) * 2u; v[i] = (unsigned)R[i] * 32u + o; v[2 + i] = (unsigned)(128 + R[i]) * 32u + o; }
    }
};
template <bool GATH> struct MoeOrder {
    static constexpr bool GATHER = GATH;
    const char* A0; const char* B0; size_t sBe; int lda, ldb, G, c; volatile LAS unsigned* MISC; const LAS int* tokL;
    __device__ __forceinline__ bool next(int i, Unit& u) const {
        if (i >= (int)MISC[152]) return false;
        const int e = (int)MISC[136 + i], mtg = (int)MISC[96 + e] + (int)MISC[144 + i], L = i * G + c;
        u.pm = mtg; u.pn = L & 3; u.aux = i;
        u.A = GATH ? A0 : A0 + (size_t)mtg * 256 * lda * 2; u.B = B0 + (size_t)e * sBe + (size_t)u.pn * 256 * ldb * 2; return true;
    }
    __device__ __forceinline__ void a_offsets(const Unit& u, const int (&R)[2], const int (&C)[2], unsigned (&v)[4]) const {
#pragma unroll
        for (int i = 0; i < 2; ++i) {
            if constexpr (GATH) { v[i] = (unsigned)tokL[u.aux * 256 + R[i]] * (unsigned)(lda * 2) + (unsigned)C[i] * 2u; v[2 + i] = (unsigned)tokL[u.aux * 256 + 128 + R[i]] * (unsigned)(lda * 2) + (unsigned)C[i] * 2u; }
            else { v[i] = (unsigned)(R[i] * lda + C[i]) * 2u; v[2 + i] = (unsigned)((128 + R[i]) * lda + C[i]) * 2u; } }
    }
};

using pg8::cvt_pk_bf16;
template <int ACT> __device__ __forceinline__ float actf(float x) { if (ACT == 1) return gelu_t(x); if (ACT == 2) return fsigmoid(x); return x; }
__device__ __forceinline__ v4u pack8(const f32x4 a, const f32x4 b) { v4u w; w.x = cvt_pk_bf16(a[0], a[1]); w.y = cvt_pk_bf16(a[2], a[3]); w.z = cvt_pk_bf16(b[0], b[1]); w.w = cvt_pk_bf16(b[2], b[3]); return w; }

__device__ __forceinline__ void unpack_u8x8(const v2u w, float (&f)[8]) {
    const float k = 1.0f / 255.0f;
    f[0] = (float)(w.x & 0xffu) * k; f[1] = (float)((w.x >> 8) & 0xffu) * k; f[2] = (float)((w.x >> 16) & 0xffu) * k; f[3] = (float)(w.x >> 24) * k;
    f[4] = (float)(w.y & 0xffu) * k; f[5] = (float)((w.y >> 8) & 0xffu) * k; f[6] = (float)((w.y >> 16) & 0xffu) * k; f[7] = (float)(w.y >> 24) * k;
}
struct EpiInProj {
    static constexpr bool PERM = true, ACC_INIT = false;
    bf16 *AG, *XL, *GL, *GA, *GB;
    template <int MODE  > __device__ __forceinline__ void tile(const f32x4 (&acc)[2][2][4][2], const Unit& u, bf16* base, int colbase, bool s5, int wr, int wc, int fr, int fq) const {
#pragma unroll
        for (int ai = 0; ai < 2; ++ai)
#pragma unroll
            for (int m = 0; m < 4; ++m) { const int r = u.pm * 256 + ai * 128 + wr * 64 + m * 16 + fr;
#pragma unroll
                for (int bj = 0; bj < 2; ++bj) { const int cl = colbase + bj * 128 + wc * 32 + 8 * fq;
                    f32x4 v0 = acc[ai][bj][m][0], v1 = acc[ai][bj][m][1];
                    if (MODE == 2) {
                        unsigned q[8];
#pragma unroll
                        for (int j = 0; j < 4; ++j) { q[j] = (unsigned)(fsigmoid(v0[j]) * 255.0f + 0.5f); q[4 + j] = (unsigned)(fsigmoid(v1[j]) * 255.0f + 0.5f); }
                        v2u w8; w8.x = q[0] | (q[1] << 8) | (q[2] << 16) | (q[3] << 24); w8.y = q[4] | (q[5] << 8) | (q[6] << 16) | (q[7] << 24);
                        __builtin_nontemporal_store(w8, (v2u*)((unsigned char*)base + (size_t)r * 1024 + cl));
                    } else {
                        if (MODE == 1) {
#pragma unroll
                            for (int j = 0; j < 4; ++j) { v0[j] = gelu_t(v0[j]); v1[j] = gelu_t(v1[j]); } }
                        const v4u w = pack8(v0, v1);
                        const int g = cl >> 4, cp = cl & 15, b = r >> 12, l = r & 4095, n = b * S5NCH + (l >> 4), s = l & 15;
                        const size_t off = s5 ? ((size_t)(g * S5N + n) * S5K + S5Q + s * 16 + cp) : ((size_t)r * 1024 + cl);
                        __builtin_nontemporal_store(w, (v4u*)(base + off)); } }
                asm volatile("" ::: "memory"); }
    }
    __device__ __forceinline__ void operator()(const f32x4 (&acc)[2][2][4][2], const Unit& u, int wr, int wc, int fr, int fq) const {
        const int pn = u.pn, reg = pn < 2 ? 0 : ((pn - 2) >> 2) + 1;
        const int colbase = reg == 0 ? pn * 256 : ((pn - 2) & 3) * 256;
        if (reg < 2) tile<0>(acc, u, reg == 0 ? AG : XL, colbase, reg == 0, wr, wc, fr, fq);
        else if (reg == 2) tile<1>(acc, u, GL, colbase, false, wr, wc, fr, fq);
        else tile<2>(acc, u, reg == 3 ? GA : GB, colbase, false, wr, wc, fr, fq);
    }
};
struct EpiS5State {
    static constexpr bool PERM = false, ACC_INIT = false;
    float* SLOC;
    __device__ __forceinline__ void operator()(const f32x4 (&acc)[2][2][4][2], const Unit& u, int wr, int wc, int fr, int fq) const {
#pragma unroll
        for (int ai = 0; ai < 2; ++ai)
#pragma unroll
            for (int m = 0; m < 4; ++m) { const int nr = u.pm * 256 + ai * 128 + wr * 64 + m * 16 + fr; float* rowp = SLOC + (size_t)(u.aux * S5N + nr) * S5Q + wc * 32 + 4 * fq;
#pragma unroll
                for (int n = 0; n < 2; ++n) *(f32x4*)(rowp + n * 16) = acc[ai][0][m][n]; }
    }
};
struct EpiS5Out {
    static constexpr bool PERM = true, ACC_INIT = false;
    bf16* GY;
    __device__ __forceinline__ void operator()(const f32x4 (&acc)[2][2][4][2], const Unit& u, int wr, int wc, int fr, int fq) const {
#pragma unroll
        for (int ai = 0; ai < 2; ++ai)
#pragma unroll
            for (int m = 0; m < 4; ++m) { const int nr = u.pm * 256 + ai * 128 + wr * 64 + m * 16 + fr, b = nr >> 8, j16 = nr & 255;
#pragma unroll
                for (int bj = 0; bj < 2; ++bj) { const int cc = bj * 128 + wc * 32 + 8 * fq, t = cc >> 4, c0 = cc & 15;
                    f32x4 v0 = acc[ai][bj][m][0], v1 = acc[ai][bj][m][1];
#pragma unroll
                    for (int j = 0; j < 4; ++j) { v0[j] = gelu_t(v0[j]); v1[j] = gelu_t(v1[j]); }
                    *(v4u*)(GY + ((size_t)u.aux * T + (size_t)(b * SEQ + j16 * 16 + t)) * 16 + c0) = pack8(v0, v1); }
                asm volatile("" ::: "memory"); }
    }
};
struct EpiYa {
    static constexpr bool PERM = true, ACC_INIT = false;
    const bf16* GA; bf16* YA;
    __device__ __forceinline__ void operator()(const f32x4 (&acc)[2][2][4][2], const Unit& u, int wr, int wc, int fr, int fq) const {
        const size_t off0 = (size_t)(u.pm * 256 + wr * 64 + fr) * 1024 + u.pn * 128 + wc * 32 + 8 * fq;
        v2u gav[2][4];
#pragma unroll
        for (int ai = 0; ai < 2; ++ai)
#pragma unroll
            for (int m = 0; m < 4; ++m) gav[ai][m] = __builtin_nontemporal_load((const v2u*)((const unsigned char*)GA + off0 + (size_t)(ai * 128 + m * 16) * 1024));
        asm volatile("" ::: "memory");
#pragma unroll
        for (int ai = 0; ai < 2; ++ai)
#pragma unroll
            for (int m = 0; m < 4; ++m) { float gaf[8]; unpack_u8x8(gav[ai][m], gaf);
                f32x4 o0, o1;
#pragma unroll
                for (int j = 0; j < 4; ++j) { o0[j] = gaf[j] * acc[ai][0][m][0][j] * fsigmoid(acc[ai][1][m][0][j]); o1[j] = gaf[4 + j] * acc[ai][0][m][1][j] * fsigmoid(acc[ai][1][m][1][j]); }
                *(v4u*)(YA + off0 + (size_t)(ai * 128 + m * 16) * 1024) = pack8(o0, o1); }
    }
};
struct EpiYb {
    static constexpr bool PERM = true, ACC_INIT = false;
    const bf16* YA; const bf16* GB; bf16* MIX;
    __device__ __forceinline__ void operator()(const f32x4 (&acc)[2][2][4][2], const Unit& u, int wr, int wc, int fr, int fq) const {
        const size_t off0 = (size_t)(u.pm * 256 + wr * 64 + fr) * 1024 + u.pn * 256 + wc * 32 + 8 * fq;
        v4u ya[2][2][2]; v2u gb[2][2][2];
#define YB_LOAD(buf, grp) do { _Pragma("unroll") for (int mm = 0; mm < 2; ++mm) _Pragma("unroll") for (int bj = 0; bj < 2; ++bj) { \
            const size_t o = off0 + (size_t)(((grp) >> 1) * 128 + (2 * ((grp) & 1) + mm) * 16) * 1024 + bj * 128; ya[buf][mm][bj] = __builtin_nontemporal_load((const v4u*)(YA + o)); gb[buf][mm][bj] = __builtin_nontemporal_load((const v2u*)((const unsigned char*)GB + o)); } } while (0)
        YB_LOAD(0, 0);
#pragma unroll
        for (int grp = 0; grp < 4; ++grp) { const int buf = grp & 1, ai = grp >> 1;
            if (grp < 3) YB_LOAD(buf ^ 1, grp + 1);
            asm volatile("" ::: "memory");
#pragma unroll
            for (int mm = 0; mm < 2; ++mm) { const int m = 2 * (grp & 1) + mm;
#pragma unroll
                for (int bj = 0; bj < 2; ++bj) { const v4u y = ya[buf][mm][bj];
                    const float yaf[8] = {bflo(y.x), bfhi(y.x), bflo(y.y), bfhi(y.y), bflo(y.z), bfhi(y.z), bflo(y.w), bfhi(y.w)};
                    float gbf[8]; unpack_u8x8(gb[buf][mm][bj], gbf);
                    f32x4 o0, o1;
#pragma unroll
                    for (int j = 0; j < 4; ++j) { o0[j] = yaf[j] + gbf[j] * acc[ai][bj][m][0][j]; o1[j] = yaf[4 + j] + gbf[4 + j] * acc[ai][bj][m][1][j]; }
                    *(v4u*)(MIX + off0 + (size_t)(ai * 128 + m * 16) * 1024 + bj * 128) = pack8(o0, o1); } }
        }
#undef YB_LOAD
    }
};
struct EpiWo {
    static constexpr bool PERM = false, ACC_INIT = true;
    const float* X; float* O;
    __device__ __forceinline__ void init(f32x4 (&acc)[2][2][4][2], const Unit& u, int wr, int wc, int fr, int fq) const {
        const size_t off0 = (size_t)(u.pm * 256 + wr * 64 + fr) * 1024 + u.pn * 256 + wc * 32 + 4 * fq;
#pragma unroll
        for (int ai = 0; ai < 2; ++ai)
#pragma unroll
            for (int m = 0; m < 4; ++m)
#pragma unroll
                for (int bj = 0; bj < 2; ++bj)
#pragma unroll
                    for (int n = 0; n < 2; ++n) acc[ai][bj][m][n] = __builtin_nontemporal_load((const f32x4*)(X + off0 + (size_t)(ai * 128 + m * 16) * 1024 + bj * 128 + n * 16));
    }
    __device__ __forceinline__ void operator()(const f32x4 (&acc)[2][2][4][2], const Unit& u, int wr, int wc, int fr, int fq) const {
        const size_t off0 = (size_t)(u.pm * 256 + wr * 64 + fr) * 1024 + u.pn * 256 + wc * 32 + 4 * fq;
#pragma unroll
        for (int ai = 0; ai < 2; ++ai)
#pragma unroll
            for (int m = 0; m < 4; ++m)
#pragma unroll
                for (int bj = 0; bj < 2; ++bj)
#pragma unroll
                    for (int n = 0; n < 2; ++n) *(f32x4*)(O + off0 + (size_t)(ai * 128 + m * 16) * 1024 + bj * 128 + n * 16) = acc[ai][bj][m][n];
    }
};
struct EpiGU {
    static constexpr bool PERM = true, ACC_INIT = false;
    bf16* ACT; const LAS float* sclL;
    __device__ __forceinline__ void operator()(const f32x4 (&acc)[2][2][4][2], const Unit& u, int wr, int wc, int fr, int fq) const {
#pragma unroll
        for (int ai = 0; ai < 2; ++ai)
#pragma unroll
            for (int m = 0; m < 4; ++m) { const int rl = ai * 128 + wr * 64 + m * 16 + fr; const float sc = sclL[u.aux * 256 + rl];
                f32x4 o0, o1;
#pragma unroll
                for (int j = 0; j < 4; ++j) { const float g0 = acc[ai][0][m][0][j] * sc, g1 = acc[ai][0][m][1][j] * sc;
                    o0[j] = g0 * fsigmoid(g0) * (acc[ai][1][m][0][j] * sc); o1[j] = g1 * fsigmoid(g1) * (acc[ai][1][m][1][j] * sc); }
                *(v4u*)(ACT + (size_t)(u.pm * 256 + rl) * DEXP + u.pn * 128 + wc * 32 + 8 * fq) = pack8(o0, o1); }
    }
};
struct EpiDown {
    static constexpr bool PERM = true, ACC_INIT = false;
    bf16* YS; const LAS float* sclL;
    __device__ __forceinline__ void operator()(const f32x4 (&acc)[2][2][4][2], const Unit& u, int wr, int wc, int fr, int fq) const {
#pragma unroll
        for (int ai = 0; ai < 2; ++ai)
#pragma unroll
            for (int m = 0; m < 4; ++m) { const int rl = ai * 128 + wr * 64 + m * 16 + fr; const float sc = sclL[u.aux * 256 + rl];
#pragma unroll
                for (int bj = 0; bj < 2; ++bj)
                    *(v4u*)(YS + (size_t)(u.pm * 256 + rl) * 1024 + u.pn * 256 + bj * 128 + wc * 32 + 8 * fq) = pack8(acc[ai][bj][m][0] * sc, acc[ai][bj][m][1] * sc); }
    }
};

struct TItem { const float* W; int N; bf16* WT; int ldk, k0, n0, drow0; };
__device__ __forceinline__ void transpose_load(const TItem& it, f32x4 (&tv)[8], int lane) {
#pragma unroll
    for (int i = 0; i < 8; ++i) tv[i] = __builtin_nontemporal_load((const f32x4*)(it.W + (size_t)(it.k0 + 8 * i + (lane >> 3)) * it.N + it.n0 + 4 * (lane & 7)));
}
template <bool NT = false> __device__ __forceinline__ void transpose_store(const TItem& it, const f32x4 (&tv)[8], LAS float* scr, int lane) {
#pragma unroll
    for (int i = 0; i < 8; ++i) { LAS float* d = scr + (8 * i + (lane >> 3)) * 33 + 4 * (lane & 7); d[0] = tv[i].x; d[1] = tv[i].y; d[2] = tv[i].z; d[3] = tv[i].w; }
    LDS_WAIT(); asm volatile("" ::: "memory");
    const int c = lane & 7;
#pragma unroll
    for (int j = 0; j < 4; ++j) { const int n = (lane >> 3) + 8 * j; const LAS float* s = scr + (8 * c) * 33 + n;
        v4u o; o.x = pk2(s[0 * 33], s[1 * 33]); o.y = pk2(s[2 * 33], s[3 * 33]); o.z = pk2(s[4 * 33], s[5 * 33]); o.w = pk2(s[6 * 33], s[7 * 33]);
        if (NT) __builtin_nontemporal_store(o, (v4u*)(it.WT + (size_t)(it.drow0 + n) * it.ldk + it.k0 + 8 * c)); else *(v4u*)(it.WT + (size_t)(it.drow0 + n) * it.ldk + it.k0 + 8 * c) = o; }
    LDS_WAIT(); asm volatile("" ::: "memory");
}
__device__ __forceinline__ int ileave_row(int n, int half) { return 256 * (n >> 7) + 128 * half + (n & 127); }

template <int NR> __device__ __forceinline__ void rms_rows_to_bf16(const float* x0, const float* gain, bf16* o0, size_t rstride, int lane) {
    f32x4 v[NR][4];
#pragma unroll
    for (int r = 0; r < NR; ++r) { const f32x4* xr = (const f32x4*)(x0 + r * rstride) + lane;
#pragma unroll
        for (int j = 0; j < 4; ++j) v[r][j] = __builtin_nontemporal_load(xr + 64 * j); }
    asm volatile("" ::: "memory");
    const f32x4* gr = (const f32x4*)gain + lane;
    f32x4 g[4];
#pragma unroll
    for (int j = 0; j < 4; ++j) g[j] = gr[64 * j];
#pragma unroll
    for (int r = 0; r < NR; ++r) { float s = 0.f;
#pragma unroll
        for (int j = 0; j < 4; ++j) s += (v[r][j].x * v[r][j].x + v[r][j].y * v[r][j].y) + (v[r][j].z * v[r][j].z + v[r][j].w * v[r][j].w);
        const float rstd = 1.0f / sqrtf(wave_sum(s) * (1.f / D) + RMS_EPS);
        unsigned long long* o8 = (unsigned long long*)(o0 + r * rstride) + lane;
#pragma unroll
        for (int j = 0; j < 4; ++j) o8[64 * j] = (unsigned long long)pk2(v[r][j].x * rstd * g[j].x, v[r][j].y * rstd * g[j].y) | ((unsigned long long)pk2(v[r][j].z * rstd * g[j].z, v[r][j].w * rstd * g[j].w) << 32); }
}

__device__ __forceinline__ void s5_tables(const Frame& F, int g, const float* lam_re, const float* lam_im, const float* log_dt, const float* b_re, const float* b_im, const float* c_re, const float* c_im, const float* dsk) {
    LAS float* Cre = (LAS float*)F.lds;
    LAS float* Cim = Cre + 1024;
    LAS float* Bre = Cim + 1024;
    LAS float* Bim = Bre + 1024;
    LAS float* Pre = Bim + 1024;
    LAS float* Pim = Pre + 17 * 64;
    LAS float* Kt = Pim + 17 * 64;
    const int tid = F.tid;
    for (int i = tid; i < 1024; i += 512) { Cre[i] = c_re[g * 1024 + i]; Cim[i] = c_im[g * 1024 + i]; }
    if (tid < 64) {
        const int p = tid; const float lr = lam_re[g * 64 + p], li = lam_im[g * 64 + p], dt = expf(log_dt[g]);
        const float er = expf(lr * dt), lbr = er * cosf(li * dt), lbi = er * sinf(li * dt);
        const float den = lr * lr + li * li, nr = lbr - 1.0f, ni = lbi;
        const float cr = (nr * lr + ni * li) / den, ci = (ni * lr - nr * li) / den;
        { float pr = 1.f, pi = 0.f; for (int k = 0; k <= 16; ++k) { Pre[k * 64 + p] = pr; Pim[k * 64 + p] = pi; const float nr2 = pr * lbr - pi * lbi, ni2 = pr * lbi + pi * lbr; pr = nr2; pi = ni2; } }
        for (int c = 0; c < 16; ++c) { const float br = b_re[(g * 64 + p) * 16 + c], bi = b_im[(g * 64 + p) * 16 + c]; Bre[p * 16 + c] = cr * br - ci * bi; Bim[p * 16 + c] = cr * bi + ci * br; }
    }
    __syncthreads();
    for (int e = tid; e < 4096; e += 512) {
        const int k = e >> 8, c = (e >> 4) & 15, cp = e & 15; float s = 0.f;
        for (int p = 0; p < 64; ++p) { const float xr = Cre[c * 64 + p] * Pre[k * 64 + p] - Cim[c * 64 + p] * Pim[k * 64 + p], xi = Cre[c * 64 + p] * Pim[k * 64 + p] + Cim[c * 64 + p] * Pre[k * 64 + p];
            s += xr * Bre[p * 16 + cp] - xi * Bim[p * 16 + cp]; }
        if (k == 0 && c == cp) s += dsk[g * 16 + c];
        Kt[e] = s;
    }
    __syncthreads();
    unsigned* btt = (unsigned*)(F.ws + WS_BTT) + (size_t)g * 256 * (S5K / 2);
    for (int e = tid; e < 256 * (S5K / 2); e += 512) {
        const int row = e / (S5K / 2), cpair = e % (S5K / 2), t = row >> 4, c = row & 15, col = 2 * cpair; float v0, v1;
        if (col < S5Q) { const int p = col >> 1; const float xr = Cre[c * 64 + p] * Pre[(t + 1) * 64 + p] - Cim[c * 64 + p] * Pim[(t + 1) * 64 + p], xi = Cre[c * 64 + p] * Pim[(t + 1) * 64 + p] + Cim[c * 64 + p] * Pre[(t + 1) * 64 + p];
            v0 = xr; v1 = -xi; }
        else { const int s = (col - S5Q) >> 4, cp = (col - S5Q) & 15;
            if (s <= t) { v0 = Kt[(t - s) * 256 + c * 16 + cp]; v1 = Kt[(t - s) * 256 + c * 16 + cp + 1]; } else { v0 = 0.f; v1 = 0.f; } }
        btt[e] = pk2(v0, v1);
    }
    unsigned* btw = (unsigned*)(F.ws + WS_BTW) + (size_t)g * 128 * 128;
    for (int e = tid; e < 128 * 128; e += 512) {
        const int q = e >> 7, cpair = e & 127, col = 2 * cpair, s = col >> 4, cp = col & 15, p = q >> 1, k = 15 - s;
        const float pr = Pre[k * 64 + p], pi = Pim[k * 64 + p];
        float v0, v1;
        if (q & 1) { v0 = pr * Bim[p * 16 + cp] + pi * Bre[p * 16 + cp]; v1 = pr * Bim[p * 16 + cp + 1] + pi * Bre[p * 16 + cp + 1]; }
        else { v0 = pr * Bre[p * 16 + cp] - pi * Bim[p * 16 + cp]; v1 = pr * Bre[p * 16 + cp + 1] - pi * Bim[p * 16 + cp + 1]; }
        btw[e] = pk2(v0, v1);
    }
    if (tid < 64) { float* l16 = (float*)(F.ws + SM_LAM16) + (g * 64 + tid) * 2; l16[0] = Pre[16 * 64 + tid]; l16[1] = Pim[16 * 64 + tid]; }
    __syncthreads();
}

struct In { const float* p[30]; };

__device__ __forceinline__ void p0_prologue(const Frame& F, const In& I) {
    for (int g = F.vcu; g < S5G; g += F.G) s5_tables(F, g, I.p[3], I.p[4], I.p[5], I.p[6], I.p[7], I.p[8], I.p[9], I.p[10]);
    const int gt = F.vcu * 512 + F.tid, NGT = F.G * 512;
    { float* lc = (float*)(F.ws + SM_LRUC); for (int i = gt; i < LRUW; i += NGT) { const float lam = I.p[18][i]; lc[i] = -8.0f * log1pf(expf(-lam)) * 1.44269504f; } }
    { bf16* wrt = (bf16*)(F.ws + SM_WRT);
        for (int i = gt; i < 2 * 65536; i += NGT) { const int which = i >> 16, r = i & 65535, h = r >> 12, j = (r >> 6) & 63, k = r & 63; const float* src = which ? I.p[16] : I.p[14]; wrt[i] = (bf16)f2bf(src[(h * 64 + k) * 64 + j]); } }
    { bf16* rhi = (bf16*)(F.ws + SM_RHI); bf16* rlo = (bf16*)(F.ws + SM_RLO);
        for (int i = gt; i < NROUT * 1024; i += NGT) { const int n = i >> 10, k = i & 1023; float w = 0.f; if (n < 4) w = I.p[22][k * 4 + n]; else if (n < 36) w = I.p[24][k * 32 + (n - 4)];
            const unsigned h = f2bf(w); rhi[i] = (bf16)h; rlo[i] = (bf16)f2bf(w - bf2f(h)); } }
    LAS float* scr = (LAS float*)(F.lds + F.wave * 16384);
    const int gw = F.vcu * NWAVES + F.wave, NGW = F.G * NWAVES;
    constexpr int I_IN = (D / 64) * (NIN / 32), I_S5 = (S5W / 64) * (2 * D / 32), I_LRU = (D / 64) * (D / 32), I_O = I_LRU;
    constexpr int NITEMS = I_IN + I_S5 + I_LRU + I_O;
    for (int it = gw; it < NITEMS; it += NGW) {
        int r = it; TItem ti;
        if (r < I_IN) { const int nb = NIN / 32, kb = r / nb, n0 = 32 * (r % nb); ti = TItem{I.p[2], NIN, (bf16*)(F.ws + WS_WIN), D, 64 * kb, n0, n0}; }
        else if ((r -= I_IN) < I_S5) { const int nb = 2 * D / 32, kb = r / nb, n0 = 32 * (r % nb); ti = TItem{I.p[11], 2 * D, (bf16*)(F.ws + WS_WS5), S5W, 64 * kb, n0, n0 < D ? ileave_row(n0, 0) : ileave_row(n0 - D, 1)}; }
        else if ((r -= I_S5) < I_LRU) { const int nb = D / 32, kb = r / nb, n0 = 32 * (r % nb); ti = TItem{I.p[19], D, (bf16*)(F.ws + WS_WLRU), D, 64 * kb, n0, n0}; }
        else { r -= I_LRU; const int nb = D / 32, kb = r / nb, n0 = 32 * (r % nb); ti = TItem{I.p[20], D, (bf16*)(F.ws + WS_WO), D, 64 * kb, n0, n0}; }
        f32x4 tv[8]; transpose_load(ti, tv, F.lane); asm volatile("" ::: "memory"); transpose_store(ti, tv, scr, F.lane);
    }
    { const int skip = F.G > 2 * S5G ? S5G : 0;
      if (F.vcu >= skip) { const int gw2 = (F.vcu - skip) * NWAVES + F.wave, NGW2 = (F.G - skip) * NWAVES;
        for (int m = gw2 * 4; m < T; m += NGW2 * 4) rms_rows_to_bf16<4>(I.p[0] + (size_t)m * D, I.p[1], (bf16*)(F.ws + WS_H) + (size_t)m * D, D, F.lane); } }
}
__device__ __forceinline__ TItem expert_item(const Frame& F, const In& I, int it) {
    constexpr int I_G = (D / 64) * (DEXP / 32), I_D = (DEXP / 64) * (D / 32);
    const int e = it / (2 * I_G + I_D); int r = it % (2 * I_G + I_D);
    if (r < 2 * I_G) { const int half = r / I_G; r %= I_G; const int nb = DEXP / 32, kb = r / nb, n0 = 32 * (r % nb);
        return TItem{(half ? I.p[27] : I.p[26]) + (size_t)e * D * DEXP, DEXP, (bf16*)(F.ws + WS_WGU) + (size_t)e * 1024 * 1024, D, 64 * kb, n0, ileave_row(n0, half)}; }
    r -= 2 * I_G; const int nb = D / 32, kb = r / nb, n0 = 32 * (r % nb);
    return TItem{I.p[28] + (size_t)e * DEXP * D, D, (bf16*)(F.ws + WS_WD) + (size_t)e * 1024 * DEXP, DEXP, 64 * kb, n0, n0};
}
__device__ __forceinline__ void expert_weight_copies(const Frame& F, const In& I) {
    LAS float* scr = (LAS float*)(F.lds + F.wave * 16384);
    const int gw = F.vcu * NWAVES + F.wave, NGW = F.G * NWAVES;
    constexpr int NIT = NEXP * 768;
    const int first = 8 * NGW < NIT ? 8 * NGW : NIT;
    for (int it = first + gw; it < NIT; it += 2 * NGW) {
        const TItem t0 = expert_item(F, I, it); const bool has1 = it + NGW < NIT; const TItem t1 = expert_item(F, I, has1 ? it + NGW : it);
        f32x4 v0[8], v1[8]; transpose_load(t0, v0, F.lane); transpose_load(t1, v1, F.lane); asm volatile("" ::: "memory");
        transpose_store(t0, v0, scr, F.lane); if (has1) transpose_store(t1, v1, scr, F.lane);
    }
}

__device__ __forceinline__ void lru_seq(const Frame& F, const In& I) {
    LAS unsigned char* wl = F.lds + F.wave * 17920;
    LAS bf16* xcA = (LAS bf16*)wl;
    LAS float* pre = (LAS float*)(wl + 9216);
    typedef float f32x2 __attribute__((ext_vector_type(2)));
    LAS f32x2* sumT = (LAS f32x2*)(F.lds + 143360);
    const int lane = F.lane, jj = lane & 15, ks = lane >> 4, c32 = lane & 31, th = lane >> 5;
    const bf16* XL = (const bf16*)(F.ws + WS_XL); const bf16* GL = (const bf16*)(F.ws + WS_GL); bf16* YL = (bf16*)(F.ws + WS_H);
    const bf16* WRT = (const bf16*)(F.ws + SM_WRT);
    for (int un = F.vcu; un < BATCH * LRUH * 2; un += F.G) {
        const int b = un >> 5, hd = (un >> 1) & 15, half = un & 1;
        const int chin = hd * 64 + lane;
        const int chg = hd * 64 + 32 * half + c32;
        const float w0 = I.p[12][chin], w1 = I.p[12][1024 + chin], w2 = I.p[12][2048 + chin], w3 = I.p[12][3072 + chin], cb = I.p[13][chin];
        const float brs = I.p[15][chg] * -1.44269504f, bis = I.p[17][chg] * -1.44269504f, cch2 = ((const float*)(F.ws + SM_LRUC))[chg];
        bf16x8 Bw[4][2];
#pragma unroll
        for (int n = 0; n < 4; ++n)
#pragma unroll
            for (int k = 0; k < 2; ++k) Bw[n][k] = *(const bf16x8*)(WRT + (size_t)(n >> 1) * 65536 + (size_t)(hd * 64 + 32 * half + 16 * (n & 1) + jj) * 64 + 32 * k + 8 * ks);
        float Rc = 0.f;
        for (int rd = 0; rd < 8; ++rd) {
            const int j = rd * 8 + F.wave;
            const size_t tok0 = (size_t)b * SEQ + (size_t)j * LRUCH;
            unsigned short xr[64], xh[3];
            { const bf16* xp = XL + tok0 * 1024 + chin;
              xh[0] = 0; xh[1] = 0; xh[2] = 0;
              if (j > 0) { xh[0] = xp[-3 * 1024]; xh[1] = xp[-2 * 1024]; xh[2] = xp[-1 * 1024]; }
#pragma unroll
              for (int t = 0; t < 64; ++t) xr[t] = xp[t * 1024]; }
            asm volatile("" ::: "memory");
            { typedef float f2v __attribute__((ext_vector_type(2)));
              float xm3 = bf2f(xh[0]), xm2 = bf2f(xh[1]), xm1 = bf2f(xh[2]);
              const f2v vw0 = {w0, w0}, vw1 = {w1, w1}, vw2 = {w2, w2}, vw3 = {w3, w3}, vcb = {cb, cb};
#pragma unroll
              for (int t = 0; t < 64; t += 2) { const float x0 = bf2f(xr[t]), x1 = bf2f(xr[t + 1]);
                  f2v xc = vcb + vw0 * (f2v){xm3, xm2}; xc = xc + vw1 * (f2v){xm2, xm1}; xc = xc + vw2 * (f2v){xm1, x0}; xc = xc + vw3 * (f2v){x0, x1};
                  const unsigned pk = pg8::cvt_pk_bf16(xc.x, xc.y);
                  xcA[t * 72 + lane] = (bf16)(pk & 0xffffu); xcA[(t + 1) * 72 + lane] = (bf16)(pk >> 16);
                  xm3 = xm1; xm2 = x0; xm1 = x1; } }
            LDS_WAIT();
            float hl[2][16], Pl[2][16], Prun[2], Hrun[2];
#pragma unroll
            for (int st = 0; st < 2; ++st) {
#pragma unroll
                for (int mh = 0; mh < 2; ++mh) { const int mt = 2 * st + mh;
                    bf16x8 a[2];
#pragma unroll
                    for (int k = 0; k < 2; ++k) a[k] = *(const LAS bf16x8*)(xcA + (16 * mt + jj) * 72 + 32 * k + 8 * ks);
#pragma unroll
                    for (int n = 0; n < 4; ++n) { f32x4 d = (f32x4){0.f, 0.f, 0.f, 0.f};
#pragma unroll
                        for (int k = 0; k < 2; ++k) d = __builtin_amdgcn_mfma_f32_16x16x32_bf16(a[k], Bw[n][k], d, 0, 0, 0);
#pragma unroll
                        for (int r = 0; r < 4; ++r) pre[(16 * mh + 4 * ks + r) * 68 + 16 * n + jj] = d[r]; } }
                LDS_WAIT();
                float h = 0.f, P = 1.f;
                typedef float f2v __attribute__((ext_vector_type(2)));
#pragma unroll
                for (int tl = 0; tl < 16; tl += 2) {
                    const int trow = 16 * th + tl;
                    const f2v pr = {pre[trow * 68 + c32], pre[(trow + 1) * 68 + c32]}, pi = {pre[trow * 68 + 32 + c32], pre[(trow + 1) * 68 + 32 + c32]};
                    const f2v zr = pr * (f2v){-1.44269504f, -1.44269504f} + (f2v){brs, brs}, zi = pi * (f2v){-1.44269504f, -1.44269504f} + (f2v){bis, bis};
                    const f2v er = {__builtin_amdgcn_exp2f(zr.x), __builtin_amdgcn_exp2f(zr.y)}, ei = {__builtin_amdgcn_exp2f(zi.x), __builtin_amdgcn_exp2f(zi.y)};
                    const f2v dr = er + (f2v){1.f, 1.f};
                    const f2v rg = {__builtin_amdgcn_rcpf(dr.x), __builtin_amdgcn_rcpf(dr.y)};
                    const f2v la2 = rg * (f2v){cch2, cch2};
                    const f2v a_ = {__builtin_amdgcn_exp2f(la2.x), __builtin_amdgcn_exp2f(la2.y)};
                    const f2v x2 = la2 * (f2v){1.38629436f, 1.38629436f};
                    f2v q = x2 * (f2v){0.0013888889f, 0.0013888889f} + (f2v){0.0083333333f, 0.0083333333f};
                    q = q * x2 + (f2v){0.041666667f, 0.041666667f}; q = q * x2 + (f2v){0.16666667f, 0.16666667f}; q = q * x2 + (f2v){0.5f, 0.5f}; q = q * x2 + (f2v){1.f, 1.f};
                    f2v om = -(q * x2);
                    const f2v alt = (f2v){1.f, 1.f} - a_ * a_;
                    om.x = x2.x > -0.3f ? om.x : alt.x; om.y = x2.y > -0.3f ? om.y : alt.y;
                    om.x = fmaxf(om.x, 1e-30f); om.y = fmaxf(om.y, 1e-30f);
                    const f2v dd = ei + (f2v){1.f, 1.f};
                    const f2v rq = om * dd * dd;
                    const f2v mi = om * (f2v){__builtin_amdgcn_rsqf(rq.x), __builtin_amdgcn_rsqf(rq.y)};
                    const f2v bx = mi * (f2v){bf2f(xcA[(32 * st + trow) * 72 + 32 * half + c32]), bf2f(xcA[(32 * st + trow + 1) * 72 + 32 * half + c32])};
                    h = a_.x * h + bx.x; P *= a_.x; hl[st][tl] = h; Pl[st][tl] = P;
                    h = a_.y * h + bx.y; P *= a_.y; hl[st][tl + 1] = h; Pl[st][tl + 1] = P;
                }
                Prun[st] = P; Hrun[st] = h;
                LDS_WAIT();
            }
            const float pP0 = __shfl_xor(Prun[0], 32), pH0 = __shfl_xor(Hrun[0], 32), pP1 = __shfl_xor(Prun[1], 32), pH1 = __shfl_xor(Hrun[1], 32);
            const float P0 = th ? pP0 : Prun[0], H0 = th ? pH0 : Hrun[0], P1 = th ? Prun[0] : pP0, H1 = th ? Hrun[0] : pH0;
            const float P2 = th ? pP1 : Prun[1], H2 = th ? pH1 : Hrun[1], P3 = th ? Prun[1] : pP1, H3 = th ? Hrun[1] : pH1;
            const float C1 = H0, Q1 = P0, C2 = P1 * C1 + H1, Q2 = P1 * Q1, C3 = P2 * C2 + H2, Q3 = P2 * Q2, Hc = P3 * C3 + H3, Pc = P3 * Q3;
            const float Cs0 = th ? C1 : 0.f, Qs0 = th ? Q1 : 1.f, Cs1 = th ? C3 : C2, Qs1 = th ? Q3 : Q2;
            const int cit = (rd * F.G + F.vcu) * NWAVES + F.wave; const bool cdo = cit < NEXP * 768;
            f32x4 ctv[8]; unsigned short ggr[2][16];
            if (cdo) { const TItem citem = expert_item(F, I, cit); transpose_load(citem, ctv, lane); }
#pragma unroll
            for (int st = 0; st < 2; ++st)
#pragma unroll
                for (int tl = 0; tl < 16; ++tl) ggr[st][tl] = GL[(tok0 + 32 * st + 16 * th + tl) * 1024 + chg];
            asm volatile("" ::: "memory");
            if (th == 0) sumT[((rd & 1) * 8 + F.wave) * 32 + c32] = (f32x2){Pc, Hc};
            LDS_WAIT();
            __syncthreads();
            float cin = Rc, mycin = 0.f;
#pragma unroll
            for (int w = 0; w < 8; ++w) { const f32x2 ph = sumT[((rd & 1) * 8 + w) * 32 + c32]; mycin = (w == F.wave) ? cin : mycin; cin = ph.x * cin + ph.y; }
            Rc = cin;
#pragma unroll
            for (int st = 0; st < 2; ++st) { const float hin = (st ? Cs1 : Cs0) + (st ? Qs1 : Qs0) * mycin;
#pragma unroll
                for (int tl = 0; tl < 16; ++tl) { const float hh = hl[st][tl] + Pl[st][tl] * hin;
                    YL[(tok0 + 32 * st + 16 * th + tl) * 1024 + chg] = (bf16)f2bf(hh * bf2f(ggr[st][tl])); } }
            if (cdo) { const TItem citem = expert_item(F, I, cit); transpose_store<true>(citem, ctv, pre, lane); }
        }
        __syncthreads();
    }
}

__device__ __forceinline__ void s5_chain(const Frame& F, int b, int g) {
    typedef float f32x2 __attribute__((ext_vector_type(2)));
    LAS f32x2* segE = (LAS f32x2*)(F.lds);
    const int lane = F.lane, w = F.wave;
    const float* SLOC = (const float*)(F.ws + WS_SLOC); unsigned* AGw = (unsigned*)(F.ws + WS_AG); const float* L16 = (const float*)(F.ws + SM_LAM16);
    const float lr = L16[(g * 64 + lane) * 2], li = L16[(g * 64 + lane) * 2 + 1];
    const float* sl = SLOC + ((size_t)(g * S5N + b * S5NCH + 32 * w)) * S5Q + 2 * lane;
    unsigned* ag = AGw + ((size_t)(g * S5N + b * S5NCH + 32 * w)) * (S5K / 2) + lane;
    float xr[32], xi[32];
#pragma unroll
    for (int u = 0; u < 32; ++u) { const float2 v = *(const float2*)(sl + (size_t)u * S5Q); xr[u] = v.x; xi[u] = v.y; }
    asm volatile("" ::: "memory");
    float sr = 0.f, si = 0.f;
#pragma unroll
    for (int u = 0; u < 32; ++u) { const float nr = lr * sr - li * si + xr[u], ni = lr * si + li * sr + xi[u]; xr[u] = sr; xi[u] = si; sr = nr; si = ni; }
    segE[w * 64 + lane] = (f32x2){sr, si};
    float qr = lr, qi = li;
#pragma unroll
    for (int k = 0; k < 5; ++k) { const float nr = qr * qr - qi * qi, ni = 2.f * qr * qi; qr = nr; qi = ni; }
    LDS_WAIT();
    __syncthreads();
    float cr = 0.f, ci = 0.f;
    for (int ww = 0; ww < w; ++ww) { const f32x2 e = segE[ww * 64 + lane]; const float nr = qr * cr - qi * ci + e.x, ni = qr * ci + qi * cr + e.y; cr = nr; ci = ni; }
#pragma unroll
    for (int u = 0; u < 32; ++u) { ag[(size_t)u * (S5K / 2)] = pk2(xr[u] + cr, xi[u] + ci); const float nr = lr * cr - li * ci, ni = lr * ci + li * cr; cr = nr; ci = ni; }
    __syncthreads();
}

__device__ __forceinline__ void p8_router(const Frame& F, const In& I) {
    const int lane = F.lane, tk = lane & 15, ks = lane >> 4;
    LAS float* lg = (LAS float*)(F.lds + F.wave * 4096);
    volatile LAS unsigned* cntL = F.MISC + 32; volatile LAS unsigned* baseL = F.MISC + 64;
    const float* X1 = F.out; bf16* H2 = (bf16*)(F.ws + WS_H2); const float* gf = I.p[21];
    const bf16* RHI = (const bf16*)(F.ws + SM_RHI); const bf16* RLO = (const bf16*)(F.ws + SM_RLO);
    float* RSTD = (float*)(F.ws + SM_RSTD); unsigned* gcnt = F.ctl + CW_CNT;
    int* LTOK = (int*)(F.ws + WS_LTOK); float* LW = (float*)(F.ws + WS_LW); int* TOKE = (int*)(F.ws + WS_TOKE); int* TOKR = (int*)(F.ws + WS_TOKR);
    for (int blk = F.vcu; blk < T / 128; blk += F.G) {
        if (F.tid < 32) cntL[F.tid] = 0u;
        __syncthreads();
        const int tok0 = blk * 128 + F.wave * 16;
        const float* xrow = X1 + (size_t)(tok0 + tk) * D + 8 * ks; bf16* hrow = H2 + (size_t)(tok0 + tk) * D + 8 * ks;
        f32x4 acc[3]; acc[0] = acc[1] = acc[2] = (f32x4){0.f, 0.f, 0.f, 0.f}; float ss = 0.f;
        f32x4 xnx[4][2];
#pragma unroll
        for (int q = 0; q < 4; ++q) { xnx[q][0] = __builtin_nontemporal_load((const f32x4*)(xrow + 32 * q)); xnx[q][1] = __builtin_nontemporal_load((const f32x4*)(xrow + 32 * q + 4)); }
        LAS bf16* slab = (LAS bf16*)(F.lds + 32768);
        v4u wst[3];
#define RT_SLAB_LOAD(g) do { _Pragma("unroll") for (int j = 0; j < 3; ++j) { const int c = F.tid + 512 * j, which = c / 768, r = (c % 768) >> 4, kq = c & 15; \
            wst[j] = *(const v4u*)((which ? RLO : RHI) + (size_t)r * D + 128 * (g) + 8 * kq); } } while (0)
#define RT_SLAB_STORE(buf) do { _Pragma("unroll") for (int j = 0; j < 3; ++j) { const int c = F.tid + 512 * j, which = c / 768, r = (c % 768) >> 4, kq = c & 15; \
            *(LAS v4u*)(slab + ((size_t)((buf) * 2 + which) * 48 + r) * 136 + 8 * kq) = wst[j]; } } while (0)
        RT_SLAB_LOAD(0); RT_SLAB_STORE(0);
        LDS_WAIT();
        __syncthreads();
        for (int kg = 0; kg < 8; ++kg) {
            f32x4 xa[4][2];
#pragma unroll
            for (int q = 0; q < 4; ++q) { xa[q][0] = xnx[q][0]; xa[q][1] = xnx[q][1]; }
            { const int kgn = kg < 7 ? kg + 1 : kg;
#pragma unroll
              for (int q = 0; q < 4; ++q) { xnx[q][0] = __builtin_nontemporal_load((const f32x4*)(xrow + 32 * (4 * kgn + q))); xnx[q][1] = __builtin_nontemporal_load((const f32x4*)(xrow + 32 * (4 * kgn + q) + 4)); }
              RT_SLAB_LOAD(kgn); }
            f32x4 ga[4][2];
#pragma unroll
            for (int q = 0; q < 4; ++q) { const int kc = 4 * kg + q; ga[q][0] = *(const f32x4*)(gf + 32 * kc + 8 * ks); ga[q][1] = *(const f32x4*)(gf + 32 * kc + 8 * ks + 4); }
            asm volatile("" ::: "memory");
            const LAS bf16* sh = slab + (size_t)((kg & 1) * 2) * 48 * 136, * sl = sh + 48 * 136;
#pragma unroll
            for (int q = 0; q < 4; ++q) { const int kc = 4 * kg + q;
                const f32x4 a0 = xa[q][0], a1 = xa[q][1];
                ss += (a0.x * a0.x + a0.y * a0.y) + (a0.z * a0.z + a0.w * a0.w) + (a1.x * a1.x + a1.y * a1.y) + (a1.z * a1.z + a1.w * a1.w);
                const f32x4 v0 = a0 * ga[q][0], v1 = a1 * ga[q][1];
                v4u hi, lo;
                { const unsigned h0 = f2bf(v0.x), h1 = f2bf(v0.y), h2 = f2bf(v0.z), h3 = f2bf(v0.w), h4 = f2bf(v1.x), h5 = f2bf(v1.y), h6 = f2bf(v1.z), h7 = f2bf(v1.w);
                  hi.x = h0 | (h1 << 16); hi.y = h2 | (h3 << 16); hi.z = h4 | (h5 << 16); hi.w = h6 | (h7 << 16);
                  lo.x = pk2(v0.x - bf2f(h0), v0.y - bf2f(h1)); lo.y = pk2(v0.z - bf2f(h2), v0.w - bf2f(h3)); lo.z = pk2(v1.x - bf2f(h4), v1.y - bf2f(h5)); lo.w = pk2(v1.z - bf2f(h6), v1.w - bf2f(h7)); }
                *(v4u*)(hrow + 32 * kc) = hi;
                const bf16x8 hf = __builtin_bit_cast(bf16x8, hi), lf = __builtin_bit_cast(bf16x8, lo);
#pragma unroll
                for (int n = 0; n < 3; ++n) {
                    const bf16x8 wh = *(const LAS bf16x8*)(sh + (16 * n + tk) * 136 + 32 * q + 8 * ks), wl = *(const LAS bf16x8*)(sl + (16 * n + tk) * 136 + 32 * q + 8 * ks);
                    acc[n] = __builtin_amdgcn_mfma_f32_16x16x32_bf16(wh, hf, acc[n], 0, 0, 0);
                    acc[n] = __builtin_amdgcn_mfma_f32_16x16x32_bf16(wh, lf, acc[n], 0, 0, 0);
                    acc[n] = __builtin_amdgcn_mfma_f32_16x16x32_bf16(wl, hf, acc[n], 0, 0, 0);
                } }
            if (kg < 7) RT_SLAB_STORE((kg + 1) & 1);
            LDS_WAIT();
            __syncthreads();
        }
#undef RT_SLAB_LOAD
#undef RT_SLAB_STORE
        ss += __shfl_xor(ss, 16); ss += __shfl_xor(ss, 32);
        const float rstd = 1.0f / sqrtf(ss * (1.f / D) + RMS_EPS);
        if (ks == 0) RSTD[tok0 + tk] = rstd;
#pragma unroll
        for (int n = 0; n < 3; ++n)
#pragma unroll
            for (int r = 0; r < 4; ++r) lg[tk * 49 + 16 * n + 4 * ks + r] = acc[n][r] * rstd;
        LDS_WAIT();
        int E1 = 0, E2 = 0; float w1 = 0.f, w2 = 0.f; unsigned r1 = 0, r2 = 0;
        if (lane < 16) {
            const LAS float* my = lg + lane * 49;
            float lgp[4];
#pragma unroll
            for (int i = 0; i < 4; ++i) lgp[i] = my[i] + I.p[23][i];
            int gi = 0; float mx = lgp[0];
#pragma unroll
            for (int i = 1; i < 4; ++i) if (lgp[i] > mx) { mx = lgp[i]; gi = i; }
            float den = 0.f;
#pragma unroll
            for (int i = 0; i < 4; ++i) den += expf(lgp[i] - mx);
            const float pg = 1.0f / den;
            float le[8];
#pragma unroll
            for (int i = 0; i < 8; ++i) le[i] = my[4 + gi * 8 + i] + I.p[25][gi * 8 + i];
            int i1 = 0; float m1 = le[0];
#pragma unroll
            for (int i = 1; i < 8; ++i) if (le[i] > m1) { m1 = le[i]; i1 = i; }
            int i2 = -1; float m2 = -3.0e38f;
#pragma unroll
            for (int i = 0; i < 8; ++i) if (i != i1 && le[i] > m2) { m2 = le[i]; i2 = i; }
            const float e2 = expf(m2 - m1);
            w1 = pg / (1.0f + e2); w2 = pg * e2 / (1.0f + e2);
            E1 = gi * 8 + i1; E2 = gi * 8 + i2;
            r1 = __hip_atomic_fetch_add((LAS unsigned*)(F.MISC + 32) + E1, 1u, __ATOMIC_RELAXED, __HIP_MEMORY_SCOPE_WORKGROUP);
            r2 = __hip_atomic_fetch_add((LAS unsigned*)(F.MISC + 32) + E2, 1u, __ATOMIC_RELAXED, __HIP_MEMORY_SCOPE_WORKGROUP);
        }
        LDS_WAIT();
        __syncthreads();
        if (F.tid < 32) { const unsigned c = cntL[F.tid]; baseL[F.tid] = c ? __hip_atomic_fetch_add(gcnt + F.tid, c, __ATOMIC_RELAXED, __HIP_MEMORY_SCOPE_AGENT) : 0u; }
        __syncthreads();
        if (lane < 16) {
            const int tok = tok0 + lane; const int k1 = (int)(baseL[E1] + r1), k2 = (int)(baseL[E2] + r2);
            LTOK[(size_t)E1 * T + k1] = tok; LW[(size_t)E1 * T + k1] = w1; LTOK[(size_t)E2 * T + k2] = tok; LW[(size_t)E2 * T + k2] = w2;
            TOKE[tok * 2] = E1; TOKE[tok * 2 + 1] = E2; TOKR[tok * 2] = k1; TOKR[tok * 2 + 1] = k2;
        }
        __syncthreads();
    }
}

__device__ __forceinline__ void moe_prefix(const Frame& F) {
    if (F.tid < 64) {
        const unsigned nt = F.tid < NEXP ? (F.ctl[CW_CNT + F.tid] + 255u) >> 8 : 0u; unsigned inc = nt;
#pragma unroll
        for (int o = 1; o < 32; o <<= 1) { const unsigned v = __shfl_up(inc, o); if (F.lane >= o) inc += v; }
        if (F.tid < NEXP) F.MISC[96 + F.tid] = inc - nt;
        if (F.tid == NEXP - 1) F.MISC[128] = inc;
    }
    LDS_WAIT();
    __syncthreads();
}
template <int MODE  >
__device__ __forceinline__ void moe_setup(const Frame& F) {
    moe_prefix(F);
    const int NT = (int)F.MISC[128];
    if (F.tid < MAXU) { const int L = F.tid * F.G + F.vcu; int e = -1, mt = 0;
        if (L < NT * 4) { const int mtg = L >> 2; e = 0; while (e < NEXP - 1 && (int)F.MISC[96 + e + 1] <= mtg) ++e; mt = mtg - (int)F.MISC[96 + e]; }
        F.MISC[136 + F.tid] = (unsigned)e; F.MISC[144 + F.tid] = (unsigned)mt; }
    __syncthreads();
    if (F.tid == 0) { int n = 0; while (n < MAXU && (int)F.MISC[136 + n] >= 0) ++n; F.MISC[152] = (unsigned)n; }
    __syncthreads();
    const int nU = (int)F.MISC[152];
    LAS int* tokL = (LAS int*)(F.lds + TOKL_OFF); LAS float* sclL = (LAS float*)(F.lds + SCLL_OFF);
    const int* LTOK = (const int*)(F.ws + WS_LTOK); const float* LW = (const float*)(F.ws + WS_LW); const float* RSTD = (const float*)(F.ws + SM_RSTD);
    for (int i = F.tid; i < nU * 256; i += 512) { const int ui = i >> 8, r = i & 255, e = (int)F.MISC[136 + ui], rank = (int)F.MISC[144 + ui] * 256 + r; const bool valid = rank < (int)F.ctl[CW_CNT + e];
        const int tok = valid ? LTOK[(size_t)e * T + rank] : 0; tokL[i] = tok; sclL[i] = valid ? (MODE == 0 ? RSTD[tok] : LW[(size_t)e * T + rank]) : 0.f; }
    LDS_WAIT(); VM_WAIT();
    __syncthreads();
}

__device__ __forceinline__ void p11_final(const Frame& F, const In& I, float* dst) {
    moe_prefix(F);
    const int gw = F.vcu * NWAVES + F.wave, NGW = F.G * NWAVES, lane = F.lane;
    const int* TOKE = (const int*)(F.ws + WS_TOKE); const int* TOKR = (const int*)(F.ws + WS_TOKR); const bf16* YS = (const bf16*)(F.ws + WS_YS);
    f32x4 gfin[4];
#pragma unroll
    for (int j = 0; j < 4; ++j) gfin[j] = ((const f32x4*)I.p[29])[lane + 64 * j];
    int ee[2][2], rr[2][2];
    { const int m0 = gw * 2 < T ? gw * 2 : 0;
#pragma unroll
      for (int q = 0; q < 2; ++q) { ee[q][0] = TOKE[2 * (m0 + q)]; ee[q][1] = TOKE[2 * (m0 + q) + 1]; rr[q][0] = TOKR[2 * (m0 + q)]; rr[q][1] = TOKR[2 * (m0 + q) + 1]; } }
    for (int m0 = gw * 2; m0 < T; m0 += NGW * 2) {
        f32x4 xv[2][4]; v2u ya[2][4], yb[2][4];
#pragma unroll
        for (int q = 0; q < 2; ++q) { const size_t s0 = (size_t)F.MISC[96 + ee[q][0]] * 256 + rr[q][0], s1 = (size_t)F.MISC[96 + ee[q][1]] * 256 + rr[q][1];
            const f32x4* xr = (const f32x4*)(F.out + (size_t)(m0 + q) * D) + lane; const v2u* y0 = (const v2u*)(YS + s0 * 1024) + lane; const v2u* y1 = (const v2u*)(YS + s1 * 1024) + lane;
#pragma unroll
            for (int j = 0; j < 4; ++j) { xv[q][j] = __builtin_nontemporal_load(xr + 64 * j); ya[q][j] = __builtin_nontemporal_load(y0 + 64 * j); yb[q][j] = __builtin_nontemporal_load(y1 + 64 * j); } }
        { const int mn = m0 + NGW * 2 < T ? m0 + NGW * 2 : m0;
#pragma unroll
          for (int q = 0; q < 2; ++q) { ee[q][0] = TOKE[2 * (mn + q)]; ee[q][1] = TOKE[2 * (mn + q) + 1]; rr[q][0] = TOKR[2 * (mn + q)]; rr[q][1] = TOKR[2 * (mn + q) + 1]; } }
        asm volatile("" ::: "memory");
#pragma unroll
        for (int q = 0; q < 2; ++q) { f32x4 v[4]; float s = 0.f;
#pragma unroll
            for (int j = 0; j < 4; ++j) { const f32x4 x = xv[q][j]; const v2u a = ya[q][j], b = yb[q][j];
                v[j].x = x.x + bflo(a.x) + bflo(b.x); v[j].y = x.y + bfhi(a.x) + bfhi(b.x); v[j].z = x.z + bflo(a.y) + bflo(b.y); v[j].w = x.w + bfhi(a.y) + bfhi(b.y);
                s += (v[j].x * v[j].x + v[j].y * v[j].y) + (v[j].z * v[j].z + v[j].w * v[j].w); }
            const float rstd = 1.0f / sqrtf(wave_sum(s) * (1.f / D) + RMS_EPS);
            f32x4* xw = (f32x4*)(dst + (size_t)(m0 + q) * D) + lane;
#pragma unroll
            for (int j = 0; j < 4; ++j) { const f32x4 g = gfin[j]; __builtin_nontemporal_store((f32x4){v[j].x * rstd * g.x, v[j].y * rstd * g.y, v[j].z * rstd * g.z, v[j].w * rstd * g.w}, xw + 64 * j); } }
    }
}

constexpr int N_PHASES = 12;
struct Args { In in; float* out; unsigned char* ws; float* fin_dst; int ph_lo, ph_hi, li, pad; };
__global__ void __launch_bounds__(NWAVES * 64, 2) mk_fwd(Args args) {
    extern __shared__ __attribute__((aligned(16))) unsigned char lds[];
    Frame F;
    F.lds = (LAS unsigned char*)lds;
    F.MISC = (volatile LAS unsigned*)(F.lds + MISC_OFF);
    F.tid = threadIdx.x; F.lane = F.tid & 63; F.wave = __builtin_amdgcn_readfirstlane(F.tid >> 6);
    F.G = gridDim.x; { const int bx = blockIdx.x; F.vcu = (F.G % 8 == 0) ? (bx % 8) * (F.G / 8) + bx / 8 : bx; }
    F.ws = args.ws; F.out = args.out; F.ctl = (unsigned*)(args.ws + WS_CTL); F.in = nullptr;
    const In& I = args.in;
    for (int u = F.tid; u < 256; u += NWAVES * 64) F.MISC[u] = 0u;
    __syncthreads();
    const int lo = args.ph_lo, hi = args.ph_hi;
    XcdBarrier bar; bar.bar = F.ctl + CW_BAR + args.li * XCD_BAR_WORDS; bar.x = 0; bar.st = nullptr;
    if (hi - lo > 1) bar = xcd_barrier_post(F.ctl + CW_BAR + args.li * XCD_BAR_WORDS, F.MISC + 8);
#ifndef PH_MASK
#define PH_MASK 0xFFF
#endif
#define IN(k) (((PH_MASK >> (k)) & 1) && lo <= (k) && (k) < hi)
#define SEAM(k) do { if (IN(k) && IN(NEXT_PH(k))) xcd_barrier(bar); } while (0)
#define NEXT_PH(k) ((k) == 2 ? 5 : (k) + 1)
    const int cblk = (int)blockIdx.x;
    LAS unsigned char* ring = F.lds;

    if (IN(0)) { p0_prologue(F, I); SEAM(0); }

    if (IN(1)) {
        DenseOrder S; S.init(F.ws + WS_H, F.ws + WS_WIN, D, D, T, NIN, F.G, cblk);
        EpiInProj E{(bf16*)(F.ws + WS_AG), (bf16*)(F.ws + WS_XL), (bf16*)(F.ws + WS_GL), (bf16*)(F.ws + WS_GA), (bf16*)(F.ws + WS_GB)};
        pg8::gemm_phase<EpiInProj, DenseOrder, true>(ring, D, D, S, E);
        SEAM(1);
    }
    if (IN(2)) {
        if (cblk < 256) {
            const int L = cblk, wgid = (L % 8) * 32 + L / 8, g = wgid >> 3, mt = wgid & 7;
            { S5One S{(const char*)(F.ws + WS_AG) + S5Q * 2, (const char*)(F.ws + WS_BTW), (size_t)S5N * S5K * 2, (size_t)128 * 256 * 2, S5K, g, mt};
              EpiS5State E{(float*)(F.ws + WS_SLOC)};
              pg8::gemm_phase<EpiS5State, S5One, false>(ring, 256, 256, S, E); }
            if (F.wave == 0) { __builtin_amdgcn_fence(__ATOMIC_ACQUIRE, "agent"); VM_WAIT(); }
            __syncthreads();
            s5_chain(F, mt, g);
            VM_WAIT();
            __syncthreads();
            if (F.wave == 0) { __builtin_amdgcn_fence(__ATOMIC_ACQUIRE, "agent"); VM_WAIT(); }
            __syncthreads();
            { S5One S{(const char*)(F.ws + WS_AG), (const char*)(F.ws + WS_BTT), (size_t)S5N * S5K * 2, (size_t)256 * S5K * 2, S5K, g, mt};
              EpiS5Out E{(bf16*)(F.ws + WS_GY)};
              pg8::gemm_phase<EpiS5Out, S5One, false>(ring, S5K, S5K, S, E); }
            __syncthreads();
        }
        lru_seq(F, I);
        SEAM(2);
    }
    if (IN(5)) {
        GyOrder S; S.d.init(F.ws + WS_GY, F.ws + WS_WS5, S5W, S5W, T, 2 * D, F.G, cblk);
        EpiYa E{(const bf16*)(F.ws + WS_GA), (bf16*)(F.ws + WS_XL)};
        pg8::gemm_phase<EpiYa, GyOrder, true>(ring, S5W, S5W, S, E, (size_t)4 * T * 32);
        SEAM(5);
    }
    if (IN(6)) {
        DenseOrder S; S.init(F.ws + WS_H, F.ws + WS_WLRU, D, D, T, D, F.G, cblk);
        EpiYb E{(const bf16*)(F.ws + WS_XL), (const bf16*)(F.ws + WS_GB), (bf16*)(F.ws + WS_GL)};
        pg8::gemm_phase<EpiYb, DenseOrder, true>(ring, D, D, S, E);
        SEAM(6);
    }
    if (IN(7)) {
        DenseOrder S; S.init(F.ws + WS_GL, F.ws + WS_WO, D, D, T, D, F.G, cblk);
        EpiWo E{I.p[0], F.out};
        pg8::gemm_phase<EpiWo, DenseOrder, true>(ring, D, D, S, E);
        SEAM(7);
    }
    if (IN(8)) { p8_router(F, I); __syncthreads(); expert_weight_copies(F, I); SEAM(8); }
    if (IN(9)) {
        moe_setup<0>(F);
        MoeOrder<true> S{(const char*)(F.ws + WS_H2), (const char*)(F.ws + WS_WGU), (size_t)1024 * 1024 * 2, D, D, F.G, F.vcu, F.MISC, (const LAS int*)(F.lds + TOKL_OFF)};
        EpiGU E{(bf16*)(F.ws + WS_ACT), (const LAS float*)(F.lds + SCLL_OFF)};
        pg8::gemm_phase<EpiGU, MoeOrder<true>, true>(ring, D, D, S, E);
        SEAM(9);
    }
    if (IN(10)) {
        moe_setup<1>(F);
        MoeOrder<false> S{(const char*)(F.ws + WS_ACT), (const char*)(F.ws + WS_WD), (size_t)1024 * DEXP * 2, DEXP, DEXP, F.G, F.vcu, F.MISC, (const LAS int*)(F.lds + TOKL_OFF)};
        EpiDown E{(bf16*)(F.ws + WS_YS), (const LAS float*)(F.lds + SCLL_OFF)};
        pg8::gemm_phase<EpiDown, MoeOrder<false>, true>(ring, DEXP, DEXP, S, E);
        SEAM(10);
    }
    if (IN(11)) { p11_final(F, I, args.fin_dst); }
#undef IN
#undef SEAM
}

extern "C" void kernel_launch(void* const* d_in, const int* in_sizes, int n_in, void* d_out, int out_size, void* d_ws, size_t ws_size, hipStream_t stream) {
    static int grid = 0;
    if (grid == 0) {
        if (n_in != 30 || in_sizes[0] != T * D || out_size != T * D || ws_size < WS_END) { fprintf(stderr, "kernel_launch: unexpected shapes / workspace (n_in %d, ws %zu)\n", n_in, ws_size); grid = -1; return; }
        int dev = 0, cus = 0, per_cu = 0;
        if (hipGetDevice(&dev) != hipSuccess || hipDeviceGetAttribute(&cus, hipDeviceAttributeMultiprocessorCount, dev) != hipSuccess) { grid = -1; return; }
        if (hipFuncSetAttribute((const void*)mk_fwd, hipFuncAttributeMaxDynamicSharedMemorySize, LDS_BYTES) != hipSuccess) { fprintf(stderr, "kernel_launch: hipFuncSetAttribute failed\n"); grid = -1; return; }
        if (hipOccupancyMaxActiveBlocksPerMultiprocessor(&per_cu, (const void*)mk_fwd, NWAVES * 64, LDS_BYTES) != hipSuccess || per_cu < 1) { fprintf(stderr, "kernel_launch: occupancy query says %d\n", per_cu); }
        (void)hipGetLastError();
        grid = cus;
    }
    if (grid < 0) return;
    if (hipMemsetAsync((char*)d_ws + WS_CTL, 0, CTL_ZERO_BYTES, stream) != hipSuccess) return;
    Args a{};
    for (int i = 0; i < 30; ++i) a.in.p[i] = (const float*)d_in[i];
    a.out = (float*)d_out; a.ws = (unsigned char*)d_ws; a.fin_dst = (float*)d_out;
#if defined(PROBE_LO)
    a.ph_lo = 0; a.ph_hi = PROBE_HI; a.li = 0;
#if PROBE_LO == 11
    a.fin_dst = (float*)((char*)d_ws + WS_H2);
#endif
    hipLaunchKernelGGL(mk_fwd, dim3(grid), dim3(NWAVES * 64), LDS_BYTES, stream, a);
#if PROBE_LO == 8
    hipMemsetAsync((char*)d_ws + WS_CTL + CW_CNT * 4, 0, 128, stream);
#endif
    a.fin_dst = (float*)d_out;
    a.ph_lo = PROBE_LO; a.ph_hi = N_PHASES; a.li = 1;
    hipLaunchKernelGGL(mk_fwd, dim3(grid), dim3(NWAVES * 64), LDS_BYTES, stream, a);
#elif MK_N_LAUNCHES == 1
    a.ph_lo = 0; a.ph_hi = N_PHASES;
    hipLaunchKernelGGL(mk_fwd, dim3(grid), dim3(NWAVES * 64), LDS_BYTES, stream, a);
#else
    for (int p = 0; p < N_PHASES; ++p) { a.ph_lo = p; a.ph_hi = p + 1; hipLaunchKernelGGL(mk_fwd, dim3(grid), dim3(NWAVES * 64), LDS_BYTES, stream, a); }
#endif
}
```

```cpp
#include <hip/hip_runtime.h>
#include <cstdio>
#include <cstdint>

#ifndef MK_N_LAUNCHES
#define MK_N_LAUNCHES 1
#endif

namespace pg8 {
#define PG8_LAS __attribute__((address_space(3)))
typedef unsigned short bf16_t;
typedef short bf16x8 __attribute__((ext_vector_type(8)));
typedef float f32x4 __attribute__((ext_vector_type(4)));
typedef unsigned u32x4 __attribute__((ext_vector_type(4)));
constexpr int BM = 256, BK = 64, HALF = 128, HTB = HALF * BK * 2  , STAGE_BYTES = 8 * HTB, NXCD = 8, WGM = 8;

__host__ __device__ __forceinline__ int lds_byte(int r, int c) { const int st = (r >> 4) * 2 + (c >> 5), rr = r & 15, cc = c & 31, ob = rr * 64 + cc * 2; return st * 1024 + (ob ^ (((ob >> 9) & 1) << 5)); }
__host__ __device__ __forceinline__ void stage_rc(int b, int& R, int& C) { const int st = b / 1024, sb = b % 1024, swz = sb ^ (((sb >> 9) & 1) << 5); R = (st >> 1) * 16 + swz / 64; C = (st & 1) * 32 + (swz % 64) / 2; }
__host__ __device__ __forceinline__ int perm32(int rho) { const int n = rho >> 4, i = rho & 15; return 8 * (i >> 2) + 4 * n + (i & 3); }

struct Unit { const char* A; const char* B; int pm, pn, aux, nt, kind; unsigned kA; };

__device__ __forceinline__ unsigned cvt_pk_bf16(float lo, float hi) { unsigned r; asm volatile("v_cvt_pk_bf16_f32 %0, %1, %2" : "=v"(r) : "v"(lo), "v"(hi)); return r; }

template <class Epi, class Sched, bool ALIGN_EPI>
__device__ __forceinline__ void gemm_phase(PG8_LAS unsigned char* lds, const int ldb, const int K, const Sched& S, const Epi& E, const size_t kstepA = (size_t)(BK * 2)) {
    const int tid = threadIdx.x, wid = __builtin_amdgcn_readfirstlane(tid >> 6), lane = tid & 63, wr = wid >> 2, wc = wid & 3, fr = lane & 15, fq = lane >> 4;
    int nt = K / BK; asm volatile("" : "+s"(nt));
    int Rr[2], Cc[2], Rbb[2]; unsigned voffB[4], vAc[4], vAn[4];
#pragma unroll
    for (int i = 0; i < 2; ++i) { int R, C; stage_rc(tid * 16 + i * 8192, R, C); Rr[i] = R; Cc[i] = C; const int Rb = Epi::PERM ? ((R & ~31) + perm32(R & 31)) : R; Rbb[i] = Rb;
        voffB[i] = (unsigned)(Rb * ldb + C) * 2u; voffB[2 + i] = (unsigned)((HALF + Rb) * ldb + C) * 2u; }
    const size_t kstep = (size_t)(BK * 2);
    const unsigned ldsw = (unsigned)wid * 1024u;
    const int aoff = lds_byte(wr * 64 + fr, fq * 8), boff = lds_byte(wc * 32 + fr, fq * 8);
#define PG8_SA(b, h) (((b) * 2 + (h)) * HTB)
#define PG8_SB(b, h) ((4 + (b) * 2 + (h)) * HTB)
#define PG8_STAGE(bufoff, gbase, voff, h) do { _Pragma("unroll") for (int _i = 0; _i < 2; ++_i) \
        __builtin_amdgcn_global_load_lds((const unsigned*)((const char*)(gbase) + (voff)[2 * (h) + _i]), (PG8_LAS unsigned*)(lds + (bufoff) + ldsw + _i * 8192), 16, 0, 0); } while (0)
#define PG8_LDA(dst, b, h) do { _Pragma("unroll") for (int m = 0; m < 4; ++m) _Pragma("unroll") for (int k = 0; k < 2; ++k) dst[m][k] = *(const PG8_LAS bf16x8*)(lds + PG8_SA(b, h) + aoff + m * 2048 + k * 1024); } while (0)
#define PG8_LDB(dst, b, h) do { _Pragma("unroll") for (int n = 0; n < 2; ++n) _Pragma("unroll") for (int k = 0; k < 2; ++k) dst[n][k] = *(const PG8_LAS bf16x8*)(lds + PG8_SB(b, h) + boff + n * 2048 + k * 1024); } while (0)
#define PG8_MMA(ai, bj, At, Bt) do { __builtin_amdgcn_s_setprio(1); _Pragma("unroll") for (int m = 0; m < 4; ++m) _Pragma("unroll") for (int n = 0; n < 2; ++n) _Pragma("unroll") for (int k = 0; k < 2; ++k) \
        acc[ai][bj][m][n] = __builtin_amdgcn_mfma_f32_16x16x32_bf16(Bt[n][k], At[m][k], acc[ai][bj][m][n], 0, 0, 0); __builtin_amdgcn_s_setprio(0); } while (0)
#define PG8_WAIT_V(n) asm volatile("s_waitcnt vmcnt(" #n ")" ::: "memory")
#define PG8_WAIT_L(n) asm volatile("s_waitcnt lgkmcnt(" #n ")" ::: "memory")
#define PG8_BAR __builtin_amdgcn_s_barrier()
#define PG8_SCHED __builtin_amdgcn_sched_barrier(0)
    Unit cur, nxt; int ui = 0;
    if (!S.next(0, cur)) return;
    S.a_offsets(cur, Rr, Cc, vAc);
    unsigned vBc[4], vBn[4];
    if constexpr (Sched::HETERO) { S.b_offsets(cur, Rbb, Cc, vBc); nt = __builtin_amdgcn_readfirstlane(cur.nt); }
    else {
#pragma unroll
        for (int q = 0; q < 4; ++q) vBc[q] = voffB[q]; }
    size_t kAc = Sched::HETERO ? (size_t)(unsigned)__builtin_amdgcn_readfirstlane((int)cur.kA) : kstepA;
    f32x4 acc[2][2][4][2];
    if constexpr (Epi::ACC_INIT) E.init(acc, cur, wr, wc, fr, fq);
    else {
#pragma unroll
    for (int a = 0; a < 2; ++a)
#pragma unroll
        for (int b = 0; b < 2; ++b)
#pragma unroll
            for (int m = 0; m < 4; ++m)
#pragma unroll
                for (int n = 0; n < 2; ++n) acc[a][b][m][n] = (f32x4){0.f, 0.f, 0.f, 0.f}; }
    bf16x8 At[4][2], B0[2][2], B1[2][2];
    const char* cA = cur.A; const char* cB = cur.B;
    if constexpr (Sched::GATHER) { PG8_WAIT_L(0); }
    PG8_STAGE(PG8_SB(0, 0), cB, vBc, 0); PG8_STAGE(PG8_SB(0, 1), cB, vBc, 1); PG8_STAGE(PG8_SA(0, 0), cA, vAc, 0); PG8_STAGE(PG8_SA(0, 1), cA, vAc, 1);
    if (wr == 1) PG8_BAR;
    PG8_WAIT_V(2); PG8_BAR;
    PG8_STAGE(PG8_SB(1, 0), cB + kstep, vBc, 0); PG8_STAGE(PG8_SA(1, 0), cA + kAc, vAc, 0); PG8_STAGE(PG8_SB(1, 1), cB + kstep, vBc, 1);
    PG8_WAIT_V(6); PG8_BAR;
    for (;;) {
        const bool has_next = S.next(ui + 1, nxt);
        const char* nA = has_next ? nxt.A : cA; const char* nB = has_next ? nxt.B : cB;
        size_t kAn = kAc;
        if constexpr (Sched::HETERO) { if (has_next) { S.b_offsets(nxt, Rbb, Cc, vBn); kAn = (size_t)(unsigned)__builtin_amdgcn_readfirstlane((int)nxt.kA); } else {
#pragma unroll
                for (int q = 0; q < 4; ++q) vBn[q] = vBc[q]; } }
        for (int t = 0; t < nt; t += 2) {
            const bool last = (t == nt - 2);
            const char* a1 = cA + (size_t)(t + 1) * kAc;
            const char* a2 = last ? nA : cA + (size_t)(t + 2) * kAc; const char* b2 = last ? nB : cB + (size_t)(t + 2) * kstep;
            const char* a3 = a2 + (last ? kAn : kAc); const char* b3 = b2 + kstep;
            unsigned vb2[4];
#pragma unroll
            for (int q = 0; q < 4; ++q) vb2[q] = (Sched::HETERO && last) ? vBn[q] : vBc[q];
            unsigned va2[4];
            if constexpr (Sched::GATHER || Sched::HETERO) {
                if (last) { if (has_next) { S.a_offsets(nxt, Rr, Cc, vAn); if constexpr (Sched::GATHER) { PG8_WAIT_L(0); } } else {
#pragma unroll
                        for (int q = 0; q < 4; ++q) vAn[q] = vAc[q]; } }
#pragma unroll
                for (int q = 0; q < 4; ++q) va2[q] = last ? vAn[q] : vAc[q];
            } else {
#pragma unroll
                for (int q = 0; q < 4; ++q) va2[q] = vAc[q];
            }
            PG8_LDB(B0, 0, 0); PG8_LDB(B1, 0, 1); PG8_SCHED; PG8_LDA(At, 0, 0); PG8_STAGE(PG8_SA(1, 1), a1, vAc, 1);
            PG8_WAIT_V(8); PG8_WAIT_L(0); PG8_BAR; PG8_MMA(0, 0, At, B0); PG8_MMA(0, 1, At, B1); PG8_BAR; PG8_SCHED;
            const bool fin = last && !has_next;
            PG8_LDA(At, 0, 1);
            if (!fin) { PG8_STAGE(PG8_SB(0, 0), b2, vb2, 0); PG8_STAGE(PG8_SB(0, 1), b2, vb2, 1); PG8_STAGE(PG8_SA(0, 0), a2, va2, 0); PG8_WAIT_V(8); } else { PG8_WAIT_V(0); }
            PG8_WAIT_L(0); PG8_BAR; PG8_MMA(1, 0, At, B0); PG8_MMA(1, 1, At, B1); PG8_BAR; PG8_SCHED;
            PG8_LDB(B0, 1, 0); PG8_LDB(B1, 1, 1); PG8_SCHED; PG8_LDA(At, 1, 0);
            if (!fin) { PG8_STAGE(PG8_SA(0, 1), a2, va2, 1); PG8_WAIT_V(8); } else { PG8_WAIT_V(0); }
            PG8_WAIT_L(0); PG8_BAR; PG8_MMA(0, 0, At, B0); PG8_MMA(0, 1, At, B1); PG8_BAR; PG8_SCHED;
            PG8_LDA(At, 1, 1);
            if (!fin) { PG8_STAGE(PG8_SB(1, 0), b3, vb2, 0); PG8_STAGE(PG8_SB(1, 1), b3, vb2, 1); PG8_STAGE(PG8_SA(1, 0), a3, va2, 0); PG8_WAIT_V(8); } else { PG8_WAIT_V(0); }
            PG8_WAIT_L(0); PG8_BAR; PG8_MMA(1, 0, At, B0); PG8_MMA(1, 1, At, B1); PG8_BAR; PG8_SCHED;
        }
        if constexpr (ALIGN_EPI) { if (wr == 0) PG8_BAR; }
        E(acc, cur, wr, wc, fr, fq);
        if (!has_next) break;
        if constexpr (Epi::ACC_INIT) E.init(acc, nxt, wr, wc, fr, fq);
        else {
#pragma unroll
        for (int a = 0; a < 2; ++a)
#pragma unroll
            for (int b = 0; b < 2; ++b)
#pragma unroll
                for (int m = 0; m < 4; ++m)
#pragma unroll
                    for (int n = 0; n < 2; ++n) acc[a][b][m][n] = (f32x4){0.f, 0.f, 0.f, 0.f}; }
        cur = nxt; cA = nA; cB = nB; ++ui;
        if constexpr (Sched::GATHER || Sched::HETERO) {
#pragma unroll
            for (int q = 0; q < 4; ++q) vAc[q] = vAn[q]; }
        if constexpr (Sched::HETERO) {
#pragma unroll
            for (int q = 0; q < 4; ++q) vBc[q] = vBn[q];
            kAc = kAn; nt = __builtin_amdgcn_readfirstlane(cur.nt); }
        if constexpr (ALIGN_EPI) { if (wr == 1) PG8_BAR; }
    }
    PG8_WAIT_V(0);
    if constexpr (!ALIGN_EPI) { if (wr == 0) PG8_BAR; }
    PG8_BAR;
#undef PG8_SA
#undef PG8_SB
#undef PG8_STAGE
#undef PG8_LDA
#undef PG8_LDB
#undef PG8_MMA
#undef PG8_WAIT_V
#undef PG8_WAIT_L
#undef PG8_BAR
#undef PG8_SCHED
}
}

constexpr int NWAVES = 8;
constexpr int BATCH = 8, SEQ = 4096, D = 1024, T = BATCH * SEQ;
constexpr int S5W = 512, S5G = 32, S5C = 16, S5P = 64, S5Q = 128;
constexpr int S5LC = 16, S5NCH = SEQ / S5LC, S5N = BATCH * S5NCH;
constexpr int S5K = S5Q + S5LC * S5C;
constexpr int LRUW = 1024, LRUH = 16, LRUHD = 64, LRUCH = 64, LRUNCH = SEQ / LRUCH;
constexpr int NIN = S5W + 2 * LRUW + 2 * D;
constexpr int NEXP = 32, EPG = 8, NGRP = 4, DEXP = 512, NROUT = 48;
constexpr int MAXSLOT = 73728;
constexpr int MAXU = 8;
constexpr float RMS_EPS = 1e-6f;

constexpr size_t MiB = 1u << 20;
constexpr size_t WS_CTL = 0, CTL_ZERO_BYTES = 128 * 1024;
constexpr size_t WS_SMALL = 1 * MiB;
constexpr size_t SM_LAM16 = WS_SMALL + 0;
constexpr size_t SM_LRUC = WS_SMALL + 16384;
constexpr size_t SM_WRT = WS_SMALL + 32768;
constexpr size_t SM_RHI = WS_SMALL + 327680;
constexpr size_t SM_RLO = SM_RHI + 98304;
constexpr size_t SM_RSTD = WS_SMALL + 524288;
constexpr size_t WS_BTT = 2 * MiB;
constexpr size_t WS_BTW = 8 * MiB;
constexpr size_t WS_WIN = 11 * MiB;
constexpr size_t WS_WS5 = 20 * MiB;
constexpr size_t WS_WLRU = 22 * MiB;
constexpr size_t WS_WO = 24 * MiB;
constexpr size_t WS_LP = 26 * MiB, WS_LH = 28 * MiB, WS_LHIN = 30 * MiB;
constexpr size_t WS_AG = 32 * MiB;
constexpr size_t WS_SLOC = 80 * MiB;
constexpr size_t WS_H = 112 * MiB;
constexpr size_t WS_XL = 176 * MiB;
constexpr size_t WS_GL = 240 * MiB;
constexpr size_t WS_GA = 304 * MiB, WS_GB = 336 * MiB;
constexpr size_t WS_GY = 368 * MiB;
constexpr size_t WS_WGU = 400 * MiB;
constexpr size_t WS_WD = 464 * MiB;
constexpr size_t WS_H2 = 32 * MiB;
constexpr size_t WS_ACT = 96 * MiB;
constexpr size_t WS_YS = 168 * MiB;
constexpr size_t WS_LTOK = 312 * MiB, WS_LW = 316 * MiB;
constexpr size_t WS_TOKE = 320 * MiB, WS_TOKR = WS_TOKE + 262144;
constexpr size_t WS_END = 496 * MiB;
static_assert(WS_YS + (size_t)MAXSLOT * 1024 * 2 <= WS_LTOK && WS_ACT + (size_t)MAXSLOT * 512 * 2 <= WS_YS && WS_TOKR + 262144 <= WS_WGU && WS_GY + (size_t)T * 512 * 2 <= WS_WGU && WS_WD + (size_t)32 * 1024 * 512 * 2 <= WS_END, "d_ws map");
constexpr int CW_BAR = 4096;
constexpr int CW_CNT = 16384;

constexpr int RING_BYTES = 131072;
constexpr int TOKL_OFF = RING_BYTES, SCLL_OFF = TOKL_OFF + MAXU * 256 * 4, MISC_OFF = SCLL_OFF + MAXU * 256 * 4;
constexpr int LDS_BYTES = MISC_OFF + 1024;

#define GAS __attribute__((address_space(1)))
#define LAS __attribute__((address_space(3)))
typedef unsigned short bf16;
typedef unsigned v4u __attribute__((ext_vector_type(4)));
typedef unsigned v2u __attribute__((ext_vector_type(2)));
typedef float f32x4 __attribute__((ext_vector_type(4)));
typedef short bf16x8 __attribute__((ext_vector_type(8)));
#define LDS_WAIT() asm volatile("s_waitcnt lgkmcnt(0)" ::: "memory")
#define VM_WAIT() asm volatile("s_waitcnt vmcnt(0)" ::: "memory")
__device__ __forceinline__ unsigned f2bf(float f) { unsigned u = __builtin_bit_cast(unsigned, f); return (u + 0x7fffu + ((u >> 16) & 1u)) >> 16; }
__device__ __forceinline__ float bf2f(unsigned h) { return __builtin_bit_cast(float, h << 16); }
__device__ __forceinline__ unsigned pk2(float lo, float hi) { return f2bf(lo) | (f2bf(hi) << 16); }
__device__ __forceinline__ float bflo(unsigned w) { return __builtin_bit_cast(float, w << 16); }
__device__ __forceinline__ float bfhi(unsigned w) { return __builtin_bit_cast(float, w & 0xffff0000u); }
__device__ __forceinline__ float fsigmoid(float x) { return __builtin_amdgcn_rcpf(1.0f + __builtin_amdgcn_exp2f(-1.44269504f * x)); }
__device__ __forceinline__ float gelu_t(float x) { const float u = x * (0.7978845608f + 0.0356774081f * x * x); return x * __builtin_amdgcn_rcpf(1.0f + __builtin_amdgcn_exp2f(-2.88539008f * u)); }
__device__ __forceinline__ float wave_sum(float v) {
#pragma unroll
    for (int o = 1; o < 64; o <<= 1) v += __shfl_xor(v, o);
    return v;
}

#define XB_TMO      128
#define XB_XCNT(j)  (256  + 64 * (j))
#define XB_XSUB(j)  (1280 + 64 * (j))
#define XB_XGEN(j)  (2304 + 64 * (j))
#define XB_TOP      3328
#define XB_TOPGEN   3392
#define XCD_BAR_WORDS 3456
#define XB_SPIN_CAP (1u << 18)
__device__ __forceinline__ unsigned xb_ld(unsigned* p)              { return __hip_atomic_load(p, __ATOMIC_RELAXED, __HIP_MEMORY_SCOPE_AGENT); }
__device__ __forceinline__ unsigned xb_add(unsigned* p, unsigned v) { return __hip_atomic_fetch_add(p, v, __ATOMIC_RELAXED, __HIP_MEMORY_SCOPE_AGENT); }
__device__ __forceinline__ unsigned xb_xcc_id() { return (unsigned)__builtin_amdgcn_s_getreg((3 << 11) | 20) & 0xFu; }
#define XB_SPIN(cond, bar) do { unsigned _sp = 0; while (cond) { __builtin_amdgcn_s_sleep(1); \
    if ((++_sp & 255u) == 0u) { if (xb_ld(&(bar)[XB_TMO])) break; if (_sp > XB_SPIN_CAP) { atomicAdd(&(bar)[XB_TMO], 1u); break; } } } } while (0)
struct XcdBarrier { unsigned* bar; unsigned x; volatile LAS unsigned* st; };
__device__ __forceinline__ XcdBarrier xcd_barrier_post(unsigned* bar, volatile LAS unsigned* st) {
    XcdBarrier b; b.bar = bar; b.x = xb_xcc_id(); b.st = st;
    if (threadIdx.x == 0) (void)xb_add(&bar[XB_XCNT(b.x)], 1u);
    return b;
}
__device__ __forceinline__ void xcd_barrier_complete(unsigned* bar, unsigned x, unsigned& nloc, unsigned& nx) {
    const unsigned G = gridDim.x * gridDim.y * gridDim.z;
    unsigned sum, cnt, mine, sp = 0u;
    for (;;) {
        sum = 0u; cnt = 0u; mine = 0u;
#pragma unroll
        for (unsigned j = 0; j < 16; ++j) { const unsigned c = xb_ld(&bar[XB_XCNT(j)]); sum += c; cnt += (c > 0u) ? 1u : 0u; mine = (j == x) ? c : mine; }
        if (sum == G) break;
        __builtin_amdgcn_s_sleep(1);
        if ((++sp & 255u) == 0u) { if (xb_ld(&bar[XB_TMO])) break; if (sp > XB_SPIN_CAP) { atomicAdd(&bar[XB_TMO], 1u); break; } }
    }
    nloc = mine > 0u ? mine : 1u; nx = cnt > 0u ? cnt : 1u;
}
__device__ __forceinline__ void xcd_barrier(const XcdBarrier& b) {
    asm volatile("s_waitcnt vmcnt(0)" ::: "memory");
    __syncthreads();
    if (threadIdx.x == 0) {
        unsigned* bar = b.bar;
        __builtin_amdgcn_s_waitcnt(0);
        unsigned nloc = b.st[0], nx = b.st[1];
        if (nloc == 0u) { xcd_barrier_complete(bar, b.x, nloc, nx); b.st[0] = nloc; b.st[1] = nx; }
        const unsigned old = xb_add(&bar[XB_XSUB(b.x)], 1u);
        const unsigned gen = old / nloc;
        if (old + 1u == (gen + 1u) * nloc) {
            __builtin_amdgcn_fence(__ATOMIC_RELEASE, "agent");
            asm volatile("s_waitcnt vmcnt(0)" ::: "memory");
            const unsigned og = xb_add(&bar[XB_TOP], 1u);
            const unsigned tg = og / nx;
            if (og + 1u == (tg + 1u) * nx) xb_add(&bar[XB_TOPGEN], 1u);
            else XB_SPIN(xb_ld(&bar[XB_TOPGEN]) == tg, bar);
            __builtin_amdgcn_fence(__ATOMIC_ACQUIRE, "agent");
            xb_add(&bar[XB_XGEN(b.x)], 1u);
            asm volatile("s_waitcnt vmcnt(0)" ::: "memory");
        } else {
            XB_SPIN(xb_ld(&bar[XB_XGEN(b.x)]) == gen, bar);
            __builtin_amdgcn_fence(__ATOMIC_ACQUIRE, "agent");
            asm volatile("s_waitcnt vmcnt(0)" ::: "memory");
        }
    }
    __syncthreads();
}

struct Frame {
    LAS unsigned char* lds;
    volatile LAS unsigned* MISC;
    unsigned* ctl;
    int tid, lane, wave, vcu, G;
    const float* const* in;
    unsigned char* ws; float* out;
};

using pg8::Unit;
struct DenseOrder {
    static constexpr bool GATHER = false, HETERO = false;
    const char* A0; const char* B0; int lda, ldb, nM, nN, nwg, G, c;
    __device__ __forceinline__ void init(const void* A, const void* B, int lda_, int ldb_, int M, int N, int G_, int c_) { A0 = (const char*)A; B0 = (const char*)B; lda = lda_; ldb = ldb_; nM = M / 256; nN = N / 256; nwg = nM * nN; G = G_; c = c_; }
    __device__ __forceinline__ bool next(int i, Unit& u) const {
        const long L = (long)i * G + c; if (L >= nwg) return false;
        int wgid = (int)L; { const int q = nwg / 8, r = nwg % 8, xcd = wgid % 8, off = wgid / 8; wgid = (xcd < r ? xcd * (q + 1) : r * (q + 1) + (xcd - r) * q) + off; }
        const int nig = 8 * nN, gid = wgid / nig, fm = gid * 8, gsz = (nM - fm) < 8 ? (nM - fm) : 8;
        u.pm = fm + ((wgid % nig) % gsz); u.pn = (wgid % nig) / gsz; u.aux = 0;
        u.A = A0 + (size_t)u.pm * 256 * lda * 2; u.B = B0 + (size_t)u.pn * 256 * ldb * 2; return true;
    }
    __device__ __forceinline__ void a_offsets(const Unit&, const int (&R)[2], const int (&C)[2], unsigned (&v)[4]) const {
#pragma unroll
        for (int i = 0; i < 2; ++i) { v[i] = (unsigned)(R[i] * lda + C[i]) * 2u; v[2 + i] = (unsigned)((128 + R[i]) * lda + C[i]) * 2u; }
    }
};
struct S5One {
    static constexpr bool GATHER = false, HETERO = false;
    const char* A0; const char* B0; size_t sA, sB; int lda, g, mt;
    __device__ __forceinline__ bool next(int i, Unit& u) const {
        if (i > 0) return false;
        u.pm = mt; u.pn = 0; u.aux = g; u.A = A0 + (size_t)g * sA + (size_t)mt * 256 * lda * 2; u.B = B0 + (size_t)g * sB; return true;
    }
    __device__ __forceinline__ void a_offsets(const Unit&, const int (&R)[2], const int (&C)[2], unsigned (&v)[4]) const {
#pragma unroll
        for (int i = 0; i < 2; ++i) { v[i] = (unsigned)(R[i] * lda + C[i]) * 2u; v[2 + i] = (unsigned)((128 + R[i]) * lda + C[i]) * 2u; }
    }
};
struct GyOrder {
    static constexpr bool GATHER = false, HETERO = false;
    DenseOrder d;
    __device__ __forceinline__ bool next(int i, Unit& u) const { if (!d.next(i, u)) return false; u.A = d.A0 + (size_t)u.pm * 256 * 32; return true; }
    __device__ __forceinline__ void a_offsets(const Unit&, const int (&R)[2], const int (&C)[2], unsigned (&v)[4]) const {
#pragma unroll
        for (int i = 0; i < 2; ++i) { const unsigned o = (unsigned)(C[i] >> 4) * (unsigned)(T * 32) + (unsigned)(C[i] & 15) * 2u; v[i] = (unsigned)R[i] * 32u + o; v[2 + i] = (unsigned)(128 + R[i]) * 32u + o; }
    }
};
struct YaYbOrder {
    static constexpr bool GATHER = false, HETERO = true;
    DenseOrder d;
    const char* GYb; const char* WS5b; const char* YLb; const char* WLb;
    __device__ __forceinline__ bool next(int i, Unit& u) const {
        const int j = i / 3, r = i - 3 * j; Unit t;
        if (!d.next(j, t)) return false;
        u.pm = t.pm; u.aux = 0;
        if (r < 2) { u.kind = 0; u.pn = 2 * t.pn + r; u.nt = S5W / 64; u.kA = (unsigned)(4 * T * 32); u.A = GYb + (size_t)t.pm * 256 * 32; u.B = WS5b + (size_t)u.pn * 256 * S5W * 2; }
        else { u.kind = 1; u.pn = t.pn; u.nt = D / 64; u.kA = 128u; u.A = YLb + (size_t)t.pm * 256 * D * 2; u.B = WLb + (size_t)t.pn * 256 * D * 2; }
        return true;
    }
    __device__ __forceinline__ void a_offsets(const Unit& u, const int (&R)[2], const int (&C)[2], unsigned (&v)[4]) const {
#pragma unroll
        for (int i = 0; i < 2; ++i) {
            const unsigned og = (unsigned)(C[i] >> 4) * (unsigned)(T * 32) + (unsigned)(C[i] & 15) * 2u;
            const unsigned g0 = (unsigned)R[i] * 32u + og, g1 = (unsigned)(128 + R[i]) * 32u + og;
            const unsigned d0 = (unsigned)(R[i] * D + C[i]) * 2u, d1 = (unsigned)((128 + R[i]) * D + C[i]) * 2u;
            v[i] = u.kind ? d0 : g0; v[2 + i] = u.kind ? d1 : g1; }
    }
    __device__ __forceinline__ void b_offsets(const Unit& u, const int (&Rb)[2], const int (&C)[2], unsigned (&v)[4]) const {
        const int ldb = u.kind ? D : S5W;
#pragma unroll
        for (int i = 0; i < 2; ++i) { v[i] = (unsigned)(Rb[i] * ldb + C[i]) * 2u; v[2 + i] = (unsigned)((128 + Rb[i]) * ldb + C[i]) * 2u; }
    }
};
template <bool GATH> struct MoeOrder {
    static constexpr bool GATHER = GATH, HETERO = false;
    const char* A0; const char* B0; size_t sBe; int lda, ldb, G, c; volatile LAS unsigned* MISC; const LAS int* tokL;
    __device__ __forceinline__ bool next(int i, Unit& u) const {
        if (i >= (int)MISC[152]) return false;
        const int e = (int)MISC[136 + i], mtg = (int)MISC[96 + e] + (int)MISC[144 + i], L = i * G + c;
        u.pm = mtg; u.pn = L & 3; u.aux = i;
        u.A = GATH ? A0 : A0 + (size_t)mtg * 256 * lda * 2; u.B = B0 + (size_t)e * sBe + (size_t)u.pn * 256 * ldb * 2; return true;
    }
    __device__ __forceinline__ void a_offsets(const Unit& u, const int (&R)[2], const int (&C)[2], unsigned (&v)[4]) const {
#pragma unroll
        for (int i = 0; i < 2; ++i) {
            if constexpr (GATH) { v[i] = (unsigned)tokL[u.aux * 256 + R[i]] * (unsigned)(lda * 2) + (unsigned)C[i] * 2u; v[2 + i] = (unsigned)tokL[u.aux * 256 + 128 + R[i]] * (unsigned)(lda * 2) + (unsigned)C[i] * 2u; }
            else { v[i] = (unsigned)(R[i] * lda + C[i]) * 2u; v[2 + i] = (unsigned)((128 + R[i]) * lda + C[i]) * 2u; } }
    }
};

using pg8::cvt_pk_bf16;
template <int ACT> __device__ __forceinline__ float actf(float x) { if (ACT == 1) return gelu_t(x); if (ACT == 2) return fsigmoid(x); return x; }
__device__ __forceinline__ v4u pack8(const f32x4 a, const f32x4 b) { v4u w; w.x = cvt_pk_bf16(a[0], a[1]); w.y = cvt_pk_bf16(a[2], a[3]); w.z = cvt_pk_bf16(b[0], b[1]); w.w = cvt_pk_bf16(b[2], b[3]); return w; }

__device__ __forceinline__ void unpack_u8x8(const v2u w, float (&f)[8]) {
    const float k = 1.0f / 255.0f;
    f[0] = (float)(w.x & 0xffu) * k; f[1] = (float)((w.x >> 8) & 0xffu) * k; f[2] = (float)((w.x >> 16) & 0xffu) * k; f[3] = (float)(w.x >> 24) * k;
    f[4] = (float)(w.y & 0xffu) * k; f[5] = (float)((w.y >> 8) & 0xffu) * k; f[6] = (float)((w.y >> 16) & 0xffu) * k; f[7] = (float)(w.y >> 24) * k;
}
struct EpiInProj {
    static constexpr bool PERM = true, ACC_INIT = false;
    bf16 *AG, *XL, *GL, *GA, *GB;
    template <int MODE  > __device__ __forceinline__ void tile(const f32x4 (&acc)[2][2][4][2], const Unit& u, bf16* base, int colbase, bool s5, int wr, int wc, int fr, int fq) const {
#pragma unroll
        for (int ai = 0; ai < 2; ++ai)
#pragma unroll
            for (int m = 0; m < 4; ++m) { const int r = u.pm * 256 + ai * 128 + wr * 64 + m * 16 + fr;
#pragma unroll
                for (int bj = 0; bj < 2; ++bj) { const int cl = colbase + bj * 128 + wc * 32 + 8 * fq;
                    f32x4 v0 = acc[ai][bj][m][0], v1 = acc[ai][bj][m][1];
                    if (MODE == 2) {
                        unsigned q[8];
#pragma unroll
                        for (int j = 0; j < 4; ++j) { q[j] = (unsigned)(fsigmoid(v0[j]) * 255.0f + 0.5f); q[4 + j] = (unsigned)(fsigmoid(v1[j]) * 255.0f + 0.5f); }
                        v2u w8; w8.x = q[0] | (q[1] << 8) | (q[2] << 16) | (q[3] << 24); w8.y = q[4] | (q[5] << 8) | (q[6] << 16) | (q[7] << 24);
                        __builtin_nontemporal_store(w8, (v2u*)((unsigned char*)base + (size_t)r * 1024 + cl));
                    } else {
                        if (MODE == 1) {
#pragma unroll
                            for (int j = 0; j < 4; ++j) { v0[j] = gelu_t(v0[j]); v1[j] = gelu_t(v1[j]); } }
                        const v4u w = pack8(v0, v1);
                        const int g = cl >> 4, cp = cl & 15, b = r >> 12, l = r & 4095, n = b * S5NCH + (l >> 4), s = l & 15;
                        const size_t off = s5 ? ((size_t)(g * S5N + n) * S5K + S5Q + s * 16 + cp) : ((size_t)r * 1024 + cl);
                        __builtin_nontemporal_store(w, (v4u*)(base + off)); } }
                asm volatile("" ::: "memory"); }
    }
    __device__ __forceinline__ void operator()(const f32x4 (&acc)[2][2][4][2], const Unit& u, int wr, int wc, int fr, int fq) const {
        const int pn = u.pn, reg = pn < 2 ? 0 : ((pn - 2) >> 2) + 1;
        const int colbase = reg == 0 ? pn * 256 : ((pn - 2) & 3) * 256;
        if (reg < 2) tile<0>(acc, u, reg == 0 ? AG : XL, colbase, reg == 0, wr, wc, fr, fq);
        else if (reg == 2) tile<1>(acc, u, GL, colbase, false, wr, wc, fr, fq);
        else tile<2>(acc, u, reg == 3 ? GA : GB, colbase, false, wr, wc, fr, fq);
    }
};
struct EpiS5State {
    static constexpr bool PERM = false, ACC_INIT = false;
    float* SLOC;
    __device__ __forceinline__ void operator()(const f32x4 (&acc)[2][2][4][2], const Unit& u, int wr, int wc, int fr, int fq) const {
#pragma unroll
        for (int ai = 0; ai < 2; ++ai)
#pragma unroll
            for (int m = 0; m < 4; ++m) { const int nr = u.pm * 256 + ai * 128 + wr * 64 + m * 16 + fr; float* rowp = SLOC + (size_t)(u.aux * S5N + nr) * S5Q + wc * 32 + 4 * fq;
#pragma unroll
                for (int n = 0; n < 2; ++n) *(f32x4*)(rowp + n * 16) = acc[ai][0][m][n]; }
    }
};
struct EpiS5Out {
    static constexpr bool PERM = true, ACC_INIT = false;
    bf16* GY;
    __device__ __forceinline__ void operator()(const f32x4 (&acc)[2][2][4][2], const Unit& u, int wr, int wc, int fr, int fq) const {
#pragma unroll
        for (int ai = 0; ai < 2; ++ai)
#pragma unroll
            for (int m = 0; m < 4; ++m) { const int nr = u.pm * 256 + ai * 128 + wr * 64 + m * 16 + fr, b = nr >> 8, j16 = nr & 255;
#pragma unroll
                for (int bj = 0; bj < 2; ++bj) { const int cc = bj * 128 + wc * 32 + 8 * fq, t = cc >> 4, c0 = cc & 15;
                    f32x4 v0 = acc[ai][bj][m][0], v1 = acc[ai][bj][m][1];
#pragma unroll
                    for (int j = 0; j < 4; ++j) { v0[j] = gelu_t(v0[j]); v1[j] = gelu_t(v1[j]); }
                    *(v4u*)(GY + ((size_t)u.aux * T + (size_t)(b * SEQ + j16 * 16 + t)) * 16 + c0) = pack8(v0, v1); }
                asm volatile("" ::: "memory"); }
    }
};
struct EpiYa {
    static constexpr bool PERM = true, ACC_INIT = false;
    const bf16* GA; bf16* YA;
    __device__ __forceinline__ void operator()(const f32x4 (&acc)[2][2][4][2], const Unit& u, int wr, int wc, int fr, int fq) const {
        const size_t off0 = (size_t)(u.pm * 256 + wr * 64 + fr) * 1024 + u.pn * 128 + wc * 32 + 8 * fq;
        v2u gav[2][4];
#pragma unroll
        for (int ai = 0; ai < 2; ++ai)
#pragma unroll
            for (int m = 0; m < 4; ++m) gav[ai][m] = __builtin_nontemporal_load((const v2u*)((const unsigned char*)GA + off0 + (size_t)(ai * 128 + m * 16) * 1024));
        asm volatile("" ::: "memory");
#pragma unroll
        for (int ai = 0; ai < 2; ++ai)
#pragma unroll
            for (int m = 0; m < 4; ++m) { float gaf[8]; unpack_u8x8(gav[ai][m], gaf);
                f32x4 o0, o1;
#pragma unroll
                for (int j = 0; j < 4; ++j) { o0[j] = gaf[j] * acc[ai][0][m][0][j] * fsigmoid(acc[ai][1][m][0][j]); o1[j] = gaf[4 + j] * acc[ai][0][m][1][j] * fsigmoid(acc[ai][1][m][1][j]); }
                *(v4u*)(YA + off0 + (size_t)(ai * 128 + m * 16) * 1024) = pack8(o0, o1); }
    }
};
struct EpiYb {
    static constexpr bool PERM = true, ACC_INIT = false;
    const bf16* YA; const bf16* GB; bf16* MIX;
    __device__ __forceinline__ void operator()(const f32x4 (&acc)[2][2][4][2], const Unit& u, int wr, int wc, int fr, int fq) const {
        const size_t off0 = (size_t)(u.pm * 256 + wr * 64 + fr) * 1024 + u.pn * 256 + wc * 32 + 8 * fq;
        v4u ya[2][2][2]; v2u gb[2][2][2];
#define YB_LOAD(buf, grp) do { _Pragma("unroll") for (int mm = 0; mm < 2; ++mm) _Pragma("unroll") for (int bj = 0; bj < 2; ++bj) { \
            const size_t o = off0 + (size_t)(((grp) >> 1) * 128 + (2 * ((grp) & 1) + mm) * 16) * 1024 + bj * 128; ya[buf][mm][bj] = *(const v4u*)(YA + o); gb[buf][mm][bj] = __builtin_nontemporal_load((const v2u*)((const unsigned char*)GB + o)); } } while (0)
        YB_LOAD(0, 0);
#pragma unroll
        for (int grp = 0; grp < 4; ++grp) { const int buf = grp & 1, ai = grp >> 1;
            if (grp < 3) YB_LOAD(buf ^ 1, grp + 1);
            asm volatile("" ::: "memory");
#pragma unroll
            for (int mm = 0; mm < 2; ++mm) { const int m = 2 * (grp & 1) + mm;
#pragma unroll
                for (int bj = 0; bj < 2; ++bj) { const v4u y = ya[buf][mm][bj];
                    const float yaf[8] = {bflo(y.x), bfhi(y.x), bflo(y.y), bfhi(y.y), bflo(y.z), bfhi(y.z), bflo(y.w), bfhi(y.w)};
                    float gbf[8]; unpack_u8x8(gb[buf][mm][bj], gbf);
                    f32x4 o0, o1;
#pragma unroll
                    for (int j = 0; j < 4; ++j) { o0[j] = yaf[j] + gbf[j] * acc[ai][bj][m][0][j]; o1[j] = yaf[4 + j] + gbf[4 + j] * acc[ai][bj][m][1][j]; }
                    *(v4u*)(MIX + off0 + (size_t)(ai * 128 + m * 16) * 1024 + bj * 128) = pack8(o0, o1); } }
        }
#undef YB_LOAD
    }
};
struct EpiYaYb {
    static constexpr bool PERM = true, ACC_INIT = false;
    EpiYa a; EpiYb b;
    __device__ __forceinline__ void operator()(const f32x4 (&acc)[2][2][4][2], const Unit& u, int wr, int wc, int fr, int fq) const {
        if (__builtin_amdgcn_readfirstlane(u.kind) == 0) a(acc, u, wr, wc, fr, fq); else b(acc, u, wr, wc, fr, fq);
    }
};
struct EpiWo {
    static constexpr bool PERM = false, ACC_INIT = true;
    const float* X; float* O;
    __device__ __forceinline__ void init(f32x4 (&acc)[2][2][4][2], const Unit& u, int wr, int wc, int fr, int fq) const {
        const size_t off0 = (size_t)(u.pm * 256 + wr * 64 + fr) * 1024 + u.pn * 256 + wc * 32 + 4 * fq;
#pragma unroll
        for (int ai = 0; ai < 2; ++ai)
#pragma unroll
            for (int m = 0; m < 4; ++m)
#pragma unroll
                for (int bj = 0; bj < 2; ++bj)
#pragma unroll
                    for (int n = 0; n < 2; ++n) acc[ai][bj][m][n] = __builtin_nontemporal_load((const f32x4*)(X + off0 + (size_t)(ai * 128 + m * 16) * 1024 + bj * 128 + n * 16));
    }
    __device__ __forceinline__ void operator()(const f32x4 (&acc)[2][2][4][2], const Unit& u, int wr, int wc, int fr, int fq) const {
        const size_t off0 = (size_t)(u.pm * 256 + wr * 64 + fr) * 1024 + u.pn * 256 + wc * 32 + 4 * fq;
#pragma unroll
        for (int ai = 0; ai < 2; ++ai)
#pragma unroll
            for (int m = 0; m < 4; ++m)
#pragma unroll
                for (int bj = 0; bj < 2; ++bj)
#pragma unroll
                    for (int n = 0; n < 2; ++n) *(f32x4*)(O + off0 + (size_t)(ai * 128 + m * 16) * 1024 + bj * 128 + n * 16) = acc[ai][bj][m][n];
    }
};
struct EpiGU {
    static constexpr bool PERM = true, ACC_INIT = false;
    bf16* ACT; const LAS float* sclL;
    __device__ __forceinline__ void operator()(const f32x4 (&acc)[2][2][4][2], const Unit& u, int wr, int wc, int fr, int fq) const {
#pragma unroll
        for (int ai = 0; ai < 2; ++ai)
#pragma unroll
            for (int m = 0; m < 4; ++m) { const int rl = ai * 128 + wr * 64 + m * 16 + fr; const float sc = sclL[u.aux * 256 + rl];
                f32x4 o0, o1;
#pragma unroll
                for (int j = 0; j < 4; ++j) { const float g0 = acc[ai][0][m][0][j] * sc, g1 = acc[ai][0][m][1][j] * sc;
                    o0[j] = g0 * fsigmoid(g0) * (acc[ai][1][m][0][j] * sc); o1[j] = g1 * fsigmoid(g1) * (acc[ai][1][m][1][j] * sc); }
                *(v4u*)(ACT + (size_t)(u.pm * 256 + rl) * DEXP + u.pn * 128 + wc * 32 + 8 * fq) = pack8(o0, o1); }
    }
};
struct EpiDown {
    static constexpr bool PERM = true, ACC_INIT = false;
    bf16* YS; const LAS float* sclL;
    __device__ __forceinline__ void operator()(const f32x4 (&acc)[2][2][4][2], const Unit& u, int wr, int wc, int fr, int fq) const {
#pragma unroll
        for (int ai = 0; ai < 2; ++ai)
#pragma unroll
            for (int m = 0; m < 4; ++m) { const int rl = ai * 128 + wr * 64 + m * 16 + fr; const float sc = sclL[u.aux * 256 + rl];
#pragma unroll
                for (int bj = 0; bj < 2; ++bj)
                    *(v4u*)(YS + (size_t)(u.pm * 256 + rl) * 1024 + u.pn * 256 + bj * 128 + wc * 32 + 8 * fq) = pack8(acc[ai][bj][m][0] * sc, acc[ai][bj][m][1] * sc); }
    }
};

struct TItem { const float* W; int N; bf16* WT; int ldk, k0, n0, drow0; };
__device__ __forceinline__ void transpose_load(const TItem& it, f32x4 (&tv)[8], int lane) {
#pragma unroll
    for (int i = 0; i < 8; ++i) tv[i] = __builtin_nontemporal_load((const f32x4*)(it.W + (size_t)(it.k0 + 8 * i + (lane >> 3)) * it.N + it.n0 + 4 * (lane & 7)));
}
template <bool NT = false> __device__ __forceinline__ void transpose_store(const TItem& it, const f32x4 (&tv)[8], LAS float* scr, int lane) {
#pragma unroll
    for (int i = 0; i < 8; ++i) { LAS float* d = scr + (8 * i + (lane >> 3)) * 33 + 4 * (lane & 7); d[0] = tv[i].x; d[1] = tv[i].y; d[2] = tv[i].z; d[3] = tv[i].w; }
    LDS_WAIT(); asm volatile("" ::: "memory");
    const int c = lane & 7;
#pragma unroll
    for (int j = 0; j < 4; ++j) { const int n = (lane >> 3) + 8 * j; const LAS float* s = scr + (8 * c) * 33 + n;
        v4u o; o.x = pk2(s[0 * 33], s[1 * 33]); o.y = pk2(s[2 * 33], s[3 * 33]); o.z = pk2(s[4 * 33], s[5 * 33]); o.w = pk2(s[6 * 33], s[7 * 33]);
        if (NT) __builtin_nontemporal_store(o, (v4u*)(it.WT + (size_t)(it.drow0 + n) * it.ldk + it.k0 + 8 * c)); else *(v4u*)(it.WT + (size_t)(it.drow0 + n) * it.ldk + it.k0 + 8 * c) = o; }
    LDS_WAIT(); asm volatile("" ::: "memory");
}
__device__ __forceinline__ int ileave_row(int n, int half) { return 256 * (n >> 7) + 128 * half + (n & 127); }

template <int NR> __device__ __forceinline__ void rms_rows_to_bf16(const float* x0, const float* gain, bf16* o0, size_t rstride, int lane) {
    f32x4 v[NR][4];
#pragma unroll
    for (int r = 0; r < NR; ++r) { const f32x4* xr = (const f32x4*)(x0 + r * rstride) + lane;
#pragma unroll
        for (int j = 0; j < 4; ++j) v[r][j] = __builtin_nontemporal_load(xr + 64 * j); }
    asm volatile("" ::: "memory");
    const f32x4* gr = (const f32x4*)gain + lane;
    f32x4 g[4];
#pragma unroll
    for (int j = 0; j < 4; ++j) g[j] = gr[64 * j];
#pragma unroll
    for (int r = 0; r < NR; ++r) { float s = 0.f;
#pragma unroll
        for (int j = 0; j < 4; ++j) s += (v[r][j].x * v[r][j].x + v[r][j].y * v[r][j].y) + (v[r][j].z * v[r][j].z + v[r][j].w * v[r][j].w);
        const float rstd = 1.0f / sqrtf(wave_sum(s) * (1.f / D) + RMS_EPS);
        unsigned long long* o8 = (unsigned long long*)(o0 + r * rstride) + lane;
#pragma unroll
        for (int j = 0; j < 4; ++j) o8[64 * j] = (unsigned long long)pk2(v[r][j].x * rstd * g[j].x, v[r][j].y * rstd * g[j].y) | ((unsigned long long)pk2(v[r][j].z * rstd * g[j].z, v[r][j].w * rstd * g[j].w) << 32); }
}

__device__ __forceinline__ void s5_tables(const Frame& F, int g, const float* lam_re, const float* lam_im, const float* log_dt, const float* b_re, const float* b_im, const float* c_re, const float* c_im, const float* dsk) {
    LAS float* Cre = (LAS float*)F.lds;
    LAS float* Cim = Cre + 1024;
    LAS float* Bre = Cim + 1024;
    LAS float* Bim = Bre + 1024;
    LAS float* Pre = Bim + 1024;
    LAS float* Pim = Pre + 17 * 64;
    LAS float* Kt = Pim + 17 * 64;
    const int tid = F.tid;
    for (int i = tid; i < 1024; i += 512) { Cre[i] = c_re[g * 1024 + i]; Cim[i] = c_im[g * 1024 + i]; }
    if (tid < 64) {
        const int p = tid; const float lr = lam_re[g * 64 + p], li = lam_im[g * 64 + p], dt = expf(log_dt[g]);
        const float er = expf(lr * dt), lbr = er * cosf(li * dt), lbi = er * sinf(li * dt);
        const float den = lr * lr + li * li, nr = lbr - 1.0f, ni = lbi;
        const float cr = (nr * lr + ni * li) / den, ci = (ni * lr - nr * li) / den;
        { float pr = 1.f, pi = 0.f; for (int k = 0; k <= 16; ++k) { Pre[k * 64 + p] = pr; Pim[k * 64 + p] = pi; const float nr2 = pr * lbr - pi * lbi, ni2 = pr * lbi + pi * lbr; pr = nr2; pi = ni2; } }
        for (int c = 0; c < 16; ++c) { const float br = b_re[(g * 64 + p) * 16 + c], bi = b_im[(g * 64 + p) * 16 + c]; Bre[p * 16 + c] = cr * br - ci * bi; Bim[p * 16 + c] = cr * bi + ci * br; }
    }
    __syncthreads();
    for (int e = tid; e < 4096; e += 512) {
        const int k = e >> 8, c = (e >> 4) & 15, cp = e & 15; float s = 0.f;
        for (int p = 0; p < 64; ++p) { const float xr = Cre[c * 64 + p] * Pre[k * 64 + p] - Cim[c * 64 + p] * Pim[k * 64 + p], xi = Cre[c * 64 + p] * Pim[k * 64 + p] + Cim[c * 64 + p] * Pre[k * 64 + p];
            s += xr * Bre[p * 16 + cp] - xi * Bim[p * 16 + cp]; }
        if (k == 0 && c == cp) s += dsk[g * 16 + c];
        Kt[e] = s;
    }
    __syncthreads();
    unsigned* btt = (unsigned*)(F.ws + WS_BTT) + (size_t)g * 256 * (S5K / 2);
    for (int e = tid; e < 256 * (S5K / 2); e += 512) {
        const int row = e / (S5K / 2), cpair = e % (S5K / 2), t = row >> 4, c = row & 15, col = 2 * cpair; float v0, v1;
        if (col < S5Q) { const int p = col >> 1; const float xr = Cre[c * 64 + p] * Pre[(t + 1) * 64 + p] - Cim[c * 64 + p] * Pim[(t + 1) * 64 + p], xi = Cre[c * 64 + p] * Pim[(t + 1) * 64 + p] + Cim[c * 64 + p] * Pre[(t + 1) * 64 + p];
            v0 = xr; v1 = -xi; }
        else { const int s = (col - S5Q) >> 4, cp = (col - S5Q) & 15;
            if (s <= t) { v0 = Kt[(t - s) * 256 + c * 16 + cp]; v1 = Kt[(t - s) * 256 + c * 16 + cp + 1]; } else { v0 = 0.f; v1 = 0.f; } }
        btt[e] = pk2(v0, v1);
    }
    unsigned* btw = (unsigned*)(F.ws + WS_BTW) + (size_t)g * 128 * 128;
    for (int e = tid; e < 128 * 128; e += 512) {
        const int q = e >> 7, cpair = e & 127, col = 2 * cpair, s = col >> 4, cp = col & 15, p = q >> 1, k = 15 - s;
        const float pr = Pre[k * 64 + p], pi = Pim[k * 64 + p];
        float v0, v1;
        if (q & 1) { v0 = pr * Bim[p * 16 + cp] + pi * Bre[p * 16 + cp]; v1 = pr * Bim[p * 16 + cp + 1] + pi * Bre[p * 16 + cp + 1]; }
        else { v0 = pr * Bre[p * 16 + cp] - pi * Bim[p * 16 + cp]; v1 = pr * Bre[p * 16 + cp + 1] - pi * Bim[p * 16 + cp + 1]; }
        btw[e] = pk2(v0, v1);
    }
    if (tid < 64) { float* l16 = (float*)(F.ws + SM_LAM16) + (g * 64 + tid) * 2; l16[0] = Pre[16 * 64 + tid]; l16[1] = Pim[16 * 64 + tid]; }
    __syncthreads();
}

struct In { const float* p[30]; };

__device__ __forceinline__ void p0_prologue(const Frame& F, const In& I) {
    for (int g = F.vcu; g < S5G; g += F.G) s5_tables(F, g, I.p[3], I.p[4], I.p[5], I.p[6], I.p[7], I.p[8], I.p[9], I.p[10]);
    const int gt = F.vcu * 512 + F.tid, NGT = F.G * 512;
    { float* lc = (float*)(F.ws + SM_LRUC); for (int i = gt; i < LRUW; i += NGT) { const float lam = I.p[18][i]; lc[i] = -8.0f * log1pf(expf(-lam)) * 1.44269504f; } }
    { bf16* wrt = (bf16*)(F.ws + SM_WRT);
        for (int i = gt; i < 2 * 65536; i += NGT) { const int which = i >> 16, r = i & 65535, h = r >> 12, j = (r >> 6) & 63, k = r & 63; const float* src = which ? I.p[16] : I.p[14]; wrt[i] = (bf16)f2bf(src[(h * 64 + k) * 64 + j]); } }
    { bf16* rhi = (bf16*)(F.ws + SM_RHI); bf16* rlo = (bf16*)(F.ws + SM_RLO);
        for (int i = gt; i < NROUT * 1024; i += NGT) { const int n = i >> 10, k = i & 1023; float w = 0.f; if (n < 4) w = I.p[22][k * 4 + n]; else if (n < 36) w = I.p[24][k * 32 + (n - 4)];
            const unsigned h = f2bf(w); rhi[i] = (bf16)h; rlo[i] = (bf16)f2bf(w - bf2f(h)); } }
    LAS float* scr = (LAS float*)(F.lds + F.wave * 16384);
    const int gw = F.vcu * NWAVES + F.wave, NGW = F.G * NWAVES;
    constexpr int I_IN = (D / 64) * (NIN / 32), I_S5 = (S5W / 64) * (2 * D / 32), I_LRU = (D / 64) * (D / 32), I_O = I_LRU;
    constexpr int NITEMS = I_IN + I_S5 + I_LRU + I_O;
    for (int it = gw; it < NITEMS; it += NGW) {
        int r = it; TItem ti;
        if (r < I_IN) { const int nb = NIN / 32, kb = r / nb, n0 = 32 * (r % nb); ti = TItem{I.p[2], NIN, (bf16*)(F.ws + WS_WIN), D, 64 * kb, n0, n0}; }
        else if ((r -= I_IN) < I_S5) { const int nb = 2 * D / 32, kb = r / nb, n0 = 32 * (r % nb); ti = TItem{I.p[11], 2 * D, (bf16*)(F.ws + WS_WS5), S5W, 64 * kb, n0, n0 < D ? ileave_row(n0, 0) : ileave_row(n0 - D, 1)}; }
        else if ((r -= I_S5) < I_LRU) { const int nb = D / 32, kb = r / nb, n0 = 32 * (r % nb); ti = TItem{I.p[19], D, (bf16*)(F.ws + WS_WLRU), D, 64 * kb, n0, n0}; }
        else { r -= I_LRU; const int nb = D / 32, kb = r / nb, n0 = 32 * (r % nb); ti = TItem{I.p[20], D, (bf16*)(F.ws + WS_WO), D, 64 * kb, n0, n0}; }
        f32x4 tv[8]; transpose_load(ti, tv, F.lane); asm volatile("" ::: "memory"); transpose_store(ti, tv, scr, F.lane);
    }
    { const int skip = F.G > 2 * S5G ? S5G : 0;
      if (F.vcu >= skip) { const int gw2 = (F.vcu - skip) * NWAVES + F.wave, NGW2 = (F.G - skip) * NWAVES;
        for (int m = gw2 * 4; m < T; m += NGW2 * 4) rms_rows_to_bf16<4>(I.p[0] + (size_t)m * D, I.p[1], (bf16*)(F.ws + WS_H) + (size_t)m * D, D, F.lane); } }
}
__device__ __forceinline__ TItem expert_item(const Frame& F, const In& I, int it) {
    constexpr int I_G = (D / 64) * (DEXP / 32), I_D = (DEXP / 64) * (D / 32);
    const int e = it / (2 * I_G + I_D); int r = it % (2 * I_G + I_D);
    if (r < 2 * I_G) { const int half = r / I_G; r %= I_G; const int nb = DEXP / 32, kb = r / nb, n0 = 32 * (r % nb);
        return TItem{(half ? I.p[27] : I.p[26]) + (size_t)e * D * DEXP, DEXP, (bf16*)(F.ws + WS_WGU) + (size_t)e * 1024 * 1024, D, 64 * kb, n0, ileave_row(n0, half)}; }
    r -= 2 * I_G; const int nb = D / 32, kb = r / nb, n0 = 32 * (r % nb);
    return TItem{I.p[28] + (size_t)e * DEXP * D, D, (bf16*)(F.ws + WS_WD) + (size_t)e * 1024 * DEXP, DEXP, 64 * kb, n0, n0};
}
__device__ __forceinline__ void expert_weight_copies(const Frame& F, const In& I) {
    LAS float* scr = (LAS float*)(F.lds + F.wave * 16384);
    const int gw = F.vcu * NWAVES + F.wave, NGW = F.G * NWAVES;
    constexpr int NIT = NEXP * 768;
    const int first = 8 * NGW < NIT ? 8 * NGW : NIT;
    for (int it = first + gw; it < NIT; it += 2 * NGW) {
        const TItem t0 = expert_item(F, I, it); const bool has1 = it + NGW < NIT; const TItem t1 = expert_item(F, I, has1 ? it + NGW : it);
        f32x4 v0[8], v1[8]; transpose_load(t0, v0, F.lane); transpose_load(t1, v1, F.lane); asm volatile("" ::: "memory");
        transpose_store(t0, v0, scr, F.lane); if (has1) transpose_store(t1, v1, scr, F.lane);
    }
}

__device__ __forceinline__ void lru_seq(const Frame& F, const In& I) {
    LAS unsigned char* wl = F.lds + F.wave * 17920;
    LAS bf16* xcA = (LAS bf16*)wl;
    LAS float* pre = (LAS float*)(wl + 9216);
    typedef float f32x2 __attribute__((ext_vector_type(2)));
    LAS f32x2* sumT = (LAS f32x2*)(F.lds + 143360);
    const int lane = F.lane, jj = lane & 15, ks = lane >> 4, c32 = lane & 31, th = lane >> 5;
    const bf16* XL = (const bf16*)(F.ws + WS_XL); const bf16* GL = (const bf16*)(F.ws + WS_GL); bf16* YL = (bf16*)(F.ws + WS_H);
    const bf16* WRT = (const bf16*)(F.ws + SM_WRT);
    for (int un = F.vcu; un < BATCH * LRUH * 2; un += F.G) {
        const int b = un >> 5, hd = (un >> 1) & 15, half = un & 1;
        const int chin = hd * 64 + lane;
        const int chg = hd * 64 + 32 * half + c32;
        const float w0 = I.p[12][chin], w1 = I.p[12][1024 + chin], w2 = I.p[12][2048 + chin], w3 = I.p[12][3072 + chin], cb = I.p[13][chin];
        const float brs = I.p[15][chg] * -1.44269504f, bis = I.p[17][chg] * -1.44269504f, cch2 = ((const float*)(F.ws + SM_LRUC))[chg];
        bf16x8 Bw[4][2];
#pragma unroll
        for (int n = 0; n < 4; ++n)
#pragma unroll
            for (int k = 0; k < 2; ++k) Bw[n][k] = *(const bf16x8*)(WRT + (size_t)(n >> 1) * 65536 + (size_t)(hd * 64 + 32 * half + 16 * (n & 1) + jj) * 64 + 32 * k + 8 * ks);
        float Rc = 0.f;
        for (int rd = 0; rd < 8; ++rd) {
            const int j = rd * 8 + F.wave;
            const size_t tok0 = (size_t)b * SEQ + (size_t)j * LRUCH;
            unsigned short xr[64], xh[3];
            { const bf16* xp = XL + tok0 * 1024 + chin;
              xh[0] = 0; xh[1] = 0; xh[2] = 0;
              if (j > 0) { xh[0] = xp[-3 * 1024]; xh[1] = xp[-2 * 1024]; xh[2] = xp[-1 * 1024]; }
#pragma unroll
              for (int t = 0; t < 64; ++t) xr[t] = xp[t * 1024]; }
            asm volatile("" ::: "memory");
            { typedef float f2v __attribute__((ext_vector_type(2)));
              float xm3 = bf2f(xh[0]), xm2 = bf2f(xh[1]), xm1 = bf2f(xh[2]);
              const f2v vw0 = {w0, w0}, vw1 = {w1, w1}, vw2 = {w2, w2}, vw3 = {w3, w3}, vcb = {cb, cb};
#pragma unroll
              for (int t = 0; t < 64; t += 2) { const float x0 = bf2f(xr[t]), x1 = bf2f(xr[t + 1]);
                  f2v xc = vcb + vw0 * (f2v){xm3, xm2}; xc = xc + vw1 * (f2v){xm2, xm1}; xc = xc + vw2 * (f2v){xm1, x0}; xc = xc + vw3 * (f2v){x0, x1};
                  const unsigned pk = pg8::cvt_pk_bf16(xc.x, xc.y);
                  xcA[t * 72 + lane] = (bf16)(pk & 0xffffu); xcA[(t + 1) * 72 + lane] = (bf16)(pk >> 16);
                  xm3 = xm1; xm2 = x0; xm1 = x1; } }
            LDS_WAIT();
            float hl[2][16], Pl[2][16], Prun[2], Hrun[2];
#pragma unroll
            for (int st = 0; st < 2; ++st) {
#pragma unroll
                for (int mh = 0; mh < 2; ++mh) { const int mt = 2 * st + mh;
                    bf16x8 a[2];
#pragma unroll
                    for (int k = 0; k < 2; ++k) a[k] = *(const LAS bf16x8*)(xcA + (16 * mt + jj) * 72 + 32 * k + 8 * ks);
#pragma unroll
                    for (int n = 0; n < 4; ++n) { f32x4 d = (f32x4){0.f, 0.f, 0.f, 0.f};
#pragma unroll
                        for (int k = 0; k < 2; ++k) d = __builtin_amdgcn_mfma_f32_16x16x32_bf16(a[k], Bw[n][k], d, 0, 0, 0);
#pragma unroll
                        for (int r = 0; r < 4; ++r) pre[(16 * mh + 4 * ks + r) * 68 + 16 * n + jj] = d[r]; } }
                LDS_WAIT();
                float h = 0.f, P = 1.f;
                typedef float f2v __attribute__((ext_vector_type(2)));
#pragma unroll
                for (int tl = 0; tl < 16; tl += 2) {
                    const int trow = 16 * th + tl;
                    const f2v pr = {pre[trow * 68 + c32], pre[(trow + 1) * 68 + c32]}, pi = {pre[trow * 68 + 32 + c32], pre[(trow + 1) * 68 + 32 + c32]};
                    const f2v zr = pr * (f2v){-1.44269504f, -1.44269504f} + (f2v){brs, brs}, zi = pi * (f2v){-1.44269504f, -1.44269504f} + (f2v){bis, bis};
                    const f2v er = {__builtin_amdgcn_exp2f(zr.x), __builtin_amdgcn_exp2f(zr.y)}, ei = {__builtin_amdgcn_exp2f(zi.x), __builtin_amdgcn_exp2f(zi.y)};
                    const f2v dr = er + (f2v){1.f, 1.f};
                    const f2v rg = {__builtin_amdgcn_rcpf(dr.x), __builtin_amdgcn_rcpf(dr.y)};
                    const f2v la2 = rg * (f2v){cch2, cch2};
                    const f2v a_ = {__builtin_amdgcn_exp2f(la2.x), __builtin_amdgcn_exp2f(la2.y)};
                    const f2v x2 = la2 * (f2v){1.38629436f, 1.38629436f};
                    f2v q = x2 * (f2v){0.0013888889f, 0.0013888889f} + (f2v){0.0083333333f, 0.0083333333f};
                    q = q * x2 + (f2v){0.041666667f, 0.041666667f}; q = q * x2 + (f2v){0.16666667f, 0.16666667f}; q = q * x2 + (f2v){0.5f, 0.5f}; q = q * x2 + (f2v){1.f, 1.f};
                    f2v om = -(q * x2);
                    const f2v alt = (f2v){1.f, 1.f} - a_ * a_;
                    om.x = x2.x > -0.3f ? om.x : alt.x; om.y = x2.y > -0.3f ? om.y : alt.y;
                    om.x = fmaxf(om.x, 1e-30f); om.y = fmaxf(om.y, 1e-30f);
                    const f2v dd = ei + (f2v){1.f, 1.f};
                    const f2v rq = om * dd * dd;
                    const f2v mi = om * (f2v){__builtin_amdgcn_rsqf(rq.x), __builtin_amdgcn_rsqf(rq.y)};
                    const f2v bx = mi * (f2v){bf2f(xcA[(32 * st + trow) * 72 + 32 * half + c32]), bf2f(xcA[(32 * st + trow + 1) * 72 + 32 * half + c32])};
                    h = a_.x * h + bx.x; P *= a_.x; hl[st][tl] = h; Pl[st][tl] = P;
                    h = a_.y * h + bx.y; P *= a_.y; hl[st][tl + 1] = h; Pl[st][tl + 1] = P;
                }
                Prun[st] = P; Hrun[st] = h;
                LDS_WAIT();
            }
            const float pP0 = __shfl_xor(Prun[0], 32), pH0 = __shfl_xor(Hrun[0], 32), pP1 = __shfl_xor(Prun[1], 32), pH1 = __shfl_xor(Hrun[1], 32);
            const float P0 = th ? pP0 : Prun[0], H0 = th ? pH0 : Hrun[0], P1 = th ? Prun[0] : pP0, H1 = th ? Hrun[0] : pH0;
            const float P2 = th ? pP1 : Prun[1], H2 = th ? pH1 : Hrun[1], P3 = th ? Prun[1] : pP1, H3 = th ? Hrun[1] : pH1;
            const float C1 = H0, Q1 = P0, C2 = P1 * C1 + H1, Q2 = P1 * Q1, C3 = P2 * C2 + H2, Q3 = P2 * Q2, Hc = P3 * C3 + H3, Pc = P3 * Q3;
            const float Cs0 = th ? C1 : 0.f, Qs0 = th ? Q1 : 1.f, Cs1 = th ? C3 : C2, Qs1 = th ? Q3 : Q2;
            const int cit = (rd * F.G + F.vcu) * NWAVES + F.wave; const bool cdo = cit < NEXP * 768;
            f32x4 ctv[8]; unsigned short ggr[2][16];
            if (cdo) { const TItem citem = expert_item(F, I, cit); transpose_load(citem, ctv, lane); }
#pragma unroll
            for (int st = 0; st < 2; ++st)
#pragma unroll
                for (int tl = 0; tl < 16; ++tl) ggr[st][tl] = GL[(tok0 + 32 * st + 16 * th + tl) * 1024 + chg];
            asm volatile("" ::: "memory");
            if (th == 0) sumT[((rd & 1) * 8 + F.wave) * 32 + c32] = (f32x2){Pc, Hc};
            LDS_WAIT();
            __syncthreads();
            float cin = Rc, mycin = 0.f;
#pragma unroll
            for (int w = 0; w < 8; ++w) { const f32x2 ph = sumT[((rd & 1) * 8 + w) * 32 + c32]; mycin = (w == F.wave) ? cin : mycin; cin = ph.x * cin + ph.y; }
            Rc = cin;
#pragma unroll
            for (int st = 0; st < 2; ++st) { const float hin = (st ? Cs1 : Cs0) + (st ? Qs1 : Qs0) * mycin;
#pragma unroll
                for (int tl = 0; tl < 16; ++tl) { const float hh = hl[st][tl] + Pl[st][tl] * hin;
                    YL[(tok0 + 32 * st + 16 * th + tl) * 1024 + chg] = (bf16)f2bf(hh * bf2f(ggr[st][tl])); } }
            if (cdo) { const TItem citem = expert_item(F, I, cit); transpose_store<true>(citem, ctv, pre, lane); }
        }
        __syncthreads();
    }
}

__device__ __forceinline__ void s5_chain(const Frame& F, int b, int g) {
    typedef float f32x2 __attribute__((ext_vector_type(2)));
    LAS f32x2* segE = (LAS f32x2*)(F.lds);
    const int lane = F.lane, w = F.wave;
    const float* SLOC = (const float*)(F.ws + WS_SLOC); unsigned* AGw = (unsigned*)(F.ws + WS_AG); const float* L16 = (const float*)(F.ws + SM_LAM16);
    const float lr = L16[(g * 64 + lane) * 2], li = L16[(g * 64 + lane) * 2 + 1];
    const float* sl = SLOC + ((size_t)(g * S5N + b * S5NCH + 32 * w)) * S5Q + 2 * lane;
    unsigned* ag = AGw + ((size_t)(g * S5N + b * S5NCH + 32 * w)) * (S5K / 2) + lane;
    float xr[32], xi[32];
#pragma unroll
    for (int u = 0; u < 32; ++u) { const float2 v = *(const float2*)(sl + (size_t)u * S5Q); xr[u] = v.x; xi[u] = v.y; }
    asm volatile("" ::: "memory");
    float sr = 0.f, si = 0.f;
#pragma unroll
    for (int u = 0; u < 32; ++u) { const float nr = lr * sr - li * si + xr[u], ni = lr * si + li * sr + xi[u]; xr[u] = sr; xi[u] = si; sr = nr; si = ni; }
    segE[w * 64 + lane] = (f32x2){sr, si};
    float qr = lr, qi = li;
#pragma unroll
    for (int k = 0; k < 5; ++k) { const float nr = qr * qr - qi * qi, ni = 2.f * qr * qi; qr = nr; qi = ni; }
    LDS_WAIT();
    __syncthreads();
    float cr = 0.f, ci = 0.f;
    for (int ww = 0; ww < w; ++ww) { const f32x2 e = segE[ww * 64 + lane]; const float nr = qr * cr - qi * ci + e.x, ni = qr * ci + qi * cr + e.y; cr = nr; ci = ni; }
#pragma unroll
    for (int u = 0; u < 32; ++u) { ag[(size_t)u * (S5K / 2)] = pk2(xr[u] + cr, xi[u] + ci); const float nr = lr * cr - li * ci, ni = lr * ci + li * cr; cr = nr; ci = ni; }
    __syncthreads();
}

__device__ __forceinline__ void p8_router(const Frame& F, const In& I) {
    const int lane = F.lane, tk = lane & 15, ks = lane >> 4;
    LAS float* lg = (LAS float*)(F.lds + F.wave * 4096);
    volatile LAS unsigned* cntL = F.MISC + 32; volatile LAS unsigned* baseL = F.MISC + 64;
    const float* X1 = F.out; bf16* H2 = (bf16*)(F.ws + WS_H2); const float* gf = I.p[21];
    const bf16* RHI = (const bf16*)(F.ws + SM_RHI); const bf16* RLO = (const bf16*)(F.ws + SM_RLO);
    float* RSTD = (float*)(F.ws + SM_RSTD); unsigned* gcnt = F.ctl + CW_CNT;
    int* LTOK = (int*)(F.ws + WS_LTOK); float* LW = (float*)(F.ws + WS_LW); int* TOKE = (int*)(F.ws + WS_TOKE); int* TOKR = (int*)(F.ws + WS_TOKR);
    for (int blk = F.vcu; blk < T / 128; blk += F.G) {
        if (F.tid < 32) cntL[F.tid] = 0u;
        __syncthreads();
        const int tok0 = blk * 128 + F.wave * 16;
        const float* xrow = X1 + (size_t)(tok0 + tk) * D + 8 * ks; bf16* hrow = H2 + (size_t)(tok0 + tk) * D + 8 * ks;
        f32x4 acc[3]; acc[0] = acc[1] = acc[2] = (f32x4){0.f, 0.f, 0.f, 0.f}; float ss = 0.f;
        f32x4 xnx[4][2];
#pragma unroll
        for (int q = 0; q < 4; ++q) { xnx[q][0] = __builtin_nontemporal_load((const f32x4*)(xrow + 32 * q)); xnx[q][1] = __builtin_nontemporal_load((const f32x4*)(xrow + 32 * q + 4)); }
        LAS bf16* slab = (LAS bf16*)(F.lds + 32768);
        v4u wst[3];
#define RT_SLAB_LOAD(g) do { _Pragma("unroll") for (int j = 0; j < 3; ++j) { const int c = F.tid + 512 * j, which = c / 768, r = (c % 768) >> 4, kq = c & 15; \
            wst[j] = *(const v4u*)((which ? RLO : RHI) + (size_t)r * D + 128 * (g) + 8 * kq); } } while (0)
#define RT_SLAB_STORE(buf) do { _Pragma("unroll") for (int j = 0; j < 3; ++j) { const int c = F.tid + 512 * j, which = c / 768, r = (c % 768) >> 4, kq = c & 15; \
            *(LAS v4u*)(slab + ((size_t)((buf) * 2 + which) * 48 + r) * 136 + 8 * kq) = wst[j]; } } while (0)
        RT_SLAB_LOAD(0); RT_SLAB_STORE(0);
        LDS_WAIT();
        __syncthreads();
        for (int kg = 0; kg < 8; ++kg) {
            f32x4 xa[4][2];
#pragma unroll
            for (int q = 0; q < 4; ++q) { xa[q][0] = xnx[q][0]; xa[q][1] = xnx[q][1]; }
            { const int kgn = kg < 7 ? kg + 1 : kg;
#pragma unroll
              for (int q = 0; q < 4; ++q) { xnx[q][0] = __builtin_nontemporal_load((const f32x4*)(xrow + 32 * (4 * kgn + q))); xnx[q][1] = __builtin_nontemporal_load((const f32x4*)(xrow + 32 * (4 * kgn + q) + 4)); }
              RT_SLAB_LOAD(kgn); }
            f32x4 ga[4][2];
#pragma unroll
            for (int q = 0; q < 4; ++q) { const int kc = 4 * kg + q; ga[q][0] = *(const f32x4*)(gf + 32 * kc + 8 * ks); ga[q][1] = *(const f32x4*)(gf + 32 * kc + 8 * ks + 4); }
            asm volatile("" ::: "memory");
            const LAS bf16* sh = slab + (size_t)((kg & 1) * 2) * 48 * 136, * sl = sh + 48 * 136;
#pragma unroll
            for (int q = 0; q < 4; ++q) { const int kc = 4 * kg + q;
                const f32x4 a0 = xa[q][0], a1 = xa[q][1];
                ss += (a0.x * a0.x + a0.y * a0.y) + (a0.z * a0.z + a0.w * a0.w) + (a1.x * a1.x + a1.y * a1.y) + (a1.z * a1.z + a1.w * a1.w);
                const f32x4 v0 = a0 * ga[q][0], v1 = a1 * ga[q][1];
                v4u hi, lo;
                { const unsigned h0 = f2bf(v0.x), h1 = f2bf(v0.y), h2 = f2bf(v0.z), h3 = f2bf(v0.w), h4 = f2bf(v1.x), h5 = f2bf(v1.y), h6 = f2bf(v1.z), h7 = f2bf(v1.w);
                  hi.x = h0 | (h1 << 16); hi.y = h2 | (h3 << 16); hi.z = h4 | (h5 << 16); hi.w = h6 | (h7 << 16);
                  lo.x = pk2(v0.x - bf2f(h0), v0.y - bf2f(h1)); lo.y = pk2(v0.z - bf2f(h2), v0.w - bf2f(h3)); lo.z = pk2(v1.x - bf2f(h4), v1.y - bf2f(h5)); lo.w = pk2(v1.z - bf2f(h6), v1.w - bf2f(h7)); }
                *(v4u*)(hrow + 32 * kc) = hi;
                const bf16x8 hf = __builtin_bit_cast(bf16x8, hi), lf = __builtin_bit_cast(bf16x8, lo);
#pragma unroll
                for (int n = 0; n < 3; ++n) {
                    const bf16x8 wh = *(const LAS bf16x8*)(sh + (16 * n + tk) * 136 + 32 * q + 8 * ks), wl = *(const LAS bf16x8*)(sl + (16 * n + tk) * 136 + 32 * q + 8 * ks);
                    acc[n] = __builtin_amdgcn_mfma_f32_16x16x32_bf16(wh, hf, acc[n], 0, 0, 0);
                    acc[n] = __builtin_amdgcn_mfma_f32_16x16x32_bf16(wh, lf, acc[n], 0, 0, 0);
                    acc[n] = __builtin_amdgcn_mfma_f32_16x16x32_bf16(wl, hf, acc[n], 0, 0, 0);
                } }
            if (kg < 7) RT_SLAB_STORE((kg + 1) & 1);
            LDS_WAIT();
            __syncthreads();
        }
#undef RT_SLAB_LOAD
#undef RT_SLAB_STORE
        ss += __shfl_xor(ss, 16); ss += __shfl_xor(ss, 32);
        const float rstd = 1.0f / sqrtf(ss * (1.f / D) + RMS_EPS);
        if (ks == 0) RSTD[tok0 + tk] = rstd;
#pragma unroll
        for (int n = 0; n < 3; ++n)
#pragma unroll
            for (int r = 0; r < 4; ++r) lg[tk * 49 + 16 * n + 4 * ks + r] = acc[n][r] * rstd;
        LDS_WAIT();
        int E1 = 0, E2 = 0; float w1 = 0.f, w2 = 0.f; unsigned r1 = 0, r2 = 0;
        if (lane < 16) {
            const LAS float* my = lg + lane * 49;
            float lgp[4];
#pragma unroll
            for (int i = 0; i < 4; ++i) lgp[i] = my[i] + I.p[23][i];
            int gi = 0; float mx = lgp[0];
#pragma unroll
            for (int i = 1; i < 4; ++i) if (lgp[i] > mx) { mx = lgp[i]; gi = i; }
            float den = 0.f;
#pragma unroll
            for (int i = 0; i < 4; ++i) den += expf(lgp[i] - mx);
            const float pg = 1.0f / den;
            float le[8];
#pragma unroll
            for (int i = 0; i < 8; ++i) le[i] = my[4 + gi * 8 + i] + I.p[25][gi * 8 + i];
            int i1 = 0; float m1 = le[0];
#pragma unroll
            for (int i = 1; i < 8; ++i) if (le[i] > m1) { m1 = le[i]; i1 = i; }
            int i2 = -1; float m2 = -3.0e38f;
#pragma unroll
            for (int i = 0; i < 8; ++i) if (i != i1 && le[i] > m2) { m2 = le[i]; i2 = i; }
            const float e2 = expf(m2 - m1);
            w1 = pg / (1.0f + e2); w2 = pg * e2 / (1.0f + e2);
            E1 = gi * 8 + i1; E2 = gi * 8 + i2;
            r1 = __hip_atomic_fetch_add((LAS unsigned*)(F.MISC + 32) + E1, 1u, __ATOMIC_RELAXED, __HIP_MEMORY_SCOPE_WORKGROUP);
            r2 = __hip_atomic_fetch_add((LAS unsigned*)(F.MISC + 32) + E2, 1u, __ATOMIC_RELAXED, __HIP_MEMORY_SCOPE_WORKGROUP);
        }
        LDS_WAIT();
        __syncthreads();
        if (F.tid < 32) { const unsigned c = cntL[F.tid]; baseL[F.tid] = c ? __hip_atomic_fetch_add(gcnt + F.tid, c, __ATOMIC_RELAXED, __HIP_MEMORY_SCOPE_AGENT) : 0u; }
        __syncthreads();
        if (lane < 16) {
            const int tok = tok0 + lane; const int k1 = (int)(baseL[E1] + r1), k2 = (int)(baseL[E2] + r2);
            LTOK[(size_t)E1 * T + k1] = tok; LW[(size_t)E1 * T + k1] = w1; LTOK[(size_t)E2 * T + k2] = tok; LW[(size_t)E2 * T + k2] = w2;
            TOKE[tok * 2] = E1; TOKE[tok * 2 + 1] = E2; TOKR[tok * 2] = k1; TOKR[tok * 2 + 1] = k2;
        }
        __syncthreads();
    }
}

__device__ __forceinline__ void moe_prefix(const Frame& F) {
    if (F.tid < 64) {
        const unsigned nt = F.tid < NEXP ? (F.ctl[CW_CNT + F.tid] + 255u) >> 8 : 0u; unsigned inc = nt;
#pragma unroll
        for (int o = 1; o < 32; o <<= 1) { const unsigned v = __shfl_up(inc, o); if (F.lane >= o) inc += v; }
        if (F.tid < NEXP) F.MISC[96 + F.tid] = inc - nt;
        if (F.tid == NEXP - 1) F.MISC[128] = inc;
    }
    LDS_WAIT();
    __syncthreads();
}
template <int MODE  >
__device__ __forceinline__ void moe_setup(const Frame& F) {
    moe_prefix(F);
    const int NT = (int)F.MISC[128];
    if (F.tid < MAXU) { const int L = F.tid * F.G + F.vcu; int e = -1, mt = 0;
        if (L < NT * 4) { const int mtg = L >> 2; e = 0; while (e < NEXP - 1 && (int)F.MISC[96 + e + 1] <= mtg) ++e; mt = mtg - (int)F.MISC[96 + e]; }
        F.MISC[136 + F.tid] = (unsigned)e; F.MISC[144 + F.tid] = (unsigned)mt; }
    __syncthreads();
    if (F.tid == 0) { int n = 0; while (n < MAXU && (int)F.MISC[136 + n] >= 0) ++n; F.MISC[152] = (unsigned)n; }
    __syncthreads();
    const int nU = (int)F.MISC[152];
    LAS int* tokL = (LAS int*)(F.lds + TOKL_OFF); LAS float* sclL = (LAS float*)(F.lds + SCLL_OFF);
    const int* LTOK = (const int*)(F.ws + WS_LTOK); const float* LW = (const float*)(F.ws + WS_LW); const float* RSTD = (const float*)(F.ws + SM_RSTD);
    for (int i = F.tid; i < nU * 256; i += 512) { const int ui = i >> 8, r = i & 255, e = (int)F.MISC[136 + ui], rank = (int)F.MISC[144 + ui] * 256 + r; const bool valid = rank < (int)F.ctl[CW_CNT + e];
        const int tok = valid ? LTOK[(size_t)e * T + rank] : 0; tokL[i] = tok; sclL[i] = valid ? (MODE == 0 ? RSTD[tok] : LW[(size_t)e * T + rank]) : 0.f; }
    LDS_WAIT(); VM_WAIT();
    __syncthreads();
}

__device__ __forceinline__ void p11_final(const Frame& F, const In& I, float* dst) {
    moe_prefix(F);
    const int gw = F.vcu * NWAVES + F.wave, NGW = F.G * NWAVES, lane = F.lane;
    const int* TOKE = (const int*)(F.ws + WS_TOKE); const int* TOKR = (const int*)(F.ws + WS_TOKR); const bf16* YS = (const bf16*)(F.ws + WS_YS);
    f32x4 gfin[4];
#pragma unroll
    for (int j = 0; j < 4; ++j) gfin[j] = ((const f32x4*)I.p[29])[lane + 64 * j];
    int ee[2][2], rr[2][2];
    { const int m0 = gw * 2 < T ? gw * 2 : 0;
#pragma unroll
      for (int q = 0; q < 2; ++q) { ee[q][0] = TOKE[2 * (m0 + q)]; ee[q][1] = TOKE[2 * (m0 + q) + 1]; rr[q][0] = TOKR[2 * (m0 + q)]; rr[q][1] = TOKR[2 * (m0 + q) + 1]; } }
    for (int m0 = gw * 2; m0 < T; m0 += NGW * 2) {
        f32x4 xv[2][4]; v2u ya[2][4], yb[2][4];
#pragma unroll
        for (int q = 0; q < 2; ++q) { const size_t s0 = (size_t)F.MISC[96 + ee[q][0]] * 256 + rr[q][0], s1 = (size_t)F.MISC[96 + ee[q][1]] * 256 + rr[q][1];
            const f32x4* xr = (const f32x4*)(F.out + (size_t)(m0 + q) * D) + lane; const v2u* y0 = (const v2u*)(YS + s0 * 1024) + lane; const v2u* y1 = (const v2u*)(YS + s1 * 1024) + lane;
#pragma unroll
            for (int j = 0; j < 4; ++j) { xv[q][j] = __builtin_nontemporal_load(xr + 64 * j); ya[q][j] = __builtin_nontemporal_load(y0 + 64 * j); yb[q][j] = __builtin_nontemporal_load(y1 + 64 * j); } }
        { const int mn = m0 + NGW * 2 < T ? m0 + NGW * 2 : m0;
#pragma unroll
          for (int q = 0; q < 2; ++q) { ee[q][0] = TOKE[2 * (mn + q)]; ee[q][1] = TOKE[2 * (mn + q) + 1]; rr[q][0] = TOKR[2 * (mn + q)]; rr[q][1] = TOKR[2 * (mn + q) + 1]; } }
        asm volatile("" ::: "memory");
#pragma unroll
        for (int q = 0; q < 2; ++q) { f32x4 v[4]; float s = 0.f;
#pragma unroll
            for (int j = 0; j < 4; ++j) { const f32x4 x = xv[q][j]; const v2u a = ya[q][j], b = yb[q][j];
                v[j].x = x.x + bflo(a.x) + bflo(b.x); v[j].y = x.y + bfhi(a.x) + bfhi(b.x); v[j].z = x.z + bflo(a.y) + bflo(b.y); v[j].w = x.w + bfhi(a.y) + bfhi(b.y);
                s += (v[j].x * v[j].x + v[j].y * v[j].y) + (v[j].z * v[j].z + v[j].w * v[j].w); }
            const float rstd = 1.0f / sqrtf(wave_sum(s) * (1.f / D) + RMS_EPS);
            f32x4* xw = (f32x4*)(dst + (size_t)(m0 + q) * D) + lane;
#pragma unroll
            for (int j = 0; j < 4; ++j) { const f32x4 g = gfin[j]; __builtin_nontemporal_store((f32x4){v[j].x * rstd * g.x, v[j].y * rstd * g.y, v[j].z * rstd * g.z, v[j].w * rstd * g.w}, xw + 64 * j); } }
    }
}

constexpr int N_PHASES = 12;
struct Args { In in; float* out; unsigned char* ws; float* fin_dst; int ph_lo, ph_hi, li, pad; };
__global__ void __launch_bounds__(NWAVES * 64, 2) mk_fwd(Args args) {
    extern __shared__ __attribute__((aligned(16))) unsigned char lds[];
    Frame F;
    F.lds = (LAS unsigned char*)lds;
    F.MISC = (volatile LAS unsigned*)(F.lds + MISC_OFF);
    F.tid = threadIdx.x; F.lane = F.tid & 63; F.wave = __builtin_amdgcn_readfirstlane(F.tid >> 6);
    F.G = gridDim.x; { const int bx = blockIdx.x; F.vcu = (F.G % 8 == 0) ? (bx % 8) * (F.G / 8) + bx / 8 : bx; }
    F.ws = args.ws; F.out = args.out; F.ctl = (unsigned*)(args.ws + WS_CTL); F.in = nullptr;
    const In& I = args.in;
    for (int u = F.tid; u < 256; u += NWAVES * 64) F.MISC[u] = 0u;
    __syncthreads();
    const int lo = args.ph_lo, hi = args.ph_hi;
    XcdBarrier bar; bar.bar = F.ctl + CW_BAR + args.li * XCD_BAR_WORDS; bar.x = 0; bar.st = nullptr;
    if (hi - lo > 1) bar = xcd_barrier_post(F.ctl + CW_BAR + args.li * XCD_BAR_WORDS, F.MISC + 8);
#ifndef PH_MASK
#define PH_MASK 0xFFF
#endif
#define IN(k) (((PH_MASK >> (k)) & 1) && lo <= (k) && (k) < hi)
#define SEAM(k) do { if (IN(k) && IN(NEXT_PH(k))) xcd_barrier(bar); } while (0)
#define NEXT_PH(k) ((k) == 2 ? 5 : (k) == 5 ? 7 : (k) + 1)
    const int cblk = (int)blockIdx.x;
    LAS unsigned char* ring = F.lds;

    if (IN(0)) { p0_prologue(F, I); SEAM(0); }

    if (IN(1)) {
        DenseOrder S; S.init(F.ws + WS_H, F.ws + WS_WIN, D, D, T, NIN, F.G, cblk);
        EpiInProj E{(bf16*)(F.ws + WS_AG), (bf16*)(F.ws + WS_XL), (bf16*)(F.ws + WS_GL), (bf16*)(F.ws + WS_GA), (bf16*)(F.ws + WS_GB)};
        pg8::gemm_phase<EpiInProj, DenseOrder, true>(ring, D, D, S, E);
        SEAM(1);
    }
    if (IN(2)) {
        if (cblk < 256) {
            const int L = cblk, wgid = (L % 8) * 32 + L / 8, g = wgid >> 3, mt = wgid & 7;
            { S5One S{(const char*)(F.ws + WS_AG) + S5Q * 2, (const char*)(F.ws + WS_BTW), (size_t)S5N * S5K * 2, (size_t)128 * 256 * 2, S5K, g, mt};
              EpiS5State E{(float*)(F.ws + WS_SLOC)};
              pg8::gemm_phase<EpiS5State, S5One, false>(ring, 256, 256, S, E); }
            if (F.wave == 0) { __builtin_amdgcn_fence(__ATOMIC_ACQUIRE, "agent"); VM_WAIT(); }
            __syncthreads();
            s5_chain(F, mt, g);
            VM_WAIT();
            __syncthreads();
            if (F.wave == 0) { __builtin_amdgcn_fence(__ATOMIC_ACQUIRE, "agent"); VM_WAIT(); }
            __syncthreads();
            { S5One S{(const char*)(F.ws + WS_AG), (const char*)(F.ws + WS_BTT), (size_t)S5N * S5K * 2, (size_t)256 * S5K * 2, S5K, g, mt};
              EpiS5Out E{(bf16*)(F.ws + WS_GY)};
              pg8::gemm_phase<EpiS5Out, S5One, false>(ring, S5K, S5K, S, E); }
            __syncthreads();
        }
        lru_seq(F, I);
        SEAM(2);
    }
    if (IN(5)) {
        YaYbOrder S; S.d.init(nullptr, nullptr, D, D, T, D, F.G, cblk);
        S.GYb = (const char*)(F.ws + WS_GY); S.WS5b = (const char*)(F.ws + WS_WS5); S.YLb = (const char*)(F.ws + WS_H); S.WLb = (const char*)(F.ws + WS_WLRU);
        EpiYaYb E{EpiYa{(const bf16*)(F.ws + WS_GA), (bf16*)(F.ws + WS_XL)}, EpiYb{(const bf16*)(F.ws + WS_XL), (const bf16*)(F.ws + WS_GB), (bf16*)(F.ws + WS_GL)}};
        pg8::gemm_phase<EpiYaYb, YaYbOrder, true>(ring, D, D, S, E);
        SEAM(5);
    }
    if (IN(7)) {
        DenseOrder S; S.init(F.ws + WS_GL, F.ws + WS_WO, D, D, T, D, F.G, cblk);
        EpiWo E{I.p[0], F.out};
        pg8::gemm_phase<EpiWo, DenseOrder, true>(ring, D, D, S, E);
        SEAM(7);
    }
    if (IN(8)) { p8_router(F, I); __syncthreads(); expert_weight_copies(F, I); SEAM(8); }
    if (IN(9)) {
        moe_setup<0>(F);
        MoeOrder<true> S{(const char*)(F.ws + WS_H2), (const char*)(F.ws + WS_WGU), (size_t)1024 * 1024 * 2, D, D, F.G, F.vcu, F.MISC, (const LAS int*)(F.lds + TOKL_OFF)};
        EpiGU E{(bf16*)(F.ws + WS_ACT), (const LAS float*)(F.lds + SCLL_OFF)};
        pg8::gemm_phase<EpiGU, MoeOrder<true>, true>(ring, D, D, S, E);
        SEAM(9);
    }
    if (IN(10)) {
        moe_setup<1>(F);
        MoeOrder<false> S{(const char*)(F.ws + WS_ACT), (const char*)(F.ws + WS_WD), (size_t)1024 * DEXP * 2, DEXP, DEXP, F.G, F.vcu, F.MISC, (const LAS int*)(F.lds + TOKL_OFF)};
        EpiDown E{(bf16*)(F.ws + WS_YS), (const LAS float*)(F.lds + SCLL_OFF)};
        pg8::gemm_phase<EpiDown, MoeOrder<false>, true>(ring, DEXP, DEXP, S, E);
        SEAM(10);
    }
    if (IN(11)) { p11_final(F, I, args.fin_dst); }
#undef IN
#undef SEAM
}

extern "C" void kernel_launch(void* const* d_in, const int* in_sizes, int n_in, void* d_out, int out_size, void* d_ws, size_t ws_size, hipStream_t stream) {
    static int grid = 0;
    if (grid == 0) {
        if (n_in != 30 || in_sizes[0] != T * D || out_size != T * D || ws_size < WS_END) { fprintf(stderr, "kernel_launch: unexpected shapes / workspace (n_in %d, ws %zu)\n", n_in, ws_size); grid = -1; return; }
        int dev = 0, cus = 0, per_cu = 0;
        if (hipGetDevice(&dev) != hipSuccess || hipDeviceGetAttribute(&cus, hipDeviceAttributeMultiprocessorCount, dev) != hipSuccess) { grid = -1; return; }
        if (hipFuncSetAttribute((const void*)mk_fwd, hipFuncAttributeMaxDynamicSharedMemorySize, LDS_BYTES) != hipSuccess) { fprintf(stderr, "kernel_launch: hipFuncSetAttribute failed\n"); grid = -1; return; }
        if (hipOccupancyMaxActiveBlocksPerMultiprocessor(&per_cu, (const void*)mk_fwd, NWAVES * 64, LDS_BYTES) != hipSuccess || per_cu < 1) { fprintf(stderr, "kernel_launch: occupancy query says %d\n", per_cu); }
        (void)hipGetLastError();
        grid = cus;
    }
    if (grid < 0) return;
    if (hipMemsetAsync((char*)d_ws + WS_CTL, 0, CTL_ZERO_BYTES, stream) != hipSuccess) return;
    Args a{};
    for (int i = 0; i < 30; ++i) a.in.p[i] = (const float*)d_in[i];
    a.out = (float*)d_out; a.ws = (unsigned char*)d_ws; a.fin_dst = (float*)d_out;
#if defined(PROBE_LO)
    a.ph_lo = 0; a.ph_hi = PROBE_HI; a.li = 0;
#if PROBE_LO == 11
    a.fin_dst = (float*)((char*)d_ws + WS_H2);
#endif
    hipLaunchKernelGGL(mk_fwd, dim3(grid), dim3(NWAVES * 64), LDS_BYTES, stream, a);
#if PROBE_LO == 8
    hipMemsetAsync((char*)d_ws + WS_CTL + CW_CNT * 4, 0, 128, stream);
#endif
    a.fin_dst = (float*)d_out;
    a.ph_lo = PROBE_LO; a.ph_hi = N_PHASES; a.li = 1;
    hipLaunchKernelGGL(mk_fwd, dim3(grid), dim3(NWAVES * 64), LDS_BYTES, stream, a);
#elif MK_N_LAUNCHES == 1
    a.ph_lo = 0; a.ph_hi = N_PHASES;
    hipLaunchKernelGGL(mk_fwd, dim3(grid), dim3(NWAVES * 64), LDS_BYTES, stream, a);
#else
    for (int p = 0; p < N_PHASES; ++p) { a.ph_lo = p; a.ph_hi = p + 1; hipLaunchKernelGGL(mk_fwd, dim3(grid), dim3(NWAVES * 64), LDS_BYTES, stream, a); }
#endif
}
```

```cpp
#include <hip/hip_runtime.h>
#include <cstdio>
#include <cstdint>

#ifndef MK_N_LAUNCHES
#define MK_N_LAUNCHES 1
#endif

namespace pg8 {
#define PG8_LAS __attribute__((address_space(3)))
typedef unsigned short bf16_t;
typedef short bf16x8 __attribute__((ext_vector_type(8)));
typedef float f32x4 __attribute__((ext_vector_type(4)));
typedef unsigned u32x4 __attribute__((ext_vector_type(4)));
constexpr int BM = 256, BK = 64, HALF = 128, HTB = HALF * BK * 2  , STAGE_BYTES = 8 * HTB, NXCD = 8, WGM = 8;

__host__ __device__ __forceinline__ int lds_byte(int r, int c) { const int st = (r >> 4) * 2 + (c >> 5), rr = r & 15, cc = c & 31, ob = rr * 64 + cc * 2; return st * 1024 + (ob ^ (((ob >> 9) & 1) << 5)); }
__host__ __device__ __forceinline__ void stage_rc(int b, int& R, int& C) { const int st = b / 1024, sb = b % 1024, swz = sb ^ (((sb >> 9) & 1) << 5); R = (st >> 1) * 16 + swz / 64; C = (st & 1) * 32 + (swz % 64) / 2; }
__host__ __device__ __forceinline__ int perm32(int rho) { const int n = rho >> 4, i = rho & 15; return 8 * (i >> 2) + 4 * n + (i & 3); }

struct Unit { const char* A; const char* B; int pm, pn, aux, nt, kind; unsigned kA; };

__device__ __forceinline__ unsigned cvt_pk_bf16(float lo, float hi) { unsigned r; asm volatile("v_cvt_pk_bf16_f32 %0, %1, %2" : "=v"(r) : "v"(lo), "v"(hi)); return r; }

template <class Epi, class Sched, bool ALIGN_EPI>
__device__ __forceinline__ void gemm_phase(PG8_LAS unsigned char* lds, const int ldb, const int K, const Sched& S, const Epi& E, const size_t kstepA = (size_t)(BK * 2)) {
    const int tid = threadIdx.x, wid = __builtin_amdgcn_readfirstlane(tid >> 6), lane = tid & 63, wr = wid >> 2, wc = wid & 3, fr = lane & 15, fq = lane >> 4;
    int nt = K / BK; asm volatile("" : "+s"(nt));
    int Rr[2], Cc[2], Rbb[2]; unsigned voffB[4], vAc[4], vAn[4];
#pragma unroll
    for (int i = 0; i < 2; ++i) { int R, C; stage_rc(tid * 16 + i * 8192, R, C); Rr[i] = R; Cc[i] = C; const int Rb = Epi::PERM ? ((R & ~31) + perm32(R & 31)) : R; Rbb[i] = Rb;
        int Rb0 = Rb, Rb1 = HALF + Rb;
        if constexpr (Epi::B16) {
            const int w_ = R >> 5, nn_ = (R >> 4) & 1, ii_ = R & 15; Rb0 = 64 * w_ + 16 * (ii_ >> 2) + 4 * nn_ + (ii_ & 3); Rb1 = Rb0 + 8; }
        voffB[i] = (unsigned)(Rb0 * ldb + C) * 2u; voffB[2 + i] = (unsigned)(Rb1 * ldb + C) * 2u; }
    const size_t kstep = (size_t)(BK * 2);
    const unsigned ldsw = (unsigned)wid * 1024u;
    const int aoff = lds_byte(wr * 64 + fr, fq * 8), boff = lds_byte(wc * 32 + fr, fq * 8);
#define PG8_SA(b, h) (((b) * 2 + (h)) * HTB)
#define PG8_SB(b, h) ((4 + (b) * 2 + (h)) * HTB)
#define PG8_STAGE(bufoff, gbase, voff, h) do { _Pragma("unroll") for (int _i = 0; _i < 2; ++_i) \
        __builtin_amdgcn_global_load_lds((const unsigned*)((const char*)(gbase) + (voff)[2 * (h) + _i]), (PG8_LAS unsigned*)(lds + (bufoff) + ldsw + _i * 8192), 16, 0, 0); } while (0)
#define PG8_LDA(dst, b, h) do { _Pragma("unroll") for (int m = 0; m < 4; ++m) _Pragma("unroll") for (int k = 0; k < 2; ++k) dst[m][k] = *(const PG8_LAS bf16x8*)(lds + PG8_SA(b, h) + aoff + m * 2048 + k * 1024); } while (0)
#define PG8_LDB(dst, b, h) do { _Pragma("unroll") for (int n = 0; n < 2; ++n) _Pragma("unroll") for (int k = 0; k < 2; ++k) dst[n][k] = *(const PG8_LAS bf16x8*)(lds + PG8_SB(b, h) + boff + n * 2048 + k * 1024); } while (0)
#define PG8_MMA(ai, bj, At, Bt) do { __builtin_amdgcn_s_setprio(1); _Pragma("unroll") for (int m = 0; m < 4; ++m) _Pragma("unroll") for (int n = 0; n < 2; ++n) _Pragma("unroll") for (int k = 0; k < 2; ++k) \
        acc[ai][bj][m][n] = __builtin_amdgcn_mfma_f32_16x16x32_bf16(Bt[n][k], At[m][k], acc[ai][bj][m][n], 0, 0, 0); __builtin_amdgcn_s_setprio(0); } while (0)
#define PG8_WAIT_V(n) asm volatile("s_waitcnt vmcnt(" #n ")" ::: "memory")
#define PG8_WAIT_L(n) asm volatile("s_waitcnt lgkmcnt(" #n ")" ::: "memory")
#define PG8_BAR __builtin_amdgcn_s_barrier()
#define PG8_SCHED __builtin_amdgcn_sched_barrier(0)
    Unit cur, nxt; int ui = 0;
    if (!S.next(0, cur)) return;
    S.a_offsets(cur, Rr, Cc, vAc);
    unsigned vBc[4], vBn[4];
    if constexpr (Sched::HETERO) { S.b_offsets(cur, Rbb, Cc, vBc); nt = __builtin_amdgcn_readfirstlane(cur.nt); }
    else {
#pragma unroll
        for (int q = 0; q < 4; ++q) vBc[q] = voffB[q]; }
    size_t kAc = Sched::HETERO ? (size_t)(unsigned)__builtin_amdgcn_readfirstlane((int)cur.kA) : kstepA;
    f32x4 acc[2][2][4][2];
    if constexpr (Epi::ACC_INIT) E.init(acc, cur, wr, wc, fr, fq);
    else {
#pragma unroll
    for (int a = 0; a < 2; ++a)
#pragma unroll
        for (int b = 0; b < 2; ++b)
#pragma unroll
            for (int m = 0; m < 4; ++m)
#pragma unroll
                for (int n = 0; n < 2; ++n) acc[a][b][m][n] = (f32x4){0.f, 0.f, 0.f, 0.f}; }
    bf16x8 At[4][2], B0[2][2], B1[2][2];
    const char* cA = cur.A; const char* cB = cur.B;
    if constexpr (Sched::GATHER) { PG8_WAIT_L(0); }
    PG8_STAGE(PG8_SB(0, 0), cB, vBc, 0); PG8_STAGE(PG8_SB(0, 1), cB, vBc, 1); PG8_STAGE(PG8_SA(0, 0), cA, vAc, 0); PG8_STAGE(PG8_SA(0, 1), cA, vAc, 1);
    if (wr == 1) PG8_BAR;
    PG8_WAIT_V(2); PG8_BAR;
    PG8_STAGE(PG8_SB(1, 0), cB + kstep, vBc, 0); PG8_STAGE(PG8_SA(1, 0), cA + kAc, vAc, 0); PG8_STAGE(PG8_SB(1, 1), cB + kstep, vBc, 1);
    PG8_WAIT_V(6); PG8_BAR;
    for (;;) {
        const bool has_next = S.next(ui + 1, nxt);
        const char* nA = has_next ? nxt.A : cA; const char* nB = has_next ? nxt.B : cB;
        size_t kAn = kAc;
        if constexpr (Sched::HETERO) { if (has_next) { S.b_offsets(nxt, Rbb, Cc, vBn); kAn = (size_t)(unsigned)__builtin_amdgcn_readfirstlane((int)nxt.kA); } else {
#pragma unroll
                for (int q = 0; q < 4; ++q) vBn[q] = vBc[q]; } }
        for (int t = 0; t < nt; t += 2) {
            const bool last = (t == nt - 2);
            const char* a1 = cA + (size_t)(t + 1) * kAc;
            const char* a2 = last ? nA : cA + (size_t)(t + 2) * kAc; const char* b2 = last ? nB : cB + (size_t)(t + 2) * kstep;
            const char* a3 = a2 + (last ? kAn : kAc); const char* b3 = b2 + kstep;
            unsigned vb2[4];
#pragma unroll
            for (int q = 0; q < 4; ++q) vb2[q] = (Sched::HETERO && last) ? vBn[q] : vBc[q];
            unsigned va2[4];
            if constexpr (Sched::GATHER || Sched::HETERO) {
                if (last) { if (has_next) { S.a_offsets(nxt, Rr, Cc, vAn); if constexpr (Sched::GATHER) { PG8_WAIT_L(0); } } else {
#pragma unroll
                        for (int q = 0; q < 4; ++q) vAn[q] = vAc[q]; } }
#pragma unroll
                for (int q = 0; q < 4; ++q) va2[q] = last ? vAn[q] : vAc[q];
            } else {
#pragma unroll
                for (int q = 0; q < 4; ++q) va2[q] = vAc[q];
            }
            PG8_LDB(B0, 0, 0); PG8_LDB(B1, 0, 1); PG8_SCHED; PG8_LDA(At, 0, 0); PG8_STAGE(PG8_SA(1, 1), a1, vAc, 1);
            PG8_WAIT_V(8); PG8_WAIT_L(0); PG8_BAR; PG8_MMA(0, 0, At, B0); PG8_MMA(0, 1, At, B1); PG8_BAR; PG8_SCHED;
            const bool fin = last && !has_next;
            PG8_LDA(At, 0, 1);
            if (!fin) { PG8_STAGE(PG8_SB(0, 0), b2, vb2, 0); PG8_STAGE(PG8_SB(0, 1), b2, vb2, 1); PG8_STAGE(PG8_SA(0, 0), a2, va2, 0); PG8_WAIT_V(8); } else { PG8_WAIT_V(0); }
            PG8_WAIT_L(0); PG8_BAR; PG8_MMA(1, 0, At, B0); PG8_MMA(1, 1, At, B1); PG8_BAR; PG8_SCHED;
            PG8_LDB(B0, 1, 0); PG8_LDB(B1, 1, 1); PG8_SCHED; PG8_LDA(At, 1, 0);
            if (!fin) { PG8_STAGE(PG8_SA(0, 1), a2, va2, 1); PG8_WAIT_V(8); } else { PG8_WAIT_V(0); }
            PG8_WAIT_L(0); PG8_BAR; PG8_MMA(0, 0, At, B0); PG8_MMA(0, 1, At, B1); PG8_BAR; PG8_SCHED;
            PG8_LDA(At, 1, 1);
            if (!fin) { PG8_STAGE(PG8_SB(1, 0), b3, vb2, 0); PG8_STAGE(PG8_SB(1, 1), b3, vb2, 1); PG8_STAGE(PG8_SA(1, 0), a3, va2, 0); PG8_WAIT_V(8); } else { PG8_WAIT_V(0); }
            PG8_WAIT_L(0); PG8_BAR; PG8_MMA(1, 0, At, B0); PG8_MMA(1, 1, At, B1); PG8_BAR; PG8_SCHED;
        }
        if constexpr (ALIGN_EPI) { if (wr == 0) PG8_BAR; }
        E(acc, cur, wr, wc, fr, fq);
        if (!has_next) break;
        if constexpr (Epi::ACC_INIT) E.init(acc, nxt, wr, wc, fr, fq);
        else {
#pragma unroll
        for (int a = 0; a < 2; ++a)
#pragma unroll
            for (int b = 0; b < 2; ++b)
#pragma unroll
                for (int m = 0; m < 4; ++m)
#pragma unroll
                    for (int n = 0; n < 2; ++n) acc[a][b][m][n] = (f32x4){0.f, 0.f, 0.f, 0.f}; }
        cur = nxt; cA = nA; cB = nB; ++ui;
        if constexpr (Sched::GATHER || Sched::HETERO) {
#pragma unroll
            for (int q = 0; q < 4; ++q) vAc[q] = vAn[q]; }
        if constexpr (Sched::HETERO) {
#pragma unroll
            for (int q = 0; q < 4; ++q) vBc[q] = vBn[q];
            kAc = kAn; nt = __builtin_amdgcn_readfirstlane(cur.nt); }
        if constexpr (ALIGN_EPI) { if (wr == 1) PG8_BAR; }
    }
    PG8_WAIT_V(0);
    if constexpr (!ALIGN_EPI) { if (wr == 0) PG8_BAR; }
    PG8_BAR;
#undef PG8_SA
#undef PG8_SB
#undef PG8_STAGE
#undef PG8_LDA
#undef PG8_LDB
#undef PG8_MMA
#undef PG8_WAIT_V
#undef PG8_WAIT_L
#undef PG8_BAR
#undef PG8_SCHED
}
}

constexpr int NWAVES = 8;
constexpr int BATCH = 8, SEQ = 4096, D = 1024, T = BATCH * SEQ;
constexpr int S5W = 512, S5G = 32, S5C = 16, S5P = 64, S5Q = 128;
constexpr int S5LC = 16, S5NCH = SEQ / S5LC, S5N = BATCH * S5NCH;
constexpr int S5K = S5Q + S5LC * S5C;
constexpr int LRUW = 1024, LRUH = 16, LRUHD = 64, LRUCH = 64, LRUNCH = SEQ / LRUCH;
constexpr int NIN = S5W + 2 * LRUW + 2 * D;
constexpr int NEXP = 32, EPG = 8, NGRP = 4, DEXP = 512, NROUT = 48;
constexpr int MAXSLOT = 73728;
constexpr int MAXU = 8;
constexpr float RMS_EPS = 1e-6f;

constexpr size_t MiB = 1u << 20;
constexpr size_t WS_CTL = 0, CTL_ZERO_BYTES = 128 * 1024;
constexpr size_t WS_SMALL = 1 * MiB;
constexpr size_t SM_LAM16 = WS_SMALL + 0;
constexpr size_t SM_LRUC = WS_SMALL + 16384;
constexpr size_t SM_WRT = WS_SMALL + 32768;
constexpr size_t SM_RHI = WS_SMALL + 327680;
constexpr size_t SM_RLO = SM_RHI + 98304;
constexpr size_t SM_RSTD = WS_SMALL + 524288;
constexpr size_t WS_BTT = 2 * MiB;
constexpr size_t WS_BTW = 8 * MiB;
constexpr size_t WS_WIN = 11 * MiB;
constexpr size_t WS_WS5 = 20 * MiB;
constexpr size_t WS_WLRU = 22 * MiB;
constexpr size_t WS_WO = 24 * MiB;
constexpr size_t WS_LP = 26 * MiB, WS_LH = 28 * MiB, WS_LHIN = 30 * MiB;
constexpr size_t WS_AG = 32 * MiB;
constexpr size_t WS_SLOC = 80 * MiB;
constexpr size_t WS_H = 112 * MiB;
constexpr size_t WS_XL = 176 * MiB;
constexpr size_t WS_GL = 240 * MiB;
constexpr size_t WS_GA = 304 * MiB, WS_GB = 336 * MiB;
constexpr size_t WS_GY = 368 * MiB;
constexpr size_t WS_WGU = 400 * MiB;
constexpr size_t WS_WD = 464 * MiB;
constexpr size_t WS_H2 = 32 * MiB;
constexpr size_t WS_ACT = 96 * MiB;
constexpr size_t WS_YS = 168 * MiB;
constexpr size_t WS_LTOK = 312 * MiB, WS_LW = 316 * MiB;
constexpr size_t WS_TOKE = 320 * MiB, WS_TOKR = WS_TOKE + 262144;
constexpr size_t WS_END = 496 * MiB;
static_assert(WS_YS + (size_t)MAXSLOT * 1024 * 2 <= WS_LTOK && WS_ACT + (size_t)MAXSLOT * 512 * 2 <= WS_YS && WS_TOKR + 262144 <= WS_WGU && WS_GY + (size_t)T * 512 * 2 <= WS_WGU && WS_WD + (size_t)32 * 1024 * 512 * 2 <= WS_END, "d_ws map");
constexpr int CW_BAR = 4096;
constexpr int CW_CNT = 16384;

constexpr int RING_BYTES = 131072;
constexpr int TOKL_OFF = RING_BYTES, SCLL_OFF = TOKL_OFF + MAXU * 256 * 4, MISC_OFF = SCLL_OFF + MAXU * 256 * 4;
constexpr int LDS_BYTES = MISC_OFF + 1024;

#define GAS __attribute__((address_space(1)))
#define LAS __attribute__((address_space(3)))
typedef unsigned short bf16;
typedef unsigned v4u __attribute__((ext_vector_type(4)));
typedef unsigned v2u __attribute__((ext_vector_type(2)));
typedef float f32x4 __attribute__((ext_vector_type(4)));
typedef short bf16x8 __attribute__((ext_vector_type(8)));
#define LDS_WAIT() asm volatile("s_waitcnt lgkmcnt(0)" ::: "memory")
#define VM_WAIT() asm volatile("s_waitcnt vmcnt(0)" ::: "memory")
__device__ __forceinline__ unsigned f2bf(float f) { unsigned u = __builtin_bit_cast(unsigned, f); return (u + 0x7fffu + ((u >> 16) & 1u)) >> 16; }
__device__ __forceinline__ float bf2f(unsigned h) { return __builtin_bit_cast(float, h << 16); }
__device__ __forceinline__ unsigned pk2(float lo, float hi) { return f2bf(lo) | (f2bf(hi) << 16); }
__device__ __forceinline__ float bflo(unsigned w) { return __builtin_bit_cast(float, w << 16); }
__device__ __forceinline__ float bfhi(unsigned w) { return __builtin_bit_cast(float, w & 0xffff0000u); }
__device__ __forceinline__ float fsigmoid(float x) { return __builtin_amdgcn_rcpf(1.0f + __builtin_amdgcn_exp2f(-1.44269504f * x)); }
__device__ __forceinline__ float gelu_t(float x) { const float u = x * (0.7978845608f + 0.0356774081f * x * x); return x * __builtin_amdgcn_rcpf(1.0f + __builtin_amdgcn_exp2f(-2.88539008f * u)); }
__device__ __forceinline__ float wave_sum(float v) {
#pragma unroll
    for (int o = 1; o < 64; o <<= 1) v += __shfl_xor(v, o);
    return v;
}

#define XB_TMO      128
#define XB_XCNT(j)  (256  + 64 * (j))
#define XB_XSUB(j)  (1280 + 64 * (j))
#define XB_XGEN(j)  (2304 + 64 * (j))
#define XB_TOP      3328
#define XB_TOPGEN   3392
#define XCD_BAR_WORDS 3456
#define XB_SPIN_CAP (1u << 18)
__device__ __forceinline__ unsigned xb_ld(unsigned* p)              { return __hip_atomic_load(p, __ATOMIC_RELAXED, __HIP_MEMORY_SCOPE_AGENT); }
__device__ __forceinline__ unsigned xb_add(unsigned* p, unsigned v) { return __hip_atomic_fetch_add(p, v, __ATOMIC_RELAXED, __HIP_MEMORY_SCOPE_AGENT); }
__device__ __forceinline__ unsigned xb_xcc_id() { return (unsigned)__builtin_amdgcn_s_getreg((3 << 11) | 20) & 0xFu; }
#define XB_SPIN(cond, bar) do { unsigned _sp = 0; while (cond) { __builtin_amdgcn_s_sleep(1); \
    if ((++_sp & 255u) == 0u) { if (xb_ld(&(bar)[XB_TMO])) break; if (_sp > XB_SPIN_CAP) { atomicAdd(&(bar)[XB_TMO], 1u); break; } } } } while (0)
struct XcdBarrier { unsigned* bar; unsigned x; volatile LAS unsigned* st; };
__device__ __forceinline__ XcdBarrier xcd_barrier_post(unsigned* bar, volatile LAS unsigned* st) {
    XcdBarrier b; b.bar = bar; b.x = xb_xcc_id(); b.st = st;
    if (threadIdx.x == 0) (void)xb_add(&bar[XB_XCNT(b.x)], 1u);
    return b;
}
__device__ __forceinline__ void xcd_barrier_complete(unsigned* bar, unsigned x, unsigned& nloc, unsigned& nx) {
    const unsigned G = gridDim.x * gridDim.y * gridDim.z;
    unsigned sum, cnt, mine, sp = 0u;
    for (;;) {
        sum = 0u; cnt = 0u; mine = 0u;
#pragma unroll
        for (unsigned j = 0; j < 16; ++j) { const unsigned c = xb_ld(&bar[XB_XCNT(j)]); sum += c; cnt += (c > 0u) ? 1u : 0u; mine = (j == x) ? c : mine; }
        if (sum == G) break;
        __builtin_amdgcn_s_sleep(1);
        if ((++sp & 255u) == 0u) { if (xb_ld(&bar[XB_TMO])) break; if (sp > XB_SPIN_CAP) { atomicAdd(&bar[XB_TMO], 1u); break; } }
    }
    nloc = mine > 0u ? mine : 1u; nx = cnt > 0u ? cnt : 1u;
}
__device__ __forceinline__ void xcd_barrier(const XcdBarrier& b) {
    asm volatile("s_waitcnt vmcnt(0)" ::: "memory");
    __syncthreads();
    if (threadIdx.x == 0) {
        unsigned* bar = b.bar;
        __builtin_amdgcn_s_waitcnt(0);
        unsigned nloc = b.st[0], nx = b.st[1];
        if (nloc == 0u) { xcd_barrier_complete(bar, b.x, nloc, nx); b.st[0] = nloc; b.st[1] = nx; }
        const unsigned old = xb_add(&bar[XB_XSUB(b.x)], 1u);
        const unsigned gen = old / nloc;
        if (old + 1u == (gen + 1u) * nloc) {
            __builtin_amdgcn_fence(__ATOMIC_RELEASE, "agent");
            asm volatile("s_waitcnt vmcnt(0)" ::: "memory");
            const unsigned og = xb_add(&bar[XB_TOP], 1u);
            const unsigned tg = og / nx;
            if (og + 1u == (tg + 1u) * nx) xb_add(&bar[XB_TOPGEN], 1u);
            else XB_SPIN(xb_ld(&bar[XB_TOPGEN]) == tg, bar);
            __builtin_amdgcn_fence(__ATOMIC_ACQUIRE, "agent");
            xb_add(&bar[XB_XGEN(b.x)], 1u);
            asm volatile("s_waitcnt vmcnt(0)" ::: "memory");
        } else {
            XB_SPIN(xb_ld(&bar[XB_XGEN(b.x)]) == gen, bar);
            __builtin_amdgcn_fence(__ATOMIC_ACQUIRE, "agent");
            asm volatile("s_waitcnt vmcnt(0)" ::: "memory");
        }
    }
    __syncthreads();
}

struct Frame {
    LAS unsigned char* lds;
    volatile LAS unsigned* MISC;
    unsigned* ctl;
    int tid, lane, wave, vcu, G;
    const float* const* in;
    unsigned char* ws; float* out;
};

using pg8::Unit;
struct DenseOrder {
    static constexpr bool GATHER = false, HETERO = false;
    const char* A0; const char* B0; int lda, ldb, nM, nN, nwg, G, c;
    __device__ __forceinline__ void init(const void* A, const void* B, int lda_, int ldb_, int M, int N, int G_, int c_) { A0 = (const char*)A; B0 = (const char*)B; lda = lda_; ldb = ldb_; nM = M / 256; nN = N / 256; nwg = nM * nN; G = G_; c = c_; }
    __device__ __forceinline__ bool next(int i, Unit& u) const {
        const long L = (long)i * G + c; if (L >= nwg) return false;
        int wgid = (int)L; { const int q = nwg / 8, r = nwg % 8, xcd = wgid % 8, off = wgid / 8; wgid = (xcd < r ? xcd * (q + 1) : r * (q + 1) + (xcd - r) * q) + off; }
        const int nig = 8 * nN, gid = wgid / nig, fm = gid * 8, gsz = (nM - fm) < 8 ? (nM - fm) : 8;
        u.pm = fm + ((wgid % nig) % gsz); u.pn = (wgid % nig) / gsz; u.aux = 0;
        u.A = A0 + (size_t)u.pm * 256 * lda * 2; u.B = B0 + (size_t)u.pn * 256 * ldb * 2; return true;
    }
    __device__ __forceinline__ void a_offsets(const Unit&, const int (&R)[2], const int (&C)[2], unsigned (&v)[4]) const {
#pragma unroll
        for (int i = 0; i < 2; ++i) { v[i] = (unsigned)(R[i] * lda + C[i]) * 2u; v[2 + i] = (unsigned)((128 + R[i]) * lda + C[i]) * 2u; }
    }
};
struct S5One {
    static constexpr bool GATHER = false, HETERO = false;
    const char* A0; const char* B0; size_t sA, sB; int lda, g, mt;
    __device__ __forceinline__ bool next(int i, Unit& u) const {
        if (i > 0) return false;
        u.pm = mt; u.pn = 0; u.aux = g; u.A = A0 + (size_t)g * sA + (size_t)mt * 256 * lda * 2; u.B = B0 + (size_t)g * sB; return true;
    }
    __device__ __forceinline__ void a_offsets(const Unit&, const int (&R)[2], const int (&C)[2], unsigned (&v)[4]) const {
#pragma unroll
        for (int i = 0; i < 2; ++i) { v[i] = (unsigned)(R[i] * lda + C[i]) * 2u; v[2 + i] = (unsigned)((128 + R[i]) * lda + C[i]) * 2u; }
    }
};
struct GyOrder {
    static constexpr bool GATHER = false, HETERO = false;
    DenseOrder d;
    __device__ __forceinline__ bool next(int i, Unit& u) const { if (!d.next(i, u)) return false; u.A = d.A0 + (size_t)u.pm * 256 * 32; return true; }
    __device__ __forceinline__ void a_offsets(const Unit&, const int (&R)[2], const int (&C)[2], unsigned (&v)[4]) const {
#pragma unroll
        for (int i = 0; i < 2; ++i) { const unsigned o = (unsigned)(C[i] >> 4) * (unsigned)(T * 32) + (unsigned)(C[i] & 15) * 2u; v[i] = (unsigned)R[i] * 32u + o; v[2 + i] = (unsigned)(128 + R[i]) * 32u + o; }
    }
};
struct YaYbOrder {
    static constexpr bool GATHER = false, HETERO = true;
    DenseOrder d;
    const char* GYb; const char* WS5b; const char* YLb; const char* WLb;
    __device__ __forceinline__ bool next(int i, Unit& u) const {
        const int j = i / 3, r = i - 3 * j; Unit t;
        if (!d.next(j, t)) return false;
        u.pm = t.pm; u.aux = 0;
        if (r < 2) { u.kind = 0; u.pn = 2 * t.pn + r; u.nt = S5W / 64; u.kA = (unsigned)(4 * T * 32); u.A = GYb + (size_t)t.pm * 256 * 32; u.B = WS5b + (size_t)u.pn * 256 * S5W * 2; }
        else { u.kind = 1; u.pn = t.pn; u.nt = D / 64; u.kA = 128u; u.A = YLb + (size_t)t.pm * 256 * D * 2; u.B = WLb + (size_t)t.pn * 256 * D * 2; }
        return true;
    }
    __device__ __forceinline__ void a_offsets(const Unit& u, const int (&R)[2], const int (&C)[2], unsigned (&v)[4]) const {
#pragma unroll
        for (int i = 0; i < 2; ++i) {
            const unsigned og = (unsigned)(C[i] >> 4) * (unsigned)(T * 32) + (unsigned)(C[i] & 15) * 2u;
            const unsigned g0 = (unsigned)R[i] * 32u + og, g1 = (unsigned)(128 + R[i]) * 32u + og;
            const unsigned d0 = (unsigned)(R[i] * D + C[i]) * 2u, d1 = (unsigned)((128 + R[i]) * D + C[i]) * 2u;
            v[i] = u.kind ? d0 : g0; v[2 + i] = u.kind ? d1 : g1; }
    }
    __device__ __forceinline__ void b_offsets(const Unit& u, const int (&Rb)[2], const int (&C)[2], unsigned (&v)[4]) const {
        const int ldb = u.kind ? D : S5W;
#pragma unroll
        for (int i = 0; i < 2; ++i) { v[i] = (unsigned)(Rb[i] * ldb + C[i]) * 2u; v[2 + i] = (unsigned)((128 + Rb[i]) * ldb + C[i]) * 2u; }
    }
};
template <bool GATH> struct MoeOrder {
    static constexpr bool GATHER = GATH, HETERO = false;
    const char* A0; const char* B0; size_t sBe; int lda, ldb, G, c; volatile LAS unsigned* MISC; const LAS int* tokL;
    __device__ __forceinline__ bool next(int i, Unit& u) const {
        if (i >= (int)MISC[152]) return false;
        const int e = (int)MISC[136 + i], mtg = (int)MISC[96 + e] + (int)MISC[144 + i], L = i * G + c;
        u.pm = mtg; u.pn = L & 3; u.aux = i;
        u.A = GATH ? A0 : A0 + (size_t)mtg * 256 * lda * 2; u.B = B0 + (size_t)e * sBe + (size_t)u.pn * 256 * ldb * 2; return true;
    }
    __device__ __forceinline__ void a_offsets(const Unit& u, const int (&R)[2], const int (&C)[2], unsigned (&v)[4]) const {
#pragma unroll
        for (int i = 0; i < 2; ++i) {
            if constexpr (GATH) { v[i] = (unsigned)tokL[u.aux * 256 + R[i]] * (unsigned)(lda * 2) + (unsigned)C[i] * 2u; v[2 + i] = (unsigned)tokL[u.aux * 256 + 128 + R[i]] * (unsigned)(lda * 2) + (unsigned)C[i] * 2u; }
            else { v[i] = (unsigned)(R[i] * lda + C[i]) * 2u; v[2 + i] = (unsigned)((128 + R[i]) * lda + C[i]) * 2u; } }
    }
};

using pg8::cvt_pk_bf16;
template <int ACT> __device__ __forceinline__ float actf(float x) { if (ACT == 1) return gelu_t(x); if (ACT == 2) return fsigmoid(x); return x; }
__device__ __forceinline__ v4u pack8(const f32x4 a, const f32x4 b) { v4u w; w.x = cvt_pk_bf16(a[0], a[1]); w.y = cvt_pk_bf16(a[2], a[3]); w.z = cvt_pk_bf16(b[0], b[1]); w.w = cvt_pk_bf16(b[2], b[3]); return w; }

__device__ __forceinline__ void unpack_u8x8(const v2u w, float (&f)[8]) {
    const float k = 1.0f / 255.0f;
    f[0] = (float)(w.x & 0xffu) * k; f[1] = (float)((w.x >> 8) & 0xffu) * k; f[2] = (float)((w.x >> 16) & 0xffu) * k; f[3] = (float)(w.x >> 24) * k;
    f[4] = (float)(w.y & 0xffu) * k; f[5] = (float)((w.y >> 8) & 0xffu) * k; f[6] = (float)((w.y >> 16) & 0xffu) * k; f[7] = (float)(w.y >> 24) * k;
}
struct EpiInProj {
    static constexpr bool PERM = true, ACC_INIT = false, B16 = false;
    bf16 *AG, *XL, *GL, *GA, *GB;
    template <int MODE  > __device__ __forceinline__ void tile(const f32x4 (&acc)[2][2][4][2], const Unit& u, bf16* base, int colbase, bool s5, int wr, int wc, int fr, int fq) const {
#pragma unroll
        for (int ai = 0; ai < 2; ++ai)
#pragma unroll
            for (int m = 0; m < 4; ++m) { const int r = u.pm * 256 + ai * 128 + wr * 64 + m * 16 + fr;
#pragma unroll
                for (int bj = 0; bj < 2; ++bj) { const int cl = colbase + bj * 128 + wc * 32 + 8 * fq;
                    f32x4 v0 = acc[ai][bj][m][0], v1 = acc[ai][bj][m][1];
                    if (MODE == 2) {
                        unsigned q[8];
#pragma unroll
                        for (int j = 0; j < 4; ++j) { q[j] = (unsigned)(fsigmoid(v0[j]) * 255.0f + 0.5f); q[4 + j] = (unsigned)(fsigmoid(v1[j]) * 255.0f + 0.5f); }
                        v2u w8; w8.x = q[0] | (q[1] << 8) | (q[2] << 16) | (q[3] << 24); w8.y = q[4] | (q[5] << 8) | (q[6] << 16) | (q[7] << 24);
                        __builtin_nontemporal_store(w8, (v2u*)((unsigned char*)base + (size_t)r * 1024 + cl));
                    } else {
                        if (MODE == 1) {
#pragma unroll
                            for (int j = 0; j < 4; ++j) { v0[j] = gelu_t(v0[j]); v1[j] = gelu_t(v1[j]); } }
                        const v4u w = pack8(v0, v1);
                        const int g = cl >> 4, cp = cl & 15, b = r >> 12, l = r & 4095, n = b * S5NCH + (l >> 4), s = l & 15;
                        const size_t off = s5 ? ((size_t)(g * S5N + n) * S5K + S5Q + s * 16 + cp) : ((size_t)r * 1024 + cl);
                        __builtin_nontemporal_store(w, (v4u*)(base + off)); } }
                asm volatile("" ::: "memory"); }
    }
    __device__ __forceinline__ void operator()(const f32x4 (&acc)[2][2][4][2], const Unit& u, int wr, int wc, int fr, int fq) const {
        const int pn = u.pn, reg = pn < 2 ? 0 : ((pn - 2) >> 2) + 1;
        const int colbase = reg == 0 ? pn * 256 : ((pn - 2) & 3) * 256;
        if (reg < 2) tile<0>(acc, u, reg == 0 ? AG : XL, colbase, reg == 0, wr, wc, fr, fq);
        else if (reg == 2) tile<1>(acc, u, GL, colbase, false, wr, wc, fr, fq);
        else tile<2>(acc, u, reg == 3 ? GA : GB, colbase, false, wr, wc, fr, fq);
    }
};
struct EpiS5State {
    static constexpr bool PERM = false, ACC_INIT = false, B16 = false;
    float* SLOC;
    __device__ __forceinline__ void operator()(const f32x4 (&acc)[2][2][4][2], const Unit& u, int wr, int wc, int fr, int fq) const {
#pragma unroll
        for (int ai = 0; ai < 2; ++ai)
#pragma unroll
            for (int m = 0; m < 4; ++m) { const int nr = u.pm * 256 + ai * 128 + wr * 64 + m * 16 + fr; float* rowp = SLOC + (size_t)(u.aux * S5N + nr) * S5Q + wc * 32 + 4 * fq;
#pragma unroll
                for (int n = 0; n < 2; ++n) *(f32x4*)(rowp + n * 16) = acc[ai][0][m][n]; }
    }
};
struct EpiS5Out {
    static constexpr bool PERM = true, ACC_INIT = false, B16 = false;
    bf16* GY;
    __device__ __forceinline__ void operator()(const f32x4 (&acc)[2][2][4][2], const Unit& u, int wr, int wc, int fr, int fq) const {
#pragma unroll
        for (int ai = 0; ai < 2; ++ai)
#pragma unroll
            for (int m = 0; m < 4; ++m) { const int nr = u.pm * 256 + ai * 128 + wr * 64 + m * 16 + fr, b = nr >> 8, j16 = nr & 255;
#pragma unroll
                for (int bj = 0; bj < 2; ++bj) { const int cc = bj * 128 + wc * 32 + 8 * fq, t = cc >> 4, c0 = cc & 15;
                    f32x4 v0 = acc[ai][bj][m][0], v1 = acc[ai][bj][m][1];
#pragma unroll
                    for (int j = 0; j < 4; ++j) { v0[j] = gelu_t(v0[j]); v1[j] = gelu_t(v1[j]); }
                    *(v4u*)(GY + ((size_t)u.aux * T + (size_t)(b * SEQ + j16 * 16 + t)) * 16 + c0) = pack8(v0, v1); }
                asm volatile("" ::: "memory"); }
    }
};
struct EpiYa {
    static constexpr bool PERM = true, ACC_INIT = false, B16 = false;
    const bf16* GA; bf16* YA;
    __device__ __forceinline__ void operator()(const f32x4 (&acc)[2][2][4][2], const Unit& u, int wr, int wc, int fr, int fq) const {
        const size_t off0 = (size_t)(u.pm * 256 + wr * 64 + fr) * 1024 + u.pn * 128 + wc * 32 + 8 * fq;
        v2u gav[2][4];
#pragma unroll
        for (int ai = 0; ai < 2; ++ai)
#pragma unroll
            for (int m = 0; m < 4; ++m) gav[ai][m] = __builtin_nontemporal_load((const v2u*)((const unsigned char*)GA + off0 + (size_t)(ai * 128 + m * 16) * 1024));
        asm volatile("" ::: "memory");
#pragma unroll
        for (int ai = 0; ai < 2; ++ai)
#pragma unroll
            for (int m = 0; m < 4; ++m) { float gaf[8]; unpack_u8x8(gav[ai][m], gaf);
                f32x4 o0, o1;
#pragma unroll
                for (int j = 0; j < 4; ++j) { o0[j] = gaf[j] * acc[ai][0][m][0][j] * fsigmoid(acc[ai][1][m][0][j]); o1[j] = gaf[4 + j] * acc[ai][0][m][1][j] * fsigmoid(acc[ai][1][m][1][j]); }
                *(v4u*)(YA + off0 + (size_t)(ai * 128 + m * 16) * 1024) = pack8(o0, o1); }
    }
};
struct EpiYb {
    static constexpr bool PERM = true, ACC_INIT = false, B16 = false;
    const bf16* YA; const bf16* GB; bf16* MIX;
    __device__ __forceinline__ void operator()(const f32x4 (&acc)[2][2][4][2], const Unit& u, int wr, int wc, int fr, int fq) const {
        const size_t off0 = (size_t)(u.pm * 256 + wr * 64 + fr) * 1024 + u.pn * 256 + wc * 32 + 8 * fq;
        v4u ya[2][2][2]; v2u gb[2][2][2];
#define YB_LOAD(buf, grp) do { _Pragma("unroll") for (int mm = 0; mm < 2; ++mm) _Pragma("unroll") for (int bj = 0; bj < 2; ++bj) { \
            const size_t o = off0 + (size_t)(((grp) >> 1) * 128 + (2 * ((grp) & 1) + mm) * 16) * 1024 + bj * 128; ya[buf][mm][bj] = *(const v4u*)(YA + o); gb[buf][mm][bj] = __builtin_nontemporal_load((const v2u*)((const unsigned char*)GB + o)); } } while (0)
        YB_LOAD(0, 0);
#pragma unroll
        for (int grp = 0; grp < 4; ++grp) { const int buf = grp & 1, ai = grp >> 1;
            if (grp < 3) YB_LOAD(buf ^ 1, grp + 1);
            asm volatile("" ::: "memory");
#pragma unroll
            for (int mm = 0; mm < 2; ++mm) { const int m = 2 * (grp & 1) + mm;
#pragma unroll
                for (int bj = 0; bj < 2; ++bj) { const v4u y = ya[buf][mm][bj];
                    const float yaf[8] = {bflo(y.x), bfhi(y.x), bflo(y.y), bfhi(y.y), bflo(y.z), bfhi(y.z), bflo(y.w), bfhi(y.w)};
                    float gbf[8]; unpack_u8x8(gb[buf][mm][bj], gbf);
                    f32x4 o0, o1;
#pragma unroll
                    for (int j = 0; j < 4; ++j) { o0[j] = yaf[j] + gbf[j] * acc[ai][bj][m][0][j]; o1[j] = yaf[4 + j] + gbf[4 + j] * acc[ai][bj][m][1][j]; }
                    *(v4u*)(MIX + off0 + (size_t)(ai * 128 + m * 16) * 1024 + bj * 128) = pack8(o0, o1); } }
        }
#undef YB_LOAD
    }
};
struct EpiYaYb {
    static constexpr bool PERM = true, ACC_INIT = false, B16 = false;
    EpiYa a; EpiYb b;
    __device__ __forceinline__ void operator()(const f32x4 (&acc)[2][2][4][2], const Unit& u, int wr, int wc, int fr, int fq) const {
        if (__builtin_amdgcn_readfirstlane(u.kind) == 0) a(acc, u, wr, wc, fr, fq); else b(acc, u, wr, wc, fr, fq);
    }
};
struct EpiWo {
    static constexpr bool PERM = false, ACC_INIT = true, B16 = false;
    const float* X; float* O;
    __device__ __forceinline__ void init(f32x4 (&acc)[2][2][4][2], const Unit& u, int wr, int wc, int fr, int fq) const {
        const size_t off0 = (size_t)(u.pm * 256 + wr * 64 + fr) * 1024 + u.pn * 256 + wc * 32 + 4 * fq;
#pragma unroll
        for (int ai = 0; ai < 2; ++ai)
#pragma unroll
            for (int m = 0; m < 4; ++m)
#pragma unroll
                for (int bj = 0; bj < 2; ++bj)
#pragma unroll
                    for (int n = 0; n < 2; ++n) acc[ai][bj][m][n] = __builtin_nontemporal_load((const f32x4*)(X + off0 + (size_t)(ai * 128 + m * 16) * 1024 + bj * 128 + n * 16));
    }
    __device__ __forceinline__ void operator()(const f32x4 (&acc)[2][2][4][2], const Unit& u, int wr, int wc, int fr, int fq) const {
        const size_t off0 = (size_t)(u.pm * 256 + wr * 64 + fr) * 1024 + u.pn * 256 + wc * 32 + 4 * fq;
#pragma unroll
        for (int ai = 0; ai < 2; ++ai)
#pragma unroll
            for (int m = 0; m < 4; ++m)
#pragma unroll
                for (int bj = 0; bj < 2; ++bj)
#pragma unroll
                    for (int n = 0; n < 2; ++n) *(f32x4*)(O + off0 + (size_t)(ai * 128 + m * 16) * 1024 + bj * 128 + n * 16) = acc[ai][bj][m][n];
    }
};
struct EpiGU {
    static constexpr bool PERM = true, ACC_INIT = false, B16 = false;
    bf16* ACT; const LAS float* sclL;
    __device__ __forceinline__ void operator()(const f32x4 (&acc)[2][2][4][2], const Unit& u, int wr, int wc, int fr, int fq) const {
#pragma unroll
        for (int ai = 0; ai < 2; ++ai)
#pragma unroll
            for (int m = 0; m < 4; ++m) { const int rl = ai * 128 + wr * 64 + m * 16 + fr; const float sc = sclL[u.aux * 256 + rl];
                f32x4 o0, o1;
#pragma unroll
                for (int j = 0; j < 4; ++j) { const float g0 = acc[ai][0][m][0][j] * sc, g1 = acc[ai][0][m][1][j] * sc;
                    o0[j] = g0 * fsigmoid(g0) * (acc[ai][1][m][0][j] * sc); o1[j] = g1 * fsigmoid(g1) * (acc[ai][1][m][1][j] * sc); }
                *(v4u*)(ACT + (size_t)(u.pm * 256 + rl) * DEXP + u.pn * 128 + wc * 32 + 8 * fq) = pack8(o0, o1); }
    }
};
struct EpiDown {
    static constexpr bool PERM = true, ACC_INIT = false, B16 = false;
    bf16* YS; const LAS float* sclL;
    __device__ __forceinline__ void operator()(const f32x4 (&acc)[2][2][4][2], const Unit& u, int wr, int wc, int fr, int fq) const {
#pragma unroll
        for (int ai = 0; ai < 2; ++ai)
#pragma unroll
            for (int m = 0; m < 4; ++m) { const int rl = ai * 128 + wr * 64 + m * 16 + fr; const float sc = sclL[u.aux * 256 + rl];
#pragma unroll
                for (int bj = 0; bj < 2; ++bj)
                    *(v4u*)(YS + (size_t)(u.pm * 256 + rl) * 1024 + u.pn * 256 + bj * 128 + wc * 32 + 8 * fq) = pack8(acc[ai][bj][m][0] * sc, acc[ai][bj][m][1] * sc); }
    }
};

struct EpiDown8 {
    static constexpr bool PERM = true, ACC_INIT = false, B16 = true;
    unsigned char* YS8; float* YSC; const LAS float* sclL;
    __device__ __forceinline__ void operator()(const f32x4 (&acc)[2][2][4][2], const Unit& u, int wr, int wc, int fr, int fq) const {
        float scs[2][4];
#pragma unroll
        for (int ai = 0; ai < 2; ++ai)
#pragma unroll
            for (int m = 0; m < 4; ++m) { const int rl = ai * 128 + wr * 64 + m * 16 + fr; const float sc = sclL[u.aux * 256 + rl];
                float v[16]; float amax = 0.f;
#pragma unroll
                for (int bj = 0; bj < 2; ++bj)
#pragma unroll
                    for (int n = 0; n < 2; ++n)
#pragma unroll
                        for (int j = 0; j < 4; ++j) { const float x = acc[ai][bj][m][n][j] * sc; v[bj * 8 + n * 4 + j] = x; amax = fmaxf(amax, fabsf(x)); }
                amax = fmaxf(amax, __shfl_xor(amax, 16)); amax = fmaxf(amax, __shfl_xor(amax, 32));
                const float inv = amax > 0.f ? 127.0f / amax : 0.f;
                scs[ai][m] = amax * (1.0f / 127.0f);
                v4u w;
#pragma unroll
                for (int d = 0; d < 4; ++d) { const int q0 = (int)__builtin_rintf(v[4 * d] * inv), q1 = (int)__builtin_rintf(v[4 * d + 1] * inv), q2 = (int)__builtin_rintf(v[4 * d + 2] * inv), q3 = (int)__builtin_rintf(v[4 * d + 3] * inv);
                    w[d] = ((unsigned)q0 & 255u) | (((unsigned)q1 & 255u) << 8) | (((unsigned)q2 & 255u) << 16) | ((unsigned)q3 << 24); }
                *(v4u*)(YS8 + (size_t)(u.pm * 256 + rl) * 1024 + u.pn * 256 + wc * 64 + fq * 16) = w; }
#pragma unroll
        for (int ai = 0; ai < 2; ++ai) { const float sv = fq == 0 ? scs[ai][0] : fq == 1 ? scs[ai][1] : fq == 2 ? scs[ai][2] : scs[ai][3];
            YSC[(size_t)(u.pm * 256 + ai * 128 + wr * 64 + fq * 16 + fr) * 16 + wc * 4 + u.pn] = sv; }
    }
};

struct TItem { const float* W; int N; bf16* WT; int ldk, k0, n0, drow0; };
__device__ __forceinline__ void transpose_load(const TItem& it, f32x4 (&tv)[8], int lane) {
#pragma unroll
    for (int i = 0; i < 8; ++i) tv[i] = __builtin_nontemporal_load((const f32x4*)(it.W + (size_t)(it.k0 + 8 * i + (lane >> 3)) * it.N + it.n0 + 4 * (lane & 7)));
}
template <bool NT = false> __device__ __forceinline__ void transpose_store(const TItem& it, const f32x4 (&tv)[8], LAS float* scr, int lane) {
#pragma unroll
    for (int i = 0; i < 8; ++i) { LAS float* d = scr + (8 * i + (lane >> 3)) * 33 + 4 * (lane & 7); d[0] = tv[i].x; d[1] = tv[i].y; d[2] = tv[i].z; d[3] = tv[i].w; }
    LDS_WAIT(); asm volatile("" ::: "memory");
    const int c = lane & 7;
#pragma unroll
    for (int j = 0; j < 4; ++j) { const int n = (lane >> 3) + 8 * j; const LAS float* s = scr + (8 * c) * 33 + n;
        v4u o; o.x = pk2(s[0 * 33], s[1 * 33]); o.y = pk2(s[2 * 33], s[3 * 33]); o.z = pk2(s[4 * 33], s[5 * 33]); o.w = pk2(s[6 * 33], s[7 * 33]);
        if (NT) __builtin_nontemporal_store(o, (v4u*)(it.WT + (size_t)(it.drow0 + n) * it.ldk + it.k0 + 8 * c)); else *(v4u*)(it.WT + (size_t)(it.drow0 + n) * it.ldk + it.k0 + 8 * c) = o; }
    LDS_WAIT(); asm volatile("" ::: "memory");
}
__device__ __forceinline__ int ileave_row(int n, int half) { return 256 * (n >> 7) + 128 * half + (n & 127); }

template <int NR> __device__ __forceinline__ void rms_rows_to_bf16(const float* x0, const float* gain, bf16* o0, size_t rstride, int lane) {
    f32x4 v[NR][4];
#pragma unroll
    for (int r = 0; r < NR; ++r) { const f32x4* xr = (const f32x4*)(x0 + r * rstride) + lane;
#pragma unroll
        for (int j = 0; j < 4; ++j) v[r][j] = __builtin_nontemporal_load(xr + 64 * j); }
    asm volatile("" ::: "memory");
    const f32x4* gr = (const f32x4*)gain + lane;
    f32x4 g[4];
#pragma unroll
    for (int j = 0; j < 4; ++j) g[j] = gr[64 * j];
#pragma unroll
    for (int r = 0; r < NR; ++r) { float s = 0.f;
#pragma unroll
        for (int j = 0; j < 4; ++j) s += (v[r][j].x * v[r][j].x + v[r][j].y * v[r][j].y) + (v[r][j].z * v[r][j].z + v[r][j].w * v[r][j].w);
        const float rstd = 1.0f / sqrtf(wave_sum(s) * (1.f / D) + RMS_EPS);
        unsigned long long* o8 = (unsigned long long*)(o0 + r * rstride) + lane;
#pragma unroll
        for (int j = 0; j < 4; ++j) o8[64 * j] = (unsigned long long)pk2(v[r][j].x * rstd * g[j].x, v[r][j].y * rstd * g[j].y) | ((unsigned long long)pk2(v[r][j].z * rstd * g[j].z, v[r][j].w * rstd * g[j].w) << 32); }
}

__device__ __forceinline__ void s5_tables(const Frame& F, int g, const float* lam_re, const float* lam_im, const float* log_dt, const float* b_re, const float* b_im, const float* c_re, const float* c_im, const float* dsk) {
    LAS float* Cre = (LAS float*)F.lds;
    LAS float* Cim = Cre + 1024;
    LAS float* Bre = Cim + 1024;
    LAS float* Bim = Bre + 1024;
    LAS float* Pre = Bim + 1024;
    LAS float* Pim = Pre + 17 * 64;
    LAS float* Kt = Pim + 17 * 64;
    const int tid = F.tid;
    for (int i = tid; i < 1024; i += 512) { Cre[i] = c_re[g * 1024 + i]; Cim[i] = c_im[g * 1024 + i]; }
    if (tid < 64) {
        const int p = tid; const float lr = lam_re[g * 64 + p], li = lam_im[g * 64 + p], dt = expf(log_dt[g]);
        const float er = expf(lr * dt), lbr = er * cosf(li * dt), lbi = er * sinf(li * dt);
        const float den = lr * lr + li * li, nr = lbr - 1.0f, ni = lbi;
        const float cr = (nr * lr + ni * li) / den, ci = (ni * lr - nr * li) / den;
        { float pr = 1.f, pi = 0.f; for (int k = 0; k <= 16; ++k) { Pre[k * 64 + p] = pr; Pim[k * 64 + p] = pi; const float nr2 = pr * lbr - pi * lbi, ni2 = pr * lbi + pi * lbr; pr = nr2; pi = ni2; } }
        for (int c = 0; c < 16; ++c) { const float br = b_re[(g * 64 + p) * 16 + c], bi = b_im[(g * 64 + p) * 16 + c]; Bre[p * 16 + c] = cr * br - ci * bi; Bim[p * 16 + c] = cr * bi + ci * br; }
    }
    __syncthreads();
    for (int e = tid; e < 4096; e += 512) {
        const int k = e >> 8, c = (e >> 4) & 15, cp = e & 15; float s = 0.f;
        for (int p = 0; p < 64; ++p) { const float xr = Cre[c * 64 + p] * Pre[k * 64 + p] - Cim[c * 64 + p] * Pim[k * 64 + p], xi = Cre[c * 64 + p] * Pim[k * 64 + p] + Cim[c * 64 + p] * Pre[k * 64 + p];
            s += xr * Bre[p * 16 + cp] - xi * Bim[p * 16 + cp]; }
        if (k == 0 && c == cp) s += dsk[g * 16 + c];
        Kt[e] = s;
    }
    __syncthreads();
    unsigned* btt = (unsigned*)(F.ws + WS_BTT) + (size_t)g * 256 * (S5K / 2);
    for (int e = tid; e < 256 * (S5K / 2); e += 512) {
        const int row = e / (S5K / 2), cpair = e % (S5K / 2), t = row >> 4, c = row & 15, col = 2 * cpair; float v0, v1;
        if (col < S5Q) { const int p = col >> 1; const float xr = Cre[c * 64 + p] * Pre[(t + 1) * 64 + p] - Cim[c * 64 + p] * Pim[(t + 1) * 64 + p], xi = Cre[c * 64 + p] * Pim[(t + 1) * 64 + p] + Cim[c * 64 + p] * Pre[(t + 1) * 64 + p];
            v0 = xr; v1 = -xi; }
        else { const int s = (col - S5Q) >> 4, cp = (col - S5Q) & 15;
            if (s <= t) { v0 = Kt[(t - s) * 256 + c * 16 + cp]; v1 = Kt[(t - s) * 256 + c * 16 + cp + 1]; } else { v0 = 0.f; v1 = 0.f; } }
        btt[e] = pk2(v0, v1);
    }
    unsigned* btw = (unsigned*)(F.ws + WS_BTW) + (size_t)g * 128 * 128;
    for (int e = tid; e < 128 * 128; e += 512) {
        const int q = e >> 7, cpair = e & 127, col = 2 * cpair, s = col >> 4, cp = col & 15, p = q >> 1, k = 15 - s;
        const float pr = Pre[k * 64 + p], pi = Pim[k * 64 + p];
        float v0, v1;
        if (q & 1) { v0 = pr * Bim[p * 16 + cp] + pi * Bre[p * 16 + cp]; v1 = pr * Bim[p * 16 + cp + 1] + pi * Bre[p * 16 + cp + 1]; }
        else { v0 = pr * Bre[p * 16 + cp] - pi * Bim[p * 16 + cp]; v1 = pr * Bre[p * 16 + cp + 1] - pi * Bim[p * 16 + cp + 1]; }
        btw[e] = pk2(v0, v1);
    }
    if (tid < 64) { float* l16 = (float*)(F.ws + SM_LAM16) + (g * 64 + tid) * 2; l16[0] = Pre[16 * 64 + tid]; l16[1] = Pim[16 * 64 + tid]; }
    __syncthreads();
}

struct In { const float* p[30]; };

__device__ __forceinline__ void p0_prologue(const Frame& F, const In& I) {
    for (int g = F.vcu; g < S5G; g += F.G) s5_tables(F, g, I.p[3], I.p[4], I.p[5], I.p[6], I.p[7], I.p[8], I.p[9], I.p[10]);
    const int gt = F.vcu * 512 + F.tid, NGT = F.G * 512;
    { float* lc = (float*)(F.ws + SM_LRUC); for (int i = gt; i < LRUW; i += NGT) { const float lam = I.p[18][i]; lc[i] = -8.0f * log1pf(expf(-lam)) * 1.44269504f; } }
    { bf16* wrt = (bf16*)(F.ws + SM_WRT);
        for (int i = gt; i < 2 * 65536; i += NGT) { const int which = i >> 16, r = i & 65535, h = r >> 12, j = (r >> 6) & 63, k = r & 63; const float* src = which ? I.p[16] : I.p[14]; wrt[i] = (bf16)f2bf(src[(h * 64 + k) * 64 + j]); } }
    { bf16* rhi = (bf16*)(F.ws + SM_RHI); bf16* rlo = (bf16*)(F.ws + SM_RLO);
        for (int i = gt; i < NROUT * 1024; i += NGT) { const int n = i >> 10, k = i & 1023; float w = 0.f; if (n < 4) w = I.p[22][k * 4 + n]; else if (n < 36) w = I.p[24][k * 32 + (n - 4)];
            const unsigned h = f2bf(w); rhi[i] = (bf16)h; rlo[i] = (bf16)f2bf(w - bf2f(h)); } }
    LAS float* scr = (LAS float*)(F.lds + F.wave * 16384);
    const int gw = F.vcu * NWAVES + F.wave, NGW = F.G * NWAVES;
    constexpr int I_IN = (D / 64) * (NIN / 32), I_S5 = (S5W / 64) * (2 * D / 32), I_LRU = (D / 64) * (D / 32), I_O = I_LRU;
    constexpr int NITEMS = I_IN + I_S5 + I_LRU + I_O;
    for (int it = gw; it < NITEMS; it += NGW) {
        int r = it; TItem ti;
        if (r < I_IN) { const int nb = NIN / 32, kb = r / nb, n0 = 32 * (r % nb); ti = TItem{I.p[2], NIN, (bf16*)(F.ws + WS_WIN), D, 64 * kb, n0, n0}; }
        else if ((r -= I_IN) < I_S5) { const int nb = 2 * D / 32, kb = r / nb, n0 = 32 * (r % nb); ti = TItem{I.p[11], 2 * D, (bf16*)(F.ws + WS_WS5), S5W, 64 * kb, n0, n0 < D ? ileave_row(n0, 0) : ileave_row(n0 - D, 1)}; }
        else if ((r -= I_S5) < I_LRU) { const int nb = D / 32, kb = r / nb, n0 = 32 * (r % nb); ti = TItem{I.p[19], D, (bf16*)(F.ws + WS_WLRU), D, 64 * kb, n0, n0}; }
        else { r -= I_LRU; const int nb = D / 32, kb = r / nb, n0 = 32 * (r % nb); ti = TItem{I.p[20], D, (bf16*)(F.ws + WS_WO), D, 64 * kb, n0, n0}; }
        f32x4 tv[8]; transpose_load(ti, tv, F.lane); asm volatile("" ::: "memory"); transpose_store(ti, tv, scr, F.lane);
    }
    { const int skip = F.G > 2 * S5G ? S5G : 0;
      if (F.vcu >= skip) { const int gw2 = (F.vcu - skip) * NWAVES + F.wave, NGW2 = (F.G - skip) * NWAVES;
        for (int m = gw2 * 4; m < T; m += NGW2 * 4) rms_rows_to_bf16<4>(I.p[0] + (size_t)m * D, I.p[1], (bf16*)(F.ws + WS_H) + (size_t)m * D, D, F.lane); } }
}
__device__ __forceinline__ TItem expert_item(const Frame& F, const In& I, int it) {
    constexpr int I_G = (D / 64) * (DEXP / 32), I_D = (DEXP / 64) * (D / 32);
    const int e = it / (2 * I_G + I_D); int r = it % (2 * I_G + I_D);
    if (r < 2 * I_G) { const int half = r / I_G; r %= I_G; const int nb = DEXP / 32, kb = r / nb, n0 = 32 * (r % nb);
        return TItem{(half ? I.p[27] : I.p[26]) + (size_t)e * D * DEXP, DEXP, (bf16*)(F.ws + WS_WGU) + (size_t)e * 1024 * 1024, D, 64 * kb, n0, ileave_row(n0, half)}; }
    r -= 2 * I_G; const int nb = D / 32, kb = r / nb, n0 = 32 * (r % nb);
    return TItem{I.p[28] + (size_t)e * DEXP * D, D, (bf16*)(F.ws + WS_WD) + (size_t)e * 1024 * DEXP, DEXP, 64 * kb, n0, n0};
}
__device__ __forceinline__ void expert_weight_copies(const Frame& F, const In& I) {
    LAS float* scr = (LAS float*)(F.lds + F.wave * 16384);
    const int gw = F.vcu * NWAVES + F.wave, NGW = F.G * NWAVES;
    constexpr int NIT = NEXP * 768;
    const int first = 8 * NGW < NIT ? 8 * NGW : NIT;
    for (int it = first + gw; it < NIT; it += 2 * NGW) {
        const TItem t0 = expert_item(F, I, it); const bool has1 = it + NGW < NIT; const TItem t1 = expert_item(F, I, has1 ? it + NGW : it);
        f32x4 v0[8], v1[8]; transpose_load(t0, v0, F.lane); transpose_load(t1, v1, F.lane); asm volatile("" ::: "memory");
        transpose_store(t0, v0, scr, F.lane); if (has1) transpose_store(t1, v1, scr, F.lane);
    }
}

__device__ __forceinline__ void lru_seq(const Frame& F, const In& I) {
    LAS unsigned char* wl = F.lds + F.wave * 17920;
    LAS bf16* xcA = (LAS bf16*)wl;
    LAS float* pre = (LAS float*)(wl + 9216);
    typedef float f32x2 __attribute__((ext_vector_type(2)));
    LAS f32x2* sumT = (LAS f32x2*)(F.lds + 143360);
    const int lane = F.lane, jj = lane & 15, ks = lane >> 4, c32 = lane & 31, th = lane >> 5;
    const bf16* XL = (const bf16*)(F.ws + WS_XL); const bf16* GL = (const bf16*)(F.ws + WS_GL); bf16* YL = (bf16*)(F.ws + WS_H);
    const bf16* WRT = (const bf16*)(F.ws + SM_WRT);
    for (int un = F.vcu; un < BATCH * LRUH * 2; un += F.G) {
        const int b = un >> 5, hd = (un >> 1) & 15, half = un & 1;
        const int chin = hd * 64 + lane;
        const int chg = hd * 64 + 32 * half + c32;
        const float w0 = I.p[12][chin], w1 = I.p[12][1024 + chin], w2 = I.p[12][2048 + chin], w3 = I.p[12][3072 + chin], cb = I.p[13][chin];
        const float brs = I.p[15][chg] * -1.44269504f, bis = I.p[17][chg] * -1.44269504f, cch2 = ((const float*)(F.ws + SM_LRUC))[chg];
        bf16x8 Bw[4][2];
#pragma unroll
        for (int n = 0; n < 4; ++n)
#pragma unroll
            for (int k = 0; k < 2; ++k) Bw[n][k] = *(const bf16x8*)(WRT + (size_t)(n >> 1) * 65536 + (size_t)(hd * 64 + 32 * half + 16 * (n & 1) + jj) * 64 + 32 * k + 8 * ks);
        float Rc = 0.f;
        for (int rd = 0; rd < 8; ++rd) {
            const int j = rd * 8 + F.wave;
            const size_t tok0 = (size_t)b * SEQ + (size_t)j * LRUCH;
            unsigned short xr[64], xh[3];
            { const bf16* xp = XL + tok0 * 1024 + chin;
              xh[0] = 0; xh[1] = 0; xh[2] = 0;
              if (j > 0) { xh[0] = xp[-3 * 1024]; xh[1] = xp[-2 * 1024]; xh[2] = xp[-1 * 1024]; }
#pragma unroll
              for (int t = 0; t < 64; ++t) xr[t] = xp[t * 1024]; }
            asm volatile("" ::: "memory");
            { typedef float f2v __attribute__((ext_vector_type(2)));
              float xm3 = bf2f(xh[0]), xm2 = bf2f(xh[1]), xm1 = bf2f(xh[2]);
              const f2v vw0 = {w0, w0}, vw1 = {w1, w1}, vw2 = {w2, w2}, vw3 = {w3, w3}, vcb = {cb, cb};
#pragma unroll
              for (int t = 0; t < 64; t += 2) { const float x0 = bf2f(xr[t]), x1 = bf2f(xr[t + 1]);
                  f2v xc = vcb + vw0 * (f2v){xm3, xm2}; xc = xc + vw1 * (f2v){xm2, xm1}; xc = xc + vw2 * (f2v){xm1, x0}; xc = xc + vw3 * (f2v){x0, x1};
                  const unsigned pk = pg8::cvt_pk_bf16(xc.x, xc.y);
                  xcA[t * 72 + lane] = (bf16)(pk & 0xffffu); xcA[(t + 1) * 72 + lane] = (bf16)(pk >> 16);
                  xm3 = xm1; xm2 = x0; xm1 = x1; } }
            LDS_WAIT();
            float hl[2][16], Pl[2][16], Prun[2], Hrun[2];
#pragma unroll
            for (int st = 0; st < 2; ++st) {
#pragma unroll
                for (int mh = 0; mh < 2; ++mh) { const int mt = 2 * st + mh;
                    bf16x8 a[2];
#pragma unroll
                    for (int k = 0; k < 2; ++k) a[k] = *(const LAS bf16x8*)(xcA + (16 * mt + jj) * 72 + 32 * k + 8 * ks);
#pragma unroll
                    for (int n = 0; n < 4; ++n) { f32x4 d = (f32x4){0.f, 0.f, 0.f, 0.f};
#pragma unroll
                        for (int k = 0; k < 2; ++k) d = __builtin_amdgcn_mfma_f32_16x16x32_bf16(a[k], Bw[n][k], d, 0, 0, 0);
#pragma unroll
                        for (int r = 0; r < 4; ++r) pre[(16 * mh + 4 * ks + r) * 68 + 16 * n + jj] = d[r]; } }
                LDS_WAIT();
                float h = 0.f, P = 1.f;
                typedef float f2v __attribute__((ext_vector_type(2)));
#pragma unroll
                for (int tl = 0; tl < 16; tl += 2) {
                    const int trow = 16 * th + tl;
                    const f2v pr = {pre[trow * 68 + c32], pre[(trow + 1) * 68 + c32]}, pi = {pre[trow * 68 + 32 + c32], pre[(trow + 1) * 68 + 32 + c32]};
                    const f2v zr = pr * (f2v){-1.44269504f, -1.44269504f} + (f2v){brs, brs}, zi = pi * (f2v){-1.44269504f, -1.44269504f} + (f2v){bis, bis};
                    const f2v er = {__builtin_amdgcn_exp2f(zr.x), __builtin_amdgcn_exp2f(zr.y)}, ei = {__builtin_amdgcn_exp2f(zi.x), __builtin_amdgcn_exp2f(zi.y)};
                    const f2v dr = er + (f2v){1.f, 1.f};
                    const f2v rg = {__builtin_amdgcn_rcpf(dr.x), __builtin_amdgcn_rcpf(dr.y)};
                    const f2v la2 = rg * (f2v){cch2, cch2};
                    const f2v a_ = {__builtin_amdgcn_exp2f(la2.x), __builtin_amdgcn_exp2f(la2.y)};
                    const f2v x2 = la2 * (f2v){1.38629436f, 1.38629436f};
                    f2v q = x2 * (f2v){0.0013888889f, 0.0013888889f} + (f2v){0.0083333333f, 0.0083333333f};
                    q = q * x2 + (f2v){0.041666667f, 0.041666667f}; q = q * x2 + (f2v){0.16666667f, 0.16666667f}; q = q * x2 + (f2v){0.5f, 0.5f}; q = q * x2 + (f2v){1.f, 1.f};
                    f2v om = -(q * x2);
                    const f2v alt = (f2v){1.f, 1.f} - a_ * a_;
                    om.x = x2.x > -0.3f ? om.x : alt.x; om.y = x2.y > -0.3f ? om.y : alt.y;
                    om.x = fmaxf(om.x, 1e-30f); om.y = fmaxf(om.y, 1e-30f);
                    const f2v dd = ei + (f2v){1.f, 1.f};
                    const f2v rq = om * dd * dd;
                    const f2v mi = om * (f2v){__builtin_amdgcn_rsqf(rq.x), __builtin_amdgcn_rsqf(rq.y)};
                    const f2v bx = mi * (f2v){bf2f(xcA[(32 * st + trow) * 72 + 32 * half + c32]), bf2f(xcA[(32 * st + trow + 1) * 72 + 32 * half + c32])};
                    h = a_.x * h + bx.x; P *= a_.x; hl[st][tl] = h; Pl[st][tl] = P;
                    h = a_.y * h + bx.y; P *= a_.y; hl[st][tl + 1] = h; Pl[st][tl + 1] = P;
                }
                Prun[st] = P; Hrun[st] = h;
                LDS_WAIT();
            }
            const float pP0 = __shfl_xor(Prun[0], 32), pH0 = __shfl_xor(Hrun[0], 32), pP1 = __shfl_xor(Prun[1], 32), pH1 = __shfl_xor(Hrun[1], 32);
            const float P0 = th ? pP0 : Prun[0], H0 = th ? pH0 : Hrun[0], P1 = th ? Prun[0] : pP0, H1 = th ? Hrun[0] : pH0;
            const float P2 = th ? pP1 : Prun[1], H2 = th ? pH1 : Hrun[1], P3 = th ? Prun[1] : pP1, H3 = th ? Hrun[1] : pH1;
            const float C1 = H0, Q1 = P0, C2 = P1 * C1 + H1, Q2 = P1 * Q1, C3 = P2 * C2 + H2, Q3 = P2 * Q2, Hc = P3 * C3 + H3, Pc = P3 * Q3;
            const float Cs0 = th ? C1 : 0.f, Qs0 = th ? Q1 : 1.f, Cs1 = th ? C3 : C2, Qs1 = th ? Q3 : Q2;
            const int cit = (rd * F.G + F.vcu) * NWAVES + F.wave; const bool cdo = cit < NEXP * 768;
            f32x4 ctv[8]; unsigned short ggr[2][16];
            if (cdo) { const TItem citem = expert_item(F, I, cit); transpose_load(citem, ctv, lane); }
#pragma unroll
            for (int st = 0; st < 2; ++st)
#pragma unroll
                for (int tl = 0; tl < 16; ++tl) ggr[st][tl] = GL[(tok0 + 32 * st + 16 * th + tl) * 1024 + chg];
            asm volatile("" ::: "memory");
            if (th == 0) sumT[((rd & 1) * 8 + F.wave) * 32 + c32] = (f32x2){Pc, Hc};
            LDS_WAIT();
            __syncthreads();
            float cin = Rc, mycin = 0.f;
#pragma unroll
            for (int w = 0; w < 8; ++w) { const f32x2 ph = sumT[((rd & 1) * 8 + w) * 32 + c32]; mycin = (w == F.wave) ? cin : mycin; cin = ph.x * cin + ph.y; }
            Rc = cin;
#pragma unroll
            for (int st = 0; st < 2; ++st) { const float hin = (st ? Cs1 : Cs0) + (st ? Qs1 : Qs0) * mycin;
#pragma unroll
                for (int tl = 0; tl < 16; ++tl) { const float hh = hl[st][tl] + Pl[st][tl] * hin;
                    YL[(tok0 + 32 * st + 16 * th + tl) * 1024 + chg] = (bf16)f2bf(hh * bf2f(ggr[st][tl])); } }
            if (cdo) { const TItem citem = expert_item(F, I, cit); transpose_store<true>(citem, ctv, pre, lane); }
        }
        __syncthreads();
    }
}

__device__ __forceinline__ void s5_chain(const Frame& F, int b, int g) {
    typedef float f32x2 __attribute__((ext_vector_type(2)));
    LAS f32x2* segE = (LAS f32x2*)(F.lds);
    const int lane = F.lane, w = F.wave;
    const float* SLOC = (const float*)(F.ws + WS_SLOC); unsigned* AGw = (unsigned*)(F.ws + WS_AG); const float* L16 = (const float*)(F.ws + SM_LAM16);
    const float lr = L16[(g * 64 + lane) * 2], li = L16[(g * 64 + lane) * 2 + 1];
    const float* sl = SLOC + ((size_t)(g * S5N + b * S5NCH + 32 * w)) * S5Q + 2 * lane;
    unsigned* ag = AGw + ((size_t)(g * S5N + b * S5NCH + 32 * w)) * (S5K / 2) + lane;
    float xr[32], xi[32];
#pragma unroll
    for (int u = 0; u < 32; ++u) { const float2 v = *(const float2*)(sl + (size_t)u * S5Q); xr[u] = v.x; xi[u] = v.y; }
    asm volatile("" ::: "memory");
    float sr = 0.f, si = 0.f;
#pragma unroll
    for (int u = 0; u < 32; ++u) { const float nr = lr * sr - li * si + xr[u], ni = lr * si + li * sr + xi[u]; xr[u] = sr; xi[u] = si; sr = nr; si = ni; }
    segE[w * 64 + lane] = (f32x2){sr, si};
    float qr = lr, qi = li;
#pragma unroll
    for (int k = 0; k < 5; ++k) { const float nr = qr * qr - qi * qi, ni = 2.f * qr * qi; qr = nr; qi = ni; }
    LDS_WAIT();
    __syncthreads();
    float cr = 0.f, ci = 0.f;
    for (int ww = 0; ww < w; ++ww) { const f32x2 e = segE[ww * 64 + lane]; const float nr = qr * cr - qi * ci + e.x, ni = qr * ci + qi * cr + e.y; cr = nr; ci = ni; }
#pragma unroll
    for (int u = 0; u < 32; ++u) { ag[(size_t)u * (S5K / 2)] = pk2(xr[u] + cr, xi[u] + ci); const float nr = lr * cr - li * ci, ni = lr * ci + li * cr; cr = nr; ci = ni; }
    __syncthreads();
}

__device__ __forceinline__ void p8_router(const Frame& F, const In& I) {
    const int lane = F.lane, tk = lane & 15, ks = lane >> 4;
    LAS float* lg = (LAS float*)(F.lds + F.wave * 4096);
    volatile LAS unsigned* cntL = F.MISC + 32; volatile LAS unsigned* baseL = F.MISC + 64;
    const float* X1 = F.out; bf16* H2 = (bf16*)(F.ws + WS_H2); const float* gf = I.p[21];
    const bf16* RHI = (const bf16*)(F.ws + SM_RHI); const bf16* RLO = (const bf16*)(F.ws + SM_RLO);
    float* RSTD = (float*)(F.ws + SM_RSTD); unsigned* gcnt = F.ctl + CW_CNT;
    int* LTOK = (int*)(F.ws + WS_LTOK); float* LW = (float*)(F.ws + WS_LW); int* TOKE = (int*)(F.ws + WS_TOKE); int* TOKR = (int*)(F.ws + WS_TOKR);
    for (int blk = F.vcu; blk < T / 128; blk += F.G) {
        if (F.tid < 32) cntL[F.tid] = 0u;
        __syncthreads();
        const int tok0 = blk * 128 + F.wave * 16;
        const float* xrow = X1 + (size_t)(tok0 + tk) * D + 8 * ks; bf16* hrow = H2 + (size_t)(tok0 + tk) * D + 8 * ks;
        f32x4 acc[3]; acc[0] = acc[1] = acc[2] = (f32x4){0.f, 0.f, 0.f, 0.f}; float ss = 0.f;
        f32x4 xnx[4][2];
#pragma unroll
        for (int q = 0; q < 4; ++q) { xnx[q][0] = __builtin_nontemporal_load((const f32x4*)(xrow + 32 * q)); xnx[q][1] = __builtin_nontemporal_load((const f32x4*)(xrow + 32 * q + 4)); }
        LAS bf16* slab = (LAS bf16*)(F.lds + 32768);
        v4u wst[3];
#define RT_SLAB_LOAD(g) do { _Pragma("unroll") for (int j = 0; j < 3; ++j) { const int c = F.tid + 512 * j, which = c / 768, r = (c % 768) >> 4, kq = c & 15; \
            wst[j] = *(const v4u*)((which ? RLO : RHI) + (size_t)r * D + 128 * (g) + 8 * kq); } } while (0)
#define RT_SLAB_STORE(buf) do { _Pragma("unroll") for (int j = 0; j < 3; ++j) { const int c = F.tid + 512 * j, which = c / 768, r = (c % 768) >> 4, kq = c & 15; \
            *(LAS v4u*)(slab + ((size_t)((buf) * 2 + which) * 48 + r) * 136 + 8 * kq) = wst[j]; } } while (0)
        RT_SLAB_LOAD(0); RT_SLAB_STORE(0);
        LDS_WAIT();
        __syncthreads();
        for (int kg = 0; kg < 8; ++kg) {
            f32x4 xa[4][2];
#pragma unroll
            for (int q = 0; q < 4; ++q) { xa[q][0] = xnx[q][0]; xa[q][1] = xnx[q][1]; }
            { const int kgn = kg < 7 ? kg + 1 : kg;
#pragma unroll
              for (int q = 0; q < 4; ++q) { xnx[q][0] = __builtin_nontemporal_load((const f32x4*)(xrow + 32 * (4 * kgn + q))); xnx[q][1] = __builtin_nontemporal_load((const f32x4*)(xrow + 32 * (4 * kgn + q) + 4)); }
              RT_SLAB_LOAD(kgn); }
            f32x4 ga[4][2];
#pragma unroll
            for (int q = 0; q < 4; ++q) { const int kc = 4 * kg + q; ga[q][0] = *(const f32x4*)(gf + 32 * kc + 8 * ks); ga[q][1] = *(const f32x4*)(gf + 32 * kc + 8 * ks + 4); }
            asm volatile("" ::: "memory");
            const LAS bf16* sh = slab + (size_t)((kg & 1) * 2) * 48 * 136, * sl = sh + 48 * 136;
#pragma unroll
            for (int q = 0; q < 4; ++q) { const int kc = 4 * kg + q;
                const f32x4 a0 = xa[q][0], a1 = xa[q][1];
                ss += (a0.x * a0.x + a0.y * a0.y) + (a0.z * a0.z + a0.w * a0.w) + (a1.x * a1.x + a1.y * a1.y) + (a1.z * a1.z + a1.w * a1.w);
                const f32x4 v0 = a0 * ga[q][0], v1 = a1 * ga[q][1];
                v4u hi, lo;
                { const unsigned h0 = f2bf(v0.x), h1 = f2bf(v0.y), h2 = f2bf(v0.z), h3 = f2bf(v0.w), h4 = f2bf(v1.x), h5 = f2bf(v1.y), h6 = f2bf(v1.z), h7 = f2bf(v1.w);
                  hi.x = h0 | (h1 << 16); hi.y = h2 | (h3 << 16); hi.z = h4 | (h5 << 16); hi.w = h6 | (h7 << 16);
                  lo.x = pk2(v0.x - bf2f(h0), v0.y - bf2f(h1)); lo.y = pk2(v0.z - bf2f(h2), v0.w - bf2f(h3)); lo.z = pk2(v1.x - bf2f(h4), v1.y - bf2f(h5)); lo.w = pk2(v1.z - bf2f(h6), v1.w - bf2f(h7)); }
                *(v4u*)(hrow + 32 * kc) = hi;
                const bf16x8 hf = __builtin_bit_cast(bf16x8, hi), lf = __builtin_bit_cast(bf16x8, lo);
#pragma unroll
                for (int n = 0; n < 3; ++n) {
                    const bf16x8 wh = *(const LAS bf16x8*)(sh + (16 * n + tk) * 136 + 32 * q + 8 * ks), wl = *(const LAS bf16x8*)(sl + (16 * n + tk) * 136 + 32 * q + 8 * ks);
                    acc[n] = __builtin_amdgcn_mfma_f32_16x16x32_bf16(wh, hf, acc[n], 0, 0, 0);
                    acc[n] = __builtin_amdgcn_mfma_f32_16x16x32_bf16(wh, lf, acc[n], 0, 0, 0);
                    acc[n] = __builtin_amdgcn_mfma_f32_16x16x32_bf16(wl, hf, acc[n], 0, 0, 0);
                } }
            if (kg < 7) RT_SLAB_STORE((kg + 1) & 1);
            LDS_WAIT();
            __syncthreads();
        }
#undef RT_SLAB_LOAD
#undef RT_SLAB_STORE
        ss += __shfl_xor(ss, 16); ss += __shfl_xor(ss, 32);
        const float rstd = 1.0f / sqrtf(ss * (1.f / D) + RMS_EPS);
        if (ks == 0) RSTD[tok0 + tk] = rstd;
#pragma unroll
        for (int n = 0; n < 3; ++n)
#pragma unroll
            for (int r = 0; r < 4; ++r) lg[tk * 49 + 16 * n + 4 * ks + r] = acc[n][r] * rstd;
        LDS_WAIT();
        int E1 = 0, E2 = 0; float w1 = 0.f, w2 = 0.f; unsigned r1 = 0, r2 = 0;
        if (lane < 16) {
            const LAS float* my = lg + lane * 49;
            float lgp[4];
#pragma unroll
            for (int i = 0; i < 4; ++i) lgp[i] = my[i] + I.p[23][i];
            int gi = 0; float mx = lgp[0];
#pragma unroll
            for (int i = 1; i < 4; ++i) if (lgp[i] > mx) { mx = lgp[i]; gi = i; }
            float den = 0.f;
#pragma unroll
            for (int i = 0; i < 4; ++i) den += expf(lgp[i] - mx);
            const float pg = 1.0f / den;
            float le[8];
#pragma unroll
            for (int i = 0; i < 8; ++i) le[i] = my[4 + gi * 8 + i] + I.p[25][gi * 8 + i];
            int i1 = 0; float m1 = le[0];
#pragma unroll
            for (int i = 1; i < 8; ++i) if (le[i] > m1) { m1 = le[i]; i1 = i; }
            int i2 = -1; float m2 = -3.0e38f;
#pragma unroll
            for (int i = 0; i < 8; ++i) if (i != i1 && le[i] > m2) { m2 = le[i]; i2 = i; }
            const float e2 = expf(m2 - m1);
            w1 = pg / (1.0f + e2); w2 = pg * e2 / (1.0f + e2);
            E1 = gi * 8 + i1; E2 = gi * 8 + i2;
            r1 = __hip_atomic_fetch_add((LAS unsigned*)(F.MISC + 32) + E1, 1u, __ATOMIC_RELAXED, __HIP_MEMORY_SCOPE_WORKGROUP);
            r2 = __hip_atomic_fetch_add((LAS unsigned*)(F.MISC + 32) + E2, 1u, __ATOMIC_RELAXED, __HIP_MEMORY_SCOPE_WORKGROUP);
        }
        LDS_WAIT();
        __syncthreads();
        if (F.tid < 32) { const unsigned c = cntL[F.tid]; baseL[F.tid] = c ? __hip_atomic_fetch_add(gcnt + F.tid, c, __ATOMIC_RELAXED, __HIP_MEMORY_SCOPE_AGENT) : 0u; }
        __syncthreads();
        if (lane < 16) {
            const int tok = tok0 + lane; const int k1 = (int)(baseL[E1] + r1), k2 = (int)(baseL[E2] + r2);
            LTOK[(size_t)E1 * T + k1] = tok; LW[(size_t)E1 * T + k1] = w1; LTOK[(size_t)E2 * T + k2] = tok; LW[(size_t)E2 * T + k2] = w2;
            TOKE[tok * 2] = E1; TOKE[tok * 2 + 1] = E2; TOKR[tok * 2] = k1; TOKR[tok * 2 + 1] = k2;
        }
        __syncthreads();
    }
}

__device__ __forceinline__ void moe_prefix(const Frame& F) {
    if (F.tid < 64) {
        const unsigned nt = F.tid < NEXP ? (F.ctl[CW_CNT + F.tid] + 255u) >> 8 : 0u; unsigned inc = nt;
#pragma unroll
        for (int o = 1; o < 32; o <<= 1) { const unsigned v = __shfl_up(inc, o); if (F.lane >= o) inc += v; }
        if (F.tid < NEXP) F.MISC[96 + F.tid] = inc - nt;
        if (F.tid == NEXP - 1) F.MISC[128] = inc;
    }
    LDS_WAIT();
    __syncthreads();
}
template <int MODE  >
__device__ __forceinline__ void moe_setup(const Frame& F) {
    moe_prefix(F);
    const int NT = (int)F.MISC[128];
    if (F.tid < MAXU) { const int L = F.tid * F.G + F.vcu; int e = -1, mt = 0;
        if (L < NT * 4) { const int mtg = L >> 2; e = 0; while (e < NEXP - 1 && (int)F.MISC[96 + e + 1] <= mtg) ++e; mt = mtg - (int)F.MISC[96 + e]; }
        F.MISC[136 + F.tid] = (unsigned)e; F.MISC[144 + F.tid] = (unsigned)mt; }
    __syncthreads();
    if (F.tid == 0) { int n = 0; while (n < MAXU && (int)F.MISC[136 + n] >= 0) ++n; F.MISC[152] = (unsigned)n; }
    __syncthreads();
    const int nU = (int)F.MISC[152];
    LAS int* tokL = (LAS int*)(F.lds + TOKL_OFF); LAS float* sclL = (LAS float*)(F.lds + SCLL_OFF);
    const int* LTOK = (const int*)(F.ws + WS_LTOK); const float* LW = (const float*)(F.ws + WS_LW); const float* RSTD = (const float*)(F.ws + SM_RSTD);
    for (int i = F.tid; i < nU * 256; i += 512) { const int ui = i >> 8, r = i & 255, e = (int)F.MISC[136 + ui], rank = (int)F.MISC[144 + ui] * 256 + r; const bool valid = rank < (int)F.ctl[CW_CNT + e];
        const int tok = valid ? LTOK[(size_t)e * T + rank] : 0; tokL[i] = tok; sclL[i] = valid ? (MODE == 0 ? RSTD[tok] : LW[(size_t)e * T + rank]) : 0.f; }
    LDS_WAIT(); VM_WAIT();
    __syncthreads();
}

__device__ __forceinline__ void p11_final(const Frame& F, const In& I, float* dst) {
    moe_prefix(F);
    const int gw = F.vcu * NWAVES + F.wave, NGW = F.G * NWAVES, lane = F.lane;
    const int* TOKE = (const int*)(F.ws + WS_TOKE); const int* TOKR = (const int*)(F.ws + WS_TOKR);
    const unsigned char* YS8 = (const unsigned char*)(F.ws + WS_YS); const float* YSC = (const float*)(F.ws + WS_YS + 80 * MiB);
    f32x4 gfin[4];
#pragma unroll
    for (int j = 0; j < 4; ++j) gfin[j] = ((const f32x4*)I.p[29])[lane + 64 * j];
    int ee[2][2], rr[2][2];
    { const int m0 = gw * 2 < T ? gw * 2 : 0;
#pragma unroll
      for (int q = 0; q < 2; ++q) { ee[q][0] = TOKE[2 * (m0 + q)]; ee[q][1] = TOKE[2 * (m0 + q) + 1]; rr[q][0] = TOKR[2 * (m0 + q)]; rr[q][1] = TOKR[2 * (m0 + q) + 1]; } }
    for (int m0 = gw * 2; m0 < T; m0 += NGW * 2) {
        f32x4 xv[2][4]; unsigned ya[2][4], yb[2][4]; f32x4 sa[2], sb[2];
#pragma unroll
        for (int q = 0; q < 2; ++q) { const size_t s0 = (size_t)F.MISC[96 + ee[q][0]] * 256 + rr[q][0], s1 = (size_t)F.MISC[96 + ee[q][1]] * 256 + rr[q][1];
            const f32x4* xr = (const f32x4*)(F.out + (size_t)(m0 + q) * D) + lane; const unsigned* y0 = (const unsigned*)(YS8 + s0 * 1024) + lane; const unsigned* y1 = (const unsigned*)(YS8 + s1 * 1024) + lane;
#pragma unroll
            for (int j = 0; j < 4; ++j) { xv[q][j] = __builtin_nontemporal_load(xr + 64 * j); ya[q][j] = y0[64 * j]; yb[q][j] = y1[64 * j]; }
            sa[q] = *(const f32x4*)(YSC + s0 * 16 + 4 * (lane >> 4)); sb[q] = *(const f32x4*)(YSC + s1 * 16 + 4 * (lane >> 4)); }
        { const int mn = m0 + NGW * 2 < T ? m0 + NGW * 2 : m0;
#pragma unroll
          for (int q = 0; q < 2; ++q) { ee[q][0] = TOKE[2 * (mn + q)]; ee[q][1] = TOKE[2 * (mn + q) + 1]; rr[q][0] = TOKR[2 * (mn + q)]; rr[q][1] = TOKR[2 * (mn + q) + 1]; } }
        asm volatile("" ::: "memory");
#pragma unroll
        for (int q = 0; q < 2; ++q) { f32x4 v[4]; float s = 0.f;
#pragma unroll
            for (int j = 0; j < 4; ++j) { const f32x4 x = xv[q][j]; const unsigned a = ya[q][j], b = yb[q][j]; const float ka = sa[q][j], kb = sb[q][j];
                v[j].x = x.x + (float)((int)(a << 24) >> 24) * ka + (float)((int)(b << 24) >> 24) * kb;
                v[j].y = x.y + (float)((int)(a << 16) >> 24) * ka + (float)((int)(b << 16) >> 24) * kb;
                v[j].z = x.z + (float)((int)(a << 8) >> 24) * ka + (float)((int)(b << 8) >> 24) * kb;
                v[j].w = x.w + (float)((int)a >> 24) * ka + (float)((int)b >> 24) * kb;
                s += (v[j].x * v[j].x + v[j].y * v[j].y) + (v[j].z * v[j].z + v[j].w * v[j].w); }
            const float rstd = 1.0f / sqrtf(wave_sum(s) * (1.f / D) + RMS_EPS);
            f32x4* xw = (f32x4*)(dst + (size_t)(m0 + q) * D) + lane;
#pragma unroll
            for (int j = 0; j < 4; ++j) { const f32x4 g = gfin[j]; __builtin_nontemporal_store((f32x4){v[j].x * rstd * g.x, v[j].y * rstd * g.y, v[j].z * rstd * g.z, v[j].w * rstd * g.w}, xw + 64 * j); } }
    }
}

constexpr int N_PHASES = 12;
struct Args { In in; float* out; unsigned char* ws; float* fin_dst; int ph_lo, ph_hi, li, pad; };
__global__ void __launch_bounds__(NWAVES * 64, 2) mk_fwd(Args args) {
    extern __shared__ __attribute__((aligned(16))) unsigned char lds[];
    Frame F;
    F.lds = (LAS unsigned char*)lds;
    F.MISC = (volatile LAS unsigned*)(F.lds + MISC_OFF);
    F.tid = threadIdx.x; F.lane = F.tid & 63; F.wave = __builtin_amdgcn_readfirstlane(F.tid >> 6);
    F.G = gridDim.x; { const int bx = blockIdx.x; F.vcu = (F.G % 8 == 0) ? (bx % 8) * (F.G / 8) + bx / 8 : bx; }
    F.ws = args.ws; F.out = args.out; F.ctl = (unsigned*)(args.ws + WS_CTL); F.in = nullptr;
    const In& I = args.in;
    for (int u = F.tid; u < 256; u += NWAVES * 64) F.MISC[u] = 0u;
    __syncthreads();
    const int lo = args.ph_lo, hi = args.ph_hi;
    XcdBarrier bar; bar.bar = F.ctl + CW_BAR + args.li * XCD_BAR_WORDS; bar.x = 0; bar.st = nullptr;
    if (hi - lo > 1) bar = xcd_barrier_post(F.ctl + CW_BAR + args.li * XCD_BAR_WORDS, F.MISC + 8);
#ifndef PH_MASK
#define PH_MASK 0xFFF
#endif
#define IN(k) (((PH_MASK >> (k)) & 1) && lo <= (k) && (k) < hi)
#define SEAM(k) do { if (IN(k) && IN(NEXT_PH(k))) xcd_barrier(bar); } while (0)
#define NEXT_PH(k) ((k) == 2 ? 5 : (k) == 5 ? 7 : (k) + 1)
    const int cblk = (int)blockIdx.x;
    LAS unsigned char* ring = F.lds;

    if (IN(0)) { p0_prologue(F, I); SEAM(0); }

    if (IN(1)) {
        DenseOrder S; S.init(F.ws + WS_H, F.ws + WS_WIN, D, D, T, NIN, F.G, cblk);
        EpiInProj E{(bf16*)(F.ws + WS_AG), (bf16*)(F.ws + WS_XL), (bf16*)(F.ws + WS_GL), (bf16*)(F.ws + WS_GA), (bf16*)(F.ws + WS_GB)};
        pg8::gemm_phase<EpiInProj, DenseOrder, true>(ring, D, D, S, E);
        SEAM(1);
    }
    if (IN(2)) {
        if (cblk < 256) {
            const int L = cblk, wgid = (L % 8) * 32 + L / 8, g = wgid >> 3, mt = wgid & 7;
            { S5One S{(const char*)(F.ws + WS_AG) + S5Q * 2, (const char*)(F.ws + WS_BTW), (size_t)S5N * S5K * 2, (size_t)128 * 256 * 2, S5K, g, mt};
              EpiS5State E{(float*)(F.ws + WS_SLOC)};
              pg8::gemm_phase<EpiS5State, S5One, false>(ring, 256, 256, S, E); }
            if (F.wave == 0) { __builtin_amdgcn_fence(__ATOMIC_ACQUIRE, "agent"); VM_WAIT(); }
            __syncthreads();
            s5_chain(F, mt, g);
            VM_WAIT();
            __syncthreads();
            if (F.wave == 0) { __builtin_amdgcn_fence(__ATOMIC_ACQUIRE, "agent"); VM_WAIT(); }
            __syncthreads();
            { S5One S{(const char*)(F.ws + WS_AG), (const char*)(F.ws + WS_BTT), (size_t)S5N * S5K * 2, (size_t)256 * S5K * 2, S5K, g, mt};
              EpiS5Out E{(bf16*)(F.ws + WS_GY)};
              pg8::gemm_phase<EpiS5Out, S5One, false>(ring, S5K, S5K, S, E); }
            __syncthreads();
        }
        lru_seq(F, I);
        SEAM(2);
    }
    if (IN(5)) {
        YaYbOrder S; S.d.init(nullptr, nullptr, D, D, T, D, F.G, cblk);
        S.GYb = (const char*)(F.ws + WS_GY); S.WS5b = (const char*)(F.ws + WS_WS5); S.YLb = (const char*)(F.ws + WS_H); S.WLb = (const char*)(F.ws + WS_WLRU);
        EpiYaYb E{EpiYa{(const bf16*)(F.ws + WS_GA), (bf16*)(F.ws + WS_XL)}, EpiYb{(const bf16*)(F.ws + WS_XL), (const bf16*)(F.ws + WS_GB), (bf16*)(F.ws + WS_GL)}};
        pg8::gemm_phase<EpiYaYb, YaYbOrder, true>(ring, D, D, S, E);
        SEAM(5);
    }
    if (IN(7)) {
        DenseOrder S; S.init(F.ws + WS_GL, F.ws + WS_WO, D, D, T, D, F.G, cblk);
        EpiWo E{I.p[0], F.out};
        pg8::gemm_phase<EpiWo, DenseOrder, true>(ring, D, D, S, E);
        SEAM(7);
    }
    if (IN(8)) { p8_router(F, I); __syncthreads(); expert_weight_copies(F, I); SEAM(8); }
    if (IN(9)) {
        moe_setup<0>(F);
        MoeOrder<true> S{(const char*)(F.ws + WS_H2), (const char*)(F.ws + WS_WGU), (size_t)1024 * 1024 * 2, D, D, F.G, F.vcu, F.MISC, (const LAS int*)(F.lds + TOKL_OFF)};
        EpiGU E{(bf16*)(F.ws + WS_ACT), (const LAS float*)(F.lds + SCLL_OFF)};
        pg8::gemm_phase<EpiGU, MoeOrder<true>, true>(ring, D, D, S, E);
        SEAM(9);
    }
    if (IN(10)) {
        moe_setup<1>(F);
        MoeOrder<false> S{(const char*)(F.ws + WS_ACT), (const char*)(F.ws + WS_WD), (size_t)1024 * DEXP * 2, DEXP, DEXP, F.G, F.vcu, F.MISC, (const LAS int*)(F.lds + TOKL_OFF)};
        EpiDown8 E{(unsigned char*)(F.ws + WS_YS), (float*)(F.ws + WS_YS + 80 * MiB), (const LAS float*)(F.lds + SCLL_OFF)};
        pg8::gemm_phase<EpiDown8, MoeOrder<false>, true>(ring, DEXP, DEXP, S, E);
        SEAM(10);
    }
    if (IN(11)) { p11_final(F, I, args.fin_dst); }
#undef IN
#undef SEAM
}

extern "C" void kernel_launch(void* const* d_in, const int* in_sizes, int n_in, void* d_out, int out_size, void* d_ws, size_t ws_size, hipStream_t stream) {
    static int grid = 0;
    if (grid == 0) {
        if (n_in != 30 || in_sizes[0] != T * D || out_size != T * D || ws_size < WS_END) { fprintf(stderr, "kernel_launch: unexpected shapes / workspace (n_in %d, ws %zu)\n", n_in, ws_size); grid = -1; return; }
        int dev = 0, cus = 0, per_cu = 0;
        if (hipGetDevice(&dev) != hipSuccess || hipDeviceGetAttribute(&cus, hipDeviceAttributeMultiprocessorCount, dev) != hipSuccess) { grid = -1; return; }
        if (hipFuncSetAttribute((const void*)mk_fwd, hipFuncAttributeMaxDynamicSharedMemorySize, LDS_BYTES) != hipSuccess) { fprintf(stderr, "kernel_launch: hipFuncSetAttribute failed\n"); grid = -1; return; }
        if (hipOccupancyMaxActiveBlocksPerMultiprocessor(&per_cu, (const void*)mk_fwd, NWAVES * 64, LDS_BYTES) != hipSuccess || per_cu < 1) { fprintf(stderr, "kernel_launch: occupancy query says %d\n", per_cu); }
        (void)hipGetLastError();
        grid = cus;
    }
    if (grid < 0) return;
    if (hipMemsetAsync((char*)d_ws + WS_CTL, 0, CTL_ZERO_BYTES, stream) != hipSuccess) return;
    Args a{};
    for (int i = 0; i < 30; ++i) a.in.p[i] = (const float*)d_in[i];
    a.out = (float*)d_out; a.ws = (unsigned char*)d_ws; a.fin_dst = (float*)d_out;
#if defined(PROBE_LO)
    a.ph_lo = 0; a.ph_hi = PROBE_HI; a.li = 0;
#if PROBE_LO == 11
    a.fin_dst = (float*)((char*)d_ws + WS_H2);
#endif
    hipLaunchKernelGGL(mk_fwd, dim3(grid), dim3(NWAVES * 64), LDS_BYTES, stream, a);
#if PROBE_LO == 8
    hipMemsetAsync((char*)d_ws + WS_CTL + CW_CNT * 4, 0, 128, stream);
#endif
    a.fin_dst = (float*)d_out;
    a.ph_lo = PROBE_LO; a.ph_hi = N_PHASES; a.li = 1;
    hipLaunchKernelGGL(mk_fwd, dim3(grid), dim3(NWAVES * 64), LDS_BYTES, stream, a);
#elif MK_N_LAUNCHES == 1
    a.ph_lo = 0; a.ph_hi = N_PHASES;
    hipLaunchKernelGGL(mk_fwd, dim3(grid), dim3(NWAVES * 64), LDS_BYTES, stream, a);
#else
    for (int p = 0; p < N_PHASES; ++p) { a.ph_lo = p; a.ph_hi = p + 1; hipLaunchKernelGGL(mk_fwd, dim3(grid), dim3(NWAVES * 64), LDS_BYTES, stream, a); }
#endif
}
```

```cpp
#include <hip/hip_runtime.h>
#include <cstdio>
#include <cstdint>

#ifndef MK_N_LAUNCHES
#define MK_N_LAUNCHES 1
#endif

namespace pg8 {
#define PG8_LAS __attribute__((address_space(3)))
typedef unsigned short bf16_t;
typedef short bf16x8 __attribute__((ext_vector_type(8)));
typedef float f32x4 __attribute__((ext_vector_type(4)));
typedef unsigned u32x4 __attribute__((ext_vector_type(4)));
constexpr int BM = 256, BK = 64, HALF = 128, HTB = HALF * BK * 2  , STAGE_BYTES = 8 * HTB, NXCD = 8, WGM = 8;

__host__ __device__ __forceinline__ int lds_byte(int r, int c) { const int st = (r >> 4) * 2 + (c >> 5), rr = r & 15, cc = c & 31, ob = rr * 64 + cc * 2; return st * 1024 + (ob ^ (((ob >> 9) & 1) << 5)); }
__host__ __device__ __forceinline__ void stage_rc(int b, int& R, int& C) { const int st = b / 1024, sb = b % 1024, swz = sb ^ (((sb >> 9) & 1) << 5); R = (st >> 1) * 16 + swz / 64; C = (st & 1) * 32 + (swz % 64) / 2; }
__host__ __device__ __forceinline__ int perm32(int rho) { const int n = rho >> 4, i = rho & 15; return 8 * (i >> 2) + 4 * n + (i & 3); }

struct Unit { const char* A; const char* B; int pm, pn, aux, nt, kind; unsigned kA; };

__device__ __forceinline__ unsigned cvt_pk_bf16(float lo, float hi) { unsigned r; asm volatile("v_cvt_pk_bf16_f32 %0, %1, %2" : "=v"(r) : "v"(lo), "v"(hi)); return r; }

template <class Epi, class Sched, bool ALIGN_EPI>
__device__ __forceinline__ void gemm_phase(PG8_LAS unsigned char* lds, const int ldb, const int K, const Sched& S, const Epi& E, const size_t kstepA = (size_t)(BK * 2)) {
    const int tid = threadIdx.x, wid = __builtin_amdgcn_readfirstlane(tid >> 6), lane = tid & 63, wr = wid >> 2, wc = wid & 3, fr = lane & 15, fq = lane >> 4;
    int nt = K / BK; asm volatile("" : "+s"(nt));
    int Rr[2], Cc[2], Rbb[2]; unsigned voffB[4], vAc[4], vAn[4];
#pragma unroll
    for (int i = 0; i < 2; ++i) { int R, C; stage_rc(tid * 16 + i * 8192, R, C); Rr[i] = R; Cc[i] = C; const int Rb = Epi::PERM ? ((R & ~31) + perm32(R & 31)) : R; Rbb[i] = Rb;
        int Rb0 = Rb, Rb1 = HALF + Rb;
        if constexpr (Epi::B16) {
            const int w_ = R >> 5, nn_ = (R >> 4) & 1, ii_ = R & 15; Rb0 = 64 * w_ + 16 * (ii_ >> 2) + 4 * nn_ + (ii_ & 3); Rb1 = Rb0 + 8; }
        voffB[i] = (unsigned)(Rb0 * ldb + C) * 2u; voffB[2 + i] = (unsigned)(Rb1 * ldb + C) * 2u; }
    const size_t kstep = (size_t)(BK * 2);
    const unsigned ldsw = (unsigned)wid * 1024u;
    const int aoff = lds_byte(wr * 64 + fr, fq * 8), boff = lds_byte(wc * 32 + fr, fq * 8);
#define PG8_SA(b, h) (((b) * 2 + (h)) * HTB)
#define PG8_SB(b, h) ((4 + (b) * 2 + (h)) * HTB)
#define PG8_STAGE(bufoff, gbase, voff, h) do { _Pragma("unroll") for (int _i = 0; _i < 2; ++_i) \
        __builtin_amdgcn_global_load_lds((const unsigned*)((const char*)(gbase) + (voff)[2 * (h) + _i]), (PG8_LAS unsigned*)(lds + (bufoff) + ldsw + _i * 8192), 16, 0, 0); } while (0)
#define PG8_LDA(dst, b, h) do { _Pragma("unroll") for (int m = 0; m < 4; ++m) _Pragma("unroll") for (int k = 0; k < 2; ++k) dst[m][k] = *(const PG8_LAS bf16x8*)(lds + PG8_SA(b, h) + aoff + m * 2048 + k * 1024); } while (0)
#define PG8_LDB(dst, b, h) do { _Pragma("unroll") for (int n = 0; n < 2; ++n) _Pragma("unroll") for (int k = 0; k < 2; ++k) dst[n][k] = *(const PG8_LAS bf16x8*)(lds + PG8_SB(b, h) + boff + n * 2048 + k * 1024); } while (0)
#define PG8_MMA(ai, bj, At, Bt) do { __builtin_amdgcn_s_setprio(1); _Pragma("unroll") for (int m = 0; m < 4; ++m) _Pragma("unroll") for (int n = 0; n < 2; ++n) _Pragma("unroll") for (int k = 0; k < 2; ++k) \
        acc[ai][bj][m][n] = __builtin_amdgcn_mfma_f32_16x16x32_bf16(Bt[n][k], At[m][k], acc[ai][bj][m][n], 0, 0, 0); __builtin_amdgcn_s_setprio(0); } while (0)
#define PG8_WAIT_V(n) asm volatile("s_waitcnt vmcnt(" #n ")" ::: "memory")
#define PG8_WAIT_L(n) asm volatile("s_waitcnt lgkmcnt(" #n ")" ::: "memory")
#define PG8_BAR __builtin_amdgcn_s_barrier()
#define PG8_SCHED __builtin_amdgcn_sched_barrier(0)
    Unit cur, nxt; int ui = 0;
    if (!S.next(0, cur)) return;
    S.a_offsets(cur, Rr, Cc, vAc);
    unsigned vBc[4], vBn[4];
    if constexpr (Sched::HETERO) { S.b_offsets(cur, Rbb, Cc, vBc); nt = __builtin_amdgcn_readfirstlane(cur.nt); }
    else {
#pragma unroll
        for (int q = 0; q < 4; ++q) vBc[q] = voffB[q]; }
    size_t kAc = Sched::HETERO ? (size_t)(unsigned)__builtin_amdgcn_readfirstlane((int)cur.kA) : kstepA;
    f32x4 acc[2][2][4][2];
    if constexpr (Epi::ACC_INIT) E.init(acc, cur, wr, wc, fr, fq);
    else {
#pragma unroll
    for (int a = 0; a < 2; ++a)
#pragma unroll
        for (int b = 0; b < 2; ++b)
#pragma unroll
            for (int m = 0; m < 4; ++m)
#pragma unroll
                for (int n = 0; n < 2; ++n) acc[a][b][m][n] = (f32x4){0.f, 0.f, 0.f, 0.f}; }
    bf16x8 At[4][2], B0[2][2], B1[2][2];
    const char* cA = cur.A; const char* cB = cur.B;
    if constexpr (Sched::GATHER) { PG8_WAIT_L(0); }
    PG8_STAGE(PG8_SB(0, 0), cB, vBc, 0); PG8_STAGE(PG8_SB(0, 1), cB, vBc, 1); PG8_STAGE(PG8_SA(0, 0), cA, vAc, 0); PG8_STAGE(PG8_SA(0, 1), cA, vAc, 1);
    if (wr == 1) PG8_BAR;
    PG8_WAIT_V(2); PG8_BAR;
    PG8_STAGE(PG8_SB(1, 0), cB + kstep, vBc, 0); PG8_STAGE(PG8_SA(1, 0), cA + kAc, vAc, 0); PG8_STAGE(PG8_SB(1, 1), cB + kstep, vBc, 1);
    PG8_WAIT_V(6); PG8_BAR;
    for (;;) {
        const bool has_next = S.next(ui + 1, nxt);
        const char* nA = has_next ? nxt.A : cA; const char* nB = has_next ? nxt.B : cB;
        size_t kAn = kAc;
        if constexpr (Sched::HETERO) { if (has_next) { S.b_offsets(nxt, Rbb, Cc, vBn); kAn = (size_t)(unsigned)__builtin_amdgcn_readfirstlane((int)nxt.kA); } else {
#pragma unroll
                for (int q = 0; q < 4; ++q) vBn[q] = vBc[q]; } }
        for (int t = 0; t < nt; t += 2) {
            const bool last = (t == nt - 2);
            const char* a1 = cA + (size_t)(t + 1) * kAc;
            const char* a2 = last ? nA : cA + (size_t)(t + 2) * kAc; const char* b2 = last ? nB : cB + (size_t)(t + 2) * kstep;
            const char* a3 = a2 + (last ? kAn : kAc); const char* b3 = b2 + kstep;
            unsigned vb2[4];
#pragma unroll
            for (int q = 0; q < 4; ++q) vb2[q] = (Sched::HETERO && last) ? vBn[q] : vBc[q];
            unsigned va2[4];
            if constexpr (Sched::GATHER || Sched::HETERO) {
                if (last) { if (has_next) { S.a_offsets(nxt, Rr, Cc, vAn); if constexpr (Sched::GATHER) { PG8_WAIT_L(0); } } else {
#pragma unroll
                        for (int q = 0; q < 4; ++q) vAn[q] = vAc[q]; } }
#pragma unroll
                for (int q = 0; q < 4; ++q) va2[q] = last ? vAn[q] : vAc[q];
            } else {
#pragma unroll
                for (int q = 0; q < 4; ++q) va2[q] = vAc[q];
            }
            PG8_LDB(B0, 0, 0); PG8_LDB(B1, 0, 1); PG8_SCHED; PG8_LDA(At, 0, 0); PG8_STAGE(PG8_SA(1, 1), a1, vAc, 1);
            PG8_WAIT_V(8); PG8_WAIT_L(0); PG8_BAR; PG8_MMA(0, 0, At, B0); PG8_MMA(0, 1, At, B1); PG8_BAR; PG8_SCHED;
            const bool fin = last && !has_next;
            PG8_LDA(At, 0, 1);
            if (!fin) { PG8_STAGE(PG8_SB(0, 0), b2, vb2, 0); PG8_STAGE(PG8_SB(0, 1), b2, vb2, 1); PG8_STAGE(PG8_SA(0, 0), a2, va2, 0); PG8_WAIT_V(8); } else { PG8_WAIT_V(0); }
            PG8_WAIT_L(0); PG8_BAR; PG8_MMA(1, 0, At, B0); PG8_MMA(1, 1, At, B1); PG8_BAR; PG8_SCHED;
            PG8_LDB(B0, 1, 0); PG8_LDB(B1, 1, 1); PG8_SCHED; PG8_LDA(At, 1, 0);
            if (!fin) { PG8_STAGE(PG8_SA(0, 1), a2, va2, 1); PG8_WAIT_V(8); } else { PG8_WAIT_V(0); }
            PG8_WAIT_L(0); PG8_BAR; PG8_MMA(0, 0, At, B0); PG8_MMA(0, 1, At, B1); PG8_BAR; PG8_SCHED;
            PG8_LDA(At, 1, 1);
            if (!fin) { PG8_STAGE(PG8_SB(1, 0), b3, vb2, 0); PG8_STAGE(PG8_SB(1, 1), b3, vb2, 1); PG8_STAGE(PG8_SA(1, 0), a3, va2, 0); PG8_WAIT_V(8); } else { PG8_WAIT_V(0); }
            PG8_WAIT_L(0); PG8_BAR; PG8_MMA(1, 0, At, B0); PG8_MMA(1, 1, At, B1); PG8_BAR; PG8_SCHED;
        }
        if constexpr (ALIGN_EPI) { if (wr == 0) PG8_BAR; }
        E(acc, cur, wr, wc, fr, fq);
        if (!has_next) break;
        if constexpr (Epi::ACC_INIT) E.init(acc, nxt, wr, wc, fr, fq);
        else {
#pragma unroll
        for (int a = 0; a < 2; ++a)
#pragma unroll
            for (int b = 0; b < 2; ++b)
#pragma unroll
                for (int m = 0; m < 4; ++m)
#pragma unroll
                    for (int n = 0; n < 2; ++n) acc[a][b][m][n] = (f32x4){0.f, 0.f, 0.f, 0.f}; }
        cur = nxt; cA = nA; cB = nB; ++ui;
        if constexpr (Sched::GATHER || Sched::HETERO) {
#pragma unroll
            for (int q = 0; q < 4; ++q) vAc[q] = vAn[q]; }
        if constexpr (Sched::HETERO) {
#pragma unroll
            for (int q = 0; q < 4; ++q) vBc[q] = vBn[q];
            kAc = kAn; nt = __builtin_amdgcn_readfirstlane(cur.nt); }
        if constexpr (ALIGN_EPI) { if (wr == 1) PG8_BAR; }
    }
    PG8_WAIT_V(0);
    if constexpr (!ALIGN_EPI) { if (wr == 0) PG8_BAR; }
    PG8_BAR;
#undef PG8_SA
#undef PG8_SB
#undef PG8_STAGE
#undef PG8_LDA
#undef PG8_LDB
#undef PG8_MMA
#undef PG8_WAIT_V
#undef PG8_WAIT_L
#undef PG8_BAR
#undef PG8_SCHED
}
}

constexpr int NWAVES = 8;
constexpr int BATCH = 8, SEQ = 4096, D = 1024, T = BATCH * SEQ;
constexpr int S5W = 512, S5G = 32, S5C = 16, S5P = 64, S5Q = 128;
constexpr int S5LC = 16, S5NCH = SEQ / S5LC, S5N = BATCH * S5NCH;
constexpr int S5K = S5Q + S5LC * S5C;
constexpr int LRUW = 1024, LRUH = 16, LRUHD = 64, LRUCH = 64, LRUNCH = SEQ / LRUCH;
constexpr int NIN = S5W + 2 * LRUW + 2 * D;
constexpr int NEXP = 32, EPG = 8, NGRP = 4, DEXP = 512, NROUT = 48;
constexpr int MAXSLOT = 73728;
constexpr int MAXU = 8;
constexpr float RMS_EPS = 1e-6f;

constexpr size_t MiB = 1u << 20;
constexpr size_t WS_CTL = 0, CTL_ZERO_BYTES = 128 * 1024;
constexpr size_t WS_SMALL = 1 * MiB;
constexpr size_t SM_LAM16 = WS_SMALL + 0;
constexpr size_t SM_LRUC = WS_SMALL + 16384;
constexpr size_t SM_WRT = WS_SMALL + 32768;
constexpr size_t SM_RHI = WS_SMALL + 327680;
constexpr size_t SM_RLO = SM_RHI + 98304;
constexpr size_t SM_RSTD = WS_SMALL + 524288;
constexpr size_t WS_BTT = 2 * MiB;
constexpr size_t WS_BTW = 8 * MiB;
constexpr size_t WS_WIN = 11 * MiB;
constexpr size_t WS_WS5 = 20 * MiB;
constexpr size_t WS_WLRU = 22 * MiB;
constexpr size_t WS_WO = 24 * MiB;
constexpr size_t WS_LP = 26 * MiB, WS_LH = 28 * MiB, WS_LHIN = 30 * MiB;
constexpr size_t WS_AG = 32 * MiB;
constexpr size_t WS_SLOC = 80 * MiB;
constexpr size_t WS_H = 112 * MiB;
constexpr size_t WS_XL = 176 * MiB;
constexpr size_t WS_GL = 240 * MiB;
constexpr size_t WS_GA = 304 * MiB, WS_GB = 336 * MiB;
constexpr size_t WS_GY = 368 * MiB;
constexpr size_t WS_D8 = 336 * MiB, WS_DSC = 368 * MiB;
constexpr size_t WS_WGU = 400 * MiB;
constexpr size_t WS_WD = 464 * MiB;
constexpr size_t WS_H2 = 32 * MiB;
constexpr size_t WS_ACT = 96 * MiB;
constexpr size_t WS_YS = 168 * MiB;
constexpr size_t WS_LTOK = 312 * MiB, WS_LW = 316 * MiB;
constexpr size_t WS_TOKE = 320 * MiB, WS_TOKR = WS_TOKE + 262144;
constexpr size_t WS_END = 496 * MiB;
static_assert(WS_YS + (size_t)MAXSLOT * 1024 * 2 <= WS_LTOK && WS_ACT + (size_t)MAXSLOT * 512 * 2 <= WS_YS && WS_TOKR + 262144 <= WS_WGU && WS_GY + (size_t)T * 512 * 2 <= WS_WGU && WS_WD + (size_t)32 * 1024 * 512 * 2 <= WS_END, "d_ws map");
constexpr int CW_BAR = 4096;
constexpr int CW_CNT = 16384;

constexpr int RING_BYTES = 131072;
constexpr int TOKL_OFF = RING_BYTES, SCLL_OFF = TOKL_OFF + MAXU * 256 * 4, MISC_OFF = SCLL_OFF + MAXU * 256 * 4;
constexpr int LDS_BYTES = MISC_OFF + 1024;

#define GAS __attribute__((address_space(1)))
#define LAS __attribute__((address_space(3)))
typedef unsigned short bf16;
typedef unsigned v4u __attribute__((ext_vector_type(4)));
typedef unsigned v2u __attribute__((ext_vector_type(2)));
typedef float f32x4 __attribute__((ext_vector_type(4)));
typedef short bf16x8 __attribute__((ext_vector_type(8)));
#define LDS_WAIT() asm volatile("s_waitcnt lgkmcnt(0)" ::: "memory")
#define VM_WAIT() asm volatile("s_waitcnt vmcnt(0)" ::: "memory")
__device__ __forceinline__ unsigned f2bf(float f) { unsigned u = __builtin_bit_cast(unsigned, f); return (u + 0x7fffu + ((u >> 16) & 1u)) >> 16; }
__device__ __forceinline__ float bf2f(unsigned h) { return __builtin_bit_cast(float, h << 16); }
__device__ __forceinline__ unsigned pk2(float lo, float hi) { return f2bf(lo) | (f2bf(hi) << 16); }
__device__ __forceinline__ float bflo(unsigned w) { return __builtin_bit_cast(float, w << 16); }
__device__ __forceinline__ float bfhi(unsigned w) { return __builtin_bit_cast(float, w & 0xffff0000u); }
__device__ __forceinline__ float fsigmoid(float x) { return __builtin_amdgcn_rcpf(1.0f + __builtin_amdgcn_exp2f(-1.44269504f * x)); }
__device__ __forceinline__ float gelu_t(float x) { const float u = x * (0.7978845608f + 0.0356774081f * x * x); return x * __builtin_amdgcn_rcpf(1.0f + __builtin_amdgcn_exp2f(-2.88539008f * u)); }
__device__ __forceinline__ float wave_sum(float v) {
#pragma unroll
    for (int o = 1; o < 64; o <<= 1) v += __shfl_xor(v, o);
    return v;
}

#define XB_TMO      128
#define XB_XCNT(j)  (256  + 64 * (j))
#define XB_XSUB(j)  (1280 + 64 * (j))
#define XB_XGEN(j)  (2304 + 64 * (j))
#define XB_TOP      3328
#define XB_TOPGEN   3392
#define XCD_BAR_WORDS 3456
#define XB_SPIN_CAP (1u << 18)
__device__ __forceinline__ unsigned xb_ld(unsigned* p)              { return __hip_atomic_load(p, __ATOMIC_RELAXED, __HIP_MEMORY_SCOPE_AGENT); }
__device__ __forceinline__ unsigned xb_add(unsigned* p, unsigned v) { return __hip_atomic_fetch_add(p, v, __ATOMIC_RELAXED, __HIP_MEMORY_SCOPE_AGENT); }
__device__ __forceinline__ unsigned xb_xcc_id() { return (unsigned)__builtin_amdgcn_s_getreg((3 << 11) | 20) & 0xFu; }
#define XB_SPIN(cond, bar) do { unsigned _sp = 0; while (cond) { __builtin_amdgcn_s_sleep(1); \
    if ((++_sp & 255u) == 0u) { if (xb_ld(&(bar)[XB_TMO])) break; if (_sp > XB_SPIN_CAP) { atomicAdd(&(bar)[XB_TMO], 1u); break; } } } } while (0)
struct XcdBarrier { unsigned* bar; unsigned x; volatile LAS unsigned* st; };
__device__ __forceinline__ XcdBarrier xcd_barrier_post(unsigned* bar, volatile LAS unsigned* st) {
    XcdBarrier b; b.bar = bar; b.x = xb_xcc_id(); b.st = st;
    if (threadIdx.x == 0) (void)xb_add(&bar[XB_XCNT(b.x)], 1u);
    return b;
}
__device__ __forceinline__ void xcd_barrier_complete(unsigned* bar, unsigned x, unsigned& nloc, unsigned& nx) {
    const unsigned G = gridDim.x * gridDim.y * gridDim.z;
    unsigned sum, cnt, mine, sp = 0u;
    for (;;) {
        sum = 0u; cnt = 0u; mine = 0u;
#pragma unroll
        for (unsigned j = 0; j < 16; ++j) { const unsigned c = xb_ld(&bar[XB_XCNT(j)]); sum += c; cnt += (c > 0u) ? 1u : 0u; mine = (j == x) ? c : mine; }
        if (sum == G) break;
        __builtin_amdgcn_s_sleep(1);
        if ((++sp & 255u) == 0u) { if (xb_ld(&bar[XB_TMO])) break; if (sp > XB_SPIN_CAP) { atomicAdd(&bar[XB_TMO], 1u); break; } }
    }
    nloc = mine > 0u ? mine : 1u; nx = cnt > 0u ? cnt : 1u;
}
__device__ __forceinline__ void xcd_barrier(const XcdBarrier& b) {
    asm volatile("s_waitcnt vmcnt(0)" ::: "memory");
    __syncthreads();
    if (threadIdx.x == 0) {
        unsigned* bar = b.bar;
        __builtin_amdgcn_s_waitcnt(0);
        unsigned nloc = b.st[0], nx = b.st[1];
        if (nloc == 0u) { xcd_barrier_complete(bar, b.x, nloc, nx); b.st[0] = nloc; b.st[1] = nx; }
        const unsigned old = xb_add(&bar[XB_XSUB(b.x)], 1u);
        const unsigned gen = old / nloc;
        if (old + 1u == (gen + 1u) * nloc) {
            __builtin_amdgcn_fence(__ATOMIC_RELEASE, "agent");
            asm volatile("s_waitcnt vmcnt(0)" ::: "memory");
            const unsigned og = xb_add(&bar[XB_TOP], 1u);
            const unsigned tg = og / nx;
            if (og + 1u == (tg + 1u) * nx) xb_add(&bar[XB_TOPGEN], 1u);
            else XB_SPIN(xb_ld(&bar[XB_TOPGEN]) == tg, bar);
            __builtin_amdgcn_fence(__ATOMIC_ACQUIRE, "agent");
            xb_add(&bar[XB_XGEN(b.x)], 1u);
            asm volatile("s_waitcnt vmcnt(0)" ::: "memory");
        } else {
            XB_SPIN(xb_ld(&bar[XB_XGEN(b.x)]) == gen, bar);
            __builtin_amdgcn_fence(__ATOMIC_ACQUIRE, "agent");
            asm volatile("s_waitcnt vmcnt(0)" ::: "memory");
        }
    }
    __syncthreads();
}

struct Frame {
    LAS unsigned char* lds;
    volatile LAS unsigned* MISC;
    unsigned* ctl;
    int tid, lane, wave, vcu, G;
    const float* const* in;
    unsigned char* ws; float* out;
};

using pg8::Unit;
struct DenseOrder {
    static constexpr bool GATHER = false, HETERO = false;
    const char* A0; const char* B0; int lda, ldb, nM, nN, nwg, G, c;
    __device__ __forceinline__ void init(const void* A, const void* B, int lda_, int ldb_, int M, int N, int G_, int c_) { A0 = (const char*)A; B0 = (const char*)B; lda = lda_; ldb = ldb_; nM = M / 256; nN = N / 256; nwg = nM * nN; G = G_; c = c_; }
    __device__ __forceinline__ bool next(int i, Unit& u) const {
        const long L = (long)i * G + c; if (L >= nwg) return false;
        int wgid = (int)L; { const int q = nwg / 8, r = nwg % 8, xcd = wgid % 8, off = wgid / 8; wgid = (xcd < r ? xcd * (q + 1) : r * (q + 1) + (xcd - r) * q) + off; }
        const int nig = 8 * nN, gid = wgid / nig, fm = gid * 8, gsz = (nM - fm) < 8 ? (nM - fm) : 8;
        u.pm = fm + ((wgid % nig) % gsz); u.pn = (wgid % nig) / gsz; u.aux = 0;
        u.A = A0 + (size_t)u.pm * 256 * lda * 2; u.B = B0 + (size_t)u.pn * 256 * ldb * 2; return true;
    }
    __device__ __forceinline__ void a_offsets(const Unit&, const int (&R)[2], const int (&C)[2], unsigned (&v)[4]) const {
#pragma unroll
        for (int i = 0; i < 2; ++i) { v[i] = (unsigned)(R[i] * lda + C[i]) * 2u; v[2 + i] = (unsigned)((128 + R[i]) * lda + C[i]) * 2u; }
    }
};
struct S5One {
    static constexpr bool GATHER = false, HETERO = false;
    const char* A0; const char* B0; size_t sA, sB; int lda, g, mt;
    __device__ __forceinline__ bool next(int i, Unit& u) const {
        if (i > 0) return false;
        u.pm = mt; u.pn = 0; u.aux = g; u.A = A0 + (size_t)g * sA + (size_t)mt * 256 * lda * 2; u.B = B0 + (size_t)g * sB; return true;
    }
    __device__ __forceinline__ void a_offsets(const Unit&, const int (&R)[2], const int (&C)[2], unsigned (&v)[4]) const {
#pragma unroll
        for (int i = 0; i < 2; ++i) { v[i] = (unsigned)(R[i] * lda + C[i]) * 2u; v[2 + i] = (unsigned)((128 + R[i]) * lda + C[i]) * 2u; }
    }
};
struct GyOrder {
    static constexpr bool GATHER = false, HETERO = false;
    DenseOrder d;
    __device__ __forceinline__ bool next(int i, Unit& u) const { if (!d.next(i, u)) return false; u.A = d.A0 + (size_t)u.pm * 256 * 32; return true; }
    __device__ __forceinline__ void a_offsets(const Unit&, const int (&R)[2], const int (&C)[2], unsigned (&v)[4]) const {
#pragma unroll
        for (int i = 0; i < 2; ++i) { const unsigned o = (unsigned)(C[i] >> 4) * (unsigned)(T * 32) + (unsigned)(C[i] & 15) * 2u; v[i] = (unsigned)R[i] * 32u + o; v[2 + i] = (unsigned)(128 + R[i]) * 32u + o; }
    }
};
struct YaYbOrder {
    static constexpr bool GATHER = false, HETERO = true;
    DenseOrder d;
    const char* GYb; const char* WS5b; const char* YLb; const char* WLb;
    __device__ __forceinline__ bool next(int i, Unit& u) const {
        const int j = i / 3, r = i - 3 * j; Unit t;
        if (!d.next(j, t)) return false;
        u.pm = t.pm; u.aux = 0;
        if (r < 2) { u.kind = 0; u.pn = 2 * t.pn + r; u.nt = S5W / 64; u.kA = (unsigned)(4 * T * 32); u.A = GYb + (size_t)t.pm * 256 * 32; u.B = WS5b + (size_t)u.pn * 256 * S5W * 2; }
        else { u.kind = 1; u.pn = t.pn; u.nt = D / 64; u.kA = 128u; u.A = YLb + (size_t)t.pm * 256 * D * 2; u.B = WLb + (size_t)t.pn * 256 * D * 2; }
        return true;
    }
    __device__ __forceinline__ void a_offsets(const Unit& u, const int (&R)[2], const int (&C)[2], unsigned (&v)[4]) const {
#pragma unroll
        for (int i = 0; i < 2; ++i) {
            const unsigned og = (unsigned)(C[i] >> 4) * (unsigned)(T * 32) + (unsigned)(C[i] & 15) * 2u;
            const unsigned g0 = (unsigned)R[i] * 32u + og, g1 = (unsigned)(128 + R[i]) * 32u + og;
            const unsigned d0 = (unsigned)(R[i] * D + C[i]) * 2u, d1 = (unsigned)((128 + R[i]) * D + C[i]) * 2u;
            v[i] = u.kind ? d0 : g0; v[2 + i] = u.kind ? d1 : g1; }
    }
    __device__ __forceinline__ void b_offsets(const Unit& u, const int (&Rb)[2], const int (&C)[2], unsigned (&v)[4]) const {
        const int ldb = u.kind ? D : S5W;
#pragma unroll
        for (int i = 0; i < 2; ++i) { v[i] = (unsigned)(Rb[i] * ldb + C[i]) * 2u; v[2 + i] = (unsigned)((128 + Rb[i]) * ldb + C[i]) * 2u; }
    }
};
template <bool GATH> struct MoeOrder {
    static constexpr bool GATHER = GATH, HETERO = false;
    const char* A0; const char* B0; size_t sBe; int lda, ldb, G, c; volatile LAS unsigned* MISC; const LAS int* tokL;
    __device__ __forceinline__ bool next(int i, Unit& u) const {
        if (i >= (int)MISC[152]) return false;
        const int e = (int)MISC[136 + i], mtg = (int)MISC[96 + e] + (int)MISC[144 + i], L = i * G + c;
        u.pm = mtg; u.pn = L & 3; u.aux = i;
        u.A = GATH ? A0 : A0 + (size_t)mtg * 256 * lda * 2; u.B = B0 + (size_t)e * sBe + (size_t)u.pn * 256 * ldb * 2; return true;
    }
    __device__ __forceinline__ void a_offsets(const Unit& u, const int (&R)[2], const int (&C)[2], unsigned (&v)[4]) const {
#pragma unroll
        for (int i = 0; i < 2; ++i) {
            if constexpr (GATH) { v[i] = (unsigned)tokL[u.aux * 256 + R[i]] * (unsigned)(lda * 2) + (unsigned)C[i] * 2u; v[2 + i] = (unsigned)tokL[u.aux * 256 + 128 + R[i]] * (unsigned)(lda * 2) + (unsigned)C[i] * 2u; }
            else { v[i] = (unsigned)(R[i] * lda + C[i]) * 2u; v[2 + i] = (unsigned)((128 + R[i]) * lda + C[i]) * 2u; } }
    }
};

using pg8::cvt_pk_bf16;
template <int ACT> __device__ __forceinline__ float actf(float x) { if (ACT == 1) return gelu_t(x); if (ACT == 2) return fsigmoid(x); return x; }
__device__ __forceinline__ v4u pack8(const f32x4 a, const f32x4 b) { v4u w; w.x = cvt_pk_bf16(a[0], a[1]); w.y = cvt_pk_bf16(a[2], a[3]); w.z = cvt_pk_bf16(b[0], b[1]); w.w = cvt_pk_bf16(b[2], b[3]); return w; }

__device__ __forceinline__ void unpack_u8x8(const v2u w, float (&f)[8]) {
    const float k = 1.0f / 255.0f;
    f[0] = (float)(w.x & 0xffu) * k; f[1] = (float)((w.x >> 8) & 0xffu) * k; f[2] = (float)((w.x >> 16) & 0xffu) * k; f[3] = (float)(w.x >> 24) * k;
    f[4] = (float)(w.y & 0xffu) * k; f[5] = (float)((w.y >> 8) & 0xffu) * k; f[6] = (float)((w.y >> 16) & 0xffu) * k; f[7] = (float)(w.y >> 24) * k;
}
struct EpiInProj {
    static constexpr bool PERM = true, ACC_INIT = false, B16 = false;
    bf16 *AG, *XL, *GL, *GA, *GB;
    template <int MODE  > __device__ __forceinline__ void tile(const f32x4 (&acc)[2][2][4][2], const Unit& u, bf16* base, int colbase, bool s5, int wr, int wc, int fr, int fq) const {
#pragma unroll
        for (int ai = 0; ai < 2; ++ai)
#pragma unroll
            for (int m = 0; m < 4; ++m) { const int r = u.pm * 256 + ai * 128 + wr * 64 + m * 16 + fr;
#pragma unroll
                for (int bj = 0; bj < 2; ++bj) { const int cl = colbase + bj * 128 + wc * 32 + 8 * fq;
                    f32x4 v0 = acc[ai][bj][m][0], v1 = acc[ai][bj][m][1];
                    if (MODE == 2) {
                        unsigned q[8];
#pragma unroll
                        for (int j = 0; j < 4; ++j) { q[j] = (unsigned)(fsigmoid(v0[j]) * 255.0f + 0.5f); q[4 + j] = (unsigned)(fsigmoid(v1[j]) * 255.0f + 0.5f); }
                        v2u w8; w8.x = q[0] | (q[1] << 8) | (q[2] << 16) | (q[3] << 24); w8.y = q[4] | (q[5] << 8) | (q[6] << 16) | (q[7] << 24);
                        __builtin_nontemporal_store(w8, (v2u*)((unsigned char*)base + (size_t)r * 1024 + cl));
                    } else {
                        if (MODE == 1) {
#pragma unroll
                            for (int j = 0; j < 4; ++j) { v0[j] = gelu_t(v0[j]); v1[j] = gelu_t(v1[j]); } }
                        const v4u w = pack8(v0, v1);
                        const int g = cl >> 4, cp = cl & 15, b = r >> 12, l = r & 4095, n = b * S5NCH + (l >> 4), s = l & 15;
                        const size_t off = s5 ? ((size_t)(g * S5N + n) * S5K + S5Q + s * 16 + cp) : ((size_t)r * 1024 + cl);
                        __builtin_nontemporal_store(w, (v4u*)(base + off)); } }
                asm volatile("" ::: "memory"); }
    }
    __device__ __forceinline__ void operator()(const f32x4 (&acc)[2][2][4][2], const Unit& u, int wr, int wc, int fr, int fq) const {
        const int pn = u.pn, reg = pn < 2 ? 0 : ((pn - 2) >> 2) + 1;
        const int colbase = reg == 0 ? pn * 256 : ((pn - 2) & 3) * 256;
        if (reg < 2) tile<0>(acc, u, reg == 0 ? AG : XL, colbase, reg == 0, wr, wc, fr, fq);
        else if (reg == 2) tile<1>(acc, u, GL, colbase, false, wr, wc, fr, fq);
        else tile<2>(acc, u, reg == 3 ? GA : GB, colbase, false, wr, wc, fr, fq);
    }
};
struct EpiS5State {
    static constexpr bool PERM = false, ACC_INIT = false, B16 = false;
    float* SLOC;
    __device__ __forceinline__ void operator()(const f32x4 (&acc)[2][2][4][2], const Unit& u, int wr, int wc, int fr, int fq) const {
#pragma unroll
        for (int ai = 0; ai < 2; ++ai)
#pragma unroll
            for (int m = 0; m < 4; ++m) { const int nr = u.pm * 256 + ai * 128 + wr * 64 + m * 16 + fr; float* rowp = SLOC + (size_t)(u.aux * S5N + nr) * S5Q + wc * 32 + 4 * fq;
#pragma unroll
                for (int n = 0; n < 2; ++n) *(f32x4*)(rowp + n * 16) = acc[ai][0][m][n]; }
    }
};
struct EpiS5Out {
    static constexpr bool PERM = true, ACC_INIT = false, B16 = false;
    bf16* GY;
    __device__ __forceinline__ void operator()(const f32x4 (&acc)[2][2][4][2], const Unit& u, int wr, int wc, int fr, int fq) const {
#pragma unroll
        for (int ai = 0; ai < 2; ++ai)
#pragma unroll
            for (int m = 0; m < 4; ++m) { const int nr = u.pm * 256 + ai * 128 + wr * 64 + m * 16 + fr, b = nr >> 8, j16 = nr & 255;
#pragma unroll
                for (int bj = 0; bj < 2; ++bj) { const int cc = bj * 128 + wc * 32 + 8 * fq, t = cc >> 4, c0 = cc & 15;
                    f32x4 v0 = acc[ai][bj][m][0], v1 = acc[ai][bj][m][1];
#pragma unroll
                    for (int j = 0; j < 4; ++j) { v0[j] = gelu_t(v0[j]); v1[j] = gelu_t(v1[j]); }
                    *(v4u*)(GY + ((size_t)u.aux * T + (size_t)(b * SEQ + j16 * 16 + t)) * 16 + c0) = pack8(v0, v1); }
                asm volatile("" ::: "memory"); }
    }
};
struct EpiYa {
    static constexpr bool PERM = true, ACC_INIT = false, B16 = false;
    const bf16* GA; bf16* YA;
    __device__ __forceinline__ void operator()(const f32x4 (&acc)[2][2][4][2], const Unit& u, int wr, int wc, int fr, int fq) const {
        const size_t off0 = (size_t)(u.pm * 256 + wr * 64 + fr) * 1024 + u.pn * 128 + wc * 32 + 8 * fq;
        v2u gav[2][4];
#pragma unroll
        for (int ai = 0; ai < 2; ++ai)
#pragma unroll
            for (int m = 0; m < 4; ++m) gav[ai][m] = __builtin_nontemporal_load((const v2u*)((const unsigned char*)GA + off0 + (size_t)(ai * 128 + m * 16) * 1024));
        asm volatile("" ::: "memory");
#pragma unroll
        for (int ai = 0; ai < 2; ++ai)
#pragma unroll
            for (int m = 0; m < 4; ++m) { float gaf[8]; unpack_u8x8(gav[ai][m], gaf);
                f32x4 o0, o1;
#pragma unroll
                for (int j = 0; j < 4; ++j) { o0[j] = gaf[j] * acc[ai][0][m][0][j] * fsigmoid(acc[ai][1][m][0][j]); o1[j] = gaf[4 + j] * acc[ai][0][m][1][j] * fsigmoid(acc[ai][1][m][1][j]); }
                *(v4u*)(YA + off0 + (size_t)(ai * 128 + m * 16) * 1024) = pack8(o0, o1); }
    }
};
struct EpiYb {
    static constexpr bool PERM = true, ACC_INIT = false, B16 = false;
    const bf16* YA; const bf16* GB; bf16* MIX;
    __device__ __forceinline__ void operator()(const f32x4 (&acc)[2][2][4][2], const Unit& u, int wr, int wc, int fr, int fq) const {
        const size_t off0 = (size_t)(u.pm * 256 + wr * 64 + fr) * 1024 + u.pn * 256 + wc * 32 + 8 * fq;
        v4u ya[2][2][2]; v2u gb[2][2][2];
#define YB_LOAD(buf, grp) do { _Pragma("unroll") for (int mm = 0; mm < 2; ++mm) _Pragma("unroll") for (int bj = 0; bj < 2; ++bj) { \
            const size_t o = off0 + (size_t)(((grp) >> 1) * 128 + (2 * ((grp) & 1) + mm) * 16) * 1024 + bj * 128; ya[buf][mm][bj] = *(const v4u*)(YA + o); gb[buf][mm][bj] = __builtin_nontemporal_load((const v2u*)((const unsigned char*)GB + o)); } } while (0)
        YB_LOAD(0, 0);
#pragma unroll
        for (int grp = 0; grp < 4; ++grp) { const int buf = grp & 1, ai = grp >> 1;
            if (grp < 3) YB_LOAD(buf ^ 1, grp + 1);
            asm volatile("" ::: "memory");
#pragma unroll
            for (int mm = 0; mm < 2; ++mm) { const int m = 2 * (grp & 1) + mm;
#pragma unroll
                for (int bj = 0; bj < 2; ++bj) { const v4u y = ya[buf][mm][bj];
                    const float yaf[8] = {bflo(y.x), bfhi(y.x), bflo(y.y), bfhi(y.y), bflo(y.z), bfhi(y.z), bflo(y.w), bfhi(y.w)};
                    float gbf[8]; unpack_u8x8(gb[buf][mm][bj], gbf);
                    f32x4 o0, o1;
#pragma unroll
                    for (int j = 0; j < 4; ++j) { o0[j] = yaf[j] + gbf[j] * acc[ai][bj][m][0][j]; o1[j] = yaf[4 + j] + gbf[4 + j] * acc[ai][bj][m][1][j]; }
                    *(v4u*)(MIX + off0 + (size_t)(ai * 128 + m * 16) * 1024 + bj * 128) = pack8(o0, o1); } }
        }
#undef YB_LOAD
    }
};
struct EpiYaYb {
    static constexpr bool PERM = true, ACC_INIT = false, B16 = false;
    EpiYa a; EpiYb b;
    __device__ __forceinline__ void operator()(const f32x4 (&acc)[2][2][4][2], const Unit& u, int wr, int wc, int fr, int fq) const {
        if (__builtin_amdgcn_readfirstlane(u.kind) == 0) a(acc, u, wr, wc, fr, fq); else b(acc, u, wr, wc, fr, fq);
    }
};
struct EpiWo {
    static constexpr bool PERM = false, ACC_INIT = true, B16 = false;
    const float* X; float* O;
    __device__ __forceinline__ void init(f32x4 (&acc)[2][2][4][2], const Unit& u, int wr, int wc, int fr, int fq) const {
        const size_t off0 = (size_t)(u.pm * 256 + wr * 64 + fr) * 1024 + u.pn * 256 + wc * 32 + 4 * fq;
#pragma unroll
        for (int ai = 0; ai < 2; ++ai)
#pragma unroll
            for (int m = 0; m < 4; ++m)
#pragma unroll
                for (int bj = 0; bj < 2; ++bj)
#pragma unroll
                    for (int n = 0; n < 2; ++n) acc[ai][bj][m][n] = __builtin_nontemporal_load((const f32x4*)(X + off0 + (size_t)(ai * 128 + m * 16) * 1024 + bj * 128 + n * 16));
    }
    __device__ __forceinline__ void operator()(const f32x4 (&acc)[2][2][4][2], const Unit& u, int wr, int wc, int fr, int fq) const {
        const size_t off0 = (size_t)(u.pm * 256 + wr * 64 + fr) * 1024 + u.pn * 256 + wc * 32 + 4 * fq;
#pragma unroll
        for (int ai = 0; ai < 2; ++ai)
#pragma unroll
            for (int m = 0; m < 4; ++m)
#pragma unroll
                for (int bj = 0; bj < 2; ++bj)
#pragma unroll
                    for (int n = 0; n < 2; ++n) *(f32x4*)(O + off0 + (size_t)(ai * 128 + m * 16) * 1024 + bj * 128 + n * 16) = acc[ai][bj][m][n];
    }
};
struct EpiGU {
    static constexpr bool PERM = true, ACC_INIT = false, B16 = false;
    bf16* ACT; const LAS float* sclL;
    __device__ __forceinline__ void operator()(const f32x4 (&acc)[2][2][4][2], const Unit& u, int wr, int wc, int fr, int fq) const {
#pragma unroll
        for (int ai = 0; ai < 2; ++ai)
#pragma unroll
            for (int m = 0; m < 4; ++m) { const int rl = ai * 128 + wr * 64 + m * 16 + fr; const float sc = sclL[u.aux * 256 + rl];
                f32x4 o0, o1;
#pragma unroll
                for (int j = 0; j < 4; ++j) { const float g0 = acc[ai][0][m][0][j] * sc, g1 = acc[ai][0][m][1][j] * sc;
                    o0[j] = g0 * fsigmoid(g0) * (acc[ai][1][m][0][j] * sc); o1[j] = g1 * fsigmoid(g1) * (acc[ai][1][m][1][j] * sc); }
                *(v4u*)(ACT + (size_t)(u.pm * 256 + rl) * DEXP + u.pn * 128 + wc * 32 + 8 * fq) = pack8(o0, o1); }
    }
};
struct EpiDown {
    static constexpr bool PERM = true, ACC_INIT = false, B16 = false;
    bf16* YS; const LAS float* sclL;
    __device__ __forceinline__ void operator()(const f32x4 (&acc)[2][2][4][2], const Unit& u, int wr, int wc, int fr, int fq) const {
#pragma unroll
        for (int ai = 0; ai < 2; ++ai)
#pragma unroll
            for (int m = 0; m < 4; ++m) { const int rl = ai * 128 + wr * 64 + m * 16 + fr; const float sc = sclL[u.aux * 256 + rl];
#pragma unroll
                for (int bj = 0; bj < 2; ++bj)
                    *(v4u*)(YS + (size_t)(u.pm * 256 + rl) * 1024 + u.pn * 256 + bj * 128 + wc * 32 + 8 * fq) = pack8(acc[ai][bj][m][0] * sc, acc[ai][bj][m][1] * sc); }
    }
};

template <bool SCALED> struct EpiQ8 {
    static constexpr bool PERM = true, ACC_INIT = false, B16 = true;
    unsigned char* YS8; float* YSC; const LAS float* sclL;
    __device__ __forceinline__ void operator()(const f32x4 (&acc)[2][2][4][2], const Unit& u, int wr, int wc, int fr, int fq) const {
        float scs[2][4];
#pragma unroll
        for (int ai = 0; ai < 2; ++ai)
#pragma unroll
            for (int m = 0; m < 4; ++m) { const int rl = ai * 128 + wr * 64 + m * 16 + fr; const float sc = SCALED ? sclL[u.aux * 256 + rl] : 1.0f;
                float v[16]; float amax = 0.f;
#pragma unroll
                for (int bj = 0; bj < 2; ++bj)
#pragma unroll
                    for (int n = 0; n < 2; ++n)
#pragma unroll
                        for (int j = 0; j < 4; ++j) { const float x = acc[ai][bj][m][n][j] * sc; v[bj * 8 + n * 4 + j] = x; amax = fmaxf(amax, fabsf(x)); }
                amax = fmaxf(amax, __shfl_xor(amax, 16)); amax = fmaxf(amax, __shfl_xor(amax, 32));
                const float inv = amax > 0.f ? 127.0f / amax : 0.f;
                scs[ai][m] = amax * (1.0f / 127.0f);
                v4u w;
#pragma unroll
                for (int d = 0; d < 4; ++d) { const int q0 = (int)__builtin_rintf(v[4 * d] * inv), q1 = (int)__builtin_rintf(v[4 * d + 1] * inv), q2 = (int)__builtin_rintf(v[4 * d + 2] * inv), q3 = (int)__builtin_rintf(v[4 * d + 3] * inv);
                    w[d] = ((unsigned)q0 & 255u) | (((unsigned)q1 & 255u) << 8) | (((unsigned)q2 & 255u) << 16) | ((unsigned)q3 << 24); }
                *(v4u*)(YS8 + (size_t)(u.pm * 256 + rl) * 1024 + u.pn * 256 + wc * 64 + fq * 16) = w; }
#pragma unroll
        for (int ai = 0; ai < 2; ++ai) { const float sv = fq == 0 ? scs[ai][0] : fq == 1 ? scs[ai][1] : fq == 2 ? scs[ai][2] : scs[ai][3];
            YSC[(size_t)(u.pm * 256 + ai * 128 + wr * 64 + fq * 16 + fr) * 16 + wc * 4 + u.pn] = sv; }
    }
};

struct TItem { const float* W; int N; bf16* WT; int ldk, k0, n0, drow0; };
__device__ __forceinline__ void transpose_load(const TItem& it, f32x4 (&tv)[8], int lane) {
#pragma unroll
    for (int i = 0; i < 8; ++i) tv[i] = __builtin_nontemporal_load((const f32x4*)(it.W + (size_t)(it.k0 + 8 * i + (lane >> 3)) * it.N + it.n0 + 4 * (lane & 7)));
}
template <bool NT = false> __device__ __forceinline__ void transpose_store(const TItem& it, const f32x4 (&tv)[8], LAS float* scr, int lane) {
#pragma unroll
    for (int i = 0; i < 8; ++i) { LAS float* d = scr + (8 * i + (lane >> 3)) * 33 + 4 * (lane & 7); d[0] = tv[i].x; d[1] = tv[i].y; d[2] = tv[i].z; d[3] = tv[i].w; }
    LDS_WAIT(); asm volatile("" ::: "memory");
    const int c = lane & 7;
#pragma unroll
    for (int j = 0; j < 4; ++j) { const int n = (lane >> 3) + 8 * j; const LAS float* s = scr + (8 * c) * 33 + n;
        v4u o; o.x = pk2(s[0 * 33], s[1 * 33]); o.y = pk2(s[2 * 33], s[3 * 33]); o.z = pk2(s[4 * 33], s[5 * 33]); o.w = pk2(s[6 * 33], s[7 * 33]);
        if (NT) __builtin_nontemporal_store(o, (v4u*)(it.WT + (size_t)(it.drow0 + n) * it.ldk + it.k0 + 8 * c)); else *(v4u*)(it.WT + (size_t)(it.drow0 + n) * it.ldk + it.k0 + 8 * c) = o; }
    LDS_WAIT(); asm volatile("" ::: "memory");
}
__device__ __forceinline__ int ileave_row(int n, int half) { return 256 * (n >> 7) + 128 * half + (n & 127); }

template <int NR> __device__ __forceinline__ void rms_rows_to_bf16(const float* x0, const float* gain, bf16* o0, size_t rstride, int lane) {
    f32x4 v[NR][4];
#pragma unroll
    for (int r = 0; r < NR; ++r) { const f32x4* xr = (const f32x4*)(x0 + r * rstride) + lane;
#pragma unroll
        for (int j = 0; j < 4; ++j) v[r][j] = __builtin_nontemporal_load(xr + 64 * j); }
    asm volatile("" ::: "memory");
    const f32x4* gr = (const f32x4*)gain + lane;
    f32x4 g[4];
#pragma unroll
    for (int j = 0; j < 4; ++j) g[j] = gr[64 * j];
#pragma unroll
    for (int r = 0; r < NR; ++r) { float s = 0.f;
#pragma unroll
        for (int j = 0; j < 4; ++j) s += (v[r][j].x * v[r][j].x + v[r][j].y * v[r][j].y) + (v[r][j].z * v[r][j].z + v[r][j].w * v[r][j].w);
        const float rstd = 1.0f / sqrtf(wave_sum(s) * (1.f / D) + RMS_EPS);
        unsigned long long* o8 = (unsigned long long*)(o0 + r * rstride) + lane;
#pragma unroll
        for (int j = 0; j < 4; ++j) o8[64 * j] = (unsigned long long)pk2(v[r][j].x * rstd * g[j].x, v[r][j].y * rstd * g[j].y) | ((unsigned long long)pk2(v[r][j].z * rstd * g[j].z, v[r][j].w * rstd * g[j].w) << 32); }
}

__device__ __forceinline__ void s5_tables(const Frame& F, int g, const float* lam_re, const float* lam_im, const float* log_dt, const float* b_re, const float* b_im, const float* c_re, const float* c_im, const float* dsk) {
    LAS float* Cre = (LAS float*)F.lds;
    LAS float* Cim = Cre + 1024;
    LAS float* Bre = Cim + 1024;
    LAS float* Bim = Bre + 1024;
    LAS float* Pre = Bim + 1024;
    LAS float* Pim = Pre + 17 * 64;
    LAS float* Kt = Pim + 17 * 64;
    const int tid = F.tid;
    for (int i = tid; i < 1024; i += 512) { Cre[i] = c_re[g * 1024 + i]; Cim[i] = c_im[g * 1024 + i]; }
    if (tid < 64) {
        const int p = tid; const float lr = lam_re[g * 64 + p], li = lam_im[g * 64 + p], dt = expf(log_dt[g]);
        const float er = expf(lr * dt), lbr = er * cosf(li * dt), lbi = er * sinf(li * dt);
        const float den = lr * lr + li * li, nr = lbr - 1.0f, ni = lbi;
        const float cr = (nr * lr + ni * li) / den, ci = (ni * lr - nr * li) / den;
        { float pr = 1.f, pi = 0.f; for (int k = 0; k <= 16; ++k) { Pre[k * 64 + p] = pr; Pim[k * 64 + p] = pi; const float nr2 = pr * lbr - pi * lbi, ni2 = pr * lbi + pi * lbr; pr = nr2; pi = ni2; } }
        for (int c = 0; c < 16; ++c) { const float br = b_re[(g * 64 + p) * 16 + c], bi = b_im[(g * 64 + p) * 16 + c]; Bre[p * 16 + c] = cr * br - ci * bi; Bim[p * 16 + c] = cr * bi + ci * br; }
    }
    __syncthreads();
    for (int e = tid; e < 4096; e += 512) {
        const int k = e >> 8, c = (e >> 4) & 15, cp = e & 15; float s = 0.f;
        for (int p = 0; p < 64; ++p) { const float xr = Cre[c * 64 + p] * Pre[k * 64 + p] - Cim[c * 64 + p] * Pim[k * 64 + p], xi = Cre[c * 64 + p] * Pim[k * 64 + p] + Cim[c * 64 + p] * Pre[k * 64 + p];
            s += xr * Bre[p * 16 + cp] - xi * Bim[p * 16 + cp]; }
        if (k == 0 && c == cp) s += dsk[g * 16 + c];
        Kt[e] = s;
    }
    __syncthreads();
    unsigned* btt = (unsigned*)(F.ws + WS_BTT) + (size_t)g * 256 * (S5K / 2);
    for (int e = tid; e < 256 * (S5K / 2); e += 512) {
        const int row = e / (S5K / 2), cpair = e % (S5K / 2), t = row >> 4, c = row & 15, col = 2 * cpair; float v0, v1;
        if (col < S5Q) { const int p = col >> 1; const float xr = Cre[c * 64 + p] * Pre[(t + 1) * 64 + p] - Cim[c * 64 + p] * Pim[(t + 1) * 64 + p], xi = Cre[c * 64 + p] * Pim[(t + 1) * 64 + p] + Cim[c * 64 + p] * Pre[(t + 1) * 64 + p];
            v0 = xr; v1 = -xi; }
        else { const int s = (col - S5Q) >> 4, cp = (col - S5Q) & 15;
            if (s <= t) { v0 = Kt[(t - s) * 256 + c * 16 + cp]; v1 = Kt[(t - s) * 256 + c * 16 + cp + 1]; } else { v0 = 0.f; v1 = 0.f; } }
        btt[e] = pk2(v0, v1);
    }
    unsigned* btw = (unsigned*)(F.ws + WS_BTW) + (size_t)g * 128 * 128;
    for (int e = tid; e < 128 * 128; e += 512) {
        const int q = e >> 7, cpair = e & 127, col = 2 * cpair, s = col >> 4, cp = col & 15, p = q >> 1, k = 15 - s;
        const float pr = Pre[k * 64 + p], pi = Pim[k * 64 + p];
        float v0, v1;
        if (q & 1) { v0 = pr * Bim[p * 16 + cp] + pi * Bre[p * 16 + cp]; v1 = pr * Bim[p * 16 + cp + 1] + pi * Bre[p * 16 + cp + 1]; }
        else { v0 = pr * Bre[p * 16 + cp] - pi * Bim[p * 16 + cp]; v1 = pr * Bre[p * 16 + cp + 1] - pi * Bim[p * 16 + cp + 1]; }
        btw[e] = pk2(v0, v1);
    }
    if (tid < 64) { float* l16 = (float*)(F.ws + SM_LAM16) + (g * 64 + tid) * 2; l16[0] = Pre[16 * 64 + tid]; l16[1] = Pim[16 * 64 + tid]; }
    __syncthreads();
}

struct In { const float* p[30]; };

__device__ __forceinline__ void p0_prologue(const Frame& F, const In& I) {
    for (int g = F.vcu; g < S5G; g += F.G) s5_tables(F, g, I.p[3], I.p[4], I.p[5], I.p[6], I.p[7], I.p[8], I.p[9], I.p[10]);
    const int gt = F.vcu * 512 + F.tid, NGT = F.G * 512;
    { float* lc = (float*)(F.ws + SM_LRUC); for (int i = gt; i < LRUW; i += NGT) { const float lam = I.p[18][i]; lc[i] = -8.0f * log1pf(expf(-lam)) * 1.44269504f; } }
    { bf16* wrt = (bf16*)(F.ws + SM_WRT);
        for (int i = gt; i < 2 * 65536; i += NGT) { const int which = i >> 16, r = i & 65535, h = r >> 12, j = (r >> 6) & 63, k = r & 63; const float* src = which ? I.p[16] : I.p[14]; wrt[i] = (bf16)f2bf(src[(h * 64 + k) * 64 + j]); } }
    { bf16* rhi = (bf16*)(F.ws + SM_RHI); bf16* rlo = (bf16*)(F.ws + SM_RLO);
        for (int i = gt; i < NROUT * 1024; i += NGT) { const int n = i >> 10, k = i & 1023; float w = 0.f; if (n < 4) w = I.p[22][k * 4 + n]; else if (n < 36) w = I.p[24][k * 32 + (n - 4)];
            const unsigned h = f2bf(w); rhi[i] = (bf16)h; rlo[i] = (bf16)f2bf(w - bf2f(h)); } }
    LAS float* scr = (LAS float*)(F.lds + F.wave * 16384);
    const int gw = F.vcu * NWAVES + F.wave, NGW = F.G * NWAVES;
    constexpr int I_IN = (D / 64) * (NIN / 32), I_S5 = (S5W / 64) * (2 * D / 32), I_LRU = (D / 64) * (D / 32), I_O = I_LRU;
    constexpr int NITEMS = I_IN + I_S5 + I_LRU + I_O;
    for (int it = gw; it < NITEMS; it += NGW) {
        int r = it; TItem ti;
        if (r < I_IN) { const int nb = NIN / 32, kb = r / nb, n0 = 32 * (r % nb); ti = TItem{I.p[2], NIN, (bf16*)(F.ws + WS_WIN), D, 64 * kb, n0, n0}; }
        else if ((r -= I_IN) < I_S5) { const int nb = 2 * D / 32, kb = r / nb, n0 = 32 * (r % nb); ti = TItem{I.p[11], 2 * D, (bf16*)(F.ws + WS_WS5), S5W, 64 * kb, n0, n0 < D ? ileave_row(n0, 0) : ileave_row(n0 - D, 1)}; }
        else if ((r -= I_S5) < I_LRU) { const int nb = D / 32, kb = r / nb, n0 = 32 * (r % nb); ti = TItem{I.p[19], D, (bf16*)(F.ws + WS_WLRU), D, 64 * kb, n0, n0}; }
        else { r -= I_LRU; const int nb = D / 32, kb = r / nb, n0 = 32 * (r % nb); ti = TItem{I.p[20], D, (bf16*)(F.ws + WS_WO), D, 64 * kb, n0, n0}; }
        f32x4 tv[8]; transpose_load(ti, tv, F.lane); asm volatile("" ::: "memory"); transpose_store(ti, tv, scr, F.lane);
    }
    { const int skip = F.G > 2 * S5G ? S5G : 0;
      if (F.vcu >= skip) { const int gw2 = (F.vcu - skip) * NWAVES + F.wave, NGW2 = (F.G - skip) * NWAVES;
        for (int m = gw2 * 4; m < T; m += NGW2 * 4) rms_rows_to_bf16<4>(I.p[0] + (size_t)m * D, I.p[1], (bf16*)(F.ws + WS_H) + (size_t)m * D, D, F.lane); } }
}
__device__ __forceinline__ TItem expert_item(const Frame& F, const In& I, int it) {
    constexpr int I_G = (D / 64) * (DEXP / 32), I_D = (DEXP / 64) * (D / 32);
    const int e = it / (2 * I_G + I_D); int r = it % (2 * I_G + I_D);
    if (r < 2 * I_G) { const int half = r / I_G; r %= I_G; const int nb = DEXP / 32, kb = r / nb, n0 = 32 * (r % nb);
        return TItem{(half ? I.p[27] : I.p[26]) + (size_t)e * D * DEXP, DEXP, (bf16*)(F.ws + WS_WGU) + (size_t)e * 1024 * 1024, D, 64 * kb, n0, ileave_row(n0, half)}; }
    r -= 2 * I_G; const int nb = D / 32, kb = r / nb, n0 = 32 * (r % nb);
    return TItem{I.p[28] + (size_t)e * DEXP * D, D, (bf16*)(F.ws + WS_WD) + (size_t)e * 1024 * DEXP, DEXP, 64 * kb, n0, n0};
}
__device__ __forceinline__ void expert_weight_copies(const Frame& F, const In& I) {
    LAS float* scr = (LAS float*)(F.lds + F.wave * 16384);
    const int gw = F.vcu * NWAVES + F.wave, NGW = F.G * NWAVES;
    constexpr int NIT = NEXP * 768;
    const int first = 8 * NGW < NIT ? 8 * NGW : NIT;
    for (int it = first + gw; it < NIT; it += 2 * NGW) {
        const TItem t0 = expert_item(F, I, it); const bool has1 = it + NGW < NIT; const TItem t1 = expert_item(F, I, has1 ? it + NGW : it);
        f32x4 v0[8], v1[8]; transpose_load(t0, v0, F.lane); transpose_load(t1, v1, F.lane); asm volatile("" ::: "memory");
        transpose_store(t0, v0, scr, F.lane); if (has1) transpose_store(t1, v1, scr, F.lane);
    }
}

__device__ __forceinline__ void lru_seq(const Frame& F, const In& I) {
    LAS unsigned char* wl = F.lds + F.wave * 17920;
    LAS bf16* xcA = (LAS bf16*)wl;
    LAS float* pre = (LAS float*)(wl + 9216);
    typedef float f32x2 __attribute__((ext_vector_type(2)));
    LAS f32x2* sumT = (LAS f32x2*)(F.lds + 143360);
    const int lane = F.lane, jj = lane & 15, ks = lane >> 4, c32 = lane & 31, th = lane >> 5;
    const bf16* XL = (const bf16*)(F.ws + WS_XL); const bf16* GL = (const bf16*)(F.ws + WS_GL); bf16* YL = (bf16*)(F.ws + WS_H);
    const bf16* WRT = (const bf16*)(F.ws + SM_WRT);
    for (int un = F.vcu; un < BATCH * LRUH * 2; un += F.G) {
        const int b = un >> 5, hd = (un >> 1) & 15, half = un & 1;
        const int chin = hd * 64 + lane;
        const int chg = hd * 64 + 32 * half + c32;
        const float w0 = I.p[12][chin], w1 = I.p[12][1024 + chin], w2 = I.p[12][2048 + chin], w3 = I.p[12][3072 + chin], cb = I.p[13][chin];
        const float brs = I.p[15][chg] * -1.44269504f, bis = I.p[17][chg] * -1.44269504f, cch2 = ((const float*)(F.ws + SM_LRUC))[chg];
        bf16x8 Bw[4][2];
#pragma unroll
        for (int n = 0; n < 4; ++n)
#pragma unroll
            for (int k = 0; k < 2; ++k) Bw[n][k] = *(const bf16x8*)(WRT + (size_t)(n >> 1) * 65536 + (size_t)(hd * 64 + 32 * half + 16 * (n & 1) + jj) * 64 + 32 * k + 8 * ks);
        float Rc = 0.f;
        for (int rd = 0; rd < 8; ++rd) {
            const int j = rd * 8 + F.wave;
            const size_t tok0 = (size_t)b * SEQ + (size_t)j * LRUCH;
            unsigned short xr[64], xh[3];
            { const bf16* xp = XL + tok0 * 1024 + chin;
              xh[0] = 0; xh[1] = 0; xh[2] = 0;
              if (j > 0) { xh[0] = xp[-3 * 1024]; xh[1] = xp[-2 * 1024]; xh[2] = xp[-1 * 1024]; }
#pragma unroll
              for (int t = 0; t < 64; ++t) xr[t] = xp[t * 1024]; }
            asm volatile("" ::: "memory");
            { typedef float f2v __attribute__((ext_vector_type(2)));
              float xm3 = bf2f(xh[0]), xm2 = bf2f(xh[1]), xm1 = bf2f(xh[2]);
              const f2v vw0 = {w0, w0}, vw1 = {w1, w1}, vw2 = {w2, w2}, vw3 = {w3, w3}, vcb = {cb, cb};
#pragma unroll
              for (int t = 0; t < 64; t += 2) { const float x0 = bf2f(xr[t]), x1 = bf2f(xr[t + 1]);
                  f2v xc = vcb + vw0 * (f2v){xm3, xm2}; xc = xc + vw1 * (f2v){xm2, xm1}; xc = xc + vw2 * (f2v){xm1, x0}; xc = xc + vw3 * (f2v){x0, x1};
                  const unsigned pk = pg8::cvt_pk_bf16(xc.x, xc.y);
                  xcA[t * 72 + lane] = (bf16)(pk & 0xffffu); xcA[(t + 1) * 72 + lane] = (bf16)(pk >> 16);
                  xm3 = xm1; xm2 = x0; xm1 = x1; } }
            LDS_WAIT();
            float hl[2][16], Pl[2][16], Prun[2], Hrun[2];
#pragma unroll
            for (int st = 0; st < 2; ++st) {
#pragma unroll
                for (int mh = 0; mh < 2; ++mh) { const int mt = 2 * st + mh;
                    bf16x8 a[2];
#pragma unroll
                    for (int k = 0; k < 2; ++k) a[k] = *(const LAS bf16x8*)(xcA + (16 * mt + jj) * 72 + 32 * k + 8 * ks);
#pragma unroll
                    for (int n = 0; n < 4; ++n) { f32x4 d = (f32x4){0.f, 0.f, 0.f, 0.f};
#pragma unroll
                        for (int k = 0; k < 2; ++k) d = __builtin_amdgcn_mfma_f32_16x16x32_bf16(a[k], Bw[n][k], d, 0, 0, 0);
#pragma unroll
                        for (int r = 0; r < 4; ++r) pre[(16 * mh + 4 * ks + r) * 68 + 16 * n + jj] = d[r]; } }
                LDS_WAIT();
                float h = 0.f, P = 1.f;
                typedef float f2v __attribute__((ext_vector_type(2)));
#pragma unroll
                for (int tl = 0; tl < 16; tl += 2) {
                    const int trow = 16 * th + tl;
                    const f2v pr = {pre[trow * 68 + c32], pre[(trow + 1) * 68 + c32]}, pi = {pre[trow * 68 + 32 + c32], pre[(trow + 1) * 68 + 32 + c32]};
                    const f2v zr = pr * (f2v){-1.44269504f, -1.44269504f} + (f2v){brs, brs}, zi = pi * (f2v){-1.44269504f, -1.44269504f} + (f2v){bis, bis};
                    const f2v er = {__builtin_amdgcn_exp2f(zr.x), __builtin_amdgcn_exp2f(zr.y)}, ei = {__builtin_amdgcn_exp2f(zi.x), __builtin_amdgcn_exp2f(zi.y)};
                    const f2v dr = er + (f2v){1.f, 1.f};
                    const f2v rg = {__builtin_amdgcn_rcpf(dr.x), __builtin_amdgcn_rcpf(dr.y)};
                    const f2v la2 = rg * (f2v){cch2, cch2};
                    const f2v a_ = {__builtin_amdgcn_exp2f(la2.x), __builtin_amdgcn_exp2f(la2.y)};
                    const f2v x2 = la2 * (f2v){1.38629436f, 1.38629436f};
                    f2v q = x2 * (f2v){0.0013888889f, 0.0013888889f} + (f2v){0.0083333333f, 0.0083333333f};
                    q = q * x2 + (f2v){0.041666667f, 0.041666667f}; q = q * x2 + (f2v){0.16666667f, 0.16666667f}; q = q * x2 + (f2v){0.5f, 0.5f}; q = q * x2 + (f2v){1.f, 1.f};
                    f2v om = -(q * x2);
                    const f2v alt = (f2v){1.f, 1.f} - a_ * a_;
                    om.x = x2.x > -0.3f ? om.x : alt.x; om.y = x2.y > -0.3f ? om.y : alt.y;
                    om.x = fmaxf(om.x, 1e-30f); om.y = fmaxf(om.y, 1e-30f);
                    const f2v dd = ei + (f2v){1.f, 1.f};
                    const f2v rq = om * dd * dd;
                    const f2v mi = om * (f2v){__builtin_amdgcn_rsqf(rq.x), __builtin_amdgcn_rsqf(rq.y)};
                    const f2v bx = mi * (f2v){bf2f(xcA[(32 * st + trow) * 72 + 32 * half + c32]), bf2f(xcA[(32 * st + trow + 1) * 72 + 32 * half + c32])};
                    h = a_.x * h + bx.x; P *= a_.x; hl[st][tl] = h; Pl[st][tl] = P;
                    h = a_.y * h + bx.y; P *= a_.y; hl[st][tl + 1] = h; Pl[st][tl + 1] = P;
                }
                Prun[st] = P; Hrun[st] = h;
                LDS_WAIT();
            }
            const float pP0 = __shfl_xor(Prun[0], 32), pH0 = __shfl_xor(Hrun[0], 32), pP1 = __shfl_xor(Prun[1], 32), pH1 = __shfl_xor(Hrun[1], 32);
            const float P0 = th ? pP0 : Prun[0], H0 = th ? pH0 : Hrun[0], P1 = th ? Prun[0] : pP0, H1 = th ? Hrun[0] : pH0;
            const float P2 = th ? pP1 : Prun[1], H2 = th ? pH1 : Hrun[1], P3 = th ? Prun[1] : pP1, H3 = th ? Hrun[1] : pH1;
            const float C1 = H0, Q1 = P0, C2 = P1 * C1 + H1, Q2 = P1 * Q1, C3 = P2 * C2 + H2, Q3 = P2 * Q2, Hc = P3 * C3 + H3, Pc = P3 * Q3;
            const float Cs0 = th ? C1 : 0.f, Qs0 = th ? Q1 : 1.f, Cs1 = th ? C3 : C2, Qs1 = th ? Q3 : Q2;
            const int cit = (rd * F.G + F.vcu) * NWAVES + F.wave; const bool cdo = cit < NEXP * 768;
            f32x4 ctv[8]; unsigned short ggr[2][16];
            if (cdo) { const TItem citem = expert_item(F, I, cit); transpose_load(citem, ctv, lane); }
#pragma unroll
            for (int st = 0; st < 2; ++st)
#pragma unroll
                for (int tl = 0; tl < 16; ++tl) ggr[st][tl] = GL[(tok0 + 32 * st + 16 * th + tl) * 1024 + chg];
            asm volatile("" ::: "memory");
            if (th == 0) sumT[((rd & 1) * 8 + F.wave) * 32 + c32] = (f32x2){Pc, Hc};
            LDS_WAIT();
            __syncthreads();
            float cin = Rc, mycin = 0.f;
#pragma unroll
            for (int w = 0; w < 8; ++w) { const f32x2 ph = sumT[((rd & 1) * 8 + w) * 32 + c32]; mycin = (w == F.wave) ? cin : mycin; cin = ph.x * cin + ph.y; }
            Rc = cin;
#pragma unroll
            for (int st = 0; st < 2; ++st) { const float hin = (st ? Cs1 : Cs0) + (st ? Qs1 : Qs0) * mycin;
#pragma unroll
                for (int tl = 0; tl < 16; ++tl) { const float hh = hl[st][tl] + Pl[st][tl] * hin;
                    YL[(tok0 + 32 * st + 16 * th + tl) * 1024 + chg] = (bf16)f2bf(hh * bf2f(ggr[st][tl])); } }
            if (cdo) { const TItem citem = expert_item(F, I, cit); transpose_store<true>(citem, ctv, pre, lane); }
        }
        __syncthreads();
    }
}

__device__ __forceinline__ void s5_chain(const Frame& F, int b, int g) {
    typedef float f32x2 __attribute__((ext_vector_type(2)));
    LAS f32x2* segE = (LAS f32x2*)(F.lds);
    const int lane = F.lane, w = F.wave;
    const float* SLOC = (const float*)(F.ws + WS_SLOC); unsigned* AGw = (unsigned*)(F.ws + WS_AG); const float* L16 = (const float*)(F.ws + SM_LAM16);
    const float lr = L16[(g * 64 + lane) * 2], li = L16[(g * 64 + lane) * 2 + 1];
    const float* sl = SLOC + ((size_t)(g * S5N + b * S5NCH + 32 * w)) * S5Q + 2 * lane;
    unsigned* ag = AGw + ((size_t)(g * S5N + b * S5NCH + 32 * w)) * (S5K / 2) + lane;
    float xr[32], xi[32];
#pragma unroll
    for (int u = 0; u < 32; ++u) { const float2 v = *(const float2*)(sl + (size_t)u * S5Q); xr[u] = v.x; xi[u] = v.y; }
    asm volatile("" ::: "memory");
    float sr = 0.f, si = 0.f;
#pragma unroll
    for (int u = 0; u < 32; ++u) { const float nr = lr * sr - li * si + xr[u], ni = lr * si + li * sr + xi[u]; xr[u] = sr; xi[u] = si; sr = nr; si = ni; }
    segE[w * 64 + lane] = (f32x2){sr, si};
    float qr = lr, qi = li;
#pragma unroll
    for (int k = 0; k < 5; ++k) { const float nr = qr * qr - qi * qi, ni = 2.f * qr * qi; qr = nr; qi = ni; }
    LDS_WAIT();
    __syncthreads();
    float cr = 0.f, ci = 0.f;
    for (int ww = 0; ww < w; ++ww) { const f32x2 e = segE[ww * 64 + lane]; const float nr = qr * cr - qi * ci + e.x, ni = qr * ci + qi * cr + e.y; cr = nr; ci = ni; }
#pragma unroll
    for (int u = 0; u < 32; ++u) { ag[(size_t)u * (S5K / 2)] = pk2(xr[u] + cr, xi[u] + ci); const float nr = lr * cr - li * ci, ni = lr * ci + li * cr; cr = nr; ci = ni; }
    __syncthreads();
}

__device__ __forceinline__ void p8_router(const Frame& F, const In& I) {
    const int lane = F.lane, tk = lane & 15, ks = lane >> 4;
    LAS float* lg = (LAS float*)(F.lds + F.wave * 4096);
    volatile LAS unsigned* cntL = F.MISC + 32; volatile LAS unsigned* baseL = F.MISC + 64;
    const float* X1 = I.p[0]; bf16* H2 = (bf16*)(F.ws + WS_H2); const float* gf = I.p[21];
    const unsigned char* D8 = (const unsigned char*)(F.ws + WS_D8); const float* DSC = (const float*)(F.ws + WS_DSC);
    const bf16* RHI = (const bf16*)(F.ws + SM_RHI); const bf16* RLO = (const bf16*)(F.ws + SM_RLO);
    float* RSTD = (float*)(F.ws + SM_RSTD); unsigned* gcnt = F.ctl + CW_CNT;
    int* LTOK = (int*)(F.ws + WS_LTOK); float* LW = (float*)(F.ws + WS_LW); int* TOKE = (int*)(F.ws + WS_TOKE); int* TOKR = (int*)(F.ws + WS_TOKR);
    for (int blk = F.vcu; blk < T / 128; blk += F.G) {
        if (F.tid < 32) cntL[F.tid] = 0u;
        __syncthreads();
        const int tok0 = blk * 128 + F.wave * 16;
        const float* xrow = X1 + (size_t)(tok0 + tk) * D + 8 * ks; bf16* hrow = H2 + (size_t)(tok0 + tk) * D + 8 * ks;
        f32x4 acc[3]; acc[0] = acc[1] = acc[2] = (f32x4){0.f, 0.f, 0.f, 0.f}; float ss = 0.f;
        const unsigned char* drow = D8 + (size_t)(tok0 + tk) * D + 8 * ks; const float* dsc = DSC + (size_t)(tok0 + tk) * 16;
        f32x4 xnx[4][2]; v2u dnx[4]; float snx[2];
#pragma unroll
        for (int q = 0; q < 4; ++q) { xnx[q][0] = __builtin_nontemporal_load((const f32x4*)(xrow + 32 * q)); xnx[q][1] = __builtin_nontemporal_load((const f32x4*)(xrow + 32 * q + 4)); dnx[q] = *(const v2u*)(drow + 32 * q); }
        snx[0] = dsc[0]; snx[1] = dsc[4];
        LAS bf16* slab = (LAS bf16*)(F.lds + 32768);
        v4u wst[3];
#define RT_SLAB_LOAD(g) do { _Pragma("unroll") for (int j = 0; j < 3; ++j) { const int c = F.tid + 512 * j, which = c / 768, r = (c % 768) >> 4, kq = c & 15; \
            wst[j] = *(const v4u*)((which ? RLO : RHI) + (size_t)r * D + 128 * (g) + 8 * kq); } } while (0)
#define RT_SLAB_STORE(buf) do { _Pragma("unroll") for (int j = 0; j < 3; ++j) { const int c = F.tid + 512 * j, which = c / 768, r = (c % 768) >> 4, kq = c & 15; \
            *(LAS v4u*)(slab + ((size_t)((buf) * 2 + which) * 48 + r) * 136 + 8 * kq) = wst[j]; } } while (0)
        RT_SLAB_LOAD(0); RT_SLAB_STORE(0);
        LDS_WAIT();
        __syncthreads();
        for (int kg = 0; kg < 8; ++kg) {
            f32x4 xa[4][2];
#pragma unroll
            for (int q = 0; q < 4; ++q) { const float sq = snx[q >> 1]; const v2u dq = dnx[q];
                xa[q][0] = xnx[q][0] + (f32x4){(float)((int)(dq.x << 24) >> 24), (float)((int)(dq.x << 16) >> 24), (float)((int)(dq.x << 8) >> 24), (float)((int)dq.x >> 24)} * sq;
                xa[q][1] = xnx[q][1] + (f32x4){(float)((int)(dq.y << 24) >> 24), (float)((int)(dq.y << 16) >> 24), (float)((int)(dq.y << 8) >> 24), (float)((int)dq.y >> 24)} * sq; }
            { const int kgn = kg < 7 ? kg + 1 : kg;
#pragma unroll
              for (int q = 0; q < 4; ++q) { xnx[q][0] = __builtin_nontemporal_load((const f32x4*)(xrow + 32 * (4 * kgn + q))); xnx[q][1] = __builtin_nontemporal_load((const f32x4*)(xrow + 32 * (4 * kgn + q) + 4)); dnx[q] = *(const v2u*)(drow + 32 * (4 * kgn + q)); }
              { const int G0 = 2 * kgn, G1 = 2 * kgn + 1; snx[0] = dsc[(G0 & 3) * 4 + (G0 >> 2)]; snx[1] = dsc[(G1 & 3) * 4 + (G1 >> 2)]; }
              RT_SLAB_LOAD(kgn); }
            f32x4 ga[4][2];
#pragma unroll
            for (int q = 0; q < 4; ++q) { const int kc = 4 * kg + q; ga[q][0] = *(const f32x4*)(gf + 32 * kc + 8 * ks); ga[q][1] = *(const f32x4*)(gf + 32 * kc + 8 * ks + 4); }
            asm volatile("" ::: "memory");
            const LAS bf16* sh = slab + (size_t)((kg & 1) * 2) * 48 * 136, * sl = sh + 48 * 136;
#pragma unroll
            for (int q = 0; q < 4; ++q) { const int kc = 4 * kg + q;
                const f32x4 a0 = xa[q][0], a1 = xa[q][1];
                ss += (a0.x * a0.x + a0.y * a0.y) + (a0.z * a0.z + a0.w * a0.w) + (a1.x * a1.x + a1.y * a1.y) + (a1.z * a1.z + a1.w * a1.w);
                const f32x4 v0 = a0 * ga[q][0], v1 = a1 * ga[q][1];
                v4u hi, lo;
                { const unsigned h0 = f2bf(v0.x), h1 = f2bf(v0.y), h2 = f2bf(v0.z), h3 = f2bf(v0.w), h4 = f2bf(v1.x), h5 = f2bf(v1.y), h6 = f2bf(v1.z), h7 = f2bf(v1.w);
                  hi.x = h0 | (h1 << 16); hi.y = h2 | (h3 << 16); hi.z = h4 | (h5 << 16); hi.w = h6 | (h7 << 16);
                  lo.x = pk2(v0.x - bf2f(h0), v0.y - bf2f(h1)); lo.y = pk2(v0.z - bf2f(h2), v0.w - bf2f(h3)); lo.z = pk2(v1.x - bf2f(h4), v1.y - bf2f(h5)); lo.w = pk2(v1.z - bf2f(h6), v1.w - bf2f(h7)); }
                *(v4u*)(hrow + 32 * kc) = hi;
                const bf16x8 hf = __builtin_bit_cast(bf16x8, hi), lf = __builtin_bit_cast(bf16x8, lo);
#pragma unroll
                for (int n = 0; n < 3; ++n) {
                    const bf16x8 wh = *(const LAS bf16x8*)(sh + (16 * n + tk) * 136 + 32 * q + 8 * ks), wl = *(const LAS bf16x8*)(sl + (16 * n + tk) * 136 + 32 * q + 8 * ks);
                    acc[n] = __builtin_amdgcn_mfma_f32_16x16x32_bf16(wh, hf, acc[n], 0, 0, 0);
                    acc[n] = __builtin_amdgcn_mfma_f32_16x16x32_bf16(wh, lf, acc[n], 0, 0, 0);
                    acc[n] = __builtin_amdgcn_mfma_f32_16x16x32_bf16(wl, hf, acc[n], 0, 0, 0);
                } }
            if (kg < 7) RT_SLAB_STORE((kg + 1) & 1);
            LDS_WAIT();
            __syncthreads();
        }
#undef RT_SLAB_LOAD
#undef RT_SLAB_STORE
        ss += __shfl_xor(ss, 16); ss += __shfl_xor(ss, 32);
        const float rstd = 1.0f / sqrtf(ss * (1.f / D) + RMS_EPS);
        if (ks == 0) RSTD[tok0 + tk] = rstd;
#pragma unroll
        for (int n = 0; n < 3; ++n)
#pragma unroll
            for (int r = 0; r < 4; ++r) lg[tk * 49 + 16 * n + 4 * ks + r] = acc[n][r] * rstd;
        LDS_WAIT();
        int E1 = 0, E2 = 0; float w1 = 0.f, w2 = 0.f; unsigned r1 = 0, r2 = 0;
        if (lane < 16) {
            const LAS float* my = lg + lane * 49;
            float lgp[4];
#pragma unroll
            for (int i = 0; i < 4; ++i) lgp[i] = my[i] + I.p[23][i];
            int gi = 0; float mx = lgp[0];
#pragma unroll
            for (int i = 1; i < 4; ++i) if (lgp[i] > mx) { mx = lgp[i]; gi = i; }
            float den = 0.f;
#pragma unroll
            for (int i = 0; i < 4; ++i) den += expf(lgp[i] - mx);
            const float pg = 1.0f / den;
            float le[8];
#pragma unroll
            for (int i = 0; i < 8; ++i) le[i] = my[4 + gi * 8 + i] + I.p[25][gi * 8 + i];
            int i1 = 0; float m1 = le[0];
#pragma unroll
            for (int i = 1; i < 8; ++i) if (le[i] > m1) { m1 = le[i]; i1 = i; }
            int i2 = -1; float m2 = -3.0e38f;
#pragma unroll
            for (int i = 0; i < 8; ++i) if (i != i1 && le[i] > m2) { m2 = le[i]; i2 = i; }
            const float e2 = expf(m2 - m1);
            w1 = pg / (1.0f + e2); w2 = pg * e2 / (1.0f + e2);
            E1 = gi * 8 + i1; E2 = gi * 8 + i2;
            r1 = __hip_atomic_fetch_add((LAS unsigned*)(F.MISC + 32) + E1, 1u, __ATOMIC_RELAXED, __HIP_MEMORY_SCOPE_WORKGROUP);
            r2 = __hip_atomic_fetch_add((LAS unsigned*)(F.MISC + 32) + E2, 1u, __ATOMIC_RELAXED, __HIP_MEMORY_SCOPE_WORKGROUP);
        }
        LDS_WAIT();
        __syncthreads();
        if (F.tid < 32) { const unsigned c = cntL[F.tid]; baseL[F.tid] = c ? __hip_atomic_fetch_add(gcnt + F.tid, c, __ATOMIC_RELAXED, __HIP_MEMORY_SCOPE_AGENT) : 0u; }
        __syncthreads();
        if (lane < 16) {
            const int tok = tok0 + lane; const int k1 = (int)(baseL[E1] + r1), k2 = (int)(baseL[E2] + r2);
            LTOK[(size_t)E1 * T + k1] = tok; LW[(size_t)E1 * T + k1] = w1; LTOK[(size_t)E2 * T + k2] = tok; LW[(size_t)E2 * T + k2] = w2;
            TOKE[tok * 2] = E1; TOKE[tok * 2 + 1] = E2; TOKR[tok * 2] = k1; TOKR[tok * 2 + 1] = k2;
        }
        __syncthreads();
    }
}

__device__ __forceinline__ void moe_prefix(const Frame& F) {
    if (F.tid < 64) {
        const unsigned nt = F.tid < NEXP ? (F.ctl[CW_CNT + F.tid] + 255u) >> 8 : 0u; unsigned inc = nt;
#pragma unroll
        for (int o = 1; o < 32; o <<= 1) { const unsigned v = __shfl_up(inc, o); if (F.lane >= o) inc += v; }
        if (F.tid < NEXP) F.MISC[96 + F.tid] = inc - nt;
        if (F.tid == NEXP - 1) F.MISC[128] = inc;
    }
    LDS_WAIT();
    __syncthreads();
}
template <int MODE  >
__device__ __forceinline__ void moe_setup(const Frame& F) {
    moe_prefix(F);
    const int NT = (int)F.MISC[128];
    if (F.tid < MAXU) { const int L = F.tid * F.G + F.vcu; int e = -1, mt = 0;
        if (L < NT * 4) { const int mtg = L >> 2; e = 0; while (e < NEXP - 1 && (int)F.MISC[96 + e + 1] <= mtg) ++e; mt = mtg - (int)F.MISC[96 + e]; }
        F.MISC[136 + F.tid] = (unsigned)e; F.MISC[144 + F.tid] = (unsigned)mt; }
    __syncthreads();
    if (F.tid == 0) { int n = 0; while (n < MAXU && (int)F.MISC[136 + n] >= 0) ++n; F.MISC[152] = (unsigned)n; }
    __syncthreads();
    const int nU = (int)F.MISC[152];
    LAS int* tokL = (LAS int*)(F.lds + TOKL_OFF); LAS float* sclL = (LAS float*)(F.lds + SCLL_OFF);
    const int* LTOK = (const int*)(F.ws + WS_LTOK); const float* LW = (const float*)(F.ws + WS_LW); const float* RSTD = (const float*)(F.ws + SM_RSTD);
    for (int i = F.tid; i < nU * 256; i += 512) { const int ui = i >> 8, r = i & 255, e = (int)F.MISC[136 + ui], rank = (int)F.MISC[144 + ui] * 256 + r; const bool valid = rank < (int)F.ctl[CW_CNT + e];
        const int tok = valid ? LTOK[(size_t)e * T + rank] : 0; tokL[i] = tok; sclL[i] = valid ? (MODE == 0 ? RSTD[tok] : LW[(size_t)e * T + rank]) : 0.f; }
    LDS_WAIT(); VM_WAIT();
    __syncthreads();
}

__device__ __forceinline__ void p11_final(const Frame& F, const In& I, float* dst) {
    moe_prefix(F);
    const int gw = F.vcu * NWAVES + F.wave, NGW = F.G * NWAVES, lane = F.lane;
    const int* TOKE = (const int*)(F.ws + WS_TOKE); const int* TOKR = (const int*)(F.ws + WS_TOKR);
    const unsigned char* YS8 = (const unsigned char*)(F.ws + WS_YS); const float* YSC = (const float*)(F.ws + WS_YS + 80 * MiB);
    const unsigned char* D8 = (const unsigned char*)(F.ws + WS_D8); const float* DSC = (const float*)(F.ws + WS_DSC); const float* X = I.p[0];
    f32x4 gfin[4];
#pragma unroll
    for (int j = 0; j < 4; ++j) gfin[j] = ((const f32x4*)I.p[29])[lane + 64 * j];
    int ee[2][2], rr[2][2];
    { const int m0 = gw * 2 < T ? gw * 2 : 0;
#pragma unroll
      for (int q = 0; q < 2; ++q) { ee[q][0] = TOKE[2 * (m0 + q)]; ee[q][1] = TOKE[2 * (m0 + q) + 1]; rr[q][0] = TOKR[2 * (m0 + q)]; rr[q][1] = TOKR[2 * (m0 + q) + 1]; } }
    for (int m0 = gw * 2; m0 < T; m0 += NGW * 2) {
        f32x4 xv[2][4]; unsigned ya[2][4], yb[2][4], yd[2][4]; f32x4 sa[2], sb[2], sd[2];
#pragma unroll
        for (int q = 0; q < 2; ++q) { const size_t s0 = (size_t)F.MISC[96 + ee[q][0]] * 256 + rr[q][0], s1 = (size_t)F.MISC[96 + ee[q][1]] * 256 + rr[q][1];
            const f32x4* xr = (const f32x4*)(X + (size_t)(m0 + q) * D) + lane; const unsigned* y0 = (const unsigned*)(YS8 + s0 * 1024) + lane; const unsigned* y1 = (const unsigned*)(YS8 + s1 * 1024) + lane;
            const unsigned* d0 = (const unsigned*)(D8 + (size_t)(m0 + q) * 1024) + lane;
#pragma unroll
            for (int j = 0; j < 4; ++j) { xv[q][j] = __builtin_nontemporal_load(xr + 64 * j); ya[q][j] = y0[64 * j]; yb[q][j] = y1[64 * j]; yd[q][j] = d0[64 * j]; }
            sa[q] = *(const f32x4*)(YSC + s0 * 16 + 4 * (lane >> 4)); sb[q] = *(const f32x4*)(YSC + s1 * 16 + 4 * (lane >> 4)); sd[q] = *(const f32x4*)(DSC + (size_t)(m0 + q) * 16 + 4 * (lane >> 4)); }
        { const int mn = m0 + NGW * 2 < T ? m0 + NGW * 2 : m0;
#pragma unroll
          for (int q = 0; q < 2; ++q) { ee[q][0] = TOKE[2 * (mn + q)]; ee[q][1] = TOKE[2 * (mn + q) + 1]; rr[q][0] = TOKR[2 * (mn + q)]; rr[q][1] = TOKR[2 * (mn + q) + 1]; } }
        asm volatile("" ::: "memory");
#pragma unroll
        for (int q = 0; q < 2; ++q) { f32x4 v[4]; float s = 0.f;
#pragma unroll
            for (int j = 0; j < 4; ++j) { const f32x4 x = xv[q][j]; const unsigned a = ya[q][j], b = yb[q][j], c = yd[q][j]; const float ka = sa[q][j], kb = sb[q][j], kc = sd[q][j];
                v[j].x = (x.x + (float)((int)(c << 24) >> 24) * kc) + (float)((int)(a << 24) >> 24) * ka + (float)((int)(b << 24) >> 24) * kb;
                v[j].y = (x.y + (float)((int)(c << 16) >> 24) * kc) + (float)((int)(a << 16) >> 24) * ka + (float)((int)(b << 16) >> 24) * kb;
                v[j].z = (x.z + (float)((int)(c << 8) >> 24) * kc) + (float)((int)(a << 8) >> 24) * ka + (float)((int)(b << 8) >> 24) * kb;
                v[j].w = (x.w + (float)((int)c >> 24) * kc) + (float)((int)a >> 24) * ka + (float)((int)b >> 24) * kb;
                s += (v[j].x * v[j].x + v[j].y * v[j].y) + (v[j].z * v[j].z + v[j].w * v[j].w); }
            const float rstd = 1.0f / sqrtf(wave_sum(s) * (1.f / D) + RMS_EPS);
            f32x4* xw = (f32x4*)(dst + (size_t)(m0 + q) * D) + lane;
#pragma unroll
            for (int j = 0; j < 4; ++j) { const f32x4 g = gfin[j]; __builtin_nontemporal_store((f32x4){v[j].x * rstd * g.x, v[j].y * rstd * g.y, v[j].z * rstd * g.z, v[j].w * rstd * g.w}, xw + 64 * j); } }
    }
}

constexpr int N_PHASES = 12;
struct Args { In in; float* out; unsigned char* ws; float* fin_dst; int ph_lo, ph_hi, li, pad; };
__global__ void __launch_bounds__(NWAVES * 64, 2) mk_fwd(Args args) {
    extern __shared__ __attribute__((aligned(16))) unsigned char lds[];
    Frame F;
    F.lds = (LAS unsigned char*)lds;
    F.MISC = (volatile LAS unsigned*)(F.lds + MISC_OFF);
    F.tid = threadIdx.x; F.lane = F.tid & 63; F.wave = __builtin_amdgcn_readfirstlane(F.tid >> 6);
    F.G = gridDim.x; { const int bx = blockIdx.x; F.vcu = (F.G % 8 == 0) ? (bx % 8) * (F.G / 8) + bx / 8 : bx; }
    F.ws = args.ws; F.out = args.out; F.ctl = (unsigned*)(args.ws + WS_CTL); F.in = nullptr;
    const In& I = args.in;
    for (int u = F.tid; u < 256; u += NWAVES * 64) F.MISC[u] = 0u;
    __syncthreads();
    const int lo = args.ph_lo, hi = args.ph_hi;
    XcdBarrier bar; bar.bar = F.ctl + CW_BAR + args.li * XCD_BAR_WORDS; bar.x = 0; bar.st = nullptr;
    if (hi - lo > 1) bar = xcd_barrier_post(F.ctl + CW_BAR + args.li * XCD_BAR_WORDS, F.MISC + 8);
#ifndef PH_MASK
#define PH_MASK 0xFFF
#endif
#define IN(k) (((PH_MASK >> (k)) & 1) && lo <= (k) && (k) < hi)
#define SEAM(k) do { if (IN(k) && IN(NEXT_PH(k))) xcd_barrier(bar); } while (0)
#define NEXT_PH(k) ((k) == 2 ? 5 : (k) == 5 ? 7 : (k) + 1)
    const int cblk = (int)blockIdx.x;
    LAS unsigned char* ring = F.lds;

    if (IN(0)) { p0_prologue(F, I); SEAM(0); }

    if (IN(1)) {
        DenseOrder S; S.init(F.ws + WS_H, F.ws + WS_WIN, D, D, T, NIN, F.G, cblk);
        EpiInProj E{(bf16*)(F.ws + WS_AG), (bf16*)(F.ws + WS_XL), (bf16*)(F.ws + WS_GL), (bf16*)(F.ws + WS_GA), (bf16*)(F.ws + WS_GB)};
        pg8::gemm_phase<EpiInProj, DenseOrder, true>(ring, D, D, S, E);
        SEAM(1);
    }
    if (IN(2)) {
        if (cblk < 256) {
            const int L = cblk, wgid = (L % 8) * 32 + L / 8, g = wgid >> 3, mt = wgid & 7;
            { S5One S{(const char*)(F.ws + WS_AG) + S5Q * 2, (const char*)(F.ws + WS_BTW), (size_t)S5N * S5K * 2, (size_t)128 * 256 * 2, S5K, g, mt};
              EpiS5State E{(float*)(F.ws + WS_SLOC)};
              pg8::gemm_phase<EpiS5State, S5One, false>(ring, 256, 256, S, E); }
            if (F.wave == 0) { __builtin_amdgcn_fence(__ATOMIC_ACQUIRE, "agent"); VM_WAIT(); }
            __syncthreads();
            s5_chain(F, mt, g);
            VM_WAIT();
            __syncthreads();
            if (F.wave == 0) { __builtin_amdgcn_fence(__ATOMIC_ACQUIRE, "agent"); VM_WAIT(); }
            __syncthreads();
            { S5One S{(const char*)(F.ws + WS_AG), (const char*)(F.ws + WS_BTT), (size_t)S5N * S5K * 2, (size_t)256 * S5K * 2, S5K, g, mt};
              EpiS5Out E{(bf16*)(F.ws + WS_GY)};
              pg8::gemm_phase<EpiS5Out, S5One, false>(ring, S5K, S5K, S, E); }
            __syncthreads();
        }
        lru_seq(F, I);
        SEAM(2);
    }
    if (IN(5)) {
        YaYbOrder S; S.d.init(nullptr, nullptr, D, D, T, D, F.G, cblk);
        S.GYb = (const char*)(F.ws + WS_GY); S.WS5b = (const char*)(F.ws + WS_WS5); S.YLb = (const char*)(F.ws + WS_H); S.WLb = (const char*)(F.ws + WS_WLRU);
        EpiYaYb E{EpiYa{(const bf16*)(F.ws + WS_GA), (bf16*)(F.ws + WS_XL)}, EpiYb{(const bf16*)(F.ws + WS_XL), (const bf16*)(F.ws + WS_GB), (bf16*)(F.ws + WS_GL)}};
        pg8::gemm_phase<EpiYaYb, YaYbOrder, true>(ring, D, D, S, E);
        SEAM(5);
    }
    if (IN(7)) {
        DenseOrder S; S.init(F.ws + WS_GL, F.ws + WS_WO, D, D, T, D, F.G, cblk);
        EpiQ8<false> E{(unsigned char*)(F.ws + WS_D8), (float*)(F.ws + WS_DSC), nullptr};
        pg8::gemm_phase<EpiQ8<false>, DenseOrder, true>(ring, D, D, S, E);
        SEAM(7);
    }
    if (IN(8)) { p8_router(F, I); __syncthreads(); expert_weight_copies(F, I); SEAM(8); }
    if (IN(9)) {
        moe_setup<0>(F);
        MoeOrder<true> S{(const char*)(F.ws + WS_H2), (const char*)(F.ws + WS_WGU), (size_t)1024 * 1024 * 2, D, D, F.G, F.vcu, F.MISC, (const LAS int*)(F.lds + TOKL_OFF)};
        EpiGU E{(bf16*)(F.ws + WS_ACT), (const LAS float*)(F.lds + SCLL_OFF)};
        pg8::gemm_phase<EpiGU, MoeOrder<true>, true>(ring, D, D, S, E);
        SEAM(9);
    }
    if (IN(10)) {
        moe_setup<1>(F);
        MoeOrder<false> S{(const char*)(F.ws + WS_ACT), (const char*)(F.ws + WS_WD), (size_t)1024 * DEXP * 2, DEXP, DEXP, F.G, F.vcu, F.MISC, (const LAS int*)(F.lds + TOKL_OFF)};
        EpiQ8<true> E{(unsigned char*)(F.ws + WS_YS), (float*)(F.ws + WS_YS + 80 * MiB), (const LAS float*)(F.lds + SCLL_OFF)};
        pg8::gemm_phase<EpiQ8<true>, MoeOrder<false>, true>(ring, DEXP, DEXP, S, E);
        SEAM(10);
    }
    if (IN(11)) { p11_final(F, I, args.fin_dst); }
#undef IN
#undef SEAM
}

extern "C" void kernel_launch(void* const* d_in, const int* in_sizes, int n_in, void* d_out, int out_size, void* d_ws, size_t ws_size, hipStream_t stream) {
    static int grid = 0;
    if (grid == 0) {
        if (n_in != 30 || in_sizes[0] != T * D || out_size != T * D || ws_size < WS_END) { fprintf(stderr, "kernel_launch: unexpected shapes / workspace (n_in %d, ws %zu)\n", n_in, ws_size); grid = -1; return; }
        int dev = 0, cus = 0, per_cu = 0;
        if (hipGetDevice(&dev) != hipSuccess || hipDeviceGetAttribute(&cus, hipDeviceAttributeMultiprocessorCount, dev) != hipSuccess) { grid = -1; return; }
        if (hipFuncSetAttribute((const void*)mk_fwd, hipFuncAttributeMaxDynamicSharedMemorySize, LDS_BYTES) != hipSuccess) { fprintf(stderr, "kernel_launch: hipFuncSetAttribute failed\n"); grid = -1; return; }
        if (hipOccupancyMaxActiveBlocksPerMultiprocessor(&per_cu, (const void*)mk_fwd, NWAVES * 64, LDS_BYTES) != hipSuccess || per_cu < 1) { fprintf(stderr, "kernel_launch: occupancy query says %d\n", per_cu); }
        (void)hipGetLastError();
        grid = cus;
    }
    if (grid < 0) return;
    if (hipMemsetAsync((char*)d_ws + WS_CTL, 0, CTL_ZERO_BYTES, stream) != hipSuccess) return;
    Args a{};
    for (int i = 0; i < 30; ++i) a.in.p[i] = (const float*)d_in[i];
    a.out = (float*)d_out; a.ws = (unsigned char*)d_ws; a.fin_dst = (float*)d_out;
#if defined(PROBE_LO)
    a.ph_lo = 0; a.ph_hi = PROBE_HI; a.li = 0;
#if PROBE_LO == 11
    a.fin_dst = (float*)((char*)d_ws + WS_H2);
#endif
    hipLaunchKernelGGL(mk_fwd, dim3(grid), dim3(NWAVES * 64), LDS_BYTES, stream, a);
#if PROBE_LO == 8
    hipMemsetAsync((char*)d_ws + WS_CTL + CW_CNT * 4, 0, 128, stream);
#endif
    a.fin_dst = (float*)d_out;
    a.ph_lo = PROBE_LO; a.ph_hi = N_PHASES; a.li = 1;
    hipLaunchKernelGGL(mk_fwd, dim3(grid), dim3(NWAVES * 64), LDS_BYTES, stream, a);
#elif MK_N_LAUNCHES == 1
    a.ph_lo = 0; a.ph_hi = N_PHASES;
    hipLaunchKernelGGL(mk_fwd, dim3(grid), dim3(NWAVES * 64), LDS_BYTES, stream, a);
#else
    for (int p = 0; p < N_PHASES; ++p) { a.ph_lo = p; a.ph_hi = p + 1; hipLaunchKernelGGL(mk_fwd, dim3(grid), dim3(NWAVES * 64), LDS_BYTES, stream, a); }
#endif
}
```

```cpp
#include <hip/hip_runtime.h>
#include <cstdio>
#include <cstdint>

#ifndef MK_N_LAUNCHES
#define MK_N_LAUNCHES 1
#endif

namespace pg8 {
#define PG8_LAS __attribute__((address_space(3)))
typedef unsigned short bf16_t;
typedef short bf16x8 __attribute__((ext_vector_type(8)));
typedef float f32x4 __attribute__((ext_vector_type(4)));
typedef unsigned u32x4 __attribute__((ext_vector_type(4)));
constexpr int BM = 256, BK = 64, HALF = 128, HTB = HALF * BK * 2  , STAGE_BYTES = 8 * HTB, NXCD = 8, WGM = 8;

__host__ __device__ __forceinline__ int lds_byte(int r, int c) { const int st = (r >> 4) * 2 + (c >> 5), rr = r & 15, cc = c & 31, ob = rr * 64 + cc * 2; return st * 1024 + (ob ^ (((ob >> 9) & 1) << 5)); }
__host__ __device__ __forceinline__ void stage_rc(int b, int& R, int& C) { const int st = b / 1024, sb = b % 1024, swz = sb ^ (((sb >> 9) & 1) << 5); R = (st >> 1) * 16 + swz / 64; C = (st & 1) * 32 + (swz % 64) / 2; }
__host__ __device__ __forceinline__ int perm32(int rho) { const int n = rho >> 4, i = rho & 15; return 8 * (i >> 2) + 4 * n + (i & 3); }

struct Unit { const char* A; const char* B; int pm, pn, aux, nt, kind; unsigned kA; };

__device__ __forceinline__ unsigned cvt_pk_bf16(float lo, float hi) { unsigned r; asm volatile("v_cvt_pk_bf16_f32 %0, %1, %2" : "=v"(r) : "v"(lo), "v"(hi)); return r; }

template <class Epi, class Sched, bool ALIGN_EPI>
__device__ __forceinline__ void gemm_phase(PG8_LAS unsigned char* lds, const int ldb, const int K, const Sched& S, const Epi& E, const size_t kstepA = (size_t)(BK * 2)) {
    const int tid = threadIdx.x, wid = __builtin_amdgcn_readfirstlane(tid >> 6), lane = tid & 63, wr = wid >> 2, wc = wid & 3, fr = lane & 15, fq = lane >> 4;
    int nt = K / BK; asm volatile("" : "+s"(nt));
    int Rr[2], Cc[2], Rbb[2]; unsigned voffB[4], vAc[4], vAn[4];
#pragma unroll
    for (int i = 0; i < 2; ++i) { int R, C; stage_rc(tid * 16 + i * 8192, R, C); Rr[i] = R; Cc[i] = C; const int Rb = Epi::PERM ? ((R & ~31) + perm32(R & 31)) : R; Rbb[i] = Rb;
        int Rb0 = Rb, Rb1 = HALF + Rb;
        if constexpr (Epi::B16) {
            const int w_ = R >> 5, nn_ = (R >> 4) & 1, ii_ = R & 15; Rb0 = 64 * w_ + 16 * (ii_ >> 2) + 4 * nn_ + (ii_ & 3); Rb1 = Rb0 + 8; }
        voffB[i] = (unsigned)(Rb0 * ldb + C) * 2u; voffB[2 + i] = (unsigned)(Rb1 * ldb + C) * 2u; }
    const size_t kstep = (size_t)(BK * 2);
    const unsigned ldsw = (unsigned)wid * 1024u;
    const int aoff = lds_byte(wr * 64 + fr, fq * 8), boff = lds_byte(wc * 32 + fr, fq * 8);
#define PG8_SA(b, h) (((b) * 2 + (h)) * HTB)
#define PG8_SB(b, h) ((4 + (b) * 2 + (h)) * HTB)
#define PG8_STAGE(bufoff, gbase, voff, h) do { _Pragma("unroll") for (int _i = 0; _i < 2; ++_i) \
        __builtin_amdgcn_global_load_lds((const unsigned*)((const char*)(gbase) + (voff)[2 * (h) + _i]), (PG8_LAS unsigned*)(lds + (bufoff) + ldsw + _i * 8192), 16, 0, 0); } while (0)
#define PG8_LDA(dst, b, h) do { _Pragma("unroll") for (int m = 0; m < 4; ++m) _Pragma("unroll") for (int k = 0; k < 2; ++k) dst[m][k] = *(const PG8_LAS bf16x8*)(lds + PG8_SA(b, h) + aoff + m * 2048 + k * 1024); } while (0)
#define PG8_LDB(dst, b, h) do { _Pragma("unroll") for (int n = 0; n < 2; ++n) _Pragma("unroll") for (int k = 0; k < 2; ++k) dst[n][k] = *(const PG8_LAS bf16x8*)(lds + PG8_SB(b, h) + boff + n * 2048 + k * 1024); } while (0)
#define PG8_MMA(ai, bj, At, Bt) do { __builtin_amdgcn_s_setprio(1); _Pragma("unroll") for (int m = 0; m < 4; ++m) _Pragma("unroll") for (int n = 0; n < 2; ++n) _Pragma("unroll") for (int k = 0; k < 2; ++k) \
        acc[ai][bj][m][n] = __builtin_amdgcn_mfma_f32_16x16x32_bf16(Bt[n][k], At[m][k], acc[ai][bj][m][n], 0, 0, 0); __builtin_amdgcn_s_setprio(0); } while (0)
#define PG8_WAIT_V(n) asm volatile("s_waitcnt vmcnt(" #n ")" ::: "memory")
#define PG8_WAIT_L(n) asm volatile("s_waitcnt lgkmcnt(" #n ")" ::: "memory")
#define PG8_BAR __builtin_amdgcn_s_barrier()
#define PG8_SCHED __builtin_amdgcn_sched_barrier(0)
    Unit cur, nxt; int ui = 0;
    if (!S.next(0, cur)) return;
    S.a_offsets(cur, Rr, Cc, vAc);
    unsigned vBc[4], vBn[4];
    if constexpr (Sched::HETERO) { S.b_offsets(cur, Rbb, Cc, vBc); nt = __builtin_amdgcn_readfirstlane(cur.nt); }
    else {
#pragma unroll
        for (int q = 0; q < 4; ++q) vBc[q] = voffB[q]; }
    size_t kAc = Sched::HETERO ? (size_t)(unsigned)__builtin_amdgcn_readfirstlane((int)cur.kA) : kstepA;
    f32x4 acc[2][2][4][2];
    if constexpr (Epi::ACC_INIT) E.init(acc, cur, wr, wc, fr, fq);
    else {
#pragma unroll
    for (int a = 0; a < 2; ++a)
#pragma unroll
        for (int b = 0; b < 2; ++b)
#pragma unroll
            for (int m = 0; m < 4; ++m)
#pragma unroll
                for (int n = 0; n < 2; ++n) acc[a][b][m][n] = (f32x4){0.f, 0.f, 0.f, 0.f}; }
    bf16x8 At[4][2], B0[2][2], B1[2][2];
    const char* cA = cur.A; const char* cB = cur.B;
    if constexpr (Sched::GATHER) { PG8_WAIT_L(0); }
    PG8_STAGE(PG8_SB(0, 0), cB, vBc, 0); PG8_STAGE(PG8_SB(0, 1), cB, vBc, 1); PG8_STAGE(PG8_SA(0, 0), cA, vAc, 0); PG8_STAGE(PG8_SA(0, 1), cA, vAc, 1);
    if (wr == 1) PG8_BAR;
    PG8_WAIT_V(2); PG8_BAR;
    PG8_STAGE(PG8_SB(1, 0), cB + kstep, vBc, 0); PG8_STAGE(PG8_SA(1, 0), cA + kAc, vAc, 0); PG8_STAGE(PG8_SB(1, 1), cB + kstep, vBc, 1);
    PG8_WAIT_V(6); PG8_BAR;
    for (;;) {
        const bool has_next = S.next(ui + 1, nxt);
        const char* nA = has_next ? nxt.A : cA; const char* nB = has_next ? nxt.B : cB;
        size_t kAn = kAc;
        if constexpr (Sched::HETERO) { if (has_next) { S.b_offsets(nxt, Rbb, Cc, vBn); kAn = (size_t)(unsigned)__builtin_amdgcn_readfirstlane((int)nxt.kA); } else {
#pragma unroll
                for (int q = 0; q < 4; ++q) vBn[q] = vBc[q]; } }
        for (int t = 0; t < nt; t += 2) {
            const bool last = (t == nt - 2);
            const char* a1 = cA + (size_t)(t + 1) * kAc;
            const char* a2 = last ? nA : cA + (size_t)(t + 2) * kAc; const char* b2 = last ? nB : cB + (size_t)(t + 2) * kstep;
            const char* a3 = a2 + (last ? kAn : kAc); const char* b3 = b2 + kstep;
            unsigned vb2[4];
#pragma unroll
            for (int q = 0; q < 4; ++q) vb2[q] = (Sched::HETERO && last) ? vBn[q] : vBc[q];
            unsigned va2[4];
            if constexpr (Sched::GATHER || Sched::HETERO) {
                if (last) { if (has_next) { S.a_offsets(nxt, Rr, Cc, vAn); if constexpr (Sched::GATHER) { PG8_WAIT_L(0); } } else {
#pragma unroll
                        for (int q = 0; q < 4; ++q) vAn[q] = vAc[q]; } }
#pragma unroll
                for (int q = 0; q < 4; ++q) va2[q] = last ? vAn[q] : vAc[q];
            } else {
#pragma unroll
                for (int q = 0; q < 4; ++q) va2[q] = vAc[q];
            }
            PG8_LDB(B0, 0, 0); PG8_LDB(B1, 0, 1); PG8_SCHED; PG8_LDA(At, 0, 0); PG8_STAGE(PG8_SA(1, 1), a1, vAc, 1);
            PG8_WAIT_V(8); PG8_WAIT_L(0); PG8_BAR; PG8_MMA(0, 0, At, B0); PG8_MMA(0, 1, At, B1); PG8_BAR; PG8_SCHED;
            const bool fin = last && !has_next;
            PG8_LDA(At, 0, 1);
            if (!fin) { PG8_STAGE(PG8_SB(0, 0), b2, vb2, 0); PG8_STAGE(PG8_SB(0, 1), b2, vb2, 1); PG8_STAGE(PG8_SA(0, 0), a2, va2, 0); PG8_WAIT_V(8); } else { PG8_WAIT_V(0); }
            PG8_WAIT_L(0); PG8_BAR; PG8_MMA(1, 0, At, B0); PG8_MMA(1, 1, At, B1); PG8_BAR; PG8_SCHED;
            PG8_LDB(B0, 1, 0); PG8_LDB(B1, 1, 1); PG8_SCHED; PG8_LDA(At, 1, 0);
            if (!fin) { PG8_STAGE(PG8_SA(0, 1), a2, va2, 1); PG8_WAIT_V(8); } else { PG8_WAIT_V(0); }
            PG8_WAIT_L(0); PG8_BAR; PG8_MMA(0, 0, At, B0); PG8_MMA(0, 1, At, B1); PG8_BAR; PG8_SCHED;
            PG8_LDA(At, 1, 1);
            if (!fin) { PG8_STAGE(PG8_SB(1, 0), b3, vb2, 0); PG8_STAGE(PG8_SB(1, 1), b3, vb2, 1); PG8_STAGE(PG8_SA(1, 0), a3, va2, 0); PG8_WAIT_V(8); } else { PG8_WAIT_V(0); }
            PG8_WAIT_L(0); PG8_BAR; PG8_MMA(1, 0, At, B0); PG8_MMA(1, 1, At, B1); PG8_BAR; PG8_SCHED;
        }
        if constexpr (ALIGN_EPI) { if (wr == 0) PG8_BAR; }
        E(acc, cur, wr, wc, fr, fq);
        if (!has_next) break;
        if constexpr (Epi::ACC_INIT) E.init(acc, nxt, wr, wc, fr, fq);
        else {
#pragma unroll
        for (int a = 0; a < 2; ++a)
#pragma unroll
            for (int b = 0; b < 2; ++b)
#pragma unroll
                for (int m = 0; m < 4; ++m)
#pragma unroll
                    for (int n = 0; n < 2; ++n) acc[a][b][m][n] = (f32x4){0.f, 0.f, 0.f, 0.f}; }
        cur = nxt; cA = nA; cB = nB; ++ui;
        if constexpr (Sched::GATHER || Sched::HETERO) {
#pragma unroll
            for (int q = 0; q < 4; ++q) vAc[q] = vAn[q]; }
        if constexpr (Sched::HETERO) {
#pragma unroll
            for (int q = 0; q < 4; ++q) vBc[q] = vBn[q];
            kAc = kAn; nt = __builtin_amdgcn_readfirstlane(cur.nt); }
        if constexpr (ALIGN_EPI) { if (wr == 1) PG8_BAR; }
    }
    PG8_WAIT_V(0);
    if constexpr (!ALIGN_EPI) { if (wr == 0) PG8_BAR; }
    PG8_BAR;
#undef PG8_SA
#undef PG8_SB
#undef PG8_STAGE
#undef PG8_LDA
#undef PG8_LDB
#undef PG8_MMA
#undef PG8_WAIT_V
#undef PG8_WAIT_L
#undef PG8_BAR
#undef PG8_SCHED
}
}

constexpr int NWAVES = 8;
constexpr int BATCH = 8, SEQ = 4096, D = 1024, T = BATCH * SEQ;
constexpr int S5W = 512, S5G = 32, S5C = 16, S5P = 64, S5Q = 128;
constexpr int S5LC = 16, S5NCH = SEQ / S5LC, S5N = BATCH * S5NCH;
constexpr int S5K = S5Q + S5LC * S5C;
constexpr int LRUW = 1024, LRUH = 16, LRUHD = 64, LRUCH = 64, LRUNCH = SEQ / LRUCH;
constexpr int NIN = S5W + 2 * LRUW + 2 * D;
constexpr int NEXP = 32, EPG = 8, NGRP = 4, DEXP = 512, NROUT = 48;
constexpr int MAXSLOT = 73728;
constexpr int MAXU = 8;
constexpr float RMS_EPS = 1e-6f;

constexpr size_t MiB = 1u << 20;
constexpr size_t WS_CTL = 0, CTL_ZERO_BYTES = 128 * 1024;
constexpr size_t WS_SMALL = 1 * MiB;
constexpr size_t SM_LAM16 = WS_SMALL + 0;
constexpr size_t SM_LRUC = WS_SMALL + 16384;
constexpr size_t SM_WRT = WS_SMALL + 32768;
constexpr size_t SM_RHI = WS_SMALL + 327680;
constexpr size_t SM_RLO = SM_RHI + 98304;
constexpr size_t SM_RSTD = WS_SMALL + 524288;
constexpr size_t WS_BTT = 2 * MiB;
constexpr size_t WS_BTW = 8 * MiB;
constexpr size_t WS_WIN = 11 * MiB;
constexpr size_t WS_WS5 = 20 * MiB;
constexpr size_t WS_WLRU = 22 * MiB;
constexpr size_t WS_WO = 24 * MiB;
constexpr size_t WS_LP = 26 * MiB, WS_LH = 28 * MiB, WS_LHIN = 30 * MiB;
constexpr size_t WS_AG = 32 * MiB;
constexpr size_t WS_SLOC = 80 * MiB;
constexpr size_t WS_H = 112 * MiB;
constexpr size_t WS_XL = 176 * MiB;
constexpr size_t WS_GL = 240 * MiB;
constexpr size_t WS_GA = 304 * MiB, WS_GB = 336 * MiB;
constexpr size_t WS_GY = 368 * MiB;
constexpr size_t WS_D8 = 336 * MiB, WS_DSC = 368 * MiB;
constexpr size_t WS_WGU = 400 * MiB;
constexpr size_t WS_WD = 464 * MiB;
constexpr size_t WS_H2 = 32 * MiB;
constexpr size_t WS_ACT = 96 * MiB;
constexpr size_t WS_YS = 168 * MiB;
constexpr size_t WS_LTOK = 312 * MiB, WS_LW = 316 * MiB;
constexpr size_t WS_TOKE = 320 * MiB, WS_TOKR = WS_TOKE + 262144;
constexpr size_t WS_END = 496 * MiB;
static_assert(WS_YS + (size_t)MAXSLOT * 1024 * 2 <= WS_LTOK && WS_ACT + (size_t)MAXSLOT * 512 * 2 <= WS_YS && WS_TOKR + 262144 <= WS_WGU && WS_GY + (size_t)T * 512 * 2 <= WS_WGU && WS_WD + (size_t)32 * 1024 * 512 * 2 <= WS_END, "d_ws map");
constexpr int CW_BAR = 4096;
constexpr int CW_CNT = 16384;

constexpr int RING_BYTES = 131072;
constexpr int TOKL_OFF = RING_BYTES, SCLL_OFF = TOKL_OFF + MAXU * 256 * 4, MISC_OFF = SCLL_OFF + MAXU * 256 * 4;
constexpr int LDS_BYTES = MISC_OFF + 1024;

#define GAS __attribute__((address_space(1)))
#define LAS __attribute__((address_space(3)))
typedef unsigned short bf16;
typedef unsigned v4u __attribute__((ext_vector_type(4)));
typedef unsigned v2u __attribute__((ext_vector_type(2)));
typedef float f32x4 __attribute__((ext_vector_type(4)));
typedef short bf16x8 __attribute__((ext_vector_type(8)));
#define LDS_WAIT() asm volatile("s_waitcnt lgkmcnt(0)" ::: "memory")
#define VM_WAIT() asm volatile("s_waitcnt vmcnt(0)" ::: "memory")
__device__ __forceinline__ unsigned pk2(float lo, float hi) { unsigned r; asm volatile("v_cvt_pk_bf16_f32 %0, %1, %2" : "=v"(r) : "v"(lo), "v"(hi)); return r; }
__device__ __forceinline__ unsigned f2bf(float f) { return pk2(f, 0.f) & 0xffffu; }
__device__ __forceinline__ float bf2f(unsigned h) { return __builtin_bit_cast(float, h << 16); }
__device__ __forceinline__ float bflo(unsigned w) { return __builtin_bit_cast(float, w << 16); }
__device__ __forceinline__ float bfhi(unsigned w) { return __builtin_bit_cast(float, w & 0xffff0000u); }
__device__ __forceinline__ float fsigmoid(float x) { return __builtin_amdgcn_rcpf(1.0f + __builtin_amdgcn_exp2f(-1.44269504f * x)); }
__device__ __forceinline__ float gelu_t(float x) { const float u = x * (0.7978845608f + 0.0356774081f * x * x); return x * __builtin_amdgcn_rcpf(1.0f + __builtin_amdgcn_exp2f(-2.88539008f * u)); }
__device__ __forceinline__ float wave_sum(float v) {
#pragma unroll
    for (int o = 1; o < 64; o <<= 1) v += __shfl_xor(v, o);
    return v;
}

#define XB_TMO      128
#define XB_XCNT(j)  (256  + 64 * (j))
#define XB_XSUB(j)  (1280 + 64 * (j))
#define XB_XGEN(j)  (2304 + 64 * (j))
#define XB_TOP      3328
#define XB_TOPGEN   3392
#define XCD_BAR_WORDS 3456
#define XB_SPIN_CAP (1u << 18)
__device__ __forceinline__ unsigned xb_ld(unsigned* p)              { return __hip_atomic_load(p, __ATOMIC_RELAXED, __HIP_MEMORY_SCOPE_AGENT); }
__device__ __forceinline__ unsigned xb_add(unsigned* p, unsigned v) { return __hip_atomic_fetch_add(p, v, __ATOMIC_RELAXED, __HIP_MEMORY_SCOPE_AGENT); }
__device__ __forceinline__ unsigned xb_xcc_id() { return (unsigned)__builtin_amdgcn_s_getreg((3 << 11) | 20) & 0xFu; }
#define XB_SPIN(cond, bar) do { unsigned _sp = 0; while (cond) { __builtin_amdgcn_s_sleep(1); \
    if ((++_sp & 255u) == 0u) { if (xb_ld(&(bar)[XB_TMO])) break; if (_sp > XB_SPIN_CAP) { atomicAdd(&(bar)[XB_TMO], 1u); break; } } } } while (0)
struct XcdBarrier { unsigned* bar; unsigned x; volatile LAS unsigned* st; };
__device__ __forceinline__ XcdBarrier xcd_barrier_post(unsigned* bar, volatile LAS unsigned* st) {
    XcdBarrier b; b.bar = bar; b.x = xb_xcc_id(); b.st = st;
    if (threadIdx.x == 0) (void)xb_add(&bar[XB_XCNT(b.x)], 1u);
    return b;
}
__device__ __forceinline__ void xcd_barrier_complete(unsigned* bar, unsigned x, unsigned& nloc, unsigned& nx) {
    const unsigned G = gridDim.x * gridDim.y * gridDim.z;
    unsigned sum, cnt, mine, sp = 0u;
    for (;;) {
        sum = 0u; cnt = 0u; mine = 0u;
#pragma unroll
        for (unsigned j = 0; j < 16; ++j) { const unsigned c = xb_ld(&bar[XB_XCNT(j)]); sum += c; cnt += (c > 0u) ? 1u : 0u; mine = (j == x) ? c : mine; }
        if (sum == G) break;
        __builtin_amdgcn_s_sleep(1);
        if ((++sp & 255u) == 0u) { if (xb_ld(&bar[XB_TMO])) break; if (sp > XB_SPIN_CAP) { atomicAdd(&bar[XB_TMO], 1u); break; } }
    }
    nloc = mine > 0u ? mine : 1u; nx = cnt > 0u ? cnt : 1u;
}
__device__ __forceinline__ void xcd_barrier(const XcdBarrier& b) {
    asm volatile("s_waitcnt vmcnt(0)" ::: "memory");
    __syncthreads();
    if (threadIdx.x == 0) {
        unsigned* bar = b.bar;
        __builtin_amdgcn_s_waitcnt(0);
        unsigned nloc = b.st[0], nx = b.st[1];
        if (nloc == 0u) { xcd_barrier_complete(bar, b.x, nloc, nx); b.st[0] = nloc; b.st[1] = nx; }
        const unsigned old = xb_add(&bar[XB_XSUB(b.x)], 1u);
        const unsigned gen = old / nloc;
        if (old + 1u == (gen + 1u) * nloc) {
            __builtin_amdgcn_fence(__ATOMIC_RELEASE, "agent");
            asm volatile("s_waitcnt vmcnt(0)" ::: "memory");
            const unsigned og = xb_add(&bar[XB_TOP], 1u);
            const unsigned tg = og / nx;
            if (og + 1u == (tg + 1u) * nx) xb_add(&bar[XB_TOPGEN], 1u);
            else XB_SPIN(xb_ld(&bar[XB_TOPGEN]) == tg, bar);
            __builtin_amdgcn_fence(__ATOMIC_ACQUIRE, "agent");
            xb_add(&bar[XB_XGEN(b.x)], 1u);
            asm volatile("s_waitcnt vmcnt(0)" ::: "memory");
        } else {
            XB_SPIN(xb_ld(&bar[XB_XGEN(b.x)]) == gen, bar);
            __builtin_amdgcn_fence(__ATOMIC_ACQUIRE, "agent");
            asm volatile("s_waitcnt vmcnt(0)" ::: "memory");
        }
    }
    __syncthreads();
}

struct Frame {
    LAS unsigned char* lds;
    volatile LAS unsigned* MISC;
    unsigned* ctl;
    int tid, lane, wave, vcu, G;
    const float* const* in;
    unsigned char* ws; float* out;
};

using pg8::Unit;
struct DenseOrder {
    static constexpr bool GATHER = false, HETERO = false;
    const char* A0; const char* B0; int lda, ldb, nM, nN, nwg, G, c;
    __device__ __forceinline__ void init(const void* A, const void* B, int lda_, int ldb_, int M, int N, int G_, int c_) { A0 = (const char*)A; B0 = (const char*)B; lda = lda_; ldb = ldb_; nM = M / 256; nN = N / 256; nwg = nM * nN; G = G_; c = c_; }
    __device__ __forceinline__ bool next(int i, Unit& u) const {
        const long L = (long)i * G + c; if (L >= nwg) return false;
        int wgid = (int)L; { const int q = nwg / 8, r = nwg % 8, xcd = wgid % 8, off = wgid / 8; wgid = (xcd < r ? xcd * (q + 1) : r * (q + 1) + (xcd - r) * q) + off; }
        const int nig = 8 * nN, gid = wgid / nig, fm = gid * 8, gsz = (nM - fm) < 8 ? (nM - fm) : 8;
        u.pm = fm + ((wgid % nig) % gsz); u.pn = (wgid % nig) / gsz; u.aux = 0;
        u.A = A0 + (size_t)u.pm * 256 * lda * 2; u.B = B0 + (size_t)u.pn * 256 * ldb * 2; return true;
    }
    __device__ __forceinline__ void a_offsets(const Unit&, const int (&R)[2], const int (&C)[2], unsigned (&v)[4]) const {
#pragma unroll
        for (int i = 0; i < 2; ++i) { v[i] = (unsigned)(R[i] * lda + C[i]) * 2u; v[2 + i] = (unsigned)((128 + R[i]) * lda + C[i]) * 2u; }
    }
};
struct S5One {
    static constexpr bool GATHER = false, HETERO = false;
    const char* A0; const char* B0; size_t sA, sB; int lda, g, mt;
    __device__ __forceinline__ bool next(int i, Unit& u) const {
        if (i > 0) return false;
        u.pm = mt; u.pn = 0; u.aux = g; u.A = A0 + (size_t)g * sA + (size_t)mt * 256 * lda * 2; u.B = B0 + (size_t)g * sB; return true;
    }
    __device__ __forceinline__ void a_offsets(const Unit&, const int (&R)[2], const int (&C)[2], unsigned (&v)[4]) const {
#pragma unroll
        for (int i = 0; i < 2; ++i) { v[i] = (unsigned)(R[i] * lda + C[i]) * 2u; v[2 + i] = (unsigned)((128 + R[i]) * lda + C[i]) * 2u; }
    }
};
struct GyOrder {
    static constexpr bool GATHER = false, HETERO = false;
    DenseOrder d;
    __device__ __forceinline__ bool next(int i, Unit& u) const { if (!d.next(i, u)) return false; u.A = d.A0 + (size_t)u.pm * 256 * 32; return true; }
    __device__ __forceinline__ void a_offsets(const Unit&, const int (&R)[2], const int (&C)[2], unsigned (&v)[4]) const {
#pragma unroll
        for (int i = 0; i < 2; ++i) { const unsigned o = (unsigned)(C[i] >> 4) * (unsigned)(T * 32) + (unsigned)(C[i] & 15) * 2u; v[i] = (unsigned)R[i] * 32u + o; v[2 + i] = (unsigned)(128 + R[i]) * 32u + o; }
    }
};
struct YaYbOrder {
    static constexpr bool GATHER = false, HETERO = true;
    DenseOrder d;
    const char* GYb; const char* WS5b; const char* YLb; const char* WLb;
    __device__ __forceinline__ bool next(int i, Unit& u) const {
        const int j = i / 3, r = i - 3 * j; Unit t;
        if (!d.next(j, t)) return false;
        u.pm = t.pm; u.aux = 0;
        if (r < 2) { u.kind = 0; u.pn = 2 * t.pn + r; u.nt = S5W / 64; u.kA = (unsigned)(4 * T * 32); u.A = GYb + (size_t)t.pm * 256 * 32; u.B = WS5b + (size_t)u.pn * 256 * S5W * 2; }
        else { u.kind = 1; u.pn = t.pn; u.nt = D / 64; u.kA = 128u; u.A = YLb + (size_t)t.pm * 256 * D * 2; u.B = WLb + (size_t)t.pn * 256 * D * 2; }
        return true;
    }
    __device__ __forceinline__ void a_offsets(const Unit& u, const int (&R)[2], const int (&C)[2], unsigned (&v)[4]) const {
#pragma unroll
        for (int i = 0; i < 2; ++i) {
            const unsigned og = (unsigned)(C[i] >> 4) * (unsigned)(T * 32) + (unsigned)(C[i] & 15) * 2u;
            const unsigned g0 = (unsigned)R[i] * 32u + og, g1 = (unsigned)(128 + R[i]) * 32u + og;
            const unsigned d0 = (unsigned)(R[i] * D + C[i]) * 2u, d1 = (unsigned)((128 + R[i]) * D + C[i]) * 2u;
            v[i] = u.kind ? d0 : g0; v[2 + i] = u.kind ? d1 : g1; }
    }
    __device__ __forceinline__ void b_offsets(const Unit& u, const int (&Rb)[2], const int (&C)[2], unsigned (&v)[4]) const {
        const int ldb = u.kind ? D : S5W;
#pragma unroll
        for (int i = 0; i < 2; ++i) { v[i] = (unsigned)(Rb[i] * ldb + C[i]) * 2u; v[2 + i] = (unsigned)((128 + Rb[i]) * ldb + C[i]) * 2u; }
    }
};
template <bool GATH> struct MoeOrder {
    static constexpr bool GATHER = GATH, HETERO = false;
    const char* A0; const char* B0; size_t sBe; int lda, ldb, G, c; volatile LAS unsigned* MISC; const LAS int* tokL;
    __device__ __forceinline__ bool next(int i, Unit& u) const {
        if (i >= (int)MISC[152]) return false;
        const int e = (int)MISC[136 + i], mtg = (int)MISC[96 + e] + (int)MISC[144 + i], L = i * G + c;
        u.pm = mtg; u.pn = L & 3; u.aux = i;
        u.A = GATH ? A0 : A0 + (size_t)mtg * 256 * lda * 2; u.B = B0 + (size_t)e * sBe + (size_t)u.pn * 256 * ldb * 2; return true;
    }
    __device__ __forceinline__ void a_offsets(const Unit& u, const int (&R)[2], const int (&C)[2], unsigned (&v)[4]) const {
#pragma unroll
        for (int i = 0; i < 2; ++i) {
            if constexpr (GATH) { v[i] = (unsigned)tokL[u.aux * 256 + R[i]] * (unsigned)(lda * 2) + (unsigned)C[i] * 2u; v[2 + i] = (unsigned)tokL[u.aux * 256 + 128 + R[i]] * (unsigned)(lda * 2) + (unsigned)C[i] * 2u; }
            else { v[i] = (unsigned)(R[i] * lda + C[i]) * 2u; v[2 + i] = (unsigned)((128 + R[i]) * lda + C[i]) * 2u; } }
    }
};

using pg8::cvt_pk_bf16;
template <int ACT> __device__ __forceinline__ float actf(float x) { if (ACT == 1) return gelu_t(x); if (ACT == 2) return fsigmoid(x); return x; }
__device__ __forceinline__ v4u pack8(const f32x4 a, const f32x4 b) { v4u w; w.x = cvt_pk_bf16(a[0], a[1]); w.y = cvt_pk_bf16(a[2], a[3]); w.z = cvt_pk_bf16(b[0], b[1]); w.w = cvt_pk_bf16(b[2], b[3]); return w; }

__device__ __forceinline__ void unpack_u8x8(const v2u w, float (&f)[8]) {
    const float k = 1.0f / 255.0f;
    f[0] = (float)(w.x & 0xffu) * k; f[1] = (float)((w.x >> 8) & 0xffu) * k; f[2] = (float)((w.x >> 16) & 0xffu) * k; f[3] = (float)(w.x >> 24) * k;
    f[4] = (float)(w.y & 0xffu) * k; f[5] = (float)((w.y >> 8) & 0xffu) * k; f[6] = (float)((w.y >> 16) & 0xffu) * k; f[7] = (float)(w.y >> 24) * k;
}
struct EpiInProj {
    static constexpr bool PERM = true, ACC_INIT = false, B16 = false;
    bf16 *AG, *XL, *GL, *GA, *GB;
    template <int MODE  > __device__ __forceinline__ void tile(const f32x4 (&acc)[2][2][4][2], const Unit& u, bf16* base, int colbase, bool s5, int wr, int wc, int fr, int fq) const {
#pragma unroll
        for (int ai = 0; ai < 2; ++ai)
#pragma unroll
            for (int m = 0; m < 4; ++m) { const int r = u.pm * 256 + ai * 128 + wr * 64 + m * 16 + fr;
#pragma unroll
                for (int bj = 0; bj < 2; ++bj) { const int cl = colbase + bj * 128 + wc * 32 + 8 * fq;
                    f32x4 v0 = acc[ai][bj][m][0], v1 = acc[ai][bj][m][1];
                    if (MODE == 2) {
                        unsigned q[8];
#pragma unroll
                        for (int j = 0; j < 4; ++j) { q[j] = (unsigned)(fsigmoid(v0[j]) * 255.0f + 0.5f); q[4 + j] = (unsigned)(fsigmoid(v1[j]) * 255.0f + 0.5f); }
                        v2u w8; w8.x = q[0] | (q[1] << 8) | (q[2] << 16) | (q[3] << 24); w8.y = q[4] | (q[5] << 8) | (q[6] << 16) | (q[7] << 24);
                        __builtin_nontemporal_store(w8, (v2u*)((unsigned char*)base + (size_t)r * 1024 + cl));
                    } else {
                        if (MODE == 1) {
#pragma unroll
                            for (int j = 0; j < 4; ++j) { v0[j] = gelu_t(v0[j]); v1[j] = gelu_t(v1[j]); } }
                        const v4u w = pack8(v0, v1);
                        const int g = cl >> 4, cp = cl & 15, b = r >> 12, l = r & 4095, n = b * S5NCH + (l >> 4), s = l & 15;
                        const size_t off = s5 ? ((size_t)(g * S5N + n) * S5K + S5Q + s * 16 + cp) : ((size_t)r * 1024 + cl);
                        __builtin_nontemporal_store(w, (v4u*)(base + off)); } }
                asm volatile("" ::: "memory"); }
    }
    __device__ __forceinline__ void operator()(const f32x4 (&acc)[2][2][4][2], const Unit& u, int wr, int wc, int fr, int fq) const {
        const int pn = u.pn, reg = pn < 2 ? 0 : ((pn - 2) >> 2) + 1;
        const int colbase = reg == 0 ? pn * 256 : ((pn - 2) & 3) * 256;
        if (reg < 2) tile<0>(acc, u, reg == 0 ? AG : XL, colbase, reg == 0, wr, wc, fr, fq);
        else if (reg == 2) tile<1>(acc, u, GL, colbase, false, wr, wc, fr, fq);
        else tile<2>(acc, u, reg == 3 ? GA : GB, colbase, false, wr, wc, fr, fq);
    }
};
struct EpiS5State {
    static constexpr bool PERM = false, ACC_INIT = false, B16 = false;
    float* SLOC;
    __device__ __forceinline__ void operator()(const f32x4 (&acc)[2][2][4][2], const Unit& u, int wr, int wc, int fr, int fq) const {
#pragma unroll
        for (int ai = 0; ai < 2; ++ai)
#pragma unroll
            for (int m = 0; m < 4; ++m) { const int nr = u.pm * 256 + ai * 128 + wr * 64 + m * 16 + fr; float* rowp = SLOC + (size_t)(u.aux * S5N + nr) * S5Q + wc * 32 + 4 * fq;
#pragma unroll
                for (int n = 0; n < 2; ++n) *(f32x4*)(rowp + n * 16) = acc[ai][0][m][n]; }
    }
};
struct EpiS5Out {
    static constexpr bool PERM = true, ACC_INIT = false, B16 = false;
    bf16* GY;
    __device__ __forceinline__ void operator()(const f32x4 (&acc)[2][2][4][2], const Unit& u, int wr, int wc, int fr, int fq) const {
#pragma unroll
        for (int ai = 0; ai < 2; ++ai)
#pragma unroll
            for (int m = 0; m < 4; ++m) { const int nr = u.pm * 256 + ai * 128 + wr * 64 + m * 16 + fr, b = nr >> 8, j16 = nr & 255;
#pragma unroll
                for (int bj = 0; bj < 2; ++bj) { const int cc = bj * 128 + wc * 32 + 8 * fq, t = cc >> 4, c0 = cc & 15;
                    f32x4 v0 = acc[ai][bj][m][0], v1 = acc[ai][bj][m][1];
#pragma unroll
                    for (int j = 0; j < 4; ++j) { v0[j] = gelu_t(v0[j]); v1[j] = gelu_t(v1[j]); }
                    *(v4u*)(GY + ((size_t)u.aux * T + (size_t)(b * SEQ + j16 * 16 + t)) * 16 + c0) = pack8(v0, v1); }
                asm volatile("" ::: "memory"); }
    }
};
struct EpiYa {
    static constexpr bool PERM = true, ACC_INIT = false, B16 = false;
    const bf16* GA; bf16* YA;
    __device__ __forceinline__ void operator()(const f32x4 (&acc)[2][2][4][2], const Unit& u, int wr, int wc, int fr, int fq) const {
        const size_t off0 = (size_t)(u.pm * 256 + wr * 64 + fr) * 1024 + u.pn * 128 + wc * 32 + 8 * fq;
        v2u gav[2][4];
#pragma unroll
        for (int ai = 0; ai < 2; ++ai)
#pragma unroll
            for (int m = 0; m < 4; ++m) gav[ai][m] = __builtin_nontemporal_load((const v2u*)((const unsigned char*)GA + off0 + (size_t)(ai * 128 + m * 16) * 1024));
        asm volatile("" ::: "memory");
#pragma unroll
        for (int ai = 0; ai < 2; ++ai)
#pragma unroll
            for (int m = 0; m < 4; ++m) { float gaf[8]; unpack_u8x8(gav[ai][m], gaf);
                f32x4 o0, o1;
#pragma unroll
                for (int j = 0; j < 4; ++j) { o0[j] = gaf[j] * acc[ai][0][m][0][j] * fsigmoid(acc[ai][1][m][0][j]); o1[j] = gaf[4 + j] * acc[ai][0][m][1][j] * fsigmoid(acc[ai][1][m][1][j]); }
                *(v4u*)(YA + off0 + (size_t)(ai * 128 + m * 16) * 1024) = pack8(o0, o1); }
    }
};
struct EpiYb {
    static constexpr bool PERM = true, ACC_INIT = false, B16 = false;
    const bf16* YA; const bf16* GB; bf16* MIX;
    __device__ __forceinline__ void operator()(const f32x4 (&acc)[2][2][4][2], const Unit& u, int wr, int wc, int fr, int fq) const {
        const size_t off0 = (size_t)(u.pm * 256 + wr * 64 + fr) * 1024 + u.pn * 256 + wc * 32 + 8 * fq;
        v4u ya[2][2][2]; v2u gb[2][2][2];
#define YB_LOAD(buf, grp) do { _Pragma("unroll") for (int mm = 0; mm < 2; ++mm) _Pragma("unroll") for (int bj = 0; bj < 2; ++bj) { \
            const size_t o = off0 + (size_t)(((grp) >> 1) * 128 + (2 * ((grp) & 1) + mm) * 16) * 1024 + bj * 128; ya[buf][mm][bj] = *(const v4u*)(YA + o); gb[buf][mm][bj] = __builtin_nontemporal_load((const v2u*)((const unsigned char*)GB + o)); } } while (0)
        YB_LOAD(0, 0);
#pragma unroll
        for (int grp = 0; grp < 4; ++grp) { const int buf = grp & 1, ai = grp >> 1;
            if (grp < 3) YB_LOAD(buf ^ 1, grp + 1);
            asm volatile("" ::: "memory");
#pragma unroll
            for (int mm = 0; mm < 2; ++mm) { const int m = 2 * (grp & 1) + mm;
#pragma unroll
                for (int bj = 0; bj < 2; ++bj) { const v4u y = ya[buf][mm][bj];
                    const float yaf[8] = {bflo(y.x), bfhi(y.x), bflo(y.y), bfhi(y.y), bflo(y.z), bfhi(y.z), bflo(y.w), bfhi(y.w)};
                    float gbf[8]; unpack_u8x8(gb[buf][mm][bj], gbf);
                    f32x4 o0, o1;
#pragma unroll
                    for (int j = 0; j < 4; ++j) { o0[j] = yaf[j] + gbf[j] * acc[ai][bj][m][0][j]; o1[j] = yaf[4 + j] + gbf[4 + j] * acc[ai][bj][m][1][j]; }
                    *(v4u*)(MIX + off0 + (size_t)(ai * 128 + m * 16) * 1024 + bj * 128) = pack8(o0, o1); } }
        }
#undef YB_LOAD
    }
};
struct EpiYaYb {
    static constexpr bool PERM = true, ACC_INIT = false, B16 = false;
    EpiYa a; EpiYb b;
    __device__ __forceinline__ void operator()(const f32x4 (&acc)[2][2][4][2], const Unit& u, int wr, int wc, int fr, int fq) const {
        if (__builtin_amdgcn_readfirstlane(u.kind) == 0) a(acc, u, wr, wc, fr, fq); else b(acc, u, wr, wc, fr, fq);
    }
};
struct EpiWo {
    static constexpr bool PERM = false, ACC_INIT = true, B16 = false;
    const float* X; float* O;
    __device__ __forceinline__ void init(f32x4 (&acc)[2][2][4][2], const Unit& u, int wr, int wc, int fr, int fq) const {
        const size_t off0 = (size_t)(u.pm * 256 + wr * 64 + fr) * 1024 + u.pn * 256 + wc * 32 + 4 * fq;
#pragma unroll
        for (int ai = 0; ai < 2; ++ai)
#pragma unroll
            for (int m = 0; m < 4; ++m)
#pragma unroll
                for (int bj = 0; bj < 2; ++bj)
#pragma unroll
                    for (int n = 0; n < 2; ++n) acc[ai][bj][m][n] = __builtin_nontemporal_load((const f32x4*)(X + off0 + (size_t)(ai * 128 + m * 16) * 1024 + bj * 128 + n * 16));
    }
    __device__ __forceinline__ void operator()(const f32x4 (&acc)[2][2][4][2], const Unit& u, int wr, int wc, int fr, int fq) const {
        const size_t off0 = (size_t)(u.pm * 256 + wr * 64 + fr) * 1024 + u.pn * 256 + wc * 32 + 4 * fq;
#pragma unroll
        for (int ai = 0; ai < 2; ++ai)
#pragma unroll
            for (int m = 0; m < 4; ++m)
#pragma unroll
                for (int bj = 0; bj < 2; ++bj)
#pragma unroll
                    for (int n = 0; n < 2; ++n) *(f32x4*)(O + off0 + (size_t)(ai * 128 + m * 16) * 1024 + bj * 128 + n * 16) = acc[ai][bj][m][n];
    }
};
struct EpiGU {
    static constexpr bool PERM = true, ACC_INIT = false, B16 = false;
    bf16* ACT; const LAS float* sclL;
    __device__ __forceinline__ void operator()(const f32x4 (&acc)[2][2][4][2], const Unit& u, int wr, int wc, int fr, int fq) const {
#pragma unroll
        for (int ai = 0; ai < 2; ++ai)
#pragma unroll
            for (int m = 0; m < 4; ++m) { const int rl = ai * 128 + wr * 64 + m * 16 + fr; const float sc = sclL[u.aux * 256 + rl];
                f32x4 o0, o1;
#pragma unroll
                for (int j = 0; j < 4; ++j) { const float g0 = acc[ai][0][m][0][j] * sc, g1 = acc[ai][0][m][1][j] * sc;
                    o0[j] = g0 * fsigmoid(g0) * (acc[ai][1][m][0][j] * sc); o1[j] = g1 * fsigmoid(g1) * (acc[ai][1][m][1][j] * sc); }
                *(v4u*)(ACT + (size_t)(u.pm * 256 + rl) * DEXP + u.pn * 128 + wc * 32 + 8 * fq) = pack8(o0, o1); }
    }
};
struct EpiDown {
    static constexpr bool PERM = true, ACC_INIT = false, B16 = false;
    bf16* YS; const LAS float* sclL;
    __device__ __forceinline__ void operator()(const f32x4 (&acc)[2][2][4][2], const Unit& u, int wr, int wc, int fr, int fq) const {
#pragma unroll
        for (int ai = 0; ai < 2; ++ai)
#pragma unroll
            for (int m = 0; m < 4; ++m) { const int rl = ai * 128 + wr * 64 + m * 16 + fr; const float sc = sclL[u.aux * 256 + rl];
#pragma unroll
                for (int bj = 0; bj < 2; ++bj)
                    *(v4u*)(YS + (size_t)(u.pm * 256 + rl) * 1024 + u.pn * 256 + bj * 128 + wc * 32 + 8 * fq) = pack8(acc[ai][bj][m][0] * sc, acc[ai][bj][m][1] * sc); }
    }
};

template <bool SCALED> struct EpiQ8 {
    static constexpr bool PERM = true, ACC_INIT = false, B16 = true;
    unsigned char* YS8; float* YSC; const LAS float* sclL;
    __device__ __forceinline__ void operator()(const f32x4 (&acc)[2][2][4][2], const Unit& u, int wr, int wc, int fr, int fq) const {
        float scs[2][4];
#pragma unroll
        for (int ai = 0; ai < 2; ++ai)
#pragma unroll
            for (int m = 0; m < 4; ++m) { const int rl = ai * 128 + wr * 64 + m * 16 + fr; const float sc = SCALED ? sclL[u.aux * 256 + rl] : 1.0f;
                float v[16]; float amax = 0.f;
#pragma unroll
                for (int bj = 0; bj < 2; ++bj)
#pragma unroll
                    for (int n = 0; n < 2; ++n)
#pragma unroll
                        for (int j = 0; j < 4; ++j) { const float x = acc[ai][bj][m][n][j] * sc; v[bj * 8 + n * 4 + j] = x; amax = fmaxf(amax, fabsf(x)); }
                amax = fmaxf(amax, __shfl_xor(amax, 16)); amax = fmaxf(amax, __shfl_xor(amax, 32));
                const float inv = amax > 0.f ? 127.0f / amax : 0.f;
                scs[ai][m] = amax * (1.0f / 127.0f);
                v4u w;
#pragma unroll
                for (int d = 0; d < 4; ++d) { const int q0 = (int)__builtin_rintf(v[4 * d] * inv), q1 = (int)__builtin_rintf(v[4 * d + 1] * inv), q2 = (int)__builtin_rintf(v[4 * d + 2] * inv), q3 = (int)__builtin_rintf(v[4 * d + 3] * inv);
                    w[d] = ((unsigned)q0 & 255u) | (((unsigned)q1 & 255u) << 8) | (((unsigned)q2 & 255u) << 16) | ((unsigned)q3 << 24); }
                *(v4u*)(YS8 + (size_t)(u.pm * 256 + rl) * 1024 + u.pn * 256 + wc * 64 + fq * 16) = w; }
#pragma unroll
        for (int ai = 0; ai < 2; ++ai) { const float sv = fq == 0 ? scs[ai][0] : fq == 1 ? scs[ai][1] : fq == 2 ? scs[ai][2] : scs[ai][3];
            YSC[(size_t)(u.pm * 256 + ai * 128 + wr * 64 + fq * 16 + fr) * 16 + wc * 4 + u.pn] = sv; }
    }
};

struct TItem { const float* W; int N; bf16* WT; int ldk, k0, n0, drow0; };
__device__ __forceinline__ void transpose_load(const TItem& it, f32x4 (&tv)[8], int lane) {
#pragma unroll
    for (int i = 0; i < 8; ++i) tv[i] = __builtin_nontemporal_load((const f32x4*)(it.W + (size_t)(it.k0 + 8 * i + (lane >> 3)) * it.N + it.n0 + 4 * (lane & 7)));
}
template <bool NT = false> __device__ __forceinline__ void transpose_store(const TItem& it, const f32x4 (&tv)[8], LAS float* scr, int lane) {
#pragma unroll
    for (int i = 0; i < 8; ++i) { LAS float* d = scr + (8 * i + (lane >> 3)) * 33 + 4 * (lane & 7); d[0] = tv[i].x; d[1] = tv[i].y; d[2] = tv[i].z; d[3] = tv[i].w; }
    LDS_WAIT(); asm volatile("" ::: "memory");
    const int c = lane & 7;
#pragma unroll
    for (int j = 0; j < 4; ++j) { const int n = (lane >> 3) + 8 * j; const LAS float* s = scr + (8 * c) * 33 + n;
        v4u o; o.x = pk2(s[0 * 33], s[1 * 33]); o.y = pk2(s[2 * 33], s[3 * 33]); o.z = pk2(s[4 * 33], s[5 * 33]); o.w = pk2(s[6 * 33], s[7 * 33]);
        if (NT) __builtin_nontemporal_store(o, (v4u*)(it.WT + (size_t)(it.drow0 + n) * it.ldk + it.k0 + 8 * c)); else *(v4u*)(it.WT + (size_t)(it.drow0 + n) * it.ldk + it.k0 + 8 * c) = o; }
    LDS_WAIT(); asm volatile("" ::: "memory");
}
__device__ __forceinline__ int ileave_row(int n, int half) { return 256 * (n >> 7) + 128 * half + (n & 127); }

template <int NR> __device__ __forceinline__ void rms_rows_to_bf16(const float* x0, const float* gain, bf16* o0, size_t rstride, int lane) {
    f32x4 v[NR][4];
#pragma unroll
    for (int r = 0; r < NR; ++r) { const f32x4* xr = (const f32x4*)(x0 + r * rstride) + lane;
#pragma unroll
        for (int j = 0; j < 4; ++j) v[r][j] = __builtin_nontemporal_load(xr + 64 * j); }
    asm volatile("" ::: "memory");
    const f32x4* gr = (const f32x4*)gain + lane;
    f32x4 g[4];
#pragma unroll
    for (int j = 0; j < 4; ++j) g[j] = gr[64 * j];
#pragma unroll
    for (int r = 0; r < NR; ++r) { float s = 0.f;
#pragma unroll
        for (int j = 0; j < 4; ++j) s += (v[r][j].x * v[r][j].x + v[r][j].y * v[r][j].y) + (v[r][j].z * v[r][j].z + v[r][j].w * v[r][j].w);
        const float rstd = 1.0f / sqrtf(wave_sum(s) * (1.f / D) + RMS_EPS);
        unsigned long long* o8 = (unsigned long long*)(o0 + r * rstride) + lane;
#pragma unroll
        for (int j = 0; j < 4; ++j) o8[64 * j] = (unsigned long long)pk2(v[r][j].x * rstd * g[j].x, v[r][j].y * rstd * g[j].y) | ((unsigned long long)pk2(v[r][j].z * rstd * g[j].z, v[r][j].w * rstd * g[j].w) << 32); }
}

__device__ __forceinline__ void s5_tables(const Frame& F, int g, const float* lam_re, const float* lam_im, const float* log_dt, const float* b_re, const float* b_im, const float* c_re, const float* c_im, const float* dsk) {
    LAS float* Cre = (LAS float*)F.lds;
    LAS float* Cim = Cre + 1024;
    LAS float* Bre = Cim + 1024;
    LAS float* Bim = Bre + 1024;
    LAS float* Pre = Bim + 1024;
    LAS float* Pim = Pre + 17 * 64;
    LAS float* Kt = Pim + 17 * 64;
    const int tid = F.tid;
    for (int i = tid; i < 1024; i += 512) { Cre[i] = c_re[g * 1024 + i]; Cim[i] = c_im[g * 1024 + i]; }
    if (tid < 64) {
        const int p = tid; const float lr = lam_re[g * 64 + p], li = lam_im[g * 64 + p], dt = expf(log_dt[g]);
        const float er = expf(lr * dt), lbr = er * cosf(li * dt), lbi = er * sinf(li * dt);
        const float den = lr * lr + li * li, nr = lbr - 1.0f, ni = lbi;
        const float cr = (nr * lr + ni * li) / den, ci = (ni * lr - nr * li) / den;
        { float pr = 1.f, pi = 0.f; for (int k = 0; k <= 16; ++k) { Pre[k * 64 + p] = pr; Pim[k * 64 + p] = pi; const float nr2 = pr * lbr - pi * lbi, ni2 = pr * lbi + pi * lbr; pr = nr2; pi = ni2; } }
        for (int c = 0; c < 16; ++c) { const float br = b_re[(g * 64 + p) * 16 + c], bi = b_im[(g * 64 + p) * 16 + c]; Bre[p * 16 + c] = cr * br - ci * bi; Bim[p * 16 + c] = cr * bi + ci * br; }
    }
    __syncthreads();
    for (int e = tid; e < 4096; e += 512) {
        const int k = e >> 8, c = (e >> 4) & 15, cp = e & 15; float s = 0.f;
        for (int p = 0; p < 64; ++p) { const float xr = Cre[c * 64 + p] * Pre[k * 64 + p] - Cim[c * 64 + p] * Pim[k * 64 + p], xi = Cre[c * 64 + p] * Pim[k * 64 + p] + Cim[c * 64 + p] * Pre[k * 64 + p];
            s += xr * Bre[p * 16 + cp] - xi * Bim[p * 16 + cp]; }
        if (k == 0 && c == cp) s += dsk[g * 16 + c];
        Kt[e] = s;
    }
    __syncthreads();
    unsigned* btt = (unsigned*)(F.ws + WS_BTT) + (size_t)g * 256 * (S5K / 2);
    for (int e = tid; e < 256 * (S5K / 2); e += 512) {
        const int row = e / (S5K / 2), cpair = e % (S5K / 2), t = row >> 4, c = row & 15, col = 2 * cpair; float v0, v1;
        if (col < S5Q) { const int p = col >> 1; const float xr = Cre[c * 64 + p] * Pre[(t + 1) * 64 + p] - Cim[c * 64 + p] * Pim[(t + 1) * 64 + p], xi = Cre[c * 64 + p] * Pim[(t + 1) * 64 + p] + Cim[c * 64 + p] * Pre[(t + 1) * 64 + p];
            v0 = xr; v1 = -xi; }
        else { const int s = (col - S5Q) >> 4, cp = (col - S5Q) & 15;
            if (s <= t) { v0 = Kt[(t - s) * 256 + c * 16 + cp]; v1 = Kt[(t - s) * 256 + c * 16 + cp + 1]; } else { v0 = 0.f; v1 = 0.f; } }
        btt[e] = pk2(v0, v1);
    }
    unsigned* btw = (unsigned*)(F.ws + WS_BTW) + (size_t)g * 128 * 128;
    for (int e = tid; e < 128 * 128; e += 512) {
        const int q = e >> 7, cpair = e & 127, col = 2 * cpair, s = col >> 4, cp = col & 15, p = q >> 1, k = 15 - s;
        const float pr = Pre[k * 64 + p], pi = Pim[k * 64 + p];
        float v0, v1;
        if (q & 1) { v0 = pr * Bim[p * 16 + cp] + pi * Bre[p * 16 + cp]; v1 = pr * Bim[p * 16 + cp + 1] + pi * Bre[p * 16 + cp + 1]; }
        else { v0 = pr * Bre[p * 16 + cp] - pi * Bim[p * 16 + cp]; v1 = pr * Bre[p * 16 + cp + 1] - pi * Bim[p * 16 + cp + 1]; }
        btw[e] = pk2(v0, v1);
    }
    if (tid < 64) { float* l16 = (float*)(F.ws + SM_LAM16) + (g * 64 + tid) * 2; l16[0] = Pre[16 * 64 + tid]; l16[1] = Pim[16 * 64 + tid]; }
    __syncthreads();
}

struct In { const float* p[30]; };

__device__ __forceinline__ void p0_prologue(const Frame& F, const In& I) {
    for (int g = F.vcu; g < S5G; g += F.G) s5_tables(F, g, I.p[3], I.p[4], I.p[5], I.p[6], I.p[7], I.p[8], I.p[9], I.p[10]);
    const int gt = F.vcu * 512 + F.tid, NGT = F.G * 512;
    { float* lc = (float*)(F.ws + SM_LRUC); for (int i = gt; i < LRUW; i += NGT) { const float lam = I.p[18][i]; lc[i] = -8.0f * log1pf(expf(-lam)) * 1.44269504f; } }
    { bf16* wrt = (bf16*)(F.ws + SM_WRT);
        for (int i = gt; i < 2 * 65536; i += NGT) { const int which = i >> 16, r = i & 65535, h = r >> 12, j = (r >> 6) & 63, k = r & 63; const float* src = which ? I.p[16] : I.p[14]; wrt[i] = (bf16)f2bf(src[(h * 64 + k) * 64 + j]); } }
    { bf16* rhi = (bf16*)(F.ws + SM_RHI); bf16* rlo = (bf16*)(F.ws + SM_RLO);
        for (int i = gt; i < NROUT * 1024; i += NGT) { const int n = i >> 10, k = i & 1023; float w = 0.f; if (n < 4) w = I.p[22][k * 4 + n]; else if (n < 36) w = I.p[24][k * 32 + (n - 4)];
            const unsigned h = f2bf(w); rhi[i] = (bf16)h; rlo[i] = (bf16)f2bf(w - bf2f(h)); } }
    LAS float* scr = (LAS float*)(F.lds + F.wave * 16384);
    const int gw = F.vcu * NWAVES + F.wave, NGW = F.G * NWAVES;
    constexpr int I_IN = (D / 64) * (NIN / 32), I_S5 = (S5W / 64) * (2 * D / 32), I_LRU = (D / 64) * (D / 32), I_O = I_LRU;
    constexpr int NITEMS = I_IN + I_S5 + I_LRU + I_O;
    for (int it = gw; it < NITEMS; it += NGW) {
        int r = it; TItem ti;
        if (r < I_IN) { const int nb = NIN / 32, kb = r / nb, n0 = 32 * (r % nb); ti = TItem{I.p[2], NIN, (bf16*)(F.ws + WS_WIN), D, 64 * kb, n0, n0}; }
        else if ((r -= I_IN) < I_S5) { const int nb = 2 * D / 32, kb = r / nb, n0 = 32 * (r % nb); ti = TItem{I.p[11], 2 * D, (bf16*)(F.ws + WS_WS5), S5W, 64 * kb, n0, n0 < D ? ileave_row(n0, 0) : ileave_row(n0 - D, 1)}; }
        else if ((r -= I_S5) < I_LRU) { const int nb = D / 32, kb = r / nb, n0 = 32 * (r % nb); ti = TItem{I.p[19], D, (bf16*)(F.ws + WS_WLRU), D, 64 * kb, n0, n0}; }
        else { r -= I_LRU; const int nb = D / 32, kb = r / nb, n0 = 32 * (r % nb); ti = TItem{I.p[20], D, (bf16*)(F.ws + WS_WO), D, 64 * kb, n0, n0}; }
        f32x4 tv[8]; transpose_load(ti, tv, F.lane); asm volatile("" ::: "memory"); transpose_store(ti, tv, scr, F.lane);
    }
    { const int skip = F.G > 2 * S5G ? S5G : 0;
      if (F.vcu >= skip) { const int gw2 = (F.vcu - skip) * NWAVES + F.wave, NGW2 = (F.G - skip) * NWAVES;
        for (int m = gw2 * 4; m < T; m += NGW2 * 4) rms_rows_to_bf16<4>(I.p[0] + (size_t)m * D, I.p[1], (bf16*)(F.ws + WS_H) + (size_t)m * D, D, F.lane); } }
}
__device__ __forceinline__ TItem expert_item(const Frame& F, const In& I, int it) {
    constexpr int I_G = (D / 64) * (DEXP / 32), I_D = (DEXP / 64) * (D / 32);
    const int e = it / (2 * I_G + I_D); int r = it % (2 * I_G + I_D);
    if (r < 2 * I_G) { const int half = r / I_G; r %= I_G; const int nb = DEXP / 32, kb = r / nb, n0 = 32 * (r % nb);
        return TItem{(half ? I.p[27] : I.p[26]) + (size_t)e * D * DEXP, DEXP, (bf16*)(F.ws + WS_WGU) + (size_t)e * 1024 * 1024, D, 64 * kb, n0, ileave_row(n0, half)}; }
    r -= 2 * I_G; const int nb = D / 32, kb = r / nb, n0 = 32 * (r % nb);
    return TItem{I.p[28] + (size_t)e * DEXP * D, D, (bf16*)(F.ws + WS_WD) + (size_t)e * 1024 * DEXP, DEXP, 64 * kb, n0, n0};
}
__device__ __forceinline__ void expert_weight_copies(const Frame& F, const In& I) {
    LAS float* scr = (LAS float*)(F.lds + F.wave * 16384);
    const int gw = F.vcu * NWAVES + F.wave, NGW = F.G * NWAVES;
    constexpr int NIT = NEXP * 768;
    const int first = 8 * NGW < NIT ? 8 * NGW : NIT;
    for (int it = first + gw; it < NIT; it += 2 * NGW) {
        const TItem t0 = expert_item(F, I, it); const bool has1 = it + NGW < NIT; const TItem t1 = expert_item(F, I, has1 ? it + NGW : it);
        f32x4 v0[8], v1[8]; transpose_load(t0, v0, F.lane); transpose_load(t1, v1, F.lane); asm volatile("" ::: "memory");
        transpose_store(t0, v0, scr, F.lane); if (has1) transpose_store(t1, v1, scr, F.lane);
    }
}

__device__ __forceinline__ void lru_seq(const Frame& F, const In& I) {
    LAS unsigned char* wl = F.lds + F.wave * 17920;
    LAS bf16* xcA = (LAS bf16*)wl;
    LAS float* pre = (LAS float*)(wl + 9216);
    typedef float f32x2 __attribute__((ext_vector_type(2)));
    LAS f32x2* sumT = (LAS f32x2*)(F.lds + 143360);
    const int lane = F.lane, jj = lane & 15, ks = lane >> 4, c32 = lane & 31, th = lane >> 5;
    const bf16* XL = (const bf16*)(F.ws + WS_XL); const bf16* GL = (const bf16*)(F.ws + WS_GL); bf16* YL = (bf16*)(F.ws + WS_H);
    const bf16* WRT = (const bf16*)(F.ws + SM_WRT);
    for (int un = F.vcu; un < BATCH * LRUH * 2; un += F.G) {
        const int b = un >> 5, hd = (un >> 1) & 15, half = un & 1;
        const int chin = hd * 64 + lane;
        const int chg = hd * 64 + 32 * half + c32;
        const float w0 = I.p[12][chin], w1 = I.p[12][1024 + chin], w2 = I.p[12][2048 + chin], w3 = I.p[12][3072 + chin], cb = I.p[13][chin];
        const float brs = I.p[15][chg] * -1.44269504f, bis = I.p[17][chg] * -1.44269504f, cch2 = ((const float*)(F.ws + SM_LRUC))[chg];
        bf16x8 Bw[4][2];
#pragma unroll
        for (int n = 0; n < 4; ++n)
#pragma unroll
            for (int k = 0; k < 2; ++k) Bw[n][k] = *(const bf16x8*)(WRT + (size_t)(n >> 1) * 65536 + (size_t)(hd * 64 + 32 * half + 16 * (n & 1) + jj) * 64 + 32 * k + 8 * ks);
        float Rc = 0.f;
        for (int rd = 0; rd < 8; ++rd) {
            const int j = rd * 8 + F.wave;
            const size_t tok0 = (size_t)b * SEQ + (size_t)j * LRUCH;
            unsigned short xr[64], xh[3];
            { const bf16* xp = XL + tok0 * 1024 + chin;
              xh[0] = 0; xh[1] = 0; xh[2] = 0;
              if (j > 0) { xh[0] = xp[-3 * 1024]; xh[1] = xp[-2 * 1024]; xh[2] = xp[-1 * 1024]; }
#pragma unroll
              for (int t = 0; t < 64; ++t) xr[t] = xp[t * 1024]; }
            asm volatile("" ::: "memory");
            { typedef float f2v __attribute__((ext_vector_type(2)));
              float xm3 = bf2f(xh[0]), xm2 = bf2f(xh[1]), xm1 = bf2f(xh[2]);
              const f2v vw0 = {w0, w0}, vw1 = {w1, w1}, vw2 = {w2, w2}, vw3 = {w3, w3}, vcb = {cb, cb};
#pragma unroll
              for (int t = 0; t < 64; t += 2) { const float x0 = bf2f(xr[t]), x1 = bf2f(xr[t + 1]);
                  f2v xc = vcb + vw0 * (f2v){xm3, xm2}; xc = xc + vw1 * (f2v){xm2, xm1}; xc = xc + vw2 * (f2v){xm1, x0}; xc = xc + vw3 * (f2v){x0, x1};
                  const unsigned pk = pg8::cvt_pk_bf16(xc.x, xc.y);
                  xcA[t * 72 + lane] = (bf16)(pk & 0xffffu); xcA[(t + 1) * 72 + lane] = (bf16)(pk >> 16);
                  xm3 = xm1; xm2 = x0; xm1 = x1; } }
            LDS_WAIT();
            float hl[2][16], Pl[2][16], Prun[2], Hrun[2];
#pragma unroll
            for (int st = 0; st < 2; ++st) {
#pragma unroll
                for (int mh = 0; mh < 2; ++mh) { const int mt = 2 * st + mh;
                    bf16x8 a[2];
#pragma unroll
                    for (int k = 0; k < 2; ++k) a[k] = *(const LAS bf16x8*)(xcA + (16 * mt + jj) * 72 + 32 * k + 8 * ks);
#pragma unroll
                    for (int n = 0; n < 4; ++n) { f32x4 d = (f32x4){0.f, 0.f, 0.f, 0.f};
#pragma unroll
                        for (int k = 0; k < 2; ++k) d = __builtin_amdgcn_mfma_f32_16x16x32_bf16(a[k], Bw[n][k], d, 0, 0, 0);
#pragma unroll
                        for (int r = 0; r < 4; ++r) pre[(16 * mh + 4 * ks + r) * 68 + 16 * n + jj] = d[r]; } }
                LDS_WAIT();
                float h = 0.f, P = 1.f;
                typedef float f2v __attribute__((ext_vector_type(2)));
#pragma unroll
                for (int tl = 0; tl < 16; tl += 2) {
                    const int trow = 16 * th + tl;
                    const f2v pr = {pre[trow * 68 + c32], pre[(trow + 1) * 68 + c32]}, pi = {pre[trow * 68 + 32 + c32], pre[(trow + 1) * 68 + 32 + c32]};
                    const f2v zr = pr * (f2v){-1.44269504f, -1.44269504f} + (f2v){brs, brs}, zi = pi * (f2v){-1.44269504f, -1.44269504f} + (f2v){bis, bis};
                    const f2v er = {__builtin_amdgcn_exp2f(zr.x), __builtin_amdgcn_exp2f(zr.y)}, ei = {__builtin_amdgcn_exp2f(zi.x), __builtin_amdgcn_exp2f(zi.y)};
                    const f2v dr = er + (f2v){1.f, 1.f};
                    const f2v rg = {__builtin_amdgcn_rcpf(dr.x), __builtin_amdgcn_rcpf(dr.y)};
                    const f2v la2 = rg * (f2v){cch2, cch2};
                    const f2v a_ = {__builtin_amdgcn_exp2f(la2.x), __builtin_amdgcn_exp2f(la2.y)};
                    const f2v x2 = la2 * (f2v){1.38629436f, 1.38629436f};
                    f2v q = x2 * (f2v){0.0013888889f, 0.0013888889f} + (f2v){0.0083333333f, 0.0083333333f};
                    q = q * x2 + (f2v){0.041666667f, 0.041666667f}; q = q * x2 + (f2v){0.16666667f, 0.16666667f}; q = q * x2 + (f2v){0.5f, 0.5f}; q = q * x2 + (f2v){1.f, 1.f};
                    f2v om = -(q * x2);
                    const f2v alt = (f2v){1.f, 1.f} - a_ * a_;
                    om.x = x2.x > -0.3f ? om.x : alt.x; om.y = x2.y > -0.3f ? om.y : alt.y;
                    om.x = fmaxf(om.x, 1e-30f); om.y = fmaxf(om.y, 1e-30f);
                    const f2v dd = ei + (f2v){1.f, 1.f};
                    const f2v rq = om * dd * dd;
                    const f2v mi = om * (f2v){__builtin_amdgcn_rsqf(rq.x), __builtin_amdgcn_rsqf(rq.y)};
                    const f2v bx = mi * (f2v){bf2f(xcA[(32 * st + trow) * 72 + 32 * half + c32]), bf2f(xcA[(32 * st + trow + 1) * 72 + 32 * half + c32])};
                    h = a_.x * h + bx.x; P *= a_.x; hl[st][tl] = h; Pl[st][tl] = P;
                    h = a_.y * h + bx.y; P *= a_.y; hl[st][tl + 1] = h; Pl[st][tl + 1] = P;
                }
                Prun[st] = P; Hrun[st] = h;
                LDS_WAIT();
            }
            const float pP0 = __shfl_xor(Prun[0], 32), pH0 = __shfl_xor(Hrun[0], 32), pP1 = __shfl_xor(Prun[1], 32), pH1 = __shfl_xor(Hrun[1], 32);
            const float P0 = th ? pP0 : Prun[0], H0 = th ? pH0 : Hrun[0], P1 = th ? Prun[0] : pP0, H1 = th ? Hrun[0] : pH0;
            const float P2 = th ? pP1 : Prun[1], H2 = th ? pH1 : Hrun[1], P3 = th ? Prun[1] : pP1, H3 = th ? Hrun[1] : pH1;
            const float C1 = H0, Q1 = P0, C2 = P1 * C1 + H1, Q2 = P1 * Q1, C3 = P2 * C2 + H2, Q3 = P2 * Q2, Hc = P3 * C3 + H3, Pc = P3 * Q3;
            const float Cs0 = th ? C1 : 0.f, Qs0 = th ? Q1 : 1.f, Cs1 = th ? C3 : C2, Qs1 = th ? Q3 : Q2;
            const int cit = (rd * F.G + F.vcu) * NWAVES + F.wave; const bool cdo = cit < NEXP * 768;
            f32x4 ctv[8]; unsigned short ggr[2][16];
            if (cdo) { const TItem citem = expert_item(F, I, cit); transpose_load(citem, ctv, lane); }
#pragma unroll
            for (int st = 0; st < 2; ++st)
#pragma unroll
                for (int tl = 0; tl < 16; ++tl) ggr[st][tl] = GL[(tok0 + 32 * st + 16 * th + tl) * 1024 + chg];
            asm volatile("" ::: "memory");
            if (th == 0) sumT[((rd & 1) * 8 + F.wave) * 32 + c32] = (f32x2){Pc, Hc};
            LDS_WAIT();
            __syncthreads();
            float cin = Rc, mycin = 0.f;
#pragma unroll
            for (int w = 0; w < 8; ++w) { const f32x2 ph = sumT[((rd & 1) * 8 + w) * 32 + c32]; mycin = (w == F.wave) ? cin : mycin; cin = ph.x * cin + ph.y; }
            Rc = cin;
#pragma unroll
            for (int st = 0; st < 2; ++st) { const float hin = (st ? Cs1 : Cs0) + (st ? Qs1 : Qs0) * mycin;
#pragma unroll
                for (int tl = 0; tl < 16; ++tl) { const float hh = hl[st][tl] + Pl[st][tl] * hin;
                    YL[(tok0 + 32 * st + 16 * th + tl) * 1024 + chg] = (bf16)f2bf(hh * bf2f(ggr[st][tl])); } }
            if (cdo) { const TItem citem = expert_item(F, I, cit); transpose_store<true>(citem, ctv, pre, lane); }
        }
        __syncthreads();
    }
}

__device__ __forceinline__ void s5_chain(const Frame& F, int b, int g) {
    typedef float f32x2 __attribute__((ext_vector_type(2)));
    LAS f32x2* segE = (LAS f32x2*)(F.lds);
    const int lane = F.lane, w = F.wave;
    const float* SLOC = (const float*)(F.ws + WS_SLOC); unsigned* AGw = (unsigned*)(F.ws + WS_AG); const float* L16 = (const float*)(F.ws + SM_LAM16);
    const float lr = L16[(g * 64 + lane) * 2], li = L16[(g * 64 + lane) * 2 + 1];
    const float* sl = SLOC + ((size_t)(g * S5N + b * S5NCH + 32 * w)) * S5Q + 2 * lane;
    unsigned* ag = AGw + ((size_t)(g * S5N + b * S5NCH + 32 * w)) * (S5K / 2) + lane;
    float xr[32], xi[32];
#pragma unroll
    for (int u = 0; u < 32; ++u) { const float2 v = *(const float2*)(sl + (size_t)u * S5Q); xr[u] = v.x; xi[u] = v.y; }
    asm volatile("" ::: "memory");
    float sr = 0.f, si = 0.f;
#pragma unroll
    for (int u = 0; u < 32; ++u) { const float nr = lr * sr - li * si + xr[u], ni = lr * si + li * sr + xi[u]; xr[u] = sr; xi[u] = si; sr = nr; si = ni; }
    segE[w * 64 + lane] = (f32x2){sr, si};
    float qr = lr, qi = li;
#pragma unroll
    for (int k = 0; k < 5; ++k) { const float nr = qr * qr - qi * qi, ni = 2.f * qr * qi; qr = nr; qi = ni; }
    LDS_WAIT();
    __syncthreads();
    float cr = 0.f, ci = 0.f;
    for (int ww = 0; ww < w; ++ww) { const f32x2 e = segE[ww * 64 + lane]; const float nr = qr * cr - qi * ci + e.x, ni = qr * ci + qi * cr + e.y; cr = nr; ci = ni; }
#pragma unroll
    for (int u = 0; u < 32; ++u) { ag[(size_t)u * (S5K / 2)] = pk2(xr[u] + cr, xi[u] + ci); const float nr = lr * cr - li * ci, ni = lr * ci + li * cr; cr = nr; ci = ni; }
    __syncthreads();
}

__device__ __forceinline__ void p8_router(const Frame& F, const In& I) {
    const int lane = F.lane, tk = lane & 15, ks = lane >> 4;
    LAS float* lg = (LAS float*)(F.lds + F.wave * 4096);
    volatile LAS unsigned* cntL = F.MISC + 32; volatile LAS unsigned* baseL = F.MISC + 64;
    const float* X1 = I.p[0]; bf16* H2 = (bf16*)(F.ws + WS_H2); const float* gf = I.p[21];
    const unsigned char* D8 = (const unsigned char*)(F.ws + WS_D8); const float* DSC = (const float*)(F.ws + WS_DSC);
    const bf16* RHI = (const bf16*)(F.ws + SM_RHI); const bf16* RLO = (const bf16*)(F.ws + SM_RLO);
    float* RSTD = (float*)(F.ws + SM_RSTD); unsigned* gcnt = F.ctl + CW_CNT;
    int* LTOK = (int*)(F.ws + WS_LTOK); float* LW = (float*)(F.ws + WS_LW); int* TOKE = (int*)(F.ws + WS_TOKE); int* TOKR = (int*)(F.ws + WS_TOKR);
    for (int blk = F.vcu; blk < T / 128; blk += F.G) {
        if (F.tid < 32) cntL[F.tid] = 0u;
        __syncthreads();
        const int tok0 = blk * 128 + F.wave * 16;
        const float* xrow = X1 + (size_t)(tok0 + tk) * D + 8 * ks; bf16* hrow = H2 + (size_t)(tok0 + tk) * D + 8 * ks;
        f32x4 acc[3]; acc[0] = acc[1] = acc[2] = (f32x4){0.f, 0.f, 0.f, 0.f}; float ss = 0.f;
        const unsigned char* drow = D8 + (size_t)(tok0 + tk) * D + 8 * ks; const float* dsc = DSC + (size_t)(tok0 + tk) * 16;
        f32x4 xnx[4][2]; v2u dnx[4]; float snx[2];
#pragma unroll
        for (int q = 0; q < 4; ++q) { xnx[q][0] = __builtin_nontemporal_load((const f32x4*)(xrow + 32 * q)); xnx[q][1] = __builtin_nontemporal_load((const f32x4*)(xrow + 32 * q + 4)); dnx[q] = *(const v2u*)(drow + 32 * q); }
        snx[0] = dsc[0]; snx[1] = dsc[4];
        LAS bf16* slab = (LAS bf16*)(F.lds + 32768);
        v4u wst[3];
#define RT_SLAB_LOAD(g) do { _Pragma("unroll") for (int j = 0; j < 3; ++j) { const int c = F.tid + 512 * j, which = c / 768, r = (c % 768) >> 4, kq = c & 15; \
            wst[j] = *(const v4u*)((which ? RLO : RHI) + (size_t)r * D + 128 * (g) + 8 * kq); } } while (0)
#define RT_SLAB_STORE(buf) do { _Pragma("unroll") for (int j = 0; j < 3; ++j) { const int c = F.tid + 512 * j, which = c / 768, r = (c % 768) >> 4, kq = c & 15; \
            *(LAS v4u*)(slab + ((size_t)((buf) * 2 + which) * 48 + r) * 136 + 8 * kq) = wst[j]; } } while (0)
        RT_SLAB_LOAD(0); RT_SLAB_STORE(0);
        LDS_WAIT();
        __syncthreads();
        for (int kg = 0; kg < 8; ++kg) {
            f32x4 xa[4][2];
#pragma unroll
            for (int q = 0; q < 4; ++q) { const float sq = snx[q >> 1]; const v2u dq = dnx[q];
                xa[q][0] = xnx[q][0] + (f32x4){(float)((int)(dq.x << 24) >> 24), (float)((int)(dq.x << 16) >> 24), (float)((int)(dq.x << 8) >> 24), (float)((int)dq.x >> 24)} * sq;
                xa[q][1] = xnx[q][1] + (f32x4){(float)((int)(dq.y << 24) >> 24), (float)((int)(dq.y << 16) >> 24), (float)((int)(dq.y << 8) >> 24), (float)((int)dq.y >> 24)} * sq; }
            { const int kgn = kg < 7 ? kg + 1 : kg;
#pragma unroll
              for (int q = 0; q < 4; ++q) { xnx[q][0] = __builtin_nontemporal_load((const f32x4*)(xrow + 32 * (4 * kgn + q))); xnx[q][1] = __builtin_nontemporal_load((const f32x4*)(xrow + 32 * (4 * kgn + q) + 4)); dnx[q] = *(const v2u*)(drow + 32 * (4 * kgn + q)); }
              { const int G0 = 2 * kgn, G1 = 2 * kgn + 1; snx[0] = dsc[(G0 & 3) * 4 + (G0 >> 2)]; snx[1] = dsc[(G1 & 3) * 4 + (G1 >> 2)]; }
              RT_SLAB_LOAD(kgn); }
            f32x4 ga[4][2];
#pragma unroll
            for (int q = 0; q < 4; ++q) { const int kc = 4 * kg + q; ga[q][0] = *(const f32x4*)(gf + 32 * kc + 8 * ks); ga[q][1] = *(const f32x4*)(gf + 32 * kc + 8 * ks + 4); }
            asm volatile("" ::: "memory");
            const LAS bf16* sh = slab + (size_t)((kg & 1) * 2) * 48 * 136, * sl = sh + 48 * 136;
#pragma unroll
            for (int q = 0; q < 4; ++q) { const int kc = 4 * kg + q;
                const f32x4 a0 = xa[q][0], a1 = xa[q][1];
                ss += (a0.x * a0.x + a0.y * a0.y) + (a0.z * a0.z + a0.w * a0.w) + (a1.x * a1.x + a1.y * a1.y) + (a1.z * a1.z + a1.w * a1.w);
                const f32x4 v0 = a0 * ga[q][0], v1 = a1 * ga[q][1];
                v4u hi, lo;
                hi.x = pg8::cvt_pk_bf16(v0.x, v0.y); hi.y = pg8::cvt_pk_bf16(v0.z, v0.w); hi.z = pg8::cvt_pk_bf16(v1.x, v1.y); hi.w = pg8::cvt_pk_bf16(v1.z, v1.w);
                lo.x = pg8::cvt_pk_bf16(v0.x - bflo(hi.x), v0.y - bfhi(hi.x)); lo.y = pg8::cvt_pk_bf16(v0.z - bflo(hi.y), v0.w - bfhi(hi.y));
                lo.z = pg8::cvt_pk_bf16(v1.x - bflo(hi.z), v1.y - bfhi(hi.z)); lo.w = pg8::cvt_pk_bf16(v1.z - bflo(hi.w), v1.w - bfhi(hi.w));
                *(v4u*)(hrow + 32 * kc) = hi;
                const bf16x8 hf = __builtin_bit_cast(bf16x8, hi), lf = __builtin_bit_cast(bf16x8, lo);
#pragma unroll
                for (int n = 0; n < 3; ++n) {
                    const bf16x8 wh = *(const LAS bf16x8*)(sh + (16 * n + tk) * 136 + 32 * q + 8 * ks), wl = *(const LAS bf16x8*)(sl + (16 * n + tk) * 136 + 32 * q + 8 * ks);
                    acc[n] = __builtin_amdgcn_mfma_f32_16x16x32_bf16(wh, hf, acc[n], 0, 0, 0);
                    acc[n] = __builtin_amdgcn_mfma_f32_16x16x32_bf16(wh, lf, acc[n], 0, 0, 0);
                    acc[n] = __builtin_amdgcn_mfma_f32_16x16x32_bf16(wl, hf, acc[n], 0, 0, 0);
                } }
            if (kg < 7) RT_SLAB_STORE((kg + 1) & 1);
            LDS_WAIT();
            __syncthreads();
        }
#undef RT_SLAB_LOAD
#undef RT_SLAB_STORE
        ss += __shfl_xor(ss, 16); ss += __shfl_xor(ss, 32);
        const float rstd = 1.0f / sqrtf(ss * (1.f / D) + RMS_EPS);
        if (ks == 0) RSTD[tok0 + tk] = rstd;
#pragma unroll
        for (int n = 0; n < 3; ++n)
#pragma unroll
            for (int r = 0; r < 4; ++r) lg[tk * 49 + 16 * n + 4 * ks + r] = acc[n][r] * rstd;
        LDS_WAIT();
        int E1 = 0, E2 = 0; float w1 = 0.f, w2 = 0.f; unsigned r1 = 0, r2 = 0;
        if (lane < 16) {
            const LAS float* my = lg + lane * 49;
            float lgp[4];
#pragma unroll
            for (int i = 0; i < 4; ++i) lgp[i] = my[i] + I.p[23][i];
            int gi = 0; float mx = lgp[0];
#pragma unroll
            for (int i = 1; i < 4; ++i) if (lgp[i] > mx) { mx = lgp[i]; gi = i; }
            float den = 0.f;
#pragma unroll
            for (int i = 0; i < 4; ++i) den += expf(lgp[i] - mx);
            const float pg = 1.0f / den;
            float le[8];
#pragma unroll
            for (int i = 0; i < 8; ++i) le[i] = my[4 + gi * 8 + i] + I.p[25][gi * 8 + i];
            int i1 = 0; float m1 = le[0];
#pragma unroll
            for (int i = 1; i < 8; ++i) if (le[i] > m1) { m1 = le[i]; i1 = i; }
            int i2 = -1; float m2 = -3.0e38f;
#pragma unroll
            for (int i = 0; i < 8; ++i) if (i != i1 && le[i] > m2) { m2 = le[i]; i2 = i; }
            const float e2 = expf(m2 - m1);
            w1 = pg / (1.0f + e2); w2 = pg * e2 / (1.0f + e2);
            E1 = gi * 8 + i1; E2 = gi * 8 + i2;
            r1 = __hip_atomic_fetch_add((LAS unsigned*)(F.MISC + 32) + E1, 1u, __ATOMIC_RELAXED, __HIP_MEMORY_SCOPE_WORKGROUP);
            r2 = __hip_atomic_fetch_add((LAS unsigned*)(F.MISC + 32) + E2, 1u, __ATOMIC_RELAXED, __HIP_MEMORY_SCOPE_WORKGROUP);
        }
        LDS_WAIT();
        __syncthreads();
        if (F.tid < 32) { const unsigned c = cntL[F.tid]; baseL[F.tid] = c ? __hip_atomic_fetch_add(gcnt + F.tid, c, __ATOMIC_RELAXED, __HIP_MEMORY_SCOPE_AGENT) : 0u; }
        __syncthreads();
        if (lane < 16) {
            const int tok = tok0 + lane; const int k1 = (int)(baseL[E1] + r1), k2 = (int)(baseL[E2] + r2);
            LTOK[(size_t)E1 * T + k1] = tok; LW[(size_t)E1 * T + k1] = w1; LTOK[(size_t)E2 * T + k2] = tok; LW[(size_t)E2 * T + k2] = w2;
            TOKE[tok * 2] = E1; TOKE[tok * 2 + 1] = E2; TOKR[tok * 2] = k1; TOKR[tok * 2 + 1] = k2;
        }
        __syncthreads();
    }
}

__device__ __forceinline__ void moe_prefix(const Frame& F) {
    if (F.tid < 64) {
        const unsigned nt = F.tid < NEXP ? (F.ctl[CW_CNT + F.tid] + 255u) >> 8 : 0u; unsigned inc = nt;
#pragma unroll
        for (int o = 1; o < 32; o <<= 1) { const unsigned v = __shfl_up(inc, o); if (F.lane >= o) inc += v; }
        if (F.tid < NEXP) F.MISC[96 + F.tid] = inc - nt;
        if (F.tid == NEXP - 1) F.MISC[128] = inc;
    }
    LDS_WAIT();
    __syncthreads();
}
template <int MODE  >
__device__ __forceinline__ void moe_setup(const Frame& F) {
    moe_prefix(F);
    const int NT = (int)F.MISC[128];
    if (F.tid < MAXU) { const int L = F.tid * F.G + F.vcu; int e = -1, mt = 0;
        if (L < NT * 4) { const int mtg = L >> 2; e = 0; while (e < NEXP - 1 && (int)F.MISC[96 + e + 1] <= mtg) ++e; mt = mtg - (int)F.MISC[96 + e]; }
        F.MISC[136 + F.tid] = (unsigned)e; F.MISC[144 + F.tid] = (unsigned)mt; }
    __syncthreads();
    if (F.tid == 0) { int n = 0; while (n < MAXU && (int)F.MISC[136 + n] >= 0) ++n; F.MISC[152] = (unsigned)n; }
    __syncthreads();
    const int nU = (int)F.MISC[152];
    LAS int* tokL = (LAS int*)(F.lds + TOKL_OFF); LAS float* sclL = (LAS float*)(F.lds + SCLL_OFF);
    const int* LTOK = (const int*)(F.ws + WS_LTOK); const float* LW = (const float*)(F.ws + WS_LW); const float* RSTD = (const float*)(F.ws + SM_RSTD);
    for (int i = F.tid; i < nU * 256; i += 512) { const int ui = i >> 8, r = i & 255, e = (int)F.MISC[136 + ui], rank = (int)F.MISC[144 + ui] * 256 + r; const bool valid = rank < (int)F.ctl[CW_CNT + e];
        const int tok = valid ? LTOK[(size_t)e * T + rank] : 0; tokL[i] = tok; sclL[i] = valid ? (MODE == 0 ? RSTD[tok] : LW[(size_t)e * T + rank]) : 0.f; }
    LDS_WAIT(); VM_WAIT();
    __syncthreads();
}

__device__ __forceinline__ void p11_final(const Frame& F, const In& I, float* dst) {
    moe_prefix(F);
    const int gw = F.vcu * NWAVES + F.wave, NGW = F.G * NWAVES, lane = F.lane;
    const int* TOKE = (const int*)(F.ws + WS_TOKE); const int* TOKR = (const int*)(F.ws + WS_TOKR);
    const unsigned char* YS8 = (const unsigned char*)(F.ws + WS_YS); const float* YSC = (const float*)(F.ws + WS_YS + 80 * MiB);
    const unsigned char* D8 = (const unsigned char*)(F.ws + WS_D8); const float* DSC = (const float*)(F.ws + WS_DSC); const float* X = I.p[0];
    f32x4 gfin[4];
#pragma unroll
    for (int j = 0; j < 4; ++j) gfin[j] = ((const f32x4*)I.p[29])[lane + 64 * j];
    int ee[2][2], rr[2][2];
    { const int m0 = gw * 2 < T ? gw * 2 : 0;
#pragma unroll
      for (int q = 0; q < 2; ++q) { ee[q][0] = TOKE[2 * (m0 + q)]; ee[q][1] = TOKE[2 * (m0 + q) + 1]; rr[q][0] = TOKR[2 * (m0 + q)]; rr[q][1] = TOKR[2 * (m0 + q) + 1]; } }
    for (int m0 = gw * 2; m0 < T; m0 += NGW * 2) {
        f32x4 xv[2][4]; unsigned ya[2][4], yb[2][4], yd[2][4]; f32x4 sa[2], sb[2], sd[2];
#pragma unroll
        for (int q = 0; q < 2; ++q) { const size_t s0 = (size_t)F.MISC[96 + ee[q][0]] * 256 + rr[q][0], s1 = (size_t)F.MISC[96 + ee[q][1]] * 256 + rr[q][1];
            const f32x4* xr = (const f32x4*)(X + (size_t)(m0 + q) * D) + lane; const unsigned* y0 = (const unsigned*)(YS8 + s0 * 1024) + lane; const unsigned* y1 = (const unsigned*)(YS8 + s1 * 1024) + lane;
            const unsigned* d0 = (const unsigned*)(D8 + (size_t)(m0 + q) * 1024) + lane;
#pragma unroll
            for (int j = 0; j < 4; ++j) { xv[q][j] = __builtin_nontemporal_load(xr + 64 * j); ya[q][j] = y0[64 * j]; yb[q][j] = y1[64 * j]; yd[q][j] = d0[64 * j]; }
            sa[q] = *(const f32x4*)(YSC + s0 * 16 + 4 * (lane >> 4)); sb[q] = *(const f32x4*)(YSC + s1 * 16 + 4 * (lane >> 4)); sd[q] = *(const f32x4*)(DSC + (size_t)(m0 + q) * 16 + 4 * (lane >> 4)); }
        { const int mn = m0 + NGW * 2 < T ? m0 + NGW * 2 : m0;
#pragma unroll
          for (int q = 0; q < 2; ++q) { ee[q][0] = TOKE[2 * (mn + q)]; ee[q][1] = TOKE[2 * (mn + q) + 1]; rr[q][0] = TOKR[2 * (mn + q)]; rr[q][1] = TOKR[2 * (mn + q) + 1]; } }
        asm volatile("" ::: "memory");
#pragma unroll
        for (int q = 0; q < 2; ++q) { f32x4 v[4]; float s = 0.f;
#pragma unroll
            for (int j = 0; j < 4; ++j) { const f32x4 x = xv[q][j]; const unsigned a = ya[q][j], b = yb[q][j], c = yd[q][j]; const float ka = sa[q][j], kb = sb[q][j], kc = sd[q][j];
                v[j].x = (x.x + (float)((int)(c << 24) >> 24) * kc) + (float)((int)(a << 24) >> 24) * ka + (float)((int)(b << 24) >> 24) * kb;
                v[j].y = (x.y + (float)((int)(c << 16) >> 24) * kc) + (float)((int)(a << 16) >> 24) * ka + (float)((int)(b << 16) >> 24) * kb;
                v[j].z = (x.z + (float)((int)(c << 8) >> 24) * kc) + (float)((int)(a << 8) >> 24) * ka + (float)((int)(b << 8) >> 24) * kb;
                v[j].w = (x.w + (float)((int)c >> 24) * kc) + (float)((int)a >> 24) * ka + (float)((int)b >> 24) * kb;
                s += (v[j].x * v[j].x + v[j].y * v[j].y) + (v[j].z * v[j].z + v[j].w * v[j].w); }
            const float rstd = 1.0f / sqrtf(wave_sum(s) * (1.f / D) + RMS_EPS);
            f32x4* xw = (f32x4*)(dst + (size_t)(m0 + q) * D) + lane;
#pragma unroll
            for (int j = 0; j < 4; ++j) { const f32x4 g = gfin[j]; __builtin_nontemporal_store((f32x4){v[j].x * rstd * g.x, v[j].y * rstd * g.y, v[j].z * rstd * g.z, v[j].w * rstd * g.w}, xw + 64 * j); } }
    }
}

constexpr int N_PHASES = 12;
struct Args { In in; float* out; unsigned char* ws; float* fin_dst; int ph_lo, ph_hi, li, pad; };
__global__ void __launch_bounds__(NWAVES * 64, 2) mk_fwd(Args args) {
    extern __shared__ __attribute__((aligned(16))) unsigned char lds[];
    Frame F;
    F.lds = (LAS unsigned char*)lds;
    F.MISC = (volatile LAS unsigned*)(F.lds + MISC_OFF);
    F.tid = threadIdx.x; F.lane = F.tid & 63; F.wave = __builtin_amdgcn_readfirstlane(F.tid >> 6);
    F.G = gridDim.x; { const int bx = blockIdx.x; F.vcu = (F.G % 8 == 0) ? (bx % 8) * (F.G / 8) + bx / 8 : bx; }
    F.ws = args.ws; F.out = args.out; F.ctl = (unsigned*)(args.ws + WS_CTL); F.in = nullptr;
    const In& I = args.in;
    for (int u = F.tid; u < 256; u += NWAVES * 64) F.MISC[u] = 0u;
    __syncthreads();
    const int lo = args.ph_lo, hi = args.ph_hi;
    XcdBarrier bar; bar.bar = F.ctl + CW_BAR + args.li * XCD_BAR_WORDS; bar.x = 0; bar.st = nullptr;
    if (hi - lo > 1) bar = xcd_barrier_post(F.ctl + CW_BAR + args.li * XCD_BAR_WORDS, F.MISC + 8);
#ifndef PH_MASK
#define PH_MASK 0xFFF
#endif
#define IN(k) (((PH_MASK >> (k)) & 1) && lo <= (k) && (k) < hi)
#define SEAM(k) do { if (IN(k) && IN(NEXT_PH(k))) xcd_barrier(bar); } while (0)
#define NEXT_PH(k) ((k) == 2 ? 5 : (k) == 5 ? 7 : (k) + 1)
    const int cblk = (int)blockIdx.x;
    LAS unsigned char* ring = F.lds;

    if (IN(0)) { p0_prologue(F, I); SEAM(0); }

    if (IN(1)) {
        DenseOrder S; S.init(F.ws + WS_H, F.ws + WS_WIN, D, D, T, NIN, F.G, cblk);
        EpiInProj E{(bf16*)(F.ws + WS_AG), (bf16*)(F.ws + WS_XL), (bf16*)(F.ws + WS_GL), (bf16*)(F.ws + WS_GA), (bf16*)(F.ws + WS_GB)};
        pg8::gemm_phase<EpiInProj, DenseOrder, true>(ring, D, D, S, E);
        SEAM(1);
    }
    if (IN(2)) {
        if (cblk < 256) {
            const int L = cblk, wgid = (L % 8) * 32 + L / 8, g = wgid >> 3, mt = wgid & 7;
            { S5One S{(const char*)(F.ws + WS_AG) + S5Q * 2, (const char*)(F.ws + WS_BTW), (size_t)S5N * S5K * 2, (size_t)128 * 256 * 2, S5K, g, mt};
              EpiS5State E{(float*)(F.ws + WS_SLOC)};
              pg8::gemm_phase<EpiS5State, S5One, false>(ring, 256, 256, S, E); }
            if (F.wave == 0) { __builtin_amdgcn_fence(__ATOMIC_ACQUIRE, "agent"); VM_WAIT(); }
            __syncthreads();
            s5_chain(F, mt, g);
            VM_WAIT();
            __syncthreads();
            if (F.wave == 0) { __builtin_amdgcn_fence(__ATOMIC_ACQUIRE, "agent"); VM_WAIT(); }
            __syncthreads();
            { S5One S{(const char*)(F.ws + WS_AG), (const char*)(F.ws + WS_BTT), (size_t)S5N * S5K * 2, (size_t)256 * S5K * 2, S5K, g, mt};
              EpiS5Out E{(bf16*)(F.ws + WS_GY)};
              pg8::gemm_phase<EpiS5Out, S5One, false>(ring, S5K, S5K, S, E); }
            __syncthreads();
        }
        lru_seq(F, I);
        SEAM(2);
    }
    if (IN(5)) {
        YaYbOrder S; S.d.init(nullptr, nullptr, D, D, T, D, F.G, cblk);
        S.GYb = (const char*)(F.ws + WS_GY); S.WS5b = (const char*)(F.ws + WS_WS5); S.YLb = (const char*)(F.ws + WS_H); S.WLb = (const char*)(F.ws + WS_WLRU);
        EpiYaYb E{EpiYa{(const bf16*)(F.ws + WS_GA), (bf16*)(F.ws + WS_XL)}, EpiYb{(const bf16*)(F.ws + WS_XL), (const bf16*)(F.ws + WS_GB), (bf16*)(F.ws + WS_GL)}};
        pg8::gemm_phase<EpiYaYb, YaYbOrder, true>(ring, D, D, S, E);
        SEAM(5);
    }
    if (IN(7)) {
        DenseOrder S; S.init(F.ws + WS_GL, F.ws + WS_WO, D, D, T, D, F.G, cblk);
        EpiQ8<false> E{(unsigned char*)(F.ws + WS_D8), (float*)(F.ws + WS_DSC), nullptr};
        pg8::gemm_phase<EpiQ8<false>, DenseOrder, true>(ring, D, D, S, E);
        SEAM(7);
    }
    if (IN(8)) { p8_router(F, I); __syncthreads(); expert_weight_copies(F, I); SEAM(8); }
    if (IN(9)) {
        moe_setup<0>(F);
        MoeOrder<true> S{(const char*)(F.ws + WS_H2), (const char*)(F.ws + WS_WGU), (size_t)1024 * 1024 * 2, D, D, F.G, F.vcu, F.MISC, (const LAS int*)(F.lds + TOKL_OFF)};
        EpiGU E{(bf16*)(F.ws + WS_ACT), (const LAS float*)(F.lds + SCLL_OFF)};
        pg8::gemm_phase<EpiGU, MoeOrder<true>, true>(ring, D, D, S, E);
        SEAM(9);
    }
    if (IN(10)) {
        moe_setup<1>(F);
        MoeOrder<false> S{(const char*)(F.ws + WS_ACT), (const char*)(F.ws + WS_WD), (size_t)1024 * DEXP * 2, DEXP, DEXP, F.G, F.vcu, F.MISC, (const LAS int*)(F.lds + TOKL_OFF)};
        EpiQ8<true> E{(unsigned char*)(F.ws + WS_YS), (float*)(F.ws + WS_YS + 80 * MiB), (const LAS float*)(F.lds + SCLL_OFF)};
        pg8::gemm_phase<EpiQ8<true>, MoeOrder<false>, true>(ring, DEXP, DEXP, S, E);
        SEAM(10);
    }
    if (IN(11)) { p11_final(F, I, args.fin_dst); }
#undef IN
#undef SEAM
}

extern "C" void kernel_launch(void* const* d_in, const int* in_sizes, int n_in, void* d_out, int out_size, void* d_ws, size_t ws_size, hipStream_t stream) {
    static int grid = 0;
    if (grid == 0) {
        if (n_in != 30 || in_sizes[0] != T * D || out_size != T * D || ws_size < WS_END) { fprintf(stderr, "kernel_launch: unexpected shapes / workspace (n_in %d, ws %zu)\n", n_in, ws_size); grid = -1; return; }
        int dev = 0, cus = 0, per_cu = 0;
        if (hipGetDevice(&dev) != hipSuccess || hipDeviceGetAttribute(&cus, hipDeviceAttributeMultiprocessorCount, dev) != hipSuccess) { grid = -1; return; }
        if (hipFuncSetAttribute((const void*)mk_fwd, hipFuncAttributeMaxDynamicSharedMemorySize, LDS_BYTES) != hipSuccess) { fprintf(stderr, "kernel_launch: hipFuncSetAttribute failed\n"); grid = -1; return; }
        if (hipOccupancyMaxActiveBlocksPerMultiprocessor(&per_cu, (const void*)mk_fwd, NWAVES * 64, LDS_BYTES) != hipSuccess || per_cu < 1) { fprintf(stderr, "kernel_launch: occupancy query says %d\n", per_cu); }
        (void)hipGetLastError();
        grid = cus;
    }
    if (grid < 0) return;
    if (hipMemsetAsync((char*)d_ws + WS_CTL, 0, CTL_ZERO_BYTES, stream) != hipSuccess) return;
    Args a{};
    for (int i = 0; i < 30; ++i) a.in.p[i] = (const float*)d_in[i];
    a.out = (float*)d_out; a.ws = (unsigned char*)d_ws; a.fin_dst = (float*)d_out;
#if defined(PROBE_LO)
    a.ph_lo = 0; a.ph_hi = PROBE_HI; a.li = 0;
#if PROBE_LO == 11
    a.fin_dst = (float*)((char*)d_ws + WS_H2);
#endif
    hipLaunchKernelGGL(mk_fwd, dim3(grid), dim3(NWAVES * 64), LDS_BYTES, stream, a);
#if PROBE_LO == 8
    hipMemsetAsync((char*)d_ws + WS_CTL + CW_CNT * 4, 0, 128, stream);
#endif
    a.fin_dst = (float*)d_out;
    a.ph_lo = PROBE_LO; a.ph_hi = N_PHASES; a.li = 1;
    hipLaunchKernelGGL(mk_fwd, dim3(grid), dim3(NWAVES * 64), LDS_BYTES, stream, a);
#elif MK_N_LAUNCHES == 1
    a.ph_lo = 0; a.ph_hi = N_PHASES;
    hipLaunchKernelGGL(mk_fwd, dim3(grid), dim3(NWAVES * 64), LDS_BYTES, stream, a);
#else
    for (int p = 0; p < N_PHASES; ++p) { a.ph_lo = p; a.ph_hi = p + 1; hipLaunchKernelGGL(mk_fwd, dim3(grid), dim3(NWAVES * 64), LDS_BYTES, stream, a); }
#endif
}
```

```cpp
#include <hip/hip_runtime.h>
#include <cstdio>
#include <cstdint>

#ifndef MK_N_LAUNCHES
#define MK_N_LAUNCHES 1
#endif

namespace pg8 {
#define PG8_LAS __attribute__((address_space(3)))
typedef unsigned short bf16_t;
typedef short bf16x8 __attribute__((ext_vector_type(8)));
typedef float f32x4 __attribute__((ext_vector_type(4)));
typedef unsigned u32x4 __attribute__((ext_vector_type(4)));
constexpr int BM = 256, BK = 64, HALF = 128, HTB = HALF * BK * 2  , STAGE_BYTES = 8 * HTB, NXCD = 8, WGM = 8;

__host__ __device__ __forceinline__ int lds_byte(int r, int c) { const int st = (r >> 4) * 2 + (c >> 5), rr = r & 15, cc = c & 31, ob = rr * 64 + cc * 2; return st * 1024 + (ob ^ (((ob >> 9) & 1) << 5)); }
__host__ __device__ __forceinline__ void stage_rc(int b, int& R, int& C) { const int st = b / 1024, sb = b % 1024, swz = sb ^ (((sb >> 9) & 1) << 5); R = (st >> 1) * 16 + swz / 64; C = (st & 1) * 32 + (swz % 64) / 2; }
__host__ __device__ __forceinline__ int perm32(int rho) { const int n = rho >> 4, i = rho & 15; return 8 * (i >> 2) + 4 * n + (i & 3); }

struct Unit { const char* A; const char* B; int pm, pn, aux, nt, kind; unsigned kA; };

__device__ __forceinline__ unsigned cvt_pk_bf16(float lo, float hi) { unsigned r; asm volatile("v_cvt_pk_bf16_f32 %0, %1, %2" : "=v"(r) : "v"(lo), "v"(hi)); return r; }

template <class Epi, class Sched, bool ALIGN_EPI>
__device__ __forceinline__ void gemm_phase(PG8_LAS unsigned char* lds, const int ldb, const int K, const Sched& S, const Epi& E, const size_t kstepA = (size_t)(BK * 2)) {
    const int tid = threadIdx.x, wid = __builtin_amdgcn_readfirstlane(tid >> 6), lane = tid & 63, wr = wid >> 2, wc = wid & 3, fr = lane & 15, fq = lane >> 4;
    int nt = K / BK; asm volatile("" : "+s"(nt));
    int Rr[2], Cc[2], Rbb[2]; unsigned voffB[4], vAc[4], vAn[4];
#pragma unroll
    for (int i = 0; i < 2; ++i) { int R, C; stage_rc(tid * 16 + i * 8192, R, C); Rr[i] = R; Cc[i] = C; const int Rb = Epi::PERM ? ((R & ~31) + perm32(R & 31)) : R; Rbb[i] = Rb;
        int Rb0 = Rb, Rb1 = HALF + Rb;
        if constexpr (Epi::B16) {
            const int w_ = R >> 5, nn_ = (R >> 4) & 1, ii_ = R & 15; Rb0 = 64 * w_ + 16 * (ii_ >> 2) + 4 * nn_ + (ii_ & 3); Rb1 = Rb0 + 8; }
        voffB[i] = (unsigned)(Rb0 * ldb + C) * 2u; voffB[2 + i] = (unsigned)(Rb1 * ldb + C) * 2u; }
    const size_t kstep = (size_t)(BK * 2);
    const unsigned ldsw = (unsigned)wid * 1024u;
    const int aoff = lds_byte(wr * 64 + fr, fq * 8), boff = lds_byte(wc * 32 + fr, fq * 8);
#define PG8_SA(b, h) (((b) * 2 + (h)) * HTB)
#define PG8_SB(b, h) ((4 + (b) * 2 + (h)) * HTB)
#define PG8_STAGE(bufoff, gbase, voff, h) do { _Pragma("unroll") for (int _i = 0; _i < 2; ++_i) \
        __builtin_amdgcn_global_load_lds((const unsigned*)((const char*)(gbase) + (voff)[2 * (h) + _i]), (PG8_LAS unsigned*)(lds + (bufoff) + ldsw + _i * 8192), 16, 0, 0); } while (0)
#define PG8_LDA(dst, b, h) do { _Pragma("unroll") for (int m = 0; m < 4; ++m) _Pragma("unroll") for (int k = 0; k < 2; ++k) dst[m][k] = *(const PG8_LAS bf16x8*)(lds + PG8_SA(b, h) + aoff + m * 2048 + k * 1024); } while (0)
#define PG8_LDB(dst, b, h) do { _Pragma("unroll") for (int n = 0; n < 2; ++n) _Pragma("unroll") for (int k = 0; k < 2; ++k) dst[n][k] = *(const PG8_LAS bf16x8*)(lds + PG8_SB(b, h) + boff + n * 2048 + k * 1024); } while (0)
#define PG8_MMA(ai, bj, At, Bt) do { __builtin_amdgcn_s_setprio(1); _Pragma("unroll") for (int m = 0; m < 4; ++m) _Pragma("unroll") for (int n = 0; n < 2; ++n) _Pragma("unroll") for (int k = 0; k < 2; ++k) \
        acc[ai][bj][m][n] = __builtin_amdgcn_mfma_f32_16x16x32_bf16(Bt[n][k], At[m][k], acc[ai][bj][m][n], 0, 0, 0); __builtin_amdgcn_s_setprio(0); } while (0)
#define PG8_WAIT_V(n) asm volatile("s_waitcnt vmcnt(" #n ")" ::: "memory")
#define PG8_WAIT_L(n) asm volatile("s_waitcnt lgkmcnt(" #n ")" ::: "memory")
#define PG8_BAR __builtin_amdgcn_s_barrier()
#define PG8_SCHED __builtin_amdgcn_sched_barrier(0)
    Unit cur, nxt; int ui = 0;
    if (!S.next(0, cur)) return;
    S.a_offsets(cur, Rr, Cc, vAc);
    unsigned vBc[4], vBn[4];
    if constexpr (Sched::HETERO) { S.b_offsets(cur, Rbb, Cc, vBc); nt = __builtin_amdgcn_readfirstlane(cur.nt); }
    else {
#pragma unroll
        for (int q = 0; q < 4; ++q) vBc[q] = voffB[q]; }
    size_t kAc = Sched::HETERO ? (size_t)(unsigned)__builtin_amdgcn_readfirstlane((int)cur.kA) : kstepA;
    f32x4 acc[2][2][4][2];
    if constexpr (Epi::ACC_INIT) E.init(acc, cur, wr, wc, fr, fq);
    else {
#pragma unroll
    for (int a = 0; a < 2; ++a)
#pragma unroll
        for (int b = 0; b < 2; ++b)
#pragma unroll
            for (int m = 0; m < 4; ++m)
#pragma unroll
                for (int n = 0; n < 2; ++n) acc[a][b][m][n] = (f32x4){0.f, 0.f, 0.f, 0.f}; }
    bf16x8 At[4][2], B0[2][2], B1[2][2];
    const char* cA = cur.A; const char* cB = cur.B;
    if constexpr (Sched::GATHER) { PG8_WAIT_L(0); }
    PG8_STAGE(PG8_SB(0, 0), cB, vBc, 0); PG8_STAGE(PG8_SB(0, 1), cB, vBc, 1); PG8_STAGE(PG8_SA(0, 0), cA, vAc, 0); PG8_STAGE(PG8_SA(0, 1), cA, vAc, 1);
    if (wr == 1) PG8_BAR;
    PG8_WAIT_V(2); PG8_BAR;
    PG8_STAGE(PG8_SB(1, 0), cB + kstep, vBc, 0); PG8_STAGE(PG8_SA(1, 0), cA + kAc, vAc, 0); PG8_STAGE(PG8_SB(1, 1), cB + kstep, vBc, 1);
    PG8_WAIT_V(6); PG8_BAR;
    for (;;) {
        const bool has_next = S.next(ui + 1, nxt);
        const char* nA = has_next ? nxt.A : cA; const char* nB = has_next ? nxt.B : cB;
        size_t kAn = kAc;
        if constexpr (Sched::HETERO) { if (has_next) { S.b_offsets(nxt, Rbb, Cc, vBn); kAn = (size_t)(unsigned)__builtin_amdgcn_readfirstlane((int)nxt.kA); } else {
#pragma unroll
                for (int q = 0; q < 4; ++q) vBn[q] = vBc[q]; } }
        for (int t = 0; t < nt; t += 2) {
            const bool last = (t == nt - 2);
            const char* a1 = cA + (size_t)(t + 1) * kAc;
            const char* a2 = last ? nA : cA + (size_t)(t + 2) * kAc; const char* b2 = last ? nB : cB + (size_t)(t + 2) * kstep;
            const char* a3 = a2 + (last ? kAn : kAc); const char* b3 = b2 + kstep;
            unsigned vb2[4];
#pragma unroll
            for (int q = 0; q < 4; ++q) vb2[q] = (Sched::HETERO && last) ? vBn[q] : vBc[q];
            unsigned va2[4];
            if constexpr (Sched::GATHER || Sched::HETERO) {
                if (last) { if (has_next) { S.a_offsets(nxt, Rr, Cc, vAn); if constexpr (Sched::GATHER) { PG8_WAIT_L(0); } } else {
#pragma unroll
                        for (int q = 0; q < 4; ++q) vAn[q] = vAc[q]; } }
#pragma unroll
                for (int q = 0; q < 4; ++q) va2[q] = last ? vAn[q] : vAc[q];
            } else {
#pragma unroll
                for (int q = 0; q < 4; ++q) va2[q] = vAc[q];
            }
            PG8_LDB(B0, 0, 0); PG8_LDB(B1, 0, 1); PG8_SCHED; PG8_LDA(At, 0, 0); PG8_STAGE(PG8_SA(1, 1), a1, vAc, 1);
            PG8_WAIT_V(8); PG8_WAIT_L(0); PG8_BAR; PG8_MMA(0, 0, At, B0); PG8_MMA(0, 1, At, B1); PG8_BAR; PG8_SCHED;
            const bool fin = last && !has_next;
            PG8_LDA(At, 0, 1);
            if (!fin) { PG8_STAGE(PG8_SB(0, 0), b2, vb2, 0); PG8_STAGE(PG8_SB(0, 1), b2, vb2, 1); PG8_STAGE(PG8_SA(0, 0), a2, va2, 0); PG8_WAIT_V(8); } else { PG8_WAIT_V(0); }
            PG8_WAIT_L(0); PG8_BAR; PG8_MMA(1, 0, At, B0); PG8_MMA(1, 1, At, B1); PG8_BAR; PG8_SCHED;
            PG8_LDB(B0, 1, 0); PG8_LDB(B1, 1, 1); PG8_SCHED; PG8_LDA(At, 1, 0);
            if (!fin) { PG8_STAGE(PG8_SA(0, 1), a2, va2, 1); PG8_WAIT_V(8); } else { PG8_WAIT_V(0); }
            PG8_WAIT_L(0); PG8_BAR; PG8_MMA(0, 0, At, B0); PG8_MMA(0, 1, At, B1); PG8_BAR; PG8_SCHED;
            PG8_LDA(At, 1, 1);
            if (!fin) { PG8_STAGE(PG8_SB(1, 0), b3, vb2, 0); PG8_STAGE(PG8_SB(1, 1), b3, vb2, 1); PG8_STAGE(PG8_SA(1, 0), a3, va2, 0); PG8_WAIT_V(8); } else { PG8_WAIT_V(0); }
            PG8_WAIT_L(0); PG8_BAR; PG8_MMA(1, 0, At, B0); PG8_MMA(1, 1, At, B1); PG8_BAR; PG8_SCHED;
        }
        if constexpr (ALIGN_EPI) { if (wr == 0) PG8_BAR; }
        E(acc, cur, wr, wc, fr, fq);
        if (!has_next) break;
        if constexpr (Epi::ACC_INIT) E.init(acc, nxt, wr, wc, fr, fq);
        else {
#pragma unroll
        for (int a = 0; a < 2; ++a)
#pragma unroll
            for (int b = 0; b < 2; ++b)
#pragma unroll
                for (int m = 0; m < 4; ++m)
#pragma unroll
                    for (int n = 0; n < 2; ++n) acc[a][b][m][n] = (f32x4){0.f, 0.f, 0.f, 0.f}; }
        cur = nxt; cA = nA; cB = nB; ++ui;
        if constexpr (Sched::GATHER || Sched::HETERO) {
#pragma unroll
            for (int q = 0; q < 4; ++q) vAc[q] = vAn[q]; }
        if constexpr (Sched::HETERO) {
#pragma unroll
            for (int q = 0; q < 4; ++q) vBc[q] = vBn[q];
            kAc = kAn; nt = __builtin_amdgcn_readfirstlane(cur.nt); }
        if constexpr (ALIGN_EPI) { if (wr == 1) PG8_BAR; }
    }
    PG8_WAIT_V(0);
    if constexpr (!ALIGN_EPI) { if (wr == 0) PG8_BAR; }
    PG8_BAR;
#undef PG8_SA
#undef PG8_SB
#undef PG8_STAGE
#undef PG8_LDA
#undef PG8_LDB
#undef PG8_MMA
#undef PG8_WAIT_V
#undef PG8_WAIT_L
#undef PG8_BAR
#undef PG8_SCHED
}
}

constexpr int NWAVES = 8;
constexpr int BATCH = 8, SEQ = 4096, D = 1024, T = BATCH * SEQ;
constexpr int S5W = 512, S5G = 32, S5C = 16, S5P = 64, S5Q = 128;
constexpr int S5LC = 16, S5NCH = SEQ / S5LC, S5N = BATCH * S5NCH;
constexpr int S5K = S5Q + S5LC * S5C;
constexpr int LRUW = 1024, LRUH = 16, LRUHD = 64, LRUCH = 64, LRUNCH = SEQ / LRUCH;
constexpr int NIN = S5W + 2 * LRUW + 2 * D;
constexpr int NEXP = 32, EPG = 8, NGRP = 4, DEXP = 512, NROUT = 48;
constexpr int MAXSLOT = 73728;
constexpr int MAXU = 8;
constexpr float RMS_EPS = 1e-6f;

constexpr size_t MiB = 1u << 20;
constexpr size_t WS_CTL = 0, CTL_ZERO_BYTES = 128 * 1024;
constexpr size_t WS_SMALL = 1 * MiB;
constexpr size_t SM_LAM16 = WS_SMALL + 0;
constexpr size_t SM_LRUC = WS_SMALL + 16384;
constexpr size_t SM_WRT = WS_SMALL + 32768;
constexpr size_t SM_RHI = WS_SMALL + 327680;
constexpr size_t SM_RLO = SM_RHI + 98304;
constexpr size_t SM_RSTD = WS_SMALL + 524288;
constexpr size_t WS_BTT = 2 * MiB;
constexpr size_t WS_BTW = 8 * MiB;
constexpr size_t WS_WIN = 11 * MiB;
constexpr size_t WS_WS5 = 20 * MiB;
constexpr size_t WS_WLRU = 22 * MiB;
constexpr size_t WS_WO = 24 * MiB;
constexpr size_t WS_LP = 26 * MiB, WS_LH = 28 * MiB, WS_LHIN = 30 * MiB;
constexpr size_t WS_AG = 32 * MiB;
constexpr size_t WS_SLOC = 80 * MiB;
constexpr size_t WS_H = 112 * MiB;
constexpr size_t WS_XL = 176 * MiB;
constexpr size_t WS_GL = 240 * MiB;
constexpr size_t WS_GA = 304 * MiB, WS_GB = 336 * MiB;
constexpr size_t WS_GY = 368 * MiB;
constexpr size_t WS_D8 = 336 * MiB, WS_DSC = 368 * MiB;
constexpr size_t WS_WGU = 400 * MiB;
constexpr size_t WS_WD = 464 * MiB;
constexpr size_t WS_H2 = 32 * MiB;
constexpr size_t WS_ACT = 96 * MiB;
constexpr size_t WS_YS = 168 * MiB;
constexpr size_t WS_LTOK = 312 * MiB, WS_LW = 316 * MiB;
constexpr size_t WS_TOKE = 320 * MiB, WS_TOKR = WS_TOKE + 262144;
constexpr size_t WS_END = 496 * MiB;
static_assert(WS_YS + (size_t)MAXSLOT * 1024 * 2 <= WS_LTOK && WS_ACT + (size_t)MAXSLOT * 512 * 2 <= WS_YS && WS_TOKR + 262144 <= WS_WGU && WS_GY + (size_t)T * 512 * 2 <= WS_WGU && WS_WD + (size_t)32 * 1024 * 512 * 2 <= WS_END, "d_ws map");
constexpr int CW_BAR = 4096;
constexpr int CW_CNT = 16384;

constexpr int RING_BYTES = 131072;
constexpr int TOKL_OFF = RING_BYTES, SCLL_OFF = TOKL_OFF + MAXU * 256 * 4, MISC_OFF = SCLL_OFF + MAXU * 256 * 4;
constexpr int LDS_BYTES = MISC_OFF + 1024;

#define GAS __attribute__((address_space(1)))
#define LAS __attribute__((address_space(3)))
typedef unsigned short bf16;
typedef unsigned v4u __attribute__((ext_vector_type(4)));
typedef unsigned v2u __attribute__((ext_vector_type(2)));
typedef float f32x4 __attribute__((ext_vector_type(4)));
typedef short bf16x8 __attribute__((ext_vector_type(8)));
#define LDS_WAIT() asm volatile("s_waitcnt lgkmcnt(0)" ::: "memory")
#define VM_WAIT() asm volatile("s_waitcnt vmcnt(0)" ::: "memory")
__device__ __forceinline__ unsigned pk2(float lo, float hi) { unsigned r; asm volatile("v_cvt_pk_bf16_f32 %0, %1, %2" : "=v"(r) : "v"(lo), "v"(hi)); return r; }
__device__ __forceinline__ unsigned f2bf(float f) { return pk2(f, 0.f) & 0xffffu; }
__device__ __forceinline__ float bf2f(unsigned h) { return __builtin_bit_cast(float, h << 16); }
__device__ __forceinline__ float bflo(unsigned w) { return __builtin_bit_cast(float, w << 16); }
__device__ __forceinline__ float bfhi(unsigned w) { return __builtin_bit_cast(float, w & 0xffff0000u); }
__device__ __forceinline__ float fsigmoid(float x) { return __builtin_amdgcn_rcpf(1.0f + __builtin_amdgcn_exp2f(-1.44269504f * x)); }
__device__ __forceinline__ float gelu_t(float x) { const float u = x * (0.7978845608f + 0.0356774081f * x * x); return x * __builtin_amdgcn_rcpf(1.0f + __builtin_amdgcn_exp2f(-2.88539008f * u)); }
__device__ __forceinline__ float wave_sum(float v) {
#pragma unroll
    for (int o = 1; o < 64; o <<= 1) v += __shfl_xor(v, o);
    return v;
}

#define XB_TMO      128
#define XB_XCNT(j)  (256  + 64 * (j))
#define XB_XSUB(j)  (1280 + 64 * (j))
#define XB_XGEN(j)  (2304 + 64 * (j))
#define XB_TOP      3328
#define XB_TOPGEN   3392
#define XCD_BAR_WORDS 3456
#define XB_SPIN_CAP (1u << 18)
__device__ __forceinline__ unsigned xb_ld(unsigned* p)              { return __hip_atomic_load(p, __ATOMIC_RELAXED, __HIP_MEMORY_SCOPE_AGENT); }
__device__ __forceinline__ unsigned xb_add(unsigned* p, unsigned v) { return __hip_atomic_fetch_add(p, v, __ATOMIC_RELAXED, __HIP_MEMORY_SCOPE_AGENT); }
__device__ __forceinline__ unsigned xb_xcc_id() { return (unsigned)__builtin_amdgcn_s_getreg((3 << 11) | 20) & 0xFu; }
#define XB_SPIN(cond, bar) do { unsigned _sp = 0; while (cond) { __builtin_amdgcn_s_sleep(1); \
    if ((++_sp & 255u) == 0u) { if (xb_ld(&(bar)[XB_TMO])) break; if (_sp > XB_SPIN_CAP) { atomicAdd(&(bar)[XB_TMO], 1u); break; } } } } while (0)
struct XcdBarrier { unsigned* bar; unsigned x; volatile LAS unsigned* st; };
__device__ __forceinline__ XcdBarrier xcd_barrier_post(unsigned* bar, volatile LAS unsigned* st) {
    XcdBarrier b; b.bar = bar; b.x = xb_xcc_id(); b.st = st;
    if (threadIdx.x == 0) (void)xb_add(&bar[XB_XCNT(b.x)], 1u);
    return b;
}
__device__ __forceinline__ void xcd_barrier_complete(unsigned* bar, unsigned x, unsigned& nloc, unsigned& nx) {
    const unsigned G = gridDim.x * gridDim.y * gridDim.z;
    unsigned sum, cnt, mine, sp = 0u;
    for (;;) {
        sum = 0u; cnt = 0u; mine = 0u;
#pragma unroll
        for (unsigned j = 0; j < 16; ++j) { const unsigned c = xb_ld(&bar[XB_XCNT(j)]); sum += c; cnt += (c > 0u) ? 1u : 0u; mine = (j == x) ? c : mine; }
        if (sum == G) break;
        __builtin_amdgcn_s_sleep(1);
        if ((++sp & 255u) == 0u) { if (xb_ld(&bar[XB_TMO])) break; if (sp > XB_SPIN_CAP) { atomicAdd(&bar[XB_TMO], 1u); break; } }
    }
    nloc = mine > 0u ? mine : 1u; nx = cnt > 0u ? cnt : 1u;
}
__device__ __forceinline__ void xcd_barrier(const XcdBarrier& b) {
    asm volatile("s_waitcnt vmcnt(0)" ::: "memory");
    __syncthreads();
    if (threadIdx.x == 0) {
        unsigned* bar = b.bar;
        __builtin_amdgcn_s_waitcnt(0);
        unsigned nloc = b.st[0], nx = b.st[1];
        if (nloc == 0u) { xcd_barrier_complete(bar, b.x, nloc, nx); b.st[0] = nloc; b.st[1] = nx; }
        const unsigned old = xb_add(&bar[XB_XSUB(b.x)], 1u);
        const unsigned gen = old / nloc;
        if (old + 1u == (gen + 1u) * nloc) {
            __builtin_amdgcn_fence(__ATOMIC_RELEASE, "agent");
            asm volatile("s_waitcnt vmcnt(0)" ::: "memory");
            const unsigned og = xb_add(&bar[XB_TOP], 1u);
            const unsigned tg = og / nx;
            if (og + 1u == (tg + 1u) * nx) xb_add(&bar[XB_TOPGEN], 1u);
            else XB_SPIN(xb_ld(&bar[XB_TOPGEN]) == tg, bar);
            __builtin_amdgcn_fence(__ATOMIC_ACQUIRE, "agent");
            xb_add(&bar[XB_XGEN(b.x)], 1u);
            asm volatile("s_waitcnt vmcnt(0)" ::: "memory");
        } else {
            XB_SPIN(xb_ld(&bar[XB_XGEN(b.x)]) == gen, bar);
            __builtin_amdgcn_fence(__ATOMIC_ACQUIRE, "agent");
            asm volatile("s_waitcnt vmcnt(0)" ::: "memory");
        }
    }
    __syncthreads();
}

struct Frame {
    LAS unsigned char* lds;
    volatile LAS unsigned* MISC;
    unsigned* ctl;
    int tid, lane, wave, vcu, G;
    const float* const* in;
    unsigned char* ws; float* out;
};

using pg8::Unit;
struct DenseOrder {
    static constexpr bool GATHER = false, HETERO = false;
    const char* A0; const char* B0; int lda, ldb, nM, nN, nwg, G, c;
    __device__ __forceinline__ void init(const void* A, const void* B, int lda_, int ldb_, int M, int N, int G_, int c_) { A0 = (const char*)A; B0 = (const char*)B; lda = lda_; ldb = ldb_; nM = M / 256; nN = N / 256; nwg = nM * nN; G = G_; c = c_; }
    __device__ __forceinline__ bool next(int i, Unit& u) const {
        const long L = (long)i * G + c; if (L >= nwg) return false;
        int wgid = (int)L; { const int q = nwg / 8, r = nwg % 8, xcd = wgid % 8, off = wgid / 8; wgid = (xcd < r ? xcd * (q + 1) : r * (q + 1) + (xcd - r) * q) + off; }
        const int nig = 8 * nN, gid = wgid / nig, fm = gid * 8, gsz = (nM - fm) < 8 ? (nM - fm) : 8;
        u.pm = fm + ((wgid % nig) % gsz); u.pn = (wgid % nig) / gsz; u.aux = 0;
        u.A = A0 + (size_t)u.pm * 256 * lda * 2; u.B = B0 + (size_t)u.pn * 256 * ldb * 2; return true;
    }
    __device__ __forceinline__ void a_offsets(const Unit&, const int (&R)[2], const int (&C)[2], unsigned (&v)[4]) const {
#pragma unroll
        for (int i = 0; i < 2; ++i) { v[i] = (unsigned)(R[i] * lda + C[i]) * 2u; v[2 + i] = (unsigned)((128 + R[i]) * lda + C[i]) * 2u; }
    }
};
struct S5One {
    static constexpr bool GATHER = false, HETERO = false;
    const char* A0; const char* B0; size_t sA, sB; int lda, g, mt;
    __device__ __forceinline__ bool next(int i, Unit& u) const {
        if (i > 0) return false;
        u.pm = mt; u.pn = 0; u.aux = g; u.A = A0 + (size_t)g * sA + (size_t)mt * 256 * lda * 2; u.B = B0 + (size_t)g * sB; return true;
    }
    __device__ __forceinline__ void a_offsets(const Unit&, const int (&R)[2], const int (&C)[2], unsigned (&v)[4]) const {
#pragma unroll
        for (int i = 0; i < 2; ++i) { v[i] = (unsigned)(R[i] * lda + C[i]) * 2u; v[2 + i] = (unsigned)((128 + R[i]) * lda + C[i]) * 2u; }
    }
};
struct GyOrder {
    static constexpr bool GATHER = false, HETERO = false;
    DenseOrder d;
    __device__ __forceinline__ bool next(int i, Unit& u) const { if (!d.next(i, u)) return false; u.A = d.A0 + (size_t)u.pm * 256 * 32; return true; }
    __device__ __forceinline__ void a_offsets(const Unit&, const int (&R)[2], const int (&C)[2], unsigned (&v)[4]) const {
#pragma unroll
        for (int i = 0; i < 2; ++i) { const unsigned o = (unsigned)(C[i] >> 4) * (unsigned)(T * 32) + (unsigned)(C[i] & 15) * 2u; v[i] = (unsigned)R[i] * 32u + o; v[2 + i] = (unsigned)(128 + R[i]) * 32u + o; }
    }
};
struct YaYbOrder {
    static constexpr bool GATHER = false, HETERO = true;
    DenseOrder d;
    const char* GYb; const char* WS5b; const char* YLb; const char* WLb;
    __device__ __forceinline__ bool next(int i, Unit& u) const {
        const int j = i / 3, r = i - 3 * j; Unit t;
        if (!d.next(j, t)) return false;
        u.pm = t.pm; u.aux = 0;
        if (r < 2) { u.kind = 0; u.pn = 2 * t.pn + r; u.nt = S5W / 64; u.kA = (unsigned)(4 * T * 32); u.A = GYb + (size_t)t.pm * 256 * 32; u.B = WS5b + (size_t)u.pn * 256 * S5W * 2; }
        else { u.kind = 1; u.pn = t.pn; u.nt = D / 64; u.kA = 128u; u.A = YLb + (size_t)t.pm * 256 * D * 2; u.B = WLb + (size_t)t.pn * 256 * D * 2; }
        return true;
    }
    __device__ __forceinline__ void a_offsets(const Unit& u, const int (&R)[2], const int (&C)[2], unsigned (&v)[4]) const {
#pragma unroll
        for (int i = 0; i < 2; ++i) {
            const unsigned og = (unsigned)(C[i] >> 4) * (unsigned)(T * 32) + (unsigned)(C[i] & 15) * 2u;
            const unsigned g0 = (unsigned)R[i] * 32u + og, g1 = (unsigned)(128 + R[i]) * 32u + og;
            const unsigned d0 = (unsigned)(R[i] * D + C[i]) * 2u, d1 = (unsigned)((128 + R[i]) * D + C[i]) * 2u;
            v[i] = u.kind ? d0 : g0; v[2 + i] = u.kind ? d1 : g1; }
    }
    __device__ __forceinline__ void b_offsets(const Unit& u, const int (&Rb)[2], const int (&C)[2], unsigned (&v)[4]) const {
        const int ldb = u.kind ? D : S5W;
#pragma unroll
        for (int i = 0; i < 2; ++i) { v[i] = (unsigned)(Rb[i] * ldb + C[i]) * 2u; v[2 + i] = (unsigned)((128 + Rb[i]) * ldb + C[i]) * 2u; }
    }
};
template <bool GATH> struct MoeOrder {
    static constexpr bool GATHER = GATH, HETERO = false;
    const char* A0; const char* B0; size_t sBe; int lda, ldb, G, c; volatile LAS unsigned* MISC; const LAS int* tokL;
    __device__ __forceinline__ bool next(int i, Unit& u) const {
        if (i >= (int)MISC[152]) return false;
        const int e = (int)MISC[136 + i], mtg = (int)MISC[96 + e] + (int)MISC[144 + i], L = i * G + c;
        u.pm = mtg; u.pn = L & 3; u.aux = i;
        u.A = GATH ? A0 : A0 + (size_t)mtg * 256 * lda * 2; u.B = B0 + (size_t)e * sBe + (size_t)u.pn * 256 * ldb * 2; return true;
    }
    __device__ __forceinline__ void a_offsets(const Unit& u, const int (&R)[2], const int (&C)[2], unsigned (&v)[4]) const {
#pragma unroll
        for (int i = 0; i < 2; ++i) {
            if constexpr (GATH) { v[i] = (unsigned)tokL[u.aux * 256 + R[i]] * (unsigned)(lda * 2) + (unsigned)C[i] * 2u; v[2 + i] = (unsigned)tokL[u.aux * 256 + 128 + R[i]] * (unsigned)(lda * 2) + (unsigned)C[i] * 2u; }
            else { v[i] = (unsigned)(R[i] * lda + C[i]) * 2u; v[2 + i] = (unsigned)((128 + R[i]) * lda + C[i]) * 2u; } }
    }
};

using pg8::cvt_pk_bf16;
template <int ACT> __device__ __forceinline__ float actf(float x) { if (ACT == 1) return gelu_t(x); if (ACT == 2) return fsigmoid(x); return x; }
__device__ __forceinline__ v4u pack8(const f32x4 a, const f32x4 b) { v4u w; w.x = cvt_pk_bf16(a[0], a[1]); w.y = cvt_pk_bf16(a[2], a[3]); w.z = cvt_pk_bf16(b[0], b[1]); w.w = cvt_pk_bf16(b[2], b[3]); return w; }

__device__ __forceinline__ void unpack_u8x8(const v2u w, float (&f)[8]) {
    const float k = 1.0f / 255.0f;
    f[0] = (float)(w.x & 0xffu) * k; f[1] = (float)((w.x >> 8) & 0xffu) * k; f[2] = (float)((w.x >> 16) & 0xffu) * k; f[3] = (float)(w.x >> 24) * k;
    f[4] = (float)(w.y & 0xffu) * k; f[5] = (float)((w.y >> 8) & 0xffu) * k; f[6] = (float)((w.y >> 16) & 0xffu) * k; f[7] = (float)(w.y >> 24) * k;
}
struct EpiInProj {
    static constexpr bool PERM = true, ACC_INIT = false, B16 = false;
    bf16 *AG, *XL, *GL, *GA, *GB;
    template <int MODE  > __device__ __forceinline__ void tile(const f32x4 (&acc)[2][2][4][2], const Unit& u, bf16* base, int colbase, bool s5, int wr, int wc, int fr, int fq) const {
#pragma unroll
        for (int ai = 0; ai < 2; ++ai)
#pragma unroll
            for (int m = 0; m < 4; ++m) { const int r = u.pm * 256 + ai * 128 + wr * 64 + m * 16 + fr;
#pragma unroll
                for (int bj = 0; bj < 2; ++bj) { const int cl = colbase + bj * 128 + wc * 32 + 8 * fq;
                    f32x4 v0 = acc[ai][bj][m][0], v1 = acc[ai][bj][m][1];
                    if (MODE == 2) {
                        unsigned q[8];
#pragma unroll
                        for (int j = 0; j < 4; ++j) { q[j] = (unsigned)(fsigmoid(v0[j]) * 255.0f + 0.5f); q[4 + j] = (unsigned)(fsigmoid(v1[j]) * 255.0f + 0.5f); }
                        v2u w8; w8.x = q[0] | (q[1] << 8) | (q[2] << 16) | (q[3] << 24); w8.y = q[4] | (q[5] << 8) | (q[6] << 16) | (q[7] << 24);
                        __builtin_nontemporal_store(w8, (v2u*)((unsigned char*)base + (size_t)r * 1024 + cl));
                    } else {
                        if (MODE == 1) {
#pragma unroll
                            for (int j = 0; j < 4; ++j) { v0[j] = gelu_t(v0[j]); v1[j] = gelu_t(v1[j]); } }
                        const v4u w = pack8(v0, v1);
                        const int g = cl >> 4, cp = cl & 15, b = r >> 12, l = r & 4095, n = b * S5NCH + (l >> 4), s = l & 15;
                        const size_t off = s5 ? ((size_t)(g * S5N + n) * S5K + S5Q + s * 16 + cp) : ((size_t)r * 1024 + cl);
                        __builtin_nontemporal_store(w, (v4u*)(base + off)); } }
                asm volatile("" ::: "memory"); }
    }
    __device__ __forceinline__ void operator()(const f32x4 (&acc)[2][2][4][2], const Unit& u, int wr, int wc, int fr, int fq) const {
        const int pn = u.pn, reg = pn < 2 ? 0 : ((pn - 2) >> 2) + 1;
        const int colbase = reg == 0 ? pn * 256 : ((pn - 2) & 3) * 256;
        if (reg < 2) tile<0>(acc, u, reg == 0 ? AG : XL, colbase, reg == 0, wr, wc, fr, fq);
        else if (reg == 2) tile<1>(acc, u, GL, colbase, false, wr, wc, fr, fq);
        else tile<2>(acc, u, reg == 3 ? GA : GB, colbase, false, wr, wc, fr, fq);
    }
};
struct EpiS5State {
    static constexpr bool PERM = false, ACC_INIT = false, B16 = false;
    float* SLOC;
    __device__ __forceinline__ void operator()(const f32x4 (&acc)[2][2][4][2], const Unit& u, int wr, int wc, int fr, int fq) const {
#pragma unroll
        for (int ai = 0; ai < 2; ++ai)
#pragma unroll
            for (int m = 0; m < 4; ++m) { const int nr = u.pm * 256 + ai * 128 + wr * 64 + m * 16 + fr; float* rowp = SLOC + (size_t)(u.aux * S5N + nr) * S5Q + wc * 32 + 4 * fq;
#pragma unroll
                for (int n = 0; n < 2; ++n) *(f32x4*)(rowp + n * 16) = acc[ai][0][m][n]; }
    }
};
struct EpiS5Out {
    static constexpr bool PERM = true, ACC_INIT = false, B16 = false;
    bf16* GY;
    __device__ __forceinline__ void operator()(const f32x4 (&acc)[2][2][4][2], const Unit& u, int wr, int wc, int fr, int fq) const {
#pragma unroll
        for (int ai = 0; ai < 2; ++ai)
#pragma unroll
            for (int m = 0; m < 4; ++m) { const int nr = u.pm * 256 + ai * 128 + wr * 64 + m * 16 + fr, b = nr >> 8, j16 = nr & 255;
#pragma unroll
                for (int bj = 0; bj < 2; ++bj) { const int cc = bj * 128 + wc * 32 + 8 * fq, t = cc >> 4, c0 = cc & 15;
                    f32x4 v0 = acc[ai][bj][m][0], v1 = acc[ai][bj][m][1];
#pragma unroll
                    for (int j = 0; j < 4; ++j) { v0[j] = gelu_t(v0[j]); v1[j] = gelu_t(v1[j]); }
                    *(v4u*)(GY + ((size_t)u.aux * T + (size_t)(b * SEQ + j16 * 16 + t)) * 16 + c0) = pack8(v0, v1); }
                asm volatile("" ::: "memory"); }
    }
};
struct EpiYa {
    static constexpr bool PERM = true, ACC_INIT = false, B16 = false;
    const bf16* GA; bf16* YA;
    __device__ __forceinline__ void operator()(const f32x4 (&acc)[2][2][4][2], const Unit& u, int wr, int wc, int fr, int fq) const {
        const size_t off0 = (size_t)(u.pm * 256 + wr * 64 + fr) * 1024 + u.pn * 128 + wc * 32 + 8 * fq;
        v2u gav[2][4];
#pragma unroll
        for (int ai = 0; ai < 2; ++ai)
#pragma unroll
            for (int m = 0; m < 4; ++m) gav[ai][m] = __builtin_nontemporal_load((const v2u*)((const unsigned char*)GA + off0 + (size_t)(ai * 128 + m * 16) * 1024));
        asm volatile("" ::: "memory");
#pragma unroll
        for (int ai = 0; ai < 2; ++ai)
#pragma unroll
            for (int m = 0; m < 4; ++m) { float gaf[8]; unpack_u8x8(gav[ai][m], gaf);
                f32x4 o0, o1;
#pragma unroll
                for (int j = 0; j < 4; ++j) { o0[j] = gaf[j] * acc[ai][0][m][0][j] * fsigmoid(acc[ai][1][m][0][j]); o1[j] = gaf[4 + j] * acc[ai][0][m][1][j] * fsigmoid(acc[ai][1][m][1][j]); }
                *(v4u*)(YA + off0 + (size_t)(ai * 128 + m * 16) * 1024) = pack8(o0, o1); }
    }
};
struct EpiYb {
    static constexpr bool PERM = true, ACC_INIT = false, B16 = false;
    const bf16* YA; const bf16* GB; bf16* MIX;
    __device__ __forceinline__ void operator()(const f32x4 (&acc)[2][2][4][2], const Unit& u, int wr, int wc, int fr, int fq) const {
        const size_t off0 = (size_t)(u.pm * 256 + wr * 64 + fr) * 1024 + u.pn * 256 + wc * 32 + 8 * fq;
        v4u ya[2][2][2]; v2u gb[2][2][2];
#define YB_LOAD(buf, grp) do { _Pragma("unroll") for (int mm = 0; mm < 2; ++mm) _Pragma("unroll") for (int bj = 0; bj < 2; ++bj) { \
            const size_t o = off0 + (size_t)(((grp) >> 1) * 128 + (2 * ((grp) & 1) + mm) * 16) * 1024 + bj * 128; ya[buf][mm][bj] = *(const v4u*)(YA + o); gb[buf][mm][bj] = __builtin_nontemporal_load((const v2u*)((const unsigned char*)GB + o)); } } while (0)
        YB_LOAD(0, 0);
#pragma unroll
        for (int grp = 0; grp < 4; ++grp) { const int buf = grp & 1, ai = grp >> 1;
            if (grp < 3) YB_LOAD(buf ^ 1, grp + 1);
            asm volatile("" ::: "memory");
#pragma unroll
            for (int mm = 0; mm < 2; ++mm) { const int m = 2 * (grp & 1) + mm;
#pragma unroll
                for (int bj = 0; bj < 2; ++bj) { const v4u y = ya[buf][mm][bj];
                    const float yaf[8] = {bflo(y.x), bfhi(y.x), bflo(y.y), bfhi(y.y), bflo(y.z), bfhi(y.z), bflo(y.w), bfhi(y.w)};
                    float gbf[8]; unpack_u8x8(gb[buf][mm][bj], gbf);
                    f32x4 o0, o1;
#pragma unroll
                    for (int j = 0; j < 4; ++j) { o0[j] = yaf[j] + gbf[j] * acc[ai][bj][m][0][j]; o1[j] = yaf[4 + j] + gbf[4 + j] * acc[ai][bj][m][1][j]; }
                    *(v4u*)(MIX + off0 + (size_t)(ai * 128 + m * 16) * 1024 + bj * 128) = pack8(o0, o1); } }
        }
#undef YB_LOAD
    }
};
struct EpiYaYb {
    static constexpr bool PERM = true, ACC_INIT = false, B16 = false;
    EpiYa a; EpiYb b;
    __device__ __forceinline__ void operator()(const f32x4 (&acc)[2][2][4][2], const Unit& u, int wr, int wc, int fr, int fq) const {
        if (__builtin_amdgcn_readfirstlane(u.kind) == 0) a(acc, u, wr, wc, fr, fq); else b(acc, u, wr, wc, fr, fq);
    }
};
struct EpiWo {
    static constexpr bool PERM = false, ACC_INIT = true, B16 = false;
    const float* X; float* O;
    __device__ __forceinline__ void init(f32x4 (&acc)[2][2][4][2], const Unit& u, int wr, int wc, int fr, int fq) const {
        const size_t off0 = (size_t)(u.pm * 256 + wr * 64 + fr) * 1024 + u.pn * 256 + wc * 32 + 4 * fq;
#pragma unroll
        for (int ai = 0; ai < 2; ++ai)
#pragma unroll
            for (int m = 0; m < 4; ++m)
#pragma unroll
                for (int bj = 0; bj < 2; ++bj)
#pragma unroll
                    for (int n = 0; n < 2; ++n) acc[ai][bj][m][n] = __builtin_nontemporal_load((const f32x4*)(X + off0 + (size_t)(ai * 128 + m * 16) * 1024 + bj * 128 + n * 16));
    }
    __device__ __forceinline__ void operator()(const f32x4 (&acc)[2][2][4][2], const Unit& u, int wr, int wc, int fr, int fq) const {
        const size_t off0 = (size_t)(u.pm * 256 + wr * 64 + fr) * 1024 + u.pn * 256 + wc * 32 + 4 * fq;
#pragma unroll
        for (int ai = 0; ai < 2; ++ai)
#pragma unroll
            for (int m = 0; m < 4; ++m)
#pragma unroll
                for (int bj = 0; bj < 2; ++bj)
#pragma unroll
                    for (int n = 0; n < 2; ++n) *(f32x4*)(O + off0 + (size_t)(ai * 128 + m * 16) * 1024 + bj * 128 + n * 16) = acc[ai][bj][m][n];
    }
};
struct EpiGU {
    static constexpr bool PERM = true, ACC_INIT = false, B16 = false;
    bf16* ACT; const LAS float* sclL;
    __device__ __forceinline__ void operator()(const f32x4 (&acc)[2][2][4][2], const Unit& u, int wr, int wc, int fr, int fq) const {
#pragma unroll
        for (int ai = 0; ai < 2; ++ai)
#pragma unroll
            for (int m = 0; m < 4; ++m) { const int rl = ai * 128 + wr * 64 + m * 16 + fr; const float sc = sclL[u.aux * 256 + rl];
                f32x4 o0, o1;
#pragma unroll
                for (int j = 0; j < 4; ++j) { const float g0 = acc[ai][0][m][0][j] * sc, g1 = acc[ai][0][m][1][j] * sc;
                    o0[j] = g0 * fsigmoid(g0) * (acc[ai][1][m][0][j] * sc); o1[j] = g1 * fsigmoid(g1) * (acc[ai][1][m][1][j] * sc); }
                *(v4u*)(ACT + (size_t)(u.pm * 256 + rl) * DEXP + u.pn * 128 + wc * 32 + 8 * fq) = pack8(o0, o1); }
    }
};
struct EpiDown {
    static constexpr bool PERM = true, ACC_INIT = false, B16 = false;
    bf16* YS; const LAS float* sclL;
    __device__ __forceinline__ void operator()(const f32x4 (&acc)[2][2][4][2], const Unit& u, int wr, int wc, int fr, int fq) const {
#pragma unroll
        for (int ai = 0; ai < 2; ++ai)
#pragma unroll
            for (int m = 0; m < 4; ++m) { const int rl = ai * 128 + wr * 64 + m * 16 + fr; const float sc = sclL[u.aux * 256 + rl];
#pragma unroll
                for (int bj = 0; bj < 2; ++bj)
                    *(v4u*)(YS + (size_t)(u.pm * 256 + rl) * 1024 + u.pn * 256 + bj * 128 + wc * 32 + 8 * fq) = pack8(acc[ai][bj][m][0] * sc, acc[ai][bj][m][1] * sc); }
    }
};

template <bool SCALED> struct EpiQ8 {
    static constexpr bool PERM = true, ACC_INIT = false, B16 = true;
    unsigned char* YS8; float* YSC; const LAS float* sclL;
    __device__ __forceinline__ void operator()(const f32x4 (&acc)[2][2][4][2], const Unit& u, int wr, int wc, int fr, int fq) const {
        float scs[2][4];
#pragma unroll
        for (int ai = 0; ai < 2; ++ai)
#pragma unroll
            for (int m = 0; m < 4; ++m) { const int rl = ai * 128 + wr * 64 + m * 16 + fr; const float sc = SCALED ? sclL[u.aux * 256 + rl] : 1.0f;
                float v[16]; float amax = 0.f;
#pragma unroll
                for (int bj = 0; bj < 2; ++bj)
#pragma unroll
                    for (int n = 0; n < 2; ++n)
#pragma unroll
                        for (int j = 0; j < 4; ++j) { const float x = acc[ai][bj][m][n][j] * sc; v[bj * 8 + n * 4 + j] = x; amax = fmaxf(amax, fabsf(x)); }
                amax = fmaxf(amax, __shfl_xor(amax, 16)); amax = fmaxf(amax, __shfl_xor(amax, 32));
                const float inv = amax > 0.f ? 127.0f / amax : 0.f;
                scs[ai][m] = amax * (1.0f / 127.0f);
                v4u w;
#pragma unroll
                for (int d = 0; d < 4; ++d) { const int q0 = (int)__builtin_rintf(v[4 * d] * inv), q1 = (int)__builtin_rintf(v[4 * d + 1] * inv), q2 = (int)__builtin_rintf(v[4 * d + 2] * inv), q3 = (int)__builtin_rintf(v[4 * d + 3] * inv);
                    w[d] = ((unsigned)q0 & 255u) | (((unsigned)q1 & 255u) << 8) | (((unsigned)q2 & 255u) << 16) | ((unsigned)q3 << 24); }
                *(v4u*)(YS8 + (size_t)(u.pm * 256 + rl) * 1024 + u.pn * 256 + wc * 64 + fq * 16) = w; }
#pragma unroll
        for (int ai = 0; ai < 2; ++ai) { const float sv = fq == 0 ? scs[ai][0] : fq == 1 ? scs[ai][1] : fq == 2 ? scs[ai][2] : scs[ai][3];
            YSC[(size_t)(u.pm * 256 + ai * 128 + wr * 64 + fq * 16 + fr) * 16 + wc * 4 + u.pn] = sv; }
    }
};

struct TItem { const float* W; int N; bf16* WT; int ldk, k0, n0, drow0; };
__device__ __forceinline__ void transpose_load(const TItem& it, f32x4 (&tv)[8], int lane) {
#pragma unroll
    for (int i = 0; i < 8; ++i) tv[i] = __builtin_nontemporal_load((const f32x4*)(it.W + (size_t)(it.k0 + 8 * i + (lane >> 3)) * it.N + it.n0 + 4 * (lane & 7)));
}
template <bool NT = false> __device__ __forceinline__ void transpose_store(const TItem& it, const f32x4 (&tv)[8], LAS float* scr, int lane) {
#pragma unroll
    for (int i = 0; i < 8; ++i) { LAS float* d = scr + (8 * i + (lane >> 3)) * 33 + 4 * (lane & 7); d[0] = tv[i].x; d[1] = tv[i].y; d[2] = tv[i].z; d[3] = tv[i].w; }
    LDS_WAIT(); asm volatile("" ::: "memory");
    const int c = lane & 7;
#pragma unroll
    for (int j = 0; j < 4; ++j) { const int n = (lane >> 3) + 8 * j; const LAS float* s = scr + (8 * c) * 33 + n;
        v4u o; o.x = pk2(s[0 * 33], s[1 * 33]); o.y = pk2(s[2 * 33], s[3 * 33]); o.z = pk2(s[4 * 33], s[5 * 33]); o.w = pk2(s[6 * 33], s[7 * 33]);
        if (NT) __builtin_nontemporal_store(o, (v4u*)(it.WT + (size_t)(it.drow0 + n) * it.ldk + it.k0 + 8 * c)); else *(v4u*)(it.WT + (size_t)(it.drow0 + n) * it.ldk + it.k0 + 8 * c) = o; }
    LDS_WAIT(); asm volatile("" ::: "memory");
}
__device__ __forceinline__ int ileave_row(int n, int half) { return 256 * (n >> 7) + 128 * half + (n & 127); }

template <int NR> __device__ __forceinline__ void rms_rows_to_bf16(const float* x0, const float* gain, bf16* o0, size_t rstride, int lane) {
    f32x4 v[NR][4];
#pragma unroll
    for (int r = 0; r < NR; ++r) { const f32x4* xr = (const f32x4*)(x0 + r * rstride) + lane;
#pragma unroll
        for (int j = 0; j < 4; ++j) v[r][j] = __builtin_nontemporal_load(xr + 64 * j); }
    asm volatile("" ::: "memory");
    const f32x4* gr = (const f32x4*)gain + lane;
    f32x4 g[4];
#pragma unroll
    for (int j = 0; j < 4; ++j) g[j] = gr[64 * j];
#pragma unroll
    for (int r = 0; r < NR; ++r) { float s = 0.f;
#pragma unroll
        for (int j = 0; j < 4; ++j) s += (v[r][j].x * v[r][j].x + v[r][j].y * v[r][j].y) + (v[r][j].z * v[r][j].z + v[r][j].w * v[r][j].w);
        const float rstd = 1.0f / sqrtf(wave_sum(s) * (1.f / D) + RMS_EPS);
        unsigned long long* o8 = (unsigned long long*)(o0 + r * rstride) + lane;
#pragma unroll
        for (int j = 0; j < 4; ++j) o8[64 * j] = (unsigned long long)pk2(v[r][j].x * rstd * g[j].x, v[r][j].y * rstd * g[j].y) | ((unsigned long long)pk2(v[r][j].z * rstd * g[j].z, v[r][j].w * rstd * g[j].w) << 32); }
}

__device__ __forceinline__ void s5_tables(const Frame& F, int g, const float* lam_re, const float* lam_im, const float* log_dt, const float* b_re, const float* b_im, const float* c_re, const float* c_im, const float* dsk) {
    LAS float* Cre = (LAS float*)F.lds;
    LAS float* Cim = Cre + 1024;
    LAS float* Bre = Cim + 1024;
    LAS float* Bim = Bre + 1024;
    LAS float* Pre = Bim + 1024;
    LAS float* Pim = Pre + 17 * 64;
    LAS float* Kt = Pim + 17 * 64;
    const int tid = F.tid;
    for (int i = tid; i < 1024; i += 512) { Cre[i] = c_re[g * 1024 + i]; Cim[i] = c_im[g * 1024 + i]; }
    if (tid < 64) {
        const int p = tid; const float lr = lam_re[g * 64 + p], li = lam_im[g * 64 + p], dt = expf(log_dt[g]);
        const float er = expf(lr * dt), lbr = er * cosf(li * dt), lbi = er * sinf(li * dt);
        const float den = lr * lr + li * li, nr = lbr - 1.0f, ni = lbi;
        const float cr = (nr * lr + ni * li) / den, ci = (ni * lr - nr * li) / den;
        { float pr = 1.f, pi = 0.f; for (int k = 0; k <= 16; ++k) { Pre[k * 64 + p] = pr; Pim[k * 64 + p] = pi; const float nr2 = pr * lbr - pi * lbi, ni2 = pr * lbi + pi * lbr; pr = nr2; pi = ni2; } }
        for (int c = 0; c < 16; ++c) { const float br = b_re[(g * 64 + p) * 16 + c], bi = b_im[(g * 64 + p) * 16 + c]; Bre[p * 16 + c] = cr * br - ci * bi; Bim[p * 16 + c] = cr * bi + ci * br; }
    }
    __syncthreads();
    for (int e = tid; e < 4096; e += 512) {
        const int k = e >> 8, c = (e >> 4) & 15, cp = e & 15; float s = 0.f;
        for (int p = 0; p < 64; ++p) { const float xr = Cre[c * 64 + p] * Pre[k * 64 + p] - Cim[c * 64 + p] * Pim[k * 64 + p], xi = Cre[c * 64 + p] * Pim[k * 64 + p] + Cim[c * 64 + p] * Pre[k * 64 + p];
            s += xr * Bre[p * 16 + cp] - xi * Bim[p * 16 + cp]; }
        if (k == 0 && c == cp) s += dsk[g * 16 + c];
        Kt[e] = s;
    }
    __syncthreads();
    unsigned* btt = (unsigned*)(F.ws + WS_BTT) + (size_t)g * 256 * (S5K / 2);
    for (int e = tid; e < 256 * (S5K / 2); e += 512) {
        const int row = e / (S5K / 2), cpair = e % (S5K / 2), t = row >> 4, c = row & 15, col = 2 * cpair; float v0, v1;
        if (col < S5Q) { const int p = col >> 1; const float xr = Cre[c * 64 + p] * Pre[(t + 1) * 64 + p] - Cim[c * 64 + p] * Pim[(t + 1) * 64 + p], xi = Cre[c * 64 + p] * Pim[(t + 1) * 64 + p] + Cim[c * 64 + p] * Pre[(t + 1) * 64 + p];
            v0 = xr; v1 = -xi; }
        else { const int s = (col - S5Q) >> 4, cp = (col - S5Q) & 15;
            if (s <= t) { v0 = Kt[(t - s) * 256 + c * 16 + cp]; v1 = Kt[(t - s) * 256 + c * 16 + cp + 1]; } else { v0 = 0.f; v1 = 0.f; } }
        btt[e] = pk2(v0, v1);
    }
    unsigned* btw = (unsigned*)(F.ws + WS_BTW) + (size_t)g * 128 * 128;
    for (int e = tid; e < 128 * 128; e += 512) {
        const int q = e >> 7, cpair = e & 127, col = 2 * cpair, s = col >> 4, cp = col & 15, p = q >> 1, k = 15 - s;
        const float pr = Pre[k * 64 + p], pi = Pim[k * 64 + p];
        float v0, v1;
        if (q & 1) { v0 = pr * Bim[p * 16 + cp] + pi * Bre[p * 16 + cp]; v1 = pr * Bim[p * 16 + cp + 1] + pi * Bre[p * 16 + cp + 1]; }
        else { v0 = pr * Bre[p * 16 + cp] - pi * Bim[p * 16 + cp]; v1 = pr * Bre[p * 16 + cp + 1] - pi * Bim[p * 16 + cp + 1]; }
        btw[e] = pk2(v0, v1);
    }
    if (tid < 64) { float* l16 = (float*)(F.ws + SM_LAM16) + (g * 64 + tid) * 2; l16[0] = Pre[16 * 64 + tid]; l16[1] = Pim[16 * 64 + tid]; }
    __syncthreads();
}

struct In { const float* p[30]; };

__device__ __forceinline__ void p0_prologue(const Frame& F, const In& I) {
    for (int g = F.vcu; g < S5G; g += F.G) s5_tables(F, g, I.p[3], I.p[4], I.p[5], I.p[6], I.p[7], I.p[8], I.p[9], I.p[10]);
    const int gt = F.vcu * 512 + F.tid, NGT = F.G * 512;
    { float* lc = (float*)(F.ws + SM_LRUC); for (int i = gt; i < LRUW; i += NGT) { const float lam = I.p[18][i]; lc[i] = -8.0f * log1pf(expf(-lam)) * 1.44269504f; } }
    { bf16* wrt = (bf16*)(F.ws + SM_WRT);
        for (int i = gt; i < 2 * 65536; i += NGT) { const int which = i >> 16, r = i & 65535, h = r >> 12, j = (r >> 6) & 63, k = r & 63; const float* src = which ? I.p[16] : I.p[14]; wrt[i] = (bf16)f2bf(src[(h * 64 + k) * 64 + j]); } }
    { bf16* rhi = (bf16*)(F.ws + SM_RHI); bf16* rlo = (bf16*)(F.ws + SM_RLO);
        for (int i = gt; i < NROUT * 1024; i += NGT) { const int n = i >> 10, k = i & 1023; float w = 0.f; if (n < 4) w = I.p[22][k * 4 + n]; else if (n < 36) w = I.p[24][k * 32 + (n - 4)];
            const unsigned h = f2bf(w); rhi[i] = (bf16)h; rlo[i] = (bf16)f2bf(w - bf2f(h)); } }
    LAS float* scr = (LAS float*)(F.lds + F.wave * 16384);
    const int gw = F.vcu * NWAVES + F.wave, NGW = F.G * NWAVES;
    constexpr int I_IN = (D / 64) * (NIN / 32), I_S5 = (S5W / 64) * (2 * D / 32), I_LRU = (D / 64) * (D / 32), I_O = I_LRU;
    constexpr int NITEMS = I_IN + I_S5 + I_LRU + I_O;
    for (int it = gw; it < NITEMS; it += NGW) {
        int r = it; TItem ti;
        if (r < I_IN) { const int nb = NIN / 32, kb = r / nb, n0 = 32 * (r % nb); ti = TItem{I.p[2], NIN, (bf16*)(F.ws + WS_WIN), D, 64 * kb, n0, n0}; }
        else if ((r -= I_IN) < I_S5) { const int nb = 2 * D / 32, kb = r / nb, n0 = 32 * (r % nb); ti = TItem{I.p[11], 2 * D, (bf16*)(F.ws + WS_WS5), S5W, 64 * kb, n0, n0 < D ? ileave_row(n0, 0) : ileave_row(n0 - D, 1)}; }
        else if ((r -= I_S5) < I_LRU) { const int nb = D / 32, kb = r / nb, n0 = 32 * (r % nb); ti = TItem{I.p[19], D, (bf16*)(F.ws + WS_WLRU), D, 64 * kb, n0, n0}; }
        else { r -= I_LRU; const int nb = D / 32, kb = r / nb, n0 = 32 * (r % nb); ti = TItem{I.p[20], D, (bf16*)(F.ws + WS_WO), D, 64 * kb, n0, n0}; }
        f32x4 tv[8]; transpose_load(ti, tv, F.lane); asm volatile("" ::: "memory"); transpose_store(ti, tv, scr, F.lane);
    }
    { const int skip = F.G > 2 * S5G ? S5G : 0;
      if (F.vcu >= skip) { const int gw2 = (F.vcu - skip) * NWAVES + F.wave, NGW2 = (F.G - skip) * NWAVES;
        for (int m = gw2 * 4; m < T; m += NGW2 * 4) rms_rows_to_bf16<4>(I.p[0] + (size_t)m * D, I.p[1], (bf16*)(F.ws + WS_H) + (size_t)m * D, D, F.lane); } }
}
__device__ __forceinline__ TItem expert_item(const Frame& F, const In& I, int it) {
    const int e = it >> 9, half = (it >> 8) & 1, r = it & 255, nb = DEXP / 32, kb = r / nb, n0 = 32 * (r % nb);
    return TItem{(half ? I.p[27] : I.p[26]) + (size_t)e * D * DEXP, DEXP, (bf16*)(F.ws + WS_WGU) + (size_t)e * 1024 * 1024, D, 64 * kb, n0, ileave_row(n0, half)};
}
__device__ __forceinline__ TItem expert_item_d(const Frame& F, const In& I, int it) {
    const int e = it >> 8, r = it & 255, nb = D / 32, kb = r / nb, n0 = 32 * (r % nb);
    return TItem{I.p[28] + (size_t)e * DEXP * D, D, (bf16*)(F.ws + WS_WD) + (size_t)e * 1024 * DEXP, DEXP, 64 * kb, n0, n0};
}
__device__ __forceinline__ void expert_weight_copies(const Frame& F, const In& I) {
    LAS float* scr = (LAS float*)(F.lds + F.wave * 16384);
    const int gw = F.vcu * NWAVES + F.wave, NGW = F.G * NWAVES;
    constexpr int NIT = NEXP * 512;
    for (int it = 8 * NGW + gw; it < NIT; it += NGW) { const TItem t0 = expert_item(F, I, it); f32x4 v0[8]; transpose_load(t0, v0, F.lane); asm volatile("" ::: "memory"); transpose_store(t0, v0, scr, F.lane); }
}
__device__ __forceinline__ void expert_down_copies(const Frame& F, const In& I) {
    LAS float* scr = (LAS float*)(F.lds + F.wave * 16384);
    const int nunits = (int)F.MISC[128] * 4, rem = nunits % F.G, nbusy = rem;
    const int nfree = F.G - nbusy;
    if (F.vcu < nbusy) return;
    const int gw = (F.vcu - nbusy) * NWAVES + F.wave, NGW = nfree * NWAVES;
    constexpr int NIT = NEXP * 256;
    for (int it = gw; it < NIT; it += 2 * NGW) {
        const TItem t0 = expert_item_d(F, I, it); const bool has1 = it + NGW < NIT; const TItem t1 = expert_item_d(F, I, has1 ? it + NGW : it);
        f32x4 v0[8], v1[8]; transpose_load(t0, v0, F.lane); transpose_load(t1, v1, F.lane); asm volatile("" ::: "memory");
        transpose_store(t0, v0, scr, F.lane); if (has1) transpose_store(t1, v1, scr, F.lane);
    }
}

__device__ __forceinline__ void lru_seq(const Frame& F, const In& I) {
    LAS unsigned char* wl = F.lds + F.wave * 17920;
    LAS bf16* xcA = (LAS bf16*)wl;
    LAS float* pre = (LAS float*)(wl + 9216);
    typedef float f32x2 __attribute__((ext_vector_type(2)));
    LAS f32x2* sumT = (LAS f32x2*)(F.lds + 143360);
    const int lane = F.lane, jj = lane & 15, ks = lane >> 4, c32 = lane & 31, th = lane >> 5;
    const bf16* XL = (const bf16*)(F.ws + WS_XL); const bf16* GL = (const bf16*)(F.ws + WS_GL); bf16* YL = (bf16*)(F.ws + WS_H);
    const bf16* WRT = (const bf16*)(F.ws + SM_WRT);
    for (int un = F.vcu; un < BATCH * LRUH * 2; un += F.G) {
        const int b = un >> 5, hd = (un >> 1) & 15, half = un & 1;
        const int chin = hd * 64 + lane;
        const int chg = hd * 64 + 32 * half + c32;
        const float w0 = I.p[12][chin], w1 = I.p[12][1024 + chin], w2 = I.p[12][2048 + chin], w3 = I.p[12][3072 + chin], cb = I.p[13][chin];
        const float brs = I.p[15][chg] * -1.44269504f, bis = I.p[17][chg] * -1.44269504f, cch2 = ((const float*)(F.ws + SM_LRUC))[chg];
        float Rc = 0.f;
        for (int rd = 0; rd < 8; ++rd) {
            const int j = rd * 8 + F.wave;
            const size_t tok0 = (size_t)b * SEQ + (size_t)j * LRUCH;
            unsigned short xr[64], xh[3];
            { const bf16* xp = XL + tok0 * 1024 + chin;
              xh[0] = 0; xh[1] = 0; xh[2] = 0;
              if (j > 0) { xh[0] = xp[-3 * 1024]; xh[1] = xp[-2 * 1024]; xh[2] = xp[-1 * 1024]; }
#pragma unroll
              for (int t = 0; t < 64; ++t) xr[t] = xp[t * 1024]; }
            asm volatile("" ::: "memory");
            { typedef float f2v __attribute__((ext_vector_type(2)));
              float xm3 = bf2f(xh[0]), xm2 = bf2f(xh[1]), xm1 = bf2f(xh[2]);
              const f2v vw0 = {w0, w0}, vw1 = {w1, w1}, vw2 = {w2, w2}, vw3 = {w3, w3}, vcb = {cb, cb};
#pragma unroll
              for (int t = 0; t < 64; t += 2) { const float x0 = bf2f(xr[t]), x1 = bf2f(xr[t + 1]);
                  f2v xc = vcb + vw0 * (f2v){xm3, xm2}; xc = xc + vw1 * (f2v){xm2, xm1}; xc = xc + vw2 * (f2v){xm1, x0}; xc = xc + vw3 * (f2v){x0, x1};
                  const unsigned pk = pg8::cvt_pk_bf16(xc.x, xc.y);
                  xcA[t * 72 + lane] = (bf16)(pk & 0xffffu); xcA[(t + 1) * 72 + lane] = (bf16)(pk >> 16);
                  xm3 = xm1; xm2 = x0; xm1 = x1; } }
            LDS_WAIT();
            float hl[2][16], Pl[2][16], Prun[2], Hrun[2];
#pragma unroll
            for (int st = 0; st < 2; ++st) {
                bf16x8 Bw[4][2];
#pragma unroll
                for (int n = 0; n < 4; ++n)
#pragma unroll
                    for (int k = 0; k < 2; ++k) Bw[n][k] = *(const bf16x8*)(WRT + (size_t)(n >> 1) * 65536 + (size_t)(hd * 64 + 32 * half + 16 * (n & 1) + jj) * 64 + 32 * k + 8 * ks);
#pragma unroll
                for (int mh = 0; mh < 2; ++mh) { const int mt = 2 * st + mh;
                    bf16x8 a[2];
#pragma unroll
                    for (int k = 0; k < 2; ++k) a[k] = *(const LAS bf16x8*)(xcA + (16 * mt + jj) * 72 + 32 * k + 8 * ks);
#pragma unroll
                    for (int n = 0; n < 4; ++n) { f32x4 d = (f32x4){0.f, 0.f, 0.f, 0.f};
#pragma unroll
                        for (int k = 0; k < 2; ++k) d = __builtin_amdgcn_mfma_f32_16x16x32_bf16(a[k], Bw[n][k], d, 0, 0, 0);
#pragma unroll
                        for (int r = 0; r < 4; ++r) pre[(16 * mh + 4 * ks + r) * 68 + 16 * n + jj] = d[r]; } }
                LDS_WAIT();
                float h = 0.f, P = 1.f;
                typedef float f2v __attribute__((ext_vector_type(2)));
#pragma unroll
                for (int tl = 0; tl < 16; tl += 2) {
                    const int trow = 16 * th + tl;
                    const f2v pr = {pre[trow * 68 + c32], pre[(trow + 1) * 68 + c32]}, pi = {pre[trow * 68 + 32 + c32], pre[(trow + 1) * 68 + 32 + c32]};
                    const f2v zr = pr * (f2v){-1.44269504f, -1.44269504f} + (f2v){brs, brs}, zi = pi * (f2v){-1.44269504f, -1.44269504f} + (f2v){bis, bis};
                    const f2v er = {__builtin_amdgcn_exp2f(zr.x), __builtin_amdgcn_exp2f(zr.y)}, ei = {__builtin_amdgcn_exp2f(zi.x), __builtin_amdgcn_exp2f(zi.y)};
                    const f2v dr = er + (f2v){1.f, 1.f};
                    const f2v rg = {__builtin_amdgcn_rcpf(dr.x), __builtin_amdgcn_rcpf(dr.y)};
                    const f2v la2 = rg * (f2v){cch2, cch2};
                    const f2v a_ = {__builtin_amdgcn_exp2f(la2.x), __builtin_amdgcn_exp2f(la2.y)};
                    const f2v x2 = la2 * (f2v){1.38629436f, 1.38629436f};
                    f2v q = x2 * (f2v){0.0013888889f, 0.0013888889f} + (f2v){0.0083333333f, 0.0083333333f};
                    q = q * x2 + (f2v){0.041666667f, 0.041666667f}; q = q * x2 + (f2v){0.16666667f, 0.16666667f}; q = q * x2 + (f2v){0.5f, 0.5f}; q = q * x2 + (f2v){1.f, 1.f};
                    f2v om = -(q * x2);
                    const f2v alt = (f2v){1.f, 1.f} - a_ * a_;
                    om.x = x2.x > -0.3f ? om.x : alt.x; om.y = x2.y > -0.3f ? om.y : alt.y;
                    om.x = fmaxf(om.x, 1e-30f); om.y = fmaxf(om.y, 1e-30f);
                    const f2v dd = ei + (f2v){1.f, 1.f};
                    const f2v rq = om * dd * dd;
                    const f2v mi = om * (f2v){__builtin_amdgcn_rsqf(rq.x), __builtin_amdgcn_rsqf(rq.y)};
                    const f2v bx = mi * (f2v){bf2f(xcA[(32 * st + trow) * 72 + 32 * half + c32]), bf2f(xcA[(32 * st + trow + 1) * 72 + 32 * half + c32])};
                    h = a_.x * h + bx.x; P *= a_.x; hl[st][tl] = h; Pl[st][tl] = P;
                    h = a_.y * h + bx.y; P *= a_.y; hl[st][tl + 1] = h; Pl[st][tl + 1] = P;
                }
                Prun[st] = P; Hrun[st] = h;
                LDS_WAIT();
            }
            const float pP0 = __shfl_xor(Prun[0], 32), pH0 = __shfl_xor(Hrun[0], 32), pP1 = __shfl_xor(Prun[1], 32), pH1 = __shfl_xor(Hrun[1], 32);
            const float P0 = th ? pP0 : Prun[0], H0 = th ? pH0 : Hrun[0], P1 = th ? Prun[0] : pP0, H1 = th ? Hrun[0] : pH0;
            const float P2 = th ? pP1 : Prun[1], H2 = th ? pH1 : Hrun[1], P3 = th ? Prun[1] : pP1, H3 = th ? Hrun[1] : pH1;
            const float C1 = H0, Q1 = P0, C2 = P1 * C1 + H1, Q2 = P1 * Q1, C3 = P2 * C2 + H2, Q3 = P2 * Q2, Hc = P3 * C3 + H3, Pc = P3 * Q3;
            const float Cs0 = th ? C1 : 0.f, Qs0 = th ? Q1 : 1.f, Cs1 = th ? C3 : C2, Qs1 = th ? Q3 : Q2;
            const int cit = (rd * F.G + F.vcu) * NWAVES + F.wave; const bool cdo = cit < NEXP * 512;
            f32x4 ctv[8]; unsigned short ggr[2][16];
            if (cdo) { const TItem citem = expert_item(F, I, cit); transpose_load(citem, ctv, lane); }
#pragma unroll
            for (int st = 0; st < 2; ++st)
#pragma unroll
                for (int tl = 0; tl < 16; ++tl) ggr[st][tl] = GL[(tok0 + 32 * st + 16 * th + tl) * 1024 + chg];
            asm volatile("" ::: "memory");
            if (th == 0) sumT[((rd & 1) * 8 + F.wave) * 32 + c32] = (f32x2){Pc, Hc};
            LDS_WAIT();
            __syncthreads();
            float cin = Rc, mycin = 0.f;
#pragma unroll
            for (int w = 0; w < 8; ++w) { const f32x2 ph = sumT[((rd & 1) * 8 + w) * 32 + c32]; mycin = (w == F.wave) ? cin : mycin; cin = ph.x * cin + ph.y; }
            Rc = cin;
#pragma unroll
            for (int st = 0; st < 2; ++st) { const float hin = (st ? Cs1 : Cs0) + (st ? Qs1 : Qs0) * mycin;
#pragma unroll
                for (int tl = 0; tl < 16; ++tl) { const float hh = hl[st][tl] + Pl[st][tl] * hin;
                    YL[(tok0 + 32 * st + 16 * th + tl) * 1024 + chg] = (bf16)f2bf(hh * bf2f(ggr[st][tl])); } }
            if (cdo) { const TItem citem = expert_item(F, I, cit); transpose_store<true>(citem, ctv, pre, lane); }
        }
        __syncthreads();
    }
}

__device__ __forceinline__ void s5_chain(const Frame& F, int b, int g) {
    typedef float f32x2 __attribute__((ext_vector_type(2)));
    LAS f32x2* segE = (LAS f32x2*)(F.lds);
    const int lane = F.lane, w = F.wave;
    const float* SLOC = (const float*)(F.ws + WS_SLOC); unsigned* AGw = (unsigned*)(F.ws + WS_AG); const float* L16 = (const float*)(F.ws + SM_LAM16);
    const float lr = L16[(g * 64 + lane) * 2], li = L16[(g * 64 + lane) * 2 + 1];
    const float* sl = SLOC + ((size_t)(g * S5N + b * S5NCH + 32 * w)) * S5Q + 2 * lane;
    unsigned* ag = AGw + ((size_t)(g * S5N + b * S5NCH + 32 * w)) * (S5K / 2) + lane;
    float xr[32], xi[32];
#pragma unroll
    for (int u = 0; u < 32; ++u) { const float2 v = *(const float2*)(sl + (size_t)u * S5Q); xr[u] = v.x; xi[u] = v.y; }
    asm volatile("" ::: "memory");
    float sr = 0.f, si = 0.f;
#pragma unroll
    for (int u = 0; u < 32; ++u) { const float nr = lr * sr - li * si + xr[u], ni = lr * si + li * sr + xi[u]; xr[u] = sr; xi[u] = si; sr = nr; si = ni; }
    segE[w * 64 + lane] = (f32x2){sr, si};
    float qr = lr, qi = li;
#pragma unroll
    for (int k = 0; k < 5; ++k) { const float nr = qr * qr - qi * qi, ni = 2.f * qr * qi; qr = nr; qi = ni; }
    LDS_WAIT();
    __syncthreads();
    float cr = 0.f, ci = 0.f;
    for (int ww = 0; ww < w; ++ww) { const f32x2 e = segE[ww * 64 + lane]; const float nr = qr * cr - qi * ci + e.x, ni = qr * ci + qi * cr + e.y; cr = nr; ci = ni; }
#pragma unroll
    for (int u = 0; u < 32; ++u) { ag[(size_t)u * (S5K / 2)] = pk2(xr[u] + cr, xi[u] + ci); const float nr = lr * cr - li * ci, ni = lr * ci + li * cr; cr = nr; ci = ni; }
    __syncthreads();
}

__device__ __forceinline__ void p8_router(const Frame& F, const In& I) {
    const int lane = F.lane, tk = lane & 15, ks = lane >> 4;
    LAS float* lg = (LAS float*)(F.lds + F.wave * 4096);
    volatile LAS unsigned* cntL = F.MISC + 32; volatile LAS unsigned* baseL = F.MISC + 64;
    const float* X1 = I.p[0]; bf16* H2 = (bf16*)(F.ws + WS_H2); const float* gf = I.p[21];
    const unsigned char* D8 = (const unsigned char*)(F.ws + WS_D8); const float* DSC = (const float*)(F.ws + WS_DSC);
    const bf16* RHI = (const bf16*)(F.ws + SM_RHI); const bf16* RLO = (const bf16*)(F.ws + SM_RLO);
    float* RSTD = (float*)(F.ws + SM_RSTD); unsigned* gcnt = F.ctl + CW_CNT;
    int* LTOK = (int*)(F.ws + WS_LTOK); float* LW = (float*)(F.ws + WS_LW); int* TOKE = (int*)(F.ws + WS_TOKE); int* TOKR = (int*)(F.ws + WS_TOKR);
    for (int blk = F.vcu; blk < T / 128; blk += F.G) {
        if (F.tid < 32) cntL[F.tid] = 0u;
        __syncthreads();
        const int tok0 = blk * 128 + F.wave * 16;
        const float* xrow = X1 + (size_t)(tok0 + tk) * D + 8 * ks; bf16* hrow = H2 + (size_t)(tok0 + tk) * D + 8 * ks;
        f32x4 acc[3]; acc[0] = acc[1] = acc[2] = (f32x4){0.f, 0.f, 0.f, 0.f}; float ss = 0.f;
        const unsigned char* drow = D8 + (size_t)(tok0 + tk) * D + 8 * ks; const float* dsc = DSC + (size_t)(tok0 + tk) * 16;
        f32x4 xnx[4][2]; v2u dnx[4]; float snx[2];
#pragma unroll
        for (int q = 0; q < 4; ++q) { xnx[q][0] = __builtin_nontemporal_load((const f32x4*)(xrow + 32 * q)); xnx[q][1] = __builtin_nontemporal_load((const f32x4*)(xrow + 32 * q + 4)); dnx[q] = *(const v2u*)(drow + 32 * q); }
        snx[0] = dsc[0]; snx[1] = dsc[4];
        LAS bf16* slab = (LAS bf16*)(F.lds + 32768);
        v4u wst[3];
#define RT_SLAB_LOAD(g) do { _Pragma("unroll") for (int j = 0; j < 3; ++j) { const int c = F.tid + 512 * j, which = c / 768, r = (c % 768) >> 4, kq = c & 15; \
            wst[j] = *(const v4u*)((which ? RLO : RHI) + (size_t)r * D + 128 * (g) + 8 * kq); } } while (0)
#define RT_SLAB_STORE(buf) do { _Pragma("unroll") for (int j = 0; j < 3; ++j) { const int c = F.tid + 512 * j, which = c / 768, r = (c % 768) >> 4, kq = c & 15; \
            *(LAS v4u*)(slab + ((size_t)((buf) * 2 + which) * 48 + r) * 136 + 8 * kq) = wst[j]; } } while (0)
        RT_SLAB_LOAD(0); RT_SLAB_STORE(0);
        LDS_WAIT();
        __syncthreads();
        for (int kg = 0; kg < 8; ++kg) {
            f32x4 xa[4][2];
#pragma unroll
            for (int q = 0; q < 4; ++q) { const float sq = snx[q >> 1]; const v2u dq = dnx[q];
                xa[q][0] = xnx[q][0] + (f32x4){(float)((int)(dq.x << 24) >> 24), (float)((int)(dq.x << 16) >> 24), (float)((int)(dq.x << 8) >> 24), (float)((int)dq.x >> 24)} * sq;
                xa[q][1] = xnx[q][1] + (f32x4){(float)((int)(dq.y << 24) >> 24), (float)((int)(dq.y << 16) >> 24), (float)((int)(dq.y << 8) >> 24), (float)((int)dq.y >> 24)} * sq; }
            { const int kgn = kg < 7 ? kg + 1 : kg;
#pragma unroll
              for (int q = 0; q < 4; ++q) { xnx[q][0] = __builtin_nontemporal_load((const f32x4*)(xrow + 32 * (4 * kgn + q))); xnx[q][1] = __builtin_nontemporal_load((const f32x4*)(xrow + 32 * (4 * kgn + q) + 4)); dnx[q] = *(const v2u*)(drow + 32 * (4 * kgn + q)); }
              { const int G0 = 2 * kgn, G1 = 2 * kgn + 1; snx[0] = dsc[(G0 & 3) * 4 + (G0 >> 2)]; snx[1] = dsc[(G1 & 3) * 4 + (G1 >> 2)]; }
              RT_SLAB_LOAD(kgn); }
            f32x4 ga[4][2];
#pragma unroll
            for (int q = 0; q < 4; ++q) { const int kc = 4 * kg + q; ga[q][0] = *(const f32x4*)(gf + 32 * kc + 8 * ks); ga[q][1] = *(const f32x4*)(gf + 32 * kc + 8 * ks + 4); }
            asm volatile("" ::: "memory");
            const LAS bf16* sh = slab + (size_t)((kg & 1) * 2) * 48 * 136, * sl = sh + 48 * 136;
#pragma unroll
            for (int q = 0; q < 4; ++q) { const int kc = 4 * kg + q;
                const f32x4 a0 = xa[q][0], a1 = xa[q][1];
                ss += (a0.x * a0.x + a0.y * a0.y) + (a0.z * a0.z + a0.w * a0.w) + (a1.x * a1.x + a1.y * a1.y) + (a1.z * a1.z + a1.w * a1.w);
                const f32x4 v0 = a0 * ga[q][0], v1 = a1 * ga[q][1];
                v4u hi, lo;
                hi.x = pg8::cvt_pk_bf16(v0.x, v0.y); hi.y = pg8::cvt_pk_bf16(v0.z, v0.w); hi.z = pg8::cvt_pk_bf16(v1.x, v1.y); hi.w = pg8::cvt_pk_bf16(v1.z, v1.w);
                lo.x = pg8::cvt_pk_bf16(v0.x - bflo(hi.x), v0.y - bfhi(hi.x)); lo.y = pg8::cvt_pk_bf16(v0.z - bflo(hi.y), v0.w - bfhi(hi.y));
                lo.z = pg8::cvt_pk_bf16(v1.x - bflo(hi.z), v1.y - bfhi(hi.z)); lo.w = pg8::cvt_pk_bf16(v1.z - bflo(hi.w), v1.w - bfhi(hi.w));
                *(v4u*)(hrow + 32 * kc) = hi;
                const bf16x8 hf = __builtin_bit_cast(bf16x8, hi), lf = __builtin_bit_cast(bf16x8, lo);
#pragma unroll
                for (int n = 0; n < 3; ++n) {
                    const bf16x8 wh = *(const LAS bf16x8*)(sh + (16 * n + tk) * 136 + 32 * q + 8 * ks), wl = *(const LAS bf16x8*)(sl + (16 * n + tk) * 136 + 32 * q + 8 * ks);
                    acc[n] = __builtin_amdgcn_mfma_f32_16x16x32_bf16(wh, hf, acc[n], 0, 0, 0);
                    acc[n] = __builtin_amdgcn_mfma_f32_16x16x32_bf16(wh, lf, acc[n], 0, 0, 0);
                    acc[n] = __builtin_amdgcn_mfma_f32_16x16x32_bf16(wl, hf, acc[n], 0, 0, 0);
                } }
            if (kg < 7) RT_SLAB_STORE((kg + 1) & 1);
            LDS_WAIT();
            __syncthreads();
        }
#undef RT_SLAB_LOAD
#undef RT_SLAB_STORE
        ss += __shfl_xor(ss, 16); ss += __shfl_xor(ss, 32);
        const float rstd = 1.0f / sqrtf(ss * (1.f / D) + RMS_EPS);
        if (ks == 0) RSTD[tok0 + tk] = rstd;
#pragma unroll
        for (int n = 0; n < 3; ++n)
#pragma unroll
            for (int r = 0; r < 4; ++r) lg[tk * 49 + 16 * n + 4 * ks + r] = acc[n][r] * rstd;
        LDS_WAIT();
        int E1 = 0, E2 = 0; float w1 = 0.f, w2 = 0.f; unsigned r1 = 0, r2 = 0;
        if (lane < 16) {
            const LAS float* my = lg + lane * 49;
            float lgp[4];
#pragma unroll
            for (int i = 0; i < 4; ++i) lgp[i] = my[i] + I.p[23][i];
            int gi = 0; float mx = lgp[0];
#pragma unroll
            for (int i = 1; i < 4; ++i) if (lgp[i] > mx) { mx = lgp[i]; gi = i; }
            float den = 0.f;
#pragma unroll
            for (int i = 0; i < 4; ++i) den += expf(lgp[i] - mx);
            const float pg = 1.0f / den;
            float le[8];
#pragma unroll
            for (int i = 0; i < 8; ++i) le[i] = my[4 + gi * 8 + i] + I.p[25][gi * 8 + i];
            int i1 = 0; float m1 = le[0];
#pragma unroll
            for (int i = 1; i < 8; ++i) if (le[i] > m1) { m1 = le[i]; i1 = i; }
            int i2 = -1; float m2 = -3.0e38f;
#pragma unroll
            for (int i = 0; i < 8; ++i) if (i != i1 && le[i] > m2) { m2 = le[i]; i2 = i; }
            const float e2 = expf(m2 - m1);
            w1 = pg / (1.0f + e2); w2 = pg * e2 / (1.0f + e2);
            E1 = gi * 8 + i1; E2 = gi * 8 + i2;
            r1 = __hip_atomic_fetch_add((LAS unsigned*)(F.MISC + 32) + E1, 1u, __ATOMIC_RELAXED, __HIP_MEMORY_SCOPE_WORKGROUP);
            r2 = __hip_atomic_fetch_add((LAS unsigned*)(F.MISC + 32) + E2, 1u, __ATOMIC_RELAXED, __HIP_MEMORY_SCOPE_WORKGROUP);
        }
        LDS_WAIT();
        __syncthreads();
        if (F.tid < 32) { const unsigned c = cntL[F.tid]; baseL[F.tid] = c ? __hip_atomic_fetch_add(gcnt + F.tid, c, __ATOMIC_RELAXED, __HIP_MEMORY_SCOPE_AGENT) : 0u; }
        __syncthreads();
        if (lane < 16) {
            const int tok = tok0 + lane; const int k1 = (int)(baseL[E1] + r1), k2 = (int)(baseL[E2] + r2);
            LTOK[(size_t)E1 * T + k1] = tok; LW[(size_t)E1 * T + k1] = w1; LTOK[(size_t)E2 * T + k2] = tok; LW[(size_t)E2 * T + k2] = w2;
            TOKE[tok * 2] = E1; TOKE[tok * 2 + 1] = E2; TOKR[tok * 2] = k1; TOKR[tok * 2 + 1] = k2;
        }
        __syncthreads();
    }
}

__device__ __forceinline__ void moe_prefix(const Frame& F) {
    if (F.tid < 64) {
        const unsigned nt = F.tid < NEXP ? (F.ctl[CW_CNT + F.tid] + 255u) >> 8 : 0u; unsigned inc = nt;
#pragma unroll
        for (int o = 1; o < 32; o <<= 1) { const unsigned v = __shfl_up(inc, o); if (F.lane >= o) inc += v; }
        if (F.tid < NEXP) F.MISC[96 + F.tid] = inc - nt;
        if (F.tid == NEXP - 1) F.MISC[128] = inc;
    }
    LDS_WAIT();
    __syncthreads();
}
template <int MODE  >
__device__ __forceinline__ void moe_setup(const Frame& F) {
    moe_prefix(F);
    const int NT = (int)F.MISC[128];
    if (F.tid < MAXU) { const int L = F.tid * F.G + F.vcu; int e = -1, mt = 0;
        if (L < NT * 4) { const int mtg = L >> 2; e = 0; while (e < NEXP - 1 && (int)F.MISC[96 + e + 1] <= mtg) ++e; mt = mtg - (int)F.MISC[96 + e]; }
        F.MISC[136 + F.tid] = (unsigned)e; F.MISC[144 + F.tid] = (unsigned)mt; }
    __syncthreads();
    if (F.tid == 0) { int n = 0; while (n < MAXU && (int)F.MISC[136 + n] >= 0) ++n; F.MISC[152] = (unsigned)n; }
    __syncthreads();
    const int nU = (int)F.MISC[152];
    LAS int* tokL = (LAS int*)(F.lds + TOKL_OFF); LAS float* sclL = (LAS float*)(F.lds + SCLL_OFF);
    const int* LTOK = (const int*)(F.ws + WS_LTOK); const float* LW = (const float*)(F.ws + WS_LW); const float* RSTD = (const float*)(F.ws + SM_RSTD);
    for (int i = F.tid; i < nU * 256; i += 512) { const int ui = i >> 8, r = i & 255, e = (int)F.MISC[136 + ui], rank = (int)F.MISC[144 + ui] * 256 + r; const bool valid = rank < (int)F.ctl[CW_CNT + e];
        const int tok = valid ? LTOK[(size_t)e * T + rank] : 0; tokL[i] = tok; sclL[i] = valid ? (MODE == 0 ? RSTD[tok] : LW[(size_t)e * T + rank]) : 0.f; }
    LDS_WAIT(); VM_WAIT();
    __syncthreads();
}

__device__ __forceinline__ void p11_final(const Frame& F, const In& I, float* dst) {
    moe_prefix(F);
    const int gw = F.vcu * NWAVES + F.wave, NGW = F.G * NWAVES, lane = F.lane;
    const int* TOKE = (const int*)(F.ws + WS_TOKE); const int* TOKR = (const int*)(F.ws + WS_TOKR);
    const unsigned char* YS8 = (const unsigned char*)(F.ws + WS_YS); const float* YSC = (const float*)(F.ws + WS_YS + 80 * MiB);
    const unsigned char* D8 = (const unsigned char*)(F.ws + WS_D8); const float* DSC = (const float*)(F.ws + WS_DSC); const float* X = I.p[0];
    f32x4 gfin[4];
#pragma unroll
    for (int j = 0; j < 4; ++j) gfin[j] = ((const f32x4*)I.p[29])[lane + 64 * j];
    int ee[2][2], rr[2][2];
    { const int m0 = gw * 2 < T ? gw * 2 : 0;
#pragma unroll
      for (int q = 0; q < 2; ++q) { ee[q][0] = TOKE[2 * (m0 + q)]; ee[q][1] = TOKE[2 * (m0 + q) + 1]; rr[q][0] = TOKR[2 * (m0 + q)]; rr[q][1] = TOKR[2 * (m0 + q) + 1]; } }
    for (int m0 = gw * 2; m0 < T; m0 += NGW * 2) {
        f32x4 xv[2][4]; unsigned ya[2][4], yb[2][4], yd[2][4]; f32x4 sa[2], sb[2], sd[2];
#pragma unroll
        for (int q = 0; q < 2; ++q) { const size_t s0 = (size_t)F.MISC[96 + ee[q][0]] * 256 + rr[q][0], s1 = (size_t)F.MISC[96 + ee[q][1]] * 256 + rr[q][1];
            const f32x4* xr = (const f32x4*)(X + (size_t)(m0 + q) * D) + lane; const unsigned* y0 = (const unsigned*)(YS8 + s0 * 1024) + lane; const unsigned* y1 = (const unsigned*)(YS8 + s1 * 1024) + lane;
            const unsigned* d0 = (const unsigned*)(D8 + (size_t)(m0 + q) * 1024) + lane;
#pragma unroll
            for (int j = 0; j < 4; ++j) { xv[q][j] = __builtin_nontemporal_load(xr + 64 * j); ya[q][j] = y0[64 * j]; yb[q][j] = y1[64 * j]; yd[q][j] = d0[64 * j]; }
            sa[q] = *(const f32x4*)(YSC + s0 * 16 + 4 * (lane >> 4)); sb[q] = *(const f32x4*)(YSC + s1 * 16 + 4 * (lane >> 4)); sd[q] = *(const f32x4*)(DSC + (size_t)(m0 + q) * 16 + 4 * (lane >> 4)); }
        { const int mn = m0 + NGW * 2 < T ? m0 + NGW * 2 : m0;
#pragma unroll
          for (int q = 0; q < 2; ++q) { ee[q][0] = TOKE[2 * (mn + q)]; ee[q][1] = TOKE[2 * (mn + q) + 1]; rr[q][0] = TOKR[2 * (mn + q)]; rr[q][1] = TOKR[2 * (mn + q) + 1]; } }
        asm volatile("" ::: "memory");
#pragma unroll
        for (int q = 0; q < 2; ++q) { f32x4 v[4]; float s = 0.f;
#pragma unroll
            for (int j = 0; j < 4; ++j) { const f32x4 x = xv[q][j]; const unsigned a = ya[q][j], b = yb[q][j], c = yd[q][j]; const float ka = sa[q][j], kb = sb[q][j], kc = sd[q][j];
                v[j].x = (x.x + (float)((int)(c << 24) >> 24) * kc) + (float)((int)(a << 24) >> 24) * ka + (float)((int)(b << 24) >> 24) * kb;
                v[j].y = (x.y + (float)((int)(c << 16) >> 24) * kc) + (float)((int)(a << 16) >> 24) * ka + (float)((int)(b << 16) >> 24) * kb;
                v[j].z = (x.z + (float)((int)(c << 8) >> 24) * kc) + (float)((int)(a << 8) >> 24) * ka + (float)((int)(b << 8) >> 24) * kb;
                v[j].w = (x.w + (float)((int)c >> 24) * kc) + (float)((int)a >> 24) * ka + (float)((int)b >> 24) * kb;
                s += (v[j].x * v[j].x + v[j].y * v[j].y) + (v[j].z * v[j].z + v[j].w * v[j].w); }
            const float rstd = 1.0f / sqrtf(wave_sum(s) * (1.f / D) + RMS_EPS);
            f32x4* xw = (f32x4*)(dst + (size_t)(m0 + q) * D) + lane;
#pragma unroll
            for (int j = 0; j < 4; ++j) { const f32x4 g = gfin[j]; __builtin_nontemporal_store((f32x4){v[j].x * rstd * g.x, v[j].y * rstd * g.y, v[j].z * rstd * g.z, v[j].w * rstd * g.w}, xw + 64 * j); } }
    }
}

constexpr int N_PHASES = 12;
struct Args { In in; float* out; unsigned char* ws; float* fin_dst; int ph_lo, ph_hi, li, pad; };
__global__ void __launch_bounds__(NWAVES * 64, 2) mk_fwd(Args args) {
    extern __shared__ __attribute__((aligned(16))) unsigned char lds[];
    Frame F;
    F.lds = (LAS unsigned char*)lds;
    F.MISC = (volatile LAS unsigned*)(F.lds + MISC_OFF);
    F.tid = threadIdx.x; F.lane = F.tid & 63; F.wave = __builtin_amdgcn_readfirstlane(F.tid >> 6);
    F.G = gridDim.x; { const int bx = blockIdx.x; F.vcu = (F.G % 8 == 0) ? (bx % 8) * (F.G / 8) + bx / 8 : bx; }
    F.ws = args.ws; F.out = args.out; F.ctl = (unsigned*)(args.ws + WS_CTL); F.in = nullptr;
    const In& I = args.in;
    for (int u = F.tid; u < 256; u += NWAVES * 64) F.MISC[u] = 0u;
    __syncthreads();
    const int lo = args.ph_lo, hi = args.ph_hi;
    XcdBarrier bar; bar.bar = F.ctl + CW_BAR + args.li * XCD_BAR_WORDS; bar.x = 0; bar.st = nullptr;
    if (hi - lo > 1) bar = xcd_barrier_post(F.ctl + CW_BAR + args.li * XCD_BAR_WORDS, F.MISC + 8);
#ifndef PH_MASK
#define PH_MASK 0xFFF
#endif
#define IN(k) (((PH_MASK >> (k)) & 1) && lo <= (k) && (k) < hi)
#define SEAM(k) do { if (IN(k) && IN(NEXT_PH(k))) xcd_barrier(bar); } while (0)
#define NEXT_PH(k) ((k) == 2 ? 5 : (k) == 5 ? 7 : (k) + 1)
    const int cblk = (int)blockIdx.x;
    LAS unsigned char* ring = F.lds;

    if (IN(0)) { p0_prologue(F, I); SEAM(0); }

    if (IN(1)) {
        DenseOrder S; S.init(F.ws + WS_H, F.ws + WS_WIN, D, D, T, NIN, F.G, cblk);
        EpiInProj E{(bf16*)(F.ws + WS_AG), (bf16*)(F.ws + WS_XL), (bf16*)(F.ws + WS_GL), (bf16*)(F.ws + WS_GA), (bf16*)(F.ws + WS_GB)};
        pg8::gemm_phase<EpiInProj, DenseOrder, true>(ring, D, D, S, E);
        SEAM(1);
    }
    if (IN(2)) {
        if (cblk < 256) {
            const int L = cblk, wgid = (L % 8) * 32 + L / 8, g = wgid >> 3, mt = wgid & 7;
            { S5One S{(const char*)(F.ws + WS_AG) + S5Q * 2, (const char*)(F.ws + WS_BTW), (size_t)S5N * S5K * 2, (size_t)128 * 256 * 2, S5K, g, mt};
              EpiS5State E{(float*)(F.ws + WS_SLOC)};
              pg8::gemm_phase<EpiS5State, S5One, false>(ring, 256, 256, S, E); }
            if (F.wave == 0) { __builtin_amdgcn_fence(__ATOMIC_ACQUIRE, "agent"); VM_WAIT(); }
            __syncthreads();
            s5_chain(F, mt, g);
            VM_WAIT();
            __syncthreads();
            if (F.wave == 0) { __builtin_amdgcn_fence(__ATOMIC_ACQUIRE, "agent"); VM_WAIT(); }
            __syncthreads();
            { S5One S{(const char*)(F.ws + WS_AG), (const char*)(F.ws + WS_BTT), (size_t)S5N * S5K * 2, (size_t)256 * S5K * 2, S5K, g, mt};
              EpiS5Out E{(bf16*)(F.ws + WS_GY)};
              pg8::gemm_phase<EpiS5Out, S5One, false>(ring, S5K, S5K, S, E); }
            __syncthreads();
        }
        lru_seq(F, I);
        SEAM(2);
    }
    if (IN(5)) {
        YaYbOrder S; S.d.init(nullptr, nullptr, D, D, T, D, F.G, cblk);
        S.GYb = (const char*)(F.ws + WS_GY); S.WS5b = (const char*)(F.ws + WS_WS5); S.YLb = (const char*)(F.ws + WS_H); S.WLb = (const char*)(F.ws + WS_WLRU);
        EpiYaYb E{EpiYa{(const bf16*)(F.ws + WS_GA), (bf16*)(F.ws + WS_XL)}, EpiYb{(const bf16*)(F.ws + WS_XL), (const bf16*)(F.ws + WS_GB), (bf16*)(F.ws + WS_GL)}};
        pg8::gemm_phase<EpiYaYb, YaYbOrder, true>(ring, D, D, S, E);
        SEAM(5);
    }
    if (IN(7)) {
        DenseOrder S; S.init(F.ws + WS_GL, F.ws + WS_WO, D, D, T, D, F.G, cblk);
        EpiQ8<false> E{(unsigned char*)(F.ws + WS_D8), (float*)(F.ws + WS_DSC), nullptr};
        pg8::gemm_phase<EpiQ8<false>, DenseOrder, true>(ring, D, D, S, E);
        SEAM(7);
    }
    if (IN(8)) { p8_router(F, I); __syncthreads(); expert_weight_copies(F, I); SEAM(8); }
    if (IN(9)) {
        moe_setup<0>(F);
        MoeOrder<true> S{(const char*)(F.ws + WS_H2), (const char*)(F.ws + WS_WGU), (size_t)1024 * 1024 * 2, D, D, F.G, F.vcu, F.MISC, (const LAS int*)(F.lds + TOKL_OFF)};
        EpiGU E{(bf16*)(F.ws + WS_ACT), (const LAS float*)(F.lds + SCLL_OFF)};
        pg8::gemm_phase<EpiGU, MoeOrder<true>, true>(ring, D, D, S, E);
        __syncthreads();
        expert_down_copies(F, I);
        SEAM(9);
    }
    if (IN(10)) {
        moe_setup<1>(F);
        MoeOrder<false> S{(const char*)(F.ws + WS_ACT), (const char*)(F.ws + WS_WD), (size_t)1024 * DEXP * 2, DEXP, DEXP, F.G, F.vcu, F.MISC, (const LAS int*)(F.lds + TOKL_OFF)};
        EpiQ8<true> E{(unsigned char*)(F.ws + WS_YS), (float*)(F.ws + WS_YS + 80 * MiB), (const LAS float*)(F.lds + SCLL_OFF)};
        pg8::gemm_phase<EpiQ8<true>, MoeOrder<false>, true>(ring, DEXP, DEXP, S, E);
        SEAM(10);
    }
    if (IN(11)) { p11_final(F, I, args.fin_dst); }
#undef IN
#undef SEAM
}

extern "C" void kernel_launch(void* const* d_in, const int* in_sizes, int n_in, void* d_out, int out_size, void* d_ws, size_t ws_size, hipStream_t stream) {
    static int grid = 0;
    if (grid == 0) {
        if (n_in != 30 || in_sizes[0] != T * D || out_size != T * D || ws_size < WS_END) { fprintf(stderr, "kernel_launch: unexpected shapes / workspace (n_in %d, ws %zu)\n", n_in, ws_size); grid = -1; return; }
        int dev = 0, cus = 0, per_cu = 0;
        if (hipGetDevice(&dev) != hipSuccess || hipDeviceGetAttribute(&cus, hipDeviceAttributeMultiprocessorCount, dev) != hipSuccess) { grid = -1; return; }
        if (hipFuncSetAttribute((const void*)mk_fwd, hipFuncAttributeMaxDynamicSharedMemorySize, LDS_BYTES) != hipSuccess) { fprintf(stderr, "kernel_launch: hipFuncSetAttribute failed\n"); grid = -1; return; }
        if (hipOccupancyMaxActiveBlocksPerMultiprocessor(&per_cu, (const void*)mk_fwd, NWAVES * 64, LDS_BYTES) != hipSuccess || per_cu < 1) { fprintf(stderr, "kernel_launch: occupancy query says %d\n", per_cu); }
        (void)hipGetLastError();
        grid = cus;
    }
    if (grid < 0) return;
    if (hipMemsetAsync((char*)d_ws + WS_CTL, 0, CTL_ZERO_BYTES, stream) != hipSuccess) return;
    Args a{};
    for (int i = 0; i < 30; ++i) a.in.p[i] = (const float*)d_in[i];
    a.out = (float*)d_out; a.ws = (unsigned char*)d_ws; a.fin_dst = (float*)d_out;
#if defined(PROBE_LO)
    a.ph_lo = 0; a.ph_hi = PROBE_HI; a.li = 0;
#if PROBE_LO == 11
    a.fin_dst = (float*)((char*)d_ws + WS_H2);
#endif
    hipLaunchKernelGGL(mk_fwd, dim3(grid), dim3(NWAVES * 64), LDS_BYTES, stream, a);
#if PROBE_LO == 8
    hipMemsetAsync((char*)d_ws + WS_CTL + CW_CNT * 4, 0, 128, stream);
#endif
    a.fin_dst = (float*)d_out;
    a.ph_lo = PROBE_LO; a.ph_hi = N_PHASES; a.li = 1;
    hipLaunchKernelGGL(mk_fwd, dim3(grid), dim3(NWAVES * 64), LDS_BYTES, stream, a);
#elif MK_N_LAUNCHES == 1
    a.ph_lo = 0; a.ph_hi = N_PHASES;
    hipLaunchKernelGGL(mk_fwd, dim3(grid), dim3(NWAVES * 64), LDS_BYTES, stream, a);
#else
    for (int p = 0; p < N_PHASES; ++p) { a.ph_lo = p; a.ph_hi = p + 1; hipLaunchKernelGGL(mk_fwd, dim3(grid), dim3(NWAVES * 64), LDS_BYTES, stream, a); }
#endif
}
```

```cpp
#include <hip/hip_runtime.h>
#include <cstdio>
#include <cstdint>

#ifndef MK_N_LAUNCHES
#define MK_N_LAUNCHES 1
#endif

namespace pg8 {
#define PG8_LAS __attribute__((address_space(3)))
typedef unsigned short bf16_t;
typedef short bf16x8 __attribute__((ext_vector_type(8)));
typedef float f32x4 __attribute__((ext_vector_type(4)));
typedef unsigned u32x4 __attribute__((ext_vector_type(4)));
constexpr int BM = 256, BK = 64, HALF = 128, HTB = HALF * BK * 2  , STAGE_BYTES = 8 * HTB, NXCD = 8, WGM = 8;

__host__ __device__ __forceinline__ int lds_byte(int r, int c) { const int st = (r >> 4) * 2 + (c >> 5), rr = r & 15, cc = c & 31, ob = rr * 64 + cc * 2; return st * 1024 + (ob ^ (((ob >> 9) & 1) << 5)); }
__host__ __device__ __forceinline__ void stage_rc(int b, int& R, int& C) { const int st = b / 1024, sb = b % 1024, swz = sb ^ (((sb >> 9) & 1) << 5); R = (st >> 1) * 16 + swz / 64; C = (st & 1) * 32 + (swz % 64) / 2; }
__host__ __device__ __forceinline__ int perm32(int rho) { const int n = rho >> 4, i = rho & 15; return 8 * (i >> 2) + 4 * n + (i & 3); }

struct Unit { const char* A; const char* B; int pm, pn, aux, nt, kind; unsigned kA; };

__device__ __forceinline__ unsigned cvt_pk_bf16(float lo, float hi) { unsigned r; asm volatile("v_cvt_pk_bf16_f32 %0, %1, %2" : "=v"(r) : "v"(lo), "v"(hi)); return r; }

template <class Epi, class Sched, bool ALIGN_EPI>
__device__ __forceinline__ void gemm_phase(PG8_LAS unsigned char* lds, const int ldb, const int K, const Sched& S, const Epi& E, const size_t kstepA = (size_t)(BK * 2)) {
    const int tid = threadIdx.x, wid = __builtin_amdgcn_readfirstlane(tid >> 6), lane = tid & 63, wr = wid >> 2, wc = wid & 3, fr = lane & 15, fq = lane >> 4;
    int nt = K / BK; asm volatile("" : "+s"(nt));
    int Rr[2], Cc[2], Rbb[2]; unsigned voffB[4], vAc[4], vAn[4];
#pragma unroll
    for (int i = 0; i < 2; ++i) { int R, C; stage_rc(tid * 16 + i * 8192, R, C); Rr[i] = R; Cc[i] = C; const int Rb = Epi::PERM ? ((R & ~31) + perm32(R & 31)) : R; Rbb[i] = Rb;
        int Rb0 = Rb, Rb1 = HALF + Rb;
        if constexpr (Epi::B16) {
            const int w_ = R >> 5, nn_ = (R >> 4) & 1, ii_ = R & 15; Rb0 = 64 * w_ + 16 * (ii_ >> 2) + 4 * nn_ + (ii_ & 3); Rb1 = Rb0 + 8; }
        voffB[i] = (unsigned)(Rb0 * ldb + C) * 2u; voffB[2 + i] = (unsigned)(Rb1 * ldb + C) * 2u; }
    const size_t kstep = (size_t)(BK * 2);
    const unsigned ldsw = (unsigned)wid * 1024u;
    const int aoff = lds_byte(wr * 64 + fr, fq * 8), boff = lds_byte(wc * 32 + fr, fq * 8);
#define PG8_SA(b, h) (((b) * 2 + (h)) * HTB)
#define PG8_SB(b, h) ((4 + (b) * 2 + (h)) * HTB)
#define PG8_STAGE(bufoff, gbase, voff, h) do { _Pragma("unroll") for (int _i = 0; _i < 2; ++_i) \
        __builtin_amdgcn_global_load_lds((const unsigned*)((const char*)(gbase) + (voff)[2 * (h) + _i]), (PG8_LAS unsigned*)(lds + (bufoff) + ldsw + _i * 8192), 16, 0, 0); } while (0)
#define PG8_LDA(dst, b, h) do { _Pragma("unroll") for (int m = 0; m < 4; ++m) _Pragma("unroll") for (int k = 0; k < 2; ++k) dst[m][k] = *(const PG8_LAS bf16x8*)(lds + PG8_SA(b, h) + aoff + m * 2048 + k * 1024); } while (0)
#define PG8_LDB(dst, b, h) do { _Pragma("unroll") for (int n = 0; n < 2; ++n) _Pragma("unroll") for (int k = 0; k < 2; ++k) dst[n][k] = *(const PG8_LAS bf16x8*)(lds + PG8_SB(b, h) + boff + n * 2048 + k * 1024); } while (0)
#define PG8_MMA(ai, bj, At, Bt) do { __builtin_amdgcn_s_setprio(1); _Pragma("unroll") for (int m = 0; m < 4; ++m) _Pragma("unroll") for (int n = 0; n < 2; ++n) _Pragma("unroll") for (int k = 0; k < 2; ++k) \
        acc[ai][bj][m][n] = __builtin_amdgcn_mfma_f32_16x16x32_bf16(Bt[n][k], At[m][k], acc[ai][bj][m][n], 0, 0, 0); __builtin_amdgcn_s_setprio(0); } while (0)
#define PG8_WAIT_V(n) asm volatile("s_waitcnt vmcnt(" #n ")" ::: "memory")
#define PG8_WAIT_L(n) asm volatile("s_waitcnt lgkmcnt(" #n ")" ::: "memory")
#define PG8_BAR __builtin_amdgcn_s_barrier()
#define PG8_SCHED __builtin_amdgcn_sched_barrier(0)
    Unit cur, nxt; int ui = 0;
    if (!S.next(0, cur)) return;
    S.a_offsets(cur, Rr, Cc, vAc);
    unsigned vBc[4], vBn[4];
    if constexpr (Sched::HETERO) { S.b_offsets(cur, Rbb, Cc, vBc); nt = __builtin_amdgcn_readfirstlane(cur.nt); }
    else {
#pragma unroll
        for (int q = 0; q < 4; ++q) vBc[q] = voffB[q]; }
    size_t kAc = Sched::HETERO ? (size_t)(unsigned)__builtin_amdgcn_readfirstlane((int)cur.kA) : kstepA;
    f32x4 acc[2][2][4][2];
    if constexpr (Epi::ACC_INIT) E.init(acc, cur, wr, wc, fr, fq);
    else {
#pragma unroll
    for (int a = 0; a < 2; ++a)
#pragma unroll
        for (int b = 0; b < 2; ++b)
#pragma unroll
            for (int m = 0; m < 4; ++m)
#pragma unroll
                for (int n = 0; n < 2; ++n) acc[a][b][m][n] = (f32x4){0.f, 0.f, 0.f, 0.f}; }
    bf16x8 At[4][2], B0[2][2], B1[2][2];
    const char* cA = cur.A; const char* cB = cur.B;
    if constexpr (Sched::GATHER) { PG8_WAIT_L(0); }
    PG8_STAGE(PG8_SB(0, 0), cB, vBc, 0); PG8_STAGE(PG8_SB(0, 1), cB, vBc, 1); PG8_STAGE(PG8_SA(0, 0), cA, vAc, 0); PG8_STAGE(PG8_SA(0, 1), cA, vAc, 1);
    if (wr == 1) PG8_BAR;
    PG8_WAIT_V(2); PG8_BAR;
    PG8_STAGE(PG8_SB(1, 0), cB + kstep, vBc, 0); PG8_STAGE(PG8_SA(1, 0), cA + kAc, vAc, 0); PG8_STAGE(PG8_SB(1, 1), cB + kstep, vBc, 1);
    PG8_WAIT_V(6); PG8_BAR;
    for (;;) {
        const bool has_next = S.next(ui + 1, nxt);
        const char* nA = has_next ? nxt.A : cA; const char* nB = has_next ? nxt.B : cB;
        size_t kAn = kAc;
        if constexpr (Sched::HETERO) { if (has_next) { S.b_offsets(nxt, Rbb, Cc, vBn); kAn = (size_t)(unsigned)__builtin_amdgcn_readfirstlane((int)nxt.kA); } else {
#pragma unroll
                for (int q = 0; q < 4; ++q) vBn[q] = vBc[q]; } }
        for (int t = 0; t < nt; t += 2) {
            const bool last = (t == nt - 2);
            const char* a1 = cA + (size_t)(t + 1) * kAc;
            const char* a2 = last ? nA : cA + (size_t)(t + 2) * kAc; const char* b2 = last ? nB : cB + (size_t)(t + 2) * kstep;
            const char* a3 = a2 + (last ? kAn : kAc); const char* b3 = b2 + kstep;
            unsigned vb2[4];
#pragma unroll
            for (int q = 0; q < 4; ++q) vb2[q] = (Sched::HETERO && last) ? vBn[q] : vBc[q];
            unsigned va2[4];
            if constexpr (Sched::GATHER || Sched::HETERO) {
                if (last) { if (has_next) { S.a_offsets(nxt, Rr, Cc, vAn); if constexpr (Sched::GATHER) { PG8_WAIT_L(0); } } else {
#pragma unroll
                        for (int q = 0; q < 4; ++q) vAn[q] = vAc[q]; } }
#pragma unroll
                for (int q = 0; q < 4; ++q) va2[q] = last ? vAn[q] : vAc[q];
            } else {
#pragma unroll
                for (int q = 0; q < 4; ++q) va2[q] = vAc[q];
            }
            PG8_LDB(B0, 0, 0); PG8_LDB(B1, 0, 1); PG8_SCHED; PG8_LDA(At, 0, 0); PG8_STAGE(PG8_SA(1, 1), a1, vAc, 1);
            PG8_WAIT_V(8); PG8_WAIT_L(0); PG8_BAR; PG8_MMA(0, 0, At, B0); PG8_MMA(0, 1, At, B1); PG8_BAR; PG8_SCHED;
            const bool fin = last && !has_next;
            PG8_LDA(At, 0, 1);
            if (!fin) { PG8_STAGE(PG8_SB(0, 0), b2, vb2, 0); PG8_STAGE(PG8_SB(0, 1), b2, vb2, 1); PG8_STAGE(PG8_SA(0, 0), a2, va2, 0); PG8_WAIT_V(8); } else { PG8_WAIT_V(0); }
            PG8_WAIT_L(0); PG8_BAR; PG8_MMA(1, 0, At, B0); PG8_MMA(1, 1, At, B1); PG8_BAR; PG8_SCHED;
            PG8_LDB(B0, 1, 0); PG8_LDB(B1, 1, 1); PG8_SCHED; PG8_LDA(At, 1, 0);
            if (!fin) { PG8_STAGE(PG8_SA(0, 1), a2, va2, 1); PG8_WAIT_V(8); } else { PG8_WAIT_V(0); }
            PG8_WAIT_L(0); PG8_BAR; PG8_MMA(0, 0, At, B0); PG8_MMA(0, 1, At, B1); PG8_BAR; PG8_SCHED;
            PG8_LDA(At, 1, 1);
            if (!fin) { PG8_STAGE(PG8_SB(1, 0), b3, vb2, 0); PG8_STAGE(PG8_SB(1, 1), b3, vb2, 1); PG8_STAGE(PG8_SA(1, 0), a3, va2, 0); PG8_WAIT_V(8); } else { PG8_WAIT_V(0); }
            PG8_WAIT_L(0); PG8_BAR; PG8_MMA(1, 0, At, B0); PG8_MMA(1, 1, At, B1); PG8_BAR; PG8_SCHED;
        }
        if constexpr (ALIGN_EPI) { if (wr == 0) PG8_BAR; }
        E(acc, cur, wr, wc, fr, fq);
        if (!has_next) break;
        if constexpr (Epi::ACC_INIT) E.init(acc, nxt, wr, wc, fr, fq);
        else {
#pragma unroll
        for (int a = 0; a < 2; ++a)
#pragma unroll
            for (int b = 0; b < 2; ++b)
#pragma unroll
                for (int m = 0; m < 4; ++m)
#pragma unroll
                    for (int n = 0; n < 2; ++n) acc[a][b][m][n] = (f32x4){0.f, 0.f, 0.f, 0.f}; }
        cur = nxt; cA = nA; cB = nB; ++ui;
        if constexpr (Sched::GATHER || Sched::HETERO) {
#pragma unroll
            for (int q = 0; q < 4; ++q) vAc[q] = vAn[q]; }
        if constexpr (Sched::HETERO) {
#pragma unroll
            for (int q = 0; q < 4; ++q) vBc[q] = vBn[q];
            kAc = kAn; nt = __builtin_amdgcn_readfirstlane(cur.nt); }
        if constexpr (ALIGN_EPI) { if (wr == 1) PG8_BAR; }
    }
    PG8_WAIT_V(0);
    if constexpr (!ALIGN_EPI) { if (wr == 0) PG8_BAR; }
    PG8_BAR;
#undef PG8_SA
#undef PG8_SB
#undef PG8_STAGE
#undef PG8_LDA
#undef PG8_LDB
#undef PG8_MMA
#undef PG8_WAIT_V
#undef PG8_WAIT_L
#undef PG8_BAR
#undef PG8_SCHED
}
}

constexpr int NWAVES = 8;
constexpr int BATCH = 8, SEQ = 4096, D = 1024, T = BATCH * SEQ;
constexpr int S5W = 512, S5G = 32, S5C = 16, S5P = 64, S5Q = 128;
constexpr int S5LC = 16, S5NCH = SEQ / S5LC, S5N = BATCH * S5NCH;
constexpr int S5K = S5Q + S5LC * S5C;
constexpr int LRUW = 1024, LRUH = 16, LRUHD = 64, LRUCH = 64, LRUNCH = SEQ / LRUCH;
constexpr int NIN = S5W + 2 * LRUW + 2 * D;
constexpr int NEXP = 32, EPG = 8, NGRP = 4, DEXP = 512, NROUT = 48;
constexpr int MAXSLOT = 73728;
constexpr int MAXU = 8;
constexpr float RMS_EPS = 1e-6f;

constexpr size_t MiB = 1u << 20;
constexpr size_t WS_CTL = 0, CTL_ZERO_BYTES = 128 * 1024;
constexpr size_t WS_SMALL = 1 * MiB;
constexpr size_t SM_LAM16 = WS_SMALL + 0;
constexpr size_t SM_LRUC = WS_SMALL + 16384;
constexpr size_t SM_WRT = WS_SMALL + 32768;
constexpr size_t SM_RHI = WS_SMALL + 327680;
constexpr size_t SM_RLO = SM_RHI + 98304;
constexpr size_t SM_RSTD = WS_SMALL + 524288;
constexpr size_t WS_BTT = 2 * MiB;
constexpr size_t WS_BTW = 8 * MiB;
constexpr size_t WS_WIN = 11 * MiB;
constexpr size_t WS_WS5 = 20 * MiB;
constexpr size_t WS_WLRU = 22 * MiB;
constexpr size_t WS_WO = 24 * MiB;
constexpr size_t WS_LP = 26 * MiB, WS_LH = 28 * MiB, WS_LHIN = 30 * MiB;
constexpr size_t WS_AG = 32 * MiB;
constexpr size_t WS_SLOC = 80 * MiB;
constexpr size_t WS_H = 112 * MiB;
constexpr size_t WS_XL = 176 * MiB;
constexpr size_t WS_GL = 240 * MiB;
constexpr size_t WS_GA = 304 * MiB, WS_GB = 336 * MiB;
constexpr size_t WS_GY = 368 * MiB;
constexpr size_t WS_D8 = 336 * MiB, WS_DSC = 368 * MiB;
constexpr size_t WS_WGU = 400 * MiB;
constexpr size_t WS_WD = 464 * MiB;
constexpr size_t WS_H2 = 32 * MiB;
constexpr size_t WS_ACT = 96 * MiB;
constexpr size_t WS_YS = 168 * MiB;
constexpr size_t WS_LTOK = 312 * MiB, WS_LW = 316 * MiB;
constexpr size_t WS_TOKE = 320 * MiB, WS_TOKR = WS_TOKE + 262144;
constexpr size_t WS_END = 496 * MiB;
static_assert(WS_YS + (size_t)MAXSLOT * 1024 * 2 <= WS_LTOK && WS_ACT + (size_t)MAXSLOT * 512 * 2 <= WS_YS && WS_TOKR + 262144 <= WS_WGU && WS_GY + (size_t)T * 512 * 2 <= WS_WGU && WS_WD + (size_t)32 * 1024 * 512 * 2 <= WS_END, "d_ws map");
constexpr int CW_BAR = 4096;
constexpr int CW_CNT = 16384;

constexpr int RING_BYTES = 131072;
constexpr int TOKL_OFF = RING_BYTES, SCLL_OFF = TOKL_OFF + MAXU * 256 * 4, MISC_OFF = SCLL_OFF + MAXU * 256 * 4;
constexpr int LDS_BYTES = MISC_OFF + 1024;

#define GAS __attribute__((address_space(1)))
#define LAS __attribute__((address_space(3)))
typedef unsigned short bf16;
typedef unsigned v4u __attribute__((ext_vector_type(4)));
typedef unsigned v2u __attribute__((ext_vector_type(2)));
typedef float f32x4 __attribute__((ext_vector_type(4)));
typedef short bf16x8 __attribute__((ext_vector_type(8)));
#define LDS_WAIT() asm volatile("s_waitcnt lgkmcnt(0)" ::: "memory")
#define VM_WAIT() asm volatile("s_waitcnt vmcnt(0)" ::: "memory")
__device__ __forceinline__ unsigned pk2(float lo, float hi) { unsigned r; asm volatile("v_cvt_pk_bf16_f32 %0, %1, %2" : "=v"(r) : "v"(lo), "v"(hi)); return r; }
__device__ __forceinline__ unsigned f2bf(float f) { return pk2(f, 0.f) & 0xffffu; }
__device__ __forceinline__ float bf2f(unsigned h) { return __builtin_bit_cast(float, h << 16); }
__device__ __forceinline__ float bflo(unsigned w) { return __builtin_bit_cast(float, w << 16); }
__device__ __forceinline__ float bfhi(unsigned w) { return __builtin_bit_cast(float, w & 0xffff0000u); }
__device__ __forceinline__ float fsigmoid(float x) { return __builtin_amdgcn_rcpf(1.0f + __builtin_amdgcn_exp2f(-1.44269504f * x)); }
__device__ __forceinline__ float gelu_t(float x) { const float u = x * (0.7978845608f + 0.0356774081f * x * x); return x * __builtin_amdgcn_rcpf(1.0f + __builtin_amdgcn_exp2f(-2.88539008f * u)); }
__device__ __forceinline__ float wave_sum(float v) {
#pragma unroll
    for (int o = 1; o < 64; o <<= 1) v += __shfl_xor(v, o);
    return v;
}

#define XB_TMO      128
#define XB_XCNT(j)  (256  + 64 * (j))
#define XB_XSUB(j)  (1280 + 64 * (j))
#define XB_XGEN(j)  (2304 + 64 * (j))
#define XB_TOP      3328
#define XB_TOPGEN   3392
#define XCD_BAR_WORDS 3456
#define XB_SPIN_CAP (1u << 18)
__device__ __forceinline__ unsigned xb_ld(unsigned* p)              { return __hip_atomic_load(p, __ATOMIC_RELAXED, __HIP_MEMORY_SCOPE_AGENT); }
__device__ __forceinline__ unsigned xb_add(unsigned* p, unsigned v) { return __hip_atomic_fetch_add(p, v, __ATOMIC_RELAXED, __HIP_MEMORY_SCOPE_AGENT); }
__device__ __forceinline__ unsigned xb_xcc_id() { return (unsigned)__builtin_amdgcn_s_getreg((3 << 11) | 20) & 0xFu; }
#define XB_SPIN(cond, bar) do { unsigned _sp = 0; while (cond) { __builtin_amdgcn_s_sleep(1); \
    if ((++_sp & 255u) == 0u) { if (xb_ld(&(bar)[XB_TMO])) break; if (_sp > XB_SPIN_CAP) { atomicAdd(&(bar)[XB_TMO], 1u); break; } } } } while (0)
struct XcdBarrier { unsigned* bar; unsigned x; volatile LAS unsigned* st; };
__device__ __forceinline__ XcdBarrier xcd_barrier_post(unsigned* bar, volatile LAS unsigned* st) {
    XcdBarrier b; b.bar = bar; b.x = xb_xcc_id(); b.st = st;
    if (threadIdx.x == 0) (void)xb_add(&bar[XB_XCNT(b.x)], 1u);
    return b;
}
__device__ __forceinline__ void xcd_barrier_complete(unsigned* bar, unsigned x, unsigned& nloc, unsigned& nx) {
    const unsigned G = gridDim.x * gridDim.y * gridDim.z;
    unsigned sum, cnt, mine, sp = 0u;
    for (;;) {
        sum = 0u; cnt = 0u; mine = 0u;
#pragma unroll
        for (unsigned j = 0; j < 16; ++j) { const unsigned c = xb_ld(&bar[XB_XCNT(j)]); sum += c; cnt += (c > 0u) ? 1u : 0u; mine = (j == x) ? c : mine; }
        if (sum == G) break;
        __builtin_amdgcn_s_sleep(1);
        if ((++sp & 255u) == 0u) { if (xb_ld(&bar[XB_TMO])) break; if (sp > XB_SPIN_CAP) { atomicAdd(&bar[XB_TMO], 1u); break; } }
    }
    nloc = mine > 0u ? mine : 1u; nx = cnt > 0u ? cnt : 1u;
}
__device__ __forceinline__ void xcd_barrier(const XcdBarrier& b) {
    asm volatile("s_waitcnt vmcnt(0)" ::: "memory");
    __syncthreads();
    if (threadIdx.x == 0) {
        unsigned* bar = b.bar;
        __builtin_amdgcn_s_waitcnt(0);
        unsigned nloc = b.st[0], nx = b.st[1];
        if (nloc == 0u) { xcd_barrier_complete(bar, b.x, nloc, nx); b.st[0] = nloc; b.st[1] = nx; }
        const unsigned old = xb_add(&bar[XB_XSUB(b.x)], 1u);
        const unsigned gen = old / nloc;
        if (old + 1u == (gen + 1u) * nloc) {
            __builtin_amdgcn_fence(__ATOMIC_RELEASE, "agent");
            asm volatile("s_waitcnt vmcnt(0)" ::: "memory");
            const unsigned og = xb_add(&bar[XB_TOP], 1u);
            const unsigned tg = og / nx;
            if (og + 1u == (tg + 1u) * nx) xb_add(&bar[XB_TOPGEN], 1u);
            else XB_SPIN(xb_ld(&bar[XB_TOPGEN]) == tg, bar);
            __builtin_amdgcn_fence(__ATOMIC_ACQUIRE, "agent");
            xb_add(&bar[XB_XGEN(b.x)], 1u);
            asm volatile("s_waitcnt vmcnt(0)" ::: "memory");
        } else {
            XB_SPIN(xb_ld(&bar[XB_XGEN(b.x)]) == gen, bar);
            __builtin_amdgcn_fence(__ATOMIC_ACQUIRE, "agent");
            asm volatile("s_waitcnt vmcnt(0)" ::: "memory");
        }
    }
    __syncthreads();
}

struct Frame {
    LAS unsigned char* lds;
    volatile LAS unsigned* MISC;
    unsigned* ctl;
    int tid, lane, wave, vcu, G;
    const float* const* in;
    unsigned char* ws; float* out;
};

using pg8::Unit;
struct DenseOrder {
    static constexpr bool GATHER = false, HETERO = false;
    const char* A0; const char* B0; int lda, ldb, nM, nN, nwg, G, c;
    __device__ __forceinline__ void init(const void* A, const void* B, int lda_, int ldb_, int M, int N, int G_, int c_) { A0 = (const char*)A; B0 = (const char*)B; lda = lda_; ldb = ldb_; nM = M / 256; nN = N / 256; nwg = nM * nN; G = G_; c = c_; }
    __device__ __forceinline__ bool next(int i, Unit& u) const {
        const long L = (long)i * G + c; if (L >= nwg) return false;
        int wgid = (int)L; { const int q = nwg / 8, r = nwg % 8, xcd = wgid % 8, off = wgid / 8; wgid = (xcd < r ? xcd * (q + 1) : r * (q + 1) + (xcd - r) * q) + off; }
        const int nig = 8 * nN, gid = wgid / nig, fm = gid * 8, gsz = (nM - fm) < 8 ? (nM - fm) : 8;
        u.pm = fm + ((wgid % nig) % gsz); u.pn = (wgid % nig) / gsz; u.aux = 0;
        u.A = A0 + (size_t)u.pm * 256 * lda * 2; u.B = B0 + (size_t)u.pn * 256 * ldb * 2; return true;
    }
    __device__ __forceinline__ void a_offsets(const Unit&, const int (&R)[2], const int (&C)[2], unsigned (&v)[4]) const {
#pragma unroll
        for (int i = 0; i < 2; ++i) { v[i] = (unsigned)(R[i] * lda + C[i]) * 2u; v[2 + i] = (unsigned)((128 + R[i]) * lda + C[i]) * 2u; }
    }
};
struct S5One {
    static constexpr bool GATHER = false, HETERO = false;
    const char* A0; const char* B0; size_t sA, sB; int lda, g, mt;
    __device__ __forceinline__ bool next(int i, Unit& u) const {
        if (i > 0) return false;
        u.pm = mt; u.pn = 0; u.aux = g; u.A = A0 + (size_t)g * sA + (size_t)mt * 256 * lda * 2; u.B = B0 + (size_t)g * sB; return true;
    }
    __device__ __forceinline__ void a_offsets(const Unit&, const int (&R)[2], const int (&C)[2], unsigned (&v)[4]) const {
#pragma unroll
        for (int i = 0; i < 2; ++i) { v[i] = (unsigned)(R[i] * lda + C[i]) * 2u; v[2 + i] = (unsigned)((128 + R[i]) * lda + C[i]) * 2u; }
    }
};
struct GyOrder {
    static constexpr bool GATHER = false, HETERO = false;
    DenseOrder d;
    __device__ __forceinline__ bool next(int i, Unit& u) const { if (!d.next(i, u)) return false; u.A = d.A0 + (size_t)u.pm * 256 * 32; return true; }
    __device__ __forceinline__ void a_offsets(const Unit&, const int (&R)[2], const int (&C)[2], unsigned (&v)[4]) const {
#pragma unroll
        for (int i = 0; i < 2; ++i) { const unsigned o = (unsigned)(C[i] >> 4) * (unsigned)(T * 32) + (unsigned)(C[i] & 15) * 2u; v[i] = (unsigned)R[i] * 32u + o; v[2 + i] = (unsigned)(128 + R[i]) * 32u + o; }
    }
};
struct YaYbOrder {
    static constexpr bool GATHER = false, HETERO = true;
    DenseOrder d;
    const char* GYb; const char* WS5b; const char* YLb; const char* WLb;
    __device__ __forceinline__ bool next(int i, Unit& u) const {
        const int j = i / 3, r = i - 3 * j; Unit t;
        if (!d.next(j, t)) return false;
        u.pm = t.pm; u.aux = 0;
        if (r < 2) { u.kind = 0; u.pn = 2 * t.pn + r; u.nt = S5W / 64; u.kA = (unsigned)(4 * T * 32); u.A = GYb + (size_t)t.pm * 256 * 32; u.B = WS5b + (size_t)u.pn * 256 * S5W * 2; }
        else { u.kind = 1; u.pn = t.pn; u.nt = D / 64; u.kA = 128u; u.A = YLb + (size_t)t.pm * 256 * D * 2; u.B = WLb + (size_t)t.pn * 256 * D * 2; }
        return true;
    }
    __device__ __forceinline__ void a_offsets(const Unit& u, const int (&R)[2], const int (&C)[2], unsigned (&v)[4]) const {
#pragma unroll
        for (int i = 0; i < 2; ++i) {
            const unsigned og = (unsigned)(C[i] >> 4) * (unsigned)(T * 32) + (unsigned)(C[i] & 15) * 2u;
            const unsigned g0 = (unsigned)R[i] * 32u + og, g1 = (unsigned)(128 + R[i]) * 32u + og;
            const unsigned d0 = (unsigned)(R[i] * D + C[i]) * 2u, d1 = (unsigned)((128 + R[i]) * D + C[i]) * 2u;
            v[i] = u.kind ? d0 : g0; v[2 + i] = u.kind ? d1 : g1; }
    }
    __device__ __forceinline__ void b_offsets(const Unit& u, const int (&Rb)[2], const int (&C)[2], unsigned (&v)[4]) const {
        const int ldb = u.kind ? D : S5W;
#pragma unroll
        for (int i = 0; i < 2; ++i) { v[i] = (unsigned)(Rb[i] * ldb + C[i]) * 2u; v[2 + i] = (unsigned)((128 + Rb[i]) * ldb + C[i]) * 2u; }
    }
};
template <bool GATH> struct MoeOrder {
    static constexpr bool GATHER = GATH, HETERO = false;
    const char* A0; const char* B0; size_t sBe; int lda, ldb, G, c; volatile LAS unsigned* MISC; const LAS int* tokL;
    __device__ __forceinline__ bool next(int i, Unit& u) const {
        if (i >= (int)MISC[152]) return false;
        const int e = (int)MISC[136 + i], mtg = (int)MISC[96 + e] + (int)MISC[144 + i], L = i * G + c;
        u.pm = mtg; u.pn = L & 3; u.aux = i;
        u.A = GATH ? A0 : A0 + (size_t)mtg * 256 * lda * 2; u.B = B0 + (size_t)e * sBe + (size_t)u.pn * 256 * ldb * 2; return true;
    }
    __device__ __forceinline__ void a_offsets(const Unit& u, const int (&R)[2], const int (&C)[2], unsigned (&v)[4]) const {
#pragma unroll
        for (int i = 0; i < 2; ++i) {
            if constexpr (GATH) { v[i] = (unsigned)tokL[u.aux * 256 + R[i]] * (unsigned)(lda * 2) + (unsigned)C[i] * 2u; v[2 + i] = (unsigned)tokL[u.aux * 256 + 128 + R[i]] * (unsigned)(lda * 2) + (unsigned)C[i] * 2u; }
            else { v[i] = (unsigned)(R[i] * lda + C[i]) * 2u; v[2 + i] = (unsigned)((128 + R[i]) * lda + C[i]) * 2u; } }
    }
};

using pg8::cvt_pk_bf16;
template <int ACT> __device__ __forceinline__ float actf(float x) { if (ACT == 1) return gelu_t(x); if (ACT == 2) return fsigmoid(x); return x; }
__device__ __forceinline__ v4u pack8(const f32x4 a, const f32x4 b) { v4u w; w.x = cvt_pk_bf16(a[0], a[1]); w.y = cvt_pk_bf16(a[2], a[3]); w.z = cvt_pk_bf16(b[0], b[1]); w.w = cvt_pk_bf16(b[2], b[3]); return w; }

__device__ __forceinline__ void unpack_u8x8(const v2u w, float (&f)[8]) {
    const float k = 1.0f / 255.0f;
    f[0] = (float)(w.x & 0xffu) * k; f[1] = (float)((w.x >> 8) & 0xffu) * k; f[2] = (float)((w.x >> 16) & 0xffu) * k; f[3] = (float)(w.x >> 24) * k;
    f[4] = (float)(w.y & 0xffu) * k; f[5] = (float)((w.y >> 8) & 0xffu) * k; f[6] = (float)((w.y >> 16) & 0xffu) * k; f[7] = (float)(w.y >> 24) * k;
}
struct EpiInProj {
    static constexpr bool PERM = true, ACC_INIT = false, B16 = false;
    bf16 *AG, *XL, *GL, *GA, *GB;
    template <int MODE  > __device__ __forceinline__ void tile(const f32x4 (&acc)[2][2][4][2], const Unit& u, bf16* base, int colbase, bool s5, int wr, int wc, int fr, int fq) const {
#pragma unroll
        for (int ai = 0; ai < 2; ++ai)
#pragma unroll
            for (int m = 0; m < 4; ++m) { const int r = u.pm * 256 + ai * 128 + wr * 64 + m * 16 + fr;
#pragma unroll
                for (int bj = 0; bj < 2; ++bj) { const int cl = colbase + bj * 128 + wc * 32 + 8 * fq;
                    f32x4 v0 = acc[ai][bj][m][0], v1 = acc[ai][bj][m][1];
                    if (MODE == 2) {
                        unsigned q[8];
#pragma unroll
                        for (int j = 0; j < 4; ++j) { q[j] = (unsigned)(fsigmoid(v0[j]) * 255.0f + 0.5f); q[4 + j] = (unsigned)(fsigmoid(v1[j]) * 255.0f + 0.5f); }
                        v2u w8; w8.x = q[0] | (q[1] << 8) | (q[2] << 16) | (q[3] << 24); w8.y = q[4] | (q[5] << 8) | (q[6] << 16) | (q[7] << 24);
                        __builtin_nontemporal_store(w8, (v2u*)((unsigned char*)base + (size_t)r * 1024 + cl));
                    } else {
                        if (MODE == 1) {
#pragma unroll
                            for (int j = 0; j < 4; ++j) { v0[j] = gelu_t(v0[j]); v1[j] = gelu_t(v1[j]); } }
                        const v4u w = pack8(v0, v1);
                        const int g = cl >> 4, cp = cl & 15, b = r >> 12, l = r & 4095, n = b * S5NCH + (l >> 4), s = l & 15;
                        const size_t off = s5 ? ((size_t)(g * S5N + n) * S5K + S5Q + s * 16 + cp) : ((size_t)r * 1024 + cl);
                        __builtin_nontemporal_store(w, (v4u*)(base + off)); } }
                asm volatile("" ::: "memory"); }
    }
    __device__ __forceinline__ void operator()(const f32x4 (&acc)[2][2][4][2], const Unit& u, int wr, int wc, int fr, int fq) const {
        const int pn = u.pn, reg = pn < 2 ? 0 : ((pn - 2) >> 2) + 1;
        const int colbase = reg == 0 ? pn * 256 : ((pn - 2) & 3) * 256;
        if (reg < 2) tile<0>(acc, u, reg == 0 ? AG : XL, colbase, reg == 0, wr, wc, fr, fq);
        else if (reg == 2) tile<1>(acc, u, GL, colbase, false, wr, wc, fr, fq);
        else tile<2>(acc, u, reg == 3 ? GA : GB, colbase, false, wr, wc, fr, fq);
    }
};
struct EpiS5State {
    static constexpr bool PERM = false, ACC_INIT = false, B16 = false;
    float* SLOC;
    __device__ __forceinline__ void operator()(const f32x4 (&acc)[2][2][4][2], const Unit& u, int wr, int wc, int fr, int fq) const {
#pragma unroll
        for (int ai = 0; ai < 2; ++ai)
#pragma unroll
            for (int m = 0; m < 4; ++m) { const int nr = u.pm * 256 + ai * 128 + wr * 64 + m * 16 + fr; float* rowp = SLOC + (size_t)(u.aux * S5N + nr) * S5Q + wc * 32 + 4 * fq;
#pragma unroll
                for (int n = 0; n < 2; ++n) *(f32x4*)(rowp + n * 16) = acc[ai][0][m][n]; }
    }
};
struct EpiS5Out {
    static constexpr bool PERM = true, ACC_INIT = false, B16 = false;
    bf16* GY;
    __device__ __forceinline__ void operator()(const f32x4 (&acc)[2][2][4][2], const Unit& u, int wr, int wc, int fr, int fq) const {
#pragma unroll
        for (int ai = 0; ai < 2; ++ai)
#pragma unroll
            for (int m = 0; m < 4; ++m) { const int nr = u.pm * 256 + ai * 128 + wr * 64 + m * 16 + fr, b = nr >> 8, j16 = nr & 255;
#pragma unroll
                for (int bj = 0; bj < 2; ++bj) { const int cc = bj * 128 + wc * 32 + 8 * fq, t = cc >> 4, c0 = cc & 15;
                    f32x4 v0 = acc[ai][bj][m][0], v1 = acc[ai][bj][m][1];
#pragma unroll
                    for (int j = 0; j < 4; ++j) { v0[j] = gelu_t(v0[j]); v1[j] = gelu_t(v1[j]); }
                    *(v4u*)(GY + ((size_t)u.aux * T + (size_t)(b * SEQ + j16 * 16 + t)) * 16 + c0) = pack8(v0, v1); }
                asm volatile("" ::: "memory"); }
    }
};
struct EpiYa {
    static constexpr bool PERM = true, ACC_INIT = false, B16 = false;
    const bf16* GA; bf16* YA;
    __device__ __forceinline__ void operator()(const f32x4 (&acc)[2][2][4][2], const Unit& u, int wr, int wc, int fr, int fq) const {
        const size_t off0 = (size_t)(u.pm * 256 + wr * 64 + fr) * 1024 + u.pn * 128 + wc * 32 + 8 * fq;
        v2u gav[2][4];
#pragma unroll
        for (int ai = 0; ai < 2; ++ai)
#pragma unroll
            for (int m = 0; m < 4; ++m) gav[ai][m] = __builtin_nontemporal_load((const v2u*)((const unsigned char*)GA + off0 + (size_t)(ai * 128 + m * 16) * 1024));
        asm volatile("" ::: "memory");
#pragma unroll
        for (int ai = 0; ai < 2; ++ai)
#pragma unroll
            for (int m = 0; m < 4; ++m) { float gaf[8]; unpack_u8x8(gav[ai][m], gaf);
                f32x4 o0, o1;
#pragma unroll
                for (int j = 0; j < 4; ++j) { o0[j] = gaf[j] * acc[ai][0][m][0][j] * fsigmoid(acc[ai][1][m][0][j]); o1[j] = gaf[4 + j] * acc[ai][0][m][1][j] * fsigmoid(acc[ai][1][m][1][j]); }
                *(v4u*)(YA + off0 + (size_t)(ai * 128 + m * 16) * 1024) = pack8(o0, o1); }
    }
};
struct EpiYb {
    static constexpr bool PERM = true, ACC_INIT = false, B16 = false;
    const bf16* YA; const bf16* GB; bf16* MIX;
    __device__ __forceinline__ void operator()(const f32x4 (&acc)[2][2][4][2], const Unit& u, int wr, int wc, int fr, int fq) const {
        const size_t off0 = (size_t)(u.pm * 256 + wr * 64 + fr) * 1024 + u.pn * 256 + wc * 32 + 8 * fq;
        v2u gb[2][4][2];
#pragma unroll
        for (int ai = 0; ai < 2; ++ai)
#pragma unroll
            for (int m = 0; m < 4; ++m)
#pragma unroll
                for (int bj = 0; bj < 2; ++bj) gb[ai][m][bj] = __builtin_nontemporal_load((const v2u*)((const unsigned char*)GB + off0 + (size_t)(ai * 128 + m * 16) * 1024 + bj * 128));
        v4u ya[2][2][2];
#define YB_LOAD(buf, grp) do { _Pragma("unroll") for (int mm = 0; mm < 2; ++mm) _Pragma("unroll") for (int bj = 0; bj < 2; ++bj) { \
            const size_t o = off0 + (size_t)(((grp) >> 1) * 128 + (2 * ((grp) & 1) + mm) * 16) * 1024 + bj * 128; ya[buf][mm][bj] = *(const v4u*)(YA + o); } } while (0)
        YB_LOAD(0, 0);
#pragma unroll
        for (int grp = 0; grp < 4; ++grp) { const int buf = grp & 1, ai = grp >> 1;
            if (grp < 3) YB_LOAD(buf ^ 1, grp + 1);
            asm volatile("" ::: "memory");
#pragma unroll
            for (int mm = 0; mm < 2; ++mm) { const int m = 2 * (grp & 1) + mm;
#pragma unroll
                for (int bj = 0; bj < 2; ++bj) { const v4u y = ya[buf][mm][bj];
                    const float yaf[8] = {bflo(y.x), bfhi(y.x), bflo(y.y), bfhi(y.y), bflo(y.z), bfhi(y.z), bflo(y.w), bfhi(y.w)};
                    float gbf[8]; unpack_u8x8(gb[ai][m][bj], gbf);
                    f32x4 o0, o1;
#pragma unroll
                    for (int j = 0; j < 4; ++j) { o0[j] = yaf[j] + gbf[j] * acc[ai][bj][m][0][j]; o1[j] = yaf[4 + j] + gbf[4 + j] * acc[ai][bj][m][1][j]; }
                    *(v4u*)(MIX + off0 + (size_t)(ai * 128 + m * 16) * 1024 + bj * 128) = pack8(o0, o1); } }
        }
#undef YB_LOAD
    }
};
struct EpiYaYb {
    static constexpr bool PERM = true, ACC_INIT = false, B16 = false;
    EpiYa a; EpiYb b;
    __device__ __forceinline__ void operator()(const f32x4 (&acc)[2][2][4][2], const Unit& u, int wr, int wc, int fr, int fq) const {
        if (__builtin_amdgcn_readfirstlane(u.kind) == 0) a(acc, u, wr, wc, fr, fq); else b(acc, u, wr, wc, fr, fq);
    }
};
struct EpiWo {
    static constexpr bool PERM = false, ACC_INIT = true, B16 = false;
    const float* X; float* O;
    __device__ __forceinline__ void init(f32x4 (&acc)[2][2][4][2], const Unit& u, int wr, int wc, int fr, int fq) const {
        const size_t off0 = (size_t)(u.pm * 256 + wr * 64 + fr) * 1024 + u.pn * 256 + wc * 32 + 4 * fq;
#pragma unroll
        for (int ai = 0; ai < 2; ++ai)
#pragma unroll
            for (int m = 0; m < 4; ++m)
#pragma unroll
                for (int bj = 0; bj < 2; ++bj)
#pragma unroll
                    for (int n = 0; n < 2; ++n) acc[ai][bj][m][n] = __builtin_nontemporal_load((const f32x4*)(X + off0 + (size_t)(ai * 128 + m * 16) * 1024 + bj * 128 + n * 16));
    }
    __device__ __forceinline__ void operator()(const f32x4 (&acc)[2][2][4][2], const Unit& u, int wr, int wc, int fr, int fq) const {
        const size_t off0 = (size_t)(u.pm * 256 + wr * 64 + fr) * 1024 + u.pn * 256 + wc * 32 + 4 * fq;
#pragma unroll
        for (int ai = 0; ai < 2; ++ai)
#pragma unroll
            for (int m = 0; m < 4; ++m)
#pragma unroll
                for (int bj = 0; bj < 2; ++bj)
#pragma unroll
                    for (int n = 0; n < 2; ++n) *(f32x4*)(O + off0 + (size_t)(ai * 128 + m * 16) * 1024 + bj * 128 + n * 16) = acc[ai][bj][m][n];
    }
};
struct EpiGU {
    static constexpr bool PERM = true, ACC_INIT = false, B16 = false;
    bf16* ACT; const LAS float* sclL;
    __device__ __forceinline__ void operator()(const f32x4 (&acc)[2][2][4][2], const Unit& u, int wr, int wc, int fr, int fq) const {
#pragma unroll
        for (int ai = 0; ai < 2; ++ai)
#pragma unroll
            for (int m = 0; m < 4; ++m) { const int rl = ai * 128 + wr * 64 + m * 16 + fr; const float sc = sclL[u.aux * 256 + rl];
                f32x4 o0, o1;
#pragma unroll
                for (int j = 0; j < 4; ++j) { const float g0 = acc[ai][0][m][0][j] * sc, g1 = acc[ai][0][m][1][j] * sc;
                    o0[j] = g0 * fsigmoid(g0) * (acc[ai][1][m][0][j] * sc); o1[j] = g1 * fsigmoid(g1) * (acc[ai][1][m][1][j] * sc); }
                *(v4u*)(ACT + (size_t)(u.pm * 256 + rl) * DEXP + u.pn * 128 + wc * 32 + 8 * fq) = pack8(o0, o1); }
    }
};
struct EpiDown {
    static constexpr bool PERM = true, ACC_INIT = false, B16 = false;
    bf16* YS; const LAS float* sclL;
    __device__ __forceinline__ void operator()(const f32x4 (&acc)[2][2][4][2], const Unit& u, int wr, int wc, int fr, int fq) const {
#pragma unroll
        for (int ai = 0; ai < 2; ++ai)
#pragma unroll
            for (int m = 0; m < 4; ++m) { const int rl = ai * 128 + wr * 64 + m * 16 + fr; const float sc = sclL[u.aux * 256 + rl];
#pragma unroll
                for (int bj = 0; bj < 2; ++bj)
                    *(v4u*)(YS + (size_t)(u.pm * 256 + rl) * 1024 + u.pn * 256 + bj * 128 + wc * 32 + 8 * fq) = pack8(acc[ai][bj][m][0] * sc, acc[ai][bj][m][1] * sc); }
    }
};

template <bool SCALED> struct EpiQ8 {
    static constexpr bool PERM = true, ACC_INIT = false, B16 = true;
    unsigned char* YS8; float* YSC; const LAS float* sclL;
    __device__ __forceinline__ void operator()(const f32x4 (&acc)[2][2][4][2], const Unit& u, int wr, int wc, int fr, int fq) const {
        float scs[2][4];
#pragma unroll
        for (int ai = 0; ai < 2; ++ai)
#pragma unroll
            for (int m = 0; m < 4; ++m) { const int rl = ai * 128 + wr * 64 + m * 16 + fr; const float sc = SCALED ? sclL[u.aux * 256 + rl] : 1.0f;
                float v[16]; float amax = 0.f;
#pragma unroll
                for (int bj = 0; bj < 2; ++bj)
#pragma unroll
                    for (int n = 0; n < 2; ++n)
#pragma unroll
                        for (int j = 0; j < 4; ++j) { const float x = acc[ai][bj][m][n][j] * sc; v[bj * 8 + n * 4 + j] = x; amax = fmaxf(amax, fabsf(x)); }
                amax = fmaxf(amax, __shfl_xor(amax, 16)); amax = fmaxf(amax, __shfl_xor(amax, 32));
                const float inv = amax > 0.f ? 127.0f / amax : 0.f;
                scs[ai][m] = amax * (1.0f / 127.0f);
                v4u w;
#pragma unroll
                for (int d = 0; d < 4; ++d) { const int q0 = (int)__builtin_rintf(v[4 * d] * inv), q1 = (int)__builtin_rintf(v[4 * d + 1] * inv), q2 = (int)__builtin_rintf(v[4 * d + 2] * inv), q3 = (int)__builtin_rintf(v[4 * d + 3] * inv);
                    w[d] = ((unsigned)q0 & 255u) | (((unsigned)q1 & 255u) << 8) | (((unsigned)q2 & 255u) << 16) | ((unsigned)q3 << 24); }
                *(v4u*)(YS8 + (size_t)(u.pm * 256 + rl) * 1024 + u.pn * 256 + wc * 64 + fq * 16) = w; }
#pragma unroll
        for (int ai = 0; ai < 2; ++ai) { const float sv = fq == 0 ? scs[ai][0] : fq == 1 ? scs[ai][1] : fq == 2 ? scs[ai][2] : scs[ai][3];
            YSC[(size_t)(u.pm * 256 + ai * 128 + wr * 64 + fq * 16 + fr) * 16 + wc * 4 + u.pn] = sv; }
    }
};

struct TItem { const float* W; int N; bf16* WT; int ldk, k0, n0, drow0; };
__device__ __forceinline__ void transpose_load(const TItem& it, f32x4 (&tv)[8], int lane) {
#pragma unroll
    for (int i = 0; i < 8; ++i) tv[i] = __builtin_nontemporal_load((const f32x4*)(it.W + (size_t)(it.k0 + 8 * i + (lane >> 3)) * it.N + it.n0 + 4 * (lane & 7)));
}
template <bool NT = false> __device__ __forceinline__ void transpose_store(const TItem& it, const f32x4 (&tv)[8], LAS float* scr, int lane) {
#pragma unroll
    for (int i = 0; i < 8; ++i) { LAS float* d = scr + (8 * i + (lane >> 3)) * 33 + 4 * (lane & 7); d[0] = tv[i].x; d[1] = tv[i].y; d[2] = tv[i].z; d[3] = tv[i].w; }
    LDS_WAIT(); asm volatile("" ::: "memory");
    const int c = lane & 7;
#pragma unroll
    for (int j = 0; j < 4; ++j) { const int n = (lane >> 3) + 8 * j; const LAS float* s = scr + (8 * c) * 33 + n;
        v4u o; o.x = pk2(s[0 * 33], s[1 * 33]); o.y = pk2(s[2 * 33], s[3 * 33]); o.z = pk2(s[4 * 33], s[5 * 33]); o.w = pk2(s[6 * 33], s[7 * 33]);
        if (NT) __builtin_nontemporal_store(o, (v4u*)(it.WT + (size_t)(it.drow0 + n) * it.ldk + it.k0 + 8 * c)); else *(v4u*)(it.WT + (size_t)(it.drow0 + n) * it.ldk + it.k0 + 8 * c) = o; }
    LDS_WAIT(); asm volatile("" ::: "memory");
}
__device__ __forceinline__ int ileave_row(int n, int half) { return 256 * (n >> 7) + 128 * half + (n & 127); }

template <int NR> __device__ __forceinline__ void rms_rows_to_bf16(const float* x0, const float* gain, bf16* o0, size_t rstride, int lane) {
    f32x4 v[NR][4];
#pragma unroll
    for (int r = 0; r < NR; ++r) { const f32x4* xr = (const f32x4*)(x0 + r * rstride) + lane;
#pragma unroll
        for (int j = 0; j < 4; ++j) v[r][j] = __builtin_nontemporal_load(xr + 64 * j); }
    asm volatile("" ::: "memory");
    const f32x4* gr = (const f32x4*)gain + lane;
    f32x4 g[4];
#pragma unroll
    for (int j = 0; j < 4; ++j) g[j] = gr[64 * j];
#pragma unroll
    for (int r = 0; r < NR; ++r) { float s = 0.f;
#pragma unroll
        for (int j = 0; j < 4; ++j) s += (v[r][j].x * v[r][j].x + v[r][j].y * v[r][j].y) + (v[r][j].z * v[r][j].z + v[r][j].w * v[r][j].w);
        const float rstd = 1.0f / sqrtf(wave_sum(s) * (1.f / D) + RMS_EPS);
        unsigned long long* o8 = (unsigned long long*)(o0 + r * rstride) + lane;
#pragma unroll
        for (int j = 0; j < 4; ++j) o8[64 * j] = (unsigned long long)pk2(v[r][j].x * rstd * g[j].x, v[r][j].y * rstd * g[j].y) | ((unsigned long long)pk2(v[r][j].z * rstd * g[j].z, v[r][j].w * rstd * g[j].w) << 32); }
}

__device__ __forceinline__ void s5_tables(const Frame& F, int g, const float* lam_re, const float* lam_im, const float* log_dt, const float* b_re, const float* b_im, const float* c_re, const float* c_im, const float* dsk) {
    LAS float* Cre = (LAS float*)F.lds;
    LAS float* Cim = Cre + 1024;
    LAS float* Bre = Cim + 1024;
    LAS float* Bim = Bre + 1024;
    LAS float* Pre = Bim + 1024;
    LAS float* Pim = Pre + 17 * 64;
    LAS float* Kt = Pim + 17 * 64;
    const int tid = F.tid;
    for (int i = tid; i < 1024; i += 512) { Cre[i] = c_re[g * 1024 + i]; Cim[i] = c_im[g * 1024 + i]; }
    if (tid < 64) {
        const int p = tid; const float lr = lam_re[g * 64 + p], li = lam_im[g * 64 + p], dt = expf(log_dt[g]);
        const float er = expf(lr * dt), lbr = er * cosf(li * dt), lbi = er * sinf(li * dt);
        const float den = lr * lr + li * li, nr = lbr - 1.0f, ni = lbi;
        const float cr = (nr * lr + ni * li) / den, ci = (ni * lr - nr * li) / den;
        { float pr = 1.f, pi = 0.f; for (int k = 0; k <= 16; ++k) { Pre[k * 64 + p] = pr; Pim[k * 64 + p] = pi; const float nr2 = pr * lbr - pi * lbi, ni2 = pr * lbi + pi * lbr; pr = nr2; pi = ni2; } }
        for (int c = 0; c < 16; ++c) { const float br = b_re[(g * 64 + p) * 16 + c], bi = b_im[(g * 64 + p) * 16 + c]; Bre[p * 16 + c] = cr * br - ci * bi; Bim[p * 16 + c] = cr * bi + ci * br; }
    }
    __syncthreads();
    for (int e = tid; e < 4096; e += 512) {
        const int k = e >> 8, c = (e >> 4) & 15, cp = e & 15; float s = 0.f;
        for (int p = 0; p < 64; ++p) { const float xr = Cre[c * 64 + p] * Pre[k * 64 + p] - Cim[c * 64 + p] * Pim[k * 64 + p], xi = Cre[c * 64 + p] * Pim[k * 64 + p] + Cim[c * 64 + p] * Pre[k * 64 + p];
            s += xr * Bre[p * 16 + cp] - xi * Bim[p * 16 + cp]; }
        if (k == 0 && c == cp) s += dsk[g * 16 + c];
        Kt[e] = s;
    }
    __syncthreads();
    unsigned* btt = (unsigned*)(F.ws + WS_BTT) + (size_t)g * 256 * (S5K / 2);
    for (int e = tid; e < 256 * (S5K / 2); e += 512) {
        const int row = e / (S5K / 2), cpair = e % (S5K / 2), t = row >> 4, c = row & 15, col = 2 * cpair; float v0, v1;
        if (col < S5Q) { const int p = col >> 1; const float xr = Cre[c * 64 + p] * Pre[(t + 1) * 64 + p] - Cim[c * 64 + p] * Pim[(t + 1) * 64 + p], xi = Cre[c * 64 + p] * Pim[(t + 1) * 64 + p] + Cim[c * 64 + p] * Pre[(t + 1) * 64 + p];
            v0 = xr; v1 = -xi; }
        else { const int s = (col - S5Q) >> 4, cp = (col - S5Q) & 15;
            if (s <= t) { v0 = Kt[(t - s) * 256 + c * 16 + cp]; v1 = Kt[(t - s) * 256 + c * 16 + cp + 1]; } else { v0 = 0.f; v1 = 0.f; } }
        btt[e] = pk2(v0, v1);
    }
    unsigned* btw = (unsigned*)(F.ws + WS_BTW) + (size_t)g * 128 * 128;
    for (int e = tid; e < 128 * 128; e += 512) {
        const int q = e >> 7, cpair = e & 127, col = 2 * cpair, s = col >> 4, cp = col & 15, p = q >> 1, k = 15 - s;
        const float pr = Pre[k * 64 + p], pi = Pim[k * 64 + p];
        float v0, v1;
        if (q & 1) { v0 = pr * Bim[p * 16 + cp] + pi * Bre[p * 16 + cp]; v1 = pr * Bim[p * 16 + cp + 1] + pi * Bre[p * 16 + cp + 1]; }
        else { v0 = pr * Bre[p * 16 + cp] - pi * Bim[p * 16 + cp]; v1 = pr * Bre[p * 16 + cp + 1] - pi * Bim[p * 16 + cp + 1]; }
        btw[e] = pk2(v0, v1);
    }
    if (tid < 64) { float* l16 = (float*)(F.ws + SM_LAM16) + (g * 64 + tid) * 2; l16[0] = Pre[16 * 64 + tid]; l16[1] = Pim[16 * 64 + tid]; }
    __syncthreads();
}

struct In { const float* p[30]; };

__device__ __forceinline__ void p0_prologue(const Frame& F, const In& I) {
    for (int g = F.vcu; g < S5G; g += F.G) s5_tables(F, g, I.p[3], I.p[4], I.p[5], I.p[6], I.p[7], I.p[8], I.p[9], I.p[10]);
    const int gt = F.vcu * 512 + F.tid, NGT = F.G * 512;
    { float* lc = (float*)(F.ws + SM_LRUC); for (int i = gt; i < LRUW; i += NGT) { const float lam = I.p[18][i]; lc[i] = -8.0f * log1pf(expf(-lam)) * 1.44269504f; } }
    { bf16* wrt = (bf16*)(F.ws + SM_WRT);
        for (int i = gt; i < 2 * 65536; i += NGT) { const int which = i >> 16, r = i & 65535, h = r >> 12, j = (r >> 6) & 63, k = r & 63; const float* src = which ? I.p[16] : I.p[14]; wrt[i] = (bf16)f2bf(src[(h * 64 + k) * 64 + j]); } }
    { bf16* rhi = (bf16*)(F.ws + SM_RHI); bf16* rlo = (bf16*)(F.ws + SM_RLO);
        for (int i = gt; i < NROUT * 1024; i += NGT) { const int n = i >> 10, k = i & 1023; float w = 0.f; if (n < 4) w = I.p[22][k * 4 + n]; else if (n < 36) w = I.p[24][k * 32 + (n - 4)];
            const unsigned h = f2bf(w); rhi[i] = (bf16)h; rlo[i] = (bf16)f2bf(w - bf2f(h)); } }
    LAS float* scr = (LAS float*)(F.lds + F.wave * 16384);
    const int gw = F.vcu * NWAVES + F.wave, NGW = F.G * NWAVES;
    constexpr int I_IN = (D / 64) * (NIN / 32), I_S5 = (S5W / 64) * (2 * D / 32), I_LRU = (D / 64) * (D / 32), I_O = I_LRU;
    constexpr int NITEMS = I_IN + I_S5 + I_LRU + I_O;
    for (int it = gw; it < NITEMS; it += NGW) {
        int r = it; TItem ti;
        if (r < I_IN) { const int nb = NIN / 32, kb = r / nb, n0 = 32 * (r % nb); ti = TItem{I.p[2], NIN, (bf16*)(F.ws + WS_WIN), D, 64 * kb, n0, n0}; }
        else if ((r -= I_IN) < I_S5) { const int nb = 2 * D / 32, kb = r / nb, n0 = 32 * (r % nb); ti = TItem{I.p[11], 2 * D, (bf16*)(F.ws + WS_WS5), S5W, 64 * kb, n0, n0 < D ? ileave_row(n0, 0) : ileave_row(n0 - D, 1)}; }
        else if ((r -= I_S5) < I_LRU) { const int nb = D / 32, kb = r / nb, n0 = 32 * (r % nb); ti = TItem{I.p[19], D, (bf16*)(F.ws + WS_WLRU), D, 64 * kb, n0, n0}; }
        else { r -= I_LRU; const int nb = D / 32, kb = r / nb, n0 = 32 * (r % nb); ti = TItem{I.p[20], D, (bf16*)(F.ws + WS_WO), D, 64 * kb, n0, n0}; }
        f32x4 tv[8]; transpose_load(ti, tv, F.lane); asm volatile("" ::: "memory"); transpose_store(ti, tv, scr, F.lane);
    }
    { const int skip = F.G > 2 * S5G ? S5G : 0;
      if (F.vcu >= skip) { const int gw2 = (F.vcu - skip) * NWAVES + F.wave, NGW2 = (F.G - skip) * NWAVES;
        for (int m = gw2 * 4; m < T; m += NGW2 * 4) rms_rows_to_bf16<4>(I.p[0] + (size_t)m * D, I.p[1], (bf16*)(F.ws + WS_H) + (size_t)m * D, D, F.lane); } }
}
__device__ __forceinline__ TItem expert_item(const Frame& F, const In& I, int it) {
    const int e = it >> 9, half = (it >> 8) & 1, r = it & 255, nb = DEXP / 32, kb = r / nb, n0 = 32 * (r % nb);
    return TItem{(half ? I.p[27] : I.p[26]) + (size_t)e * D * DEXP, DEXP, (bf16*)(F.ws + WS_WGU) + (size_t)e * 1024 * 1024, D, 64 * kb, n0, ileave_row(n0, half)};
}
__device__ __forceinline__ TItem expert_item_d(const Frame& F, const In& I, int it) {
    const int e = it >> 8, r = it & 255, nb = D / 32, kb = r / nb, n0 = 32 * (r % nb);
    return TItem{I.p[28] + (size_t)e * DEXP * D, D, (bf16*)(F.ws + WS_WD) + (size_t)e * 1024 * DEXP, DEXP, 64 * kb, n0, n0};
}
__device__ __forceinline__ void expert_weight_copies(const Frame& F, const In& I) {
    LAS float* scr = (LAS float*)(F.lds + F.wave * 16384);
    const int gw = F.vcu * NWAVES + F.wave, NGW = F.G * NWAVES;
    constexpr int NIT = NEXP * 512;
    for (int it = 8 * NGW + gw; it < NIT; it += NGW) { const TItem t0 = expert_item(F, I, it); f32x4 v0[8]; transpose_load(t0, v0, F.lane); asm volatile("" ::: "memory"); transpose_store(t0, v0, scr, F.lane); }
}
__device__ __forceinline__ void expert_down_copies(const Frame& F, const In& I) {
    LAS float* scr = (LAS float*)(F.lds + F.wave * 16384);
    const int nunits = (int)F.MISC[128] * 4, rem = nunits % F.G, nbusy = rem;
    const int nfree = F.G - nbusy;
    if (F.vcu < nbusy) return;
    const int gw = (F.vcu - nbusy) * NWAVES + F.wave, NGW = nfree * NWAVES;
    constexpr int NIT = NEXP * 256;
    for (int it = gw; it < NIT; it += 2 * NGW) {
        const TItem t0 = expert_item_d(F, I, it); const bool has1 = it + NGW < NIT; const TItem t1 = expert_item_d(F, I, has1 ? it + NGW : it);
        f32x4 v0[8], v1[8]; transpose_load(t0, v0, F.lane); transpose_load(t1, v1, F.lane); asm volatile("" ::: "memory");
        transpose_store(t0, v0, scr, F.lane); if (has1) transpose_store(t1, v1, scr, F.lane);
    }
}

__device__ __forceinline__ void lru_seq(const Frame& F, const In& I) {
    LAS unsigned char* wl = F.lds + F.wave * 17920;
    LAS bf16* xcA = (LAS bf16*)wl;
    LAS float* pre = (LAS float*)(wl + 9216);
    typedef float f32x2 __attribute__((ext_vector_type(2)));
    LAS f32x2* sumT = (LAS f32x2*)(F.lds + 143360);
    const int lane = F.lane, jj = lane & 15, ks = lane >> 4, c32 = lane & 31, th = lane >> 5;
    const bf16* XL = (const bf16*)(F.ws + WS_XL); const bf16* GL = (const bf16*)(F.ws + WS_GL); bf16* YL = (bf16*)(F.ws + WS_H);
    const bf16* WRT = (const bf16*)(F.ws + SM_WRT);
    for (int un = F.vcu; un < BATCH * LRUH * 2; un += F.G) {
        const int b = un >> 5, hd = (un >> 1) & 15, half = un & 1;
        const int chin = hd * 64 + lane;
        const int chg = hd * 64 + 32 * half + c32;
        const float w0 = I.p[12][chin], w1 = I.p[12][1024 + chin], w2 = I.p[12][2048 + chin], w3 = I.p[12][3072 + chin], cb = I.p[13][chin];
        const float brs = I.p[15][chg] * -1.44269504f, bis = I.p[17][chg] * -1.44269504f, cch2 = ((const float*)(F.ws + SM_LRUC))[chg];
        float Rc = 0.f;
        for (int rd = 0; rd < 8; ++rd) {
            const int j = rd * 8 + F.wave;
            const size_t tok0 = (size_t)b * SEQ + (size_t)j * LRUCH;
            unsigned short xr[64], xh[3];
            { const bf16* xp = XL + tok0 * 1024 + chin;
              xh[0] = 0; xh[1] = 0; xh[2] = 0;
              if (j > 0) { xh[0] = xp[-3 * 1024]; xh[1] = xp[-2 * 1024]; xh[2] = xp[-1 * 1024]; }
#pragma unroll
              for (int t = 0; t < 64; ++t) xr[t] = xp[t * 1024]; }
            asm volatile("" ::: "memory");
            { typedef float f2v __attribute__((ext_vector_type(2)));
              float xm3 = bf2f(xh[0]), xm2 = bf2f(xh[1]), xm1 = bf2f(xh[2]);
              const f2v vw0 = {w0, w0}, vw1 = {w1, w1}, vw2 = {w2, w2}, vw3 = {w3, w3}, vcb = {cb, cb};
#pragma unroll
              for (int t = 0; t < 64; t += 2) { const float x0 = bf2f(xr[t]), x1 = bf2f(xr[t + 1]);
                  f2v xc = vcb + vw0 * (f2v){xm3, xm2}; xc = xc + vw1 * (f2v){xm2, xm1}; xc = xc + vw2 * (f2v){xm1, x0}; xc = xc + vw3 * (f2v){x0, x1};
                  const unsigned pk = pg8::cvt_pk_bf16(xc.x, xc.y);
                  xcA[t * 72 + lane] = (bf16)(pk & 0xffffu); xcA[(t + 1) * 72 + lane] = (bf16)(pk >> 16);
                  xm3 = xm1; xm2 = x0; xm1 = x1; } }
            LDS_WAIT();
            float hl[2][16], Pl[2][16], Prun[2], Hrun[2];
#pragma unroll
            for (int st = 0; st < 2; ++st) {
                bf16x8 Bw[4][2];
#pragma unroll
                for (int n = 0; n < 4; ++n)
#pragma unroll
                    for (int k = 0; k < 2; ++k) Bw[n][k] = *(const bf16x8*)(WRT + (size_t)(n >> 1) * 65536 + (size_t)(hd * 64 + 32 * half + 16 * (n & 1) + jj) * 64 + 32 * k + 8 * ks);
#pragma unroll
                for (int mh = 0; mh < 2; ++mh) { const int mt = 2 * st + mh;
                    bf16x8 a[2];
#pragma unroll
                    for (int k = 0; k < 2; ++k) a[k] = *(const LAS bf16x8*)(xcA + (16 * mt + jj) * 72 + 32 * k + 8 * ks);
#pragma unroll
                    for (int n = 0; n < 4; ++n) { f32x4 d = (f32x4){0.f, 0.f, 0.f, 0.f};
#pragma unroll
                        for (int k = 0; k < 2; ++k) d = __builtin_amdgcn_mfma_f32_16x16x32_bf16(a[k], Bw[n][k], d, 0, 0, 0);
#pragma unroll
                        for (int r = 0; r < 4; ++r) pre[(16 * mh + 4 * ks + r) * 68 + 16 * n + jj] = d[r]; } }
                LDS_WAIT();
                float h = 0.f, P = 1.f;
                typedef float f2v __attribute__((ext_vector_type(2)));
#pragma unroll
                for (int tl = 0; tl < 16; tl += 2) {
                    const int trow = 16 * th + tl;
                    const f2v pr = {pre[trow * 68 + c32], pre[(trow + 1) * 68 + c32]}, pi = {pre[trow * 68 + 32 + c32], pre[(trow + 1) * 68 + 32 + c32]};
                    const f2v zr = pr * (f2v){-1.44269504f, -1.44269504f} + (f2v){brs, brs}, zi = pi * (f2v){-1.44269504f, -1.44269504f} + (f2v){bis, bis};
                    const f2v er = {__builtin_amdgcn_exp2f(zr.x), __builtin_amdgcn_exp2f(zr.y)}, ei = {__builtin_amdgcn_exp2f(zi.x), __builtin_amdgcn_exp2f(zi.y)};
                    const f2v dr = er + (f2v){1.f, 1.f};
                    const f2v rg = {__builtin_amdgcn_rcpf(dr.x), __builtin_amdgcn_rcpf(dr.y)};
                    const f2v la2 = rg * (f2v){cch2, cch2};
                    const f2v a_ = {__builtin_amdgcn_exp2f(la2.x), __builtin_amdgcn_exp2f(la2.y)};
                    const f2v x2 = la2 * (f2v){1.38629436f, 1.38629436f};
                    f2v q = x2 * (f2v){0.0013888889f, 0.0013888889f} + (f2v){0.0083333333f, 0.0083333333f};
                    q = q * x2 + (f2v){0.041666667f, 0.041666667f}; q = q * x2 + (f2v){0.16666667f, 0.16666667f}; q = q * x2 + (f2v){0.5f, 0.5f}; q = q * x2 + (f2v){1.f, 1.f};
                    f2v om = -(q * x2);
                    const f2v alt = (f2v){1.f, 1.f} - a_ * a_;
                    om.x = x2.x > -0.3f ? om.x : alt.x; om.y = x2.y > -0.3f ? om.y : alt.y;
                    om.x = fmaxf(om.x, 1e-30f); om.y = fmaxf(om.y, 1e-30f);
                    const f2v dd = ei + (f2v){1.f, 1.f};
                    const f2v rq = om * dd * dd;
                    const f2v mi = om * (f2v){__builtin_amdgcn_rsqf(rq.x), __builtin_amdgcn_rsqf(rq.y)};
                    const f2v bx = mi * (f2v){bf2f(xcA[(32 * st + trow) * 72 + 32 * half + c32]), bf2f(xcA[(32 * st + trow + 1) * 72 + 32 * half + c32])};
                    h = a_.x * h + bx.x; P *= a_.x; hl[st][tl] = h; Pl[st][tl] = P;
                    h = a_.y * h + bx.y; P *= a_.y; hl[st][tl + 1] = h; Pl[st][tl + 1] = P;
                }
                Prun[st] = P; Hrun[st] = h;
                LDS_WAIT();
            }
            const float pP0 = __shfl_xor(Prun[0], 32), pH0 = __shfl_xor(Hrun[0], 32), pP1 = __shfl_xor(Prun[1], 32), pH1 = __shfl_xor(Hrun[1], 32);
            const float P0 = th ? pP0 : Prun[0], H0 = th ? pH0 : Hrun[0], P1 = th ? Prun[0] : pP0, H1 = th ? Hrun[0] : pH0;
            const float P2 = th ? pP1 : Prun[1], H2 = th ? pH1 : Hrun[1], P3 = th ? Prun[1] : pP1, H3 = th ? Hrun[1] : pH1;
            const float C1 = H0, Q1 = P0, C2 = P1 * C1 + H1, Q2 = P1 * Q1, C3 = P2 * C2 + H2, Q3 = P2 * Q2, Hc = P3 * C3 + H3, Pc = P3 * Q3;
            const float Cs0 = th ? C1 : 0.f, Qs0 = th ? Q1 : 1.f, Cs1 = th ? C3 : C2, Qs1 = th ? Q3 : Q2;
            const int cit = (rd * F.G + F.vcu) * NWAVES + F.wave; const bool cdo = cit < NEXP * 512;
            f32x4 ctv[8]; unsigned short ggr[2][16];
            if (cdo) { const TItem citem = expert_item(F, I, cit); transpose_load(citem, ctv, lane); }
#pragma unroll
            for (int st = 0; st < 2; ++st)
#pragma unroll
                for (int tl = 0; tl < 16; ++tl) ggr[st][tl] = GL[(tok0 + 32 * st + 16 * th + tl) * 1024 + chg];
            asm volatile("" ::: "memory");
            if (th == 0) sumT[((rd & 1) * 8 + F.wave) * 32 + c32] = (f32x2){Pc, Hc};
            LDS_WAIT();
            __syncthreads();
            float cin = Rc, mycin = 0.f;
#pragma unroll
            for (int w = 0; w < 8; ++w) { const f32x2 ph = sumT[((rd & 1) * 8 + w) * 32 + c32]; mycin = (w == F.wave) ? cin : mycin; cin = ph.x * cin + ph.y; }
            Rc = cin;
#pragma unroll
            for (int st = 0; st < 2; ++st) { const float hin = (st ? Cs1 : Cs0) + (st ? Qs1 : Qs0) * mycin;
#pragma unroll
                for (int tl = 0; tl < 16; ++tl) { const float hh = hl[st][tl] + Pl[st][tl] * hin;
                    YL[(tok0 + 32 * st + 16 * th + tl) * 1024 + chg] = (bf16)f2bf(hh * bf2f(ggr[st][tl])); } }
            if (cdo) { const TItem citem = expert_item(F, I, cit); transpose_store<true>(citem, ctv, pre, lane); }
        }
        __syncthreads();
    }
}

__device__ __forceinline__ void s5_chain(const Frame& F, int b, int g) {
    typedef float f32x2 __attribute__((ext_vector_type(2)));
    LAS f32x2* segE = (LAS f32x2*)(F.lds);
    const int lane = F.lane, w = F.wave;
    const float* SLOC = (const float*)(F.ws + WS_SLOC); unsigned* AGw = (unsigned*)(F.ws + WS_AG); const float* L16 = (const float*)(F.ws + SM_LAM16);
    const float lr = L16[(g * 64 + lane) * 2], li = L16[(g * 64 + lane) * 2 + 1];
    const float* sl = SLOC + ((size_t)(g * S5N + b * S5NCH + 32 * w)) * S5Q + 2 * lane;
    unsigned* ag = AGw + ((size_t)(g * S5N + b * S5NCH + 32 * w)) * (S5K / 2) + lane;
    float xr[32], xi[32];
#pragma unroll
    for (int u = 0; u < 32; ++u) { const float2 v = *(const float2*)(sl + (size_t)u * S5Q); xr[u] = v.x; xi[u] = v.y; }
    asm volatile("" ::: "memory");
    float sr = 0.f, si = 0.f;
#pragma unroll
    for (int u = 0; u < 32; ++u) { const float nr = lr * sr - li * si + xr[u], ni = lr * si + li * sr + xi[u]; xr[u] = sr; xi[u] = si; sr = nr; si = ni; }
    segE[w * 64 + lane] = (f32x2){sr, si};
    float qr = lr, qi = li;
#pragma unroll
    for (int k = 0; k < 5; ++k) { const float nr = qr * qr - qi * qi, ni = 2.f * qr * qi; qr = nr; qi = ni; }
    LDS_WAIT();
    __syncthreads();
    float cr = 0.f, ci = 0.f;
    for (int ww = 0; ww < w; ++ww) { const f32x2 e = segE[ww * 64 + lane]; const float nr = qr * cr - qi * ci + e.x, ni = qr * ci + qi * cr + e.y; cr = nr; ci = ni; }
#pragma unroll
    for (int u = 0; u < 32; ++u) { ag[(size_t)u * (S5K / 2)] = pk2(xr[u] + cr, xi[u] + ci); const float nr = lr * cr - li * ci, ni = lr * ci + li * cr; cr = nr; ci = ni; }
    __syncthreads();
}

__device__ __forceinline__ void p8_router(const Frame& F, const In& I) {
    const int lane = F.lane, tk = lane & 15, ks = lane >> 4;
    LAS float* lg = (LAS float*)(F.lds + F.wave * 4096);
    volatile LAS unsigned* cntL = F.MISC + 32; volatile LAS unsigned* baseL = F.MISC + 64;
    const float* X1 = I.p[0]; bf16* H2 = (bf16*)(F.ws + WS_H2); const float* gf = I.p[21];
    const unsigned char* D8 = (const unsigned char*)(F.ws + WS_D8); const float* DSC = (const float*)(F.ws + WS_DSC);
    const bf16* RHI = (const bf16*)(F.ws + SM_RHI); const bf16* RLO = (const bf16*)(F.ws + SM_RLO);
    float* RSTD = (float*)(F.ws + SM_RSTD); unsigned* gcnt = F.ctl + CW_CNT;
    int* LTOK = (int*)(F.ws + WS_LTOK); float* LW = (float*)(F.ws + WS_LW); int* TOKE = (int*)(F.ws + WS_TOKE); int* TOKR = (int*)(F.ws + WS_TOKR);
    for (int blk = F.vcu; blk < T / 128; blk += F.G) {
        if (F.tid < 32) cntL[F.tid] = 0u;
        __syncthreads();
        const int tok0 = blk * 128 + F.wave * 16;
        const float* xrow = X1 + (size_t)(tok0 + tk) * D + 8 * ks; bf16* hrow = H2 + (size_t)(tok0 + tk) * D + 8 * ks;
        f32x4 acc[3]; acc[0] = acc[1] = acc[2] = (f32x4){0.f, 0.f, 0.f, 0.f}; float ss = 0.f;
        const unsigned char* drow = D8 + (size_t)(tok0 + tk) * D + 8 * ks; const float* dsc = DSC + (size_t)(tok0 + tk) * 16;
        f32x4 xnx[4][2]; v2u dnx[4]; float snx[2];
#pragma unroll
        for (int q = 0; q < 4; ++q) { xnx[q][0] = __builtin_nontemporal_load((const f32x4*)(xrow + 32 * q)); xnx[q][1] = __builtin_nontemporal_load((const f32x4*)(xrow + 32 * q + 4)); dnx[q] = *(const v2u*)(drow + 32 * q); }
        snx[0] = dsc[0]; snx[1] = dsc[4];
        LAS bf16* slab = (LAS bf16*)(F.lds + 32768);
        v4u wst[3];
#define RT_SLAB_LOAD(g) do { _Pragma("unroll") for (int j = 0; j < 3; ++j) { const int c = F.tid + 512 * j, which = c / 768, r = (c % 768) >> 4, kq = c & 15; \
            wst[j] = *(const v4u*)((which ? RLO : RHI) + (size_t)r * D + 128 * (g) + 8 * kq); } } while (0)
#define RT_SLAB_STORE(buf) do { _Pragma("unroll") for (int j = 0; j < 3; ++j) { const int c = F.tid + 512 * j, which = c / 768, r = (c % 768) >> 4, kq = c & 15; \
            *(LAS v4u*)(slab + ((size_t)((buf) * 2 + which) * 48 + r) * 136 + 8 * kq) = wst[j]; } } while (0)
        RT_SLAB_LOAD(0); RT_SLAB_STORE(0);
        LDS_WAIT();
        __syncthreads();
        for (int kg = 0; kg < 8; ++kg) {
            f32x4 xa[4][2];
#pragma unroll
            for (int q = 0; q < 4; ++q) { const float sq = snx[q >> 1]; const v2u dq = dnx[q];
                xa[q][0] = xnx[q][0] + (f32x4){(float)((int)(dq.x << 24) >> 24), (float)((int)(dq.x << 16) >> 24), (float)((int)(dq.x << 8) >> 24), (float)((int)dq.x >> 24)} * sq;
                xa[q][1] = xnx[q][1] + (f32x4){(float)((int)(dq.y << 24) >> 24), (float)((int)(dq.y << 16) >> 24), (float)((int)(dq.y << 8) >> 24), (float)((int)dq.y >> 24)} * sq; }
            { const int kgn = kg < 7 ? kg + 1 : kg;
#pragma unroll
              for (int q = 0; q < 4; ++q) { xnx[q][0] = __builtin_nontemporal_load((const f32x4*)(xrow + 32 * (4 * kgn + q))); xnx[q][1] = __builtin_nontemporal_load((const f32x4*)(xrow + 32 * (4 * kgn + q) + 4)); dnx[q] = *(const v2u*)(drow + 32 * (4 * kgn + q)); }
              { const int G0 = 2 * kgn, G1 = 2 * kgn + 1; snx[0] = dsc[(G0 & 3) * 4 + (G0 >> 2)]; snx[1] = dsc[(G1 & 3) * 4 + (G1 >> 2)]; }
              RT_SLAB_LOAD(kgn); }
            f32x4 ga[4][2];
#pragma unroll
            for (int q = 0; q < 4; ++q) { const int kc = 4 * kg + q; ga[q][0] = *(const f32x4*)(gf + 32 * kc + 8 * ks); ga[q][1] = *(const f32x4*)(gf + 32 * kc + 8 * ks + 4); }
            asm volatile("" ::: "memory");
            const LAS bf16* sh = slab + (size_t)((kg & 1) * 2) * 48 * 136, * sl = sh + 48 * 136;
#pragma unroll
            for (int q = 0; q < 4; ++q) { const int kc = 4 * kg + q;
                const f32x4 a0 = xa[q][0], a1 = xa[q][1];
                ss += (a0.x * a0.x + a0.y * a0.y) + (a0.z * a0.z + a0.w * a0.w) + (a1.x * a1.x + a1.y * a1.y) + (a1.z * a1.z + a1.w * a1.w);
                const f32x4 v0 = a0 * ga[q][0], v1 = a1 * ga[q][1];
                v4u hi, lo;
                hi.x = pg8::cvt_pk_bf16(v0.x, v0.y); hi.y = pg8::cvt_pk_bf16(v0.z, v0.w); hi.z = pg8::cvt_pk_bf16(v1.x, v1.y); hi.w = pg8::cvt_pk_bf16(v1.z, v1.w);
                lo.x = pg8::cvt_pk_bf16(v0.x - bflo(hi.x), v0.y - bfhi(hi.x)); lo.y = pg8::cvt_pk_bf16(v0.z - bflo(hi.y), v0.w - bfhi(hi.y));
                lo.z = pg8::cvt_pk_bf16(v1.x - bflo(hi.z), v1.y - bfhi(hi.z)); lo.w = pg8::cvt_pk_bf16(v1.z - bflo(hi.w), v1.w - bfhi(hi.w));
                *(v4u*)(hrow + 32 * kc) = hi;
                const bf16x8 hf = __builtin_bit_cast(bf16x8, hi), lf = __builtin_bit_cast(bf16x8, lo);
#pragma unroll
                for (int n = 0; n < 3; ++n) {
                    const bf16x8 wh = *(const LAS bf16x8*)(sh + (16 * n + tk) * 136 + 32 * q + 8 * ks), wl = *(const LAS bf16x8*)(sl + (16 * n + tk) * 136 + 32 * q + 8 * ks);
                    acc[n] = __builtin_amdgcn_mfma_f32_16x16x32_bf16(wh, hf, acc[n], 0, 0, 0);
                    acc[n] = __builtin_amdgcn_mfma_f32_16x16x32_bf16(wh, lf, acc[n], 0, 0, 0);
                    acc[n] = __builtin_amdgcn_mfma_f32_16x16x32_bf16(wl, hf, acc[n], 0, 0, 0);
                } }
            if (kg < 7) RT_SLAB_STORE((kg + 1) & 1);
            LDS_WAIT();
            __syncthreads();
        }
#undef RT_SLAB_LOAD
#undef RT_SLAB_STORE
        ss += __shfl_xor(ss, 16); ss += __shfl_xor(ss, 32);
        const float rstd = 1.0f / sqrtf(ss * (1.f / D) + RMS_EPS);
        if (ks == 0) RSTD[tok0 + tk] = rstd;
#pragma unroll
        for (int n = 0; n < 3; ++n)
#pragma unroll
            for (int r = 0; r < 4; ++r) lg[tk * 49 + 16 * n + 4 * ks + r] = acc[n][r] * rstd;
        LDS_WAIT();
        int E1 = 0, E2 = 0; float w1 = 0.f, w2 = 0.f; unsigned r1 = 0, r2 = 0;
        if (lane < 16) {
            const LAS float* my = lg + lane * 49;
            float lgp[4];
#pragma unroll
            for (int i = 0; i < 4; ++i) lgp[i] = my[i] + I.p[23][i];
            int gi = 0; float mx = lgp[0];
#pragma unroll
            for (int i = 1; i < 4; ++i) if (lgp[i] > mx) { mx = lgp[i]; gi = i; }
            float den = 0.f;
#pragma unroll
            for (int i = 0; i < 4; ++i) den += expf(lgp[i] - mx);
            const float pg = 1.0f / den;
            float le[8];
#pragma unroll
            for (int i = 0; i < 8; ++i) le[i] = my[4 + gi * 8 + i] + I.p[25][gi * 8 + i];
            int i1 = 0; float m1 = le[0];
#pragma unroll
            for (int i = 1; i < 8; ++i) if (le[i] > m1) { m1 = le[i]; i1 = i; }
            int i2 = -1; float m2 = -3.0e38f;
#pragma unroll
            for (int i = 0; i < 8; ++i) if (i != i1 && le[i] > m2) { m2 = le[i]; i2 = i; }
            const float e2 = expf(m2 - m1);
            w1 = pg / (1.0f + e2); w2 = pg * e2 / (1.0f + e2);
            E1 = gi * 8 + i1; E2 = gi * 8 + i2;
            r1 = __hip_atomic_fetch_add((LAS unsigned*)(F.MISC + 32) + E1, 1u, __ATOMIC_RELAXED, __HIP_MEMORY_SCOPE_WORKGROUP);
            r2 = __hip_atomic_fetch_add((LAS unsigned*)(F.MISC + 32) + E2, 1u, __ATOMIC_RELAXED, __HIP_MEMORY_SCOPE_WORKGROUP);
        }
        LDS_WAIT();
        __syncthreads();
        if (F.tid < 32) { const unsigned c = cntL[F.tid]; baseL[F.tid] = c ? __hip_atomic_fetch_add(gcnt + F.tid, c, __ATOMIC_RELAXED, __HIP_MEMORY_SCOPE_AGENT) : 0u; }
        __syncthreads();
        if (lane < 16) {
            const int tok = tok0 + lane; const int k1 = (int)(baseL[E1] + r1), k2 = (int)(baseL[E2] + r2);
            LTOK[(size_t)E1 * T + k1] = tok; LW[(size_t)E1 * T + k1] = w1; LTOK[(size_t)E2 * T + k2] = tok; LW[(size_t)E2 * T + k2] = w2;
            TOKE[tok * 2] = E1; TOKE[tok * 2 + 1] = E2; TOKR[tok * 2] = k1; TOKR[tok * 2 + 1] = k2;
        }
        __syncthreads();
    }
}

__device__ __forceinline__ void moe_prefix(const Frame& F) {
    if (F.tid < 64) {
        const unsigned nt = F.tid < NEXP ? (F.ctl[CW_CNT + F.tid] + 255u) >> 8 : 0u; unsigned inc = nt;
#pragma unroll
        for (int o = 1; o < 32; o <<= 1) { const unsigned v = __shfl_up(inc, o); if (F.lane >= o) inc += v; }
        if (F.tid < NEXP) F.MISC[96 + F.tid] = inc - nt;
        if (F.tid == NEXP - 1) F.MISC[128] = inc;
    }
    LDS_WAIT();
    __syncthreads();
}
template <int MODE  >
__device__ __forceinline__ void moe_setup(const Frame& F) {
    moe_prefix(F);
    const int NT = (int)F.MISC[128];
    if (F.tid < MAXU) { const int L = F.tid * F.G + F.vcu; int e = -1, mt = 0;
        if (L < NT * 4) { const int mtg = L >> 2; e = 0; while (e < NEXP - 1 && (int)F.MISC[96 + e + 1] <= mtg) ++e; mt = mtg - (int)F.MISC[96 + e]; }
        F.MISC[136 + F.tid] = (unsigned)e; F.MISC[144 + F.tid] = (unsigned)mt; }
    __syncthreads();
    if (F.tid == 0) { int n = 0; while (n < MAXU && (int)F.MISC[136 + n] >= 0) ++n; F.MISC[152] = (unsigned)n; }
    __syncthreads();
    const int nU = (int)F.MISC[152];
    LAS int* tokL = (LAS int*)(F.lds + TOKL_OFF); LAS float* sclL = (LAS float*)(F.lds + SCLL_OFF);
    const int* LTOK = (const int*)(F.ws + WS_LTOK); const float* LW = (const float*)(F.ws + WS_LW); const float* RSTD = (const float*)(F.ws + SM_RSTD);
    for (int i = F.tid; i < nU * 256; i += 512) { const int ui = i >> 8, r = i & 255, e = (int)F.MISC[136 + ui], rank = (int)F.MISC[144 + ui] * 256 + r; const bool valid = rank < (int)F.ctl[CW_CNT + e];
        const int tok = valid ? LTOK[(size_t)e * T + rank] : 0; tokL[i] = tok; sclL[i] = valid ? (MODE == 0 ? RSTD[tok] : LW[(size_t)e * T + rank]) : 0.f; }
    LDS_WAIT(); VM_WAIT();
    __syncthreads();
}

__device__ __forceinline__ void p11_final(const Frame& F, const In& I, float* dst) {
    moe_prefix(F);
    const int gw = F.vcu * NWAVES + F.wave, NGW = F.G * NWAVES, lane = F.lane;
    const int* TOKE = (const int*)(F.ws + WS_TOKE); const int* TOKR = (const int*)(F.ws + WS_TOKR);
    const unsigned char* YS8 = (const unsigned char*)(F.ws + WS_YS); const float* YSC = (const float*)(F.ws + WS_YS + 80 * MiB);
    const unsigned char* D8 = (const unsigned char*)(F.ws + WS_D8); const float* DSC = (const float*)(F.ws + WS_DSC); const float* X = I.p[0];
    f32x4 gfin[4];
#pragma unroll
    for (int j = 0; j < 4; ++j) gfin[j] = ((const f32x4*)I.p[29])[lane + 64 * j];
    int ee[2][2], rr[2][2];
    { const int m0 = gw * 2 < T ? gw * 2 : 0;
#pragma unroll
      for (int q = 0; q < 2; ++q) { ee[q][0] = TOKE[2 * (m0 + q)]; ee[q][1] = TOKE[2 * (m0 + q) + 1]; rr[q][0] = TOKR[2 * (m0 + q)]; rr[q][1] = TOKR[2 * (m0 + q) + 1]; } }
    for (int m0 = gw * 2; m0 < T; m0 += NGW * 2) {
        f32x4 xv[2][4]; unsigned ya[2][4], yb[2][4], yd[2][4]; f32x4 sa[2], sb[2], sd[2];
#pragma unroll
        for (int q = 0; q < 2; ++q) { const size_t s0 = (size_t)F.MISC[96 + ee[q][0]] * 256 + rr[q][0], s1 = (size_t)F.MISC[96 + ee[q][1]] * 256 + rr[q][1];
            const f32x4* xr = (const f32x4*)(X + (size_t)(m0 + q) * D) + lane; const unsigned* y0 = (const unsigned*)(YS8 + s0 * 1024) + lane; const unsigned* y1 = (const unsigned*)(YS8 + s1 * 1024) + lane;
            const unsigned* d0 = (const unsigned*)(D8 + (size_t)(m0 + q) * 1024) + lane;
#pragma unroll
            for (int j = 0; j < 4; ++j) { xv[q][j] = __builtin_nontemporal_load(xr + 64 * j); ya[q][j] = y0[64 * j]; yb[q][j] = y1[64 * j]; yd[q][j] = d0[64 * j]; }
            sa[q] = *(const f32x4*)(YSC + s0 * 16 + 4 * (lane >> 4)); sb[q] = *(const f32x4*)(YSC + s1 * 16 + 4 * (lane >> 4)); sd[q] = *(const f32x4*)(DSC + (size_t)(m0 + q) * 16 + 4 * (lane >> 4)); }
        { const int mn = m0 + NGW * 2 < T ? m0 + NGW * 2 : m0;
#pragma unroll
          for (int q = 0; q < 2; ++q) { ee[q][0] = TOKE[2 * (mn + q)]; ee[q][1] = TOKE[2 * (mn + q) + 1]; rr[q][0] = TOKR[2 * (mn + q)]; rr[q][1] = TOKR[2 * (mn + q) + 1]; } }
        asm volatile("" ::: "memory");
#pragma unroll
        for (int q = 0; q < 2; ++q) { f32x4 v[4]; float s = 0.f;
#pragma unroll
            for (int j = 0; j < 4; ++j) { const f32x4 x = xv[q][j]; const unsigned a = ya[q][j], b = yb[q][j], c = yd[q][j]; const float ka = sa[q][j], kb = sb[q][j], kc = sd[q][j];
                v[j].x = (x.x + (float)((int)(c << 24) >> 24) * kc) + (float)((int)(a << 24) >> 24) * ka + (float)((int)(b << 24) >> 24) * kb;
                v[j].y = (x.y + (float)((int)(c << 16) >> 24) * kc) + (float)((int)(a << 16) >> 24) * ka + (float)((int)(b << 16) >> 24) * kb;
                v[j].z = (x.z + (float)((int)(c << 8) >> 24) * kc) + (float)((int)(a << 8) >> 24) * ka + (float)((int)(b << 8) >> 24) * kb;
                v[j].w = (x.w + (float)((int)c >> 24) * kc) + (float)((int)a >> 24) * ka + (float)((int)b >> 24) * kb;
                s += (v[j].x * v[j].x + v[j].y * v[j].y) + (v[j].z * v[j].z + v[j].w * v[j].w); }
            const float rstd = 1.0f / sqrtf(wave_sum(s) * (1.f / D) + RMS_EPS);
            f32x4* xw = (f32x4*)(dst + (size_t)(m0 + q) * D) + lane;
#pragma unroll
            for (int j = 0; j < 4; ++j) { const f32x4 g = gfin[j]; __builtin_nontemporal_store((f32x4){v[j].x * rstd * g.x, v[j].y * rstd * g.y, v[j].z * rstd * g.z, v[j].w * rstd * g.w}, xw + 64 * j); } }
    }
}

constexpr int N_PHASES = 12;
struct Args { In in; float* out; unsigned char* ws; float* fin_dst; int ph_lo, ph_hi, li, pad; };
__global__ void __launch_bounds__(NWAVES * 64, 2) mk_fwd(Args args) {
    extern __shared__ __attribute__((aligned(16))) unsigned char lds[];
    Frame F;
    F.lds = (LAS unsigned char*)lds;
    F.MISC = (volatile LAS unsigned*)(F.lds + MISC_OFF);
    F.tid = threadIdx.x; F.lane = F.tid & 63; F.wave = __builtin_amdgcn_readfirstlane(F.tid >> 6);
    F.G = gridDim.x; { const int bx = blockIdx.x; F.vcu = (F.G % 8 == 0) ? (bx % 8) * (F.G / 8) + bx / 8 : bx; }
    F.ws = args.ws; F.out = args.out; F.ctl = (unsigned*)(args.ws + WS_CTL); F.in = nullptr;
    const In& I = args.in;
    for (int u = F.tid; u < 256; u += NWAVES * 64) F.MISC[u] = 0u;
    __syncthreads();
    const int lo = args.ph_lo, hi = args.ph_hi;
    XcdBarrier bar; bar.bar = F.ctl + CW_BAR + args.li * XCD_BAR_WORDS; bar.x = 0; bar.st = nullptr;
    if (hi - lo > 1) bar = xcd_barrier_post(F.ctl + CW_BAR + args.li * XCD_BAR_WORDS, F.MISC + 8);
#ifndef PH_MASK
#define PH_MASK 0xFFF
#endif
#define IN(k) (((PH_MASK >> (k)) & 1) && lo <= (k) && (k) < hi)
#define SEAM(k) do { if (IN(k) && IN(NEXT_PH(k))) xcd_barrier(bar); } while (0)
#define NEXT_PH(k) ((k) == 2 ? 5 : (k) == 5 ? 7 : (k) + 1)
    const int cblk = (int)blockIdx.x;
    LAS unsigned char* ring = F.lds;

    if (IN(0)) { p0_prologue(F, I); SEAM(0); }

    if (IN(1)) {
        DenseOrder S; S.init(F.ws + WS_H, F.ws + WS_WIN, D, D, T, NIN, F.G, cblk);
        EpiInProj E{(bf16*)(F.ws + WS_AG), (bf16*)(F.ws + WS_XL), (bf16*)(F.ws + WS_GL), (bf16*)(F.ws + WS_GA), (bf16*)(F.ws + WS_GB)};
        pg8::gemm_phase<EpiInProj, DenseOrder, true>(ring, D, D, S, E);
        SEAM(1);
    }
    if (IN(2)) {
        if (cblk < 256) {
            const int L = cblk, wgid = (L % 8) * 32 + L / 8, g = wgid >> 3, mt = wgid & 7;
            { S5One S{(const char*)(F.ws + WS_AG) + S5Q * 2, (const char*)(F.ws + WS_BTW), (size_t)S5N * S5K * 2, (size_t)128 * 256 * 2, S5K, g, mt};
              EpiS5State E{(float*)(F.ws + WS_SLOC)};
              pg8::gemm_phase<EpiS5State, S5One, false>(ring, 256, 256, S, E); }
            if (F.wave == 0) { __builtin_amdgcn_fence(__ATOMIC_ACQUIRE, "agent"); VM_WAIT(); }
            __syncthreads();
            s5_chain(F, mt, g);
            VM_WAIT();
            __syncthreads();
            if (F.wave == 0) { __builtin_amdgcn_fence(__ATOMIC_ACQUIRE, "agent"); VM_WAIT(); }
            __syncthreads();
            { S5One S{(const char*)(F.ws + WS_AG), (const char*)(F.ws + WS_BTT), (size_t)S5N * S5K * 2, (size_t)256 * S5K * 2, S5K, g, mt};
              EpiS5Out E{(bf16*)(F.ws + WS_GY)};
              pg8::gemm_phase<EpiS5Out, S5One, false>(ring, S5K, S5K, S, E); }
            __syncthreads();
        }
        lru_seq(F, I);
        SEAM(2);
    }
    if (IN(5)) {
        YaYbOrder S; S.d.init(nullptr, nullptr, D, D, T, D, F.G, cblk);
        S.GYb = (const char*)(F.ws + WS_GY); S.WS5b = (const char*)(F.ws + WS_WS5); S.YLb = (const char*)(F.ws + WS_H); S.WLb = (const char*)(F.ws + WS_WLRU);
        EpiYaYb E{EpiYa{(const bf16*)(F.ws + WS_GA), (bf16*)(F.ws + WS_XL)}, EpiYb{(const bf16*)(F.ws + WS_XL), (const bf16*)(F.ws + WS_GB), (bf16*)(F.ws + WS_GL)}};
        pg8::gemm_phase<EpiYaYb, YaYbOrder, true>(ring, D, D, S, E);
        SEAM(5);
    }
    if (IN(7)) {
        DenseOrder S; S.init(F.ws + WS_GL, F.ws + WS_WO, D, D, T, D, F.G, cblk);
        EpiQ8<false> E{(unsigned char*)(F.ws + WS_D8), (float*)(F.ws + WS_DSC), nullptr};
        pg8::gemm_phase<EpiQ8<false>, DenseOrder, true>(ring, D, D, S, E);
        SEAM(7);
    }
    if (IN(8)) { p8_router(F, I); __syncthreads(); expert_weight_copies(F, I); SEAM(8); }
    if (IN(9)) {
        moe_setup<0>(F);
        MoeOrder<true> S{(const char*)(F.ws + WS_H2), (const char*)(F.ws + WS_WGU), (size_t)1024 * 1024 * 2, D, D, F.G, F.vcu, F.MISC, (const LAS int*)(F.lds + TOKL_OFF)};
        EpiGU E{(bf16*)(F.ws + WS_ACT), (const LAS float*)(F.lds + SCLL_OFF)};
        pg8::gemm_phase<EpiGU, MoeOrder<true>, true>(ring, D, D, S, E);
        __syncthreads();
        expert_down_copies(F, I);
        SEAM(9);
    }
    if (IN(10)) {
        moe_setup<1>(F);
        MoeOrder<false> S{(const char*)(F.ws + WS_ACT), (const char*)(F.ws + WS_WD), (size_t)1024 * DEXP * 2, DEXP, DEXP, F.G, F.vcu, F.MISC, (const LAS int*)(F.lds + TOKL_OFF)};
        EpiQ8<true> E{(unsigned char*)(F.ws + WS_YS), (float*)(F.ws + WS_YS + 80 * MiB), (const LAS float*)(F.lds + SCLL_OFF)};
        pg8::gemm_phase<EpiQ8<true>, MoeOrder<false>, true>(ring, DEXP, DEXP, S, E);
        SEAM(10);
    }
    if (IN(11)) { p11_final(F, I, args.fin_dst); }
#undef IN
#undef SEAM
}

extern "C" void kernel_launch(void* const* d_in, const int* in_sizes, int n_in, void* d_out, int out_size, void* d_ws, size_t ws_size, hipStream_t stream) {
    static int grid = 0;
    if (grid == 0) {
        if (n_in != 30 || in_sizes[0] != T * D || out_size != T * D || ws_size < WS_END) { fprintf(stderr, "kernel_launch: unexpected shapes / workspace (n_in %d, ws %zu)\n", n_in, ws_size); grid = -1; return; }
        int dev = 0, cus = 0, per_cu = 0;
        if (hipGetDevice(&dev) != hipSuccess || hipDeviceGetAttribute(&cus, hipDeviceAttributeMultiprocessorCount, dev) != hipSuccess) { grid = -1; return; }
        if (hipFuncSetAttribute((const void*)mk_fwd, hipFuncAttributeMaxDynamicSharedMemorySize, LDS_BYTES) != hipSuccess) { fprintf(stderr, "kernel_launch: hipFuncSetAttribute failed\n"); grid = -1; return; }
        if (hipOccupancyMaxActiveBlocksPerMultiprocessor(&per_cu, (const void*)mk_fwd, NWAVES * 64, LDS_BYTES) != hipSuccess || per_cu < 1) { fprintf(stderr, "kernel_launch: occupancy query says %d\n", per_cu); }
        (void)hipGetLastError();
        grid = cus;
    }
    if (grid < 0) return;
    if (hipMemsetAsync((char*)d_ws + WS_CTL, 0, CTL_ZERO_BYTES, stream) != hipSuccess) return;
    Args a{};
    for (int i = 0; i < 30; ++i) a.in.p[i] = (const float*)d_in[i];
    a.out = (float*)d_out; a.ws = (unsigned char*)d_ws; a.fin_dst = (float*)d_out;
#if defined(PROBE_LO)
    a.ph_lo = 0; a.ph_hi = PROBE_HI; a.li = 0;
#if PROBE_LO == 11
    a.fin_dst = (float*)((char*)d_ws + WS_H2);
#endif
    hipLaunchKernelGGL(mk_fwd, dim3(grid), dim3(NWAVES * 64), LDS_BYTES, stream, a);
#if PROBE_LO == 8
    hipMemsetAsync((char*)d_ws + WS_CTL + CW_CNT * 4, 0, 128, stream);
#endif
    a.fin_dst = (float*)d_out;
    a.ph_lo = PROBE_LO; a.ph_hi = N_PHASES; a.li = 1;
    hipLaunchKernelGGL(mk_fwd, dim3(grid), dim3(NWAVES * 64), LDS_BYTES, stream, a);
#elif MK_N_LAUNCHES == 1
    a.ph_lo = 0; a.ph_hi = N_PHASES;
    hipLaunchKernelGGL(mk_fwd, dim3(grid), dim3(NWAVES * 64), LDS_BYTES, stream, a);
#else
    for (int p = 0; p < N_PHASES; ++p) { a.ph_lo = p; a.ph_hi = p + 1; hipLaunchKernelGGL(mk_fwd, dim3(grid), dim3(NWAVES * 64), LDS_BYTES, stream, a); }
#endif
}
```

```cpp
#include <hip/hip_runtime.h>
#include <cstdio>
#include <cstdint>

#ifndef MK_N_LAUNCHES
#define MK_N_LAUNCHES 1
#endif

namespace pg8 {
#define PG8_LAS __attribute__((address_space(3)))
typedef unsigned short bf16_t;
typedef short bf16x8 __attribute__((ext_vector_type(8)));
typedef float f32x4 __attribute__((ext_vector_type(4)));
typedef unsigned u32x4 __attribute__((ext_vector_type(4)));
constexpr int BM = 256, BK = 64, HALF = 128, HTB = HALF * BK * 2  , STAGE_BYTES = 8 * HTB, NXCD = 8, WGM = 8;

__host__ __device__ __forceinline__ int lds_byte(int r, int c) { const int st = (r >> 4) * 2 + (c >> 5), rr = r & 15, cc = c & 31, ob = rr * 64 + cc * 2; return st * 1024 + (ob ^ (((ob >> 9) & 1) << 5)); }
__host__ __device__ __forceinline__ void stage_rc(int b, int& R, int& C) { const int st = b / 1024, sb = b % 1024, swz = sb ^ (((sb >> 9) & 1) << 5); R = (st >> 1) * 16 + swz / 64; C = (st & 1) * 32 + (swz % 64) / 2; }
__host__ __device__ __forceinline__ int perm32(int rho) { const int n = rho >> 4, i = rho & 15; return 8 * (i >> 2) + 4 * n + (i & 3); }

struct Unit { const char* A; const char* B; int pm, pn, aux, nt, kind; unsigned kA; };

__device__ __forceinline__ unsigned cvt_pk_bf16(float lo, float hi) { unsigned r; asm volatile("v_cvt_pk_bf16_f32 %0, %1, %2" : "=v"(r) : "v"(lo), "v"(hi)); return r; }

template <class Epi, class Sched, bool ALIGN_EPI>
__device__ __forceinline__ void gemm_phase(PG8_LAS unsigned char* lds, const int ldb, const int K, const Sched& S, const Epi& E, const size_t kstepA = (size_t)(BK * 2)) {
    const int tid = threadIdx.x, wid = __builtin_amdgcn_readfirstlane(tid >> 6), lane = tid & 63, wr = wid >> 2, wc = wid & 3, fr = lane & 15, fq = lane >> 4;
    int nt = K / BK; asm volatile("" : "+s"(nt));
    int Rr[2], Cc[2], Rbb[2]; unsigned voffB[4], vAc[4], vAn[4];
#pragma unroll
    for (int i = 0; i < 2; ++i) { int R, C; stage_rc(tid * 16 + i * 8192, R, C); Rr[i] = R; Cc[i] = C; const int Rb = Epi::PERM ? ((R & ~31) + perm32(R & 31)) : R; Rbb[i] = Rb;
        int Rb0 = Rb, Rb1 = HALF + Rb;
        if constexpr (Epi::B16) {
            const int w_ = R >> 5, nn_ = (R >> 4) & 1, ii_ = R & 15; Rb0 = 64 * w_ + 16 * (ii_ >> 2) + 4 * nn_ + (ii_ & 3); Rb1 = Rb0 + 8; }
        voffB[i] = (unsigned)(Rb0 * ldb + C) * 2u; voffB[2 + i] = (unsigned)(Rb1 * ldb + C) * 2u; }
    const size_t kstep = (size_t)(BK * 2);
    const unsigned ldsw = (unsigned)wid * 1024u;
    const int aoff = lds_byte(wr * 64 + fr, fq * 8), boff = lds_byte(wc * 32 + fr, fq * 8);
#define PG8_SA(b, h) (((b) * 2 + (h)) * HTB)
#define PG8_SB(b, h) ((4 + (b) * 2 + (h)) * HTB)
#define PG8_STAGE(bufoff, gbase, voff, h) do { _Pragma("unroll") for (int _i = 0; _i < 2; ++_i) \
        __builtin_amdgcn_global_load_lds((const unsigned*)((const char*)(gbase) + (voff)[2 * (h) + _i]), (PG8_LAS unsigned*)(lds + (bufoff) + ldsw + _i * 8192), 16, 0, 0); } while (0)
#define PG8_LDA(dst, b, h) do { _Pragma("unroll") for (int m = 0; m < 4; ++m) _Pragma("unroll") for (int k = 0; k < 2; ++k) dst[m][k] = *(const PG8_LAS bf16x8*)(lds + PG8_SA(b, h) + aoff + m * 2048 + k * 1024); } while (0)
#define PG8_LDB(dst, b, h) do { _Pragma("unroll") for (int n = 0; n < 2; ++n) _Pragma("unroll") for (int k = 0; k < 2; ++k) dst[n][k] = *(const PG8_LAS bf16x8*)(lds + PG8_SB(b, h) + boff + n * 2048 + k * 1024); } while (0)
#define PG8_MMA(ai, bj, At, Bt) do { __builtin_amdgcn_s_setprio(1); _Pragma("unroll") for (int m = 0; m < 4; ++m) _Pragma("unroll") for (int n = 0; n < 2; ++n) _Pragma("unroll") for (int k = 0; k < 2; ++k) \
        acc[ai][bj][m][n] = __builtin_amdgcn_mfma_f32_16x16x32_bf16(Bt[n][k], At[m][k], acc[ai][bj][m][n], 0, 0, 0); __builtin_amdgcn_s_setprio(0); } while (0)
#define PG8_WAIT_V(n) asm volatile("s_waitcnt vmcnt(" #n ")" ::: "memory")
#define PG8_WAIT_L(n) asm volatile("s_waitcnt lgkmcnt(" #n ")" ::: "memory")
#define PG8_BAR __builtin_amdgcn_s_barrier()
#define PG8_SCHED __builtin_amdgcn_sched_barrier(0)
    Unit cur, nxt; int ui = 0;
    if (!S.next(0, cur)) return;
    S.a_offsets(cur, Rr, Cc, vAc);
    unsigned vBc[4], vBn[4];
    if constexpr (Sched::HETERO) { S.b_offsets(cur, Rbb, Cc, vBc); nt = __builtin_amdgcn_readfirstlane(cur.nt); }
    else {
#pragma unroll
        for (int q = 0; q < 4; ++q) vBc[q] = voffB[q]; }
    size_t kAc = Sched::HETERO ? (size_t)(unsigned)__builtin_amdgcn_readfirstlane((int)cur.kA) : kstepA;
    f32x4 acc[2][2][4][2];
    if constexpr (Epi::ACC_INIT) E.init(acc, cur, wr, wc, fr, fq);
    else {
#pragma unroll
    for (int a = 0; a < 2; ++a)
#pragma unroll
        for (int b = 0; b < 2; ++b)
#pragma unroll
            for (int m = 0; m < 4; ++m)
#pragma unroll
                for (int n = 0; n < 2; ++n) acc[a][b][m][n] = (f32x4){0.f, 0.f, 0.f, 0.f}; }
    bf16x8 At[4][2], B0[2][2], B1[2][2];
    const char* cA = cur.A; const char* cB = cur.B;
    if constexpr (Sched::GATHER) { PG8_WAIT_L(0); }
    PG8_STAGE(PG8_SB(0, 0), cB, vBc, 0); PG8_STAGE(PG8_SB(0, 1), cB, vBc, 1); PG8_STAGE(PG8_SA(0, 0), cA, vAc, 0); PG8_STAGE(PG8_SA(0, 1), cA, vAc, 1);
    if (wr == 1) PG8_BAR;
    PG8_WAIT_V(2); PG8_BAR;
    PG8_STAGE(PG8_SB(1, 0), cB + kstep, vBc, 0); PG8_STAGE(PG8_SA(1, 0), cA + kAc, vAc, 0); PG8_STAGE(PG8_SB(1, 1), cB + kstep, vBc, 1);
    PG8_WAIT_V(6); PG8_BAR;
    for (;;) {
        const bool has_next = S.next(ui + 1, nxt);
        const char* nA = has_next ? nxt.A : cA; const char* nB = has_next ? nxt.B : cB;
        size_t kAn = kAc;
        if constexpr (Sched::HETERO) { if (has_next) { S.b_offsets(nxt, Rbb, Cc, vBn); kAn = (size_t)(unsigned)__builtin_amdgcn_readfirstlane((int)nxt.kA); } else {
#pragma unroll
                for (int q = 0; q < 4; ++q) vBn[q] = vBc[q]; } }
        for (int t = 0; t < nt; t += 2) {
            const bool last = (t == nt - 2);
            const char* a1 = cA + (size_t)(t + 1) * kAc;
            const char* a2 = last ? nA : cA + (size_t)(t + 2) * kAc; const char* b2 = last ? nB : cB + (size_t)(t + 2) * kstep;
            const char* a3 = a2 + (last ? kAn : kAc); const char* b3 = b2 + kstep;
            unsigned vb2[4];
#pragma unroll
            for (int q = 0; q < 4; ++q) vb2[q] = (Sched::HETERO && last) ? vBn[q] : vBc[q];
            unsigned va2[4];
            if constexpr (Sched::GATHER || Sched::HETERO) {
                if (last) { if (has_next) { S.a_offsets(nxt, Rr, Cc, vAn); if constexpr (Sched::GATHER) { PG8_WAIT_L(0); } } else {
#pragma unroll
                        for (int q = 0; q < 4; ++q) vAn[q] = vAc[q]; } }
#pragma unroll
                for (int q = 0; q < 4; ++q) va2[q] = last ? vAn[q] : vAc[q];
            } else {
#pragma unroll
                for (int q = 0; q < 4; ++q) va2[q] = vAc[q];
            }
            PG8_LDB(B0, 0, 0); PG8_LDB(B1, 0, 1); PG8_SCHED; PG8_LDA(At, 0, 0); PG8_STAGE(PG8_SA(1, 1), a1, vAc, 1);
            PG8_WAIT_V(8); PG8_WAIT_L(0); PG8_BAR; PG8_MMA(0, 0, At, B0); PG8_MMA(0, 1, At, B1); PG8_BAR; PG8_SCHED;
            const bool fin = last && !has_next;
            PG8_LDA(At, 0, 1);
            if (!fin) { PG8_STAGE(PG8_SB(0, 0), b2, vb2, 0); PG8_STAGE(PG8_SB(0, 1), b2, vb2, 1); PG8_STAGE(PG8_SA(0, 0), a2, va2, 0); PG8_WAIT_V(8); } else { PG8_WAIT_V(0); }
            PG8_WAIT_L(0); PG8_BAR; PG8_MMA(1, 0, At, B0); PG8_MMA(1, 1, At, B1); PG8_BAR; PG8_SCHED;
            PG8_LDB(B0, 1, 0); PG8_LDB(B1, 1, 1); PG8_SCHED; PG8_LDA(At, 1, 0);
            if (!fin) { PG8_STAGE(PG8_SA(0, 1), a2, va2, 1); PG8_WAIT_V(8); } else { PG8_WAIT_V(0); }
            PG8_WAIT_L(0); PG8_BAR; PG8_MMA(0, 0, At, B0); PG8_MMA(0, 1, At, B1); PG8_BAR; PG8_SCHED;
            PG8_LDA(At, 1, 1);
            if (!fin) { PG8_STAGE(PG8_SB(1, 0), b3, vb2, 0); PG8_STAGE(PG8_SB(1, 1), b3, vb2, 1); PG8_STAGE(PG8_SA(1, 0), a3, va2, 0); PG8_WAIT_V(8); } else { PG8_WAIT_V(0); }
            PG8_WAIT_L(0); PG8_BAR; PG8_MMA(1, 0, At, B0); PG8_MMA(1, 1, At, B1); PG8_BAR; PG8_SCHED;
        }
        if constexpr (ALIGN_EPI) { if (wr == 0) PG8_BAR; }
        E(acc, cur, wr, wc, fr, fq);
        if (!has_next) break;
        if constexpr (Epi::ACC_INIT) E.init(acc, nxt, wr, wc, fr, fq);
        else {
#pragma unroll
        for (int a = 0; a < 2; ++a)
#pragma unroll
            for (int b = 0; b < 2; ++b)
#pragma unroll
                for (int m = 0; m < 4; ++m)
#pragma unroll
                    for (int n = 0; n < 2; ++n) acc[a][b][m][n] = (f32x4){0.f, 0.f, 0.f, 0.f}; }
        cur = nxt; cA = nA; cB = nB; ++ui;
        if constexpr (Sched::GATHER || Sched::HETERO) {
#pragma unroll
            for (int q = 0; q < 4; ++q) vAc[q] = vAn[q]; }
        if constexpr (Sched::HETERO) {
#pragma unroll
            for (int q = 0; q < 4; ++q) vBc[q] = vBn[q];
            kAc = kAn; nt = __builtin_amdgcn_readfirstlane(cur.nt); }
        if constexpr (ALIGN_EPI) { if (wr == 1) PG8_BAR; }
    }
    PG8_WAIT_V(0);
    if constexpr (!ALIGN_EPI) { if (wr == 0) PG8_BAR; }
    PG8_BAR;
#undef PG8_SA
#undef PG8_SB
#undef PG8_STAGE
#undef PG8_LDA
#undef PG8_LDB
#undef PG8_MMA
#undef PG8_WAIT_V
#undef PG8_WAIT_L
#undef PG8_BAR
#undef PG8_SCHED
}
}

constexpr int NWAVES = 8;
constexpr int BATCH = 8, SEQ = 4096, D = 1024, T = BATCH * SEQ;
constexpr int S5W = 512, S5G = 32, S5C = 16, S5P = 64, S5Q = 128;
constexpr int S5LC = 16, S5NCH = SEQ / S5LC, S5N = BATCH * S5NCH;
constexpr int S5K = S5Q + S5LC * S5C;
constexpr int LRUW = 1024, LRUH = 16, LRUHD = 64, LRUCH = 64, LRUNCH = SEQ / LRUCH;
constexpr int NIN = S5W + 2 * LRUW + 2 * D;
constexpr int NEXP = 32, EPG = 8, NGRP = 4, DEXP = 512, NROUT = 48;
constexpr int MAXSLOT = 73728;
constexpr int MAXU = 8;
constexpr float RMS_EPS = 1e-6f;

constexpr size_t MiB = 1u << 20;
constexpr size_t WS_CTL = 0, CTL_ZERO_BYTES = 128 * 1024;
constexpr size_t WS_SMALL = 1 * MiB;
constexpr size_t SM_LAM16 = WS_SMALL + 0;
constexpr size_t SM_LRUC = WS_SMALL + 16384;
constexpr size_t SM_WRT = WS_SMALL + 32768;
constexpr size_t SM_RHI = WS_SMALL + 327680;
constexpr size_t SM_RLO = SM_RHI + 98304;
constexpr size_t SM_RSTD = WS_SMALL + 524288;
constexpr size_t WS_BTT = 2 * MiB;
constexpr size_t WS_BTW = 8 * MiB;
constexpr size_t WS_WIN = 11 * MiB;
constexpr size_t WS_WS5 = 20 * MiB;
constexpr size_t WS_WLRU = 22 * MiB;
constexpr size_t WS_WO = 24 * MiB;
constexpr size_t WS_LP = 26 * MiB, WS_LH = 28 * MiB, WS_LHIN = 30 * MiB;
constexpr size_t WS_AG = 32 * MiB;
constexpr size_t WS_SLOC = 80 * MiB;
constexpr size_t WS_H = 112 * MiB;
constexpr size_t WS_XL = 176 * MiB;
constexpr size_t WS_GL = 240 * MiB;
constexpr size_t WS_GA = 304 * MiB, WS_GB = 336 * MiB;
constexpr size_t WS_GY = 368 * MiB;
constexpr size_t WS_D8 = 336 * MiB, WS_DSC = 368 * MiB;
constexpr size_t WS_WGU = 400 * MiB;
constexpr size_t WS_WD = 464 * MiB;
constexpr size_t WS_H2 = 32 * MiB;
constexpr size_t WS_ACT = 96 * MiB;
constexpr size_t WS_YS = 168 * MiB;
constexpr size_t WS_LTOK = 312 * MiB, WS_LW = 316 * MiB;
constexpr size_t WS_TOKE = 320 * MiB, WS_TOKR = WS_TOKE + 262144;
constexpr size_t WS_END = 496 * MiB;
static_assert(WS_YS + (size_t)MAXSLOT * 1024 * 2 <= WS_LTOK && WS_ACT + (size_t)MAXSLOT * 512 * 2 <= WS_YS && WS_TOKR + 262144 <= WS_WGU && WS_GY + (size_t)T * 512 * 2 <= WS_WGU && WS_WD + (size_t)32 * 1024 * 512 * 2 <= WS_END, "d_ws map");
constexpr int CW_BAR = 4096;
constexpr int CW_CNT = 16384;

constexpr int RING_BYTES = 131072;
constexpr int TOKL_OFF = RING_BYTES, SCLL_OFF = TOKL_OFF + MAXU * 256 * 4, MISC_OFF = SCLL_OFF + MAXU * 256 * 4;
constexpr int LDS_BYTES = MISC_OFF + 1024;

#define GAS __attribute__((address_space(1)))
#define LAS __attribute__((address_space(3)))
typedef unsigned short bf16;
typedef unsigned v4u __attribute__((ext_vector_type(4)));
typedef unsigned v2u __attribute__((ext_vector_type(2)));
typedef float f32x4 __attribute__((ext_vector_type(4)));
typedef short bf16x8 __attribute__((ext_vector_type(8)));
#define LDS_WAIT() asm volatile("s_waitcnt lgkmcnt(0)" ::: "memory")
#define VM_WAIT() asm volatile("s_waitcnt vmcnt(0)" ::: "memory")
__device__ __forceinline__ unsigned pk2(float lo, float hi) { unsigned r; asm volatile("v_cvt_pk_bf16_f32 %0, %1, %2" : "=v"(r) : "v"(lo), "v"(hi)); return r; }
__device__ __forceinline__ unsigned f2bf(float f) { return pk2(f, 0.f) & 0xffffu; }
__device__ __forceinline__ float bf2f(unsigned h) { return __builtin_bit_cast(float, h << 16); }
__device__ __forceinline__ float bflo(unsigned w) { return __builtin_bit_cast(float, w << 16); }
__device__ __forceinline__ float bfhi(unsigned w) { return __builtin_bit_cast(float, w & 0xffff0000u); }
__device__ __forceinline__ float fsigmoid(float x) { return __builtin_amdgcn_rcpf(1.0f + __builtin_amdgcn_exp2f(-1.44269504f * x)); }
__device__ __forceinline__ float gelu_t(float x) { const float u = x * (0.7978845608f + 0.0356774081f * x * x); return x * __builtin_amdgcn_rcpf(1.0f + __builtin_amdgcn_exp2f(-2.88539008f * u)); }
__device__ __forceinline__ float wave_sum(float v) {
#pragma unroll
    for (int o = 1; o < 64; o <<= 1) v += __shfl_xor(v, o);
    return v;
}

#define XB_TMO      128
#define XB_XCNT(j)  (256  + 64 * (j))
#define XB_XSUB(j)  (1280 + 64 * (j))
#define XB_XGEN(j)  (2304 + 64 * (j))
#define XB_TOP      3328
#define XB_TOPGEN   3392
#define XCD_BAR_WORDS 3456
#define XB_SPIN_CAP (1u << 18)
__device__ __forceinline__ unsigned xb_ld(unsigned* p)              { return __hip_atomic_load(p, __ATOMIC_RELAXED, __HIP_MEMORY_SCOPE_AGENT); }
__device__ __forceinline__ unsigned xb_add(unsigned* p, unsigned v) { return __hip_atomic_fetch_add(p, v, __ATOMIC_RELAXED, __HIP_MEMORY_SCOPE_AGENT); }
__device__ __forceinline__ unsigned xb_xcc_id() { return (unsigned)__builtin_amdgcn_s_getreg((3 << 11) | 20) & 0xFu; }
#define XB_SPIN(cond, bar) do { unsigned _sp = 0; while (cond) { __builtin_amdgcn_s_sleep(1); \
    if ((++_sp & 255u) == 0u) { if (xb_ld(&(bar)[XB_TMO])) break; if (_sp > XB_SPIN_CAP) { atomicAdd(&(bar)[XB_TMO], 1u); break; } } } } while (0)
struct XcdBarrier { unsigned* bar; unsigned x; volatile LAS unsigned* st; };
__device__ __forceinline__ XcdBarrier xcd_barrier_post(unsigned* bar, volatile LAS unsigned* st) {
    XcdBarrier b; b.bar = bar; b.x = xb_xcc_id(); b.st = st;
    if (threadIdx.x == 0) (void)xb_add(&bar[XB_XCNT(b.x)], 1u);
    return b;
}
__device__ __forceinline__ void xcd_barrier_complete(unsigned* bar, unsigned x, unsigned& nloc, unsigned& nx) {
    const unsigned G = gridDim.x * gridDim.y * gridDim.z;
    unsigned sum, cnt, mine, sp = 0u;
    for (;;) {
        sum = 0u; cnt = 0u; mine = 0u;
#pragma unroll
        for (unsigned j = 0; j < 16; ++j) { const unsigned c = xb_ld(&bar[XB_XCNT(j)]); sum += c; cnt += (c > 0u) ? 1u : 0u; mine = (j == x) ? c : mine; }
        if (sum == G) break;
        __builtin_amdgcn_s_sleep(1);
        if ((++sp & 255u) == 0u) { if (xb_ld(&bar[XB_TMO])) break; if (sp > XB_SPIN_CAP) { atomicAdd(&bar[XB_TMO], 1u); break; } }
    }
    nloc = mine > 0u ? mine : 1u; nx = cnt > 0u ? cnt : 1u;
}
__device__ __forceinline__ void xcd_barrier(const XcdBarrier& b) {
    asm volatile("s_waitcnt vmcnt(0)" ::: "memory");
    __syncthreads();
    if (threadIdx.x == 0) {
        unsigned* bar = b.bar;
        __builtin_amdgcn_s_waitcnt(0);
        unsigned nloc = b.st[0], nx = b.st[1];
        if (nloc == 0u) { xcd_barrier_complete(bar, b.x, nloc, nx); b.st[0] = nloc; b.st[1] = nx; }
        const unsigned old = xb_add(&bar[XB_XSUB(b.x)], 1u);
        const unsigned gen = old / nloc;
        if (old + 1u == (gen + 1u) * nloc) {
            __builtin_amdgcn_fence(__ATOMIC_RELEASE, "agent");
            asm volatile("s_waitcnt vmcnt(0)" ::: "memory");
            const unsigned og = xb_add(&bar[XB_TOP], 1u);
            const unsigned tg = og / nx;
            if (og + 1u == (tg + 1u) * nx) xb_add(&bar[XB_TOPGEN], 1u);
            else XB_SPIN(xb_ld(&bar[XB_TOPGEN]) == tg, bar);
            __builtin_amdgcn_fence(__ATOMIC_ACQUIRE, "agent");
            xb_add(&bar[XB_XGEN(b.x)], 1u);
            asm volatile("s_waitcnt vmcnt(0)" ::: "memory");
        } else {
            XB_SPIN(xb_ld(&bar[XB_XGEN(b.x)]) == gen, bar);
            __builtin_amdgcn_fence(__ATOMIC_ACQUIRE, "agent");
            asm volatile("s_waitcnt vmcnt(0)" ::: "memory");
        }
    }
    __syncthreads();
}

struct Frame {
    LAS unsigned char* lds;
    volatile LAS unsigned* MISC;
    unsigned* ctl;
    int tid, lane, wave, vcu, G;
    const float* const* in;
    unsigned char* ws; float* out;
};

using pg8::Unit;
struct DenseOrder {
    static constexpr bool GATHER = false, HETERO = false;
    const char* A0; const char* B0; int lda, ldb, nM, nN, nwg, G, c;
    __device__ __forceinline__ void init(const void* A, const void* B, int lda_, int ldb_, int M, int N, int G_, int c_) { A0 = (const char*)A; B0 = (const char*)B; lda = lda_; ldb = ldb_; nM = M / 256; nN = N / 256; nwg = nM * nN; G = G_; c = c_; }
    __device__ __forceinline__ bool next(int i, Unit& u) const {
        const long L = (long)i * G + c; if (L >= nwg) return false;
        int wgid = (int)L; { const int q = nwg / 8, r = nwg % 8, xcd = wgid % 8, off = wgid / 8; wgid = (xcd < r ? xcd * (q + 1) : r * (q + 1) + (xcd - r) * q) + off; }
        const int nig = 8 * nN, gid = wgid / nig, fm = gid * 8, gsz = (nM - fm) < 8 ? (nM - fm) : 8;
        u.pm = fm + ((wgid % nig) % gsz); u.pn = (wgid % nig) / gsz; u.aux = 0;
        u.A = A0 + (size_t)u.pm * 256 * lda * 2; u.B = B0 + (size_t)u.pn * 256 * ldb * 2; return true;
    }
    __device__ __forceinline__ void a_offsets(const Unit&, const int (&R)[2], const int (&C)[2], unsigned (&v)[4]) const {
#pragma unroll
        for (int i = 0; i < 2; ++i) { v[i] = (unsigned)(R[i] * lda + C[i]) * 2u; v[2 + i] = (unsigned)((128 + R[i]) * lda + C[i]) * 2u; }
    }
};
struct S5One {
    static constexpr bool GATHER = false, HETERO = false;
    const char* A0; const char* B0; size_t sA, sB; int lda, g, mt;
    __device__ __forceinline__ bool next(int i, Unit& u) const {
        if (i > 0) return false;
        u.pm = mt; u.pn = 0; u.aux = g; u.A = A0 + (size_t)g * sA + (size_t)mt * 256 * lda * 2; u.B = B0 + (size_t)g * sB; return true;
    }
    __device__ __forceinline__ void a_offsets(const Unit&, const int (&R)[2], const int (&C)[2], unsigned (&v)[4]) const {
#pragma unroll
        for (int i = 0; i < 2; ++i) { v[i] = (unsigned)(R[i] * lda + C[i]) * 2u; v[2 + i] = (unsigned)((128 + R[i]) * lda + C[i]) * 2u; }
    }
};
struct GyOrder {
    static constexpr bool GATHER = false, HETERO = false;
    DenseOrder d;
    __device__ __forceinline__ bool next(int i, Unit& u) const { if (!d.next(i, u)) return false; u.A = d.A0 + (size_t)u.pm * 256 * 32; return true; }
    __device__ __forceinline__ void a_offsets(const Unit&, const int (&R)[2], const int (&C)[2], unsigned (&v)[4]) const {
#pragma unroll
        for (int i = 0; i < 2; ++i) { const unsigned o = (unsigned)(C[i] >> 4) * (unsigned)(T * 32) + (unsigned)(C[i] & 15) * 2u; v[i] = (unsigned)R[i] * 32u + o; v[2 + i] = (unsigned)(128 + R[i]) * 32u + o; }
    }
};
struct YaYbOrder {
    static constexpr bool GATHER = false, HETERO = true;
    DenseOrder d;
    const char* GYb; const char* WS5b; const char* YLb; const char* WLb;
    __device__ __forceinline__ bool next(int i, Unit& u) const {
        const int j = i / 3, r = i - 3 * j; Unit t;
        if (!d.next(j, t)) return false;
        u.pm = t.pm; u.aux = 0;
        if (r < 2) { u.kind = 0; u.pn = 2 * t.pn + r; u.nt = S5W / 64; u.kA = (unsigned)(4 * T * 32); u.A = GYb + (size_t)t.pm * 256 * 32; u.B = WS5b + (size_t)u.pn * 256 * S5W * 2; }
        else { u.kind = 1; u.pn = t.pn; u.nt = D / 64; u.kA = 128u; u.A = YLb + (size_t)t.pm * 256 * D * 2; u.B = WLb + (size_t)t.pn * 256 * D * 2; }
        return true;
    }
    __device__ __forceinline__ void a_offsets(const Unit& u, const int (&R)[2], const int (&C)[2], unsigned (&v)[4]) const {
#pragma unroll
        for (int i = 0; i < 2; ++i) {
            const unsigned og = (unsigned)(C[i] >> 4) * (unsigned)(T * 32) + (unsigned)(C[i] & 15) * 2u;
            const unsigned g0 = (unsigned)R[i] * 32u + og, g1 = (unsigned)(128 + R[i]) * 32u + og;
            const unsigned d0 = (unsigned)(R[i] * D + C[i]) * 2u, d1 = (unsigned)((128 + R[i]) * D + C[i]) * 2u;
            v[i] = u.kind ? d0 : g0; v[2 + i] = u.kind ? d1 : g1; }
    }
    __device__ __forceinline__ void b_offsets(const Unit& u, const int (&Rb)[2], const int (&C)[2], unsigned (&v)[4]) const {
        const int ldb = u.kind ? D : S5W;
#pragma unroll
        for (int i = 0; i < 2; ++i) { v[i] = (unsigned)(Rb[i] * ldb + C[i]) * 2u; v[2 + i] = (unsigned)((128 + Rb[i]) * ldb + C[i]) * 2u; }
    }
};
template <bool GATH> struct MoeOrder {
    static constexpr bool GATHER = GATH, HETERO = false;
    const char* A0; const char* B0; size_t sBe; int lda, ldb, G, c; volatile LAS unsigned* MISC; const LAS int* tokL;
    __device__ __forceinline__ bool next(int i, Unit& u) const {
        if (i >= (int)MISC[152]) return false;
        const int e = (int)MISC[136 + i], mtg = (int)MISC[96 + e] + (int)MISC[144 + i], L = i * G + c;
        u.pm = mtg; u.pn = L & 3; u.aux = i;
        u.A = GATH ? A0 : A0 + (size_t)mtg * 256 * lda * 2; u.B = B0 + (size_t)e * sBe + (size_t)u.pn * 256 * ldb * 2; return true;
    }
    __device__ __forceinline__ void a_offsets(const Unit& u, const int (&R)[2], const int (&C)[2], unsigned (&v)[4]) const {
#pragma unroll
        for (int i = 0; i < 2; ++i) {
            if constexpr (GATH) { v[i] = (unsigned)tokL[u.aux * 256 + R[i]] * (unsigned)(lda * 2) + (unsigned)C[i] * 2u; v[2 + i] = (unsigned)tokL[u.aux * 256 + 128 + R[i]] * (unsigned)(lda * 2) + (unsigned)C[i] * 2u; }
            else { v[i] = (unsigned)(R[i] * lda + C[i]) * 2u; v[2 + i] = (unsigned)((128 + R[i]) * lda + C[i]) * 2u; } }
    }
};

using pg8::cvt_pk_bf16;
template <int ACT> __device__ __forceinline__ float actf(float x) { if (ACT == 1) return gelu_t(x); if (ACT == 2) return fsigmoid(x); return x; }
__device__ __forceinline__ v4u pack8(const f32x4 a, const f32x4 b) { v4u w; w.x = cvt_pk_bf16(a[0], a[1]); w.y = cvt_pk_bf16(a[2], a[3]); w.z = cvt_pk_bf16(b[0], b[1]); w.w = cvt_pk_bf16(b[2], b[3]); return w; }

__device__ __forceinline__ void unpack_u8x8(const v2u w, float (&f)[8]) {
    const float k = 1.0f / 255.0f;
    f[0] = (float)(w.x & 0xffu) * k; f[1] = (float)((w.x >> 8) & 0xffu) * k; f[2] = (float)((w.x >> 16) & 0xffu) * k; f[3] = (float)(w.x >> 24) * k;
    f[4] = (float)(w.y & 0xffu) * k; f[5] = (float)((w.y >> 8) & 0xffu) * k; f[6] = (float)((w.y >> 16) & 0xffu) * k; f[7] = (float)(w.y >> 24) * k;
}
struct EpiInProj {
    static constexpr bool PERM = true, ACC_INIT = false, B16 = false;
    bf16 *AG, *XL, *GL, *GA, *GB;
    template <int MODE  > __device__ __forceinline__ void tile(const f32x4 (&acc)[2][2][4][2], const Unit& u, bf16* base, int colbase, bool s5, int wr, int wc, int fr, int fq) const {
#pragma unroll
        for (int ai = 0; ai < 2; ++ai)
#pragma unroll
            for (int m = 0; m < 4; ++m) { const int r = u.pm * 256 + ai * 128 + wr * 64 + m * 16 + fr;
#pragma unroll
                for (int bj = 0; bj < 2; ++bj) { const int cl = colbase + bj * 128 + wc * 32 + 8 * fq;
                    f32x4 v0 = acc[ai][bj][m][0], v1 = acc[ai][bj][m][1];
                    if (MODE == 2) {
                        unsigned q[8];
#pragma unroll
                        for (int j = 0; j < 4; ++j) { q[j] = (unsigned)(fsigmoid(v0[j]) * 255.0f + 0.5f); q[4 + j] = (unsigned)(fsigmoid(v1[j]) * 255.0f + 0.5f); }
                        v2u w8; w8.x = q[0] | (q[1] << 8) | (q[2] << 16) | (q[3] << 24); w8.y = q[4] | (q[5] << 8) | (q[6] << 16) | (q[7] << 24);
                        __builtin_nontemporal_store(w8, (v2u*)((unsigned char*)base + (size_t)r * 1024 + cl));
                    } else {
                        if (MODE == 1) {
#pragma unroll
                            for (int j = 0; j < 4; ++j) { v0[j] = gelu_t(v0[j]); v1[j] = gelu_t(v1[j]); } }
                        const v4u w = pack8(v0, v1);
                        const int g = cl >> 4, cp = cl & 15, b = r >> 12, l = r & 4095, n = b * S5NCH + (l >> 4), s = l & 15;
                        const size_t off = s5 ? ((size_t)(g * S5N + n) * S5K + S5Q + s * 16 + cp) : ((size_t)r * 1024 + cl);
                        __builtin_nontemporal_store(w, (v4u*)(base + off)); } }
                asm volatile("" ::: "memory"); }
    }
    __device__ __forceinline__ void operator()(const f32x4 (&acc)[2][2][4][2], const Unit& u, int wr, int wc, int fr, int fq) const {
        const int pn = u.pn, reg = pn < 2 ? 0 : ((pn - 2) >> 2) + 1;
        const int colbase = reg == 0 ? pn * 256 : ((pn - 2) & 3) * 256;
        if (reg < 2) tile<0>(acc, u, reg == 0 ? AG : XL, colbase, reg == 0, wr, wc, fr, fq);
        else if (reg == 2) tile<1>(acc, u, GL, colbase, false, wr, wc, fr, fq);
        else tile<2>(acc, u, reg == 3 ? GA : GB, colbase, false, wr, wc, fr, fq);
    }
};
struct EpiS5State {
    static constexpr bool PERM = false, ACC_INIT = false, B16 = false;
    float* SLOC;
    __device__ __forceinline__ void operator()(const f32x4 (&acc)[2][2][4][2], const Unit& u, int wr, int wc, int fr, int fq) const {
#pragma unroll
        for (int ai = 0; ai < 2; ++ai)
#pragma unroll
            for (int m = 0; m < 4; ++m) { const int nr = u.pm * 256 + ai * 128 + wr * 64 + m * 16 + fr; float* rowp = SLOC + (size_t)(u.aux * S5N + nr) * S5Q + wc * 32 + 4 * fq;
#pragma unroll
                for (int n = 0; n < 2; ++n) *(f32x4*)(rowp + n * 16) = acc[ai][0][m][n]; }
    }
};
struct EpiS5Out {
    static constexpr bool PERM = true, ACC_INIT = false, B16 = false;
    bf16* GY;
    __device__ __forceinline__ void operator()(const f32x4 (&acc)[2][2][4][2], const Unit& u, int wr, int wc, int fr, int fq) const {
#pragma unroll
        for (int ai = 0; ai < 2; ++ai)
#pragma unroll
            for (int m = 0; m < 4; ++m) { const int nr = u.pm * 256 + ai * 128 + wr * 64 + m * 16 + fr, b = nr >> 8, j16 = nr & 255;
#pragma unroll
                for (int bj = 0; bj < 2; ++bj) { const int cc = bj * 128 + wc * 32 + 8 * fq, t = cc >> 4, c0 = cc & 15;
                    f32x4 v0 = acc[ai][bj][m][0], v1 = acc[ai][bj][m][1];
#pragma unroll
                    for (int j = 0; j < 4; ++j) { v0[j] = gelu_t(v0[j]); v1[j] = gelu_t(v1[j]); }
                    *(v4u*)(GY + ((size_t)u.aux * T + (size_t)(b * SEQ + j16 * 16 + t)) * 16 + c0) = pack8(v0, v1); }
                asm volatile("" ::: "memory"); }
    }
};
struct EpiYa {
    static constexpr bool PERM = true, ACC_INIT = false, B16 = false;
    const bf16* GA; bf16* YA;
    __device__ __forceinline__ void operator()(const f32x4 (&acc)[2][2][4][2], const Unit& u, int wr, int wc, int fr, int fq) const {
        const size_t off0 = (size_t)(u.pm * 256 + wr * 64 + fr) * 1024 + u.pn * 128 + wc * 32 + 8 * fq;
        v2u gav[2][4];
#pragma unroll
        for (int ai = 0; ai < 2; ++ai)
#pragma unroll
            for (int m = 0; m < 4; ++m) gav[ai][m] = __builtin_nontemporal_load((const v2u*)((const unsigned char*)GA + off0 + (size_t)(ai * 128 + m * 16) * 1024));
        asm volatile("" ::: "memory");
#pragma unroll
        for (int ai = 0; ai < 2; ++ai)
#pragma unroll
            for (int m = 0; m < 4; ++m) { float gaf[8]; unpack_u8x8(gav[ai][m], gaf);
                f32x4 o0, o1;
#pragma unroll
                for (int j = 0; j < 4; ++j) { o0[j] = gaf[j] * acc[ai][0][m][0][j] * fsigmoid(acc[ai][1][m][0][j]); o1[j] = gaf[4 + j] * acc[ai][0][m][1][j] * fsigmoid(acc[ai][1][m][1][j]); }
                *(v4u*)(YA + off0 + (size_t)(ai * 128 + m * 16) * 1024) = pack8(o0, o1); }
    }
};
struct EpiYb {
    static constexpr bool PERM = true, ACC_INIT = false, B16 = false;
    const bf16* YA; const bf16* GB; bf16* MIX;
    __device__ __forceinline__ void operator()(const f32x4 (&acc)[2][2][4][2], const Unit& u, int wr, int wc, int fr, int fq) const {
        const size_t off0 = (size_t)(u.pm * 256 + wr * 64 + fr) * 1024 + u.pn * 256 + wc * 32 + 8 * fq;
        v2u gb[2][4][2];
#pragma unroll
        for (int ai = 0; ai < 2; ++ai)
#pragma unroll
            for (int m = 0; m < 4; ++m)
#pragma unroll
                for (int bj = 0; bj < 2; ++bj) gb[ai][m][bj] = __builtin_nontemporal_load((const v2u*)((const unsigned char*)GB + off0 + (size_t)(ai * 128 + m * 16) * 1024 + bj * 128));
        v4u ya[2][2][2];
#define YB_LOAD(buf, grp) do { _Pragma("unroll") for (int mm = 0; mm < 2; ++mm) _Pragma("unroll") for (int bj = 0; bj < 2; ++bj) { \
            const size_t o = off0 + (size_t)(((grp) >> 1) * 128 + (2 * ((grp) & 1) + mm) * 16) * 1024 + bj * 128; ya[buf][mm][bj] = *(const v4u*)(YA + o); } } while (0)
        YB_LOAD(0, 0);
#pragma unroll
        for (int grp = 0; grp < 4; ++grp) { const int buf = grp & 1, ai = grp >> 1;
            if (grp < 3) YB_LOAD(buf ^ 1, grp + 1);
            asm volatile("" ::: "memory");
#pragma unroll
            for (int mm = 0; mm < 2; ++mm) { const int m = 2 * (grp & 1) + mm;
#pragma unroll
                for (int bj = 0; bj < 2; ++bj) { const v4u y = ya[buf][mm][bj];
                    const float yaf[8] = {bflo(y.x), bfhi(y.x), bflo(y.y), bfhi(y.y), bflo(y.z), bfhi(y.z), bflo(y.w), bfhi(y.w)};
                    float gbf[8]; unpack_u8x8(gb[ai][m][bj], gbf);
                    f32x4 o0, o1;
#pragma unroll
                    for (int j = 0; j < 4; ++j) { o0[j] = yaf[j] + gbf[j] * acc[ai][bj][m][0][j]; o1[j] = yaf[4 + j] + gbf[4 + j] * acc[ai][bj][m][1][j]; }
                    *(v4u*)(MIX + off0 + (size_t)(ai * 128 + m * 16) * 1024 + bj * 128) = pack8(o0, o1); } }
        }
#undef YB_LOAD
    }
};
struct EpiYaYb {
    static constexpr bool PERM = true, ACC_INIT = false, B16 = false;
    EpiYa a; EpiYb b;
    __device__ __forceinline__ void operator()(const f32x4 (&acc)[2][2][4][2], const Unit& u, int wr, int wc, int fr, int fq) const {
        if (__builtin_amdgcn_readfirstlane(u.kind) == 0) a(acc, u, wr, wc, fr, fq); else b(acc, u, wr, wc, fr, fq);
    }
};
struct EpiWo {
    static constexpr bool PERM = false, ACC_INIT = true, B16 = false;
    const float* X; float* O;
    __device__ __forceinline__ void init(f32x4 (&acc)[2][2][4][2], const Unit& u, int wr, int wc, int fr, int fq) const {
        const size_t off0 = (size_t)(u.pm * 256 + wr * 64 + fr) * 1024 + u.pn * 256 + wc * 32 + 4 * fq;
#pragma unroll
        for (int ai = 0; ai < 2; ++ai)
#pragma unroll
            for (int m = 0; m < 4; ++m)
#pragma unroll
                for (int bj = 0; bj < 2; ++bj)
#pragma unroll
                    for (int n = 0; n < 2; ++n) acc[ai][bj][m][n] = __builtin_nontemporal_load((const f32x4*)(X + off0 + (size_t)(ai * 128 + m * 16) * 1024 + bj * 128 + n * 16));
    }
    __device__ __forceinline__ void operator()(const f32x4 (&acc)[2][2][4][2], const Unit& u, int wr, int wc, int fr, int fq) const {
        const size_t off0 = (size_t)(u.pm * 256 + wr * 64 + fr) * 1024 + u.pn * 256 + wc * 32 + 4 * fq;
#pragma unroll
        for (int ai = 0; ai < 2; ++ai)
#pragma unroll
            for (int m = 0; m < 4; ++m)
#pragma unroll
                for (int bj = 0; bj < 2; ++bj)
#pragma unroll
                    for (int n = 0; n < 2; ++n) *(f32x4*)(O + off0 + (size_t)(ai * 128 + m * 16) * 1024 + bj * 128 + n * 16) = acc[ai][bj][m][n];
    }
};
struct EpiGU {
    static constexpr bool PERM = true, ACC_INIT = false, B16 = false;
    bf16* ACT; const LAS float* sclL;
    __device__ __forceinline__ void operator()(const f32x4 (&acc)[2][2][4][2], const Unit& u, int wr, int wc, int fr, int fq) const {
#pragma unroll
        for (int ai = 0; ai < 2; ++ai)
#pragma unroll
            for (int m = 0; m < 4; ++m) { const int rl = ai * 128 + wr * 64 + m * 16 + fr; const float sc = sclL[u.aux * 256 + rl];
                f32x4 o0, o1;
#pragma unroll
                for (int j = 0; j < 4; ++j) { const float g0 = acc[ai][0][m][0][j] * sc, g1 = acc[ai][0][m][1][j] * sc;
                    o0[j] = g0 * fsigmoid(g0) * (acc[ai][1][m][0][j] * sc); o1[j] = g1 * fsigmoid(g1) * (acc[ai][1][m][1][j] * sc); }
                *(v4u*)(ACT + (size_t)(u.pm * 256 + rl) * DEXP + u.pn * 128 + wc * 32 + 8 * fq) = pack8(o0, o1); }
    }
};
struct EpiDown {
    static constexpr bool PERM = true, ACC_INIT = false, B16 = false;
    bf16* YS; const LAS float* sclL;
    __device__ __forceinline__ void operator()(const f32x4 (&acc)[2][2][4][2], const Unit& u, int wr, int wc, int fr, int fq) const {
#pragma unroll
        for (int ai = 0; ai < 2; ++ai)
#pragma unroll
            for (int m = 0; m < 4; ++m) { const int rl = ai * 128 + wr * 64 + m * 16 + fr; const float sc = sclL[u.aux * 256 + rl];
#pragma unroll
                for (int bj = 0; bj < 2; ++bj)
                    *(v4u*)(YS + (size_t)(u.pm * 256 + rl) * 1024 + u.pn * 256 + bj * 128 + wc * 32 + 8 * fq) = pack8(acc[ai][bj][m][0] * sc, acc[ai][bj][m][1] * sc); }
    }
};

template <bool SCALED> struct EpiQ8 {
    static constexpr bool PERM = true, ACC_INIT = false, B16 = true;
    unsigned char* YS8; float* YSC; const LAS float* sclL;
    __device__ __forceinline__ void operator()(const f32x4 (&acc)[2][2][4][2], const Unit& u, int wr, int wc, int fr, int fq) const {
        float scs[2][4];
#pragma unroll
        for (int ai = 0; ai < 2; ++ai)
#pragma unroll
            for (int m = 0; m < 4; ++m) { const int rl = ai * 128 + wr * 64 + m * 16 + fr; const float sc = SCALED ? sclL[u.aux * 256 + rl] : 1.0f;
                float v[16]; float amax = 0.f;
#pragma unroll
                for (int bj = 0; bj < 2; ++bj)
#pragma unroll
                    for (int n = 0; n < 2; ++n)
#pragma unroll
                        for (int j = 0; j < 4; ++j) { const float x = acc[ai][bj][m][n][j] * sc; v[bj * 8 + n * 4 + j] = x; amax = fmaxf(amax, fabsf(x)); }
                amax = fmaxf(amax, __shfl_xor(amax, 16)); amax = fmaxf(amax, __shfl_xor(amax, 32));
                const float inv = amax > 0.f ? 127.0f / amax : 0.f;
                scs[ai][m] = amax * (1.0f / 127.0f);
                v4u w;
#pragma unroll
                for (int d = 0; d < 4; ++d) { const int q0 = (int)__builtin_rintf(v[4 * d] * inv), q1 = (int)__builtin_rintf(v[4 * d + 1] * inv), q2 = (int)__builtin_rintf(v[4 * d + 2] * inv), q3 = (int)__builtin_rintf(v[4 * d + 3] * inv);
                    w[d] = ((unsigned)q0 & 255u) | (((unsigned)q1 & 255u) << 8) | (((unsigned)q2 & 255u) << 16) | ((unsigned)q3 << 24); }
                *(v4u*)(YS8 + (size_t)(u.pm * 256 + rl) * 1024 + u.pn * 256 + wc * 64 + fq * 16) = w; }
#pragma unroll
        for (int ai = 0; ai < 2; ++ai) { const float sv = fq == 0 ? scs[ai][0] : fq == 1 ? scs[ai][1] : fq == 2 ? scs[ai][2] : scs[ai][3];
            YSC[(size_t)(u.pm * 256 + ai * 128 + wr * 64 + fq * 16 + fr) * 16 + wc * 4 + u.pn] = sv; }
    }
};

struct TItem { const float* W; int N; bf16* WT; int ldk, k0, n0, drow0; };
__device__ __forceinline__ void transpose_load(const TItem& it, f32x4 (&tv)[8], int lane) {
#pragma unroll
    for (int i = 0; i < 8; ++i) tv[i] = __builtin_nontemporal_load((const f32x4*)(it.W + (size_t)(it.k0 + 8 * i + (lane >> 3)) * it.N + it.n0 + 4 * (lane & 7)));
}
template <bool NT = false> __device__ __forceinline__ void transpose_store(const TItem& it, const f32x4 (&tv)[8], LAS float* scr, int lane) {
#pragma unroll
    for (int i = 0; i < 8; ++i) { LAS float* d = scr + (8 * i + (lane >> 3)) * 33 + 4 * (lane & 7); d[0] = tv[i].x; d[1] = tv[i].y; d[2] = tv[i].z; d[3] = tv[i].w; }
    LDS_WAIT(); asm volatile("" ::: "memory");
    const int c = lane & 7;
#pragma unroll
    for (int j = 0; j < 4; ++j) { const int n = (lane >> 3) + 8 * j; const LAS float* s = scr + (8 * c) * 33 + n;
        v4u o; o.x = pk2(s[0 * 33], s[1 * 33]); o.y = pk2(s[2 * 33], s[3 * 33]); o.z = pk2(s[4 * 33], s[5 * 33]); o.w = pk2(s[6 * 33], s[7 * 33]);
        if (NT) __builtin_nontemporal_store(o, (v4u*)(it.WT + (size_t)(it.drow0 + n) * it.ldk + it.k0 + 8 * c)); else *(v4u*)(it.WT + (size_t)(it.drow0 + n) * it.ldk + it.k0 + 8 * c) = o; }
    LDS_WAIT(); asm volatile("" ::: "memory");
}
__device__ __forceinline__ int ileave_row(int n, int half) { return 256 * (n >> 7) + 128 * half + (n & 127); }

template <int NR> __device__ __forceinline__ void rms_rows_to_bf16(const float* x0, const float* gain, bf16* o0, size_t rstride, int lane) {
    f32x4 v[NR][4];
#pragma unroll
    for (int r = 0; r < NR; ++r) { const f32x4* xr = (const f32x4*)(x0 + r * rstride) + lane;
#pragma unroll
        for (int j = 0; j < 4; ++j) v[r][j] = __builtin_nontemporal_load(xr + 64 * j); }
    asm volatile("" ::: "memory");
    const f32x4* gr = (const f32x4*)gain + lane;
    f32x4 g[4];
#pragma unroll
    for (int j = 0; j < 4; ++j) g[j] = gr[64 * j];
#pragma unroll
    for (int r = 0; r < NR; ++r) { float s = 0.f;
#pragma unroll
        for (int j = 0; j < 4; ++j) s += (v[r][j].x * v[r][j].x + v[r][j].y * v[r][j].y) + (v[r][j].z * v[r][j].z + v[r][j].w * v[r][j].w);
        const float rstd = 1.0f / sqrtf(wave_sum(s) * (1.f / D) + RMS_EPS);
        unsigned long long* o8 = (unsigned long long*)(o0 + r * rstride) + lane;
#pragma unroll
        for (int j = 0; j < 4; ++j) o8[64 * j] = (unsigned long long)pk2(v[r][j].x * rstd * g[j].x, v[r][j].y * rstd * g[j].y) | ((unsigned long long)pk2(v[r][j].z * rstd * g[j].z, v[r][j].w * rstd * g[j].w) << 32); }
}

__device__ __forceinline__ void s5_tables(const Frame& F, int g, const float* lam_re, const float* lam_im, const float* log_dt, const float* b_re, const float* b_im, const float* c_re, const float* c_im, const float* dsk) {
    LAS float* Cre = (LAS float*)F.lds;
    LAS float* Cim = Cre + 1024;
    LAS float* Bre = Cim + 1024;
    LAS float* Bim = Bre + 1024;
    LAS float* Pre = Bim + 1024;
    LAS float* Pim = Pre + 17 * 64;
    LAS float* Kt = Pim + 17 * 64;
    const int tid = F.tid;
    for (int i = tid; i < 1024; i += 512) { Cre[i] = c_re[g * 1024 + i]; Cim[i] = c_im[g * 1024 + i]; }
    if (tid < 64) {
        const int p = tid; const float lr = lam_re[g * 64 + p], li = lam_im[g * 64 + p], dt = expf(log_dt[g]);
        const float er = expf(lr * dt), lbr = er * cosf(li * dt), lbi = er * sinf(li * dt);
        const float den = lr * lr + li * li, nr = lbr - 1.0f, ni = lbi;
        const float cr = (nr * lr + ni * li) / den, ci = (ni * lr - nr * li) / den;
        { float pr = 1.f, pi = 0.f; for (int k = 0; k <= 16; ++k) { Pre[k * 64 + p] = pr; Pim[k * 64 + p] = pi; const float nr2 = pr * lbr - pi * lbi, ni2 = pr * lbi + pi * lbr; pr = nr2; pi = ni2; } }
        for (int c = 0; c < 16; ++c) { const float br = b_re[(g * 64 + p) * 16 + c], bi = b_im[(g * 64 + p) * 16 + c]; Bre[p * 16 + c] = cr * br - ci * bi; Bim[p * 16 + c] = cr * bi + ci * br; }
    }
    __syncthreads();
    {
        const int kc = tid & 255, k = kc >> 4, c = kc & 15, ph = tid >> 8; float a16[16];
#pragma unroll
        for (int i = 0; i < 16; ++i) a16[i] = 0.f;
        for (int p = 32 * ph; p < 32 * ph + 32; ++p) {
            const float cr_ = Cre[c * 64 + p], ci_ = Cim[c * 64 + p], pr_ = Pre[k * 64 + p], pi_ = Pim[k * 64 + p];
            const float xr = cr_ * pr_ - ci_ * pi_, xi = cr_ * pi_ + ci_ * pr_;
#pragma unroll
            for (int j = 0; j < 4; ++j) { const f32x4 br = *(const LAS f32x4*)(Bre + p * 16 + 4 * j), bi = *(const LAS f32x4*)(Bim + p * 16 + 4 * j);
#pragma unroll
                for (int i = 0; i < 4; ++i) a16[4 * j + i] += xr * br[i] - xi * bi[i]; }
        }
        LAS float* Kh = Kt + 4096;
        if (ph == 1) {
#pragma unroll
            for (int j = 0; j < 4; ++j) *(LAS f32x4*)(Kh + kc * 16 + 4 * j) = (f32x4){a16[4 * j], a16[4 * j + 1], a16[4 * j + 2], a16[4 * j + 3]}; }
        __syncthreads();
        if (ph == 0) {
#pragma unroll
            for (int j = 0; j < 4; ++j) { const f32x4 o = *(const LAS f32x4*)(Kh + kc * 16 + 4 * j); f32x4 r = (f32x4){a16[4 * j], a16[4 * j + 1], a16[4 * j + 2], a16[4 * j + 3]} + o;
                if (k == 0 && (c >> 2) == j) r[c & 3] += dsk[g * 16 + c];
                *(LAS f32x4*)(Kt + kc * 16 + 4 * j) = r; } }
    }
    __syncthreads();
    unsigned* btt = (unsigned*)(F.ws + WS_BTT) + (size_t)g * 256 * (S5K / 2);
    for (int e = tid; e < 256 * (S5K / 2); e += 512) {
        const int row = e / (S5K / 2), cpair = e % (S5K / 2), t = row >> 4, c = row & 15, col = 2 * cpair; float v0, v1;
        if (col < S5Q) { const int p = col >> 1; const float xr = Cre[c * 64 + p] * Pre[(t + 1) * 64 + p] - Cim[c * 64 + p] * Pim[(t + 1) * 64 + p], xi = Cre[c * 64 + p] * Pim[(t + 1) * 64 + p] + Cim[c * 64 + p] * Pre[(t + 1) * 64 + p];
            v0 = xr; v1 = -xi; }
        else { const int s = (col - S5Q) >> 4, cp = (col - S5Q) & 15;
            if (s <= t) { v0 = Kt[(t - s) * 256 + c * 16 + cp]; v1 = Kt[(t - s) * 256 + c * 16 + cp + 1]; } else { v0 = 0.f; v1 = 0.f; } }
        btt[e] = pk2(v0, v1);
    }
    unsigned* btw = (unsigned*)(F.ws + WS_BTW) + (size_t)g * 128 * 128;
    for (int e = tid; e < 128 * 128; e += 512) {
        const int q = e >> 7, cpair = e & 127, col = 2 * cpair, s = col >> 4, cp = col & 15, p = q >> 1, k = 15 - s;
        const float pr = Pre[k * 64 + p], pi = Pim[k * 64 + p];
        float v0, v1;
        if (q & 1) { v0 = pr * Bim[p * 16 + cp] + pi * Bre[p * 16 + cp]; v1 = pr * Bim[p * 16 + cp + 1] + pi * Bre[p * 16 + cp + 1]; }
        else { v0 = pr * Bre[p * 16 + cp] - pi * Bim[p * 16 + cp]; v1 = pr * Bre[p * 16 + cp + 1] - pi * Bim[p * 16 + cp + 1]; }
        btw[e] = pk2(v0, v1);
    }
    if (tid < 64) { float* l16 = (float*)(F.ws + SM_LAM16) + (g * 64 + tid) * 2; l16[0] = Pre[16 * 64 + tid]; l16[1] = Pim[16 * 64 + tid]; }
    __syncthreads();
}

struct In { const float* p[30]; };

__device__ __forceinline__ void p0_prologue(const Frame& F, const In& I) {
    for (int g = F.vcu; g < S5G; g += F.G) s5_tables(F, g, I.p[3], I.p[4], I.p[5], I.p[6], I.p[7], I.p[8], I.p[9], I.p[10]);
    const int gt = F.vcu * 512 + F.tid, NGT = F.G * 512;
    { float* lc = (float*)(F.ws + SM_LRUC); for (int i = gt; i < LRUW; i += NGT) { const float lam = I.p[18][i]; lc[i] = -8.0f * log1pf(expf(-lam)) * 1.44269504f; } }
    { bf16* wrt = (bf16*)(F.ws + SM_WRT);
        for (int i = gt; i < 2 * 65536; i += NGT) { const int which = i >> 16, r = i & 65535, h = r >> 12, j = (r >> 6) & 63, k = r & 63; const float* src = which ? I.p[16] : I.p[14]; wrt[i] = (bf16)f2bf(src[(h * 64 + k) * 64 + j]); } }
    { bf16* rhi = (bf16*)(F.ws + SM_RHI); bf16* rlo = (bf16*)(F.ws + SM_RLO);
        for (int i = gt; i < NROUT * 1024; i += NGT) { const int n = i >> 10, k = i & 1023; float w = 0.f; if (n < 4) w = I.p[22][k * 4 + n]; else if (n < 36) w = I.p[24][k * 32 + (n - 4)];
            const unsigned h = f2bf(w); rhi[i] = (bf16)h; rlo[i] = (bf16)f2bf(w - bf2f(h)); } }
    LAS float* scr = (LAS float*)(F.lds + F.wave * 16384);
    const int gw = F.vcu * NWAVES + F.wave, NGW = F.G * NWAVES;
    constexpr int I_IN = (D / 64) * (NIN / 32), I_S5 = (S5W / 64) * (2 * D / 32), I_LRU = (D / 64) * (D / 32), I_O = I_LRU;
    constexpr int NITEMS = I_IN + I_S5 + I_LRU + I_O;
    for (int it = gw; it < NITEMS; it += NGW) {
        int r = it; TItem ti;
        if (r < I_IN) { const int nb = NIN / 32, kb = r / nb, n0 = 32 * (r % nb); ti = TItem{I.p[2], NIN, (bf16*)(F.ws + WS_WIN), D, 64 * kb, n0, n0}; }
        else if ((r -= I_IN) < I_S5) { const int nb = 2 * D / 32, kb = r / nb, n0 = 32 * (r % nb); ti = TItem{I.p[11], 2 * D, (bf16*)(F.ws + WS_WS5), S5W, 64 * kb, n0, n0 < D ? ileave_row(n0, 0) : ileave_row(n0 - D, 1)}; }
        else if ((r -= I_S5) < I_LRU) { const int nb = D / 32, kb = r / nb, n0 = 32 * (r % nb); ti = TItem{I.p[19], D, (bf16*)(F.ws + WS_WLRU), D, 64 * kb, n0, n0}; }
        else { r -= I_LRU; const int nb = D / 32, kb = r / nb, n0 = 32 * (r % nb); ti = TItem{I.p[20], D, (bf16*)(F.ws + WS_WO), D, 64 * kb, n0, n0}; }
        f32x4 tv[8]; transpose_load(ti, tv, F.lane); asm volatile("" ::: "memory"); transpose_store(ti, tv, scr, F.lane);
    }
    { const int skip = F.G > 2 * S5G ? S5G : 0;
      if (F.vcu >= skip) { const int gw2 = (F.vcu - skip) * NWAVES + F.wave, NGW2 = (F.G - skip) * NWAVES;
        for (int m = gw2 * 4; m < T; m += NGW2 * 4) rms_rows_to_bf16<4>(I.p[0] + (size_t)m * D, I.p[1], (bf16*)(F.ws + WS_H) + (size_t)m * D, D, F.lane); } }
}
__device__ __forceinline__ TItem expert_item(const Frame& F, const In& I, int it) {
    const int e = it >> 9, half = (it >> 8) & 1, r = it & 255, nb = DEXP / 32, kb = r / nb, n0 = 32 * (r % nb);
    return TItem{(half ? I.p[27] : I.p[26]) + (size_t)e * D * DEXP, DEXP, (bf16*)(F.ws + WS_WGU) + (size_t)e * 1024 * 1024, D, 64 * kb, n0, ileave_row(n0, half)};
}
__device__ __forceinline__ TItem expert_item_d(const Frame& F, const In& I, int it) {
    const int e = it >> 8, r = it & 255, nb = D / 32, kb = r / nb, n0 = 32 * (r % nb);
    return TItem{I.p[28] + (size_t)e * DEXP * D, D, (bf16*)(F.ws + WS_WD) + (size_t)e * 1024 * DEXP, DEXP, 64 * kb, n0, n0};
}
__device__ __forceinline__ void expert_weight_copies(const Frame& F, const In& I) {
    LAS float* scr = (LAS float*)(F.lds + F.wave * 16384);
    const int gw = F.vcu * NWAVES + F.wave, NGW = F.G * NWAVES;
    constexpr int NIT = NEXP * 512;
    for (int it = 8 * NGW + gw; it < NIT; it += NGW) { const TItem t0 = expert_item(F, I, it); f32x4 v0[8]; transpose_load(t0, v0, F.lane); asm volatile("" ::: "memory"); transpose_store(t0, v0, scr, F.lane); }
}
__device__ __forceinline__ void expert_down_copies(const Frame& F, const In& I) {
    LAS float* scr = (LAS float*)(F.lds + F.wave * 16384);
    const int nunits = (int)F.MISC[128] * 4, rem = nunits % F.G, nbusy = rem;
    const int nfree = F.G - nbusy;
    if (F.vcu < nbusy) return;
    const int gw = (F.vcu - nbusy) * NWAVES + F.wave, NGW = nfree * NWAVES;
    constexpr int NIT = NEXP * 256;
    for (int it = gw; it < NIT; it += 2 * NGW) {
        const TItem t0 = expert_item_d(F, I, it); const bool has1 = it + NGW < NIT; const TItem t1 = expert_item_d(F, I, has1 ? it + NGW : it);
        f32x4 v0[8], v1[8]; transpose_load(t0, v0, F.lane); transpose_load(t1, v1, F.lane); asm volatile("" ::: "memory");
        transpose_store(t0, v0, scr, F.lane); if (has1) transpose_store(t1, v1, scr, F.lane);
    }
}

__device__ __forceinline__ void lru_seq(const Frame& F, const In& I) {
    LAS unsigned char* wl = F.lds + F.wave * 17920;
    LAS bf16* xcA = (LAS bf16*)wl;
    LAS float* pre = (LAS float*)(wl + 9216);
    typedef float f32x2 __attribute__((ext_vector_type(2)));
    LAS f32x2* sumT = (LAS f32x2*)(F.lds + 143360);
    const int lane = F.lane, jj = lane & 15, ks = lane >> 4, c32 = lane & 31, th = lane >> 5;
    const bf16* XL = (const bf16*)(F.ws + WS_XL); const bf16* GL = (const bf16*)(F.ws + WS_GL); bf16* YL = (bf16*)(F.ws + WS_H);
    const bf16* WRT = (const bf16*)(F.ws + SM_WRT);
    for (int un = F.vcu; un < BATCH * LRUH * 2; un += F.G) {
        const int b = un >> 5, hd = (un >> 1) & 15, half = un & 1;
        const int chin = hd * 64 + lane;
        const int chg = hd * 64 + 32 * half + c32;
        const float w0 = I.p[12][chin], w1 = I.p[12][1024 + chin], w2 = I.p[12][2048 + chin], w3 = I.p[12][3072 + chin], cb = I.p[13][chin];
        const float brs = I.p[15][chg] * -1.44269504f, bis = I.p[17][chg] * -1.44269504f, cch2 = ((const float*)(F.ws + SM_LRUC))[chg];
        float Rc = 0.f;
        for (int rd = 0; rd < 8; ++rd) {
            const int j = rd * 8 + F.wave;
            const size_t tok0 = (size_t)b * SEQ + (size_t)j * LRUCH;
            unsigned short xr[64], xh[3];
            { const bf16* xp = XL + tok0 * 1024 + chin;
              xh[0] = 0; xh[1] = 0; xh[2] = 0;
              if (j > 0) { xh[0] = xp[-3 * 1024]; xh[1] = xp[-2 * 1024]; xh[2] = xp[-1 * 1024]; }
#pragma unroll
              for (int t = 0; t < 64; ++t) xr[t] = xp[t * 1024]; }
            asm volatile("" ::: "memory");
            { typedef float f2v __attribute__((ext_vector_type(2)));
              float xm3 = bf2f(xh[0]), xm2 = bf2f(xh[1]), xm1 = bf2f(xh[2]);
              const f2v vw0 = {w0, w0}, vw1 = {w1, w1}, vw2 = {w2, w2}, vw3 = {w3, w3}, vcb = {cb, cb};
#pragma unroll
              for (int t = 0; t < 64; t += 2) { const float x0 = bf2f(xr[t]), x1 = bf2f(xr[t + 1]);
                  f2v xc = vcb + vw0 * (f2v){xm3, xm2}; xc = xc + vw1 * (f2v){xm2, xm1}; xc = xc + vw2 * (f2v){xm1, x0}; xc = xc + vw3 * (f2v){x0, x1};
                  const unsigned pk = pg8::cvt_pk_bf16(xc.x, xc.y);
                  xcA[t * 72 + lane] = (bf16)(pk & 0xffffu); xcA[(t + 1) * 72 + lane] = (bf16)(pk >> 16);
                  xm3 = xm1; xm2 = x0; xm1 = x1; } }
            LDS_WAIT();
            float hl[2][16], Pl[2][16], Prun[2], Hrun[2];
#pragma unroll
            for (int st = 0; st < 2; ++st) {
                bf16x8 Bw[4][2];
#pragma unroll
                for (int n = 0; n < 4; ++n)
#pragma unroll
                    for (int k = 0; k < 2; ++k) Bw[n][k] = *(const bf16x8*)(WRT + (size_t)(n >> 1) * 65536 + (size_t)(hd * 64 + 32 * half + 16 * (n & 1) + jj) * 64 + 32 * k + 8 * ks);
#pragma unroll
                for (int mh = 0; mh < 2; ++mh) { const int mt = 2 * st + mh;
                    bf16x8 a[2];
#pragma unroll
                    for (int k = 0; k < 2; ++k) a[k] = *(const LAS bf16x8*)(xcA + (16 * mt + jj) * 72 + 32 * k + 8 * ks);
#pragma unroll
                    for (int n = 0; n < 4; ++n) { f32x4 d = (f32x4){0.f, 0.f, 0.f, 0.f};
#pragma unroll
                        for (int k = 0; k < 2; ++k) d = __builtin_amdgcn_mfma_f32_16x16x32_bf16(a[k], Bw[n][k], d, 0, 0, 0);
#pragma unroll
                        for (int r = 0; r < 4; ++r) pre[(16 * mh + 4 * ks + r) * 68 + 16 * n + jj] = d[r]; } }
                LDS_WAIT();
                float h = 0.f, P = 1.f;
                typedef float f2v __attribute__((ext_vector_type(2)));
#pragma unroll
                for (int tl = 0; tl < 16; tl += 2) {
                    const int trow = 16 * th + tl;
                    const f2v pr = {pre[trow * 68 + c32], pre[(trow + 1) * 68 + c32]}, pi = {pre[trow * 68 + 32 + c32], pre[(trow + 1) * 68 + 32 + c32]};
                    const f2v zr = pr * (f2v){-1.44269504f, -1.44269504f} + (f2v){brs, brs}, zi = pi * (f2v){-1.44269504f, -1.44269504f} + (f2v){bis, bis};
                    const f2v er = {__builtin_amdgcn_exp2f(zr.x), __builtin_amdgcn_exp2f(zr.y)}, ei = {__builtin_amdgcn_exp2f(zi.x), __builtin_amdgcn_exp2f(zi.y)};
                    const f2v dr = er + (f2v){1.f, 1.f};
                    const f2v rg = {__builtin_amdgcn_rcpf(dr.x), __builtin_amdgcn_rcpf(dr.y)};
                    const f2v la2 = rg * (f2v){cch2, cch2};
                    const f2v a_ = {__builtin_amdgcn_exp2f(la2.x), __builtin_amdgcn_exp2f(la2.y)};
                    const f2v x2 = la2 * (f2v){1.38629436f, 1.38629436f};
                    f2v q = x2 * (f2v){0.0013888889f, 0.0013888889f} + (f2v){0.0083333333f, 0.0083333333f};
                    q = q * x2 + (f2v){0.041666667f, 0.041666667f}; q = q * x2 + (f2v){0.16666667f, 0.16666667f}; q = q * x2 + (f2v){0.5f, 0.5f}; q = q * x2 + (f2v){1.f, 1.f};
                    f2v om = -(q * x2);
                    const f2v alt = (f2v){1.f, 1.f} - a_ * a_;
                    om.x = x2.x > -0.3f ? om.x : alt.x; om.y = x2.y > -0.3f ? om.y : alt.y;
                    om.x = fmaxf(om.x, 1e-30f); om.y = fmaxf(om.y, 1e-30f);
                    const f2v dd = ei + (f2v){1.f, 1.f};
                    const f2v rq = om * dd * dd;
                    const f2v mi = om * (f2v){__builtin_amdgcn_rsqf(rq.x), __builtin_amdgcn_rsqf(rq.y)};
                    const f2v bx = mi * (f2v){bf2f(xcA[(32 * st + trow) * 72 + 32 * half + c32]), bf2f(xcA[(32 * st + trow + 1) * 72 + 32 * half + c32])};
                    h = a_.x * h + bx.x; P *= a_.x; hl[st][tl] = h; Pl[st][tl] = P;
                    h = a_.y * h + bx.y; P *= a_.y; hl[st][tl + 1] = h; Pl[st][tl + 1] = P;
                }
                Prun[st] = P; Hrun[st] = h;
                LDS_WAIT();
            }
            const float pP0 = __shfl_xor(Prun[0], 32), pH0 = __shfl_xor(Hrun[0], 32), pP1 = __shfl_xor(Prun[1], 32), pH1 = __shfl_xor(Hrun[1], 32);
            const float P0 = th ? pP0 : Prun[0], H0 = th ? pH0 : Hrun[0], P1 = th ? Prun[0] : pP0, H1 = th ? Hrun[0] : pH0;
            const float P2 = th ? pP1 : Prun[1], H2 = th ? pH1 : Hrun[1], P3 = th ? Prun[1] : pP1, H3 = th ? Hrun[1] : pH1;
            const float C1 = H0, Q1 = P0, C2 = P1 * C1 + H1, Q2 = P1 * Q1, C3 = P2 * C2 + H2, Q3 = P2 * Q2, Hc = P3 * C3 + H3, Pc = P3 * Q3;
            const float Cs0 = th ? C1 : 0.f, Qs0 = th ? Q1 : 1.f, Cs1 = th ? C3 : C2, Qs1 = th ? Q3 : Q2;
            const int cit = (rd * F.G + F.vcu) * NWAVES + F.wave; const bool cdo = cit < NEXP * 512;
            f32x4 ctv[8]; unsigned short ggr[2][16];
            if (cdo) { const TItem citem = expert_item(F, I, cit); transpose_load(citem, ctv, lane); }
#pragma unroll
            for (int st = 0; st < 2; ++st)
#pragma unroll
                for (int tl = 0; tl < 16; ++tl) ggr[st][tl] = GL[(tok0 + 32 * st + 16 * th + tl) * 1024 + chg];
            asm volatile("" ::: "memory");
            if (th == 0) sumT[((rd & 1) * 8 + F.wave) * 32 + c32] = (f32x2){Pc, Hc};
            LDS_WAIT();
            __syncthreads();
            float cin = Rc, mycin = 0.f;
#pragma unroll
            for (int w = 0; w < 8; ++w) { const f32x2 ph = sumT[((rd & 1) * 8 + w) * 32 + c32]; mycin = (w == F.wave) ? cin : mycin; cin = ph.x * cin + ph.y; }
            Rc = cin;
#pragma unroll
            for (int st = 0; st < 2; ++st) { const float hin = (st ? Cs1 : Cs0) + (st ? Qs1 : Qs0) * mycin;
#pragma unroll
                for (int tl = 0; tl < 16; ++tl) { const float hh = hl[st][tl] + Pl[st][tl] * hin;
                    YL[(tok0 + 32 * st + 16 * th + tl) * 1024 + chg] = (bf16)f2bf(hh * bf2f(ggr[st][tl])); } }
            if (cdo) { const TItem citem = expert_item(F, I, cit); transpose_store<true>(citem, ctv, pre, lane); }
        }
        __syncthreads();
    }
}

__device__ __forceinline__ void s5_chain(const Frame& F, int b, int g) {
    typedef float f32x2 __attribute__((ext_vector_type(2)));
    LAS f32x2* segE = (LAS f32x2*)(F.lds);
    const int lane = F.lane, w = F.wave;
    const float* SLOC = (const float*)(F.ws + WS_SLOC); unsigned* AGw = (unsigned*)(F.ws + WS_AG); const float* L16 = (const float*)(F.ws + SM_LAM16);
    const float lr = L16[(g * 64 + lane) * 2], li = L16[(g * 64 + lane) * 2 + 1];
    const float* sl = SLOC + ((size_t)(g * S5N + b * S5NCH + 32 * w)) * S5Q + 2 * lane;
    unsigned* ag = AGw + ((size_t)(g * S5N + b * S5NCH + 32 * w)) * (S5K / 2) + lane;
    float xr[32], xi[32];
#pragma unroll
    for (int u = 0; u < 32; ++u) { const float2 v = *(const float2*)(sl + (size_t)u * S5Q); xr[u] = v.x; xi[u] = v.y; }
    asm volatile("" ::: "memory");
    float sr = 0.f, si = 0.f;
#pragma unroll
    for (int u = 0; u < 32; ++u) { const float nr = lr * sr - li * si + xr[u], ni = lr * si + li * sr + xi[u]; xr[u] = sr; xi[u] = si; sr = nr; si = ni; }
    segE[w * 64 + lane] = (f32x2){sr, si};
    float qr = lr, qi = li;
#pragma unroll
    for (int k = 0; k < 5; ++k) { const float nr = qr * qr - qi * qi, ni = 2.f * qr * qi; qr = nr; qi = ni; }
    LDS_WAIT();
    __syncthreads();
    float cr = 0.f, ci = 0.f;
    for (int ww = 0; ww < w; ++ww) { const f32x2 e = segE[ww * 64 + lane]; const float nr = qr * cr - qi * ci + e.x, ni = qr * ci + qi * cr + e.y; cr = nr; ci = ni; }
#pragma unroll
    for (int u = 0; u < 32; ++u) { ag[(size_t)u * (S5K / 2)] = pk2(xr[u] + cr, xi[u] + ci); const float nr = lr * cr - li * ci, ni = lr * ci + li * cr; cr = nr; ci = ni; }
    __syncthreads();
}

__device__ __forceinline__ void p8_router(const Frame& F, const In& I) {
    const int lane = F.lane, tk = lane & 15, ks = lane >> 4;
    LAS float* lg = (LAS float*)(F.lds + F.wave * 4096);
    volatile LAS unsigned* cntL = F.MISC + 32; volatile LAS unsigned* baseL = F.MISC + 64;
    const float* X1 = I.p[0]; bf16* H2 = (bf16*)(F.ws + WS_H2); const float* gf = I.p[21];
    const unsigned char* D8 = (const unsigned char*)(F.ws + WS_D8); const float* DSC = (const float*)(F.ws + WS_DSC);
    const bf16* RHI = (const bf16*)(F.ws + SM_RHI); const bf16* RLO = (const bf16*)(F.ws + SM_RLO);
    float* RSTD = (float*)(F.ws + SM_RSTD); unsigned* gcnt = F.ctl + CW_CNT;
    int* LTOK = (int*)(F.ws + WS_LTOK); float* LW = (float*)(F.ws + WS_LW); int* TOKE = (int*)(F.ws + WS_TOKE); int* TOKR = (int*)(F.ws + WS_TOKR);
    for (int blk = F.vcu; blk < T / 128; blk += F.G) {
        if (F.tid < 32) cntL[F.tid] = 0u;
        __syncthreads();
        const int tok0 = blk * 128 + F.wave * 16;
        const float* xrow = X1 + (size_t)(tok0 + tk) * D + 8 * ks; bf16* hrow = H2 + (size_t)(tok0 + tk) * D + 8 * ks;
        f32x4 acc[3]; acc[0] = acc[1] = acc[2] = (f32x4){0.f, 0.f, 0.f, 0.f}; float ss = 0.f;
        const unsigned char* drow = D8 + (size_t)(tok0 + tk) * D + 8 * ks; const float* dsc = DSC + (size_t)(tok0 + tk) * 16;
        f32x4 xnx[4][2]; v2u dnx[4]; float snx[2];
#pragma unroll
        for (int q = 0; q < 4; ++q) { xnx[q][0] = __builtin_nontemporal_load((const f32x4*)(xrow + 32 * q)); xnx[q][1] = __builtin_nontemporal_load((const f32x4*)(xrow + 32 * q + 4)); dnx[q] = *(const v2u*)(drow + 32 * q); }
        snx[0] = dsc[0]; snx[1] = dsc[4];
        LAS bf16* slab = (LAS bf16*)(F.lds + 32768);
        v4u wst[3];
#define RT_SLAB_LOAD(g) do { _Pragma("unroll") for (int j = 0; j < 3; ++j) { const int c = F.tid + 512 * j, which = c / 768, r = (c % 768) >> 4, kq = c & 15; \
            wst[j] = *(const v4u*)((which ? RLO : RHI) + (size_t)r * D + 128 * (g) + 8 * kq); } } while (0)
#define RT_SLAB_STORE(buf) do { _Pragma("unroll") for (int j = 0; j < 3; ++j) { const int c = F.tid + 512 * j, which = c / 768, r = (c % 768) >> 4, kq = c & 15; \
            *(LAS v4u*)(slab + ((size_t)((buf) * 2 + which) * 48 + r) * 136 + 8 * kq) = wst[j]; } } while (0)
        RT_SLAB_LOAD(0); RT_SLAB_STORE(0);
        LDS_WAIT();
        __syncthreads();
        for (int kg = 0; kg < 8; ++kg) {
            f32x4 xa[4][2];
#pragma unroll
            for (int q = 0; q < 4; ++q) { const float sq = snx[q >> 1]; const v2u dq = dnx[q];
                xa[q][0] = xnx[q][0] + (f32x4){(float)((int)(dq.x << 24) >> 24), (float)((int)(dq.x << 16) >> 24), (float)((int)(dq.x << 8) >> 24), (float)((int)dq.x >> 24)} * sq;
                xa[q][1] = xnx[q][1] + (f32x4){(float)((int)(dq.y << 24) >> 24), (float)((int)(dq.y << 16) >> 24), (float)((int)(dq.y << 8) >> 24), (float)((int)dq.y >> 24)} * sq; }
            { const int kgn = kg < 7 ? kg + 1 : kg;
#pragma unroll
              for (int q = 0; q < 4; ++q) { xnx[q][0] = __builtin_nontemporal_load((const f32x4*)(xrow + 32 * (4 * kgn + q))); xnx[q][1] = __builtin_nontemporal_load((const f32x4*)(xrow + 32 * (4 * kgn + q) + 4)); dnx[q] = *(const v2u*)(drow + 32 * (4 * kgn + q)); }
              { const int G0 = 2 * kgn, G1 = 2 * kgn + 1; snx[0] = dsc[(G0 & 3) * 4 + (G0 >> 2)]; snx[1] = dsc[(G1 & 3) * 4 + (G1 >> 2)]; }
              RT_SLAB_LOAD(kgn); }
            f32x4 ga[4][2];
#pragma unroll
            for (int q = 0; q < 4; ++q) { const int kc = 4 * kg + q; ga[q][0] = *(const f32x4*)(gf + 32 * kc + 8 * ks); ga[q][1] = *(const f32x4*)(gf + 32 * kc + 8 * ks + 4); }
            asm volatile("" ::: "memory");
            const LAS bf16* sh = slab + (size_t)((kg & 1) * 2) * 48 * 136, * sl = sh + 48 * 136;
#pragma unroll
            for (int q = 0; q < 4; ++q) { const int kc = 4 * kg + q;
                const f32x4 a0 = xa[q][0], a1 = xa[q][1];
                ss += (a0.x * a0.x + a0.y * a0.y) + (a0.z * a0.z + a0.w * a0.w) + (a1.x * a1.x + a1.y * a1.y) + (a1.z * a1.z + a1.w * a1.w);
                const f32x4 v0 = a0 * ga[q][0], v1 = a1 * ga[q][1];
                v4u hi, lo;
                hi.x = pg8::cvt_pk_bf16(v0.x, v0.y); hi.y = pg8::cvt_pk_bf16(v0.z, v0.w); hi.z = pg8::cvt_pk_bf16(v1.x, v1.y); hi.w = pg8::cvt_pk_bf16(v1.z, v1.w);
                lo.x = pg8::cvt_pk_bf16(v0.x - bflo(hi.x), v0.y - bfhi(hi.x)); lo.y = pg8::cvt_pk_bf16(v0.z - bflo(hi.y), v0.w - bfhi(hi.y));
                lo.z = pg8::cvt_pk_bf16(v1.x - bflo(hi.z), v1.y - bfhi(hi.z)); lo.w = pg8::cvt_pk_bf16(v1.z - bflo(hi.w), v1.w - bfhi(hi.w));
                *(v4u*)(hrow + 32 * kc) = hi;
                const bf16x8 hf = __builtin_bit_cast(bf16x8, hi), lf = __builtin_bit_cast(bf16x8, lo);
#pragma unroll
                for (int n = 0; n < 3; ++n) {
                    const bf16x8 wh = *(const LAS bf16x8*)(sh + (16 * n + tk) * 136 + 32 * q + 8 * ks), wl = *(const LAS bf16x8*)(sl + (16 * n + tk) * 136 + 32 * q + 8 * ks);
                    acc[n] = __builtin_amdgcn_mfma_f32_16x16x32_bf16(wh, hf, acc[n], 0, 0, 0);
                    acc[n] = __builtin_amdgcn_mfma_f32_16x16x32_bf16(wh, lf, acc[n], 0, 0, 0);
                    acc[n] = __builtin_amdgcn_mfma_f32_16x16x32_bf16(wl, hf, acc[n], 0, 0, 0);
                } }
            if (kg < 7) RT_SLAB_STORE((kg + 1) & 1);
            LDS_WAIT();
            __syncthreads();
        }
#undef RT_SLAB_LOAD
#undef RT_SLAB_STORE
        ss += __shfl_xor(ss, 16); ss += __shfl_xor(ss, 32);
        const float rstd = 1.0f / sqrtf(ss * (1.f / D) + RMS_EPS);
        if (ks == 0) RSTD[tok0 + tk] = rstd;
#pragma unroll
        for (int n = 0; n < 3; ++n)
#pragma unroll
            for (int r = 0; r < 4; ++r) lg[tk * 49 + 16 * n + 4 * ks + r] = acc[n][r] * rstd;
        LDS_WAIT();
        int E1 = 0, E2 = 0; float w1 = 0.f, w2 = 0.f; unsigned r1 = 0, r2 = 0;
        if (lane < 16) {
            const LAS float* my = lg + lane * 49;
            float lgp[4];
#pragma unroll
            for (int i = 0; i < 4; ++i) lgp[i] = my[i] + I.p[23][i];
            int gi = 0; float mx = lgp[0];
#pragma unroll
            for (int i = 1; i < 4; ++i) if (lgp[i] > mx) { mx = lgp[i]; gi = i; }
            float den = 0.f;
#pragma unroll
            for (int i = 0; i < 4; ++i) den += expf(lgp[i] - mx);
            const float pg = 1.0f / den;
            float le[8];
#pragma unroll
            for (int i = 0; i < 8; ++i) le[i] = my[4 + gi * 8 + i] + I.p[25][gi * 8 + i];
            int i1 = 0; float m1 = le[0];
#pragma unroll
            for (int i = 1; i < 8; ++i) if (le[i] > m1) { m1 = le[i]; i1 = i; }
            int i2 = -1; float m2 = -3.0e38f;
#pragma unroll
            for (int i = 0; i < 8; ++i) if (i != i1 && le[i] > m2) { m2 = le[i]; i2 = i; }
            const float e2 = expf(m2 - m1);
            w1 = pg / (1.0f + e2); w2 = pg * e2 / (1.0f + e2);
            E1 = gi * 8 + i1; E2 = gi * 8 + i2;
            r1 = __hip_atomic_fetch_add((LAS unsigned*)(F.MISC + 32) + E1, 1u, __ATOMIC_RELAXED, __HIP_MEMORY_SCOPE_WORKGROUP);
            r2 = __hip_atomic_fetch_add((LAS unsigned*)(F.MISC + 32) + E2, 1u, __ATOMIC_RELAXED, __HIP_MEMORY_SCOPE_WORKGROUP);
        }
        LDS_WAIT();
        __syncthreads();
        if (F.tid < 32) { const unsigned c = cntL[F.tid]; baseL[F.tid] = c ? __hip_atomic_fetch_add(gcnt + F.tid, c, __ATOMIC_RELAXED, __HIP_MEMORY_SCOPE_AGENT) : 0u; }
        __syncthreads();
        if (lane < 16) {
            const int tok = tok0 + lane; const int k1 = (int)(baseL[E1] + r1), k2 = (int)(baseL[E2] + r2);
            LTOK[(size_t)E1 * T + k1] = tok; LW[(size_t)E1 * T + k1] = w1; LTOK[(size_t)E2 * T + k2] = tok; LW[(size_t)E2 * T + k2] = w2;
            TOKE[tok * 2] = E1; TOKE[tok * 2 + 1] = E2; TOKR[tok * 2] = k1; TOKR[tok * 2 + 1] = k2;
        }
        __syncthreads();
    }
}

__device__ __forceinline__ void moe_prefix(const Frame& F) {
    if (F.tid < 64) {
        const unsigned nt = F.tid < NEXP ? (F.ctl[CW_CNT + F.tid] + 255u) >> 8 : 0u; unsigned inc = nt;
#pragma unroll
        for (int o = 1; o < 32; o <<= 1) { const unsigned v = __shfl_up(inc, o); if (F.lane >= o) inc += v; }
        if (F.tid < NEXP) F.MISC[96 + F.tid] = inc - nt;
        if (F.tid == NEXP - 1) F.MISC[128] = inc;
    }
    LDS_WAIT();
    __syncthreads();
}
template <int MODE  >
__device__ __forceinline__ void moe_setup(const Frame& F) {
    moe_prefix(F);
    const int NT = (int)F.MISC[128];
    if (F.tid < MAXU) { const int L = F.tid * F.G + F.vcu; int e = -1, mt = 0;
        if (L < NT * 4) { const int mtg = L >> 2; e = 0; while (e < NEXP - 1 && (int)F.MISC[96 + e + 1] <= mtg) ++e; mt = mtg - (int)F.MISC[96 + e]; }
        F.MISC[136 + F.tid] = (unsigned)e; F.MISC[144 + F.tid] = (unsigned)mt; }
    __syncthreads();
    if (F.tid == 0) { int n = 0; while (n < MAXU && (int)F.MISC[136 + n] >= 0) ++n; F.MISC[152] = (unsigned)n; }
    __syncthreads();
    const int nU = (int)F.MISC[152];
    LAS int* tokL = (LAS int*)(F.lds + TOKL_OFF); LAS float* sclL = (LAS float*)(F.lds + SCLL_OFF);
    const int* LTOK = (const int*)(F.ws + WS_LTOK); const float* LW = (const float*)(F.ws + WS_LW); const float* RSTD = (const float*)(F.ws + SM_RSTD);
    for (int i = F.tid; i < nU * 256; i += 512) { const int ui = i >> 8, r = i & 255, e = (int)F.MISC[136 + ui], rank = (int)F.MISC[144 + ui] * 256 + r; const bool valid = rank < (int)F.ctl[CW_CNT + e];
        const int tok = valid ? LTOK[(size_t)e * T + rank] : 0; tokL[i] = tok; sclL[i] = valid ? (MODE == 0 ? RSTD[tok] : LW[(size_t)e * T + rank]) : 0.f; }
    LDS_WAIT(); VM_WAIT();
    __syncthreads();
}

__device__ __forceinline__ void p11_final(const Frame& F, const In& I, float* dst) {
    moe_prefix(F);
    const int gw = F.vcu * NWAVES + F.wave, NGW = F.G * NWAVES, lane = F.lane;
    const int* TOKE = (const int*)(F.ws + WS_TOKE); const int* TOKR = (const int*)(F.ws + WS_TOKR);
    const unsigned char* YS8 = (const unsigned char*)(F.ws + WS_YS); const float* YSC = (const float*)(F.ws + WS_YS + 80 * MiB);
    const unsigned char* D8 = (const unsigned char*)(F.ws + WS_D8); const float* DSC = (const float*)(F.ws + WS_DSC); const float* X = I.p[0];
    f32x4 gfin[4];
#pragma unroll
    for (int j = 0; j < 4; ++j) gfin[j] = ((const f32x4*)I.p[29])[lane + 64 * j];
    int ee[2][2], rr[2][2];
    { const int m0 = gw * 2 < T ? gw * 2 : 0;
#pragma unroll
      for (int q = 0; q < 2; ++q) { ee[q][0] = TOKE[2 * (m0 + q)]; ee[q][1] = TOKE[2 * (m0 + q) + 1]; rr[q][0] = TOKR[2 * (m0 + q)]; rr[q][1] = TOKR[2 * (m0 + q) + 1]; } }
    for (int m0 = gw * 2; m0 < T; m0 += NGW * 2) {
        f32x4 xv[2][4]; unsigned ya[2][4], yb[2][4], yd[2][4]; f32x4 sa[2], sb[2], sd[2];
#pragma unroll
        for (int q = 0; q < 2; ++q) { const size_t s0 = (size_t)F.MISC[96 + ee[q][0]] * 256 + rr[q][0], s1 = (size_t)F.MISC[96 + ee[q][1]] * 256 + rr[q][1];
            const f32x4* xr = (const f32x4*)(X + (size_t)(m0 + q) * D) + lane; const unsigned* y0 = (const unsigned*)(YS8 + s0 * 1024) + lane; const unsigned* y1 = (const unsigned*)(YS8 + s1 * 1024) + lane;
            const unsigned* d0 = (const unsigned*)(D8 + (size_t)(m0 + q) * 1024) + lane;
#pragma unroll
            for (int j = 0; j < 4; ++j) { xv[q][j] = __builtin_nontemporal_load(xr + 64 * j); ya[q][j] = y0[64 * j]; yb[q][j] = y1[64 * j]; yd[q][j] = d0[64 * j]; }
            sa[q] = *(const f32x4*)(YSC + s0 * 16 + 4 * (lane >> 4)); sb[q] = *(const f32x4*)(YSC + s1 * 16 + 4 * (lane >> 4)); sd[q] = *(const f32x4*)(DSC + (size_t)(m0 + q) * 16 + 4 * (lane >> 4)); }
        { const int mn = m0 + NGW * 2 < T ? m0 + NGW * 2 : m0;
#pragma unroll
          for (int q = 0; q < 2; ++q) { ee[q][0] = TOKE[2 * (mn + q)]; ee[q][1] = TOKE[2 * (mn + q) + 1]; rr[q][0] = TOKR[2 * (mn + q)]; rr[q][1] = TOKR[2 * (mn + q) + 1]; } }
        asm volatile("" ::: "memory");
#pragma unroll
        for (int q = 0; q < 2; ++q) { f32x4 v[4]; float s = 0.f;
#pragma unroll
            for (int j = 0; j < 4; ++j) { const f32x4 x = xv[q][j]; const unsigned a = ya[q][j], b = yb[q][j], c = yd[q][j]; const float ka = sa[q][j], kb = sb[q][j], kc = sd[q][j];
                v[j].x = (x.x + (float)((int)(c << 24) >> 24) * kc) + (float)((int)(a << 24) >> 24) * ka + (float)((int)(b << 24) >> 24) * kb;
                v[j].y = (x.y + (float)((int)(c << 16) >> 24) * kc) + (float)((int)(a << 16) >> 24) * ka + (float)((int)(b << 16) >> 24) * kb;
                v[j].z = (x.z + (float)((int)(c << 8) >> 24) * kc) + (float)((int)(a << 8) >> 24) * ka + (float)((int)(b << 8) >> 24) * kb;
                v[j].w = (x.w + (float)((int)c >> 24) * kc) + (float)((int)a >> 24) * ka + (float)((int)b >> 24) * kb;
                s += (v[j].x * v[j].x + v[j].y * v[j].y) + (v[j].z * v[j].z + v[j].w * v[j].w); }
            const float rstd = 1.0f / sqrtf(wave_sum(s) * (1.f / D) + RMS_EPS);
            f32x4* xw = (f32x4*)(dst + (size_t)(m0 + q) * D) + lane;
#pragma unroll
            for (int j = 0; j < 4; ++j) { const f32x4 g = gfin[j]; __builtin_nontemporal_store((f32x4){v[j].x * rstd * g.x, v[j].y * rstd * g.y, v[j].z * rstd * g.z, v[j].w * rstd * g.w}, xw + 64 * j); } }
    }
}

constexpr int N_PHASES = 12;
struct Args { In in; float* out; unsigned char* ws; float* fin_dst; int ph_lo, ph_hi, li, pad; };
__global__ void __launch_bounds__(NWAVES * 64, 2) mk_fwd(Args args) {
    extern __shared__ __attribute__((aligned(16))) unsigned char lds[];
    Frame F;
    F.lds = (LAS unsigned char*)lds;
    F.MISC = (volatile LAS unsigned*)(F.lds + MISC_OFF);
    F.tid = threadIdx.x; F.lane = F.tid & 63; F.wave = __builtin_amdgcn_readfirstlane(F.tid >> 6);
    F.G = gridDim.x; { const int bx = blockIdx.x; F.vcu = (F.G % 8 == 0) ? (bx % 8) * (F.G / 8) + bx / 8 : bx; }
    F.ws = args.ws; F.out = args.out; F.ctl = (unsigned*)(args.ws + WS_CTL); F.in = nullptr;
    const In& I = args.in;
    for (int u = F.tid; u < 256; u += NWAVES * 64) F.MISC[u] = 0u;
    __syncthreads();
    const int lo = args.ph_lo, hi = args.ph_hi;
    XcdBarrier bar; bar.bar = F.ctl + CW_BAR + args.li * XCD_BAR_WORDS; bar.x = 0; bar.st = nullptr;
    if (hi - lo > 1) bar = xcd_barrier_post(F.ctl + CW_BAR + args.li * XCD_BAR_WORDS, F.MISC + 8);
#ifndef PH_MASK
#define PH_MASK 0xFFF
#endif
#define IN(k) (((PH_MASK >> (k)) & 1) && lo <= (k) && (k) < hi)
#define SEAM(k) do { if (IN(k) && IN(NEXT_PH(k))) xcd_barrier(bar); } while (0)
#define NEXT_PH(k) ((k) == 2 ? 5 : (k) == 5 ? 7 : (k) + 1)
    const int cblk = (int)blockIdx.x;
    LAS unsigned char* ring = F.lds;

    if (IN(0)) { p0_prologue(F, I); SEAM(0); }

    if (IN(1)) {
        DenseOrder S; S.init(F.ws + WS_H, F.ws + WS_WIN, D, D, T, NIN, F.G, cblk);
        EpiInProj E{(bf16*)(F.ws + WS_AG), (bf16*)(F.ws + WS_XL), (bf16*)(F.ws + WS_GL), (bf16*)(F.ws + WS_GA), (bf16*)(F.ws + WS_GB)};
        pg8::gemm_phase<EpiInProj, DenseOrder, true>(ring, D, D, S, E);
        SEAM(1);
    }
    if (IN(2)) {
        if (cblk < 256) {
            const int L = cblk, wgid = (L % 8) * 32 + L / 8, g = wgid >> 3, mt = wgid & 7;
            { S5One S{(const char*)(F.ws + WS_AG) + S5Q * 2, (const char*)(F.ws + WS_BTW), (size_t)S5N * S5K * 2, (size_t)128 * 256 * 2, S5K, g, mt};
              EpiS5State E{(float*)(F.ws + WS_SLOC)};
              pg8::gemm_phase<EpiS5State, S5One, false>(ring, 256, 256, S, E); }
            if (F.wave == 0) { __builtin_amdgcn_fence(__ATOMIC_ACQUIRE, "agent"); VM_WAIT(); }
            __syncthreads();
            s5_chain(F, mt, g);
            VM_WAIT();
            __syncthreads();
            if (F.wave == 0) { __builtin_amdgcn_fence(__ATOMIC_ACQUIRE, "agent"); VM_WAIT(); }
            __syncthreads();
            { S5One S{(const char*)(F.ws + WS_AG), (const char*)(F.ws + WS_BTT), (size_t)S5N * S5K * 2, (size_t)256 * S5K * 2, S5K, g, mt};
              EpiS5Out E{(bf16*)(F.ws + WS_GY)};
              pg8::gemm_phase<EpiS5Out, S5One, false>(ring, S5K, S5K, S, E); }
            __syncthreads();
        }
        lru_seq(F, I);
        SEAM(2);
    }
    if (IN(5)) {
        YaYbOrder S; S.d.init(nullptr, nullptr, D, D, T, D, F.G, cblk);
        S.GYb = (const char*)(F.ws + WS_GY); S.WS5b = (const char*)(F.ws + WS_WS5); S.YLb = (const char*)(F.ws + WS_H); S.WLb = (const char*)(F.ws + WS_WLRU);
        EpiYaYb E{EpiYa{(const bf16*)(F.ws + WS_GA), (bf16*)(F.ws + WS_XL)}, EpiYb{(const bf16*)(F.ws + WS_XL), (const bf16*)(F.ws + WS_GB), (bf16*)(F.ws + WS_GL)}};
        pg8::gemm_phase<EpiYaYb, YaYbOrder, true>(ring, D, D, S, E);
        SEAM(5);
    }
    if (IN(7)) {
        DenseOrder S; S.init(F.ws + WS_GL, F.ws + WS_WO, D, D, T, D, F.G, cblk);
        EpiQ8<false> E{(unsigned char*)(F.ws + WS_D8), (float*)(F.ws + WS_DSC), nullptr};
        pg8::gemm_phase<EpiQ8<false>, DenseOrder, true>(ring, D, D, S, E);
        SEAM(7);
    }
    if (IN(8)) { p8_router(F, I); __syncthreads(); expert_weight_copies(F, I); SEAM(8); }
    if (IN(9)) {
        moe_setup<0>(F);
        MoeOrder<true> S{(const char*)(F.ws + WS_H2), (const char*)(F.ws + WS_WGU), (size_t)1024 * 1024 * 2, D, D, F.G, F.vcu, F.MISC, (const LAS int*)(F.lds + TOKL_OFF)};
        EpiGU E{(bf16*)(F.ws + WS_ACT), (const LAS float*)(F.lds + SCLL_OFF)};
        pg8::gemm_phase<EpiGU, MoeOrder<true>, true>(ring, D, D, S, E);
        __syncthreads();
        expert_down_copies(F, I);
        SEAM(9);
    }
    if (IN(10)) {
        moe_setup<1>(F);
        MoeOrder<false> S{(const char*)(F.ws + WS_ACT), (const char*)(F.ws + WS_WD), (size_t)1024 * DEXP * 2, DEXP, DEXP, F.G, F.vcu, F.MISC, (const LAS int*)(F.lds + TOKL_OFF)};
        EpiQ8<true> E{(unsigned char*)(F.ws + WS_YS), (float*)(F.ws + WS_YS + 80 * MiB), (const LAS float*)(F.lds + SCLL_OFF)};
        pg8::gemm_phase<EpiQ8<true>, MoeOrder<false>, true>(ring, DEXP, DEXP, S, E);
        SEAM(10);
    }
    if (IN(11)) { p11_final(F, I, args.fin_dst); }
#undef IN
#undef SEAM
}

extern "C" void kernel_launch(void* const* d_in, const int* in_sizes, int n_in, void* d_out, int out_size, void* d_ws, size_t ws_size, hipStream_t stream) {
    static int grid = 0;
    if (grid == 0) {
        if (n_in != 30 || in_sizes[0] != T * D || out_size != T * D || ws_size < WS_END) { fprintf(stderr, "kernel_launch: unexpected shapes / workspace (n_in %d, ws %zu)\n", n_in, ws_size); grid = -1; return; }
        int dev = 0, cus = 0, per_cu = 0;
        if (hipGetDevice(&dev) != hipSuccess || hipDeviceGetAttribute(&cus, hipDeviceAttributeMultiprocessorCount, dev) != hipSuccess) { grid = -1; return; }
        if (hipFuncSetAttribute((const void*)mk_fwd, hipFuncAttributeMaxDynamicSharedMemorySize, LDS_BYTES) != hipSuccess) { fprintf(stderr, "kernel_launch: hipFuncSetAttribute failed\n"); grid = -1; return; }
        if (hipOccupancyMaxActiveBlocksPerMultiprocessor(&per_cu, (const void*)mk_fwd, NWAVES * 64, LDS_BYTES) != hipSuccess || per_cu < 1) { fprintf(stderr, "kernel_launch: occupancy query says %d\n", per_cu); }
        (void)hipGetLastError();
        grid = cus;
    }
    if (grid < 0) return;
    if (hipMemsetAsync((char*)d_ws + WS_CTL, 0, CTL_ZERO_BYTES, stream) != hipSuccess) return;
    Args a{};
    for (int i = 0; i < 30; ++i) a.in.p[i] = (const float*)d_in[i];
    a.out = (float*)d_out; a.ws = (unsigned char*)d_ws; a.fin_dst = (float*)d_out;
#if defined(PROBE_LO)
    a.ph_lo = 0; a.ph_hi = PROBE_HI; a.li = 0;
#if PROBE_LO == 11
    a.fin_dst = (float*)((char*)d_ws + WS_H2);
#endif
    hipLaunchKernelGGL(mk_fwd, dim3(grid), dim3(NWAVES * 64), LDS_BYTES, stream, a);
#if PROBE_LO == 8
    hipMemsetAsync((char*)d_ws + WS_CTL + CW_CNT * 4, 0, 128, stream);
#endif
    a.fin_dst = (float*)d_out;
    a.ph_lo = PROBE_LO; a.ph_hi = N_PHASES; a.li = 1;
    hipLaunchKernelGGL(mk_fwd, dim3(grid), dim3(NWAVES * 64), LDS_BYTES, stream, a);
#elif MK_N_LAUNCHES == 1
    a.ph_lo = 0; a.ph_hi = N_PHASES;
    hipLaunchKernelGGL(mk_fwd, dim3(grid), dim3(NWAVES * 64), LDS_BYTES, stream, a);
#else
    for (int p = 0; p < N_PHASES; ++p) { a.ph_lo = p; a.ph_hi = p + 1; hipLaunchKernelGGL(mk_fwd, dim3(grid), dim3(NWAVES * 64), LDS_BYTES, stream, a); }
#endif
}
```

```cpp
#include <hip/hip_runtime.h>
#include <cstdio>
#include <cstdint>

#ifndef MK_N_LAUNCHES
#define MK_N_LAUNCHES 1
#endif

namespace pg8 {
#define PG8_LAS __attribute__((address_space(3)))
typedef unsigned short bf16_t;
typedef short bf16x8 __attribute__((ext_vector_type(8)));
typedef float f32x4 __attribute__((ext_vector_type(4)));
typedef unsigned u32x4 __attribute__((ext_vector_type(4)));
typedef int i32x4 __attribute__((ext_vector_type(4)));
template <class E, class = void> struct epi_i8 { static constexpr bool v = false; };
template <class E> struct epi_i8<E, decltype((void)E::I8)> { static constexpr bool v = E::I8; };
template <bool I8> struct acc_sel { typedef f32x4 t; };
template <> struct acc_sel<true> { typedef i32x4 t; };
constexpr int BM = 256, BK = 64, HALF = 128, HTB = HALF * BK * 2  , STAGE_BYTES = 8 * HTB, NXCD = 8, WGM = 8;

__host__ __device__ __forceinline__ int lds_byte(int r, int c) { const int st = (r >> 4) * 2 + (c >> 5), rr = r & 15, cc = c & 31, ob = rr * 64 + cc * 2; return st * 1024 + (ob ^ (((ob >> 9) & 1) << 5)); }
__host__ __device__ __forceinline__ void stage_rc(int b, int& R, int& C) { const int st = b / 1024, sb = b % 1024, swz = sb ^ (((sb >> 9) & 1) << 5); R = (st >> 1) * 16 + swz / 64; C = (st & 1) * 32 + (swz % 64) / 2; }
__host__ __device__ __forceinline__ int perm32(int rho) { const int n = rho >> 4, i = rho & 15; return 8 * (i >> 2) + 4 * n + (i & 3); }

struct Unit { const char* A; const char* B; int pm, pn, aux, nt, kind; unsigned kA; };

__device__ __forceinline__ unsigned cvt_pk_bf16(float lo, float hi) { unsigned r; asm volatile("v_cvt_pk_bf16_f32 %0, %1, %2" : "=v"(r) : "v"(lo), "v"(hi)); return r; }

template <class Epi, class Sched, bool ALIGN_EPI>
__device__ __forceinline__ void gemm_phase(PG8_LAS unsigned char* lds, const int ldb, const int K, const Sched& S, const Epi& E, const size_t kstepA = (size_t)(BK * 2)) {
    const int tid = threadIdx.x, wid = __builtin_amdgcn_readfirstlane(tid >> 6), lane = tid & 63, wr = wid >> 2, wc = wid & 3, fr = lane & 15, fq = lane >> 4;
    constexpr bool I8 = epi_i8<Epi>::v; typedef typename acc_sel<I8>::t acc_t;
    int nt = K / BK; asm volatile("" : "+s"(nt));
    int Rr[2], Cc[2], Rbb[2]; unsigned voffB[4], vAc[4], vAn[4];
#pragma unroll
    for (int i = 0; i < 2; ++i) { int R, C; stage_rc(tid * 16 + i * 8192, R, C); Rr[i] = R; Cc[i] = C; const int Rb = Epi::PERM ? ((R & ~31) + perm32(R & 31)) : R; Rbb[i] = Rb;
        int Rb0 = Rb, Rb1 = HALF + Rb;
        if constexpr (Epi::B16) {
            const int w_ = R >> 5, nn_ = (R >> 4) & 1, ii_ = R & 15; Rb0 = 64 * w_ + 16 * (ii_ >> 2) + 4 * nn_ + (ii_ & 3); Rb1 = Rb0 + 8; }
        voffB[i] = (unsigned)(Rb0 * ldb + C) * 2u; voffB[2 + i] = (unsigned)(Rb1 * ldb + C) * 2u; }
    const size_t kstep = (size_t)(BK * 2);
    const unsigned ldsw = (unsigned)wid * 1024u;
    const int aoff = lds_byte(wr * 64 + fr, fq * 8), boff = lds_byte(wc * 32 + fr, fq * 8);
#define PG8_SA(b, h) (((b) * 2 + (h)) * HTB)
#define PG8_SB(b, h) ((4 + (b) * 2 + (h)) * HTB)
#define PG8_STAGE(bufoff, gbase, voff, h) do { _Pragma("unroll") for (int _i = 0; _i < 2; ++_i) \
        __builtin_amdgcn_global_load_lds((const unsigned*)((const char*)(gbase) + (voff)[2 * (h) + _i]), (PG8_LAS unsigned*)(lds + (bufoff) + ldsw + _i * 8192), 16, 0, 0); } while (0)
#define PG8_LDA(dst, b, h) do { _Pragma("unroll") for (int m = 0; m < 4; ++m) _Pragma("unroll") for (int k = 0; k < 2; ++k) dst[m][k] = *(const PG8_LAS bf16x8*)(lds + PG8_SA(b, h) + aoff + m * 2048 + k * 1024); } while (0)
#define PG8_LDB(dst, b, h) do { _Pragma("unroll") for (int n = 0; n < 2; ++n) _Pragma("unroll") for (int k = 0; k < 2; ++k) dst[n][k] = *(const PG8_LAS bf16x8*)(lds + PG8_SB(b, h) + boff + n * 2048 + k * 1024); } while (0)
#define PG8_MMA(ai, bj, At, Bt) do { __builtin_amdgcn_s_setprio(1); _Pragma("unroll") for (int m = 0; m < 4; ++m) _Pragma("unroll") for (int n = 0; n < 2; ++n) _Pragma("unroll") for (int k = 0; k < 2; ++k) \
        { if constexpr (I8) acc[ai][bj][m][n] = __builtin_amdgcn_mfma_i32_16x16x64_i8(__builtin_bit_cast(i32x4, Bt[n][k]), __builtin_bit_cast(i32x4, At[m][k]), acc[ai][bj][m][n], 0, 0, 0); \
          else acc[ai][bj][m][n] = __builtin_amdgcn_mfma_f32_16x16x32_bf16(Bt[n][k], At[m][k], acc[ai][bj][m][n], 0, 0, 0); } __builtin_amdgcn_s_setprio(0); } while (0)
#define PG8_WAIT_V(n) asm volatile("s_waitcnt vmcnt(" #n ")" ::: "memory")
#define PG8_WAIT_L(n) asm volatile("s_waitcnt lgkmcnt(" #n ")" ::: "memory")
#define PG8_BAR __builtin_amdgcn_s_barrier()
#define PG8_SCHED __builtin_amdgcn_sched_barrier(0)
    Unit cur, nxt; int ui = 0;
    if (!S.next(0, cur)) return;
    S.a_offsets(cur, Rr, Cc, vAc);
    unsigned vBc[4], vBn[4];
    if constexpr (Sched::HETERO) { S.b_offsets(cur, Rbb, Cc, vBc); nt = __builtin_amdgcn_readfirstlane(cur.nt); }
    else {
#pragma unroll
        for (int q = 0; q < 4; ++q) vBc[q] = voffB[q]; }
    size_t kAc = Sched::HETERO ? (size_t)(unsigned)__builtin_amdgcn_readfirstlane((int)cur.kA) : kstepA;
    acc_t acc[2][2][4][2];
    if constexpr (Epi::ACC_INIT) E.init(acc, cur, wr, wc, fr, fq);
    else {
#pragma unroll
    for (int a = 0; a < 2; ++a)
#pragma unroll
        for (int b = 0; b < 2; ++b)
#pragma unroll
            for (int m = 0; m < 4; ++m)
#pragma unroll
                for (int n = 0; n < 2; ++n) acc[a][b][m][n] = acc_t{}; }
    bf16x8 At[4][2], B0[2][2], B1[2][2];
    const char* cA = cur.A; const char* cB = cur.B;
    if constexpr (Sched::GATHER) { PG8_WAIT_L(0); }
    PG8_STAGE(PG8_SB(0, 0), cB, vBc, 0); PG8_STAGE(PG8_SB(0, 1), cB, vBc, 1); PG8_STAGE(PG8_SA(0, 0), cA, vAc, 0); PG8_STAGE(PG8_SA(0, 1), cA, vAc, 1);
    if (wr == 1) PG8_BAR;
    PG8_WAIT_V(2); PG8_BAR;
    PG8_STAGE(PG8_SB(1, 0), cB + kstep, vBc, 0); PG8_STAGE(PG8_SA(1, 0), cA + kAc, vAc, 0); PG8_STAGE(PG8_SB(1, 1), cB + kstep, vBc, 1);
    PG8_WAIT_V(6); PG8_BAR;
    for (;;) {
        const bool has_next = S.next(ui + 1, nxt);
        const char* nA = has_next ? nxt.A : cA; const char* nB = has_next ? nxt.B : cB;
        size_t kAn = kAc;
        if constexpr (Sched::HETERO) { if (has_next) { S.b_offsets(nxt, Rbb, Cc, vBn); kAn = (size_t)(unsigned)__builtin_amdgcn_readfirstlane((int)nxt.kA); } else {
#pragma unroll
                for (int q = 0; q < 4; ++q) vBn[q] = vBc[q]; } }
        for (int t = 0; t < nt; t += 2) {
            const bool last = (t == nt - 2);
            const char* a1 = cA + (size_t)(t + 1) * kAc;
            const char* a2 = last ? nA : cA + (size_t)(t + 2) * kAc; const char* b2 = last ? nB : cB + (size_t)(t + 2) * kstep;
            const char* a3 = a2 + (last ? kAn : kAc); const char* b3 = b2 + kstep;
            unsigned vb2[4];
#pragma unroll
            for (int q = 0; q < 4; ++q) vb2[q] = (Sched::HETERO && last) ? vBn[q] : vBc[q];
            unsigned va2[4];
            if constexpr (Sched::GATHER || Sched::HETERO) {
                if (last) { if (has_next) { S.a_offsets(nxt, Rr, Cc, vAn); if constexpr (Sched::GATHER) { PG8_WAIT_L(0); } } else {
#pragma unroll
                        for (int q = 0; q < 4; ++q) vAn[q] = vAc[q]; } }
#pragma unroll
                for (int q = 0; q < 4; ++q) va2[q] = last ? vAn[q] : vAc[q];
            } else {
#pragma unroll
                for (int q = 0; q < 4; ++q) va2[q] = vAc[q];
            }
            PG8_LDB(B0, 0, 0); PG8_LDB(B1, 0, 1); PG8_SCHED; PG8_LDA(At, 0, 0); PG8_STAGE(PG8_SA(1, 1), a1, vAc, 1);
            PG8_WAIT_V(8); PG8_WAIT_L(0); PG8_BAR; PG8_MMA(0, 0, At, B0); PG8_MMA(0, 1, At, B1); PG8_BAR; PG8_SCHED;
            const bool fin = last && !has_next;
            PG8_LDA(At, 0, 1);
            if (!fin) { PG8_STAGE(PG8_SB(0, 0), b2, vb2, 0); PG8_STAGE(PG8_SB(0, 1), b2, vb2, 1); PG8_STAGE(PG8_SA(0, 0), a2, va2, 0); PG8_WAIT_V(8); } else { PG8_WAIT_V(0); }
            PG8_WAIT_L(0); PG8_BAR; PG8_MMA(1, 0, At, B0); PG8_MMA(1, 1, At, B1); PG8_BAR; PG8_SCHED;
            PG8_LDB(B0, 1, 0); PG8_LDB(B1, 1, 1); PG8_SCHED; PG8_LDA(At, 1, 0);
            if (!fin) { PG8_STAGE(PG8_SA(0, 1), a2, va2, 1); PG8_WAIT_V(8); } else { PG8_WAIT_V(0); }
            PG8_WAIT_L(0); PG8_BAR; PG8_MMA(0, 0, At, B0); PG8_MMA(0, 1, At, B1); PG8_BAR; PG8_SCHED;
            PG8_LDA(At, 1, 1);
            if (!fin) { PG8_STAGE(PG8_SB(1, 0), b3, vb2, 0); PG8_STAGE(PG8_SB(1, 1), b3, vb2, 1); PG8_STAGE(PG8_SA(1, 0), a3, va2, 0); PG8_WAIT_V(8); } else { PG8_WAIT_V(0); }
            PG8_WAIT_L(0); PG8_BAR; PG8_MMA(1, 0, At, B0); PG8_MMA(1, 1, At, B1); PG8_BAR; PG8_SCHED;
        }
        if constexpr (ALIGN_EPI) { if (wr == 0) PG8_BAR; }
        E(acc, cur, wr, wc, fr, fq);
        if (!has_next) break;
        if constexpr (Epi::ACC_INIT) E.init(acc, nxt, wr, wc, fr, fq);
        else {
#pragma unroll
        for (int a = 0; a < 2; ++a)
#pragma unroll
            for (int b = 0; b < 2; ++b)
#pragma unroll
                for (int m = 0; m < 4; ++m)
#pragma unroll
                    for (int n = 0; n < 2; ++n) acc[a][b][m][n] = acc_t{}; }
        cur = nxt; cA = nA; cB = nB; ++ui;
        if constexpr (Sched::GATHER || Sched::HETERO) {
#pragma unroll
            for (int q = 0; q < 4; ++q) vAc[q] = vAn[q]; }
        if constexpr (Sched::HETERO) {
#pragma unroll
            for (int q = 0; q < 4; ++q) vBc[q] = vBn[q];
            kAc = kAn; nt = __builtin_amdgcn_readfirstlane(cur.nt); }
        if constexpr (ALIGN_EPI) { if (wr == 1) PG8_BAR; }
    }
    PG8_WAIT_V(0);
    if constexpr (!ALIGN_EPI) { if (wr == 0) PG8_BAR; }
    PG8_BAR;
#undef PG8_SA
#undef PG8_SB
#undef PG8_STAGE
#undef PG8_LDA
#undef PG8_LDB
#undef PG8_MMA
#undef PG8_WAIT_V
#undef PG8_WAIT_L
#undef PG8_BAR
#undef PG8_SCHED
}
}

constexpr int NWAVES = 8;
constexpr int BATCH = 8, SEQ = 4096, D = 1024, T = BATCH * SEQ;
constexpr int S5W = 512, S5G = 32, S5C = 16, S5P = 64, S5Q = 128;
constexpr int S5LC = 16, S5NCH = SEQ / S5LC, S5N = BATCH * S5NCH;
constexpr int S5K = S5Q + S5LC * S5C;
constexpr int LRUW = 1024, LRUH = 16, LRUHD = 64, LRUCH = 64, LRUNCH = SEQ / LRUCH;
constexpr int NIN = S5W + 2 * LRUW + 2 * D;
constexpr int NEXP = 32, EPG = 8, NGRP = 4, DEXP = 512, NROUT = 48;
constexpr int MAXSLOT = 73728;
constexpr int MAXU = 8;
constexpr float RMS_EPS = 1e-6f;

constexpr size_t MiB = 1u << 20;
constexpr size_t WS_CTL = 0, CTL_ZERO_BYTES = 128 * 1024;
constexpr size_t WS_SMALL = 1 * MiB;
constexpr size_t SM_LAM16 = WS_SMALL + 0;
constexpr size_t SM_LRUC = WS_SMALL + 16384;
constexpr size_t SM_WRT = WS_SMALL + 32768;
constexpr size_t SM_RHI = WS_SMALL + 327680;
constexpr size_t SM_RLO = SM_RHI + 98304;
constexpr size_t SM_RSTD = WS_SMALL + 524288;
constexpr size_t SM_HSC = WS_SMALL + 720896;
constexpr size_t SM_WSC = WS_SMALL + 851968;
constexpr size_t WS_BTT = 2 * MiB;
constexpr size_t WS_BTW = 8 * MiB;
constexpr size_t WS_WIN = 11 * MiB;
constexpr size_t WS_WS5 = 20 * MiB;
constexpr size_t WS_WLRU = 22 * MiB;
constexpr size_t WS_WO = 24 * MiB;
constexpr size_t WS_LP = 26 * MiB, WS_LH = 28 * MiB, WS_LHIN = 30 * MiB;
constexpr size_t WS_AG = 32 * MiB;
constexpr size_t WS_SLOC = 80 * MiB;
constexpr size_t WS_H = 112 * MiB;
constexpr size_t WS_XL = 176 * MiB;
constexpr size_t WS_GL = 240 * MiB;
constexpr size_t WS_GA = 304 * MiB, WS_GB = 336 * MiB;
constexpr size_t WS_GY = 368 * MiB;
constexpr size_t WS_D8 = 336 * MiB, WS_DSC = 368 * MiB;
constexpr size_t WS_WGU = 400 * MiB;
constexpr size_t WS_WD = 464 * MiB;
constexpr size_t WS_H2 = 32 * MiB;
constexpr size_t WS_ACT = 96 * MiB;
constexpr size_t WS_YS = 168 * MiB;
constexpr size_t WS_LTOK = 312 * MiB, WS_LW = 316 * MiB;
constexpr size_t WS_TOKE = 320 * MiB, WS_TOKR = WS_TOKE + 262144;
constexpr size_t WS_END = 496 * MiB;
static_assert(WS_YS + (size_t)MAXSLOT * 1024 * 2 <= WS_LTOK && WS_ACT + (size_t)MAXSLOT * 512 * 2 <= WS_YS && WS_TOKR + 262144 <= WS_WGU && WS_GY + (size_t)T * 512 * 2 <= WS_WGU && WS_WD + (size_t)32 * 1024 * 512 * 2 <= WS_END, "d_ws map");
constexpr int CW_BAR = 4096;
constexpr int CW_CNT = 16384;

constexpr int RING_BYTES = 131072;
constexpr int TOKL_OFF = RING_BYTES, SCLL_OFF = TOKL_OFF + MAXU * 256 * 4, MISC_OFF = SCLL_OFF + MAXU * 256 * 4;
constexpr int LDS_BYTES = MISC_OFF + 1024;

#define GAS __attribute__((address_space(1)))
#define LAS __attribute__((address_space(3)))
typedef unsigned short bf16;
typedef unsigned v4u __attribute__((ext_vector_type(4)));
typedef unsigned v2u __attribute__((ext_vector_type(2)));
typedef float f32x4 __attribute__((ext_vector_type(4)));
typedef int i32x4 __attribute__((ext_vector_type(4)));
typedef short bf16x8 __attribute__((ext_vector_type(8)));
#define LDS_WAIT() asm volatile("s_waitcnt lgkmcnt(0)" ::: "memory")
#define VM_WAIT() asm volatile("s_waitcnt vmcnt(0)" ::: "memory")
__device__ __forceinline__ unsigned pk2(float lo, float hi) { unsigned r; asm volatile("v_cvt_pk_bf16_f32 %0, %1, %2" : "=v"(r) : "v"(lo), "v"(hi)); return r; }
__device__ __forceinline__ unsigned f2bf(float f) { return pk2(f, 0.f) & 0xffffu; }
__device__ __forceinline__ float bf2f(unsigned h) { return __builtin_bit_cast(float, h << 16); }
__device__ __forceinline__ float bflo(unsigned w) { return __builtin_bit_cast(float, w << 16); }
__device__ __forceinline__ float bfhi(unsigned w) { return __builtin_bit_cast(float, w & 0xffff0000u); }
__device__ __forceinline__ float fsigmoid(float x) { return __builtin_amdgcn_rcpf(1.0f + __builtin_amdgcn_exp2f(-1.44269504f * x)); }
__device__ __forceinline__ float gelu_t(float x) { const float u = x * (0.7978845608f + 0.0356774081f * x * x); return x * __builtin_amdgcn_rcpf(1.0f + __builtin_amdgcn_exp2f(-2.88539008f * u)); }
__device__ __forceinline__ float wave_sum(float v) {
#pragma unroll
    for (int o = 1; o < 64; o <<= 1) v += __shfl_xor(v, o);
    return v;
}

#define XB_TMO      128
#define XB_XCNT(j)  (256  + 64 * (j))
#define XB_XSUB(j)  (1280 + 64 * (j))
#define XB_XGEN(j)  (2304 + 64 * (j))
#define XB_TOP      3328
#define XB_TOPGEN   3392
#define XCD_BAR_WORDS 3456
#define XB_SPIN_CAP (1u << 18)
__device__ __forceinline__ unsigned xb_ld(unsigned* p)              { return __hip_atomic_load(p, __ATOMIC_RELAXED, __HIP_MEMORY_SCOPE_AGENT); }
__device__ __forceinline__ unsigned xb_add(unsigned* p, unsigned v) { return __hip_atomic_fetch_add(p, v, __ATOMIC_RELAXED, __HIP_MEMORY_SCOPE_AGENT); }
__device__ __forceinline__ unsigned xb_xcc_id() { return (unsigned)__builtin_amdgcn_s_getreg((3 << 11) | 20) & 0xFu; }
#define XB_SPIN(cond, bar) do { unsigned _sp = 0; while (cond) { __builtin_amdgcn_s_sleep(1); \
    if ((++_sp & 255u) == 0u) { if (xb_ld(&(bar)[XB_TMO])) break; if (_sp > XB_SPIN_CAP) { atomicAdd(&(bar)[XB_TMO], 1u); break; } } } } while (0)
struct XcdBarrier { unsigned* bar; unsigned x; volatile LAS unsigned* st; };
__device__ __forceinline__ XcdBarrier xcd_barrier_post(unsigned* bar, volatile LAS unsigned* st) {
    XcdBarrier b; b.bar = bar; b.x = xb_xcc_id(); b.st = st;
    if (threadIdx.x == 0) (void)xb_add(&bar[XB_XCNT(b.x)], 1u);
    return b;
}
__device__ __forceinline__ void xcd_barrier_complete(unsigned* bar, unsigned x, unsigned& nloc, unsigned& nx) {
    const unsigned G = gridDim.x * gridDim.y * gridDim.z;
    unsigned sum, cnt, mine, sp = 0u;
    for (;;) {
        sum = 0u; cnt = 0u; mine = 0u;
#pragma unroll
        for (unsigned j = 0; j < 16; ++j) { const unsigned c = xb_ld(&bar[XB_XCNT(j)]); sum += c; cnt += (c > 0u) ? 1u : 0u; mine = (j == x) ? c : mine; }
        if (sum == G) break;
        __builtin_amdgcn_s_sleep(1);
        if ((++sp & 255u) == 0u) { if (xb_ld(&bar[XB_TMO])) break; if (sp > XB_SPIN_CAP) { atomicAdd(&bar[XB_TMO], 1u); break; } }
    }
    nloc = mine > 0u ? mine : 1u; nx = cnt > 0u ? cnt : 1u;
}
__device__ __forceinline__ void xcd_barrier(const XcdBarrier& b) {
    asm volatile("s_waitcnt vmcnt(0)" ::: "memory");
    __syncthreads();
    if (threadIdx.x == 0) {
        unsigned* bar = b.bar;
        __builtin_amdgcn_s_waitcnt(0);
        unsigned nloc = b.st[0], nx = b.st[1];
        if (nloc == 0u) { xcd_barrier_complete(bar, b.x, nloc, nx); b.st[0] = nloc; b.st[1] = nx; }
        const unsigned old = xb_add(&bar[XB_XSUB(b.x)], 1u);
        const unsigned gen = old / nloc;
        if (old + 1u == (gen + 1u) * nloc) {
            __builtin_amdgcn_fence(__ATOMIC_RELEASE, "agent");
            asm volatile("s_waitcnt vmcnt(0)" ::: "memory");
            const unsigned og = xb_add(&bar[XB_TOP], 1u);
            const unsigned tg = og / nx;
            if (og + 1u == (tg + 1u) * nx) xb_add(&bar[XB_TOPGEN], 1u);
            else XB_SPIN(xb_ld(&bar[XB_TOPGEN]) == tg, bar);
            __builtin_amdgcn_fence(__ATOMIC_ACQUIRE, "agent");
            xb_add(&bar[XB_XGEN(b.x)], 1u);
            asm volatile("s_waitcnt vmcnt(0)" ::: "memory");
        } else {
            XB_SPIN(xb_ld(&bar[XB_XGEN(b.x)]) == gen, bar);
            __builtin_amdgcn_fence(__ATOMIC_ACQUIRE, "agent");
            asm volatile("s_waitcnt vmcnt(0)" ::: "memory");
        }
    }
    __syncthreads();
}

struct Frame {
    LAS unsigned char* lds;
    volatile LAS unsigned* MISC;
    unsigned* ctl;
    int tid, lane, wave, vcu, G;
    const float* const* in;
    unsigned char* ws; float* out;
};

using pg8::Unit;
struct DenseOrder {
    static constexpr bool GATHER = false, HETERO = false;
    const char* A0; const char* B0; int lda, ldb, nM, nN, nwg, G, c;
    __device__ __forceinline__ void init(const void* A, const void* B, int lda_, int ldb_, int M, int N, int G_, int c_) { A0 = (const char*)A; B0 = (const char*)B; lda = lda_; ldb = ldb_; nM = M / 256; nN = N / 256; nwg = nM * nN; G = G_; c = c_; }
    __device__ __forceinline__ bool next(int i, Unit& u) const {
        const long L = (long)i * G + c; if (L >= nwg) return false;
        int wgid = (int)L; { const int q = nwg / 8, r = nwg % 8, xcd = wgid % 8, off = wgid / 8; wgid = (xcd < r ? xcd * (q + 1) : r * (q + 1) + (xcd - r) * q) + off; }
        const int nig = 8 * nN, gid = wgid / nig, fm = gid * 8, gsz = (nM - fm) < 8 ? (nM - fm) : 8;
        u.pm = fm + ((wgid % nig) % gsz); u.pn = (wgid % nig) / gsz; u.aux = i & 1;
        u.A = A0 + (size_t)u.pm * 256 * lda * 2; u.B = B0 + (size_t)u.pn * 256 * ldb * 2; return true;
    }
    __device__ __forceinline__ void a_offsets(const Unit&, const int (&R)[2], const int (&C)[2], unsigned (&v)[4]) const {
#pragma unroll
        for (int i = 0; i < 2; ++i) { v[i] = (unsigned)(R[i] * lda + C[i]) * 2u; v[2 + i] = (unsigned)((128 + R[i]) * lda + C[i]) * 2u; }
    }
};
struct S5One {
    static constexpr bool GATHER = false, HETERO = false;
    const char* A0; const char* B0; size_t sA, sB; int lda, g, mt;
    __device__ __forceinline__ bool next(int i, Unit& u) const {
        if (i > 0) return false;
        u.pm = mt; u.pn = 0; u.aux = g; u.A = A0 + (size_t)g * sA + (size_t)mt * 256 * lda * 2; u.B = B0 + (size_t)g * sB; return true;
    }
    __device__ __forceinline__ void a_offsets(const Unit&, const int (&R)[2], const int (&C)[2], unsigned (&v)[4]) const {
#pragma unroll
        for (int i = 0; i < 2; ++i) { v[i] = (unsigned)(R[i] * lda + C[i]) * 2u; v[2 + i] = (unsigned)((128 + R[i]) * lda + C[i]) * 2u; }
    }
};
struct GyOrder {
    static constexpr bool GATHER = false, HETERO = false;
    DenseOrder d;
    __device__ __forceinline__ bool next(int i, Unit& u) const { if (!d.next(i, u)) return false; u.A = d.A0 + (size_t)u.pm * 256 * 32; return true; }
    __device__ __forceinline__ void a_offsets(const Unit&, const int (&R)[2], const int (&C)[2], unsigned (&v)[4]) const {
#pragma unroll
        for (int i = 0; i < 2; ++i) { const unsigned o = (unsigned)(C[i] >> 4) * (unsigned)(T * 32) + (unsigned)(C[i] & 15) * 2u; v[i] = (unsigned)R[i] * 32u + o; v[2 + i] = (unsigned)(128 + R[i]) * 32u + o; }
    }
};
struct YaYbOrder {
    static constexpr bool GATHER = false, HETERO = true;
    DenseOrder d;
    const char* GYb; const char* WS5b; const char* YLb; const char* WLb;
    __device__ __forceinline__ bool next(int i, Unit& u) const {
        const int j = i / 3, r = i - 3 * j; Unit t;
        if (!d.next(j, t)) return false;
        u.pm = t.pm; u.aux = 0;
        if (r < 2) { u.kind = 0; u.pn = 2 * t.pn + r; u.nt = S5W / 64; u.kA = (unsigned)(4 * T * 32); u.A = GYb + (size_t)t.pm * 256 * 32; u.B = WS5b + (size_t)u.pn * 256 * S5W * 2; }
        else { u.kind = 1; u.pn = t.pn; u.nt = D / 64; u.kA = 128u; u.A = YLb + (size_t)t.pm * 256 * D * 2; u.B = WLb + (size_t)t.pn * 256 * D * 2; }
        return true;
    }
    __device__ __forceinline__ void a_offsets(const Unit& u, const int (&R)[2], const int (&C)[2], unsigned (&v)[4]) const {
#pragma unroll
        for (int i = 0; i < 2; ++i) {
            const unsigned og = (unsigned)(C[i] >> 4) * (unsigned)(T * 32) + (unsigned)(C[i] & 15) * 2u;
            const unsigned g0 = (unsigned)R[i] * 32u + og, g1 = (unsigned)(128 + R[i]) * 32u + og;
            const unsigned d0 = (unsigned)(R[i] * D + C[i]) * 2u, d1 = (unsigned)((128 + R[i]) * D + C[i]) * 2u;
            v[i] = u.kind ? d0 : g0; v[2 + i] = u.kind ? d1 : g1; }
    }
    __device__ __forceinline__ void b_offsets(const Unit& u, const int (&Rb)[2], const int (&C)[2], unsigned (&v)[4]) const {
        const int ldb = u.kind ? D : S5W;
#pragma unroll
        for (int i = 0; i < 2; ++i) { v[i] = (unsigned)(Rb[i] * ldb + C[i]) * 2u; v[2 + i] = (unsigned)((128 + Rb[i]) * ldb + C[i]) * 2u; }
    }
};
template <bool GATH> struct MoeOrder {
    static constexpr bool GATHER = GATH, HETERO = false;
    const char* A0; const char* B0; size_t sBe; int lda, ldb, G, c; volatile LAS unsigned* MISC; const LAS int* tokL;
    __device__ __forceinline__ bool next(int i, Unit& u) const {
        if (i >= (int)MISC[152]) return false;
        const int e = (int)MISC[136 + i], mtg = (int)MISC[96 + e] + (int)MISC[144 + i], L = i * G + c;
        u.pm = mtg; u.pn = L & 3; u.aux = i;
        u.A = GATH ? A0 : A0 + (size_t)mtg * 256 * lda * 2; u.B = B0 + (size_t)e * sBe + (size_t)u.pn * 256 * ldb * 2; return true;
    }
    __device__ __forceinline__ void a_offsets(const Unit& u, const int (&R)[2], const int (&C)[2], unsigned (&v)[4]) const {
#pragma unroll
        for (int i = 0; i < 2; ++i) {
            if constexpr (GATH) { v[i] = (unsigned)tokL[u.aux * 256 + R[i]] * (unsigned)(lda * 2) + (unsigned)C[i] * 2u; v[2 + i] = (unsigned)tokL[u.aux * 256 + 128 + R[i]] * (unsigned)(lda * 2) + (unsigned)C[i] * 2u; }
            else { v[i] = (unsigned)(R[i] * lda + C[i]) * 2u; v[2 + i] = (unsigned)((128 + R[i]) * lda + C[i]) * 2u; } }
    }
};

using pg8::cvt_pk_bf16;
template <int ACT> __device__ __forceinline__ float actf(float x) { if (ACT == 1) return gelu_t(x); if (ACT == 2) return fsigmoid(x); return x; }
__device__ __forceinline__ v4u pack8(const f32x4 a, const f32x4 b) { v4u w; w.x = cvt_pk_bf16(a[0], a[1]); w.y = cvt_pk_bf16(a[2], a[3]); w.z = cvt_pk_bf16(b[0], b[1]); w.w = cvt_pk_bf16(b[2], b[3]); return w; }

__device__ __forceinline__ void unpack_u8x8(const v2u w, float (&f)[8]) {
    const float k = 1.0f / 255.0f;
    f[0] = (float)(w.x & 0xffu) * k; f[1] = (float)((w.x >> 8) & 0xffu) * k; f[2] = (float)((w.x >> 16) & 0xffu) * k; f[3] = (float)(w.x >> 24) * k;
    f[4] = (float)(w.y & 0xffu) * k; f[5] = (float)((w.y >> 8) & 0xffu) * k; f[6] = (float)((w.y >> 16) & 0xffu) * k; f[7] = (float)(w.y >> 24) * k;
}
struct EpiInProj {
    static constexpr bool PERM = true, ACC_INIT = true, B16 = false, I8 = true;
    bf16 *AG, *XL, *GL, *GA, *GB; const float* HS; const float* WSC; LAS unsigned char* sl;
    __device__ __forceinline__ void init(i32x4 (&acc)[2][2][4][2], const Unit& u, int wr, int wc, int fr, int fq) const {
#pragma unroll
        for (int a = 0; a < 2; ++a)
#pragma unroll
            for (int b = 0; b < 2; ++b)
#pragma unroll
                for (int m = 0; m < 4; ++m)
#pragma unroll
                    for (int n = 0; n < 2; ++n) acc[a][b][m][n] = i32x4{};
        const int w = wr * 4 + wc, lane = fq * 16 + fr;
        const int pm = __builtin_amdgcn_readfirstlane(u.pm), pn = __builtin_amdgcn_readfirstlane(u.pn), par = __builtin_amdgcn_readfirstlane(u.aux);
        const float* src = w < 4 ? HS + pm * 256 + w * 64 : WSC + pn * 256 + (w - 4) * 64;
        __builtin_amdgcn_global_load_lds((const unsigned*)(src + lane), (LAS unsigned*)(sl + par * 2048 + w * 256), 4, 0, 0);
    }
    template <int MODE  > __device__ __forceinline__ void tile(const i32x4 (&acc)[2][2][4][2], const Unit& u, bf16* base, int colbase, bool s5, int wr, int wc, int fr, int fq) const {
        const LAS float* sb = (const LAS float*)(sl + __builtin_amdgcn_readfirstlane(u.aux) * 2048);
        f32x4 wsv[2][2];
#pragma unroll
        for (int bj = 0; bj < 2; ++bj)
#pragma unroll
            for (int n = 0; n < 2; ++n) wsv[bj][n] = *(const LAS f32x4*)(sb + 256 + bj * 128 + wc * 32 + 8 * fq + 4 * n);
#pragma unroll
        for (int ai = 0; ai < 2; ++ai)
#pragma unroll
            for (int m = 0; m < 4; ++m) { const int rl = ai * 128 + wr * 64 + m * 16 + fr, r = u.pm * 256 + rl; const float hs = sb[rl];
#pragma unroll
                for (int bj = 0; bj < 2; ++bj) { const int cl = colbase + bj * 128 + wc * 32 + 8 * fq;
                    f32x4 v0 = __builtin_convertvector(acc[ai][bj][m][0], f32x4) * (wsv[bj][0] * hs), v1 = __builtin_convertvector(acc[ai][bj][m][1], f32x4) * (wsv[bj][1] * hs);
                    if (MODE == 2) {
                        unsigned q[8];
#pragma unroll
                        for (int j = 0; j < 4; ++j) { q[j] = (unsigned)(fsigmoid(v0[j]) * 255.0f + 0.5f); q[4 + j] = (unsigned)(fsigmoid(v1[j]) * 255.0f + 0.5f); }
                        v2u w8; w8.x = q[0] | (q[1] << 8) | (q[2] << 16) | (q[3] << 24); w8.y = q[4] | (q[5] << 8) | (q[6] << 16) | (q[7] << 24);
                        __builtin_nontemporal_store(w8, (v2u*)((unsigned char*)base + (size_t)r * 1024 + cl));
                    } else {
                        if (MODE == 1) {
#pragma unroll
                            for (int j = 0; j < 4; ++j) { v0[j] = gelu_t(v0[j]); v1[j] = gelu_t(v1[j]); } }
                        const v4u w = pack8(v0, v1);
                        const int g = cl >> 4, cp = cl & 15, b = r >> 12, l = r & 4095, n = b * S5NCH + (l >> 4), s = l & 15;
                        const size_t off = s5 ? ((size_t)(g * S5N + n) * S5K + S5Q + s * 16 + cp) : ((size_t)r * 1024 + cl);
                        __builtin_nontemporal_store(w, (v4u*)(base + off)); } }
                asm volatile("" ::: "memory"); }
    }
    __device__ __forceinline__ void operator()(const i32x4 (&acc)[2][2][4][2], const Unit& u, int wr, int wc, int fr, int fq) const {
        const int pn = u.pn, reg = pn < 2 ? 0 : ((pn - 2) >> 2) + 1;
        const int colbase = reg == 0 ? pn * 256 : ((pn - 2) & 3) * 256;
        if (reg < 2) tile<0>(acc, u, reg == 0 ? AG : XL, colbase, reg == 0, wr, wc, fr, fq);
        else if (reg == 2) tile<1>(acc, u, GL, colbase, false, wr, wc, fr, fq);
        else tile<2>(acc, u, reg == 3 ? GA : GB, colbase, false, wr, wc, fr, fq);
    }
};
struct EpiS5State {
    static constexpr bool PERM = false, ACC_INIT = false, B16 = false;
    float* SLOC;
    __device__ __forceinline__ void operator()(const f32x4 (&acc)[2][2][4][2], const Unit& u, int wr, int wc, int fr, int fq) const {
#pragma unroll
        for (int ai = 0; ai < 2; ++ai)
#pragma unroll
            for (int m = 0; m < 4; ++m) { const int nr = u.pm * 256 + ai * 128 + wr * 64 + m * 16 + fr; float* rowp = SLOC + (size_t)(u.aux * S5N + nr) * S5Q + wc * 32 + 4 * fq;
#pragma unroll
                for (int n = 0; n < 2; ++n) *(f32x4*)(rowp + n * 16) = acc[ai][0][m][n]; }
    }
};
struct EpiS5Out {
    static constexpr bool PERM = true, ACC_INIT = false, B16 = false;
    bf16* GY;
    __device__ __forceinline__ void operator()(const f32x4 (&acc)[2][2][4][2], const Unit& u, int wr, int wc, int fr, int fq) const {
#pragma unroll
        for (int ai = 0; ai < 2; ++ai)
#pragma unroll
            for (int m = 0; m < 4; ++m) { const int nr = u.pm * 256 + ai * 128 + wr * 64 + m * 16 + fr, b = nr >> 8, j16 = nr & 255;
#pragma unroll
                for (int bj = 0; bj < 2; ++bj) { const int cc = bj * 128 + wc * 32 + 8 * fq, t = cc >> 4, c0 = cc & 15;
                    f32x4 v0 = acc[ai][bj][m][0], v1 = acc[ai][bj][m][1];
#pragma unroll
                    for (int j = 0; j < 4; ++j) { v0[j] = gelu_t(v0[j]); v1[j] = gelu_t(v1[j]); }
                    *(v4u*)(GY + ((size_t)u.aux * T + (size_t)(b * SEQ + j16 * 16 + t)) * 16 + c0) = pack8(v0, v1); }
                asm volatile("" ::: "memory"); }
    }
};
struct EpiYa {
    static constexpr bool PERM = true, ACC_INIT = false, B16 = false;
    const bf16* GA; bf16* YA;
    __device__ __forceinline__ void operator()(const f32x4 (&acc)[2][2][4][2], const Unit& u, int wr, int wc, int fr, int fq) const {
        const size_t off0 = (size_t)(u.pm * 256 + wr * 64 + fr) * 1024 + u.pn * 128 + wc * 32 + 8 * fq;
        v2u gav[2][4];
#pragma unroll
        for (int ai = 0; ai < 2; ++ai)
#pragma unroll
            for (int m = 0; m < 4; ++m) gav[ai][m] = __builtin_nontemporal_load((const v2u*)((const unsigned char*)GA + off0 + (size_t)(ai * 128 + m * 16) * 1024));
        asm volatile("" ::: "memory");
#pragma unroll
        for (int ai = 0; ai < 2; ++ai)
#pragma unroll
            for (int m = 0; m < 4; ++m) { float gaf[8]; unpack_u8x8(gav[ai][m], gaf);
                f32x4 o0, o1;
#pragma unroll
                for (int j = 0; j < 4; ++j) { o0[j] = gaf[j] * acc[ai][0][m][0][j] * fsigmoid(acc[ai][1][m][0][j]); o1[j] = gaf[4 + j] * acc[ai][0][m][1][j] * fsigmoid(acc[ai][1][m][1][j]); }
                *(v4u*)(YA + off0 + (size_t)(ai * 128 + m * 16) * 1024) = pack8(o0, o1); }
    }
};
struct EpiYb {
    static constexpr bool PERM = true, ACC_INIT = false, B16 = false;
    const bf16* YA; const bf16* GB; bf16* MIX;
    __device__ __forceinline__ void operator()(const f32x4 (&acc)[2][2][4][2], const Unit& u, int wr, int wc, int fr, int fq) const {
        const size_t off0 = (size_t)(u.pm * 256 + wr * 64 + fr) * 1024 + u.pn * 256 + wc * 32 + 8 * fq;
        v2u gb[2][4][2];
#pragma unroll
        for (int ai = 0; ai < 2; ++ai)
#pragma unroll
            for (int m = 0; m < 4; ++m)
#pragma unroll
                for (int bj = 0; bj < 2; ++bj) gb[ai][m][bj] = __builtin_nontemporal_load((const v2u*)((const unsigned char*)GB + off0 + (size_t)(ai * 128 + m * 16) * 1024 + bj * 128));
        v4u ya[2][2][2];
#define YB_LOAD(buf, grp) do { _Pragma("unroll") for (int mm = 0; mm < 2; ++mm) _Pragma("unroll") for (int bj = 0; bj < 2; ++bj) { \
            const size_t o = off0 + (size_t)(((grp) >> 1) * 128 + (2 * ((grp) & 1) + mm) * 16) * 1024 + bj * 128; ya[buf][mm][bj] = *(const v4u*)(YA + o); } } while (0)
        YB_LOAD(0, 0);
#pragma unroll
        for (int grp = 0; grp < 4; ++grp) { const int buf = grp & 1, ai = grp >> 1;
            if (grp < 3) YB_LOAD(buf ^ 1, grp + 1);
            asm volatile("" ::: "memory");
#pragma unroll
            for (int mm = 0; mm < 2; ++mm) { const int m = 2 * (grp & 1) + mm;
#pragma unroll
                for (int bj = 0; bj < 2; ++bj) { const v4u y = ya[buf][mm][bj];
                    const float yaf[8] = {bflo(y.x), bfhi(y.x), bflo(y.y), bfhi(y.y), bflo(y.z), bfhi(y.z), bflo(y.w), bfhi(y.w)};
                    float gbf[8]; unpack_u8x8(gb[ai][m][bj], gbf);
                    f32x4 o0, o1;
#pragma unroll
                    for (int j = 0; j < 4; ++j) { o0[j] = yaf[j] + gbf[j] * acc[ai][bj][m][0][j]; o1[j] = yaf[4 + j] + gbf[4 + j] * acc[ai][bj][m][1][j]; }
                    *(v4u*)(MIX + off0 + (size_t)(ai * 128 + m * 16) * 1024 + bj * 128) = pack8(o0, o1); } }
        }
#undef YB_LOAD
    }
};
struct EpiYaYb {
    static constexpr bool PERM = true, ACC_INIT = false, B16 = false;
    EpiYa a; EpiYb b;
    __device__ __forceinline__ void operator()(const f32x4 (&acc)[2][2][4][2], const Unit& u, int wr, int wc, int fr, int fq) const {
        if (__builtin_amdgcn_readfirstlane(u.kind) == 0) a(acc, u, wr, wc, fr, fq); else b(acc, u, wr, wc, fr, fq);
    }
};
struct EpiWo {
    static constexpr bool PERM = false, ACC_INIT = true, B16 = false;
    const float* X; float* O;
    __device__ __forceinline__ void init(f32x4 (&acc)[2][2][4][2], const Unit& u, int wr, int wc, int fr, int fq) const {
        const size_t off0 = (size_t)(u.pm * 256 + wr * 64 + fr) * 1024 + u.pn * 256 + wc * 32 + 4 * fq;
#pragma unroll
        for (int ai = 0; ai < 2; ++ai)
#pragma unroll
            for (int m = 0; m < 4; ++m)
#pragma unroll
                for (int bj = 0; bj < 2; ++bj)
#pragma unroll
                    for (int n = 0; n < 2; ++n) acc[ai][bj][m][n] = __builtin_nontemporal_load((const f32x4*)(X + off0 + (size_t)(ai * 128 + m * 16) * 1024 + bj * 128 + n * 16));
    }
    __device__ __forceinline__ void operator()(const f32x4 (&acc)[2][2][4][2], const Unit& u, int wr, int wc, int fr, int fq) const {
        const size_t off0 = (size_t)(u.pm * 256 + wr * 64 + fr) * 1024 + u.pn * 256 + wc * 32 + 4 * fq;
#pragma unroll
        for (int ai = 0; ai < 2; ++ai)
#pragma unroll
            for (int m = 0; m < 4; ++m)
#pragma unroll
                for (int bj = 0; bj < 2; ++bj)
#pragma unroll
                    for (int n = 0; n < 2; ++n) *(f32x4*)(O + off0 + (size_t)(ai * 128 + m * 16) * 1024 + bj * 128 + n * 16) = acc[ai][bj][m][n];
    }
};
struct EpiGU {
    static constexpr bool PERM = true, ACC_INIT = false, B16 = false;
    bf16* ACT; const LAS float* sclL;
    __device__ __forceinline__ void operator()(const f32x4 (&acc)[2][2][4][2], const Unit& u, int wr, int wc, int fr, int fq) const {
#pragma unroll
        for (int ai = 0; ai < 2; ++ai)
#pragma unroll
            for (int m = 0; m < 4; ++m) { const int rl = ai * 128 + wr * 64 + m * 16 + fr; const float sc = sclL[u.aux * 256 + rl];
                f32x4 o0, o1;
#pragma unroll
                for (int j = 0; j < 4; ++j) { const float g0 = acc[ai][0][m][0][j] * sc, g1 = acc[ai][0][m][1][j] * sc;
                    o0[j] = g0 * fsigmoid(g0) * (acc[ai][1][m][0][j] * sc); o1[j] = g1 * fsigmoid(g1) * (acc[ai][1][m][1][j] * sc); }
                *(v4u*)(ACT + (size_t)(u.pm * 256 + rl) * DEXP + u.pn * 128 + wc * 32 + 8 * fq) = pack8(o0, o1); }
    }
};
struct EpiDown {
    static constexpr bool PERM = true, ACC_INIT = false, B16 = false;
    bf16* YS; const LAS float* sclL;
    __device__ __forceinline__ void operator()(const f32x4 (&acc)[2][2][4][2], const Unit& u, int wr, int wc, int fr, int fq) const {
#pragma unroll
        for (int ai = 0; ai < 2; ++ai)
#pragma unroll
            for (int m = 0; m < 4; ++m) { const int rl = ai * 128 + wr * 64 + m * 16 + fr; const float sc = sclL[u.aux * 256 + rl];
#pragma unroll
                for (int bj = 0; bj < 2; ++bj)
                    *(v4u*)(YS + (size_t)(u.pm * 256 + rl) * 1024 + u.pn * 256 + bj * 128 + wc * 32 + 8 * fq) = pack8(acc[ai][bj][m][0] * sc, acc[ai][bj][m][1] * sc); }
    }
};

template <bool SCALED> struct EpiQ8 {
    static constexpr bool PERM = true, ACC_INIT = false, B16 = true;
    unsigned char* YS8; float* YSC; const LAS float* sclL;
    __device__ __forceinline__ void operator()(const f32x4 (&acc)[2][2][4][2], const Unit& u, int wr, int wc, int fr, int fq) const {
        float scs[2][4];
#pragma unroll
        for (int ai = 0; ai < 2; ++ai)
#pragma unroll
            for (int m = 0; m < 4; ++m) { const int rl = ai * 128 + wr * 64 + m * 16 + fr; const float sc = SCALED ? sclL[u.aux * 256 + rl] : 1.0f;
                float v[16]; float amax = 0.f;
#pragma unroll
                for (int bj = 0; bj < 2; ++bj)
#pragma unroll
                    for (int n = 0; n < 2; ++n)
#pragma unroll
                        for (int j = 0; j < 4; ++j) { const float x = acc[ai][bj][m][n][j] * sc; v[bj * 8 + n * 4 + j] = x; amax = fmaxf(amax, fabsf(x)); }
                amax = fmaxf(amax, __shfl_xor(amax, 16)); amax = fmaxf(amax, __shfl_xor(amax, 32));
                const float inv = amax > 0.f ? 127.0f / amax : 0.f;
                scs[ai][m] = amax * (1.0f / 127.0f);
                v4u w;
#pragma unroll
                for (int d = 0; d < 4; ++d) { const int q0 = (int)__builtin_rintf(v[4 * d] * inv), q1 = (int)__builtin_rintf(v[4 * d + 1] * inv), q2 = (int)__builtin_rintf(v[4 * d + 2] * inv), q3 = (int)__builtin_rintf(v[4 * d + 3] * inv);
                    w[d] = ((unsigned)q0 & 255u) | (((unsigned)q1 & 255u) << 8) | (((unsigned)q2 & 255u) << 16) | ((unsigned)q3 << 24); }
                *(v4u*)(YS8 + (size_t)(u.pm * 256 + rl) * 1024 + u.pn * 256 + wc * 64 + fq * 16) = w; }
#pragma unroll
        for (int ai = 0; ai < 2; ++ai) { const float sv = fq == 0 ? scs[ai][0] : fq == 1 ? scs[ai][1] : fq == 2 ? scs[ai][2] : scs[ai][3];
            YSC[(size_t)(u.pm * 256 + ai * 128 + wr * 64 + fq * 16 + fr) * 16 + wc * 4 + u.pn] = sv; }
    }
};

struct TItem { const float* W; int N; bf16* WT; int ldk, k0, n0, drow0; };
__device__ __forceinline__ void transpose_load(const TItem& it, f32x4 (&tv)[8], int lane) {
#pragma unroll
    for (int i = 0; i < 8; ++i) tv[i] = __builtin_nontemporal_load((const f32x4*)(it.W + (size_t)(it.k0 + 8 * i + (lane >> 3)) * it.N + it.n0 + 4 * (lane & 7)));
}
template <bool NT = false> __device__ __forceinline__ void transpose_store(const TItem& it, const f32x4 (&tv)[8], LAS float* scr, int lane) {
#pragma unroll
    for (int i = 0; i < 8; ++i) { LAS float* d = scr + (8 * i + (lane >> 3)) * 33 + 4 * (lane & 7); d[0] = tv[i].x; d[1] = tv[i].y; d[2] = tv[i].z; d[3] = tv[i].w; }
    LDS_WAIT(); asm volatile("" ::: "memory");
    const int c = lane & 7;
#pragma unroll
    for (int j = 0; j < 4; ++j) { const int n = (lane >> 3) + 8 * j; const LAS float* s = scr + (8 * c) * 33 + n;
        v4u o; o.x = pk2(s[0 * 33], s[1 * 33]); o.y = pk2(s[2 * 33], s[3 * 33]); o.z = pk2(s[4 * 33], s[5 * 33]); o.w = pk2(s[6 * 33], s[7 * 33]);
        if (NT) __builtin_nontemporal_store(o, (v4u*)(it.WT + (size_t)(it.drow0 + n) * it.ldk + it.k0 + 8 * c)); else *(v4u*)(it.WT + (size_t)(it.drow0 + n) * it.ldk + it.k0 + 8 * c) = o; }
    LDS_WAIT(); asm volatile("" ::: "memory");
}
__device__ __forceinline__ int ileave_row(int n, int half) { return 256 * (n >> 7) + 128 * half + (n & 127); }

template <int NR> __device__ __forceinline__ void rms_rows_to_bf16(const float* x0, const float* gain, bf16* o0, size_t rstride, int lane) {
    f32x4 v[NR][4];
#pragma unroll
    for (int r = 0; r < NR; ++r) { const f32x4* xr = (const f32x4*)(x0 + r * rstride) + lane;
#pragma unroll
        for (int j = 0; j < 4; ++j) v[r][j] = __builtin_nontemporal_load(xr + 64 * j); }
    asm volatile("" ::: "memory");
    const f32x4* gr = (const f32x4*)gain + lane;
    f32x4 g[4];
#pragma unroll
    for (int j = 0; j < 4; ++j) g[j] = gr[64 * j];
#pragma unroll
    for (int r = 0; r < NR; ++r) { float s = 0.f;
#pragma unroll
        for (int j = 0; j < 4; ++j) s += (v[r][j].x * v[r][j].x + v[r][j].y * v[r][j].y) + (v[r][j].z * v[r][j].z + v[r][j].w * v[r][j].w);
        const float rstd = 1.0f / sqrtf(wave_sum(s) * (1.f / D) + RMS_EPS);
        unsigned long long* o8 = (unsigned long long*)(o0 + r * rstride) + lane;
#pragma unroll
        for (int j = 0; j < 4; ++j) o8[64 * j] = (unsigned long long)pk2(v[r][j].x * rstd * g[j].x, v[r][j].y * rstd * g[j].y) | ((unsigned long long)pk2(v[r][j].z * rstd * g[j].z, v[r][j].w * rstd * g[j].w) << 32); }
}

__device__ __forceinline__ float wave_max(float v) {
#pragma unroll
    for (int o = 1; o < 64; o <<= 1) v = fmaxf(v, __shfl_xor(v, o));
    return v;
}
__device__ __forceinline__ unsigned pk_i8(float a, float b, float c, float d) {
    const int q0 = (int)__builtin_rintf(a), q1 = (int)__builtin_rintf(b), q2 = (int)__builtin_rintf(c), q3 = (int)__builtin_rintf(d);
    return ((unsigned)q0 & 255u) | (((unsigned)q1 & 255u) << 8) | (((unsigned)q2 & 255u) << 16) | ((unsigned)q3 << 24);
}
template <int NR> __device__ __forceinline__ void rms_rows_to_i8(const float* x0, const float* gain, unsigned char* o0, float* hs, int lane) {
    f32x4 v[NR][4];
#pragma unroll
    for (int r = 0; r < NR; ++r) { const f32x4* xr = (const f32x4*)(x0 + (size_t)r * D) + lane;
#pragma unroll
        for (int j = 0; j < 4; ++j) v[r][j] = __builtin_nontemporal_load(xr + 64 * j); }
    asm volatile("" ::: "memory");
    const f32x4* gr = (const f32x4*)gain + lane;
    f32x4 g[4];
#pragma unroll
    for (int j = 0; j < 4; ++j) g[j] = gr[64 * j];
#pragma unroll
    for (int r = 0; r < NR; ++r) { float s = 0.f;
#pragma unroll
        for (int j = 0; j < 4; ++j) s += (v[r][j].x * v[r][j].x + v[r][j].y * v[r][j].y) + (v[r][j].z * v[r][j].z + v[r][j].w * v[r][j].w);
        const float rstd = 1.0f / sqrtf(wave_sum(s) * (1.f / D) + RMS_EPS);
        float am = 0.f;
#pragma unroll
        for (int j = 0; j < 4; ++j) { v[r][j] = v[r][j] * rstd * g[j]; am = fmaxf(fmaxf(am, fmaxf(fabsf(v[r][j].x), fabsf(v[r][j].y))), fmaxf(fabsf(v[r][j].z), fabsf(v[r][j].w))); }
        am = fmaxf(wave_max(am), 1e-20f);
        const float inv = 127.0f / am;
        unsigned* o = (unsigned*)(o0 + (size_t)r * D) + lane;
#pragma unroll
        for (int j = 0; j < 4; ++j) o[64 * j] = pk_i8(v[r][j].x * inv, v[r][j].y * inv, v[r][j].z * inv, v[r][j].w * inv);
        if (lane == 0) hs[r] = am * (1.0f / 127.0f); }
}
__device__ __forceinline__ void win_to_i8(const Frame& F, const float* W, int nb) {
    const int lane = F.lane, w = F.wave, n0 = 32 * nb;
    f32x4 tv[2][8];
#pragma unroll
    for (int s2 = 0; s2 < 2; ++s2)
#pragma unroll
        for (int i = 0; i < 8; ++i) tv[s2][i] = __builtin_nontemporal_load((const f32x4*)(W + (size_t)(128 * w + 64 * s2 + 8 * i + (lane >> 3)) * NIN + n0 + 4 * (lane & 7)));
    asm volatile("" ::: "memory");
    f32x4 am = {0.f, 0.f, 0.f, 0.f};
#pragma unroll
    for (int s2 = 0; s2 < 2; ++s2)
#pragma unroll
        for (int i = 0; i < 8; ++i)
#pragma unroll
            for (int c = 0; c < 4; ++c) am[c] = fmaxf(am[c], fabsf(tv[s2][i][c]));
#pragma unroll
    for (int c = 0; c < 4; ++c) { am[c] = fmaxf(am[c], __shfl_xor(am[c], 8)); am[c] = fmaxf(am[c], __shfl_xor(am[c], 16)); am[c] = fmaxf(am[c], __shfl_xor(am[c], 32)); }
    LAS float* cm = (LAS float*)(F.lds + TOKL_OFF);
    if (lane < 8) *(LAS f32x4*)(cm + w * 32 + 4 * lane) = am;
    __syncthreads();
    f32x4 tot = *(const LAS f32x4*)(cm + 4 * (lane & 7));
#pragma unroll
    for (int ww = 1; ww < 8; ++ww) { const f32x4 o = *(const LAS f32x4*)(cm + ww * 32 + 4 * (lane & 7));
#pragma unroll
        for (int c = 0; c < 4; ++c) tot[c] = fmaxf(tot[c], o[c]); }
    f32x4 inv;
#pragma unroll
    for (int c = 0; c < 4; ++c) { tot[c] = fmaxf(tot[c], 1e-20f); inv[c] = 127.0f / tot[c]; }
    if (w == 0 && lane < 8) *(f32x4*)((float*)(F.ws + SM_WSC) + n0 + 4 * lane) = tot * (1.0f / 127.0f);
    LAS int* scr = (LAS int*)(F.lds + w * 16384);
    unsigned char* wt = F.ws + WS_WIN;
#pragma unroll
    for (int s2 = 0; s2 < 2; ++s2) {
#pragma unroll
        for (int i = 0; i < 8; ++i) { LAS int* d = scr + (8 * i + (lane >> 3)) * 33 + 4 * (lane & 7);
#pragma unroll
            for (int c = 0; c < 4; ++c) d[c] = (int)__builtin_rintf(tv[s2][i][c] * inv[c]); }
        LDS_WAIT(); asm volatile("" ::: "memory");
        const int n = lane & 31, kh = lane >> 5; const LAS int* sp = scr + (32 * kh) * 33 + n;
        v4u o[2];
#pragma unroll
        for (int d = 0; d < 8; ++d) o[d >> 2][d & 3] = ((unsigned)sp[(4 * d) * 33] & 255u) | (((unsigned)sp[(4 * d + 1) * 33] & 255u) << 8) | (((unsigned)sp[(4 * d + 2) * 33] & 255u) << 16) | ((unsigned)sp[(4 * d + 3) * 33] << 24);
        v4u* dst = (v4u*)(wt + (size_t)(n0 + n) * D + 128 * w + 64 * s2 + 32 * kh);
        dst[0] = o[0]; dst[1] = o[1];
        LDS_WAIT(); asm volatile("" ::: "memory");
    }
    __syncthreads();
}

__device__ __forceinline__ void s5_tables(const Frame& F, int g, const float* lam_re, const float* lam_im, const float* log_dt, const float* b_re, const float* b_im, const float* c_re, const float* c_im, const float* dsk) {
    LAS float* Cre = (LAS float*)F.lds;
    LAS float* Cim = Cre + 1024;
    LAS float* Bre = Cim + 1024;
    LAS float* Bim = Bre + 1024;
    LAS float* Pre = Bim + 1024;
    LAS float* Pim = Pre + 17 * 64;
    LAS float* Kt = Pim + 17 * 64;
    const int tid = F.tid;
    for (int i = tid; i < 1024; i += 512) { Cre[i] = c_re[g * 1024 + i]; Cim[i] = c_im[g * 1024 + i]; }
    if (tid < 64) {
        const int p = tid; const float lr = lam_re[g * 64 + p], li = lam_im[g * 64 + p], dt = expf(log_dt[g]);
        const float er = expf(lr * dt), lbr = er * cosf(li * dt), lbi = er * sinf(li * dt);
        const float den = lr * lr + li * li, nr = lbr - 1.0f, ni = lbi;
        const float cr = (nr * lr + ni * li) / den, ci = (ni * lr - nr * li) / den;
        { float pr = 1.f, pi = 0.f; for (int k = 0; k <= 16; ++k) { Pre[k * 64 + p] = pr; Pim[k * 64 + p] = pi; const float nr2 = pr * lbr - pi * lbi, ni2 = pr * lbi + pi * lbr; pr = nr2; pi = ni2; } }
        for (int c = 0; c < 16; ++c) { const float br = b_re[(g * 64 + p) * 16 + c], bi = b_im[(g * 64 + p) * 16 + c]; Bre[p * 16 + c] = cr * br - ci * bi; Bim[p * 16 + c] = cr * bi + ci * br; }
    }
    __syncthreads();
    {
        const int kc = tid & 255, k = kc >> 4, c = kc & 15, ph = tid >> 8; float a16[16];
#pragma unroll
        for (int i = 0; i < 16; ++i) a16[i] = 0.f;
        for (int p = 32 * ph; p < 32 * ph + 32; ++p) {
            const float cr_ = Cre[c * 64 + p], ci_ = Cim[c * 64 + p], pr_ = Pre[k * 64 + p], pi_ = Pim[k * 64 + p];
            const float xr = cr_ * pr_ - ci_ * pi_, xi = cr_ * pi_ + ci_ * pr_;
#pragma unroll
            for (int j = 0; j < 4; ++j) { const f32x4 br = *(const LAS f32x4*)(Bre + p * 16 + 4 * j), bi = *(const LAS f32x4*)(Bim + p * 16 + 4 * j);
#pragma unroll
                for (int i = 0; i < 4; ++i) a16[4 * j + i] += xr * br[i] - xi * bi[i]; }
        }
        LAS float* Kh = Kt + 4096;
        if (ph == 1) {
#pragma unroll
            for (int j = 0; j < 4; ++j) *(LAS f32x4*)(Kh + kc * 16 + 4 * j) = (f32x4){a16[4 * j], a16[4 * j + 1], a16[4 * j + 2], a16[4 * j + 3]}; }
        __syncthreads();
        if (ph == 0) {
#pragma unroll
            for (int j = 0; j < 4; ++j) { const f32x4 o = *(const LAS f32x4*)(Kh + kc * 16 + 4 * j); f32x4 r = (f32x4){a16[4 * j], a16[4 * j + 1], a16[4 * j + 2], a16[4 * j + 3]} + o;
                if (k == 0 && (c >> 2) == j) r[c & 3] += dsk[g * 16 + c];
                *(LAS f32x4*)(Kt + kc * 16 + 4 * j) = r; } }
    }
    __syncthreads();
    unsigned* btt = (unsigned*)(F.ws + WS_BTT) + (size_t)g * 256 * (S5K / 2);
    for (int e = tid; e < 256 * (S5K / 2); e += 512) {
        const int row = e / (S5K / 2), cpair = e % (S5K / 2), t = row >> 4, c = row & 15, col = 2 * cpair; float v0, v1;
        if (col < S5Q) { const int p = col >> 1; const float xr = Cre[c * 64 + p] * Pre[(t + 1) * 64 + p] - Cim[c * 64 + p] * Pim[(t + 1) * 64 + p], xi = Cre[c * 64 + p] * Pim[(t + 1) * 64 + p] + Cim[c * 64 + p] * Pre[(t + 1) * 64 + p];
            v0 = xr; v1 = -xi; }
        else { const int s = (col - S5Q) >> 4, cp = (col - S5Q) & 15;
            if (s <= t) { v0 = Kt[(t - s) * 256 + c * 16 + cp]; v1 = Kt[(t - s) * 256 + c * 16 + cp + 1]; } else { v0 = 0.f; v1 = 0.f; } }
        btt[e] = pk2(v0, v1);
    }
    unsigned* btw = (unsigned*)(F.ws + WS_BTW) + (size_t)g * 128 * 128;
    for (int e = tid; e < 128 * 128; e += 512) {
        const int q = e >> 7, cpair = e & 127, col = 2 * cpair, s = col >> 4, cp = col & 15, p = q >> 1, k = 15 - s;
        const float pr = Pre[k * 64 + p], pi = Pim[k * 64 + p];
        float v0, v1;
        if (q & 1) { v0 = pr * Bim[p * 16 + cp] + pi * Bre[p * 16 + cp]; v1 = pr * Bim[p * 16 + cp + 1] + pi * Bre[p * 16 + cp + 1]; }
        else { v0 = pr * Bre[p * 16 + cp] - pi * Bim[p * 16 + cp]; v1 = pr * Bre[p * 16 + cp + 1] - pi * Bim[p * 16 + cp + 1]; }
        btw[e] = pk2(v0, v1);
    }
    if (tid < 64) { float* l16 = (float*)(F.ws + SM_LAM16) + (g * 64 + tid) * 2; l16[0] = Pre[16 * 64 + tid]; l16[1] = Pim[16 * 64 + tid]; }
    __syncthreads();
}

struct In { const float* p[30]; };

__device__ __forceinline__ void p0_prologue(const Frame& F, const In& I) {
    for (int g = F.vcu; g < S5G; g += F.G) s5_tables(F, g, I.p[3], I.p[4], I.p[5], I.p[6], I.p[7], I.p[8], I.p[9], I.p[10]);
    const int gt = F.vcu * 512 + F.tid, NGT = F.G * 512;
    { float* lc = (float*)(F.ws + SM_LRUC); for (int i = gt; i < LRUW; i += NGT) { const float lam = I.p[18][i]; lc[i] = -8.0f * log1pf(expf(-lam)) * 1.44269504f; } }
    { bf16* wrt = (bf16*)(F.ws + SM_WRT);
        for (int i = gt; i < 2 * 65536; i += NGT) { const int which = i >> 16, r = i & 65535, h = r >> 12, j = (r >> 6) & 63, k = r & 63; const float* src = which ? I.p[16] : I.p[14]; wrt[i] = (bf16)f2bf(src[(h * 64 + k) * 64 + j]); } }
    { bf16* rhi = (bf16*)(F.ws + SM_RHI); bf16* rlo = (bf16*)(F.ws + SM_RLO);
        for (int i = gt; i < NROUT * 1024; i += NGT) { const int n = i >> 10, k = i & 1023; float w = 0.f; if (n < 4) w = I.p[22][k * 4 + n]; else if (n < 36) w = I.p[24][k * 32 + (n - 4)];
            const unsigned h = f2bf(w); rhi[i] = (bf16)h; rlo[i] = (bf16)f2bf(w - bf2f(h)); } }
    LAS float* scr = (LAS float*)(F.lds + F.wave * 16384);
    const int gw = F.vcu * NWAVES + F.wave, NGW = F.G * NWAVES;
    constexpr int I_S5 = (S5W / 64) * (2 * D / 32), I_LRU = (D / 64) * (D / 32), I_O = I_LRU;
    constexpr int NITEMS = I_S5 + I_LRU + I_O;
    for (int it = gw; it < NITEMS; it += NGW) {
        int r = it; TItem ti;
        if (r < I_S5) { const int nb = 2 * D / 32, kb = r / nb, n0 = 32 * (r % nb); ti = TItem{I.p[11], 2 * D, (bf16*)(F.ws + WS_WS5), S5W, 64 * kb, n0, n0 < D ? ileave_row(n0, 0) : ileave_row(n0 - D, 1)}; }
        else if ((r -= I_S5) < I_LRU) { const int nb = D / 32, kb = r / nb, n0 = 32 * (r % nb); ti = TItem{I.p[19], D, (bf16*)(F.ws + WS_WLRU), D, 64 * kb, n0, n0}; }
        else { r -= I_LRU; const int nb = D / 32, kb = r / nb, n0 = 32 * (r % nb); ti = TItem{I.p[20], D, (bf16*)(F.ws + WS_WO), D, 64 * kb, n0, n0}; }
        f32x4 tv[8]; transpose_load(ti, tv, F.lane); asm volatile("" ::: "memory"); transpose_store(ti, tv, scr, F.lane);
    }
    { const int skip = F.G > 2 * S5G ? S5G : 0;
      if (F.vcu >= skip) {
        for (int nb = F.vcu - skip; nb < NIN / 32; nb += F.G - skip) win_to_i8(F, I.p[2], nb);
        const int gw2 = (F.vcu - skip) * NWAVES + F.wave, NGW2 = (F.G - skip) * NWAVES;
        for (int m = gw2 * 4; m < T; m += NGW2 * 4) rms_rows_to_i8<4>(I.p[0] + (size_t)m * D, I.p[1], F.ws + WS_H + (size_t)m * D, (float*)(F.ws + SM_HSC) + m, F.lane); } }
}
__device__ __forceinline__ TItem expert_item(const Frame& F, const In& I, int it) {
    const int e = it >> 9, half = (it >> 8) & 1, r = it & 255, nb = DEXP / 32, kb = r / nb, n0 = 32 * (r % nb);
    return TItem{(half ? I.p[27] : I.p[26]) + (size_t)e * D * DEXP, DEXP, (bf16*)(F.ws + WS_WGU) + (size_t)e * 1024 * 1024, D, 64 * kb, n0, ileave_row(n0, half)};
}
__device__ __forceinline__ TItem expert_item_d(const Frame& F, const In& I, int it) {
    const int e = it >> 8, r = it & 255, nb = D / 32, kb = r / nb, n0 = 32 * (r % nb);
    return TItem{I.p[28] + (size_t)e * DEXP * D, D, (bf16*)(F.ws + WS_WD) + (size_t)e * 1024 * DEXP, DEXP, 64 * kb, n0, n0};
}
__device__ __forceinline__ void expert_weight_copies(const Frame& F, const In& I) {
    LAS float* scr = (LAS float*)(F.lds + F.wave * 16384);
    const int gw = F.vcu * NWAVES + F.wave, NGW = F.G * NWAVES;
    constexpr int NIT = NEXP * 512;
    for (int it = 8 * NGW + gw; it < NIT; it += NGW) { const TItem t0 = expert_item(F, I, it); f32x4 v0[8]; transpose_load(t0, v0, F.lane); asm volatile("" ::: "memory"); transpose_store(t0, v0, scr, F.lane); }
}
__device__ __forceinline__ void expert_down_copies(const Frame& F, const In& I) {
    LAS float* scr = (LAS float*)(F.lds + F.wave * 16384);
    const int nunits = (int)F.MISC[128] * 4, rem = nunits % F.G, nbusy = rem;
    const int nfree = F.G - nbusy;
    if (F.vcu < nbusy) return;
    const int gw = (F.vcu - nbusy) * NWAVES + F.wave, NGW = nfree * NWAVES;
    constexpr int NIT = NEXP * 256;
    for (int it = gw; it < NIT; it += 2 * NGW) {
        const TItem t0 = expert_item_d(F, I, it); const bool has1 = it + NGW < NIT; const TItem t1 = expert_item_d(F, I, has1 ? it + NGW : it);
        f32x4 v0[8], v1[8]; transpose_load(t0, v0, F.lane); transpose_load(t1, v1, F.lane); asm volatile("" ::: "memory");
        transpose_store(t0, v0, scr, F.lane); if (has1) transpose_store(t1, v1, scr, F.lane);
    }
}

__device__ __forceinline__ void lru_seq(const Frame& F, const In& I) {
    LAS unsigned char* wl = F.lds + F.wave * 17920;
    LAS bf16* xcA = (LAS bf16*)wl;
    LAS float* pre = (LAS float*)(wl + 9216);
    typedef float f32x2 __attribute__((ext_vector_type(2)));
    LAS f32x2* sumT = (LAS f32x2*)(F.lds + 143360);
    const int lane = F.lane, jj = lane & 15, ks = lane >> 4, c32 = lane & 31, th = lane >> 5;
    const bf16* XL = (const bf16*)(F.ws + WS_XL); const bf16* GL = (const bf16*)(F.ws + WS_GL); bf16* YL = (bf16*)(F.ws + WS_H);
    const bf16* WRT = (const bf16*)(F.ws + SM_WRT);
    for (int un = F.vcu; un < BATCH * LRUH * 2; un += F.G) {
        const int b = un >> 5, hd = (un >> 1) & 15, half = un & 1;
        const int chin = hd * 64 + lane;
        const int chg = hd * 64 + 32 * half + c32;
        const float w0 = I.p[12][chin], w1 = I.p[12][1024 + chin], w2 = I.p[12][2048 + chin], w3 = I.p[12][3072 + chin], cb = I.p[13][chin];
        const float brs = I.p[15][chg] * -1.44269504f, bis = I.p[17][chg] * -1.44269504f, cch2 = ((const float*)(F.ws + SM_LRUC))[chg];
        float Rc = 0.f;
        for (int rd = 0; rd < 8; ++rd) {
            const int j = rd * 8 + F.wave;
            const size_t tok0 = (size_t)b * SEQ + (size_t)j * LRUCH;
            unsigned short xr[64], xh[3];
            { const bf16* xp = XL + tok0 * 1024 + chin;
              xh[0] = 0; xh[1] = 0; xh[2] = 0;
              if (j > 0) { xh[0] = xp[-3 * 1024]; xh[1] = xp[-2 * 1024]; xh[2] = xp[-1 * 1024]; }
#pragma unroll
              for (int t = 0; t < 64; ++t) xr[t] = xp[t * 1024]; }
            asm volatile("" ::: "memory");
            { typedef float f2v __attribute__((ext_vector_type(2)));
              float xm3 = bf2f(xh[0]), xm2 = bf2f(xh[1]), xm1 = bf2f(xh[2]);
              const f2v vw0 = {w0, w0}, vw1 = {w1, w1}, vw2 = {w2, w2}, vw3 = {w3, w3}, vcb = {cb, cb};
#pragma unroll
              for (int t = 0; t < 64; t += 2) { const float x0 = bf2f(xr[t]), x1 = bf2f(xr[t + 1]);
                  f2v xc = vcb + vw0 * (f2v){xm3, xm2}; xc = xc + vw1 * (f2v){xm2, xm1}; xc = xc + vw2 * (f2v){xm1, x0}; xc = xc + vw3 * (f2v){x0, x1};
                  const unsigned pk = pg8::cvt_pk_bf16(xc.x, xc.y);
                  xcA[t * 72 + lane] = (bf16)(pk & 0xffffu); xcA[(t + 1) * 72 + lane] = (bf16)(pk >> 16);
                  xm3 = xm1; xm2 = x0; xm1 = x1; } }
            LDS_WAIT();
            float hl[2][16], Pl[2][16], Prun[2], Hrun[2];
#pragma unroll
            for (int st = 0; st < 2; ++st) {
                bf16x8 Bw[4][2];
#pragma unroll
                for (int n = 0; n < 4; ++n)
#pragma unroll
                    for (int k = 0; k < 2; ++k) Bw[n][k] = *(const bf16x8*)(WRT + (size_t)(n >> 1) * 65536 + (size_t)(hd * 64 + 32 * half + 16 * (n & 1) + jj) * 64 + 32 * k + 8 * ks);
#pragma unroll
                for (int mh = 0; mh < 2; ++mh) { const int mt = 2 * st + mh;
                    bf16x8 a[2];
#pragma unroll
                    for (int k = 0; k < 2; ++k) a[k] = *(const LAS bf16x8*)(xcA + (16 * mt + jj) * 72 + 32 * k + 8 * ks);
#pragma unroll
                    for (int n = 0; n < 4; ++n) { f32x4 d = (f32x4){0.f, 0.f, 0.f, 0.f};
#pragma unroll
                        for (int k = 0; k < 2; ++k) d = __builtin_amdgcn_mfma_f32_16x16x32_bf16(a[k], Bw[n][k], d, 0, 0, 0);
#pragma unroll
                        for (int r = 0; r < 4; ++r) pre[(16 * mh + 4 * ks + r) * 68 + 16 * n + jj] = d[r]; } }
                LDS_WAIT();
                float h = 0.f, P = 1.f;
                typedef float f2v __attribute__((ext_vector_type(2)));
#pragma unroll
                for (int tl = 0; tl < 16; tl += 2) {
                    const int trow = 16 * th + tl;
                    const f2v pr = {pre[trow * 68 + c32], pre[(trow + 1) * 68 + c32]}, pi = {pre[trow * 68 + 32 + c32], pre[(trow + 1) * 68 + 32 + c32]};
                    const f2v zr = pr * (f2v){-1.44269504f, -1.44269504f} + (f2v){brs, brs}, zi = pi * (f2v){-1.44269504f, -1.44269504f} + (f2v){bis, bis};
                    const f2v er = {__builtin_amdgcn_exp2f(zr.x), __builtin_amdgcn_exp2f(zr.y)}, ei = {__builtin_amdgcn_exp2f(zi.x), __builtin_amdgcn_exp2f(zi.y)};
                    const f2v dr = er + (f2v){1.f, 1.f};
                    const f2v rg = {__builtin_amdgcn_rcpf(dr.x), __builtin_amdgcn_rcpf(dr.y)};
                    const f2v la2 = rg * (f2v){cch2, cch2};
                    const f2v a_ = {__builtin_amdgcn_exp2f(la2.x), __builtin_amdgcn_exp2f(la2.y)};
                    const f2v x2 = la2 * (f2v){1.38629436f, 1.38629436f};
                    f2v q = x2 * (f2v){0.0013888889f, 0.0013888889f} + (f2v){0.0083333333f, 0.0083333333f};
                    q = q * x2 + (f2v){0.041666667f, 0.041666667f}; q = q * x2 + (f2v){0.16666667f, 0.16666667f}; q = q * x2 + (f2v){0.5f, 0.5f}; q = q * x2 + (f2v){1.f, 1.f};
                    f2v om = -(q * x2);
                    const f2v alt = (f2v){1.f, 1.f} - a_ * a_;
                    om.x = x2.x > -0.3f ? om.x : alt.x; om.y = x2.y > -0.3f ? om.y : alt.y;
                    om.x = fmaxf(om.x, 1e-30f); om.y = fmaxf(om.y, 1e-30f);
                    const f2v dd = ei + (f2v){1.f, 1.f};
                    const f2v rq = om * dd * dd;
                    const f2v mi = om * (f2v){__builtin_amdgcn_rsqf(rq.x), __builtin_amdgcn_rsqf(rq.y)};
                    const f2v bx = mi * (f2v){bf2f(xcA[(32 * st + trow) * 72 + 32 * half + c32]), bf2f(xcA[(32 * st + trow + 1) * 72 + 32 * half + c32])};
                    h = a_.x * h + bx.x; P *= a_.x; hl[st][tl] = h; Pl[st][tl] = P;
                    h = a_.y * h + bx.y; P *= a_.y; hl[st][tl + 1] = h; Pl[st][tl + 1] = P;
                }
                Prun[st] = P; Hrun[st] = h;
                LDS_WAIT();
            }
            const float pP0 = __shfl_xor(Prun[0], 32), pH0 = __shfl_xor(Hrun[0], 32), pP1 = __shfl_xor(Prun[1], 32), pH1 = __shfl_xor(Hrun[1], 32);
            const float P0 = th ? pP0 : Prun[0], H0 = th ? pH0 : Hrun[0], P1 = th ? Prun[0] : pP0, H1 = th ? Hrun[0] : pH0;
            const float P2 = th ? pP1 : Prun[1], H2 = th ? pH1 : Hrun[1], P3 = th ? Prun[1] : pP1, H3 = th ? Hrun[1] : pH1;
            const float C1 = H0, Q1 = P0, C2 = P1 * C1 + H1, Q2 = P1 * Q1, C3 = P2 * C2 + H2, Q3 = P2 * Q2, Hc = P3 * C3 + H3, Pc = P3 * Q3;
            const float Cs0 = th ? C1 : 0.f, Qs0 = th ? Q1 : 1.f, Cs1 = th ? C3 : C2, Qs1 = th ? Q3 : Q2;
            const int cit = (rd * F.G + F.vcu) * NWAVES + F.wave; const bool cdo = cit < NEXP * 512;
            f32x4 ctv[8]; unsigned short ggr[2][16];
            if (cdo) { const TItem citem = expert_item(F, I, cit); transpose_load(citem, ctv, lane); }
#pragma unroll
            for (int st = 0; st < 2; ++st)
#pragma unroll
                for (int tl = 0; tl < 16; ++tl) ggr[st][tl] = GL[(tok0 + 32 * st + 16 * th + tl) * 1024 + chg];
            asm volatile("" ::: "memory");
            if (th == 0) sumT[((rd & 1) * 8 + F.wave) * 32 + c32] = (f32x2){Pc, Hc};
            LDS_WAIT();
            __syncthreads();
            float cin = Rc, mycin = 0.f;
#pragma unroll
            for (int w = 0; w < 8; ++w) { const f32x2 ph = sumT[((rd & 1) * 8 + w) * 32 + c32]; mycin = (w == F.wave) ? cin : mycin; cin = ph.x * cin + ph.y; }
            Rc = cin;
#pragma unroll
            for (int st = 0; st < 2; ++st) { const float hin = (st ? Cs1 : Cs0) + (st ? Qs1 : Qs0) * mycin;
#pragma unroll
                for (int tl = 0; tl < 16; ++tl) { const float hh = hl[st][tl] + Pl[st][tl] * hin;
                    YL[(tok0 + 32 * st + 16 * th + tl) * 1024 + chg] = (bf16)f2bf(hh * bf2f(ggr[st][tl])); } }
            if (cdo) { const TItem citem = expert_item(F, I, cit); transpose_store<true>(citem, ctv, pre, lane); }
        }
        __syncthreads();
    }
}

__device__ __forceinline__ void s5_chain(const Frame& F, int b, int g) {
    typedef float f32x2 __attribute__((ext_vector_type(2)));
    LAS f32x2* segE = (LAS f32x2*)(F.lds);
    const int lane = F.lane, w = F.wave;
    const float* SLOC = (const float*)(F.ws + WS_SLOC); unsigned* AGw = (unsigned*)(F.ws + WS_AG); const float* L16 = (const float*)(F.ws + SM_LAM16);
    const float lr = L16[(g * 64 + lane) * 2], li = L16[(g * 64 + lane) * 2 + 1];
    const float* sl = SLOC + ((size_t)(g * S5N + b * S5NCH + 32 * w)) * S5Q + 2 * lane;
    unsigned* ag = AGw + ((size_t)(g * S5N + b * S5NCH + 32 * w)) * (S5K / 2) + lane;
    float xr[32], xi[32];
#pragma unroll
    for (int u = 0; u < 32; ++u) { const float2 v = *(const float2*)(sl + (size_t)u * S5Q); xr[u] = v.x; xi[u] = v.y; }
    asm volatile("" ::: "memory");
    float sr = 0.f, si = 0.f;
#pragma unroll
    for (int u = 0; u < 32; ++u) { const float nr = lr * sr - li * si + xr[u], ni = lr * si + li * sr + xi[u]; xr[u] = sr; xi[u] = si; sr = nr; si = ni; }
    segE[w * 64 + lane] = (f32x2){sr, si};
    float qr = lr, qi = li;
#pragma unroll
    for (int k = 0; k < 5; ++k) { const float nr = qr * qr - qi * qi, ni = 2.f * qr * qi; qr = nr; qi = ni; }
    LDS_WAIT();
    __syncthreads();
    float cr = 0.f, ci = 0.f;
    for (int ww = 0; ww < w; ++ww) { const f32x2 e = segE[ww * 64 + lane]; const float nr = qr * cr - qi * ci + e.x, ni = qr * ci + qi * cr + e.y; cr = nr; ci = ni; }
#pragma unroll
    for (int u = 0; u < 32; ++u) { ag[(size_t)u * (S5K / 2)] = pk2(xr[u] + cr, xi[u] + ci); const float nr = lr * cr - li * ci, ni = lr * ci + li * cr; cr = nr; ci = ni; }
    __syncthreads();
}

__device__ __forceinline__ void p8_router(const Frame& F, const In& I) {
    const int lane = F.lane, tk = lane & 15, ks = lane >> 4;
    LAS float* lg = (LAS float*)(F.lds + F.wave * 4096);
    volatile LAS unsigned* cntL = F.MISC + 32; volatile LAS unsigned* baseL = F.MISC + 64;
    const float* X1 = I.p[0]; bf16* H2 = (bf16*)(F.ws + WS_H2); const float* gf = I.p[21];
    const unsigned char* D8 = (const unsigned char*)(F.ws + WS_D8); const float* DSC = (const float*)(F.ws + WS_DSC);
    const bf16* RHI = (const bf16*)(F.ws + SM_RHI); const bf16* RLO = (const bf16*)(F.ws + SM_RLO);
    float* RSTD = (float*)(F.ws + SM_RSTD); unsigned* gcnt = F.ctl + CW_CNT;
    int* LTOK = (int*)(F.ws + WS_LTOK); float* LW = (float*)(F.ws + WS_LW); int* TOKE = (int*)(F.ws + WS_TOKE); int* TOKR = (int*)(F.ws + WS_TOKR);
    for (int blk = F.vcu; blk < T / 128; blk += F.G) {
        if (F.tid < 32) cntL[F.tid] = 0u;
        __syncthreads();
        const int tok0 = blk * 128 + F.wave * 16;
        const float* xrow = X1 + (size_t)(tok0 + tk) * D + 8 * ks; bf16* hrow = H2 + (size_t)(tok0 + tk) * D + 8 * ks;
        f32x4 acc[3]; acc[0] = acc[1] = acc[2] = (f32x4){0.f, 0.f, 0.f, 0.f}; float ss = 0.f;
        const unsigned char* drow = D8 + (size_t)(tok0 + tk) * D + 8 * ks; const float* dsc = DSC + (size_t)(tok0 + tk) * 16;
        f32x4 xnx[4][2]; v2u dnx[4]; float snx[2];
#pragma unroll
        for (int q = 0; q < 4; ++q) { xnx[q][0] = __builtin_nontemporal_load((const f32x4*)(xrow + 32 * q)); xnx[q][1] = __builtin_nontemporal_load((const f32x4*)(xrow + 32 * q + 4)); dnx[q] = *(const v2u*)(drow + 32 * q); }
        snx[0] = dsc[0]; snx[1] = dsc[4];
        LAS bf16* slab = (LAS bf16*)(F.lds + 32768);
        v4u wst[3];
#define RT_SLAB_LOAD(g) do { _Pragma("unroll") for (int j = 0; j < 3; ++j) { const int c = F.tid + 512 * j, which = c / 768, r = (c % 768) >> 4, kq = c & 15; \
            wst[j] = *(const v4u*)((which ? RLO : RHI) + (size_t)r * D + 128 * (g) + 8 * kq); } } while (0)
#define RT_SLAB_STORE(buf) do { _Pragma("unroll") for (int j = 0; j < 3; ++j) { const int c = F.tid + 512 * j, which = c / 768, r = (c % 768) >> 4, kq = c & 15; \
            *(LAS v4u*)(slab + ((size_t)((buf) * 2 + which) * 48 + r) * 136 + 8 * kq) = wst[j]; } } while (0)
        RT_SLAB_LOAD(0); RT_SLAB_STORE(0);
        LDS_WAIT();
        __syncthreads();
        for (int kg = 0; kg < 8; ++kg) {
            f32x4 xa[4][2];
#pragma unroll
            for (int q = 0; q < 4; ++q) { const float sq = snx[q >> 1]; const v2u dq = dnx[q];
                xa[q][0] = xnx[q][0] + (f32x4){(float)((int)(dq.x << 24) >> 24), (float)((int)(dq.x << 16) >> 24), (float)((int)(dq.x << 8) >> 24), (float)((int)dq.x >> 24)} * sq;
                xa[q][1] = xnx[q][1] + (f32x4){(float)((int)(dq.y << 24) >> 24), (float)((int)(dq.y << 16) >> 24), (float)((int)(dq.y << 8) >> 24), (float)((int)dq.y >> 24)} * sq; }
            { const int kgn = kg < 7 ? kg + 1 : kg;
#pragma unroll
              for (int q = 0; q < 4; ++q) { xnx[q][0] = __builtin_nontemporal_load((const f32x4*)(xrow + 32 * (4 * kgn + q))); xnx[q][1] = __builtin_nontemporal_load((const f32x4*)(xrow + 32 * (4 * kgn + q) + 4)); dnx[q] = *(const v2u*)(drow + 32 * (4 * kgn + q)); }
              { const int G0 = 2 * kgn, G1 = 2 * kgn + 1; snx[0] = dsc[(G0 & 3) * 4 + (G0 >> 2)]; snx[1] = dsc[(G1 & 3) * 4 + (G1 >> 2)]; }
              RT_SLAB_LOAD(kgn); }
            f32x4 ga[4][2];
#pragma unroll
            for (int q = 0; q < 4; ++q) { const int kc = 4 * kg + q; ga[q][0] = *(const f32x4*)(gf + 32 * kc + 8 * ks); ga[q][1] = *(const f32x4*)(gf + 32 * kc + 8 * ks + 4); }
            asm volatile("" ::: "memory");
            const LAS bf16* sh = slab + (size_t)((kg & 1) * 2) * 48 * 136, * sl = sh + 48 * 136;
#pragma unroll
            for (int q = 0; q < 4; ++q) { const int kc = 4 * kg + q;
                const f32x4 a0 = xa[q][0], a1 = xa[q][1];
                ss += (a0.x * a0.x + a0.y * a0.y) + (a0.z * a0.z + a0.w * a0.w) + (a1.x * a1.x + a1.y * a1.y) + (a1.z * a1.z + a1.w * a1.w);
                const f32x4 v0 = a0 * ga[q][0], v1 = a1 * ga[q][1];
                v4u hi, lo;
                hi.x = pg8::cvt_pk_bf16(v0.x, v0.y); hi.y = pg8::cvt_pk_bf16(v0.z, v0.w); hi.z = pg8::cvt_pk_bf16(v1.x, v1.y); hi.w = pg8::cvt_pk_bf16(v1.z, v1.w);
                lo.x = pg8::cvt_pk_bf16(v0.x - bflo(hi.x), v0.y - bfhi(hi.x)); lo.y = pg8::cvt_pk_bf16(v0.z - bflo(hi.y), v0.w - bfhi(hi.y));
                lo.z = pg8::cvt_pk_bf16(v1.x - bflo(hi.z), v1.y - bfhi(hi.z)); lo.w = pg8::cvt_pk_bf16(v1.z - bflo(hi.w), v1.w - bfhi(hi.w));
                *(v4u*)(hrow + 32 * kc) = hi;
                const bf16x8 hf = __builtin_bit_cast(bf16x8, hi), lf = __builtin_bit_cast(bf16x8, lo);
#pragma unroll
                for (int n = 0; n < 3; ++n) {
                    const bf16x8 wh = *(const LAS bf16x8*)(sh + (16 * n + tk) * 136 + 32 * q + 8 * ks), wl = *(const LAS bf16x8*)(sl + (16 * n + tk) * 136 + 32 * q + 8 * ks);
                    acc[n] = __builtin_amdgcn_mfma_f32_16x16x32_bf16(wh, hf, acc[n], 0, 0, 0);
                    acc[n] = __builtin_amdgcn_mfma_f32_16x16x32_bf16(wh, lf, acc[n], 0, 0, 0);
                    acc[n] = __builtin_amdgcn_mfma_f32_16x16x32_bf16(wl, hf, acc[n], 0, 0, 0);
                } }
            if (kg < 7) RT_SLAB_STORE((kg + 1) & 1);
            LDS_WAIT();
            __syncthreads();
        }
#undef RT_SLAB_LOAD
#undef RT_SLAB_STORE
        ss += __shfl_xor(ss, 16); ss += __shfl_xor(ss, 32);
        const float rstd = 1.0f / sqrtf(ss * (1.f / D) + RMS_EPS);
        if (ks == 0) RSTD[tok0 + tk] = rstd;
#pragma unroll
        for (int n = 0; n < 3; ++n)
#pragma unroll
            for (int r = 0; r < 4; ++r) lg[tk * 49 + 16 * n + 4 * ks + r] = acc[n][r] * rstd;
        LDS_WAIT();
        int E1 = 0, E2 = 0; float w1 = 0.f, w2 = 0.f; unsigned r1 = 0, r2 = 0;
        if (lane < 16) {
            const LAS float* my = lg + lane * 49;
            float lgp[4];
#pragma unroll
            for (int i = 0; i < 4; ++i) lgp[i] = my[i] + I.p[23][i];
            int gi = 0; float mx = lgp[0];
#pragma unroll
            for (int i = 1; i < 4; ++i) if (lgp[i] > mx) { mx = lgp[i]; gi = i; }
            float den = 0.f;
#pragma unroll
            for (int i = 0; i < 4; ++i) den += expf(lgp[i] - mx);
            const float pg = 1.0f / den;
            float le[8];
#pragma unroll
            for (int i = 0; i < 8; ++i) le[i] = my[4 + gi * 8 + i] + I.p[25][gi * 8 + i];
            int i1 = 0; float m1 = le[0];
#pragma unroll
            for (int i = 1; i < 8; ++i) if (le[i] > m1) { m1 = le[i]; i1 = i; }
            int i2 = -1; float m2 = -3.0e38f;
#pragma unroll
            for (int i = 0; i < 8; ++i) if (i != i1 && le[i] > m2) { m2 = le[i]; i2 = i; }
            const float e2 = expf(m2 - m1);
            w1 = pg / (1.0f + e2); w2 = pg * e2 / (1.0f + e2);
            E1 = gi * 8 + i1; E2 = gi * 8 + i2;
            r1 = __hip_atomic_fetch_add((LAS unsigned*)(F.MISC + 32) + E1, 1u, __ATOMIC_RELAXED, __HIP_MEMORY_SCOPE_WORKGROUP);
            r2 = __hip_atomic_fetch_add((LAS unsigned*)(F.MISC + 32) + E2, 1u, __ATOMIC_RELAXED, __HIP_MEMORY_SCOPE_WORKGROUP);
        }
        LDS_WAIT();
        __syncthreads();
        if (F.tid < 32) { const unsigned c = cntL[F.tid]; baseL[F.tid] = c ? __hip_atomic_fetch_add(gcnt + F.tid, c, __ATOMIC_RELAXED, __HIP_MEMORY_SCOPE_AGENT) : 0u; }
        __syncthreads();
        if (lane < 16) {
            const int tok = tok0 + lane; const int k1 = (int)(baseL[E1] + r1), k2 = (int)(baseL[E2] + r2);
            LTOK[(size_t)E1 * T + k1] = tok; LW[(size_t)E1 * T + k1] = w1; LTOK[(size_t)E2 * T + k2] = tok; LW[(size_t)E2 * T + k2] = w2;
            TOKE[tok * 2] = E1; TOKE[tok * 2 + 1] = E2; TOKR[tok * 2] = k1; TOKR[tok * 2 + 1] = k2;
        }
        __syncthreads();
    }
}

__device__ __forceinline__ void moe_prefix(const Frame& F) {
    if (F.tid < 64) {
        const unsigned nt = F.tid < NEXP ? (F.ctl[CW_CNT + F.tid] + 255u) >> 8 : 0u; unsigned inc = nt;
#pragma unroll
        for (int o = 1; o < 32; o <<= 1) { const unsigned v = __shfl_up(inc, o); if (F.lane >= o) inc += v; }
        if (F.tid < NEXP) F.MISC[96 + F.tid] = inc - nt;
        if (F.tid == NEXP - 1) F.MISC[128] = inc;
    }
    LDS_WAIT();
    __syncthreads();
}
template <int MODE  >
__device__ __forceinline__ void moe_setup(const Frame& F) {
    moe_prefix(F);
    const int NT = (int)F.MISC[128];
    if (F.tid < MAXU) { const int L = F.tid * F.G + F.vcu; int e = -1, mt = 0;
        if (L < NT * 4) { const int mtg = L >> 2; e = 0; while (e < NEXP - 1 && (int)F.MISC[96 + e + 1] <= mtg) ++e; mt = mtg - (int)F.MISC[96 + e]; }
        F.MISC[136 + F.tid] = (unsigned)e; F.MISC[144 + F.tid] = (unsigned)mt; }
    __syncthreads();
    if (F.tid == 0) { int n = 0; while (n < MAXU && (int)F.MISC[136 + n] >= 0) ++n; F.MISC[152] = (unsigned)n; }
    __syncthreads();
    const int nU = (int)F.MISC[152];
    LAS int* tokL = (LAS int*)(F.lds + TOKL_OFF); LAS float* sclL = (LAS float*)(F.lds + SCLL_OFF);
    const int* LTOK = (const int*)(F.ws + WS_LTOK); const float* LW = (const float*)(F.ws + WS_LW); const float* RSTD = (const float*)(F.ws + SM_RSTD);
    for (int i = F.tid; i < nU * 256; i += 512) { const int ui = i >> 8, r = i & 255, e = (int)F.MISC[136 + ui], rank = (int)F.MISC[144 + ui] * 256 + r; const bool valid = rank < (int)F.ctl[CW_CNT + e];
        const int tok = valid ? LTOK[(size_t)e * T + rank] : 0; tokL[i] = tok; sclL[i] = valid ? (MODE == 0 ? RSTD[tok] : LW[(size_t)e * T + rank]) : 0.f; }
    LDS_WAIT(); VM_WAIT();
    __syncthreads();
}

__device__ __forceinline__ void p11_final(const Frame& F, const In& I, float* dst) {
    moe_prefix(F);
    const int gw = F.vcu * NWAVES + F.wave, NGW = F.G * NWAVES, lane = F.lane;
    const int* TOKE = (const int*)(F.ws + WS_TOKE); const int* TOKR = (const int*)(F.ws + WS_TOKR);
    const unsigned char* YS8 = (const unsigned char*)(F.ws + WS_YS); const float* YSC = (const float*)(F.ws + WS_YS + 80 * MiB);
    const unsigned char* D8 = (const unsigned char*)(F.ws + WS_D8); const float* DSC = (const float*)(F.ws + WS_DSC); const float* X = I.p[0];
    f32x4 gfin[4];
#pragma unroll
    for (int j = 0; j < 4; ++j) gfin[j] = ((const f32x4*)I.p[29])[lane + 64 * j];
    int ee[2][2], rr[2][2];
    { const int m0 = gw * 2 < T ? gw * 2 : 0;
#pragma unroll
      for (int q = 0; q < 2; ++q) { ee[q][0] = TOKE[2 * (m0 + q)]; ee[q][1] = TOKE[2 * (m0 + q) + 1]; rr[q][0] = TOKR[2 * (m0 + q)]; rr[q][1] = TOKR[2 * (m0 + q) + 1]; } }
    for (int m0 = gw * 2; m0 < T; m0 += NGW * 2) {
        f32x4 xv[2][4]; unsigned ya[2][4], yb[2][4], yd[2][4]; f32x4 sa[2], sb[2], sd[2];
#pragma unroll
        for (int q = 0; q < 2; ++q) { const size_t s0 = (size_t)F.MISC[96 + ee[q][0]] * 256 + rr[q][0], s1 = (size_t)F.MISC[96 + ee[q][1]] * 256 + rr[q][1];
            const f32x4* xr = (const f32x4*)(X + (size_t)(m0 + q) * D) + lane; const unsigned* y0 = (const unsigned*)(YS8 + s0 * 1024) + lane; const unsigned* y1 = (const unsigned*)(YS8 + s1 * 1024) + lane;
            const unsigned* d0 = (const unsigned*)(D8 + (size_t)(m0 + q) * 1024) + lane;
#pragma unroll
            for (int j = 0; j < 4; ++j) { xv[q][j] = __builtin_nontemporal_load(xr + 64 * j); ya[q][j] = y0[64 * j]; yb[q][j] = y1[64 * j]; yd[q][j] = d0[64 * j]; }
            sa[q] = *(const f32x4*)(YSC + s0 * 16 + 4 * (lane >> 4)); sb[q] = *(const f32x4*)(YSC + s1 * 16 + 4 * (lane >> 4)); sd[q] = *(const f32x4*)(DSC + (size_t)(m0 + q) * 16 + 4 * (lane >> 4)); }
        { const int mn = m0 + NGW * 2 < T ? m0 + NGW * 2 : m0;
#pragma unroll
          for (int q = 0; q < 2; ++q) { ee[q][0] = TOKE[2 * (mn + q)]; ee[q][1] = TOKE[2 * (mn + q) + 1]; rr[q][0] = TOKR[2 * (mn + q)]; rr[q][1] = TOKR[2 * (mn + q) + 1]; } }
        asm volatile("" ::: "memory");
#pragma unroll
        for (int q = 0; q < 2; ++q) { f32x4 v[4]; float s = 0.f;
#pragma unroll
            for (int j = 0; j < 4; ++j) { const f32x4 x = xv[q][j]; const unsigned a = ya[q][j], b = yb[q][j], c = yd[q][j]; const float ka = sa[q][j], kb = sb[q][j], kc = sd[q][j];
                v[j].x = (x.x + (float)((int)(c << 24) >> 24) * kc) + (float)((int)(a << 24) >> 24) * ka + (float)((int)(b << 24) >> 24) * kb;
                v[j].y = (x.y + (float)((int)(c << 16) >> 24) * kc) + (float)((int)(a << 16) >> 24) * ka + (float)((int)(b << 16) >> 24) * kb;
                v[j].z = (x.z + (float)((int)(c << 8) >> 24) * kc) + (float)((int)(a << 8) >> 24) * ka + (float)((int)(b << 8) >> 24) * kb;
                v[j].w = (x.w + (float)((int)c >> 24) * kc) + (float)((int)a >> 24) * ka + (float)((int)b >> 24) * kb;
                s += (v[j].x * v[j].x + v[j].y * v[j].y) + (v[j].z * v[j].z + v[j].w * v[j].w); }
            const float rstd = 1.0f / sqrtf(wave_sum(s) * (1.f / D) + RMS_EPS);
            f32x4* xw = (f32x4*)(dst + (size_t)(m0 + q) * D) + lane;
#pragma unroll
            for (int j = 0; j < 4; ++j) { const f32x4 g = gfin[j]; __builtin_nontemporal_store((f32x4){v[j].x * rstd * g.x, v[j].y * rstd * g.y, v[j].z * rstd * g.z, v[j].w * rstd * g.w}, xw + 64 * j); } }
    }
}

constexpr int N_PHASES = 12;
struct Args { In in; float* out; unsigned char* ws; float* fin_dst; int ph_lo, ph_hi, li, pad; };
__global__ void __launch_bounds__(NWAVES * 64, 2) mk_fwd(Args args) {
    extern __shared__ __attribute__((aligned(16))) unsigned char lds[];
    Frame F;
    F.lds = (LAS unsigned char*)lds;
    F.MISC = (volatile LAS unsigned*)(F.lds + MISC_OFF);
    F.tid = threadIdx.x; F.lane = F.tid & 63; F.wave = __builtin_amdgcn_readfirstlane(F.tid >> 6);
    F.G = gridDim.x; { const int bx = blockIdx.x; F.vcu = (F.G % 8 == 0) ? (bx % 8) * (F.G / 8) + bx / 8 : bx; }
    F.ws = args.ws; F.out = args.out; F.ctl = (unsigned*)(args.ws + WS_CTL); F.in = nullptr;
    const In& I = args.in;
    for (int u = F.tid; u < 256; u += NWAVES * 64) F.MISC[u] = 0u;
    __syncthreads();
    const int lo = args.ph_lo, hi = args.ph_hi;
    XcdBarrier bar; bar.bar = F.ctl + CW_BAR + args.li * XCD_BAR_WORDS; bar.x = 0; bar.st = nullptr;
    if (hi - lo > 1) bar = xcd_barrier_post(F.ctl + CW_BAR + args.li * XCD_BAR_WORDS, F.MISC + 8);
#ifndef PH_MASK
#define PH_MASK 0xFFF
#endif
#define IN(k) (((PH_MASK >> (k)) & 1) && lo <= (k) && (k) < hi)
#define SEAM(k) do { if (IN(k) && IN(NEXT_PH(k))) xcd_barrier(bar); } while (0)
#define NEXT_PH(k) ((k) == 2 ? 5 : (k) == 5 ? 7 : (k) + 1)
    const int cblk = (int)blockIdx.x;
    LAS unsigned char* ring = F.lds;

    if (IN(0)) { p0_prologue(F, I); SEAM(0); }

    if (IN(1)) {
        DenseOrder S; S.init(F.ws + WS_H, F.ws + WS_WIN, D / 2, D / 2, T, NIN, F.G, cblk);
        EpiInProj E{(bf16*)(F.ws + WS_AG), (bf16*)(F.ws + WS_XL), (bf16*)(F.ws + WS_GL), (bf16*)(F.ws + WS_GA), (bf16*)(F.ws + WS_GB), (const float*)(F.ws + SM_HSC), (const float*)(F.ws + SM_WSC), F.lds + TOKL_OFF};
        pg8::gemm_phase<EpiInProj, DenseOrder, true>(ring, D / 2, D / 2, S, E);
        SEAM(1);
    }
    if (IN(2)) {
        if (cblk < 256) {
            const int L = cblk, wgid = (L % 8) * 32 + L / 8, g = wgid >> 3, mt = wgid & 7;
            { S5One S{(const char*)(F.ws + WS_AG) + S5Q * 2, (const char*)(F.ws + WS_BTW), (size_t)S5N * S5K * 2, (size_t)128 * 256 * 2, S5K, g, mt};
              EpiS5State E{(float*)(F.ws + WS_SLOC)};
              pg8::gemm_phase<EpiS5State, S5One, false>(ring, 256, 256, S, E); }
            if (F.wave == 0) { __builtin_amdgcn_fence(__ATOMIC_ACQUIRE, "agent"); VM_WAIT(); }
            __syncthreads();
            s5_chain(F, mt, g);
            VM_WAIT();
            __syncthreads();
            if (F.wave == 0) { __builtin_amdgcn_fence(__ATOMIC_ACQUIRE, "agent"); VM_WAIT(); }
            __syncthreads();
            { S5One S{(const char*)(F.ws + WS_AG), (const char*)(F.ws + WS_BTT), (size_t)S5N * S5K * 2, (size_t)256 * S5K * 2, S5K, g, mt};
              EpiS5Out E{(bf16*)(F.ws + WS_GY)};
              pg8::gemm_phase<EpiS5Out, S5One, false>(ring, S5K, S5K, S, E); }
            __syncthreads();
        }
        lru_seq(F, I);
        SEAM(2);
    }
    if (IN(5)) {
        YaYbOrder S; S.d.init(nullptr, nullptr, D, D, T, D, F.G, cblk);
        S.GYb = (const char*)(F.ws + WS_GY); S.WS5b = (const char*)(F.ws + WS_WS5); S.YLb = (const char*)(F.ws + WS_H); S.WLb = (const char*)(F.ws + WS_WLRU);
        EpiYaYb E{EpiYa{(const bf16*)(F.ws + WS_GA), (bf16*)(F.ws + WS_XL)}, EpiYb{(const bf16*)(F.ws + WS_XL), (const bf16*)(F.ws + WS_GB), (bf16*)(F.ws + WS_GL)}};
        pg8::gemm_phase<EpiYaYb, YaYbOrder, true>(ring, D, D, S, E);
        SEAM(5);
    }
    if (IN(7)) {
        DenseOrder S; S.init(F.ws + WS_GL, F.ws + WS_WO, D, D, T, D, F.G, cblk);
        EpiQ8<false> E{(unsigned char*)(F.ws + WS_D8), (float*)(F.ws + WS_DSC), nullptr};
        pg8::gemm_phase<EpiQ8<false>, DenseOrder, true>(ring, D, D, S, E);
        SEAM(7);
    }
    if (IN(8)) { p8_router(F, I); __syncthreads(); expert_weight_copies(F, I); SEAM(8); }
    if (IN(9)) {
        moe_setup<0>(F);
        MoeOrder<true> S{(const char*)(F.ws + WS_H2), (const char*)(F.ws + WS_WGU), (size_t)1024 * 1024 * 2, D, D, F.G, F.vcu, F.MISC, (const LAS int*)(F.lds + TOKL_OFF)};
        EpiGU E{(bf16*)(F.ws + WS_ACT), (const LAS float*)(F.lds + SCLL_OFF)};
        pg8::gemm_phase<EpiGU, MoeOrder<true>, true>(ring, D, D, S, E);
        __syncthreads();
        expert_down_copies(F, I);
        SEAM(9);
    }
    if (IN(10)) {
        moe_setup<1>(F);
        MoeOrder<false> S{(const char*)(F.ws + WS_ACT), (const char*)(F.ws + WS_WD), (size_t)1024 * DEXP * 2, DEXP, DEXP, F.G, F.vcu, F.MISC, (const LAS int*)(F.lds + TOKL_OFF)};
        EpiQ8<true> E{(unsigned char*)(F.ws + WS_YS), (float*)(F.ws + WS_YS + 80 * MiB), (const LAS float*)(F.lds + SCLL_OFF)};
        pg8::gemm_phase<EpiQ8<true>, MoeOrder<false>, true>(ring, DEXP, DEXP, S, E);
        SEAM(10);
    }
    if (IN(11)) { p11_final(F, I, args.fin_dst); }
#undef IN
#undef SEAM
}

extern "C" void kernel_launch(void* const* d_in, const int* in_sizes, int n_in, void* d_out, int out_size, void* d_ws, size_t ws_size, hipStream_t stream) {
    static int grid = 0;
    if (grid == 0) {
        if (n_in != 30 || in_sizes[0] != T * D || out_size != T * D || ws_size < WS_END) { fprintf(stderr, "kernel_launch: unexpected shapes / workspace (n_in %d, ws %zu)\n", n_in, ws_size); grid = -1; return; }
        int dev = 0, cus = 0, per_cu = 0;
        if (hipGetDevice(&dev) != hipSuccess || hipDeviceGetAttribute(&cus, hipDeviceAttributeMultiprocessorCount, dev) != hipSuccess) { grid = -1; return; }
        if (hipFuncSetAttribute((const void*)mk_fwd, hipFuncAttributeMaxDynamicSharedMemorySize, LDS_BYTES) != hipSuccess) { fprintf(stderr, "kernel_launch: hipFuncSetAttribute failed\n"); grid = -1; return; }
        if (hipOccupancyMaxActiveBlocksPerMultiprocessor(&per_cu, (const void*)mk_fwd, NWAVES * 64, LDS_BYTES) != hipSuccess || per_cu < 1) { fprintf(stderr, "kernel_launch: occupancy query says %d\n", per_cu); }
        (void)hipGetLastError();
        grid = cus;
    }
    if (grid < 0) return;
    if (hipMemsetAsync((char*)d_ws + WS_CTL, 0, CTL_ZERO_BYTES, stream) != hipSuccess) return;
    Args a{};
    for (int i = 0; i < 30; ++i) a.in.p[i] = (const float*)d_in[i];
    a.out = (float*)d_out; a.ws = (unsigned char*)d_ws; a.fin_dst = (float*)d_out;
#if defined(PROBE_LO)
    a.ph_lo = 0; a.ph_hi = PROBE_HI; a.li = 0;
#if PROBE_LO == 11
    a.fin_dst = (float*)((char*)d_ws + WS_H2);
#endif
    hipLaunchKernelGGL(mk_fwd, dim3(grid), dim3(NWAVES * 64), LDS_BYTES, stream, a);
#if PROBE_LO == 8
    hipMemsetAsync((char*)d_ws + WS_CTL + CW_CNT * 4, 0, 128, stream);
#endif
    a.fin_dst = (float*)d_out;
    a.ph_lo = PROBE_LO; a.ph_hi = N_PHASES; a.li = 1;
    hipLaunchKernelGGL(mk_fwd, dim3(grid), dim3(NWAVES * 64), LDS_BYTES, stream, a);
#elif MK_N_LAUNCHES == 1
    a.ph_lo = 0; a.ph_hi = N_PHASES;
    hipLaunchKernelGGL(mk_fwd, dim3(grid), dim3(NWAVES * 64), LDS_BYTES, stream, a);
#else
    for (int p = 0; p < N_PHASES; ++p) { a.ph_lo = p; a.ph_hi = p + 1; hipLaunchKernelGGL(mk_fwd, dim3(grid), dim3(NWAVES * 64), LDS_BYTES, stream, a); }
#endif
}
```

```cpp
#include <hip/hip_runtime.h>
#include <cstdio>
#include <cstdint>

#ifndef MK_N_LAUNCHES
#define MK_N_LAUNCHES 1
#endif

namespace pg8 {
#define PG8_LAS __attribute__((address_space(3)))
typedef unsigned short bf16_t;
typedef short bf16x8 __attribute__((ext_vector_type(8)));
typedef float f32x4 __attribute__((ext_vector_type(4)));
typedef unsigned u32x4 __attribute__((ext_vector_type(4)));
typedef int i32x4 __attribute__((ext_vector_type(4)));
template <class E, class = void> struct epi_i8 { static constexpr bool v = false; };
template <class E> struct epi_i8<E, decltype((void)E::I8)> { static constexpr bool v = E::I8; };
template <class E, class = void> struct epi_f8 { static constexpr bool v = false; };
template <class E> struct epi_f8<E, decltype((void)E::F8)> { static constexpr bool v = E::F8; };
typedef int i32x8 __attribute__((ext_vector_type(8)));
template <bool I8> struct acc_sel { typedef f32x4 t; };
template <> struct acc_sel<true> { typedef i32x4 t; };
constexpr int BM = 256, BK = 64, HALF = 128, HTB = HALF * BK * 2  , STAGE_BYTES = 8 * HTB, NXCD = 8, WGM = 8;

__host__ __device__ __forceinline__ int lds_byte(int r, int c) { const int st = (r >> 4) * 2 + (c >> 5), rr = r & 15, cc = c & 31, ob = rr * 64 + cc * 2; return st * 1024 + (ob ^ (((ob >> 9) & 1) << 5)); }
__host__ __device__ __forceinline__ void stage_rc(int b, int& R, int& C) { const int st = b / 1024, sb = b % 1024, swz = sb ^ (((sb >> 9) & 1) << 5); R = (st >> 1) * 16 + swz / 64; C = (st & 1) * 32 + (swz % 64) / 2; }
__host__ __device__ __forceinline__ int perm32(int rho) { const int n = rho >> 4, i = rho & 15; return 8 * (i >> 2) + 4 * n + (i & 3); }

struct Unit { const char* A; const char* B; int pm, pn, aux, nt, kind; unsigned kA; };

__device__ __forceinline__ unsigned cvt_pk_bf16(float lo, float hi) { unsigned r; asm volatile("v_cvt_pk_bf16_f32 %0, %1, %2" : "=v"(r) : "v"(lo), "v"(hi)); return r; }

template <class Epi, class Sched, bool ALIGN_EPI>
__device__ __forceinline__ void gemm_phase(PG8_LAS unsigned char* lds, const int ldb, const int K, const Sched& S, const Epi& E, const size_t kstepA = (size_t)(BK * 2)) {
    const int tid = threadIdx.x, wid = __builtin_amdgcn_readfirstlane(tid >> 6), lane = tid & 63, wr = wid >> 2, wc = wid & 3, fr = lane & 15, fq = lane >> 4;
    constexpr bool I8 = epi_i8<Epi>::v, F8 = epi_f8<Epi>::v; typedef typename acc_sel<I8>::t acc_t;
    int nt = K / BK; asm volatile("" : "+s"(nt));
    int Rr[2], Cc[2], Rbb[2]; unsigned voffB[4], vAc[4], vAn[4];
#pragma unroll
    for (int i = 0; i < 2; ++i) { int R, C; stage_rc(tid * 16 + i * 8192, R, C); Rr[i] = R; Cc[i] = C; const int Rb = Epi::PERM ? ((R & ~31) + perm32(R & 31)) : R; Rbb[i] = Rb;
        int Rb0 = Rb, Rb1 = HALF + Rb;
        if constexpr (Epi::B16) {
            const int w_ = R >> 5, nn_ = (R >> 4) & 1, ii_ = R & 15; Rb0 = 64 * w_ + 16 * (ii_ >> 2) + 4 * nn_ + (ii_ & 3); Rb1 = Rb0 + 8; }
        voffB[i] = (unsigned)(Rb0 * ldb + C) * 2u; voffB[2 + i] = (unsigned)(Rb1 * ldb + C) * 2u; }
    const size_t kstep = (size_t)(BK * 2);
    const unsigned ldsw = (unsigned)wid * 1024u;
    const int aoff = lds_byte(wr * 64 + fr, fq * 8), boff = lds_byte(wc * 32 + fr, fq * 8);
#define PG8_SA(b, h) (((b) * 2 + (h)) * HTB)
#define PG8_SB(b, h) ((4 + (b) * 2 + (h)) * HTB)
#define PG8_STAGE(bufoff, gbase, voff, h) do { _Pragma("unroll") for (int _i = 0; _i < 2; ++_i) \
        __builtin_amdgcn_global_load_lds((const unsigned*)((const char*)(gbase) + (voff)[2 * (h) + _i]), (PG8_LAS unsigned*)(lds + (bufoff) + ldsw + _i * 8192), 16, 0, 0); } while (0)
#define PG8_LDA(dst, b, h) do { _Pragma("unroll") for (int m = 0; m < 4; ++m) _Pragma("unroll") for (int k = 0; k < 2; ++k) dst[m][k] = *(const PG8_LAS bf16x8*)(lds + PG8_SA(b, h) + aoff + m * 2048 + k * 1024); } while (0)
#define PG8_LDB(dst, b, h) do { _Pragma("unroll") for (int n = 0; n < 2; ++n) _Pragma("unroll") for (int k = 0; k < 2; ++k) dst[n][k] = *(const PG8_LAS bf16x8*)(lds + PG8_SB(b, h) + boff + n * 2048 + k * 1024); } while (0)
#define PG8_MMA(ai, bj, At, Bt) do { __builtin_amdgcn_s_setprio(1); _Pragma("unroll") for (int m = 0; m < 4; ++m) _Pragma("unroll") for (int n = 0; n < 2; ++n) { \
        if constexpr (F8) { const i32x4 b0_ = __builtin_bit_cast(i32x4, Bt[n][0]), b1_ = __builtin_bit_cast(i32x4, Bt[n][1]), a0_ = __builtin_bit_cast(i32x4, At[m][0]), a1_ = __builtin_bit_cast(i32x4, At[m][1]); \
            acc[ai][bj][m][n] = __builtin_amdgcn_mfma_scale_f32_16x16x128_f8f6f4((i32x8){b0_[0], b0_[1], b0_[2], b0_[3], b1_[0], b1_[1], b1_[2], b1_[3]}, (i32x8){a0_[0], a0_[1], a0_[2], a0_[3], a1_[0], a1_[1], a1_[2], a1_[3]}, acc[ai][bj][m][n], 0, 0, 0, 0, 0, 0); } \
        else { _Pragma("unroll") for (int k = 0; k < 2; ++k) { \
          if constexpr (I8) acc[ai][bj][m][n] = __builtin_amdgcn_mfma_i32_16x16x64_i8(__builtin_bit_cast(i32x4, Bt[n][k]), __builtin_bit_cast(i32x4, At[m][k]), acc[ai][bj][m][n], 0, 0, 0); \
          else acc[ai][bj][m][n] = __builtin_amdgcn_mfma_f32_16x16x32_bf16(Bt[n][k], At[m][k], acc[ai][bj][m][n], 0, 0, 0); } } } __builtin_amdgcn_s_setprio(0); } while (0)
#define PG8_WAIT_V(n) asm volatile("s_waitcnt vmcnt(" #n ")" ::: "memory")
#define PG8_WAIT_L(n) asm volatile("s_waitcnt lgkmcnt(" #n ")" ::: "memory")
#define PG8_BAR __builtin_amdgcn_s_barrier()
#define PG8_SCHED __builtin_amdgcn_sched_barrier(0)
    Unit cur, nxt; int ui = 0;
    if (!S.next(0, cur)) return;
    S.a_offsets(cur, Rr, Cc, vAc);
    unsigned vBc[4], vBn[4];
    if constexpr (Sched::HETERO) { S.b_offsets(cur, Rbb, Cc, vBc); nt = __builtin_amdgcn_readfirstlane(cur.nt); }
    else {
#pragma unroll
        for (int q = 0; q < 4; ++q) vBc[q] = voffB[q]; }
    size_t kAc = Sched::HETERO ? (size_t)(unsigned)__builtin_amdgcn_readfirstlane((int)cur.kA) : kstepA;
    acc_t acc[2][2][4][2];
    if constexpr (Epi::ACC_INIT) E.init(acc, cur, wr, wc, fr, fq);
    else {
#pragma unroll
    for (int a = 0; a < 2; ++a)
#pragma unroll
        for (int b = 0; b < 2; ++b)
#pragma unroll
            for (int m = 0; m < 4; ++m)
#pragma unroll
                for (int n = 0; n < 2; ++n) acc[a][b][m][n] = acc_t{}; }
    bf16x8 At[4][2], B0[2][2], B1[2][2];
    const char* cA = cur.A; const char* cB = cur.B;
    if constexpr (Sched::GATHER) { PG8_WAIT_L(0); }
    PG8_STAGE(PG8_SB(0, 0), cB, vBc, 0); PG8_STAGE(PG8_SB(0, 1), cB, vBc, 1); PG8_STAGE(PG8_SA(0, 0), cA, vAc, 0); PG8_STAGE(PG8_SA(0, 1), cA, vAc, 1);
    if (wr == 1) PG8_BAR;
    PG8_WAIT_V(2); PG8_BAR;
    PG8_STAGE(PG8_SB(1, 0), cB + kstep, vBc, 0); PG8_STAGE(PG8_SA(1, 0), cA + kAc, vAc, 0); PG8_STAGE(PG8_SB(1, 1), cB + kstep, vBc, 1);
    PG8_WAIT_V(6); PG8_BAR;
    for (;;) {
        const bool has_next = S.next(ui + 1, nxt);
        const char* nA = has_next ? nxt.A : cA; const char* nB = has_next ? nxt.B : cB;
        size_t kAn = kAc;
        if constexpr (Sched::HETERO) { if (has_next) { S.b_offsets(nxt, Rbb, Cc, vBn); kAn = (size_t)(unsigned)__builtin_amdgcn_readfirstlane((int)nxt.kA); } else {
#pragma unroll
                for (int q = 0; q < 4; ++q) vBn[q] = vBc[q]; } }
        for (int t = 0; t < nt; t += 2) {
            const bool last = (t == nt - 2);
            const char* a1 = cA + (size_t)(t + 1) * kAc;
            const char* a2 = last ? nA : cA + (size_t)(t + 2) * kAc; const char* b2 = last ? nB : cB + (size_t)(t + 2) * kstep;
            const char* a3 = a2 + (last ? kAn : kAc); const char* b3 = b2 + kstep;
            unsigned vb2[4];
#pragma unroll
            for (int q = 0; q < 4; ++q) vb2[q] = (Sched::HETERO && last) ? vBn[q] : vBc[q];
            unsigned va2[4];
            if constexpr (Sched::GATHER || Sched::HETERO) {
                if (last) { if (has_next) { S.a_offsets(nxt, Rr, Cc, vAn); if constexpr (Sched::GATHER) { PG8_WAIT_L(0); } } else {
#pragma unroll
                        for (int q = 0; q < 4; ++q) vAn[q] = vAc[q]; } }
#pragma unroll
                for (int q = 0; q < 4; ++q) va2[q] = last ? vAn[q] : vAc[q];
            } else {
#pragma unroll
                for (int q = 0; q < 4; ++q) va2[q] = vAc[q];
            }
            PG8_LDB(B0, 0, 0); PG8_LDB(B1, 0, 1); PG8_SCHED; PG8_LDA(At, 0, 0); PG8_STAGE(PG8_SA(1, 1), a1, vAc, 1);
            PG8_WAIT_V(8); PG8_WAIT_L(0); PG8_BAR; PG8_MMA(0, 0, At, B0); PG8_MMA(0, 1, At, B1); PG8_BAR; PG8_SCHED;
            const bool fin = last && !has_next;
            PG8_LDA(At, 0, 1);
            if (!fin) { PG8_STAGE(PG8_SB(0, 0), b2, vb2, 0); PG8_STAGE(PG8_SB(0, 1), b2, vb2, 1); PG8_STAGE(PG8_SA(0, 0), a2, va2, 0); PG8_WAIT_V(8); } else { PG8_WAIT_V(0); }
            PG8_WAIT_L(0); PG8_BAR; PG8_MMA(1, 0, At, B0); PG8_MMA(1, 1, At, B1); PG8_BAR; PG8_SCHED;
            PG8_LDB(B0, 1, 0); PG8_LDB(B1, 1, 1); PG8_SCHED; PG8_LDA(At, 1, 0);
            if (!fin) { PG8_STAGE(PG8_SA(0, 1), a2, va2, 1); PG8_WAIT_V(8); } else { PG8_WAIT_V(0); }
            PG8_WAIT_L(0); PG8_BAR; PG8_MMA(0, 0, At, B0); PG8_MMA(0, 1, At, B1); PG8_BAR; PG8_SCHED;
            PG8_LDA(At, 1, 1);
            if (!fin) { PG8_STAGE(PG8_SB(1, 0), b3, vb2, 0); PG8_STAGE(PG8_SB(1, 1), b3, vb2, 1); PG8_STAGE(PG8_SA(1, 0), a3, va2, 0); PG8_WAIT_V(8); } else { PG8_WAIT_V(0); }
            PG8_WAIT_L(0); PG8_BAR; PG8_MMA(1, 0, At, B0); PG8_MMA(1, 1, At, B1); PG8_BAR; PG8_SCHED;
        }
        if constexpr (ALIGN_EPI) { if (wr == 0) PG8_BAR; }
        E(acc, cur, wr, wc, fr, fq);
        if (!has_next) break;
        if constexpr (Epi::ACC_INIT) E.init(acc, nxt, wr, wc, fr, fq);
        else {
#pragma unroll
        for (int a = 0; a < 2; ++a)
#pragma unroll
            for (int b = 0; b < 2; ++b)
#pragma unroll
                for (int m = 0; m < 4; ++m)
#pragma unroll
                    for (int n = 0; n < 2; ++n) acc[a][b][m][n] = acc_t{}; }
        cur = nxt; cA = nA; cB = nB; ++ui;
        if constexpr (Sched::GATHER || Sched::HETERO) {
#pragma unroll
            for (int q = 0; q < 4; ++q) vAc[q] = vAn[q]; }
        if constexpr (Sched::HETERO) {
#pragma unroll
            for (int q = 0; q < 4; ++q) vBc[q] = vBn[q];
            kAc = kAn; nt = __builtin_amdgcn_readfirstlane(cur.nt); }
        if constexpr (ALIGN_EPI) { if (wr == 1) PG8_BAR; }
    }
    PG8_WAIT_V(0);
    if constexpr (!ALIGN_EPI) { if (wr == 0) PG8_BAR; }
    PG8_BAR;
#undef PG8_SA
#undef PG8_SB
#undef PG8_STAGE
#undef PG8_LDA
#undef PG8_LDB
#undef PG8_MMA
#undef PG8_WAIT_V
#undef PG8_WAIT_L
#undef PG8_BAR
#undef PG8_SCHED
}
}

constexpr int NWAVES = 8;
constexpr int BATCH = 8, SEQ = 4096, D = 1024, T = BATCH * SEQ;
constexpr int S5W = 512, S5G = 32, S5C = 16, S5P = 64, S5Q = 128;
constexpr int S5LC = 16, S5NCH = SEQ / S5LC, S5N = BATCH * S5NCH;
constexpr int S5K = S5Q + S5LC * S5C;
constexpr int LRUW = 1024, LRUH = 16, LRUHD = 64, LRUCH = 64, LRUNCH = SEQ / LRUCH;
constexpr int NIN = S5W + 2 * LRUW + 2 * D;
constexpr int NEXP = 32, EPG = 8, NGRP = 4, DEXP = 512, NROUT = 48;
constexpr int MAXSLOT = 73728;
constexpr int MAXU = 8;
constexpr float RMS_EPS = 1e-6f;

constexpr size_t MiB = 1u << 20;
constexpr size_t WS_CTL = 0, CTL_ZERO_BYTES = 128 * 1024;
constexpr size_t WS_SMALL = 1 * MiB;
constexpr size_t SM_LAM16 = WS_SMALL + 0;
constexpr size_t SM_LRUC = WS_SMALL + 16384;
constexpr size_t SM_WRT = WS_SMALL + 32768;
constexpr size_t SM_RHI = WS_SMALL + 327680;
constexpr size_t SM_RLO = SM_RHI + 98304;
constexpr size_t SM_RSTD = WS_SMALL + 524288;
constexpr size_t SM_HSC = WS_SMALL + 720896;
constexpr size_t SM_WSC = WS_SMALL + 851968;
constexpr size_t WS_BTT = 2 * MiB;
constexpr size_t WS_BTW = 8 * MiB;
constexpr size_t WS_WIN = 11 * MiB;
constexpr size_t WS_WS5 = 20 * MiB;
constexpr size_t WS_WLRU = 22 * MiB;
constexpr size_t WS_WO = 24 * MiB;
constexpr size_t WS_LP = 26 * MiB, WS_LH = 28 * MiB, WS_LHIN = 30 * MiB;
constexpr size_t WS_AG = 32 * MiB;
constexpr size_t WS_SLOC = 80 * MiB;
constexpr size_t WS_H = 112 * MiB;
constexpr size_t WS_XL = 176 * MiB;
constexpr size_t WS_GL = 240 * MiB;
constexpr size_t WS_GA = 304 * MiB, WS_GB = 336 * MiB;
constexpr size_t WS_GY = 368 * MiB;
constexpr size_t WS_D8 = 336 * MiB, WS_DSC = 368 * MiB;
constexpr size_t WS_WGU = 400 * MiB;
constexpr size_t WS_WD = 464 * MiB;
constexpr size_t WS_H2 = 32 * MiB;
constexpr size_t WS_ACT = 96 * MiB;
constexpr size_t WS_YS = 168 * MiB;
constexpr size_t WS_LTOK = 312 * MiB, WS_LW = 316 * MiB;
constexpr size_t WS_TOKE = 320 * MiB, WS_TOKR = WS_TOKE + 262144;
constexpr size_t WS_END = 496 * MiB;
static_assert(WS_YS + (size_t)MAXSLOT * 1024 * 2 <= WS_LTOK && WS_ACT + (size_t)MAXSLOT * 512 * 2 <= WS_YS && WS_TOKR + 262144 <= WS_WGU && WS_GY + (size_t)T * 512 * 2 <= WS_WGU && WS_WD + (size_t)32 * 1024 * 512 * 2 <= WS_END, "d_ws map");
constexpr int CW_BAR = 4096;
constexpr int CW_CNT = 16384;

constexpr int RING_BYTES = 131072;
constexpr int TOKL_OFF = RING_BYTES, SCLL_OFF = TOKL_OFF + MAXU * 256 * 4, MISC_OFF = SCLL_OFF + MAXU * 256 * 4;
constexpr int LDS_BYTES = MISC_OFF + 1024;

#define GAS __attribute__((address_space(1)))
#define LAS __attribute__((address_space(3)))
typedef unsigned short bf16;
typedef unsigned v4u __attribute__((ext_vector_type(4)));
typedef unsigned v2u __attribute__((ext_vector_type(2)));
typedef float f32x4 __attribute__((ext_vector_type(4)));
typedef int i32x4 __attribute__((ext_vector_type(4)));
typedef short bf16x8 __attribute__((ext_vector_type(8)));
#define LDS_WAIT() asm volatile("s_waitcnt lgkmcnt(0)" ::: "memory")
#define VM_WAIT() asm volatile("s_waitcnt vmcnt(0)" ::: "memory")
__device__ __forceinline__ unsigned pk2(float lo, float hi) { unsigned r; asm volatile("v_cvt_pk_bf16_f32 %0, %1, %2" : "=v"(r) : "v"(lo), "v"(hi)); return r; }
__device__ __forceinline__ unsigned f2bf(float f) { return pk2(f, 0.f) & 0xffffu; }
__device__ __forceinline__ float bf2f(unsigned h) { return __builtin_bit_cast(float, h << 16); }
__device__ __forceinline__ float bflo(unsigned w) { return __builtin_bit_cast(float, w << 16); }
__device__ __forceinline__ float bfhi(unsigned w) { return __builtin_bit_cast(float, w & 0xffff0000u); }
__device__ __forceinline__ float fsigmoid(float x) { return __builtin_amdgcn_rcpf(1.0f + __builtin_amdgcn_exp2f(-1.44269504f * x)); }
__device__ __forceinline__ float gelu_t(float x) { const float u = x * (0.7978845608f + 0.0356774081f * x * x); return x * __builtin_amdgcn_rcpf(1.0f + __builtin_amdgcn_exp2f(-2.88539008f * u)); }
__device__ __forceinline__ float wave_sum(float v) {
#pragma unroll
    for (int o = 1; o < 64; o <<= 1) v += __shfl_xor(v, o);
    return v;
}

#define XB_TMO      128
#define XB_XCNT(j)  (256  + 64 * (j))
#define XB_XSUB(j)  (1280 + 64 * (j))
#define XB_XGEN(j)  (2304 + 64 * (j))
#define XB_TOP      3328
#define XB_TOPGEN   3392
#define XCD_BAR_WORDS 3456
#define XB_SPIN_CAP (1u << 18)
__device__ __forceinline__ unsigned xb_ld(unsigned* p)              { return __hip_atomic_load(p, __ATOMIC_RELAXED, __HIP_MEMORY_SCOPE_AGENT); }
__device__ __forceinline__ unsigned xb_add(unsigned* p, unsigned v) { return __hip_atomic_fetch_add(p, v, __ATOMIC_RELAXED, __HIP_MEMORY_SCOPE_AGENT); }
__device__ __forceinline__ unsigned xb_xcc_id() { return (unsigned)__builtin_amdgcn_s_getreg((3 << 11) | 20) & 0xFu; }
#define XB_SPIN(cond, bar) do { unsigned _sp = 0; while (cond) { __builtin_amdgcn_s_sleep(1); \
    if ((++_sp & 255u) == 0u) { if (xb_ld(&(bar)[XB_TMO])) break; if (_sp > XB_SPIN_CAP) { atomicAdd(&(bar)[XB_TMO], 1u); break; } } } } while (0)
struct XcdBarrier { unsigned* bar; unsigned x; volatile LAS unsigned* st; };
__device__ __forceinline__ XcdBarrier xcd_barrier_post(unsigned* bar, volatile LAS unsigned* st) {
    XcdBarrier b; b.bar = bar; b.x = xb_xcc_id(); b.st = st;
    if (threadIdx.x == 0) (void)xb_add(&bar[XB_XCNT(b.x)], 1u);
    return b;
}
__device__ __forceinline__ void xcd_barrier_complete(unsigned* bar, unsigned x, unsigned& nloc, unsigned& nx) {
    const unsigned G = gridDim.x * gridDim.y * gridDim.z;
    unsigned sum, cnt, mine, sp = 0u;
    for (;;) {
        sum = 0u; cnt = 0u; mine = 0u;
#pragma unroll
        for (unsigned j = 0; j < 16; ++j) { const unsigned c = xb_ld(&bar[XB_XCNT(j)]); sum += c; cnt += (c > 0u) ? 1u : 0u; mine = (j == x) ? c : mine; }
        if (sum == G) break;
        __builtin_amdgcn_s_sleep(1);
        if ((++sp & 255u) == 0u) { if (xb_ld(&bar[XB_TMO])) break; if (sp > XB_SPIN_CAP) { atomicAdd(&bar[XB_TMO], 1u); break; } }
    }
    nloc = mine > 0u ? mine : 1u; nx = cnt > 0u ? cnt : 1u;
}
__device__ __forceinline__ void xcd_barrier(const XcdBarrier& b) {
    asm volatile("s_waitcnt vmcnt(0)" ::: "memory");
    __syncthreads();
    if (threadIdx.x == 0) {
        unsigned* bar = b.bar;
        __builtin_amdgcn_s_waitcnt(0);
        unsigned nloc = b.st[0], nx = b.st[1];
        if (nloc == 0u) { xcd_barrier_complete(bar, b.x, nloc, nx); b.st[0] = nloc; b.st[1] = nx; }
        const unsigned old = xb_add(&bar[XB_XSUB(b.x)], 1u);
        const unsigned gen = old / nloc;
        if (old + 1u == (gen + 1u) * nloc) {
            __builtin_amdgcn_fence(__ATOMIC_RELEASE, "agent");
            asm volatile("s_waitcnt vmcnt(0)" ::: "memory");
            const unsigned og = xb_add(&bar[XB_TOP], 1u);
            const unsigned tg = og / nx;
            if (og + 1u == (tg + 1u) * nx) xb_add(&bar[XB_TOPGEN], 1u);
            else XB_SPIN(xb_ld(&bar[XB_TOPGEN]) == tg, bar);
            __builtin_amdgcn_fence(__ATOMIC_ACQUIRE, "agent");
            xb_add(&bar[XB_XGEN(b.x)], 1u);
            asm volatile("s_waitcnt vmcnt(0)" ::: "memory");
        } else {
            XB_SPIN(xb_ld(&bar[XB_XGEN(b.x)]) == gen, bar);
            __builtin_amdgcn_fence(__ATOMIC_ACQUIRE, "agent");
            asm volatile("s_waitcnt vmcnt(0)" ::: "memory");
        }
    }
    __syncthreads();
}

struct Frame {
    LAS unsigned char* lds;
    volatile LAS unsigned* MISC;
    unsigned* ctl;
    int tid, lane, wave, vcu, G;
    const float* const* in;
    unsigned char* ws; float* out;
};

using pg8::Unit;
struct DenseOrder {
    static constexpr bool GATHER = false, HETERO = false;
    const char* A0; const char* B0; int lda, ldb, nM, nN, nwg, G, c;
    __device__ __forceinline__ void init(const void* A, const void* B, int lda_, int ldb_, int M, int N, int G_, int c_) { A0 = (const char*)A; B0 = (const char*)B; lda = lda_; ldb = ldb_; nM = M / 256; nN = N / 256; nwg = nM * nN; G = G_; c = c_; }
    __device__ __forceinline__ bool next(int i, Unit& u) const {
        const long L = (long)i * G + c; if (L >= nwg) return false;
        int wgid = (int)L; { const int q = nwg / 8, r = nwg % 8, xcd = wgid % 8, off = wgid / 8; wgid = (xcd < r ? xcd * (q + 1) : r * (q + 1) + (xcd - r) * q) + off; }
        const int nig = 8 * nN, gid = wgid / nig, fm = gid * 8, gsz = (nM - fm) < 8 ? (nM - fm) : 8;
        u.pm = fm + ((wgid % nig) % gsz); u.pn = (wgid % nig) / gsz; u.aux = i & 1;
        u.A = A0 + (size_t)u.pm * 256 * lda * 2; u.B = B0 + (size_t)u.pn * 256 * ldb * 2; return true;
    }
    __device__ __forceinline__ void a_offsets(const Unit&, const int (&R)[2], const int (&C)[2], unsigned (&v)[4]) const {
#pragma unroll
        for (int i = 0; i < 2; ++i) { v[i] = (unsigned)(R[i] * lda + C[i]) * 2u; v[2 + i] = (unsigned)((128 + R[i]) * lda + C[i]) * 2u; }
    }
};
struct S5One {
    static constexpr bool GATHER = false, HETERO = false;
    const char* A0; const char* B0; size_t sA, sB; int lda, g, mt;
    __device__ __forceinline__ bool next(int i, Unit& u) const {
        if (i > 0) return false;
        u.pm = mt; u.pn = 0; u.aux = g; u.A = A0 + (size_t)g * sA + (size_t)mt * 256 * lda * 2; u.B = B0 + (size_t)g * sB; return true;
    }
    __device__ __forceinline__ void a_offsets(const Unit&, const int (&R)[2], const int (&C)[2], unsigned (&v)[4]) const {
#pragma unroll
        for (int i = 0; i < 2; ++i) { v[i] = (unsigned)(R[i] * lda + C[i]) * 2u; v[2 + i] = (unsigned)((128 + R[i]) * lda + C[i]) * 2u; }
    }
};
struct GyOrder {
    static constexpr bool GATHER = false, HETERO = false;
    DenseOrder d;
    __device__ __forceinline__ bool next(int i, Unit& u) const { if (!d.next(i, u)) return false; u.A = d.A0 + (size_t)u.pm * 256 * 32; return true; }
    __device__ __forceinline__ void a_offsets(const Unit&, const int (&R)[2], const int (&C)[2], unsigned (&v)[4]) const {
#pragma unroll
        for (int i = 0; i < 2; ++i) { const unsigned o = (unsigned)(C[i] >> 4) * (unsigned)(T * 32) + (unsigned)(C[i] & 15) * 2u; v[i] = (unsigned)R[i] * 32u + o; v[2 + i] = (unsigned)(128 + R[i]) * 32u + o; }
    }
};
struct YaYbOrder {
    static constexpr bool GATHER = false, HETERO = true;
    DenseOrder d;
    const char* GYb; const char* WS5b; const char* YLb; const char* WLb;
    __device__ __forceinline__ bool next(int i, Unit& u) const {
        const int j = i / 3, r = i - 3 * j; Unit t;
        if (!d.next(j, t)) return false;
        u.pm = t.pm; u.aux = 0;
        if (r < 2) { u.kind = 0; u.pn = 2 * t.pn + r; u.nt = S5W / 64; u.kA = (unsigned)(4 * T * 32); u.A = GYb + (size_t)t.pm * 256 * 32; u.B = WS5b + (size_t)u.pn * 256 * S5W * 2; }
        else { u.kind = 1; u.pn = t.pn; u.nt = D / 64; u.kA = 128u; u.A = YLb + (size_t)t.pm * 256 * D * 2; u.B = WLb + (size_t)t.pn * 256 * D * 2; }
        return true;
    }
    __device__ __forceinline__ void a_offsets(const Unit& u, const int (&R)[2], const int (&C)[2], unsigned (&v)[4]) const {
#pragma unroll
        for (int i = 0; i < 2; ++i) {
            const unsigned og = (unsigned)(C[i] >> 4) * (unsigned)(T * 32) + (unsigned)(C[i] & 15) * 2u;
            const unsigned g0 = (unsigned)R[i] * 32u + og, g1 = (unsigned)(128 + R[i]) * 32u + og;
            const unsigned d0 = (unsigned)(R[i] * D + C[i]) * 2u, d1 = (unsigned)((128 + R[i]) * D + C[i]) * 2u;
            v[i] = u.kind ? d0 : g0; v[2 + i] = u.kind ? d1 : g1; }
    }
    __device__ __forceinline__ void b_offsets(const Unit& u, const int (&Rb)[2], const int (&C)[2], unsigned (&v)[4]) const {
        const int ldb = u.kind ? D : S5W;
#pragma unroll
        for (int i = 0; i < 2; ++i) { v[i] = (unsigned)(Rb[i] * ldb + C[i]) * 2u; v[2 + i] = (unsigned)((128 + Rb[i]) * ldb + C[i]) * 2u; }
    }
};
template <bool GATH> struct MoeOrder {
    static constexpr bool GATHER = GATH, HETERO = false;
    const char* A0; const char* B0; size_t sBe; int lda, ldb, G, c; volatile LAS unsigned* MISC; const LAS int* tokL;
    __device__ __forceinline__ bool next(int i, Unit& u) const {
        if (i >= (int)MISC[152]) return false;
        const int e = (int)MISC[136 + i], mtg = (int)MISC[96 + e] + (int)MISC[144 + i], L = i * G + c;
        u.pm = mtg; u.pn = L & 3; u.aux = i;
        u.A = GATH ? A0 : A0 + (size_t)mtg * 256 * lda * 2; u.B = B0 + (size_t)e * sBe + (size_t)u.pn * 256 * ldb * 2; return true;
    }
    __device__ __forceinline__ void a_offsets(const Unit& u, const int (&R)[2], const int (&C)[2], unsigned (&v)[4]) const {
#pragma unroll
        for (int i = 0; i < 2; ++i) {
            if constexpr (GATH) { v[i] = (unsigned)tokL[u.aux * 256 + R[i]] * (unsigned)(lda * 2) + (unsigned)C[i] * 2u; v[2 + i] = (unsigned)tokL[u.aux * 256 + 128 + R[i]] * (unsigned)(lda * 2) + (unsigned)C[i] * 2u; }
            else { v[i] = (unsigned)(R[i] * lda + C[i]) * 2u; v[2 + i] = (unsigned)((128 + R[i]) * lda + C[i]) * 2u; } }
    }
};

using pg8::cvt_pk_bf16;
template <int ACT> __device__ __forceinline__ float actf(float x) { if (ACT == 1) return gelu_t(x); if (ACT == 2) return fsigmoid(x); return x; }
__device__ __forceinline__ v4u pack8(const f32x4 a, const f32x4 b) { v4u w; w.x = cvt_pk_bf16(a[0], a[1]); w.y = cvt_pk_bf16(a[2], a[3]); w.z = cvt_pk_bf16(b[0], b[1]); w.w = cvt_pk_bf16(b[2], b[3]); return w; }

__device__ __forceinline__ void unpack_u8x8(const v2u w, float (&f)[8]) {
    const float k = 1.0f / 255.0f;
    f[0] = (float)(w.x & 0xffu) * k; f[1] = (float)((w.x >> 8) & 0xffu) * k; f[2] = (float)((w.x >> 16) & 0xffu) * k; f[3] = (float)(w.x >> 24) * k;
    f[4] = (float)(w.y & 0xffu) * k; f[5] = (float)((w.y >> 8) & 0xffu) * k; f[6] = (float)((w.y >> 16) & 0xffu) * k; f[7] = (float)(w.y >> 24) * k;
}
struct EpiInProj {
    static constexpr bool PERM = true, ACC_INIT = true, B16 = false, I8 = true;
    bf16 *AG, *XL, *GL, *GA, *GB; const float* HS; const float* WSC; LAS unsigned char* sl;
    __device__ __forceinline__ void init(i32x4 (&acc)[2][2][4][2], const Unit& u, int wr, int wc, int fr, int fq) const {
#pragma unroll
        for (int a = 0; a < 2; ++a)
#pragma unroll
            for (int b = 0; b < 2; ++b)
#pragma unroll
                for (int m = 0; m < 4; ++m)
#pragma unroll
                    for (int n = 0; n < 2; ++n) acc[a][b][m][n] = i32x4{};
        const int w = wr * 4 + wc, lane = fq * 16 + fr;
        const int pm = __builtin_amdgcn_readfirstlane(u.pm), pn = __builtin_amdgcn_readfirstlane(u.pn), par = __builtin_amdgcn_readfirstlane(u.aux);
        const float* src = w < 4 ? HS + pm * 256 + w * 64 : WSC + pn * 256 + (w - 4) * 64;
        __builtin_amdgcn_global_load_lds((const unsigned*)(src + lane), (LAS unsigned*)(sl + par * 2048 + w * 256), 4, 0, 0);
    }
    template <int MODE  > __device__ __forceinline__ void tile(const i32x4 (&acc)[2][2][4][2], const Unit& u, bf16* base, int colbase, bool s5, int wr, int wc, int fr, int fq) const {
        const LAS float* sb = (const LAS float*)(sl + __builtin_amdgcn_readfirstlane(u.aux) * 2048);
        f32x4 wsv[2][2];
#pragma unroll
        for (int bj = 0; bj < 2; ++bj)
#pragma unroll
            for (int n = 0; n < 2; ++n) wsv[bj][n] = *(const LAS f32x4*)(sb + 256 + bj * 128 + wc * 32 + 8 * fq + 4 * n);
#pragma unroll
        for (int ai = 0; ai < 2; ++ai)
#pragma unroll
            for (int m = 0; m < 4; ++m) { const int rl = ai * 128 + wr * 64 + m * 16 + fr, r = u.pm * 256 + rl; const float hs = sb[rl];
#pragma unroll
                for (int bj = 0; bj < 2; ++bj) { const int cl = colbase + bj * 128 + wc * 32 + 8 * fq;
                    f32x4 v0 = __builtin_convertvector(acc[ai][bj][m][0], f32x4) * (wsv[bj][0] * hs), v1 = __builtin_convertvector(acc[ai][bj][m][1], f32x4) * (wsv[bj][1] * hs);
                    if (MODE == 2) {
                        unsigned q[8];
#pragma unroll
                        for (int j = 0; j < 4; ++j) { q[j] = (unsigned)(fsigmoid(v0[j]) * 255.0f + 0.5f); q[4 + j] = (unsigned)(fsigmoid(v1[j]) * 255.0f + 0.5f); }
                        v2u w8; w8.x = q[0] | (q[1] << 8) | (q[2] << 16) | (q[3] << 24); w8.y = q[4] | (q[5] << 8) | (q[6] << 16) | (q[7] << 24);
                        __builtin_nontemporal_store(w8, (v2u*)((unsigned char*)base + (size_t)r * 1024 + cl));
                    } else {
                        if (MODE == 1) {
#pragma unroll
                            for (int j = 0; j < 4; ++j) { v0[j] = gelu_t(v0[j]); v1[j] = gelu_t(v1[j]); } }
                        const v4u w = pack8(v0, v1);
                        const int g = cl >> 4, cp = cl & 15, b = r >> 12, l = r & 4095, n = b * S5NCH + (l >> 4), s = l & 15;
                        const size_t off = s5 ? ((size_t)(g * S5N + n) * S5K + S5Q + s * 16 + cp) : ((size_t)r * 1024 + cl);
                        __builtin_nontemporal_store(w, (v4u*)(base + off)); } }
                asm volatile("" ::: "memory"); }
    }
    __device__ __forceinline__ void operator()(const i32x4 (&acc)[2][2][4][2], const Unit& u, int wr, int wc, int fr, int fq) const {
        const int pn = u.pn, reg = pn < 2 ? 0 : ((pn - 2) >> 2) + 1;
        const int colbase = reg == 0 ? pn * 256 : ((pn - 2) & 3) * 256;
        if (reg < 2) tile<0>(acc, u, reg == 0 ? AG : XL, colbase, reg == 0, wr, wc, fr, fq);
        else if (reg == 2) tile<1>(acc, u, GL, colbase, false, wr, wc, fr, fq);
        else tile<2>(acc, u, reg == 3 ? GA : GB, colbase, false, wr, wc, fr, fq);
    }
};
struct EpiS5State {
    static constexpr bool PERM = false, ACC_INIT = false, B16 = false;
    float* SLOC;
    __device__ __forceinline__ void operator()(const f32x4 (&acc)[2][2][4][2], const Unit& u, int wr, int wc, int fr, int fq) const {
#pragma unroll
        for (int ai = 0; ai < 2; ++ai)
#pragma unroll
            for (int m = 0; m < 4; ++m) { const int nr = u.pm * 256 + ai * 128 + wr * 64 + m * 16 + fr; float* rowp = SLOC + (size_t)(u.aux * S5N + nr) * S5Q + wc * 32 + 4 * fq;
#pragma unroll
                for (int n = 0; n < 2; ++n) *(f32x4*)(rowp + n * 16) = acc[ai][0][m][n]; }
    }
};
struct EpiS5Out {
    static constexpr bool PERM = true, ACC_INIT = false, B16 = false;
    bf16* GY;
    __device__ __forceinline__ void operator()(const f32x4 (&acc)[2][2][4][2], const Unit& u, int wr, int wc, int fr, int fq) const {
#pragma unroll
        for (int ai = 0; ai < 2; ++ai)
#pragma unroll
            for (int m = 0; m < 4; ++m) { const int nr = u.pm * 256 + ai * 128 + wr * 64 + m * 16 + fr, b = nr >> 8, j16 = nr & 255;
#pragma unroll
                for (int bj = 0; bj < 2; ++bj) { const int cc = bj * 128 + wc * 32 + 8 * fq, t = cc >> 4, c0 = cc & 15;
                    f32x4 v0 = acc[ai][bj][m][0], v1 = acc[ai][bj][m][1];
#pragma unroll
                    for (int j = 0; j < 4; ++j) { v0[j] = gelu_t(v0[j]); v1[j] = gelu_t(v1[j]); }
                    *(v4u*)(GY + ((size_t)u.aux * T + (size_t)(b * SEQ + j16 * 16 + t)) * 16 + c0) = pack8(v0, v1); }
                asm volatile("" ::: "memory"); }
    }
};
struct EpiYa {
    static constexpr bool PERM = true, ACC_INIT = false, B16 = false;
    const bf16* GA; bf16* YA;
    __device__ __forceinline__ void operator()(const f32x4 (&acc)[2][2][4][2], const Unit& u, int wr, int wc, int fr, int fq) const {
        const size_t off0 = (size_t)(u.pm * 256 + wr * 64 + fr) * 1024 + u.pn * 128 + wc * 32 + 8 * fq;
        v2u gav[2][4];
#pragma unroll
        for (int ai = 0; ai < 2; ++ai)
#pragma unroll
            for (int m = 0; m < 4; ++m) gav[ai][m] = __builtin_nontemporal_load((const v2u*)((const unsigned char*)GA + off0 + (size_t)(ai * 128 + m * 16) * 1024));
        asm volatile("" ::: "memory");
#pragma unroll
        for (int ai = 0; ai < 2; ++ai)
#pragma unroll
            for (int m = 0; m < 4; ++m) { float gaf[8]; unpack_u8x8(gav[ai][m], gaf);
                f32x4 o0, o1;
#pragma unroll
                for (int j = 0; j < 4; ++j) { o0[j] = gaf[j] * acc[ai][0][m][0][j] * fsigmoid(acc[ai][1][m][0][j]); o1[j] = gaf[4 + j] * acc[ai][0][m][1][j] * fsigmoid(acc[ai][1][m][1][j]); }
                *(v4u*)(YA + off0 + (size_t)(ai * 128 + m * 16) * 1024) = pack8(o0, o1); }
    }
};
struct EpiYb {
    static constexpr bool PERM = true, ACC_INIT = false, B16 = false;
    const bf16* YA; const bf16* GB; bf16* MIX;
    __device__ __forceinline__ void operator()(const f32x4 (&acc)[2][2][4][2], const Unit& u, int wr, int wc, int fr, int fq) const {
        const size_t off0 = (size_t)(u.pm * 256 + wr * 64 + fr) * 1024 + u.pn * 256 + wc * 32 + 8 * fq;
        v2u gb[2][4][2];
#pragma unroll
        for (int ai = 0; ai < 2; ++ai)
#pragma unroll
            for (int m = 0; m < 4; ++m)
#pragma unroll
                for (int bj = 0; bj < 2; ++bj) gb[ai][m][bj] = __builtin_nontemporal_load((const v2u*)((const unsigned char*)GB + off0 + (size_t)(ai * 128 + m * 16) * 1024 + bj * 128));
        v4u ya[2][2][2];
#define YB_LOAD(buf, grp) do { _Pragma("unroll") for (int mm = 0; mm < 2; ++mm) _Pragma("unroll") for (int bj = 0; bj < 2; ++bj) { \
            const size_t o = off0 + (size_t)(((grp) >> 1) * 128 + (2 * ((grp) & 1) + mm) * 16) * 1024 + bj * 128; ya[buf][mm][bj] = *(const v4u*)(YA + o); } } while (0)
        YB_LOAD(0, 0);
#pragma unroll
        for (int grp = 0; grp < 4; ++grp) { const int buf = grp & 1, ai = grp >> 1;
            if (grp < 3) YB_LOAD(buf ^ 1, grp + 1);
            asm volatile("" ::: "memory");
#pragma unroll
            for (int mm = 0; mm < 2; ++mm) { const int m = 2 * (grp & 1) + mm;
#pragma unroll
                for (int bj = 0; bj < 2; ++bj) { const v4u y = ya[buf][mm][bj];
                    const float yaf[8] = {bflo(y.x), bfhi(y.x), bflo(y.y), bfhi(y.y), bflo(y.z), bfhi(y.z), bflo(y.w), bfhi(y.w)};
                    float gbf[8]; unpack_u8x8(gb[ai][m][bj], gbf);
                    f32x4 o0, o1;
#pragma unroll
                    for (int j = 0; j < 4; ++j) { o0[j] = yaf[j] + gbf[j] * acc[ai][bj][m][0][j]; o1[j] = yaf[4 + j] + gbf[4 + j] * acc[ai][bj][m][1][j]; }
                    *(v4u*)(MIX + off0 + (size_t)(ai * 128 + m * 16) * 1024 + bj * 128) = pack8(o0, o1); } }
        }
#undef YB_LOAD
    }
};
struct EpiYaYb {
    static constexpr bool PERM = true, ACC_INIT = false, B16 = false;
    EpiYa a; EpiYb b;
    __device__ __forceinline__ void operator()(const f32x4 (&acc)[2][2][4][2], const Unit& u, int wr, int wc, int fr, int fq) const {
        if (__builtin_amdgcn_readfirstlane(u.kind) == 0) a(acc, u, wr, wc, fr, fq); else b(acc, u, wr, wc, fr, fq);
    }
};
struct EpiWo {
    static constexpr bool PERM = false, ACC_INIT = true, B16 = false;
    const float* X; float* O;
    __device__ __forceinline__ void init(f32x4 (&acc)[2][2][4][2], const Unit& u, int wr, int wc, int fr, int fq) const {
        const size_t off0 = (size_t)(u.pm * 256 + wr * 64 + fr) * 1024 + u.pn * 256 + wc * 32 + 4 * fq;
#pragma unroll
        for (int ai = 0; ai < 2; ++ai)
#pragma unroll
            for (int m = 0; m < 4; ++m)
#pragma unroll
                for (int bj = 0; bj < 2; ++bj)
#pragma unroll
                    for (int n = 0; n < 2; ++n) acc[ai][bj][m][n] = __builtin_nontemporal_load((const f32x4*)(X + off0 + (size_t)(ai * 128 + m * 16) * 1024 + bj * 128 + n * 16));
    }
    __device__ __forceinline__ void operator()(const f32x4 (&acc)[2][2][4][2], const Unit& u, int wr, int wc, int fr, int fq) const {
        const size_t off0 = (size_t)(u.pm * 256 + wr * 64 + fr) * 1024 + u.pn * 256 + wc * 32 + 4 * fq;
#pragma unroll
        for (int ai = 0; ai < 2; ++ai)
#pragma unroll
            for (int m = 0; m < 4; ++m)
#pragma unroll
                for (int bj = 0; bj < 2; ++bj)
#pragma unroll
                    for (int n = 0; n < 2; ++n) *(f32x4*)(O + off0 + (size_t)(ai * 128 + m * 16) * 1024 + bj * 128 + n * 16) = acc[ai][bj][m][n];
    }
};
struct EpiGU {
    static constexpr bool PERM = true, ACC_INIT = false, B16 = false, F8 = true;
    bf16* ACT; const LAS float* sclL;
    __device__ __forceinline__ void operator()(const f32x4 (&acc)[2][2][4][2], const Unit& u, int wr, int wc, int fr, int fq) const {
#pragma unroll
        for (int ai = 0; ai < 2; ++ai)
#pragma unroll
            for (int m = 0; m < 4; ++m) { const int rl = ai * 128 + wr * 64 + m * 16 + fr; const float sc = sclL[u.aux * 256 + rl] * (1.0f / 32.0f);
                f32x4 o0, o1;
#pragma unroll
                for (int j = 0; j < 4; ++j) { const float g0 = acc[ai][0][m][0][j] * sc, g1 = acc[ai][0][m][1][j] * sc;
                    o0[j] = g0 * fsigmoid(g0) * (acc[ai][1][m][0][j] * sc); o1[j] = g1 * fsigmoid(g1) * (acc[ai][1][m][1][j] * sc); }
                *(v4u*)(ACT + (size_t)(u.pm * 256 + rl) * DEXP + u.pn * 128 + wc * 32 + 8 * fq) = pack8(o0, o1); }
    }
};
struct EpiDown {
    static constexpr bool PERM = true, ACC_INIT = false, B16 = false;
    bf16* YS; const LAS float* sclL;
    __device__ __forceinline__ void operator()(const f32x4 (&acc)[2][2][4][2], const Unit& u, int wr, int wc, int fr, int fq) const {
#pragma unroll
        for (int ai = 0; ai < 2; ++ai)
#pragma unroll
            for (int m = 0; m < 4; ++m) { const int rl = ai * 128 + wr * 64 + m * 16 + fr; const float sc = sclL[u.aux * 256 + rl];
#pragma unroll
                for (int bj = 0; bj < 2; ++bj)
                    *(v4u*)(YS + (size_t)(u.pm * 256 + rl) * 1024 + u.pn * 256 + bj * 128 + wc * 32 + 8 * fq) = pack8(acc[ai][bj][m][0] * sc, acc[ai][bj][m][1] * sc); }
    }
};

template <bool SCALED> struct EpiQ8 {
    static constexpr bool PERM = true, ACC_INIT = false, B16 = true;
    unsigned char* YS8; float* YSC; const LAS float* sclL;
    __device__ __forceinline__ void operator()(const f32x4 (&acc)[2][2][4][2], const Unit& u, int wr, int wc, int fr, int fq) const {
        float scs[2][4];
#pragma unroll
        for (int ai = 0; ai < 2; ++ai)
#pragma unroll
            for (int m = 0; m < 4; ++m) { const int rl = ai * 128 + wr * 64 + m * 16 + fr; const float sc = SCALED ? sclL[u.aux * 256 + rl] : 1.0f;
                float v[16]; float amax = 0.f;
#pragma unroll
                for (int bj = 0; bj < 2; ++bj)
#pragma unroll
                    for (int n = 0; n < 2; ++n)
#pragma unroll
                        for (int j = 0; j < 4; ++j) { const float x = acc[ai][bj][m][n][j] * sc; v[bj * 8 + n * 4 + j] = x; amax = fmaxf(amax, fabsf(x)); }
                amax = fmaxf(amax, __shfl_xor(amax, 16)); amax = fmaxf(amax, __shfl_xor(amax, 32));
                const float inv = amax > 0.f ? 127.0f / amax : 0.f;
                scs[ai][m] = amax * (1.0f / 127.0f);
                v4u w;
#pragma unroll
                for (int d = 0; d < 4; ++d) { const int q0 = (int)__builtin_rintf(v[4 * d] * inv), q1 = (int)__builtin_rintf(v[4 * d + 1] * inv), q2 = (int)__builtin_rintf(v[4 * d + 2] * inv), q3 = (int)__builtin_rintf(v[4 * d + 3] * inv);
                    w[d] = ((unsigned)q0 & 255u) | (((unsigned)q1 & 255u) << 8) | (((unsigned)q2 & 255u) << 16) | ((unsigned)q3 << 24); }
                *(v4u*)(YS8 + (size_t)(u.pm * 256 + rl) * 1024 + u.pn * 256 + wc * 64 + fq * 16) = w; }
#pragma unroll
        for (int ai = 0; ai < 2; ++ai) { const float sv = fq == 0 ? scs[ai][0] : fq == 1 ? scs[ai][1] : fq == 2 ? scs[ai][2] : scs[ai][3];
            YSC[(size_t)(u.pm * 256 + ai * 128 + wr * 64 + fq * 16 + fr) * 16 + wc * 4 + u.pn] = sv; }
    }
};

struct TItem { const float* W; int N; bf16* WT; int ldk, k0, n0, drow0; };
__device__ __forceinline__ void transpose_load(const TItem& it, f32x4 (&tv)[8], int lane) {
#pragma unroll
    for (int i = 0; i < 8; ++i) tv[i] = __builtin_nontemporal_load((const f32x4*)(it.W + (size_t)(it.k0 + 8 * i + (lane >> 3)) * it.N + it.n0 + 4 * (lane & 7)));
}
template <bool NT = false> __device__ __forceinline__ void transpose_store(const TItem& it, const f32x4 (&tv)[8], LAS float* scr, int lane) {
#pragma unroll
    for (int i = 0; i < 8; ++i) { LAS float* d = scr + (8 * i + (lane >> 3)) * 33 + 4 * (lane & 7); d[0] = tv[i].x; d[1] = tv[i].y; d[2] = tv[i].z; d[3] = tv[i].w; }
    LDS_WAIT(); asm volatile("" ::: "memory");
    const int c = lane & 7;
#pragma unroll
    for (int j = 0; j < 4; ++j) { const int n = (lane >> 3) + 8 * j; const LAS float* s = scr + (8 * c) * 33 + n;
        v4u o; o.x = pk2(s[0 * 33], s[1 * 33]); o.y = pk2(s[2 * 33], s[3 * 33]); o.z = pk2(s[4 * 33], s[5 * 33]); o.w = pk2(s[6 * 33], s[7 * 33]);
        if (NT) __builtin_nontemporal_store(o, (v4u*)(it.WT + (size_t)(it.drow0 + n) * it.ldk + it.k0 + 8 * c)); else *(v4u*)(it.WT + (size_t)(it.drow0 + n) * it.ldk + it.k0 + 8 * c) = o; }
    LDS_WAIT(); asm volatile("" ::: "memory");
}
__device__ __forceinline__ unsigned pk_fp8x4(float a, float b, float c, float d) { int w = 0; w = __builtin_amdgcn_cvt_pk_fp8_f32(a, b, w, false); w = __builtin_amdgcn_cvt_pk_fp8_f32(c, d, w, true); return (unsigned)w; }
__device__ __forceinline__ void transpose_store_fp8(const TItem& it, const f32x4 (&tv)[8], LAS float* scr, int lane) {
#pragma unroll
    for (int i = 0; i < 8; ++i) { LAS float* d = scr + (8 * i + (lane >> 3)) * 33 + 4 * (lane & 7); d[0] = tv[i].x; d[1] = tv[i].y; d[2] = tv[i].z; d[3] = tv[i].w; }
    LDS_WAIT(); asm volatile("" ::: "memory");
    const int c = lane & 7;
#pragma unroll
    for (int j = 0; j < 4; ++j) { const int n = (lane >> 3) + 8 * j; const LAS float* s = scr + (8 * c) * 33 + n;
        v2u o; o.x = pk_fp8x4(s[0 * 33] * 32.f, s[1 * 33] * 32.f, s[2 * 33] * 32.f, s[3 * 33] * 32.f); o.y = pk_fp8x4(s[4 * 33] * 32.f, s[5 * 33] * 32.f, s[6 * 33] * 32.f, s[7 * 33] * 32.f);
        __builtin_nontemporal_store(o, (v2u*)((unsigned char*)it.WT + (size_t)(it.drow0 + n) * it.ldk + it.k0 + 8 * c)); }
    LDS_WAIT(); asm volatile("" ::: "memory");
}
__device__ __forceinline__ int ileave_row(int n, int half) { return 256 * (n >> 7) + 128 * half + (n & 127); }

template <int NR> __device__ __forceinline__ void rms_rows_to_bf16(const float* x0, const float* gain, bf16* o0, size_t rstride, int lane) {
    f32x4 v[NR][4];
#pragma unroll
    for (int r = 0; r < NR; ++r) { const f32x4* xr = (const f32x4*)(x0 + r * rstride) + lane;
#pragma unroll
        for (int j = 0; j < 4; ++j) v[r][j] = __builtin_nontemporal_load(xr + 64 * j); }
    asm volatile("" ::: "memory");
    const f32x4* gr = (const f32x4*)gain + lane;
    f32x4 g[4];
#pragma unroll
    for (int j = 0; j < 4; ++j) g[j] = gr[64 * j];
#pragma unroll
    for (int r = 0; r < NR; ++r) { float s = 0.f;
#pragma unroll
        for (int j = 0; j < 4; ++j) s += (v[r][j].x * v[r][j].x + v[r][j].y * v[r][j].y) + (v[r][j].z * v[r][j].z + v[r][j].w * v[r][j].w);
        const float rstd = 1.0f / sqrtf(wave_sum(s) * (1.f / D) + RMS_EPS);
        unsigned long long* o8 = (unsigned long long*)(o0 + r * rstride) + lane;
#pragma unroll
        for (int j = 0; j < 4; ++j) o8[64 * j] = (unsigned long long)pk2(v[r][j].x * rstd * g[j].x, v[r][j].y * rstd * g[j].y) | ((unsigned long long)pk2(v[r][j].z * rstd * g[j].z, v[r][j].w * rstd * g[j].w) << 32); }
}

__device__ __forceinline__ float wave_max(float v) {
#pragma unroll
    for (int o = 1; o < 64; o <<= 1) v = fmaxf(v, __shfl_xor(v, o));
    return v;
}
__device__ __forceinline__ unsigned pk_i8(float a, float b, float c, float d) {
    const int q0 = (int)__builtin_rintf(a), q1 = (int)__builtin_rintf(b), q2 = (int)__builtin_rintf(c), q3 = (int)__builtin_rintf(d);
    return ((unsigned)q0 & 255u) | (((unsigned)q1 & 255u) << 8) | (((unsigned)q2 & 255u) << 16) | ((unsigned)q3 << 24);
}
template <int NR> __device__ __forceinline__ void rms_rows_to_i8(const float* x0, const float* gain, unsigned char* o0, float* hs, int lane) {
    f32x4 v[NR][4];
#pragma unroll
    for (int r = 0; r < NR; ++r) { const f32x4* xr = (const f32x4*)(x0 + (size_t)r * D) + lane;
#pragma unroll
        for (int j = 0; j < 4; ++j) v[r][j] = __builtin_nontemporal_load(xr + 64 * j); }
    asm volatile("" ::: "memory");
    const f32x4* gr = (const f32x4*)gain + lane;
    f32x4 g[4];
#pragma unroll
    for (int j = 0; j < 4; ++j) g[j] = gr[64 * j];
#pragma unroll
    for (int r = 0; r < NR; ++r) { float s = 0.f;
#pragma unroll
        for (int j = 0; j < 4; ++j) s += (v[r][j].x * v[r][j].x + v[r][j].y * v[r][j].y) + (v[r][j].z * v[r][j].z + v[r][j].w * v[r][j].w);
        const float rstd = 1.0f / sqrtf(wave_sum(s) * (1.f / D) + RMS_EPS);
        float am = 0.f;
#pragma unroll
        for (int j = 0; j < 4; ++j) { v[r][j] = v[r][j] * rstd * g[j]; am = fmaxf(fmaxf(am, fmaxf(fabsf(v[r][j].x), fabsf(v[r][j].y))), fmaxf(fabsf(v[r][j].z), fabsf(v[r][j].w))); }
        am = fmaxf(wave_max(am), 1e-20f);
        const float inv = 127.0f / am;
        unsigned* o = (unsigned*)(o0 + (size_t)r * D) + lane;
#pragma unroll
        for (int j = 0; j < 4; ++j) o[64 * j] = pk_i8(v[r][j].x * inv, v[r][j].y * inv, v[r][j].z * inv, v[r][j].w * inv);
        if (lane == 0) hs[r] = am * (1.0f / 127.0f); }
}
__device__ __forceinline__ void win_to_i8(const Frame& F, const float* W, int nb) {
    const int lane = F.lane, w = F.wave, n0 = 32 * nb;
    f32x4 tv[2][8];
#pragma unroll
    for (int s2 = 0; s2 < 2; ++s2)
#pragma unroll
        for (int i = 0; i < 8; ++i) tv[s2][i] = __builtin_nontemporal_load((const f32x4*)(W + (size_t)(128 * w + 64 * s2 + 8 * i + (lane >> 3)) * NIN + n0 + 4 * (lane & 7)));
    asm volatile("" ::: "memory");
    f32x4 am = {0.f, 0.f, 0.f, 0.f};
#pragma unroll
    for (int s2 = 0; s2 < 2; ++s2)
#pragma unroll
        for (int i = 0; i < 8; ++i)
#pragma unroll
            for (int c = 0; c < 4; ++c) am[c] = fmaxf(am[c], fabsf(tv[s2][i][c]));
#pragma unroll
    for (int c = 0; c < 4; ++c) { am[c] = fmaxf(am[c], __shfl_xor(am[c], 8)); am[c] = fmaxf(am[c], __shfl_xor(am[c], 16)); am[c] = fmaxf(am[c], __shfl_xor(am[c], 32)); }
    LAS float* cm = (LAS float*)(F.lds + TOKL_OFF);
    if (lane < 8) *(LAS f32x4*)(cm + w * 32 + 4 * lane) = am;
    __syncthreads();
    f32x4 tot = *(const LAS f32x4*)(cm + 4 * (lane & 7));
#pragma unroll
    for (int ww = 1; ww < 8; ++ww) { const f32x4 o = *(const LAS f32x4*)(cm + ww * 32 + 4 * (lane & 7));
#pragma unroll
        for (int c = 0; c < 4; ++c) tot[c] = fmaxf(tot[c], o[c]); }
    f32x4 inv;
#pragma unroll
    for (int c = 0; c < 4; ++c) { tot[c] = fmaxf(tot[c], 1e-20f); inv[c] = 127.0f / tot[c]; }
    if (w == 0 && lane < 8) *(f32x4*)((float*)(F.ws + SM_WSC) + n0 + 4 * lane) = tot * (1.0f / 127.0f);
    LAS int* scr = (LAS int*)(F.lds + w * 16384);
    unsigned char* wt = F.ws + WS_WIN;
#pragma unroll
    for (int s2 = 0; s2 < 2; ++s2) {
#pragma unroll
        for (int i = 0; i < 8; ++i) { LAS int* d = scr + (8 * i + (lane >> 3)) * 33 + 4 * (lane & 7);
#pragma unroll
            for (int c = 0; c < 4; ++c) d[c] = (int)__builtin_rintf(tv[s2][i][c] * inv[c]); }
        LDS_WAIT(); asm volatile("" ::: "memory");
        const int n = lane & 31, kh = lane >> 5; const LAS int* sp = scr + (32 * kh) * 33 + n;
        v4u o[2];
#pragma unroll
        for (int d = 0; d < 8; ++d) o[d >> 2][d & 3] = ((unsigned)sp[(4 * d) * 33] & 255u) | (((unsigned)sp[(4 * d + 1) * 33] & 255u) << 8) | (((unsigned)sp[(4 * d + 2) * 33] & 255u) << 16) | ((unsigned)sp[(4 * d + 3) * 33] << 24);
        v4u* dst = (v4u*)(wt + (size_t)(n0 + n) * D + 128 * w + 64 * s2 + 32 * kh);
        dst[0] = o[0]; dst[1] = o[1];
        LDS_WAIT(); asm volatile("" ::: "memory");
    }
    __syncthreads();
}

__device__ __forceinline__ void s5_tables(const Frame& F, int g, const float* lam_re, const float* lam_im, const float* log_dt, const float* b_re, const float* b_im, const float* c_re, const float* c_im, const float* dsk) {
    LAS float* Cre = (LAS float*)F.lds;
    LAS float* Cim = Cre + 1024;
    LAS float* Bre = Cim + 1024;
    LAS float* Bim = Bre + 1024;
    LAS float* Pre = Bim + 1024;
    LAS float* Pim = Pre + 17 * 64;
    LAS float* Kt = Pim + 17 * 64;
    const int tid = F.tid;
    for (int i = tid; i < 1024; i += 512) { Cre[i] = c_re[g * 1024 + i]; Cim[i] = c_im[g * 1024 + i]; }
    if (tid < 64) {
        const int p = tid; const float lr = lam_re[g * 64 + p], li = lam_im[g * 64 + p], dt = expf(log_dt[g]);
        const float er = expf(lr * dt), lbr = er * cosf(li * dt), lbi = er * sinf(li * dt);
        const float den = lr * lr + li * li, nr = lbr - 1.0f, ni = lbi;
        const float cr = (nr * lr + ni * li) / den, ci = (ni * lr - nr * li) / den;
        { float pr = 1.f, pi = 0.f; for (int k = 0; k <= 16; ++k) { Pre[k * 64 + p] = pr; Pim[k * 64 + p] = pi; const float nr2 = pr * lbr - pi * lbi, ni2 = pr * lbi + pi * lbr; pr = nr2; pi = ni2; } }
        for (int c = 0; c < 16; ++c) { const float br = b_re[(g * 64 + p) * 16 + c], bi = b_im[(g * 64 + p) * 16 + c]; Bre[p * 16 + c] = cr * br - ci * bi; Bim[p * 16 + c] = cr * bi + ci * br; }
    }
    __syncthreads();
    {
        const int kc = tid & 255, k = kc >> 4, c = kc & 15, ph = tid >> 8; float a16[16];
#pragma unroll
        for (int i = 0; i < 16; ++i) a16[i] = 0.f;
        for (int p = 32 * ph; p < 32 * ph + 32; ++p) {
            const float cr_ = Cre[c * 64 + p], ci_ = Cim[c * 64 + p], pr_ = Pre[k * 64 + p], pi_ = Pim[k * 64 + p];
            const float xr = cr_ * pr_ - ci_ * pi_, xi = cr_ * pi_ + ci_ * pr_;
#pragma unroll
            for (int j = 0; j < 4; ++j) { const f32x4 br = *(const LAS f32x4*)(Bre + p * 16 + 4 * j), bi = *(const LAS f32x4*)(Bim + p * 16 + 4 * j);
#pragma unroll
                for (int i = 0; i < 4; ++i) a16[4 * j + i] += xr * br[i] - xi * bi[i]; }
        }
        LAS float* Kh = Kt + 4096;
        if (ph == 1) {
#pragma unroll
            for (int j = 0; j < 4; ++j) *(LAS f32x4*)(Kh + kc * 16 + 4 * j) = (f32x4){a16[4 * j], a16[4 * j + 1], a16[4 * j + 2], a16[4 * j + 3]}; }
        __syncthreads();
        if (ph == 0) {
#pragma unroll
            for (int j = 0; j < 4; ++j) { const f32x4 o = *(const LAS f32x4*)(Kh + kc * 16 + 4 * j); f32x4 r = (f32x4){a16[4 * j], a16[4 * j + 1], a16[4 * j + 2], a16[4 * j + 3]} + o;
                if (k == 0 && (c >> 2) == j) r[c & 3] += dsk[g * 16 + c];
                *(LAS f32x4*)(Kt + kc * 16 + 4 * j) = r; } }
    }
    __syncthreads();
    unsigned* btt = (unsigned*)(F.ws + WS_BTT) + (size_t)g * 256 * (S5K / 2);
    for (int e = tid; e < 256 * (S5K / 2); e += 512) {
        const int row = e / (S5K / 2), cpair = e % (S5K / 2), t = row >> 4, c = row & 15, col = 2 * cpair; float v0, v1;
        if (col < S5Q) { const int p = col >> 1; const float xr = Cre[c * 64 + p] * Pre[(t + 1) * 64 + p] - Cim[c * 64 + p] * Pim[(t + 1) * 64 + p], xi = Cre[c * 64 + p] * Pim[(t + 1) * 64 + p] + Cim[c * 64 + p] * Pre[(t + 1) * 64 + p];
            v0 = xr; v1 = -xi; }
        else { const int s = (col - S5Q) >> 4, cp = (col - S5Q) & 15;
            if (s <= t) { v0 = Kt[(t - s) * 256 + c * 16 + cp]; v1 = Kt[(t - s) * 256 + c * 16 + cp + 1]; } else { v0 = 0.f; v1 = 0.f; } }
        btt[e] = pk2(v0, v1);
    }
    unsigned* btw = (unsigned*)(F.ws + WS_BTW) + (size_t)g * 128 * 128;
    for (int e = tid; e < 128 * 128; e += 512) {
        const int q = e >> 7, cpair = e & 127, col = 2 * cpair, s = col >> 4, cp = col & 15, p = q >> 1, k = 15 - s;
        const float pr = Pre[k * 64 + p], pi = Pim[k * 64 + p];
        float v0, v1;
        if (q & 1) { v0 = pr * Bim[p * 16 + cp] + pi * Bre[p * 16 + cp]; v1 = pr * Bim[p * 16 + cp + 1] + pi * Bre[p * 16 + cp + 1]; }
        else { v0 = pr * Bre[p * 16 + cp] - pi * Bim[p * 16 + cp]; v1 = pr * Bre[p * 16 + cp + 1] - pi * Bim[p * 16 + cp + 1]; }
        btw[e] = pk2(v0, v1);
    }
    if (tid < 64) { float* l16 = (float*)(F.ws + SM_LAM16) + (g * 64 + tid) * 2; l16[0] = Pre[16 * 64 + tid]; l16[1] = Pim[16 * 64 + tid]; }
    __syncthreads();
}

struct In { const float* p[30]; };

__device__ __forceinline__ void p0_prologue(const Frame& F, const In& I) {
    for (int g = F.vcu; g < S5G; g += F.G) s5_tables(F, g, I.p[3], I.p[4], I.p[5], I.p[6], I.p[7], I.p[8], I.p[9], I.p[10]);
    const int gt = F.vcu * 512 + F.tid, NGT = F.G * 512;
    { float* lc = (float*)(F.ws + SM_LRUC); for (int i = gt; i < LRUW; i += NGT) { const float lam = I.p[18][i]; lc[i] = -8.0f * log1pf(expf(-lam)) * 1.44269504f; } }
    { bf16* wrt = (bf16*)(F.ws + SM_WRT);
        for (int i = gt; i < 2 * 65536; i += NGT) { const int which = i >> 16, r = i & 65535, h = r >> 12, j = (r >> 6) & 63, k = r & 63; const float* src = which ? I.p[16] : I.p[14]; wrt[i] = (bf16)f2bf(src[(h * 64 + k) * 64 + j]); } }
    { bf16* rhi = (bf16*)(F.ws + SM_RHI); bf16* rlo = (bf16*)(F.ws + SM_RLO);
        for (int i = gt; i < NROUT * 1024; i += NGT) { const int n = i >> 10, k = i & 1023; float w = 0.f; if (n < 4) w = I.p[22][k * 4 + n]; else if (n < 36) w = I.p[24][k * 32 + (n - 4)];
            const unsigned h = f2bf(w); rhi[i] = (bf16)h; rlo[i] = (bf16)f2bf(w - bf2f(h)); } }
    LAS float* scr = (LAS float*)(F.lds + F.wave * 16384);
    const int gw = F.vcu * NWAVES + F.wave, NGW = F.G * NWAVES;
    constexpr int I_S5 = (S5W / 64) * (2 * D / 32), I_LRU = (D / 64) * (D / 32), I_O = I_LRU;
    constexpr int NITEMS = I_S5 + I_LRU + I_O;
    for (int it = gw; it < NITEMS; it += NGW) {
        int r = it; TItem ti;
        if (r < I_S5) { const int nb = 2 * D / 32, kb = r / nb, n0 = 32 * (r % nb); ti = TItem{I.p[11], 2 * D, (bf16*)(F.ws + WS_WS5), S5W, 64 * kb, n0, n0 < D ? ileave_row(n0, 0) : ileave_row(n0 - D, 1)}; }
        else if ((r -= I_S5) < I_LRU) { const int nb = D / 32, kb = r / nb, n0 = 32 * (r % nb); ti = TItem{I.p[19], D, (bf16*)(F.ws + WS_WLRU), D, 64 * kb, n0, n0}; }
        else { r -= I_LRU; const int nb = D / 32, kb = r / nb, n0 = 32 * (r % nb); ti = TItem{I.p[20], D, (bf16*)(F.ws + WS_WO), D, 64 * kb, n0, n0}; }
        f32x4 tv[8]; transpose_load(ti, tv, F.lane); asm volatile("" ::: "memory"); transpose_store(ti, tv, scr, F.lane);
    }
    { const int skip = F.G > 2 * S5G ? S5G : 0;
      if (F.vcu >= skip) {
        for (int nb = F.vcu - skip; nb < NIN / 32; nb += F.G - skip) win_to_i8(F, I.p[2], nb);
        const int gw2 = (F.vcu - skip) * NWAVES + F.wave, NGW2 = (F.G - skip) * NWAVES;
        for (int m = gw2 * 4; m < T; m += NGW2 * 4) rms_rows_to_i8<4>(I.p[0] + (size_t)m * D, I.p[1], F.ws + WS_H + (size_t)m * D, (float*)(F.ws + SM_HSC) + m, F.lane); } }
}
__device__ __forceinline__ TItem expert_item(const Frame& F, const In& I, int it) {
    const int e = it >> 9, half = (it >> 8) & 1, r = it & 255, nb = DEXP / 32, kb = r / nb, n0 = 32 * (r % nb);
    return TItem{(half ? I.p[27] : I.p[26]) + (size_t)e * D * DEXP, DEXP, (bf16*)(F.ws + WS_WGU + (size_t)e * 1024 * 1024), D, 64 * kb, n0, ileave_row(n0, half)};
}
__device__ __forceinline__ TItem expert_item_d(const Frame& F, const In& I, int it) {
    const int e = it >> 8, r = it & 255, nb = D / 32, kb = r / nb, n0 = 32 * (r % nb);
    return TItem{I.p[28] + (size_t)e * DEXP * D, D, (bf16*)(F.ws + WS_WD) + (size_t)e * 1024 * DEXP, DEXP, 64 * kb, n0, n0};
}
__device__ __forceinline__ void expert_weight_copies(const Frame& F, const In& I) {
    LAS float* scr = (LAS float*)(F.lds + F.wave * 16384);
    const int gw = F.vcu * NWAVES + F.wave, NGW = F.G * NWAVES;
    constexpr int NIT = NEXP * 512;
    for (int it = 8 * NGW + gw; it < NIT; it += NGW) { const TItem t0 = expert_item(F, I, it); f32x4 v0[8]; transpose_load(t0, v0, F.lane); asm volatile("" ::: "memory"); transpose_store_fp8(t0, v0, scr, F.lane); }
}
__device__ __forceinline__ void expert_down_copies(const Frame& F, const In& I) {
    LAS float* scr = (LAS float*)(F.lds + F.wave * 16384);
    const int nunits = (int)F.MISC[128] * 4, rem = nunits % F.G, nbusy = rem;
    const int nfree = F.G - nbusy;
    if (F.vcu < nbusy) return;
    const int gw = (F.vcu - nbusy) * NWAVES + F.wave, NGW = nfree * NWAVES;
    constexpr int NIT = NEXP * 256;
    for (int it = gw; it < NIT; it += 2 * NGW) {
        const TItem t0 = expert_item_d(F, I, it); const bool has1 = it + NGW < NIT; const TItem t1 = expert_item_d(F, I, has1 ? it + NGW : it);
        f32x4 v0[8], v1[8]; transpose_load(t0, v0, F.lane); transpose_load(t1, v1, F.lane); asm volatile("" ::: "memory");
        transpose_store(t0, v0, scr, F.lane); if (has1) transpose_store(t1, v1, scr, F.lane);
    }
}

__device__ __forceinline__ void lru_seq(const Frame& F, const In& I) {
    LAS unsigned char* wl = F.lds + F.wave * 17920;
    LAS bf16* xcA = (LAS bf16*)wl;
    LAS float* pre = (LAS float*)(wl + 9216);
    typedef float f32x2 __attribute__((ext_vector_type(2)));
    LAS f32x2* sumT = (LAS f32x2*)(F.lds + 143360);
    const int lane = F.lane, jj = lane & 15, ks = lane >> 4, c32 = lane & 31, th = lane >> 5;
    const bf16* XL = (const bf16*)(F.ws + WS_XL); const bf16* GL = (const bf16*)(F.ws + WS_GL); bf16* YL = (bf16*)(F.ws + WS_H);
    const bf16* WRT = (const bf16*)(F.ws + SM_WRT);
    for (int un = F.vcu; un < BATCH * LRUH * 2; un += F.G) {
        const int b = un >> 5, hd = (un >> 1) & 15, half = un & 1;
        const int chin = hd * 64 + lane;
        const int chg = hd * 64 + 32 * half + c32;
        const float w0 = I.p[12][chin], w1 = I.p[12][1024 + chin], w2 = I.p[12][2048 + chin], w3 = I.p[12][3072 + chin], cb = I.p[13][chin];
        const float brs = I.p[15][chg] * -1.44269504f, bis = I.p[17][chg] * -1.44269504f, cch2 = ((const float*)(F.ws + SM_LRUC))[chg];
        float Rc = 0.f;
        for (int rd = 0; rd < 8; ++rd) {
            const int j = rd * 8 + F.wave;
            const size_t tok0 = (size_t)b * SEQ + (size_t)j * LRUCH;
            unsigned short xr[64], xh[3];
            { const bf16* xp = XL + tok0 * 1024 + chin;
              xh[0] = 0; xh[1] = 0; xh[2] = 0;
              if (j > 0) { xh[0] = xp[-3 * 1024]; xh[1] = xp[-2 * 1024]; xh[2] = xp[-1 * 1024]; }
#pragma unroll
              for (int t = 0; t < 64; ++t) xr[t] = xp[t * 1024]; }
            asm volatile("" ::: "memory");
            { typedef float f2v __attribute__((ext_vector_type(2)));
              float xm3 = bf2f(xh[0]), xm2 = bf2f(xh[1]), xm1 = bf2f(xh[2]);
              const f2v vw0 = {w0, w0}, vw1 = {w1, w1}, vw2 = {w2, w2}, vw3 = {w3, w3}, vcb = {cb, cb};
#pragma unroll
              for (int t = 0; t < 64; t += 2) { const float x0 = bf2f(xr[t]), x1 = bf2f(xr[t + 1]);
                  f2v xc = vcb + vw0 * (f2v){xm3, xm2}; xc = xc + vw1 * (f2v){xm2, xm1}; xc = xc + vw2 * (f2v){xm1, x0}; xc = xc + vw3 * (f2v){x0, x1};
                  const unsigned pk = pg8::cvt_pk_bf16(xc.x, xc.y);
                  xcA[t * 72 + lane] = (bf16)(pk & 0xffffu); xcA[(t + 1) * 72 + lane] = (bf16)(pk >> 16);
                  xm3 = xm1; xm2 = x0; xm1 = x1; } }
            LDS_WAIT();
            float hl[2][16], Pl[2][16], Prun[2], Hrun[2];
#pragma unroll
            for (int st = 0; st < 2; ++st) {
                bf16x8 Bw[4][2];
#pragma unroll
                for (int n = 0; n < 4; ++n)
#pragma unroll
                    for (int k = 0; k < 2; ++k) Bw[n][k] = *(const bf16x8*)(WRT + (size_t)(n >> 1) * 65536 + (size_t)(hd * 64 + 32 * half + 16 * (n & 1) + jj) * 64 + 32 * k + 8 * ks);
#pragma unroll
                for (int mh = 0; mh < 2; ++mh) { const int mt = 2 * st + mh;
                    bf16x8 a[2];
#pragma unroll
                    for (int k = 0; k < 2; ++k) a[k] = *(const LAS bf16x8*)(xcA + (16 * mt + jj) * 72 + 32 * k + 8 * ks);
#pragma unroll
                    for (int n = 0; n < 4; ++n) { f32x4 d = (f32x4){0.f, 0.f, 0.f, 0.f};
#pragma unroll
                        for (int k = 0; k < 2; ++k) d = __builtin_amdgcn_mfma_f32_16x16x32_bf16(a[k], Bw[n][k], d, 0, 0, 0);
#pragma unroll
                        for (int r = 0; r < 4; ++r) pre[(16 * mh + 4 * ks + r) * 68 + 16 * n + jj] = d[r]; } }
                LDS_WAIT();
                float h = 0.f, P = 1.f;
                typedef float f2v __attribute__((ext_vector_type(2)));
#pragma unroll
                for (int tl = 0; tl < 16; tl += 2) {
                    const int trow = 16 * th + tl;
                    const f2v pr = {pre[trow * 68 + c32], pre[(trow + 1) * 68 + c32]}, pi = {pre[trow * 68 + 32 + c32], pre[(trow + 1) * 68 + 32 + c32]};
                    const f2v zr = pr * (f2v){-1.44269504f, -1.44269504f} + (f2v){brs, brs}, zi = pi * (f2v){-1.44269504f, -1.44269504f} + (f2v){bis, bis};
                    const f2v er = {__builtin_amdgcn_exp2f(zr.x), __builtin_amdgcn_exp2f(zr.y)}, ei = {__builtin_amdgcn_exp2f(zi.x), __builtin_amdgcn_exp2f(zi.y)};
                    const f2v dr = er + (f2v){1.f, 1.f};
                    const f2v rg = {__builtin_amdgcn_rcpf(dr.x), __builtin_amdgcn_rcpf(dr.y)};
                    const f2v la2 = rg * (f2v){cch2, cch2};
                    const f2v a_ = {__builtin_amdgcn_exp2f(la2.x), __builtin_amdgcn_exp2f(la2.y)};
                    const f2v x2 = la2 * (f2v){1.38629436f, 1.38629436f};
                    f2v q = x2 * (f2v){0.0013888889f, 0.0013888889f} + (f2v){0.0083333333f, 0.0083333333f};
                    q = q * x2 + (f2v){0.041666667f, 0.041666667f}; q = q * x2 + (f2v){0.16666667f, 0.16666667f}; q = q * x2 + (f2v){0.5f, 0.5f}; q = q * x2 + (f2v){1.f, 1.f};
                    f2v om = -(q * x2);
                    const f2v alt = (f2v){1.f, 1.f} - a_ * a_;
                    om.x = x2.x > -0.3f ? om.x : alt.x; om.y = x2.y > -0.3f ? om.y : alt.y;
                    om.x = fmaxf(om.x, 1e-30f); om.y = fmaxf(om.y, 1e-30f);
                    const f2v dd = ei + (f2v){1.f, 1.f};
                    const f2v rq = om * dd * dd;
                    const f2v mi = om * (f2v){__builtin_amdgcn_rsqf(rq.x), __builtin_amdgcn_rsqf(rq.y)};
                    const f2v bx = mi * (f2v){bf2f(xcA[(32 * st + trow) * 72 + 32 * half + c32]), bf2f(xcA[(32 * st + trow + 1) * 72 + 32 * half + c32])};
                    h = a_.x * h + bx.x; P *= a_.x; hl[st][tl] = h; Pl[st][tl] = P;
                    h = a_.y * h + bx.y; P *= a_.y; hl[st][tl + 1] = h; Pl[st][tl + 1] = P;
                }
                Prun[st] = P; Hrun[st] = h;
                LDS_WAIT();
            }
            const float pP0 = __shfl_xor(Prun[0], 32), pH0 = __shfl_xor(Hrun[0], 32), pP1 = __shfl_xor(Prun[1], 32), pH1 = __shfl_xor(Hrun[1], 32);
            const float P0 = th ? pP0 : Prun[0], H0 = th ? pH0 : Hrun[0], P1 = th ? Prun[0] : pP0, H1 = th ? Hrun[0] : pH0;
            const float P2 = th ? pP1 : Prun[1], H2 = th ? pH1 : Hrun[1], P3 = th ? Prun[1] : pP1, H3 = th ? Hrun[1] : pH1;
            const float C1 = H0, Q1 = P0, C2 = P1 * C1 + H1, Q2 = P1 * Q1, C3 = P2 * C2 + H2, Q3 = P2 * Q2, Hc = P3 * C3 + H3, Pc = P3 * Q3;
            const float Cs0 = th ? C1 : 0.f, Qs0 = th ? Q1 : 1.f, Cs1 = th ? C3 : C2, Qs1 = th ? Q3 : Q2;
            const int cit = (rd * F.G + F.vcu) * NWAVES + F.wave; const bool cdo = cit < NEXP * 512;
            f32x4 ctv[8]; unsigned short ggr[2][16];
            if (cdo) { const TItem citem = expert_item(F, I, cit); transpose_load(citem, ctv, lane); }
#pragma unroll
            for (int st = 0; st < 2; ++st)
#pragma unroll
                for (int tl = 0; tl < 16; ++tl) ggr[st][tl] = GL[(tok0 + 32 * st + 16 * th + tl) * 1024 + chg];
            asm volatile("" ::: "memory");
            if (th == 0) sumT[((rd & 1) * 8 + F.wave) * 32 + c32] = (f32x2){Pc, Hc};
            LDS_WAIT();
            __syncthreads();
            float cin = Rc, mycin = 0.f;
#pragma unroll
            for (int w = 0; w < 8; ++w) { const f32x2 ph = sumT[((rd & 1) * 8 + w) * 32 + c32]; mycin = (w == F.wave) ? cin : mycin; cin = ph.x * cin + ph.y; }
            Rc = cin;
#pragma unroll
            for (int st = 0; st < 2; ++st) { const float hin = (st ? Cs1 : Cs0) + (st ? Qs1 : Qs0) * mycin;
#pragma unroll
                for (int tl = 0; tl < 16; ++tl) { const float hh = hl[st][tl] + Pl[st][tl] * hin;
                    YL[(tok0 + 32 * st + 16 * th + tl) * 1024 + chg] = (bf16)f2bf(hh * bf2f(ggr[st][tl])); } }
            if (cdo) { const TItem citem = expert_item(F, I, cit); transpose_store_fp8(citem, ctv, pre, lane); }
        }
        __syncthreads();
    }
}

__device__ __forceinline__ void s5_chain(const Frame& F, int b, int g) {
    typedef float f32x2 __attribute__((ext_vector_type(2)));
    LAS f32x2* segE = (LAS f32x2*)(F.lds);
    const int lane = F.lane, w = F.wave;
    const float* SLOC = (const float*)(F.ws + WS_SLOC); unsigned* AGw = (unsigned*)(F.ws + WS_AG); const float* L16 = (const float*)(F.ws + SM_LAM16);
    const float lr = L16[(g * 64 + lane) * 2], li = L16[(g * 64 + lane) * 2 + 1];
    const float* sl = SLOC + ((size_t)(g * S5N + b * S5NCH + 32 * w)) * S5Q + 2 * lane;
    unsigned* ag = AGw + ((size_t)(g * S5N + b * S5NCH + 32 * w)) * (S5K / 2) + lane;
    float xr[32], xi[32];
#pragma unroll
    for (int u = 0; u < 32; ++u) { const float2 v = *(const float2*)(sl + (size_t)u * S5Q); xr[u] = v.x; xi[u] = v.y; }
    asm volatile("" ::: "memory");
    float sr = 0.f, si = 0.f;
#pragma unroll
    for (int u = 0; u < 32; ++u) { const float nr = lr * sr - li * si + xr[u], ni = lr * si + li * sr + xi[u]; xr[u] = sr; xi[u] = si; sr = nr; si = ni; }
    segE[w * 64 + lane] = (f32x2){sr, si};
    float qr = lr, qi = li;
#pragma unroll
    for (int k = 0; k < 5; ++k) { const float nr = qr * qr - qi * qi, ni = 2.f * qr * qi; qr = nr; qi = ni; }
    LDS_WAIT();
    __syncthreads();
    float cr = 0.f, ci = 0.f;
    for (int ww = 0; ww < w; ++ww) { const f32x2 e = segE[ww * 64 + lane]; const float nr = qr * cr - qi * ci + e.x, ni = qr * ci + qi * cr + e.y; cr = nr; ci = ni; }
#pragma unroll
    for (int u = 0; u < 32; ++u) { ag[(size_t)u * (S5K / 2)] = pk2(xr[u] + cr, xi[u] + ci); const float nr = lr * cr - li * ci, ni = lr * ci + li * cr; cr = nr; ci = ni; }
    __syncthreads();
}

__device__ __forceinline__ void p8_router(const Frame& F, const In& I) {
    const int lane = F.lane, tk = lane & 15, ks = lane >> 4;
    LAS float* lg = (LAS float*)(F.lds + F.wave * 4096);
    volatile LAS unsigned* cntL = F.MISC + 32; volatile LAS unsigned* baseL = F.MISC + 64;
    const float* X1 = I.p[0]; unsigned char* H2 = F.ws + WS_H2; const float* gf = I.p[21];
    const unsigned char* D8 = (const unsigned char*)(F.ws + WS_D8); const float* DSC = (const float*)(F.ws + WS_DSC);
    const bf16* RHI = (const bf16*)(F.ws + SM_RHI); const bf16* RLO = (const bf16*)(F.ws + SM_RLO);
    float* RSTD = (float*)(F.ws + SM_RSTD); unsigned* gcnt = F.ctl + CW_CNT;
    int* LTOK = (int*)(F.ws + WS_LTOK); float* LW = (float*)(F.ws + WS_LW); int* TOKE = (int*)(F.ws + WS_TOKE); int* TOKR = (int*)(F.ws + WS_TOKR);
    for (int blk = F.vcu; blk < T / 128; blk += F.G) {
        if (F.tid < 32) cntL[F.tid] = 0u;
        __syncthreads();
        const int tok0 = blk * 128 + F.wave * 16;
        const float* xrow = X1 + (size_t)(tok0 + tk) * D + 8 * ks; unsigned char* hrow = H2 + (size_t)(tok0 + tk) * D + 8 * ks;
        f32x4 acc[3]; acc[0] = acc[1] = acc[2] = (f32x4){0.f, 0.f, 0.f, 0.f}; float ss = 0.f;
        const unsigned char* drow = D8 + (size_t)(tok0 + tk) * D + 8 * ks; const float* dsc = DSC + (size_t)(tok0 + tk) * 16;
        f32x4 xnx[4][2]; v2u dnx[4]; float snx[2];
#pragma unroll
        for (int q = 0; q < 4; ++q) { xnx[q][0] = __builtin_nontemporal_load((const f32x4*)(xrow + 32 * q)); xnx[q][1] = __builtin_nontemporal_load((const f32x4*)(xrow + 32 * q + 4)); dnx[q] = *(const v2u*)(drow + 32 * q); }
        snx[0] = dsc[0]; snx[1] = dsc[4];
        LAS bf16* slab = (LAS bf16*)(F.lds + 32768);
        v4u wst[3];
#define RT_SLAB_LOAD(g) do { _Pragma("unroll") for (int j = 0; j < 3; ++j) { const int c = F.tid + 512 * j, which = c / 768, r = (c % 768) >> 4, kq = c & 15; \
            wst[j] = *(const v4u*)((which ? RLO : RHI) + (size_t)r * D + 128 * (g) + 8 * kq); } } while (0)
#define RT_SLAB_STORE(buf) do { _Pragma("unroll") for (int j = 0; j < 3; ++j) { const int c = F.tid + 512 * j, which = c / 768, r = (c % 768) >> 4, kq = c & 15; \
            *(LAS v4u*)(slab + ((size_t)((buf) * 2 + which) * 48 + r) * 136 + 8 * kq) = wst[j]; } } while (0)
        RT_SLAB_LOAD(0); RT_SLAB_STORE(0);
        LDS_WAIT();
        __syncthreads();
        for (int kg = 0; kg < 8; ++kg) {
            f32x4 xa[4][2];
#pragma unroll
            for (int q = 0; q < 4; ++q) { const float sq = snx[q >> 1]; const v2u dq = dnx[q];
                xa[q][0] = xnx[q][0] + (f32x4){(float)((int)(dq.x << 24) >> 24), (float)((int)(dq.x << 16) >> 24), (float)((int)(dq.x << 8) >> 24), (float)((int)dq.x >> 24)} * sq;
                xa[q][1] = xnx[q][1] + (f32x4){(float)((int)(dq.y << 24) >> 24), (float)((int)(dq.y << 16) >> 24), (float)((int)(dq.y << 8) >> 24), (float)((int)dq.y >> 24)} * sq; }
            { const int kgn = kg < 7 ? kg + 1 : kg;
#pragma unroll
              for (int q = 0; q < 4; ++q) { xnx[q][0] = __builtin_nontemporal_load((const f32x4*)(xrow + 32 * (4 * kgn + q))); xnx[q][1] = __builtin_nontemporal_load((const f32x4*)(xrow + 32 * (4 * kgn + q) + 4)); dnx[q] = *(const v2u*)(drow + 32 * (4 * kgn + q)); }
              { const int G0 = 2 * kgn, G1 = 2 * kgn + 1; snx[0] = dsc[(G0 & 3) * 4 + (G0 >> 2)]; snx[1] = dsc[(G1 & 3) * 4 + (G1 >> 2)]; }
              RT_SLAB_LOAD(kgn); }
            f32x4 ga[4][2];
#pragma unroll
            for (int q = 0; q < 4; ++q) { const int kc = 4 * kg + q; ga[q][0] = *(const f32x4*)(gf + 32 * kc + 8 * ks); ga[q][1] = *(const f32x4*)(gf + 32 * kc + 8 * ks + 4); }
            asm volatile("" ::: "memory");
            const LAS bf16* sh = slab + (size_t)((kg & 1) * 2) * 48 * 136, * sl = sh + 48 * 136;
#pragma unroll
            for (int q = 0; q < 4; ++q) { const int kc = 4 * kg + q;
                const f32x4 a0 = xa[q][0], a1 = xa[q][1];
                ss += (a0.x * a0.x + a0.y * a0.y) + (a0.z * a0.z + a0.w * a0.w) + (a1.x * a1.x + a1.y * a1.y) + (a1.z * a1.z + a1.w * a1.w);
                const f32x4 v0 = a0 * ga[q][0], v1 = a1 * ga[q][1];
                v4u hi, lo;
                hi.x = pg8::cvt_pk_bf16(v0.x, v0.y); hi.y = pg8::cvt_pk_bf16(v0.z, v0.w); hi.z = pg8::cvt_pk_bf16(v1.x, v1.y); hi.w = pg8::cvt_pk_bf16(v1.z, v1.w);
                lo.x = pg8::cvt_pk_bf16(v0.x - bflo(hi.x), v0.y - bfhi(hi.x)); lo.y = pg8::cvt_pk_bf16(v0.z - bflo(hi.y), v0.w - bfhi(hi.y));
                lo.z = pg8::cvt_pk_bf16(v1.x - bflo(hi.z), v1.y - bfhi(hi.z)); lo.w = pg8::cvt_pk_bf16(v1.z - bflo(hi.w), v1.w - bfhi(hi.w));
                { v2u h8; h8.x = pk_fp8x4(v0.x, v0.y, v0.z, v0.w); h8.y = pk_fp8x4(v1.x, v1.y, v1.z, v1.w); *(v2u*)(hrow + 32 * kc) = h8; }
                const bf16x8 hf = __builtin_bit_cast(bf16x8, hi), lf = __builtin_bit_cast(bf16x8, lo);
#pragma unroll
                for (int n = 0; n < 3; ++n) {
                    const bf16x8 wh = *(const LAS bf16x8*)(sh + (16 * n + tk) * 136 + 32 * q + 8 * ks), wl = *(const LAS bf16x8*)(sl + (16 * n + tk) * 136 + 32 * q + 8 * ks);
                    acc[n] = __builtin_amdgcn_mfma_f32_16x16x32_bf16(wh, hf, acc[n], 0, 0, 0);
                    acc[n] = __builtin_amdgcn_mfma_f32_16x16x32_bf16(wh, lf, acc[n], 0, 0, 0);
                    acc[n] = __builtin_amdgcn_mfma_f32_16x16x32_bf16(wl, hf, acc[n], 0, 0, 0);
                } }
            if (kg < 7) RT_SLAB_STORE((kg + 1) & 1);
            LDS_WAIT();
            __syncthreads();
        }
#undef RT_SLAB_LOAD
#undef RT_SLAB_STORE
        ss += __shfl_xor(ss, 16); ss += __shfl_xor(ss, 32);
        const float rstd = 1.0f / sqrtf(ss * (1.f / D) + RMS_EPS);
        if (ks == 0) RSTD[tok0 + tk] = rstd;
#pragma unroll
        for (int n = 0; n < 3; ++n)
#pragma unroll
            for (int r = 0; r < 4; ++r) lg[tk * 49 + 16 * n + 4 * ks + r] = acc[n][r] * rstd;
        LDS_WAIT();
        int E1 = 0, E2 = 0; float w1 = 0.f, w2 = 0.f; unsigned r1 = 0, r2 = 0;
        if (lane < 16) {
            const LAS float* my = lg + lane * 49;
            float lgp[4];
#pragma unroll
            for (int i = 0; i < 4; ++i) lgp[i] = my[i] + I.p[23][i];
            int gi = 0; float mx = lgp[0];
#pragma unroll
            for (int i = 1; i < 4; ++i) if (lgp[i] > mx) { mx = lgp[i]; gi = i; }
            float den = 0.f;
#pragma unroll
            for (int i = 0; i < 4; ++i) den += expf(lgp[i] - mx);
            const float pg = 1.0f / den;
            float le[8];
#pragma unroll
            for (int i = 0; i < 8; ++i) le[i] = my[4 + gi * 8 + i] + I.p[25][gi * 8 + i];
            int i1 = 0; float m1 = le[0];
#pragma unroll
            for (int i = 1; i < 8; ++i) if (le[i] > m1) { m1 = le[i]; i1 = i; }
            int i2 = -1; float m2 = -3.0e38f;
#pragma unroll
            for (int i = 0; i < 8; ++i) if (i != i1 && le[i] > m2) { m2 = le[i]; i2 = i; }
            const float e2 = expf(m2 - m1);
            w1 = pg / (1.0f + e2); w2 = pg * e2 / (1.0f + e2);
            E1 = gi * 8 + i1; E2 = gi * 8 + i2;
            r1 = __hip_atomic_fetch_add((LAS unsigned*)(F.MISC + 32) + E1, 1u, __ATOMIC_RELAXED, __HIP_MEMORY_SCOPE_WORKGROUP);
            r2 = __hip_atomic_fetch_add((LAS unsigned*)(F.MISC + 32) + E2, 1u, __ATOMIC_RELAXED, __HIP_MEMORY_SCOPE_WORKGROUP);
        }
        LDS_WAIT();
        __syncthreads();
        if (F.tid < 32) { const unsigned c = cntL[F.tid]; baseL[F.tid] = c ? __hip_atomic_fetch_add(gcnt + F.tid, c, __ATOMIC_RELAXED, __HIP_MEMORY_SCOPE_AGENT) : 0u; }
        __syncthreads();
        if (lane < 16) {
            const int tok = tok0 + lane; const int k1 = (int)(baseL[E1] + r1), k2 = (int)(baseL[E2] + r2);
            LTOK[(size_t)E1 * T + k1] = tok; LW[(size_t)E1 * T + k1] = w1; LTOK[(size_t)E2 * T + k2] = tok; LW[(size_t)E2 * T + k2] = w2;
            TOKE[tok * 2] = E1; TOKE[tok * 2 + 1] = E2; TOKR[tok * 2] = k1; TOKR[tok * 2 + 1] = k2;
        }
        __syncthreads();
    }
}

__device__ __forceinline__ void moe_prefix(const Frame& F) {
    if (F.tid < 64) {
        const unsigned nt = F.tid < NEXP ? (F.ctl[CW_CNT + F.tid] + 255u) >> 8 : 0u; unsigned inc = nt;
#pragma unroll
        for (int o = 1; o < 32; o <<= 1) { const unsigned v = __shfl_up(inc, o); if (F.lane >= o) inc += v; }
        if (F.tid < NEXP) F.MISC[96 + F.tid] = inc - nt;
        if (F.tid == NEXP - 1) F.MISC[128] = inc;
    }
    LDS_WAIT();
    __syncthreads();
}
template <int MODE  >
__device__ __forceinline__ void moe_setup(const Frame& F) {
    moe_prefix(F);
    const int NT = (int)F.MISC[128];
    if (F.tid < MAXU) { const int L = F.tid * F.G + F.vcu; int e = -1, mt = 0;
        if (L < NT * 4) { const int mtg = L >> 2; e = 0; while (e < NEXP - 1 && (int)F.MISC[96 + e + 1] <= mtg) ++e; mt = mtg - (int)F.MISC[96 + e]; }
        F.MISC[136 + F.tid] = (unsigned)e; F.MISC[144 + F.tid] = (unsigned)mt; }
    __syncthreads();
    if (F.tid == 0) { int n = 0; while (n < MAXU && (int)F.MISC[136 + n] >= 0) ++n; F.MISC[152] = (unsigned)n; }
    __syncthreads();
    const int nU = (int)F.MISC[152];
    LAS int* tokL = (LAS int*)(F.lds + TOKL_OFF); LAS float* sclL = (LAS float*)(F.lds + SCLL_OFF);
    const int* LTOK = (const int*)(F.ws + WS_LTOK); const float* LW = (const float*)(F.ws + WS_LW); const float* RSTD = (const float*)(F.ws + SM_RSTD);
    for (int i = F.tid; i < nU * 256; i += 512) { const int ui = i >> 8, r = i & 255, e = (int)F.MISC[136 + ui], rank = (int)F.MISC[144 + ui] * 256 + r; const bool valid = rank < (int)F.ctl[CW_CNT + e];
        const int tok = valid ? LTOK[(size_t)e * T + rank] : 0; tokL[i] = tok; sclL[i] = valid ? (MODE == 0 ? RSTD[tok] : LW[(size_t)e * T + rank]) : 0.f; }
    LDS_WAIT(); VM_WAIT();
    __syncthreads();
}

__device__ __forceinline__ void p11_final(const Frame& F, const In& I, float* dst) {
    moe_prefix(F);
    const int gw = F.vcu * NWAVES + F.wave, NGW = F.G * NWAVES, lane = F.lane;
    const int* TOKE = (const int*)(F.ws + WS_TOKE); const int* TOKR = (const int*)(F.ws + WS_TOKR);
    const unsigned char* YS8 = (const unsigned char*)(F.ws + WS_YS); const float* YSC = (const float*)(F.ws + WS_YS + 80 * MiB);
    const unsigned char* D8 = (const unsigned char*)(F.ws + WS_D8); const float* DSC = (const float*)(F.ws + WS_DSC); const float* X = I.p[0];
    f32x4 gfin[4];
#pragma unroll
    for (int j = 0; j < 4; ++j) gfin[j] = ((const f32x4*)I.p[29])[lane + 64 * j];
    int ee[2][2], rr[2][2];
    { const int m0 = gw * 2 < T ? gw * 2 : 0;
#pragma unroll
      for (int q = 0; q < 2; ++q) { ee[q][0] = TOKE[2 * (m0 + q)]; ee[q][1] = TOKE[2 * (m0 + q) + 1]; rr[q][0] = TOKR[2 * (m0 + q)]; rr[q][1] = TOKR[2 * (m0 + q) + 1]; } }
    for (int m0 = gw * 2; m0 < T; m0 += NGW * 2) {
        f32x4 xv[2][4]; unsigned ya[2][4], yb[2][4], yd[2][4]; f32x4 sa[2], sb[2], sd[2];
#pragma unroll
        for (int q = 0; q < 2; ++q) { const size_t s0 = (size_t)F.MISC[96 + ee[q][0]] * 256 + rr[q][0], s1 = (size_t)F.MISC[96 + ee[q][1]] * 256 + rr[q][1];
            const f32x4* xr = (const f32x4*)(X + (size_t)(m0 + q) * D) + lane; const unsigned* y0 = (const unsigned*)(YS8 + s0 * 1024) + lane; const unsigned* y1 = (const unsigned*)(YS8 + s1 * 1024) + lane;
            const unsigned* d0 = (const unsigned*)(D8 + (size_t)(m0 + q) * 1024) + lane;
#pragma unroll
            for (int j = 0; j < 4; ++j) { xv[q][j] = __builtin_nontemporal_load(xr + 64 * j); ya[q][j] = y0[64 * j]; yb[q][j] = y1[64 * j]; yd[q][j] = d0[64 * j]; }
            sa[q] = *(const f32x4*)(YSC + s0 * 16 + 4 * (lane >> 4)); sb[q] = *(const f32x4*)(YSC + s1 * 16 + 4 * (lane >> 4)); sd[q] = *(const f32x4*)(DSC + (size_t)(m0 + q) * 16 + 4 * (lane >> 4)); }
        { const int mn = m0 + NGW * 2 < T ? m0 + NGW * 2 : m0;
#pragma unroll
          for (int q = 0; q < 2; ++q) { ee[q][0] = TOKE[2 * (mn + q)]; ee[q][1] = TOKE[2 * (mn + q) + 1]; rr[q][0] = TOKR[2 * (mn + q)]; rr[q][1] = TOKR[2 * (mn + q) + 1]; } }
        asm volatile("" ::: "memory");
#pragma unroll
        for (int q = 0; q < 2; ++q) { f32x4 v[4]; float s = 0.f;
#pragma unroll
            for (int j = 0; j < 4; ++j) { const f32x4 x = xv[q][j]; const unsigned a = ya[q][j], b = yb[q][j], c = yd[q][j]; const float ka = sa[q][j], kb = sb[q][j], kc = sd[q][j];
                v[j].x = (x.x + (float)((int)(c << 24) >> 24) * kc) + (float)((int)(a << 24) >> 24) * ka + (float)((int)(b << 24) >> 24) * kb;
                v[j].y = (x.y + (float)((int)(c << 16) >> 24) * kc) + (float)((int)(a << 16) >> 24) * ka + (float)((int)(b << 16) >> 24) * kb;
                v[j].z = (x.z + (float)((int)(c << 8) >> 24) * kc) + (float)((int)(a << 8) >> 24) * ka + (float)((int)(b << 8) >> 24) * kb;
                v[j].w = (x.w + (float)((int)c >> 24) * kc) + (float)((int)a >> 24) * ka + (float)((int)b >> 24) * kb;
                s += (v[j].x * v[j].x + v[j].y * v[j].y) + (v[j].z * v[j].z + v[j].w * v[j].w); }
            const float rstd = 1.0f / sqrtf(wave_sum(s) * (1.f / D) + RMS_EPS);
            f32x4* xw = (f32x4*)(dst + (size_t)(m0 + q) * D) + lane;
#pragma unroll
            for (int j = 0; j < 4; ++j) { const f32x4 g = gfin[j]; __builtin_nontemporal_store((f32x4){v[j].x * rstd * g.x, v[j].y * rstd * g.y, v[j].z * rstd * g.z, v[j].w * rstd * g.w}, xw + 64 * j); } }
    }
}

constexpr int N_PHASES = 12;
struct Args { In in; float* out; unsigned char* ws; float* fin_dst; int ph_lo, ph_hi, li, pad; };
__global__ void __launch_bounds__(NWAVES * 64, 2) mk_fwd(Args args) {
    extern __shared__ __attribute__((aligned(16))) unsigned char lds[];
    Frame F;
    F.lds = (LAS unsigned char*)lds;
    F.MISC = (volatile LAS unsigned*)(F.lds + MISC_OFF);
    F.tid = threadIdx.x; F.lane = F.tid & 63; F.wave = __builtin_amdgcn_readfirstlane(F.tid >> 6);
    F.G = gridDim.x; { const int bx = blockIdx.x; F.vcu = (F.G % 8 == 0) ? (bx % 8) * (F.G / 8) + bx / 8 : bx; }
    F.ws = args.ws; F.out = args.out; F.ctl = (unsigned*)(args.ws + WS_CTL); F.in = nullptr;
    const In& I = args.in;
    for (int u = F.tid; u < 256; u += NWAVES * 64) F.MISC[u] = 0u;
    __syncthreads();
    const int lo = args.ph_lo, hi = args.ph_hi;
    XcdBarrier bar; bar.bar = F.ctl + CW_BAR + args.li * XCD_BAR_WORDS; bar.x = 0; bar.st = nullptr;
    if (hi - lo > 1) bar = xcd_barrier_post(F.ctl + CW_BAR + args.li * XCD_BAR_WORDS, F.MISC + 8);
#ifndef PH_MASK
#define PH_MASK 0xFFF
#endif
#define IN(k) (((PH_MASK >> (k)) & 1) && lo <= (k) && (k) < hi)
#define SEAM(k) do { if (IN(k) && IN(NEXT_PH(k))) xcd_barrier(bar); } while (0)
#define NEXT_PH(k) ((k) == 2 ? 5 : (k) == 5 ? 7 : (k) + 1)
    const int cblk = (int)blockIdx.x;
    LAS unsigned char* ring = F.lds;

    if (IN(0)) { p0_prologue(F, I); SEAM(0); }

    if (IN(1)) {
        DenseOrder S; S.init(F.ws + WS_H, F.ws + WS_WIN, D / 2, D / 2, T, NIN, F.G, cblk);
        EpiInProj E{(bf16*)(F.ws + WS_AG), (bf16*)(F.ws + WS_XL), (bf16*)(F.ws + WS_GL), (bf16*)(F.ws + WS_GA), (bf16*)(F.ws + WS_GB), (const float*)(F.ws + SM_HSC), (const float*)(F.ws + SM_WSC), F.lds + TOKL_OFF};
        pg8::gemm_phase<EpiInProj, DenseOrder, true>(ring, D / 2, D / 2, S, E);
        SEAM(1);
    }
    if (IN(2)) {
        if (cblk < 256) {
            const int L = cblk, wgid = (L % 8) * 32 + L / 8, g = wgid >> 3, mt = wgid & 7;
            { S5One S{(const char*)(F.ws + WS_AG) + S5Q * 2, (const char*)(F.ws + WS_BTW), (size_t)S5N * S5K * 2, (size_t)128 * 256 * 2, S5K, g, mt};
              EpiS5State E{(float*)(F.ws + WS_SLOC)};
              pg8::gemm_phase<EpiS5State, S5One, false>(ring, 256, 256, S, E); }
            if (F.wave == 0) { __builtin_amdgcn_fence(__ATOMIC_ACQUIRE, "agent"); VM_WAIT(); }
            __syncthreads();
            s5_chain(F, mt, g);
            VM_WAIT();
            __syncthreads();
            if (F.wave == 0) { __builtin_amdgcn_fence(__ATOMIC_ACQUIRE, "agent"); VM_WAIT(); }
            __syncthreads();
            { S5One S{(const char*)(F.ws + WS_AG), (const char*)(F.ws + WS_BTT), (size_t)S5N * S5K * 2, (size_t)256 * S5K * 2, S5K, g, mt};
              EpiS5Out E{(bf16*)(F.ws + WS_GY)};
              pg8::gemm_phase<EpiS5Out, S5One, false>(ring, S5K, S5K, S, E); }
            __syncthreads();
        }
        lru_seq(F, I);
        SEAM(2);
    }
    if (IN(5)) {
        YaYbOrder S; S.d.init(nullptr, nullptr, D, D, T, D, F.G, cblk);
        S.GYb = (const char*)(F.ws + WS_GY); S.WS5b = (const char*)(F.ws + WS_WS5); S.YLb = (const char*)(F.ws + WS_H); S.WLb = (const char*)(F.ws + WS_WLRU);
        EpiYaYb E{EpiYa{(const bf16*)(F.ws + WS_GA), (bf16*)(F.ws + WS_XL)}, EpiYb{(const bf16*)(F.ws + WS_XL), (const bf16*)(F.ws + WS_GB), (bf16*)(F.ws + WS_GL)}};
        pg8::gemm_phase<EpiYaYb, YaYbOrder, true>(ring, D, D, S, E);
        SEAM(5);
    }
    if (IN(7)) {
        DenseOrder S; S.init(F.ws + WS_GL, F.ws + WS_WO, D, D, T, D, F.G, cblk);
        EpiQ8<false> E{(unsigned char*)(F.ws + WS_D8), (float*)(F.ws + WS_DSC), nullptr};
        pg8::gemm_phase<EpiQ8<false>, DenseOrder, true>(ring, D, D, S, E);
        SEAM(7);
    }
    if (IN(8)) { p8_router(F, I); __syncthreads(); expert_weight_copies(F, I); SEAM(8); }
    if (IN(9)) {
        moe_setup<0>(F);
        MoeOrder<true> S{(const char*)(F.ws + WS_H2), (const char*)(F.ws + WS_WGU), (size_t)1024 * 1024, D / 2, D / 2, F.G, F.vcu, F.MISC, (const LAS int*)(F.lds + TOKL_OFF)};
        EpiGU E{(bf16*)(F.ws + WS_ACT), (const LAS float*)(F.lds + SCLL_OFF)};
        pg8::gemm_phase<EpiGU, MoeOrder<true>, true>(ring, D / 2, D / 2, S, E);
        __syncthreads();
        expert_down_copies(F, I);
        SEAM(9);
    }
    if (IN(10)) {
        moe_setup<1>(F);
        MoeOrder<false> S{(const char*)(F.ws + WS_ACT), (const char*)(F.ws + WS_WD), (size_t)1024 * DEXP * 2, DEXP, DEXP, F.G, F.vcu, F.MISC, (const LAS int*)(F.lds + TOKL_OFF)};
        EpiQ8<true> E{(unsigned char*)(F.ws + WS_YS), (float*)(F.ws + WS_YS + 80 * MiB), (const LAS float*)(F.lds + SCLL_OFF)};
        pg8::gemm_phase<EpiQ8<true>, MoeOrder<false>, true>(ring, DEXP, DEXP, S, E);
        SEAM(10);
    }
    if (IN(11)) { p11_final(F, I, args.fin_dst); }
#undef IN
#undef SEAM
}

extern "C" void kernel_launch(void* const* d_in, const int* in_sizes, int n_in, void* d_out, int out_size, void* d_ws, size_t ws_size, hipStream_t stream) {
    static int grid = 0;
    if (grid == 0) {
        if (n_in != 30 || in_sizes[0] != T * D || out_size != T * D || ws_size < WS_END) { fprintf(stderr, "kernel_launch: unexpected shapes / workspace (n_in %d, ws %zu)\n", n_in, ws_size); grid = -1; return; }
        int dev = 0, cus = 0, per_cu = 0;
        if (hipGetDevice(&dev) != hipSuccess || hipDeviceGetAttribute(&cus, hipDeviceAttributeMultiprocessorCount, dev) != hipSuccess) { grid = -1; return; }
        if (hipFuncSetAttribute((const void*)mk_fwd, hipFuncAttributeMaxDynamicSharedMemorySize, LDS_BYTES) != hipSuccess) { fprintf(stderr, "kernel_launch: hipFuncSetAttribute failed\n"); grid = -1; return; }
        if (hipOccupancyMaxActiveBlocksPerMultiprocessor(&per_cu, (const void*)mk_fwd, NWAVES * 64, LDS_BYTES) != hipSuccess || per_cu < 1) { fprintf(stderr, "kernel_launch: occupancy query says %d\n", per_cu); }
        (void)hipGetLastError();
        grid = cus;
    }
    if (grid < 0) return;
    if (hipMemsetAsync((char*)d_ws + WS_CTL, 0, CTL_ZERO_BYTES, stream) != hipSuccess) return;
    Args a{};
    for (int i = 0; i < 30; ++i) a.in.p[i] = (const float*)d_in[i];
    a.out = (float*)d_out; a.ws = (unsigned char*)d_ws; a.fin_dst = (float*)d_out;
#if defined(PROBE_LO)
    a.ph_lo = 0; a.ph_hi = PROBE_HI; a.li = 0;
#if PROBE_LO == 11
    a.fin_dst = (float*)((char*)d_ws + WS_H2);
#endif
    hipLaunchKernelGGL(mk_fwd, dim3(grid), dim3(NWAVES * 64), LDS_BYTES, stream, a);
#if PROBE_LO == 8
    hipMemsetAsync((char*)d_ws + WS_CTL + CW_CNT * 4, 0, 128, stream);
#endif
    a.fin_dst = (float*)d_out;
    a.ph_lo = PROBE_LO; a.ph_hi = N_PHASES; a.li = 1;
    hipLaunchKernelGGL(mk_fwd, dim3(grid), dim3(NWAVES * 64), LDS_BYTES, stream, a);
#elif MK_N_LAUNCHES == 1
    a.ph_lo = 0; a.ph_hi = N_PHASES;
    hipLaunchKernelGGL(mk_fwd, dim3(grid), dim3(NWAVES * 64), LDS_BYTES, stream, a);
#else
    for (int p = 0; p < N_PHASES; ++p) { a.ph_lo = p; a.ph_hi = p + 1; hipLaunchKernelGGL(mk_fwd, dim3(grid), dim3(NWAVES * 64), LDS_BYTES, stream, a); }
#endif
}
```

```cpp
#include <hip/hip_runtime.h>
#include <cstdio>
#include <cstdint>

#ifndef MK_N_LAUNCHES
#define MK_N_LAUNCHES 1
#endif

namespace pg8 {
#define PG8_LAS __attribute__((address_space(3)))
typedef unsigned short bf16_t;
typedef short bf16x8 __attribute__((ext_vector_type(8)));
typedef float f32x4 __attribute__((ext_vector_type(4)));
typedef unsigned u32x4 __attribute__((ext_vector_type(4)));
typedef int i32x4 __attribute__((ext_vector_type(4)));
template <class E, class = void> struct epi_i8 { static constexpr bool v = false; };
template <class E> struct epi_i8<E, decltype((void)E::I8)> { static constexpr bool v = E::I8; };
template <class E, class = void> struct epi_f8 { static constexpr bool v = false; };
template <class E> struct epi_f8<E, decltype((void)E::F8)> { static constexpr bool v = E::F8; };
typedef int i32x8 __attribute__((ext_vector_type(8)));
template <bool I8> struct acc_sel { typedef f32x4 t; };
template <> struct acc_sel<true> { typedef i32x4 t; };
constexpr int BM = 256, BK = 64, HALF = 128, HTB = HALF * BK * 2  , STAGE_BYTES = 8 * HTB, NXCD = 8, WGM = 8;

__host__ __device__ __forceinline__ int lds_byte(int r, int c) { const int st = (r >> 4) * 2 + (c >> 5), rr = r & 15, cc = c & 31, ob = rr * 64 + cc * 2; return st * 1024 + (ob ^ (((ob >> 9) & 1) << 5)); }
__host__ __device__ __forceinline__ void stage_rc(int b, int& R, int& C) { const int st = b / 1024, sb = b % 1024, swz = sb ^ (((sb >> 9) & 1) << 5); R = (st >> 1) * 16 + swz / 64; C = (st & 1) * 32 + (swz % 64) / 2; }
__host__ __device__ __forceinline__ int perm32(int rho) { const int n = rho >> 4, i = rho & 15; return 8 * (i >> 2) + 4 * n + (i & 3); }

struct Unit { const char* A; const char* B; int pm, pn, aux, nt, kind; unsigned kA; };

__device__ __forceinline__ unsigned cvt_pk_bf16(float lo, float hi) { unsigned r; asm volatile("v_cvt_pk_bf16_f32 %0, %1, %2" : "=v"(r) : "v"(lo), "v"(hi)); return r; }

template <class Epi, class Sched, bool ALIGN_EPI>
__device__ __forceinline__ void gemm_phase(PG8_LAS unsigned char* lds, const int ldb, const int K, const Sched& S, const Epi& E, const size_t kstepA = (size_t)(BK * 2)) {
    const int tid = threadIdx.x, wid = __builtin_amdgcn_readfirstlane(tid >> 6), lane = tid & 63, wr = wid >> 2, wc = wid & 3, fr = lane & 15, fq = lane >> 4;
    constexpr bool I8 = epi_i8<Epi>::v, F8 = epi_f8<Epi>::v; typedef typename acc_sel<I8>::t acc_t;
    int nt = K / BK; asm volatile("" : "+s"(nt));
    int Rr[2], Cc[2], Rbb[2]; unsigned voffB[4], vAc[4], vAn[4];
#pragma unroll
    for (int i = 0; i < 2; ++i) { int R, C; stage_rc(tid * 16 + i * 8192, R, C); Rr[i] = R; Cc[i] = C; const int Rb = Epi::PERM ? ((R & ~31) + perm32(R & 31)) : R; Rbb[i] = Rb;
        int Rb0 = Rb, Rb1 = HALF + Rb;
        if constexpr (Epi::B16) {
            const int w_ = R >> 5, nn_ = (R >> 4) & 1, ii_ = R & 15; Rb0 = 64 * w_ + 16 * (ii_ >> 2) + 4 * nn_ + (ii_ & 3); Rb1 = Rb0 + 8; }
        voffB[i] = (unsigned)(Rb0 * ldb + C) * 2u; voffB[2 + i] = (unsigned)(Rb1 * ldb + C) * 2u; }
    const size_t kstep = (size_t)(BK * 2);
    const unsigned ldsw = (unsigned)wid * 1024u;
    const int aoff = lds_byte(wr * 64 + fr, fq * 8), boff = lds_byte(wc * 32 + fr, fq * 8);
#define PG8_SA(b, h) (((b) * 2 + (h)) * HTB)
#define PG8_SB(b, h) ((4 + (b) * 2 + (h)) * HTB)
#define PG8_STAGE(bufoff, gbase, voff, h) do { _Pragma("unroll") for (int _i = 0; _i < 2; ++_i) \
        __builtin_amdgcn_global_load_lds((const unsigned*)((const char*)(gbase) + (voff)[2 * (h) + _i]), (PG8_LAS unsigned*)(lds + (bufoff) + ldsw + _i * 8192), 16, 0, 0); } while (0)
#define PG8_LDA(dst, b, h) do { _Pragma("unroll") for (int m = 0; m < 4; ++m) _Pragma("unroll") for (int k = 0; k < 2; ++k) dst[m][k] = *(const PG8_LAS bf16x8*)(lds + PG8_SA(b, h) + aoff + m * 2048 + k * 1024); } while (0)
#define PG8_LDB(dst, b, h) do { _Pragma("unroll") for (int n = 0; n < 2; ++n) _Pragma("unroll") for (int k = 0; k < 2; ++k) dst[n][k] = *(const PG8_LAS bf16x8*)(lds + PG8_SB(b, h) + boff + n * 2048 + k * 1024); } while (0)
#define PG8_MMA(ai, bj, At, Bt) do { __builtin_amdgcn_s_setprio(1); _Pragma("unroll") for (int m = 0; m < 4; ++m) _Pragma("unroll") for (int n = 0; n < 2; ++n) { \
        if constexpr (F8) { const i32x4 b0_ = __builtin_bit_cast(i32x4, Bt[n][0]), b1_ = __builtin_bit_cast(i32x4, Bt[n][1]), a0_ = __builtin_bit_cast(i32x4, At[m][0]), a1_ = __builtin_bit_cast(i32x4, At[m][1]); \
            acc[ai][bj][m][n] = __builtin_amdgcn_mfma_scale_f32_16x16x128_f8f6f4((i32x8){b0_[0], b0_[1], b0_[2], b0_[3], b1_[0], b1_[1], b1_[2], b1_[3]}, (i32x8){a0_[0], a0_[1], a0_[2], a0_[3], a1_[0], a1_[1], a1_[2], a1_[3]}, acc[ai][bj][m][n], 0, 0, 0, 0, 0, 0); } \
        else { _Pragma("unroll") for (int k = 0; k < 2; ++k) { \
          if constexpr (I8) acc[ai][bj][m][n] = __builtin_amdgcn_mfma_i32_16x16x64_i8(__builtin_bit_cast(i32x4, Bt[n][k]), __builtin_bit_cast(i32x4, At[m][k]), acc[ai][bj][m][n], 0, 0, 0); \
          else acc[ai][bj][m][n] = __builtin_amdgcn_mfma_f32_16x16x32_bf16(Bt[n][k], At[m][k], acc[ai][bj][m][n], 0, 0, 0); } } } __builtin_amdgcn_s_setprio(0); } while (0)
#define PG8_WAIT_V(n) asm volatile("s_waitcnt vmcnt(" #n ")" ::: "memory")
#define PG8_WAIT_L(n) asm volatile("s_waitcnt lgkmcnt(" #n ")" ::: "memory")
#define PG8_BAR __builtin_amdgcn_s_barrier()
#define PG8_SCHED __builtin_amdgcn_sched_barrier(0)
    Unit cur, nxt; int ui = 0;
    if (!S.next(0, cur)) return;
    S.a_offsets(cur, Rr, Cc, vAc);
    unsigned vBc[4], vBn[4];
    if constexpr (Sched::HETERO) { S.b_offsets(cur, Rbb, Cc, vBc); nt = __builtin_amdgcn_readfirstlane(cur.nt); }
    else {
#pragma unroll
        for (int q = 0; q < 4; ++q) vBc[q] = voffB[q]; }
    size_t kAc = Sched::HETERO ? (size_t)(unsigned)__builtin_amdgcn_readfirstlane((int)cur.kA) : kstepA;
    acc_t acc[2][2][4][2];
    if constexpr (Epi::ACC_INIT) E.init(acc, cur, wr, wc, fr, fq);
    else {
#pragma unroll
    for (int a = 0; a < 2; ++a)
#pragma unroll
        for (int b = 0; b < 2; ++b)
#pragma unroll
            for (int m = 0; m < 4; ++m)
#pragma unroll
                for (int n = 0; n < 2; ++n) acc[a][b][m][n] = acc_t{}; }
    bf16x8 At[4][2], B0[2][2], B1[2][2];
    const char* cA = cur.A; const char* cB = cur.B;
    if constexpr (Sched::GATHER) { PG8_WAIT_L(0); }
    PG8_STAGE(PG8_SB(0, 0), cB, vBc, 0); PG8_STAGE(PG8_SB(0, 1), cB, vBc, 1); PG8_STAGE(PG8_SA(0, 0), cA, vAc, 0); PG8_STAGE(PG8_SA(0, 1), cA, vAc, 1);
    if (wr == 1) PG8_BAR;
    PG8_WAIT_V(2); PG8_BAR;
    PG8_STAGE(PG8_SB(1, 0), cB + kstep, vBc, 0); PG8_STAGE(PG8_SA(1, 0), cA + kAc, vAc, 0); PG8_STAGE(PG8_SB(1, 1), cB + kstep, vBc, 1);
    PG8_WAIT_V(6); PG8_BAR;
    for (;;) {
        const bool has_next = S.next(ui + 1, nxt);
        const char* nA = has_next ? nxt.A : cA; const char* nB = has_next ? nxt.B : cB;
        size_t kAn = kAc;
        if constexpr (Sched::HETERO) { if (has_next) { S.b_offsets(nxt, Rbb, Cc, vBn); kAn = (size_t)(unsigned)__builtin_amdgcn_readfirstlane((int)nxt.kA); } else {
#pragma unroll
                for (int q = 0; q < 4; ++q) vBn[q] = vBc[q]; } }
        for (int t = 0; t < nt; t += 2) {
            const bool last = (t == nt - 2);
            const char* a1 = cA + (size_t)(t + 1) * kAc;
            const char* a2 = last ? nA : cA + (size_t)(t + 2) * kAc; const char* b2 = last ? nB : cB + (size_t)(t + 2) * kstep;
            const char* a3 = a2 + (last ? kAn : kAc); const char* b3 = b2 + kstep;
            unsigned vb2[4];
#pragma unroll
            for (int q = 0; q < 4; ++q) vb2[q] = (Sched::HETERO && last) ? vBn[q] : vBc[q];
            unsigned va2[4];
            if constexpr (Sched::GATHER || Sched::HETERO) {
                if (last) { if (has_next) { S.a_offsets(nxt, Rr, Cc, vAn); if constexpr (Sched::GATHER) { PG8_WAIT_L(0); } } else {
#pragma unroll
                        for (int q = 0; q < 4; ++q) vAn[q] = vAc[q]; } }
#pragma unroll
                for (int q = 0; q < 4; ++q) va2[q] = last ? vAn[q] : vAc[q];
            } else {
#pragma unroll
                for (int q = 0; q < 4; ++q) va2[q] = vAc[q];
            }
            PG8_LDB(B0, 0, 0); PG8_LDB(B1, 0, 1); PG8_SCHED; PG8_LDA(At, 0, 0); PG8_STAGE(PG8_SA(1, 1), a1, vAc, 1);
            PG8_WAIT_V(8); PG8_WAIT_L(0); PG8_BAR; PG8_MMA(0, 0, At, B0); PG8_MMA(0, 1, At, B1); PG8_BAR; PG8_SCHED;
            const bool fin = last && !has_next;
            PG8_LDA(At, 0, 1);
            if (!fin) { PG8_STAGE(PG8_SB(0, 0), b2, vb2, 0); PG8_STAGE(PG8_SB(0, 1), b2, vb2, 1); PG8_STAGE(PG8_SA(0, 0), a2, va2, 0); PG8_WAIT_V(8); } else { PG8_WAIT_V(0); }
            PG8_WAIT_L(0); PG8_BAR; PG8_MMA(1, 0, At, B0); PG8_MMA(1, 1, At, B1); PG8_BAR; PG8_SCHED;
            PG8_LDB(B0, 1, 0); PG8_LDB(B1, 1, 1); PG8_SCHED; PG8_LDA(At, 1, 0);
            if (!fin) { PG8_STAGE(PG8_SA(0, 1), a2, va2, 1); PG8_WAIT_V(8); } else { PG8_WAIT_V(0); }
            PG8_WAIT_L(0); PG8_BAR; PG8_MMA(0, 0, At, B0); PG8_MMA(0, 1, At, B1); PG8_BAR; PG8_SCHED;
            PG8_LDA(At, 1, 1);
            if (!fin) { PG8_STAGE(PG8_SB(1, 0), b3, vb2, 0); PG8_STAGE(PG8_SB(1, 1), b3, vb2, 1); PG8_STAGE(PG8_SA(1, 0), a3, va2, 0); PG8_WAIT_V(8); } else { PG8_WAIT_V(0); }
            PG8_WAIT_L(0); PG8_BAR; PG8_MMA(1, 0, At, B0); PG8_MMA(1, 1, At, B1); PG8_BAR; PG8_SCHED;
        }
        if constexpr (ALIGN_EPI) { if (wr == 0) PG8_BAR; }
        E(acc, cur, wr, wc, fr, fq);
        if (!has_next) break;
        if constexpr (Epi::ACC_INIT) E.init(acc, nxt, wr, wc, fr, fq);
        else {
#pragma unroll
        for (int a = 0; a < 2; ++a)
#pragma unroll
            for (int b = 0; b < 2; ++b)
#pragma unroll
                for (int m = 0; m < 4; ++m)
#pragma unroll
                    for (int n = 0; n < 2; ++n) acc[a][b][m][n] = acc_t{}; }
        cur = nxt; cA = nA; cB = nB; ++ui;
        if constexpr (Sched::GATHER || Sched::HETERO) {
#pragma unroll
            for (int q = 0; q < 4; ++q) vAc[q] = vAn[q]; }
        if constexpr (Sched::HETERO) {
#pragma unroll
            for (int q = 0; q < 4; ++q) vBc[q] = vBn[q];
            kAc = kAn; nt = __builtin_amdgcn_readfirstlane(cur.nt); }
        if constexpr (ALIGN_EPI) { if (wr == 1) PG8_BAR; }
    }
    PG8_WAIT_V(0);
    if constexpr (!ALIGN_EPI) { if (wr == 0) PG8_BAR; }
    PG8_BAR;
#undef PG8_SA
#undef PG8_SB
#undef PG8_STAGE
#undef PG8_LDA
#undef PG8_LDB
#undef PG8_MMA
#undef PG8_WAIT_V
#undef PG8_WAIT_L
#undef PG8_BAR
#undef PG8_SCHED
}
}

constexpr int NWAVES = 8;
constexpr int BATCH = 8, SEQ = 4096, D = 1024, T = BATCH * SEQ;
constexpr int S5W = 512, S5G = 32, S5C = 16, S5P = 64, S5Q = 128;
constexpr int S5LC = 16, S5NCH = SEQ / S5LC, S5N = BATCH * S5NCH;
constexpr int S5K = S5Q + S5LC * S5C;
constexpr int LRUW = 1024, LRUH = 16, LRUHD = 64, LRUCH = 64, LRUNCH = SEQ / LRUCH;
constexpr int NIN = S5W + 2 * LRUW + 2 * D;
constexpr int NEXP = 32, EPG = 8, NGRP = 4, DEXP = 512, NROUT = 48;
constexpr int MAXSLOT = 73728;
constexpr int MAXU = 8;
constexpr float RMS_EPS = 1e-6f;

constexpr size_t MiB = 1u << 20;
constexpr size_t WS_CTL = 0, CTL_ZERO_BYTES = 128 * 1024;
constexpr size_t WS_SMALL = 1 * MiB;
constexpr size_t SM_LAM16 = WS_SMALL + 0;
constexpr size_t SM_LRUC = WS_SMALL + 16384;
constexpr size_t SM_WRT = WS_SMALL + 32768;
constexpr size_t SM_RHI = WS_SMALL + 327680;
constexpr size_t SM_RLO = SM_RHI + 98304;
constexpr size_t SM_RSTD = WS_SMALL + 524288;
constexpr size_t SM_HSC = WS_SMALL + 720896;
constexpr size_t SM_WSC = WS_SMALL + 851968;
constexpr size_t WS_BTT = 2 * MiB;
constexpr size_t WS_BTW = 8 * MiB;
constexpr size_t WS_WIN = 11 * MiB;
constexpr size_t WS_WS5 = 20 * MiB;
constexpr size_t WS_WLRU = 22 * MiB;
constexpr size_t WS_WO = 24 * MiB;
constexpr size_t WS_LP = 26 * MiB, WS_LH = 28 * MiB, WS_LHIN = 30 * MiB;
constexpr size_t WS_AG = 32 * MiB;
constexpr size_t WS_SLOC = 80 * MiB;
constexpr size_t WS_H = 112 * MiB;
constexpr size_t WS_XL = 176 * MiB;
constexpr size_t WS_GL = 240 * MiB;
constexpr size_t WS_GA = 304 * MiB, WS_GB = 336 * MiB;
constexpr size_t WS_GY = 368 * MiB;
constexpr size_t WS_D8 = 336 * MiB, WS_DSC = 368 * MiB;
constexpr size_t WS_WGU = 400 * MiB;
constexpr size_t WS_WD = 464 * MiB;
constexpr size_t WS_H2 = 32 * MiB;
constexpr size_t WS_ACT = 96 * MiB;
constexpr size_t WS_YS = 168 * MiB;
constexpr size_t WS_LTOK = 312 * MiB, WS_LW = 316 * MiB;
constexpr size_t WS_TOKE = 320 * MiB, WS_TOKR = WS_TOKE + 262144;
constexpr size_t WS_END = 496 * MiB;
static_assert(WS_YS + (size_t)MAXSLOT * 1024 * 2 <= WS_LTOK && WS_ACT + (size_t)MAXSLOT * 512 * 2 <= WS_YS && WS_TOKR + 262144 <= WS_WGU && WS_GY + (size_t)T * 512 * 2 <= WS_WGU && WS_WD + (size_t)32 * 1024 * 512 * 2 <= WS_END, "d_ws map");
constexpr int CW_BAR = 4096;
constexpr int CW_CNT = 16384;

constexpr int RING_BYTES = 131072;
constexpr int TOKL_OFF = RING_BYTES, SCLL_OFF = TOKL_OFF + MAXU * 256 * 4, MISC_OFF = SCLL_OFF + MAXU * 256 * 4;
constexpr int LDS_BYTES = MISC_OFF + 1024;

#define GAS __attribute__((address_space(1)))
#define LAS __attribute__((address_space(3)))
typedef unsigned short bf16;
typedef unsigned v4u __attribute__((ext_vector_type(4)));
typedef unsigned v2u __attribute__((ext_vector_type(2)));
typedef float f32x4 __attribute__((ext_vector_type(4)));
typedef int i32x4 __attribute__((ext_vector_type(4)));
typedef short bf16x8 __attribute__((ext_vector_type(8)));
#define LDS_WAIT() asm volatile("s_waitcnt lgkmcnt(0)" ::: "memory")
#define VM_WAIT() asm volatile("s_waitcnt vmcnt(0)" ::: "memory")
__device__ __forceinline__ unsigned pk2(float lo, float hi) { unsigned r; asm volatile("v_cvt_pk_bf16_f32 %0, %1, %2" : "=v"(r) : "v"(lo), "v"(hi)); return r; }
__device__ __forceinline__ unsigned f2bf(float f) { return pk2(f, 0.f) & 0xffffu; }
__device__ __forceinline__ float bf2f(unsigned h) { return __builtin_bit_cast(float, h << 16); }
__device__ __forceinline__ float bflo(unsigned w) { return __builtin_bit_cast(float, w << 16); }
__device__ __forceinline__ float bfhi(unsigned w) { return __builtin_bit_cast(float, w & 0xffff0000u); }
__device__ __forceinline__ float fsigmoid(float x) { return __builtin_amdgcn_rcpf(1.0f + __builtin_amdgcn_exp2f(-1.44269504f * x)); }
__device__ __forceinline__ float gelu_t(float x) { const float u = x * (0.7978845608f + 0.0356774081f * x * x); return x * __builtin_amdgcn_rcpf(1.0f + __builtin_amdgcn_exp2f(-2.88539008f * u)); }
__device__ __forceinline__ unsigned pk_fp8x4(float a, float b, float c, float d) { int w = 0; w = __builtin_amdgcn_cvt_pk_fp8_f32(a, b, w, false); w = __builtin_amdgcn_cvt_pk_fp8_f32(c, d, w, true); return (unsigned)w; }
__device__ __forceinline__ float wave_sum(float v) {
#pragma unroll
    for (int o = 1; o < 64; o <<= 1) v += __shfl_xor(v, o);
    return v;
}

#define XB_TMO      128
#define XB_XCNT(j)  (256  + 64 * (j))
#define XB_XSUB(j)  (1280 + 64 * (j))
#define XB_XGEN(j)  (2304 + 64 * (j))
#define XB_TOP      3328
#define XB_TOPGEN   3392
#define XCD_BAR_WORDS 3456
#define XB_SPIN_CAP (1u << 18)
__device__ __forceinline__ unsigned xb_ld(unsigned* p)              { return __hip_atomic_load(p, __ATOMIC_RELAXED, __HIP_MEMORY_SCOPE_AGENT); }
__device__ __forceinline__ unsigned xb_add(unsigned* p, unsigned v) { return __hip_atomic_fetch_add(p, v, __ATOMIC_RELAXED, __HIP_MEMORY_SCOPE_AGENT); }
__device__ __forceinline__ unsigned xb_xcc_id() { return (unsigned)__builtin_amdgcn_s_getreg((3 << 11) | 20) & 0xFu; }
#define XB_SPIN(cond, bar) do { unsigned _sp = 0; while (cond) { __builtin_amdgcn_s_sleep(1); \
    if ((++_sp & 255u) == 0u) { if (xb_ld(&(bar)[XB_TMO])) break; if (_sp > XB_SPIN_CAP) { atomicAdd(&(bar)[XB_TMO], 1u); break; } } } } while (0)
struct XcdBarrier { unsigned* bar; unsigned x; volatile LAS unsigned* st; };
__device__ __forceinline__ XcdBarrier xcd_barrier_post(unsigned* bar, volatile LAS unsigned* st) {
    XcdBarrier b; b.bar = bar; b.x = xb_xcc_id(); b.st = st;
    if (threadIdx.x == 0) (void)xb_add(&bar[XB_XCNT(b.x)], 1u);
    return b;
}
__device__ __forceinline__ void xcd_barrier_complete(unsigned* bar, unsigned x, unsigned& nloc, unsigned& nx) {
    const unsigned G = gridDim.x * gridDim.y * gridDim.z;
    unsigned sum, cnt, mine, sp = 0u;
    for (;;) {
        sum = 0u; cnt = 0u; mine = 0u;
#pragma unroll
        for (unsigned j = 0; j < 16; ++j) { const unsigned c = xb_ld(&bar[XB_XCNT(j)]); sum += c; cnt += (c > 0u) ? 1u : 0u; mine = (j == x) ? c : mine; }
        if (sum == G) break;
        __builtin_amdgcn_s_sleep(1);
        if ((++sp & 255u) == 0u) { if (xb_ld(&bar[XB_TMO])) break; if (sp > XB_SPIN_CAP) { atomicAdd(&bar[XB_TMO], 1u); break; } }
    }
    nloc = mine > 0u ? mine : 1u; nx = cnt > 0u ? cnt : 1u;
}
__device__ __forceinline__ void xcd_barrier(const XcdBarrier& b) {
    asm volatile("s_waitcnt vmcnt(0)" ::: "memory");
    __syncthreads();
    if (threadIdx.x == 0) {
        unsigned* bar = b.bar;
        __builtin_amdgcn_s_waitcnt(0);
        unsigned nloc = b.st[0], nx = b.st[1];
        if (nloc == 0u) { xcd_barrier_complete(bar, b.x, nloc, nx); b.st[0] = nloc; b.st[1] = nx; }
        const unsigned old = xb_add(&bar[XB_XSUB(b.x)], 1u);
        const unsigned gen = old / nloc;
        if (old + 1u == (gen + 1u) * nloc) {
            __builtin_amdgcn_fence(__ATOMIC_RELEASE, "agent");
            asm volatile("s_waitcnt vmcnt(0)" ::: "memory");
            const unsigned og = xb_add(&bar[XB_TOP], 1u);
            const unsigned tg = og / nx;
            if (og + 1u == (tg + 1u) * nx) xb_add(&bar[XB_TOPGEN], 1u);
            else XB_SPIN(xb_ld(&bar[XB_TOPGEN]) == tg, bar);
            __builtin_amdgcn_fence(__ATOMIC_ACQUIRE, "agent");
            xb_add(&bar[XB_XGEN(b.x)], 1u);
            asm volatile("s_waitcnt vmcnt(0)" ::: "memory");
        } else {
            XB_SPIN(xb_ld(&bar[XB_XGEN(b.x)]) == gen, bar);
            __builtin_amdgcn_fence(__ATOMIC_ACQUIRE, "agent");
            asm volatile("s_waitcnt vmcnt(0)" ::: "memory");
        }
    }
    __syncthreads();
}

struct Frame {
    LAS unsigned char* lds;
    volatile LAS unsigned* MISC;
    unsigned* ctl;
    int tid, lane, wave, vcu, G;
    const float* const* in;
    unsigned char* ws; float* out;
};

using pg8::Unit;
struct DenseOrder {
    static constexpr bool GATHER = false, HETERO = false;
    const char* A0; const char* B0; int lda, ldb, nM, nN, nwg, G, c;
    __device__ __forceinline__ void init(const void* A, const void* B, int lda_, int ldb_, int M, int N, int G_, int c_) { A0 = (const char*)A; B0 = (const char*)B; lda = lda_; ldb = ldb_; nM = M / 256; nN = N / 256; nwg = nM * nN; G = G_; c = c_; }
    __device__ __forceinline__ bool next(int i, Unit& u) const {
        const long L = (long)i * G + c; if (L >= nwg) return false;
        int wgid = (int)L; { const int q = nwg / 8, r = nwg % 8, xcd = wgid % 8, off = wgid / 8; wgid = (xcd < r ? xcd * (q + 1) : r * (q + 1) + (xcd - r) * q) + off; }
        const int nig = 8 * nN, gid = wgid / nig, fm = gid * 8, gsz = (nM - fm) < 8 ? (nM - fm) : 8;
        u.pm = fm + ((wgid % nig) % gsz); u.pn = (wgid % nig) / gsz; u.aux = i & 1;
        u.A = A0 + (size_t)u.pm * 256 * lda * 2; u.B = B0 + (size_t)u.pn * 256 * ldb * 2; return true;
    }
    __device__ __forceinline__ void a_offsets(const Unit&, const int (&R)[2], const int (&C)[2], unsigned (&v)[4]) const {
#pragma unroll
        for (int i = 0; i < 2; ++i) { v[i] = (unsigned)(R[i] * lda + C[i]) * 2u; v[2 + i] = (unsigned)((128 + R[i]) * lda + C[i]) * 2u; }
    }
};
struct S5One {
    static constexpr bool GATHER = false, HETERO = false;
    const char* A0; const char* B0; size_t sA, sB; int lda, g, mt;
    __device__ __forceinline__ bool next(int i, Unit& u) const {
        if (i > 0) return false;
        u.pm = mt; u.pn = 0; u.aux = g; u.A = A0 + (size_t)g * sA + (size_t)mt * 256 * lda * 2; u.B = B0 + (size_t)g * sB; return true;
    }
    __device__ __forceinline__ void a_offsets(const Unit&, const int (&R)[2], const int (&C)[2], unsigned (&v)[4]) const {
#pragma unroll
        for (int i = 0; i < 2; ++i) { v[i] = (unsigned)(R[i] * lda + C[i]) * 2u; v[2 + i] = (unsigned)((128 + R[i]) * lda + C[i]) * 2u; }
    }
};
struct GyOrder {
    static constexpr bool GATHER = false, HETERO = false;
    DenseOrder d;
    __device__ __forceinline__ bool next(int i, Unit& u) const { if (!d.next(i, u)) return false; u.A = d.A0 + (size_t)u.pm * 256 * 32; return true; }
    __device__ __forceinline__ void a_offsets(const Unit&, const int (&R)[2], const int (&C)[2], unsigned (&v)[4]) const {
#pragma unroll
        for (int i = 0; i < 2; ++i) { const unsigned o = (unsigned)(C[i] >> 4) * (unsigned)(T * 32) + (unsigned)(C[i] & 15) * 2u; v[i] = (unsigned)R[i] * 32u + o; v[2 + i] = (unsigned)(128 + R[i]) * 32u + o; }
    }
};
struct YaYbOrder {
    static constexpr bool GATHER = false, HETERO = true;
    DenseOrder d;
    const char* GYb; const char* WS5b; const char* YLb; const char* WLb;
    __device__ __forceinline__ bool next(int i, Unit& u) const {
        const int j = i / 3, r = i - 3 * j; Unit t;
        if (!d.next(j, t)) return false;
        u.pm = t.pm; u.aux = 0;
        if (r < 2) { u.kind = 0; u.pn = 2 * t.pn + r; u.nt = S5W / 64; u.kA = (unsigned)(4 * T * 32); u.A = GYb + (size_t)t.pm * 256 * 32; u.B = WS5b + (size_t)u.pn * 256 * S5W * 2; }
        else { u.kind = 1; u.pn = t.pn; u.nt = D / 64; u.kA = 128u; u.A = YLb + (size_t)t.pm * 256 * D * 2; u.B = WLb + (size_t)t.pn * 256 * D * 2; }
        return true;
    }
    __device__ __forceinline__ void a_offsets(const Unit& u, const int (&R)[2], const int (&C)[2], unsigned (&v)[4]) const {
#pragma unroll
        for (int i = 0; i < 2; ++i) {
            const unsigned og = (unsigned)(C[i] >> 4) * (unsigned)(T * 32) + (unsigned)(C[i] & 15) * 2u;
            const unsigned g0 = (unsigned)R[i] * 32u + og, g1 = (unsigned)(128 + R[i]) * 32u + og;
            const unsigned d0 = (unsigned)(R[i] * D + C[i]) * 2u, d1 = (unsigned)((128 + R[i]) * D + C[i]) * 2u;
            v[i] = u.kind ? d0 : g0; v[2 + i] = u.kind ? d1 : g1; }
    }
    __device__ __forceinline__ void b_offsets(const Unit& u, const int (&Rb)[2], const int (&C)[2], unsigned (&v)[4]) const {
        const int ldb = u.kind ? D : S5W;
#pragma unroll
        for (int i = 0; i < 2; ++i) { v[i] = (unsigned)(Rb[i] * ldb + C[i]) * 2u; v[2 + i] = (unsigned)((128 + Rb[i]) * ldb + C[i]) * 2u; }
    }
};
template <bool GATH> struct MoeOrder {
    static constexpr bool GATHER = GATH, HETERO = false;
    const char* A0; const char* B0; size_t sBe; int lda, ldb, G, c; volatile LAS unsigned* MISC; const LAS int* tokL;
    __device__ __forceinline__ bool next(int i, Unit& u) const {
        if (i >= (int)MISC[152]) return false;
        const int e = (int)MISC[136 + i], mtg = (int)MISC[96 + e] + (int)MISC[144 + i], L = i * G + c;
        u.pm = mtg; u.pn = L & 3; u.aux = i;
        u.A = GATH ? A0 : A0 + (size_t)mtg * 256 * lda * 2; u.B = B0 + (size_t)e * sBe + (size_t)u.pn * 256 * ldb * 2; return true;
    }
    __device__ __forceinline__ void a_offsets(const Unit& u, const int (&R)[2], const int (&C)[2], unsigned (&v)[4]) const {
#pragma unroll
        for (int i = 0; i < 2; ++i) {
            if constexpr (GATH) { v[i] = (unsigned)tokL[u.aux * 256 + R[i]] * (unsigned)(lda * 2) + (unsigned)C[i] * 2u; v[2 + i] = (unsigned)tokL[u.aux * 256 + 128 + R[i]] * (unsigned)(lda * 2) + (unsigned)C[i] * 2u; }
            else { v[i] = (unsigned)(R[i] * lda + C[i]) * 2u; v[2 + i] = (unsigned)((128 + R[i]) * lda + C[i]) * 2u; } }
    }
};

using pg8::cvt_pk_bf16;
template <int ACT> __device__ __forceinline__ float actf(float x) { if (ACT == 1) return gelu_t(x); if (ACT == 2) return fsigmoid(x); return x; }
__device__ __forceinline__ v4u pack8(const f32x4 a, const f32x4 b) { v4u w; w.x = cvt_pk_bf16(a[0], a[1]); w.y = cvt_pk_bf16(a[2], a[3]); w.z = cvt_pk_bf16(b[0], b[1]); w.w = cvt_pk_bf16(b[2], b[3]); return w; }

__device__ __forceinline__ void unpack_u8x8(const v2u w, float (&f)[8]) {
    const float k = 1.0f / 255.0f;
    f[0] = (float)(w.x & 0xffu) * k; f[1] = (float)((w.x >> 8) & 0xffu) * k; f[2] = (float)((w.x >> 16) & 0xffu) * k; f[3] = (float)(w.x >> 24) * k;
    f[4] = (float)(w.y & 0xffu) * k; f[5] = (float)((w.y >> 8) & 0xffu) * k; f[6] = (float)((w.y >> 16) & 0xffu) * k; f[7] = (float)(w.y >> 24) * k;
}
struct EpiInProj {
    static constexpr bool PERM = true, ACC_INIT = true, B16 = false, I8 = true;
    bf16 *AG, *XL, *GL, *GA, *GB; const float* HS; const float* WSC; LAS unsigned char* sl;
    __device__ __forceinline__ void init(i32x4 (&acc)[2][2][4][2], const Unit& u, int wr, int wc, int fr, int fq) const {
#pragma unroll
        for (int a = 0; a < 2; ++a)
#pragma unroll
            for (int b = 0; b < 2; ++b)
#pragma unroll
                for (int m = 0; m < 4; ++m)
#pragma unroll
                    for (int n = 0; n < 2; ++n) acc[a][b][m][n] = i32x4{};
        const int w = wr * 4 + wc, lane = fq * 16 + fr;
        const int pm = __builtin_amdgcn_readfirstlane(u.pm), pn = __builtin_amdgcn_readfirstlane(u.pn), par = __builtin_amdgcn_readfirstlane(u.aux);
        const float* src = w < 4 ? HS + pm * 256 + w * 64 : WSC + pn * 256 + (w - 4) * 64;
        __builtin_amdgcn_global_load_lds((const unsigned*)(src + lane), (LAS unsigned*)(sl + par * 2048 + w * 256), 4, 0, 0);
    }
    template <int MODE  > __device__ __forceinline__ void tile(const i32x4 (&acc)[2][2][4][2], const Unit& u, bf16* base, int colbase, bool s5, int wr, int wc, int fr, int fq) const {
        const LAS float* sb = (const LAS float*)(sl + __builtin_amdgcn_readfirstlane(u.aux) * 2048);
        f32x4 wsv[2][2];
#pragma unroll
        for (int bj = 0; bj < 2; ++bj)
#pragma unroll
            for (int n = 0; n < 2; ++n) wsv[bj][n] = *(const LAS f32x4*)(sb + 256 + bj * 128 + wc * 32 + 8 * fq + 4 * n);
#pragma unroll
        for (int ai = 0; ai < 2; ++ai)
#pragma unroll
            for (int m = 0; m < 4; ++m) { const int rl = ai * 128 + wr * 64 + m * 16 + fr, r = u.pm * 256 + rl; const float hs = sb[rl];
#pragma unroll
                for (int bj = 0; bj < 2; ++bj) { const int cl = colbase + bj * 128 + wc * 32 + 8 * fq;
                    f32x4 v0 = __builtin_convertvector(acc[ai][bj][m][0], f32x4) * (wsv[bj][0] * hs), v1 = __builtin_convertvector(acc[ai][bj][m][1], f32x4) * (wsv[bj][1] * hs);
                    if (MODE == 2) {
                        unsigned q[8];
#pragma unroll
                        for (int j = 0; j < 4; ++j) { q[j] = (unsigned)(fsigmoid(v0[j]) * 255.0f + 0.5f); q[4 + j] = (unsigned)(fsigmoid(v1[j]) * 255.0f + 0.5f); }
                        v2u w8; w8.x = q[0] | (q[1] << 8) | (q[2] << 16) | (q[3] << 24); w8.y = q[4] | (q[5] << 8) | (q[6] << 16) | (q[7] << 24);
                        __builtin_nontemporal_store(w8, (v2u*)((unsigned char*)base + (size_t)r * 1024 + cl));
                    } else {
                        if (MODE == 1) {
#pragma unroll
                            for (int j = 0; j < 4; ++j) { v0[j] = gelu_t(v0[j]); v1[j] = gelu_t(v1[j]); } }
                        const v4u w = pack8(v0, v1);
                        const int g = cl >> 4, cp = cl & 15, b = r >> 12, l = r & 4095, n = b * S5NCH + (l >> 4), s = l & 15;
                        const size_t off = s5 ? ((size_t)(g * S5N + n) * S5K + S5Q + s * 16 + cp) : ((size_t)r * 1024 + cl);
                        __builtin_nontemporal_store(w, (v4u*)(base + off)); } }
                asm volatile("" ::: "memory"); }
    }
    __device__ __forceinline__ void operator()(const i32x4 (&acc)[2][2][4][2], const Unit& u, int wr, int wc, int fr, int fq) const {
        const int pn = u.pn, reg = pn < 2 ? 0 : ((pn - 2) >> 2) + 1;
        const int colbase = reg == 0 ? pn * 256 : ((pn - 2) & 3) * 256;
        if (reg < 2) tile<0>(acc, u, reg == 0 ? AG : XL, colbase, reg == 0, wr, wc, fr, fq);
        else if (reg == 2) tile<1>(acc, u, GL, colbase, false, wr, wc, fr, fq);
        else tile<2>(acc, u, reg == 3 ? GA : GB, colbase, false, wr, wc, fr, fq);
    }
};
struct EpiS5State {
    static constexpr bool PERM = false, ACC_INIT = false, B16 = false;
    float* SLOC;
    __device__ __forceinline__ void operator()(const f32x4 (&acc)[2][2][4][2], const Unit& u, int wr, int wc, int fr, int fq) const {
#pragma unroll
        for (int ai = 0; ai < 2; ++ai)
#pragma unroll
            for (int m = 0; m < 4; ++m) { const int nr = u.pm * 256 + ai * 128 + wr * 64 + m * 16 + fr; float* rowp = SLOC + (size_t)(u.aux * S5N + nr) * S5Q + wc * 32 + 4 * fq;
#pragma unroll
                for (int n = 0; n < 2; ++n) *(f32x4*)(rowp + n * 16) = acc[ai][0][m][n]; }
    }
};
struct EpiS5Out {
    static constexpr bool PERM = true, ACC_INIT = false, B16 = false;
    bf16* GY;
    __device__ __forceinline__ void operator()(const f32x4 (&acc)[2][2][4][2], const Unit& u, int wr, int wc, int fr, int fq) const {
#pragma unroll
        for (int ai = 0; ai < 2; ++ai)
#pragma unroll
            for (int m = 0; m < 4; ++m) { const int nr = u.pm * 256 + ai * 128 + wr * 64 + m * 16 + fr, b = nr >> 8, j16 = nr & 255;
#pragma unroll
                for (int bj = 0; bj < 2; ++bj) { const int cc = bj * 128 + wc * 32 + 8 * fq, t = cc >> 4, c0 = cc & 15;
                    f32x4 v0 = acc[ai][bj][m][0], v1 = acc[ai][bj][m][1];
#pragma unroll
                    for (int j = 0; j < 4; ++j) { v0[j] = gelu_t(v0[j]); v1[j] = gelu_t(v1[j]); }
                    *(v4u*)(GY + ((size_t)u.aux * T + (size_t)(b * SEQ + j16 * 16 + t)) * 16 + c0) = pack8(v0, v1); }
                asm volatile("" ::: "memory"); }
    }
};
struct EpiYa {
    static constexpr bool PERM = true, ACC_INIT = false, B16 = false;
    const bf16* GA; bf16* YA;
    __device__ __forceinline__ void operator()(const f32x4 (&acc)[2][2][4][2], const Unit& u, int wr, int wc, int fr, int fq) const {
        const size_t off0 = (size_t)(u.pm * 256 + wr * 64 + fr) * 1024 + u.pn * 128 + wc * 32 + 8 * fq;
        v2u gav[2][4];
#pragma unroll
        for (int ai = 0; ai < 2; ++ai)
#pragma unroll
            for (int m = 0; m < 4; ++m) gav[ai][m] = __builtin_nontemporal_load((const v2u*)((const unsigned char*)GA + off0 + (size_t)(ai * 128 + m * 16) * 1024));
        asm volatile("" ::: "memory");
#pragma unroll
        for (int ai = 0; ai < 2; ++ai)
#pragma unroll
            for (int m = 0; m < 4; ++m) { float gaf[8]; unpack_u8x8(gav[ai][m], gaf);
                f32x4 o0, o1;
#pragma unroll
                for (int j = 0; j < 4; ++j) { o0[j] = gaf[j] * acc[ai][0][m][0][j] * fsigmoid(acc[ai][1][m][0][j]); o1[j] = gaf[4 + j] * acc[ai][0][m][1][j] * fsigmoid(acc[ai][1][m][1][j]); }
                *(v4u*)(YA + off0 + (size_t)(ai * 128 + m * 16) * 1024) = pack8(o0, o1); }
    }
};
struct EpiYb {
    static constexpr bool PERM = true, ACC_INIT = false, B16 = false;
    const bf16* YA; const bf16* GB; bf16* MIX;
    __device__ __forceinline__ void operator()(const f32x4 (&acc)[2][2][4][2], const Unit& u, int wr, int wc, int fr, int fq) const {
        const size_t off0 = (size_t)(u.pm * 256 + wr * 64 + fr) * 1024 + u.pn * 256 + wc * 32 + 8 * fq;
        v2u gb[2][4][2];
#pragma unroll
        for (int ai = 0; ai < 2; ++ai)
#pragma unroll
            for (int m = 0; m < 4; ++m)
#pragma unroll
                for (int bj = 0; bj < 2; ++bj) gb[ai][m][bj] = __builtin_nontemporal_load((const v2u*)((const unsigned char*)GB + off0 + (size_t)(ai * 128 + m * 16) * 1024 + bj * 128));
        v4u ya[2][2][2];
#define YB_LOAD(buf, grp) do { _Pragma("unroll") for (int mm = 0; mm < 2; ++mm) _Pragma("unroll") for (int bj = 0; bj < 2; ++bj) { \
            const size_t o = off0 + (size_t)(((grp) >> 1) * 128 + (2 * ((grp) & 1) + mm) * 16) * 1024 + bj * 128; ya[buf][mm][bj] = *(const v4u*)(YA + o); } } while (0)
        YB_LOAD(0, 0);
#pragma unroll
        for (int grp = 0; grp < 4; ++grp) { const int buf = grp & 1, ai = grp >> 1;
            if (grp < 3) YB_LOAD(buf ^ 1, grp + 1);
            asm volatile("" ::: "memory");
#pragma unroll
            for (int mm = 0; mm < 2; ++mm) { const int m = 2 * (grp & 1) + mm;
#pragma unroll
                for (int bj = 0; bj < 2; ++bj) { const v4u y = ya[buf][mm][bj];
                    const float yaf[8] = {bflo(y.x), bfhi(y.x), bflo(y.y), bfhi(y.y), bflo(y.z), bfhi(y.z), bflo(y.w), bfhi(y.w)};
                    float gbf[8]; unpack_u8x8(gb[ai][m][bj], gbf);
                    f32x4 o0, o1;
#pragma unroll
                    for (int j = 0; j < 4; ++j) { o0[j] = yaf[j] + gbf[j] * acc[ai][bj][m][0][j]; o1[j] = yaf[4 + j] + gbf[4 + j] * acc[ai][bj][m][1][j]; }
                    *(v4u*)(MIX + off0 + (size_t)(ai * 128 + m * 16) * 1024 + bj * 128) = pack8(o0, o1); } }
        }
#undef YB_LOAD
    }
};
struct EpiYaYb {
    static constexpr bool PERM = true, ACC_INIT = false, B16 = false;
    EpiYa a; EpiYb b;
    __device__ __forceinline__ void operator()(const f32x4 (&acc)[2][2][4][2], const Unit& u, int wr, int wc, int fr, int fq) const {
        if (__builtin_amdgcn_readfirstlane(u.kind) == 0) a(acc, u, wr, wc, fr, fq); else b(acc, u, wr, wc, fr, fq);
    }
};
struct EpiWo {
    static constexpr bool PERM = false, ACC_INIT = true, B16 = false;
    const float* X; float* O;
    __device__ __forceinline__ void init(f32x4 (&acc)[2][2][4][2], const Unit& u, int wr, int wc, int fr, int fq) const {
        const size_t off0 = (size_t)(u.pm * 256 + wr * 64 + fr) * 1024 + u.pn * 256 + wc * 32 + 4 * fq;
#pragma unroll
        for (int ai = 0; ai < 2; ++ai)
#pragma unroll
            for (int m = 0; m < 4; ++m)
#pragma unroll
                for (int bj = 0; bj < 2; ++bj)
#pragma unroll
                    for (int n = 0; n < 2; ++n) acc[ai][bj][m][n] = __builtin_nontemporal_load((const f32x4*)(X + off0 + (size_t)(ai * 128 + m * 16) * 1024 + bj * 128 + n * 16));
    }
    __device__ __forceinline__ void operator()(const f32x4 (&acc)[2][2][4][2], const Unit& u, int wr, int wc, int fr, int fq) const {
        const size_t off0 = (size_t)(u.pm * 256 + wr * 64 + fr) * 1024 + u.pn * 256 + wc * 32 + 4 * fq;
#pragma unroll
        for (int ai = 0; ai < 2; ++ai)
#pragma unroll
            for (int m = 0; m < 4; ++m)
#pragma unroll
                for (int bj = 0; bj < 2; ++bj)
#pragma unroll
                    for (int n = 0; n < 2; ++n) *(f32x4*)(O + off0 + (size_t)(ai * 128 + m * 16) * 1024 + bj * 128 + n * 16) = acc[ai][bj][m][n];
    }
};
struct EpiGU {
    static constexpr bool PERM = true, ACC_INIT = false, B16 = false, F8 = true;
    unsigned char* ACT; const LAS float* sclL;
    __device__ __forceinline__ void operator()(const f32x4 (&acc)[2][2][4][2], const Unit& u, int wr, int wc, int fr, int fq) const {
#pragma unroll
        for (int ai = 0; ai < 2; ++ai)
#pragma unroll
            for (int m = 0; m < 4; ++m) { const int rl = ai * 128 + wr * 64 + m * 16 + fr; const float sc = sclL[u.aux * 256 + rl] * (1.0f / 32.0f);
                f32x4 o0, o1;
#pragma unroll
                for (int j = 0; j < 4; ++j) { const float g0 = acc[ai][0][m][0][j] * sc, g1 = acc[ai][0][m][1][j] * sc;
                    o0[j] = g0 * fsigmoid(g0) * (acc[ai][1][m][0][j] * sc); o1[j] = g1 * fsigmoid(g1) * (acc[ai][1][m][1][j] * sc); }
                v2u a8; a8.x = pk_fp8x4(o0[0], o0[1], o0[2], o0[3]); a8.y = pk_fp8x4(o1[0], o1[1], o1[2], o1[3]);
                *(v2u*)(ACT + (size_t)(u.pm * 256 + rl) * DEXP + u.pn * 128 + wc * 32 + 8 * fq) = a8; }
    }
};
struct EpiDown {
    static constexpr bool PERM = true, ACC_INIT = false, B16 = false;
    bf16* YS; const LAS float* sclL;
    __device__ __forceinline__ void operator()(const f32x4 (&acc)[2][2][4][2], const Unit& u, int wr, int wc, int fr, int fq) const {
#pragma unroll
        for (int ai = 0; ai < 2; ++ai)
#pragma unroll
            for (int m = 0; m < 4; ++m) { const int rl = ai * 128 + wr * 64 + m * 16 + fr; const float sc = sclL[u.aux * 256 + rl];
#pragma unroll
                for (int bj = 0; bj < 2; ++bj)
                    *(v4u*)(YS + (size_t)(u.pm * 256 + rl) * 1024 + u.pn * 256 + bj * 128 + wc * 32 + 8 * fq) = pack8(acc[ai][bj][m][0] * sc, acc[ai][bj][m][1] * sc); }
    }
};

template <bool SCALED> struct EpiQ8 {
    static constexpr bool PERM = true, ACC_INIT = false, B16 = true, F8 = SCALED;
    unsigned char* YS8; float* YSC; const LAS float* sclL;
    __device__ __forceinline__ void operator()(const f32x4 (&acc)[2][2][4][2], const Unit& u, int wr, int wc, int fr, int fq) const {
        float scs[2][4];
#pragma unroll
        for (int ai = 0; ai < 2; ++ai)
#pragma unroll
            for (int m = 0; m < 4; ++m) { const int rl = ai * 128 + wr * 64 + m * 16 + fr; const float sc = SCALED ? sclL[u.aux * 256 + rl] * (1.0f / 32.0f) : 1.0f;
                float v[16]; float amax = 0.f;
#pragma unroll
                for (int bj = 0; bj < 2; ++bj)
#pragma unroll
                    for (int n = 0; n < 2; ++n)
#pragma unroll
                        for (int j = 0; j < 4; ++j) { const float x = acc[ai][bj][m][n][j] * sc; v[bj * 8 + n * 4 + j] = x; amax = fmaxf(amax, fabsf(x)); }
                amax = fmaxf(amax, __shfl_xor(amax, 16)); amax = fmaxf(amax, __shfl_xor(amax, 32));
                const float inv = amax > 0.f ? 127.0f / amax : 0.f;
                scs[ai][m] = amax * (1.0f / 127.0f);
                v4u w;
#pragma unroll
                for (int d = 0; d < 4; ++d) { const int q0 = (int)__builtin_rintf(v[4 * d] * inv), q1 = (int)__builtin_rintf(v[4 * d + 1] * inv), q2 = (int)__builtin_rintf(v[4 * d + 2] * inv), q3 = (int)__builtin_rintf(v[4 * d + 3] * inv);
                    w[d] = ((unsigned)q0 & 255u) | (((unsigned)q1 & 255u) << 8) | (((unsigned)q2 & 255u) << 16) | ((unsigned)q3 << 24); }
                *(v4u*)(YS8 + (size_t)(u.pm * 256 + rl) * 1024 + u.pn * 256 + wc * 64 + fq * 16) = w; }
#pragma unroll
        for (int ai = 0; ai < 2; ++ai) { const float sv = fq == 0 ? scs[ai][0] : fq == 1 ? scs[ai][1] : fq == 2 ? scs[ai][2] : scs[ai][3];
            YSC[(size_t)(u.pm * 256 + ai * 128 + wr * 64 + fq * 16 + fr) * 16 + wc * 4 + u.pn] = sv; }
    }
};

struct TItem { const float* W; int N; bf16* WT; int ldk, k0, n0, drow0; };
__device__ __forceinline__ void transpose_load(const TItem& it, f32x4 (&tv)[8], int lane) {
#pragma unroll
    for (int i = 0; i < 8; ++i) tv[i] = __builtin_nontemporal_load((const f32x4*)(it.W + (size_t)(it.k0 + 8 * i + (lane >> 3)) * it.N + it.n0 + 4 * (lane & 7)));
}
template <bool NT = false> __device__ __forceinline__ void transpose_store(const TItem& it, const f32x4 (&tv)[8], LAS float* scr, int lane) {
#pragma unroll
    for (int i = 0; i < 8; ++i) { LAS float* d = scr + (8 * i + (lane >> 3)) * 33 + 4 * (lane & 7); d[0] = tv[i].x; d[1] = tv[i].y; d[2] = tv[i].z; d[3] = tv[i].w; }
    LDS_WAIT(); asm volatile("" ::: "memory");
    const int c = lane & 7;
#pragma unroll
    for (int j = 0; j < 4; ++j) { const int n = (lane >> 3) + 8 * j; const LAS float* s = scr + (8 * c) * 33 + n;
        v4u o; o.x = pk2(s[0 * 33], s[1 * 33]); o.y = pk2(s[2 * 33], s[3 * 33]); o.z = pk2(s[4 * 33], s[5 * 33]); o.w = pk2(s[6 * 33], s[7 * 33]);
        if (NT) __builtin_nontemporal_store(o, (v4u*)(it.WT + (size_t)(it.drow0 + n) * it.ldk + it.k0 + 8 * c)); else *(v4u*)(it.WT + (size_t)(it.drow0 + n) * it.ldk + it.k0 + 8 * c) = o; }
    LDS_WAIT(); asm volatile("" ::: "memory");
}
__device__ __forceinline__ void transpose_store_fp8(const TItem& it, const f32x4 (&tv)[8], LAS float* scr, int lane) {
#pragma unroll
    for (int i = 0; i < 8; ++i) { LAS float* d = scr + (8 * i + (lane >> 3)) * 33 + 4 * (lane & 7); d[0] = tv[i].x; d[1] = tv[i].y; d[2] = tv[i].z; d[3] = tv[i].w; }
    LDS_WAIT(); asm volatile("" ::: "memory");
    const int c = lane & 7;
#pragma unroll
    for (int j = 0; j < 4; ++j) { const int n = (lane >> 3) + 8 * j; const LAS float* s = scr + (8 * c) * 33 + n;
        v2u o; o.x = pk_fp8x4(s[0 * 33] * 32.f, s[1 * 33] * 32.f, s[2 * 33] * 32.f, s[3 * 33] * 32.f); o.y = pk_fp8x4(s[4 * 33] * 32.f, s[5 * 33] * 32.f, s[6 * 33] * 32.f, s[7 * 33] * 32.f);
        __builtin_nontemporal_store(o, (v2u*)((unsigned char*)it.WT + (size_t)(it.drow0 + n) * it.ldk + it.k0 + 8 * c)); }
    LDS_WAIT(); asm volatile("" ::: "memory");
}
__device__ __forceinline__ int ileave_row(int n, int half) { return 256 * (n >> 7) + 128 * half + (n & 127); }

template <int NR> __device__ __forceinline__ void rms_rows_to_bf16(const float* x0, const float* gain, bf16* o0, size_t rstride, int lane) {
    f32x4 v[NR][4];
#pragma unroll
    for (int r = 0; r < NR; ++r) { const f32x4* xr = (const f32x4*)(x0 + r * rstride) + lane;
#pragma unroll
        for (int j = 0; j < 4; ++j) v[r][j] = __builtin_nontemporal_load(xr + 64 * j); }
    asm volatile("" ::: "memory");
    const f32x4* gr = (const f32x4*)gain + lane;
    f32x4 g[4];
#pragma unroll
    for (int j = 0; j < 4; ++j) g[j] = gr[64 * j];
#pragma unroll
    for (int r = 0; r < NR; ++r) { float s = 0.f;
#pragma unroll
        for (int j = 0; j < 4; ++j) s += (v[r][j].x * v[r][j].x + v[r][j].y * v[r][j].y) + (v[r][j].z * v[r][j].z + v[r][j].w * v[r][j].w);
        const float rstd = 1.0f / sqrtf(wave_sum(s) * (1.f / D) + RMS_EPS);
        unsigned long long* o8 = (unsigned long long*)(o0 + r * rstride) + lane;
#pragma unroll
        for (int j = 0; j < 4; ++j) o8[64 * j] = (unsigned long long)pk2(v[r][j].x * rstd * g[j].x, v[r][j].y * rstd * g[j].y) | ((unsigned long long)pk2(v[r][j].z * rstd * g[j].z, v[r][j].w * rstd * g[j].w) << 32); }
}

__device__ __forceinline__ float wave_max(float v) {
#pragma unroll
    for (int o = 1; o < 64; o <<= 1) v = fmaxf(v, __shfl_xor(v, o));
    return v;
}
__device__ __forceinline__ unsigned pk_i8(float a, float b, float c, float d) {
    const int q0 = (int)__builtin_rintf(a), q1 = (int)__builtin_rintf(b), q2 = (int)__builtin_rintf(c), q3 = (int)__builtin_rintf(d);
    return ((unsigned)q0 & 255u) | (((unsigned)q1 & 255u) << 8) | (((unsigned)q2 & 255u) << 16) | ((unsigned)q3 << 24);
}
template <int NR> __device__ __forceinline__ void rms_rows_to_i8(const float* x0, const float* gain, unsigned char* o0, float* hs, int lane) {
    f32x4 v[NR][4];
#pragma unroll
    for (int r = 0; r < NR; ++r) { const f32x4* xr = (const f32x4*)(x0 + (size_t)r * D) + lane;
#pragma unroll
        for (int j = 0; j < 4; ++j) v[r][j] = __builtin_nontemporal_load(xr + 64 * j); }
    asm volatile("" ::: "memory");
    const f32x4* gr = (const f32x4*)gain + lane;
    f32x4 g[4];
#pragma unroll
    for (int j = 0; j < 4; ++j) g[j] = gr[64 * j];
#pragma unroll
    for (int r = 0; r < NR; ++r) { float s = 0.f;
#pragma unroll
        for (int j = 0; j < 4; ++j) s += (v[r][j].x * v[r][j].x + v[r][j].y * v[r][j].y) + (v[r][j].z * v[r][j].z + v[r][j].w * v[r][j].w);
        const float rstd = 1.0f / sqrtf(wave_sum(s) * (1.f / D) + RMS_EPS);
        float am = 0.f;
#pragma unroll
        for (int j = 0; j < 4; ++j) { v[r][j] = v[r][j] * rstd * g[j]; am = fmaxf(fmaxf(am, fmaxf(fabsf(v[r][j].x), fabsf(v[r][j].y))), fmaxf(fabsf(v[r][j].z), fabsf(v[r][j].w))); }
        am = fmaxf(wave_max(am), 1e-20f);
        const float inv = 127.0f / am;
        unsigned* o = (unsigned*)(o0 + (size_t)r * D) + lane;
#pragma unroll
        for (int j = 0; j < 4; ++j) o[64 * j] = pk_i8(v[r][j].x * inv, v[r][j].y * inv, v[r][j].z * inv, v[r][j].w * inv);
        if (lane == 0) hs[r] = am * (1.0f / 127.0f); }
}
__device__ __forceinline__ void win_to_i8(const Frame& F, const float* W, int nb) {
    const int lane = F.lane, w = F.wave, n0 = 32 * nb;
    f32x4 tv[2][8];
#pragma unroll
    for (int s2 = 0; s2 < 2; ++s2)
#pragma unroll
        for (int i = 0; i < 8; ++i) tv[s2][i] = __builtin_nontemporal_load((const f32x4*)(W + (size_t)(128 * w + 64 * s2 + 8 * i + (lane >> 3)) * NIN + n0 + 4 * (lane & 7)));
    asm volatile("" ::: "memory");
    f32x4 am = {0.f, 0.f, 0.f, 0.f};
#pragma unroll
    for (int s2 = 0; s2 < 2; ++s2)
#pragma unroll
        for (int i = 0; i < 8; ++i)
#pragma unroll
            for (int c = 0; c < 4; ++c) am[c] = fmaxf(am[c], fabsf(tv[s2][i][c]));
#pragma unroll
    for (int c = 0; c < 4; ++c) { am[c] = fmaxf(am[c], __shfl_xor(am[c], 8)); am[c] = fmaxf(am[c], __shfl_xor(am[c], 16)); am[c] = fmaxf(am[c], __shfl_xor(am[c], 32)); }
    LAS float* cm = (LAS float*)(F.lds + TOKL_OFF);
    if (lane < 8) *(LAS f32x4*)(cm + w * 32 + 4 * lane) = am;
    __syncthreads();
    f32x4 tot = *(const LAS f32x4*)(cm + 4 * (lane & 7));
#pragma unroll
    for (int ww = 1; ww < 8; ++ww) { const f32x4 o = *(const LAS f32x4*)(cm + ww * 32 + 4 * (lane & 7));
#pragma unroll
        for (int c = 0; c < 4; ++c) tot[c] = fmaxf(tot[c], o[c]); }
    f32x4 inv;
#pragma unroll
    for (int c = 0; c < 4; ++c) { tot[c] = fmaxf(tot[c], 1e-20f); inv[c] = 127.0f / tot[c]; }
    if (w == 0 && lane < 8) *(f32x4*)((float*)(F.ws + SM_WSC) + n0 + 4 * lane) = tot * (1.0f / 127.0f);
    LAS int* scr = (LAS int*)(F.lds + w * 16384);
    unsigned char* wt = F.ws + WS_WIN;
#pragma unroll
    for (int s2 = 0; s2 < 2; ++s2) {
#pragma unroll
        for (int i = 0; i < 8; ++i) { LAS int* d = scr + (8 * i + (lane >> 3)) * 33 + 4 * (lane & 7);
#pragma unroll
            for (int c = 0; c < 4; ++c) d[c] = (int)__builtin_rintf(tv[s2][i][c] * inv[c]); }
        LDS_WAIT(); asm volatile("" ::: "memory");
        const int n = lane & 31, kh = lane >> 5; const LAS int* sp = scr + (32 * kh) * 33 + n;
        v4u o[2];
#pragma unroll
        for (int d = 0; d < 8; ++d) o[d >> 2][d & 3] = ((unsigned)sp[(4 * d) * 33] & 255u) | (((unsigned)sp[(4 * d + 1) * 33] & 255u) << 8) | (((unsigned)sp[(4 * d + 2) * 33] & 255u) << 16) | ((unsigned)sp[(4 * d + 3) * 33] << 24);
        v4u* dst = (v4u*)(wt + (size_t)(n0 + n) * D + 128 * w + 64 * s2 + 32 * kh);
        dst[0] = o[0]; dst[1] = o[1];
        LDS_WAIT(); asm volatile("" ::: "memory");
    }
    __syncthreads();
}

__device__ __forceinline__ void s5_tables(const Frame& F, int g, const float* lam_re, const float* lam_im, const float* log_dt, const float* b_re, const float* b_im, const float* c_re, const float* c_im, const float* dsk) {
    LAS float* Cre = (LAS float*)F.lds;
    LAS float* Cim = Cre + 1024;
    LAS float* Bre = Cim + 1024;
    LAS float* Bim = Bre + 1024;
    LAS float* Pre = Bim + 1024;
    LAS float* Pim = Pre + 17 * 64;
    LAS float* Kt = Pim + 17 * 64;
    const int tid = F.tid;
    for (int i = tid; i < 1024; i += 512) { Cre[i] = c_re[g * 1024 + i]; Cim[i] = c_im[g * 1024 + i]; }
    if (tid < 64) {
        const int p = tid; const float lr = lam_re[g * 64 + p], li = lam_im[g * 64 + p], dt = expf(log_dt[g]);
        const float er = expf(lr * dt), lbr = er * cosf(li * dt), lbi = er * sinf(li * dt);
        const float den = lr * lr + li * li, nr = lbr - 1.0f, ni = lbi;
        const float cr = (nr * lr + ni * li) / den, ci = (ni * lr - nr * li) / den;
        { float pr = 1.f, pi = 0.f; for (int k = 0; k <= 16; ++k) { Pre[k * 64 + p] = pr; Pim[k * 64 + p] = pi; const float nr2 = pr * lbr - pi * lbi, ni2 = pr * lbi + pi * lbr; pr = nr2; pi = ni2; } }
        for (int c = 0; c < 16; ++c) { const float br = b_re[(g * 64 + p) * 16 + c], bi = b_im[(g * 64 + p) * 16 + c]; Bre[p * 16 + c] = cr * br - ci * bi; Bim[p * 16 + c] = cr * bi + ci * br; }
    }
    __syncthreads();
    {
        const int kc = tid & 255, k = kc >> 4, c = kc & 15, ph = tid >> 8; float a16[16];
#pragma unroll
        for (int i = 0; i < 16; ++i) a16[i] = 0.f;
        for (int p = 32 * ph; p < 32 * ph + 32; ++p) {
            const float cr_ = Cre[c * 64 + p], ci_ = Cim[c * 64 + p], pr_ = Pre[k * 64 + p], pi_ = Pim[k * 64 + p];
            const float xr = cr_ * pr_ - ci_ * pi_, xi = cr_ * pi_ + ci_ * pr_;
#pragma unroll
            for (int j = 0; j < 4; ++j) { const f32x4 br = *(const LAS f32x4*)(Bre + p * 16 + 4 * j), bi = *(const LAS f32x4*)(Bim + p * 16 + 4 * j);
#pragma unroll
                for (int i = 0; i < 4; ++i) a16[4 * j + i] += xr * br[i] - xi * bi[i]; }
        }
        LAS float* Kh = Kt + 4096;
        if (ph == 1) {
#pragma unroll
            for (int j = 0; j < 4; ++j) *(LAS f32x4*)(Kh + kc * 16 + 4 * j) = (f32x4){a16[4 * j], a16[4 * j + 1], a16[4 * j + 2], a16[4 * j + 3]}; }
        __syncthreads();
        if (ph == 0) {
#pragma unroll
            for (int j = 0; j < 4; ++j) { const f32x4 o = *(const LAS f32x4*)(Kh + kc * 16 + 4 * j); f32x4 r = (f32x4){a16[4 * j], a16[4 * j + 1], a16[4 * j + 2], a16[4 * j + 3]} + o;
                if (k == 0 && (c >> 2) == j) r[c & 3] += dsk[g * 16 + c];
                *(LAS f32x4*)(Kt + kc * 16 + 4 * j) = r; } }
    }
    __syncthreads();
    unsigned* btt = (unsigned*)(F.ws + WS_BTT) + (size_t)g * 256 * (S5K / 2);
    for (int e = tid; e < 256 * (S5K / 2); e += 512) {
        const int row = e / (S5K / 2), cpair = e % (S5K / 2), t = row >> 4, c = row & 15, col = 2 * cpair; float v0, v1;
        if (col < S5Q) { const int p = col >> 1; const float xr = Cre[c * 64 + p] * Pre[(t + 1) * 64 + p] - Cim[c * 64 + p] * Pim[(t + 1) * 64 + p], xi = Cre[c * 64 + p] * Pim[(t + 1) * 64 + p] + Cim[c * 64 + p] * Pre[(t + 1) * 64 + p];
            v0 = xr; v1 = -xi; }
        else { const int s = (col - S5Q) >> 4, cp = (col - S5Q) & 15;
            if (s <= t) { v0 = Kt[(t - s) * 256 + c * 16 + cp]; v1 = Kt[(t - s) * 256 + c * 16 + cp + 1]; } else { v0 = 0.f; v1 = 0.f; } }
        btt[e] = pk2(v0, v1);
    }
    unsigned* btw = (unsigned*)(F.ws + WS_BTW) + (size_t)g * 128 * 128;
    for (int e = tid; e < 128 * 128; e += 512) {
        const int q = e >> 7, cpair = e & 127, col = 2 * cpair, s = col >> 4, cp = col & 15, p = q >> 1, k = 15 - s;
        const float pr = Pre[k * 64 + p], pi = Pim[k * 64 + p];
        float v0, v1;
        if (q & 1) { v0 = pr * Bim[p * 16 + cp] + pi * Bre[p * 16 + cp]; v1 = pr * Bim[p * 16 + cp + 1] + pi * Bre[p * 16 + cp + 1]; }
        else { v0 = pr * Bre[p * 16 + cp] - pi * Bim[p * 16 + cp]; v1 = pr * Bre[p * 16 + cp + 1] - pi * Bim[p * 16 + cp + 1]; }
        btw[e] = pk2(v0, v1);
    }
    if (tid < 64) { float* l16 = (float*)(F.ws + SM_LAM16) + (g * 64 + tid) * 2; l16[0] = Pre[16 * 64 + tid]; l16[1] = Pim[16 * 64 + tid]; }
    __syncthreads();
}

struct In { const float* p[30]; };

__device__ __forceinline__ void p0_prologue(const Frame& F, const In& I) {
    for (int g = F.vcu; g < S5G; g += F.G) s5_tables(F, g, I.p[3], I.p[4], I.p[5], I.p[6], I.p[7], I.p[8], I.p[9], I.p[10]);
    const int gt = F.vcu * 512 + F.tid, NGT = F.G * 512;
    { float* lc = (float*)(F.ws + SM_LRUC); for (int i = gt; i < LRUW; i += NGT) { const float lam = I.p[18][i]; lc[i] = -8.0f * log1pf(expf(-lam)) * 1.44269504f; } }
    { bf16* wrt = (bf16*)(F.ws + SM_WRT);
        for (int i = gt; i < 2 * 65536; i += NGT) { const int which = i >> 16, r = i & 65535, h = r >> 12, j = (r >> 6) & 63, k = r & 63; const float* src = which ? I.p[16] : I.p[14]; wrt[i] = (bf16)f2bf(src[(h * 64 + k) * 64 + j]); } }
    { bf16* rhi = (bf16*)(F.ws + SM_RHI); bf16* rlo = (bf16*)(F.ws + SM_RLO);
        for (int i = gt; i < NROUT * 1024; i += NGT) { const int n = i >> 10, k = i & 1023; float w = 0.f; if (n < 4) w = I.p[22][k * 4 + n]; else if (n < 36) w = I.p[24][k * 32 + (n - 4)];
            const unsigned h = f2bf(w); rhi[i] = (bf16)h; rlo[i] = (bf16)f2bf(w - bf2f(h)); } }
    LAS float* scr = (LAS float*)(F.lds + F.wave * 16384);
    const int gw = F.vcu * NWAVES + F.wave, NGW = F.G * NWAVES;
    constexpr int I_S5 = (S5W / 64) * (2 * D / 32), I_LRU = (D / 64) * (D / 32), I_O = I_LRU;
    constexpr int NITEMS = I_S5 + I_LRU + I_O;
    for (int it = gw; it < NITEMS; it += NGW) {
        int r = it; TItem ti;
        if (r < I_S5) { const int nb = 2 * D / 32, kb = r / nb, n0 = 32 * (r % nb); ti = TItem{I.p[11], 2 * D, (bf16*)(F.ws + WS_WS5), S5W, 64 * kb, n0, n0 < D ? ileave_row(n0, 0) : ileave_row(n0 - D, 1)}; }
        else if ((r -= I_S5) < I_LRU) { const int nb = D / 32, kb = r / nb, n0 = 32 * (r % nb); ti = TItem{I.p[19], D, (bf16*)(F.ws + WS_WLRU), D, 64 * kb, n0, n0}; }
        else { r -= I_LRU; const int nb = D / 32, kb = r / nb, n0 = 32 * (r % nb); ti = TItem{I.p[20], D, (bf16*)(F.ws + WS_WO), D, 64 * kb, n0, n0}; }
        f32x4 tv[8]; transpose_load(ti, tv, F.lane); asm volatile("" ::: "memory"); transpose_store(ti, tv, scr, F.lane);
    }
    { const int skip = F.G > 2 * S5G ? S5G : 0;
      if (F.vcu >= skip) {
        for (int nb = F.vcu - skip; nb < NIN / 32; nb += F.G - skip) win_to_i8(F, I.p[2], nb);
        const int gw2 = (F.vcu - skip) * NWAVES + F.wave, NGW2 = (F.G - skip) * NWAVES;
        for (int m = gw2 * 4; m < T; m += NGW2 * 4) rms_rows_to_i8<4>(I.p[0] + (size_t)m * D, I.p[1], F.ws + WS_H + (size_t)m * D, (float*)(F.ws + SM_HSC) + m, F.lane); } }
}
__device__ __forceinline__ TItem expert_item(const Frame& F, const In& I, int it) {
    const int e = it >> 9, half = (it >> 8) & 1, r = it & 255, nb = DEXP / 32, kb = r / nb, n0 = 32 * (r % nb);
    return TItem{(half ? I.p[27] : I.p[26]) + (size_t)e * D * DEXP, DEXP, (bf16*)(F.ws + WS_WGU + (size_t)e * 1024 * 1024), D, 64 * kb, n0, ileave_row(n0, half)};
}
__device__ __forceinline__ TItem expert_item_d(const Frame& F, const In& I, int it) {
    const int e = it >> 8, r = it & 255, nb = D / 32, kb = r / nb, n0 = 32 * (r % nb);
    return TItem{I.p[28] + (size_t)e * DEXP * D, D, (bf16*)(F.ws + WS_WD + (size_t)e * 1024 * DEXP), DEXP, 64 * kb, n0, n0};
}
__device__ __forceinline__ void expert_weight_copies(const Frame& F, const In& I) {
    LAS float* scr = (LAS float*)(F.lds + F.wave * 16384);
    const int gw = F.vcu * NWAVES + F.wave, NGW = F.G * NWAVES;
    constexpr int NIT = NEXP * 512;
    for (int it = 8 * NGW + gw; it < NIT; it += NGW) { const TItem t0 = expert_item(F, I, it); f32x4 v0[8]; transpose_load(t0, v0, F.lane); asm volatile("" ::: "memory"); transpose_store_fp8(t0, v0, scr, F.lane); }
}
__device__ __forceinline__ void expert_down_copies(const Frame& F, const In& I) {
    LAS float* scr = (LAS float*)(F.lds + F.wave * 16384);
    const int nunits = (int)F.MISC[128] * 4, rem = nunits % F.G, nbusy = rem;
    const int nfree = F.G - nbusy;
    if (F.vcu < nbusy) return;
    const int gw = (F.vcu - nbusy) * NWAVES + F.wave, NGW = nfree * NWAVES;
    constexpr int NIT = NEXP * 256;
    for (int it = gw; it < NIT; it += 2 * NGW) {
        const TItem t0 = expert_item_d(F, I, it); const bool has1 = it + NGW < NIT; const TItem t1 = expert_item_d(F, I, has1 ? it + NGW : it);
        f32x4 v0[8], v1[8]; transpose_load(t0, v0, F.lane); transpose_load(t1, v1, F.lane); asm volatile("" ::: "memory");
        transpose_store_fp8(t0, v0, scr, F.lane); if (has1) transpose_store_fp8(t1, v1, scr, F.lane);
    }
}

__device__ __forceinline__ void lru_seq(const Frame& F, const In& I) {
    LAS unsigned char* wl = F.lds + F.wave * 17920;
    LAS bf16* xcA = (LAS bf16*)wl;
    LAS float* pre = (LAS float*)(wl + 9216);
    typedef float f32x2 __attribute__((ext_vector_type(2)));
    LAS f32x2* sumT = (LAS f32x2*)(F.lds + 143360);
    const int lane = F.lane, jj = lane & 15, ks = lane >> 4, c32 = lane & 31, th = lane >> 5;
    const bf16* XL = (const bf16*)(F.ws + WS_XL); const bf16* GL = (const bf16*)(F.ws + WS_GL); bf16* YL = (bf16*)(F.ws + WS_H);
    const bf16* WRT = (const bf16*)(F.ws + SM_WRT);
    for (int un = F.vcu; un < BATCH * LRUH * 2; un += F.G) {
        const int b = un >> 5, hd = (un >> 1) & 15, half = un & 1;
        const int chin = hd * 64 + lane;
        const int chg = hd * 64 + 32 * half + c32;
        const float w0 = I.p[12][chin], w1 = I.p[12][1024 + chin], w2 = I.p[12][2048 + chin], w3 = I.p[12][3072 + chin], cb = I.p[13][chin];
        const float brs = I.p[15][chg] * -1.44269504f, bis = I.p[17][chg] * -1.44269504f, cch2 = ((const float*)(F.ws + SM_LRUC))[chg];
        float Rc = 0.f;
        for (int rd = 0; rd < 8; ++rd) {
            const int j = rd * 8 + F.wave;
            const size_t tok0 = (size_t)b * SEQ + (size_t)j * LRUCH;
            unsigned short xr[64], xh[3];
            { const bf16* xp = XL + tok0 * 1024 + chin;
              xh[0] = 0; xh[1] = 0; xh[2] = 0;
              if (j > 0) { xh[0] = xp[-3 * 1024]; xh[1] = xp[-2 * 1024]; xh[2] = xp[-1 * 1024]; }
#pragma unroll
              for (int t = 0; t < 64; ++t) xr[t] = xp[t * 1024]; }
            asm volatile("" ::: "memory");
            { typedef float f2v __attribute__((ext_vector_type(2)));
              float xm3 = bf2f(xh[0]), xm2 = bf2f(xh[1]), xm1 = bf2f(xh[2]);
              const f2v vw0 = {w0, w0}, vw1 = {w1, w1}, vw2 = {w2, w2}, vw3 = {w3, w3}, vcb = {cb, cb};
#pragma unroll
              for (int t = 0; t < 64; t += 2) { const float x0 = bf2f(xr[t]), x1 = bf2f(xr[t + 1]);
                  f2v xc = vcb + vw0 * (f2v){xm3, xm2}; xc = xc + vw1 * (f2v){xm2, xm1}; xc = xc + vw2 * (f2v){xm1, x0}; xc = xc + vw3 * (f2v){x0, x1};
                  const unsigned pk = pg8::cvt_pk_bf16(xc.x, xc.y);
                  xcA[t * 72 + lane] = (bf16)(pk & 0xffffu); xcA[(t + 1) * 72 + lane] = (bf16)(pk >> 16);
                  xm3 = xm1; xm2 = x0; xm1 = x1; } }
            LDS_WAIT();
            float hl[2][16], Pl[2][16], Prun[2], Hrun[2];
#pragma unroll
            for (int st = 0; st < 2; ++st) {
                bf16x8 Bw[4][2];
#pragma unroll
                for (int n = 0; n < 4; ++n)
#pragma unroll
                    for (int k = 0; k < 2; ++k) Bw[n][k] = *(const bf16x8*)(WRT + (size_t)(n >> 1) * 65536 + (size_t)(hd * 64 + 32 * half + 16 * (n & 1) + jj) * 64 + 32 * k + 8 * ks);
#pragma unroll
                for (int mh = 0; mh < 2; ++mh) { const int mt = 2 * st + mh;
                    bf16x8 a[2];
#pragma unroll
                    for (int k = 0; k < 2; ++k) a[k] = *(const LAS bf16x8*)(xcA + (16 * mt + jj) * 72 + 32 * k + 8 * ks);
#pragma unroll
                    for (int n = 0; n < 4; ++n) { f32x4 d = (f32x4){0.f, 0.f, 0.f, 0.f};
#pragma unroll
                        for (int k = 0; k < 2; ++k) d = __builtin_amdgcn_mfma_f32_16x16x32_bf16(a[k], Bw[n][k], d, 0, 0, 0);
#pragma unroll
                        for (int r = 0; r < 4; ++r) pre[(16 * mh + 4 * ks + r) * 68 + 16 * n + jj] = d[r]; } }
                LDS_WAIT();
                float h = 0.f, P = 1.f;
                typedef float f2v __attribute__((ext_vector_type(2)));
#pragma unroll
                for (int tl = 0; tl < 16; tl += 2) {
                    const int trow = 16 * th + tl;
                    const f2v pr = {pre[trow * 68 + c32], pre[(trow + 1) * 68 + c32]}, pi = {pre[trow * 68 + 32 + c32], pre[(trow + 1) * 68 + 32 + c32]};
                    const f2v zr = pr * (f2v){-1.44269504f, -1.44269504f} + (f2v){brs, brs}, zi = pi * (f2v){-1.44269504f, -1.44269504f} + (f2v){bis, bis};
                    const f2v er = {__builtin_amdgcn_exp2f(zr.x), __builtin_amdgcn_exp2f(zr.y)}, ei = {__builtin_amdgcn_exp2f(zi.x), __builtin_amdgcn_exp2f(zi.y)};
                    const f2v dr = er + (f2v){1.f, 1.f};
                    const f2v rg = {__builtin_amdgcn_rcpf(dr.x), __builtin_amdgcn_rcpf(dr.y)};
                    const f2v la2 = rg * (f2v){cch2, cch2};
                    const f2v a_ = {__builtin_amdgcn_exp2f(la2.x), __builtin_amdgcn_exp2f(la2.y)};
                    const f2v x2 = la2 * (f2v){1.38629436f, 1.38629436f};
                    f2v q = x2 * (f2v){0.0013888889f, 0.0013888889f} + (f2v){0.0083333333f, 0.0083333333f};
                    q = q * x2 + (f2v){0.041666667f, 0.041666667f}; q = q * x2 + (f2v){0.16666667f, 0.16666667f}; q = q * x2 + (f2v){0.5f, 0.5f}; q = q * x2 + (f2v){1.f, 1.f};
                    f2v om = -(q * x2);
                    const f2v alt = (f2v){1.f, 1.f} - a_ * a_;
                    om.x = x2.x > -0.3f ? om.x : alt.x; om.y = x2.y > -0.3f ? om.y : alt.y;
                    om.x = fmaxf(om.x, 1e-30f); om.y = fmaxf(om.y, 1e-30f);
                    const f2v dd = ei + (f2v){1.f, 1.f};
                    const f2v rq = om * dd * dd;
                    const f2v mi = om * (f2v){__builtin_amdgcn_rsqf(rq.x), __builtin_amdgcn_rsqf(rq.y)};
                    const f2v bx = mi * (f2v){bf2f(xcA[(32 * st + trow) * 72 + 32 * half + c32]), bf2f(xcA[(32 * st + trow + 1) * 72 + 32 * half + c32])};
                    h = a_.x * h + bx.x; P *= a_.x; hl[st][tl] = h; Pl[st][tl] = P;
                    h = a_.y * h + bx.y; P *= a_.y; hl[st][tl + 1] = h; Pl[st][tl + 1] = P;
                }
                Prun[st] = P; Hrun[st] = h;
                LDS_WAIT();
            }
            const float pP0 = __shfl_xor(Prun[0], 32), pH0 = __shfl_xor(Hrun[0], 32), pP1 = __shfl_xor(Prun[1], 32), pH1 = __shfl_xor(Hrun[1], 32);
            const float P0 = th ? pP0 : Prun[0], H0 = th ? pH0 : Hrun[0], P1 = th ? Prun[0] : pP0, H1 = th ? Hrun[0] : pH0;
            const float P2 = th ? pP1 : Prun[1], H2 = th ? pH1 : Hrun[1], P3 = th ? Prun[1] : pP1, H3 = th ? Hrun[1] : pH1;
            const float C1 = H0, Q1 = P0, C2 = P1 * C1 + H1, Q2 = P1 * Q1, C3 = P2 * C2 + H2, Q3 = P2 * Q2, Hc = P3 * C3 + H3, Pc = P3 * Q3;
            const float Cs0 = th ? C1 : 0.f, Qs0 = th ? Q1 : 1.f, Cs1 = th ? C3 : C2, Qs1 = th ? Q3 : Q2;
            const int cit = (rd * F.G + F.vcu) * NWAVES + F.wave; const bool cdo = cit < NEXP * 512;
            f32x4 ctv[8]; unsigned short ggr[2][16];
            if (cdo) { const TItem citem = expert_item(F, I, cit); transpose_load(citem, ctv, lane); }
#pragma unroll
            for (int st = 0; st < 2; ++st)
#pragma unroll
                for (int tl = 0; tl < 16; ++tl) ggr[st][tl] = GL[(tok0 + 32 * st + 16 * th + tl) * 1024 + chg];
            asm volatile("" ::: "memory");
            if (th == 0) sumT[((rd & 1) * 8 + F.wave) * 32 + c32] = (f32x2){Pc, Hc};
            LDS_WAIT();
            __syncthreads();
            float cin = Rc, mycin = 0.f;
#pragma unroll
            for (int w = 0; w < 8; ++w) { const f32x2 ph = sumT[((rd & 1) * 8 + w) * 32 + c32]; mycin = (w == F.wave) ? cin : mycin; cin = ph.x * cin + ph.y; }
            Rc = cin;
#pragma unroll
            for (int st = 0; st < 2; ++st) { const float hin = (st ? Cs1 : Cs0) + (st ? Qs1 : Qs0) * mycin;
#pragma unroll
                for (int tl = 0; tl < 16; ++tl) { const float hh = hl[st][tl] + Pl[st][tl] * hin;
                    YL[(tok0 + 32 * st + 16 * th + tl) * 1024 + chg] = (bf16)f2bf(hh * bf2f(ggr[st][tl])); } }
            if (cdo) { const TItem citem = expert_item(F, I, cit); transpose_store_fp8(citem, ctv, pre, lane); }
        }
        __syncthreads();
    }
}

__device__ __forceinline__ void s5_chain(const Frame& F, int b, int g) {
    typedef float f32x2 __attribute__((ext_vector_type(2)));
    LAS f32x2* segE = (LAS f32x2*)(F.lds);
    const int lane = F.lane, w = F.wave;
    const float* SLOC = (const float*)(F.ws + WS_SLOC); unsigned* AGw = (unsigned*)(F.ws + WS_AG); const float* L16 = (const float*)(F.ws + SM_LAM16);
    const float lr = L16[(g * 64 + lane) * 2], li = L16[(g * 64 + lane) * 2 + 1];
    const float* sl = SLOC + ((size_t)(g * S5N + b * S5NCH + 32 * w)) * S5Q + 2 * lane;
    unsigned* ag = AGw + ((size_t)(g * S5N + b * S5NCH + 32 * w)) * (S5K / 2) + lane;
    float xr[32], xi[32];
#pragma unroll
    for (int u = 0; u < 32; ++u) { const float2 v = *(const float2*)(sl + (size_t)u * S5Q); xr[u] = v.x; xi[u] = v.y; }
    asm volatile("" ::: "memory");
    float sr = 0.f, si = 0.f;
#pragma unroll
    for (int u = 0; u < 32; ++u) { const float nr = lr * sr - li * si + xr[u], ni = lr * si + li * sr + xi[u]; xr[u] = sr; xi[u] = si; sr = nr; si = ni; }
    segE[w * 64 + lane] = (f32x2){sr, si};
    float qr = lr, qi = li;
#pragma unroll
    for (int k = 0; k < 5; ++k) { const float nr = qr * qr - qi * qi, ni = 2.f * qr * qi; qr = nr; qi = ni; }
    LDS_WAIT();
    __syncthreads();
    float cr = 0.f, ci = 0.f;
    for (int ww = 0; ww < w; ++ww) { const f32x2 e = segE[ww * 64 + lane]; const float nr = qr * cr - qi * ci + e.x, ni = qr * ci + qi * cr + e.y; cr = nr; ci = ni; }
#pragma unroll
    for (int u = 0; u < 32; ++u) { ag[(size_t)u * (S5K / 2)] = pk2(xr[u] + cr, xi[u] + ci); const float nr = lr * cr - li * ci, ni = lr * ci + li * cr; cr = nr; ci = ni; }
    __syncthreads();
}

__device__ __forceinline__ void p8_router(const Frame& F, const In& I) {
    const int lane = F.lane, tk = lane & 15, ks = lane >> 4;
    LAS float* lg = (LAS float*)(F.lds + F.wave * 4096);
    volatile LAS unsigned* cntL = F.MISC + 32; volatile LAS unsigned* baseL = F.MISC + 64;
    const float* X1 = I.p[0]; unsigned char* H2 = F.ws + WS_H2; const float* gf = I.p[21];
    const unsigned char* D8 = (const unsigned char*)(F.ws + WS_D8); const float* DSC = (const float*)(F.ws + WS_DSC);
    const bf16* RHI = (const bf16*)(F.ws + SM_RHI); const bf16* RLO = (const bf16*)(F.ws + SM_RLO);
    float* RSTD = (float*)(F.ws + SM_RSTD); unsigned* gcnt = F.ctl + CW_CNT;
    int* LTOK = (int*)(F.ws + WS_LTOK); float* LW = (float*)(F.ws + WS_LW); int* TOKE = (int*)(F.ws + WS_TOKE); int* TOKR = (int*)(F.ws + WS_TOKR);
    for (int blk = F.vcu; blk < T / 128; blk += F.G) {
        if (F.tid < 32) cntL[F.tid] = 0u;
        __syncthreads();
        const int tok0 = blk * 128 + F.wave * 16;
        const float* xrow = X1 + (size_t)(tok0 + tk) * D + 8 * ks; unsigned char* hrow = H2 + (size_t)(tok0 + tk) * D + 8 * ks;
        f32x4 acc[3]; acc[0] = acc[1] = acc[2] = (f32x4){0.f, 0.f, 0.f, 0.f}; float ss = 0.f;
        const unsigned char* drow = D8 + (size_t)(tok0 + tk) * D + 8 * ks; const float* dsc = DSC + (size_t)(tok0 + tk) * 16;
        f32x4 xnx[4][2]; v2u dnx[4]; float snx[2];
#pragma unroll
        for (int q = 0; q < 4; ++q) { xnx[q][0] = __builtin_nontemporal_load((const f32x4*)(xrow + 32 * q)); xnx[q][1] = __builtin_nontemporal_load((const f32x4*)(xrow + 32 * q + 4)); dnx[q] = *(const v2u*)(drow + 32 * q); }
        snx[0] = dsc[0]; snx[1] = dsc[4];
        LAS bf16* slab = (LAS bf16*)(F.lds + 32768);
        v4u wst[3];
#define RT_SLAB_LOAD(g) do { _Pragma("unroll") for (int j = 0; j < 3; ++j) { const int c = F.tid + 512 * j, which = c / 768, r = (c % 768) >> 4, kq = c & 15; \
            wst[j] = *(const v4u*)((which ? RLO : RHI) + (size_t)r * D + 128 * (g) + 8 * kq); } } while (0)
#define RT_SLAB_STORE(buf) do { _Pragma("unroll") for (int j = 0; j < 3; ++j) { const int c = F.tid + 512 * j, which = c / 768, r = (c % 768) >> 4, kq = c & 15; \
            *(LAS v4u*)(slab + ((size_t)((buf) * 2 + which) * 48 + r) * 136 + 8 * kq) = wst[j]; } } while (0)
        RT_SLAB_LOAD(0); RT_SLAB_STORE(0);
        LDS_WAIT();
        __syncthreads();
        for (int kg = 0; kg < 8; ++kg) {
            f32x4 xa[4][2];
#pragma unroll
            for (int q = 0; q < 4; ++q) { const float sq = snx[q >> 1]; const v2u dq = dnx[q];
                xa[q][0] = xnx[q][0] + (f32x4){(float)((int)(dq.x << 24) >> 24), (float)((int)(dq.x << 16) >> 24), (float)((int)(dq.x << 8) >> 24), (float)((int)dq.x >> 24)} * sq;
                xa[q][1] = xnx[q][1] + (f32x4){(float)((int)(dq.y << 24) >> 24), (float)((int)(dq.y << 16) >> 24), (float)((int)(dq.y << 8) >> 24), (float)((int)dq.y >> 24)} * sq; }
            { const int kgn = kg < 7 ? kg + 1 : kg;
#pragma unroll
              for (int q = 0; q < 4; ++q) { xnx[q][0] = __builtin_nontemporal_load((const f32x4*)(xrow + 32 * (4 * kgn + q))); xnx[q][1] = __builtin_nontemporal_load((const f32x4*)(xrow + 32 * (4 * kgn + q) + 4)); dnx[q] = *(const v2u*)(drow + 32 * (4 * kgn + q)); }
              { const int G0 = 2 * kgn, G1 = 2 * kgn + 1; snx[0] = dsc[(G0 & 3) * 4 + (G0 >> 2)]; snx[1] = dsc[(G1 & 3) * 4 + (G1 >> 2)]; }
              RT_SLAB_LOAD(kgn); }
            f32x4 ga[4][2];
#pragma unroll
            for (int q = 0; q < 4; ++q) { const int kc = 4 * kg + q; ga[q][0] = *(const f32x4*)(gf + 32 * kc + 8 * ks); ga[q][1] = *(const f32x4*)(gf + 32 * kc + 8 * ks + 4); }
            asm volatile("" ::: "memory");
            const LAS bf16* sh = slab + (size_t)((kg & 1) * 2) * 48 * 136, * sl = sh + 48 * 136;
#pragma unroll
            for (int q = 0; q < 4; ++q) { const int kc = 4 * kg + q;
                const f32x4 a0 = xa[q][0], a1 = xa[q][1];
                ss += (a0.x * a0.x + a0.y * a0.y) + (a0.z * a0.z + a0.w * a0.w) + (a1.x * a1.x + a1.y * a1.y) + (a1.z * a1.z + a1.w * a1.w);
                const f32x4 v0 = a0 * ga[q][0], v1 = a1 * ga[q][1];
                v4u hi, lo;
                hi.x = pg8::cvt_pk_bf16(v0.x, v0.y); hi.y = pg8::cvt_pk_bf16(v0.z, v0.w); hi.z = pg8::cvt_pk_bf16(v1.x, v1.y); hi.w = pg8::cvt_pk_bf16(v1.z, v1.w);
                lo.x = pg8::cvt_pk_bf16(v0.x - bflo(hi.x), v0.y - bfhi(hi.x)); lo.y = pg8::cvt_pk_bf16(v0.z - bflo(hi.y), v0.w - bfhi(hi.y));
                lo.z = pg8::cvt_pk_bf16(v1.x - bflo(hi.z), v1.y - bfhi(hi.z)); lo.w = pg8::cvt_pk_bf16(v1.z - bflo(hi.w), v1.w - bfhi(hi.w));
                { v2u h8; h8.x = pk_fp8x4(v0.x, v0.y, v0.z, v0.w); h8.y = pk_fp8x4(v1.x, v1.y, v1.z, v1.w); *(v2u*)(hrow + 32 * kc) = h8; }
                const bf16x8 hf = __builtin_bit_cast(bf16x8, hi), lf = __builtin_bit_cast(bf16x8, lo);
#pragma unroll
                for (int n = 0; n < 3; ++n) {
                    const bf16x8 wh = *(const LAS bf16x8*)(sh + (16 * n + tk) * 136 + 32 * q + 8 * ks), wl = *(const LAS bf16x8*)(sl + (16 * n + tk) * 136 + 32 * q + 8 * ks);
                    acc[n] = __builtin_amdgcn_mfma_f32_16x16x32_bf16(wh, hf, acc[n], 0, 0, 0);
                    acc[n] = __builtin_amdgcn_mfma_f32_16x16x32_bf16(wh, lf, acc[n], 0, 0, 0);
                    acc[n] = __builtin_amdgcn_mfma_f32_16x16x32_bf16(wl, hf, acc[n], 0, 0, 0);
                } }
            if (kg < 7) RT_SLAB_STORE((kg + 1) & 1);
            LDS_WAIT();
            __syncthreads();
        }
#undef RT_SLAB_LOAD
#undef RT_SLAB_STORE
        ss += __shfl_xor(ss, 16); ss += __shfl_xor(ss, 32);
        const float rstd = 1.0f / sqrtf(ss * (1.f / D) + RMS_EPS);
        if (ks == 0) RSTD[tok0 + tk] = rstd;
#pragma unroll
        for (int n = 0; n < 3; ++n)
#pragma unroll
            for (int r = 0; r < 4; ++r) lg[tk * 49 + 16 * n + 4 * ks + r] = acc[n][r] * rstd;
        LDS_WAIT();
        int E1 = 0, E2 = 0; float w1 = 0.f, w2 = 0.f; unsigned r1 = 0, r2 = 0;
        if (lane < 16) {
            const LAS float* my = lg + lane * 49;
            float lgp[4];
#pragma unroll
            for (int i = 0; i < 4; ++i) lgp[i] = my[i] + I.p[23][i];
            int gi = 0; float mx = lgp[0];
#pragma unroll
            for (int i = 1; i < 4; ++i) if (lgp[i] > mx) { mx = lgp[i]; gi = i; }
            float den = 0.f;
#pragma unroll
            for (int i = 0; i < 4; ++i) den += expf(lgp[i] - mx);
            const float pg = 1.0f / den;
            float le[8];
#pragma unroll
            for (int i = 0; i < 8; ++i) le[i] = my[4 + gi * 8 + i] + I.p[25][gi * 8 + i];
            int i1 = 0; float m1 = le[0];
#pragma unroll
            for (int i = 1; i < 8; ++i) if (le[i] > m1) { m1 = le[i]; i1 = i; }
            int i2 = -1; float m2 = -3.0e38f;
#pragma unroll
            for (int i = 0; i < 8; ++i) if (i != i1 && le[i] > m2) { m2 = le[i]; i2 = i; }
            const float e2 = expf(m2 - m1);
            w1 = pg / (1.0f + e2); w2 = pg * e2 / (1.0f + e2);
            E1 = gi * 8 + i1; E2 = gi * 8 + i2;
            r1 = __hip_atomic_fetch_add((LAS unsigned*)(F.MISC + 32) + E1, 1u, __ATOMIC_RELAXED, __HIP_MEMORY_SCOPE_WORKGROUP);
            r2 = __hip_atomic_fetch_add((LAS unsigned*)(F.MISC + 32) + E2, 1u, __ATOMIC_RELAXED, __HIP_MEMORY_SCOPE_WORKGROUP);
        }
        LDS_WAIT();
        __syncthreads();
        if (F.tid < 32) { const unsigned c = cntL[F.tid]; baseL[F.tid] = c ? __hip_atomic_fetch_add(gcnt + F.tid, c, __ATOMIC_RELAXED, __HIP_MEMORY_SCOPE_AGENT) : 0u; }
        __syncthreads();
        if (lane < 16) {
            const int tok = tok0 + lane; const int k1 = (int)(baseL[E1] + r1), k2 = (int)(baseL[E2] + r2);
            LTOK[(size_t)E1 * T + k1] = tok; LW[(size_t)E1 * T + k1] = w1; LTOK[(size_t)E2 * T + k2] = tok; LW[(size_t)E2 * T + k2] = w2;
            TOKE[tok * 2] = E1; TOKE[tok * 2 + 1] = E2; TOKR[tok * 2] = k1; TOKR[tok * 2 + 1] = k2;
        }
        __syncthreads();
    }
}

__device__ __forceinline__ void moe_prefix(const Frame& F) {
    if (F.tid < 64) {
        const unsigned nt = F.tid < NEXP ? (F.ctl[CW_CNT + F.tid] + 255u) >> 8 : 0u; unsigned inc = nt;
#pragma unroll
        for (int o = 1; o < 32; o <<= 1) { const unsigned v = __shfl_up(inc, o); if (F.lane >= o) inc += v; }
        if (F.tid < NEXP) F.MISC[96 + F.tid] = inc - nt;
        if (F.tid == NEXP - 1) F.MISC[128] = inc;
    }
    LDS_WAIT();
    __syncthreads();
}
template <int MODE  >
__device__ __forceinline__ void moe_setup(const Frame& F) {
    moe_prefix(F);
    const int NT = (int)F.MISC[128];
    if (F.tid < MAXU) { const int L = F.tid * F.G + F.vcu; int e = -1, mt = 0;
        if (L < NT * 4) { const int mtg = L >> 2; e = 0; while (e < NEXP - 1 && (int)F.MISC[96 + e + 1] <= mtg) ++e; mt = mtg - (int)F.MISC[96 + e]; }
        F.MISC[136 + F.tid] = (unsigned)e; F.MISC[144 + F.tid] = (unsigned)mt; }
    __syncthreads();
    if (F.tid == 0) { int n = 0; while (n < MAXU && (int)F.MISC[136 + n] >= 0) ++n; F.MISC[152] = (unsigned)n; }
    __syncthreads();
    const int nU = (int)F.MISC[152];
    LAS int* tokL = (LAS int*)(F.lds + TOKL_OFF); LAS float* sclL = (LAS float*)(F.lds + SCLL_OFF);
    const int* LTOK = (const int*)(F.ws + WS_LTOK); const float* LW = (const float*)(F.ws + WS_LW); const float* RSTD = (const float*)(F.ws + SM_RSTD);
    for (int i = F.tid; i < nU * 256; i += 512) { const int ui = i >> 8, r = i & 255, e = (int)F.MISC[136 + ui], rank = (int)F.MISC[144 + ui] * 256 + r; const bool valid = rank < (int)F.ctl[CW_CNT + e];
        const int tok = valid ? LTOK[(size_t)e * T + rank] : 0; tokL[i] = tok; sclL[i] = valid ? (MODE == 0 ? RSTD[tok] : LW[(size_t)e * T + rank]) : 0.f; }
    LDS_WAIT(); VM_WAIT();
    __syncthreads();
}

__device__ __forceinline__ void p11_final(const Frame& F, const In& I, float* dst) {
    moe_prefix(F);
    const int gw = F.vcu * NWAVES + F.wave, NGW = F.G * NWAVES, lane = F.lane;
    const int* TOKE = (const int*)(F.ws + WS_TOKE); const int* TOKR = (const int*)(F.ws + WS_TOKR);
    const unsigned char* YS8 = (const unsigned char*)(F.ws + WS_YS); const float* YSC = (const float*)(F.ws + WS_YS + 80 * MiB);
    const unsigned char* D8 = (const unsigned char*)(F.ws + WS_D8); const float* DSC = (const float*)(F.ws + WS_DSC); const float* X = I.p[0];
    f32x4 gfin[4];
#pragma unroll
    for (int j = 0; j < 4; ++j) gfin[j] = ((const f32x4*)I.p[29])[lane + 64 * j];
    int ee[2][2], rr[2][2];
    { const int m0 = gw * 2 < T ? gw * 2 : 0;
#pragma unroll
      for (int q = 0; q < 2; ++q) { ee[q][0] = TOKE[2 * (m0 + q)]; ee[q][1] = TOKE[2 * (m0 + q) + 1]; rr[q][0] = TOKR[2 * (m0 + q)]; rr[q][1] = TOKR[2 * (m0 + q) + 1]; } }
    for (int m0 = gw * 2; m0 < T; m0 += NGW * 2) {
        f32x4 xv[2][4]; unsigned ya[2][4], yb[2][4], yd[2][4]; f32x4 sa[2], sb[2], sd[2];
#pragma unroll
        for (int q = 0; q < 2; ++q) { const size_t s0 = (size_t)F.MISC[96 + ee[q][0]] * 256 + rr[q][0], s1 = (size_t)F.MISC[96 + ee[q][1]] * 256 + rr[q][1];
            const f32x4* xr = (const f32x4*)(X + (size_t)(m0 + q) * D) + lane; const unsigned* y0 = (const unsigned*)(YS8 + s0 * 1024) + lane; const unsigned* y1 = (const unsigned*)(YS8 + s1 * 1024) + lane;
            const unsigned* d0 = (const unsigned*)(D8 + (size_t)(m0 + q) * 1024) + lane;
#pragma unroll
            for (int j = 0; j < 4; ++j) { xv[q][j] = __builtin_nontemporal_load(xr + 64 * j); ya[q][j] = y0[64 * j]; yb[q][j] = y1[64 * j]; yd[q][j] = d0[64 * j]; }
            sa[q] = *(const f32x4*)(YSC + s0 * 16 + 4 * (lane >> 4)); sb[q] = *(const f32x4*)(YSC + s1 * 16 + 4 * (lane >> 4)); sd[q] = *(const f32x4*)(DSC + (size_t)(m0 + q) * 16 + 4 * (lane >> 4)); }
        { const int mn = m0 + NGW * 2 < T ? m0 + NGW * 2 : m0;
#pragma unroll
          for (int q = 0; q < 2; ++q) { ee[q][0] = TOKE[2 * (mn + q)]; ee[q][1] = TOKE[2 * (mn + q) + 1]; rr[q][0] = TOKR[2 * (mn + q)]; rr[q][1] = TOKR[2 * (mn + q) + 1]; } }
        asm volatile("" ::: "memory");
#pragma unroll
        for (int q = 0; q < 2; ++q) { f32x4 v[4]; float s = 0.f;
#pragma unroll
            for (int j = 0; j < 4; ++j) { const f32x4 x = xv[q][j]; const unsigned a = ya[q][j], b = yb[q][j], c = yd[q][j]; const float ka = sa[q][j], kb = sb[q][j], kc = sd[q][j];
                v[j].x = (x.x + (float)((int)(c << 24) >> 24) * kc) + (float)((int)(a << 24) >> 24) * ka + (float)((int)(b << 24) >> 24) * kb;
                v[j].y = (x.y + (float)((int)(c << 16) >> 24) * kc) + (float)((int)(a << 16) >> 24) * ka + (float)((int)(b << 16) >> 24) * kb;
                v[j].z = (x.z + (float)((int)(c << 8) >> 24) * kc) + (float)((int)(a << 8) >> 24) * ka + (float)((int)(b << 8) >> 24) * kb;
                v[j].w = (x.w + (float)((int)c >> 24) * kc) + (float)((int)a >> 24) * ka + (float)((int)b >> 24) * kb;
                s += (v[j].x * v[j].x + v[j].y * v[j].y) + (v[j].z * v[j].z + v[j].w * v[j].w); }
            const float rstd = 1.0f / sqrtf(wave_sum(s) * (1.f / D) + RMS_EPS);
            f32x4* xw = (f32x4*)(dst + (size_t)(m0 + q) * D) + lane;
#pragma unroll
            for (int j = 0; j < 4; ++j) { const f32x4 g = gfin[j]; __builtin_nontemporal_store((f32x4){v[j].x * rstd * g.x, v[j].y * rstd * g.y, v[j].z * rstd * g.z, v[j].w * rstd * g.w}, xw + 64 * j); } }
    }
}

constexpr int N_PHASES = 12;
struct Args { In in; float* out; unsigned char* ws; float* fin_dst; int ph_lo, ph_hi, li, pad; };
__global__ void __launch_bounds__(NWAVES * 64, 2) mk_fwd(Args args) {
    extern __shared__ __attribute__((aligned(16))) unsigned char lds[];
    Frame F;
    F.lds = (LAS unsigned char*)lds;
    F.MISC = (volatile LAS unsigned*)(F.lds + MISC_OFF);
    F.tid = threadIdx.x; F.lane = F.tid & 63; F.wave = __builtin_amdgcn_readfirstlane(F.tid >> 6);
    F.G = gridDim.x; { const int bx = blockIdx.x; F.vcu = (F.G % 8 == 0) ? (bx % 8) * (F.G / 8) + bx / 8 : bx; }
    F.ws = args.ws; F.out = args.out; F.ctl = (unsigned*)(args.ws + WS_CTL); F.in = nullptr;
    const In& I = args.in;
    for (int u = F.tid; u < 256; u += NWAVES * 64) F.MISC[u] = 0u;
    __syncthreads();
    const int lo = args.ph_lo, hi = args.ph_hi;
    XcdBarrier bar; bar.bar = F.ctl + CW_BAR + args.li * XCD_BAR_WORDS; bar.x = 0; bar.st = nullptr;
    if (hi - lo > 1) bar = xcd_barrier_post(F.ctl + CW_BAR + args.li * XCD_BAR_WORDS, F.MISC + 8);
#ifndef PH_MASK
#define PH_MASK 0xFFF
#endif
#define IN(k) (((PH_MASK >> (k)) & 1) && lo <= (k) && (k) < hi)
#define SEAM(k) do { if (IN(k) && IN(NEXT_PH(k))) xcd_barrier(bar); } while (0)
#define NEXT_PH(k) ((k) == 2 ? 5 : (k) == 5 ? 7 : (k) + 1)
    const int cblk = (int)blockIdx.x;
    LAS unsigned char* ring = F.lds;

    if (IN(0)) { p0_prologue(F, I); SEAM(0); }

    if (IN(1)) {
        DenseOrder S; S.init(F.ws + WS_H, F.ws + WS_WIN, D / 2, D / 2, T, NIN, F.G, cblk);
        EpiInProj E{(bf16*)(F.ws + WS_AG), (bf16*)(F.ws + WS_XL), (bf16*)(F.ws + WS_GL), (bf16*)(F.ws + WS_GA), (bf16*)(F.ws + WS_GB), (const float*)(F.ws + SM_HSC), (const float*)(F.ws + SM_WSC), F.lds + TOKL_OFF};
        pg8::gemm_phase<EpiInProj, DenseOrder, true>(ring, D / 2, D / 2, S, E);
        SEAM(1);
    }
    if (IN(2)) {
        if (cblk < 256) {
            const int L = cblk, wgid = (L % 8) * 32 + L / 8, g = wgid >> 3, mt = wgid & 7;
            { S5One S{(const char*)(F.ws + WS_AG) + S5Q * 2, (const char*)(F.ws + WS_BTW), (size_t)S5N * S5K * 2, (size_t)128 * 256 * 2, S5K, g, mt};
              EpiS5State E{(float*)(F.ws + WS_SLOC)};
              pg8::gemm_phase<EpiS5State, S5One, false>(ring, 256, 256, S, E); }
            if (F.wave == 0) { __builtin_amdgcn_fence(__ATOMIC_ACQUIRE, "agent"); VM_WAIT(); }
            __syncthreads();
            s5_chain(F, mt, g);
            VM_WAIT();
            __syncthreads();
            if (F.wave == 0) { __builtin_amdgcn_fence(__ATOMIC_ACQUIRE, "agent"); VM_WAIT(); }
            __syncthreads();
            { S5One S{(const char*)(F.ws + WS_AG), (const char*)(F.ws + WS_BTT), (size_t)S5N * S5K * 2, (size_t)256 * S5K * 2, S5K, g, mt};
              EpiS5Out E{(bf16*)(F.ws + WS_GY)};
              pg8::gemm_phase<EpiS5Out, S5One, false>(ring, S5K, S5K, S, E); }
            __syncthreads();
        }
        lru_seq(F, I);
        SEAM(2);
    }
    if (IN(5)) {
        YaYbOrder S; S.d.init(nullptr, nullptr, D, D, T, D, F.G, cblk);
        S.GYb = (const char*)(F.ws + WS_GY); S.WS5b = (const char*)(F.ws + WS_WS5); S.YLb = (const char*)(F.ws + WS_H); S.WLb = (const char*)(F.ws + WS_WLRU);
        EpiYaYb E{EpiYa{(const bf16*)(F.ws + WS_GA), (bf16*)(F.ws + WS_XL)}, EpiYb{(const bf16*)(F.ws + WS_XL), (const bf16*)(F.ws + WS_GB), (bf16*)(F.ws + WS_GL)}};
        pg8::gemm_phase<EpiYaYb, YaYbOrder, true>(ring, D, D, S, E);
        SEAM(5);
    }
    if (IN(7)) {
        DenseOrder S; S.init(F.ws + WS_GL, F.ws + WS_WO, D, D, T, D, F.G, cblk);
        EpiQ8<false> E{(unsigned char*)(F.ws + WS_D8), (float*)(F.ws + WS_DSC), nullptr};
        pg8::gemm_phase<EpiQ8<false>, DenseOrder, true>(ring, D, D, S, E);
        SEAM(7);
    }
    if (IN(8)) { p8_router(F, I); __syncthreads(); expert_weight_copies(F, I); SEAM(8); }
    if (IN(9)) {
        moe_setup<0>(F);
        MoeOrder<true> S{(const char*)(F.ws + WS_H2), (const char*)(F.ws + WS_WGU), (size_t)1024 * 1024, D / 2, D / 2, F.G, F.vcu, F.MISC, (const LAS int*)(F.lds + TOKL_OFF)};
        EpiGU E{F.ws + WS_ACT, (const LAS float*)(F.lds + SCLL_OFF)};
        pg8::gemm_phase<EpiGU, MoeOrder<true>, true>(ring, D / 2, D / 2, S, E);
        __syncthreads();
        expert_down_copies(F, I);
        SEAM(9);
    }
    if (IN(10)) {
        moe_setup<1>(F);
        MoeOrder<false> S{(const char*)(F.ws + WS_ACT), (const char*)(F.ws + WS_WD), (size_t)1024 * DEXP, DEXP / 2, DEXP / 2, F.G, F.vcu, F.MISC, (const LAS int*)(F.lds + TOKL_OFF)};
        EpiQ8<true> E{(unsigned char*)(F.ws + WS_YS), (float*)(F.ws + WS_YS + 80 * MiB), (const LAS float*)(F.lds + SCLL_OFF)};
        pg8::gemm_phase<EpiQ8<true>, MoeOrder<false>, true>(ring, DEXP / 2, DEXP / 2, S, E);
        SEAM(10);
    }
    if (IN(11)) { p11_final(F, I, args.fin_dst); }
#undef IN
#undef SEAM
}

extern "C" void kernel_launch(void* const* d_in, const int* in_sizes, int n_in, void* d_out, int out_size, void* d_ws, size_t ws_size, hipStream_t stream) {
    static int grid = 0;
    if (grid == 0) {
        if (n_in != 30 || in_sizes[0] != T * D || out_size != T * D || ws_size < WS_END) { fprintf(stderr, "kernel_launch: unexpected shapes / workspace (n_in %d, ws %zu)\n", n_in, ws_size); grid = -1; return; }
        int dev = 0, cus = 0, per_cu = 0;
        if (hipGetDevice(&dev) != hipSuccess || hipDeviceGetAttribute(&cus, hipDeviceAttributeMultiprocessorCount, dev) != hipSuccess) { grid = -1; return; }
        if (hipFuncSetAttribute((const void*)mk_fwd, hipFuncAttributeMaxDynamicSharedMemorySize, LDS_BYTES) != hipSuccess) { fprintf(stderr, "kernel_launch: hipFuncSetAttribute failed\n"); grid = -1; return; }
        if (hipOccupancyMaxActiveBlocksPerMultiprocessor(&per_cu, (const void*)mk_fwd, NWAVES * 64, LDS_BYTES) != hipSuccess || per_cu < 1) { fprintf(stderr, "kernel_launch: occupancy query says %d\n", per_cu); }
        (void)hipGetLastError();
        grid = cus;
    }
    if (grid < 0) return;
    if (hipMemsetAsync((char*)d_ws + WS_CTL, 0, CTL_ZERO_BYTES, stream) != hipSuccess) return;
    Args a{};
    for (int i = 0; i < 30; ++i) a.in.p[i] = (const float*)d_in[i];
    a.out = (float*)d_out; a.ws = (unsigned char*)d_ws; a.fin_dst = (float*)d_out;
#if defined(PROBE_LO)
    a.ph_lo = 0; a.ph_hi = PROBE_HI; a.li = 0;
#if PROBE_LO == 11
    a.fin_dst = (float*)((char*)d_ws + WS_H2);
#endif
    hipLaunchKernelGGL(mk_fwd, dim3(grid), dim3(NWAVES * 64), LDS_BYTES, stream, a);
#if PROBE_LO == 8
    hipMemsetAsync((char*)d_ws + WS_CTL + CW_CNT * 4, 0, 128, stream);
#endif
    a.fin_dst = (float*)d_out;
    a.ph_lo = PROBE_LO; a.ph_hi = N_PHASES; a.li = 1;
    hipLaunchKernelGGL(mk_fwd, dim3(grid), dim3(NWAVES * 64), LDS_BYTES, stream, a);
#elif MK_N_LAUNCHES == 1
    a.ph_lo = 0; a.ph_hi = N_PHASES;
    hipLaunchKernelGGL(mk_fwd, dim3(grid), dim3(NWAVES * 64), LDS_BYTES, stream, a);
#else
    for (int p = 0; p < N_PHASES; ++p) { a.ph_lo = p; a.ph_hi = p + 1; hipLaunchKernelGGL(mk_fwd, dim3(grid), dim3(NWAVES * 64), LDS_BYTES, stream, a); }
#endif
}
```

```cpp
#include <hip/hip_runtime.h>
#include <cstdio>
#include <cstdint>

#ifndef MK_N_LAUNCHES
#define MK_N_LAUNCHES 1
#endif

namespace pg8 {
#define PG8_LAS __attribute__((address_space(3)))
typedef unsigned short bf16_t;
typedef short bf16x8 __attribute__((ext_vector_type(8)));
typedef float f32x4 __attribute__((ext_vector_type(4)));
typedef unsigned u32x4 __attribute__((ext_vector_type(4)));
typedef int i32x4 __attribute__((ext_vector_type(4)));
template <class E, class = void> struct epi_i8 { static constexpr bool v = false; };
template <class E> struct epi_i8<E, decltype((void)E::I8)> { static constexpr bool v = E::I8; };
template <class E, class = void> struct epi_f8 { static constexpr bool v = false; };
template <class E> struct epi_f8<E, decltype((void)E::F8)> { static constexpr bool v = E::F8; };
typedef int i32x8 __attribute__((ext_vector_type(8)));
template <bool I8> struct acc_sel { typedef f32x4 t; };
template <> struct acc_sel<true> { typedef i32x4 t; };
constexpr int BM = 256, BK = 64, HALF = 128, HTB = HALF * BK * 2  , STAGE_BYTES = 8 * HTB, NXCD = 8, WGM = 8;

__host__ __device__ __forceinline__ int lds_byte(int r, int c) { const int st = (r >> 4) * 2 + (c >> 5), rr = r & 15, cc = c & 31, ob = rr * 64 + cc * 2; return st * 1024 + (ob ^ (((ob >> 9) & 1) << 5)); }
__host__ __device__ __forceinline__ void stage_rc(int b, int& R, int& C) { const int st = b / 1024, sb = b % 1024, swz = sb ^ (((sb >> 9) & 1) << 5); R = (st >> 1) * 16 + swz / 64; C = (st & 1) * 32 + (swz % 64) / 2; }
__host__ __device__ __forceinline__ int perm32(int rho) { const int n = rho >> 4, i = rho & 15; return 8 * (i >> 2) + 4 * n + (i & 3); }

struct Unit { const char* A; const char* B; int pm, pn, aux, nt, kind; unsigned kA; };

__device__ __forceinline__ unsigned cvt_pk_bf16(float lo, float hi) { unsigned r; asm volatile("v_cvt_pk_bf16_f32 %0, %1, %2" : "=v"(r) : "v"(lo), "v"(hi)); return r; }

template <class Epi, class Sched, bool ALIGN_EPI>
__device__ __forceinline__ void gemm_phase(PG8_LAS unsigned char* lds, const int ldb, const int K, const Sched& S, const Epi& E, const size_t kstepA = (size_t)(BK * 2)) {
    const int tid = threadIdx.x, wid = __builtin_amdgcn_readfirstlane(tid >> 6), lane = tid & 63, wr = wid >> 2, wc = wid & 3, fr = lane & 15, fq = lane >> 4;
    constexpr bool I8 = epi_i8<Epi>::v, F8 = epi_f8<Epi>::v; typedef typename acc_sel<I8>::t acc_t;
    int nt = K / BK; asm volatile("" : "+s"(nt));
    int Rr[2], Cc[2], Rbb[2]; unsigned voffB[4], vAc[4], vAn[4];
#pragma unroll
    for (int i = 0; i < 2; ++i) { int R, C; stage_rc(tid * 16 + i * 8192, R, C); Rr[i] = R; Cc[i] = C; const int Rb = Epi::PERM ? ((R & ~31) + perm32(R & 31)) : R; Rbb[i] = Rb;
        int Rb0 = Rb, Rb1 = HALF + Rb;
        if constexpr (Epi::B16) {
            const int w_ = R >> 5, nn_ = (R >> 4) & 1, ii_ = R & 15; Rb0 = 64 * w_ + 16 * (ii_ >> 2) + 4 * nn_ + (ii_ & 3); Rb1 = Rb0 + 8; }
        voffB[i] = (unsigned)(Rb0 * ldb + C) * 2u; voffB[2 + i] = (unsigned)(Rb1 * ldb + C) * 2u; }
    const size_t kstep = (size_t)(BK * 2);
    const unsigned ldsw = (unsigned)wid * 1024u;
    const int aoff = lds_byte(wr * 64 + fr, fq * 8), boff = lds_byte(wc * 32 + fr, fq * 8);
#define PG8_SA(b, h) (((b) * 2 + (h)) * HTB)
#define PG8_SB(b, h) ((4 + (b) * 2 + (h)) * HTB)
#define PG8_STAGE(bufoff, gbase, voff, h) do { _Pragma("unroll") for (int _i = 0; _i < 2; ++_i) \
        __builtin_amdgcn_global_load_lds((const unsigned*)((const char*)(gbase) + (voff)[2 * (h) + _i]), (PG8_LAS unsigned*)(lds + (bufoff) + ldsw + _i * 8192), 16, 0, 0); } while (0)
#define PG8_LDA(dst, b, h) do { _Pragma("unroll") for (int m = 0; m < 4; ++m) _Pragma("unroll") for (int k = 0; k < 2; ++k) dst[m][k] = *(const PG8_LAS bf16x8*)(lds + PG8_SA(b, h) + aoff + m * 2048 + k * 1024); } while (0)
#define PG8_LDB(dst, b, h) do { _Pragma("unroll") for (int n = 0; n < 2; ++n) _Pragma("unroll") for (int k = 0; k < 2; ++k) dst[n][k] = *(const PG8_LAS bf16x8*)(lds + PG8_SB(b, h) + boff + n * 2048 + k * 1024); } while (0)
#define PG8_MMA(ai, bj, At, Bt) do { __builtin_amdgcn_s_setprio(1); _Pragma("unroll") for (int m = 0; m < 4; ++m) _Pragma("unroll") for (int n = 0; n < 2; ++n) { \
        if constexpr (F8) { const i32x4 b0_ = __builtin_bit_cast(i32x4, Bt[n][0]), b1_ = __builtin_bit_cast(i32x4, Bt[n][1]), a0_ = __builtin_bit_cast(i32x4, At[m][0]), a1_ = __builtin_bit_cast(i32x4, At[m][1]); \
            acc[ai][bj][m][n] = __builtin_amdgcn_mfma_scale_f32_16x16x128_f8f6f4((i32x8){b0_[0], b0_[1], b0_[2], b0_[3], b1_[0], b1_[1], b1_[2], b1_[3]}, (i32x8){a0_[0], a0_[1], a0_[2], a0_[3], a1_[0], a1_[1], a1_[2], a1_[3]}, acc[ai][bj][m][n], 0, 0, 0, 0, 0, 0); } \
        else { _Pragma("unroll") for (int k = 0; k < 2; ++k) { \
          if constexpr (I8) acc[ai][bj][m][n] = __builtin_amdgcn_mfma_i32_16x16x64_i8(__builtin_bit_cast(i32x4, Bt[n][k]), __builtin_bit_cast(i32x4, At[m][k]), acc[ai][bj][m][n], 0, 0, 0); \
          else acc[ai][bj][m][n] = __builtin_amdgcn_mfma_f32_16x16x32_bf16(Bt[n][k], At[m][k], acc[ai][bj][m][n], 0, 0, 0); } } } __builtin_amdgcn_s_setprio(0); } while (0)
#define PG8_WAIT_V(n) asm volatile("s_waitcnt vmcnt(" #n ")" ::: "memory")
#define PG8_WAIT_L(n) asm volatile("s_waitcnt lgkmcnt(" #n ")" ::: "memory")
#define PG8_BAR __builtin_amdgcn_s_barrier()
#define PG8_SCHED __builtin_amdgcn_sched_barrier(0)
    Unit cur, nxt; int ui = 0;
    if (!S.next(0, cur)) return;
    S.a_offsets(cur, Rr, Cc, vAc);
    unsigned vBc[4], vBn[4];
    if constexpr (Sched::HETERO) { S.b_offsets(cur, Rbb, Cc, vBc); nt = __builtin_amdgcn_readfirstlane(cur.nt); }
    else {
#pragma unroll
        for (int q = 0; q < 4; ++q) vBc[q] = voffB[q]; }
    size_t kAc = Sched::HETERO ? (size_t)(unsigned)__builtin_amdgcn_readfirstlane((int)cur.kA) : kstepA;
    acc_t acc[2][2][4][2];
    if constexpr (Epi::ACC_INIT) E.init(acc, cur, wr, wc, fr, fq);
    else {
#pragma unroll
    for (int a = 0; a < 2; ++a)
#pragma unroll
        for (int b = 0; b < 2; ++b)
#pragma unroll
            for (int m = 0; m < 4; ++m)
#pragma unroll
                for (int n = 0; n < 2; ++n) acc[a][b][m][n] = acc_t{}; }
    bf16x8 At[4][2], B0[2][2], B1[2][2];
    const char* cA = cur.A; const char* cB = cur.B;
    if constexpr (Sched::GATHER) { PG8_WAIT_L(0); }
    PG8_STAGE(PG8_SB(0, 0), cB, vBc, 0); PG8_STAGE(PG8_SB(0, 1), cB, vBc, 1); PG8_STAGE(PG8_SA(0, 0), cA, vAc, 0); PG8_STAGE(PG8_SA(0, 1), cA, vAc, 1);
    if (wr == 1) PG8_BAR;
    PG8_WAIT_V(2); PG8_BAR;
    PG8_STAGE(PG8_SB(1, 0), cB + kstep, vBc, 0); PG8_STAGE(PG8_SA(1, 0), cA + kAc, vAc, 0); PG8_STAGE(PG8_SB(1, 1), cB + kstep, vBc, 1);
    PG8_WAIT_V(6); PG8_BAR;
    for (;;) {
        const bool has_next = S.next(ui + 1, nxt);
        const char* nA = has_next ? nxt.A : cA; const char* nB = has_next ? nxt.B : cB;
        size_t kAn = kAc;
        if constexpr (Sched::HETERO) { if (has_next) { S.b_offsets(nxt, Rbb, Cc, vBn); kAn = (size_t)(unsigned)__builtin_amdgcn_readfirstlane((int)nxt.kA); } else {
#pragma unroll
                for (int q = 0; q < 4; ++q) vBn[q] = vBc[q]; } }
        for (int t = 0; t < nt; t += 2) {
            const bool last = (t == nt - 2);
            const char* a1 = cA + (size_t)(t + 1) * kAc;
            const char* a2 = last ? nA : cA + (size_t)(t + 2) * kAc; const char* b2 = last ? nB : cB + (size_t)(t + 2) * kstep;
            const char* a3 = a2 + (last ? kAn : kAc); const char* b3 = b2 + kstep;
            unsigned vb2[4];
#pragma unroll
            for (int q = 0; q < 4; ++q) vb2[q] = (Sched::HETERO && last) ? vBn[q] : vBc[q];
            unsigned va2[4];
            if constexpr (Sched::GATHER || Sched::HETERO) {
                if (last) { if (has_next) { S.a_offsets(nxt, Rr, Cc, vAn); if constexpr (Sched::GATHER) { PG8_WAIT_L(0); } } else {
#pragma unroll
                        for (int q = 0; q < 4; ++q) vAn[q] = vAc[q]; } }
#pragma unroll
                for (int q = 0; q < 4; ++q) va2[q] = last ? vAn[q] : vAc[q];
            } else {
#pragma unroll
                for (int q = 0; q < 4; ++q) va2[q] = vAc[q];
            }
            PG8_LDB(B0, 0, 0); PG8_LDB(B1, 0, 1); PG8_SCHED; PG8_LDA(At, 0, 0); PG8_STAGE(PG8_SA(1, 1), a1, vAc, 1);
            PG8_WAIT_V(8); PG8_WAIT_L(0); PG8_BAR; PG8_MMA(0, 0, At, B0); PG8_MMA(0, 1, At, B1); PG8_BAR; PG8_SCHED;
            const bool fin = last && !has_next;
            PG8_LDA(At, 0, 1);
            if (!fin) { PG8_STAGE(PG8_SB(0, 0), b2, vb2, 0); PG8_STAGE(PG8_SB(0, 1), b2, vb2, 1); PG8_STAGE(PG8_SA(0, 0), a2, va2, 0); PG8_WAIT_V(8); } else { PG8_WAIT_V(0); }
            PG8_WAIT_L(0); PG8_BAR; PG8_MMA(1, 0, At, B0); PG8_MMA(1, 1, At, B1); PG8_BAR; PG8_SCHED;
            PG8_LDB(B0, 1, 0); PG8_LDB(B1, 1, 1); PG8_SCHED; PG8_LDA(At, 1, 0);
            if (!fin) { PG8_STAGE(PG8_SA(0, 1), a2, va2, 1); PG8_WAIT_V(8); } else { PG8_WAIT_V(0); }
            PG8_WAIT_L(0); PG8_BAR; PG8_MMA(0, 0, At, B0); PG8_MMA(0, 1, At, B1); PG8_BAR; PG8_SCHED;
            PG8_LDA(At, 1, 1);
            if (!fin) { PG8_STAGE(PG8_SB(1, 0), b3, vb2, 0); PG8_STAGE(PG8_SB(1, 1), b3, vb2, 1); PG8_STAGE(PG8_SA(1, 0), a3, va2, 0); PG8_WAIT_V(8); } else { PG8_WAIT_V(0); }
            PG8_WAIT_L(0); PG8_BAR; PG8_MMA(1, 0, At, B0); PG8_MMA(1, 1, At, B1); PG8_BAR; PG8_SCHED;
        }
        if constexpr (ALIGN_EPI) { if (wr == 0) PG8_BAR; }
        E(acc, cur, wr, wc, fr, fq);
        if (!has_next) break;
        if constexpr (Epi::ACC_INIT) E.init(acc, nxt, wr, wc, fr, fq);
        else {
#pragma unroll
        for (int a = 0; a < 2; ++a)
#pragma unroll
            for (int b = 0; b < 2; ++b)
#pragma unroll
                for (int m = 0; m < 4; ++m)
#pragma unroll
                    for (int n = 0; n < 2; ++n) acc[a][b][m][n] = acc_t{}; }
        cur = nxt; cA = nA; cB = nB; ++ui;
        if constexpr (Sched::GATHER || Sched::HETERO) {
#pragma unroll
            for (int q = 0; q < 4; ++q) vAc[q] = vAn[q]; }
        if constexpr (Sched::HETERO) {
#pragma unroll
            for (int q = 0; q < 4; ++q) vBc[q] = vBn[q];
            kAc = kAn; nt = __builtin_amdgcn_readfirstlane(cur.nt); }
        if constexpr (ALIGN_EPI) { if (wr == 1) PG8_BAR; }
    }
    PG8_WAIT_V(0);
    if constexpr (!ALIGN_EPI) { if (wr == 0) PG8_BAR; }
    PG8_BAR;
#undef PG8_SA
#undef PG8_SB
#undef PG8_STAGE
#undef PG8_LDA
#undef PG8_LDB
#undef PG8_MMA
#undef PG8_WAIT_V
#undef PG8_WAIT_L
#undef PG8_BAR
#undef PG8_SCHED
}
}

constexpr int NWAVES = 8;
constexpr int BATCH = 8, SEQ = 4096, D = 1024, T = BATCH * SEQ;
constexpr int S5W = 512, S5G = 32, S5C = 16, S5P = 64, S5Q = 128;
constexpr int S5LC = 16, S5NCH = SEQ / S5LC, S5N = BATCH * S5NCH;
constexpr int S5K = S5Q + S5LC * S5C;
constexpr int LRUW = 1024, LRUH = 16, LRUHD = 64, LRUCH = 64, LRUNCH = SEQ / LRUCH;
constexpr int NIN = S5W + 2 * LRUW + 2 * D;
constexpr int NEXP = 32, EPG = 8, NGRP = 4, DEXP = 512, NROUT = 48;
constexpr int MAXSLOT = 73728;
constexpr int MAXU = 8;
constexpr float RMS_EPS = 1e-6f;

constexpr size_t MiB = 1u << 20;
constexpr size_t WS_CTL = 0, CTL_ZERO_BYTES = 128 * 1024;
constexpr size_t WS_SMALL = 1 * MiB;
constexpr size_t SM_LAM16 = WS_SMALL + 0;
constexpr size_t SM_LRUC = WS_SMALL + 16384;
constexpr size_t SM_WRT = WS_SMALL + 32768;
constexpr size_t SM_RHI = WS_SMALL + 327680;
constexpr size_t SM_RLO = SM_RHI + 98304;
constexpr size_t SM_RSTD = WS_SMALL + 524288;
constexpr size_t SM_HSC = WS_SMALL + 720896;
constexpr size_t SM_WSC = WS_SMALL + 851968;
constexpr size_t WS_BTT = 2 * MiB;
constexpr size_t WS_BTW = 8 * MiB;
constexpr size_t WS_WIN = 11 * MiB;
constexpr size_t WS_WS5 = 20 * MiB;
constexpr size_t WS_WLRU = 22 * MiB;
constexpr size_t WS_WO = 24 * MiB;
constexpr size_t WS_LP = 26 * MiB, WS_LH = 28 * MiB, WS_LHIN = 30 * MiB;
constexpr size_t WS_AG = 32 * MiB;
constexpr size_t WS_SLOC = 80 * MiB;
constexpr size_t WS_H = 112 * MiB;
constexpr size_t WS_XL = 176 * MiB;
constexpr size_t WS_GL = 240 * MiB;
constexpr size_t WS_GA = 304 * MiB, WS_GB = 336 * MiB;
constexpr size_t WS_GY = 368 * MiB;
constexpr size_t WS_D8 = 336 * MiB, WS_DSC = 368 * MiB;
constexpr size_t WS_WGU = 400 * MiB;
constexpr size_t WS_WD = 464 * MiB;
constexpr size_t WS_H2 = 32 * MiB;
constexpr size_t WS_ACT = 96 * MiB;
constexpr size_t WS_YS = 168 * MiB;
constexpr size_t WS_LTOK = 312 * MiB, WS_LW = 316 * MiB;
constexpr size_t WS_TOKE = 320 * MiB, WS_TOKR = WS_TOKE + 262144;
constexpr size_t WS_END = 496 * MiB;
static_assert(WS_YS + (size_t)MAXSLOT * 1024 * 2 <= WS_LTOK && WS_ACT + (size_t)MAXSLOT * 512 * 2 <= WS_YS && WS_TOKR + 262144 <= WS_WGU && WS_GY + (size_t)T * 512 * 2 <= WS_WGU && WS_WD + (size_t)32 * 1024 * 512 * 2 <= WS_END, "d_ws map");
constexpr int CW_BAR = 4096;
constexpr int CW_CNT = 16384;

constexpr int RING_BYTES = 131072;
constexpr int TOKL_OFF = RING_BYTES, SCLL_OFF = TOKL_OFF + MAXU * 256 * 4, MISC_OFF = SCLL_OFF + MAXU * 256 * 4;
constexpr int LDS_BYTES = MISC_OFF + 1024;

#define GAS __attribute__((address_space(1)))
#define LAS __attribute__((address_space(3)))
typedef unsigned short bf16;
typedef unsigned v4u __attribute__((ext_vector_type(4)));
typedef unsigned v2u __attribute__((ext_vector_type(2)));
typedef float f32x4 __attribute__((ext_vector_type(4)));
typedef int i32x4 __attribute__((ext_vector_type(4)));
typedef short bf16x8 __attribute__((ext_vector_type(8)));
#define LDS_WAIT() asm volatile("s_waitcnt lgkmcnt(0)" ::: "memory")
#define VM_WAIT() asm volatile("s_waitcnt vmcnt(0)" ::: "memory")
__device__ __forceinline__ unsigned pk2(float lo, float hi) { unsigned r; asm volatile("v_cvt_pk_bf16_f32 %0, %1, %2" : "=v"(r) : "v"(lo), "v"(hi)); return r; }
__device__ __forceinline__ unsigned f2bf(float f) { return pk2(f, 0.f) & 0xffffu; }
__device__ __forceinline__ float bf2f(unsigned h) { return __builtin_bit_cast(float, h << 16); }
__device__ __forceinline__ float bflo(unsigned w) { return __builtin_bit_cast(float, w << 16); }
__device__ __forceinline__ float bfhi(unsigned w) { return __builtin_bit_cast(float, w & 0xffff0000u); }
__device__ __forceinline__ float fsigmoid(float x) { return __builtin_amdgcn_rcpf(1.0f + __builtin_amdgcn_exp2f(-1.44269504f * x)); }
__device__ __forceinline__ float gelu_t(float x) { const float u = x * (0.7978845608f + 0.0356774081f * x * x); return x * __builtin_amdgcn_rcpf(1.0f + __builtin_amdgcn_exp2f(-2.88539008f * u)); }
__device__ __forceinline__ unsigned pk_fp8x4(float a, float b, float c, float d) { int w = 0; w = __builtin_amdgcn_cvt_pk_fp8_f32(a, b, w, false); w = __builtin_amdgcn_cvt_pk_fp8_f32(c, d, w, true); return (unsigned)w; }
__device__ __forceinline__ float wave_sum(float v) {
#pragma unroll
    for (int o = 1; o < 64; o <<= 1) v += __shfl_xor(v, o);
    return v;
}

#define XB_TMO      128
#define XB_XCNT(j)  (256  + 64 * (j))
#define XB_XSUB(j)  (1280 + 64 * (j))
#define XB_XGEN(j)  (2304 + 64 * (j))
#define XB_TOP      3328
#define XB_TOPGEN   3392
#define XCD_BAR_WORDS 3456
#define XB_SPIN_CAP (1u << 18)
__device__ __forceinline__ unsigned xb_ld(unsigned* p)              { return __hip_atomic_load(p, __ATOMIC_RELAXED, __HIP_MEMORY_SCOPE_AGENT); }
__device__ __forceinline__ unsigned xb_add(unsigned* p, unsigned v) { return __hip_atomic_fetch_add(p, v, __ATOMIC_RELAXED, __HIP_MEMORY_SCOPE_AGENT); }
__device__ __forceinline__ unsigned xb_xcc_id() { return (unsigned)__builtin_amdgcn_s_getreg((3 << 11) | 20) & 0xFu; }
#define XB_SPIN(cond, bar) do { unsigned _sp = 0; while (cond) { __builtin_amdgcn_s_sleep(1); \
    if ((++_sp & 255u) == 0u) { if (xb_ld(&(bar)[XB_TMO])) break; if (_sp > XB_SPIN_CAP) { atomicAdd(&(bar)[XB_TMO], 1u); break; } } } } while (0)
struct XcdBarrier { unsigned* bar; unsigned x; volatile LAS unsigned* st; };
__device__ __forceinline__ XcdBarrier xcd_barrier_post(unsigned* bar, volatile LAS unsigned* st) {
    XcdBarrier b; b.bar = bar; b.x = xb_xcc_id(); b.st = st;
    if (threadIdx.x == 0) (void)xb_add(&bar[XB_XCNT(b.x)], 1u);
    return b;
}
__device__ __forceinline__ void xcd_barrier_complete(unsigned* bar, unsigned x, unsigned& nloc, unsigned& nx) {
    const unsigned G = gridDim.x * gridDim.y * gridDim.z;
    unsigned sum, cnt, mine, sp = 0u;
    for (;;) {
        sum = 0u; cnt = 0u; mine = 0u;
#pragma unroll
        for (unsigned j = 0; j < 16; ++j) { const unsigned c = xb_ld(&bar[XB_XCNT(j)]); sum += c; cnt += (c > 0u) ? 1u : 0u; mine = (j == x) ? c : mine; }
        if (sum == G) break;
        __builtin_amdgcn_s_sleep(1);
        if ((++sp & 255u) == 0u) { if (xb_ld(&bar[XB_TMO])) break; if (sp > XB_SPIN_CAP) { atomicAdd(&bar[XB_TMO], 1u); break; } }
    }
    nloc = mine > 0u ? mine : 1u; nx = cnt > 0u ? cnt : 1u;
}
__device__ __forceinline__ void xcd_barrier(const XcdBarrier& b) {
    asm volatile("s_waitcnt vmcnt(0)" ::: "memory");
    __syncthreads();
    if (threadIdx.x == 0) {
        unsigned* bar = b.bar;
        __builtin_amdgcn_s_waitcnt(0);
        unsigned nloc = b.st[0], nx = b.st[1];
        if (nloc == 0u) { xcd_barrier_complete(bar, b.x, nloc, nx); b.st[0] = nloc; b.st[1] = nx; }
        const unsigned old = xb_add(&bar[XB_XSUB(b.x)], 1u);
        const unsigned gen = old / nloc;
        if (old + 1u == (gen + 1u) * nloc) {
            __builtin_amdgcn_fence(__ATOMIC_RELEASE, "agent");
            asm volatile("s_waitcnt vmcnt(0)" ::: "memory");
            const unsigned og = xb_add(&bar[XB_TOP], 1u);
            const unsigned tg = og / nx;
            if (og + 1u == (tg + 1u) * nx) xb_add(&bar[XB_TOPGEN], 1u);
            else XB_SPIN(xb_ld(&bar[XB_TOPGEN]) == tg, bar);
            __builtin_amdgcn_fence(__ATOMIC_ACQUIRE, "agent");
            xb_add(&bar[XB_XGEN(b.x)], 1u);
            asm volatile("s_waitcnt vmcnt(0)" ::: "memory");
        } else {
            XB_SPIN(xb_ld(&bar[XB_XGEN(b.x)]) == gen, bar);
            __builtin_amdgcn_fence(__ATOMIC_ACQUIRE, "agent");
            asm volatile("s_waitcnt vmcnt(0)" ::: "memory");
        }
    }
    __syncthreads();
}

struct Frame {
    LAS unsigned char* lds;
    volatile LAS unsigned* MISC;
    unsigned* ctl;
    int tid, lane, wave, vcu, G;
    const float* const* in;
    unsigned char* ws; float* out;
};

using pg8::Unit;
struct DenseOrder {
    static constexpr bool GATHER = false, HETERO = false;
    const char* A0; const char* B0; int lda, ldb, nM, nN, nwg, G, c;
    __device__ __forceinline__ void init(const void* A, const void* B, int lda_, int ldb_, int M, int N, int G_, int c_) { A0 = (const char*)A; B0 = (const char*)B; lda = lda_; ldb = ldb_; nM = M / 256; nN = N / 256; nwg = nM * nN; G = G_; c = c_; }
    __device__ __forceinline__ bool next(int i, Unit& u) const {
        const long L = (long)i * G + c; if (L >= nwg) return false;
        int wgid = (int)L; { const int q = nwg / 8, r = nwg % 8, xcd = wgid % 8, off = wgid / 8; wgid = (xcd < r ? xcd * (q + 1) : r * (q + 1) + (xcd - r) * q) + off; }
        const int nig = 8 * nN, gid = wgid / nig, fm = gid * 8, gsz = (nM - fm) < 8 ? (nM - fm) : 8;
        u.pm = fm + ((wgid % nig) % gsz); u.pn = (wgid % nig) / gsz; u.aux = i & 1;
        u.A = A0 + (size_t)u.pm * 256 * lda * 2; u.B = B0 + (size_t)u.pn * 256 * ldb * 2; return true;
    }
    __device__ __forceinline__ void a_offsets(const Unit&, const int (&R)[2], const int (&C)[2], unsigned (&v)[4]) const {
#pragma unroll
        for (int i = 0; i < 2; ++i) { v[i] = (unsigned)(R[i] * lda + C[i]) * 2u; v[2 + i] = (unsigned)((128 + R[i]) * lda + C[i]) * 2u; }
    }
};
struct S5One {
    static constexpr bool GATHER = false, HETERO = false;
    const char* A0; const char* B0; size_t sA, sB; int lda, g, mt;
    __device__ __forceinline__ bool next(int i, Unit& u) const {
        if (i > 0) return false;
        u.pm = mt; u.pn = 0; u.aux = g; u.A = A0 + (size_t)g * sA + (size_t)mt * 256 * lda * 2; u.B = B0 + (size_t)g * sB; return true;
    }
    __device__ __forceinline__ void a_offsets(const Unit&, const int (&R)[2], const int (&C)[2], unsigned (&v)[4]) const {
#pragma unroll
        for (int i = 0; i < 2; ++i) { v[i] = (unsigned)(R[i] * lda + C[i]) * 2u; v[2 + i] = (unsigned)((128 + R[i]) * lda + C[i]) * 2u; }
    }
};
struct GyOrder {
    static constexpr bool GATHER = false, HETERO = false;
    DenseOrder d;
    __device__ __forceinline__ bool next(int i, Unit& u) const { if (!d.next(i, u)) return false; u.A = d.A0 + (size_t)u.pm * 256 * 32; return true; }
    __device__ __forceinline__ void a_offsets(const Unit&, const int (&R)[2], const int (&C)[2], unsigned (&v)[4]) const {
#pragma unroll
        for (int i = 0; i < 2; ++i) { const unsigned o = (unsigned)(C[i] >> 4) * (unsigned)(T * 32) + (unsigned)(C[i] & 15) * 2u; v[i] = (unsigned)R[i] * 32u + o; v[2 + i] = (unsigned)(128 + R[i]) * 32u + o; }
    }
};
struct YaYbOrder {
    static constexpr bool GATHER = false, HETERO = true;
    DenseOrder d;
    const char* GYb; const char* WS5b; const char* YLb; const char* WLb;
    __device__ __forceinline__ bool next(int i, Unit& u) const {
        const int j = i / 3, r = i - 3 * j; Unit t;
        if (!d.next(j, t)) return false;
        u.pm = t.pm; u.aux = 0;
        if (r < 2) { u.kind = 0; u.pn = 2 * t.pn + r; u.nt = S5W / 64; u.kA = (unsigned)(4 * T * 32); u.A = GYb + (size_t)t.pm * 256 * 32; u.B = WS5b + (size_t)u.pn * 256 * S5W * 2; }
        else { u.kind = 1; u.pn = t.pn; u.nt = D / 64; u.kA = 128u; u.A = YLb + (size_t)t.pm * 256 * D * 2; u.B = WLb + (size_t)t.pn * 256 * D * 2; }
        return true;
    }
    __device__ __forceinline__ void a_offsets(const Unit& u, const int (&R)[2], const int (&C)[2], unsigned (&v)[4]) const {
#pragma unroll
        for (int i = 0; i < 2; ++i) {
            const unsigned og = (unsigned)(C[i] >> 4) * (unsigned)(T * 32) + (unsigned)(C[i] & 15) * 2u;
            const unsigned g0 = (unsigned)R[i] * 32u + og, g1 = (unsigned)(128 + R[i]) * 32u + og;
            const unsigned d0 = (unsigned)(R[i] * D + C[i]) * 2u, d1 = (unsigned)((128 + R[i]) * D + C[i]) * 2u;
            v[i] = u.kind ? d0 : g0; v[2 + i] = u.kind ? d1 : g1; }
    }
    __device__ __forceinline__ void b_offsets(const Unit& u, const int (&Rb)[2], const int (&C)[2], unsigned (&v)[4]) const {
        const int ldb = u.kind ? D : S5W;
#pragma unroll
        for (int i = 0; i < 2; ++i) { v[i] = (unsigned)(Rb[i] * ldb + C[i]) * 2u; v[2 + i] = (unsigned)((128 + Rb[i]) * ldb + C[i]) * 2u; }
    }
};
template <bool GATH> struct MoeOrder {
    static constexpr bool GATHER = GATH, HETERO = false;
    const char* A0; const char* B0; size_t sBe; int lda, ldb, G, c; volatile LAS unsigned* MISC; const LAS int* tokL;
    __device__ __forceinline__ bool next(int i, Unit& u) const {
        if (i >= (int)MISC[152]) return false;
        const int e = (int)MISC[136 + i], mtg = (int)MISC[96 + e] + (int)MISC[144 + i], L = i * G + c;
        u.pm = mtg; u.pn = L & 3; u.aux = i;
        u.A = GATH ? A0 : A0 + (size_t)mtg * 256 * lda * 2; u.B = B0 + (size_t)e * sBe + (size_t)u.pn * 256 * ldb * 2; return true;
    }
    __device__ __forceinline__ void a_offsets(const Unit& u, const int (&R)[2], const int (&C)[2], unsigned (&v)[4]) const {
#pragma unroll
        for (int i = 0; i < 2; ++i) {
            if constexpr (GATH) { v[i] = (unsigned)tokL[u.aux * 256 + R[i]] * (unsigned)(lda * 2) + (unsigned)C[i] * 2u; v[2 + i] = (unsigned)tokL[u.aux * 256 + 128 + R[i]] * (unsigned)(lda * 2) + (unsigned)C[i] * 2u; }
            else { v[i] = (unsigned)(R[i] * lda + C[i]) * 2u; v[2 + i] = (unsigned)((128 + R[i]) * lda + C[i]) * 2u; } }
    }
};

using pg8::cvt_pk_bf16;
template <int ACT> __device__ __forceinline__ float actf(float x) { if (ACT == 1) return gelu_t(x); if (ACT == 2) return fsigmoid(x); return x; }
__device__ __forceinline__ v4u pack8(const f32x4 a, const f32x4 b) { v4u w; w.x = cvt_pk_bf16(a[0], a[1]); w.y = cvt_pk_bf16(a[2], a[3]); w.z = cvt_pk_bf16(b[0], b[1]); w.w = cvt_pk_bf16(b[2], b[3]); return w; }

__device__ __forceinline__ void unpack_u8x8(const v2u w, float (&f)[8]) {
    const float k = 1.0f / 255.0f;
    f[0] = (float)(w.x & 0xffu) * k; f[1] = (float)((w.x >> 8) & 0xffu) * k; f[2] = (float)((w.x >> 16) & 0xffu) * k; f[3] = (float)(w.x >> 24) * k;
    f[4] = (float)(w.y & 0xffu) * k; f[5] = (float)((w.y >> 8) & 0xffu) * k; f[6] = (float)((w.y >> 16) & 0xffu) * k; f[7] = (float)(w.y >> 24) * k;
}
struct EpiInProj {
    static constexpr bool PERM = true, ACC_INIT = true, B16 = false, I8 = true;
    bf16 *AG, *XL, *GL, *GA, *GB; const float* HS; const float* WSC; LAS unsigned char* sl;
    __device__ __forceinline__ void init(i32x4 (&acc)[2][2][4][2], const Unit& u, int wr, int wc, int fr, int fq) const {
#pragma unroll
        for (int a = 0; a < 2; ++a)
#pragma unroll
            for (int b = 0; b < 2; ++b)
#pragma unroll
                for (int m = 0; m < 4; ++m)
#pragma unroll
                    for (int n = 0; n < 2; ++n) acc[a][b][m][n] = i32x4{};
        const int w = wr * 4 + wc, lane = fq * 16 + fr;
        const int pm = __builtin_amdgcn_readfirstlane(u.pm), pn = __builtin_amdgcn_readfirstlane(u.pn), par = __builtin_amdgcn_readfirstlane(u.aux);
        const float* src = w < 4 ? HS + pm * 256 + w * 64 : WSC + pn * 256 + (w - 4) * 64;
        __builtin_amdgcn_global_load_lds((const unsigned*)(src + lane), (LAS unsigned*)(sl + par * 2048 + w * 256), 4, 0, 0);
    }
    template <int MODE  > __device__ __forceinline__ void tile(const i32x4 (&acc)[2][2][4][2], const Unit& u, bf16* base, int colbase, bool s5, int wr, int wc, int fr, int fq) const {
        const LAS float* sb = (const LAS float*)(sl + __builtin_amdgcn_readfirstlane(u.aux) * 2048);
        f32x4 wsv[2][2];
#pragma unroll
        for (int bj = 0; bj < 2; ++bj)
#pragma unroll
            for (int n = 0; n < 2; ++n) wsv[bj][n] = *(const LAS f32x4*)(sb + 256 + bj * 128 + wc * 32 + 8 * fq + 4 * n);
#pragma unroll
        for (int ai = 0; ai < 2; ++ai)
#pragma unroll
            for (int m = 0; m < 4; ++m) { const int rl = ai * 128 + wr * 64 + m * 16 + fr, r = u.pm * 256 + rl; const float hs = sb[rl];
#pragma unroll
                for (int bj = 0; bj < 2; ++bj) { const int cl = colbase + bj * 128 + wc * 32 + 8 * fq;
                    f32x4 v0 = __builtin_convertvector(acc[ai][bj][m][0], f32x4) * (wsv[bj][0] * hs), v1 = __builtin_convertvector(acc[ai][bj][m][1], f32x4) * (wsv[bj][1] * hs);
                    if (MODE == 2) {
                        unsigned q[8];
#pragma unroll
                        for (int j = 0; j < 4; ++j) { q[j] = (unsigned)(fsigmoid(v0[j]) * 255.0f + 0.5f); q[4 + j] = (unsigned)(fsigmoid(v1[j]) * 255.0f + 0.5f); }
                        v2u w8; w8.x = q[0] | (q[1] << 8) | (q[2] << 16) | (q[3] << 24); w8.y = q[4] | (q[5] << 8) | (q[6] << 16) | (q[7] << 24);
                        __builtin_nontemporal_store(w8, (v2u*)((unsigned char*)base + (size_t)r * 1024 + cl));
                    } else {
                        if (MODE == 1) {
#pragma unroll
                            for (int j = 0; j < 4; ++j) { v0[j] = gelu_t(v0[j]); v1[j] = gelu_t(v1[j]); } }
                        const v4u w = pack8(v0, v1);
                        const int g = cl >> 4, cp = cl & 15, b = r >> 12, l = r & 4095, n = b * S5NCH + (l >> 4), s = l & 15;
                        const size_t off = s5 ? ((size_t)(g * S5N + n) * S5K + S5Q + s * 16 + cp) : ((size_t)r * 1024 + cl);
                        __builtin_nontemporal_store(w, (v4u*)(base + off)); } }
                asm volatile("" ::: "memory"); }
    }
    __device__ __forceinline__ void operator()(const i32x4 (&acc)[2][2][4][2], const Unit& u, int wr, int wc, int fr, int fq) const {
        const int pn = u.pn, reg = pn < 2 ? 0 : ((pn - 2) >> 2) + 1;
        const int colbase = reg == 0 ? pn * 256 : ((pn - 2) & 3) * 256;
        if (reg < 2) tile<0>(acc, u, reg == 0 ? AG : XL, colbase, reg == 0, wr, wc, fr, fq);
        else if (reg == 2) tile<1>(acc, u, GL, colbase, false, wr, wc, fr, fq);
        else tile<2>(acc, u, reg == 3 ? GA : GB, colbase, false, wr, wc, fr, fq);
    }
};
struct EpiS5State {
    static constexpr bool PERM = false, ACC_INIT = false, B16 = false;
    float* SLOC;
    __device__ __forceinline__ void operator()(const f32x4 (&acc)[2][2][4][2], const Unit& u, int wr, int wc, int fr, int fq) const {
#pragma unroll
        for (int ai = 0; ai < 2; ++ai)
#pragma unroll
            for (int m = 0; m < 4; ++m) { const int nr = u.pm * 256 + ai * 128 + wr * 64 + m * 16 + fr; float* rowp = SLOC + (size_t)(u.aux * S5N + nr) * S5Q + wc * 32 + 4 * fq;
#pragma unroll
                for (int n = 0; n < 2; ++n) *(f32x4*)(rowp + n * 16) = acc[ai][0][m][n]; }
    }
};
struct EpiS5Out {
    static constexpr bool PERM = true, ACC_INIT = false, B16 = false;
    bf16* GY;
    __device__ __forceinline__ void operator()(const f32x4 (&acc)[2][2][4][2], const Unit& u, int wr, int wc, int fr, int fq) const {
#pragma unroll
        for (int ai = 0; ai < 2; ++ai)
#pragma unroll
            for (int m = 0; m < 4; ++m) { const int nr = u.pm * 256 + ai * 128 + wr * 64 + m * 16 + fr, b = nr >> 8, j16 = nr & 255;
#pragma unroll
                for (int bj = 0; bj < 2; ++bj) { const int cc = bj * 128 + wc * 32 + 8 * fq, t = cc >> 4, c0 = cc & 15;
                    f32x4 v0 = acc[ai][bj][m][0], v1 = acc[ai][bj][m][1];
#pragma unroll
                    for (int j = 0; j < 4; ++j) { v0[j] = gelu_t(v0[j]); v1[j] = gelu_t(v1[j]); }
                    *(v4u*)(GY + ((size_t)u.aux * T + (size_t)(b * SEQ + j16 * 16 + t)) * 16 + c0) = pack8(v0, v1); }
                asm volatile("" ::: "memory"); }
    }
};
struct EpiYa {
    static constexpr bool PERM = true, ACC_INIT = false, B16 = false;
    const bf16* GA; bf16* YA;
    __device__ __forceinline__ void operator()(const f32x4 (&acc)[2][2][4][2], const Unit& u, int wr, int wc, int fr, int fq) const {
        const size_t off0 = (size_t)(u.pm * 256 + wr * 64 + fr) * 1024 + u.pn * 128 + wc * 32 + 8 * fq;
        v2u gav[2][4];
#pragma unroll
        for (int ai = 0; ai < 2; ++ai)
#pragma unroll
            for (int m = 0; m < 4; ++m) gav[ai][m] = __builtin_nontemporal_load((const v2u*)((const unsigned char*)GA + off0 + (size_t)(ai * 128 + m * 16) * 1024));
        asm volatile("" ::: "memory");
#pragma unroll
        for (int ai = 0; ai < 2; ++ai)
#pragma unroll
            for (int m = 0; m < 4; ++m) { float gaf[8]; unpack_u8x8(gav[ai][m], gaf);
                f32x4 o0, o1;
#pragma unroll
                for (int j = 0; j < 4; ++j) { o0[j] = gaf[j] * acc[ai][0][m][0][j] * fsigmoid(acc[ai][1][m][0][j]); o1[j] = gaf[4 + j] * acc[ai][0][m][1][j] * fsigmoid(acc[ai][1][m][1][j]); }
                *(v4u*)(YA + off0 + (size_t)(ai * 128 + m * 16) * 1024) = pack8(o0, o1); }
    }
};
struct EpiYb {
    static constexpr bool PERM = true, ACC_INIT = false, B16 = false;
    const bf16* YA; const bf16* GB; bf16* MIX;
    __device__ __forceinline__ void operator()(const f32x4 (&acc)[2][2][4][2], const Unit& u, int wr, int wc, int fr, int fq) const {
        const size_t off0 = (size_t)(u.pm * 256 + wr * 64 + fr) * 1024 + u.pn * 256 + wc * 32 + 8 * fq;
        v2u gb[2][4][2];
#pragma unroll
        for (int ai = 0; ai < 2; ++ai)
#pragma unroll
            for (int m = 0; m < 4; ++m)
#pragma unroll
                for (int bj = 0; bj < 2; ++bj) gb[ai][m][bj] = __builtin_nontemporal_load((const v2u*)((const unsigned char*)GB + off0 + (size_t)(ai * 128 + m * 16) * 1024 + bj * 128));
        v4u ya[2][2][2];
#define YB_LOAD(buf, grp) do { _Pragma("unroll") for (int mm = 0; mm < 2; ++mm) _Pragma("unroll") for (int bj = 0; bj < 2; ++bj) { \
            const size_t o = off0 + (size_t)(((grp) >> 1) * 128 + (2 * ((grp) & 1) + mm) * 16) * 1024 + bj * 128; ya[buf][mm][bj] = *(const v4u*)(YA + o); } } while (0)
        YB_LOAD(0, 0);
#pragma unroll
        for (int grp = 0; grp < 4; ++grp) { const int buf = grp & 1, ai = grp >> 1;
            if (grp < 3) YB_LOAD(buf ^ 1, grp + 1);
            asm volatile("" ::: "memory");
#pragma unroll
            for (int mm = 0; mm < 2; ++mm) { const int m = 2 * (grp & 1) + mm;
#pragma unroll
                for (int bj = 0; bj < 2; ++bj) { const v4u y = ya[buf][mm][bj];
                    const float yaf[8] = {bflo(y.x), bfhi(y.x), bflo(y.y), bfhi(y.y), bflo(y.z), bfhi(y.z), bflo(y.w), bfhi(y.w)};
                    float gbf[8]; unpack_u8x8(gb[ai][m][bj], gbf);
                    f32x4 o0, o1;
#pragma unroll
                    for (int j = 0; j < 4; ++j) { o0[j] = yaf[j] + gbf[j] * acc[ai][bj][m][0][j]; o1[j] = yaf[4 + j] + gbf[4 + j] * acc[ai][bj][m][1][j]; }
                    *(v4u*)(MIX + off0 + (size_t)(ai * 128 + m * 16) * 1024 + bj * 128) = pack8(o0, o1); } }
        }
#undef YB_LOAD
    }
};
struct EpiYaYb {
    static constexpr bool PERM = true, ACC_INIT = false, B16 = false;
    EpiYa a; EpiYb b;
    __device__ __forceinline__ void operator()(const f32x4 (&acc)[2][2][4][2], const Unit& u, int wr, int wc, int fr, int fq) const {
        if (__builtin_amdgcn_readfirstlane(u.kind) == 0) a(acc, u, wr, wc, fr, fq); else b(acc, u, wr, wc, fr, fq);
    }
};
struct EpiWo {
    static constexpr bool PERM = false, ACC_INIT = true, B16 = false;
    const float* X; float* O;
    __device__ __forceinline__ void init(f32x4 (&acc)[2][2][4][2], const Unit& u, int wr, int wc, int fr, int fq) const {
        const size_t off0 = (size_t)(u.pm * 256 + wr * 64 + fr) * 1024 + u.pn * 256 + wc * 32 + 4 * fq;
#pragma unroll
        for (int ai = 0; ai < 2; ++ai)
#pragma unroll
            for (int m = 0; m < 4; ++m)
#pragma unroll
                for (int bj = 0; bj < 2; ++bj)
#pragma unroll
                    for (int n = 0; n < 2; ++n) acc[ai][bj][m][n] = __builtin_nontemporal_load((const f32x4*)(X + off0 + (size_t)(ai * 128 + m * 16) * 1024 + bj * 128 + n * 16));
    }
    __device__ __forceinline__ void operator()(const f32x4 (&acc)[2][2][4][2], const Unit& u, int wr, int wc, int fr, int fq) const {
        const size_t off0 = (size_t)(u.pm * 256 + wr * 64 + fr) * 1024 + u.pn * 256 + wc * 32 + 4 * fq;
#pragma unroll
        for (int ai = 0; ai < 2; ++ai)
#pragma unroll
            for (int m = 0; m < 4; ++m)
#pragma unroll
                for (int bj = 0; bj < 2; ++bj)
#pragma unroll
                    for (int n = 0; n < 2; ++n) *(f32x4*)(O + off0 + (size_t)(ai * 128 + m * 16) * 1024 + bj * 128 + n * 16) = acc[ai][bj][m][n];
    }
};
struct EpiGU {
    static constexpr bool PERM = true, ACC_INIT = false, B16 = false, F8 = true;
    unsigned char* ACT; const LAS float* sclL;
    __device__ __forceinline__ void operator()(const f32x4 (&acc)[2][2][4][2], const Unit& u, int wr, int wc, int fr, int fq) const {
#pragma unroll
        for (int ai = 0; ai < 2; ++ai)
#pragma unroll
            for (int m = 0; m < 4; ++m) { const int rl = ai * 128 + wr * 64 + m * 16 + fr; const float sc = sclL[u.aux * 256 + rl] * (1.0f / 32.0f);
                f32x4 o0, o1;
#pragma unroll
                for (int j = 0; j < 4; ++j) { const float g0 = acc[ai][0][m][0][j] * sc, g1 = acc[ai][0][m][1][j] * sc;
                    o0[j] = g0 * fsigmoid(g0) * (acc[ai][1][m][0][j] * sc); o1[j] = g1 * fsigmoid(g1) * (acc[ai][1][m][1][j] * sc); }
                v2u a8; a8.x = pk_fp8x4(o0[0], o0[1], o0[2], o0[3]); a8.y = pk_fp8x4(o1[0], o1[1], o1[2], o1[3]);
                *(v2u*)(ACT + (size_t)(u.pm * 256 + rl) * DEXP + u.pn * 128 + wc * 32 + 8 * fq) = a8; }
    }
};
struct EpiDown {
    static constexpr bool PERM = true, ACC_INIT = false, B16 = false;
    bf16* YS; const LAS float* sclL;
    __device__ __forceinline__ void operator()(const f32x4 (&acc)[2][2][4][2], const Unit& u, int wr, int wc, int fr, int fq) const {
#pragma unroll
        for (int ai = 0; ai < 2; ++ai)
#pragma unroll
            for (int m = 0; m < 4; ++m) { const int rl = ai * 128 + wr * 64 + m * 16 + fr; const float sc = sclL[u.aux * 256 + rl];
#pragma unroll
                for (int bj = 0; bj < 2; ++bj)
                    *(v4u*)(YS + (size_t)(u.pm * 256 + rl) * 1024 + u.pn * 256 + bj * 128 + wc * 32 + 8 * fq) = pack8(acc[ai][bj][m][0] * sc, acc[ai][bj][m][1] * sc); }
    }
};

template <bool SCALED> struct EpiQ8 {
    static constexpr bool PERM = true, ACC_INIT = false, B16 = true, F8 = SCALED;
    unsigned char* YS8; float* YSC; const LAS float* sclL;
    __device__ __forceinline__ void operator()(const f32x4 (&acc)[2][2][4][2], const Unit& u, int wr, int wc, int fr, int fq) const {
        float scs[2][4];
#pragma unroll
        for (int ai = 0; ai < 2; ++ai)
#pragma unroll
            for (int m = 0; m < 4; ++m) { const int rl = ai * 128 + wr * 64 + m * 16 + fr; const float sc = SCALED ? sclL[u.aux * 256 + rl] * (1.0f / 32.0f) : 1.0f;
                float v[16]; float amax = 0.f;
#pragma unroll
                for (int bj = 0; bj < 2; ++bj)
#pragma unroll
                    for (int n = 0; n < 2; ++n)
#pragma unroll
                        for (int j = 0; j < 4; ++j) { const float x = acc[ai][bj][m][n][j] * sc; v[bj * 8 + n * 4 + j] = x; amax = fmaxf(amax, fabsf(x)); }
                amax = fmaxf(amax, __shfl_xor(amax, 16)); amax = fmaxf(amax, __shfl_xor(amax, 32));
                const float inv = amax > 0.f ? 127.0f / amax : 0.f;
                scs[ai][m] = amax * (1.0f / 127.0f);
                v4u w;
#pragma unroll
                for (int d = 0; d < 4; ++d) { const int q0 = (int)__builtin_rintf(v[4 * d] * inv), q1 = (int)__builtin_rintf(v[4 * d + 1] * inv), q2 = (int)__builtin_rintf(v[4 * d + 2] * inv), q3 = (int)__builtin_rintf(v[4 * d + 3] * inv);
                    w[d] = ((unsigned)q0 & 255u) | (((unsigned)q1 & 255u) << 8) | (((unsigned)q2 & 255u) << 16) | ((unsigned)q3 << 24); }
                *(v4u*)(YS8 + (size_t)(u.pm * 256 + rl) * 1024 + u.pn * 256 + wc * 64 + fq * 16) = w; }
#pragma unroll
        for (int ai = 0; ai < 2; ++ai) { const float sv = fq == 0 ? scs[ai][0] : fq == 1 ? scs[ai][1] : fq == 2 ? scs[ai][2] : scs[ai][3];
            YSC[(size_t)(u.pm * 256 + ai * 128 + wr * 64 + fq * 16 + fr) * 16 + wc * 4 + u.pn] = sv; }
    }
};

struct TItem { const float* W; int N; bf16* WT; int ldk, k0, n0, drow0; };
__device__ __forceinline__ void transpose_load(const TItem& it, f32x4 (&tv)[8], int lane) {
#pragma unroll
    for (int i = 0; i < 8; ++i) tv[i] = __builtin_nontemporal_load((const f32x4*)(it.W + (size_t)(it.k0 + 8 * i + (lane >> 3)) * it.N + it.n0 + 4 * (lane & 7)));
}
template <bool NT = false> __device__ __forceinline__ void transpose_store(const TItem& it, const f32x4 (&tv)[8], LAS float* scr, int lane) {
#pragma unroll
    for (int i = 0; i < 8; ++i) { LAS float* d = scr + (8 * i + (lane >> 3)) * 33 + 4 * (lane & 7); d[0] = tv[i].x; d[1] = tv[i].y; d[2] = tv[i].z; d[3] = tv[i].w; }
    LDS_WAIT(); asm volatile("" ::: "memory");
    const int c = lane & 7;
#pragma unroll
    for (int j = 0; j < 4; ++j) { const int n = (lane >> 3) + 8 * j; const LAS float* s = scr + (8 * c) * 33 + n;
        v4u o; o.x = pk2(s[0 * 33], s[1 * 33]); o.y = pk2(s[2 * 33], s[3 * 33]); o.z = pk2(s[4 * 33], s[5 * 33]); o.w = pk2(s[6 * 33], s[7 * 33]);
        if (NT) __builtin_nontemporal_store(o, (v4u*)(it.WT + (size_t)(it.drow0 + n) * it.ldk + it.k0 + 8 * c)); else *(v4u*)(it.WT + (size_t)(it.drow0 + n) * it.ldk + it.k0 + 8 * c) = o; }
    LDS_WAIT(); asm volatile("" ::: "memory");
}
__device__ __forceinline__ void transpose_store_fp8(const TItem& it, const f32x4 (&tv)[8], LAS float* scr, int lane) {
#pragma unroll
    for (int i = 0; i < 8; ++i) { LAS float* d = scr + (8 * i + (lane >> 3)) * 33 + 4 * (lane & 7); d[0] = tv[i].x; d[1] = tv[i].y; d[2] = tv[i].z; d[3] = tv[i].w; }
    LDS_WAIT(); asm volatile("" ::: "memory");
    const int c = lane & 7;
#pragma unroll
    for (int j = 0; j < 4; ++j) { const int n = (lane >> 3) + 8 * j; const LAS float* s = scr + (8 * c) * 33 + n;
        v2u o; o.x = pk_fp8x4(s[0 * 33] * 32.f, s[1 * 33] * 32.f, s[2 * 33] * 32.f, s[3 * 33] * 32.f); o.y = pk_fp8x4(s[4 * 33] * 32.f, s[5 * 33] * 32.f, s[6 * 33] * 32.f, s[7 * 33] * 32.f);
        __builtin_nontemporal_store(o, (v2u*)((unsigned char*)it.WT + (size_t)(it.drow0 + n) * it.ldk + it.k0 + 8 * c)); }
    LDS_WAIT(); asm volatile("" ::: "memory");
}
__device__ __forceinline__ int ileave_row(int n, int half) { return 256 * (n >> 7) + 128 * half + (n & 127); }

template <int NR> __device__ __forceinline__ void rms_rows_to_bf16(const float* x0, const float* gain, bf16* o0, size_t rstride, int lane) {
    f32x4 v[NR][4];
#pragma unroll
    for (int r = 0; r < NR; ++r) { const f32x4* xr = (const f32x4*)(x0 + r * rstride) + lane;
#pragma unroll
        for (int j = 0; j < 4; ++j) v[r][j] = __builtin_nontemporal_load(xr + 64 * j); }
    asm volatile("" ::: "memory");
    const f32x4* gr = (const f32x4*)gain + lane;
    f32x4 g[4];
#pragma unroll
    for (int j = 0; j < 4; ++j) g[j] = gr[64 * j];
#pragma unroll
    for (int r = 0; r < NR; ++r) { float s = 0.f;
#pragma unroll
        for (int j = 0; j < 4; ++j) s += (v[r][j].x * v[r][j].x + v[r][j].y * v[r][j].y) + (v[r][j].z * v[r][j].z + v[r][j].w * v[r][j].w);
        const float rstd = 1.0f / sqrtf(wave_sum(s) * (1.f / D) + RMS_EPS);
        unsigned long long* o8 = (unsigned long long*)(o0 + r * rstride) + lane;
#pragma unroll
        for (int j = 0; j < 4; ++j) o8[64 * j] = (unsigned long long)pk2(v[r][j].x * rstd * g[j].x, v[r][j].y * rstd * g[j].y) | ((unsigned long long)pk2(v[r][j].z * rstd * g[j].z, v[r][j].w * rstd * g[j].w) << 32); }
}

__device__ __forceinline__ float wave_max(float v) {
#pragma unroll
    for (int o = 1; o < 64; o <<= 1) v = fmaxf(v, __shfl_xor(v, o));
    return v;
}
__device__ __forceinline__ unsigned pk_i8(float a, float b, float c, float d) {
    const int q0 = (int)__builtin_rintf(a), q1 = (int)__builtin_rintf(b), q2 = (int)__builtin_rintf(c), q3 = (int)__builtin_rintf(d);
    return ((unsigned)q0 & 255u) | (((unsigned)q1 & 255u) << 8) | (((unsigned)q2 & 255u) << 16) | ((unsigned)q3 << 24);
}
template <int NR> __device__ __forceinline__ void rms_rows_to_i8(const float* x0, const float* gain, unsigned char* o0, float* hs, int lane) {
    f32x4 v[NR][4];
#pragma unroll
    for (int r = 0; r < NR; ++r) { const f32x4* xr = (const f32x4*)(x0 + (size_t)r * D) + lane;
#pragma unroll
        for (int j = 0; j < 4; ++j) v[r][j] = __builtin_nontemporal_load(xr + 64 * j); }
    asm volatile("" ::: "memory");
    const f32x4* gr = (const f32x4*)gain + lane;
    f32x4 g[4];
#pragma unroll
    for (int j = 0; j < 4; ++j) g[j] = gr[64 * j];
#pragma unroll
    for (int r = 0; r < NR; ++r) { float s = 0.f;
#pragma unroll
        for (int j = 0; j < 4; ++j) s += (v[r][j].x * v[r][j].x + v[r][j].y * v[r][j].y) + (v[r][j].z * v[r][j].z + v[r][j].w * v[r][j].w);
        const float rstd = 1.0f / sqrtf(wave_sum(s) * (1.f / D) + RMS_EPS);
        float am = 0.f;
#pragma unroll
        for (int j = 0; j < 4; ++j) { v[r][j] = v[r][j] * rstd * g[j]; am = fmaxf(fmaxf(am, fmaxf(fabsf(v[r][j].x), fabsf(v[r][j].y))), fmaxf(fabsf(v[r][j].z), fabsf(v[r][j].w))); }
        am = fmaxf(wave_max(am), 1e-20f);
        const float inv = 127.0f / am;
        unsigned* o = (unsigned*)(o0 + (size_t)r * D) + lane;
#pragma unroll
        for (int j = 0; j < 4; ++j) o[64 * j] = pk_i8(v[r][j].x * inv, v[r][j].y * inv, v[r][j].z * inv, v[r][j].w * inv);
        if (lane == 0) hs[r] = am * (1.0f / 127.0f); }
}
__device__ __forceinline__ void win_to_i8(const Frame& F, const float* W, int nb) {
    const int lane = F.lane, w = F.wave, n0 = 32 * nb;
    f32x4 tv[2][8];
#pragma unroll
    for (int s2 = 0; s2 < 2; ++s2)
#pragma unroll
        for (int i = 0; i < 8; ++i) tv[s2][i] = __builtin_nontemporal_load((const f32x4*)(W + (size_t)(128 * w + 64 * s2 + 8 * i + (lane >> 3)) * NIN + n0 + 4 * (lane & 7)));
    asm volatile("" ::: "memory");
    f32x4 am = {0.f, 0.f, 0.f, 0.f};
#pragma unroll
    for (int s2 = 0; s2 < 2; ++s2)
#pragma unroll
        for (int i = 0; i < 8; ++i)
#pragma unroll
            for (int c = 0; c < 4; ++c) am[c] = fmaxf(am[c], fabsf(tv[s2][i][c]));
#pragma unroll
    for (int c = 0; c < 4; ++c) { am[c] = fmaxf(am[c], __shfl_xor(am[c], 8)); am[c] = fmaxf(am[c], __shfl_xor(am[c], 16)); am[c] = fmaxf(am[c], __shfl_xor(am[c], 32)); }
    LAS float* cm = (LAS float*)(F.lds + TOKL_OFF);
    if (lane < 8) *(LAS f32x4*)(cm + w * 32 + 4 * lane) = am;
    __syncthreads();
    f32x4 tot = *(const LAS f32x4*)(cm + 4 * (lane & 7));
#pragma unroll
    for (int ww = 1; ww < 8; ++ww) { const f32x4 o = *(const LAS f32x4*)(cm + ww * 32 + 4 * (lane & 7));
#pragma unroll
        for (int c = 0; c < 4; ++c) tot[c] = fmaxf(tot[c], o[c]); }
    f32x4 inv;
#pragma unroll
    for (int c = 0; c < 4; ++c) { tot[c] = fmaxf(tot[c], 1e-20f); inv[c] = 127.0f / tot[c]; }
    if (w == 0 && lane < 8) *(f32x4*)((float*)(F.ws + SM_WSC) + n0 + 4 * lane) = tot * (1.0f / 127.0f);
    LAS int* scr = (LAS int*)(F.lds + w * 16384);
    unsigned char* wt = F.ws + WS_WIN;
#pragma unroll
    for (int s2 = 0; s2 < 2; ++s2) {
#pragma unroll
        for (int i = 0; i < 8; ++i) { LAS int* d = scr + (8 * i + (lane >> 3)) * 33 + 4 * (lane & 7);
#pragma unroll
            for (int c = 0; c < 4; ++c) d[c] = (int)__builtin_rintf(tv[s2][i][c] * inv[c]); }
        LDS_WAIT(); asm volatile("" ::: "memory");
        const int n = lane & 31, kh = lane >> 5; const LAS int* sp = scr + (32 * kh) * 33 + n;
        v4u o[2];
#pragma unroll
        for (int d = 0; d < 8; ++d) o[d >> 2][d & 3] = ((unsigned)sp[(4 * d) * 33] & 255u) | (((unsigned)sp[(4 * d + 1) * 33] & 255u) << 8) | (((unsigned)sp[(4 * d + 2) * 33] & 255u) << 16) | ((unsigned)sp[(4 * d + 3) * 33] << 24);
        v4u* dst = (v4u*)(wt + (size_t)(n0 + n) * D + 128 * w + 64 * s2 + 32 * kh);
        dst[0] = o[0]; dst[1] = o[1];
        LDS_WAIT(); asm volatile("" ::: "memory");
    }
    __syncthreads();
}

__device__ __forceinline__ void s5_tables(const Frame& F, int g, const float* lam_re, const float* lam_im, const float* log_dt, const float* b_re, const float* b_im, const float* c_re, const float* c_im, const float* dsk) {
    LAS float* Cre = (LAS float*)F.lds;
    LAS float* Cim = Cre + 1024;
    LAS float* Bre = Cim + 1024;
    LAS float* Bim = Bre + 1024;
    LAS float* Pre = Bim + 1024;
    LAS float* Pim = Pre + 17 * 64;
    LAS float* Kt = Pim + 17 * 64;
    const int tid = F.tid;
    for (int i = tid; i < 1024; i += 512) { Cre[i] = c_re[g * 1024 + i]; Cim[i] = c_im[g * 1024 + i]; }
    if (tid < 64) {
        const int p = tid; const float lr = lam_re[g * 64 + p], li = lam_im[g * 64 + p], dt = expf(log_dt[g]);
        const float er = expf(lr * dt), lbr = er * cosf(li * dt), lbi = er * sinf(li * dt);
        const float den = lr * lr + li * li, nr = lbr - 1.0f, ni = lbi;
        const float cr = (nr * lr + ni * li) / den, ci = (ni * lr - nr * li) / den;
        { float pr = 1.f, pi = 0.f; for (int k = 0; k <= 16; ++k) { Pre[k * 64 + p] = pr; Pim[k * 64 + p] = pi; const float nr2 = pr * lbr - pi * lbi, ni2 = pr * lbi + pi * lbr; pr = nr2; pi = ni2; } }
        for (int c = 0; c < 16; ++c) { const float br = b_re[(g * 64 + p) * 16 + c], bi = b_im[(g * 64 + p) * 16 + c]; Bre[p * 16 + c] = cr * br - ci * bi; Bim[p * 16 + c] = cr * bi + ci * br; }
    }
    __syncthreads();
    {
        const int kc = tid & 255, k = kc >> 4, c = kc & 15, ph = tid >> 8; float a16[16];
#pragma unroll
        for (int i = 0; i < 16; ++i) a16[i] = 0.f;
        for (int p = 32 * ph; p < 32 * ph + 32; ++p) {
            const float cr_ = Cre[c * 64 + p], ci_ = Cim[c * 64 + p], pr_ = Pre[k * 64 + p], pi_ = Pim[k * 64 + p];
            const float xr = cr_ * pr_ - ci_ * pi_, xi = cr_ * pi_ + ci_ * pr_;
#pragma unroll
            for (int j = 0; j < 4; ++j) { const f32x4 br = *(const LAS f32x4*)(Bre + p * 16 + 4 * j), bi = *(const LAS f32x4*)(Bim + p * 16 + 4 * j);
#pragma unroll
                for (int i = 0; i < 4; ++i) a16[4 * j + i] += xr * br[i] - xi * bi[i]; }
        }
        LAS float* Kh = Kt + 4096;
        if (ph == 1) {
#pragma unroll
            for (int j = 0; j < 4; ++j) *(LAS f32x4*)(Kh + kc * 16 + 4 * j) = (f32x4){a16[4 * j], a16[4 * j + 1], a16[4 * j + 2], a16[4 * j + 3]}; }
        __syncthreads();
        if (ph == 0) {
#pragma unroll
            for (int j = 0; j < 4; ++j) { const f32x4 o = *(const LAS f32x4*)(Kh + kc * 16 + 4 * j); f32x4 r = (f32x4){a16[4 * j], a16[4 * j + 1], a16[4 * j + 2], a16[4 * j + 3]} + o;
                if (k == 0 && (c >> 2) == j) r[c & 3] += dsk[g * 16 + c];
                *(LAS f32x4*)(Kt + kc * 16 + 4 * j) = r; } }
    }
    __syncthreads();
    unsigned* btt = (unsigned*)(F.ws + WS_BTT) + (size_t)g * 256 * (S5K / 2);
    for (int e = tid; e < 256 * (S5K / 2); e += 512) {
        const int row = e / (S5K / 2), cpair = e % (S5K / 2), t = row >> 4, c = row & 15, col = 2 * cpair; float v0, v1;
        if (col < S5Q) { const int p = col >> 1; const float xr = Cre[c * 64 + p] * Pre[(t + 1) * 64 + p] - Cim[c * 64 + p] * Pim[(t + 1) * 64 + p], xi = Cre[c * 64 + p] * Pim[(t + 1) * 64 + p] + Cim[c * 64 + p] * Pre[(t + 1) * 64 + p];
            v0 = xr; v1 = -xi; }
        else { const int s = (col - S5Q) >> 4, cp = (col - S5Q) & 15;
            if (s <= t) { v0 = Kt[(t - s) * 256 + c * 16 + cp]; v1 = Kt[(t - s) * 256 + c * 16 + cp + 1]; } else { v0 = 0.f; v1 = 0.f; } }
        btt[e] = pk2(v0, v1);
    }
    unsigned* btw = (unsigned*)(F.ws + WS_BTW) + (size_t)g * 128 * 128;
    for (int e = tid; e < 128 * 128; e += 512) {
        const int q = e >> 7, cpair = e & 127, col = 2 * cpair, s = col >> 4, cp = col & 15, p = q >> 1, k = 15 - s;
        const float pr = Pre[k * 64 + p], pi = Pim[k * 64 + p];
        float v0, v1;
        if (q & 1) { v0 = pr * Bim[p * 16 + cp] + pi * Bre[p * 16 + cp]; v1 = pr * Bim[p * 16 + cp + 1] + pi * Bre[p * 16 + cp + 1]; }
        else { v0 = pr * Bre[p * 16 + cp] - pi * Bim[p * 16 + cp]; v1 = pr * Bre[p * 16 + cp + 1] - pi * Bim[p * 16 + cp + 1]; }
        btw[e] = pk2(v0, v1);
    }
    if (tid < 64) { float* l16 = (float*)(F.ws + SM_LAM16) + (g * 64 + tid) * 2; l16[0] = Pre[16 * 64 + tid]; l16[1] = Pim[16 * 64 + tid]; }
    __syncthreads();
}

struct In { const float* p[30]; };

__device__ __forceinline__ void p0_prologue(const Frame& F, const In& I) {
    for (int g = F.vcu; g < S5G; g += F.G) s5_tables(F, g, I.p[3], I.p[4], I.p[5], I.p[6], I.p[7], I.p[8], I.p[9], I.p[10]);
    const int gt = F.vcu * 512 + F.tid, NGT = F.G * 512;
    { float* lc = (float*)(F.ws + SM_LRUC); for (int i = gt; i < LRUW; i += NGT) { const float lam = I.p[18][i]; lc[i] = -8.0f * log1pf(expf(-lam)) * 1.44269504f; } }
    { bf16* wrt = (bf16*)(F.ws + SM_WRT);
        for (int i = gt; i < 2 * 65536; i += NGT) { const int which = i >> 16, r = i & 65535, h = r >> 12, j = (r >> 6) & 63, k = r & 63; const float* src = which ? I.p[16] : I.p[14]; wrt[i] = (bf16)f2bf(src[(h * 64 + k) * 64 + j]); } }
    { bf16* rhi = (bf16*)(F.ws + SM_RHI); bf16* rlo = (bf16*)(F.ws + SM_RLO);
        for (int i = gt; i < NROUT * 1024; i += NGT) { const int n = i >> 10, k = i & 1023; float w = 0.f; if (n < 4) w = I.p[22][k * 4 + n]; else if (n < 36) w = I.p[24][k * 32 + (n - 4)];
            const unsigned h = f2bf(w); rhi[i] = (bf16)h; rlo[i] = (bf16)f2bf(w - bf2f(h)); } }
    { const int skip = F.G > 2 * S5G ? S5G : 0;
      if (F.vcu >= skip) {
        for (int nb = F.vcu - skip; nb < NIN / 32; nb += F.G - skip) win_to_i8(F, I.p[2], nb);
        const int gw2 = (F.vcu - skip) * NWAVES + F.wave, NGW2 = (F.G - skip) * NWAVES;
        for (int m = gw2 * 4; m < T; m += NGW2 * 4) rms_rows_to_i8<4>(I.p[0] + (size_t)m * D, I.p[1], F.ws + WS_H + (size_t)m * D, (float*)(F.ws + SM_HSC) + m, F.lane); } }
}
__device__ __forceinline__ void late_weight_copies(const Frame& F, const In& I, int gw, int NGW) {
    LAS float* scr = (LAS float*)(F.lds + F.wave * 16384);
    constexpr int I_S5 = (S5W / 64) * (2 * D / 32), I_LRU = (D / 64) * (D / 32), I_O = I_LRU;
    constexpr int NITEMS = I_S5 + I_LRU + I_O;
    for (int it = gw; it < NITEMS; it += NGW) {
        int r = it; TItem ti;
        if (r < I_S5) { const int nb = 2 * D / 32, kb = r / nb, n0 = 32 * (r % nb); ti = TItem{I.p[11], 2 * D, (bf16*)(F.ws + WS_WS5), S5W, 64 * kb, n0, n0 < D ? ileave_row(n0, 0) : ileave_row(n0 - D, 1)}; }
        else if ((r -= I_S5) < I_LRU) { const int nb = D / 32, kb = r / nb, n0 = 32 * (r % nb); ti = TItem{I.p[19], D, (bf16*)(F.ws + WS_WLRU), D, 64 * kb, n0, n0}; }
        else { r -= I_LRU; const int nb = D / 32, kb = r / nb, n0 = 32 * (r % nb); ti = TItem{I.p[20], D, (bf16*)(F.ws + WS_WO), D, 64 * kb, n0, n0}; }
        f32x4 tv[8]; transpose_load(ti, tv, F.lane); asm volatile("" ::: "memory"); transpose_store(ti, tv, scr, F.lane);
    }
    __syncthreads();
}
__device__ __forceinline__ TItem expert_item(const Frame& F, const In& I, int it) {
    const int e = it >> 9, half = (it >> 8) & 1, r = it & 255, nb = DEXP / 32, kb = r / nb, n0 = 32 * (r % nb);
    return TItem{(half ? I.p[27] : I.p[26]) + (size_t)e * D * DEXP, DEXP, (bf16*)(F.ws + WS_WGU + (size_t)e * 1024 * 1024), D, 64 * kb, n0, ileave_row(n0, half)};
}
__device__ __forceinline__ TItem expert_item_d(const Frame& F, const In& I, int it) {
    const int e = it >> 8, r = it & 255, nb = D / 32, kb = r / nb, n0 = 32 * (r % nb);
    return TItem{I.p[28] + (size_t)e * DEXP * D, D, (bf16*)(F.ws + WS_WD + (size_t)e * 1024 * DEXP), DEXP, 64 * kb, n0, n0};
}
__device__ __forceinline__ void expert_weight_copies(const Frame& F, const In& I) {
    LAS float* scr = (LAS float*)(F.lds + F.wave * 16384);
    const int gw = F.vcu * NWAVES + F.wave, NGW = F.G * NWAVES;
    constexpr int NIT = NEXP * 512;
    for (int it = 8 * NGW + gw; it < NIT; it += NGW) { const TItem t0 = expert_item(F, I, it); f32x4 v0[8]; transpose_load(t0, v0, F.lane); asm volatile("" ::: "memory"); transpose_store_fp8(t0, v0, scr, F.lane); }
}
__device__ __forceinline__ void expert_down_copies(const Frame& F, const In& I) {
    LAS float* scr = (LAS float*)(F.lds + F.wave * 16384);
    const int nunits = (int)F.MISC[128] * 4, rem = nunits % F.G, nbusy = rem;
    const int nfree = F.G - nbusy;
    if (F.vcu < nbusy) return;
    const int gw = (F.vcu - nbusy) * NWAVES + F.wave, NGW = nfree * NWAVES;
    constexpr int NIT = NEXP * 256;
    for (int it = gw; it < NIT; it += 2 * NGW) {
        const TItem t0 = expert_item_d(F, I, it); const bool has1 = it + NGW < NIT; const TItem t1 = expert_item_d(F, I, has1 ? it + NGW : it);
        f32x4 v0[8], v1[8]; transpose_load(t0, v0, F.lane); transpose_load(t1, v1, F.lane); asm volatile("" ::: "memory");
        transpose_store_fp8(t0, v0, scr, F.lane); if (has1) transpose_store_fp8(t1, v1, scr, F.lane);
    }
}

__device__ __forceinline__ void lru_seq(const Frame& F, const In& I) {
    LAS unsigned char* wl = F.lds + F.wave * 17920;
    LAS bf16* xcA = (LAS bf16*)wl;
    LAS float* pre = (LAS float*)(wl + 9216);
    typedef float f32x2 __attribute__((ext_vector_type(2)));
    LAS f32x2* sumT = (LAS f32x2*)(F.lds + 143360);
    const int lane = F.lane, jj = lane & 15, ks = lane >> 4, c32 = lane & 31, th = lane >> 5;
    const bf16* XL = (const bf16*)(F.ws + WS_XL); const bf16* GL = (const bf16*)(F.ws + WS_GL); bf16* YL = (bf16*)(F.ws + WS_H);
    const bf16* WRT = (const bf16*)(F.ws + SM_WRT);
    for (int un = F.vcu; un < BATCH * LRUH * 2; un += F.G) {
        const int b = un >> 5, hd = (un >> 1) & 15, half = un & 1;
        const int chin = hd * 64 + lane;
        const int chg = hd * 64 + 32 * half + c32;
        const float w0 = I.p[12][chin], w1 = I.p[12][1024 + chin], w2 = I.p[12][2048 + chin], w3 = I.p[12][3072 + chin], cb = I.p[13][chin];
        const float brs = I.p[15][chg] * -1.44269504f, bis = I.p[17][chg] * -1.44269504f, cch2 = ((const float*)(F.ws + SM_LRUC))[chg];
        float Rc = 0.f;
        for (int rd = 0; rd < 8; ++rd) {
            const int j = rd * 8 + F.wave;
            const size_t tok0 = (size_t)b * SEQ + (size_t)j * LRUCH;
            unsigned short xr[64], xh[3];
            { const bf16* xp = XL + tok0 * 1024 + chin;
              xh[0] = 0; xh[1] = 0; xh[2] = 0;
              if (j > 0) { xh[0] = xp[-3 * 1024]; xh[1] = xp[-2 * 1024]; xh[2] = xp[-1 * 1024]; }
#pragma unroll
              for (int t = 0; t < 64; ++t) xr[t] = xp[t * 1024]; }
            asm volatile("" ::: "memory");
            { typedef float f2v __attribute__((ext_vector_type(2)));
              float xm3 = bf2f(xh[0]), xm2 = bf2f(xh[1]), xm1 = bf2f(xh[2]);
              const f2v vw0 = {w0, w0}, vw1 = {w1, w1}, vw2 = {w2, w2}, vw3 = {w3, w3}, vcb = {cb, cb};
#pragma unroll
              for (int t = 0; t < 64; t += 2) { const float x0 = bf2f(xr[t]), x1 = bf2f(xr[t + 1]);
                  f2v xc = vcb + vw0 * (f2v){xm3, xm2}; xc = xc + vw1 * (f2v){xm2, xm1}; xc = xc + vw2 * (f2v){xm1, x0}; xc = xc + vw3 * (f2v){x0, x1};
                  const unsigned pk = pg8::cvt_pk_bf16(xc.x, xc.y);
                  xcA[t * 72 + lane] = (bf16)(pk & 0xffffu); xcA[(t + 1) * 72 + lane] = (bf16)(pk >> 16);
                  xm3 = xm1; xm2 = x0; xm1 = x1; } }
            LDS_WAIT();
            float hl[2][16], Pl[2][16], Prun[2], Hrun[2];
#pragma unroll
            for (int st = 0; st < 2; ++st) {
                bf16x8 Bw[4][2];
#pragma unroll
                for (int n = 0; n < 4; ++n)
#pragma unroll
                    for (int k = 0; k < 2; ++k) Bw[n][k] = *(const bf16x8*)(WRT + (size_t)(n >> 1) * 65536 + (size_t)(hd * 64 + 32 * half + 16 * (n & 1) + jj) * 64 + 32 * k + 8 * ks);
#pragma unroll
                for (int mh = 0; mh < 2; ++mh) { const int mt = 2 * st + mh;
                    bf16x8 a[2];
#pragma unroll
                    for (int k = 0; k < 2; ++k) a[k] = *(const LAS bf16x8*)(xcA + (16 * mt + jj) * 72 + 32 * k + 8 * ks);
#pragma unroll
                    for (int n = 0; n < 4; ++n) { f32x4 d = (f32x4){0.f, 0.f, 0.f, 0.f};
#pragma unroll
                        for (int k = 0; k < 2; ++k) d = __builtin_amdgcn_mfma_f32_16x16x32_bf16(a[k], Bw[n][k], d, 0, 0, 0);
#pragma unroll
                        for (int r = 0; r < 4; ++r) pre[(16 * mh + 4 * ks + r) * 68 + 16 * n + jj] = d[r]; } }
                LDS_WAIT();
                float h = 0.f, P = 1.f;
                typedef float f2v __attribute__((ext_vector_type(2)));
#pragma unroll
                for (int tl = 0; tl < 16; tl += 2) {
                    const int trow = 16 * th + tl;
                    const f2v pr = {pre[trow * 68 + c32], pre[(trow + 1) * 68 + c32]}, pi = {pre[trow * 68 + 32 + c32], pre[(trow + 1) * 68 + 32 + c32]};
                    const f2v zr = pr * (f2v){-1.44269504f, -1.44269504f} + (f2v){brs, brs}, zi = pi * (f2v){-1.44269504f, -1.44269504f} + (f2v){bis, bis};
                    const f2v er = {__builtin_amdgcn_exp2f(zr.x), __builtin_amdgcn_exp2f(zr.y)}, ei = {__builtin_amdgcn_exp2f(zi.x), __builtin_amdgcn_exp2f(zi.y)};
                    const f2v dr = er + (f2v){1.f, 1.f};
                    const f2v rg = {__builtin_amdgcn_rcpf(dr.x), __builtin_amdgcn_rcpf(dr.y)};
                    const f2v la2 = rg * (f2v){cch2, cch2};
                    const f2v a_ = {__builtin_amdgcn_exp2f(la2.x), __builtin_amdgcn_exp2f(la2.y)};
                    const f2v x2 = la2 * (f2v){1.38629436f, 1.38629436f};
                    f2v q = x2 * (f2v){0.0013888889f, 0.0013888889f} + (f2v){0.0083333333f, 0.0083333333f};
                    q = q * x2 + (f2v){0.041666667f, 0.041666667f}; q = q * x2 + (f2v){0.16666667f, 0.16666667f}; q = q * x2 + (f2v){0.5f, 0.5f}; q = q * x2 + (f2v){1.f, 1.f};
                    f2v om = -(q * x2);
                    const f2v alt = (f2v){1.f, 1.f} - a_ * a_;
                    om.x = x2.x > -0.3f ? om.x : alt.x; om.y = x2.y > -0.3f ? om.y : alt.y;
                    om.x = fmaxf(om.x, 1e-30f); om.y = fmaxf(om.y, 1e-30f);
                    const f2v dd = ei + (f2v){1.f, 1.f};
                    const f2v rq = om * dd * dd;
                    const f2v mi = om * (f2v){__builtin_amdgcn_rsqf(rq.x), __builtin_amdgcn_rsqf(rq.y)};
                    const f2v bx = mi * (f2v){bf2f(xcA[(32 * st + trow) * 72 + 32 * half + c32]), bf2f(xcA[(32 * st + trow + 1) * 72 + 32 * half + c32])};
                    h = a_.x * h + bx.x; P *= a_.x; hl[st][tl] = h; Pl[st][tl] = P;
                    h = a_.y * h + bx.y; P *= a_.y; hl[st][tl + 1] = h; Pl[st][tl + 1] = P;
                }
                Prun[st] = P; Hrun[st] = h;
                LDS_WAIT();
            }
            const float pP0 = __shfl_xor(Prun[0], 32), pH0 = __shfl_xor(Hrun[0], 32), pP1 = __shfl_xor(Prun[1], 32), pH1 = __shfl_xor(Hrun[1], 32);
            const float P0 = th ? pP0 : Prun[0], H0 = th ? pH0 : Hrun[0], P1 = th ? Prun[0] : pP0, H1 = th ? Hrun[0] : pH0;
            const float P2 = th ? pP1 : Prun[1], H2 = th ? pH1 : Hrun[1], P3 = th ? Prun[1] : pP1, H3 = th ? Hrun[1] : pH1;
            const float C1 = H0, Q1 = P0, C2 = P1 * C1 + H1, Q2 = P1 * Q1, C3 = P2 * C2 + H2, Q3 = P2 * Q2, Hc = P3 * C3 + H3, Pc = P3 * Q3;
            const float Cs0 = th ? C1 : 0.f, Qs0 = th ? Q1 : 1.f, Cs1 = th ? C3 : C2, Qs1 = th ? Q3 : Q2;
            const int cit = (rd * F.G + F.vcu) * NWAVES + F.wave; const bool cdo = cit < NEXP * 512;
            f32x4 ctv[8]; unsigned short ggr[2][16];
            if (cdo) { const TItem citem = expert_item(F, I, cit); transpose_load(citem, ctv, lane); }
#pragma unroll
            for (int st = 0; st < 2; ++st)
#pragma unroll
                for (int tl = 0; tl < 16; ++tl) ggr[st][tl] = GL[(tok0 + 32 * st + 16 * th + tl) * 1024 + chg];
            asm volatile("" ::: "memory");
            if (th == 0) sumT[((rd & 1) * 8 + F.wave) * 32 + c32] = (f32x2){Pc, Hc};
            LDS_WAIT();
            __syncthreads();
            float cin = Rc, mycin = 0.f;
#pragma unroll
            for (int w = 0; w < 8; ++w) { const f32x2 ph = sumT[((rd & 1) * 8 + w) * 32 + c32]; mycin = (w == F.wave) ? cin : mycin; cin = ph.x * cin + ph.y; }
            Rc = cin;
#pragma unroll
            for (int st = 0; st < 2; ++st) { const float hin = (st ? Cs1 : Cs0) + (st ? Qs1 : Qs0) * mycin;
#pragma unroll
                for (int tl = 0; tl < 16; ++tl) { const float hh = hl[st][tl] + Pl[st][tl] * hin;
                    YL[(tok0 + 32 * st + 16 * th + tl) * 1024 + chg] = (bf16)f2bf(hh * bf2f(ggr[st][tl])); } }
            if (cdo) { const TItem citem = expert_item(F, I, cit); transpose_store_fp8(citem, ctv, pre, lane); }
        }
        __syncthreads();
    }
}

__device__ __forceinline__ void s5_chain(const Frame& F, int b, int g) {
    typedef float f32x2 __attribute__((ext_vector_type(2)));
    LAS f32x2* segE = (LAS f32x2*)(F.lds);
    const int lane = F.lane, w = F.wave;
    const float* SLOC = (const float*)(F.ws + WS_SLOC); unsigned* AGw = (unsigned*)(F.ws + WS_AG); const float* L16 = (const float*)(F.ws + SM_LAM16);
    const float lr = L16[(g * 64 + lane) * 2], li = L16[(g * 64 + lane) * 2 + 1];
    const float* sl = SLOC + ((size_t)(g * S5N + b * S5NCH + 32 * w)) * S5Q + 2 * lane;
    unsigned* ag = AGw + ((size_t)(g * S5N + b * S5NCH + 32 * w)) * (S5K / 2) + lane;
    float xr[32], xi[32];
#pragma unroll
    for (int u = 0; u < 32; ++u) { const float2 v = *(const float2*)(sl + (size_t)u * S5Q); xr[u] = v.x; xi[u] = v.y; }
    asm volatile("" ::: "memory");
    float sr = 0.f, si = 0.f;
#pragma unroll
    for (int u = 0; u < 32; ++u) { const float nr = lr * sr - li * si + xr[u], ni = lr * si + li * sr + xi[u]; xr[u] = sr; xi[u] = si; sr = nr; si = ni; }
    segE[w * 64 + lane] = (f32x2){sr, si};
    float qr = lr, qi = li;
#pragma unroll
    for (int k = 0; k < 5; ++k) { const float nr = qr * qr - qi * qi, ni = 2.f * qr * qi; qr = nr; qi = ni; }
    LDS_WAIT();
    __syncthreads();
    float cr = 0.f, ci = 0.f;
    for (int ww = 0; ww < w; ++ww) { const f32x2 e = segE[ww * 64 + lane]; const float nr = qr * cr - qi * ci + e.x, ni = qr * ci + qi * cr + e.y; cr = nr; ci = ni; }
#pragma unroll
    for (int u = 0; u < 32; ++u) { ag[(size_t)u * (S5K / 2)] = pk2(xr[u] + cr, xi[u] + ci); const float nr = lr * cr - li * ci, ni = lr * ci + li * cr; cr = nr; ci = ni; }
    __syncthreads();
}

__device__ __forceinline__ void p8_router(const Frame& F, const In& I) {
    const int lane = F.lane, tk = lane & 15, ks = lane >> 4;
    LAS float* lg = (LAS float*)(F.lds + F.wave * 4096);
    volatile LAS unsigned* cntL = F.MISC + 32; volatile LAS unsigned* baseL = F.MISC + 64;
    const float* X1 = I.p[0]; unsigned char* H2 = F.ws + WS_H2; const float* gf = I.p[21];
    const unsigned char* D8 = (const unsigned char*)(F.ws + WS_D8); const float* DSC = (const float*)(F.ws + WS_DSC);
    const bf16* RHI = (const bf16*)(F.ws + SM_RHI); const bf16* RLO = (const bf16*)(F.ws + SM_RLO);
    float* RSTD = (float*)(F.ws + SM_RSTD); unsigned* gcnt = F.ctl + CW_CNT;
    int* LTOK = (int*)(F.ws + WS_LTOK); float* LW = (float*)(F.ws + WS_LW); int* TOKE = (int*)(F.ws + WS_TOKE); int* TOKR = (int*)(F.ws + WS_TOKR);
    for (int blk = F.vcu; blk < T / 128; blk += F.G) {
        if (F.tid < 32) cntL[F.tid] = 0u;
        __syncthreads();
        const int tok0 = blk * 128 + F.wave * 16;
        const float* xrow = X1 + (size_t)(tok0 + tk) * D + 8 * ks; unsigned char* hrow = H2 + (size_t)(tok0 + tk) * D + 8 * ks;
        f32x4 acc[3]; acc[0] = acc[1] = acc[2] = (f32x4){0.f, 0.f, 0.f, 0.f}; float ss = 0.f;
        const unsigned char* drow = D8 + (size_t)(tok0 + tk) * D + 8 * ks; const float* dsc = DSC + (size_t)(tok0 + tk) * 16;
        f32x4 xnx[4][2]; v2u dnx[4]; float snx[2];
#pragma unroll
        for (int q = 0; q < 4; ++q) { xnx[q][0] = __builtin_nontemporal_load((const f32x4*)(xrow + 32 * q)); xnx[q][1] = __builtin_nontemporal_load((const f32x4*)(xrow + 32 * q + 4)); dnx[q] = *(const v2u*)(drow + 32 * q); }
        snx[0] = dsc[0]; snx[1] = dsc[4];
        LAS bf16* slab = (LAS bf16*)(F.lds + 32768);
        v4u wst[3];
#define RT_SLAB_LOAD(g) do { _Pragma("unroll") for (int j = 0; j < 3; ++j) { const int c = F.tid + 512 * j, which = c / 768, r = (c % 768) >> 4, kq = c & 15; \
            wst[j] = *(const v4u*)((which ? RLO : RHI) + (size_t)r * D + 128 * (g) + 8 * kq); } } while (0)
#define RT_SLAB_STORE(buf) do { _Pragma("unroll") for (int j = 0; j < 3; ++j) { const int c = F.tid + 512 * j, which = c / 768, r = (c % 768) >> 4, kq = c & 15; \
            *(LAS v4u*)(slab + ((size_t)((buf) * 2 + which) * 48 + r) * 136 + 8 * kq) = wst[j]; } } while (0)
        RT_SLAB_LOAD(0); RT_SLAB_STORE(0);
        LDS_WAIT();
        __syncthreads();
        for (int kg = 0; kg < 8; ++kg) {
            f32x4 xa[4][2];
#pragma unroll
            for (int q = 0; q < 4; ++q) { const float sq = snx[q >> 1]; const v2u dq = dnx[q];
                xa[q][0] = xnx[q][0] + (f32x4){(float)((int)(dq.x << 24) >> 24), (float)((int)(dq.x << 16) >> 24), (float)((int)(dq.x << 8) >> 24), (float)((int)dq.x >> 24)} * sq;
                xa[q][1] = xnx[q][1] + (f32x4){(float)((int)(dq.y << 24) >> 24), (float)((int)(dq.y << 16) >> 24), (float)((int)(dq.y << 8) >> 24), (float)((int)dq.y >> 24)} * sq; }
            { const int kgn = kg < 7 ? kg + 1 : kg;
#pragma unroll
              for (int q = 0; q < 4; ++q) { xnx[q][0] = __builtin_nontemporal_load((const f32x4*)(xrow + 32 * (4 * kgn + q))); xnx[q][1] = __builtin_nontemporal_load((const f32x4*)(xrow + 32 * (4 * kgn + q) + 4)); dnx[q] = *(const v2u*)(drow + 32 * (4 * kgn + q)); }
              { const int G0 = 2 * kgn, G1 = 2 * kgn + 1; snx[0] = dsc[(G0 & 3) * 4 + (G0 >> 2)]; snx[1] = dsc[(G1 & 3) * 4 + (G1 >> 2)]; }
              RT_SLAB_LOAD(kgn); }
            f32x4 ga[4][2];
#pragma unroll
            for (int q = 0; q < 4; ++q) { const int kc = 4 * kg + q; ga[q][0] = *(const f32x4*)(gf + 32 * kc + 8 * ks); ga[q][1] = *(const f32x4*)(gf + 32 * kc + 8 * ks + 4); }
            asm volatile("" ::: "memory");
            const LAS bf16* sh = slab + (size_t)((kg & 1) * 2) * 48 * 136, * sl = sh + 48 * 136;
#pragma unroll
            for (int q = 0; q < 4; ++q) { const int kc = 4 * kg + q;
                const f32x4 a0 = xa[q][0], a1 = xa[q][1];
                ss += (a0.x * a0.x + a0.y * a0.y) + (a0.z * a0.z + a0.w * a0.w) + (a1.x * a1.x + a1.y * a1.y) + (a1.z * a1.z + a1.w * a1.w);
                const f32x4 v0 = a0 * ga[q][0], v1 = a1 * ga[q][1];
                v4u hi, lo;
                hi.x = pg8::cvt_pk_bf16(v0.x, v0.y); hi.y = pg8::cvt_pk_bf16(v0.z, v0.w); hi.z = pg8::cvt_pk_bf16(v1.x, v1.y); hi.w = pg8::cvt_pk_bf16(v1.z, v1.w);
                lo.x = pg8::cvt_pk_bf16(v0.x - bflo(hi.x), v0.y - bfhi(hi.x)); lo.y = pg8::cvt_pk_bf16(v0.z - bflo(hi.y), v0.w - bfhi(hi.y));
                lo.z = pg8::cvt_pk_bf16(v1.x - bflo(hi.z), v1.y - bfhi(hi.z)); lo.w = pg8::cvt_pk_bf16(v1.z - bflo(hi.w), v1.w - bfhi(hi.w));
                { v2u h8; h8.x = pk_fp8x4(v0.x, v0.y, v0.z, v0.w); h8.y = pk_fp8x4(v1.x, v1.y, v1.z, v1.w); *(v2u*)(hrow + 32 * kc) = h8; }
                const bf16x8 hf = __builtin_bit_cast(bf16x8, hi), lf = __builtin_bit_cast(bf16x8, lo);
#pragma unroll
                for (int n = 0; n < 3; ++n) {
                    const bf16x8 wh = *(const LAS bf16x8*)(sh + (16 * n + tk) * 136 + 32 * q + 8 * ks), wl = *(const LAS bf16x8*)(sl + (16 * n + tk) * 136 + 32 * q + 8 * ks);
                    acc[n] = __builtin_amdgcn_mfma_f32_16x16x32_bf16(wh, hf, acc[n], 0, 0, 0);
                    acc[n] = __builtin_amdgcn_mfma_f32_16x16x32_bf16(wh, lf, acc[n], 0, 0, 0);
                    acc[n] = __builtin_amdgcn_mfma_f32_16x16x32_bf16(wl, hf, acc[n], 0, 0, 0);
                } }
            if (kg < 7) RT_SLAB_STORE((kg + 1) & 1);
            LDS_WAIT();
            __syncthreads();
        }
#undef RT_SLAB_LOAD
#undef RT_SLAB_STORE
        ss += __shfl_xor(ss, 16); ss += __shfl_xor(ss, 32);
        const float rstd = 1.0f / sqrtf(ss * (1.f / D) + RMS_EPS);
        if (ks == 0) RSTD[tok0 + tk] = rstd;
#pragma unroll
        for (int n = 0; n < 3; ++n)
#pragma unroll
            for (int r = 0; r < 4; ++r) lg[tk * 49 + 16 * n + 4 * ks + r] = acc[n][r] * rstd;
        LDS_WAIT();
        int E1 = 0, E2 = 0; float w1 = 0.f, w2 = 0.f; unsigned r1 = 0, r2 = 0;
        if (lane < 16) {
            const LAS float* my = lg + lane * 49;
            float lgp[4];
#pragma unroll
            for (int i = 0; i < 4; ++i) lgp[i] = my[i] + I.p[23][i];
            int gi = 0; float mx = lgp[0];
#pragma unroll
            for (int i = 1; i < 4; ++i) if (lgp[i] > mx) { mx = lgp[i]; gi = i; }
            float den = 0.f;
#pragma unroll
            for (int i = 0; i < 4; ++i) den += expf(lgp[i] - mx);
            const float pg = 1.0f / den;
            float le[8];
#pragma unroll
            for (int i = 0; i < 8; ++i) le[i] = my[4 + gi * 8 + i] + I.p[25][gi * 8 + i];
            int i1 = 0; float m1 = le[0];
#pragma unroll
            for (int i = 1; i < 8; ++i) if (le[i] > m1) { m1 = le[i]; i1 = i; }
            int i2 = -1; float m2 = -3.0e38f;
#pragma unroll
            for (int i = 0; i < 8; ++i) if (i != i1 && le[i] > m2) { m2 = le[i]; i2 = i; }
            const float e2 = expf(m2 - m1);
            w1 = pg / (1.0f + e2); w2 = pg * e2 / (1.0f + e2);
            E1 = gi * 8 + i1; E2 = gi * 8 + i2;
            r1 = __hip_atomic_fetch_add((LAS unsigned*)(F.MISC + 32) + E1, 1u, __ATOMIC_RELAXED, __HIP_MEMORY_SCOPE_WORKGROUP);
            r2 = __hip_atomic_fetch_add((LAS unsigned*)(F.MISC + 32) + E2, 1u, __ATOMIC_RELAXED, __HIP_MEMORY_SCOPE_WORKGROUP);
        }
        LDS_WAIT();
        __syncthreads();
        if (F.tid < 32) { const unsigned c = cntL[F.tid]; baseL[F.tid] = c ? __hip_atomic_fetch_add(gcnt + F.tid, c, __ATOMIC_RELAXED, __HIP_MEMORY_SCOPE_AGENT) : 0u; }
        __syncthreads();
        if (lane < 16) {
            const int tok = tok0 + lane; const int k1 = (int)(baseL[E1] + r1), k2 = (int)(baseL[E2] + r2);
            LTOK[(size_t)E1 * T + k1] = tok; LW[(size_t)E1 * T + k1] = w1; LTOK[(size_t)E2 * T + k2] = tok; LW[(size_t)E2 * T + k2] = w2;
            TOKE[tok * 2] = E1; TOKE[tok * 2 + 1] = E2; TOKR[tok * 2] = k1; TOKR[tok * 2 + 1] = k2;
        }
        __syncthreads();
    }
}

__device__ __forceinline__ void moe_prefix(const Frame& F) {
    if (F.tid < 64) {
        const unsigned nt = F.tid < NEXP ? (F.ctl[CW_CNT + F.tid] + 255u) >> 8 : 0u; unsigned inc = nt;
#pragma unroll
        for (int o = 1; o < 32; o <<= 1) { const unsigned v = __shfl_up(inc, o); if (F.lane >= o) inc += v; }
        if (F.tid < NEXP) F.MISC[96 + F.tid] = inc - nt;
        if (F.tid == NEXP - 1) F.MISC[128] = inc;
    }
    LDS_WAIT();
    __syncthreads();
}
template <int MODE  >
__device__ __forceinline__ void moe_setup(const Frame& F) {
    moe_prefix(F);
    const int NT = (int)F.MISC[128];
    if (F.tid < MAXU) { const int L = F.tid * F.G + F.vcu; int e = -1, mt = 0;
        if (L < NT * 4) { const int mtg = L >> 2; e = 0; while (e < NEXP - 1 && (int)F.MISC[96 + e + 1] <= mtg) ++e; mt = mtg - (int)F.MISC[96 + e]; }
        F.MISC[136 + F.tid] = (unsigned)e; F.MISC[144 + F.tid] = (unsigned)mt; }
    __syncthreads();
    if (F.tid == 0) { int n = 0; while (n < MAXU && (int)F.MISC[136 + n] >= 0) ++n; F.MISC[152] = (unsigned)n; }
    __syncthreads();
    const int nU = (int)F.MISC[152];
    LAS int* tokL = (LAS int*)(F.lds + TOKL_OFF); LAS float* sclL = (LAS float*)(F.lds + SCLL_OFF);
    const int* LTOK = (const int*)(F.ws + WS_LTOK); const float* LW = (const float*)(F.ws + WS_LW); const float* RSTD = (const float*)(F.ws + SM_RSTD);
    for (int i = F.tid; i < nU * 256; i += 512) { const int ui = i >> 8, r = i & 255, e = (int)F.MISC[136 + ui], rank = (int)F.MISC[144 + ui] * 256 + r; const bool valid = rank < (int)F.ctl[CW_CNT + e];
        const int tok = valid ? LTOK[(size_t)e * T + rank] : 0; tokL[i] = tok; sclL[i] = valid ? (MODE == 0 ? RSTD[tok] : LW[(size_t)e * T + rank]) : 0.f; }
    LDS_WAIT(); VM_WAIT();
    __syncthreads();
}

__device__ __forceinline__ void p11_final(const Frame& F, const In& I, float* dst) {
    moe_prefix(F);
    const int gw = F.vcu * NWAVES + F.wave, NGW = F.G * NWAVES, lane = F.lane;
    const int* TOKE = (const int*)(F.ws + WS_TOKE); const int* TOKR = (const int*)(F.ws + WS_TOKR);
    const unsigned char* YS8 = (const unsigned char*)(F.ws + WS_YS); const float* YSC = (const float*)(F.ws + WS_YS + 80 * MiB);
    const unsigned char* D8 = (const unsigned char*)(F.ws + WS_D8); const float* DSC = (const float*)(F.ws + WS_DSC); const float* X = I.p[0];
    f32x4 gfin[4];
#pragma unroll
    for (int j = 0; j < 4; ++j) gfin[j] = ((const f32x4*)I.p[29])[lane + 64 * j];
    int ee[2][2], rr[2][2];
    { const int m0 = gw * 2 < T ? gw * 2 : 0;
#pragma unroll
      for (int q = 0; q < 2; ++q) { ee[q][0] = TOKE[2 * (m0 + q)]; ee[q][1] = TOKE[2 * (m0 + q) + 1]; rr[q][0] = TOKR[2 * (m0 + q)]; rr[q][1] = TOKR[2 * (m0 + q) + 1]; } }
    for (int m0 = gw * 2; m0 < T; m0 += NGW * 2) {
        f32x4 xv[2][4]; unsigned ya[2][4], yb[2][4], yd[2][4]; f32x4 sa[2], sb[2], sd[2];
#pragma unroll
        for (int q = 0; q < 2; ++q) { const size_t s0 = (size_t)F.MISC[96 + ee[q][0]] * 256 + rr[q][0], s1 = (size_t)F.MISC[96 + ee[q][1]] * 256 + rr[q][1];
            const f32x4* xr = (const f32x4*)(X + (size_t)(m0 + q) * D) + lane; const unsigned* y0 = (const unsigned*)(YS8 + s0 * 1024) + lane; const unsigned* y1 = (const unsigned*)(YS8 + s1 * 1024) + lane;
            const unsigned* d0 = (const unsigned*)(D8 + (size_t)(m0 + q) * 1024) + lane;
#pragma unroll
            for (int j = 0; j < 4; ++j) { xv[q][j] = __builtin_nontemporal_load(xr + 64 * j); ya[q][j] = y0[64 * j]; yb[q][j] = y1[64 * j]; yd[q][j] = d0[64 * j]; }
            sa[q] = *(const f32x4*)(YSC + s0 * 16 + 4 * (lane >> 4)); sb[q] = *(const f32x4*)(YSC + s1 * 16 + 4 * (lane >> 4)); sd[q] = *(const f32x4*)(DSC + (size_t)(m0 + q) * 16 + 4 * (lane >> 4)); }
        { const int mn = m0 + NGW * 2 < T ? m0 + NGW * 2 : m0;
#pragma unroll
          for (int q = 0; q < 2; ++q) { ee[q][0] = TOKE[2 * (mn + q)]; ee[q][1] = TOKE[2 * (mn + q) + 1]; rr[q][0] = TOKR[2 * (mn + q)]; rr[q][1] = TOKR[2 * (mn + q) + 1]; } }
        asm volatile("" ::: "memory");
#pragma unroll
        for (int q = 0; q < 2; ++q) { f32x4 v[4]; float s = 0.f;
#pragma unroll
            for (int j = 0; j < 4; ++j) { const f32x4 x = xv[q][j]; const unsigned a = ya[q][j], b = yb[q][j], c = yd[q][j]; const float ka = sa[q][j], kb = sb[q][j], kc = sd[q][j];
                v[j].x = (x.x + (float)((int)(c << 24) >> 24) * kc) + (float)((int)(a << 24) >> 24) * ka + (float)((int)(b << 24) >> 24) * kb;
                v[j].y = (x.y + (float)((int)(c << 16) >> 24) * kc) + (float)((int)(a << 16) >> 24) * ka + (float)((int)(b << 16) >> 24) * kb;
                v[j].z = (x.z + (float)((int)(c << 8) >> 24) * kc) + (float)((int)(a << 8) >> 24) * ka + (float)((int)(b << 8) >> 24) * kb;
                v[j].w = (x.w + (float)((int)c >> 24) * kc) + (float)((int)a >> 24) * ka + (float)((int)b >> 24) * kb;
                s += (v[j].x * v[j].x + v[j].y * v[j].y) + (v[j].z * v[j].z + v[j].w * v[j].w); }
            const float rstd = 1.0f / sqrtf(wave_sum(s) * (1.f / D) + RMS_EPS);
            f32x4* xw = (f32x4*)(dst + (size_t)(m0 + q) * D) + lane;
#pragma unroll
            for (int j = 0; j < 4; ++j) { const f32x4 g = gfin[j]; __builtin_nontemporal_store((f32x4){v[j].x * rstd * g.x, v[j].y * rstd * g.y, v[j].z * rstd * g.z, v[j].w * rstd * g.w}, xw + 64 * j); } }
    }
}

constexpr int N_PHASES = 12;
struct Args { In in; float* out; unsigned char* ws; float* fin_dst; int ph_lo, ph_hi, li, pad; };
__global__ void __launch_bounds__(NWAVES * 64, 2) mk_fwd(Args args) {
    extern __shared__ __attribute__((aligned(16))) unsigned char lds[];
    Frame F;
    F.lds = (LAS unsigned char*)lds;
    F.MISC = (volatile LAS unsigned*)(F.lds + MISC_OFF);
    F.tid = threadIdx.x; F.lane = F.tid & 63; F.wave = __builtin_amdgcn_readfirstlane(F.tid >> 6);
    F.G = gridDim.x; { const int bx = blockIdx.x; F.vcu = (F.G % 8 == 0) ? (bx % 8) * (F.G / 8) + bx / 8 : bx; }
    F.ws = args.ws; F.out = args.out; F.ctl = (unsigned*)(args.ws + WS_CTL); F.in = nullptr;
    const In& I = args.in;
    for (int u = F.tid; u < 256; u += NWAVES * 64) F.MISC[u] = 0u;
    __syncthreads();
    const int lo = args.ph_lo, hi = args.ph_hi;
    XcdBarrier bar; bar.bar = F.ctl + CW_BAR + args.li * XCD_BAR_WORDS; bar.x = 0; bar.st = nullptr;
    if (hi - lo > 1) bar = xcd_barrier_post(F.ctl + CW_BAR + args.li * XCD_BAR_WORDS, F.MISC + 8);
#ifndef PH_MASK
#define PH_MASK 0xFFF
#endif
#define IN(k) (((PH_MASK >> (k)) & 1) && lo <= (k) && (k) < hi)
#define SEAM(k) do { if (IN(k) && IN(NEXT_PH(k))) xcd_barrier(bar); } while (0)
#define NEXT_PH(k) ((k) == 2 ? 5 : (k) == 5 ? 7 : (k) + 1)
    const int cblk = (int)blockIdx.x;
    LAS unsigned char* ring = F.lds;

    if (IN(0)) { p0_prologue(F, I); SEAM(0); }

    if (IN(1)) {
        if (F.G < 2) late_weight_copies(F, I, F.wave, NWAVES); else if (cblk & 1) late_weight_copies(F, I, (cblk >> 1) * NWAVES + F.wave, (F.G >> 1) * NWAVES);
        DenseOrder S; S.init(F.ws + WS_H, F.ws + WS_WIN, D / 2, D / 2, T, NIN, F.G, cblk);
        EpiInProj E{(bf16*)(F.ws + WS_AG), (bf16*)(F.ws + WS_XL), (bf16*)(F.ws + WS_GL), (bf16*)(F.ws + WS_GA), (bf16*)(F.ws + WS_GB), (const float*)(F.ws + SM_HSC), (const float*)(F.ws + SM_WSC), F.lds + TOKL_OFF};
        pg8::gemm_phase<EpiInProj, DenseOrder, true>(ring, D / 2, D / 2, S, E);
        SEAM(1);
    }
    if (IN(2)) {
        if (cblk < 256) {
            const int L = cblk, wgid = (L % 8) * 32 + L / 8, g = wgid >> 3, mt = wgid & 7;
            { S5One S{(const char*)(F.ws + WS_AG) + S5Q * 2, (const char*)(F.ws + WS_BTW), (size_t)S5N * S5K * 2, (size_t)128 * 256 * 2, S5K, g, mt};
              EpiS5State E{(float*)(F.ws + WS_SLOC)};
              pg8::gemm_phase<EpiS5State, S5One, false>(ring, 256, 256, S, E); }
            if (F.wave == 0) { __builtin_amdgcn_fence(__ATOMIC_ACQUIRE, "agent"); VM_WAIT(); }
            __syncthreads();
            s5_chain(F, mt, g);
            VM_WAIT();
            __syncthreads();
            if (F.wave == 0) { __builtin_amdgcn_fence(__ATOMIC_ACQUIRE, "agent"); VM_WAIT(); }
            __syncthreads();
            { S5One S{(const char*)(F.ws + WS_AG), (const char*)(F.ws + WS_BTT), (size_t)S5N * S5K * 2, (size_t)256 * S5K * 2, S5K, g, mt};
              EpiS5Out E{(bf16*)(F.ws + WS_GY)};
              pg8::gemm_phase<EpiS5Out, S5One, false>(ring, S5K, S5K, S, E); }
            __syncthreads();
        }
        lru_seq(F, I);
        SEAM(2);
    }
    if (IN(5)) {
        YaYbOrder S; S.d.init(nullptr, nullptr, D, D, T, D, F.G, cblk);
        S.GYb = (const char*)(F.ws + WS_GY); S.WS5b = (const char*)(F.ws + WS_WS5); S.YLb = (const char*)(F.ws + WS_H); S.WLb = (const char*)(F.ws + WS_WLRU);
        EpiYaYb E{EpiYa{(const bf16*)(F.ws + WS_GA), (bf16*)(F.ws + WS_XL)}, EpiYb{(const bf16*)(F.ws + WS_XL), (const bf16*)(F.ws + WS_GB), (bf16*)(F.ws + WS_GL)}};
        pg8::gemm_phase<EpiYaYb, YaYbOrder, true>(ring, D, D, S, E);
        SEAM(5);
    }
    if (IN(7)) {
        DenseOrder S; S.init(F.ws + WS_GL, F.ws + WS_WO, D, D, T, D, F.G, cblk);
        EpiQ8<false> E{(unsigned char*)(F.ws + WS_D8), (float*)(F.ws + WS_DSC), nullptr};
        pg8::gemm_phase<EpiQ8<false>, DenseOrder, true>(ring, D, D, S, E);
        SEAM(7);
    }
    if (IN(8)) { p8_router(F, I); __syncthreads(); expert_weight_copies(F, I); SEAM(8); }
    if (IN(9)) {
        moe_setup<0>(F);
        MoeOrder<true> S{(const char*)(F.ws + WS_H2), (const char*)(F.ws + WS_WGU), (size_t)1024 * 1024, D / 2, D / 2, F.G, F.vcu, F.MISC, (const LAS int*)(F.lds + TOKL_OFF)};
        EpiGU E{F.ws + WS_ACT, (const LAS float*)(F.lds + SCLL_OFF)};
        pg8::gemm_phase<EpiGU, MoeOrder<true>, true>(ring, D / 2, D / 2, S, E);
        __syncthreads();
        expert_down_copies(F, I);
        SEAM(9);
    }
    if (IN(10)) {
        moe_setup<1>(F);
        MoeOrder<false> S{(const char*)(F.ws + WS_ACT), (const char*)(F.ws + WS_WD), (size_t)1024 * DEXP, DEXP / 2, DEXP / 2, F.G, F.vcu, F.MISC, (const LAS int*)(F.lds + TOKL_OFF)};
        EpiQ8<true> E{(unsigned char*)(F.ws + WS_YS), (float*)(F.ws + WS_YS + 80 * MiB), (const LAS float*)(F.lds + SCLL_OFF)};
        pg8::gemm_phase<EpiQ8<true>, MoeOrder<false>, true>(ring, DEXP / 2, DEXP / 2, S, E);
        SEAM(10);
    }
    if (IN(11)) { p11_final(F, I, args.fin_dst); }
#undef IN
#undef SEAM
}

extern "C" void kernel_launch(void* const* d_in, const int* in_sizes, int n_in, void* d_out, int out_size, void* d_ws, size_t ws_size, hipStream_t stream) {
    static int grid = 0;
    if (grid == 0) {
        if (n_in != 30 || in_sizes[0] != T * D || out_size != T * D || ws_size < WS_END) { fprintf(stderr, "kernel_launch: unexpected shapes / workspace (n_in %d, ws %zu)\n", n_in, ws_size); grid = -1; return; }
        int dev = 0, cus = 0, per_cu = 0;
        if (hipGetDevice(&dev) != hipSuccess || hipDeviceGetAttribute(&cus, hipDeviceAttributeMultiprocessorCount, dev) != hipSuccess) { grid = -1; return; }
        if (hipFuncSetAttribute((const void*)mk_fwd, hipFuncAttributeMaxDynamicSharedMemorySize, LDS_BYTES) != hipSuccess) { fprintf(stderr, "kernel_launch: hipFuncSetAttribute failed\n"); grid = -1; return; }
        if (hipOccupancyMaxActiveBlocksPerMultiprocessor(&per_cu, (const void*)mk_fwd, NWAVES * 64, LDS_BYTES) != hipSuccess || per_cu < 1) { fprintf(stderr, "kernel_launch: occupancy query says %d\n", per_cu); }
        (void)hipGetLastError();
        grid = cus;
    }
    if (grid < 0) return;
    if (hipMemsetAsync((char*)d_ws + WS_CTL, 0, CTL_ZERO_BYTES, stream) != hipSuccess) return;
    Args a{};
    for (int i = 0; i < 30; ++i) a.in.p[i] = (const float*)d_in[i];
    a.out = (float*)d_out; a.ws = (unsigned char*)d_ws; a.fin_dst = (float*)d_out;
#if defined(PROBE_LO)
    a.ph_lo = 0; a.ph_hi = PROBE_HI; a.li = 0;
#if PROBE_LO == 11
    a.fin_dst = (float*)((char*)d_ws + WS_H2);
#endif
    hipLaunchKernelGGL(mk_fwd, dim3(grid), dim3(NWAVES * 64), LDS_BYTES, stream, a);
#if PROBE_LO == 8
    hipMemsetAsync((char*)d_ws + WS_CTL + CW_CNT * 4, 0, 128, stream);
#endif
    a.fin_dst = (float*)d_out;
    a.ph_lo = PROBE_LO; a.ph_hi = N_PHASES; a.li = 1;
    hipLaunchKernelGGL(mk_fwd, dim3(grid), dim3(NWAVES * 64), LDS_BYTES, stream, a);
#elif MK_N_LAUNCHES == 1
    a.ph_lo = 0; a.ph_hi = N_PHASES;
    hipLaunchKernelGGL(mk_fwd, dim3(grid), dim3(NWAVES * 64), LDS_BYTES, stream, a);
#else
    for (int p = 0; p < N_PHASES; ++p) { a.ph_lo = p; a.ph_hi = p + 1; hipLaunchKernelGGL(mk_fwd, dim3(grid), dim3(NWAVES * 64), LDS_BYTES, stream, a); }
#endif
}
```

```cpp
#include <hip/hip_runtime.h>
#include <cstdio>
#include <cstdint>

#ifndef MK_N_LAUNCHES
#define MK_N_LAUNCHES 1
#endif

namespace pg8 {
#define PG8_LAS __attribute__((address_space(3)))
typedef unsigned short bf16_t;
typedef short bf16x8 __attribute__((ext_vector_type(8)));
typedef float f32x4 __attribute__((ext_vector_type(4)));
typedef unsigned u32x4 __attribute__((ext_vector_type(4)));
typedef int i32x4 __attribute__((ext_vector_type(4)));
template <class E, class = void> struct epi_i8 { static constexpr bool v = false; };
template <class E> struct epi_i8<E, decltype((void)E::I8)> { static constexpr bool v = E::I8; };
template <class E, class = void> struct epi_f8 { static constexpr bool v = false; };
template <class E> struct epi_f8<E, decltype((void)E::F8)> { static constexpr bool v = E::F8; };
typedef int i32x8 __attribute__((ext_vector_type(8)));
template <bool I8> struct acc_sel { typedef f32x4 t; };
template <> struct acc_sel<true> { typedef i32x4 t; };
constexpr int BM = 256, BK = 64, HALF = 128, HTB = HALF * BK * 2  , STAGE_BYTES = 8 * HTB, NXCD = 8, WGM = 8;

__host__ __device__ __forceinline__ int lds_byte(int r, int c) { const int st = (r >> 4) * 2 + (c >> 5), rr = r & 15, cc = c & 31, ob = rr * 64 + cc * 2; return st * 1024 + (ob ^ (((ob >> 9) & 1) << 5)); }
__host__ __device__ __forceinline__ void stage_rc(int b, int& R, int& C) { const int st = b / 1024, sb = b % 1024, swz = sb ^ (((sb >> 9) & 1) << 5); R = (st >> 1) * 16 + swz / 64; C = (st & 1) * 32 + (swz % 64) / 2; }
__host__ __device__ __forceinline__ int perm32(int rho) { const int n = rho >> 4, i = rho & 15; return 8 * (i >> 2) + 4 * n + (i & 3); }

struct Unit { const char* A; const char* B; int pm, pn, aux, nt, kind; unsigned kA; };

__device__ __forceinline__ unsigned cvt_pk_bf16(float lo, float hi) { unsigned r; asm volatile("v_cvt_pk_bf16_f32 %0, %1, %2" : "=v"(r) : "v"(lo), "v"(hi)); return r; }

template <class Epi, class Sched, bool ALIGN_EPI>
__device__ __forceinline__ void gemm_phase(PG8_LAS unsigned char* lds, const int ldb, const int K, const Sched& S, const Epi& E, const size_t kstepA = (size_t)(BK * 2)) {
    const int tid = threadIdx.x, wid = __builtin_amdgcn_readfirstlane(tid >> 6), lane = tid & 63, wr = wid >> 2, wc = wid & 3, fr = lane & 15, fq = lane >> 4;
    constexpr bool I8 = epi_i8<Epi>::v, F8 = epi_f8<Epi>::v; typedef typename acc_sel<I8>::t acc_t;
    int nt = K / BK; asm volatile("" : "+s"(nt));
    int Rr[2], Cc[2], Rbb[2]; unsigned voffB[4], vAc[4], vAn[4];
#pragma unroll
    for (int i = 0; i < 2; ++i) { int R, C; stage_rc(tid * 16 + i * 8192, R, C); Rr[i] = R; Cc[i] = C; const int Rb = Epi::PERM ? ((R & ~31) + perm32(R & 31)) : R; Rbb[i] = Rb;
        int Rb0 = Rb, Rb1 = HALF + Rb;
        if constexpr (Epi::B16) {
            const int w_ = R >> 5, nn_ = (R >> 4) & 1, ii_ = R & 15; Rb0 = 64 * w_ + 16 * (ii_ >> 2) + 4 * nn_ + (ii_ & 3); Rb1 = Rb0 + 8; }
        voffB[i] = (unsigned)(Rb0 * ldb + C) * 2u; voffB[2 + i] = (unsigned)(Rb1 * ldb + C) * 2u; }
    const size_t kstep = (size_t)(BK * 2);
    const unsigned ldsw = (unsigned)wid * 1024u;
    const int aoff = lds_byte(wr * 64 + fr, fq * 8), boff = lds_byte(wc * 32 + fr, fq * 8);
#define PG8_SA(b, h) (((b) * 2 + (h)) * HTB)
#define PG8_SB(b, h) ((4 + (b) * 2 + (h)) * HTB)
#define PG8_STAGE(bufoff, gbase, voff, h) do { _Pragma("unroll") for (int _i = 0; _i < 2; ++_i) \
        __builtin_amdgcn_global_load_lds((const unsigned*)((const char*)(gbase) + (voff)[2 * (h) + _i]), (PG8_LAS unsigned*)(lds + (bufoff) + ldsw + _i * 8192), 16, 0, 0); } while (0)
#define PG8_LDA(dst, b, h) do { _Pragma("unroll") for (int m = 0; m < 4; ++m) _Pragma("unroll") for (int k = 0; k < 2; ++k) dst[m][k] = *(const PG8_LAS bf16x8*)(lds + PG8_SA(b, h) + aoff + m * 2048 + k * 1024); } while (0)
#define PG8_LDB(dst, b, h) do { _Pragma("unroll") for (int n = 0; n < 2; ++n) _Pragma("unroll") for (int k = 0; k < 2; ++k) dst[n][k] = *(const PG8_LAS bf16x8*)(lds + PG8_SB(b, h) + boff + n * 2048 + k * 1024); } while (0)
#define PG8_MMA(ai, bj, At, Bt) do { __builtin_amdgcn_s_setprio(1); _Pragma("unroll") for (int m = 0; m < 4; ++m) _Pragma("unroll") for (int n = 0; n < 2; ++n) { \
        if constexpr (F8) { const i32x4 b0_ = __builtin_bit_cast(i32x4, Bt[n][0]), b1_ = __builtin_bit_cast(i32x4, Bt[n][1]), a0_ = __builtin_bit_cast(i32x4, At[m][0]), a1_ = __builtin_bit_cast(i32x4, At[m][1]); \
            acc[ai][bj][m][n] = __builtin_amdgcn_mfma_scale_f32_16x16x128_f8f6f4((i32x8){b0_[0], b0_[1], b0_[2], b0_[3], b1_[0], b1_[1], b1_[2], b1_[3]}, (i32x8){a0_[0], a0_[1], a0_[2], a0_[3], a1_[0], a1_[1], a1_[2], a1_[3]}, acc[ai][bj][m][n], 0, 0, 0, 0, 0, 0); } \
        else { _Pragma("unroll") for (int k = 0; k < 2; ++k) { \
          if constexpr (I8) acc[ai][bj][m][n] = __builtin_amdgcn_mfma_i32_16x16x64_i8(__builtin_bit_cast(i32x4, Bt[n][k]), __builtin_bit_cast(i32x4, At[m][k]), acc[ai][bj][m][n], 0, 0, 0); \
          else acc[ai][bj][m][n] = __builtin_amdgcn_mfma_f32_16x16x32_bf16(Bt[n][k], At[m][k], acc[ai][bj][m][n], 0, 0, 0); } } } __builtin_amdgcn_s_setprio(0); } while (0)
#define PG8_WAIT_V(n) asm volatile("s_waitcnt vmcnt(" #n ")" ::: "memory")
#define PG8_WAIT_L(n) asm volatile("s_waitcnt lgkmcnt(" #n ")" ::: "memory")
#define PG8_BAR __builtin_amdgcn_s_barrier()
#define PG8_SCHED __builtin_amdgcn_sched_barrier(0)
    Unit cur, nxt; int ui = 0;
    if (!S.next(0, cur)) return;
    S.a_offsets(cur, Rr, Cc, vAc);
    unsigned vBc[4], vBn[4];
    if constexpr (Sched::HETERO) { S.b_offsets(cur, Rbb, Cc, vBc); nt = __builtin_amdgcn_readfirstlane(cur.nt); }
    else {
#pragma unroll
        for (int q = 0; q < 4; ++q) vBc[q] = voffB[q]; }
    size_t kAc = Sched::HETERO ? (size_t)(unsigned)__builtin_amdgcn_readfirstlane((int)cur.kA) : kstepA;
    acc_t acc[2][2][4][2];
    if constexpr (Epi::ACC_INIT) E.init(acc, cur, wr, wc, fr, fq);
    else {
#pragma unroll
    for (int a = 0; a < 2; ++a)
#pragma unroll
        for (int b = 0; b < 2; ++b)
#pragma unroll
            for (int m = 0; m < 4; ++m)
#pragma unroll
                for (int n = 0; n < 2; ++n) acc[a][b][m][n] = acc_t{}; }
    bf16x8 At[4][2], B0[2][2], B1[2][2];
    const char* cA = cur.A; const char* cB = cur.B;
    if constexpr (Sched::GATHER) { PG8_WAIT_L(0); }
    PG8_STAGE(PG8_SB(0, 0), cB, vBc, 0); PG8_STAGE(PG8_SB(0, 1), cB, vBc, 1); PG8_STAGE(PG8_SA(0, 0), cA, vAc, 0); PG8_STAGE(PG8_SA(0, 1), cA, vAc, 1);
    if (wr == 1) PG8_BAR;
    PG8_WAIT_V(2); PG8_BAR;
    PG8_STAGE(PG8_SB(1, 0), cB + kstep, vBc, 0); PG8_STAGE(PG8_SA(1, 0), cA + kAc, vAc, 0); PG8_STAGE(PG8_SB(1, 1), cB + kstep, vBc, 1);
    PG8_WAIT_V(6); PG8_BAR;
    for (;;) {
        const bool has_next = S.next(ui + 1, nxt);
        const char* nA = has_next ? nxt.A : cA; const char* nB = has_next ? nxt.B : cB;
        size_t kAn = kAc;
        if constexpr (Sched::HETERO) { if (has_next) { S.b_offsets(nxt, Rbb, Cc, vBn); kAn = (size_t)(unsigned)__builtin_amdgcn_readfirstlane((int)nxt.kA); } else {
#pragma unroll
                for (int q = 0; q < 4; ++q) vBn[q] = vBc[q]; } }
        for (int t = 0; t < nt; t += 2) {
            const bool last = (t == nt - 2);
            const char* a1 = cA + (size_t)(t + 1) * kAc;
            const char* a2 = last ? nA : cA + (size_t)(t + 2) * kAc; const char* b2 = last ? nB : cB + (size_t)(t + 2) * kstep;
            const char* a3 = a2 + (last ? kAn : kAc); const char* b3 = b2 + kstep;
            unsigned vb2[4];
#pragma unroll
            for (int q = 0; q < 4; ++q) vb2[q] = (Sched::HETERO && last) ? vBn[q] : vBc[q];
            unsigned va2[4];
            if constexpr (Sched::GATHER || Sched::HETERO) {
                if (last) { if (has_next) { S.a_offsets(nxt, Rr, Cc, vAn); if constexpr (Sched::GATHER) { PG8_WAIT_L(0); } } else {
#pragma unroll
                        for (int q = 0; q < 4; ++q) vAn[q] = vAc[q]; } }
#pragma unroll
                for (int q = 0; q < 4; ++q) va2[q] = last ? vAn[q] : vAc[q];
            } else {
#pragma unroll
                for (int q = 0; q < 4; ++q) va2[q] = vAc[q];
            }
            PG8_LDB(B0, 0, 0); PG8_LDB(B1, 0, 1); PG8_SCHED; PG8_LDA(At, 0, 0); PG8_STAGE(PG8_SA(1, 1), a1, vAc, 1);
            PG8_WAIT_V(8); PG8_WAIT_L(0); PG8_BAR; PG8_MMA(0, 0, At, B0); PG8_MMA(0, 1, At, B1); PG8_BAR; PG8_SCHED;
            const bool fin = last && !has_next;
            PG8_LDA(At, 0, 1);
            if (!fin) { PG8_STAGE(PG8_SB(0, 0), b2, vb2, 0); PG8_STAGE(PG8_SB(0, 1), b2, vb2, 1); PG8_STAGE(PG8_SA(0, 0), a2, va2, 0); PG8_WAIT_V(8); } else { PG8_WAIT_V(0); }
            PG8_WAIT_L(0); PG8_BAR; PG8_MMA(1, 0, At, B0); PG8_MMA(1, 1, At, B1); PG8_BAR; PG8_SCHED;
            PG8_LDB(B0, 1, 0); PG8_LDB(B1, 1, 1); PG8_SCHED; PG8_LDA(At, 1, 0);
            if (!fin) { PG8_STAGE(PG8_SA(0, 1), a2, va2, 1); PG8_WAIT_V(8); } else { PG8_WAIT_V(0); }
            PG8_WAIT_L(0); PG8_BAR; PG8_MMA(0, 0, At, B0); PG8_MMA(0, 1, At, B1); PG8_BAR; PG8_SCHED;
            PG8_LDA(At, 1, 1);
            if (!fin) { PG8_STAGE(PG8_SB(1, 0), b3, vb2, 0); PG8_STAGE(PG8_SB(1, 1), b3, vb2, 1); PG8_STAGE(PG8_SA(1, 0), a3, va2, 0); PG8_WAIT_V(8); } else { PG8_WAIT_V(0); }
            PG8_WAIT_L(0); PG8_BAR; PG8_MMA(1, 0, At, B0); PG8_MMA(1, 1, At, B1); PG8_BAR; PG8_SCHED;
        }
        if constexpr (ALIGN_EPI) { if (wr == 0) PG8_BAR; }
        E(acc, cur, wr, wc, fr, fq);
        if (!has_next) break;
        if constexpr (Epi::ACC_INIT) E.init(acc, nxt, wr, wc, fr, fq);
        else {
#pragma unroll
        for (int a = 0; a < 2; ++a)
#pragma unroll
            for (int b = 0; b < 2; ++b)
#pragma unroll
                for (int m = 0; m < 4; ++m)
#pragma unroll
                    for (int n = 0; n < 2; ++n) acc[a][b][m][n] = acc_t{}; }
        cur = nxt; cA = nA; cB = nB; ++ui;
        if constexpr (Sched::GATHER || Sched::HETERO) {
#pragma unroll
            for (int q = 0; q < 4; ++q) vAc[q] = vAn[q]; }
        if constexpr (Sched::HETERO) {
#pragma unroll
            for (int q = 0; q < 4; ++q) vBc[q] = vBn[q];
            kAc = kAn; nt = __builtin_amdgcn_readfirstlane(cur.nt); }
        if constexpr (ALIGN_EPI) { if (wr == 1) PG8_BAR; }
    }
    PG8_WAIT_V(0);
    if constexpr (!ALIGN_EPI) { if (wr == 0) PG8_BAR; }
    PG8_BAR;
#undef PG8_SA
#undef PG8_SB
#undef PG8_STAGE
#undef PG8_LDA
#undef PG8_LDB
#undef PG8_MMA
#undef PG8_WAIT_V
#undef PG8_WAIT_L
#undef PG8_BAR
#undef PG8_SCHED
}
}

constexpr int NWAVES = 8;
constexpr int BATCH = 8, SEQ = 4096, D = 1024, T = BATCH * SEQ;
constexpr int S5W = 512, S5G = 32, S5C = 16, S5P = 64, S5Q = 128;
constexpr int S5LC = 16, S5NCH = SEQ / S5LC, S5N = BATCH * S5NCH;
constexpr int S5K = S5Q + S5LC * S5C;
constexpr int LRUW = 1024, LRUH = 16, LRUHD = 64, LRUCH = 64, LRUNCH = SEQ / LRUCH;
constexpr int NIN = S5W + 2 * LRUW + 2 * D;
constexpr int NEXP = 32, EPG = 8, NGRP = 4, DEXP = 512, NROUT = 48;
constexpr int MAXSLOT = 73728;
constexpr int MAXU = 8;
constexpr float RMS_EPS = 1e-6f;

constexpr size_t MiB = 1u << 20;
constexpr size_t WS_CTL = 0, CTL_ZERO_BYTES = 128 * 1024;
constexpr size_t WS_SMALL = 1 * MiB;
constexpr size_t SM_LAM16 = WS_SMALL + 0;
constexpr size_t SM_LRUC = WS_SMALL + 16384;
constexpr size_t SM_WRT = WS_SMALL + 32768;
constexpr size_t SM_RHI = WS_SMALL + 327680;
constexpr size_t SM_RLO = SM_RHI + 98304;
constexpr size_t SM_RSTD = WS_SMALL + 524288;
constexpr size_t SM_HSC = WS_SMALL + 720896;
constexpr size_t SM_WSC = WS_SMALL + 851968;
constexpr size_t WS_BTT = 2 * MiB;
constexpr size_t WS_BTW = 8 * MiB;
constexpr size_t WS_WIN = 11 * MiB;
constexpr size_t WS_WS5 = 20 * MiB;
constexpr size_t WS_WLRU = 22 * MiB;
constexpr size_t WS_WO = 24 * MiB;
constexpr size_t WS_LP = 26 * MiB, WS_LH = 28 * MiB, WS_LHIN = 30 * MiB;
constexpr size_t WS_AG = 32 * MiB;
constexpr size_t WS_SLOC = 80 * MiB;
constexpr size_t WS_H = 112 * MiB;
constexpr size_t WS_XL = 176 * MiB;
constexpr size_t WS_GL = 240 * MiB;
constexpr size_t WS_GA = 304 * MiB, WS_GB = 336 * MiB;
constexpr size_t WS_GY = 368 * MiB;
constexpr size_t WS_D8 = 336 * MiB, WS_DSC = 368 * MiB;
constexpr size_t WS_WGU = 400 * MiB;
constexpr size_t WS_WD = 464 * MiB;
constexpr size_t WS_H2 = 32 * MiB;
constexpr size_t WS_ACT = 96 * MiB;
constexpr size_t WS_YS = 168 * MiB;
constexpr size_t WS_LTOK = 312 * MiB, WS_LW = 316 * MiB;
constexpr size_t WS_TOKE = 320 * MiB, WS_TOKR = WS_TOKE + 262144;
constexpr size_t WS_END = 496 * MiB;
static_assert(WS_YS + (size_t)MAXSLOT * 1024 * 2 <= WS_LTOK && WS_ACT + (size_t)MAXSLOT * 512 * 2 <= WS_YS && WS_TOKR + 262144 <= WS_WGU && WS_GY + (size_t)T * 512 * 2 <= WS_WGU && WS_WD + (size_t)32 * 1024 * 512 * 2 <= WS_END, "d_ws map");
constexpr int CW_BAR = 4096;
constexpr int CW_CNT = 16384;

constexpr int RING_BYTES = 131072;
constexpr int TOKL_OFF = RING_BYTES, SCLL_OFF = TOKL_OFF + MAXU * 256 * 4, MISC_OFF = SCLL_OFF + MAXU * 256 * 4;
constexpr int LDS_BYTES = MISC_OFF + 1024;

#define GAS __attribute__((address_space(1)))
#define LAS __attribute__((address_space(3)))
typedef unsigned short bf16;
typedef unsigned v4u __attribute__((ext_vector_type(4)));
typedef unsigned v2u __attribute__((ext_vector_type(2)));
typedef float f32x4 __attribute__((ext_vector_type(4)));
typedef int i32x4 __attribute__((ext_vector_type(4)));
typedef short bf16x8 __attribute__((ext_vector_type(8)));
#define LDS_WAIT() asm volatile("s_waitcnt lgkmcnt(0)" ::: "memory")
#define VM_WAIT() asm volatile("s_waitcnt vmcnt(0)" ::: "memory")
__device__ __forceinline__ unsigned pk2(float lo, float hi) { unsigned r; asm volatile("v_cvt_pk_bf16_f32 %0, %1, %2" : "=v"(r) : "v"(lo), "v"(hi)); return r; }
__device__ __forceinline__ unsigned f2bf(float f) { return pk2(f, 0.f) & 0xffffu; }
__device__ __forceinline__ float bf2f(unsigned h) { return __builtin_bit_cast(float, h << 16); }
__device__ __forceinline__ float bflo(unsigned w) { return __builtin_bit_cast(float, w << 16); }
__device__ __forceinline__ float bfhi(unsigned w) { return __builtin_bit_cast(float, w & 0xffff0000u); }
__device__ __forceinline__ float fsigmoid(float x) { return __builtin_amdgcn_rcpf(1.0f + __builtin_amdgcn_exp2f(-1.44269504f * x)); }
__device__ __forceinline__ float gelu_t(float x) { const float u = x * (0.7978845608f + 0.0356774081f * x * x); return x * __builtin_amdgcn_rcpf(1.0f + __builtin_amdgcn_exp2f(-2.88539008f * u)); }
__device__ __forceinline__ unsigned pk_fp8x4(float a, float b, float c, float d) { int w = 0; w = __builtin_amdgcn_cvt_pk_fp8_f32(a, b, w, false); w = __builtin_amdgcn_cvt_pk_fp8_f32(c, d, w, true); return (unsigned)w; }
__device__ __forceinline__ float wave_sum(float v) {
#pragma unroll
    for (int o = 1; o < 64; o <<= 1) v += __shfl_xor(v, o);
    return v;
}

#define XB_TMO      128
#define XB_XCNT(j)  (256  + 64 * (j))
#define XB_XSUB(j)  (1280 + 64 * (j))
#define XB_XGEN(j)  (2304 + 64 * (j))
#define XB_TOP      3328
#define XB_TOPGEN   3392
#define XCD_BAR_WORDS 3456
#define XB_SPIN_CAP (1u << 18)
__device__ __forceinline__ unsigned xb_ld(unsigned* p)              { return __hip_atomic_load(p, __ATOMIC_RELAXED, __HIP_MEMORY_SCOPE_AGENT); }
__device__ __forceinline__ unsigned xb_add(unsigned* p, unsigned v) { return __hip_atomic_fetch_add(p, v, __ATOMIC_RELAXED, __HIP_MEMORY_SCOPE_AGENT); }
__device__ __forceinline__ unsigned xb_xcc_id() { return (unsigned)__builtin_amdgcn_s_getreg((3 << 11) | 20) & 0xFu; }
#define XB_SPIN(cond, bar) do { unsigned _sp = 0; while (cond) { __builtin_amdgcn_s_sleep(1); \
    if ((++_sp & 255u) == 0u) { if (xb_ld(&(bar)[XB_TMO])) break; if (_sp > XB_SPIN_CAP) { atomicAdd(&(bar)[XB_TMO], 1u); break; } } } } while (0)
struct XcdBarrier { unsigned* bar; unsigned x; volatile LAS unsigned* st; };
__device__ __forceinline__ XcdBarrier xcd_barrier_post(unsigned* bar, volatile LAS unsigned* st) {
    XcdBarrier b; b.bar = bar; b.x = xb_xcc_id(); b.st = st;
    if (threadIdx.x == 0) (void)xb_add(&bar[XB_XCNT(b.x)], 1u);
    return b;
}
__device__ __forceinline__ void xcd_barrier_complete(unsigned* bar, unsigned x, unsigned& nloc, unsigned& nx) {
    const unsigned G = gridDim.x * gridDim.y * gridDim.z;
    unsigned sum, cnt, mine, sp = 0u;
    for (;;) {
        sum = 0u; cnt = 0u; mine = 0u;
#pragma unroll
        for (unsigned j = 0; j < 16; ++j) { const unsigned c = xb_ld(&bar[XB_XCNT(j)]); sum += c; cnt += (c > 0u) ? 1u : 0u; mine = (j == x) ? c : mine; }
        if (sum == G) break;
        __builtin_amdgcn_s_sleep(1);
        if ((++sp & 255u) == 0u) { if (xb_ld(&bar[XB_TMO])) break; if (sp > XB_SPIN_CAP) { atomicAdd(&bar[XB_TMO], 1u); break; } }
    }
    nloc = mine > 0u ? mine : 1u; nx = cnt > 0u ? cnt : 1u;
}
__device__ __forceinline__ void xcd_barrier(const XcdBarrier& b) {
    asm volatile("s_waitcnt vmcnt(0)" ::: "memory");
    __syncthreads();
    if (threadIdx.x == 0) {
        unsigned* bar = b.bar;
        __builtin_amdgcn_s_waitcnt(0);
        unsigned nloc = b.st[0], nx = b.st[1];
        if (nloc == 0u) { xcd_barrier_complete(bar, b.x, nloc, nx); b.st[0] = nloc; b.st[1] = nx; }
        const unsigned old = xb_add(&bar[XB_XSUB(b.x)], 1u);
        const unsigned gen = old / nloc;
        if (old + 1u == (gen + 1u) * nloc) {
            __builtin_amdgcn_fence(__ATOMIC_RELEASE, "agent");
            asm volatile("s_waitcnt vmcnt(0)" ::: "memory");
            const unsigned og = xb_add(&bar[XB_TOP], 1u);
            const unsigned tg = og / nx;
            if (og + 1u == (tg + 1u) * nx) xb_add(&bar[XB_TOPGEN], 1u);
            else XB_SPIN(xb_ld(&bar[XB_TOPGEN]) == tg, bar);
            __builtin_amdgcn_fence(__ATOMIC_ACQUIRE, "agent");
            xb_add(&bar[XB_XGEN(b.x)], 1u);
            asm volatile("s_waitcnt vmcnt(0)" ::: "memory");
        } else {
            XB_SPIN(xb_ld(&bar[XB_XGEN(b.x)]) == gen, bar);
            __builtin_amdgcn_fence(__ATOMIC_ACQUIRE, "agent");
            asm volatile("s_waitcnt vmcnt(0)" ::: "memory");
        }
    }
    __syncthreads();
}

struct Frame {
    LAS unsigned char* lds;
    volatile LAS unsigned* MISC;
    unsigned* ctl;
    int tid, lane, wave, vcu, G;
    const float* const* in;
    unsigned char* ws; float* out;
};

using pg8::Unit;
struct DenseOrder {
    static constexpr bool GATHER = false, HETERO = false;
    const char* A0; const char* B0; int lda, ldb, nM, nN, nwg, G, c;
    __device__ __forceinline__ void init(const void* A, const void* B, int lda_, int ldb_, int M, int N, int G_, int c_) { A0 = (const char*)A; B0 = (const char*)B; lda = lda_; ldb = ldb_; nM = M / 256; nN = N / 256; nwg = nM * nN; G = G_; c = c_; }
    __device__ __forceinline__ bool next(int i, Unit& u) const {
        const long L = (long)i * G + c; if (L >= nwg) return false;
        int wgid = (int)L; { const int q = nwg / 8, r = nwg % 8, xcd = wgid % 8, off = wgid / 8; wgid = (xcd < r ? xcd * (q + 1) : r * (q + 1) + (xcd - r) * q) + off; }
        const int nig = 8 * nN, gid = wgid / nig, fm = gid * 8, gsz = (nM - fm) < 8 ? (nM - fm) : 8;
        u.pm = fm + ((wgid % nig) % gsz); u.pn = (wgid % nig) / gsz; u.aux = i & 1;
        u.A = A0 + (size_t)u.pm * 256 * lda * 2; u.B = B0 + (size_t)u.pn * 256 * ldb * 2; return true;
    }
    __device__ __forceinline__ void a_offsets(const Unit&, const int (&R)[2], const int (&C)[2], unsigned (&v)[4]) const {
#pragma unroll
        for (int i = 0; i < 2; ++i) { v[i] = (unsigned)(R[i] * lda + C[i]) * 2u; v[2 + i] = (unsigned)((128 + R[i]) * lda + C[i]) * 2u; }
    }
};
struct S5One {
    static constexpr bool GATHER = false, HETERO = false;
    const char* A0; const char* B0; size_t sA, sB; int lda, g, mt;
    __device__ __forceinline__ bool next(int i, Unit& u) const {
        if (i > 0) return false;
        u.pm = mt; u.pn = 0; u.aux = g; u.A = A0 + (size_t)g * sA + (size_t)mt * 256 * lda * 2; u.B = B0 + (size_t)g * sB; return true;
    }
    __device__ __forceinline__ void a_offsets(const Unit&, const int (&R)[2], const int (&C)[2], unsigned (&v)[4]) const {
#pragma unroll
        for (int i = 0; i < 2; ++i) { v[i] = (unsigned)(R[i] * lda + C[i]) * 2u; v[2 + i] = (unsigned)((128 + R[i]) * lda + C[i]) * 2u; }
    }
};
struct GyOrder {
    static constexpr bool GATHER = false, HETERO = false;
    DenseOrder d;
    __device__ __forceinline__ bool next(int i, Unit& u) const { if (!d.next(i, u)) return false; u.A = d.A0 + (size_t)u.pm * 256 * 32; return true; }
    __device__ __forceinline__ void a_offsets(const Unit&, const int (&R)[2], const int (&C)[2], unsigned (&v)[4]) const {
#pragma unroll
        for (int i = 0; i < 2; ++i) { const unsigned o = (unsigned)(C[i] >> 4) * (unsigned)(T * 32) + (unsigned)(C[i] & 15) * 2u; v[i] = (unsigned)R[i] * 32u + o; v[2 + i] = (unsigned)(128 + R[i]) * 32u + o; }
    }
};
struct YaYbOrder {
    static constexpr bool GATHER = false, HETERO = true;
    DenseOrder d;
    const char* GYb; const char* WS5b; const char* YLb; const char* WLb;
    __device__ __forceinline__ bool next(int i, Unit& u) const {
        const int j = i / 3, r = i - 3 * j; Unit t;
        if (!d.next(j, t)) return false;
        u.pm = t.pm; u.aux = 0;
        if (r < 2) { u.kind = 0; u.pn = 2 * t.pn + r; u.nt = S5W / 64; u.kA = (unsigned)(4 * T * 32); u.A = GYb + (size_t)t.pm * 256 * 32; u.B = WS5b + (size_t)u.pn * 256 * S5W * 2; }
        else { u.kind = 1; u.pn = t.pn; u.nt = D / 64; u.kA = 128u; u.A = YLb + (size_t)t.pm * 256 * D * 2; u.B = WLb + (size_t)t.pn * 256 * D * 2; }
        return true;
    }
    __device__ __forceinline__ void a_offsets(const Unit& u, const int (&R)[2], const int (&C)[2], unsigned (&v)[4]) const {
#pragma unroll
        for (int i = 0; i < 2; ++i) {
            const unsigned og = (unsigned)(C[i] >> 4) * (unsigned)(T * 32) + (unsigned)(C[i] & 15) * 2u;
            const unsigned g0 = (unsigned)R[i] * 32u + og, g1 = (unsigned)(128 + R[i]) * 32u + og;
            const unsigned d0 = (unsigned)(R[i] * D + C[i]) * 2u, d1 = (unsigned)((128 + R[i]) * D + C[i]) * 2u;
            v[i] = u.kind ? d0 : g0; v[2 + i] = u.kind ? d1 : g1; }
    }
    __device__ __forceinline__ void b_offsets(const Unit& u, const int (&Rb)[2], const int (&C)[2], unsigned (&v)[4]) const {
        const int ldb = u.kind ? D : S5W;
#pragma unroll
        for (int i = 0; i < 2; ++i) { v[i] = (unsigned)(Rb[i] * ldb + C[i]) * 2u; v[2 + i] = (unsigned)((128 + Rb[i]) * ldb + C[i]) * 2u; }
    }
};
template <bool GATH> struct MoeOrder {
    static constexpr bool GATHER = GATH, HETERO = false;
    const char* A0; const char* B0; size_t sBe; int lda, ldb, G, c; volatile LAS unsigned* MISC; const LAS int* tokL;
    __device__ __forceinline__ bool next(int i, Unit& u) const {
        if (i >= (int)MISC[152]) return false;
        const int e = (int)MISC[136 + i], mtg = (int)MISC[96 + e] + (int)MISC[144 + i], L = i * G + c;
        u.pm = mtg; u.pn = L & 3; u.aux = i;
        u.A = GATH ? A0 : A0 + (size_t)mtg * 256 * lda * 2; u.B = B0 + (size_t)e * sBe + (size_t)u.pn * 256 * ldb * 2; return true;
    }
    __device__ __forceinline__ void a_offsets(const Unit& u, const int (&R)[2], const int (&C)[2], unsigned (&v)[4]) const {
#pragma unroll
        for (int i = 0; i < 2; ++i) {
            if constexpr (GATH) { v[i] = (unsigned)tokL[u.aux * 256 + R[i]] * (unsigned)(lda * 2) + (unsigned)C[i] * 2u; v[2 + i] = (unsigned)tokL[u.aux * 256 + 128 + R[i]] * (unsigned)(lda * 2) + (unsigned)C[i] * 2u; }
            else { v[i] = (unsigned)(R[i] * lda + C[i]) * 2u; v[2 + i] = (unsigned)((128 + R[i]) * lda + C[i]) * 2u; } }
    }
};

using pg8::cvt_pk_bf16;
template <int ACT> __device__ __forceinline__ float actf(float x) { if (ACT == 1) return gelu_t(x); if (ACT == 2) return fsigmoid(x); return x; }
__device__ __forceinline__ v4u pack8(const f32x4 a, const f32x4 b) { v4u w; w.x = cvt_pk_bf16(a[0], a[1]); w.y = cvt_pk_bf16(a[2], a[3]); w.z = cvt_pk_bf16(b[0], b[1]); w.w = cvt_pk_bf16(b[2], b[3]); return w; }

__device__ __forceinline__ void unpack_u8x8(const v2u w, float (&f)[8]) {
    const float k = 1.0f / 255.0f;
    f[0] = (float)(w.x & 0xffu) * k; f[1] = (float)((w.x >> 8) & 0xffu) * k; f[2] = (float)((w.x >> 16) & 0xffu) * k; f[3] = (float)(w.x >> 24) * k;
    f[4] = (float)(w.y & 0xffu) * k; f[5] = (float)((w.y >> 8) & 0xffu) * k; f[6] = (float)((w.y >> 16) & 0xffu) * k; f[7] = (float)(w.y >> 24) * k;
}
__device__ __forceinline__ unsigned nat_ya(int pm, int pnq, int w, int ai, int m, int bj, int lane) { return ((unsigned)(((pm * 4 + pnq) * 8 + w) * 16 + (ai * 8 + m * 2 + bj)) * 64u + (unsigned)lane) * 16u; }
__device__ __forceinline__ unsigned nat_ga(int pm, int pnq, int w, int ai, int m, int bj, int lane) { return ((unsigned)(((pm * 4 + pnq) * 8 + w) * 16 + (bj * 8 + ai * 4 + m)) * 64u + (unsigned)lane) * 8u; }
__device__ __forceinline__ unsigned nat_gb(int pm, int pnq, int w, int ai, int m, int lane) { return ((unsigned)(((pm * 4 + pnq) * 8 + w) * 8 + (ai * 4 + m)) * 64u + (unsigned)lane) * 16u; }
struct EpiInProj {
    static constexpr bool PERM = true, ACC_INIT = true, B16 = false, I8 = true;
    bf16 *AG, *XL, *GL, *GA, *GB; const float* HS; const float* WSC; LAS unsigned char* sl;
    __device__ __forceinline__ void init(i32x4 (&acc)[2][2][4][2], const Unit& u, int wr, int wc, int fr, int fq) const {
#pragma unroll
        for (int a = 0; a < 2; ++a)
#pragma unroll
            for (int b = 0; b < 2; ++b)
#pragma unroll
                for (int m = 0; m < 4; ++m)
#pragma unroll
                    for (int n = 0; n < 2; ++n) acc[a][b][m][n] = i32x4{};
        const int w = wr * 4 + wc, lane = fq * 16 + fr;
        const int pm = __builtin_amdgcn_readfirstlane(u.pm), pn = __builtin_amdgcn_readfirstlane(u.pn), par = __builtin_amdgcn_readfirstlane(u.aux);
        const float* src = w < 4 ? HS + pm * 256 + w * 64 : WSC + pn * 256 + (w - 4) * 64;
        __builtin_amdgcn_global_load_lds((const unsigned*)(src + lane), (LAS unsigned*)(sl + par * 2048 + w * 256), 4, 0, 0);
    }
    template <int MODE  > __device__ __forceinline__ void tile(const i32x4 (&acc)[2][2][4][2], const Unit& u, bf16* base, int colbase, bool s5, int wr, int wc, int fr, int fq) const {
        const LAS float* sb = (const LAS float*)(sl + __builtin_amdgcn_readfirstlane(u.aux) * 2048);
        f32x4 wsv[2][2];
#pragma unroll
        for (int bj = 0; bj < 2; ++bj)
#pragma unroll
            for (int n = 0; n < 2; ++n) wsv[bj][n] = *(const LAS f32x4*)(sb + 256 + bj * 128 + wc * 32 + 8 * fq + 4 * n);
#pragma unroll
        for (int ai = 0; ai < 2; ++ai)
#pragma unroll
            for (int m = 0; m < 4; ++m) { const int rl = ai * 128 + wr * 64 + m * 16 + fr, r = u.pm * 256 + rl; const float hs = sb[rl]; v2u gpair = {0u, 0u};
#pragma unroll
                for (int bj = 0; bj < 2; ++bj) { const int cl = colbase + bj * 128 + wc * 32 + 8 * fq;
                    f32x4 v0 = __builtin_convertvector(acc[ai][bj][m][0], f32x4) * (wsv[bj][0] * hs), v1 = __builtin_convertvector(acc[ai][bj][m][1], f32x4) * (wsv[bj][1] * hs);
                    if (MODE == 2) {
                        unsigned q[8];
#pragma unroll
                        for (int j = 0; j < 4; ++j) { q[j] = (unsigned)(fsigmoid(v0[j]) * 255.0f + 0.5f); q[4 + j] = (unsigned)(fsigmoid(v1[j]) * 255.0f + 0.5f); }
                        v2u w8; w8.x = q[0] | (q[1] << 8) | (q[2] << 16) | (q[3] << 24); w8.y = q[4] | (q[5] << 8) | (q[6] << 16) | (q[7] << 24);
                        if (s5) { if (bj == 0) gpair = w8; else __builtin_nontemporal_store((v4u){gpair.x, gpair.y, w8.x, w8.y}, (v4u*)((unsigned char*)base + nat_gb(u.pm, colbase >> 8, wr * 4 + wc, ai, m, fq * 16 + fr))); }
                        else __builtin_nontemporal_store(w8, (v2u*)((unsigned char*)base + nat_ga(u.pm, colbase >> 8, wr * 4 + wc, ai, m, bj, fq * 16 + fr)));
                    } else {
                        if (MODE == 1) {
#pragma unroll
                            for (int j = 0; j < 4; ++j) { v0[j] = gelu_t(v0[j]); v1[j] = gelu_t(v1[j]); } }
                        const v4u w = pack8(v0, v1);
                        const int g = cl >> 4, cp = cl & 15, b = r >> 12, l = r & 4095, n = b * S5NCH + (l >> 4), s = l & 15;
                        const size_t off = s5 ? ((size_t)(g * S5N + n) * S5K + S5Q + s * 16 + cp) : ((size_t)r * 1024 + cl);
                        __builtin_nontemporal_store(w, (v4u*)(base + off)); } }
                asm volatile("" ::: "memory"); }
    }
    __device__ __forceinline__ void operator()(const i32x4 (&acc)[2][2][4][2], const Unit& u, int wr, int wc, int fr, int fq) const {
        const int pn = u.pn, reg = pn < 2 ? 0 : ((pn - 2) >> 2) + 1;
        const int colbase = reg == 0 ? pn * 256 : ((pn - 2) & 3) * 256;
        if (reg < 2) tile<0>(acc, u, reg == 0 ? AG : XL, colbase, reg == 0, wr, wc, fr, fq);
        else if (reg == 2) tile<1>(acc, u, GL, colbase, false, wr, wc, fr, fq);
        else tile<2>(acc, u, reg == 3 ? GA : GB, colbase, reg == 4, wr, wc, fr, fq);
    }
};
struct EpiS5State {
    static constexpr bool PERM = false, ACC_INIT = false, B16 = false;
    float* SLOC;
    __device__ __forceinline__ void operator()(const f32x4 (&acc)[2][2][4][2], const Unit& u, int wr, int wc, int fr, int fq) const {
#pragma unroll
        for (int ai = 0; ai < 2; ++ai)
#pragma unroll
            for (int m = 0; m < 4; ++m) { const int nr = u.pm * 256 + ai * 128 + wr * 64 + m * 16 + fr; float* rowp = SLOC + (size_t)(u.aux * S5N + nr) * S5Q + wc * 32 + 4 * fq;
#pragma unroll
                for (int n = 0; n < 2; ++n) *(f32x4*)(rowp + n * 16) = acc[ai][0][m][n]; }
    }
};
struct EpiS5Out {
    static constexpr bool PERM = true, ACC_INIT = false, B16 = false;
    bf16* GY;
    __device__ __forceinline__ void operator()(const f32x4 (&acc)[2][2][4][2], const Unit& u, int wr, int wc, int fr, int fq) const {
#pragma unroll
        for (int ai = 0; ai < 2; ++ai)
#pragma unroll
            for (int m = 0; m < 4; ++m) { const int nr = u.pm * 256 + ai * 128 + wr * 64 + m * 16 + fr, b = nr >> 8, j16 = nr & 255;
#pragma unroll
                for (int bj = 0; bj < 2; ++bj) { const int cc = bj * 128 + wc * 32 + 8 * fq, t = cc >> 4, c0 = cc & 15;
                    f32x4 v0 = acc[ai][bj][m][0], v1 = acc[ai][bj][m][1];
#pragma unroll
                    for (int j = 0; j < 4; ++j) { v0[j] = gelu_t(v0[j]); v1[j] = gelu_t(v1[j]); }
                    *(v4u*)(GY + ((size_t)u.aux * T + (size_t)(b * SEQ + j16 * 16 + t)) * 16 + c0) = pack8(v0, v1); }
                asm volatile("" ::: "memory"); }
    }
};
struct EpiYa {
    static constexpr bool PERM = true, ACC_INIT = false, B16 = false;
    const bf16* GA; bf16* YA;
    __device__ __forceinline__ void operator()(const f32x4 (&acc)[2][2][4][2], const Unit& u, int wr, int wc, int fr, int fq) const {
        const int pnq = u.pn >> 1, r = u.pn & 1, w = wr * 4 + wc, lane = fq * 16 + fr;
        v2u gav[2][4];
#pragma unroll
        for (int ai = 0; ai < 2; ++ai)
#pragma unroll
            for (int m = 0; m < 4; ++m) gav[ai][m] = __builtin_nontemporal_load((const v2u*)((const unsigned char*)GA + nat_ga(u.pm, pnq, w, ai, m, r, lane)));
        asm volatile("" ::: "memory");
#pragma unroll
        for (int ai = 0; ai < 2; ++ai)
#pragma unroll
            for (int m = 0; m < 4; ++m) { float gaf[8]; unpack_u8x8(gav[ai][m], gaf);
                f32x4 o0, o1;
#pragma unroll
                for (int j = 0; j < 4; ++j) { o0[j] = gaf[j] * acc[ai][0][m][0][j] * fsigmoid(acc[ai][1][m][0][j]); o1[j] = gaf[4 + j] * acc[ai][0][m][1][j] * fsigmoid(acc[ai][1][m][1][j]); }
                *(v4u*)((unsigned char*)YA + nat_ya(u.pm, pnq, w, ai, m, r, lane)) = pack8(o0, o1); }
    }
};
struct EpiYb {
    static constexpr bool PERM = true, ACC_INIT = false, B16 = false;
    const bf16* YA; const bf16* GB; bf16* MIX;
    __device__ __forceinline__ void operator()(const f32x4 (&acc)[2][2][4][2], const Unit& u, int wr, int wc, int fr, int fq) const {
        const size_t off0 = (size_t)(u.pm * 256 + wr * 64 + fr) * 1024 + u.pn * 256 + wc * 32 + 8 * fq;
        const int w = wr * 4 + wc, lane = fq * 16 + fr;
        v4u gb[2][2];
        v4u ya[2][2][2];
#define YB_LOAD(buf, grp) do { _Pragma("unroll") for (int mm = 0; mm < 2; ++mm) { gb[buf][mm] = __builtin_nontemporal_load((const v4u*)((const unsigned char*)GB + nat_gb(u.pm, u.pn, w, (grp) >> 1, 2 * ((grp) & 1) + mm, lane))); _Pragma("unroll") for (int bj = 0; bj < 2; ++bj) { \
            ya[buf][mm][bj] = *(const v4u*)((const unsigned char*)YA + nat_ya(u.pm, u.pn, w, (grp) >> 1, 2 * ((grp) & 1) + mm, bj, lane)); } } } while (0)
        YB_LOAD(0, 0);
#pragma unroll
        for (int grp = 0; grp < 4; ++grp) { const int buf = grp & 1, ai = grp >> 1;
            if (grp < 3) YB_LOAD(buf ^ 1, grp + 1);
            asm volatile("" ::: "memory");
#pragma unroll
            for (int mm = 0; mm < 2; ++mm) { const int m = 2 * (grp & 1) + mm;
#pragma unroll
                for (int bj = 0; bj < 2; ++bj) { const v4u y = ya[buf][mm][bj];
                    const float yaf[8] = {bflo(y.x), bfhi(y.x), bflo(y.y), bfhi(y.y), bflo(y.z), bfhi(y.z), bflo(y.w), bfhi(y.w)};
                    float gbf[8]; unpack_u8x8(bj ? (v2u){gb[buf][mm].z, gb[buf][mm].w} : (v2u){gb[buf][mm].x, gb[buf][mm].y}, gbf);
                    f32x4 o0, o1;
#pragma unroll
                    for (int j = 0; j < 4; ++j) { o0[j] = yaf[j] + gbf[j] * acc[ai][bj][m][0][j]; o1[j] = yaf[4 + j] + gbf[4 + j] * acc[ai][bj][m][1][j]; }
                    *(v4u*)(MIX + off0 + (size_t)(ai * 128 + m * 16) * 1024 + bj * 128) = pack8(o0, o1); } }
        }
#undef YB_LOAD
    }
};
struct EpiYaYb {
    static constexpr bool PERM = true, ACC_INIT = false, B16 = false;
    EpiYa a; EpiYb b;
    __device__ __forceinline__ void operator()(const f32x4 (&acc)[2][2][4][2], const Unit& u, int wr, int wc, int fr, int fq) const {
        if (__builtin_amdgcn_readfirstlane(u.kind) == 0) a(acc, u, wr, wc, fr, fq); else b(acc, u, wr, wc, fr, fq);
    }
};
struct EpiWo {
    static constexpr bool PERM = false, ACC_INIT = true, B16 = false;
    const float* X; float* O;
    __device__ __forceinline__ void init(f32x4 (&acc)[2][2][4][2], const Unit& u, int wr, int wc, int fr, int fq) const {
        const size_t off0 = (size_t)(u.pm * 256 + wr * 64 + fr) * 1024 + u.pn * 256 + wc * 32 + 4 * fq;
#pragma unroll
        for (int ai = 0; ai < 2; ++ai)
#pragma unroll
            for (int m = 0; m < 4; ++m)
#pragma unroll
                for (int bj = 0; bj < 2; ++bj)
#pragma unroll
                    for (int n = 0; n < 2; ++n) acc[ai][bj][m][n] = __builtin_nontemporal_load((const f32x4*)(X + off0 + (size_t)(ai * 128 + m * 16) * 1024 + bj * 128 + n * 16));
    }
    __device__ __forceinline__ void operator()(const f32x4 (&acc)[2][2][4][2], const Unit& u, int wr, int wc, int fr, int fq) const {
        const size_t off0 = (size_t)(u.pm * 256 + wr * 64 + fr) * 1024 + u.pn * 256 + wc * 32 + 4 * fq;
#pragma unroll
        for (int ai = 0; ai < 2; ++ai)
#pragma unroll
            for (int m = 0; m < 4; ++m)
#pragma unroll
                for (int bj = 0; bj < 2; ++bj)
#pragma unroll
                    for (int n = 0; n < 2; ++n) *(f32x4*)(O + off0 + (size_t)(ai * 128 + m * 16) * 1024 + bj * 128 + n * 16) = acc[ai][bj][m][n];
    }
};
struct EpiGU {
    static constexpr bool PERM = true, ACC_INIT = false, B16 = false, F8 = true;
    unsigned char* ACT; const LAS float* sclL;
    __device__ __forceinline__ void operator()(const f32x4 (&acc)[2][2][4][2], const Unit& u, int wr, int wc, int fr, int fq) const {
#pragma unroll
        for (int ai = 0; ai < 2; ++ai)
#pragma unroll
            for (int m = 0; m < 4; ++m) { const int rl = ai * 128 + wr * 64 + m * 16 + fr; const float sc = sclL[u.aux * 256 + rl] * (1.0f / 32.0f);
                f32x4 o0, o1;
#pragma unroll
                for (int j = 0; j < 4; ++j) { const float g0 = acc[ai][0][m][0][j] * sc, g1 = acc[ai][0][m][1][j] * sc;
                    o0[j] = g0 * fsigmoid(g0) * (acc[ai][1][m][0][j] * sc); o1[j] = g1 * fsigmoid(g1) * (acc[ai][1][m][1][j] * sc); }
                v2u a8; a8.x = pk_fp8x4(o0[0], o0[1], o0[2], o0[3]); a8.y = pk_fp8x4(o1[0], o1[1], o1[2], o1[3]);
                *(v2u*)(ACT + (size_t)(u.pm * 256 + rl) * DEXP + u.pn * 128 + wc * 32 + 8 * fq) = a8; }
    }
};
struct EpiDown {
    static constexpr bool PERM = true, ACC_INIT = false, B16 = false;
    bf16* YS; const LAS float* sclL;
    __device__ __forceinline__ void operator()(const f32x4 (&acc)[2][2][4][2], const Unit& u, int wr, int wc, int fr, int fq) const {
#pragma unroll
        for (int ai = 0; ai < 2; ++ai)
#pragma unroll
            for (int m = 0; m < 4; ++m) { const int rl = ai * 128 + wr * 64 + m * 16 + fr; const float sc = sclL[u.aux * 256 + rl];
#pragma unroll
                for (int bj = 0; bj < 2; ++bj)
                    *(v4u*)(YS + (size_t)(u.pm * 256 + rl) * 1024 + u.pn * 256 + bj * 128 + wc * 32 + 8 * fq) = pack8(acc[ai][bj][m][0] * sc, acc[ai][bj][m][1] * sc); }
    }
};

template <bool SCALED> struct EpiQ8 {
    static constexpr bool PERM = true, ACC_INIT = false, B16 = true, F8 = SCALED;
    unsigned char* YS8; float* YSC; const LAS float* sclL;
    __device__ __forceinline__ void operator()(const f32x4 (&acc)[2][2][4][2], const Unit& u, int wr, int wc, int fr, int fq) const {
        float scs[2][4];
#pragma unroll
        for (int ai = 0; ai < 2; ++ai)
#pragma unroll
            for (int m = 0; m < 4; ++m) { const int rl = ai * 128 + wr * 64 + m * 16 + fr; const float sc = SCALED ? sclL[u.aux * 256 + rl] * (1.0f / 32.0f) : 1.0f;
                float v[16]; float amax = 0.f;
#pragma unroll
                for (int bj = 0; bj < 2; ++bj)
#pragma unroll
                    for (int n = 0; n < 2; ++n)
#pragma unroll
                        for (int j = 0; j < 4; ++j) { const float x = acc[ai][bj][m][n][j] * sc; v[bj * 8 + n * 4 + j] = x; amax = fmaxf(amax, fabsf(x)); }
                amax = fmaxf(amax, __shfl_xor(amax, 16)); amax = fmaxf(amax, __shfl_xor(amax, 32));
                const float inv = amax > 0.f ? 127.0f / amax : 0.f;
                scs[ai][m] = amax * (1.0f / 127.0f);
                v4u w;
#pragma unroll
                for (int d = 0; d < 4; ++d) { const int q0 = (int)__builtin_rintf(v[4 * d] * inv), q1 = (int)__builtin_rintf(v[4 * d + 1] * inv), q2 = (int)__builtin_rintf(v[4 * d + 2] * inv), q3 = (int)__builtin_rintf(v[4 * d + 3] * inv);
                    w[d] = ((unsigned)q0 & 255u) | (((unsigned)q1 & 255u) << 8) | (((unsigned)q2 & 255u) << 16) | ((unsigned)q3 << 24); }
                *(v4u*)(YS8 + (size_t)(u.pm * 256 + rl) * 1024 + u.pn * 256 + wc * 64 + fq * 16) = w; }
#pragma unroll
        for (int ai = 0; ai < 2; ++ai) { const float sv = fq == 0 ? scs[ai][0] : fq == 1 ? scs[ai][1] : fq == 2 ? scs[ai][2] : scs[ai][3];
            YSC[(size_t)(u.pm * 256 + ai * 128 + wr * 64 + fq * 16 + fr) * 16 + wc * 4 + u.pn] = sv; }
    }
};

struct TItem { const float* W; int N; bf16* WT; int ldk, k0, n0, drow0; };
__device__ __forceinline__ void transpose_load(const TItem& it, f32x4 (&tv)[8], int lane) {
#pragma unroll
    for (int i = 0; i < 8; ++i) tv[i] = __builtin_nontemporal_load((const f32x4*)(it.W + (size_t)(it.k0 + 8 * i + (lane >> 3)) * it.N + it.n0 + 4 * (lane & 7)));
}
template <bool NT = false> __device__ __forceinline__ void transpose_store(const TItem& it, const f32x4 (&tv)[8], LAS float* scr, int lane) {
#pragma unroll
    for (int i = 0; i < 8; ++i) { LAS float* d = scr + (8 * i + (lane >> 3)) * 33 + 4 * (lane & 7); d[0] = tv[i].x; d[1] = tv[i].y; d[2] = tv[i].z; d[3] = tv[i].w; }
    LDS_WAIT(); asm volatile("" ::: "memory");
    const int c = lane & 7;
#pragma unroll
    for (int j = 0; j < 4; ++j) { const int n = (lane >> 3) + 8 * j; const LAS float* s = scr + (8 * c) * 33 + n;
        v4u o; o.x = pk2(s[0 * 33], s[1 * 33]); o.y = pk2(s[2 * 33], s[3 * 33]); o.z = pk2(s[4 * 33], s[5 * 33]); o.w = pk2(s[6 * 33], s[7 * 33]);
        if (NT) __builtin_nontemporal_store(o, (v4u*)(it.WT + (size_t)(it.drow0 + n) * it.ldk + it.k0 + 8 * c)); else *(v4u*)(it.WT + (size_t)(it.drow0 + n) * it.ldk + it.k0 + 8 * c) = o; }
    LDS_WAIT(); asm volatile("" ::: "memory");
}
__device__ __forceinline__ void transpose_store_fp8(const TItem& it, const f32x4 (&tv)[8], LAS float* scr, int lane) {
#pragma unroll
    for (int i = 0; i < 8; ++i) { LAS float* d = scr + (8 * i + (lane >> 3)) * 33 + 4 * (lane & 7); d[0] = tv[i].x; d[1] = tv[i].y; d[2] = tv[i].z; d[3] = tv[i].w; }
    LDS_WAIT(); asm volatile("" ::: "memory");
    const int c = lane & 7;
#pragma unroll
    for (int j = 0; j < 4; ++j) { const int n = (lane >> 3) + 8 * j; const LAS float* s = scr + (8 * c) * 33 + n;
        v2u o; o.x = pk_fp8x4(s[0 * 33] * 32.f, s[1 * 33] * 32.f, s[2 * 33] * 32.f, s[3 * 33] * 32.f); o.y = pk_fp8x4(s[4 * 33] * 32.f, s[5 * 33] * 32.f, s[6 * 33] * 32.f, s[7 * 33] * 32.f);
        __builtin_nontemporal_store(o, (v2u*)((unsigned char*)it.WT + (size_t)(it.drow0 + n) * it.ldk + it.k0 + 8 * c)); }
    LDS_WAIT(); asm volatile("" ::: "memory");
}
__device__ __forceinline__ int ileave_row(int n, int half) { return 256 * (n >> 7) + 128 * half + (n & 127); }

template <int NR> __device__ __forceinline__ void rms_rows_to_bf16(const float* x0, const float* gain, bf16* o0, size_t rstride, int lane) {
    f32x4 v[NR][4];
#pragma unroll
    for (int r = 0; r < NR; ++r) { const f32x4* xr = (const f32x4*)(x0 + r * rstride) + lane;
#pragma unroll
        for (int j = 0; j < 4; ++j) v[r][j] = __builtin_nontemporal_load(xr + 64 * j); }
    asm volatile("" ::: "memory");
    const f32x4* gr = (const f32x4*)gain + lane;
    f32x4 g[4];
#pragma unroll
    for (int j = 0; j < 4; ++j) g[j] = gr[64 * j];
#pragma unroll
    for (int r = 0; r < NR; ++r) { float s = 0.f;
#pragma unroll
        for (int j = 0; j < 4; ++j) s += (v[r][j].x * v[r][j].x + v[r][j].y * v[r][j].y) + (v[r][j].z * v[r][j].z + v[r][j].w * v[r][j].w);
        const float rstd = 1.0f / sqrtf(wave_sum(s) * (1.f / D) + RMS_EPS);
        unsigned long long* o8 = (unsigned long long*)(o0 + r * rstride) + lane;
#pragma unroll
        for (int j = 0; j < 4; ++j) o8[64 * j] = (unsigned long long)pk2(v[r][j].x * rstd * g[j].x, v[r][j].y * rstd * g[j].y) | ((unsigned long long)pk2(v[r][j].z * rstd * g[j].z, v[r][j].w * rstd * g[j].w) << 32); }
}

__device__ __forceinline__ float wave_max(float v) {
#pragma unroll
    for (int o = 1; o < 64; o <<= 1) v = fmaxf(v, __shfl_xor(v, o));
    return v;
}
__device__ __forceinline__ unsigned pk_i8(float a, float b, float c, float d) {
    const int q0 = (int)__builtin_rintf(a), q1 = (int)__builtin_rintf(b), q2 = (int)__builtin_rintf(c), q3 = (int)__builtin_rintf(d);
    return ((unsigned)q0 & 255u) | (((unsigned)q1 & 255u) << 8) | (((unsigned)q2 & 255u) << 16) | ((unsigned)q3 << 24);
}
template <int NR> __device__ __forceinline__ void rms_rows_to_i8(const float* x0, const float* gain, unsigned char* o0, float* hs, int lane) {
    f32x4 v[NR][4];
#pragma unroll
    for (int r = 0; r < NR; ++r) { const f32x4* xr = (const f32x4*)(x0 + (size_t)r * D) + lane;
#pragma unroll
        for (int j = 0; j < 4; ++j) v[r][j] = __builtin_nontemporal_load(xr + 64 * j); }
    asm volatile("" ::: "memory");
    const f32x4* gr = (const f32x4*)gain + lane;
    f32x4 g[4];
#pragma unroll
    for (int j = 0; j < 4; ++j) g[j] = gr[64 * j];
#pragma unroll
    for (int r = 0; r < NR; ++r) { float s = 0.f;
#pragma unroll
        for (int j = 0; j < 4; ++j) s += (v[r][j].x * v[r][j].x + v[r][j].y * v[r][j].y) + (v[r][j].z * v[r][j].z + v[r][j].w * v[r][j].w);
        const float rstd = 1.0f / sqrtf(wave_sum(s) * (1.f / D) + RMS_EPS);
        float am = 0.f;
#pragma unroll
        for (int j = 0; j < 4; ++j) { v[r][j] = v[r][j] * rstd * g[j]; am = fmaxf(fmaxf(am, fmaxf(fabsf(v[r][j].x), fabsf(v[r][j].y))), fmaxf(fabsf(v[r][j].z), fabsf(v[r][j].w))); }
        am = fmaxf(wave_max(am), 1e-20f);
        const float inv = 127.0f / am;
        unsigned* o = (unsigned*)(o0 + (size_t)r * D) + lane;
#pragma unroll
        for (int j = 0; j < 4; ++j) o[64 * j] = pk_i8(v[r][j].x * inv, v[r][j].y * inv, v[r][j].z * inv, v[r][j].w * inv);
        if (lane == 0) hs[r] = am * (1.0f / 127.0f); }
}
__device__ __forceinline__ void win_to_i8(const Frame& F, const float* W, int nb) {
    const int lane = F.lane, w = F.wave, n0 = 32 * nb;
    f32x4 tv[2][8];
#pragma unroll
    for (int s2 = 0; s2 < 2; ++s2)
#pragma unroll
        for (int i = 0; i < 8; ++i) tv[s2][i] = __builtin_nontemporal_load((const f32x4*)(W + (size_t)(128 * w + 64 * s2 + 8 * i + (lane >> 3)) * NIN + n0 + 4 * (lane & 7)));
    asm volatile("" ::: "memory");
    f32x4 am = {0.f, 0.f, 0.f, 0.f};
#pragma unroll
    for (int s2 = 0; s2 < 2; ++s2)
#pragma unroll
        for (int i = 0; i < 8; ++i)
#pragma unroll
            for (int c = 0; c < 4; ++c) am[c] = fmaxf(am[c], fabsf(tv[s2][i][c]));
#pragma unroll
    for (int c = 0; c < 4; ++c) { am[c] = fmaxf(am[c], __shfl_xor(am[c], 8)); am[c] = fmaxf(am[c], __shfl_xor(am[c], 16)); am[c] = fmaxf(am[c], __shfl_xor(am[c], 32)); }
    LAS float* cm = (LAS float*)(F.lds + TOKL_OFF);
    if (lane < 8) *(LAS f32x4*)(cm + w * 32 + 4 * lane) = am;
    __syncthreads();
    f32x4 tot = *(const LAS f32x4*)(cm + 4 * (lane & 7));
#pragma unroll
    for (int ww = 1; ww < 8; ++ww) { const f32x4 o = *(const LAS f32x4*)(cm + ww * 32 + 4 * (lane & 7));
#pragma unroll
        for (int c = 0; c < 4; ++c) tot[c] = fmaxf(tot[c], o[c]); }
    f32x4 inv;
#pragma unroll
    for (int c = 0; c < 4; ++c) { tot[c] = fmaxf(tot[c], 1e-20f); inv[c] = 127.0f / tot[c]; }
    if (w == 0 && lane < 8) *(f32x4*)((float*)(F.ws + SM_WSC) + n0 + 4 * lane) = tot * (1.0f / 127.0f);
    LAS int* scr = (LAS int*)(F.lds + w * 16384);
    unsigned char* wt = F.ws + WS_WIN;
#pragma unroll
    for (int s2 = 0; s2 < 2; ++s2) {
#pragma unroll
        for (int i = 0; i < 8; ++i) { LAS int* d = scr + (8 * i + (lane >> 3)) * 33 + 4 * (lane & 7);
#pragma unroll
            for (int c = 0; c < 4; ++c) d[c] = (int)__builtin_rintf(tv[s2][i][c] * inv[c]); }
        LDS_WAIT(); asm volatile("" ::: "memory");
        const int n = lane & 31, kh = lane >> 5; const LAS int* sp = scr + (32 * kh) * 33 + n;
        v4u o[2];
#pragma unroll
        for (int d = 0; d < 8; ++d) o[d >> 2][d & 3] = ((unsigned)sp[(4 * d) * 33] & 255u) | (((unsigned)sp[(4 * d + 1) * 33] & 255u) << 8) | (((unsigned)sp[(4 * d + 2) * 33] & 255u) << 16) | ((unsigned)sp[(4 * d + 3) * 33] << 24);
        v4u* dst = (v4u*)(wt + (size_t)(n0 + n) * D + 128 * w + 64 * s2 + 32 * kh);
        dst[0] = o[0]; dst[1] = o[1];
        LDS_WAIT(); asm volatile("" ::: "memory");
    }
    __syncthreads();
}

__device__ __forceinline__ void s5_tables(const Frame& F, int g, const float* lam_re, const float* lam_im, const float* log_dt, const float* b_re, const float* b_im, const float* c_re, const float* c_im, const float* dsk) {
    LAS float* Cre = (LAS float*)F.lds;
    LAS float* Cim = Cre + 1024;
    LAS float* Bre = Cim + 1024;
    LAS float* Bim = Bre + 1024;
    LAS float* Pre = Bim + 1024;
    LAS float* Pim = Pre + 17 * 64;
    LAS float* Kt = Pim + 17 * 64;
    const int tid = F.tid;
    for (int i = tid; i < 1024; i += 512) { Cre[i] = c_re[g * 1024 + i]; Cim[i] = c_im[g * 1024 + i]; }
    if (tid < 64) {
        const int p = tid; const float lr = lam_re[g * 64 + p], li = lam_im[g * 64 + p], dt = expf(log_dt[g]);
        const float er = expf(lr * dt), lbr = er * cosf(li * dt), lbi = er * sinf(li * dt);
        const float den = lr * lr + li * li, nr = lbr - 1.0f, ni = lbi;
        const float cr = (nr * lr + ni * li) / den, ci = (ni * lr - nr * li) / den;
        { float pr = 1.f, pi = 0.f; for (int k = 0; k <= 16; ++k) { Pre[k * 64 + p] = pr; Pim[k * 64 + p] = pi; const float nr2 = pr * lbr - pi * lbi, ni2 = pr * lbi + pi * lbr; pr = nr2; pi = ni2; } }
        for (int c = 0; c < 16; ++c) { const float br = b_re[(g * 64 + p) * 16 + c], bi = b_im[(g * 64 + p) * 16 + c]; Bre[p * 16 + c] = cr * br - ci * bi; Bim[p * 16 + c] = cr * bi + ci * br; }
    }
    __syncthreads();
    {
        const int kc = tid & 255, k = kc >> 4, c = kc & 15, ph = tid >> 8; float a16[16];
#pragma unroll
        for (int i = 0; i < 16; ++i) a16[i] = 0.f;
        for (int p = 32 * ph; p < 32 * ph + 32; ++p) {
            const float cr_ = Cre[c * 64 + p], ci_ = Cim[c * 64 + p], pr_ = Pre[k * 64 + p], pi_ = Pim[k * 64 + p];
            const float xr = cr_ * pr_ - ci_ * pi_, xi = cr_ * pi_ + ci_ * pr_;
#pragma unroll
            for (int j = 0; j < 4; ++j) { const f32x4 br = *(const LAS f32x4*)(Bre + p * 16 + 4 * j), bi = *(const LAS f32x4*)(Bim + p * 16 + 4 * j);
#pragma unroll
                for (int i = 0; i < 4; ++i) a16[4 * j + i] += xr * br[i] - xi * bi[i]; }
        }
        LAS float* Kh = Kt + 4096;
        if (ph == 1) {
#pragma unroll
            for (int j = 0; j < 4; ++j) *(LAS f32x4*)(Kh + kc * 16 + 4 * j) = (f32x4){a16[4 * j], a16[4 * j + 1], a16[4 * j + 2], a16[4 * j + 3]}; }
        __syncthreads();
        if (ph == 0) {
#pragma unroll
            for (int j = 0; j < 4; ++j) { const f32x4 o = *(const LAS f32x4*)(Kh + kc * 16 + 4 * j); f32x4 r = (f32x4){a16[4 * j], a16[4 * j + 1], a16[4 * j + 2], a16[4 * j + 3]} + o;
                if (k == 0 && (c >> 2) == j) r[c & 3] += dsk[g * 16 + c];
                *(LAS f32x4*)(Kt + kc * 16 + 4 * j) = r; } }
    }
    __syncthreads();
    unsigned* btt = (unsigned*)(F.ws + WS_BTT) + (size_t)g * 256 * (S5K / 2);
    for (int e = tid; e < 256 * (S5K / 2); e += 512) {
        const int row = e / (S5K / 2), cpair = e % (S5K / 2), t = row >> 4, c = row & 15, col = 2 * cpair; float v0, v1;
        if (col < S5Q) { const int p = col >> 1; const float xr = Cre[c * 64 + p] * Pre[(t + 1) * 64 + p] - Cim[c * 64 + p] * Pim[(t + 1) * 64 + p], xi = Cre[c * 64 + p] * Pim[(t + 1) * 64 + p] + Cim[c * 64 + p] * Pre[(t + 1) * 64 + p];
            v0 = xr; v1 = -xi; }
        else { const int s = (col - S5Q) >> 4, cp = (col - S5Q) & 15;
            if (s <= t) { v0 = Kt[(t - s) * 256 + c * 16 + cp]; v1 = Kt[(t - s) * 256 + c * 16 + cp + 1]; } else { v0 = 0.f; v1 = 0.f; } }
        btt[e] = pk2(v0, v1);
    }
    unsigned* btw = (unsigned*)(F.ws + WS_BTW) + (size_t)g * 128 * 128;
    for (int e = tid; e < 128 * 128; e += 512) {
        const int q = e >> 7, cpair = e & 127, col = 2 * cpair, s = col >> 4, cp = col & 15, p = q >> 1, k = 15 - s;
        const float pr = Pre[k * 64 + p], pi = Pim[k * 64 + p];
        float v0, v1;
        if (q & 1) { v0 = pr * Bim[p * 16 + cp] + pi * Bre[p * 16 + cp]; v1 = pr * Bim[p * 16 + cp + 1] + pi * Bre[p * 16 + cp + 1]; }
        else { v0 = pr * Bre[p * 16 + cp] - pi * Bim[p * 16 + cp]; v1 = pr * Bre[p * 16 + cp + 1] - pi * Bim[p * 16 + cp + 1]; }
        btw[e] = pk2(v0, v1);
    }
    if (tid < 64) { float* l16 = (float*)(F.ws + SM_LAM16) + (g * 64 + tid) * 2; l16[0] = Pre[16 * 64 + tid]; l16[1] = Pim[16 * 64 + tid]; }
    __syncthreads();
}

struct In { const float* p[30]; };

__device__ __forceinline__ void p0_prologue(const Frame& F, const In& I) {
    for (int g = F.vcu; g < S5G; g += F.G) s5_tables(F, g, I.p[3], I.p[4], I.p[5], I.p[6], I.p[7], I.p[8], I.p[9], I.p[10]);
    const int gt = F.vcu * 512 + F.tid, NGT = F.G * 512;
    { float* lc = (float*)(F.ws + SM_LRUC); for (int i = gt; i < LRUW; i += NGT) { const float lam = I.p[18][i]; lc[i] = -8.0f * log1pf(expf(-lam)) * 1.44269504f; } }
    { bf16* wrt = (bf16*)(F.ws + SM_WRT);
        for (int i = gt; i < 2 * 65536; i += NGT) { const int which = i >> 16, r = i & 65535, h = r >> 12, j = (r >> 6) & 63, k = r & 63; const float* src = which ? I.p[16] : I.p[14]; wrt[i] = (bf16)f2bf(src[(h * 64 + k) * 64 + j]); } }
    { bf16* rhi = (bf16*)(F.ws + SM_RHI); bf16* rlo = (bf16*)(F.ws + SM_RLO);
        for (int i = gt; i < NROUT * 1024; i += NGT) { const int n = i >> 10, k = i & 1023; float w = 0.f; if (n < 4) w = I.p[22][k * 4 + n]; else if (n < 36) w = I.p[24][k * 32 + (n - 4)];
            const unsigned h = f2bf(w); rhi[i] = (bf16)h; rlo[i] = (bf16)f2bf(w - bf2f(h)); } }
    { const int skip = F.G > 2 * S5G ? S5G : 0;
      if (F.vcu >= skip) {
        for (int nb = F.vcu - skip; nb < NIN / 32; nb += F.G - skip) win_to_i8(F, I.p[2], nb);
        const int gw2 = (F.vcu - skip) * NWAVES + F.wave, NGW2 = (F.G - skip) * NWAVES;
        for (int m = gw2 * 4; m < T; m += NGW2 * 4) rms_rows_to_i8<4>(I.p[0] + (size_t)m * D, I.p[1], F.ws + WS_H + (size_t)m * D, (float*)(F.ws + SM_HSC) + m, F.lane); } }
}
__device__ __forceinline__ void late_weight_copies(const Frame& F, const In& I, int gw, int NGW) {
    LAS float* scr = (LAS float*)(F.lds + F.wave * 16384);
    constexpr int I_S5 = (S5W / 64) * (2 * D / 32), I_LRU = (D / 64) * (D / 32), I_O = I_LRU;
    constexpr int NITEMS = I_S5 + I_LRU + I_O;
    for (int it = gw; it < NITEMS; it += NGW) {
        int r = it; TItem ti;
        if (r < I_S5) { const int nb = 2 * D / 32, kb = r / nb, n0 = 32 * (r % nb); ti = TItem{I.p[11], 2 * D, (bf16*)(F.ws + WS_WS5), S5W, 64 * kb, n0, n0 < D ? ileave_row(n0, 0) : ileave_row(n0 - D, 1)}; }
        else if ((r -= I_S5) < I_LRU) { const int nb = D / 32, kb = r / nb, n0 = 32 * (r % nb); ti = TItem{I.p[19], D, (bf16*)(F.ws + WS_WLRU), D, 64 * kb, n0, n0}; }
        else { r -= I_LRU; const int nb = D / 32, kb = r / nb, n0 = 32 * (r % nb); ti = TItem{I.p[20], D, (bf16*)(F.ws + WS_WO), D, 64 * kb, n0, n0}; }
        f32x4 tv[8]; transpose_load(ti, tv, F.lane); asm volatile("" ::: "memory"); transpose_store(ti, tv, scr, F.lane);
    }
    __syncthreads();
}
__device__ __forceinline__ TItem expert_item(const Frame& F, const In& I, int it) {
    const int e = it >> 9, half = (it >> 8) & 1, r = it & 255, nb = DEXP / 32, kb = r / nb, n0 = 32 * (r % nb);
    return TItem{(half ? I.p[27] : I.p[26]) + (size_t)e * D * DEXP, DEXP, (bf16*)(F.ws + WS_WGU + (size_t)e * 1024 * 1024), D, 64 * kb, n0, ileave_row(n0, half)};
}
__device__ __forceinline__ TItem expert_item_d(const Frame& F, const In& I, int it) {
    const int e = it >> 8, r = it & 255, nb = D / 32, kb = r / nb, n0 = 32 * (r % nb);
    return TItem{I.p[28] + (size_t)e * DEXP * D, D, (bf16*)(F.ws + WS_WD + (size_t)e * 1024 * DEXP), DEXP, 64 * kb, n0, n0};
}
__device__ __forceinline__ void expert_weight_copies(const Frame& F, const In& I) {
    LAS float* scr = (LAS float*)(F.lds + F.wave * 16384);
    const int gw = F.vcu * NWAVES + F.wave, NGW = F.G * NWAVES;
    constexpr int NIT = NEXP * 512;
    for (int it = 8 * NGW + gw; it < NIT; it += NGW) { const TItem t0 = expert_item(F, I, it); f32x4 v0[8]; transpose_load(t0, v0, F.lane); asm volatile("" ::: "memory"); transpose_store_fp8(t0, v0, scr, F.lane); }
}
__device__ __forceinline__ void expert_down_copies(const Frame& F, const In& I) {
    LAS float* scr = (LAS float*)(F.lds + F.wave * 16384);
    const int nunits = (int)F.MISC[128] * 4, rem = nunits % F.G, nbusy = rem;
    const int nfree = F.G - nbusy;
    if (F.vcu < nbusy) return;
    const int gw = (F.vcu - nbusy) * NWAVES + F.wave, NGW = nfree * NWAVES;
    constexpr int NIT = NEXP * 256;
    for (int it = gw; it < NIT; it += 2 * NGW) {
        const TItem t0 = expert_item_d(F, I, it); const bool has1 = it + NGW < NIT; const TItem t1 = expert_item_d(F, I, has1 ? it + NGW : it);
        f32x4 v0[8], v1[8]; transpose_load(t0, v0, F.lane); transpose_load(t1, v1, F.lane); asm volatile("" ::: "memory");
        transpose_store_fp8(t0, v0, scr, F.lane); if (has1) transpose_store_fp8(t1, v1, scr, F.lane);
    }
}

__device__ __forceinline__ void lru_seq(const Frame& F, const In& I) {
    LAS unsigned char* wl = F.lds + F.wave * 17920;
    LAS bf16* xcA = (LAS bf16*)wl;
    LAS float* pre = (LAS float*)(wl + 9216);
    typedef float f32x2 __attribute__((ext_vector_type(2)));
    LAS f32x2* sumT = (LAS f32x2*)(F.lds + 143360);
    const int lane = F.lane, jj = lane & 15, ks = lane >> 4, c32 = lane & 31, th = lane >> 5;
    const bf16* XL = (const bf16*)(F.ws + WS_XL); const bf16* GL = (const bf16*)(F.ws + WS_GL); bf16* YL = (bf16*)(F.ws + WS_H);
    const bf16* WRT = (const bf16*)(F.ws + SM_WRT);
    for (int un = F.vcu; un < BATCH * LRUH * 2; un += F.G) {
        const int b = un >> 5, hd = (un >> 1) & 15, half = un & 1;
        const int chin = hd * 64 + lane;
        const int chg = hd * 64 + 32 * half + c32;
        const float w0 = I.p[12][chin], w1 = I.p[12][1024 + chin], w2 = I.p[12][2048 + chin], w3 = I.p[12][3072 + chin], cb = I.p[13][chin];
        const float brs = I.p[15][chg] * -1.44269504f, bis = I.p[17][chg] * -1.44269504f, cch2 = ((const float*)(F.ws + SM_LRUC))[chg];
        float Rc = 0.f;
        for (int rd = 0; rd < 8; ++rd) {
            const int j = rd * 8 + F.wave;
            const size_t tok0 = (size_t)b * SEQ + (size_t)j * LRUCH;
            unsigned short xr[64], xh[3];
            { const bf16* xp = XL + tok0 * 1024 + chin;
              xh[0] = 0; xh[1] = 0; xh[2] = 0;
              if (j > 0) { xh[0] = xp[-3 * 1024]; xh[1] = xp[-2 * 1024]; xh[2] = xp[-1 * 1024]; }
#pragma unroll
              for (int t = 0; t < 64; ++t) xr[t] = xp[t * 1024]; }
            asm volatile("" ::: "memory");
            { typedef float f2v __attribute__((ext_vector_type(2)));
              float xm3 = bf2f(xh[0]), xm2 = bf2f(xh[1]), xm1 = bf2f(xh[2]);
              const f2v vw0 = {w0, w0}, vw1 = {w1, w1}, vw2 = {w2, w2}, vw3 = {w3, w3}, vcb = {cb, cb};
#pragma unroll
              for (int t = 0; t < 64; t += 2) { const float x0 = bf2f(xr[t]), x1 = bf2f(xr[t + 1]);
                  f2v xc = vcb + vw0 * (f2v){xm3, xm2}; xc = xc + vw1 * (f2v){xm2, xm1}; xc = xc + vw2 * (f2v){xm1, x0}; xc = xc + vw3 * (f2v){x0, x1};
                  const unsigned pk = pg8::cvt_pk_bf16(xc.x, xc.y);
                  xcA[t * 72 + lane] = (bf16)(pk & 0xffffu); xcA[(t + 1) * 72 + lane] = (bf16)(pk >> 16);
                  xm3 = xm1; xm2 = x0; xm1 = x1; } }
            LDS_WAIT();
            float hl[2][16], Pl[2][16], Prun[2], Hrun[2];
#pragma unroll
            for (int st = 0; st < 2; ++st) {
                bf16x8 Bw[4][2];
#pragma unroll
                for (int n = 0; n < 4; ++n)
#pragma unroll
                    for (int k = 0; k < 2; ++k) Bw[n][k] = *(const bf16x8*)(WRT + (size_t)(n >> 1) * 65536 + (size_t)(hd * 64 + 32 * half + 16 * (n & 1) + jj) * 64 + 32 * k + 8 * ks);
#pragma unroll
                for (int mh = 0; mh < 2; ++mh) { const int mt = 2 * st + mh;
                    bf16x8 a[2];
#pragma unroll
                    for (int k = 0; k < 2; ++k) a[k] = *(const LAS bf16x8*)(xcA + (16 * mt + jj) * 72 + 32 * k + 8 * ks);
#pragma unroll
                    for (int n = 0; n < 4; ++n) { f32x4 d = (f32x4){0.f, 0.f, 0.f, 0.f};
#pragma unroll
                        for (int k = 0; k < 2; ++k) d = __builtin_amdgcn_mfma_f32_16x16x32_bf16(a[k], Bw[n][k], d, 0, 0, 0);
#pragma unroll
                        for (int r = 0; r < 4; ++r) pre[(16 * mh + 4 * ks + r) * 68 + 16 * n + jj] = d[r]; } }
                LDS_WAIT();
                float h = 0.f, P = 1.f;
                typedef float f2v __attribute__((ext_vector_type(2)));
#pragma unroll
                for (int tl = 0; tl < 16; tl += 2) {
                    const int trow = 16 * th + tl;
                    const f2v pr = {pre[trow * 68 + c32], pre[(trow + 1) * 68 + c32]}, pi = {pre[trow * 68 + 32 + c32], pre[(trow + 1) * 68 + 32 + c32]};
                    const f2v zr = pr * (f2v){-1.44269504f, -1.44269504f} + (f2v){brs, brs}, zi = pi * (f2v){-1.44269504f, -1.44269504f} + (f2v){bis, bis};
                    const f2v er = {__builtin_amdgcn_exp2f(zr.x), __builtin_amdgcn_exp2f(zr.y)}, ei = {__builtin_amdgcn_exp2f(zi.x), __builtin_amdgcn_exp2f(zi.y)};
                    const f2v dr = er + (f2v){1.f, 1.f};
                    const f2v rg = {__builtin_amdgcn_rcpf(dr.x), __builtin_amdgcn_rcpf(dr.y)};
                    const f2v la2 = rg * (f2v){cch2, cch2};
                    const f2v a_ = {__builtin_amdgcn_exp2f(la2.x), __builtin_amdgcn_exp2f(la2.y)};
                    const f2v x2 = la2 * (f2v){1.38629436f, 1.38629436f};
                    f2v q = x2 * (f2v){0.0013888889f, 0.0013888889f} + (f2v){0.0083333333f, 0.0083333333f};
                    q = q * x2 + (f2v){0.041666667f, 0.041666667f}; q = q * x2 + (f2v){0.16666667f, 0.16666667f}; q = q * x2 + (f2v){0.5f, 0.5f}; q = q * x2 + (f2v){1.f, 1.f};
                    f2v om = -(q * x2);
                    const f2v alt = (f2v){1.f, 1.f} - a_ * a_;
                    om.x = x2.x > -0.3f ? om.x : alt.x; om.y = x2.y > -0.3f ? om.y : alt.y;
                    om.x = fmaxf(om.x, 1e-30f); om.y = fmaxf(om.y, 1e-30f);
                    const f2v dd = ei + (f2v){1.f, 1.f};
                    const f2v rq = om * dd * dd;
                    const f2v mi = om * (f2v){__builtin_amdgcn_rsqf(rq.x), __builtin_amdgcn_rsqf(rq.y)};
                    const f2v bx = mi * (f2v){bf2f(xcA[(32 * st + trow) * 72 + 32 * half + c32]), bf2f(xcA[(32 * st + trow + 1) * 72 + 32 * half + c32])};
                    h = a_.x * h + bx.x; P *= a_.x; hl[st][tl] = h; Pl[st][tl] = P;
                    h = a_.y * h + bx.y; P *= a_.y; hl[st][tl + 1] = h; Pl[st][tl + 1] = P;
                }
                Prun[st] = P; Hrun[st] = h;
                LDS_WAIT();
            }
            const float pP0 = __shfl_xor(Prun[0], 32), pH0 = __shfl_xor(Hrun[0], 32), pP1 = __shfl_xor(Prun[1], 32), pH1 = __shfl_xor(Hrun[1], 32);
            const float P0 = th ? pP0 : Prun[0], H0 = th ? pH0 : Hrun[0], P1 = th ? Prun[0] : pP0, H1 = th ? Hrun[0] : pH0;
            const float P2 = th ? pP1 : Prun[1], H2 = th ? pH1 : Hrun[1], P3 = th ? Prun[1] : pP1, H3 = th ? Hrun[1] : pH1;
            const float C1 = H0, Q1 = P0, C2 = P1 * C1 + H1, Q2 = P1 * Q1, C3 = P2 * C2 + H2, Q3 = P2 * Q2, Hc = P3 * C3 + H3, Pc = P3 * Q3;
            const float Cs0 = th ? C1 : 0.f, Qs0 = th ? Q1 : 1.f, Cs1 = th ? C3 : C2, Qs1 = th ? Q3 : Q2;
            const int cit = (rd * F.G + F.vcu) * NWAVES + F.wave; const bool cdo = cit < NEXP * 512;
            f32x4 ctv[8]; unsigned short ggr[2][16];
            if (cdo) { const TItem citem = expert_item(F, I, cit); transpose_load(citem, ctv, lane); }
#pragma unroll
            for (int st = 0; st < 2; ++st)
#pragma unroll
                for (int tl = 0; tl < 16; ++tl) ggr[st][tl] = GL[(tok0 + 32 * st + 16 * th + tl) * 1024 + chg];
            asm volatile("" ::: "memory");
            if (th == 0) sumT[((rd & 1) * 8 + F.wave) * 32 + c32] = (f32x2){Pc, Hc};
            LDS_WAIT();
            __syncthreads();
            float cin = Rc, mycin = 0.f;
#pragma unroll
            for (int w = 0; w < 8; ++w) { const f32x2 ph = sumT[((rd & 1) * 8 + w) * 32 + c32]; mycin = (w == F.wave) ? cin : mycin; cin = ph.x * cin + ph.y; }
            Rc = cin;
#pragma unroll
            for (int st = 0; st < 2; ++st) { const float hin = (st ? Cs1 : Cs0) + (st ? Qs1 : Qs0) * mycin;
#pragma unroll
                for (int tl = 0; tl < 16; ++tl) { const float hh = hl[st][tl] + Pl[st][tl] * hin;
                    YL[(tok0 + 32 * st + 16 * th + tl) * 1024 + chg] = (bf16)f2bf(hh * bf2f(ggr[st][tl])); } }
            if (cdo) { const TItem citem = expert_item(F, I, cit); transpose_store_fp8(citem, ctv, pre, lane); }
        }
        __syncthreads();
    }
}

__device__ __forceinline__ void s5_chain(const Frame& F, int b, int g) {
    typedef float f32x2 __attribute__((ext_vector_type(2)));
    LAS f32x2* segE = (LAS f32x2*)(F.lds);
    const int lane = F.lane, w = F.wave;
    const float* SLOC = (const float*)(F.ws + WS_SLOC); unsigned* AGw = (unsigned*)(F.ws + WS_AG); const float* L16 = (const float*)(F.ws + SM_LAM16);
    const float lr = L16[(g * 64 + lane) * 2], li = L16[(g * 64 + lane) * 2 + 1];
    const float* sl = SLOC + ((size_t)(g * S5N + b * S5NCH + 32 * w)) * S5Q + 2 * lane;
    unsigned* ag = AGw + ((size_t)(g * S5N + b * S5NCH + 32 * w)) * (S5K / 2) + lane;
    float xr[32], xi[32];
#pragma unroll
    for (int u = 0; u < 32; ++u) { const float2 v = *(const float2*)(sl + (size_t)u * S5Q); xr[u] = v.x; xi[u] = v.y; }
    asm volatile("" ::: "memory");
    float sr = 0.f, si = 0.f;
#pragma unroll
    for (int u = 0; u < 32; ++u) { const float nr = lr * sr - li * si + xr[u], ni = lr * si + li * sr + xi[u]; xr[u] = sr; xi[u] = si; sr = nr; si = ni; }
    segE[w * 64 + lane] = (f32x2){sr, si};
    float qr = lr, qi = li;
#pragma unroll
    for (int k = 0; k < 5; ++k) { const float nr = qr * qr - qi * qi, ni = 2.f * qr * qi; qr = nr; qi = ni; }
    LDS_WAIT();
    __syncthreads();
    float cr = 0.f, ci = 0.f;
    for (int ww = 0; ww < w; ++ww) { const f32x2 e = segE[ww * 64 + lane]; const float nr = qr * cr - qi * ci + e.x, ni = qr * ci + qi * cr + e.y; cr = nr; ci = ni; }
#pragma unroll
    for (int u = 0; u < 32; ++u) { ag[(size_t)u * (S5K / 2)] = pk2(xr[u] + cr, xi[u] + ci); const float nr = lr * cr - li * ci, ni = lr * ci + li * cr; cr = nr; ci = ni; }
    __syncthreads();
}

__device__ __forceinline__ void p8_router(const Frame& F, const In& I) {
    const int lane = F.lane, tk = lane & 15, ks = lane >> 4;
    LAS float* lg = (LAS float*)(F.lds + F.wave * 4096);
    volatile LAS unsigned* cntL = F.MISC + 32; volatile LAS unsigned* baseL = F.MISC + 64;
    const float* X1 = I.p[0]; unsigned char* H2 = F.ws + WS_H2; const float* gf = I.p[21];
    const unsigned char* D8 = (const unsigned char*)(F.ws + WS_D8); const float* DSC = (const float*)(F.ws + WS_DSC);
    const bf16* RHI = (const bf16*)(F.ws + SM_RHI); const bf16* RLO = (const bf16*)(F.ws + SM_RLO);
    float* RSTD = (float*)(F.ws + SM_RSTD); unsigned* gcnt = F.ctl + CW_CNT;
    int* LTOK = (int*)(F.ws + WS_LTOK); float* LW = (float*)(F.ws + WS_LW); int* TOKE = (int*)(F.ws + WS_TOKE); int* TOKR = (int*)(F.ws + WS_TOKR);
    for (int blk = F.vcu; blk < T / 128; blk += F.G) {
        if (F.tid < 32) cntL[F.tid] = 0u;
        __syncthreads();
        const int tok0 = blk * 128 + F.wave * 16;
        const float* xrow = X1 + (size_t)(tok0 + tk) * D + 8 * ks; unsigned char* hrow = H2 + (size_t)(tok0 + tk) * D + 8 * ks;
        f32x4 acc[3]; acc[0] = acc[1] = acc[2] = (f32x4){0.f, 0.f, 0.f, 0.f}; float ss = 0.f;
        const unsigned char* drow = D8 + (size_t)(tok0 + tk) * D + 8 * ks; const float* dsc = DSC + (size_t)(tok0 + tk) * 16;
        f32x4 xnx[4][2]; v2u dnx[4]; float snx[2];
#pragma unroll
        for (int q = 0; q < 4; ++q) { xnx[q][0] = __builtin_nontemporal_load((const f32x4*)(xrow + 32 * q)); xnx[q][1] = __builtin_nontemporal_load((const f32x4*)(xrow + 32 * q + 4)); dnx[q] = *(const v2u*)(drow + 32 * q); }
        snx[0] = dsc[0]; snx[1] = dsc[4];
        LAS bf16* slab = (LAS bf16*)(F.lds + 32768);
        v4u wst[3];
#define RT_SLAB_LOAD(g) do { _Pragma("unroll") for (int j = 0; j < 3; ++j) { const int c = F.tid + 512 * j, which = c / 768, r = (c % 768) >> 4, kq = c & 15; \
            wst[j] = *(const v4u*)((which ? RLO : RHI) + (size_t)r * D + 128 * (g) + 8 * kq); } } while (0)
#define RT_SLAB_STORE(buf) do { _Pragma("unroll") for (int j = 0; j < 3; ++j) { const int c = F.tid + 512 * j, which = c / 768, r = (c % 768) >> 4, kq = c & 15; \
            *(LAS v4u*)(slab + ((size_t)((buf) * 2 + which) * 48 + r) * 136 + 8 * kq) = wst[j]; } } while (0)
        RT_SLAB_LOAD(0); RT_SLAB_STORE(0);
        LDS_WAIT();
        __syncthreads();
        for (int kg = 0; kg < 8; ++kg) {
            f32x4 xa[4][2];
#pragma unroll
            for (int q = 0; q < 4; ++q) { const float sq = snx[q >> 1]; const v2u dq = dnx[q];
                xa[q][0] = xnx[q][0] + (f32x4){(float)((int)(dq.x << 24) >> 24), (float)((int)(dq.x << 16) >> 24), (float)((int)(dq.x << 8) >> 24), (float)((int)dq.x >> 24)} * sq;
                xa[q][1] = xnx[q][1] + (f32x4){(float)((int)(dq.y << 24) >> 24), (float)((int)(dq.y << 16) >> 24), (float)((int)(dq.y << 8) >> 24), (float)((int)dq.y >> 24)} * sq; }
            { const int kgn = kg < 7 ? kg + 1 : kg;
#pragma unroll
              for (int q = 0; q < 4; ++q) { xnx[q][0] = __builtin_nontemporal_load((const f32x4*)(xrow + 32 * (4 * kgn + q))); xnx[q][1] = __builtin_nontemporal_load((const f32x4*)(xrow + 32 * (4 * kgn + q) + 4)); dnx[q] = *(const v2u*)(drow + 32 * (4 * kgn + q)); }
              { const int G0 = 2 * kgn, G1 = 2 * kgn + 1; snx[0] = dsc[(G0 & 3) * 4 + (G0 >> 2)]; snx[1] = dsc[(G1 & 3) * 4 + (G1 >> 2)]; }
              RT_SLAB_LOAD(kgn); }
            f32x4 ga[4][2];
#pragma unroll
            for (int q = 0; q < 4; ++q) { const int kc = 4 * kg + q; ga[q][0] = *(const f32x4*)(gf + 32 * kc + 8 * ks); ga[q][1] = *(const f32x4*)(gf + 32 * kc + 8 * ks + 4); }
            asm volatile("" ::: "memory");
            const LAS bf16* sh = slab + (size_t)((kg & 1) * 2) * 48 * 136, * sl = sh + 48 * 136;
#pragma unroll
            for (int q = 0; q < 4; ++q) { const int kc = 4 * kg + q;
                const f32x4 a0 = xa[q][0], a1 = xa[q][1];
                ss += (a0.x * a0.x + a0.y * a0.y) + (a0.z * a0.z + a0.w * a0.w) + (a1.x * a1.x + a1.y * a1.y) + (a1.z * a1.z + a1.w * a1.w);
                const f32x4 v0 = a0 * ga[q][0], v1 = a1 * ga[q][1];
                v4u hi, lo;
                hi.x = pg8::cvt_pk_bf16(v0.x, v0.y); hi.y = pg8::cvt_pk_bf16(v0.z, v0.w); hi.z = pg8::cvt_pk_bf16(v1.x, v1.y); hi.w = pg8::cvt_pk_bf16(v1.z, v1.w);
                lo.x = pg8::cvt_pk_bf16(v0.x - bflo(hi.x), v0.y - bfhi(hi.x)); lo.y = pg8::cvt_pk_bf16(v0.z - bflo(hi.y), v0.w - bfhi(hi.y));
                lo.z = pg8::cvt_pk_bf16(v1.x - bflo(hi.z), v1.y - bfhi(hi.z)); lo.w = pg8::cvt_pk_bf16(v1.z - bflo(hi.w), v1.w - bfhi(hi.w));
                { v2u h8; h8.x = pk_fp8x4(v0.x, v0.y, v0.z, v0.w); h8.y = pk_fp8x4(v1.x, v1.y, v1.z, v1.w); *(v2u*)(hrow + 32 * kc) = h8; }
                const bf16x8 hf = __builtin_bit_cast(bf16x8, hi), lf = __builtin_bit_cast(bf16x8, lo);
#pragma unroll
                for (int n = 0; n < 3; ++n) {
                    const bf16x8 wh = *(const LAS bf16x8*)(sh + (16 * n + tk) * 136 + 32 * q + 8 * ks), wl = *(const LAS bf16x8*)(sl + (16 * n + tk) * 136 + 32 * q + 8 * ks);
                    acc[n] = __builtin_amdgcn_mfma_f32_16x16x32_bf16(wh, hf, acc[n], 0, 0, 0);
                    acc[n] = __builtin_amdgcn_mfma_f32_16x16x32_bf16(wh, lf, acc[n], 0, 0, 0);
                    acc[n] = __builtin_amdgcn_mfma_f32_16x16x32_bf16(wl, hf, acc[n], 0, 0, 0);
                } }
            if (kg < 7) RT_SLAB_STORE((kg + 1) & 1);
            LDS_WAIT();
            __syncthreads();
        }
#undef RT_SLAB_LOAD
#undef RT_SLAB_STORE
        ss += __shfl_xor(ss, 16); ss += __shfl_xor(ss, 32);
        const float rstd = 1.0f / sqrtf(ss * (1.f / D) + RMS_EPS);
        if (ks == 0) RSTD[tok0 + tk] = rstd;
#pragma unroll
        for (int n = 0; n < 3; ++n)
#pragma unroll
            for (int r = 0; r < 4; ++r) lg[tk * 49 + 16 * n + 4 * ks + r] = acc[n][r] * rstd;
        LDS_WAIT();
        int E1 = 0, E2 = 0; float w1 = 0.f, w2 = 0.f; unsigned r1 = 0, r2 = 0;
        if (lane < 16) {
            const LAS float* my = lg + lane * 49;
            float lgp[4];
#pragma unroll
            for (int i = 0; i < 4; ++i) lgp[i] = my[i] + I.p[23][i];
            int gi = 0; float mx = lgp[0];
#pragma unroll
            for (int i = 1; i < 4; ++i) if (lgp[i] > mx) { mx = lgp[i]; gi = i; }
            float den = 0.f;
#pragma unroll
            for (int i = 0; i < 4; ++i) den += expf(lgp[i] - mx);
            const float pg = 1.0f / den;
            float le[8];
#pragma unroll
            for (int i = 0; i < 8; ++i) le[i] = my[4 + gi * 8 + i] + I.p[25][gi * 8 + i];
            int i1 = 0; float m1 = le[0];
#pragma unroll
            for (int i = 1; i < 8; ++i) if (le[i] > m1) { m1 = le[i]; i1 = i; }
            int i2 = -1; float m2 = -3.0e38f;
#pragma unroll
            for (int i = 0; i < 8; ++i) if (i != i1 && le[i] > m2) { m2 = le[i]; i2 = i; }
            const float e2 = expf(m2 - m1);
            w1 = pg / (1.0f + e2); w2 = pg * e2 / (1.0f + e2);
            E1 = gi * 8 + i1; E2 = gi * 8 + i2;
            r1 = __hip_atomic_fetch_add((LAS unsigned*)(F.MISC + 32) + E1, 1u, __ATOMIC_RELAXED, __HIP_MEMORY_SCOPE_WORKGROUP);
            r2 = __hip_atomic_fetch_add((LAS unsigned*)(F.MISC + 32) + E2, 1u, __ATOMIC_RELAXED, __HIP_MEMORY_SCOPE_WORKGROUP);
        }
        LDS_WAIT();
        __syncthreads();
        if (F.tid < 32) { const unsigned c = cntL[F.tid]; baseL[F.tid] = c ? __hip_atomic_fetch_add(gcnt + F.tid, c, __ATOMIC_RELAXED, __HIP_MEMORY_SCOPE_AGENT) : 0u; }
        __syncthreads();
        if (lane < 16) {
            const int tok = tok0 + lane; const int k1 = (int)(baseL[E1] + r1), k2 = (int)(baseL[E2] + r2);
            LTOK[(size_t)E1 * T + k1] = tok; LW[(size_t)E1 * T + k1] = w1; LTOK[(size_t)E2 * T + k2] = tok; LW[(size_t)E2 * T + k2] = w2;
            TOKE[tok * 2] = E1; TOKE[tok * 2 + 1] = E2; TOKR[tok * 2] = k1; TOKR[tok * 2 + 1] = k2;
        }
        __syncthreads();
    }
}

__device__ __forceinline__ void moe_prefix(const Frame& F) {
    if (F.tid < 64) {
        const unsigned nt = F.tid < NEXP ? (F.ctl[CW_CNT + F.tid] + 255u) >> 8 : 0u; unsigned inc = nt;
#pragma unroll
        for (int o = 1; o < 32; o <<= 1) { const unsigned v = __shfl_up(inc, o); if (F.lane >= o) inc += v; }
        if (F.tid < NEXP) F.MISC[96 + F.tid] = inc - nt;
        if (F.tid == NEXP - 1) F.MISC[128] = inc;
    }
    LDS_WAIT();
    __syncthreads();
}
template <int MODE  >
__device__ __forceinline__ void moe_setup(const Frame& F) {
    moe_prefix(F);
    const int NT = (int)F.MISC[128];
    if (F.tid < MAXU) { const int L = F.tid * F.G + F.vcu; int e = -1, mt = 0;
        if (L < NT * 4) { const int mtg = L >> 2; e = 0; while (e < NEXP - 1 && (int)F.MISC[96 + e + 1] <= mtg) ++e; mt = mtg - (int)F.MISC[96 + e]; }
        F.MISC[136 + F.tid] = (unsigned)e; F.MISC[144 + F.tid] = (unsigned)mt; }
    __syncthreads();
    if (F.tid == 0) { int n = 0; while (n < MAXU && (int)F.MISC[136 + n] >= 0) ++n; F.MISC[152] = (unsigned)n; }
    __syncthreads();
    const int nU = (int)F.MISC[152];
    LAS int* tokL = (LAS int*)(F.lds + TOKL_OFF); LAS float* sclL = (LAS float*)(F.lds + SCLL_OFF);
    const int* LTOK = (const int*)(F.ws + WS_LTOK); const float* LW = (const float*)(F.ws + WS_LW); const float* RSTD = (const float*)(F.ws + SM_RSTD);
    for (int i = F.tid; i < nU * 256; i += 512) { const int ui = i >> 8, r = i & 255, e = (int)F.MISC[136 + ui], rank = (int)F.MISC[144 + ui] * 256 + r; const bool valid = rank < (int)F.ctl[CW_CNT + e];
        const int tok = valid ? LTOK[(size_t)e * T + rank] : 0; tokL[i] = tok; sclL[i] = valid ? (MODE == 0 ? RSTD[tok] : LW[(size_t)e * T + rank]) : 0.f; }
    LDS_WAIT(); VM_WAIT();
    __syncthreads();
}

__device__ __forceinline__ void p11_final(const Frame& F, const In& I, float* dst) {
    moe_prefix(F);
    const int gw = F.vcu * NWAVES + F.wave, NGW = F.G * NWAVES, lane = F.lane;
    const int* TOKE = (const int*)(F.ws + WS_TOKE); const int* TOKR = (const int*)(F.ws + WS_TOKR);
    const unsigned char* YS8 = (const unsigned char*)(F.ws + WS_YS); const float* YSC = (const float*)(F.ws + WS_YS + 80 * MiB);
    const unsigned char* D8 = (const unsigned char*)(F.ws + WS_D8); const float* DSC = (const float*)(F.ws + WS_DSC); const float* X = I.p[0];
    f32x4 gfin[4];
#pragma unroll
    for (int j = 0; j < 4; ++j) gfin[j] = ((const f32x4*)I.p[29])[lane + 64 * j];
    int ee[2][2], rr[2][2];
    { const int m0 = gw * 2 < T ? gw * 2 : 0;
#pragma unroll
      for (int q = 0; q < 2; ++q) { ee[q][0] = TOKE[2 * (m0 + q)]; ee[q][1] = TOKE[2 * (m0 + q) + 1]; rr[q][0] = TOKR[2 * (m0 + q)]; rr[q][1] = TOKR[2 * (m0 + q) + 1]; } }
    for (int m0 = gw * 2; m0 < T; m0 += NGW * 2) {
        f32x4 xv[2][4]; unsigned ya[2][4], yb[2][4], yd[2][4]; f32x4 sa[2], sb[2], sd[2];
#pragma unroll
        for (int q = 0; q < 2; ++q) { const size_t s0 = (size_t)F.MISC[96 + ee[q][0]] * 256 + rr[q][0], s1 = (size_t)F.MISC[96 + ee[q][1]] * 256 + rr[q][1];
            const f32x4* xr = (const f32x4*)(X + (size_t)(m0 + q) * D) + lane; const unsigned* y0 = (const unsigned*)(YS8 + s0 * 1024) + lane; const unsigned* y1 = (const unsigned*)(YS8 + s1 * 1024) + lane;
            const unsigned* d0 = (const unsigned*)(D8 + (size_t)(m0 + q) * 1024) + lane;
#pragma unroll
            for (int j = 0; j < 4; ++j) { xv[q][j] = __builtin_nontemporal_load(xr + 64 * j); ya[q][j] = y0[64 * j]; yb[q][j] = y1[64 * j]; yd[q][j] = d0[64 * j]; }
            sa[q] = *(const f32x4*)(YSC + s0 * 16 + 4 * (lane >> 4)); sb[q] = *(const f32x4*)(YSC + s1 * 16 + 4 * (lane >> 4)); sd[q] = *(const f32x4*)(DSC + (size_t)(m0 + q) * 16 + 4 * (lane >> 4)); }
        { const int mn = m0 + NGW * 2 < T ? m0 + NGW * 2 : m0;
#pragma unroll
          for (int q = 0; q < 2; ++q) { ee[q][0] = TOKE[2 * (mn + q)]; ee[q][1] = TOKE[2 * (mn + q) + 1]; rr[q][0] = TOKR[2 * (mn + q)]; rr[q][1] = TOKR[2 * (mn + q) + 1]; } }
        asm volatile("" ::: "memory");
#pragma unroll
        for (int q = 0; q < 2; ++q) { f32x4 v[4]; float s = 0.f;
#pragma unroll
            for (int j = 0; j < 4; ++j) { const f32x4 x = xv[q][j]; const unsigned a = ya[q][j], b = yb[q][j], c = yd[q][j]; const float ka = sa[q][j], kb = sb[q][j], kc = sd[q][j];
                v[j].x = (x.x + (float)((int)(c << 24) >> 24) * kc) + (float)((int)(a << 24) >> 24) * ka + (float)((int)(b << 24) >> 24) * kb;
                v[j].y = (x.y + (float)((int)(c << 16) >> 24) * kc) + (float)((int)(a << 16) >> 24) * ka + (float)((int)(b << 16) >> 24) * kb;
                v[j].z = (x.z + (float)((int)(c << 8) >> 24) * kc) + (float)((int)(a << 8) >> 24) * ka + (float)((int)(b << 8) >> 24) * kb;
                v[j].w = (x.w + (float)((int)c >> 24) * kc) + (float)((int)a >> 24) * ka + (float)((int)b >> 24) * kb;
                s += (v[j].x * v[j].x + v[j].y * v[j].y) + (v[j].z * v[j].z + v[j].w * v[j].w); }
            const float rstd = 1.0f / sqrtf(wave_sum(s) * (1.f / D) + RMS_EPS);
            f32x4* xw = (f32x4*)(dst + (size_t)(m0 + q) * D) + lane;
#pragma unroll
            for (int j = 0; j < 4; ++j) { const f32x4 g = gfin[j]; __builtin_nontemporal_store((f32x4){v[j].x * rstd * g.x, v[j].y * rstd * g.y, v[j].z * rstd * g.z, v[j].w * rstd * g.w}, xw + 64 * j); } }
    }
}

constexpr int N_PHASES = 12;
struct Args { In in; float* out; unsigned char* ws; float* fin_dst; int ph_lo, ph_hi, li, pad; };
__global__ void __launch_bounds__(NWAVES * 64, 2) mk_fwd(Args args) {
    extern __shared__ __attribute__((aligned(16))) unsigned char lds[];
    Frame F;
    F.lds = (LAS unsigned char*)lds;
    F.MISC = (volatile LAS unsigned*)(F.lds + MISC_OFF);
    F.tid = threadIdx.x; F.lane = F.tid & 63; F.wave = __builtin_amdgcn_readfirstlane(F.tid >> 6);
    F.G = gridDim.x; { const int bx = blockIdx.x; F.vcu = (F.G % 8 == 0) ? (bx % 8) * (F.G / 8) + bx / 8 : bx; }
    F.ws = args.ws; F.out = args.out; F.ctl = (unsigned*)(args.ws + WS_CTL); F.in = nullptr;
    const In& I = args.in;
    for (int u = F.tid; u < 256; u += NWAVES * 64) F.MISC[u] = 0u;
    __syncthreads();
    const int lo = args.ph_lo, hi = args.ph_hi;
    XcdBarrier bar; bar.bar = F.ctl + CW_BAR + args.li * XCD_BAR_WORDS; bar.x = 0; bar.st = nullptr;
    if (hi - lo > 1) bar = xcd_barrier_post(F.ctl + CW_BAR + args.li * XCD_BAR_WORDS, F.MISC + 8);
#ifndef PH_MASK
#define PH_MASK 0xFFF
#endif
#define IN(k) (((PH_MASK >> (k)) & 1) && lo <= (k) && (k) < hi)
#define SEAM(k) do { if (IN(k) && IN(NEXT_PH(k))) xcd_barrier(bar); } while (0)
#define NEXT_PH(k) ((k) == 2 ? 5 : (k) == 5 ? 7 : (k) + 1)
    const int cblk = (int)blockIdx.x;
    LAS unsigned char* ring = F.lds;

    if (IN(0)) { p0_prologue(F, I); SEAM(0); }

    if (IN(1)) {
        if (F.G < 2) late_weight_copies(F, I, F.wave, NWAVES); else if (cblk & 1) late_weight_copies(F, I, (cblk >> 1) * NWAVES + F.wave, (F.G >> 1) * NWAVES);
        DenseOrder S; S.init(F.ws + WS_H, F.ws + WS_WIN, D / 2, D / 2, T, NIN, F.G, cblk);
        EpiInProj E{(bf16*)(F.ws + WS_AG), (bf16*)(F.ws + WS_XL), (bf16*)(F.ws + WS_GL), (bf16*)(F.ws + WS_GA), (bf16*)(F.ws + WS_GB), (const float*)(F.ws + SM_HSC), (const float*)(F.ws + SM_WSC), F.lds + TOKL_OFF};
        pg8::gemm_phase<EpiInProj, DenseOrder, true>(ring, D / 2, D / 2, S, E);
        SEAM(1);
    }
    if (IN(2)) {
        if (cblk < 256) {
            const int L = cblk, wgid = (L % 8) * 32 + L / 8, g = wgid >> 3, mt = wgid & 7;
            { S5One S{(const char*)(F.ws + WS_AG) + S5Q * 2, (const char*)(F.ws + WS_BTW), (size_t)S5N * S5K * 2, (size_t)128 * 256 * 2, S5K, g, mt};
              EpiS5State E{(float*)(F.ws + WS_SLOC)};
              pg8::gemm_phase<EpiS5State, S5One, false>(ring, 256, 256, S, E); }
            if (F.wave == 0) { __builtin_amdgcn_fence(__ATOMIC_ACQUIRE, "agent"); VM_WAIT(); }
            __syncthreads();
            s5_chain(F, mt, g);
            VM_WAIT();
            __syncthreads();
            if (F.wave == 0) { __builtin_amdgcn_fence(__ATOMIC_ACQUIRE, "agent"); VM_WAIT(); }
            __syncthreads();
            { S5One S{(const char*)(F.ws + WS_AG), (const char*)(F.ws + WS_BTT), (size_t)S5N * S5K * 2, (size_t)256 * S5K * 2, S5K, g, mt};
              EpiS5Out E{(bf16*)(F.ws + WS_GY)};
              pg8::gemm_phase<EpiS5Out, S5One, false>(ring, S5K, S5K, S, E); }
            __syncthreads();
        }
        lru_seq(F, I);
        SEAM(2);
    }
    if (IN(5)) {
        YaYbOrder S; S.d.init(nullptr, nullptr, D, D, T, D, F.G, cblk);
        S.GYb = (const char*)(F.ws + WS_GY); S.WS5b = (const char*)(F.ws + WS_WS5); S.YLb = (const char*)(F.ws + WS_H); S.WLb = (const char*)(F.ws + WS_WLRU);
        EpiYaYb E{EpiYa{(const bf16*)(F.ws + WS_GA), (bf16*)(F.ws + WS_XL)}, EpiYb{(const bf16*)(F.ws + WS_XL), (const bf16*)(F.ws + WS_GB), (bf16*)(F.ws + WS_GL)}};
        pg8::gemm_phase<EpiYaYb, YaYbOrder, true>(ring, D, D, S, E);
        SEAM(5);
    }
    if (IN(7)) {
        DenseOrder S; S.init(F.ws + WS_GL, F.ws + WS_WO, D, D, T, D, F.G, cblk);
        EpiQ8<false> E{(unsigned char*)(F.ws + WS_D8), (float*)(F.ws + WS_DSC), nullptr};
        pg8::gemm_phase<EpiQ8<false>, DenseOrder, true>(ring, D, D, S, E);
        SEAM(7);
    }
    if (IN(8)) { p8_router(F, I); __syncthreads(); expert_weight_copies(F, I); SEAM(8); }
    if (IN(9)) {
        moe_setup<0>(F);
        MoeOrder<true> S{(const char*)(F.ws + WS_H2), (const char*)(F.ws + WS_WGU), (size_t)1024 * 1024, D / 2, D / 2, F.G, F.vcu, F.MISC, (const LAS int*)(F.lds + TOKL_OFF)};
        EpiGU E{F.ws + WS_ACT, (const LAS float*)(F.lds + SCLL_OFF)};
        pg8::gemm_phase<EpiGU, MoeOrder<true>, true>(ring, D / 2, D / 2, S, E);
        __syncthreads();
        expert_down_copies(F, I);
        SEAM(9);
    }
    if (IN(10)) {
        moe_setup<1>(F);
        MoeOrder<false> S{(const char*)(F.ws + WS_ACT), (const char*)(F.ws + WS_WD), (size_t)1024 * DEXP, DEXP / 2, DEXP / 2, F.G, F.vcu, F.MISC, (const LAS int*)(F.lds + TOKL_OFF)};
        EpiQ8<true> E{(unsigned char*)(F.ws + WS_YS), (float*)(F.ws + WS_YS + 80 * MiB), (const LAS float*)(F.lds + SCLL_OFF)};
        pg8::gemm_phase<EpiQ8<true>, MoeOrder<false>, true>(ring, DEXP / 2, DEXP / 2, S, E);
        SEAM(10);
    }
    if (IN(11)) { p11_final(F, I, args.fin_dst); }
#undef IN
#undef SEAM
}

extern "C" void kernel_launch(void* const* d_in, const int* in_sizes, int n_in, void* d_out, int out_size, void* d_ws, size_t ws_size, hipStream_t stream) {
    static int grid = 0;
    if (grid == 0) {
        if (n_in != 30 || in_sizes[0] != T * D || out_size != T * D || ws_size < WS_END) { fprintf(stderr, "kernel_launch: unexpected shapes / workspace (n_in %d, ws %zu)\n", n_in, ws_size); grid = -1; return; }
        int dev = 0, cus = 0, per_cu = 0;
        if (hipGetDevice(&dev) != hipSuccess || hipDeviceGetAttribute(&cus, hipDeviceAttributeMultiprocessorCount, dev) != hipSuccess) { grid = -1; return; }
        if (hipFuncSetAttribute((const void*)mk_fwd, hipFuncAttributeMaxDynamicSharedMemorySize, LDS_BYTES) != hipSuccess) { fprintf(stderr, "kernel_launch: hipFuncSetAttribute failed\n"); grid = -1; return; }
        if (hipOccupancyMaxActiveBlocksPerMultiprocessor(&per_cu, (const void*)mk_fwd, NWAVES * 64, LDS_BYTES) != hipSuccess || per_cu < 1) { fprintf(stderr, "kernel_launch: occupancy query says %d\n", per_cu); }
        (void)hipGetLastError();
        grid = cus;
    }
    if (grid < 0) return;
    if (hipMemsetAsync((char*)d_ws + WS_CTL, 0, CTL_ZERO_BYTES, stream) != hipSuccess) return;
    Args a{};
    for (int i = 0; i < 30; ++i) a.in.p[i] = (const float*)d_in[i];
    a.out = (float*)d_out; a.ws = (unsigned char*)d_ws; a.fin_dst = (float*)d_out;
#if defined(PROBE_LO)
    a.ph_lo = 0; a.ph_hi = PROBE_HI; a.li = 0;
#if PROBE_LO == 11
    a.fin_dst = (float*)((char*)d_ws + WS_H2);
#endif
    hipLaunchKernelGGL(mk_fwd, dim3(grid), dim3(NWAVES * 64), LDS_BYTES, stream, a);
#if PROBE_LO == 8
    hipMemsetAsync((char*)d_ws + WS_CTL + CW_CNT * 4, 0, 128, stream);
#endif
    a.fin_dst = (float*)d_out;
    a.ph_lo = PROBE_LO; a.ph_hi = N_PHASES; a.li = 1;
    hipLaunchKernelGGL(mk_fwd, dim3(grid), dim3(NWAVES * 64), LDS_BYTES, stream, a);
#elif MK_N_LAUNCHES == 1
    a.ph_lo = 0; a.ph_hi = N_PHASES;
    hipLaunchKernelGGL(mk_fwd, dim3(grid), dim3(NWAVES * 64), LDS_BYTES, stream, a);
#else
    for (int p = 0; p < N_PHASES; ++p) { a.ph_lo = p; a.ph_hi = p + 1; hipLaunchKernelGGL(mk_fwd, dim3(grid), dim3(NWAVES * 64), LDS_BYTES, stream, a); }
#endif
}
```

```cpp
#include <hip/hip_runtime.h>
#include <cstdio>
#include <cstdint>

#ifndef MK_N_LAUNCHES
#define MK_N_LAUNCHES 1
#endif

namespace pg8 {
#define PG8_LAS __attribute__((address_space(3)))
typedef unsigned short bf16_t;
typedef short bf16x8 __attribute__((ext_vector_type(8)));
typedef float f32x4 __attribute__((ext_vector_type(4)));
typedef unsigned u32x4 __attribute__((ext_vector_type(4)));
typedef int i32x4 __attribute__((ext_vector_type(4)));
template <class E, class = void> struct epi_i8 { static constexpr bool v = false; };
template <class E> struct epi_i8<E, decltype((void)E::I8)> { static constexpr bool v = E::I8; };
template <class E, class = void> struct epi_f8 { static constexpr bool v = false; };
template <class E> struct epi_f8<E, decltype((void)E::F8)> { static constexpr bool v = E::F8; };
typedef int i32x8 __attribute__((ext_vector_type(8)));
template <bool I8> struct acc_sel { typedef f32x4 t; };
template <> struct acc_sel<true> { typedef i32x4 t; };
constexpr int BM = 256, BK = 64, HALF = 128, HTB = HALF * BK * 2  , STAGE_BYTES = 8 * HTB, NXCD = 8, WGM = 8;

__host__ __device__ __forceinline__ int lds_byte(int r, int c) { const int st = (r >> 4) * 2 + (c >> 5), rr = r & 15, cc = c & 31, ob = rr * 64 + cc * 2; return st * 1024 + (ob ^ (((ob >> 9) & 1) << 5)); }
__host__ __device__ __forceinline__ void stage_rc(int b, int& R, int& C) { const int st = b / 1024, sb = b % 1024, swz = sb ^ (((sb >> 9) & 1) << 5); R = (st >> 1) * 16 + swz / 64; C = (st & 1) * 32 + (swz % 64) / 2; }
__host__ __device__ __forceinline__ int perm32(int rho) { const int n = rho >> 4, i = rho & 15; return 8 * (i >> 2) + 4 * n + (i & 3); }

struct Unit { const char* A; const char* B; int pm, pn, aux, nt, kind; unsigned kA; };

__device__ __forceinline__ unsigned cvt_pk_bf16(float lo, float hi) { unsigned r; asm volatile("v_cvt_pk_bf16_f32 %0, %1, %2" : "=v"(r) : "v"(lo), "v"(hi)); return r; }

template <class Epi, class Sched, bool ALIGN_EPI>
__device__ __forceinline__ void gemm_phase(PG8_LAS unsigned char* lds, const int ldb, const int K, const Sched& S, const Epi& E, const size_t kstepA = (size_t)(BK * 2)) {
    const int tid = threadIdx.x, wid = __builtin_amdgcn_readfirstlane(tid >> 6), lane = tid & 63, wr = wid >> 2, wc = wid & 3, fr = lane & 15, fq = lane >> 4;
    constexpr bool I8 = epi_i8<Epi>::v, F8 = epi_f8<Epi>::v; typedef typename acc_sel<I8>::t acc_t;
    int nt = K / BK; asm volatile("" : "+s"(nt));
    int Rr[2], Cc[2], Rbb[2]; unsigned voffB[4], vAc[4], vAn[4];
#pragma unroll
    for (int i = 0; i < 2; ++i) { int R, C; stage_rc(tid * 16 + i * 8192, R, C); Rr[i] = R; Cc[i] = C; const int Rb = Epi::PERM ? ((R & ~31) + perm32(R & 31)) : R; Rbb[i] = Rb;
        int Rb0 = Rb, Rb1 = HALF + Rb;
        if constexpr (Epi::B16) {
            const int w_ = R >> 5, nn_ = (R >> 4) & 1, ii_ = R & 15; Rb0 = 64 * w_ + 16 * (ii_ >> 2) + 4 * nn_ + (ii_ & 3); Rb1 = Rb0 + 8; }
        voffB[i] = (unsigned)(Rb0 * ldb + C) * 2u; voffB[2 + i] = (unsigned)(Rb1 * ldb + C) * 2u; }
    const size_t kstep = (size_t)(BK * 2);
    const unsigned ldsw = (unsigned)wid * 1024u;
    const int aoff = lds_byte(wr * 64 + fr, fq * 8), boff = lds_byte(wc * 32 + fr, fq * 8);
#define PG8_SA(b, h) (((b) * 2 + (h)) * HTB)
#define PG8_SB(b, h) ((4 + (b) * 2 + (h)) * HTB)
#define PG8_STAGE(bufoff, gbase, voff, h) do { _Pragma("unroll") for (int _i = 0; _i < 2; ++_i) \
        __builtin_amdgcn_global_load_lds((const unsigned*)((const char*)(gbase) + (voff)[2 * (h) + _i]), (PG8_LAS unsigned*)(lds + (bufoff) + ldsw + _i * 8192), 16, 0, 0); } while (0)
#define PG8_LDA(dst, b, h) do { _Pragma("unroll") for (int m = 0; m < 4; ++m) _Pragma("unroll") for (int k = 0; k < 2; ++k) dst[m][k] = *(const PG8_LAS bf16x8*)(lds + PG8_SA(b, h) + aoff + m * 2048 + k * 1024); } while (0)
#define PG8_LDB(dst, b, h) do { _Pragma("unroll") for (int n = 0; n < 2; ++n) _Pragma("unroll") for (int k = 0; k < 2; ++k) dst[n][k] = *(const PG8_LAS bf16x8*)(lds + PG8_SB(b, h) + boff + n * 2048 + k * 1024); } while (0)
#define PG8_MMA(ai, bj, At, Bt) do { __builtin_amdgcn_s_setprio(1); _Pragma("unroll") for (int m = 0; m < 4; ++m) _Pragma("unroll") for (int n = 0; n < 2; ++n) { \
        if constexpr (F8) { const i32x4 b0_ = __builtin_bit_cast(i32x4, Bt[n][0]), b1_ = __builtin_bit_cast(i32x4, Bt[n][1]), a0_ = __builtin_bit_cast(i32x4, At[m][0]), a1_ = __builtin_bit_cast(i32x4, At[m][1]); \
            acc[ai][bj][m][n] = __builtin_amdgcn_mfma_scale_f32_16x16x128_f8f6f4((i32x8){b0_[0], b0_[1], b0_[2], b0_[3], b1_[0], b1_[1], b1_[2], b1_[3]}, (i32x8){a0_[0], a0_[1], a0_[2], a0_[3], a1_[0], a1_[1], a1_[2], a1_[3]}, acc[ai][bj][m][n], 0, 0, 0, 0, 0, 0); } \
        else { _Pragma("unroll") for (int k = 0; k < 2; ++k) { \
          if constexpr (I8) acc[ai][bj][m][n] = __builtin_amdgcn_mfma_i32_16x16x64_i8(__builtin_bit_cast(i32x4, Bt[n][k]), __builtin_bit_cast(i32x4, At[m][k]), acc[ai][bj][m][n], 0, 0, 0); \
          else acc[ai][bj][m][n] = __builtin_amdgcn_mfma_f32_16x16x32_bf16(Bt[n][k], At[m][k], acc[ai][bj][m][n], 0, 0, 0); } } } __builtin_amdgcn_s_setprio(0); } while (0)
#define PG8_WAIT_V(n) asm volatile("s_waitcnt vmcnt(" #n ")" ::: "memory")
#define PG8_WAIT_L(n) asm volatile("s_waitcnt lgkmcnt(" #n ")" ::: "memory")
#define PG8_BAR __builtin_amdgcn_s_barrier()
#define PG8_SCHED __builtin_amdgcn_sched_barrier(0)
    Unit cur, nxt; int ui = 0;
    if (!S.next(0, cur)) return;
    S.a_offsets(cur, Rr, Cc, vAc);
    unsigned vBc[4], vBn[4];
    if constexpr (Sched::HETERO) { S.b_offsets(cur, Rbb, Cc, vBc); nt = __builtin_amdgcn_readfirstlane(cur.nt); }
    else {
#pragma unroll
        for (int q = 0; q < 4; ++q) vBc[q] = voffB[q]; }
    size_t kAc = Sched::HETERO ? (size_t)(unsigned)__builtin_amdgcn_readfirstlane((int)cur.kA) : kstepA;
    acc_t acc[2][2][4][2];
    if constexpr (Epi::ACC_INIT) E.init(acc, cur, wr, wc, fr, fq);
    else {
#pragma unroll
    for (int a = 0; a < 2; ++a)
#pragma unroll
        for (int b = 0; b < 2; ++b)
#pragma unroll
            for (int m = 0; m < 4; ++m)
#pragma unroll
                for (int n = 0; n < 2; ++n) acc[a][b][m][n] = acc_t{}; }
    bf16x8 At[4][2], B0[2][2], B1[2][2];
    const char* cA = cur.A; const char* cB = cur.B;
    if constexpr (Sched::GATHER) { PG8_WAIT_L(0); }
    PG8_STAGE(PG8_SB(0, 0), cB, vBc, 0); PG8_STAGE(PG8_SB(0, 1), cB, vBc, 1); PG8_STAGE(PG8_SA(0, 0), cA, vAc, 0); PG8_STAGE(PG8_SA(0, 1), cA, vAc, 1);
    if (wr == 1) PG8_BAR;
    PG8_WAIT_V(2); PG8_BAR;
    PG8_STAGE(PG8_SB(1, 0), cB + kstep, vBc, 0); PG8_STAGE(PG8_SA(1, 0), cA + kAc, vAc, 0); PG8_STAGE(PG8_SB(1, 1), cB + kstep, vBc, 1);
    PG8_WAIT_V(6); PG8_BAR;
    for (;;) {
        const bool has_next = S.next(ui + 1, nxt);
        const char* nA = has_next ? nxt.A : cA; const char* nB = has_next ? nxt.B : cB;
        size_t kAn = kAc;
        if constexpr (Sched::HETERO) { if (has_next) { S.b_offsets(nxt, Rbb, Cc, vBn); kAn = (size_t)(unsigned)__builtin_amdgcn_readfirstlane((int)nxt.kA); } else {
#pragma unroll
                for (int q = 0; q < 4; ++q) vBn[q] = vBc[q]; } }
        for (int t = 0; t < nt; t += 2) {
            const bool last = (t == nt - 2);
            const char* a1 = cA + (size_t)(t + 1) * kAc;
            const char* a2 = last ? nA : cA + (size_t)(t + 2) * kAc; const char* b2 = last ? nB : cB + (size_t)(t + 2) * kstep;
            const char* a3 = a2 + (last ? kAn : kAc); const char* b3 = b2 + kstep;
            unsigned vb2[4];
#pragma unroll
            for (int q = 0; q < 4; ++q) vb2[q] = (Sched::HETERO && last) ? vBn[q] : vBc[q];
            unsigned va2[4];
            if constexpr (Sched::GATHER || Sched::HETERO) {
                if (last) { if (has_next) { S.a_offsets(nxt, Rr, Cc, vAn); if constexpr (Sched::GATHER) { PG8_WAIT_L(0); } } else {
#pragma unroll
                        for (int q = 0; q < 4; ++q) vAn[q] = vAc[q]; } }
#pragma unroll
                for (int q = 0; q < 4; ++q) va2[q] = last ? vAn[q] : vAc[q];
            } else {
#pragma unroll
                for (int q = 0; q < 4; ++q) va2[q] = vAc[q];
            }
            PG8_LDB(B0, 0, 0); PG8_LDB(B1, 0, 1); PG8_SCHED; PG8_LDA(At, 0, 0); PG8_STAGE(PG8_SA(1, 1), a1, vAc, 1);
            PG8_WAIT_V(8); PG8_WAIT_L(0); PG8_BAR; PG8_MMA(0, 0, At, B0); PG8_MMA(0, 1, At, B1); PG8_BAR; PG8_SCHED;
            const bool fin = last && !has_next;
            PG8_LDA(At, 0, 1);
            if (!fin) { PG8_STAGE(PG8_SB(0, 0), b2, vb2, 0); PG8_STAGE(PG8_SB(0, 1), b2, vb2, 1); PG8_STAGE(PG8_SA(0, 0), a2, va2, 0); PG8_WAIT_V(8); } else { PG8_WAIT_V(0); }
            PG8_WAIT_L(0); PG8_BAR; PG8_MMA(1, 0, At, B0); PG8_MMA(1, 1, At, B1); PG8_BAR; PG8_SCHED;
            PG8_LDB(B0, 1, 0); PG8_LDB(B1, 1, 1); PG8_SCHED; PG8_LDA(At, 1, 0);
            if (!fin) { PG8_STAGE(PG8_SA(0, 1), a2, va2, 1); PG8_WAIT_V(8); } else { PG8_WAIT_V(0); }
            PG8_WAIT_L(0); PG8_BAR; PG8_MMA(0, 0, At, B0); PG8_MMA(0, 1, At, B1); PG8_BAR; PG8_SCHED;
            PG8_LDA(At, 1, 1);
            if (!fin) { PG8_STAGE(PG8_SB(1, 0), b3, vb2, 0); PG8_STAGE(PG8_SB(1, 1), b3, vb2, 1); PG8_STAGE(PG8_SA(1, 0), a3, va2, 0); PG8_WAIT_V(8); } else { PG8_WAIT_V(0); }
            PG8_WAIT_L(0); PG8_BAR; PG8_MMA(1, 0, At, B0); PG8_MMA(1, 1, At, B1); PG8_BAR; PG8_SCHED;
        }
        if constexpr (ALIGN_EPI) { if (wr == 0) PG8_BAR; }
        E(acc, cur, wr, wc, fr, fq);
        if (!has_next) break;
        if constexpr (Epi::ACC_INIT) E.init(acc, nxt, wr, wc, fr, fq);
        else {
#pragma unroll
        for (int a = 0; a < 2; ++a)
#pragma unroll
            for (int b = 0; b < 2; ++b)
#pragma unroll
                for (int m = 0; m < 4; ++m)
#pragma unroll
                    for (int n = 0; n < 2; ++n) acc[a][b][m][n] = acc_t{}; }
        cur = nxt; cA = nA; cB = nB; ++ui;
        if constexpr (Sched::GATHER || Sched::HETERO) {
#pragma unroll
            for (int q = 0; q < 4; ++q) vAc[q] = vAn[q]; }
        if constexpr (Sched::HETERO) {
#pragma unroll
            for (int q = 0; q < 4; ++q) vBc[q] = vBn[q];
            kAc = kAn; nt = __builtin_amdgcn_readfirstlane(cur.nt); }
        if constexpr (ALIGN_EPI) { if (wr == 1) PG8_BAR; }
    }
    PG8_WAIT_V(0);
    if constexpr (!ALIGN_EPI) { if (wr == 0) PG8_BAR; }
    PG8_BAR;
#undef PG8_SA
#undef PG8_SB
#undef PG8_STAGE
#undef PG8_LDA
#undef PG8_LDB
#undef PG8_MMA
#undef PG8_WAIT_V
#undef PG8_WAIT_L
#undef PG8_BAR
#undef PG8_SCHED
}
}

constexpr int NWAVES = 8;
constexpr int BATCH = 8, SEQ = 4096, D = 1024, T = BATCH * SEQ;
constexpr int S5W = 512, S5G = 32, S5C = 16, S5P = 64, S5Q = 128;
constexpr int S5LC = 16, S5NCH = SEQ / S5LC, S5N = BATCH * S5NCH;
constexpr int S5K = S5Q + S5LC * S5C;
constexpr int LRUW = 1024, LRUH = 16, LRUHD = 64, LRUCH = 64, LRUNCH = SEQ / LRUCH;
constexpr int NIN = S5W + 2 * LRUW + 2 * D;
constexpr int NEXP = 32, EPG = 8, NGRP = 4, DEXP = 512, NROUT = 48;
constexpr int MAXSLOT = 73728;
constexpr int MAXU = 8;
constexpr float RMS_EPS = 1e-6f;

constexpr size_t MiB = 1u << 20;
constexpr size_t WS_CTL = 0, CTL_ZERO_BYTES = 128 * 1024;
constexpr size_t WS_SMALL = 1 * MiB;
constexpr size_t SM_LAM16 = WS_SMALL + 0;
constexpr size_t SM_LRUC = WS_SMALL + 16384;
constexpr size_t SM_WRT = WS_SMALL + 32768;
constexpr size_t SM_RHI = WS_SMALL + 327680;
constexpr size_t SM_RLO = SM_RHI + 98304;
constexpr size_t SM_RSTD = WS_SMALL + 524288;
constexpr size_t SM_HSC = WS_SMALL + 720896;
constexpr size_t SM_WSC = WS_SMALL + 851968;
constexpr size_t WS_BTT = 2 * MiB;
constexpr size_t WS_BTW = 8 * MiB;
constexpr size_t WS_WIN = 11 * MiB;
constexpr size_t WS_WS5 = 20 * MiB;
constexpr size_t WS_WLRU = 22 * MiB;
constexpr size_t WS_WO = 24 * MiB;
constexpr size_t WS_LP = 26 * MiB, WS_LH = 28 * MiB, WS_LHIN = 30 * MiB;
constexpr size_t WS_AG = 32 * MiB;
constexpr size_t WS_SLOC = 80 * MiB;
constexpr size_t WS_H = 112 * MiB;
constexpr size_t WS_XL = 176 * MiB;
constexpr size_t WS_GL = 240 * MiB;
constexpr size_t WS_GA = 304 * MiB, WS_GB = 336 * MiB;
constexpr size_t WS_GY = 368 * MiB;
constexpr size_t WS_D8 = 336 * MiB, WS_DSC = 80 * MiB;
constexpr size_t WS_WGU = 400 * MiB;
constexpr size_t WS_WD = 464 * MiB;
constexpr size_t WS_H2 = 432 * MiB;
constexpr size_t WS_ACT = 96 * MiB;
constexpr size_t WS_YS = 168 * MiB;
constexpr size_t WS_LTOK = 480 * MiB, WS_LW = 484 * MiB;
constexpr size_t WS_TOKE = 488 * MiB, WS_TOKR = WS_TOKE + 262144;
constexpr size_t WS_END = 496 * MiB;
static_assert(WS_YS + (size_t)MAXSLOT * 1024 * 2 <= WS_LTOK && WS_ACT + (size_t)MAXSLOT * 512 * 2 <= WS_YS && WS_TOKR + 262144 <= WS_END && WS_WGU + (size_t)32 * 1024 * 1024 <= WS_H2 && WS_H2 + (size_t)T * 1024 <= WS_WD && WS_WD + (size_t)32 * 1024 * 512 <= WS_LTOK && WS_GY + (size_t)T * 512 * 2 <= WS_WGU && WS_WD + (size_t)32 * 1024 * 512 * 2 <= WS_END, "d_ws map");
constexpr int CW_BAR = 4096;
constexpr int CW_LB = 4096 + 2 * 3456;
constexpr int CW_CNT = 16384;

constexpr int RING_BYTES = 131072;
constexpr int TOKL_OFF = RING_BYTES, SCLL_OFF = TOKL_OFF + MAXU * 256 * 4, MISC_OFF = SCLL_OFF + MAXU * 256 * 4;
constexpr int SCL2_OFF = MISC_OFF + 1024;
constexpr int LDS_BYTES = SCL2_OFF + MAXU * 256 * 4;

#define GAS __attribute__((address_space(1)))
#define LAS __attribute__((address_space(3)))
typedef unsigned short bf16;
typedef unsigned v4u __attribute__((ext_vector_type(4)));
typedef unsigned v2u __attribute__((ext_vector_type(2)));
typedef float f32x4 __attribute__((ext_vector_type(4)));
typedef int i32x4 __attribute__((ext_vector_type(4)));
typedef short bf16x8 __attribute__((ext_vector_type(8)));
#define LDS_WAIT() asm volatile("s_waitcnt lgkmcnt(0)" ::: "memory")
#define VM_WAIT() asm volatile("s_waitcnt vmcnt(0)" ::: "memory")
__device__ __forceinline__ unsigned pk2(float lo, float hi) { unsigned r; asm volatile("v_cvt_pk_bf16_f32 %0, %1, %2" : "=v"(r) : "v"(lo), "v"(hi)); return r; }
__device__ __forceinline__ unsigned f2bf(float f) { return pk2(f, 0.f) & 0xffffu; }
__device__ __forceinline__ float bf2f(unsigned h) { return __builtin_bit_cast(float, h << 16); }
__device__ __forceinline__ float bflo(unsigned w) { return __builtin_bit_cast(float, w << 16); }
__device__ __forceinline__ float bfhi(unsigned w) { return __builtin_bit_cast(float, w & 0xffff0000u); }
__device__ __forceinline__ float fsigmoid(float x) { return __builtin_amdgcn_rcpf(1.0f + __builtin_amdgcn_exp2f(-1.44269504f * x)); }
__device__ __forceinline__ float gelu_t(float x) { const float u = x * (0.7978845608f + 0.0356774081f * x * x); return x * __builtin_amdgcn_rcpf(1.0f + __builtin_amdgcn_exp2f(-2.88539008f * u)); }
__device__ __forceinline__ unsigned pk_fp8x4(float a, float b, float c, float d) { int w = 0; w = __builtin_amdgcn_cvt_pk_fp8_f32(a, b, w, false); w = __builtin_amdgcn_cvt_pk_fp8_f32(c, d, w, true); return (unsigned)w; }
__device__ __forceinline__ unsigned pk4_rne(float a, float b, float c, float d) {
    const float M = 12582912.0f;
    const unsigned ta = __builtin_bit_cast(unsigned, a + M), tb = __builtin_bit_cast(unsigned, b + M), tc = __builtin_bit_cast(unsigned, c + M), td = __builtin_bit_cast(unsigned, d + M);
    return __builtin_amdgcn_perm(__builtin_amdgcn_perm(td, tc, 0x0c0c0400u), __builtin_amdgcn_perm(tb, ta, 0x0c0c0400u), 0x05040100u);
}
__device__ __forceinline__ v4u widen16(v2u a, v2u b) {
    const auto rx = __builtin_amdgcn_permlane16_swap(a.x, b.x, false, false), ry = __builtin_amdgcn_permlane16_swap(a.y, b.y, false, false);
    return (v4u){rx[0], ry[0], rx[1], ry[1]};
}
__device__ __forceinline__ float wave_sum(float v) {
#pragma unroll
    for (int o = 1; o < 64; o <<= 1) v += __shfl_xor(v, o);
    return v;
}

#define XB_TMO      128
#define XB_XCNT(j)  (256  + 64 * (j))
#define XB_XSUB(j)  (1280 + 64 * (j))
#define XB_XGEN(j)  (2304 + 64 * (j))
#define XB_TOP      3328
#define XB_TOPGEN   3392
#define XCD_BAR_WORDS 3456
#define XB_SPIN_CAP (1u << 18)
__device__ __forceinline__ unsigned xb_ld(unsigned* p)              { return __hip_atomic_load(p, __ATOMIC_RELAXED, __HIP_MEMORY_SCOPE_AGENT); }
__device__ __forceinline__ unsigned xb_add(unsigned* p, unsigned v) { return __hip_atomic_fetch_add(p, v, __ATOMIC_RELAXED, __HIP_MEMORY_SCOPE_AGENT); }
__device__ __forceinline__ unsigned xb_xcc_id() { return (unsigned)__builtin_amdgcn_s_getreg((3 << 11) | 20) & 0xFu; }
#define XB_SPIN(cond, bar) do { unsigned _sp = 0; while (cond) { __builtin_amdgcn_s_sleep(1); \
    if ((++_sp & 255u) == 0u) { if (xb_ld(&(bar)[XB_TMO])) break; if (_sp > XB_SPIN_CAP) { atomicAdd(&(bar)[XB_TMO], 1u); break; } } } } while (0)
struct XcdBarrier { unsigned* bar; unsigned x; volatile LAS unsigned* st; };
__device__ __forceinline__ XcdBarrier xcd_barrier_post(unsigned* bar, volatile LAS unsigned* st) {
    XcdBarrier b; b.bar = bar; b.x = xb_xcc_id(); b.st = st;
    if (threadIdx.x == 0) (void)xb_add(&bar[XB_XCNT(b.x)], 1u);
    return b;
}
__device__ __forceinline__ void xcd_barrier_complete(unsigned* bar, unsigned x, unsigned& nloc, unsigned& nx) {
    const unsigned G = gridDim.x * gridDim.y * gridDim.z;
    unsigned sum, cnt, mine, sp = 0u;
    for (;;) {
        sum = 0u; cnt = 0u; mine = 0u;
#pragma unroll
        for (unsigned j = 0; j < 16; ++j) { const unsigned c = xb_ld(&bar[XB_XCNT(j)]); sum += c; cnt += (c > 0u) ? 1u : 0u; mine = (j == x) ? c : mine; }
        if (sum == G) break;
        __builtin_amdgcn_s_sleep(1);
        if ((++sp & 255u) == 0u) { if (xb_ld(&bar[XB_TMO])) break; if (sp > XB_SPIN_CAP) { atomicAdd(&bar[XB_TMO], 1u); break; } }
    }
    nloc = mine > 0u ? mine : 1u; nx = cnt > 0u ? cnt : 1u;
}
__device__ __forceinline__ void xcd_barrier(const XcdBarrier& b) {
    asm volatile("s_waitcnt vmcnt(0)" ::: "memory");
    __syncthreads();
    if (threadIdx.x == 0) {
        unsigned* bar = b.bar;
        __builtin_amdgcn_s_waitcnt(0);
        unsigned nloc = b.st[0], nx = b.st[1];
        if (nloc == 0u) { xcd_barrier_complete(bar, b.x, nloc, nx); b.st[0] = nloc; b.st[1] = nx; }
        const unsigned old = xb_add(&bar[XB_XSUB(b.x)], 1u);
        const unsigned gen = old / nloc;
        if (old + 1u == (gen + 1u) * nloc) {
            __builtin_amdgcn_fence(__ATOMIC_RELEASE, "agent");
            asm volatile("s_waitcnt vmcnt(0)" ::: "memory");
            const unsigned og = xb_add(&bar[XB_TOP], 1u);
            const unsigned tg = og / nx;
            if (og + 1u == (tg + 1u) * nx) xb_add(&bar[XB_TOPGEN], 1u);
            else XB_SPIN(xb_ld(&bar[XB_TOPGEN]) == tg, bar);
            __builtin_amdgcn_fence(__ATOMIC_ACQUIRE, "agent");
            xb_add(&bar[XB_XGEN(b.x)], 1u);
            asm volatile("s_waitcnt vmcnt(0)" ::: "memory");
        } else {
            XB_SPIN(xb_ld(&bar[XB_XGEN(b.x)]) == gen, bar);
            __builtin_amdgcn_fence(__ATOMIC_ACQUIRE, "agent");
            asm volatile("s_waitcnt vmcnt(0)" ::: "memory");
        }
    }
    __syncthreads();
}

#define LB_SUB(j) (64 * (j))
#define LB_GEN(j) (1024 + 64 * (j))
#define LB_CHK    2048
#define LB_BAD    2056
#define LB_LCP    2064
#define LB_P1D    2080
__device__ __forceinline__ void xcd_local_barrier(const XcdBarrier& b, unsigned* lb, unsigned* pub_release = nullptr, unsigned* pub_plain = nullptr) {
    asm volatile("s_waitcnt vmcnt(0)" ::: "memory");
    __syncthreads();
    if (threadIdx.x == 0) {
        __builtin_amdgcn_s_waitcnt(0);
        const unsigned nloc = b.st[0];
        const unsigned old = xb_add(&lb[LB_SUB(b.x)], 1u);
        const unsigned gen = old / nloc;
        if (old + 1u == (gen + 1u) * nloc) {
            if (pub_release) { __builtin_amdgcn_fence(__ATOMIC_RELEASE, "agent"); asm volatile("s_waitcnt vmcnt(0)" ::: "memory"); xb_add(pub_release, 1u); }
            if (pub_plain) xb_add(pub_plain, 1u);
            xb_add(&lb[LB_GEN(b.x)], 1u); }
        else XB_SPIN(xb_ld(&lb[LB_GEN(b.x)]) == gen, b.bar);
        __builtin_amdgcn_fence(__ATOMIC_ACQUIRE, "agent");
        asm volatile("s_waitcnt vmcnt(0)" ::: "memory");
    }
    __syncthreads();
}

struct Frame {
    LAS unsigned char* lds;
    volatile LAS unsigned* MISC;
    unsigned* ctl;
    int tid, lane, wave, vcu, G;
    const float* const* in;
    unsigned char* ws; float* out;
};

using pg8::Unit;
struct DenseOrder {
    static constexpr bool GATHER = false, HETERO = false;
    const char* A0; const char* B0; int lda, ldb, nM, nN, nwg, G, c;
    __device__ __forceinline__ void init(const void* A, const void* B, int lda_, int ldb_, int M, int N, int G_, int c_) { A0 = (const char*)A; B0 = (const char*)B; lda = lda_; ldb = ldb_; nM = M / 256; nN = N / 256; nwg = nM * nN; G = G_; c = c_; }
    __device__ __forceinline__ bool next(int i, Unit& u) const {
        const long L = (long)i * G + c; if (L >= nwg) return false;
        int wgid = (int)L; { const int q = nwg / 8, r = nwg % 8, xcd = wgid % 8, off = wgid / 8; wgid = (xcd < r ? xcd * (q + 1) : r * (q + 1) + (xcd - r) * q) + off; }
        const int nig = 8 * nN, gid = wgid / nig, fm = gid * 8, gsz = (nM - fm) < 8 ? (nM - fm) : 8;
        u.pm = fm + ((wgid % nig) % gsz); u.pn = (wgid % nig) / gsz; u.aux = i & 1;
        u.A = A0 + (size_t)u.pm * 256 * lda * 2; u.B = B0 + (size_t)u.pn * 256 * ldb * 2; return true;
    }
    __device__ __forceinline__ void a_offsets(const Unit&, const int (&R)[2], const int (&C)[2], unsigned (&v)[4]) const {
#pragma unroll
        for (int i = 0; i < 2; ++i) { v[i] = (unsigned)(R[i] * lda + C[i]) * 2u; v[2 + i] = (unsigned)((128 + R[i]) * lda + C[i]) * 2u; }
    }
};
struct S5One {
    static constexpr bool GATHER = false, HETERO = false;
    const char* A0; const char* B0; size_t sA, sB; int lda, g, mt;
    __device__ __forceinline__ bool next(int i, Unit& u) const {
        if (i > 0) return false;
        u.pm = mt; u.pn = 0; u.aux = g; u.A = A0 + (size_t)g * sA + (size_t)mt * 256 * lda * 2; u.B = B0 + (size_t)g * sB; return true;
    }
    __device__ __forceinline__ void a_offsets(const Unit&, const int (&R)[2], const int (&C)[2], unsigned (&v)[4]) const {
#pragma unroll
        for (int i = 0; i < 2; ++i) { v[i] = (unsigned)(R[i] * lda + C[i]) * 2u; v[2 + i] = (unsigned)((128 + R[i]) * lda + C[i]) * 2u; }
    }
};
struct YaYbOrder {
    static constexpr bool GATHER = false, HETERO = true;
    DenseOrder d;
    const char* GYb; const char* WS5b; const char* YLb; const char* WLb;
    __device__ __forceinline__ bool next(int i, Unit& u) const {
        const int j = i / 3, r = i - 3 * j; Unit t;
        if (!d.next(j, t)) return false;
        u.pm = t.pm; u.aux = 0;
        if (r < 2) { u.kind = 0; u.pn = 2 * t.pn + r; u.nt = S5W / 64; u.kA = 128u; u.A = GYb + (size_t)t.pm * 256 * S5W * 2; u.B = WS5b + (size_t)u.pn * 256 * S5W * 2; }
        else { u.kind = 1; u.pn = t.pn; u.nt = D / 64; u.kA = 128u; u.A = YLb + (size_t)t.pm * 256 * D * 2; u.B = WLb + (size_t)t.pn * 256 * D * 2; }
        return true;
    }
    __device__ __forceinline__ void a_offsets(const Unit& u, const int (&R)[2], const int (&C)[2], unsigned (&v)[4]) const {
#pragma unroll
        for (int i = 0; i < 2; ++i) {
            const unsigned g0 = (unsigned)(R[i] * S5W + C[i]) * 2u, g1 = (unsigned)((128 + R[i]) * S5W + C[i]) * 2u;
            const unsigned d0 = (unsigned)(R[i] * D + C[i]) * 2u, d1 = (unsigned)((128 + R[i]) * D + C[i]) * 2u;
            v[i] = u.kind ? d0 : g0; v[2 + i] = u.kind ? d1 : g1; }
    }
    __device__ __forceinline__ void b_offsets(const Unit& u, const int (&Rb)[2], const int (&C)[2], unsigned (&v)[4]) const {
        const int ldb = u.kind ? D : S5W;
#pragma unroll
        for (int i = 0; i < 2; ++i) { v[i] = (unsigned)(Rb[i] * ldb + C[i]) * 2u; v[2 + i] = (unsigned)((128 + Rb[i]) * ldb + C[i]) * 2u; }
    }
};
template <bool GATH> struct MoeOrder {
    static constexpr bool GATHER = GATH, HETERO = false;
    const char* A0; const char* B0; size_t sBe; int lda, ldb, G, c; volatile LAS unsigned* MISC; const LAS int* tokL;
    __device__ __forceinline__ bool next(int i, Unit& u) const {
        if (i >= (int)MISC[152]) return false;
        const int e = (int)MISC[136 + i], mtg = (int)MISC[96 + e] + (int)MISC[144 + i], L = i * G + c;
        u.pm = mtg; u.pn = L & 3; u.aux = i;
        u.A = GATH ? A0 : A0 + (size_t)mtg * 256 * lda * 2; u.B = B0 + (size_t)e * sBe + (size_t)u.pn * 256 * ldb * 2; return true;
    }
    __device__ __forceinline__ void a_offsets(const Unit& u, const int (&R)[2], const int (&C)[2], unsigned (&v)[4]) const {
#pragma unroll
        for (int i = 0; i < 2; ++i) {
            if constexpr (GATH) { v[i] = (unsigned)tokL[u.aux * 256 + R[i]] * (unsigned)(lda * 2) + (unsigned)C[i] * 2u; v[2 + i] = (unsigned)tokL[u.aux * 256 + 128 + R[i]] * (unsigned)(lda * 2) + (unsigned)C[i] * 2u; }
            else { v[i] = (unsigned)(R[i] * lda + C[i]) * 2u; v[2 + i] = (unsigned)((128 + R[i]) * lda + C[i]) * 2u; } }
    }
};

using pg8::cvt_pk_bf16;
template <int ACT> __device__ __forceinline__ float actf(float x) { if (ACT == 1) return gelu_t(x); if (ACT == 2) return fsigmoid(x); return x; }
__device__ __forceinline__ v4u pack8(const f32x4 a, const f32x4 b) { v4u w; w.x = cvt_pk_bf16(a[0], a[1]); w.y = cvt_pk_bf16(a[2], a[3]); w.z = cvt_pk_bf16(b[0], b[1]); w.w = cvt_pk_bf16(b[2], b[3]); return w; }

__device__ __forceinline__ void unpack_u8x8(const v2u w, float (&f)[8]) {
    const float k = 1.0f / 255.0f;
    f[0] = (float)(w.x & 0xffu) * k; f[1] = (float)((w.x >> 8) & 0xffu) * k; f[2] = (float)((w.x >> 16) & 0xffu) * k; f[3] = (float)(w.x >> 24) * k;
    f[4] = (float)(w.y & 0xffu) * k; f[5] = (float)((w.y >> 8) & 0xffu) * k; f[6] = (float)((w.y >> 16) & 0xffu) * k; f[7] = (float)(w.y >> 24) * k;
}
__device__ __forceinline__ unsigned nat_ya(int pm, int pnq, int w, int ai, int m, int bj, int lane) { return ((unsigned)(((pm * 4 + pnq) * 8 + w) * 16 + (ai * 8 + m * 2 + bj)) * 64u + (unsigned)lane) * 16u; }
__device__ __forceinline__ unsigned nat_ga(int pm, int pnq, int w, int ai, int m, int bj, int lane) { return ((unsigned)(((pm * 4 + pnq) * 8 + w) * 16 + (bj * 8 + ai * 4 + m)) * 64u + (unsigned)lane) * 8u; }
__device__ __forceinline__ unsigned nat_gb(int pm, int pnq, int w, int ai, int m, int lane) { return ((unsigned)(((pm * 4 + pnq) * 8 + w) * 8 + (ai * 4 + m)) * 64u + (unsigned)lane) * 16u; }
struct EpiInProj {
    static constexpr bool PERM = true, ACC_INIT = true, B16 = false, I8 = true;
    bf16 *AG, *XL, *GL, *GA, *GB; const float* HS; const float* WSC; LAS unsigned char* sl;
    __device__ __forceinline__ void init(i32x4 (&acc)[2][2][4][2], const Unit& u, int wr, int wc, int fr, int fq) const {
#pragma unroll
        for (int a = 0; a < 2; ++a)
#pragma unroll
            for (int b = 0; b < 2; ++b)
#pragma unroll
                for (int m = 0; m < 4; ++m)
#pragma unroll
                    for (int n = 0; n < 2; ++n) acc[a][b][m][n] = i32x4{};
        const int w = wr * 4 + wc, lane = fq * 16 + fr;
        const int pm = __builtin_amdgcn_readfirstlane(u.pm), pn = __builtin_amdgcn_readfirstlane(u.pn), par = __builtin_amdgcn_readfirstlane(u.aux);
        const float* src = w < 4 ? HS + pm * 256 + w * 64 : WSC + pn * 256 + (w - 4) * 64;
        __builtin_amdgcn_global_load_lds((const unsigned*)(src + lane), (LAS unsigned*)(sl + par * 2048 + w * 256), 4, 0, 0);
    }
    template <int MODE  > __device__ __forceinline__ void tile(const i32x4 (&acc)[2][2][4][2], const Unit& u, bf16* base, int colbase, bool s5, int wr, int wc, int fr, int fq) const {
        const LAS float* sb = (const LAS float*)(sl + __builtin_amdgcn_readfirstlane(u.aux) * 2048);
        f32x4 wsv[2][2];
#pragma unroll
        for (int bj = 0; bj < 2; ++bj)
#pragma unroll
            for (int n = 0; n < 2; ++n) wsv[bj][n] = *(const LAS f32x4*)(sb + 256 + bj * 128 + wc * 32 + 8 * fq + 4 * n);
#pragma unroll
        for (int ai = 0; ai < 2; ++ai)
#pragma unroll
            for (int m = 0; m < 4; ++m) { const int rl = ai * 128 + wr * 64 + m * 16 + fr, r = u.pm * 256 + rl; const float hs = sb[rl]; v2u gpair = {0u, 0u};
#pragma unroll
                for (int bj = 0; bj < 2; ++bj) { const int cl = colbase + bj * 128 + wc * 32 + 8 * fq;
                    f32x4 v0 = __builtin_convertvector(acc[ai][bj][m][0], f32x4) * (wsv[bj][0] * hs), v1 = __builtin_convertvector(acc[ai][bj][m][1], f32x4) * (wsv[bj][1] * hs);
                    if (MODE == 2) {
                        v2u w8; w8.x = pk4_rne(fsigmoid(v0[0]) * 255.0f, fsigmoid(v0[1]) * 255.0f, fsigmoid(v0[2]) * 255.0f, fsigmoid(v0[3]) * 255.0f);
                        w8.y = pk4_rne(fsigmoid(v1[0]) * 255.0f, fsigmoid(v1[1]) * 255.0f, fsigmoid(v1[2]) * 255.0f, fsigmoid(v1[3]) * 255.0f);
                        if (s5) { if (bj == 0) gpair = w8; else __builtin_nontemporal_store((v4u){gpair.x, gpair.y, w8.x, w8.y}, (v4u*)((unsigned char*)base + nat_gb(u.pm, colbase >> 8, wr * 4 + wc, ai, m, fq * 16 + fr))); }
                        else __builtin_nontemporal_store(w8, (v2u*)((unsigned char*)base + nat_ga(u.pm, colbase >> 8, wr * 4 + wc, ai, m, bj, fq * 16 + fr)));
                    } else {
                        if (MODE == 1) {
#pragma unroll
                            for (int j = 0; j < 4; ++j) { v0[j] = gelu_t(v0[j]); v1[j] = gelu_t(v1[j]); } }
                        const v4u w = pack8(v0, v1);
                        const int g = cl >> 4, cp = cl & 15, b = r >> 12, l = r & 4095, n = b * S5NCH + (l >> 4), s = l & 15;
                        const size_t off = s5 ? ((size_t)(g * S5N + n) * S5K + S5Q + s * 16 + cp) : ((size_t)r * 1024 + cl);
                        *(v4u*)(base + off) = w; } }
                asm volatile("" ::: "memory"); }
    }
    __device__ __forceinline__ void operator()(const i32x4 (&acc)[2][2][4][2], const Unit& u, int wr, int wc, int fr, int fq) const {
        const int pn = u.pn, reg = pn < 2 ? 0 : ((pn - 2) >> 2) + 1;
        const int colbase = reg == 0 ? pn * 256 : ((pn - 2) & 3) * 256;
        if (reg < 2) tile<0>(acc, u, reg == 0 ? AG : XL, colbase, reg == 0, wr, wc, fr, fq);
        else if (reg == 2) tile<1>(acc, u, GL, colbase, false, wr, wc, fr, fq);
        else tile<2>(acc, u, reg == 3 ? GA : GB, colbase, reg == 4, wr, wc, fr, fq);
    }
};
struct EpiS5State {
    static constexpr bool PERM = false, ACC_INIT = false, B16 = false;
    LAS float* SL;
    __device__ __forceinline__ void operator()(const f32x4 (&acc)[2][2][4][2], const Unit& u, int wr, int wc, int fr, int fq) const {
#pragma unroll
        for (int ai = 0; ai < 2; ++ai)
#pragma unroll
            for (int m = 0; m < 4; ++m) { LAS float* rowp = SL + (ai * 128 + wr * 64 + m * 16 + fr) * S5Q + wc * 32 + 4 * fq;
#pragma unroll
                for (int n = 0; n < 2; ++n) *(LAS f32x4*)(rowp + n * 16) = acc[ai][0][m][n]; }
    }
};
struct EpiS5Out {
    static constexpr bool PERM = true, ACC_INIT = false, B16 = false;
    bf16* GY;
    __device__ __forceinline__ void operator()(const f32x4 (&acc)[2][2][4][2], const Unit& u, int wr, int wc, int fr, int fq) const {
#pragma unroll
        for (int ai = 0; ai < 2; ++ai)
#pragma unroll
            for (int m = 0; m < 4; ++m) { const int nr = u.pm * 256 + ai * 128 + wr * 64 + m * 16 + fr, b = nr >> 8, j16 = nr & 255;
#pragma unroll
                for (int bj = 0; bj < 2; ++bj) { const int cc = bj * 128 + wc * 32 + 8 * fq, t = cc >> 4, c0 = cc & 15;
                    f32x4 v0 = acc[ai][bj][m][0], v1 = acc[ai][bj][m][1];
#pragma unroll
                    for (int j = 0; j < 4; ++j) { v0[j] = gelu_t(v0[j]); v1[j] = gelu_t(v1[j]); }
                    *(v4u*)(GY + (size_t)(b * SEQ + j16 * 16 + t) * S5W + u.aux * 16 + c0) = pack8(v0, v1); }
                asm volatile("" ::: "memory"); }
    }
};
struct EpiYa {
    static constexpr bool PERM = true, ACC_INIT = false, B16 = false;
    const bf16* GA; bf16* YA;
    __device__ __forceinline__ void operator()(const f32x4 (&acc)[2][2][4][2], const Unit& u, int wr, int wc, int fr, int fq) const {
        const int pnq = u.pn >> 1, r = u.pn & 1, w = wr * 4 + wc, lane = fq * 16 + fr;
        v2u gav[2][4];
#pragma unroll
        for (int ai = 0; ai < 2; ++ai)
#pragma unroll
            for (int m = 0; m < 4; ++m) gav[ai][m] = __builtin_nontemporal_load((const v2u*)((const unsigned char*)GA + nat_ga(u.pm, pnq, w, ai, m, r, lane)));
        asm volatile("" ::: "memory");
#pragma unroll
        for (int ai = 0; ai < 2; ++ai)
#pragma unroll
            for (int m = 0; m < 4; ++m) { float gaf[8]; unpack_u8x8(gav[ai][m], gaf);
                f32x4 o0, o1;
#pragma unroll
                for (int j = 0; j < 4; ++j) { o0[j] = gaf[j] * acc[ai][0][m][0][j] * fsigmoid(acc[ai][1][m][0][j]); o1[j] = gaf[4 + j] * acc[ai][0][m][1][j] * fsigmoid(acc[ai][1][m][1][j]); }
                *(v4u*)((unsigned char*)YA + nat_ya(u.pm, pnq, w, ai, m, r, lane)) = pack8(o0, o1); }
    }
};
struct EpiYb {
    static constexpr bool PERM = true, ACC_INIT = false, B16 = false;
    const bf16* YA; const bf16* GB; bf16* MIX;
    __device__ __forceinline__ void operator()(const f32x4 (&acc)[2][2][4][2], const Unit& u, int wr, int wc, int fr, int fq) const {
        const size_t off0 = (size_t)(u.pm * 256 + wr * 64 + fr) * 1024 + u.pn * 256 + wc * 32 + 8 * fq;
        const int w = wr * 4 + wc, lane = fq * 16 + fr;
        v4u gb[2][4];
#pragma unroll
        for (int ai = 0; ai < 2; ++ai)
#pragma unroll
            for (int m = 0; m < 4; ++m) gb[ai][m] = __builtin_nontemporal_load((const v4u*)((const unsigned char*)GB + nat_gb(u.pm, u.pn, w, ai, m, lane)));
        v4u ya[2][2][2];
#define YB_LOAD(buf, grp) do { _Pragma("unroll") for (int mm = 0; mm < 2; ++mm) { _Pragma("unroll") for (int bj = 0; bj < 2; ++bj) { \
            ya[buf][mm][bj] = *(const v4u*)((const unsigned char*)YA + nat_ya(u.pm, u.pn, w, (grp) >> 1, 2 * ((grp) & 1) + mm, bj, lane)); } } } while (0)
        YB_LOAD(0, 0);
#pragma unroll
        for (int grp = 0; grp < 4; ++grp) { const int buf = grp & 1, ai = grp >> 1;
            if (grp < 3) YB_LOAD(buf ^ 1, grp + 1);
            asm volatile("" ::: "memory");
#pragma unroll
            for (int mm = 0; mm < 2; ++mm) { const int m = 2 * (grp & 1) + mm;
#pragma unroll
                for (int bj = 0; bj < 2; ++bj) { const v4u y = ya[buf][mm][bj];
                    const float yaf[8] = {bflo(y.x), bfhi(y.x), bflo(y.y), bfhi(y.y), bflo(y.z), bfhi(y.z), bflo(y.w), bfhi(y.w)};
                    float gbf[8]; unpack_u8x8(bj ? (v2u){gb[ai][m].z, gb[ai][m].w} : (v2u){gb[ai][m].x, gb[ai][m].y}, gbf);
                    f32x4 o0, o1;
#pragma unroll
                    for (int j = 0; j < 4; ++j) { o0[j] = yaf[j] + gbf[j] * acc[ai][bj][m][0][j]; o1[j] = yaf[4 + j] + gbf[4 + j] * acc[ai][bj][m][1][j]; }
                    *(v4u*)(MIX + off0 + (size_t)(ai * 128 + m * 16) * 1024 + bj * 128) = pack8(o0, o1); } }
        }
#undef YB_LOAD
    }
};
struct EpiYaYb {
    static constexpr bool PERM = true, ACC_INIT = false, B16 = false;
    EpiYa a; EpiYb b;
    __device__ __forceinline__ void operator()(const f32x4 (&acc)[2][2][4][2], const Unit& u, int wr, int wc, int fr, int fq) const {
        if (__builtin_amdgcn_readfirstlane(u.kind) == 0) a(acc, u, wr, wc, fr, fq); else b(acc, u, wr, wc, fr, fq);
    }
};
struct EpiWo {
    static constexpr bool PERM = false, ACC_INIT = true, B16 = false;
    const float* X; float* O;
    __device__ __forceinline__ void init(f32x4 (&acc)[2][2][4][2], const Unit& u, int wr, int wc, int fr, int fq) const {
        const size_t off0 = (size_t)(u.pm * 256 + wr * 64 + fr) * 1024 + u.pn * 256 + wc * 32 + 4 * fq;
#pragma unroll
        for (int ai = 0; ai < 2; ++ai)
#pragma unroll
            for (int m = 0; m < 4; ++m)
#pragma unroll
                for (int bj = 0; bj < 2; ++bj)
#pragma unroll
                    for (int n = 0; n < 2; ++n) acc[ai][bj][m][n] = __builtin_nontemporal_load((const f32x4*)(X + off0 + (size_t)(ai * 128 + m * 16) * 1024 + bj * 128 + n * 16));
    }
    __device__ __forceinline__ void operator()(const f32x4 (&acc)[2][2][4][2], const Unit& u, int wr, int wc, int fr, int fq) const {
        const size_t off0 = (size_t)(u.pm * 256 + wr * 64 + fr) * 1024 + u.pn * 256 + wc * 32 + 4 * fq;
#pragma unroll
        for (int ai = 0; ai < 2; ++ai)
#pragma unroll
            for (int m = 0; m < 4; ++m)
#pragma unroll
                for (int bj = 0; bj < 2; ++bj)
#pragma unroll
                    for (int n = 0; n < 2; ++n) *(f32x4*)(O + off0 + (size_t)(ai * 128 + m * 16) * 1024 + bj * 128 + n * 16) = acc[ai][bj][m][n];
    }
};
struct EpiGU {
    static constexpr bool PERM = true, ACC_INIT = false, B16 = false, F8 = true;
    unsigned char* ACT; const LAS float* sclL;
    __device__ __forceinline__ void operator()(const f32x4 (&acc)[2][2][4][2], const Unit& u, int wr, int wc, int fr, int fq) const {
        v2u aprev = {0u, 0u};
#pragma unroll
        for (int ai = 0; ai < 2; ++ai)
#pragma unroll
            for (int m = 0; m < 4; ++m) { const int rl = ai * 128 + wr * 64 + m * 16 + fr; const float sc = sclL[u.aux * 256 + rl] * (1.0f / 32.0f);
                f32x4 o0, o1;
#pragma unroll
                for (int j = 0; j < 4; ++j) { const float g0 = acc[ai][0][m][0][j] * sc, g1 = acc[ai][0][m][1][j] * sc;
                    o0[j] = g0 * fsigmoid(g0) * (acc[ai][1][m][0][j] * sc); o1[j] = g1 * fsigmoid(g1) * (acc[ai][1][m][1][j] * sc); }
#pragma unroll
                for (int j = 0; j < 4; ++j) { o0[j] = __builtin_amdgcn_fmed3f(o0[j], -448.0f, 448.0f); o1[j] = __builtin_amdgcn_fmed3f(o1[j], -448.0f, 448.0f); }
                v2u a8; a8.x = pk_fp8x4(o0[0], o0[1], o0[2], o0[3]); a8.y = pk_fp8x4(o1[0], o1[1], o1[2], o1[3]);
                if ((m & 1) == 0) aprev = a8;
                else *(v4u*)(ACT + (size_t)(u.pm * 256 + ai * 128 + wr * 64 + (m - 1 + (fq & 1)) * 16 + fr) * DEXP + u.pn * 128 + wc * 32 + 8 * (fq & ~1)) = widen16(aprev, a8); }
    }
};
struct EpiDown {
    static constexpr bool PERM = true, ACC_INIT = false, B16 = false;
    bf16* YS; const LAS float* sclL;
    __device__ __forceinline__ void operator()(const f32x4 (&acc)[2][2][4][2], const Unit& u, int wr, int wc, int fr, int fq) const {
#pragma unroll
        for (int ai = 0; ai < 2; ++ai)
#pragma unroll
            for (int m = 0; m < 4; ++m) { const int rl = ai * 128 + wr * 64 + m * 16 + fr; const float sc = sclL[u.aux * 256 + rl];
#pragma unroll
                for (int bj = 0; bj < 2; ++bj)
                    *(v4u*)(YS + (size_t)(u.pm * 256 + rl) * 1024 + u.pn * 256 + bj * 128 + wc * 32 + 8 * fq) = pack8(acc[ai][bj][m][0] * sc, acc[ai][bj][m][1] * sc); }
    }
};

template <bool SCALED> struct EpiQ8 {
    static constexpr bool PERM = true, ACC_INIT = false, B16 = true, F8 = SCALED;
    unsigned char* YS8; float* YSC; const LAS float* sclL;
    __device__ __forceinline__ void operator()(const f32x4 (&acc)[2][2][4][2], const Unit& u, int wr, int wc, int fr, int fq) const {
        float scs[2][4];
#pragma unroll
        for (int ai = 0; ai < 2; ++ai)
#pragma unroll
            for (int m = 0; m < 4; ++m) { const int rl = ai * 128 + wr * 64 + m * 16 + fr; const float sc = SCALED ? sclL[u.aux * 256 + rl] * (1.0f / 32.0f) : 1.0f;
                float v[16]; float amax = 0.f;
#pragma unroll
                for (int bj = 0; bj < 2; ++bj)
#pragma unroll
                    for (int n = 0; n < 2; ++n)
#pragma unroll
                        for (int j = 0; j < 4; ++j) { const float x = acc[ai][bj][m][n][j] * sc; v[bj * 8 + n * 4 + j] = x; amax = fmaxf(amax, fabsf(x)); }
                amax = fmaxf(amax, __shfl_xor(amax, 16)); amax = fmaxf(amax, __shfl_xor(amax, 32));
                const float inv = amax > 0.f ? 127.0f / amax : 0.f;
                scs[ai][m] = amax * (1.0f / 127.0f);
                v4u w;
#pragma unroll
                for (int d = 0; d < 4; ++d) w[d] = pk4_rne(v[4 * d] * inv, v[4 * d + 1] * inv, v[4 * d + 2] * inv, v[4 * d + 3] * inv);
                *(v4u*)(YS8 + (size_t)(u.pm * 256 + rl) * 1024 + u.pn * 256 + wc * 64 + fq * 16) = w; }
#pragma unroll
        for (int ai = 0; ai < 2; ++ai) { const float sv = fq == 0 ? scs[ai][0] : fq == 1 ? scs[ai][1] : fq == 2 ? scs[ai][2] : scs[ai][3];
            YSC[(size_t)(u.pm * 256 + ai * 128 + wr * 64 + fq * 16 + fr) * 16 + wc * 4 + u.pn] = sv; }
    }
};

struct TItem { const float* W; int N; bf16* WT; int ldk, k0, n0, drow0; };
__device__ __forceinline__ void transpose_load(const TItem& it, f32x4 (&tv)[8], int lane) {
#pragma unroll
    for (int i = 0; i < 8; ++i) tv[i] = __builtin_nontemporal_load((const f32x4*)(it.W + (size_t)(it.k0 + 8 * i + (lane >> 3)) * it.N + it.n0 + 4 * (lane & 7)));
}
template <bool NT = false> __device__ __forceinline__ void transpose_store(const TItem& it, const f32x4 (&tv)[8], LAS float* scr, int lane) {
#pragma unroll
    for (int i = 0; i < 8; ++i) { LAS float* d = scr + (8 * i + (lane >> 3)) * 33 + 4 * (lane & 7); d[0] = tv[i].x; d[1] = tv[i].y; d[2] = tv[i].z; d[3] = tv[i].w; }
    LDS_WAIT(); asm volatile("" ::: "memory");
    const int c = lane & 7;
#pragma unroll
    for (int j = 0; j < 4; ++j) { const int n = (lane >> 3) + 8 * j; const LAS float* s = scr + (8 * c) * 33 + n;
        v4u o; o.x = pk2(s[0 * 33], s[1 * 33]); o.y = pk2(s[2 * 33], s[3 * 33]); o.z = pk2(s[4 * 33], s[5 * 33]); o.w = pk2(s[6 * 33], s[7 * 33]);
        if (NT) __builtin_nontemporal_store(o, (v4u*)(it.WT + (size_t)(it.drow0 + n) * it.ldk + it.k0 + 8 * c)); else *(v4u*)(it.WT + (size_t)(it.drow0 + n) * it.ldk + it.k0 + 8 * c) = o; }
    LDS_WAIT(); asm volatile("" ::: "memory");
}
__device__ __forceinline__ void transpose_store_fp8(const TItem& it, const f32x4 (&tv)[8], LAS float* scr, int lane) {
#pragma unroll
    for (int i = 0; i < 8; ++i) { LAS float* d = scr + (8 * i + (lane >> 3)) * 33 + 4 * (lane & 7); d[0] = tv[i].x; d[1] = tv[i].y; d[2] = tv[i].z; d[3] = tv[i].w; }
    LDS_WAIT(); asm volatile("" ::: "memory");
    const int c = lane & 7;
#pragma unroll
    for (int j = 0; j < 4; ++j) { const int n = (lane >> 3) + 8 * j; const LAS float* s = scr + (8 * c) * 33 + n;
        v2u o; o.x = pk_fp8x4(s[0 * 33] * 32.f, s[1 * 33] * 32.f, s[2 * 33] * 32.f, s[3 * 33] * 32.f); o.y = pk_fp8x4(s[4 * 33] * 32.f, s[5 * 33] * 32.f, s[6 * 33] * 32.f, s[7 * 33] * 32.f);
        __builtin_nontemporal_store(o, (v2u*)((unsigned char*)it.WT + (size_t)(it.drow0 + n) * it.ldk + it.k0 + 8 * c)); }
    LDS_WAIT(); asm volatile("" ::: "memory");
}
__device__ __forceinline__ int ileave_row(int n, int half) { return 256 * (n >> 7) + 128 * half + (n & 127); }

template <int NR> __device__ __forceinline__ void rms_rows_to_bf16(const float* x0, const float* gain, bf16* o0, size_t rstride, int lane) {
    f32x4 v[NR][4];
#pragma unroll
    for (int r = 0; r < NR; ++r) { const f32x4* xr = (const f32x4*)(x0 + r * rstride) + lane;
#pragma unroll
        for (int j = 0; j < 4; ++j) v[r][j] = __builtin_nontemporal_load(xr + 64 * j); }
    asm volatile("" ::: "memory");
    const f32x4* gr = (const f32x4*)gain + lane;
    f32x4 g[4];
#pragma unroll
    for (int j = 0; j < 4; ++j) g[j] = gr[64 * j];
#pragma unroll
    for (int r = 0; r < NR; ++r) { float s = 0.f;
#pragma unroll
        for (int j = 0; j < 4; ++j) s += (v[r][j].x * v[r][j].x + v[r][j].y * v[r][j].y) + (v[r][j].z * v[r][j].z + v[r][j].w * v[r][j].w);
        const float rstd = 1.0f / sqrtf(wave_sum(s) * (1.f / D) + RMS_EPS);
        unsigned long long* o8 = (unsigned long long*)(o0 + r * rstride) + lane;
#pragma unroll
        for (int j = 0; j < 4; ++j) o8[64 * j] = (unsigned long long)pk2(v[r][j].x * rstd * g[j].x, v[r][j].y * rstd * g[j].y) | ((unsigned long long)pk2(v[r][j].z * rstd * g[j].z, v[r][j].w * rstd * g[j].w) << 32); }
}

__device__ __forceinline__ float wave_max(float v) {
#pragma unroll
    for (int o = 1; o < 64; o <<= 1) v = fmaxf(v, __shfl_xor(v, o));
    return v;
}
__device__ __forceinline__ unsigned pk_i8(float a, float b, float c, float d) { return pk4_rne(a, b, c, d); }
template <int NR> __device__ __forceinline__ void rms_rows_to_i8(const float* x0, const float* gain, unsigned char* o0, float* hs, int lane) {
    f32x4 v[NR][4];
#pragma unroll
    for (int r = 0; r < NR; ++r) { const f32x4* xr = (const f32x4*)(x0 + (size_t)r * D) + lane;
#pragma unroll
        for (int j = 0; j < 4; ++j) v[r][j] = __builtin_nontemporal_load(xr + 64 * j); }
    asm volatile("" ::: "memory");
    const f32x4* gr = (const f32x4*)gain + lane;
    f32x4 g[4];
#pragma unroll
    for (int j = 0; j < 4; ++j) g[j] = gr[64 * j];
#pragma unroll
    for (int r = 0; r < NR; ++r) { float s = 0.f;
#pragma unroll
        for (int j = 0; j < 4; ++j) s += (v[r][j].x * v[r][j].x + v[r][j].y * v[r][j].y) + (v[r][j].z * v[r][j].z + v[r][j].w * v[r][j].w);
        const float rstd = 1.0f / sqrtf(wave_sum(s) * (1.f / D) + RMS_EPS);
        float am = 0.f;
#pragma unroll
        for (int j = 0; j < 4; ++j) { v[r][j] = v[r][j] * rstd * g[j]; am = fmaxf(fmaxf(am, fmaxf(fabsf(v[r][j].x), fabsf(v[r][j].y))), fmaxf(fabsf(v[r][j].z), fabsf(v[r][j].w))); }
        am = fmaxf(wave_max(am), 1e-20f);
        const float inv = 127.0f / am;
        unsigned* o = (unsigned*)(o0 + (size_t)r * D) + lane;
#pragma unroll
        for (int j = 0; j < 4; ++j) o[64 * j] = pk_i8(v[r][j].x * inv, v[r][j].y * inv, v[r][j].z * inv, v[r][j].w * inv);
        if (lane == 0) hs[r] = am * (1.0f / 127.0f); }
}
__device__ __forceinline__ void win_to_i8(const Frame& F, const float* W, int nb) {
    const int lane = F.lane, w = F.wave, n0 = 32 * nb;
    f32x4 tv[2][8];
#pragma unroll
    for (int s2 = 0; s2 < 2; ++s2)
#pragma unroll
        for (int i = 0; i < 8; ++i) tv[s2][i] = __builtin_nontemporal_load((const f32x4*)(W + (size_t)(128 * w + 64 * s2 + 8 * i + (lane >> 3)) * NIN + n0 + 4 * (lane & 7)));
    asm volatile("" ::: "memory");
    f32x4 am = {0.f, 0.f, 0.f, 0.f};
#pragma unroll
    for (int s2 = 0; s2 < 2; ++s2)
#pragma unroll
        for (int i = 0; i < 8; ++i)
#pragma unroll
            for (int c = 0; c < 4; ++c) am[c] = fmaxf(am[c], fabsf(tv[s2][i][c]));
#pragma unroll
    for (int c = 0; c < 4; ++c) { am[c] = fmaxf(am[c], __shfl_xor(am[c], 8)); am[c] = fmaxf(am[c], __shfl_xor(am[c], 16)); am[c] = fmaxf(am[c], __shfl_xor(am[c], 32)); }
    LAS float* cm = (LAS float*)(F.lds + TOKL_OFF);
    if (lane < 8) *(LAS f32x4*)(cm + w * 32 + 4 * lane) = am;
    __syncthreads();
    f32x4 tot = *(const LAS f32x4*)(cm + 4 * (lane & 7));
#pragma unroll
    for (int ww = 1; ww < 8; ++ww) { const f32x4 o = *(const LAS f32x4*)(cm + ww * 32 + 4 * (lane & 7));
#pragma unroll
        for (int c = 0; c < 4; ++c) tot[c] = fmaxf(tot[c], o[c]); }
    f32x4 inv;
#pragma unroll
    for (int c = 0; c < 4; ++c) { tot[c] = fmaxf(tot[c], 1e-20f); inv[c] = 127.0f / tot[c]; }
    if (w == 0 && lane < 8) *(f32x4*)((float*)(F.ws + SM_WSC) + n0 + 4 * lane) = tot * (1.0f / 127.0f);
    LAS int* scr = (LAS int*)(F.lds + w * 16384);
    unsigned char* wt = F.ws + WS_WIN;
#pragma unroll
    for (int s2 = 0; s2 < 2; ++s2) {
#pragma unroll
        for (int i = 0; i < 8; ++i) { LAS int* d = scr + (8 * i + (lane >> 3)) * 33 + 4 * (lane & 7);
#pragma unroll
            for (int c = 0; c < 4; ++c) d[c] = (int)__builtin_rintf(tv[s2][i][c] * inv[c]); }
        LDS_WAIT(); asm volatile("" ::: "memory");
        const int n = lane & 31, kh = lane >> 5; const LAS int* sp = scr + (32 * kh) * 33 + n;
        v4u o[2];
#pragma unroll
        for (int d = 0; d < 8; ++d) o[d >> 2][d & 3] = ((unsigned)sp[(4 * d) * 33] & 255u) | (((unsigned)sp[(4 * d + 1) * 33] & 255u) << 8) | (((unsigned)sp[(4 * d + 2) * 33] & 255u) << 16) | ((unsigned)sp[(4 * d + 3) * 33] << 24);
        v4u* dst = (v4u*)(wt + (size_t)(n0 + n) * D + 128 * w + 64 * s2 + 32 * kh);
        dst[0] = o[0]; dst[1] = o[1];
        LDS_WAIT(); asm volatile("" ::: "memory");
    }
    __syncthreads();
}

__device__ __forceinline__ void s5_tables(const Frame& F, int g, const float* lam_re, const float* lam_im, const float* log_dt, const float* b_re, const float* b_im, const float* c_re, const float* c_im, const float* dsk) {
    LAS float* Cre = (LAS float*)F.lds;
    LAS float* Cim = Cre + 1024;
    LAS float* Bre = Cim + 1024;
    LAS float* Bim = Bre + 1024;
    LAS float* Pre = Bim + 1024;
    LAS float* Pim = Pre + 17 * 64;
    LAS float* Kt = Pim + 17 * 64;
    const int tid = F.tid;
    for (int i = tid; i < 1024; i += 512) { Cre[i] = c_re[g * 1024 + i]; Cim[i] = c_im[g * 1024 + i]; }
    if (tid < 64) {
        const int p = tid; const float lr = lam_re[g * 64 + p], li = lam_im[g * 64 + p], dt = expf(log_dt[g]);
        const float er = expf(lr * dt), lbr = er * cosf(li * dt), lbi = er * sinf(li * dt);
        const float den = lr * lr + li * li, nr = lbr - 1.0f, ni = lbi;
        const float cr = (nr * lr + ni * li) / den, ci = (ni * lr - nr * li) / den;
        { float pr = 1.f, pi = 0.f; for (int k = 0; k <= 16; ++k) { Pre[k * 64 + p] = pr; Pim[k * 64 + p] = pi; const float nr2 = pr * lbr - pi * lbi, ni2 = pr * lbi + pi * lbr; pr = nr2; pi = ni2; } }
        { f32x4 brv[4], biv[4];
#pragma unroll
          for (int j = 0; j < 4; ++j) { brv[j] = *(const f32x4*)(b_re + (g * 64 + p) * 16 + 4 * j); biv[j] = *(const f32x4*)(b_im + (g * 64 + p) * 16 + 4 * j); }
          asm volatile("" ::: "memory");
#pragma unroll
          for (int j = 0; j < 4; ++j) { *(LAS f32x4*)(Bre + p * 16 + 4 * j) = brv[j] * cr - biv[j] * ci; *(LAS f32x4*)(Bim + p * 16 + 4 * j) = biv[j] * cr + brv[j] * ci; } }
    }
    __syncthreads();
    {
        const int kc = tid & 255, k = kc >> 4, c = kc & 15, ph = tid >> 8; float a16[16];
#pragma unroll
        for (int i = 0; i < 16; ++i) a16[i] = 0.f;
        for (int p = 32 * ph; p < 32 * ph + 32; ++p) {
            const float cr_ = Cre[c * 64 + p], ci_ = Cim[c * 64 + p], pr_ = Pre[k * 64 + p], pi_ = Pim[k * 64 + p];
            const float xr = cr_ * pr_ - ci_ * pi_, xi = cr_ * pi_ + ci_ * pr_;
#pragma unroll
            for (int j = 0; j < 4; ++j) { const f32x4 br = *(const LAS f32x4*)(Bre + p * 16 + 4 * j), bi = *(const LAS f32x4*)(Bim + p * 16 + 4 * j);
#pragma unroll
                for (int i = 0; i < 4; ++i) a16[4 * j + i] += xr * br[i] - xi * bi[i]; }
        }
        LAS float* Kh = Kt + 4096;
        if (ph == 1) {
#pragma unroll
            for (int j = 0; j < 4; ++j) *(LAS f32x4*)(Kh + kc * 16 + 4 * j) = (f32x4){a16[4 * j], a16[4 * j + 1], a16[4 * j + 2], a16[4 * j + 3]}; }
        __syncthreads();
        if (ph == 0) {
#pragma unroll
            for (int j = 0; j < 4; ++j) { const f32x4 o = *(const LAS f32x4*)(Kh + kc * 16 + 4 * j); f32x4 r = (f32x4){a16[4 * j], a16[4 * j + 1], a16[4 * j + 2], a16[4 * j + 3]} + o;
                if (k == 0 && (c >> 2) == j) r[c & 3] += dsk[g * 16 + c];
                *(LAS f32x4*)(Kt + kc * 16 + 4 * j) = r; } }
    }
    __syncthreads();
    unsigned* btt = (unsigned*)(F.ws + WS_BTT) + (size_t)g * 256 * (S5K / 2);
    for (int e = tid; e < 256 * (S5K / 2); e += 512) {
        const int row = e / (S5K / 2), cpair = e % (S5K / 2), t = row >> 4, c = row & 15, col = 2 * cpair; float v0, v1;
        if (col < S5Q) { const int p = col >> 1; const float xr = Cre[c * 64 + p] * Pre[(t + 1) * 64 + p] - Cim[c * 64 + p] * Pim[(t + 1) * 64 + p], xi = Cre[c * 64 + p] * Pim[(t + 1) * 64 + p] + Cim[c * 64 + p] * Pre[(t + 1) * 64 + p];
            v0 = xr; v1 = -xi; }
        else { const int s = (col - S5Q) >> 4, cp = (col - S5Q) & 15;
            if (s <= t) { v0 = Kt[(t - s) * 256 + c * 16 + cp]; v1 = Kt[(t - s) * 256 + c * 16 + cp + 1]; } else { v0 = 0.f; v1 = 0.f; } }
        btt[e] = pk2(v0, v1);
    }
    unsigned* btw = (unsigned*)(F.ws + WS_BTW) + (size_t)g * 128 * 128;
    for (int e = tid; e < 128 * 128; e += 512) {
        const int q = e >> 7, cpair = e & 127, col = 2 * cpair, s = col >> 4, cp = col & 15, p = q >> 1, k = 15 - s;
        const float pr = Pre[k * 64 + p], pi = Pim[k * 64 + p];
        float v0, v1;
        if (q & 1) { v0 = pr * Bim[p * 16 + cp] + pi * Bre[p * 16 + cp]; v1 = pr * Bim[p * 16 + cp + 1] + pi * Bre[p * 16 + cp + 1]; }
        else { v0 = pr * Bre[p * 16 + cp] - pi * Bim[p * 16 + cp]; v1 = pr * Bre[p * 16 + cp + 1] - pi * Bim[p * 16 + cp + 1]; }
        btw[e] = pk2(v0, v1);
    }
    if (tid < 64) { float* l16 = (float*)(F.ws + SM_LAM16) + (g * 64 + tid) * 2; l16[0] = Pre[16 * 64 + tid]; l16[1] = Pim[16 * 64 + tid]; }
    __syncthreads();
}

struct In { const float* p[30]; };

__device__ __forceinline__ void p0_prologue(const Frame& F, const In& I) {
    for (int g = F.vcu; g < S5G; g += F.G) s5_tables(F, g, I.p[3], I.p[4], I.p[5], I.p[6], I.p[7], I.p[8], I.p[9], I.p[10]);
    const int gt = F.vcu * 512 + F.tid, NGT = F.G * 512;
    { float* lc = (float*)(F.ws + SM_LRUC); for (int i = gt; i < LRUW; i += NGT) { const float lam = I.p[18][i]; lc[i] = -8.0f * log1pf(expf(-lam)) * 1.44269504f; } }
    { bf16* wrt = (bf16*)(F.ws + SM_WRT);
        for (int i = gt; i < 2 * 65536; i += NGT) { const int which = i >> 16, r = i & 65535, h = r >> 12, j = (r >> 6) & 63, k = r & 63; const float* src = which ? I.p[16] : I.p[14]; wrt[i] = (bf16)f2bf(src[(h * 64 + k) * 64 + j]); } }
    { bf16* rhi = (bf16*)(F.ws + SM_RHI); bf16* rlo = (bf16*)(F.ws + SM_RLO);
        for (int i = gt; i < NROUT * 1024; i += NGT) { const int n = i >> 10, k = i & 1023; float w = 0.f; if (n < 4) w = I.p[22][k * 4 + n]; else if (n < 36) w = I.p[24][k * 32 + (n - 4)];
            const unsigned h = f2bf(w); rhi[i] = (bf16)h; rlo[i] = (bf16)f2bf(w - bf2f(h)); } }
    { const int skip = F.G > 2 * S5G ? S5G : 0;
      if (F.vcu >= skip) {
        for (int nb = F.vcu - skip; nb < NIN / 32; nb += F.G - skip) win_to_i8(F, I.p[2], nb);
        const int gw2 = (F.vcu - skip) * NWAVES + F.wave, NGW2 = (F.G - skip) * NWAVES;
        for (int m = gw2 * 4; m < T; m += NGW2 * 4) rms_rows_to_i8<4>(I.p[0] + (size_t)m * D, I.p[1], F.ws + WS_H + (size_t)m * D, (float*)(F.ws + SM_HSC) + m, F.lane); } }
}
__device__ __forceinline__ void late_weight_copies(const Frame& F, const In& I, int gw, int NGW) {
    LAS float* scr = (LAS float*)(F.lds + F.wave * 16384);
    constexpr int I_S5 = (S5W / 64) * (2 * D / 32), I_LRU = (D / 64) * (D / 32), I_O = I_LRU;
    constexpr int NITEMS = I_S5 + I_LRU + I_O;
    for (int it = gw; it < NITEMS; it += NGW) {
        int r = it; TItem ti;
        if (r < I_S5) { const int nb = 2 * D / 32, kb = r / nb, n0 = 32 * (r % nb); ti = TItem{I.p[11], 2 * D, (bf16*)(F.ws + WS_WS5), S5W, 64 * kb, n0, n0 < D ? ileave_row(n0, 0) : ileave_row(n0 - D, 1)}; }
        else if ((r -= I_S5) < I_LRU) { const int nb = D / 32, kb = r / nb, n0 = 32 * (r % nb); ti = TItem{I.p[19], D, (bf16*)(F.ws + WS_WLRU), D, 64 * kb, n0, n0}; }
        else { r -= I_LRU; const int nb = D / 32, kb = r / nb, n0 = 32 * (r % nb); ti = TItem{I.p[20], D, (bf16*)(F.ws + WS_WO), D, 64 * kb, n0, n0}; }
        f32x4 tv[8]; transpose_load(ti, tv, F.lane); asm volatile("" ::: "memory"); transpose_store(ti, tv, scr, F.lane);
    }
    __syncthreads();
}
__device__ __forceinline__ TItem expert_item(const Frame& F, const In& I, int it) {
    const int e = it >> 9, half = (it >> 8) & 1, r = it & 255, nb = DEXP / 32, kb = r / nb, n0 = 32 * (r % nb);
    return TItem{(half ? I.p[27] : I.p[26]) + (size_t)e * D * DEXP, DEXP, (bf16*)(F.ws + WS_WGU + (size_t)e * 1024 * 1024), D, 64 * kb, n0, ileave_row(n0, half)};
}
__device__ __forceinline__ TItem expert_item_d(const Frame& F, const In& I, int it) {
    const int e = it >> 8, r = it & 255, nb = D / 32, kb = r / nb, n0 = 32 * (r % nb);
    return TItem{I.p[28] + (size_t)e * DEXP * D, D, (bf16*)(F.ws + WS_WD + (size_t)e * 1024 * DEXP), DEXP, 64 * kb, n0, n0};
}
__device__ __forceinline__ void expert_weight_copies(const Frame& F, const In& I) {
    LAS float* scr = (LAS float*)(F.lds + F.wave * 16384);
    const int gw = F.vcu * NWAVES + F.wave, NGW = F.G * NWAVES;
    constexpr int NIT = NEXP * 512;
    for (int it = 8 * NGW + gw; it < NIT; it += NGW) { const TItem t0 = expert_item(F, I, it); f32x4 v0[8]; transpose_load(t0, v0, F.lane); asm volatile("" ::: "memory"); transpose_store_fp8(t0, v0, scr, F.lane); }
}
__device__ __forceinline__ void expert_down_copies(const Frame& F, const In& I) {
    LAS float* scr = (LAS float*)(F.lds + F.wave * 16384);
    const int nunits = (int)F.MISC[128] * 4, rem = nunits % F.G, nbusy = rem;
    const int nfree = F.G - nbusy;
    if (F.vcu < nbusy) return;
    const int gw = (F.vcu - nbusy) * NWAVES + F.wave, NGW = nfree * NWAVES;
    constexpr int NIT = NEXP * 256;
    for (int it = gw; it < NIT; it += 2 * NGW) {
        const TItem t0 = expert_item_d(F, I, it); const bool has1 = it + NGW < NIT; const TItem t1 = expert_item_d(F, I, has1 ? it + NGW : it);
        f32x4 v0[8], v1[8]; transpose_load(t0, v0, F.lane); transpose_load(t1, v1, F.lane); asm volatile("" ::: "memory");
        transpose_store_fp8(t0, v0, scr, F.lane); if (has1) transpose_store_fp8(t1, v1, scr, F.lane);
    }
}

__device__ __forceinline__ void lru_seq(const Frame& F, const In& I) {
    LAS unsigned char* wl = F.lds + F.wave * 17920;
    LAS bf16* xcA = (LAS bf16*)wl;
    LAS float* pre = (LAS float*)(wl + 9216);
    typedef float f32x2 __attribute__((ext_vector_type(2)));
    LAS f32x2* sumT = (LAS f32x2*)(F.lds + 143360);
    const int lane = F.lane, jj = lane & 15, ks = lane >> 4, c32 = lane & 31, th = lane >> 5;
    const bf16* XL = (const bf16*)(F.ws + WS_XL); const bf16* GL = (const bf16*)(F.ws + WS_GL); bf16* YL = (bf16*)(F.ws + WS_H);
    const bf16* WRT = (const bf16*)(F.ws + SM_WRT);
    for (int un = F.vcu; un < BATCH * LRUH * 2; un += F.G) {
        const int b = un >> 5, hd = (un >> 1) & 15, half = un & 1;
        const int chin = hd * 64 + lane;
        const int chg = hd * 64 + 32 * half + c32;
        const float w0 = I.p[12][chin], w1 = I.p[12][1024 + chin], w2 = I.p[12][2048 + chin], w3 = I.p[12][3072 + chin], cb = I.p[13][chin];
        const float brs = I.p[15][chg] * -1.44269504f, bis = I.p[17][chg] * -1.44269504f, cch2 = ((const float*)(F.ws + SM_LRUC))[chg];
        float Rc = 0.f;
        for (int rd = 0; rd < 8; ++rd) {
            const int j = rd * 8 + F.wave;
            const size_t tok0 = (size_t)b * SEQ + (size_t)j * LRUCH;
#define LRU_LD16(dst, vo, IMM, BASE) asm volatile("global_load_ushort %0, %1, %2 offset:" #IMM : "=v"(dst) : "v"(vo), "s"(BASE) : "memory")
#define LRU_LD16NT(dst, vo, IMM, BASE) asm volatile("global_load_ushort %0, %1, %2 offset:" #IMM " nt" : "=v"(dst) : "v"(vo), "s"(BASE) : "memory")
            unsigned xr[64], xh[3] = {0u, 0u, 0u};
            const unsigned xo = (unsigned)((tok0 * 1024 + chin) * 2), go = (unsigned)((tok0 * 1024 + chg) * 2);
            { if (j > 0) { const unsigned oh = xo - 4096u; LRU_LD16(xh[0], oh, -2048, XL); LRU_LD16(xh[1], oh, 0, XL); LRU_LD16(xh[2], oh, 2048, XL); }
              unsigned ob = xo + 4096u;
#pragma unroll
              for (int k = 0; k < 16; ++k) { LRU_LD16(xr[4 * k], ob, -4096, XL); LRU_LD16(xr[4 * k + 1], ob, -2048, XL); LRU_LD16(xr[4 * k + 2], ob, 0, XL); LRU_LD16(xr[4 * k + 3], ob, 2048, XL); ob += 8192u; } }
            VM_WAIT();
#pragma unroll
            for (int t = 0; t < 64; ++t) asm volatile("" : "+v"(xr[t]));
            asm volatile("" : "+v"(xh[0]), "+v"(xh[1]), "+v"(xh[2]));
            { typedef float f2v __attribute__((ext_vector_type(2)));
              float xm3 = bf2f(xh[0]), xm2 = bf2f(xh[1]), xm1 = bf2f(xh[2]);
              const f2v vw0 = {w0, w0}, vw1 = {w1, w1}, vw2 = {w2, w2}, vw3 = {w3, w3}, vcb = {cb, cb};
#pragma unroll
              for (int t = 0; t < 64; t += 2) { const float x0 = bf2f(xr[t]), x1 = bf2f(xr[t + 1]);
                  f2v xc = vcb + vw0 * (f2v){xm3, xm2}; xc = xc + vw1 * (f2v){xm2, xm1}; xc = xc + vw2 * (f2v){xm1, x0}; xc = xc + vw3 * (f2v){x0, x1};
                  const unsigned pk = pg8::cvt_pk_bf16(xc.x, xc.y);
                  xcA[t * 72 + lane] = (bf16)(pk & 0xffffu); xcA[(t + 1) * 72 + lane] = (bf16)(pk >> 16);
                  xm3 = xm1; xm2 = x0; xm1 = x1; } }
            LDS_WAIT();
            float hl[2][16], Pl[2][16], Prun[2], Hrun[2];
#pragma unroll
            for (int st = 0; st < 2; ++st) {
                bf16x8 Bw[4][2];
#pragma unroll
                for (int n = 0; n < 4; ++n)
#pragma unroll
                    for (int k = 0; k < 2; ++k) Bw[n][k] = *(const bf16x8*)(WRT + (size_t)(n >> 1) * 65536 + (size_t)(hd * 64 + 32 * half + 16 * (n & 1) + jj) * 64 + 32 * k + 8 * ks);
#pragma unroll
                for (int mh = 0; mh < 2; ++mh) { const int mt = 2 * st + mh;
                    bf16x8 a[2];
#pragma unroll
                    for (int k = 0; k < 2; ++k) a[k] = *(const LAS bf16x8*)(xcA + (16 * mt + jj) * 72 + 32 * k + 8 * ks);
#pragma unroll
                    for (int n = 0; n < 4; ++n) { f32x4 d = (f32x4){0.f, 0.f, 0.f, 0.f};
#pragma unroll
                        for (int k = 0; k < 2; ++k) d = __builtin_amdgcn_mfma_f32_16x16x32_bf16(a[k], Bw[n][k], d, 0, 0, 0);
#pragma unroll
                        for (int r = 0; r < 4; ++r) pre[(16 * mh + 4 * ks + r) * 68 + 16 * n + jj] = d[r]; } }
                LDS_WAIT();
                float h = 0.f, P = 1.f;
                typedef float f2v __attribute__((ext_vector_type(2)));
#pragma unroll
                for (int tl = 0; tl < 16; tl += 2) {
                    const int trow = 16 * th + tl;
                    const f2v pr = {pre[trow * 68 + c32], pre[(trow + 1) * 68 + c32]}, pi = {pre[trow * 68 + 32 + c32], pre[(trow + 1) * 68 + 32 + c32]};
                    const f2v zr = pr * (f2v){-1.44269504f, -1.44269504f} + (f2v){brs, brs}, zi = pi * (f2v){-1.44269504f, -1.44269504f} + (f2v){bis, bis};
                    const f2v er = {__builtin_amdgcn_exp2f(zr.x), __builtin_amdgcn_exp2f(zr.y)}, ei = {__builtin_amdgcn_exp2f(zi.x), __builtin_amdgcn_exp2f(zi.y)};
                    const f2v dr = er + (f2v){1.f, 1.f};
                    const f2v rg = {__builtin_amdgcn_rcpf(dr.x), __builtin_amdgcn_rcpf(dr.y)};
                    const f2v la2 = rg * (f2v){cch2, cch2};
                    const f2v a_ = {__builtin_amdgcn_exp2f(la2.x), __builtin_amdgcn_exp2f(la2.y)};
                    const f2v x2 = la2 * (f2v){1.38629436f, 1.38629436f};
                    f2v q = x2 * (f2v){0.0013888889f, 0.0013888889f} + (f2v){0.0083333333f, 0.0083333333f};
                    q = q * x2 + (f2v){0.041666667f, 0.041666667f}; q = q * x2 + (f2v){0.16666667f, 0.16666667f}; q = q * x2 + (f2v){0.5f, 0.5f}; q = q * x2 + (f2v){1.f, 1.f};
                    f2v om = -(q * x2);
                    const f2v alt = (f2v){1.f, 1.f} - a_ * a_;
                    om.x = x2.x > -0.3f ? om.x : alt.x; om.y = x2.y > -0.3f ? om.y : alt.y;
                    om.x = fmaxf(om.x, 1e-30f); om.y = fmaxf(om.y, 1e-30f);
                    const f2v dd = ei + (f2v){1.f, 1.f};
                    const f2v rq = om * dd * dd;
                    const f2v mi = om * (f2v){__builtin_amdgcn_rsqf(rq.x), __builtin_amdgcn_rsqf(rq.y)};
                    const f2v bx = mi * (f2v){bf2f(xcA[(32 * st + trow) * 72 + 32 * half + c32]), bf2f(xcA[(32 * st + trow + 1) * 72 + 32 * half + c32])};
                    h = a_.x * h + bx.x; P *= a_.x; hl[st][tl] = h; Pl[st][tl] = P;
                    h = a_.y * h + bx.y; P *= a_.y; hl[st][tl + 1] = h; Pl[st][tl + 1] = P;
                }
                Prun[st] = P; Hrun[st] = h;
                LDS_WAIT();
            }
            const float pP0 = __shfl_xor(Prun[0], 32), pH0 = __shfl_xor(Hrun[0], 32), pP1 = __shfl_xor(Prun[1], 32), pH1 = __shfl_xor(Hrun[1], 32);
            const float P0 = th ? pP0 : Prun[0], H0 = th ? pH0 : Hrun[0], P1 = th ? Prun[0] : pP0, H1 = th ? Hrun[0] : pH0;
            const float P2 = th ? pP1 : Prun[1], H2 = th ? pH1 : Hrun[1], P3 = th ? Prun[1] : pP1, H3 = th ? Hrun[1] : pH1;
            const float C1 = H0, Q1 = P0, C2 = P1 * C1 + H1, Q2 = P1 * Q1, C3 = P2 * C2 + H2, Q3 = P2 * Q2, Hc = P3 * C3 + H3, Pc = P3 * Q3;
            const float Cs0 = th ? C1 : 0.f, Qs0 = th ? Q1 : 1.f, Cs1 = th ? C3 : C2, Qs1 = th ? Q3 : Q2;
            const int cit = (rd * F.G + F.vcu) * NWAVES + F.wave; const bool cdo = cit < NEXP * 512;
            f32x4 ctv[8]; unsigned ggr[2][16];
            if (cdo) { const TItem citem = expert_item(F, I, cit); transpose_load(citem, ctv, lane); }
#pragma unroll
            for (int st = 0; st < 2; ++st) { unsigned og = go + (unsigned)(32 * st + 16 * th) * 2048u + 4096u;
#pragma unroll
                for (int k = 0; k < 4; ++k) { LRU_LD16NT(ggr[st][4 * k], og, -4096, GL); LRU_LD16NT(ggr[st][4 * k + 1], og, -2048, GL); LRU_LD16NT(ggr[st][4 * k + 2], og, 0, GL); LRU_LD16NT(ggr[st][4 * k + 3], og, 2048, GL); og += 8192u; } }
            asm volatile("" ::: "memory");
            if (th == 0) sumT[((rd & 1) * 8 + F.wave) * 32 + c32] = (f32x2){Pc, Hc};
            LDS_WAIT(); asm volatile("" ::: "memory");
            __builtin_amdgcn_s_barrier();
            asm volatile("" ::: "memory");
            float cin = Rc, mycin = 0.f;
#pragma unroll
            for (int w = 0; w < 8; ++w) { const f32x2 ph = sumT[((rd & 1) * 8 + w) * 32 + c32]; mycin = (w == F.wave) ? cin : mycin; cin = ph.x * cin + ph.y; }
            Rc = cin;
            VM_WAIT();
#pragma unroll
            for (int st = 0; st < 2; ++st)
#pragma unroll
                for (int tl = 0; tl < 16; ++tl) asm volatile("" : "+v"(ggr[st][tl]));
#pragma unroll
            for (int st = 0; st < 2; ++st) { const float hin = (st ? Cs1 : Cs0) + (st ? Qs1 : Qs0) * mycin;
#pragma unroll
                for (int k = 0; k < 4; ++k) { const unsigned oy = go + (unsigned)(32 * st + 16 * th + 4 * k) * 2048u + 4096u;
#define LRU_ST16(TL, IMM) do { const float hh_ = hl[st][TL] + Pl[st][TL] * hin; const unsigned yv_ = f2bf(hh_ * bf2f(ggr[st][TL])); asm volatile("global_store_short %0, %1, %2 offset:" #IMM :: "v"(oy), "v"(yv_), "s"(YL) : "memory"); } while (0)
                    LRU_ST16(4 * k, -4096); LRU_ST16(4 * k + 1, -2048); LRU_ST16(4 * k + 2, 0); LRU_ST16(4 * k + 3, 2048); } }
#undef LRU_ST16
            if (cdo) { const TItem citem = expert_item(F, I, cit); transpose_store_fp8(citem, ctv, pre, lane); }
        }
#undef LRU_LD16
#undef LRU_LD16NT
        __syncthreads();
    }
}

__device__ __forceinline__ void s5_chain(const Frame& F, int b, int g) {
    typedef float f32x2 __attribute__((ext_vector_type(2)));
    LAS f32x2* segE = (LAS f32x2*)(F.lds + TOKL_OFF);
    const int lane = F.lane, w = F.wave;
    unsigned* AGw = (unsigned*)(F.ws + WS_AG); const float* L16 = (const float*)(F.ws + SM_LAM16);
    const float lr = L16[(g * 64 + lane) * 2], li = L16[(g * 64 + lane) * 2 + 1];
    const LAS float* sl = (const LAS float*)F.lds + (32 * w) * S5Q + 2 * lane;
    unsigned* ag = AGw + ((size_t)(g * S5N + b * S5NCH + 32 * w)) * (S5K / 2) + lane;
    float xr[32], xi[32];
#pragma unroll
    for (int u = 0; u < 32; ++u) { const f32x2 v = *(const LAS f32x2*)(sl + u * S5Q); xr[u] = v.x; xi[u] = v.y; }
    asm volatile("" ::: "memory");
    float sr = 0.f, si = 0.f;
#pragma unroll
    for (int u = 0; u < 32; ++u) { const float nr = lr * sr - li * si + xr[u], ni = lr * si + li * sr + xi[u]; xr[u] = sr; xi[u] = si; sr = nr; si = ni; }
    segE[w * 64 + lane] = (f32x2){sr, si};
    float qr = lr, qi = li;
#pragma unroll
    for (int k = 0; k < 5; ++k) { const float nr = qr * qr - qi * qi, ni = 2.f * qr * qi; qr = nr; qi = ni; }
    LDS_WAIT();
    __syncthreads();
    float cr = 0.f, ci = 0.f;
    for (int ww = 0; ww < w; ++ww) { const f32x2 e = segE[ww * 64 + lane]; const float nr = qr * cr - qi * ci + e.x, ni = qr * ci + qi * cr + e.y; cr = nr; ci = ni; }
#pragma unroll
    for (int u = 0; u < 32; ++u) { ag[(size_t)u * (S5K / 2)] = pk2(xr[u] + cr, xi[u] + ci); const float nr = lr * cr - li * ci, ni = lr * ci + li * cr; cr = nr; ci = ni; }
    __syncthreads();
}

__device__ __forceinline__ void p8_router(const Frame& F, const In& I) {
    const int lane = F.lane, tk = lane & 15, ks = lane >> 4;
    LAS float* lg = (LAS float*)(F.lds + F.wave * 4096);
    volatile LAS unsigned* cntL = F.MISC + 32; volatile LAS unsigned* baseL = F.MISC + 64;
    const float* X1 = I.p[0]; unsigned char* H2 = F.ws + WS_H2; const float* gf = I.p[21];
    const unsigned char* D8 = (const unsigned char*)(F.ws + WS_D8); const float* DSC = (const float*)(F.ws + WS_DSC);
    const bf16* RHI = (const bf16*)(F.ws + SM_RHI); const bf16* RLO = (const bf16*)(F.ws + SM_RLO);
    float* RSTD = (float*)(F.ws + SM_RSTD); unsigned* gcnt = F.ctl + CW_CNT;
    int* LTOK = (int*)(F.ws + WS_LTOK); float* LW = (float*)(F.ws + WS_LW); int* TOKE = (int*)(F.ws + WS_TOKE); int* TOKR = (int*)(F.ws + WS_TOKR);
    for (int blk = F.vcu; blk < T / 128; blk += F.G) {
        if (F.tid < 32) cntL[F.tid] = 0u;
        __syncthreads();
        const int tok0 = blk * 128 + F.wave * 16;
        const float* xrow = X1 + (size_t)(tok0 + tk) * D + 8 * ks; unsigned char* hrow = H2 + (size_t)(tok0 + tk) * D + 8 * ks;
        f32x4 acc[3]; acc[0] = acc[1] = acc[2] = (f32x4){0.f, 0.f, 0.f, 0.f}; float ss = 0.f;
        const unsigned char* drow = D8 + (size_t)(tok0 + tk) * D + 8 * ks; const float* dsc = DSC + (size_t)(tok0 + tk) * 16;
        f32x4 xnx[4][2]; v2u dnx[4]; float snx[2];
#pragma unroll
        for (int q = 0; q < 4; ++q) { xnx[q][0] = *((const f32x4*)(xrow + 32 * q)); xnx[q][1] = *((const f32x4*)(xrow + 32 * q + 4)); dnx[q] = *(const v2u*)(drow + 32 * q); }
        snx[0] = dsc[0]; snx[1] = dsc[4];
        LAS bf16* slab = (LAS bf16*)(F.lds + 32768);
        v4u wst[3];
#define RT_SLAB_LOAD(g) do { _Pragma("unroll") for (int j = 0; j < 3; ++j) { const int c = F.tid + 512 * j, which = c / 768, r = (c % 768) >> 4, kq = c & 15; \
            wst[j] = *(const v4u*)((which ? RLO : RHI) + (size_t)r * D + 128 * (g) + 8 * kq); } } while (0)
#define RT_SLAB_STORE(buf) do { _Pragma("unroll") for (int j = 0; j < 3; ++j) { const int c = F.tid + 512 * j, which = c / 768, r = (c % 768) >> 4, kq = c & 15; \
            *(LAS v4u*)(slab + ((size_t)((buf) * 2 + which) * 48 + r) * 136 + 8 * kq) = wst[j]; } } while (0)
        RT_SLAB_LOAD(0); RT_SLAB_STORE(0);
        LDS_WAIT();
        __syncthreads();
        for (int kg = 0; kg < 8; ++kg) {
            f32x4 xa[4][2];
#pragma unroll
            for (int q = 0; q < 4; ++q) { const float sq = snx[q >> 1]; const v2u dq = dnx[q];
                xa[q][0] = xnx[q][0] + (f32x4){(float)((int)(dq.x << 24) >> 24), (float)((int)(dq.x << 16) >> 24), (float)((int)(dq.x << 8) >> 24), (float)((int)dq.x >> 24)} * sq;
                xa[q][1] = xnx[q][1] + (f32x4){(float)((int)(dq.y << 24) >> 24), (float)((int)(dq.y << 16) >> 24), (float)((int)(dq.y << 8) >> 24), (float)((int)dq.y >> 24)} * sq; }
            { const int kgn = kg < 7 ? kg + 1 : kg;
#pragma unroll
              for (int q = 0; q < 4; ++q) { xnx[q][0] = *((const f32x4*)(xrow + 32 * (4 * kgn + q))); xnx[q][1] = *((const f32x4*)(xrow + 32 * (4 * kgn + q) + 4)); dnx[q] = *(const v2u*)(drow + 32 * (4 * kgn + q)); }
              { const int G0 = 2 * kgn, G1 = 2 * kgn + 1; snx[0] = dsc[(G0 & 3) * 4 + (G0 >> 2)]; snx[1] = dsc[(G1 & 3) * 4 + (G1 >> 2)]; }
              RT_SLAB_LOAD(kgn); }
            f32x4 ga[4][2];
#pragma unroll
            for (int q = 0; q < 4; ++q) { const int kc = 4 * kg + q; ga[q][0] = *(const f32x4*)(gf + 32 * kc + 8 * ks); ga[q][1] = *(const f32x4*)(gf + 32 * kc + 8 * ks + 4); }
            asm volatile("" ::: "memory");
            const LAS bf16* sh = slab + (size_t)((kg & 1) * 2) * 48 * 136, * sl = sh + 48 * 136;
#pragma unroll
            for (int q = 0; q < 4; ++q) { const int kc = 4 * kg + q;
                const f32x4 a0 = xa[q][0], a1 = xa[q][1];
                ss += (a0.x * a0.x + a0.y * a0.y) + (a0.z * a0.z + a0.w * a0.w) + (a1.x * a1.x + a1.y * a1.y) + (a1.z * a1.z + a1.w * a1.w);
                const f32x4 v0 = a0 * ga[q][0], v1 = a1 * ga[q][1];
                v4u hi, lo;
                hi.x = pg8::cvt_pk_bf16(v0.x, v0.y); hi.y = pg8::cvt_pk_bf16(v0.z, v0.w); hi.z = pg8::cvt_pk_bf16(v1.x, v1.y); hi.w = pg8::cvt_pk_bf16(v1.z, v1.w);
                lo.x = pg8::cvt_pk_bf16(v0.x - bflo(hi.x), v0.y - bfhi(hi.x)); lo.y = pg8::cvt_pk_bf16(v0.z - bflo(hi.y), v0.w - bfhi(hi.y));
                lo.z = pg8::cvt_pk_bf16(v1.x - bflo(hi.z), v1.y - bfhi(hi.z)); lo.w = pg8::cvt_pk_bf16(v1.z - bflo(hi.w), v1.w - bfhi(hi.w));
                { f32x4 c0, c1;
#pragma unroll
                  for (int j = 0; j < 4; ++j) { c0[j] = __builtin_amdgcn_fmed3f(v0[j], -448.0f, 448.0f); c1[j] = __builtin_amdgcn_fmed3f(v1[j], -448.0f, 448.0f); }
                  v2u h8; h8.x = pk_fp8x4(c0.x, c0.y, c0.z, c0.w); h8.y = pk_fp8x4(c1.x, c1.y, c1.z, c1.w); *(v2u*)(hrow + 32 * kc) = h8; }
                const bf16x8 hf = __builtin_bit_cast(bf16x8, hi), lf = __builtin_bit_cast(bf16x8, lo);
#pragma unroll
                for (int n = 0; n < 3; ++n) {
                    const bf16x8 wh = *(const LAS bf16x8*)(sh + (16 * n + tk) * 136 + 32 * q + 8 * ks), wl = *(const LAS bf16x8*)(sl + (16 * n + tk) * 136 + 32 * q + 8 * ks);
                    acc[n] = __builtin_amdgcn_mfma_f32_16x16x32_bf16(wh, hf, acc[n], 0, 0, 0);
                    acc[n] = __builtin_amdgcn_mfma_f32_16x16x32_bf16(wh, lf, acc[n], 0, 0, 0);
                    acc[n] = __builtin_amdgcn_mfma_f32_16x16x32_bf16(wl, hf, acc[n], 0, 0, 0);
                } }
            if (kg < 7) RT_SLAB_STORE((kg + 1) & 1);
            LDS_WAIT();
            __syncthreads();
        }
#undef RT_SLAB_LOAD
#undef RT_SLAB_STORE
        ss += __shfl_xor(ss, 16); ss += __shfl_xor(ss, 32);
        const float rstd = 1.0f / sqrtf(ss * (1.f / D) + RMS_EPS);
        if (ks == 0) RSTD[tok0 + tk] = rstd;
#pragma unroll
        for (int n = 0; n < 3; ++n)
#pragma unroll
            for (int r = 0; r < 4; ++r) lg[tk * 49 + 16 * n + 4 * ks + r] = acc[n][r] * rstd;
        LDS_WAIT();
        int E1 = 0, E2 = 0; float w1 = 0.f, w2 = 0.f; unsigned r1 = 0, r2 = 0;
        if (lane < 16) {
            const LAS float* my = lg + lane * 49;
            float lgp[4];
#pragma unroll
            for (int i = 0; i < 4; ++i) lgp[i] = my[i] + I.p[23][i];
            int gi = 0; float mx = lgp[0];
#pragma unroll
            for (int i = 1; i < 4; ++i) if (lgp[i] > mx) { mx = lgp[i]; gi = i; }
            float den = 0.f;
#pragma unroll
            for (int i = 0; i < 4; ++i) den += expf(lgp[i] - mx);
            const float pg = 1.0f / den;
            float le[8];
#pragma unroll
            for (int i = 0; i < 8; ++i) le[i] = my[4 + gi * 8 + i] + I.p[25][gi * 8 + i];
            int i1 = 0; float m1 = le[0];
#pragma unroll
            for (int i = 1; i < 8; ++i) if (le[i] > m1) { m1 = le[i]; i1 = i; }
            int i2 = -1; float m2 = -3.0e38f;
#pragma unroll
            for (int i = 0; i < 8; ++i) if (i != i1 && le[i] > m2) { m2 = le[i]; i2 = i; }
            const float e2 = expf(m2 - m1);
            w1 = pg / (1.0f + e2); w2 = pg * e2 / (1.0f + e2);
            E1 = gi * 8 + i1; E2 = gi * 8 + i2;
            r1 = __hip_atomic_fetch_add((LAS unsigned*)(F.MISC + 32) + E1, 1u, __ATOMIC_RELAXED, __HIP_MEMORY_SCOPE_WORKGROUP);
            r2 = __hip_atomic_fetch_add((LAS unsigned*)(F.MISC + 32) + E2, 1u, __ATOMIC_RELAXED, __HIP_MEMORY_SCOPE_WORKGROUP);
        }
        LDS_WAIT();
        __syncthreads();
        if (F.tid < 32) { const unsigned c = cntL[F.tid]; baseL[F.tid] = c ? __hip_atomic_fetch_add(gcnt + F.tid, c, __ATOMIC_RELAXED, __HIP_MEMORY_SCOPE_AGENT) : 0u; }
        __syncthreads();
        if (lane < 16) {
            const int tok = tok0 + lane; const int k1 = (int)(baseL[E1] + r1), k2 = (int)(baseL[E2] + r2);
            LTOK[(size_t)E1 * T + k1] = tok; LW[(size_t)E1 * T + k1] = w1; LTOK[(size_t)E2 * T + k2] = tok; LW[(size_t)E2 * T + k2] = w2;
            TOKE[tok * 2] = E1; TOKE[tok * 2 + 1] = E2; TOKR[tok * 2] = k1; TOKR[tok * 2 + 1] = k2;
        }
        __syncthreads();
    }
}

__device__ __forceinline__ void moe_prefix(const Frame& F) {
    if (F.tid < 64) {
        const unsigned nt = F.tid < NEXP ? (F.ctl[CW_CNT + F.tid] + 255u) >> 8 : 0u; unsigned inc = nt;
#pragma unroll
        for (int o = 1; o < 32; o <<= 1) { const unsigned v = __shfl_up(inc, o); if (F.lane >= o) inc += v; }
        if (F.tid < NEXP) F.MISC[96 + F.tid] = inc - nt;
        if (F.tid == NEXP - 1) F.MISC[128] = inc;
    }
    LDS_WAIT();
    __syncthreads();
}
template <int MODE  >
__device__ __forceinline__ void moe_setup(const Frame& F) {
    moe_prefix(F);
    const int NT = (int)F.MISC[128];
    if (F.tid < MAXU) { const int L = F.tid * F.G + F.vcu; int e = -1, mt = 0;
        if (L < NT * 4) { const int mtg = L >> 2; e = 0; while (e < NEXP - 1 && (int)F.MISC[96 + e + 1] <= mtg) ++e; mt = mtg - (int)F.MISC[96 + e]; }
        F.MISC[136 + F.tid] = (unsigned)e; F.MISC[144 + F.tid] = (unsigned)mt; }
    __syncthreads();
    if (F.tid == 0) { int n = 0; while (n < MAXU && (int)F.MISC[136 + n] >= 0) ++n; F.MISC[152] = (unsigned)n; }
    __syncthreads();
    const int nU = (int)F.MISC[152];
    LAS int* tokL = (LAS int*)(F.lds + TOKL_OFF); LAS float* sclL = (LAS float*)(F.lds + SCLL_OFF); LAS float* scl2L = (LAS float*)(F.lds + SCL2_OFF);
    const int* LTOK = (const int*)(F.ws + WS_LTOK); const float* LW = (const float*)(F.ws + WS_LW); const float* RSTD = (const float*)(F.ws + SM_RSTD);
    for (int i = F.tid; i < nU * 256; i += 512) { const int ui = i >> 8, r = i & 255, e = (int)F.MISC[136 + ui], rank = (int)F.MISC[144 + ui] * 256 + r; const bool valid = rank < (int)F.ctl[CW_CNT + e];
        const int tok = valid ? LTOK[(size_t)e * T + rank] : 0; tokL[i] = tok; const float lw = valid ? LW[(size_t)e * T + rank] : 0.f; sclL[i] = valid ? (MODE == 0 ? RSTD[tok] : lw) : 0.f; scl2L[i] = lw; }
    LDS_WAIT(); VM_WAIT();
    __syncthreads();
}

__device__ __forceinline__ void p11_final(const Frame& F, const In& I, float* dst, bool have_prefix) {
    if (!have_prefix) moe_prefix(F);
    const int gw = F.vcu * NWAVES + F.wave, NGW = F.G * NWAVES, lane = F.lane;
    const int* TOKE = (const int*)(F.ws + WS_TOKE); const int* TOKR = (const int*)(F.ws + WS_TOKR);
    const unsigned char* YS8 = (const unsigned char*)(F.ws + WS_YS); const float* YSC = (const float*)(F.ws + WS_YS + 80 * MiB);
    const unsigned char* D8 = (const unsigned char*)(F.ws + WS_D8); const float* DSC = (const float*)(F.ws + WS_DSC); const float* X = I.p[0];
    f32x4 gfin[4];
#pragma unroll
    for (int j = 0; j < 4; ++j) gfin[j] = ((const f32x4*)I.p[29])[lane + 64 * j];
    int ee[2][2], rr[2][2];
    { const int m0 = gw * 2 < T ? gw * 2 : 0;
#pragma unroll
      for (int q = 0; q < 2; ++q) { ee[q][0] = TOKE[2 * (m0 + q)]; ee[q][1] = TOKE[2 * (m0 + q) + 1]; rr[q][0] = TOKR[2 * (m0 + q)]; rr[q][1] = TOKR[2 * (m0 + q) + 1]; } }
    for (int m0 = gw * 2; m0 < T; m0 += NGW * 2) {
        f32x4 xv[2][4]; unsigned ya[2][4], yb[2][4], yd[2][4]; f32x4 sa[2], sb[2], sd[2];
#pragma unroll
        for (int q = 0; q < 2; ++q) { const size_t s0 = (size_t)F.MISC[96 + ee[q][0]] * 256 + rr[q][0], s1 = (size_t)F.MISC[96 + ee[q][1]] * 256 + rr[q][1];
            const f32x4* xr = (const f32x4*)(X + (size_t)(m0 + q) * D) + lane; const unsigned* y0 = (const unsigned*)(YS8 + s0 * 1024) + lane; const unsigned* y1 = (const unsigned*)(YS8 + s1 * 1024) + lane;
            const unsigned* d0 = (const unsigned*)(D8 + (size_t)(m0 + q) * 1024) + lane;
#pragma unroll
            for (int j = 0; j < 4; ++j) { xv[q][j] = __builtin_nontemporal_load(xr + 64 * j); ya[q][j] = y0[64 * j]; yb[q][j] = y1[64 * j]; yd[q][j] = d0[64 * j]; }
            sa[q] = *(const f32x4*)(YSC + s0 * 16 + 4 * (lane >> 4)); sb[q] = *(const f32x4*)(YSC + s1 * 16 + 4 * (lane >> 4)); sd[q] = *(const f32x4*)(DSC + (size_t)(m0 + q) * 16 + 4 * (lane >> 4)); }
        { const int mn = m0 + NGW * 2 < T ? m0 + NGW * 2 : m0;
#pragma unroll
          for (int q = 0; q < 2; ++q) { ee[q][0] = TOKE[2 * (mn + q)]; ee[q][1] = TOKE[2 * (mn + q) + 1]; rr[q][0] = TOKR[2 * (mn + q)]; rr[q][1] = TOKR[2 * (mn + q) + 1]; } }
        asm volatile("" ::: "memory");
#pragma unroll
        for (int q = 0; q < 2; ++q) { f32x4 v[4]; float s = 0.f;
#pragma unroll
            for (int j = 0; j < 4; ++j) { const f32x4 x = xv[q][j]; const unsigned a = ya[q][j], b = yb[q][j], c = yd[q][j]; const float ka = sa[q][j], kb = sb[q][j], kc = sd[q][j];
                v[j].x = (x.x + (float)((int)(c << 24) >> 24) * kc) + (float)((int)(a << 24) >> 24) * ka + (float)((int)(b << 24) >> 24) * kb;
                v[j].y = (x.y + (float)((int)(c << 16) >> 24) * kc) + (float)((int)(a << 16) >> 24) * ka + (float)((int)(b << 16) >> 24) * kb;
                v[j].z = (x.z + (float)((int)(c << 8) >> 24) * kc) + (float)((int)(a << 8) >> 24) * ka + (float)((int)(b << 8) >> 24) * kb;
                v[j].w = (x.w + (float)((int)c >> 24) * kc) + (float)((int)a >> 24) * ka + (float)((int)b >> 24) * kb;
                s += (v[j].x * v[j].x + v[j].y * v[j].y) + (v[j].z * v[j].z + v[j].w * v[j].w); }
            const float rstd = 1.0f / sqrtf(wave_sum(s) * (1.f / D) + RMS_EPS);
            f32x4* xw = (f32x4*)(dst + (size_t)(m0 + q) * D) + lane;
#pragma unroll
            for (int j = 0; j < 4; ++j) { const f32x4 g = gfin[j]; __builtin_nontemporal_store((f32x4){v[j].x * rstd * g.x, v[j].y * rstd * g.y, v[j].z * rstd * g.z, v[j].w * rstd * g.w}, xw + 64 * j); } }
    }
}

constexpr int N_PHASES = 12;
struct Args { In in; float* out; unsigned char* ws; float* fin_dst; int ph_lo, ph_hi, li, pad; };
__global__ void __launch_bounds__(NWAVES * 64, 2) mk_fwd(Args args) {
    extern __shared__ __attribute__((aligned(16))) unsigned char lds[];
    Frame F;
    F.lds = (LAS unsigned char*)lds;
    F.MISC = (volatile LAS unsigned*)(F.lds + MISC_OFF);
    F.tid = threadIdx.x; F.lane = F.tid & 63; F.wave = __builtin_amdgcn_readfirstlane(F.tid >> 6);
    F.G = gridDim.x; { const int bx = blockIdx.x; F.vcu = (F.G % 8 == 0) ? (bx % 8) * (F.G / 8) + bx / 8 : bx; }
    F.ws = args.ws; F.out = args.out; F.ctl = (unsigned*)(args.ws + WS_CTL); F.in = nullptr;
    const In& I = args.in;
    for (int u = F.tid; u < 256; u += NWAVES * 64) F.MISC[u] = 0u;
    __syncthreads();
    const int lo = args.ph_lo, hi = args.ph_hi;
    XcdBarrier bar; bar.bar = F.ctl + CW_BAR + args.li * XCD_BAR_WORDS; bar.x = 0; bar.st = nullptr;
    if (hi - lo > 1) bar = xcd_barrier_post(F.ctl + CW_BAR + args.li * XCD_BAR_WORDS, F.MISC + 8);
    unsigned* lbw = F.ctl + CW_LB;
    if (F.tid == 0 && F.G == 256 && lo == 0 && hi == N_PHASES) {
        const unsigned v = xb_xcc_id() + 1u, prev = atomicCAS(&lbw[LB_CHK + (blockIdx.x & 7)], 0u, v); if (prev != 0u && prev != v) atomicOr(&lbw[LB_BAD], 1u); }
    bool use_local = false;
#ifndef PH_MASK
#define PH_MASK 0xFFF
#endif
#define IN(k) (((PH_MASK >> (k)) & 1) && lo <= (k) && (k) < hi)
#define SEAM(k) do { if (IN(k) && IN(NEXT_PH(k))) xcd_barrier(bar); } while (0)
#define SEAM_LOCAL(k) do { if (IN(k) && IN(NEXT_PH(k))) { if (use_local) xcd_local_barrier(bar, lbw); else xcd_barrier(bar); } } while (0)
#define NEXT_PH(k) ((k) == 2 ? 5 : (k) == 5 ? 7 : (k) + 1)
    const int cblk = (int)blockIdx.x;
    LAS unsigned char* ring = F.lds;

    if (IN(0)) { p0_prologue(F, I); SEAM(0); }
    if (F.G == 256 && lo == 0 && hi == N_PHASES) {
        if (F.tid == 0) { unsigned bad = xb_ld(&lbw[LB_BAD]);
            for (int j = 0; j < 16; ++j) { const unsigned c = xb_ld(&bar.bar[XB_XCNT(j)]); bad |= (c != 0u && c != 32u) ? 1u : 0u; }
            F.MISC[10] = bad; }
        __syncthreads();
        use_local = F.MISC[10] == 0u; }

    if (IN(1)) {
        if (F.G < 2) late_weight_copies(F, I, F.wave, NWAVES); else if (cblk & 1) late_weight_copies(F, I, (cblk >> 1) * NWAVES + F.wave, (F.G >> 1) * NWAVES);
        if (use_local && (cblk & 1)) xcd_local_barrier(bar, lbw, lbw + LB_LCP);
        DenseOrder S; S.init(F.ws + WS_H, F.ws + WS_WIN, D / 2, D / 2, T, NIN, F.G, cblk);
        EpiInProj E{(bf16*)(F.ws + WS_AG), (bf16*)(F.ws + WS_XL), (bf16*)(F.ws + WS_GL), (bf16*)(F.ws + WS_GA), (bf16*)(F.ws + WS_GB), (const float*)(F.ws + SM_HSC), (const float*)(F.ws + SM_WSC), F.lds + TOKL_OFF};
        pg8::gemm_phase<EpiInProj, DenseOrder, true>(ring, D / 2, D / 2, S, E);
        if (use_local && IN(2)) {
            xcd_local_barrier(bar, lbw, nullptr, lbw + LB_P1D + (cblk & 7));
            const int gb_ = cblk & 7;
            if (gb_ < 4) { if (F.tid == 0) { XB_SPIN(xb_ld(lbw + LB_P1D + 2 * gb_) == 0u || xb_ld(lbw + LB_P1D + 2 * gb_ + 1) == 0u, bar.bar); }
                __syncthreads(); } }
        else SEAM(1);
    }
    if (IN(2)) {
        lru_seq(F, I); __syncthreads();
        if (cblk < 256) {
            const int L = cblk, g = L >> 3, mt = L & 7;
            { S5One S{(const char*)(F.ws + WS_AG) + S5Q * 2, (const char*)(F.ws + WS_BTW), (size_t)S5N * S5K * 2, (size_t)128 * 256 * 2, S5K, g, mt};
              EpiS5State E{(LAS float*)ring};
              pg8::gemm_phase<EpiS5State, S5One, true>(ring, 256, 256, S, E); }
            LDS_WAIT();
            __syncthreads();
            s5_chain(F, mt, g);
            VM_WAIT();
            __syncthreads();
            if (F.wave == 0) { __builtin_amdgcn_fence(__ATOMIC_ACQUIRE, "agent"); VM_WAIT(); }
            __syncthreads();
            { S5One S{(const char*)(F.ws + WS_AG), (const char*)(F.ws + WS_BTT), (size_t)S5N * S5K * 2, (size_t)256 * S5K * 2, S5K, g, mt};
              EpiS5Out E{(bf16*)(F.ws + WS_GY)};
              pg8::gemm_phase<EpiS5Out, S5One, false>(ring, S5K, S5K, S, E); }
            __syncthreads();
        }
        SEAM_LOCAL(2);
    }
    if (IN(5) && use_local) {
        if (F.tid == 0) { XB_SPIN(xb_ld(lbw + LB_LCP) < 4u, bar.bar); __builtin_amdgcn_fence(__ATOMIC_ACQUIRE, "agent"); VM_WAIT(); }
        __syncthreads(); }
    if (IN(5)) {
        YaYbOrder S; S.d.init(nullptr, nullptr, D, D, T, D, F.G, cblk);
        S.GYb = (const char*)(F.ws + WS_GY); S.WS5b = (const char*)(F.ws + WS_WS5); S.YLb = (const char*)(F.ws + WS_H); S.WLb = (const char*)(F.ws + WS_WLRU);
        EpiYaYb E{EpiYa{(const bf16*)(F.ws + WS_GA), (bf16*)(F.ws + WS_XL)}, EpiYb{(const bf16*)(F.ws + WS_XL), (const bf16*)(F.ws + WS_GB), (bf16*)(F.ws + WS_GL)}};
        pg8::gemm_phase<EpiYaYb, YaYbOrder, true>(ring, D, D, S, E);
        SEAM_LOCAL(5);
    }
    if (IN(7)) {
        DenseOrder S; S.init(F.ws + WS_GL, F.ws + WS_WO, D, D, T, D, F.G, cblk);
        EpiQ8<false> E{(unsigned char*)(F.ws + WS_D8), (float*)(F.ws + WS_DSC), nullptr};
        pg8::gemm_phase<EpiQ8<false>, DenseOrder, true>(ring, D, D, S, E);
        SEAM_LOCAL(7);
    }
    if (IN(8)) { p8_router(F, I); __syncthreads(); expert_weight_copies(F, I); SEAM(8); }
    if (IN(9)) {
        moe_setup<0>(F);
        MoeOrder<true> S{(const char*)(F.ws + WS_H2), (const char*)(F.ws + WS_WGU), (size_t)1024 * 1024, D / 2, D / 2, F.G, F.vcu, F.MISC, (const LAS int*)(F.lds + TOKL_OFF)};
        EpiGU E{F.ws + WS_ACT, (const LAS float*)(F.lds + SCLL_OFF)};
        pg8::gemm_phase<EpiGU, MoeOrder<true>, true>(ring, D / 2, D / 2, S, E);
        __syncthreads();
        expert_down_copies(F, I);
        SEAM(9);
    }
    if (IN(10)) {
        if (!IN(9)) moe_setup<1>(F);
        MoeOrder<false> S{(const char*)(F.ws + WS_ACT), (const char*)(F.ws + WS_WD), (size_t)1024 * DEXP, DEXP / 2, DEXP / 2, F.G, F.vcu, F.MISC, (const LAS int*)(F.lds + TOKL_OFF)};
        EpiQ8<true> E{(unsigned char*)(F.ws + WS_YS), (float*)(F.ws + WS_YS + 80 * MiB), (const LAS float*)(F.lds + SCL2_OFF)};
        pg8::gemm_phase<EpiQ8<true>, MoeOrder<false>, true>(ring, DEXP / 2, DEXP / 2, S, E);
        SEAM(10);
    }
    if (IN(11)) { p11_final(F, I, args.fin_dst, IN(9)); }
#undef IN
#undef SEAM
}

extern "C" void kernel_launch(void* const* d_in, const int* in_sizes, int n_in, void* d_out, int out_size, void* d_ws, size_t ws_size, hipStream_t stream) {
    static int grid = 0;
    if (grid == 0) {
        if (n_in != 30 || in_sizes[0] != T * D || out_size != T * D || ws_size < WS_END) { fprintf(stderr, "kernel_launch: unexpected shapes / workspace (n_in %d, ws %zu)\n", n_in, ws_size); grid = -1; return; }
        int dev = 0, cus = 0, per_cu = 0;
        if (hipGetDevice(&dev) != hipSuccess || hipDeviceGetAttribute(&cus, hipDeviceAttributeMultiprocessorCount, dev) != hipSuccess) { grid = -1; return; }
        if (hipFuncSetAttribute((const void*)mk_fwd, hipFuncAttributeMaxDynamicSharedMemorySize, LDS_BYTES) != hipSuccess) { fprintf(stderr, "kernel_launch: hipFuncSetAttribute failed\n"); grid = -1; return; }
        if (hipOccupancyMaxActiveBlocksPerMultiprocessor(&per_cu, (const void*)mk_fwd, NWAVES * 64, LDS_BYTES) != hipSuccess || per_cu < 1) { fprintf(stderr, "kernel_launch: occupancy query says %d\n", per_cu); }
        (void)hipGetLastError();
        grid = cus;
    }
    if (grid < 0) return;
    if (hipMemsetAsync((char*)d_ws + WS_CTL, 0, CTL_ZERO_BYTES, stream) != hipSuccess) return;
    Args a{};
    for (int i = 0; i < 30; ++i) a.in.p[i] = (const float*)d_in[i];
    a.out = (float*)d_out; a.ws = (unsigned char*)d_ws; a.fin_dst = (float*)d_out;
#if defined(PROBE_LO)
    a.ph_lo = 0; a.ph_hi = PROBE_HI; a.li = 0;
#if PROBE_LO == 11
    a.fin_dst = (float*)((char*)d_ws + WS_H2);
#endif
    hipLaunchKernelGGL(mk_fwd, dim3(grid), dim3(NWAVES * 64), LDS_BYTES, stream, a);
#if PROBE_LO == 8
    hipMemsetAsync((char*)d_ws + WS_CTL + CW_CNT * 4, 0, 128, stream);
#endif
    a.fin_dst = (float*)d_out;
    a.ph_lo = PROBE_LO; a.ph_hi = N_PHASES; a.li = 1;
    hipLaunchKernelGGL(mk_fwd, dim3(grid), dim3(NWAVES * 64), LDS_BYTES, stream, a);
#elif MK_N_LAUNCHES == 1
    a.ph_lo = 0; a.ph_hi = N_PHASES;
    hipLaunchKernelGGL(mk_fwd, dim3(grid), dim3(NWAVES * 64), LDS_BYTES, stream, a);
#else
    for (int p = 0; p < N_PHASES; ++p) { a.ph_lo = p; a.ph_hi = p + 1; hipLaunchKernelGGL(mk_fwd, dim3(grid), dim3(NWAVES * 64), LDS_BYTES, stream, a); }
#endif
}
```
